# Optimizing an MI355X kernel written in HIP

```python
import jax, jax.numpy as jnp
from jax import lax
import numpy as np

D_MODEL = 1024
BATCH = 2
SEQ = 8192
DEPTH = 2

GRID_W = 64
CTX_LEN = 256
EPS = 1e-6
LRU_WIDTH = 256
LRU_BLOCKS = 4
LRU_BLOCK = LRU_WIDTH // LRU_BLOCKS
LRU_C = 8.0
CONV_W = 4
CONV_LEFT = 2
MLA_HEADS = 8
MLA_NOPE = 64
MLA_ROPE = 32
MLA_V = 64
MLA_Q_RANK = 256
MLA_KV_RANK = 128
ROPE_AXIS_FREQ = MLA_ROPE // 4
ROPE_BASE = 10000.0
Q_BLOCK = 128
ML_HEADS = 4
ML_HEAD_DIM = 64
ML_WIDTH = ML_HEADS * ML_HEAD_DIM
ML_CHUNK = 128
D_MIX = LRU_WIDTH + MLA_HEADS * MLA_V + ML_WIDTH
IN_SPLITS = (LRU_WIDTH, LRU_WIDTH, MLA_Q_RANK, MLA_KV_RANK, MLA_ROPE, ML_WIDTH, ML_WIDTH)
D_IN = sum(IN_SPLITS)
N_EXPERTS = 32
TOP_K = 4
D_EXPERT = 1024
SWIGLU_LIMIT = 7.0
SWIGLU_ALPHA = 1.702
MOE_BLOCK = 256

kernel_name = 'hybrid_lru_mla_mlstm_moe_dit'

F32 = jnp.float32


def rmsnorm(x, g):
    xf = x.astype(F32)
    y = xf * lax.rsqrt(jnp.mean(xf * xf, axis=-1, keepdims=True) + EPS)
    return (y * g.astype(F32)).astype(x.dtype)


def modulation(cvec, w_mod, b_mod):
    m = jax.nn.silu(cvec) @ w_mod + b_mod
    return [t[:, None, :] for t in jnp.split(m, 6, axis=-1)]


def short_conv(x, w, b):
    S = x.shape[1]
    xp = jnp.pad(x, ((0, 0), (CONV_LEFT, CONV_W - 1 - CONV_LEFT), (0, 0)))
    return sum(xp[:, k:k + S] * w[k] for k in range(CONV_W)) + b


def block_diag(x, w):
    G, I, J = w.shape
    y = jnp.einsum('...gi,gij->...gj', x.reshape(x.shape[:-1] + (G, I)), w)
    return y.reshape(x.shape[:-1] + (G * J,))


def flip_seq(t, rev, axis):
    return jnp.flip(t, axis=axis) if rev else t


def _lin_combine(l, r):
    a1, b1 = l
    a2, b2 = r
    return a1 * a2, a2 * b1 + b2


def linear_scan(a, b, h0):
    A, Bc = lax.associative_scan(_lin_combine, (a, b), axis=1)
    return A * h0[:, None] + Bc


def rglru_coeffs(xc, wa, ba, wx, bx, lam):
    r = jax.nn.sigmoid((block_diag(xc, wa) + ba).astype(F32))
    i = jax.nn.sigmoid((block_diag(xc, wx) + bx).astype(F32))
    log_a = LRU_C * r * jax.nn.log_sigmoid(lam.astype(F32))
    a = jnp.exp(log_a)
    b = jnp.sqrt(-jnp.expm1(2.0 * log_a)) * i * xc.astype(F32)
    return a, b


def rglru_group(u_x, u_g, uc_x, uc_g, conv_w, conv_b, wa, ba, wx, bx, lam, need_ctx):
    xl = short_conv(u_x, conv_w, conv_b)
    xc = short_conv(uc_x, conv_w, conv_b)
    B = u_x.shape[0]
    hs_l, hs_c = [], []
    for d in range(2):
        rev = d == 1
        a_c, b_c = rglru_coeffs(flip_seq(xc, rev, 1), wa[d], ba[d], wx[d], bx[d], lam[d])
        h_c = linear_scan(a_c, b_c, jnp.zeros((B, LRU_WIDTH), F32))
        a_l, b_l = rglru_coeffs(flip_seq(xl, rev, 1), wa[d], ba[d], wx[d], bx[d], lam[d])
        h_l = linear_scan(a_l, b_l, h_c[:, -1])
        hs_l.append(flip_seq(h_l, rev, 1))
        hs_c.append(flip_seq(h_c, rev, 1))
    y_l = (hs_l[0] + hs_l[1]).astype(u_x.dtype) * jax.nn.gelu(u_g)
    y_c = (hs_c[0] + hs_c[1]).astype(uc_x.dtype) * jax.nn.gelu(uc_g) if need_ctx else None
    return y_l, y_c


def rope2d(x, cos, sin):
    xs = x.reshape(x.shape[:-1] + (2, 2, ROPE_AXIS_FREQ)).astype(F32)
    x1, x2 = xs[..., 0, :], xs[..., 1, :]
    out = jnp.stack([x1 * cos - x2 * sin, x2 * cos + x1 * sin], axis=-2)
    return out.reshape(x.shape).astype(x.dtype)


def mla_project(uq, ukv, ukr, q_norm_g, w_qb, kv_norm_g, w_kvb, cos, sin):
    B, S = uq.shape[:2]
    q = (rmsnorm(uq, q_norm_g) @ w_qb).reshape(B, S, MLA_HEADS, MLA_NOPE + MLA_ROPE)
    kv = (rmsnorm(ukv, kv_norm_g) @ w_kvb).reshape(B, S, MLA_HEADS, MLA_NOPE + MLA_V)
    q_nope, q_rope = q[..., :MLA_NOPE], q[..., MLA_NOPE:]
    k_nope, v = kv[..., :MLA_NOPE], kv[..., MLA_NOPE:]
    k_rope = ukr
    if cos is not None:
        q_rope = rope2d(q_rope, cos[:, None], sin[:, None])
        k_rope = rope2d(k_rope, cos, sin)
    q = jnp.concatenate([q_nope, q_rope], axis=-1)
    k = jnp.concatenate([k_nope, jnp.broadcast_to(k_rope[:, :, None, :], (B, S, MLA_HEADS, MLA_ROPE))], axis=-1)
    return q, k, v


def attend(q, k, v):
    s = jnp.einsum('bqhd,bkhd->bhqk', q, k).astype(F32) * (MLA_NOPE + MLA_ROPE) ** -0.5
    p = jax.nn.softmax(s, axis=-1).astype(v.dtype)
    return jnp.einsum('bhqk,bkhd->bqhd', p, v)


def mla_group(uq, ukv, ukr, uq_c, ukv_c, ukr_c, q_norm_g, w_qb, kv_norm_g, w_kvb, cos, sin, need_ctx):
    B, S = uq.shape[:2]
    ql, kl, vl = mla_project(uq, ukv, ukr, q_norm_g, w_qb, kv_norm_g, w_kvb, cos, sin)
    qc, kc, vc = mla_project(uq_c, ukv_c, ukr_c, q_norm_g, w_qb, kv_norm_g, w_kvb, None, None)
    k_all = jnp.concatenate([kc, kl], axis=1)
    v_all = jnp.concatenate([vc, vl], axis=1)
    qb = ql.reshape(B, S // Q_BLOCK, Q_BLOCK, MLA_HEADS, MLA_NOPE + MLA_ROPE).transpose(1, 0, 2, 3, 4)
    ob = lax.map(lambda qi: attend(qi, k_all, v_all), qb)
    y_l = ob.transpose(1, 0, 2, 3, 4).reshape(B, S, MLA_HEADS * MLA_V)
    y_c = attend(qc, kc, vc).reshape(B, uq_c.shape[1], MLA_HEADS * MLA_V) if need_ctx else None
    return y_l, y_c


def mlstm_scan(q, k, v, ig, lf, state):
    B, H, S, d = q.shape
    nc = S // ML_CHUNK

    def to_chunks(t):
        return jnp.moveaxis(t.reshape(t.shape[:2] + (nc, ML_CHUNK) + t.shape[3:]), 2, 0)

    pos = jnp.arange(ML_CHUNK)
    lower = pos[:, None] >= pos[None, :]

    def step(carry, xs):
        C, n, m = carry
        qc, kc, vc, ic, fc = xs
        b = jnp.cumsum(fc, axis=-1)
        D = jnp.where(lower, b[..., :, None] - b[..., None, :] + ic[..., None, :], -jnp.inf)
        inter = b + m[..., None]
        m_t = jnp.maximum(inter, jnp.max(D, axis=-1))
        P = jnp.einsum('bhtk,bhsk->bhts', qc, kc) * jnp.exp(D - m_t[..., None])
        w_inter = jnp.exp(inter - m_t)
        num = jnp.einsum('bhts,bhsv->bhtv', P, vc) + w_inter[..., None] * jnp.einsum('bhvk,bhtk->bhtv', C, qc)
        den = jnp.sum(P, axis=-1) + w_inter * jnp.einsum('bhk,bhtk->bht', n, qc)
        h = num / jnp.maximum(jnp.abs(den), jnp.exp(-m_t))[..., None]
        bL = b[..., -1]
        w_s = bL[..., None] - b + ic
        m_new = jnp.maximum(bL + m, jnp.max(w_s, axis=-1))
        decay = jnp.exp(bL + m - m_new)
        w_s = jnp.exp(w_s - m_new[..., None])
        C_new = decay[..., None, None] * C + jnp.einsum('bhs,bhsv,bhsk->bhvk', w_s, vc, kc)
        n_new = decay[..., None] * n + jnp.einsum('bhs,bhsk->bhk', w_s, kc)
        return (C_new, n_new, m_new), h

    state, hs = lax.scan(step, state, (to_chunks(q), to_chunks(k), to_chunks(v), to_chunks(ig), to_chunks(lf)))
    return jnp.moveaxis(hs, 0, 2).reshape(B, H, S, d), state


def mlstm_gates(qkv, w_gate, b_gate):
    g = (qkv @ w_gate + b_gate).astype(F32)
    ig = jnp.swapaxes(g[..., :ML_HEADS], 1, 2)
    lf = jnp.swapaxes(jax.nn.log_sigmoid(g[..., ML_HEADS:]), 1, 2)
    return ig, lf


def mlstm_group(u_x, u_z, uc_x, uc_z, conv_w, conv_b, wq, wk, wv, w_gate, b_gate, norm_g, skip, need_ctx):
    def qkv(ux):
        xc = jax.nn.silu(short_conv(ux, conv_w, conv_b))
        q = block_diag(xc, wq)
        k = block_diag(xc, wk) * ML_HEAD_DIM ** -0.5
        v = block_diag(ux, wv)
        return xc, q, k, v

    def heads(t):
        B, S, _ = t.shape
        return t.reshape(B, S, ML_HEADS, ML_HEAD_DIM).transpose(0, 2, 1, 3).astype(F32)

    def finish(h, xconv, z):
        B, H, S, d = h.shape
        h = h.transpose(0, 2, 1, 3)
        mu = jnp.mean(h, axis=-1, keepdims=True)
        var = jnp.mean(jnp.square(h - mu), axis=-1, keepdims=True)
        h = ((h - mu) * lax.rsqrt(var + EPS)).reshape(B, S, H * d) * norm_g.astype(F32)
        return ((h + skip.astype(F32) * xconv.astype(F32)) * jax.nn.silu(z.astype(F32))).astype(z.dtype)

    xl, ql, kl, vl = qkv(u_x)
    xc, qc, kc, vc = qkv(uc_x)
    qkv_l = jnp.concatenate([ql, kl, vl], axis=-1)
    qkv_c = jnp.concatenate([qc, kc, vc], axis=-1)
    ql, kl, vl, qc, kc, vc = [heads(t) for t in (ql, kl, vl, qc, kc, vc)]
    B = u_x.shape[0]
    hs_l, hs_c = [], []
    for d in range(2):
        rev = d == 1
        ig_c, lf_c = mlstm_gates(qkv_c, w_gate[d], b_gate[d])
        ig_l, lf_l = mlstm_gates(qkv_l, w_gate[d], b_gate[d])
        state0 = (jnp.zeros((B, ML_HEADS, ML_HEAD_DIM, ML_HEAD_DIM), F32),
                  jnp.zeros((B, ML_HEADS, ML_HEAD_DIM), F32),
                  jnp.zeros((B, ML_HEADS), F32))
        h_c, st = mlstm_scan(*[flip_seq(t, rev, 2) for t in (qc, kc, vc, ig_c, lf_c)], state0)
        h_l, _ = mlstm_scan(*[flip_seq(t, rev, 2) for t in (ql, kl, vl, ig_l, lf_l)], st)
        hs_l.append(flip_seq(h_l, rev, 2))
        hs_c.append(flip_seq(h_c, rev, 2))
    y_l = finish(hs_l[0] + hs_l[1], xl, u_z)
    y_c = finish(hs_c[0] + hs_c[1], xc, uc_z) if need_ctx else None
    return y_l, y_c


def moe(t, w_router, b_router, w_gu, b_gu, w_down, b_down):
    T, D = t.shape
    TK = T * TOP_K
    logits = (t @ w_router + b_router).astype(F32)
    top_v, top_e = lax.top_k(logits, TOP_K)
    gate = jax.nn.softmax(top_v, axis=-1)
    flat_e = top_e.reshape(-1)
    flat_tok = jnp.arange(TK, dtype=jnp.int32) // TOP_K
    order = jnp.argsort(flat_e)
    sorted_e = flat_e[order]
    counts = jnp.zeros((N_EXPERTS,), jnp.int32).at[flat_e].add(1)
    start = jnp.cumsum(counts) - counts
    padded = (counts + MOE_BLOCK - 1) // MOE_BLOCK * MOE_BLOCK
    padded_end = jnp.cumsum(padded)
    padded_start = padded_end - padded
    dest = padded_start[sorted_e] + jnp.arange(TK, dtype=jnp.int32) - start[sorted_e]
    n_blocks = -(-TK // MOE_BLOCK) + N_EXPERTS
    P = n_blocks * MOE_BLOCK
    rows_tok = jnp.full((P,), T, jnp.int32).at[dest].set(flat_tok[order])
    rows_gate = jnp.zeros((P,), F32).at[dest].set(gate.reshape(-1)[order])
    block_e = jnp.minimum(jnp.searchsorted(padded_end, jnp.arange(n_blocks, dtype=jnp.int32) * MOE_BLOCK, side='right'), N_EXPERTS - 1)
    t_pad = jnp.concatenate([t, jnp.zeros((1, D), t.dtype)], axis=0)
    xb = t_pad[rows_tok].reshape(n_blocks, MOE_BLOCK, D)

    def expert_block(args):
        xe, e = args
        gu = xe @ w_gu[e] + b_gu[e]
        glu = jnp.minimum(gu[:, :D_EXPERT], SWIGLU_LIMIT)
        lin = jnp.clip(gu[:, D_EXPERT:], -SWIGLU_LIMIT, SWIGLU_LIMIT)
        act = glu * jax.nn.sigmoid(SWIGLU_ALPHA * glu) * (lin + 1)
        return act @ w_down[e] + b_down[e]

    yb = lax.map(expert_block, (xb, block_e))
    out = jnp.zeros((T + 1, D), t.dtype).at[rows_tok].add(yb.reshape(P, D) * rows_gate[:, None].astype(t.dtype))
    return out[:T]


def setup_inputs(seed: int = 0) -> dict:
    state = [jax.random.key(seed)]

    def nk():
        state[0], sub = jax.random.split(state[0])
        return sub

    def nrm(shape, scale):
        return jax.random.normal(nk(), shape, F32) * scale

    def gain(shape):
        return 1.0 + nrm(shape, 0.02)

    L, D = DEPTH, D_MODEL
    u = jax.random.uniform(nk(), (L, 2, LRU_WIDTH), F32, 0.9, 0.999)
    sig = u ** (1.0 / LRU_C)
    lru_lambda = jnp.log(sig) - jnp.log1p(-sig)
    ml_b_gate = jnp.concatenate([nrm((L, 2, ML_HEADS), 0.1),
                                 3.0 + 3.0 * jax.random.uniform(nk(), (L, 2, ML_HEADS), F32)], axis=-1)
    return {
        'x': nrm((BATCH, SEQ, D), 1.0),
        'c': nrm((BATCH, D), 1.0),
        'ctx': nrm((BATCH, CTX_LEN, D), 1.0),
        'c_ctx': nrm((D,), 1.0),
        'norm1_g': gain((L, D)),
        'norm2_g': gain((L, D)),
        'w_mod': nrm((L, D, 6 * D), 0.5 * D ** -0.5),
        'b_mod': nrm((L, 6 * D), 0.02),
        'w_in': nrm((L, D, D_IN), D ** -0.5),
        'w_out': nrm((L, D_MIX, D), D_MIX ** -0.5),
        'lru_conv_w': nrm((L, CONV_W, LRU_WIDTH), CONV_W ** -0.5),
        'lru_conv_b': nrm((L, LRU_WIDTH), 0.02),
        'lru_wa': nrm((L, 2, LRU_BLOCKS, LRU_BLOCK, LRU_BLOCK), LRU_BLOCK ** -0.5),
        'lru_ba': nrm((L, 2, LRU_WIDTH), 0.1),
        'lru_wx': nrm((L, 2, LRU_BLOCKS, LRU_BLOCK, LRU_BLOCK), LRU_BLOCK ** -0.5),
        'lru_bx': nrm((L, 2, LRU_WIDTH), 0.1),
        'lru_lambda': lru_lambda,
        'mla_q_norm_g': gain((L, MLA_Q_RANK)),
        'mla_w_qb': nrm((L, MLA_Q_RANK, MLA_HEADS * (MLA_NOPE + MLA_ROPE)), MLA_Q_RANK ** -0.5),
        'mla_kv_norm_g': gain((L, MLA_KV_RANK)),
        'mla_w_kvb': nrm((L, MLA_KV_RANK, MLA_HEADS * (MLA_NOPE + MLA_V)), MLA_KV_RANK ** -0.5),
        'ml_conv_w': nrm((L, CONV_W, ML_WIDTH), CONV_W ** -0.5),
        'ml_conv_b': nrm((L, ML_WIDTH), 0.02),
        'ml_wq': nrm((L, ML_HEADS, ML_HEAD_DIM, ML_HEAD_DIM), ML_HEAD_DIM ** -0.5),
        'ml_wk': nrm((L, ML_HEADS, ML_HEAD_DIM, ML_HEAD_DIM), ML_HEAD_DIM ** -0.5),
        'ml_wv': nrm((L, ML_HEADS, ML_HEAD_DIM, ML_HEAD_DIM), ML_HEAD_DIM ** -0.5),
        'ml_w_gate': nrm((L, 2, 3 * ML_WIDTH, 2 * ML_HEADS), (3 * ML_WIDTH) ** -0.5),
        'ml_b_gate': ml_b_gate,
        'ml_norm_g': gain((L, ML_WIDTH)),
        'ml_skip': gain((L, ML_WIDTH)),
        'w_router': nrm((L, D, N_EXPERTS), D ** -0.5),
        'b_router': nrm((L, N_EXPERTS), 0.01),
        'w_gu': nrm((L, N_EXPERTS, D, 2 * D_EXPERT), D ** -0.5),
        'b_gu': nrm((L, N_EXPERTS, 2 * D_EXPERT), 0.01),
        'w_down': nrm((L, N_EXPERTS, D_EXPERT, D), D_EXPERT ** -0.5),
        'b_down': nrm((L, N_EXPERTS, D), 0.01),
        'final_g': gain((D,)),
    }


def reference(x, c, ctx, c_ctx, norm1_g, norm2_g, w_mod, b_mod, w_in, w_out,
              lru_conv_w, lru_conv_b, lru_wa, lru_ba, lru_wx, lru_bx, lru_lambda,
              mla_q_norm_g, mla_w_qb, mla_kv_norm_g, mla_w_kvb,
              ml_conv_w, ml_conv_b, ml_wq, ml_wk, ml_wv, ml_w_gate, ml_b_gate, ml_norm_g, ml_skip,
              w_router, b_router, w_gu, b_gu, w_down, b_down, final_g):
    B, S, D = x.shape
    ROWS = S // GRID_W
    row = jnp.repeat(jnp.arange(ROWS, dtype=jnp.int32), GRID_W)
    col = jnp.tile(jnp.arange(GRID_W, dtype=jnp.int32), ROWS)
    freqs = ROPE_BASE ** (-jnp.arange(ROPE_AXIS_FREQ, dtype=F32) / ROPE_AXIS_FREQ)
    ang = jnp.stack([row[:, None] * freqs, col[:, None] * freqs], axis=1)
    cos, sin = jnp.cos(ang), jnp.sin(ang)
    split_at = list(np.cumsum(IN_SPLITS)[:-1])

    x_l, x_c = x, ctx
    for l in range(DEPTH):
        need_ctx = l < DEPTH - 1
        sh1, sc1, g1, sh2, sc2, g2 = modulation(c, w_mod[l], b_mod[l])
        csh1, csc1, cg1, csh2, csc2, cg2 = modulation(c_ctx[None], w_mod[l], b_mod[l])
        h = rmsnorm(x_l, norm1_g[l]) * (1 + sc1) + sh1
        hc = rmsnorm(x_c, norm1_g[l]) * (1 + csc1) + csh1
        a_x, a_g, b_q, b_kv, b_kr, m_x, m_z = jnp.split(h @ w_in[l], split_at, axis=-1)
        ac_x, ac_g, bc_q, bc_kv, bc_kr, mc_x, mc_z = jnp.split(hc @ w_in[l], split_at, axis=-1)
        ya_l, ya_c = rglru_group(a_x, a_g, ac_x, ac_g, lru_conv_w[l], lru_conv_b[l], lru_wa[l], lru_ba[l],
                                 lru_wx[l], lru_bx[l], lru_lambda[l], need_ctx)
        yb_l, yb_c = mla_group(b_q, b_kv, b_kr, bc_q, bc_kv, bc_kr, mla_q_norm_g[l], mla_w_qb[l],
                               mla_kv_norm_g[l], mla_w_kvb[l], cos, sin, need_ctx)
        yc_l, yc_c = mlstm_group(m_x, m_z, mc_x, mc_z, ml_conv_w[l], ml_conv_b[l], ml_wq[l], ml_wk[l], ml_wv[l],
                                 ml_w_gate[l], ml_b_gate[l], ml_norm_g[l], ml_skip[l], need_ctx)
        x_l = x_l + g1 * (jnp.concatenate([ya_l, yb_l, yc_l], axis=-1) @ w_out[l])
        h2 = rmsnorm(x_l, norm2_g[l]) * (1 + sc2) + sh2
        moe_args = (w_router[l], b_router[l], w_gu[l], b_gu[l], w_down[l], b_down[l])
        if need_ctx:
            x_c = x_c + cg1 * (jnp.concatenate([ya_c, yb_c, yc_c], axis=-1) @ w_out[l])
            hc2 = rmsnorm(x_c, norm2_g[l]) * (1 + csc2) + csh2
            f = moe(jnp.concatenate([h2.reshape(-1, D), hc2.reshape(-1, D)], axis=0), *moe_args)
            f_l, f_c = f[:B * S], f[B * S:]
            x_c = x_c + cg2 * f_c.reshape(x_c.shape)
        else:
            f_l = moe(h2.reshape(-1, D), *moe_args)
        x_l = x_l + g2 * f_l.reshape(x_l.shape)
    return rmsnorm(x_l, final_g)
```

```cpp
#include <hip/hip_runtime.h>
#define ONE_LAUNCH 1
#include <math.h>
#include <stdint.h>

#ifndef CFG_D_MODEL
#define CFG_D_MODEL 1024
#endif
#ifndef CFG_SEQ
#define CFG_SEQ 8192
#endif
#ifndef CFG_GRID_W
#define CFG_GRID_W 64
#endif
#ifndef CFG_CTX_LEN
#define CFG_CTX_LEN 256
#endif
#ifndef CFG_N_EXPERTS
#define CFG_N_EXPERTS 32
#endif
#ifndef CFG_D_EXPERT
#define CFG_D_EXPERT 1024
#endif

#ifdef HOST_TEST
#define HD inline
struct float4 { float x, y, z, w; };
static inline int atomic_add_i(int* p, int v) { int o = *p; *p = o + v; return o; }
#else
#define HD __device__ __forceinline__
static __device__ __forceinline__ int atomic_add_i(int* p, int v) { return atomicAdd(p, v); }
#endif

constexpr int D = CFG_D_MODEL, NB = 2, SEQ = CFG_SEQ, DEPTH = 2, GRID_W = CFG_GRID_W, CTX = CFG_CTX_LEN;
constexpr int TPB = CTX + SEQ;
constexpr int NT = NB * TPB;
constexpr int LW = 256, MLH = 4, MHD = 64, MW = 256;
constexpr int AH = 8, NOPE = 64, ROPE = 32, VD = 64, QRANK = 256, KVRANK = 128, QKD = NOPE + ROPE;
constexpr int DIN = 1440, DMIX = 1024;
constexpr int OFF_AX = 0, OFF_AG = 256, OFF_BQ = 512, OFF_BKV = 768, OFF_BKR = 896, OFF_MX = 928, OFF_MZ = 1184;
constexpr int NE = CFG_N_EXPERTS, TOPK = 4, DE = CFG_D_EXPERT;
constexpr float EPS = 1e-6f;

enum { I_X = 0, I_C, I_CTX, I_CCTX, I_N1G, I_N2G, I_WMOD, I_BMOD, I_WIN, I_WOUT, I_LCW, I_LCB, I_LWA, I_LBA, I_LWX, I_LBX, I_LLAM,
       I_QNG, I_WQB, I_KVNG, I_WKVB, I_MCW, I_MCB, I_MWQ, I_MWK, I_MWV, I_MWG, I_MBG, I_MNG, I_MSK, I_WR, I_BR, I_WGU, I_BGU, I_WD, I_BD, I_FG, N_IN };

struct P {
    const float* in[N_IN];
    float* out;
    float *MOD, *ROPET, *X, *H, *U, *XC, *LA, *LB, *HL, *QN, *KVN, *QF, *KVF, *Qr, *Kr, *Vr, *XCM, *QM, *KM, *VM, *IGF, *HM, *Y, *TOPG, *ACT, *YB;
    int *TOPE, *CNT, *LIST;
};

HD float sigmoid_f(float x) { return 1.f / (1.f + expf(-x)); }
HD float silu_f(float x) { return x * sigmoid_f(x); }
HD float logsigmoid_f(float x) { return fminf(x, 0.f) - log1pf(expf(-fabsf(x))); }
HD float gelu_f(float x) { return 0.5f * x * (1.f + tanhf(0.7978845608028654f * (x + 0.044715f * x * x * x))); }

HD int tok_b(int t) { return t / TPB; }
HD int tok_i(int t) { return t % TPB; }
HD bool tok_isctx(int t) { return tok_i(t) < CTX; }
HD int tok_cv(int t) { return tok_isctx(t) ? 2 : tok_b(t); }
HD const float* modp(const P& p, int l, int cv, int which) { return p.MOD + (((size_t)l * 3 + cv) * 6 + which) * D; }

template <int R>
HD void gemm_rx4(const float* (&a)[R], const float* B, int ldb, int K, float4 (&acc)[R]) {
    for (int k = 0; k < K; ++k) {
        const float4 bv = *(const float4*)(B + (size_t)k * ldb);
#pragma unroll
        for (int r = 0; r < R; ++r) { const float av = a[r][k]; acc[r].x += av * bv.x; acc[r].y += av * bv.y; acc[r].z += av * bv.z; acc[r].w += av * bv.w; }
    }
}

HD void nv_init(const P& p, long gtid, long nthr) {
    for (long it = gtid; it < (long)DEPTH * 6 * D; it += nthr) {
        const int l = (int)(it / (6 * D)), j = (int)(it % (6 * D));
        const float* w = p.in[I_WMOD] + (size_t)l * D * 6 * D + j;
        float a0 = 0.f, a1 = 0.f, a2 = 0.f;
        for (int k = 0; k < D; ++k) { const float wv = w[(size_t)k * 6 * D];
            a0 += silu_f(p.in[I_C][k]) * wv; a1 += silu_f(p.in[I_C][D + k]) * wv; a2 += silu_f(p.in[I_CCTX][k]) * wv; }
        const float bb = p.in[I_BMOD][(size_t)l * 6 * D + j];
        p.MOD[((size_t)l * 3 + 0) * 6 * D + j] = a0 + bb; p.MOD[((size_t)l * 3 + 1) * 6 * D + j] = a1 + bb; p.MOD[((size_t)l * 3 + 2) * 6 * D + j] = a2 + bb;
    }
    for (long it = gtid; it < (long)NT * D; it += nthr) {
        const int t = (int)(it / D), k = (int)(it % D), b = tok_b(t), i = tok_i(t);
        p.X[it] = (i < CTX) ? p.in[I_CTX][((size_t)b * CTX + i) * D + k] : p.in[I_X][((size_t)b * SEQ + (i - CTX)) * D + k];
    }
    for (long it = gtid; it < (long)SEQ * 16; it += nthr) {
        const int s = (int)(it / 16), a = (int)((it / 8) & 1), f = (int)(it & 7);
        const int pos = a == 0 ? s / GRID_W : s % GRID_W;
        const double fr = pow(10000.0, -(double)f / 8.0);
        const float frf = (float)fr;
        const double ang = (double)((float)pos * frf);
        p.ROPET[it * 2] = (float)cos(ang); p.ROPET[it * 2 + 1] = (float)sin(ang);
    }
}

HD void nv_norm(const P& p, int l, int which  , long gtid, long nthr) {
    const float* g = p.in[which == 0 ? I_N1G : I_N2G] + (size_t)l * D;
    for (long t = gtid; t < NT; t += nthr) {
        const float* x = p.X + (size_t)t * D; float ss = 0.f;
        for (int k = 0; k < D; ++k) ss += x[k] * x[k];
        const float rstd = 1.f / sqrtf(ss / (float)D + EPS);
        const int cv = tok_cv((int)t); const float* sh = modp(p, l, cv, which == 0 ? 0 : 3); const float* sc = modp(p, l, cv, which == 0 ? 1 : 4);
        float* h = p.H + (size_t)t * D;
        for (int k = 0; k < D; ++k) h[k] = x[k] * rstd * g[k] * (1.f + sc[k]) + sh[k];
    }
}

HD void nv_inproj(const P& p, int l, long gtid, long nthr) {
    constexpr int R = 8, NQ = DIN / 4; const float* W = p.in[I_WIN] + (size_t)l * D * DIN;
    for (long it = gtid; it < (long)(NT / R) * NQ; it += nthr) {
        const int mi = (int)(it / NQ), n = (int)(it % NQ) * 4;
        const float* a[R]; float4 acc[R];
#pragma unroll
        for (int r = 0; r < R; ++r) { a[r] = p.H + (size_t)(mi * R + r) * D; acc[r] = float4{0.f, 0.f, 0.f, 0.f}; }
        gemm_rx4<R>(a, W + n, DIN, D, acc);
#pragma unroll
        for (int r = 0; r < R; ++r) *(float4*)(p.U + (size_t)(mi * R + r) * DIN + n) = acc[r];
    }
}

HD float conv_at(const P& p, int t, int col, int c, const float* w  , const float* bias) {
    const int i = tok_i(t), isc = i < CTX, li = isc ? i : i - CTX, len = isc ? CTX : SEQ;
    float s = bias[c];
#pragma unroll
    for (int k = 0; k < 4; ++k) { const int j = li + k - 2; if (j >= 0 && j < len) s += w[k * 256 + c] * p.U[(size_t)(t + k - 2) * DIN + col + c]; }
    return s;
}

HD void nv_prep1(const P& p, int l, long gtid, long nthr) {
    for (long it = gtid; it < (long)NT * 256; it += nthr) {
        const int t = (int)(it / 256), c = (int)(it % 256);
        p.XC[it] = conv_at(p, t, OFF_AX, c, p.in[I_LCW] + (size_t)l * 4 * 256, p.in[I_LCB] + (size_t)l * 256);
        p.XCM[it] = silu_f(conv_at(p, t, OFF_MX, c, p.in[I_MCW] + (size_t)l * 4 * 256, p.in[I_MCB] + (size_t)l * 256));
    }
    for (long t = gtid; t < NT; t += nthr) {
        const float* u = p.U + (size_t)t * DIN; float sq = 0.f, sk = 0.f;
        for (int k = 0; k < QRANK; ++k) sq += u[OFF_BQ + k] * u[OFF_BQ + k];
        for (int k = 0; k < KVRANK; ++k) sk += u[OFF_BKV + k] * u[OFF_BKV + k];
        const float rq = 1.f / sqrtf(sq / (float)QRANK + EPS), rk = 1.f / sqrtf(sk / (float)KVRANK + EPS);
        for (int k = 0; k < QRANK; ++k) p.QN[(size_t)t * QRANK + k] = u[OFF_BQ + k] * rq * p.in[I_QNG][(size_t)l * QRANK + k];
        for (int k = 0; k < KVRANK; ++k) p.KVN[(size_t)t * KVRANK + k] = u[OFF_BKV + k] * rk * p.in[I_KVNG][(size_t)l * KVRANK + k];
    }
}

HD void nv_prep2(const P& p, int l, long gtid, long nthr) {
    for (long it = gtid; it < (long)2 * NT * 256; it += nthr) {
        const int d = (int)(it / ((long)NT * 256)), t = (int)((it / 256) % NT), c = (int)(it % 256), g = c / 64, j = c % 64;
        const float* xc = p.XC + (size_t)t * 256 + g * 64;
        const float* wa = p.in[I_LWA] + ((((size_t)l * 2 + d) * 4 + g) * 64) * 64 + j;
        const float* wx = p.in[I_LWX] + ((((size_t)l * 2 + d) * 4 + g) * 64) * 64 + j;
        float sa = 0.f, sx = 0.f;
        for (int i = 0; i < 64; ++i) { sa += xc[i] * wa[i * 64]; sx += xc[i] * wx[i * 64]; }
        const float r = sigmoid_f(sa + p.in[I_LBA][((size_t)l * 2 + d) * 256 + c]), ig = sigmoid_f(sx + p.in[I_LBX][((size_t)l * 2 + d) * 256 + c]);
        const float log_a = 8.0f * r * logsigmoid_f(p.in[I_LLAM][((size_t)l * 2 + d) * 256 + c]);
        p.LA[it] = expf(log_a); p.LB[it] = sqrtf(-expm1f(2.f * log_a)) * ig * p.XC[(size_t)t * 256 + c];
    }
    { constexpr int R = 8, NQ = 768 / 4; const float* W = p.in[I_WQB] + (size_t)l * QRANK * 768;
      for (long it = gtid; it < (long)(NT / R) * NQ; it += nthr) { const int mi = (int)(it / NQ), n = (int)(it % NQ) * 4;
        const float* a[R]; float4 acc[R];
#pragma unroll
        for (int r = 0; r < R; ++r) { a[r] = p.QN + (size_t)(mi * R + r) * QRANK; acc[r] = float4{0.f, 0.f, 0.f, 0.f}; }
        gemm_rx4<R>(a, W + n, 768, QRANK, acc);
#pragma unroll
        for (int r = 0; r < R; ++r) *(float4*)(p.QF + (size_t)(mi * R + r) * 768 + n) = acc[r]; } }
    { constexpr int R = 8, NQ = 1024 / 4; const float* W = p.in[I_WKVB] + (size_t)l * KVRANK * 1024;
      for (long it = gtid; it < (long)(NT / R) * NQ; it += nthr) { const int mi = (int)(it / NQ), n = (int)(it % NQ) * 4;
        const float* a[R]; float4 acc[R];
#pragma unroll
        for (int r = 0; r < R; ++r) { a[r] = p.KVN + (size_t)(mi * R + r) * KVRANK; acc[r] = float4{0.f, 0.f, 0.f, 0.f}; }
        gemm_rx4<R>(a, W + n, 1024, KVRANK, acc);
#pragma unroll
        for (int r = 0; r < R; ++r) *(float4*)(p.KVF + (size_t)(mi * R + r) * 1024 + n) = acc[r]; } }
    for (long it = gtid; it < (long)NT * 256; it += nthr) {
        const int t = (int)(it / 256), c = (int)(it % 256), h = c / 64, j = c % 64;
        const float* xc = p.XCM + (size_t)t * 256 + h * 64; const float* ux = p.U + (size_t)t * DIN + OFF_MX + h * 64;
        const float* wq = p.in[I_MWQ] + (((size_t)l * 4 + h) * 64) * 64 + j; const float* wk = p.in[I_MWK] + (((size_t)l * 4 + h) * 64) * 64 + j; const float* wv = p.in[I_MWV] + (((size_t)l * 4 + h) * 64) * 64 + j;
        float sq = 0.f, sk = 0.f, sv = 0.f;
        for (int i = 0; i < 64; ++i) { sq += xc[i] * wq[i * 64]; sk += xc[i] * wk[i * 64]; sv += ux[i] * wv[i * 64]; }
        p.QM[it] = sq; p.KM[it] = sk * 0.125f; p.VM[it] = sv;
    }
}

HD void nv_prep3(const P& p, int l, long gtid, long nthr) {
    for (long it = gtid; it < (long)NB * 2 * 256; it += nthr) {
        const int b = (int)(it / 512), d = (int)((it / 256) & 1), c = (int)(it % 256);
        const float* A = p.LA + (size_t)d * NT * 256; const float* Bc = p.LB + (size_t)d * NT * 256; float* Ho = p.HL + (size_t)d * NT * 256;
        float h = 0.f;
        for (int seg = 0; seg < 2; ++seg) { const int base = b * TPB + (seg == 0 ? 0 : CTX), len = seg == 0 ? CTX : SEQ;
            for (int s = 0; s < len; ++s) { const int t = base + (d == 0 ? s : len - 1 - s);
                h = A[(size_t)t * 256 + c] * h + Bc[(size_t)t * 256 + c]; Ho[(size_t)t * 256 + c] = h; } }
    }
    for (long it = gtid; it < (long)NT * AH; it += nthr) {
        const int t = (int)(it / AH), h = (int)(it % AH), i = tok_i(t); const bool lat = i >= CTX; const int s = i - CTX;
        const float* qf = p.QF + (size_t)t * 768 + h * QKD; const float* kvf = p.KVF + (size_t)t * 1024 + h * (NOPE + VD); const float* kr = p.U + (size_t)t * DIN + OFF_BKR;
        float* qo = p.Qr + ((size_t)t * AH + h) * QKD; float* ko = p.Kr + ((size_t)t * AH + h) * QKD; float* vo = p.Vr + ((size_t)t * AH + h) * VD;
        for (int k = 0; k < NOPE; ++k) { qo[k] = qf[k]; ko[k] = kvf[k]; vo[k] = kvf[NOPE + k]; }
        for (int a = 0; a < 2; ++a) for (int f = 0; f < 8; ++f) {
            float cs = 1.f, sn = 0.f; if (lat) { cs = p.ROPET[(((size_t)s * 2 + a) * 8 + f) * 2]; sn = p.ROPET[(((size_t)s * 2 + a) * 8 + f) * 2 + 1]; }
            const float q1 = qf[NOPE + a * 16 + f], q2 = qf[NOPE + a * 16 + 8 + f], k1 = kr[a * 16 + f], k2 = kr[a * 16 + 8 + f];
            qo[NOPE + a * 16 + f] = q1 * cs - q2 * sn; qo[NOPE + a * 16 + 8 + f] = q2 * cs + q1 * sn;
            ko[NOPE + a * 16 + f] = k1 * cs - k2 * sn; ko[NOPE + a * 16 + 8 + f] = k2 * cs + k1 * sn; }
    }
    for (long it = gtid; it < (long)2 * NT * 8; it += nthr) {
        const int d = (int)(it / ((long)NT * 8)), t = (int)((it / 8) % NT), g = (int)(it % 8);
        const float* w = p.in[I_MWG] + (((size_t)l * 2 + d) * 768) * 8 + g; float s = p.in[I_MBG][((size_t)l * 2 + d) * 8 + g];
        for (int i = 0; i < 256; ++i) s += p.QM[(size_t)t * 256 + i] * w[(size_t)i * 8];
        for (int i = 0; i < 256; ++i) s += p.KM[(size_t)t * 256 + i] * w[(size_t)(256 + i) * 8];
        for (int i = 0; i < 256; ++i) s += p.VM[(size_t)t * 256 + i] * w[(size_t)(512 + i) * 8];
        p.IGF[it] = g < 4 ? s : logsigmoid_f(s);
    }
}

HD void nv_attn(const P& p, long gtid, long nthr) {
    const float scale = 1.0f / sqrtf((float)QKD);
    for (long it = gtid; it < (long)NT * AH; it += nthr) {
        const int h = (int)((it / TPB) % AH), b = (int)(it / ((long)TPB * AH)), i = (int)(it % TPB), t = b * TPB + i;
        const int nk = i < CTX ? CTX : TPB;
        float q[QKD], o[VD];
#pragma unroll
        for (int k = 0; k < QKD; ++k) q[k] = p.Qr[((size_t)t * AH + h) * QKD + k] * scale;
#pragma unroll
        for (int k = 0; k < VD; ++k) o[k] = 0.f;
        float m = -1e30f, lsum = 0.f;
        for (int j = 0; j < nk; ++j) {
            const float* kk = p.Kr + ((size_t)(b * TPB + j) * AH + h) * QKD; const float* vv = p.Vr + ((size_t)(b * TPB + j) * AH + h) * VD;
            float s = 0.f;
#pragma unroll
            for (int k = 0; k < QKD; ++k) s += q[k] * kk[k];
            if (s > m) { const float f = expf(m - s); lsum *= f;
#pragma unroll
                for (int k = 0; k < VD; ++k) o[k] *= f;
                m = s; }
            const float pr = expf(s - m); lsum += pr;
#pragma unroll
            for (int k = 0; k < VD; ++k) o[k] += pr * vv[k];
        }
        const float inv = 1.f / lsum;
#pragma unroll
        for (int k = 0; k < VD; ++k) p.Y[(size_t)t * DMIX + 256 + h * VD + k] = o[k] * inv;
    }
}
HD void nv_mlstm_scan(const P& p, long gtid, long nthr) {
    for (long it = gtid; it < (long)NB * MLH * 2 * 64; it += nthr) {
        const int v = (int)(it % 64), d = (int)((it / 64) & 1), h = (int)((it / 128) % MLH), b = (int)(it / (128 * MLH));
        float C[64], n[64];
#pragma unroll
        for (int k = 0; k < 64; ++k) { C[k] = 0.f; n[k] = 0.f; }
        float m = 0.f;
        for (int seg = 0; seg < 2; ++seg) { const int base = b * TPB + (seg == 0 ? 0 : CTX), len = seg == 0 ? CTX : SEQ;
            for (int s = 0; s < len; ++s) { const int t = base + (d == 0 ? s : len - 1 - s);
                const float ig = p.IGF[((size_t)d * NT + t) * 8 + h], lf = p.IGF[((size_t)d * NT + t) * 8 + 4 + h];
                const float mn = fmaxf(lf + m, ig), fd = expf(lf + m - mn), iw = expf(ig - mn); m = mn;
                const float* qq = p.QM + (size_t)t * 256 + h * 64; const float* kk = p.KM + (size_t)t * 256 + h * 64; const float vv = p.VM[(size_t)t * 256 + h * 64 + v];
                float num = 0.f, den = 0.f;
#pragma unroll
                for (int k = 0; k < 64; ++k) { const float kv = kk[k], qv = qq[k]; C[k] = fd * C[k] + iw * vv * kv; n[k] = fd * n[k] + iw * kv; num += C[k] * qv; den += n[k] * qv; }
                p.HM[((size_t)d * NT + t) * 256 + h * 64 + v] = num / fmaxf(fabsf(den), expf(-mn)); } }
    }
}
HD void nv_lru_out(const P& p, long gtid, long nthr) {
    for (long it = gtid; it < (long)NT * 256; it += nthr) { const int t = (int)(it / 256), c = (int)(it % 256);
        p.Y[(size_t)t * DMIX + c] = (p.HL[it] + p.HL[(size_t)NT * 256 + it]) * gelu_f(p.U[(size_t)t * DIN + OFF_AG + c]); }
}
HD void nv_mlstm_finish(const P& p, int l, long gtid, long nthr) {
    for (long it = gtid; it < (long)NT * MLH; it += nthr) { const int t = (int)(it / MLH), h = (int)(it % MLH);
        const float* h0 = p.HM + (size_t)t * 256 + h * 64; const float* h1 = p.HM + ((size_t)NT + t) * 256 + h * 64;
        float mu = 0.f; for (int j = 0; j < 64; ++j) mu += h0[j] + h1[j]; mu *= (1.f / 64.f);
        float var = 0.f; for (int j = 0; j < 64; ++j) { const float dlt = h0[j] + h1[j] - mu; var += dlt * dlt; } var *= (1.f / 64.f);
        const float rstd = 1.f / sqrtf(var + EPS);
        for (int j = 0; j < 64; ++j) { const int c = h * 64 + j;
            const float y = (h0[j] + h1[j] - mu) * rstd * p.in[I_MNG][(size_t)l * 256 + c] + p.in[I_MSK][(size_t)l * 256 + c] * p.XCM[(size_t)t * 256 + c];
            p.Y[(size_t)t * DMIX + 768 + c] = y * silu_f(p.U[(size_t)t * DIN + OFF_MZ + c]); } }
}
HD void nv_outproj(const P& p, int l, long gtid, long nthr) {
    constexpr int R = 8, NQ = D / 4; const float* W = p.in[I_WOUT] + (size_t)l * DMIX * D;
    for (long it = gtid; it < (long)(NT / R) * NQ; it += nthr) { const int mi = (int)(it / NQ), n = (int)(it % NQ) * 4;
        const float* a[R]; float4 acc[R];
#pragma unroll
        for (int r = 0; r < R; ++r) { a[r] = p.Y + (size_t)(mi * R + r) * DMIX; acc[r] = float4{0.f, 0.f, 0.f, 0.f}; }
        gemm_rx4<R>(a, W + n, D, DMIX, acc);
#pragma unroll
        for (int r = 0; r < R; ++r) { const int t = mi * R + r; const float* g1 = modp(p, l, tok_cv(t), 2) + n; float* x = p.X + (size_t)t * D + n;
            x[0] += g1[0] * acc[r].x; x[1] += g1[1] * acc[r].y; x[2] += g1[2] * acc[r].z; x[3] += g1[3] * acc[r].w; } }
}
HD void nv_zero_cnt(const P& p, long gtid, long nthr) { for (long i = gtid; i < NE; i += nthr) p.CNT[i] = 0; }
HD void nv_router(const P& p, int l, long gtid, long nthr) {
    for (long t = gtid; t < NT; t += nthr) {
        float lg[NE]; const float* h = p.H + (size_t)t * D; const float* W = p.in[I_WR] + (size_t)l * D * NE;
#pragma unroll
        for (int e = 0; e < NE; ++e) lg[e] = p.in[I_BR][(size_t)l * NE + e];
        for (int k = 0; k < D; ++k) { const float hv = h[k];
#pragma unroll
            for (int e = 0; e < NE; ++e) lg[e] += hv * W[(size_t)k * NE + e]; }
        int te[TOPK]; float tv[TOPK];
#pragma unroll
        for (int r = 0; r < TOPK; ++r) { float best = -3.0e38f; int bi = 0;
#pragma unroll
            for (int e = 0; e < NE; ++e) { const bool c = lg[e] > best; best = c ? lg[e] : best; bi = c ? e : bi; }
            te[r] = bi; tv[r] = best;
#pragma unroll
            for (int e = 0; e < NE; ++e) lg[e] = (e == bi) ? -3.0e38f : lg[e]; }
        float s = 0.f, ex[TOPK];
#pragma unroll
        for (int r = 0; r < TOPK; ++r) { ex[r] = expf(tv[r] - tv[0]); s += ex[r]; }
#pragma unroll
        for (int r = 0; r < TOPK; ++r) { p.TOPE[t * TOPK + r] = te[r]; p.TOPG[t * TOPK + r] = ex[r] / s;
            const int pos = atomic_add_i(&p.CNT[te[r]], 1); p.LIST[(size_t)te[r] * NT + pos] = (int)t * TOPK + r; }
    }
}
HD bool moe_item(const P& p, int R, long grp, int& e, int& r0) {
    long acc = 0;
    for (int x = 0; x < NE; ++x) { const int c = p.CNT[x], ng = (c + R - 1) / R; if (grp < acc + ng) { e = x; r0 = (int)(grp - acc) * R; return true; } acc += ng; }
    return false;
}
HD long moe_groups(const P& p, int R) { long acc = 0; for (int x = 0; x < NE; ++x) acc += (p.CNT[x] + R - 1) / R; return acc; }
HD void nv_moe_gu(const P& p, int l, long gtid, long nthr) {
    constexpr int R = 8, NQ = DE / 4; const long ngrp = moe_groups(p, R);
    for (long it = gtid; it < ngrp * NQ; it += nthr) { int e, r0; moe_item(p, R, it / NQ, e, r0); const int n = (int)(it % NQ) * 4, cnt = p.CNT[e];
        const float* Wg = p.in[I_WGU] + ((size_t)l * NE + e) * D * 2 * DE; const float* bg = p.in[I_BGU] + ((size_t)l * NE + e) * 2 * DE;
        const float* a[R]; int pr[R]; float4 ag[R], al[R];
#pragma unroll
        for (int r = 0; r < R; ++r) { const int rr = r0 + r < cnt ? r0 + r : cnt - 1; pr[r] = p.LIST[(size_t)e * NT + rr]; a[r] = p.H + (size_t)(pr[r] / TOPK) * D; ag[r] = float4{0.f, 0.f, 0.f, 0.f}; al[r] = float4{0.f, 0.f, 0.f, 0.f}; }
        gemm_rx4<R>(a, Wg + n, 2 * DE, D, ag);
        gemm_rx4<R>(a, Wg + DE + n, 2 * DE, D, al);
#pragma unroll
        for (int r = 0; r < R; ++r) if (r0 + r < cnt) { float gv[4] = {ag[r].x + bg[n], ag[r].y + bg[n + 1], ag[r].z + bg[n + 2], ag[r].w + bg[n + 3]};
            float lv[4] = {al[r].x + bg[DE + n], al[r].y + bg[DE + n + 1], al[r].z + bg[DE + n + 2], al[r].w + bg[DE + n + 3]};
#pragma unroll
            for (int q = 0; q < 4; ++q) { const float glu = fminf(gv[q], 7.0f), lin = fminf(fmaxf(lv[q], -7.0f), 7.0f);
                p.ACT[(size_t)pr[r] * DE + n + q] = glu * sigmoid_f(1.702f * glu) * (lin + 1.f); } }
    }
}
HD void nv_moe_down(const P& p, int l, long gtid, long nthr) {
    constexpr int R = 8, NQ = D / 4; const long ngrp = moe_groups(p, R);
    for (long it = gtid; it < ngrp * NQ; it += nthr) { int e, r0; moe_item(p, R, it / NQ, e, r0); const int n = (int)(it % NQ) * 4, cnt = p.CNT[e];
        const float* Wd = p.in[I_WD] + ((size_t)l * NE + e) * DE * D; const float* bd = p.in[I_BD] + ((size_t)l * NE + e) * D;
        const float* a[R]; int pr[R]; float4 acc[R];
#pragma unroll
        for (int r = 0; r < R; ++r) { const int rr = r0 + r < cnt ? r0 + r : cnt - 1; pr[r] = p.LIST[(size_t)e * NT + rr]; a[r] = p.ACT + (size_t)pr[r] * DE; acc[r] = float4{0.f, 0.f, 0.f, 0.f}; }
        gemm_rx4<R>(a, Wd + n, D, DE, acc);
#pragma unroll
        for (int r = 0; r < R; ++r) if (r0 + r < cnt) { const float g = p.TOPG[pr[r]]; float* y = p.YB + (size_t)pr[r] * D + n;
            y[0] = g * (acc[r].x + bd[n]); y[1] = g * (acc[r].y + bd[n + 1]); y[2] = g * (acc[r].z + bd[n + 2]); y[3] = g * (acc[r].w + bd[n + 3]); }
    }
}
HD void nv_combine(const P& p, int l, long gtid, long nthr) {
    for (long it = gtid; it < (long)NT * D; it += nthr) { const int t = (int)(it / D), n = (int)(it % D);
        const float s = ((p.YB[((size_t)t * 4 + 0) * D + n] + p.YB[((size_t)t * 4 + 1) * D + n]) + p.YB[((size_t)t * 4 + 2) * D + n]) + p.YB[((size_t)t * 4 + 3) * D + n];
        p.X[it] += modp(p, l, tok_cv(t), 5)[n] * s; }
}
HD void nv_final(const P& p, long gtid, long nthr) {
    for (long r = gtid; r < (long)NB * SEQ; r += nthr) { const int b = (int)(r / SEQ), s = (int)(r % SEQ), t = b * TPB + CTX + s;
        const float* x = p.X + (size_t)t * D; float ss = 0.f;
        for (int k = 0; k < D; ++k) ss += x[k] * x[k];
        const float rstd = 1.f / sqrtf(ss / (float)D + EPS);
        for (int k = 0; k < D; ++k) p.out[(size_t)r * D + k] = x[k] * rstd * p.in[I_FG][k]; }
}

constexpr int PH_PER_LAYER = 13, N_PHASES = 1 + DEPTH * PH_PER_LAYER + 1;
HD void nv_run_phase(const P& p, int ph, long gtid, long nthr) {
    if (ph == 0) { nv_init(p, gtid, nthr); return; }
    if (ph == N_PHASES - 1) { nv_final(p, gtid, nthr); return; }
    const int l = (ph - 1) / PH_PER_LAYER, s = (ph - 1) % PH_PER_LAYER;
    switch (s) {
        case 0: nv_norm(p, l, 0, gtid, nthr); break;
        case 1: nv_inproj(p, l, gtid, nthr); break;
        case 2: nv_prep1(p, l, gtid, nthr); break;
        case 3: nv_prep2(p, l, gtid, nthr); break;
        case 4: nv_prep3(p, l, gtid, nthr); break;
        case 5: nv_mlstm_scan(p, gtid, nthr); nv_attn(p, gtid, nthr); nv_lru_out(p, gtid, nthr); break;
        case 6: nv_mlstm_finish(p, l, gtid, nthr); break;
        case 7: nv_outproj(p, l, gtid, nthr); break;
        case 8: nv_norm(p, l, 1, gtid, nthr); nv_zero_cnt(p, gtid, nthr); break;
        case 9: nv_router(p, l, gtid, nthr); break;
        case 10: nv_moe_gu(p, l, gtid, nthr); break;
        case 11: nv_moe_down(p, l, gtid, nthr); break;
        case 12: nv_combine(p, l, gtid, nthr); break;
    }
}

struct WsMap { size_t off[32]; size_t total; };
static inline WsMap ws_map() {
    WsMap m; size_t o = 0; int i = 0;
    auto add = [&](size_t n) { m.off[i++] = o; o += (n + 63) & ~(size_t)63; };
    add((size_t)DEPTH * 3 * 6 * D);
    add((size_t)SEQ * 16 * 2);
    add((size_t)NT * D);
    add((size_t)NT * D);
    add((size_t)NT * DIN);
    add((size_t)NT * 256);
    add((size_t)2 * NT * 256);
    add((size_t)2 * NT * 256);
    add((size_t)2 * NT * 256);
    add((size_t)NT * QRANK);
    add((size_t)NT * KVRANK);
    add((size_t)NT * 768);
    add((size_t)NT * 1024);
    add((size_t)NT * AH * QKD);
    add((size_t)NT * AH * QKD);
    add((size_t)NT * AH * VD);
    add((size_t)NT * 256);
    add((size_t)NT * 256);
    add((size_t)NT * 256);
    add((size_t)NT * 256);
    add((size_t)2 * NT * 8);
    add((size_t)2 * NT * 256);
    add((size_t)NT * DMIX);
    add((size_t)NT * TOPK);
    add((size_t)NT * TOPK * DE);
    add((size_t)NT * TOPK * D);
    add((size_t)NT * TOPK);
    add((size_t)64);
    add((size_t)NE * NT);
    m.total = o; return m;
}
static inline void fill_params(P& p, void* const* d_in, void* d_out, void* d_ws) {
    for (int i = 0; i < N_IN; ++i) p.in[i] = (const float*)d_in[i];
    p.out = (float*)d_out; float* w = (float*)d_ws; const WsMap m = ws_map();
    p.MOD = w + m.off[0]; p.ROPET = w + m.off[1]; p.X = w + m.off[2]; p.H = w + m.off[3]; p.U = w + m.off[4]; p.XC = w + m.off[5]; p.LA = w + m.off[6]; p.LB = w + m.off[7]; p.HL = w + m.off[8];
    p.QN = w + m.off[9]; p.KVN = w + m.off[10]; p.QF = w + m.off[11]; p.KVF = w + m.off[12]; p.Qr = w + m.off[13]; p.Kr = w + m.off[14]; p.Vr = w + m.off[15];
    p.XCM = w + m.off[16]; p.QM = w + m.off[17]; p.KM = w + m.off[18]; p.VM = w + m.off[19]; p.IGF = w + m.off[20]; p.HM = w + m.off[21]; p.Y = w + m.off[22];
    p.TOPG = w + m.off[23]; p.ACT = w + m.off[24]; p.YB = w + m.off[25]; p.TOPE = (int*)(w + m.off[26]); p.CNT = (int*)(w + m.off[27]); p.LIST = (int*)(w + m.off[28]);
}
#include <hip/hip_cooperative_groups.h>
#include <cstdio>
namespace cg = cooperative_groups;

#ifndef ONE_LAUNCH
#define ONE_LAUNCH 1
#endif

__global__ void __launch_bounds__(256) k_phase(P p, int ph) {
    nv_run_phase(p, ph, (long)blockIdx.x * blockDim.x + threadIdx.x, (long)gridDim.x * blockDim.x);
}
__global__ void __launch_bounds__(256) k_mega(P p) {
    cg::grid_group grid = cg::this_grid();
    const long gtid = (long)blockIdx.x * blockDim.x + threadIdx.x, nthr = (long)gridDim.x * blockDim.x;
    for (int ph = 0; ph < N_PHASES; ++ph) {
        nv_run_phase(p, ph, gtid, nthr);
        if (ph + 1 < N_PHASES) grid.sync();
    }
}

extern "C" void kernel_launch(void* const* d_in, const int* in_sizes, int n_in, void* d_out, int out_size, void* d_ws, size_t ws_size, hipStream_t stream) {
    static int grid_blocks = 0;
    if (!grid_blocks) {
        int dev = 0, cus = 0, per_cu = 0;
        hipGetDevice(&dev);
        hipDeviceGetAttribute(&cus, hipDeviceAttributeMultiprocessorCount, dev);
        hipOccupancyMaxActiveBlocksPerMultiprocessor(&per_cu, ONE_LAUNCH ? (const void*)k_mega : (const void*)k_phase, 256, 0);
        if (per_cu < 1) per_cu = 1;
        grid_blocks = cus * per_cu;
        const WsMap m = ws_map();
        if (n_in != N_IN || m.total * 4 > ws_size) { fprintf(stderr, "kernel_launch: bad n_in %d or workspace too small (%zu needed, %zu given)\n", n_in, m.total * 4, ws_size); }
    }
    P p{};
    fill_params(p, d_in, d_out, d_ws);
#if ONE_LAUNCH
    void* args[] = {&p};
    hipError_t e = hipLaunchCooperativeKernel((const void*)k_mega, dim3(grid_blocks), dim3(256), args, 0, stream);
    if (e != hipSuccess) fprintf(stderr, "cooperative launch failed: %s (grid %d)\n", hipGetErrorString(e), grid_blocks);
#else
    for (int ph = 0; ph < N_PHASES; ++ph) hipLaunchKernelGGL(k_phase, dim3(grid_blocks), dim3(256), 0, stream, p, ph);
#endif
}
```

```cpp
#include <hip/hip_runtime.h>
#define ONE_LAUNCH 1
#include <math.h>
#include <stdint.h>

#ifndef CFG_D_MODEL
#define CFG_D_MODEL 1024
#endif
#ifndef CFG_SEQ
#define CFG_SEQ 8192
#endif
#ifndef CFG_GRID_W
#define CFG_GRID_W 64
#endif
#ifndef CFG_CTX_LEN
#define CFG_CTX_LEN 256
#endif
#ifndef CFG_N_EXPERTS
#define CFG_N_EXPERTS 32
#endif
#ifndef CFG_D_EXPERT
#define CFG_D_EXPERT 1024
#endif

#ifdef HOST_TEST
#define HD inline
struct float4 { float x, y, z, w; };
static inline int atomic_add_i(int* p, int v) { int o = *p; *p = o + v; return o; }
#else
#define HD __device__ __forceinline__
static __device__ __forceinline__ int atomic_add_i(int* p, int v) { return atomicAdd(p, v); }
#endif

constexpr int D = CFG_D_MODEL, NB = 2, SEQ = CFG_SEQ, DEPTH = 2, GRID_W = CFG_GRID_W, CTX = CFG_CTX_LEN;
constexpr int TPB = CTX + SEQ;
constexpr int NT = NB * TPB;
constexpr int LW = 256, MLH = 4, MHD = 64, MW = 256;
constexpr int AH = 8, NOPE = 64, ROPE = 32, VD = 64, QRANK = 256, KVRANK = 128, QKD = NOPE + ROPE;
constexpr int DIN = 1440, DMIX = 1024;
constexpr int OFF_AX = 0, OFF_AG = 256, OFF_BQ = 512, OFF_BKV = 768, OFF_BKR = 896, OFF_MX = 928, OFF_MZ = 1184;
constexpr int NE = CFG_N_EXPERTS, TOPK = 4, DE = CFG_D_EXPERT;
constexpr float EPS = 1e-6f;

enum { I_X = 0, I_C, I_CTX, I_CCTX, I_N1G, I_N2G, I_WMOD, I_BMOD, I_WIN, I_WOUT, I_LCW, I_LCB, I_LWA, I_LBA, I_LWX, I_LBX, I_LLAM,
       I_QNG, I_WQB, I_KVNG, I_WKVB, I_MCW, I_MCB, I_MWQ, I_MWK, I_MWV, I_MWG, I_MBG, I_MNG, I_MSK, I_WR, I_BR, I_WGU, I_BGU, I_WD, I_BD, I_FG, N_IN };

struct P {
    const float* in[N_IN];
    float* out;
    float *MOD, *ROPET, *X, *H, *U, *XC, *LA, *LB, *HL, *QN, *KVN, *QF, *KVF, *Qr, *Kr, *Vr, *XCM, *QM, *KM, *VM, *IGF, *HM, *Y, *TOPG, *ACT, *YB;
    int *TOPE, *CNT, *LIST;
};

HD float sigmoid_f(float x) { return 1.f / (1.f + expf(-x)); }
HD float silu_f(float x) { return x * sigmoid_f(x); }
HD float logsigmoid_f(float x) { return fminf(x, 0.f) - log1pf(expf(-fabsf(x))); }
HD float gelu_f(float x) { return 0.5f * x * (1.f + tanhf(0.7978845608028654f * (x + 0.044715f * x * x * x))); }

HD int tok_b(int t) { return t / TPB; }
HD int tok_i(int t) { return t % TPB; }
HD bool tok_isctx(int t) { return tok_i(t) < CTX; }
HD int tok_cv(int t) { return tok_isctx(t) ? 2 : tok_b(t); }
HD const float* modp(const P& p, int l, int cv, int which) { return p.MOD + (((size_t)l * 3 + cv) * 6 + which) * D; }

template <int R>
HD void gemm_rx4(const float* (&a)[R], const float* B, int ldb, int K, float4 (&acc)[R]) {
    for (int k = 0; k < K; ++k) {
        const float4 bv = *(const float4*)(B + (size_t)k * ldb);
#pragma unroll
        for (int r = 0; r < R; ++r) { const float av = a[r][k]; acc[r].x += av * bv.x; acc[r].y += av * bv.y; acc[r].z += av * bv.z; acc[r].w += av * bv.w; }
    }
}

HD void nv_init(const P& p, long gtid, long nthr) {
    for (long it = gtid; it < (long)DEPTH * 6 * D; it += nthr) {
        const int l = (int)(it / (6 * D)), j = (int)(it % (6 * D));
        const float* w = p.in[I_WMOD] + (size_t)l * D * 6 * D + j;
        float a0 = 0.f, a1 = 0.f, a2 = 0.f;
        for (int k = 0; k < D; ++k) { const float wv = w[(size_t)k * 6 * D];
            a0 += silu_f(p.in[I_C][k]) * wv; a1 += silu_f(p.in[I_C][D + k]) * wv; a2 += silu_f(p.in[I_CCTX][k]) * wv; }
        const float bb = p.in[I_BMOD][(size_t)l * 6 * D + j];
        p.MOD[((size_t)l * 3 + 0) * 6 * D + j] = a0 + bb; p.MOD[((size_t)l * 3 + 1) * 6 * D + j] = a1 + bb; p.MOD[((size_t)l * 3 + 2) * 6 * D + j] = a2 + bb;
    }
    for (long it = gtid; it < (long)NT * D; it += nthr) {
        const int t = (int)(it / D), k = (int)(it % D), b = tok_b(t), i = tok_i(t);
        p.X[it] = (i < CTX) ? p.in[I_CTX][((size_t)b * CTX + i) * D + k] : p.in[I_X][((size_t)b * SEQ + (i - CTX)) * D + k];
    }
    for (long it = gtid; it < (long)SEQ * 16; it += nthr) {
        const int s = (int)(it / 16), a = (int)((it / 8) & 1), f = (int)(it & 7);
        const int pos = a == 0 ? s / GRID_W : s % GRID_W;
        const double fr = pow(10000.0, -(double)f / 8.0);
        const float frf = (float)fr;
        const double ang = (double)((float)pos * frf);
        p.ROPET[it * 2] = (float)cos(ang); p.ROPET[it * 2 + 1] = (float)sin(ang);
    }
}

HD void nv_norm(const P& p, int l, int which  , long gtid, long nthr) {
    const float* g = p.in[which == 0 ? I_N1G : I_N2G] + (size_t)l * D;
    for (long t = gtid; t < NT; t += nthr) {
        const float* x = p.X + (size_t)t * D; float ss = 0.f;
        for (int k = 0; k < D; ++k) ss += x[k] * x[k];
        const float rstd = 1.f / sqrtf(ss / (float)D + EPS);
        const int cv = tok_cv((int)t); const float* sh = modp(p, l, cv, which == 0 ? 0 : 3); const float* sc = modp(p, l, cv, which == 0 ? 1 : 4);
        float* h = p.H + (size_t)t * D;
        for (int k = 0; k < D; ++k) h[k] = x[k] * rstd * g[k] * (1.f + sc[k]) + sh[k];
    }
}

HD void nv_inproj(const P& p, int l, long gtid, long nthr) {
    constexpr int R = 8, NQ = DIN / 4; const float* W = p.in[I_WIN] + (size_t)l * D * DIN;
    for (long it = gtid; it < (long)(NT / R) * NQ; it += nthr) {
        const int mi = (int)(it / NQ), n = (int)(it % NQ) * 4;
        const float* a[R]; float4 acc[R];
#pragma unroll
        for (int r = 0; r < R; ++r) { a[r] = p.H + (size_t)(mi * R + r) * D; acc[r] = float4{0.f, 0.f, 0.f, 0.f}; }
        gemm_rx4<R>(a, W + n, DIN, D, acc);
#pragma unroll
        for (int r = 0; r < R; ++r) *(float4*)(p.U + (size_t)(mi * R + r) * DIN + n) = acc[r];
    }
}

HD float conv_at(const P& p, int t, int col, int c, const float* w  , const float* bias) {
    const int i = tok_i(t), isc = i < CTX, li = isc ? i : i - CTX, len = isc ? CTX : SEQ;
    float s = bias[c];
#pragma unroll
    for (int k = 0; k < 4; ++k) { const int j = li + k - 2; if (j >= 0 && j < len) s += w[k * 256 + c] * p.U[(size_t)(t + k - 2) * DIN + col + c]; }
    return s;
}

HD void nv_prep1(const P& p, int l, long gtid, long nthr) {
    for (long it = gtid; it < (long)NT * 256; it += nthr) {
        const int t = (int)(it / 256), c = (int)(it % 256);
        p.XC[it] = conv_at(p, t, OFF_AX, c, p.in[I_LCW] + (size_t)l * 4 * 256, p.in[I_LCB] + (size_t)l * 256);
        p.XCM[it] = silu_f(conv_at(p, t, OFF_MX, c, p.in[I_MCW] + (size_t)l * 4 * 256, p.in[I_MCB] + (size_t)l * 256));
    }
    for (long t = gtid; t < NT; t += nthr) {
        const float* u = p.U + (size_t)t * DIN; float sq = 0.f, sk = 0.f;
        for (int k = 0; k < QRANK; ++k) sq += u[OFF_BQ + k] * u[OFF_BQ + k];
        for (int k = 0; k < KVRANK; ++k) sk += u[OFF_BKV + k] * u[OFF_BKV + k];
        const float rq = 1.f / sqrtf(sq / (float)QRANK + EPS), rk = 1.f / sqrtf(sk / (float)KVRANK + EPS);
        for (int k = 0; k < QRANK; ++k) p.QN[(size_t)t * QRANK + k] = u[OFF_BQ + k] * rq * p.in[I_QNG][(size_t)l * QRANK + k];
        for (int k = 0; k < KVRANK; ++k) p.KVN[(size_t)t * KVRANK + k] = u[OFF_BKV + k] * rk * p.in[I_KVNG][(size_t)l * KVRANK + k];
    }
}

HD void nv_prep2(const P& p, int l, long gtid, long nthr) {
    for (long it = gtid; it < (long)2 * NT * 256; it += nthr) {
        const int d = (int)(it / ((long)NT * 256)), t = (int)((it / 256) % NT), c = (int)(it % 256), g = c / 64, j = c % 64;
        const float* xc = p.XC + (size_t)t * 256 + g * 64;
        const float* wa = p.in[I_LWA] + ((((size_t)l * 2 + d) * 4 + g) * 64) * 64 + j;
        const float* wx = p.in[I_LWX] + ((((size_t)l * 2 + d) * 4 + g) * 64) * 64 + j;
        float sa = 0.f, sx = 0.f;
        for (int i = 0; i < 64; ++i) { sa += xc[i] * wa[i * 64]; sx += xc[i] * wx[i * 64]; }
        const float r = sigmoid_f(sa + p.in[I_LBA][((size_t)l * 2 + d) * 256 + c]), ig = sigmoid_f(sx + p.in[I_LBX][((size_t)l * 2 + d) * 256 + c]);
        const float log_a = 8.0f * r * logsigmoid_f(p.in[I_LLAM][((size_t)l * 2 + d) * 256 + c]);
        p.LA[it] = expf(log_a); p.LB[it] = sqrtf(-expm1f(2.f * log_a)) * ig * p.XC[(size_t)t * 256 + c];
    }
    { constexpr int R = 8, NQ = 768 / 4; const float* W = p.in[I_WQB] + (size_t)l * QRANK * 768;
      for (long it = gtid; it < (long)(NT / R) * NQ; it += nthr) { const int mi = (int)(it / NQ), n = (int)(it % NQ) * 4;
        const float* a[R]; float4 acc[R];
#pragma unroll
        for (int r = 0; r < R; ++r) { a[r] = p.QN + (size_t)(mi * R + r) * QRANK; acc[r] = float4{0.f, 0.f, 0.f, 0.f}; }
        gemm_rx4<R>(a, W + n, 768, QRANK, acc);
#pragma unroll
        for (int r = 0; r < R; ++r) *(float4*)(p.QF + (size_t)(mi * R + r) * 768 + n) = acc[r]; } }
    { constexpr int R = 8, NQ = 1024 / 4; const float* W = p.in[I_WKVB] + (size_t)l * KVRANK * 1024;
      for (long it = gtid; it < (long)(NT / R) * NQ; it += nthr) { const int mi = (int)(it / NQ), n = (int)(it % NQ) * 4;
        const float* a[R]; float4 acc[R];
#pragma unroll
        for (int r = 0; r < R; ++r) { a[r] = p.KVN + (size_t)(mi * R + r) * KVRANK; acc[r] = float4{0.f, 0.f, 0.f, 0.f}; }
        gemm_rx4<R>(a, W + n, 1024, KVRANK, acc);
#pragma unroll
        for (int r = 0; r < R; ++r) *(float4*)(p.KVF + (size_t)(mi * R + r) * 1024 + n) = acc[r]; } }
    for (long it = gtid; it < (long)NT * 256; it += nthr) {
        const int t = (int)(it / 256), c = (int)(it % 256), h = c / 64, j = c % 64;
        const float* xc = p.XCM + (size_t)t * 256 + h * 64; const float* ux = p.U + (size_t)t * DIN + OFF_MX + h * 64;
        const float* wq = p.in[I_MWQ] + (((size_t)l * 4 + h) * 64) * 64 + j; const float* wk = p.in[I_MWK] + (((size_t)l * 4 + h) * 64) * 64 + j; const float* wv = p.in[I_MWV] + (((size_t)l * 4 + h) * 64) * 64 + j;
        float sq = 0.f, sk = 0.f, sv = 0.f;
        for (int i = 0; i < 64; ++i) { sq += xc[i] * wq[i * 64]; sk += xc[i] * wk[i * 64]; sv += ux[i] * wv[i * 64]; }
        p.QM[it] = sq; p.KM[it] = sk * 0.125f; p.VM[it] = sv;
    }
}

HD void nv_prep3(const P& p, int l, long gtid, long nthr) {
    for (long it = gtid; it < (long)NB * 2 * 256; it += nthr) {
        const int b = (int)(it / 512), d = (int)((it / 256) & 1), c = (int)(it % 256);
        const float* A = p.LA + (size_t)d * NT * 256; const float* Bc = p.LB + (size_t)d * NT * 256; float* Ho = p.HL + (size_t)d * NT * 256;
        float h = 0.f;
        for (int seg = 0; seg < 2; ++seg) { const int base = b * TPB + (seg == 0 ? 0 : CTX), len = seg == 0 ? CTX : SEQ;
            for (int s = 0; s < len; ++s) { const int t = base + (d == 0 ? s : len - 1 - s);
                h = A[(size_t)t * 256 + c] * h + Bc[(size_t)t * 256 + c]; Ho[(size_t)t * 256 + c] = h; } }
    }
    for (long it = gtid; it < (long)NT * AH; it += nthr) {
        const int t = (int)(it / AH), h = (int)(it % AH), i = tok_i(t); const bool lat = i >= CTX; const int s = i - CTX;
        const float* qf = p.QF + (size_t)t * 768 + h * QKD; const float* kvf = p.KVF + (size_t)t * 1024 + h * (NOPE + VD); const float* kr = p.U + (size_t)t * DIN + OFF_BKR;
        float* qo = p.Qr + ((size_t)t * AH + h) * QKD; float* ko = p.Kr + ((size_t)t * AH + h) * QKD; float* vo = p.Vr + ((size_t)t * AH + h) * VD;
        for (int k = 0; k < NOPE; ++k) { qo[k] = qf[k]; ko[k] = kvf[k]; vo[k] = kvf[NOPE + k]; }
        for (int a = 0; a < 2; ++a) for (int f = 0; f < 8; ++f) {
            float cs = 1.f, sn = 0.f; if (lat) { cs = p.ROPET[(((size_t)s * 2 + a) * 8 + f) * 2]; sn = p.ROPET[(((size_t)s * 2 + a) * 8 + f) * 2 + 1]; }
            const float q1 = qf[NOPE + a * 16 + f], q2 = qf[NOPE + a * 16 + 8 + f], k1 = kr[a * 16 + f], k2 = kr[a * 16 + 8 + f];
            qo[NOPE + a * 16 + f] = q1 * cs - q2 * sn; qo[NOPE + a * 16 + 8 + f] = q2 * cs + q1 * sn;
            ko[NOPE + a * 16 + f] = k1 * cs - k2 * sn; ko[NOPE + a * 16 + 8 + f] = k2 * cs + k1 * sn; }
    }
    for (long it = gtid; it < (long)2 * NT * 8; it += nthr) {
        const int d = (int)(it / ((long)NT * 8)), t = (int)((it / 8) % NT), g = (int)(it % 8);
        const float* w = p.in[I_MWG] + (((size_t)l * 2 + d) * 768) * 8 + g; float s = p.in[I_MBG][((size_t)l * 2 + d) * 8 + g];
        for (int i = 0; i < 256; ++i) s += p.QM[(size_t)t * 256 + i] * w[(size_t)i * 8];
        for (int i = 0; i < 256; ++i) s += p.KM[(size_t)t * 256 + i] * w[(size_t)(256 + i) * 8];
        for (int i = 0; i < 256; ++i) s += p.VM[(size_t)t * 256 + i] * w[(size_t)(512 + i) * 8];
        p.IGF[it] = g < 4 ? s : logsigmoid_f(s);
    }
}

HD void nv_attn(const P& p, long gtid, long nthr) {
    const float scale = 1.0f / sqrtf((float)QKD);
    for (long it = gtid; it < (long)NT * AH; it += nthr) {
        const int h = (int)((it / TPB) % AH), b = (int)(it / ((long)TPB * AH)), i = (int)(it % TPB), t = b * TPB + i;
        const int nk = i < CTX ? CTX : TPB;
        float q[QKD], o[VD];
#pragma unroll
        for (int k = 0; k < QKD; ++k) q[k] = p.Qr[((size_t)t * AH + h) * QKD + k] * scale;
#pragma unroll
        for (int k = 0; k < VD; ++k) o[k] = 0.f;
        float m = -1e30f, lsum = 0.f;
        for (int j = 0; j < nk; ++j) {
            const float* kk = p.Kr + ((size_t)(b * TPB + j) * AH + h) * QKD; const float* vv = p.Vr + ((size_t)(b * TPB + j) * AH + h) * VD;
            float s = 0.f;
#pragma unroll
            for (int k = 0; k < QKD; ++k) s += q[k] * kk[k];
            if (s > m) { const float f = expf(m - s); lsum *= f;
#pragma unroll
                for (int k = 0; k < VD; ++k) o[k] *= f;
                m = s; }
            const float pr = expf(s - m); lsum += pr;
#pragma unroll
            for (int k = 0; k < VD; ++k) o[k] += pr * vv[k];
        }
        const float inv = 1.f / lsum;
#pragma unroll
        for (int k = 0; k < VD; ++k) p.Y[(size_t)t * DMIX + 256 + h * VD + k] = o[k] * inv;
    }
}
HD void nv_mlstm_scan(const P& p, long gtid, long nthr) {
    for (long it = gtid; it < (long)NB * MLH * 2 * 64; it += nthr) {
        const int v = (int)(it % 64), d = (int)((it / 64) & 1), h = (int)((it / 128) % MLH), b = (int)(it / (128 * MLH));
        float C[64], n[64];
#pragma unroll
        for (int k = 0; k < 64; ++k) { C[k] = 0.f; n[k] = 0.f; }
        float m = 0.f;
        for (int seg = 0; seg < 2; ++seg) { const int base = b * TPB + (seg == 0 ? 0 : CTX), len = seg == 0 ? CTX : SEQ;
            for (int s = 0; s < len; ++s) { const int t = base + (d == 0 ? s : len - 1 - s);
                const float ig = p.IGF[((size_t)d * NT + t) * 8 + h], lf = p.IGF[((size_t)d * NT + t) * 8 + 4 + h];
                const float mn = fmaxf(lf + m, ig), fd = expf(lf + m - mn), iw = expf(ig - mn); m = mn;
                const float* qq = p.QM + (size_t)t * 256 + h * 64; const float* kk = p.KM + (size_t)t * 256 + h * 64; const float vv = p.VM[(size_t)t * 256 + h * 64 + v];
                float num = 0.f, den = 0.f;
#pragma unroll
                for (int k = 0; k < 64; ++k) { const float kv = kk[k], qv = qq[k]; C[k] = fd * C[k] + iw * vv * kv; n[k] = fd * n[k] + iw * kv; num += C[k] * qv; den += n[k] * qv; }
                p.HM[((size_t)d * NT + t) * 256 + h * 64 + v] = num / fmaxf(fabsf(den), expf(-mn)); } }
    }
}
HD void nv_lru_out(const P& p, long gtid, long nthr) {
    for (long it = gtid; it < (long)NT * 256; it += nthr) { const int t = (int)(it / 256), c = (int)(it % 256);
        p.Y[(size_t)t * DMIX + c] = (p.HL[it] + p.HL[(size_t)NT * 256 + it]) * gelu_f(p.U[(size_t)t * DIN + OFF_AG + c]); }
}
HD void nv_mlstm_finish(const P& p, int l, long gtid, long nthr) {
    for (long it = gtid; it < (long)NT * MLH; it += nthr) { const int t = (int)(it / MLH), h = (int)(it % MLH);
        const float* h0 = p.HM + (size_t)t * 256 + h * 64; const float* h1 = p.HM + ((size_t)NT + t) * 256 + h * 64;
        float mu = 0.f; for (int j = 0; j < 64; ++j) mu += h0[j] + h1[j]; mu *= (1.f / 64.f);
        float var = 0.f; for (int j = 0; j < 64; ++j) { const float dlt = h0[j] + h1[j] - mu; var += dlt * dlt; } var *= (1.f / 64.f);
        const float rstd = 1.f / sqrtf(var + EPS);
        for (int j = 0; j < 64; ++j) { const int c = h * 64 + j;
            const float y = (h0[j] + h1[j] - mu) * rstd * p.in[I_MNG][(size_t)l * 256 + c] + p.in[I_MSK][(size_t)l * 256 + c] * p.XCM[(size_t)t * 256 + c];
            p.Y[(size_t)t * DMIX + 768 + c] = y * silu_f(p.U[(size_t)t * DIN + OFF_MZ + c]); } }
}
HD void nv_outproj(const P& p, int l, long gtid, long nthr) {
    constexpr int R = 8, NQ = D / 4; const float* W = p.in[I_WOUT] + (size_t)l * DMIX * D;
    for (long it = gtid; it < (long)(NT / R) * NQ; it += nthr) { const int mi = (int)(it / NQ), n = (int)(it % NQ) * 4;
        const float* a[R]; float4 acc[R];
#pragma unroll
        for (int r = 0; r < R; ++r) { a[r] = p.Y + (size_t)(mi * R + r) * DMIX; acc[r] = float4{0.f, 0.f, 0.f, 0.f}; }
        gemm_rx4<R>(a, W + n, D, DMIX, acc);
#pragma unroll
        for (int r = 0; r < R; ++r) { const int t = mi * R + r; const float* g1 = modp(p, l, tok_cv(t), 2) + n; float* x = p.X + (size_t)t * D + n;
            x[0] += g1[0] * acc[r].x; x[1] += g1[1] * acc[r].y; x[2] += g1[2] * acc[r].z; x[3] += g1[3] * acc[r].w; } }
}
HD void nv_zero_cnt(const P& p, long gtid, long nthr) { for (long i = gtid; i < NE; i += nthr) p.CNT[i] = 0; }
HD void nv_router(const P& p, int l, long gtid, long nthr) {
    for (long t = gtid; t < NT; t += nthr) {
        float lg[NE]; const float* h = p.H + (size_t)t * D; const float* W = p.in[I_WR] + (size_t)l * D * NE;
#pragma unroll
        for (int e = 0; e < NE; ++e) lg[e] = p.in[I_BR][(size_t)l * NE + e];
        for (int k = 0; k < D; ++k) { const float hv = h[k];
#pragma unroll
            for (int e = 0; e < NE; ++e) lg[e] += hv * W[(size_t)k * NE + e]; }
        int te[TOPK]; float tv[TOPK];
#pragma unroll
        for (int r = 0; r < TOPK; ++r) { float best = -3.0e38f; int bi = 0;
#pragma unroll
            for (int e = 0; e < NE; ++e) { const bool c = lg[e] > best; best = c ? lg[e] : best; bi = c ? e : bi; }
            te[r] = bi; tv[r] = best;
#pragma unroll
            for (int e = 0; e < NE; ++e) lg[e] = (e == bi) ? -3.0e38f : lg[e]; }
        float s = 0.f, ex[TOPK];
#pragma unroll
        for (int r = 0; r < TOPK; ++r) { ex[r] = expf(tv[r] - tv[0]); s += ex[r]; }
#pragma unroll
        for (int r = 0; r < TOPK; ++r) { p.TOPE[t * TOPK + r] = te[r]; p.TOPG[t * TOPK + r] = ex[r] / s;
            const int pos = atomic_add_i(&p.CNT[te[r]], 1); p.LIST[(size_t)te[r] * NT + pos] = (int)t * TOPK + r; }
    }
}
HD bool moe_item(const P& p, int R, long grp, int& e, int& r0) {
    long acc = 0;
    for (int x = 0; x < NE; ++x) { const int c = p.CNT[x], ng = (c + R - 1) / R; if (grp < acc + ng) { e = x; r0 = (int)(grp - acc) * R; return true; } acc += ng; }
    return false;
}
HD long moe_groups(const P& p, int R) { long acc = 0; for (int x = 0; x < NE; ++x) acc += (p.CNT[x] + R - 1) / R; return acc; }
HD void nv_moe_gu(const P& p, int l, long gtid, long nthr) {
    constexpr int R = 8, NQ = DE / 4; const long ngrp = moe_groups(p, R);
    for (long it = gtid; it < ngrp * NQ; it += nthr) { int e, r0; moe_item(p, R, it / NQ, e, r0); const int n = (int)(it % NQ) * 4, cnt = p.CNT[e];
        const float* Wg = p.in[I_WGU] + ((size_t)l * NE + e) * D * 2 * DE; const float* bg = p.in[I_BGU] + ((size_t)l * NE + e) * 2 * DE;
        const float* a[R]; int pr[R]; float4 ag[R], al[R];
#pragma unroll
        for (int r = 0; r < R; ++r) { const int rr = r0 + r < cnt ? r0 + r : cnt - 1; pr[r] = p.LIST[(size_t)e * NT + rr]; a[r] = p.H + (size_t)(pr[r] / TOPK) * D; ag[r] = float4{0.f, 0.f, 0.f, 0.f}; al[r] = float4{0.f, 0.f, 0.f, 0.f}; }
        gemm_rx4<R>(a, Wg + n, 2 * DE, D, ag);
        gemm_rx4<R>(a, Wg + DE + n, 2 * DE, D, al);
#pragma unroll
        for (int r = 0; r < R; ++r) if (r0 + r < cnt) { float gv[4] = {ag[r].x + bg[n], ag[r].y + bg[n + 1], ag[r].z + bg[n + 2], ag[r].w + bg[n + 3]};
            float lv[4] = {al[r].x + bg[DE + n], al[r].y + bg[DE + n + 1], al[r].z + bg[DE + n + 2], al[r].w + bg[DE + n + 3]};
#pragma unroll
            for (int q = 0; q < 4; ++q) { const float glu = fminf(gv[q], 7.0f), lin = fminf(fmaxf(lv[q], -7.0f), 7.0f);
                p.ACT[(size_t)pr[r] * DE + n + q] = glu * sigmoid_f(1.702f * glu) * (lin + 1.f); } }
    }
}
HD void nv_moe_down(const P& p, int l, long gtid, long nthr) {
    constexpr int R = 8, NQ = D / 4; const long ngrp = moe_groups(p, R);
    for (long it = gtid; it < ngrp * NQ; it += nthr) { int e, r0; moe_item(p, R, it / NQ, e, r0); const int n = (int)(it % NQ) * 4, cnt = p.CNT[e];
        const float* Wd = p.in[I_WD] + ((size_t)l * NE + e) * DE * D; const float* bd = p.in[I_BD] + ((size_t)l * NE + e) * D;
        const float* a[R]; int pr[R]; float4 acc[R];
#pragma unroll
        for (int r = 0; r < R; ++r) { const int rr = r0 + r < cnt ? r0 + r : cnt - 1; pr[r] = p.LIST[(size_t)e * NT + rr]; a[r] = p.ACT + (size_t)pr[r] * DE; acc[r] = float4{0.f, 0.f, 0.f, 0.f}; }
        gemm_rx4<R>(a, Wd + n, D, DE, acc);
#pragma unroll
        for (int r = 0; r < R; ++r) if (r0 + r < cnt) { const float g = p.TOPG[pr[r]]; float* y = p.YB + (size_t)pr[r] * D + n;
            y[0] = g * (acc[r].x + bd[n]); y[1] = g * (acc[r].y + bd[n + 1]); y[2] = g * (acc[r].z + bd[n + 2]); y[3] = g * (acc[r].w + bd[n + 3]); }
    }
}
HD void nv_combine(const P& p, int l, long gtid, long nthr) {
    for (long it = gtid; it < (long)NT * D; it += nthr) { const int t = (int)(it / D), n = (int)(it % D);
        const float s = ((p.YB[((size_t)t * 4 + 0) * D + n] + p.YB[((size_t)t * 4 + 1) * D + n]) + p.YB[((size_t)t * 4 + 2) * D + n]) + p.YB[((size_t)t * 4 + 3) * D + n];
        p.X[it] += modp(p, l, tok_cv(t), 5)[n] * s; }
}
HD void nv_final(const P& p, long gtid, long nthr) {
    for (long r = gtid; r < (long)NB * SEQ; r += nthr) { const int b = (int)(r / SEQ), s = (int)(r % SEQ), t = b * TPB + CTX + s;
        const float* x = p.X + (size_t)t * D; float ss = 0.f;
        for (int k = 0; k < D; ++k) ss += x[k] * x[k];
        const float rstd = 1.f / sqrtf(ss / (float)D + EPS);
        for (int k = 0; k < D; ++k) p.out[(size_t)r * D + k] = x[k] * rstd * p.in[I_FG][k]; }
}

constexpr int PH_PER_LAYER = 13, N_PHASES = 1 + DEPTH * PH_PER_LAYER + 1;
HD void nv_run_phase(const P& p, int ph, long gtid, long nthr) {
    if (ph == 0) { nv_init(p, gtid, nthr); return; }
    if (ph == N_PHASES - 1) { nv_final(p, gtid, nthr); return; }
    const int l = (ph - 1) / PH_PER_LAYER, s = (ph - 1) % PH_PER_LAYER;
    switch (s) {
        case 0: nv_norm(p, l, 0, gtid, nthr); break;
        case 1: nv_inproj(p, l, gtid, nthr); break;
        case 2: nv_prep1(p, l, gtid, nthr); break;
        case 3: nv_prep2(p, l, gtid, nthr); break;
        case 4: nv_prep3(p, l, gtid, nthr); break;
        case 5: nv_mlstm_scan(p, gtid, nthr); nv_attn(p, gtid, nthr); nv_lru_out(p, gtid, nthr); break;
        case 6: nv_mlstm_finish(p, l, gtid, nthr); break;
        case 7: nv_outproj(p, l, gtid, nthr); break;
        case 8: nv_norm(p, l, 1, gtid, nthr); nv_zero_cnt(p, gtid, nthr); break;
        case 9: nv_router(p, l, gtid, nthr); break;
        case 10: nv_moe_gu(p, l, gtid, nthr); break;
        case 11: nv_moe_down(p, l, gtid, nthr); break;
        case 12: nv_combine(p, l, gtid, nthr); break;
    }
}

struct WsMap { size_t off[32]; size_t total; };
static inline WsMap ws_map() {
    WsMap m; size_t o = 0; int i = 0;
    auto add = [&](size_t n) { m.off[i++] = o; o += (n + 63) & ~(size_t)63; };
    add((size_t)DEPTH * 3 * 6 * D);
    add((size_t)SEQ * 16 * 2);
    add((size_t)NT * D);
    add((size_t)NT * D);
    add((size_t)NT * DIN);
    add((size_t)NT * 256);
    add((size_t)2 * NT * 256);
    add((size_t)2 * NT * 256);
    add((size_t)2 * NT * 256);
    add((size_t)NT * QRANK);
    add((size_t)NT * KVRANK);
    add((size_t)NT * 768);
    add((size_t)NT * 1024);
    add((size_t)NT * AH * QKD);
    add((size_t)NT * AH * QKD);
    add((size_t)NT * AH * VD);
    add((size_t)NT * 256);
    add((size_t)NT * 256);
    add((size_t)NT * 256);
    add((size_t)NT * 256);
    add((size_t)2 * NT * 8);
    add((size_t)2 * NT * 256);
    add((size_t)NT * DMIX);
    add((size_t)NT * TOPK);
    add((size_t)NT * TOPK * DE);
    add((size_t)NT * TOPK * D);
    add((size_t)NT * TOPK);
    add((size_t)64);
    add((size_t)NE * NT);
    m.total = o; return m;
}
static inline void fill_params(P& p, void* const* d_in, void* d_out, void* d_ws) {
    for (int i = 0; i < N_IN; ++i) p.in[i] = (const float*)d_in[i];
    p.out = (float*)d_out; float* w = (float*)d_ws; const WsMap m = ws_map();
    p.MOD = w + m.off[0]; p.ROPET = w + m.off[1]; p.X = w + m.off[2]; p.H = w + m.off[3]; p.U = w + m.off[4]; p.XC = w + m.off[5]; p.LA = w + m.off[6]; p.LB = w + m.off[7]; p.HL = w + m.off[8];
    p.QN = w + m.off[9]; p.KVN = w + m.off[10]; p.QF = w + m.off[11]; p.KVF = w + m.off[12]; p.Qr = w + m.off[13]; p.Kr = w + m.off[14]; p.Vr = w + m.off[15];
    p.XCM = w + m.off[16]; p.QM = w + m.off[17]; p.KM = w + m.off[18]; p.VM = w + m.off[19]; p.IGF = w + m.off[20]; p.HM = w + m.off[21]; p.Y = w + m.off[22];
    p.TOPG = w + m.off[23]; p.ACT = w + m.off[24]; p.YB = w + m.off[25]; p.TOPE = (int*)(w + m.off[26]); p.CNT = (int*)(w + m.off[27]); p.LIST = (int*)(w + m.off[28]);
}
namespace pg8 {
#define PG8_LAS __attribute__((address_space(3)))
typedef unsigned short bf16_t;
typedef short bf16x8 __attribute__((ext_vector_type(8)));
typedef float f32x4 __attribute__((ext_vector_type(4)));
typedef unsigned u32x4 __attribute__((ext_vector_type(4)));
constexpr int BM = 256, BK = 64, HALF = 128, HTB = HALF * BK * 2  , STAGE_BYTES = 8 * HTB, NXCD = 8, WGM = 8;

__host__ __device__ __forceinline__ int lds_byte(int r, int c) { const int st = (r >> 4) * 2 + (c >> 5), rr = r & 15, cc = c & 31, ob = rr * 64 + cc * 2; return st * 1024 + (ob ^ (((ob >> 9) & 1) << 5)); }
__host__ __device__ __forceinline__ void stage_rc(int b, int& R, int& C) { const int st = b / 1024, sb = b % 1024, swz = sb ^ (((sb >> 9) & 1) << 5); R = (st >> 1) * 16 + swz / 64; C = (st & 1) * 32 + (swz % 64) / 2; }
__host__ __device__ __forceinline__ int perm32(int rho) { const int n = rho >> 4, i = rho & 15; return 8 * (i >> 2) + 4 * n + (i & 3); }

struct Unit { int pm, pn, e, mb; };
struct Gemm { const bf16_t* A; const bf16_t* Bt; int K; };

struct StaticOrder {
    int nM, nN, nwg, G, c;
    __device__ void init(int M, int N, int G_, int c_) { nM = M / BM; nN = N / BM; nwg = nM * nN; G = G_; c = c_; }
    __device__ bool next(int i, Unit& u) const {
        const long L = (long)i * G + c; if (L >= nwg) return false;
        int wgid = (int)L; { const int q = nwg / NXCD, r = nwg % NXCD, xcd = wgid % NXCD, off = wgid / NXCD; wgid = (xcd < r ? xcd * (q + 1) : r * (q + 1) + (xcd - r) * q) + off; }
        const int nig = WGM * nN, gid = wgid / nig, fm = gid * WGM, gsz = (nM - fm) < WGM ? (nM - fm) : WGM;
        u.pm = fm + ((wgid % nig) % gsz); u.pn = (wgid % nig) / gsz; u.e = 0; u.mb = 0; return true;
    }
    __device__ __forceinline__ int arow(const Unit& u, int r) const { return u.pm * BM + r; }
};

__device__ __forceinline__ unsigned cvt_pk_bf16(float lo, float hi) { unsigned r; asm volatile("v_cvt_pk_bf16_f32 %0, %1, %2" : "=v"(r) : "v"(lo), "v"(hi)); return r; }

template <class Epi, class Sched, bool ALIGN_EPI>
__device__ __forceinline__ void gemm_phase(PG8_LAS unsigned char* lds, const Gemm g, const Sched& S, const Epi& E) {
    int tid_ = threadIdx.x; asm volatile("" : "+v"(tid_));
    const int tid = tid_, wid = __builtin_amdgcn_readfirstlane(tid >> 6), lane = tid & 63, wr = wid >> 2, wc = wid & 3, fr = lane & 15, fq = lane >> 4;
    const int K = g.K, nt = K / BK;
    int Rr[2], Cc[2]; unsigned voffB[2];
#pragma unroll
    for (int i = 0; i < 2; ++i) { int R, C; stage_rc(tid * 16 + i * 8192, R, C); const int Rb = Epi::PERM ? ((R & ~31) + perm32(R & 31)) : R;
        Rr[i] = R; Cc[i] = C; voffB[i] = (unsigned)(Rb * K + C) * 2u; }
    const size_t kstep = (size_t)(BK * 2);
    const size_t hstep = (size_t)HALF * K * 2;
    const size_t tstep = 2 * hstep;
    const unsigned ldsw = (unsigned)wid * 1024u;
    const int aoff = lds_byte(wr * 64 + fr, fq * 8), boff = lds_byte(wc * 32 + fr, fq * 8);
#define PG8_SA(b, h) (((b) * 2 + (h)) * HTB)
#define PG8_SB(b, h) ((4 + (b) * 2 + (h)) * HTB)
#define PG8_STAGE(bufoff, gbase, voff) do { _Pragma("unroll") for (int _i = 0; _i < 2; ++_i) \
        __builtin_amdgcn_global_load_lds((const unsigned*)((const char*)(gbase) + (voff)[_i]), (PG8_LAS unsigned*)(lds + (bufoff) + ldsw + _i * 8192), 16, 0, 0); } while (0)
#define PG8_LDA(dst, b, h) do { _Pragma("unroll") for (int m = 0; m < 4; ++m) _Pragma("unroll") for (int k = 0; k < 2; ++k) dst[m][k] = *(const PG8_LAS bf16x8*)(lds + PG8_SA(b, h) + aoff + m * 2048 + k * 1024); } while (0)
#define PG8_LDB(dst, b, h) do { _Pragma("unroll") for (int n = 0; n < 2; ++n) _Pragma("unroll") for (int k = 0; k < 2; ++k) dst[n][k] = *(const PG8_LAS bf16x8*)(lds + PG8_SB(b, h) + boff + n * 2048 + k * 1024); } while (0)
#define PG8_MMA(ai, bj, At, Bt) do { __builtin_amdgcn_s_setprio(1); _Pragma("unroll") for (int m = 0; m < 4; ++m) _Pragma("unroll") for (int n = 0; n < 2; ++n) _Pragma("unroll") for (int k = 0; k < 2; ++k) \
        acc[ai][bj][m][n] = __builtin_amdgcn_mfma_f32_16x16x32_bf16(Bt[n][k], At[m][k], acc[ai][bj][m][n], 0, 0, 0); __builtin_amdgcn_s_setprio(0); } while (0)
#define PG8_WAIT_V(n) asm volatile("s_waitcnt vmcnt(" #n ")" ::: "memory")
#define PG8_WAIT_L(n) asm volatile("s_waitcnt lgkmcnt(" #n ")" ::: "memory")
#define PG8_BAR __builtin_amdgcn_s_barrier()
#define PG8_SCHED __builtin_amdgcn_sched_barrier(0)
#define PG8_AOFFS(dst, U) do { _Pragma("unroll") for (int _h = 0; _h < 2; ++_h) _Pragma("unroll") for (int _i = 0; _i < 2; ++_i) \
        dst[_h][_i] = (unsigned)(S.arow(U, _h * HALF + Rr[_i]) * K + Cc[_i]) * 2u; } while (0)
    Unit cur, nxt; int ui = 0;
    if (!S.next(0, cur)) return;
    f32x4 acc[2][2][4][2];
#pragma unroll
    for (int a = 0; a < 2; ++a)
#pragma unroll
        for (int b = 0; b < 2; ++b)
#pragma unroll
            for (int m = 0; m < 4; ++m)
#pragma unroll
                for (int n = 0; n < 2; ++n) acc[a][b][m][n] = (f32x4){0.f, 0.f, 0.f, 0.f};
    bf16x8 At[4][2], B0[2][2], B1[2][2];
    unsigned vA[2][2], nvA[2][2];
    PG8_AOFFS(vA, cur);
    const char* gA = (const char*)g.A;
    const char* cB = (const char*)g.Bt + (size_t)cur.pn * tstep;
    PG8_STAGE(PG8_SB(0, 0), cB, voffB); PG8_STAGE(PG8_SB(0, 1), cB + hstep, voffB); PG8_STAGE(PG8_SA(0, 0), gA, vA[0]); PG8_STAGE(PG8_SA(0, 1), gA, vA[1]);
    if (wr == 1) PG8_BAR;
    PG8_WAIT_V(2); PG8_BAR;
    PG8_STAGE(PG8_SB(1, 0), cB + kstep, voffB); PG8_STAGE(PG8_SA(1, 0), gA + kstep, vA[0]); PG8_STAGE(PG8_SB(1, 1), cB + hstep + kstep, voffB);
    PG8_WAIT_V(6); PG8_BAR;
    for (;;) {
        const bool has_next = S.next(ui + 1, nxt);
        if (has_next) { PG8_AOFFS(nvA, nxt); } else {
#pragma unroll
            for (int h = 0; h < 2; ++h)
#pragma unroll
                for (int i = 0; i < 2; ++i) nvA[h][i] = vA[h][i]; }
        const char* nB = has_next ? (const char*)g.Bt + (size_t)nxt.pn * tstep : cB;
#pragma unroll 1
        for (int t = 0; t < nt; t += 2) {
            const bool last = (t == nt - 2);
            const char* a1 = gA + (size_t)(t + 1) * kstep;
            const char* a2 = last ? gA : gA + (size_t)(t + 2) * kstep; const char* b2 = last ? nB : cB + (size_t)(t + 2) * kstep;
            const char* a3 = a2 + kstep; const char* b3 = b2 + kstep;
            unsigned o2[2][2];
#pragma unroll
            for (int h = 0; h < 2; ++h)
#pragma unroll
                for (int i = 0; i < 2; ++i) o2[h][i] = last ? nvA[h][i] : vA[h][i];
            PG8_LDB(B0, 0, 0); PG8_LDB(B1, 0, 1); PG8_SCHED; PG8_LDA(At, 0, 0); PG8_STAGE(PG8_SA(1, 1), a1, vA[1]);
            PG8_WAIT_V(8); PG8_WAIT_L(0); PG8_BAR; PG8_MMA(0, 0, At, B0); PG8_MMA(0, 1, At, B1); PG8_BAR; PG8_SCHED;
            PG8_LDA(At, 0, 1); PG8_STAGE(PG8_SB(0, 0), b2, voffB); PG8_STAGE(PG8_SB(0, 1), b2 + hstep, voffB); PG8_STAGE(PG8_SA(0, 0), a2, o2[0]);
            PG8_WAIT_V(8); PG8_WAIT_L(0); PG8_BAR; PG8_MMA(1, 0, At, B0); PG8_MMA(1, 1, At, B1); PG8_BAR; PG8_SCHED;
            PG8_LDB(B0, 1, 0); PG8_LDB(B1, 1, 1); PG8_SCHED; PG8_LDA(At, 1, 0); PG8_STAGE(PG8_SA(0, 1), a2, o2[1]);
            PG8_WAIT_V(8); PG8_WAIT_L(0); PG8_BAR; PG8_MMA(0, 0, At, B0); PG8_MMA(0, 1, At, B1); PG8_BAR; PG8_SCHED;
            PG8_LDA(At, 1, 1); PG8_STAGE(PG8_SB(1, 0), b3, voffB); PG8_STAGE(PG8_SB(1, 1), b3 + hstep, voffB); PG8_STAGE(PG8_SA(1, 0), a3, o2[0]);
            PG8_WAIT_V(8); PG8_WAIT_L(0); PG8_BAR; PG8_MMA(1, 0, At, B0); PG8_MMA(1, 1, At, B1); PG8_BAR; PG8_SCHED;
        }
        if constexpr (ALIGN_EPI) { if (wr == 0) PG8_BAR; }
        E(acc, cur, wr, wc, fr, fq);
        if (!has_next) break;
#pragma unroll
        for (int a = 0; a < 2; ++a)
#pragma unroll
            for (int b = 0; b < 2; ++b)
#pragma unroll
                for (int m = 0; m < 4; ++m)
#pragma unroll
                    for (int n = 0; n < 2; ++n) acc[a][b][m][n] = (f32x4){0.f, 0.f, 0.f, 0.f};
        cur = nxt; cB = nB; ++ui;
#pragma unroll
        for (int h = 0; h < 2; ++h)
#pragma unroll
            for (int i = 0; i < 2; ++i) vA[h][i] = nvA[h][i];
        if constexpr (ALIGN_EPI) { if (wr == 1) PG8_BAR; }
    }
    PG8_WAIT_V(0);
    if constexpr (!ALIGN_EPI) { if (wr == 0) PG8_BAR; }
    PG8_BAR;
#undef PG8_SA
#undef PG8_SB
#undef PG8_STAGE
#undef PG8_LDA
#undef PG8_LDB
#undef PG8_MMA
#undef PG8_WAIT_V
#undef PG8_WAIT_L
#undef PG8_BAR
#undef PG8_SCHED
#undef PG8_AOFFS
}
}
#define LAS __attribute__((address_space(3)))
typedef unsigned short bf16;
typedef float f32x4 __attribute__((ext_vector_type(4)));
typedef unsigned u32x4 __attribute__((ext_vector_type(4)));
typedef unsigned u32x2 __attribute__((ext_vector_type(2)));

constexpr int NWAVES = 8, NTHREADS = 512;
constexpr int DINP = 1536;
constexpr int SLOT_MAX = NT * TOPK + NE * 256;

struct Q {
    bf16 *WtIn, *WtOut, *WtGu, *WtDn, *WtQb, *WtKvb;
    bf16 *H16, *Y16, *ACT16, *K16, *V16;
};

__device__ __forceinline__ unsigned f2bf(float f) { unsigned u = __builtin_bit_cast(unsigned, f); return (u + 0x7fffu + ((u >> 16) & 1u)) >> 16; }
__device__ __forceinline__ unsigned pk2(float lo, float hi) { return f2bf(lo) | (f2bf(hi) << 16); }
__device__ __forceinline__ float bf2f(unsigned short b) { return __builtin_bit_cast(float, (unsigned)b << 16); }

__device__ __forceinline__ void transpose_item(const float* W, int K, int N, bf16* WT, int k0, int n0, int drow0, LAS float* scr, int lane) {
#pragma unroll 8
    for (int i = 0; i < 32; ++i) { const int kk = 2 * i + (lane >> 5); scr[kk * 33 + (lane & 31)] = W[(size_t)(k0 + kk) * N + n0 + (lane & 31)]; }
    asm volatile("s_waitcnt lgkmcnt(0)" ::: "memory");
    const int c = lane & 7;
#pragma unroll
    for (int j = 0; j < 4; ++j) { const int n = (lane >> 3) + 8 * j; const LAS float* s = scr + (8 * c) * 33 + n;
        u32x4 o; o.x = pk2(s[0 * 33], s[1 * 33]); o.y = pk2(s[2 * 33], s[3 * 33]); o.z = pk2(s[4 * 33], s[5 * 33]); o.w = pk2(s[6 * 33], s[7 * 33]);
        *(u32x4*)(WT + (size_t)(drow0 + n) * K + k0 + 8 * c) = o; }
    asm volatile("s_waitcnt lgkmcnt(0)" ::: "memory");
}
__device__ __forceinline__ void opt_convert_weights(const P& p, const Q& q, LAS unsigned char* lds, int gw, int ngw, int wave, int lane) {
    LAS float* scr = (LAS float*)(lds + wave * 8704);
    constexpr int I_IN = (D / 64) * (DIN / 32), I_OUT = (DMIX / 64) * (D / 32), I_QB = (QRANK / 64) * (768 / 32), I_KVB = (KVRANK / 64) * (1024 / 32);
    constexpr int I_GU = (D / 64) * (2 * DE / 32), I_DN = (DE / 64) * (D / 32);
    constexpr int PER_L = I_IN + I_OUT + I_QB + I_KVB + NE * (I_GU + I_DN);
    for (int it = gw; it < DEPTH * PER_L; it += ngw) {
        const int l = it / PER_L; int r = it % PER_L;
        if (r < I_IN) { const int nb = DIN / 32, kb = r / nb, n0 = 32 * (r % nb); transpose_item(p.in[I_WIN] + (size_t)l * D * DIN, D, DIN, q.WtIn + (size_t)l * DINP * D, 64 * kb, n0, n0, scr, lane); continue; } r -= I_IN;
        if (r < I_OUT) { const int nb = D / 32, kb = r / nb, n0 = 32 * (r % nb); transpose_item(p.in[I_WOUT] + (size_t)l * DMIX * D, DMIX, D, q.WtOut + (size_t)l * D * DMIX, 64 * kb, n0, n0, scr, lane); continue; } r -= I_OUT;
        if (r < I_QB) { const int nb = 768 / 32, kb = r / nb, n0 = 32 * (r % nb); transpose_item(p.in[I_WQB] + (size_t)l * QRANK * 768, QRANK, 768, q.WtQb + (size_t)l * 768 * QRANK, 64 * kb, n0, n0, scr, lane); continue; } r -= I_QB;
        if (r < I_KVB) { const int nb = 1024 / 32, kb = r / nb, n0 = 32 * (r % nb); transpose_item(p.in[I_WKVB] + (size_t)l * KVRANK * 1024, KVRANK, 1024, q.WtKvb + (size_t)l * 1024 * KVRANK, 64 * kb, n0, n0, scr, lane); continue; } r -= I_KVB;
        if (r < NE * I_GU) { const int e = r / I_GU, rr = r % I_GU, nb = 2 * DE / 32, kb = rr / nb, n0 = 32 * (rr % nb);
            const int isl = n0 >= DE, j0 = n0 - isl * DE, drow0 = 256 * (j0 / 128) + 128 * isl + (j0 % 128);
            transpose_item(p.in[I_WGU] + ((size_t)l * NE + e) * D * 2 * DE, D, 2 * DE, q.WtGu + ((size_t)l * NE + e) * 2 * DE * D, 64 * kb, n0, drow0, scr, lane); continue; } r -= NE * I_GU;
        { const int e = r / I_DN, rr = r % I_DN, nb = D / 32, kb = rr / nb, n0 = 32 * (rr % nb);
            transpose_item(p.in[I_WD] + ((size_t)l * NE + e) * DE * D, DE, D, q.WtDn + ((size_t)l * NE + e) * D * DE, 64 * kb, n0, n0, scr, lane); }
    }
    const long gt = (long)gw * 64 + lane, ngt = (long)ngw * 64;
    for (long i = gt; i < (long)DEPTH * (DINP - DIN) * D / 8; i += ngt) { const int l = (int)(i / ((DINP - DIN) * D / 8)); const long o = i % ((DINP - DIN) * D / 8);
        *(u32x4*)(q.WtIn + ((size_t)l * DINP + DIN) * D + o * 8) = (u32x4){0u, 0u, 0u, 0u}; }
}

struct EpiInprojF32 {
    static constexpr bool PERM = false; float* U;
    __device__ __forceinline__ void operator()(const pg8::f32x4 (&acc)[2][2][4][2], const pg8::Unit& u, int wr, int wc, int fr, int fq) const {
#pragma unroll
        for (int ai = 0; ai < 2; ++ai)
#pragma unroll
            for (int m = 0; m < 4; ++m) { const int row = u.pm * 256 + ai * 128 + wr * 64 + m * 16 + fr;
#pragma unroll
                for (int bj = 0; bj < 2; ++bj)
#pragma unroll
                    for (int n = 0; n < 2; ++n) { const int c = u.pn * 256 + bj * 128 + wc * 32 + n * 16 + 4 * fq; if (c < DIN) *(pg8::f32x4*)(U + (size_t)row * DIN + c) = acc[ai][bj][m][n]; } }
    }
};
struct EpiOutproj {
    static constexpr bool PERM = false; float* X; const float* mod;
    __device__ __forceinline__ void operator()(const pg8::f32x4 (&acc)[2][2][4][2], const pg8::Unit& u, int wr, int wc, int fr, int fq) const {
#pragma unroll
        for (int ai = 0; ai < 2; ++ai)
#pragma unroll
            for (int m = 0; m < 4; ++m) { const int row = u.pm * 256 + ai * 128 + wr * 64 + m * 16 + fr; const float* g1 = mod + ((size_t)tok_cv(row) * 6 + 2) * D;
#pragma unroll
                for (int bj = 0; bj < 2; ++bj)
#pragma unroll
                    for (int n = 0; n < 2; ++n) { const int c = u.pn * 256 + bj * 128 + wc * 32 + n * 16 + 4 * fq;
                        pg8::f32x4* xp = (pg8::f32x4*)(X + (size_t)row * D + c); const pg8::f32x4 gv = *(const pg8::f32x4*)(g1 + c); *xp = *xp + gv * acc[ai][bj][m][n]; } }
    }
};
struct GroupedOrder {
    const int* CNT; const int* LIST; int nN, G, c, total; const LAS int* pre;
    __device__ void init(const int* cnt, const int* list, int nN_, int G_, int c_, LAS int* pre_lds) { CNT = cnt; LIST = list; nN = nN_; G = G_; c = c_; pre = pre_lds;
        __syncthreads();
        if (threadIdx.x == 0) { int a = 0; for (int e = 0; e < NE; ++e) { pre_lds[e] = a; a += (cnt[e] + 255) >> 8; } pre_lds[NE] = a; }
        __syncthreads();
        total = pre_lds[NE] * nN; }
    __device__ bool next(int i, pg8::Unit& u) const {
        const long L = (long)i * G + c; if (L >= total) return false;
        int w = (int)L; { const int nx = pg8::NXCD, qq = total / nx, r = total % nx, xcd = w % nx, off = w / nx; w = (xcd < r ? xcd * (qq + 1) : r * (qq + 1) + (xcd - r) * qq) + off; }
        const int blk = w / nN, ntile = w % nN; int e = 0;
#pragma unroll 1
        for (int x = 1; x < NE; ++x) if (pre[x] <= blk) e = x;
        u.e = e; u.mb = blk - pre[e]; u.pm = blk; u.pn = e * nN + ntile; return true;
    }
};
struct GuOrder : GroupedOrder {
    __device__ __forceinline__ int arow(const pg8::Unit& u, int r) const { const int idx = u.mb * 256 + r; return idx < CNT[u.e] ? (LIST[(size_t)u.e * NT + idx] >> 2) : 0; }
};
struct DnOrder : GroupedOrder {
    __device__ __forceinline__ int arow(const pg8::Unit& u, int r) const { return u.pm * 256 + r; }
};
struct EpiGu {
    static constexpr bool PERM = true; bf16* ACT; const float* bgu;   int nN;
    __device__ __forceinline__ void operator()(const pg8::f32x4 (&acc)[2][2][4][2], const pg8::Unit& u, int wr, int wc, int fr, int fq) const {
        const int ntile = u.pn - u.e * nN, j0 = ntile * 128 + wc * 32 + 8 * fq; const float* bg = bgu + (size_t)u.e * 2 * DE;
        float bgl[8], bli[8];
#pragma unroll
        for (int x = 0; x < 8; ++x) { bgl[x] = bg[j0 + x]; bli[x] = bg[DE + j0 + x]; }
#pragma unroll
        for (int ai = 0; ai < 2; ++ai)
#pragma unroll
            for (int m = 0; m < 4; ++m) { const int row = u.pm * 256 + ai * 128 + wr * 64 + m * 16 + fr; float a[8];
#pragma unroll
                for (int n = 0; n < 2; ++n)
#pragma unroll
                    for (int x = 0; x < 4; ++x) { const float glu = fminf(acc[ai][0][m][n][x] + bgl[4 * n + x], 7.0f), lin = fminf(fmaxf(acc[ai][1][m][n][x] + bli[4 * n + x], -7.0f), 7.0f);
                        a[4 * n + x] = glu / (1.f + __expf(-1.702f * glu)) * (lin + 1.f); }
                u32x4 w; w.x = pg8::cvt_pk_bf16(a[0], a[1]); w.y = pg8::cvt_pk_bf16(a[2], a[3]); w.z = pg8::cvt_pk_bf16(a[4], a[5]); w.w = pg8::cvt_pk_bf16(a[6], a[7]);
                *(u32x4*)(ACT + (size_t)row * DE + j0) = w; }
    }
};
struct EpiDownF32 {
    static constexpr bool PERM = false; float* YB; const float* bd;   const float* TOPG; const int* CNT; const int* LIST; int nN;
    __device__ __forceinline__ void operator()(const pg8::f32x4 (&acc)[2][2][4][2], const pg8::Unit& u, int wr, int wc, int fr, int fq) const {
        const int ntile = u.pn - u.e * nN, cnt = CNT[u.e]; const float* b = bd + (size_t)u.e * D;
#pragma unroll
        for (int ai = 0; ai < 2; ++ai)
#pragma unroll
            for (int m = 0; m < 4; ++m) { const int idx = u.mb * 256 + ai * 128 + wr * 64 + m * 16 + fr;
                if (idx < cnt) { const int pr = LIST[(size_t)u.e * NT + idx]; const float g = TOPG[pr];
#pragma unroll
                    for (int bj = 0; bj < 2; ++bj)
#pragma unroll
                        for (int n = 0; n < 2; ++n) { const int c = ntile * 256 + bj * 128 + wc * 32 + n * 16 + 4 * fq; const pg8::f32x4 bv = *(const pg8::f32x4*)(b + c);
                            *(pg8::f32x4*)(YB + (size_t)pr * D + c) = (acc[ai][bj][m][n] + bv) * g; } } }
    }
};

__device__ __forceinline__ void opt_inproj(const P& p, const Q& q, int l, LAS unsigned char* lds) {
    pg8::Gemm g{q.H16, q.WtIn + (size_t)l * DINP * D, D}; pg8::StaticOrder S; S.init(NT, DINP, gridDim.x, blockIdx.x);
    EpiInprojF32 E{p.U}; pg8::gemm_phase<EpiInprojF32, pg8::StaticOrder, true>(lds, g, S, E);
}
__device__ __forceinline__ void opt_outproj(const P& p, const Q& q, int l, LAS unsigned char* lds) {
    pg8::Gemm g{q.Y16, q.WtOut + (size_t)l * D * DMIX, DMIX}; pg8::StaticOrder S; S.init(NT, D, gridDim.x, blockIdx.x);
    EpiOutproj E{p.X, p.MOD + (size_t)l * 3 * 6 * D}; pg8::gemm_phase<EpiOutproj, pg8::StaticOrder, true>(lds, g, S, E);
}
__device__ __forceinline__ void opt_moe_gu(const P& p, const Q& q, int l, LAS unsigned char* lds) {
    pg8::Gemm g{q.H16, q.WtGu + (size_t)l * NE * 2 * DE * D, D}; GuOrder S; S.init(p.CNT, p.LIST, 2 * DE / 256, gridDim.x, blockIdx.x, (LAS int*)(lds + pg8::STAGE_BYTES));
    EpiGu E{q.ACT16, p.in[I_BGU] + (size_t)l * NE * 2 * DE, 2 * DE / 256}; pg8::gemm_phase<EpiGu, GuOrder, true>(lds, g, S, E);
}
__device__ __forceinline__ void opt_moe_down(const P& p, const Q& q, int l, LAS unsigned char* lds) {
    pg8::Gemm g{q.ACT16, q.WtDn + (size_t)l * NE * D * DE, DE}; DnOrder S; S.init(p.CNT, p.LIST, D / 256, gridDim.x, blockIdx.x, (LAS int*)(lds + pg8::STAGE_BYTES));
    EpiDownF32 E{p.YB, p.in[I_BD] + (size_t)l * NE * D, p.TOPG, p.CNT, p.LIST, D / 256}; pg8::gemm_phase<EpiDownF32, DnOrder, true>(lds, g, S, E);
}
namespace att {
using bf16x8 = __attribute__((ext_vector_type(8))) short;
using s16x4  = __attribute__((ext_vector_type(4))) short;
using f32x16 = __attribute__((ext_vector_type(16))) float;
using f32x8  = __attribute__((ext_vector_type(8))) float;
using u32x4  = __attribute__((ext_vector_type(4))) unsigned;
constexpr int DK = 96, DV = 64, NW = 8, QBLK = 32, KVBLK = 64;
constexpr float SCALE = 0.10206207261596575f;
#ifndef ATTN_THR
#define ATTN_THR 8.f
#endif
constexpr float THR = ATTN_THR;
constexpr int SHM_K = KVBLK * 256, SHM_V = KVBLK * DV * 2;
constexpr int SHM_ATTN = 2 * SHM_V + 2 * SHM_K + NW * 64 * 4;
#define KSWZ(row, colB) ((row) * 256 + ((colB) ^ (((row) & 7) << 4)))
#define SBAR() __builtin_amdgcn_sched_barrier(0)
__device__ __forceinline__ int crow(int r, int hi) { return (r & 3) + 8 * (r >> 2) + 4 * hi; }
__device__ __forceinline__ unsigned cvtpk(float lo, float hi) { unsigned r; asm volatile("v_cvt_pk_bf16_f32 %0, %1, %2" : "=v"(r) : "v"(lo), "v"(hi)); return r; }
__device__ __forceinline__ bf16x8 tobf(f32x8 x) { u32x4 w = {cvtpk(x[0], x[1]), cvtpk(x[2], x[3]), cvtpk(x[4], x[5]), cvtpk(x[6], x[7])}; return *reinterpret_cast<bf16x8*>(&w); }

__device__ __forceinline__ void partialSM(f32x16& p0, f32x16& p1, float& m_reg, float& mn, float& alpha) {
  constexpr float C = SCALE * 1.4426950408889634f;
  float pmax = p0[0];
#pragma unroll
  for (int r = 1; r < 16; ++r) pmax = fmaxf(pmax, p0[r]);
#pragma unroll
  for (int r = 0; r < 16; ++r) pmax = fmaxf(pmax, p1[r]);
  { auto rr = __builtin_amdgcn_permlane32_swap(__float_as_uint(pmax), __float_as_uint(pmax), false, false);
    pmax = fmaxf(__uint_as_float(rr[0]), __uint_as_float(rr[1])); }
  if (__builtin_expect(__all(pmax - m_reg <= THR / SCALE), 1)) { mn = m_reg; alpha = 1.f; }
  else { mn = fmaxf(m_reg, pmax); alpha = __builtin_amdgcn_exp2f((m_reg - mn) * C); m_reg = mn; }
  const float mnC = -mn * C;
#pragma unroll
  for (int r = 0; r < 16; ++r) p0[r] = fmaf(p0[r], C, mnC);
#pragma unroll
  for (int r = 0; r < 16; ++r) p1[r] = fmaf(p1[r], C, mnC);
#pragma unroll
  for (int r = 0; r < 16; ++r) p0[r] = __builtin_amdgcn_exp2f(p0[r]);
}
__device__ __forceinline__ void finishSM(f32x16& p0, f32x16& p1, float alpha, float& l_reg, bf16x8& pa0, bf16x8& pa1, bf16x8& pa2, bf16x8& pa3) {
#pragma unroll
  for (int r = 0; r < 16; ++r) p1[r] = __builtin_amdgcn_exp2f(p1[r]);
  float ps = 0;
#pragma unroll
  for (int r = 0; r < 16; ++r) ps += p0[r];
#pragma unroll
  for (int r = 0; r < 16; ++r) ps += p1[r];
  { auto rr = __builtin_amdgcn_permlane32_swap(__float_as_uint(ps), __float_as_uint(ps), false, false);
    ps = __uint_as_float(rr[0]) + __uint_as_float(rr[1]); }
  l_reg = l_reg * alpha + ps;
#define PK4(P, BASE, OUT) do { unsigned a0 = cvtpk(P[BASE + 0], P[BASE + 1]), a1 = cvtpk(P[BASE + 2], P[BASE + 3]);   \
    unsigned b0 = cvtpk(P[BASE + 4], P[BASE + 5]), b1 = cvtpk(P[BASE + 6], P[BASE + 7]);                              \
    auto r0 = __builtin_amdgcn_permlane32_swap(a0, b0, false, false); auto r1 = __builtin_amdgcn_permlane32_swap(a1, b1, false, false); \
    u32x4 w = {r0[0], r1[0], r0[1], r1[1]}; OUT = *reinterpret_cast<bf16x8*>(&w); } while (0)
  PK4(p0, 0, pa0); PK4(p0, 8, pa1); PK4(p1, 0, pa2); PK4(p1, 8, pa3);
#undef PK4
}
__device__ __forceinline__ void qkt(f32x16& p0, f32x16& p1, const char* Ks, const bf16x8* qr, int r32, int hi) {
  p0 = f32x16{}; p1 = f32x16{};
#pragma unroll
  for (int d0 = 0; d0 < DK / 16; ++d0) { const int cb = (d0 * 16 + hi * 8) * 2;
    const bf16x8 b0 = *reinterpret_cast<const bf16x8*>(Ks + KSWZ(r32, cb));
    const bf16x8 b1 = *reinterpret_cast<const bf16x8*>(Ks + KSWZ(32 + r32, cb));
    p0 = __builtin_amdgcn_mfma_f32_32x32x16_bf16(b0, qr[d0], p0, 0, 0, 0);
    p1 = __builtin_amdgcn_mfma_f32_32x32x16_bf16(b1, qr[d0], p1, 0, 0, 0); }
}
__device__ __forceinline__ int v_st(int k, int c) { const int kk = (k & ~0xC) | ((k & 4) << 1) | ((k & 8) >> 1); return ((kk >> 3) * 2 + (c >> 5)) * 512 + ((kk & 7) * 32 + (c & 31)) * 2; }
__device__ __forceinline__ int v_rd_base(int lane) { return ((lane & 3) << 3) | (((lane >> 2) & 3) << 6) | (((lane >> 4) & 1) << 5) | (((lane >> 5) & 1) << 8); }
constexpr int v_rd_off(int d0, int ks, int half) { return d0 * 512 + ks * 2048 + half * 1024; }
template <int OFF> __device__ __forceinline__ s16x4 tr_read(int vb) {
  s16x4 r; asm volatile("ds_read_b64_tr_b16 %0, %1 offset:%2" : "=&v"(r) : "v"(vb), "i"(OFF) : "memory"); return r;
}
template <int D0> __device__ __forceinline__ void pv_one(f32x16& od, int vb, bf16x8 pa0, bf16x8 pa1, bf16x8 pa2, bf16x8 pa3) {
  const s16x4 l0 = tr_read<v_rd_off(D0, 0, 0)>(vb), h0 = tr_read<v_rd_off(D0, 0, 1)>(vb), l1 = tr_read<v_rd_off(D0, 1, 0)>(vb), h1 = tr_read<v_rd_off(D0, 1, 1)>(vb);
  const s16x4 l2 = tr_read<v_rd_off(D0, 2, 0)>(vb), h2 = tr_read<v_rd_off(D0, 2, 1)>(vb), l3 = tr_read<v_rd_off(D0, 3, 0)>(vb), h3 = tr_read<v_rd_off(D0, 3, 1)>(vb);
  asm volatile("s_waitcnt lgkmcnt(0)" ::: "memory"); SBAR();
#define PK(L, H) (bf16x8){L[0], L[1], L[2], L[3], H[0], H[1], H[2], H[3]}
  od = __builtin_amdgcn_mfma_f32_32x32x16_bf16(pa0, PK(l0, h0), od, 0, 0, 0);
  od = __builtin_amdgcn_mfma_f32_32x32x16_bf16(pa1, PK(l1, h1), od, 0, 0, 0);
  od = __builtin_amdgcn_mfma_f32_32x32x16_bf16(pa2, PK(l2, h2), od, 0, 0, 0);
  od = __builtin_amdgcn_mfma_f32_32x32x16_bf16(pa3, PK(l3, h3), od, 0, 0, 0);
#undef PK
}
__device__ __forceinline__ void pv_d0(f32x16* o, int vb, bf16x8 pa0, bf16x8 pa1, bf16x8 pa2, bf16x8 pa3) {
  pv_one<0>(o[0], vb, pa0, pa1, pa2, pa3); pv_one<1>(o[1], vb, pa0, pa1, pa2, pa3);
}

template <class TQ, class Out>
__device__ __forceinline__ void attn_unit(const TQ* Qb, int ldq, const unsigned short* Kh, const unsigned short* Vh, int seq, char* lds, const Out& OUT) {
  int tid_ = threadIdx.x; asm volatile("" : "+v"(tid_));
  const int tid = tid_, wid = tid >> 6, lane = tid & 63, r32 = lane & 31, hi = lane >> 5;
  char* V_lds = lds; char* K_lds = lds + 2 * SHM_V;
  float* ws = (float*)(lds + 2 * SHM_V + 2 * SHM_K) + wid * 64; float* li_l = ws; float* al_l = ws + 32;
  float m_reg = -1e30f, l_reg = 0; f32x16 o[2] = {}; bf16x8 qr[DK / 16];
  { const TQ* Qw = Qb + (long)(wid * QBLK + r32) * ldq + hi * 8;
#pragma unroll
    for (int d0 = 0; d0 < DK / 16; ++d0) {
      if constexpr (sizeof(TQ) == 4) qr[d0] = tobf(*reinterpret_cast<const f32x8*>(Qw + d0 * 16)); else qr[d0] = *reinterpret_cast<const bf16x8*>(Qw + d0 * 16); } }
  const int kc0 = tid, kc1 = 512 + tid; const bool two = tid < 256;
  const int kst0 = KSWZ(kc0 / 12, (kc0 % 12) * 16), kst1 = KSWZ(kc1 / 12, (kc1 % 12) * 16), vst = v_st(tid >> 3, (tid & 7) * 8);
  const int vb0 = (int)(uintptr_t)V_lds + v_rd_base(lane);
  struct { bf16x8 v, k0, k1; } sr_[2];
#define SLOAD(i, key0) do { sr_[i].v = *reinterpret_cast<const bf16x8*>(Vh + (long)(key0) * DV + tid * 8); sr_[i].k0 = *reinterpret_cast<const bf16x8*>(Kh + (long)(key0) * DK + kc0 * 8); \
    if (two) sr_[i].k1 = *reinterpret_cast<const bf16x8*>(Kh + (long)(key0) * DK + kc1 * 8); } while (0)
#define SWRITE(b, i) do { *(bf16x8*)(V_lds + (b) * SHM_V + vst) = sr_[i].v; *(bf16x8*)(K_lds + (b) * SHM_K + kst0) = sr_[i].k0; if (two) *(bf16x8*)(K_lds + (b) * SHM_K + kst1) = sr_[i].k1; } while (0)
#define RESC(a) do { if (__any((a) < 1.f)) { if (hi == 0) al_l[r32] = (a); asm volatile("s_waitcnt lgkmcnt(0)" ::: "memory"); \
    _Pragma("unroll") for (int d = 0; d < 2; ++d) _Pragma("unroll") for (int r = 0; r < 16; ++r) o[d][r] *= al_l[crow(r, hi)]; } } while (0)
  f32x16 pA0, pA1, pB0, pB1; float mnA, mnB, alA, alB; bf16x8 pa0, pa1, pa2, pa3; const int NT = seq / KVBLK;
  constexpr int SE = 0, SO = 1;
  SLOAD(SE, 0); asm volatile("s_waitcnt vmcnt(0)" ::: "memory"); SWRITE(0, SE); __syncthreads();
  qkt(pA0, pA1, K_lds, qr, r32, hi); partialSM(pA0, pA1, m_reg, mnA, alA);
  SLOAD(SO, KVBLK); if (2 < NT) SLOAD(SE, 2 * KVBLK);
  SWRITE(1, SO); __syncthreads();
  for (int j = 1; j + 1 < NT; j += 2) {
    SBAR(); qkt(pB0, pB1, K_lds + SHM_K, qr, r32, hi);
    finishSM(pA0, pA1, alA, l_reg, pa0, pa1, pa2, pa3); SBAR();
    SLOAD(SO, (j + 2) * KVBLK); SBAR();
    pv_d0(o, vb0, pa0, pa1, pa2, pa3); partialSM(pB0, pB1, m_reg, mnB, alB);
    __syncthreads(); SWRITE(0, SE);
    RESC(alB); __syncthreads();
    SBAR(); qkt(pA0, pA1, K_lds, qr, r32, hi);
    finishSM(pB0, pB1, alB, l_reg, pa0, pa1, pa2, pa3); SBAR();
    if (j + 3 < NT) SLOAD(SE, (j + 3) * KVBLK); SBAR();
    pv_d0(o, vb0 + SHM_V, pa0, pa1, pa2, pa3); partialSM(pA0, pA1, m_reg, mnA, alA);
    __syncthreads(); SWRITE(1, SO);
    RESC(alA); __syncthreads();
  }
  SBAR(); qkt(pB0, pB1, K_lds + SHM_K, qr, r32, hi);
  finishSM(pA0, pA1, alA, l_reg, pa0, pa1, pa2, pa3); SBAR();
  pv_d0(o, vb0, pa0, pa1, pa2, pa3); partialSM(pB0, pB1, m_reg, mnB, alB);
  __syncthreads(); RESC(alB);
  finishSM(pB0, pB1, alB, l_reg, pa0, pa1, pa2, pa3); SBAR();
  pv_d0(o, vb0 + SHM_V, pa0, pa1, pa2, pa3);
  if (hi == 0) li_l[r32] = l_reg; asm volatile("s_waitcnt lgkmcnt(0)" ::: "memory");
  float rli[16];
#pragma unroll
  for (int r = 0; r < 16; ++r) rli[r] = __builtin_amdgcn_rcpf(li_l[crow(r, hi)]);
#pragma unroll
  for (int r = 0; r < 16; ++r) { const int orow = wid * QBLK + crow(r, hi);
#pragma unroll
    for (int d0 = 0; d0 < 2; ++d0) OUT(orow, d0 * 32 + r32, o[d0][r] * rli[r]); }
  __syncthreads();
#undef SLOAD
#undef SWRITE
#undef RESC
}
#undef KSWZ
#undef SBAR
}
struct Q2 {
    bf16* U16;
    bf16 *WtL;
    bf16 *WtM;
    bf16 *WtG;
    float *LSL;
    float *HLOC, *PCUM;
    float *SA, *SB;
    bf16 *QN16, *KVN16;
    bf16 *Q16;
    bf16 *WtKvbP;
    bf16 *XCM16, *QKV16;
    float *GATES;
    float *CLOC, *NLOC, *MLB;
    bf16 *YB16;
};
constexpr int NCH = TPB / 128;
constexpr int NCH_CTX = CTX / 128;

__device__ __forceinline__ float wave_sum(float v) {
#pragma unroll
    for (int o = 1; o < 64; o <<= 1) v += __shfl_xor(v, o);
    return v;
}
__device__ __forceinline__ float fast_sigmoid(float x) { return __builtin_amdgcn_rcpf(1.f + __expf(-x)); }
__device__ __forceinline__ float fast_silu(float x) { return x * fast_sigmoid(x); }
__device__ __forceinline__ float fast_gelu(float x) { const float u = 0.7978845608028654f * (x + 0.044715f * x * x * x); return x * fast_sigmoid(2.f * u); }

struct EpiU16 {
    static constexpr bool PERM = true; bf16* U;
    __device__ __forceinline__ void operator()(const pg8::f32x4 (&acc)[2][2][4][2], const pg8::Unit& u, int wr, int wc, int fr, int fq) const {
#pragma unroll
        for (int ai = 0; ai < 2; ++ai)
#pragma unroll
            for (int m = 0; m < 4; ++m) { const int row = u.pm * 256 + ai * 128 + wr * 64 + m * 16 + fr;
#pragma unroll
                for (int bj = 0; bj < 2; ++bj) { const int c = u.pn * 256 + bj * 128 + wc * 32 + 8 * fq; const pg8::f32x4 v0 = acc[ai][bj][m][0], v1 = acc[ai][bj][m][1];
                    u32x4 w; w.x = pg8::cvt_pk_bf16(v0[0], v0[1]); w.y = pg8::cvt_pk_bf16(v0[2], v0[3]); w.z = pg8::cvt_pk_bf16(v1[0], v1[1]); w.w = pg8::cvt_pk_bf16(v1[2], v1[3]);
                    *(u32x4*)(U + (size_t)row * DINP + c) = w; } }
    }
};
__device__ __forceinline__ void opt_inproj16(const Q& q, const Q2& q2, int l, LAS unsigned char* lds) {
    pg8::Gemm g{q.H16, q.WtIn + (size_t)l * DINP * D, D}; pg8::StaticOrder S; S.init(NT, DINP, gridDim.x, blockIdx.x);
    EpiU16 E{q2.U16}; pg8::gemm_phase<EpiU16, pg8::StaticOrder, true>(lds, g, S, E);
}

__device__ __forceinline__ void opt_convert_small(const P& p, const Q2& q2, long gtid, long nthr) {
    for (long it = gtid; it < (long)DEPTH * 4 * 256 * 64; it += nthr) { const int i = (int)(it & 63), n = (int)((it >> 6) & 255), g = (int)((it >> 14) & 3), l = (int)(it >> 16);
        const int d = n >> 7, gate = (n >> 6) & 1, j = n & 63; const float* w = p.in[gate ? I_LWX : I_LWA] + ((((size_t)l * 2 + d) * 4 + g) * 64 + i) * 64 + j;
        q2.WtL[it] = (bf16)f2bf(*w); }
    for (long it = gtid; it < (long)DEPTH * 4 * 3 * 64 * 64; it += nthr) { const int i = (int)(it & 63), j = (int)((it >> 6) & 63), m = (int)((it >> 12) % 3), h = (int)((it / (3 * 4096)) & 3), l = (int)(it / (12 * 4096));
        const float* w = p.in[m == 0 ? I_MWQ : (m == 1 ? I_MWK : I_MWV)] + (((size_t)l * 4 + h) * 64 + i) * 64 + j;
        q2.WtM[it] = (bf16)f2bf(*w * (m == 1 ? 0.125f : 1.f)); }
    for (long it = gtid; it < (long)DEPTH * 32 * 768; it += nthr) { const int i = (int)(it % 768), n = (int)((it / 768) & 31), l = (int)(it / (32 * 768));
        q2.WtG[it] = n < 16 ? (bf16)f2bf(p.in[I_MWG][((((size_t)l * 2 + (n >> 3)) * 768) + i) * 8 + (n & 7)]) : (bf16)0; }
    for (long it = gtid; it < (long)DEPTH * 2 * 256; it += nthr) q2.LSL[it] = logsigmoid_f(p.in[I_LLAM][it]);
    for (long it = gtid; it < (long)DEPTH * 1024 * 256; it += nthr) { const int k = (int)(it & 255), n = (int)((it >> 8) & 1023), l = (int)(it >> 18);
        q2.WtKvbP[it] = k < KVRANK ? (bf16)f2bf(p.in[I_WKVB][((size_t)l * KVRANK + k) * 1024 + n]) : (bf16)0; }
}

template <int KS, class TA, class TB>
__device__ __forceinline__ void wave_mm32(att::f32x16& acc, const TA* A, int lda, const TB* B, int ldb, int r32, int hi) {
#pragma unroll
    for (int ks = 0; ks < KS; ++ks) {
        const att::bf16x8 a = *reinterpret_cast<const att::bf16x8*>(A + (size_t)r32 * lda + ks * 16 + hi * 8);
        const att::bf16x8 b = *reinterpret_cast<const att::bf16x8*>(B + (size_t)r32 * ldb + ks * 16 + hi * 8);
        acc = __builtin_amdgcn_mfma_f32_32x32x16_bf16(a, b, acc, 0, 0, 0);
    }
}

constexpr int LRU1_LDS = 18432 + 65536 + 4096;
template <class UL>
__device__ __forceinline__ void lru1_item(const P& p, const Q2& q2, int l, int b, int ch, int g, char* lds, const UL& U) {
    int tid_ = threadIdx.x; asm volatile("" : "+v"(tid_));
    const int tid = tid_, wave = tid >> 6, lane = tid & 63, r32 = lane & 31, hi = lane >> 5;
    unsigned short* XC16 = (unsigned short*)lds; float* AB = (float*)(lds + 18432); float* CMP = (float*)(lds + 18432 + 65536);
    const int t0 = b * TPB + ch * 128, seg_lo = ch < NCH_CTX ? b * TPB : b * TPB + CTX, seg_hi = ch < NCH_CTX ? b * TPB + CTX : (b + 1) * TPB;
    { const int j = tid & 63, c = g * 64 + j, tb = (tid >> 6) * 16; const float* cw = p.in[I_LCW] + (size_t)l * 4 * 256 + c; const float w0 = cw[0], w1 = cw[256], w2 = cw[512], w3 = cw[768], cb = p.in[I_LCB][(size_t)l * 256 + c];
      float xm2 = (t0 + tb - 2 >= seg_lo) ? U(t0 + tb - 2, OFF_AX + c) : 0.f, xm1 = (t0 + tb - 1 >= seg_lo) ? U(t0 + tb - 1, OFF_AX + c) : 0.f, x0 = U(t0 + tb, OFF_AX + c);
#pragma unroll 4
      for (int i = 0; i < 16; ++i) { const int t = t0 + tb + i; const float xp1 = (t + 1 < seg_hi) ? U(t + 1, OFF_AX + c) : 0.f;
          const float v = cb + w0 * xm2 + w1 * xm1 + w2 * x0 + w3 * xp1; XC16[(tb + i) * 72 + j] = (unsigned short)f2bf(v); xm2 = xm1; xm1 = x0; x0 = xp1; } }
    __syncthreads();
    const bf16* Wt = q2.WtL + ((size_t)l * 4 + g) * 256 * 64;
#pragma unroll 1
    for (int d = 0; d < 2; ++d) {
        const int rt = wave & 3, cj = wave >> 2; att::f32x16 ar = {}, ai = {};
        wave_mm32<4>(ar, XC16 + rt * 32 * 72, 72, Wt + (size_t)(d * 128 + cj * 32) * 64, 64, r32, hi);
        wave_mm32<4>(ai, XC16 + rt * 32 * 72, 72, Wt + (size_t)(d * 128 + 64 + cj * 32) * 64, 64, r32, hi);
        { const int j = cj * 32 + r32, c = g * 64 + j; const float ba = p.in[I_LBA][((size_t)l * 2 + d) * 256 + c], bx = p.in[I_LBX][((size_t)l * 2 + d) * 256 + c], lsl = q2.LSL[((size_t)l * 2 + d) * 256 + c];
#pragma unroll
          for (int r = 0; r < 16; ++r) { const int tt = rt * 32 + att::crow(r, hi); const float rg = fast_sigmoid(ar[r] + ba), ig = fast_sigmoid(ai[r] + bx), la = 8.f * rg * lsl, a = __expf(la);
              const float xc = bf2f(XC16[tt * 72 + j]); const float bb = sqrtf(fmaxf(1.f - a * a, 0.f)) * ig * xc;
              AB[(tt * 64 + j) * 2] = a; AB[(tt * 64 + j) * 2 + 1] = bb; } }
        __syncthreads();
        { const int j = tid & 63, sg = tid >> 6; float av[16], bv[16]; float A = 1.f, B = 0.f;
#pragma unroll
          for (int i = 0; i < 16; ++i) { const int s = sg * 16 + i, tt = d == 0 ? s : 127 - s; av[i] = AB[(tt * 64 + j) * 2]; bv[i] = AB[(tt * 64 + j) * 2 + 1]; B = av[i] * B + bv[i]; A *= av[i]; }
          CMP[(sg * 64 + j) * 2] = A; CMP[(sg * 64 + j) * 2 + 1] = B;
          __syncthreads();
          float cA = 1.f, cB = 0.f;
          for (int x = 0; x < sg; ++x) { const float xa = CMP[(x * 64 + j) * 2], xb = CMP[(x * 64 + j) * 2 + 1]; cB = xa * cB + xb; cA *= xa; }
          const int c = g * 64 + j; float h = cB, pc = cA;
#pragma unroll
          for (int i = 0; i < 16; ++i) { const int s = sg * 16 + i, tt = d == 0 ? s : 127 - s; h = av[i] * h + bv[i]; pc *= av[i];
              q2.HLOC[((size_t)d * NT + t0 + tt) * 256 + c] = h; q2.PCUM[((size_t)d * NT + t0 + tt) * 256 + c] = pc; }
          if (sg == 7) { q2.SA[(((size_t)d * NB + b) * NCH + ch) * 256 + c] = pc; q2.SB[(((size_t)d * NB + b) * NCH + ch) * 256 + c] = h; } }
        __syncthreads();
    }
}
template <class UL, class YS>
__device__ __forceinline__ void lru2_item(const Q2& q2, int b, int ch, char* lds, const UL& U, const YS& Y) {
    int tid_ = threadIdx.x; asm volatile("" : "+v"(tid_));
    const int tid = tid_; float* CAR = (float*)lds;
    { const int d = tid >> 8, c = tid & 255; float h = 0.f;
      if (d == 0) { for (int j = 0; j < ch; ++j) h = q2.SA[(((size_t)0 * NB + b) * NCH + j) * 256 + c] * h + q2.SB[(((size_t)0 * NB + b) * NCH + j) * 256 + c]; }
      else { const bool isctx = ch < NCH_CTX;
          for (int j = NCH_CTX - 1; j >= (isctx ? ch + 1 : 0); --j) h = q2.SA[(((size_t)1 * NB + b) * NCH + j) * 256 + c] * h + q2.SB[(((size_t)1 * NB + b) * NCH + j) * 256 + c];
          if (!isctx) for (int j = NCH - 1; j > ch; --j) h = q2.SA[(((size_t)1 * NB + b) * NCH + j) * 256 + c] * h + q2.SB[(((size_t)1 * NB + b) * NCH + j) * 256 + c]; }
      CAR[tid] = h; }
    __syncthreads();
    const int t0 = b * TPB + ch * 128, c = tid & 255; const float c0 = CAR[c], c1 = CAR[256 + c];
#pragma unroll 4
    for (int i = 0; i < 64; ++i) { const int t = t0 + (tid >> 8) + 2 * i;
        const float hf = q2.HLOC[(size_t)t * 256 + c] + q2.PCUM[(size_t)t * 256 + c] * c0, hb = q2.HLOC[((size_t)NT + t) * 256 + c] + q2.PCUM[((size_t)NT + t) * 256 + c] * c1;
        Y(t, c, (hf + hb) * fast_gelu(U(t, OFF_AG + c))); }
    __syncthreads();
}

template <class UL>
__device__ __forceinline__ void mla_prep_token(const P& p, const Q& q, const Q2& q2, int l, int t, int lane, const UL& U) {
    float xq[4], xk[2]; float sq = 0.f, sk = 0.f;
#pragma unroll
    for (int i = 0; i < 4; ++i) { xq[i] = U(t, OFF_BQ + lane * 4 + i); sq += xq[i] * xq[i]; }
#pragma unroll
    for (int i = 0; i < 2; ++i) { xk[i] = U(t, OFF_BKV + lane * 2 + i); sk += xk[i] * xk[i]; }
    sq = wave_sum(sq); sk = wave_sum(sk);
    const float rq = 1.f / sqrtf(sq * (1.f / QRANK) + EPS), rk = 1.f / sqrtf(sk * (1.f / KVRANK) + EPS);
    const float* gq = p.in[I_QNG] + (size_t)l * QRANK + lane * 4; const float* gk = p.in[I_KVNG] + (size_t)l * KVRANK + lane * 2;
    u32x2 wq; wq.x = pk2(xq[0] * rq * gq[0], xq[1] * rq * gq[1]); wq.y = pk2(xq[2] * rq * gq[2], xq[3] * rq * gq[3]);
    *(u32x2*)(q2.QN16 + (size_t)t * 256 + lane * 4) = wq;
    *(unsigned*)(q2.KVN16 + (size_t)t * 256 + lane * 2) = pk2(xk[0] * rk * gk[0], xk[1] * rk * gk[1]);
    *(unsigned*)(q2.KVN16 + (size_t)t * 256 + 128 + lane * 2) = 0u;
    const int b = t / TPB, key = t % TPB, h = lane >> 3, d0 = (lane & 7) * 4; const bool lat = key >= CTX; const int s = key - CTX;
    float o[4];
#pragma unroll
    for (int i = 0; i < 4; ++i) { const int dd = d0 + i, a = dd >> 4, half = (dd >> 3) & 1, f = dd & 7; const float me = U(t, OFF_BKR + dd), other = U(t, OFF_BKR + (dd ^ 8));
        float cs = 1.f, sn = 0.f; if (lat) { cs = p.ROPET[(((size_t)s * 2 + a) * 8 + f) * 2]; sn = p.ROPET[(((size_t)s * 2 + a) * 8 + f) * 2 + 1]; }
        o[i] = half == 0 ? me * cs - other * sn : me * cs + other * sn; }
    u32x2 wk; wk.x = pk2(o[0], o[1]); wk.y = pk2(o[2], o[3]);
    *(u32x2*)(q.K16 + (((size_t)b * AH + h) * TPB + key) * QKD + NOPE + d0) = wk;
}

struct EpiQproj {
    static constexpr bool PERM = true; bf16* Q16; const float* ROPET;
    __device__ __forceinline__ void operator()(const pg8::f32x4 (&acc)[2][2][4][2], const pg8::Unit& u, int wr, int wc, int fr, int fq) const {
#pragma unroll
        for (int bj = 0; bj < 2; ++bj) { const int blk = u.pn * 8 + bj * 4 + wc; const bool rope = (blk % 3) == 2; const int c = blk * 32 + 8 * fq;
#pragma unroll
            for (int ai = 0; ai < 2; ++ai)
#pragma unroll
                for (int m = 0; m < 4; ++m) { const int row = u.pm * 256 + ai * 128 + wr * 64 + m * 16 + fr; float v[8];
#pragma unroll
                    for (int x = 0; x < 4; ++x) { v[x] = acc[ai][bj][m][0][x]; v[4 + x] = acc[ai][bj][m][1][x]; }
                    if (rope) {
                        const int key = (u.pm % (TPB / 256)) * 256 + ai * 128 + wr * 64 + m * 16 + fr; const bool lat = key >= CTX; const int s = lat ? key - CTX : 0, a = fq >> 1; const float* tb = ROPET + ((size_t)s * 2 + a) * 16;
#pragma unroll
                        for (int x = 0; x < 8; ++x) { const float other = __shfl_xor(v[x], 16); const float cs = lat ? tb[x * 2] : 1.f, sn = lat ? tb[x * 2 + 1] : 0.f;
                            v[x] = (fq & 1) == 0 ? v[x] * cs - other * sn : v[x] * cs + other * sn; } }
                    u32x4 w; w.x = pg8::cvt_pk_bf16(v[0], v[1]); w.y = pg8::cvt_pk_bf16(v[2], v[3]); w.z = pg8::cvt_pk_bf16(v[4], v[5]); w.w = pg8::cvt_pk_bf16(v[6], v[7]);
                    *(u32x4*)(Q16 + (size_t)row * 768 + c) = w; asm volatile("" ::: "memory"); } }
    }
};
struct EpiKVproj {
    static constexpr bool PERM = true; bf16* K16; bf16* V16;
    __device__ __forceinline__ void operator()(const pg8::f32x4 (&acc)[2][2][4][2], const pg8::Unit& u, int wr, int wc, int fr, int fq) const {
#pragma unroll
        for (int bj = 0; bj < 2; ++bj) { const int h = u.pn * 2 + bj, dcol = wc * 32 + 8 * fq; const bool isv = dcol >= 64;
#pragma unroll
            for (int ai = 0; ai < 2; ++ai)
#pragma unroll
                for (int m = 0; m < 4; ++m) { const int b = u.pm / (TPB / 256), key = (u.pm % (TPB / 256)) * 256 + ai * 128 + wr * 64 + m * 16 + fr; const pg8::f32x4 v0 = acc[ai][bj][m][0], v1 = acc[ai][bj][m][1];
                    u32x4 w; w.x = pg8::cvt_pk_bf16(v0[0], v0[1]); w.y = pg8::cvt_pk_bf16(v0[2], v0[3]); w.z = pg8::cvt_pk_bf16(v1[0], v1[1]); w.w = pg8::cvt_pk_bf16(v1[2], v1[3]);
                    bf16* dst = isv ? V16 + (((size_t)b * AH + h) * TPB + key) * VD + (dcol - 64) : K16 + (((size_t)b * AH + h) * TPB + key) * QKD + dcol;
                    *(u32x4*)dst = w; asm volatile("" ::: "memory"); } }
    }
};
__device__ __forceinline__ void opt_mla_proj(const P& p, const Q& q, const Q2& q2, int l, LAS unsigned char* lds) {
    { pg8::Gemm g{q2.QN16, q.WtQb + (size_t)l * 768 * QRANK, QRANK}; pg8::StaticOrder S; S.init(NT, 768, gridDim.x, blockIdx.x);
      EpiQproj E{q2.Q16, p.ROPET}; pg8::gemm_phase<EpiQproj, pg8::StaticOrder, true>(lds, g, S, E); }
    { pg8::Gemm g{q2.KVN16, q2.WtKvbP + (size_t)l * 1024 * 256, 256}; pg8::StaticOrder S; S.init(NT, 1024, gridDim.x, (blockIdx.x + 198) % gridDim.x);
      EpiKVproj E{q.K16, q.V16}; pg8::gemm_phase<EpiKVproj, pg8::StaticOrder, true>(lds, g, S, E); }
}
__device__ __forceinline__ int ord_len(int d, int ch) { return d == 0 ? ch : (ch < NCH_CTX ? NCH_CTX - 1 - ch : NCH_CTX + (NCH - 1 - ch)); }
__device__ __forceinline__ int ord_chunk(int d, int ch, int i) { return d == 0 ? i : (i < (ch < NCH_CTX ? NCH_CTX - 1 - ch : NCH_CTX) ? NCH_CTX - 1 - i : NCH - 1 - (i - NCH_CTX)); }

constexpr int ML1_LDS = 116736;
template <class UL>
__device__ __forceinline__ void ml1_item(const P& p, const Q2& q2, int l, int b, int ch, char* lds, const UL& U) {
    int tid_ = threadIdx.x; asm volatile("" : "+v"(tid_));
    const int tid = tid_, wave = tid >> 6, lane = tid & 63, r32 = lane & 31, hi = lane >> 5;
    unsigned short* XCh = (unsigned short*)lds; unsigned short* UXh = (unsigned short*)(lds + 18432); unsigned short* QKVh = (unsigned short*)(lds + 36864);
    float* GP = (float*)(lds + 92160); float* GT = (float*)(lds + 108544);
    const int t0 = b * TPB + ch * 128, seg_lo = ch < NCH_CTX ? b * TPB : b * TPB + CTX, seg_hi = ch < NCH_CTX ? b * TPB + CTX : (b + 1) * TPB;
    const int rt = wave & 3, wh = wave >> 2;
    att::f32x16 gacc = {};
#pragma unroll 1
    for (int h = 0; h < 4; ++h) {
        { const int j = tid & 63, c = h * 64 + j, tb = (tid >> 6) * 16; const float* cw = p.in[I_MCW] + (size_t)l * 4 * 256 + c; const float w0 = cw[0], w1 = cw[256], w2 = cw[512], w3 = cw[768], cb = p.in[I_MCB][(size_t)l * 256 + c];
          float xm2 = (t0 + tb - 2 >= seg_lo) ? U(t0 + tb - 2, OFF_MX + c) : 0.f, xm1 = (t0 + tb - 1 >= seg_lo) ? U(t0 + tb - 1, OFF_MX + c) : 0.f, x0 = U(t0 + tb, OFF_MX + c);
#pragma unroll 4
          for (int i = 0; i < 16; ++i) { const int t = t0 + tb + i; const float xp1 = (t + 1 < seg_hi) ? U(t + 1, OFF_MX + c) : 0.f;
              const float v = fast_silu(cb + w0 * xm2 + w1 * xm1 + w2 * x0 + w3 * xp1); const unsigned short vb = (unsigned short)f2bf(v);
              XCh[(tb + i) * 72 + j] = vb; UXh[(tb + i) * 72 + j] = (unsigned short)f2bf(x0); q2.XCM16[(size_t)t * 256 + c] = vb; xm2 = xm1; xm1 = x0; x0 = xp1; } }
        __syncthreads();
        { const bf16* Wm = q2.WtM + ((size_t)l * 4 + h) * 3 * 4096;
#pragma unroll
          for (int m = 0; m < 3; ++m) { att::f32x16 a = {};
              wave_mm32<4>(a, (m == 2 ? UXh : XCh) + rt * 32 * 72, 72, Wm + (size_t)m * 4096 + (size_t)wh * 32 * 64, 64, r32, hi);
#pragma unroll
              for (int r = 0; r < 16; ++r) { const int tt = rt * 32 + att::crow(r, hi); const unsigned short vb = (unsigned short)f2bf(a[r]);
                  QKVh[(m * 128 + tt) * 72 + wh * 32 + r32] = vb; q2.QKV16[(size_t)(t0 + tt) * 768 + m * 256 + h * 64 + wh * 32 + r32] = vb; } } }
        __syncthreads();
        { const bf16* Wg = q2.WtG + (size_t)l * 32 * 768;
#pragma unroll
          for (int x = 0; x < 6; ++x) { const int idx = wh * 6 + x, m = idx >> 2, ks = idx & 3;
              const att::bf16x8 a = *reinterpret_cast<const att::bf16x8*>(QKVh + (m * 128 + rt * 32 + r32) * 72 + ks * 16 + hi * 8);
              const att::bf16x8 bb = *reinterpret_cast<const att::bf16x8*>(Wg + (size_t)r32 * 768 + m * 256 + h * 64 + ks * 16 + hi * 8);
              gacc = __builtin_amdgcn_mfma_f32_32x32x16_bf16(a, bb, gacc, 0, 0, 0); } }
        __syncthreads();
    }
    if (r32 < 16) {
#pragma unroll
        for (int r = 0; r < 16; ++r) GP[(wh * 128 + rt * 32 + att::crow(r, hi)) * 16 + r32] = gacc[r]; }
    __syncthreads();
    for (int i = tid; i < 128 * 16; i += 512) { const int n = i & 15, d = n >> 3, g = n & 7; float v = GP[i] + GP[128 * 16 + i] + p.in[I_MBG][((size_t)l * 2 + d) * 8 + g];
        if (g >= 4) v = fminf(v, 0.f) - __logf(1.f + __expf(-fabsf(v)));
        GT[i] = v; q2.GATES[(size_t)(t0 + (i >> 4)) * 16 + n] = v; }
    __syncthreads();
    unsigned short* KT = (unsigned short*)lds; unsigned short* VT = (unsigned short*)(lds + 17408); float* WR = (float*)(lds + 52224); float* MB = (float*)(lds + 53248); float* WE = (float*)(lds + 53280);
#pragma unroll 1
    for (int h = 0; h < 4; ++h) {
        if (tid < 2) { const int d = tid; float bsum = 0.f;
            for (int s = 0; s < 128; ++s) { const int tt = d == 0 ? s : 127 - s; bsum += GT[tt * 16 + d * 8 + 4 + h]; WR[d * 128 + tt] = GT[tt * 16 + d * 8 + h] - bsum; }
            float mx = -3.0e38f; for (int tt = 0; tt < 128; ++tt) { const float w = WR[d * 128 + tt] + bsum; WR[d * 128 + tt] = w; mx = fmaxf(mx, w); }
            MB[d * 2] = mx; MB[d * 2 + 1] = bsum; }
        __syncthreads();
        { const int tt = tid & 127, jg = tid >> 7; const float w0 = __expf(WR[tt] - MB[0]), w1 = __expf(WR[128 + tt] - MB[2]);
          const unsigned short* ksrc = (const unsigned short*)q2.QKV16 + (size_t)(t0 + tt) * 768 + 256 + h * 64 + jg * 16; const unsigned short* vsrc = ksrc + 256;
          const att::bf16x8 k0 = *reinterpret_cast<const att::bf16x8*>(ksrc), k1 = *reinterpret_cast<const att::bf16x8*>(ksrc + 8), v0 = *reinterpret_cast<const att::bf16x8*>(vsrc), v1 = *reinterpret_cast<const att::bf16x8*>(vsrc + 8);
#pragma unroll
          for (int i = 0; i < 8; ++i) { KT[(jg * 16 + i) * 136 + tt] = (unsigned short)k0[i]; KT[(jg * 16 + 8 + i) * 136 + tt] = (unsigned short)k1[i];
              const float va = bf2f((unsigned short)v0[i]), vb = bf2f((unsigned short)v1[i]);
              VT[(jg * 16 + i) * 136 + tt] = (unsigned short)f2bf(va * w0); VT[(jg * 16 + 8 + i) * 136 + tt] = (unsigned short)f2bf(vb * w0);
              VT[(64 + jg * 16 + i) * 136 + tt] = (unsigned short)f2bf(va * w1); VT[(64 + jg * 16 + 8 + i) * 136 + tt] = (unsigned short)f2bf(vb * w1); }
          if (tid < 128) WE[tid] = w0; else if (tid < 256) WE[tid] = w1; }
        __syncthreads();
        { const int d = wave >> 2, vt = (wave >> 1) & 1, kt = wave & 1; att::f32x16 c = {};
          wave_mm32<8>(c, VT + (size_t)(d * 64 + vt * 32) * 136, 136, KT + (size_t)kt * 32 * 136, 136, r32, hi);
          float* dst = q2.CLOC + ((((size_t)d * NB + b) * NCH + ch) * 4 + h) * 4096;
#pragma unroll
          for (int r = 0; r < 16; ++r) dst[(vt * 32 + att::crow(r, hi)) * 64 + kt * 32 + r32] = c[r];
          if (tid < 128) { const int dd = tid >> 6, k = tid & 63; float s = 0.f; for (int tt = 0; tt < 128; ++tt) s += WE[dd * 128 + tt] * bf2f(KT[k * 136 + tt]);
              q2.NLOC[((((size_t)dd * NB + b) * NCH + ch) * 4 + h) * 64 + k] = s; }
          if (tid < 2) { float* mb = q2.MLB + ((((size_t)tid * NB + b) * NCH + ch) * 4 + h) * 2; mb[0] = MB[tid * 2]; mb[1] = MB[tid * 2 + 1]; } }
        __syncthreads();
    }
}

constexpr int ML2_LDS = 145536;
template <class UL, class YS>
__device__ __forceinline__ void ml2_item(const P& p, const Q2& q2, int l, int b, int ch, int h, char* lds, const UL& U, const YS& Y) {
    int tid_ = threadIdx.x; asm volatile("" : "+v"(tid_));
    const int tid = tid_, wave = tid >> 6, lane = tid & 63, r32 = lane & 31, hi = lane >> 5;
    char* Ks = lds; char* Vs = lds + 32768; unsigned short* C0 = (unsigned short*)(lds + 49152); float* N0 = (float*)(lds + 67584); float* ROWV = (float*)(lds + 68096);
    float* COEF = (float*)(lds + 73216); float* M0 = (float*)(lds + 73792); float* WS = (float*)(lds + 73856) + wave * 64; float* HX = (float*)(lds + 75904);
    const int t0 = b * TPB + ch * 128;
    { const unsigned short* base = (const unsigned short*)q2.QKV16 + (size_t)t0 * 768 + h * 64;
#pragma unroll
      for (int x = 0; x < 2; ++x) { const int cidx = tid + x * 512, key = cidx >> 3, c8 = cidx & 7, tile = key >> 6, kk = key & 63;
          const att::bf16x8 kv = *reinterpret_cast<const att::bf16x8*>(base + (size_t)key * 768 + 256 + c8 * 8), vv = *reinterpret_cast<const att::bf16x8*>(base + (size_t)key * 768 + 512 + c8 * 8);
          *(att::bf16x8*)(Ks + tile * 16384 + (kk * 256 + ((c8 * 16) ^ ((kk & 7) << 4)))) = kv;
          *(att::bf16x8*)(Vs + tile * 8192 + att::v_st(kk, c8 * 8)) = vv; } }
    if (tid < 2) { const int d = tid; float bsum = 0.f, pm = -3.0e38f; float* g = ROWV + (d * 5 + 0) * 128; float* pmv = ROWV + (d * 5 + 1) * 128; float* bv = ROWV + (d * 5 + 2) * 128;
        for (int s = 0; s < 128; ++s) { const int tt = d == 0 ? s : 127 - s; const float ig = q2.GATES[(size_t)(t0 + tt) * 16 + d * 8 + h], lf = q2.GATES[(size_t)(t0 + tt) * 16 + d * 8 + 4 + h];
            bsum += lf; const float gg = ig - bsum; pm = fmaxf(pm, gg); g[tt] = gg; pmv[tt] = pm; bv[tt] = bsum; } }
    if (tid == 64 || tid == 65) { const int d = tid - 64, n = ord_len(d, ch); float m = 0.f;
        for (int i = 0; i < n; ++i) { const int j = ord_chunk(d, ch, i);
            const float* mb = q2.MLB + ((((size_t)d * NB + b) * NCH + j) * 4 + h) * 2; m = fmaxf(mb[1] + m, mb[0]); }
        float suf = 0.f;
        for (int i = n - 1; i >= 0; --i) { const int j = ord_chunk(d, ch, i);
            const float* mb = q2.MLB + ((((size_t)d * NB + b) * NCH + j) * 4 + h) * 2; COEF[d * 72 + i] = __expf(mb[0] + suf - m); suf += mb[1]; }
        M0[d] = m; }
    __syncthreads();
    { const int d = tid >> 8, e0 = (tid & 255) * 16, n = ord_len(d, ch); f32x4 a0 = {0.f, 0.f, 0.f, 0.f}, a1 = a0, a2 = a0, a3 = a0; float nn = 0.f; const int nk = tid & 63, nd = (tid >> 6) & 1;
      for (int i = 0; i < n; ++i) { const float cf = COEF[d * 72 + i]; if (cf < 1e-16f) continue;
          const int j = ord_chunk(d, ch, i);
          const f32x4* src = (const f32x4*)(q2.CLOC + ((((size_t)d * NB + b) * NCH + j) * 4 + h) * 4096 + e0);
          a0 += src[0] * cf; a1 += src[1] * cf; a2 += src[2] * cf; a3 += src[3] * cf; }
      { const int v = e0 >> 6, k = e0 & 63; unsigned short* dst = C0 + (d * 64 + v) * 72 + k;
        u32x4 w0, w1; w0.x = pk2(a0.x, a0.y); w0.y = pk2(a0.z, a0.w); w0.z = pk2(a1.x, a1.y); w0.w = pk2(a1.z, a1.w); w1.x = pk2(a2.x, a2.y); w1.y = pk2(a2.z, a2.w); w1.z = pk2(a3.x, a3.y); w1.w = pk2(a3.z, a3.w);
        *(u32x4*)dst = w0; *(u32x4*)(dst + 8) = w1; }
      if (tid < 128) { const int n2 = ord_len(nd, ch);
          for (int i = 0; i < n2; ++i) { const float cf = COEF[nd * 72 + i]; if (cf < 1e-16f) continue;
              const int j = ord_chunk(nd, ch, i);
              nn += cf * q2.NLOC[((((size_t)nd * NB + b) * NCH + j) * 4 + h) * 64 + nk]; }
          N0[nd * 64 + nk] = nn; }
      if (tid < 256) { const int dd = tid >> 7, tt = tid & 127; const float m0 = M0[dd], M = fmaxf(m0, ROWV[(dd * 5 + 1) * 128 + tt]);
          ROWV[(dd * 5 + 1) * 128 + tt] = M; ROWV[(dd * 5 + 3) * 128 + tt] = __expf(m0 - M); ROWV[(dd * 5 + 4) * 128 + tt] = __expf(-(ROWV[(dd * 5 + 2) * 128 + tt] + M)); } }
    __syncthreads();
    { const int qb = wave & 3, d = wave >> 2; const float* g = ROWV + (d * 5 + 0) * 128; const float* Mv = ROWV + (d * 5 + 1) * 128; const float* wiv = ROWV + (d * 5 + 3) * 128; const float* emtv = ROWV + (d * 5 + 4) * 128;
      att::bf16x8 qr[4]; const int sq = qb * 32 + r32;
      { const unsigned short* qw = (const unsigned short*)q2.QKV16 + (size_t)(t0 + sq) * 768 + h * 64 + hi * 8;
#pragma unroll
        for (int d0 = 0; d0 < 4; ++d0) qr[d0] = *reinterpret_cast<const att::bf16x8*>(qw + d0 * 16); }
      const float Ms = Mv[sq] * 1.4426950408889634f; att::f32x16 o[2] = {}; float rs = 0.f;
      const int vb0 = (int)(uintptr_t)Vs + att::v_rd_base(lane);
#pragma unroll
      for (int kt = 0; kt < 2; ++kt) {
          const bool skip = d == 0 ? (kt == 1 && qb < 2) : (kt == 0 && qb >= 2);
          if (!skip) {
              att::f32x16 p0 = {}, p1 = {}; const char* Kt = Ks + kt * 16384;
#pragma unroll
              for (int d0 = 0; d0 < 4; ++d0) { const int cb = (d0 * 16 + hi * 8) * 2;
                  const att::bf16x8 b0 = *reinterpret_cast<const att::bf16x8*>(Kt + (r32 * 256 + (cb ^ ((r32 & 7) << 4))));
                  const att::bf16x8 b1 = *reinterpret_cast<const att::bf16x8*>(Kt + ((32 + r32) * 256 + (cb ^ ((r32 & 7) << 4))));
                  p0 = __builtin_amdgcn_mfma_f32_32x32x16_bf16(b0, qr[d0], p0, 0, 0, 0); p1 = __builtin_amdgcn_mfma_f32_32x32x16_bf16(b1, qr[d0], p1, 0, 0, 0); }
#pragma unroll
              for (int r = 0; r < 16; ++r) { const int k0 = kt * 64 + att::crow(r, hi), k1 = k0 + 32;
                  const bool ok0 = d == 0 ? k0 <= sq : k0 >= sq, ok1 = d == 0 ? k1 <= sq : k1 >= sq;
                  p0[r] = ok0 ? p0[r] * __builtin_amdgcn_exp2f(g[k0] * 1.4426950408889634f - Ms) : 0.f; p1[r] = ok1 ? p1[r] * __builtin_amdgcn_exp2f(g[k1] * 1.4426950408889634f - Ms) : 0.f;
                  rs += p0[r] + p1[r]; }
              att::bf16x8 pa0, pa1, pa2, pa3;
#define PK4(P, BASE, OUT) do { unsigned a0 = att::cvtpk(P[BASE + 0], P[BASE + 1]), a1 = att::cvtpk(P[BASE + 2], P[BASE + 3]);   \
    unsigned b0 = att::cvtpk(P[BASE + 4], P[BASE + 5]), b1 = att::cvtpk(P[BASE + 6], P[BASE + 7]);                              \
    auto r0 = __builtin_amdgcn_permlane32_swap(a0, b0, false, false); auto r1 = __builtin_amdgcn_permlane32_swap(a1, b1, false, false); \
    att::u32x4 w = {r0[0], r1[0], r0[1], r1[1]}; OUT = *reinterpret_cast<att::bf16x8*>(&w); } while (0)
              PK4(p0, 0, pa0); PK4(p0, 8, pa1); PK4(p1, 0, pa2); PK4(p1, 8, pa3);
#undef PK4
              att::pv_d0(o, vb0 + kt * 8192, pa0, pa1, pa2, pa3);
          }
      }
      att::f32x16 ic[2] = {};
#pragma unroll
      for (int vt = 0; vt < 2; ++vt)
#pragma unroll
          for (int d0 = 0; d0 < 4; ++d0) { const att::bf16x8 cb = *reinterpret_cast<const att::bf16x8*>(C0 + (d * 64 + vt * 32 + r32) * 72 + d0 * 16 + hi * 8);
              ic[vt] = __builtin_amdgcn_mfma_f32_32x32x16_bf16(qr[d0], cb, ic[vt], 0, 0, 0); }
      float nq = 0.f;
#pragma unroll
      for (int d0 = 0; d0 < 4; ++d0)
#pragma unroll
          for (int x = 0; x < 8; ++x) nq += bf2f((unsigned short)qr[d0][x]) * N0[d * 64 + d0 * 16 + hi * 8 + x];
      { auto rr = __builtin_amdgcn_permlane32_swap(__float_as_uint(nq), __float_as_uint(nq), false, false); nq = __uint_as_float(rr[0]) + __uint_as_float(rr[1]); }
      { auto rr = __builtin_amdgcn_permlane32_swap(__float_as_uint(rs), __float_as_uint(rs), false, false); rs = __uint_as_float(rr[0]) + __uint_as_float(rr[1]); }
      const float den = rs + wiv[sq] * nq, dn = fmaxf(fabsf(den), emtv[sq]);
      if (hi == 0) WS[r32] = __builtin_amdgcn_rcpf(dn);
      asm volatile("s_waitcnt lgkmcnt(0)" ::: "memory");
#pragma unroll
      for (int r = 0; r < 16; ++r) { const int row = att::crow(r, hi), tt = qb * 32 + row; const float inv = WS[row], wi = wiv[tt];
#pragma unroll
          for (int vt = 0; vt < 2; ++vt) HX[(d * 128 + tt) * 68 + vt * 32 + r32] = (o[vt][r] + wi * ic[vt][r]) * inv; }
    }
    __syncthreads();
    { const int tt = tid >> 2, v0 = (tid & 3) * 16, t = t0 + tt; float hv[16]; float s = 0.f;
#pragma unroll
      for (int i = 0; i < 16; ++i) { hv[i] = HX[tt * 68 + v0 + i] + HX[(128 + tt) * 68 + v0 + i]; s += hv[i]; }
      s += __shfl_xor(s, 1); s += __shfl_xor(s, 2); const float mu = s * (1.f / 64.f); float vs = 0.f;
#pragma unroll
      for (int i = 0; i < 16; ++i) { hv[i] -= mu; vs += hv[i] * hv[i]; }
      vs += __shfl_xor(vs, 1); vs += __shfl_xor(vs, 2); const float rstd = 1.f / sqrtf(vs * (1.f / 64.f) + EPS);
#pragma unroll
      for (int i = 0; i < 16; ++i) { const int c = h * 64 + v0 + i;
          const float y = hv[i] * rstd * p.in[I_MNG][(size_t)l * 256 + c] + p.in[I_MSK][(size_t)l * 256 + c] * bf2f(q2.XCM16[(size_t)t * 256 + c]);
          Y(t, 768 + c, y * fast_silu(U(t, OFF_MZ + c))); } }
    __syncthreads();
}
typedef float f32x4_t __attribute__((ext_vector_type(4)));

__device__ __forceinline__ void row_norm_mod(f32x4 (&v)[4], const float* g, const float* sc, const float* sh, int lane) {
    float s = 0.f;
#pragma unroll
    for (int j = 0; j < 4; ++j) s += (v[j].x * v[j].x + v[j].y * v[j].y) + (v[j].z * v[j].z + v[j].w * v[j].w);
    const float rstd = 1.f / sqrtf(wave_sum(s) * (1.f / D) + EPS);
#pragma unroll
    for (int j = 0; j < 4; ++j) { const int k = (j * 64 + lane) * 4; const f32x4 gv = *(const f32x4*)(g + k);
        if (sc) { const f32x4 scv = *(const f32x4*)(sc + k), shv = *(const f32x4*)(sh + k); v[j] = v[j] * rstd * gv * (scv + 1.f) + shv; } else v[j] = v[j] * rstd * gv; }
}
__device__ __forceinline__ void row_store_bf16(bf16* dst, const f32x4 (&v)[4], int lane) {
#pragma unroll
    for (int j = 0; j < 4; ++j) { u32x2 w; w.x = pk2(v[j].x, v[j].y); w.y = pk2(v[j].z, v[j].w); *(u32x2*)(dst + (j * 64 + lane) * 4) = w; }
}
__device__ __forceinline__ void rp_first(const P& p, const Q& q, int gw, int ngw, int lane) {
    for (int t = gw; t < NT; t += ngw) { const int b = t / TPB, i = t % TPB; const float* src = i < CTX ? p.in[I_CTX] + ((size_t)b * CTX + i) * D : p.in[I_X] + ((size_t)b * SEQ + (i - CTX)) * D;
        f32x4 v[4];
#pragma unroll
        for (int j = 0; j < 4; ++j) { v[j] = *(const f32x4*)(src + (j * 64 + lane) * 4); *(f32x4*)(p.X + (size_t)t * D + (j * 64 + lane) * 4) = v[j]; }
        const int cv = tok_cv(t); row_norm_mod(v, p.in[I_N1G], modp(p, 0, cv, 1), modp(p, 0, cv, 0), lane); row_store_bf16(q.H16 + (size_t)t * D, v, lane); }
}
__device__ __forceinline__ void rp_end(const P& p, const Q& q, const Q2& q2, int l, int gw, int ngw, int lane) {
    for (int t = gw; t < NT; t += ngw) { const int cv = tok_cv(t); const float* g2 = modp(p, l, cv, 5); f32x4 v[4];
#pragma unroll
        for (int j = 0; j < 4; ++j) { const int k = (j * 64 + lane) * 4; f32x4 s = {0.f, 0.f, 0.f, 0.f};
#pragma unroll
            for (int e = 0; e < 4; ++e) { const u32x2 w = *(const u32x2*)(q2.YB16 + ((size_t)t * 4 + e) * D + k);
                s.x += __builtin_bit_cast(float, w.x << 16); s.y += __builtin_bit_cast(float, w.x & 0xffff0000u); s.z += __builtin_bit_cast(float, w.y << 16); s.w += __builtin_bit_cast(float, w.y & 0xffff0000u); }
            v[j] = *(const f32x4*)(p.X + (size_t)t * D + k) + *(const f32x4*)(g2 + k) * s; }
        if (l + 1 < DEPTH) {
#pragma unroll
            for (int j = 0; j < 4; ++j) *(f32x4*)(p.X + (size_t)t * D + (j * 64 + lane) * 4) = v[j];
            row_norm_mod(v, p.in[I_N1G] + (size_t)(l + 1) * D, modp(p, l + 1, cv, 1), modp(p, l + 1, cv, 0), lane); row_store_bf16(q.H16 + (size_t)t * D, v, lane);
        } else { const int b = t / TPB, i = t % TPB; if (i < CTX) continue;
            row_norm_mod(v, p.in[I_FG], nullptr, nullptr, lane);
#pragma unroll
            for (int j = 0; j < 4; ++j) *(f32x4*)(p.out + ((size_t)b * SEQ + (i - CTX)) * D + (j * 64 + lane) * 4) = v[j]; }
    }
}
constexpr int RPM_LDS = 87488;
__device__ __forceinline__ void rp_mid(const P& p, const Q& q, int l, char* lds) {
    int tid_ = threadIdx.x; asm volatile("" : "+v"(tid_));
    const int tid = tid_, wave = tid >> 6, lane = tid & 63;
    float* HS = (float*)lds; float* PART = (float*)(lds + 65664); float* LG = (float*)(lds + 82048); int* LCNT = (int*)(lds + 84096); int* LBASE = (int*)(lds + 84224); int* PEND = (int*)(lds + 84352); int* NPEND = (int*)(lds + 87424);
    if (tid < 32) LCNT[tid] = 0; if (tid == 32) NPEND[0] = 0;
    float B0[32], B1[32]; const float* Wr = p.in[I_WR] + (size_t)l * D * NE;
#pragma unroll
    for (int ks = 0; ks < 32; ++ks) { const int k = 128 * wave + 4 * ks + (lane >> 4); B0[ks] = Wr[(size_t)k * NE + (lane & 15)]; B1[ks] = Wr[(size_t)k * NE + 16 + (lane & 15)]; }
    __syncthreads();
    const int nitems = NT / 16;
    for (int it = blockIdx.x; it < nitems; it += gridDim.x) {
#pragma unroll 1
        for (int rr = 0; rr < 2; ++rr) { const int row = 2 * wave + rr, t = it * 16 + row, cv = tok_cv(t); f32x4 v[4];
#pragma unroll
            for (int j = 0; j < 4; ++j) v[j] = *(const f32x4*)(p.X + (size_t)t * D + (j * 64 + lane) * 4);
            row_norm_mod(v, p.in[I_N2G] + (size_t)l * D, modp(p, l, cv, 4), modp(p, l, cv, 3), lane); row_store_bf16(q.H16 + (size_t)t * D, v, lane);
#pragma unroll
            for (int j = 0; j < 4; ++j) { float* d = HS + row * 1026 + (j * 64 + lane) * 4; *(float2*)d = make_float2(v[j].x, v[j].y); *(float2*)(d + 2) = make_float2(v[j].z, v[j].w); } }
        __syncthreads();
        { f32x4_t a0 = {0.f, 0.f, 0.f, 0.f}, a1 = a0; const float* hrow = HS + (lane & 15) * 1026 + 128 * wave + (lane >> 4);
#pragma unroll
          for (int ks = 0; ks < 32; ++ks) { const float a = hrow[4 * ks]; a0 = __builtin_amdgcn_mfma_f32_16x16x4f32(a, B0[ks], a0, 0, 0, 0); a1 = __builtin_amdgcn_mfma_f32_16x16x4f32(a, B1[ks], a1, 0, 0, 0); }
#pragma unroll
          for (int r = 0; r < 4; ++r) { const int row = (lane >> 4) * 4 + r; PART[(wave * 16 + row) * 32 + (lane & 15)] = a0[r]; PART[(wave * 16 + row) * 32 + 16 + (lane & 15)] = a1[r]; } }
        __syncthreads();
        { float s = p.in[I_BR][(size_t)l * NE + (tid & 31)];
#pragma unroll
          for (int w = 0; w < 8; ++w) s += PART[w * 512 + tid];
          LG[tid] = s; }
        __syncthreads();
        if (tid < 16) { const int t = it * 16 + tid; float lg[NE];
#pragma unroll
            for (int e = 0; e < NE; ++e) lg[e] = LG[tid * 32 + e];
            int te[TOPK]; float tv[TOPK];
#pragma unroll
            for (int r = 0; r < TOPK; ++r) { float best = -3.0e38f; int bi = 0;
#pragma unroll
                for (int e = 0; e < NE; ++e) { const bool c = lg[e] > best; best = c ? lg[e] : best; bi = c ? e : bi; }
                te[r] = bi; tv[r] = best;
#pragma unroll
                for (int e = 0; e < NE; ++e) lg[e] = (e == bi) ? -3.0e38f : lg[e]; }
            float ssum = 0.f, ex[TOPK];
#pragma unroll
            for (int r = 0; r < TOPK; ++r) { ex[r] = __expf(tv[r] - tv[0]); ssum += ex[r]; }
            const float inv = 1.f / ssum;
#pragma unroll
            for (int r = 0; r < TOPK; ++r) { p.TOPG[t * TOPK + r] = ex[r] * inv; const int lp = atomicAdd(&LCNT[te[r]], 1); const int slot = atomicAdd(NPEND, 1);
                PEND[slot * 2] = t * TOPK + r; PEND[slot * 2 + 1] = (te[r] << 16) | lp; } }
        __syncthreads();
    }
    if (tid < 32) LBASE[tid] = LCNT[tid] > 0 ? atomicAdd(&p.CNT[tid], LCNT[tid]) : 0;
    __syncthreads();
    for (int i = tid; i < NPEND[0]; i += 512) { const int pr = PEND[i * 2], x = PEND[i * 2 + 1], e = x >> 16, lp = x & 0xffff; p.LIST[(size_t)e * NT + LBASE[e] + lp] = pr; }
    __syncthreads();
}
struct EpiDown16 {
    static constexpr bool PERM = true; bf16* YB; const float* bd; const float* TOPG; const int* CNT; const int* LIST; int nN;
    __device__ __forceinline__ void operator()(const pg8::f32x4 (&acc)[2][2][4][2], const pg8::Unit& u, int wr, int wc, int fr, int fq) const {
        const int ntile = u.pn - u.e * nN, cnt = CNT[u.e]; const float* b = bd + (size_t)u.e * D;
#pragma unroll
        for (int ai = 0; ai < 2; ++ai)
#pragma unroll
            for (int m = 0; m < 4; ++m) { const int idx = u.mb * 256 + ai * 128 + wr * 64 + m * 16 + fr;
                if (idx < cnt) { const int pr = LIST[(size_t)u.e * NT + idx]; const float g = TOPG[pr];
#pragma unroll
                    for (int bj = 0; bj < 2; ++bj) { const int c = ntile * 256 + bj * 128 + wc * 32 + 8 * fq; const pg8::f32x4 b0 = *(const pg8::f32x4*)(b + c), b1 = *(const pg8::f32x4*)(b + c + 4);
                        const pg8::f32x4 v0 = (acc[ai][bj][m][0] + b0) * g, v1 = (acc[ai][bj][m][1] + b1) * g;
                        u32x4 w; w.x = pg8::cvt_pk_bf16(v0[0], v0[1]); w.y = pg8::cvt_pk_bf16(v0[2], v0[3]); w.z = pg8::cvt_pk_bf16(v1[0], v1[1]); w.w = pg8::cvt_pk_bf16(v1[2], v1[3]);
                        *(u32x4*)(YB + (size_t)pr * D + c) = w; } } }
    }
};
__device__ __forceinline__ void opt_moe_down16(const P& p, const Q& q, const Q2& q2, int l, LAS unsigned char* lds) {
    pg8::Gemm g{q.ACT16, q.WtDn + (size_t)l * NE * D * DE, DE}; DnOrder S; S.init(p.CNT, p.LIST, D / 256, gridDim.x, blockIdx.x, (LAS int*)(lds + pg8::STAGE_BYTES));
    EpiDown16 E{q2.YB16, p.in[I_BD] + (size_t)l * NE * D, p.TOPG, p.CNT, p.LIST, D / 256}; pg8::gemm_phase<EpiDown16, DnOrder, true>(lds, g, S, E);
}
#include <hip/hip_cooperative_groups.h>
#include <cstdio>
namespace cg = cooperative_groups;
#ifndef ONE_LAUNCH
#define ONE_LAUNCH 1
#endif
constexpr int LDS_BYTES = 148480;
static_assert(ML2_LDS <= LDS_BYTES && ML1_LDS <= LDS_BYTES && LRU1_LDS <= LDS_BYTES && RPM_LDS <= LDS_BYTES && att::SHM_ATTN <= LDS_BYTES && pg8::STAGE_BYTES + 1024 <= LDS_BYTES, "LDS map");

struct BMap { size_t off[64]; size_t total; };
static inline BMap b_map() {
    BMap m; size_t o = 0; int i = 0;
    auto add = [&](size_t bytes) { m.off[i++] = o; o += (bytes + 255) & ~(size_t)255; };
    add((size_t)DEPTH * 3 * 6 * D * 4);
    add((size_t)SEQ * 16 * 2 * 4);
    add((size_t)NT * D * 4);
    add((size_t)NT * TOPK * 4);
    add((size_t)256);
    add((size_t)NE * NT * 4);
    add((size_t)DEPTH * DINP * D * 2);
    add((size_t)DEPTH * D * DMIX * 2);
    add((size_t)DEPTH * NE * 2 * DE * D * 2);
    add((size_t)DEPTH * NE * D * DE * 2);
    add((size_t)DEPTH * 768 * QRANK * 2);
    add((size_t)DEPTH * 1024 * KVRANK * 2);
    add((size_t)NT * D * 2);
    add((size_t)NT * DMIX * 2);
    add((size_t)SLOT_MAX * DE * 2);
    add((size_t)NT * AH * QKD * 2);
    add((size_t)NT * AH * VD * 2);
    add((size_t)NT * DINP * 2);
    add((size_t)DEPTH * 4 * 256 * 64 * 2);
    add((size_t)DEPTH * 4 * 3 * 4096 * 2);
    add((size_t)DEPTH * 32 * 768 * 2);
    add((size_t)DEPTH * 2 * 256 * 4);
    add((size_t)2 * NT * 256 * 4);
    add((size_t)2 * NT * 256 * 4);
    add((size_t)2 * NB * NCH * 256 * 4);
    add((size_t)2 * NB * NCH * 256 * 4);
    add((size_t)NT * 256 * 2);
    add((size_t)NT * 256 * 2);
    add((size_t)NT * 768 * 2);
    add((size_t)DEPTH * 1024 * 256 * 2);
    add((size_t)NT * 256 * 2);
    add((size_t)NT * 768 * 2);
    add((size_t)NT * 16 * 4);
    add((size_t)2 * NB * NCH * 4 * 4096 * 4);
    add((size_t)2 * NB * NCH * 4 * 64 * 4);
    add((size_t)2 * NB * NCH * 4 * 2 * 4);
    add((size_t)NT * TOPK * D * 2);
    m.total = o; return m;
}
struct Args { P p; Q q; Q2 q2; };
static inline void fill_args(Args& a, void* const* d_in, void* d_out, void* d_ws) {
    for (int i = 0; i < N_IN; ++i) a.p.in[i] = (const float*)d_in[i];
    a.p.out = (float*)d_out; char* w = (char*)d_ws; const BMap m = b_map();
    a.p.MOD = (float*)(w + m.off[0]); a.p.ROPET = (float*)(w + m.off[1]); a.p.X = (float*)(w + m.off[2]); a.p.TOPG = (float*)(w + m.off[3]); a.p.CNT = (int*)(w + m.off[4]); a.p.LIST = (int*)(w + m.off[5]);
    a.q.WtIn = (bf16*)(w + m.off[6]); a.q.WtOut = (bf16*)(w + m.off[7]); a.q.WtGu = (bf16*)(w + m.off[8]); a.q.WtDn = (bf16*)(w + m.off[9]); a.q.WtQb = (bf16*)(w + m.off[10]); a.q.WtKvb = (bf16*)(w + m.off[11]);
    a.q.H16 = (bf16*)(w + m.off[12]); a.q.Y16 = (bf16*)(w + m.off[13]); a.q.ACT16 = (bf16*)(w + m.off[14]); a.q.K16 = (bf16*)(w + m.off[15]); a.q.V16 = (bf16*)(w + m.off[16]);
    a.q2.U16 = (bf16*)(w + m.off[17]); a.q2.WtL = (bf16*)(w + m.off[18]); a.q2.WtM = (bf16*)(w + m.off[19]); a.q2.WtG = (bf16*)(w + m.off[20]); a.q2.LSL = (float*)(w + m.off[21]);
    a.q2.HLOC = (float*)(w + m.off[22]); a.q2.PCUM = (float*)(w + m.off[23]); a.q2.SA = (float*)(w + m.off[24]); a.q2.SB = (float*)(w + m.off[25]);
    a.q2.QN16 = (bf16*)(w + m.off[26]); a.q2.KVN16 = (bf16*)(w + m.off[27]); a.q2.Q16 = (bf16*)(w + m.off[28]); a.q2.WtKvbP = (bf16*)(w + m.off[29]);
    a.q2.XCM16 = (bf16*)(w + m.off[30]); a.q2.QKV16 = (bf16*)(w + m.off[31]); a.q2.GATES = (float*)(w + m.off[32]); a.q2.CLOC = (float*)(w + m.off[33]); a.q2.NLOC = (float*)(w + m.off[34]); a.q2.MLB = (float*)(w + m.off[35]);
    a.q2.YB16 = (bf16*)(w + m.off[36]);
}

struct ULoad16 { const bf16* U; __device__ __forceinline__ float operator()(int t, int col) const { return bf2f(U[(size_t)t * DINP + col]); } };
struct YStore16 { bf16* Y; __device__ __forceinline__ void operator()(int t, int col, float v) const { Y[(size_t)t * DMIX + col] = (bf16)f2bf(v); } };
struct OutY16 { bf16* y; __device__ __forceinline__ void operator()(int row, int col, float v) const { y[(size_t)row * DMIX + col] = (bf16)f2bf(v); } };

enum { ST_INIT = 0, ST_RPFIRST, ST_INPROJ, ST_PREP, ST_MLAPROJ, ST_MIX, ST_OUTPROJ, ST_RPMID, ST_GU, ST_DOWN, ST_RPEND, N_ST };

__device__ __forceinline__ void run_step(const Args& a, int step, int l, unsigned char* lds_raw) {
    const P& p = a.p; const Q& q = a.q; const Q2& q2 = a.q2;
    LAS unsigned char* lds = (LAS unsigned char*)lds_raw; char* ldsg = (char*)lds_raw;
    const int G = gridDim.x;
#define THREAD_IDS int tid_ = threadIdx.x; asm volatile("" : "+v"(tid_)); const int tid = tid_, lane = tid & 63, wave = __builtin_amdgcn_readfirstlane(tid >> 6); \
    const int gw = blockIdx.x * NWAVES + wave, ngw = G * NWAVES; const long gtid = (long)blockIdx.x * NTHREADS + tid, nthr = (long)G * NTHREADS; (void)lane; (void)gw; (void)ngw; (void)gtid; (void)nthr;
    switch (step) {
    case ST_INIT: { THREAD_IDS
        nv_init(p, gtid, nthr); opt_convert_small(p, q2, gtid, nthr); opt_convert_weights(p, q, lds, gw, ngw, wave, lane); break; }
    case ST_RPFIRST: { THREAD_IDS rp_first(p, q, gw, ngw, lane); break; }
    case ST_INPROJ: opt_inproj16(q, q2, l, lds); break;
    case ST_PREP: { THREAD_IDS
        if (gtid < NE) p.CNT[gtid] = 0;
        const ULoad16 U{q2.U16};
        for (int it = blockIdx.x; it < NB * NCH * 5; it += G) {
            if (it < NB * NCH) ml1_item(p, q2, l, it / NCH, it % NCH, ldsg, U);
            else { const int x = it - NB * NCH; lru1_item(p, q2, l, (x >> 2) / NCH, (x >> 2) % NCH, x & 3, ldsg, U); } }
        for (int t = gw; t < NT; t += ngw) mla_prep_token(p, q, q2, l, t, lane, U);
        break; }
    case ST_MLAPROJ: opt_mla_proj(p, q, q2, l, lds); break;
    case ST_MIX: {
        const ULoad16 U{q2.U16}; const YStore16 Y{q.Y16};
        const int c = blockIdx.x, vcu = (G % 8 == 0) ? (c % 8) * (G / 8) + c / 8 : c;
        constexpr int QB_LAT = SEQ / 256, QB_CTX = CTX / 256, NU_LAT = NB * AH * QB_LAT, NU_CTX = NB * AH * QB_CTX;
        for (int u = vcu; u < NU_LAT; u += G) { const int bh = u / QB_LAT, qb = u % QB_LAT, b = bh / AH, h = bh % AH, t0 = b * TPB + CTX + qb * 256;
            OutY16 out{q.Y16 + (size_t)t0 * DMIX + 256 + h * VD};
            att::attn_unit<unsigned short, OutY16>((const unsigned short*)q2.Q16 + (size_t)t0 * 768 + h * QKD, 768, (const unsigned short*)q.K16 + ((size_t)b * AH + h) * TPB * QKD, (const unsigned short*)q.V16 + ((size_t)b * AH + h) * TPB * VD, TPB, ldsg, out); }
        if (l + 1 < DEPTH) for (int u = vcu; u < NU_CTX; u += G) { const int bh = u / QB_CTX, qb = u % QB_CTX, b = bh / AH, h = bh % AH, t0 = b * TPB + qb * 256;
            OutY16 out{q.Y16 + (size_t)t0 * DMIX + 256 + h * VD};
            att::attn_unit<unsigned short, OutY16>((const unsigned short*)q2.Q16 + (size_t)t0 * 768 + h * QKD, 768, (const unsigned short*)q.K16 + ((size_t)b * AH + h) * TPB * QKD, (const unsigned short*)q.V16 + ((size_t)b * AH + h) * TPB * VD, CTX, ldsg, out); }
        for (int it = G - 1 - c; it < NB * NCH * 4; it += G) { const int x = it; ml2_item(p, q2, l, (x >> 2) / NCH, (x >> 2) % NCH, x & 3, ldsg, U, Y); }
        for (int it = c; it < NB * NCH; it += G) lru2_item(q2, it / NCH, it % NCH, ldsg, U, Y);
        break; }
    case ST_OUTPROJ: opt_outproj(p, q, l, lds); break;
    case ST_RPMID: rp_mid(p, q, l, ldsg); break;
    case ST_GU: opt_moe_gu(p, q, l, lds); break;
    case ST_DOWN: opt_moe_down16(p, q, q2, l, lds); break;
    case ST_RPEND: { THREAD_IDS rp_end(p, q, q2, l, gw, ngw, lane); break; }
    }
}

#if ONE_LAUNCH
__global__ void __launch_bounds__(512, 2) k_mega(Args a) {
    extern __shared__ __attribute__((aligned(16))) unsigned char lds_raw[];
    cg::grid_group grid = cg::this_grid();
    run_step(a, ST_INIT, 0, lds_raw); grid.sync();
    run_step(a, ST_RPFIRST, 0, lds_raw); grid.sync();
#pragma unroll 1
    for (int l = 0; l < DEPTH; ++l) {
#pragma unroll 1
        for (int s = ST_INPROJ; s <= ST_RPEND; ++s) { run_step(a, s, l, lds_raw); if (!(l == DEPTH - 1 && s == ST_RPEND)) grid.sync(); }
    }
}
#else
template <int STEP>
__global__ void __launch_bounds__(512, 2) k_step(Args a, int l) {
    extern __shared__ __attribute__((aligned(16))) unsigned char lds_raw[];
    run_step(a, STEP, l, lds_raw);
}
template <int STEP> static void launch_step(const Args& a, int l, hipStream_t stream) {
    static bool attr = false;
    if (!attr) { (void)hipFuncSetAttribute((const void*)k_step<STEP>, hipFuncAttributeMaxDynamicSharedMemorySize, LDS_BYTES); attr = true; }
    hipLaunchKernelGGL(k_step<STEP>, dim3(256), dim3(512), LDS_BYTES, stream, a, l);
}
#endif

extern "C" void kernel_launch(void* const* d_in, const int* in_sizes, int n_in, void* d_out, int out_size, void* d_ws, size_t ws_size, hipStream_t stream) {
    static int grid_blocks = 0;
    if (!grid_blocks) {
        int dev = 0, cus = 0;
        (void)hipGetDevice(&dev); (void)hipDeviceGetAttribute(&cus, hipDeviceAttributeMultiprocessorCount, dev);
        grid_blocks = cus;
#if ONE_LAUNCH
        int per_cu = 0;
        (void)hipFuncSetAttribute((const void*)k_mega, hipFuncAttributeMaxDynamicSharedMemorySize, LDS_BYTES);
        (void)hipOccupancyMaxActiveBlocksPerMultiprocessor(&per_cu, (const void*)k_mega, 512, LDS_BYTES);
        if (per_cu < 1) fprintf(stderr, "kernel_launch: occupancy query reports %d workgroups per CU\n", per_cu);
#endif
        const BMap m = b_map();
        if (n_in != N_IN || m.total > ws_size) fprintf(stderr, "kernel_launch: bad n_in %d or workspace too small (%zu needed, %zu given)\n", n_in, m.total, ws_size);
    }
    Args a{}; fill_args(a, d_in, d_out, d_ws);
#if ONE_LAUNCH
    void* args[] = {&a};
    hipError_t e = hipLaunchCooperativeKernel((const void*)k_mega, dim3(grid_blocks), dim3(512), args, LDS_BYTES, stream);
    if (e != hipSuccess) fprintf(stderr, "cooperative launch failed: %s (grid %d)\n", hipGetErrorString(e), grid_blocks);
#else
    launch_step<ST_INIT>(a, 0, stream); launch_step<ST_RPFIRST>(a, 0, stream);
    for (int l = 0; l < DEPTH; ++l) {
        launch_step<ST_INPROJ>(a, l, stream); launch_step<ST_PREP>(a, l, stream); launch_step<ST_MLAPROJ>(a, l, stream); launch_step<ST_MIX>(a, l, stream); launch_step<ST_OUTPROJ>(a, l, stream);
        launch_step<ST_RPMID>(a, l, stream); launch_step<ST_GU>(a, l, stream); launch_step<ST_DOWN>(a, l, stream); launch_step<ST_RPEND>(a, l, stream);
    }
#endif
}
```

```cpp
#include <hip/hip_runtime.h>
#define ONE_LAUNCH 1
#include <math.h>
#include <stdint.h>

#ifndef CFG_D_MODEL
#define CFG_D_MODEL 1024
#endif
#ifndef CFG_SEQ
#define CFG_SEQ 8192
#endif
#ifndef CFG_GRID_W
#define CFG_GRID_W 64
#endif
#ifndef CFG_CTX_LEN
#define CFG_CTX_LEN 256
#endif
#ifndef CFG_N_EXPERTS
#define CFG_N_EXPERTS 32
#endif
#ifndef CFG_D_EXPERT
#define CFG_D_EXPERT 1024
#endif

#ifdef HOST_TEST
#define HD inline
struct float4 { float x, y, z, w; };
static inline int atomic_add_i(int* p, int v) { int o = *p; *p = o + v; return o; }
#else
#define HD __device__ __forceinline__
static __device__ __forceinline__ int atomic_add_i(int* p, int v) { return atomicAdd(p, v); }
#endif

constexpr int D = CFG_D_MODEL, NB = 2, SEQ = CFG_SEQ, DEPTH = 2, GRID_W = CFG_GRID_W, CTX = CFG_CTX_LEN;
constexpr int TPB = CTX + SEQ;
constexpr int NT = NB * TPB;
constexpr int LW = 256, MLH = 4, MHD = 64, MW = 256;
constexpr int AH = 8, NOPE = 64, ROPE = 32, VD = 64, QRANK = 256, KVRANK = 128, QKD = NOPE + ROPE;
constexpr int DIN = 1440, DMIX = 1024;
constexpr int OFF_AX = 0, OFF_AG = 256, OFF_BQ = 512, OFF_BKV = 768, OFF_BKR = 896, OFF_MX = 928, OFF_MZ = 1184;
constexpr int NE = CFG_N_EXPERTS, TOPK = 4, DE = CFG_D_EXPERT;
constexpr float EPS = 1e-6f;

enum { I_X = 0, I_C, I_CTX, I_CCTX, I_N1G, I_N2G, I_WMOD, I_BMOD, I_WIN, I_WOUT, I_LCW, I_LCB, I_LWA, I_LBA, I_LWX, I_LBX, I_LLAM,
       I_QNG, I_WQB, I_KVNG, I_WKVB, I_MCW, I_MCB, I_MWQ, I_MWK, I_MWV, I_MWG, I_MBG, I_MNG, I_MSK, I_WR, I_BR, I_WGU, I_BGU, I_WD, I_BD, I_FG, N_IN };

struct P {
    const float* in[N_IN];
    float* out;
    float *MOD, *ROPET, *X, *H, *U, *XC, *LA, *LB, *HL, *QN, *KVN, *QF, *KVF, *Qr, *Kr, *Vr, *XCM, *QM, *KM, *VM, *IGF, *HM, *Y, *TOPG, *ACT, *YB;
    int *TOPE, *CNT, *LIST;
};

HD float sigmoid_f(float x) { return 1.f / (1.f + expf(-x)); }
HD float silu_f(float x) { return x * sigmoid_f(x); }
HD float logsigmoid_f(float x) { return fminf(x, 0.f) - log1pf(expf(-fabsf(x))); }
HD float gelu_f(float x) { return 0.5f * x * (1.f + tanhf(0.7978845608028654f * (x + 0.044715f * x * x * x))); }

HD int tok_b(int t) { return t / TPB; }
HD int tok_i(int t) { return t % TPB; }
HD bool tok_isctx(int t) { return tok_i(t) < CTX; }
HD int tok_cv(int t) { return tok_isctx(t) ? 2 : tok_b(t); }
HD const float* modp(const P& p, int l, int cv, int which) { return p.MOD + (((size_t)l * 3 + cv) * 6 + which) * D; }

template <int R>
HD void gemm_rx4(const float* (&a)[R], const float* B, int ldb, int K, float4 (&acc)[R]) {
    for (int k = 0; k < K; ++k) {
        const float4 bv = *(const float4*)(B + (size_t)k * ldb);
#pragma unroll
        for (int r = 0; r < R; ++r) { const float av = a[r][k]; acc[r].x += av * bv.x; acc[r].y += av * bv.y; acc[r].z += av * bv.z; acc[r].w += av * bv.w; }
    }
}

HD void nv_init(const P& p, long gtid, long nthr) {
    for (long it = gtid; it < (long)DEPTH * 6 * D; it += nthr) {
        const int l = (int)(it / (6 * D)), j = (int)(it % (6 * D));
        const float* w = p.in[I_WMOD] + (size_t)l * D * 6 * D + j;
        float a0 = 0.f, a1 = 0.f, a2 = 0.f;
        for (int k = 0; k < D; ++k) { const float wv = w[(size_t)k * 6 * D];
            a0 += silu_f(p.in[I_C][k]) * wv; a1 += silu_f(p.in[I_C][D + k]) * wv; a2 += silu_f(p.in[I_CCTX][k]) * wv; }
        const float bb = p.in[I_BMOD][(size_t)l * 6 * D + j];
        p.MOD[((size_t)l * 3 + 0) * 6 * D + j] = a0 + bb; p.MOD[((size_t)l * 3 + 1) * 6 * D + j] = a1 + bb; p.MOD[((size_t)l * 3 + 2) * 6 * D + j] = a2 + bb;
    }
    for (long it = gtid; it < (long)NT * D; it += nthr) {
        const int t = (int)(it / D), k = (int)(it % D), b = tok_b(t), i = tok_i(t);
        p.X[it] = (i < CTX) ? p.in[I_CTX][((size_t)b * CTX + i) * D + k] : p.in[I_X][((size_t)b * SEQ + (i - CTX)) * D + k];
    }
    for (long it = gtid; it < (long)SEQ * 16; it += nthr) {
        const int s = (int)(it / 16), a = (int)((it / 8) & 1), f = (int)(it & 7);
        const int pos = a == 0 ? s / GRID_W : s % GRID_W;
        const double fr = pow(10000.0, -(double)f / 8.0);
        const float frf = (float)fr;
        const double ang = (double)((float)pos * frf);
        p.ROPET[it * 2] = (float)cos(ang); p.ROPET[it * 2 + 1] = (float)sin(ang);
    }
}

HD void nv_norm(const P& p, int l, int which  , long gtid, long nthr) {
    const float* g = p.in[which == 0 ? I_N1G : I_N2G] + (size_t)l * D;
    for (long t = gtid; t < NT; t += nthr) {
        const float* x = p.X + (size_t)t * D; float ss = 0.f;
        for (int k = 0; k < D; ++k) ss += x[k] * x[k];
        const float rstd = 1.f / sqrtf(ss / (float)D + EPS);
        const int cv = tok_cv((int)t); const float* sh = modp(p, l, cv, which == 0 ? 0 : 3); const float* sc = modp(p, l, cv, which == 0 ? 1 : 4);
        float* h = p.H + (size_t)t * D;
        for (int k = 0; k < D; ++k) h[k] = x[k] * rstd * g[k] * (1.f + sc[k]) + sh[k];
    }
}

HD void nv_inproj(const P& p, int l, long gtid, long nthr) {
    constexpr int R = 8, NQ = DIN / 4; const float* W = p.in[I_WIN] + (size_t)l * D * DIN;
    for (long it = gtid; it < (long)(NT / R) * NQ; it += nthr) {
        const int mi = (int)(it / NQ), n = (int)(it % NQ) * 4;
        const float* a[R]; float4 acc[R];
#pragma unroll
        for (int r = 0; r < R; ++r) { a[r] = p.H + (size_t)(mi * R + r) * D; acc[r] = float4{0.f, 0.f, 0.f, 0.f}; }
        gemm_rx4<R>(a, W + n, DIN, D, acc);
#pragma unroll
        for (int r = 0; r < R; ++r) *(float4*)(p.U + (size_t)(mi * R + r) * DIN + n) = acc[r];
    }
}

HD float conv_at(const P& p, int t, int col, int c, const float* w  , const float* bias) {
    const int i = tok_i(t), isc = i < CTX, li = isc ? i : i - CTX, len = isc ? CTX : SEQ;
    float s = bias[c];
#pragma unroll
    for (int k = 0; k < 4; ++k) { const int j = li + k - 2; if (j >= 0 && j < len) s += w[k * 256 + c] * p.U[(size_t)(t + k - 2) * DIN + col + c]; }
    return s;
}

HD void nv_prep1(const P& p, int l, long gtid, long nthr) {
    for (long it = gtid; it < (long)NT * 256; it += nthr) {
        const int t = (int)(it / 256), c = (int)(it % 256);
        p.XC[it] = conv_at(p, t, OFF_AX, c, p.in[I_LCW] + (size_t)l * 4 * 256, p.in[I_LCB] + (size_t)l * 256);
        p.XCM[it] = silu_f(conv_at(p, t, OFF_MX, c, p.in[I_MCW] + (size_t)l * 4 * 256, p.in[I_MCB] + (size_t)l * 256));
    }
    for (long t = gtid; t < NT; t += nthr) {
        const float* u = p.U + (size_t)t * DIN; float sq = 0.f, sk = 0.f;
        for (int k = 0; k < QRANK; ++k) sq += u[OFF_BQ + k] * u[OFF_BQ + k];
        for (int k = 0; k < KVRANK; ++k) sk += u[OFF_BKV + k] * u[OFF_BKV + k];
        const float rq = 1.f / sqrtf(sq / (float)QRANK + EPS), rk = 1.f / sqrtf(sk / (float)KVRANK + EPS);
        for (int k = 0; k < QRANK; ++k) p.QN[(size_t)t * QRANK + k] = u[OFF_BQ + k] * rq * p.in[I_QNG][(size_t)l * QRANK + k];
        for (int k = 0; k < KVRANK; ++k) p.KVN[(size_t)t * KVRANK + k] = u[OFF_BKV + k] * rk * p.in[I_KVNG][(size_t)l * KVRANK + k];
    }
}

HD void nv_prep2(const P& p, int l, long gtid, long nthr) {
    for (long it = gtid; it < (long)2 * NT * 256; it += nthr) {
        const int d = (int)(it / ((long)NT * 256)), t = (int)((it / 256) % NT), c = (int)(it % 256), g = c / 64, j = c % 64;
        const float* xc = p.XC + (size_t)t * 256 + g * 64;
        const float* wa = p.in[I_LWA] + ((((size_t)l * 2 + d) * 4 + g) * 64) * 64 + j;
        const float* wx = p.in[I_LWX] + ((((size_t)l * 2 + d) * 4 + g) * 64) * 64 + j;
        float sa = 0.f, sx = 0.f;
        for (int i = 0; i < 64; ++i) { sa += xc[i] * wa[i * 64]; sx += xc[i] * wx[i * 64]; }
        const float r = sigmoid_f(sa + p.in[I_LBA][((size_t)l * 2 + d) * 256 + c]), ig = sigmoid_f(sx + p.in[I_LBX][((size_t)l * 2 + d) * 256 + c]);
        const float log_a = 8.0f * r * logsigmoid_f(p.in[I_LLAM][((size_t)l * 2 + d) * 256 + c]);
        p.LA[it] = expf(log_a); p.LB[it] = sqrtf(-expm1f(2.f * log_a)) * ig * p.XC[(size_t)t * 256 + c];
    }
    { constexpr int R = 8, NQ = 768 / 4; const float* W = p.in[I_WQB] + (size_t)l * QRANK * 768;
      for (long it = gtid; it < (long)(NT / R) * NQ; it += nthr) { const int mi = (int)(it / NQ), n = (int)(it % NQ) * 4;
        const float* a[R]; float4 acc[R];
#pragma unroll
        for (int r = 0; r < R; ++r) { a[r] = p.QN + (size_t)(mi * R + r) * QRANK; acc[r] = float4{0.f, 0.f, 0.f, 0.f}; }
        gemm_rx4<R>(a, W + n, 768, QRANK, acc);
#pragma unroll
        for (int r = 0; r < R; ++r) *(float4*)(p.QF + (size_t)(mi * R + r) * 768 + n) = acc[r]; } }
    { constexpr int R = 8, NQ = 1024 / 4; const float* W = p.in[I_WKVB] + (size_t)l * KVRANK * 1024;
      for (long it = gtid; it < (long)(NT / R) * NQ; it += nthr) { const int mi = (int)(it / NQ), n = (int)(it % NQ) * 4;
        const float* a[R]; float4 acc[R];
#pragma unroll
        for (int r = 0; r < R; ++r) { a[r] = p.KVN + (size_t)(mi * R + r) * KVRANK; acc[r] = float4{0.f, 0.f, 0.f, 0.f}; }
        gemm_rx4<R>(a, W + n, 1024, KVRANK, acc);
#pragma unroll
        for (int r = 0; r < R; ++r) *(float4*)(p.KVF + (size_t)(mi * R + r) * 1024 + n) = acc[r]; } }
    for (long it = gtid; it < (long)NT * 256; it += nthr) {
        const int t = (int)(it / 256), c = (int)(it % 256), h = c / 64, j = c % 64;
        const float* xc = p.XCM + (size_t)t * 256 + h * 64; const float* ux = p.U + (size_t)t * DIN + OFF_MX + h * 64;
        const float* wq = p.in[I_MWQ] + (((size_t)l * 4 + h) * 64) * 64 + j; const float* wk = p.in[I_MWK] + (((size_t)l * 4 + h) * 64) * 64 + j; const float* wv = p.in[I_MWV] + (((size_t)l * 4 + h) * 64) * 64 + j;
        float sq = 0.f, sk = 0.f, sv = 0.f;
        for (int i = 0; i < 64; ++i) { sq += xc[i] * wq[i * 64]; sk += xc[i] * wk[i * 64]; sv += ux[i] * wv[i * 64]; }
        p.QM[it] = sq; p.KM[it] = sk * 0.125f; p.VM[it] = sv;
    }
}

HD void nv_prep3(const P& p, int l, long gtid, long nthr) {
    for (long it = gtid; it < (long)NB * 2 * 256; it += nthr) {
        const int b = (int)(it / 512), d = (int)((it / 256) & 1), c = (int)(it % 256);
        const float* A = p.LA + (size_t)d * NT * 256; const float* Bc = p.LB + (size_t)d * NT * 256; float* Ho = p.HL + (size_t)d * NT * 256;
        float h = 0.f;
        for (int seg = 0; seg < 2; ++seg) { const int base = b * TPB + (seg == 0 ? 0 : CTX), len = seg == 0 ? CTX : SEQ;
            for (int s = 0; s < len; ++s) { const int t = base + (d == 0 ? s : len - 1 - s);
                h = A[(size_t)t * 256 + c] * h + Bc[(size_t)t * 256 + c]; Ho[(size_t)t * 256 + c] = h; } }
    }
    for (long it = gtid; it < (long)NT * AH; it += nthr) {
        const int t = (int)(it / AH), h = (int)(it % AH), i = tok_i(t); const bool lat = i >= CTX; const int s = i - CTX;
        const float* qf = p.QF + (size_t)t * 768 + h * QKD; const float* kvf = p.KVF + (size_t)t * 1024 + h * (NOPE + VD); const float* kr = p.U + (size_t)t * DIN + OFF_BKR;
        float* qo = p.Qr + ((size_t)t * AH + h) * QKD; float* ko = p.Kr + ((size_t)t * AH + h) * QKD; float* vo = p.Vr + ((size_t)t * AH + h) * VD;
        for (int k = 0; k < NOPE; ++k) { qo[k] = qf[k]; ko[k] = kvf[k]; vo[k] = kvf[NOPE + k]; }
        for (int a = 0; a < 2; ++a) for (int f = 0; f < 8; ++f) {
            float cs = 1.f, sn = 0.f; if (lat) { cs = p.ROPET[(((size_t)s * 2 + a) * 8 + f) * 2]; sn = p.ROPET[(((size_t)s * 2 + a) * 8 + f) * 2 + 1]; }
            const float q1 = qf[NOPE + a * 16 + f], q2 = qf[NOPE + a * 16 + 8 + f], k1 = kr[a * 16 + f], k2 = kr[a * 16 + 8 + f];
            qo[NOPE + a * 16 + f] = q1 * cs - q2 * sn; qo[NOPE + a * 16 + 8 + f] = q2 * cs + q1 * sn;
            ko[NOPE + a * 16 + f] = k1 * cs - k2 * sn; ko[NOPE + a * 16 + 8 + f] = k2 * cs + k1 * sn; }
    }
    for (long it = gtid; it < (long)2 * NT * 8; it += nthr) {
        const int d = (int)(it / ((long)NT * 8)), t = (int)((it / 8) % NT), g = (int)(it % 8);
        const float* w = p.in[I_MWG] + (((size_t)l * 2 + d) * 768) * 8 + g; float s = p.in[I_MBG][((size_t)l * 2 + d) * 8 + g];
        for (int i = 0; i < 256; ++i) s += p.QM[(size_t)t * 256 + i] * w[(size_t)i * 8];
        for (int i = 0; i < 256; ++i) s += p.KM[(size_t)t * 256 + i] * w[(size_t)(256 + i) * 8];
        for (int i = 0; i < 256; ++i) s += p.VM[(size_t)t * 256 + i] * w[(size_t)(512 + i) * 8];
        p.IGF[it] = g < 4 ? s : logsigmoid_f(s);
    }
}

HD void nv_attn(const P& p, long gtid, long nthr) {
    const float scale = 1.0f / sqrtf((float)QKD);
    for (long it = gtid; it < (long)NT * AH; it += nthr) {
        const int h = (int)((it / TPB) % AH), b = (int)(it / ((long)TPB * AH)), i = (int)(it % TPB), t = b * TPB + i;
        const int nk = i < CTX ? CTX : TPB;
        float q[QKD], o[VD];
#pragma unroll
        for (int k = 0; k < QKD; ++k) q[k] = p.Qr[((size_t)t * AH + h) * QKD + k] * scale;
#pragma unroll
        for (int k = 0; k < VD; ++k) o[k] = 0.f;
        float m = -1e30f, lsum = 0.f;
        for (int j = 0; j < nk; ++j) {
            const float* kk = p.Kr + ((size_t)(b * TPB + j) * AH + h) * QKD; const float* vv = p.Vr + ((size_t)(b * TPB + j) * AH + h) * VD;
            float s = 0.f;
#pragma unroll
            for (int k = 0; k < QKD; ++k) s += q[k] * kk[k];
            if (s > m) { const float f = expf(m - s); lsum *= f;
#pragma unroll
                for (int k = 0; k < VD; ++k) o[k] *= f;
                m = s; }
            const float pr = expf(s - m); lsum += pr;
#pragma unroll
            for (int k = 0; k < VD; ++k) o[k] += pr * vv[k];
        }
        const float inv = 1.f / lsum;
#pragma unroll
        for (int k = 0; k < VD; ++k) p.Y[(size_t)t * DMIX + 256 + h * VD + k] = o[k] * inv;
    }
}
HD void nv_mlstm_scan(const P& p, long gtid, long nthr) {
    for (long it = gtid; it < (long)NB * MLH * 2 * 64; it += nthr) {
        const int v = (int)(it % 64), d = (int)((it / 64) & 1), h = (int)((it / 128) % MLH), b = (int)(it / (128 * MLH));
        float C[64], n[64];
#pragma unroll
        for (int k = 0; k < 64; ++k) { C[k] = 0.f; n[k] = 0.f; }
        float m = 0.f;
        for (int seg = 0; seg < 2; ++seg) { const int base = b * TPB + (seg == 0 ? 0 : CTX), len = seg == 0 ? CTX : SEQ;
            for (int s = 0; s < len; ++s) { const int t = base + (d == 0 ? s : len - 1 - s);
                const float ig = p.IGF[((size_t)d * NT + t) * 8 + h], lf = p.IGF[((size_t)d * NT + t) * 8 + 4 + h];
                const float mn = fmaxf(lf + m, ig), fd = expf(lf + m - mn), iw = expf(ig - mn); m = mn;
                const float* qq = p.QM + (size_t)t * 256 + h * 64; const float* kk = p.KM + (size_t)t * 256 + h * 64; const float vv = p.VM[(size_t)t * 256 + h * 64 + v];
                float num = 0.f, den = 0.f;
#pragma unroll
                for (int k = 0; k < 64; ++k) { const float kv = kk[k], qv = qq[k]; C[k] = fd * C[k] + iw * vv * kv; n[k] = fd * n[k] + iw * kv; num += C[k] * qv; den += n[k] * qv; }
                p.HM[((size_t)d * NT + t) * 256 + h * 64 + v] = num / fmaxf(fabsf(den), expf(-mn)); } }
    }
}
HD void nv_lru_out(const P& p, long gtid, long nthr) {
    for (long it = gtid; it < (long)NT * 256; it += nthr) { const int t = (int)(it / 256), c = (int)(it % 256);
        p.Y[(size_t)t * DMIX + c] = (p.HL[it] + p.HL[(size_t)NT * 256 + it]) * gelu_f(p.U[(size_t)t * DIN + OFF_AG + c]); }
}
HD void nv_mlstm_finish(const P& p, int l, long gtid, long nthr) {
    for (long it = gtid; it < (long)NT * MLH; it += nthr) { const int t = (int)(it / MLH), h = (int)(it % MLH);
        const float* h0 = p.HM + (size_t)t * 256 + h * 64; const float* h1 = p.HM + ((size_t)NT + t) * 256 + h * 64;
        float mu = 0.f; for (int j = 0; j < 64; ++j) mu += h0[j] + h1[j]; mu *= (1.f / 64.f);
        float var = 0.f; for (int j = 0; j < 64; ++j) { const float dlt = h0[j] + h1[j] - mu; var += dlt * dlt; } var *= (1.f / 64.f);
        const float rstd = 1.f / sqrtf(var + EPS);
        for (int j = 0; j < 64; ++j) { const int c = h * 64 + j;
            const float y = (h0[j] + h1[j] - mu) * rstd * p.in[I_MNG][(size_t)l * 256 + c] + p.in[I_MSK][(size_t)l * 256 + c] * p.XCM[(size_t)t * 256 + c];
            p.Y[(size_t)t * DMIX + 768 + c] = y * silu_f(p.U[(size_t)t * DIN + OFF_MZ + c]); } }
}
HD void nv_outproj(const P& p, int l, long gtid, long nthr) {
    constexpr int R = 8, NQ = D / 4; const float* W = p.in[I_WOUT] + (size_t)l * DMIX * D;
    for (long it = gtid; it < (long)(NT / R) * NQ; it += nthr) { const int mi = (int)(it / NQ), n = (int)(it % NQ) * 4;
        const float* a[R]; float4 acc[R];
#pragma unroll
        for (int r = 0; r < R; ++r) { a[r] = p.Y + (size_t)(mi * R + r) * DMIX; acc[r] = float4{0.f, 0.f, 0.f, 0.f}; }
        gemm_rx4<R>(a, W + n, D, DMIX, acc);
#pragma unroll
        for (int r = 0; r < R; ++r) { const int t = mi * R + r; const float* g1 = modp(p, l, tok_cv(t), 2) + n; float* x = p.X + (size_t)t * D + n;
            x[0] += g1[0] * acc[r].x; x[1] += g1[1] * acc[r].y; x[2] += g1[2] * acc[r].z; x[3] += g1[3] * acc[r].w; } }
}
HD void nv_zero_cnt(const P& p, long gtid, long nthr) { for (long i = gtid; i < NE; i += nthr) p.CNT[i] = 0; }
HD void nv_router(const P& p, int l, long gtid, long nthr) {
    for (long t = gtid; t < NT; t += nthr) {
        float lg[NE]; const float* h = p.H + (size_t)t * D; const float* W = p.in[I_WR] + (size_t)l * D * NE;
#pragma unroll
        for (int e = 0; e < NE; ++e) lg[e] = p.in[I_BR][(size_t)l * NE + e];
        for (int k = 0; k < D; ++k) { const float hv = h[k];
#pragma unroll
            for (int e = 0; e < NE; ++e) lg[e] += hv * W[(size_t)k * NE + e]; }
        int te[TOPK]; float tv[TOPK];
#pragma unroll
        for (int r = 0; r < TOPK; ++r) { float best = -3.0e38f; int bi = 0;
#pragma unroll
            for (int e = 0; e < NE; ++e) { const bool c = lg[e] > best; best = c ? lg[e] : best; bi = c ? e : bi; }
            te[r] = bi; tv[r] = best;
#pragma unroll
            for (int e = 0; e < NE; ++e) lg[e] = (e == bi) ? -3.0e38f : lg[e]; }
        float s = 0.f, ex[TOPK];
#pragma unroll
        for (int r = 0; r < TOPK; ++r) { ex[r] = expf(tv[r] - tv[0]); s += ex[r]; }
#pragma unroll
        for (int r = 0; r < TOPK; ++r) { p.TOPE[t * TOPK + r] = te[r]; p.TOPG[t * TOPK + r] = ex[r] / s;
            const int pos = atomic_add_i(&p.CNT[te[r]], 1); p.LIST[(size_t)te[r] * NT + pos] = (int)t * TOPK + r; }
    }
}
HD bool moe_item(const P& p, int R, long grp, int& e, int& r0) {
    long acc = 0;
    for (int x = 0; x < NE; ++x) { const int c = p.CNT[x], ng = (c + R - 1) / R; if (grp < acc + ng) { e = x; r0 = (int)(grp - acc) * R; return true; } acc += ng; }
    return false;
}
HD long moe_groups(const P& p, int R) { long acc = 0; for (int x = 0; x < NE; ++x) acc += (p.CNT[x] + R - 1) / R; return acc; }
HD void nv_moe_gu(const P& p, int l, long gtid, long nthr) {
    constexpr int R = 8, NQ = DE / 4; const long ngrp = moe_groups(p, R);
    for (long it = gtid; it < ngrp * NQ; it += nthr) { int e, r0; moe_item(p, R, it / NQ, e, r0); const int n = (int)(it % NQ) * 4, cnt = p.CNT[e];
        const float* Wg = p.in[I_WGU] + ((size_t)l * NE + e) * D * 2 * DE; const float* bg = p.in[I_BGU] + ((size_t)l * NE + e) * 2 * DE;
        const float* a[R]; int pr[R]; float4 ag[R], al[R];
#pragma unroll
        for (int r = 0; r < R; ++r) { const int rr = r0 + r < cnt ? r0 + r : cnt - 1; pr[r] = p.LIST[(size_t)e * NT + rr]; a[r] = p.H + (size_t)(pr[r] / TOPK) * D; ag[r] = float4{0.f, 0.f, 0.f, 0.f}; al[r] = float4{0.f, 0.f, 0.f, 0.f}; }
        gemm_rx4<R>(a, Wg + n, 2 * DE, D, ag);
        gemm_rx4<R>(a, Wg + DE + n, 2 * DE, D, al);
#pragma unroll
        for (int r = 0; r < R; ++r) if (r0 + r < cnt) { float gv[4] = {ag[r].x + bg[n], ag[r].y + bg[n + 1], ag[r].z + bg[n + 2], ag[r].w + bg[n + 3]};
            float lv[4] = {al[r].x + bg[DE + n], al[r].y + bg[DE + n + 1], al[r].z + bg[DE + n + 2], al[r].w + bg[DE + n + 3]};
#pragma unroll
            for (int q = 0; q < 4; ++q) { const float glu = fminf(gv[q], 7.0f), lin = fminf(fmaxf(lv[q], -7.0f), 7.0f);
                p.ACT[(size_t)pr[r] * DE + n + q] = glu * sigmoid_f(1.702f * glu) * (lin + 1.f); } }
    }
}
HD void nv_moe_down(const P& p, int l, long gtid, long nthr) {
    constexpr int R = 8, NQ = D / 4; const long ngrp = moe_groups(p, R);
    for (long it = gtid; it < ngrp * NQ; it += nthr) { int e, r0; moe_item(p, R, it / NQ, e, r0); const int n = (int)(it % NQ) * 4, cnt = p.CNT[e];
        const float* Wd = p.in[I_WD] + ((size_t)l * NE + e) * DE * D; const float* bd = p.in[I_BD] + ((size_t)l * NE + e) * D;
        const float* a[R]; int pr[R]; float4 acc[R];
#pragma unroll
        for (int r = 0; r < R; ++r) { const int rr = r0 + r < cnt ? r0 + r : cnt - 1; pr[r] = p.LIST[(size_t)e * NT + rr]; a[r] = p.ACT + (size_t)pr[r] * DE; acc[r] = float4{0.f, 0.f, 0.f, 0.f}; }
        gemm_rx4<R>(a, Wd + n, D, DE, acc);
#pragma unroll
        for (int r = 0; r < R; ++r) if (r0 + r < cnt) { const float g = p.TOPG[pr[r]]; float* y = p.YB + (size_t)pr[r] * D + n;
            y[0] = g * (acc[r].x + bd[n]); y[1] = g * (acc[r].y + bd[n + 1]); y[2] = g * (acc[r].z + bd[n + 2]); y[3] = g * (acc[r].w + bd[n + 3]); }
    }
}
HD void nv_combine(const P& p, int l, long gtid, long nthr) {
    for (long it = gtid; it < (long)NT * D; it += nthr) { const int t = (int)(it / D), n = (int)(it % D);
        const float s = ((p.YB[((size_t)t * 4 + 0) * D + n] + p.YB[((size_t)t * 4 + 1) * D + n]) + p.YB[((size_t)t * 4 + 2) * D + n]) + p.YB[((size_t)t * 4 + 3) * D + n];
        p.X[it] += modp(p, l, tok_cv(t), 5)[n] * s; }
}
HD void nv_final(const P& p, long gtid, long nthr) {
    for (long r = gtid; r < (long)NB * SEQ; r += nthr) { const int b = (int)(r / SEQ), s = (int)(r % SEQ), t = b * TPB + CTX + s;
        const float* x = p.X + (size_t)t * D; float ss = 0.f;
        for (int k = 0; k < D; ++k) ss += x[k] * x[k];
        const float rstd = 1.f / sqrtf(ss / (float)D + EPS);
        for (int k = 0; k < D; ++k) p.out[(size_t)r * D + k] = x[k] * rstd * p.in[I_FG][k]; }
}

constexpr int PH_PER_LAYER = 13, N_PHASES = 1 + DEPTH * PH_PER_LAYER + 1;
HD void nv_run_phase(const P& p, int ph, long gtid, long nthr) {
    if (ph == 0) { nv_init(p, gtid, nthr); return; }
    if (ph == N_PHASES - 1) { nv_final(p, gtid, nthr); return; }
    const int l = (ph - 1) / PH_PER_LAYER, s = (ph - 1) % PH_PER_LAYER;
    switch (s) {
        case 0: nv_norm(p, l, 0, gtid, nthr); break;
        case 1: nv_inproj(p, l, gtid, nthr); break;
        case 2: nv_prep1(p, l, gtid, nthr); break;
        case 3: nv_prep2(p, l, gtid, nthr); break;
        case 4: nv_prep3(p, l, gtid, nthr); break;
        case 5: nv_mlstm_scan(p, gtid, nthr); nv_attn(p, gtid, nthr); nv_lru_out(p, gtid, nthr); break;
        case 6: nv_mlstm_finish(p, l, gtid, nthr); break;
        case 7: nv_outproj(p, l, gtid, nthr); break;
        case 8: nv_norm(p, l, 1, gtid, nthr); nv_zero_cnt(p, gtid, nthr); break;
        case 9: nv_router(p, l, gtid, nthr); break;
        case 10: nv_moe_gu(p, l, gtid, nthr); break;
        case 11: nv_moe_down(p, l, gtid, nthr); break;
        case 12: nv_combine(p, l, gtid, nthr); break;
    }
}

struct WsMap { size_t off[32]; size_t total; };
static inline WsMap ws_map() {
    WsMap m; size_t o = 0; int i = 0;
    auto add = [&](size_t n) { m.off[i++] = o; o += (n + 63) & ~(size_t)63; };
    add((size_t)DEPTH * 3 * 6 * D);
    add((size_t)SEQ * 16 * 2);
    add((size_t)NT * D);
    add((size_t)NT * D);
    add((size_t)NT * DIN);
    add((size_t)NT * 256);
    add((size_t)2 * NT * 256);
    add((size_t)2 * NT * 256);
    add((size_t)2 * NT * 256);
    add((size_t)NT * QRANK);
    add((size_t)NT * KVRANK);
    add((size_t)NT * 768);
    add((size_t)NT * 1024);
    add((size_t)NT * AH * QKD);
    add((size_t)NT * AH * QKD);
    add((size_t)NT * AH * VD);
    add((size_t)NT * 256);
    add((size_t)NT * 256);
    add((size_t)NT * 256);
    add((size_t)NT * 256);
    add((size_t)2 * NT * 8);
    add((size_t)2 * NT * 256);
    add((size_t)NT * DMIX);
    add((size_t)NT * TOPK);
    add((size_t)NT * TOPK * DE);
    add((size_t)NT * TOPK * D);
    add((size_t)NT * TOPK);
    add((size_t)64);
    add((size_t)NE * NT);
    m.total = o; return m;
}
static inline void fill_params(P& p, void* const* d_in, void* d_out, void* d_ws) {
    for (int i = 0; i < N_IN; ++i) p.in[i] = (const float*)d_in[i];
    p.out = (float*)d_out; float* w = (float*)d_ws; const WsMap m = ws_map();
    p.MOD = w + m.off[0]; p.ROPET = w + m.off[1]; p.X = w + m.off[2]; p.H = w + m.off[3]; p.U = w + m.off[4]; p.XC = w + m.off[5]; p.LA = w + m.off[6]; p.LB = w + m.off[7]; p.HL = w + m.off[8];
    p.QN = w + m.off[9]; p.KVN = w + m.off[10]; p.QF = w + m.off[11]; p.KVF = w + m.off[12]; p.Qr = w + m.off[13]; p.Kr = w + m.off[14]; p.Vr = w + m.off[15];
    p.XCM = w + m.off[16]; p.QM = w + m.off[17]; p.KM = w + m.off[18]; p.VM = w + m.off[19]; p.IGF = w + m.off[20]; p.HM = w + m.off[21]; p.Y = w + m.off[22];
    p.TOPG = w + m.off[23]; p.ACT = w + m.off[24]; p.YB = w + m.off[25]; p.TOPE = (int*)(w + m.off[26]); p.CNT = (int*)(w + m.off[27]); p.LIST = (int*)(w + m.off[28]);
}
namespace pg8 {
#define PG8_LAS __attribute__((address_space(3)))
typedef unsigned short bf16_t;
typedef short bf16x8 __attribute__((ext_vector_type(8)));
typedef float f32x4 __attribute__((ext_vector_type(4)));
typedef unsigned u32x4 __attribute__((ext_vector_type(4)));
constexpr int BM = 256, BK = 64, HALF = 128, HTB = HALF * BK * 2  , STAGE_BYTES = 8 * HTB, NXCD = 8, WGM = 8;

__host__ __device__ __forceinline__ int lds_byte(int r, int c) { const int st = (r >> 4) * 2 + (c >> 5), rr = r & 15, cc = c & 31, ob = rr * 64 + cc * 2; return st * 1024 + (ob ^ (((ob >> 9) & 1) << 5)); }
__host__ __device__ __forceinline__ void stage_rc(int b, int& R, int& C) { const int st = b / 1024, sb = b % 1024, swz = sb ^ (((sb >> 9) & 1) << 5); R = (st >> 1) * 16 + swz / 64; C = (st & 1) * 32 + (swz % 64) / 2; }
__host__ __device__ __forceinline__ int perm32(int rho) { const int n = rho >> 4, i = rho & 15; return 8 * (i >> 2) + 4 * n + (i & 3); }

struct Unit { int pm, pn, e, mb; };
struct Gemm { const bf16_t* A; const bf16_t* Bt; int K; };

struct StaticOrder {
    int nM, nN, nwg, G, c;
    __device__ void init(int M, int N, int G_, int c_) { nM = M / BM; nN = N / BM; nwg = nM * nN; G = G_; c = c_; }
    __device__ bool next(int i, Unit& u) const {
        const long L = (long)i * G + c; if (L >= nwg) return false;
        int wgid = (int)L; { const int q = nwg / NXCD, r = nwg % NXCD, xcd = wgid % NXCD, off = wgid / NXCD; wgid = (xcd < r ? xcd * (q + 1) : r * (q + 1) + (xcd - r) * q) + off; }
        const int nig = WGM * nN, gid = wgid / nig, fm = gid * WGM, gsz = (nM - fm) < WGM ? (nM - fm) : WGM;
        u.pm = fm + ((wgid % nig) % gsz); u.pn = (wgid % nig) / gsz; u.e = 0; u.mb = 0; return true;
    }
    __device__ __forceinline__ int arow(const Unit& u, int r) const { return u.pm * BM + r; }
};

__device__ __forceinline__ unsigned cvt_pk_bf16(float lo, float hi) { unsigned r; asm volatile("v_cvt_pk_bf16_f32 %0, %1, %2" : "=v"(r) : "v"(lo), "v"(hi)); return r; }

template <class Epi, class Sched, bool ALIGN_EPI>
__device__ __forceinline__ void gemm_phase(PG8_LAS unsigned char* lds, const Gemm g, const Sched& S, const Epi& E) {
    int tid_ = threadIdx.x; asm volatile("" : "+v"(tid_));
    const int tid = tid_, wid = __builtin_amdgcn_readfirstlane(tid >> 6), lane = tid & 63, wr = wid >> 2, wc = wid & 3, fr = lane & 15, fq = lane >> 4;
    const int K = g.K, nt = K / BK;
    int Rr[2], Cc[2]; unsigned voffB[2];
#pragma unroll
    for (int i = 0; i < 2; ++i) { int R, C; stage_rc(tid * 16 + i * 8192, R, C); const int Rb = Epi::PERM ? ((R & ~31) + perm32(R & 31)) : R;
        Rr[i] = R; Cc[i] = C; voffB[i] = (unsigned)(Rb * K + C) * 2u; }
    const size_t kstep = (size_t)(BK * 2);
    const size_t hstep = (size_t)HALF * K * 2;
    const size_t tstep = 2 * hstep;
    const unsigned ldsw = (unsigned)wid * 1024u;
    const int aoff = lds_byte(wr * 64 + fr, fq * 8), boff = lds_byte(wc * 32 + fr, fq * 8);
#define PG8_SA(b, h) (((b) * 2 + (h)) * HTB)
#define PG8_SB(b, h) ((4 + (b) * 2 + (h)) * HTB)
#define PG8_STAGE(bufoff, gbase, voff) do { _Pragma("unroll") for (int _i = 0; _i < 2; ++_i) \
        __builtin_amdgcn_global_load_lds((const unsigned*)((const char*)(gbase) + (voff)[_i]), (PG8_LAS unsigned*)(lds + (bufoff) + ldsw + _i * 8192), 16, 0, 0); } while (0)
#define PG8_LDA(dst, b, h) do { _Pragma("unroll") for (int m = 0; m < 4; ++m) _Pragma("unroll") for (int k = 0; k < 2; ++k) dst[m][k] = *(const PG8_LAS bf16x8*)(lds + PG8_SA(b, h) + aoff + m * 2048 + k * 1024); } while (0)
#define PG8_LDB(dst, b, h) do { _Pragma("unroll") for (int n = 0; n < 2; ++n) _Pragma("unroll") for (int k = 0; k < 2; ++k) dst[n][k] = *(const PG8_LAS bf16x8*)(lds + PG8_SB(b, h) + boff + n * 2048 + k * 1024); } while (0)
#define PG8_MMA(ai, bj, At, Bt) do { __builtin_amdgcn_s_setprio(1); _Pragma("unroll") for (int m = 0; m < 4; ++m) _Pragma("unroll") for (int n = 0; n < 2; ++n) _Pragma("unroll") for (int k = 0; k < 2; ++k) \
        acc[ai][bj][m][n] = __builtin_amdgcn_mfma_f32_16x16x32_bf16(Bt[n][k], At[m][k], acc[ai][bj][m][n], 0, 0, 0); __builtin_amdgcn_s_setprio(0); } while (0)
#define PG8_WAIT_V(n) asm volatile("s_waitcnt vmcnt(" #n ")" ::: "memory")
#define PG8_WAIT_L(n) asm volatile("s_waitcnt lgkmcnt(" #n ")" ::: "memory")
#define PG8_BAR __builtin_amdgcn_s_barrier()
#define PG8_SCHED __builtin_amdgcn_sched_barrier(0)
#define PG8_AOFFS(dst, U) do { _Pragma("unroll") for (int _h = 0; _h < 2; ++_h) _Pragma("unroll") for (int _i = 0; _i < 2; ++_i) \
        dst[_h][_i] = (unsigned)(S.arow(U, _h * HALF + Rr[_i]) * K + Cc[_i]) * 2u; } while (0)
    Unit cur, nxt; int ui = 0;
    if (!S.next(0, cur)) return;
    f32x4 acc[2][2][4][2];
#pragma unroll
    for (int a = 0; a < 2; ++a)
#pragma unroll
        for (int b = 0; b < 2; ++b)
#pragma unroll
            for (int m = 0; m < 4; ++m)
#pragma unroll
                for (int n = 0; n < 2; ++n) acc[a][b][m][n] = (f32x4){0.f, 0.f, 0.f, 0.f};
    bf16x8 At[4][2], B0[2][2], B1[2][2];
    unsigned vA[2][2], nvA[2][2];
    PG8_AOFFS(vA, cur);
    const char* gA = (const char*)g.A;
    const char* cB = (const char*)g.Bt + (size_t)cur.pn * tstep;
    PG8_STAGE(PG8_SB(0, 0), cB, voffB); PG8_STAGE(PG8_SB(0, 1), cB + hstep, voffB); PG8_STAGE(PG8_SA(0, 0), gA, vA[0]); PG8_STAGE(PG8_SA(0, 1), gA, vA[1]);
    if (wr == 1) PG8_BAR;
    PG8_WAIT_V(2); PG8_BAR;
    PG8_STAGE(PG8_SB(1, 0), cB + kstep, voffB); PG8_STAGE(PG8_SA(1, 0), gA + kstep, vA[0]); PG8_STAGE(PG8_SB(1, 1), cB + hstep + kstep, voffB);
    PG8_WAIT_V(6); PG8_BAR;
    for (;;) {
        const bool has_next = S.next(ui + 1, nxt);
        if (has_next) { PG8_AOFFS(nvA, nxt); } else {
#pragma unroll
            for (int h = 0; h < 2; ++h)
#pragma unroll
                for (int i = 0; i < 2; ++i) nvA[h][i] = vA[h][i]; }
        const char* nB = has_next ? (const char*)g.Bt + (size_t)nxt.pn * tstep : cB;
#pragma unroll 1
        for (int t = 0; t < nt; t += 2) {
            const bool last = (t == nt - 2);
            const char* a1 = gA + (size_t)(t + 1) * kstep;
            const char* a2 = last ? gA : gA + (size_t)(t + 2) * kstep; const char* b2 = last ? nB : cB + (size_t)(t + 2) * kstep;
            const char* a3 = a2 + kstep; const char* b3 = b2 + kstep;
            unsigned o2[2][2];
#pragma unroll
            for (int h = 0; h < 2; ++h)
#pragma unroll
                for (int i = 0; i < 2; ++i) o2[h][i] = last ? nvA[h][i] : vA[h][i];
            PG8_LDB(B0, 0, 0); PG8_LDB(B1, 0, 1); PG8_SCHED; PG8_LDA(At, 0, 0); PG8_STAGE(PG8_SA(1, 1), a1, vA[1]);
            PG8_WAIT_V(8); PG8_WAIT_L(0); PG8_BAR; PG8_MMA(0, 0, At, B0); PG8_MMA(0, 1, At, B1); PG8_BAR; PG8_SCHED;
            PG8_LDA(At, 0, 1); PG8_STAGE(PG8_SB(0, 0), b2, voffB); PG8_STAGE(PG8_SB(0, 1), b2 + hstep, voffB); PG8_STAGE(PG8_SA(0, 0), a2, o2[0]);
            PG8_WAIT_V(8); PG8_WAIT_L(0); PG8_BAR; PG8_MMA(1, 0, At, B0); PG8_MMA(1, 1, At, B1); PG8_BAR; PG8_SCHED;
            PG8_LDB(B0, 1, 0); PG8_LDB(B1, 1, 1); PG8_SCHED; PG8_LDA(At, 1, 0); PG8_STAGE(PG8_SA(0, 1), a2, o2[1]);
            PG8_WAIT_V(8); PG8_WAIT_L(0); PG8_BAR; PG8_MMA(0, 0, At, B0); PG8_MMA(0, 1, At, B1); PG8_BAR; PG8_SCHED;
            PG8_LDA(At, 1, 1); PG8_STAGE(PG8_SB(1, 0), b3, voffB); PG8_STAGE(PG8_SB(1, 1), b3 + hstep, voffB); PG8_STAGE(PG8_SA(1, 0), a3, o2[0]);
            PG8_WAIT_V(8); PG8_WAIT_L(0); PG8_BAR; PG8_MMA(1, 0, At, B0); PG8_MMA(1, 1, At, B1); PG8_BAR; PG8_SCHED;
        }
        if constexpr (ALIGN_EPI) { if (wr == 0) PG8_BAR; }
        E(acc, cur, wr, wc, fr, fq);
        if (!has_next) break;
#pragma unroll
        for (int a = 0; a < 2; ++a)
#pragma unroll
            for (int b = 0; b < 2; ++b)
#pragma unroll
                for (int m = 0; m < 4; ++m)
#pragma unroll
                    for (int n = 0; n < 2; ++n) acc[a][b][m][n] = (f32x4){0.f, 0.f, 0.f, 0.f};
        cur = nxt; cB = nB; ++ui;
#pragma unroll
        for (int h = 0; h < 2; ++h)
#pragma unroll
            for (int i = 0; i < 2; ++i) vA[h][i] = nvA[h][i];
        if constexpr (ALIGN_EPI) { if (wr == 1) PG8_BAR; }
    }
    PG8_WAIT_V(0);
    if constexpr (!ALIGN_EPI) { if (wr == 0) PG8_BAR; }
    PG8_BAR;
#undef PG8_SA
#undef PG8_SB
#undef PG8_STAGE
#undef PG8_LDA
#undef PG8_LDB
#undef PG8_MMA
#undef PG8_WAIT_V
#undef PG8_WAIT_L
#undef PG8_BAR
#undef PG8_SCHED
#undef PG8_AOFFS
}
}
#define LAS __attribute__((address_space(3)))
typedef unsigned short bf16;
typedef float f32x4 __attribute__((ext_vector_type(4)));
typedef unsigned u32x4 __attribute__((ext_vector_type(4)));
typedef unsigned u32x2 __attribute__((ext_vector_type(2)));

constexpr int NWAVES = 8, NTHREADS = 512;
constexpr int DINP = 1536;
constexpr int SLOT_MAX = NT * TOPK + NE * 256;

struct Q {
    bf16 *WtIn, *WtOut, *WtGu, *WtDn, *WtQb, *WtKvb;
    bf16 *H16, *Y16, *ACT16, *K16, *V16;
};

__device__ __forceinline__ unsigned f2bf(float f) { unsigned u = __builtin_bit_cast(unsigned, f); return (u + 0x7fffu + ((u >> 16) & 1u)) >> 16; }
__device__ __forceinline__ unsigned pk2(float lo, float hi) { return f2bf(lo) | (f2bf(hi) << 16); }
__device__ __forceinline__ float bf2f(unsigned short b) { return __builtin_bit_cast(float, (unsigned)b << 16); }

__device__ __forceinline__ void transpose_item(const float* W, int N, bf16* WT, int ldk, int k0, int n0, int drow0, LAS float* scr, int lane) {
#pragma unroll 4
    for (int i = 0; i < 16; ++i) { const int kk = 4 * i + (lane >> 4), c4 = (lane & 15) * 4; const f32x4 v = *(const f32x4*)(W + (size_t)(k0 + kk) * N + n0 + c4);
        LAS float* d = scr + kk * 65 + c4; d[0] = v.x; d[1] = v.y; d[2] = v.z; d[3] = v.w; }
    asm volatile("s_waitcnt lgkmcnt(0)" ::: "memory");
#pragma unroll
    for (int j = 0; j < 8; ++j) { const int n = 8 * j + (lane >> 3), c = lane & 7; const LAS float* sp = scr + (8 * c) * 65 + n;
        u32x4 o; o.x = pk2(sp[0 * 65], sp[1 * 65]); o.y = pk2(sp[2 * 65], sp[3 * 65]); o.z = pk2(sp[4 * 65], sp[5 * 65]); o.w = pk2(sp[6 * 65], sp[7 * 65]);
        *(u32x4*)(WT + (size_t)(drow0 + n) * ldk + k0 + 8 * c) = o; }
    asm volatile("s_waitcnt lgkmcnt(0)" ::: "memory");
}
__device__ __forceinline__ void opt_convert_weights(const P& p, const Q& q, bf16* WtKvbP, LAS unsigned char* lds, int gw, int ngw, int wave, int lane) {
    LAS float* scr = (LAS float*)(lds + wave * 16640);
    constexpr int I_GU = (D / 64) * (2 * DE / 64), I_DN = (DE / 64) * (D / 64);
    constexpr int I_IN = (D / 64) * ((DIN + 63) / 64), I_OUT = (DMIX / 64) * (D / 64), I_QB = (QRANK / 64) * (768 / 64), I_KVB = (KVRANK / 64) * (1024 / 64);
    constexpr int PER_L = NE * (I_GU + I_DN) + I_IN + I_OUT + I_QB + I_KVB;
    for (int it = gw; it < DEPTH * PER_L; it += ngw) {
        const int l = it / PER_L; int r = it % PER_L;
        if (r < NE * I_GU) { const int e = r / I_GU, rr = r % I_GU, nb = 2 * DE / 64, kb = rr / nb, n0 = 64 * (rr % nb);
            const int isl = n0 >= DE, j0 = n0 - isl * DE, drow0 = 256 * (j0 / 128) + 128 * isl + (j0 % 128);
            transpose_item(p.in[I_WGU] + ((size_t)l * NE + e) * D * 2 * DE, 2 * DE, q.WtGu + ((size_t)l * NE + e) * 2 * DE * D, D, 64 * kb, n0, drow0, scr, lane); continue; } r -= NE * I_GU;
        if (r < NE * I_DN) { const int e = r / I_DN, rr = r % I_DN, nb = D / 64, kb = rr / nb, n0 = 64 * (rr % nb);
            transpose_item(p.in[I_WD] + ((size_t)l * NE + e) * DE * D, D, q.WtDn + ((size_t)l * NE + e) * D * DE, DE, 64 * kb, n0, n0, scr, lane); continue; } r -= NE * I_DN;
        if (r < I_IN) { const int nb = (DIN + 63) / 64, kb = r / nb, n0 = 64 * (r % nb);
            const int n0c = n0 + 64 <= DIN ? n0 : DIN - 64; transpose_item(p.in[I_WIN] + (size_t)l * D * DIN, DIN, q.WtIn + (size_t)l * DINP * D, D, 64 * kb, n0c, n0c, scr, lane); continue; } r -= I_IN;
        if (r < I_OUT) { const int nb = D / 64, kb = r / nb, n0 = 64 * (r % nb); transpose_item(p.in[I_WOUT] + (size_t)l * DMIX * D, D, q.WtOut + (size_t)l * D * DMIX, DMIX, 64 * kb, n0, n0, scr, lane); continue; } r -= I_OUT;
        if (r < I_QB) { const int nb = 768 / 64, kb = r / nb, n0 = 64 * (r % nb); transpose_item(p.in[I_WQB] + (size_t)l * QRANK * 768, 768, q.WtQb + (size_t)l * 768 * QRANK, QRANK, 64 * kb, n0, n0, scr, lane); continue; } r -= I_QB;
        { const int nb = 1024 / 64, kb = r / nb, n0 = 64 * (r % nb); transpose_item(p.in[I_WKVB] + (size_t)l * KVRANK * 1024, 1024, WtKvbP + (size_t)l * 1024 * 256, 256, 64 * kb, n0, n0, scr, lane); }
    }
    const long gt = (long)gw * 64 + lane, ngt = (long)ngw * 64;
    for (long i = gt; i < (long)DEPTH * (DINP - DIN) * D / 8; i += ngt) { const int l = (int)(i / ((DINP - DIN) * D / 8)); const long o = i % ((DINP - DIN) * D / 8);
        *(u32x4*)(q.WtIn + ((size_t)l * DINP + DIN) * D + o * 8) = (u32x4){0u, 0u, 0u, 0u}; }
    for (long i = gt; i < (long)DEPTH * 1024 * 16; i += ngt) *(u32x4*)(WtKvbP + (size_t)(i >> 4) * 256 + 128 + (i & 15) * 8) = (u32x4){0u, 0u, 0u, 0u};
}

struct EpiInprojF32 {
    static constexpr bool PERM = false; float* U;
    __device__ __forceinline__ void operator()(const pg8::f32x4 (&acc)[2][2][4][2], const pg8::Unit& u, int wr, int wc, int fr, int fq) const {
#pragma unroll
        for (int ai = 0; ai < 2; ++ai)
#pragma unroll
            for (int m = 0; m < 4; ++m) { const int row = u.pm * 256 + ai * 128 + wr * 64 + m * 16 + fr;
#pragma unroll
                for (int bj = 0; bj < 2; ++bj)
#pragma unroll
                    for (int n = 0; n < 2; ++n) { const int c = u.pn * 256 + bj * 128 + wc * 32 + n * 16 + 4 * fq; if (c < DIN) *(pg8::f32x4*)(U + (size_t)row * DIN + c) = acc[ai][bj][m][n]; } }
    }
};
struct EpiOutproj {
    static constexpr bool PERM = false; float* X; const float* mod;
    __device__ __forceinline__ void operator()(const pg8::f32x4 (&acc)[2][2][4][2], const pg8::Unit& u, int wr, int wc, int fr, int fq) const {
#pragma unroll
        for (int ai = 0; ai < 2; ++ai)
#pragma unroll
            for (int m = 0; m < 4; ++m) { const int row = u.pm * 256 + ai * 128 + wr * 64 + m * 16 + fr; const float* g1 = mod + ((size_t)tok_cv(row) * 6 + 2) * D;
#pragma unroll
                for (int bj = 0; bj < 2; ++bj)
#pragma unroll
                    for (int n = 0; n < 2; ++n) { const int c = u.pn * 256 + bj * 128 + wc * 32 + n * 16 + 4 * fq;
                        pg8::f32x4* xp = (pg8::f32x4*)(X + (size_t)row * D + c); const pg8::f32x4 gv = *(const pg8::f32x4*)(g1 + c); *xp = *xp + gv * acc[ai][bj][m][n]; } }
    }
};
struct GroupedOrder {
    const int* CNT; const int* LIST; int nN, G, c, total; const LAS int* pre;
    __device__ void init(const int* cnt, const int* list, int nN_, int G_, int c_, LAS int* pre_lds) { CNT = cnt; LIST = list; nN = nN_; G = G_; c = c_; pre = pre_lds;
        __syncthreads();
        if (threadIdx.x == 0) { int a = 0; for (int e = 0; e < NE; ++e) { pre_lds[e] = a; a += (cnt[e] + 255) >> 8; } pre_lds[NE] = a; }
        __syncthreads();
        total = pre_lds[NE] * nN; }
    __device__ bool next(int i, pg8::Unit& u) const {
        const long L = (long)i * G + c; if (L >= total) return false;
        int w = (int)L; { const int nx = pg8::NXCD, qq = total / nx, r = total % nx, xcd = w % nx, off = w / nx; w = (xcd < r ? xcd * (qq + 1) : r * (qq + 1) + (xcd - r) * qq) + off; }
        const int blk = w / nN, ntile = w % nN; int e = 0;
#pragma unroll 1
        for (int x = 1; x < NE; ++x) if (pre[x] <= blk) e = x;
        u.e = e; u.mb = blk - pre[e]; u.pm = blk; u.pn = e * nN + ntile; return true;
    }
};
struct GuOrder : GroupedOrder {
    __device__ __forceinline__ int arow(const pg8::Unit& u, int r) const { const int idx = u.mb * 256 + r; return idx < CNT[u.e] ? (LIST[(size_t)u.e * NT + idx] >> 2) : 0; }
};
struct DnOrder : GroupedOrder {
    __device__ __forceinline__ int arow(const pg8::Unit& u, int r) const { return u.pm * 256 + r; }
};
struct EpiGu {
    static constexpr bool PERM = true; bf16* ACT; const float* bgu;   int nN;
    __device__ __forceinline__ void operator()(const pg8::f32x4 (&acc)[2][2][4][2], const pg8::Unit& u, int wr, int wc, int fr, int fq) const {
        const int ntile = u.pn - u.e * nN, j0 = ntile * 128 + wc * 32 + 8 * fq; const float* bg = bgu + (size_t)u.e * 2 * DE;
        float bgl[8], bli[8];
#pragma unroll
        for (int x = 0; x < 8; ++x) { bgl[x] = bg[j0 + x]; bli[x] = bg[DE + j0 + x]; }
#pragma unroll
        for (int ai = 0; ai < 2; ++ai)
#pragma unroll
            for (int m = 0; m < 4; ++m) { const int row = u.pm * 256 + ai * 128 + wr * 64 + m * 16 + fr; float a[8];
#pragma unroll
                for (int n = 0; n < 2; ++n)
#pragma unroll
                    for (int x = 0; x < 4; ++x) { const float glu = fminf(acc[ai][0][m][n][x] + bgl[4 * n + x], 7.0f), lin = fminf(fmaxf(acc[ai][1][m][n][x] + bli[4 * n + x], -7.0f), 7.0f);
                        a[4 * n + x] = glu / (1.f + __expf(-1.702f * glu)) * (lin + 1.f); }
                u32x4 w; w.x = pg8::cvt_pk_bf16(a[0], a[1]); w.y = pg8::cvt_pk_bf16(a[2], a[3]); w.z = pg8::cvt_pk_bf16(a[4], a[5]); w.w = pg8::cvt_pk_bf16(a[6], a[7]);
                *(u32x4*)(ACT + (size_t)row * DE + j0) = w; }
    }
};
struct EpiDownF32 {
    static constexpr bool PERM = false; float* YB; const float* bd;   const float* TOPG; const int* CNT; const int* LIST; int nN;
    __device__ __forceinline__ void operator()(const pg8::f32x4 (&acc)[2][2][4][2], const pg8::Unit& u, int wr, int wc, int fr, int fq) const {
        const int ntile = u.pn - u.e * nN, cnt = CNT[u.e]; const float* b = bd + (size_t)u.e * D;
#pragma unroll
        for (int ai = 0; ai < 2; ++ai)
#pragma unroll
            for (int m = 0; m < 4; ++m) { const int idx = u.mb * 256 + ai * 128 + wr * 64 + m * 16 + fr;
                if (idx < cnt) { const int pr = LIST[(size_t)u.e * NT + idx]; const float g = TOPG[pr];
#pragma unroll
                    for (int bj = 0; bj < 2; ++bj)
#pragma unroll
                        for (int n = 0; n < 2; ++n) { const int c = ntile * 256 + bj * 128 + wc * 32 + n * 16 + 4 * fq; const pg8::f32x4 bv = *(const pg8::f32x4*)(b + c);
                            *(pg8::f32x4*)(YB + (size_t)pr * D + c) = (acc[ai][bj][m][n] + bv) * g; } } }
    }
};

__device__ __forceinline__ void opt_inproj(const P& p, const Q& q, int l, LAS unsigned char* lds, int G, int bid) {
    pg8::Gemm g{q.H16, q.WtIn + (size_t)l * DINP * D, D}; pg8::StaticOrder S; S.init(NT, DINP, G, bid);
    EpiInprojF32 E{p.U}; pg8::gemm_phase<EpiInprojF32, pg8::StaticOrder, true>(lds, g, S, E);
}
__device__ __forceinline__ void opt_outproj(const P& p, const Q& q, int l, LAS unsigned char* lds, int G, int bid) {
    pg8::Gemm g{q.Y16, q.WtOut + (size_t)l * D * DMIX, DMIX}; pg8::StaticOrder S; S.init(NT, D, G, bid);
    EpiOutproj E{p.X, p.MOD + (size_t)l * 3 * 6 * D}; pg8::gemm_phase<EpiOutproj, pg8::StaticOrder, true>(lds, g, S, E);
}
__device__ __forceinline__ void opt_moe_gu(const P& p, const Q& q, int l, LAS unsigned char* lds, int G, int bid) {
    pg8::Gemm g{q.H16, q.WtGu + (size_t)l * NE * 2 * DE * D, D}; GuOrder S; S.init(p.CNT, p.LIST, 2 * DE / 256, G, bid, (LAS int*)(lds + pg8::STAGE_BYTES));
    EpiGu E{q.ACT16, p.in[I_BGU] + (size_t)l * NE * 2 * DE, 2 * DE / 256}; pg8::gemm_phase<EpiGu, GuOrder, true>(lds, g, S, E);
}
__device__ __forceinline__ void opt_moe_down(const P& p, const Q& q, int l, LAS unsigned char* lds, int G, int bid) {
    pg8::Gemm g{q.ACT16, q.WtDn + (size_t)l * NE * D * DE, DE}; DnOrder S; S.init(p.CNT, p.LIST, D / 256, G, bid, (LAS int*)(lds + pg8::STAGE_BYTES));
    EpiDownF32 E{p.YB, p.in[I_BD] + (size_t)l * NE * D, p.TOPG, p.CNT, p.LIST, D / 256}; pg8::gemm_phase<EpiDownF32, DnOrder, true>(lds, g, S, E);
}
namespace att {
using bf16x8 = __attribute__((ext_vector_type(8))) short;
using s16x4  = __attribute__((ext_vector_type(4))) short;
using f32x16 = __attribute__((ext_vector_type(16))) float;
using f32x8  = __attribute__((ext_vector_type(8))) float;
using u32x4  = __attribute__((ext_vector_type(4))) unsigned;
constexpr int DK = 96, DV = 64, NW = 8, QBLK = 32, KVBLK = 64;
constexpr float SCALE = 0.10206207261596575f;
#ifndef ATTN_THR
#define ATTN_THR 8.f
#endif
constexpr float THR = ATTN_THR;
constexpr int SHM_K = KVBLK * 256, SHM_V = KVBLK * DV * 2;
constexpr int SHM_ATTN = 2 * SHM_V + 2 * SHM_K + NW * 64 * 4;
#define KSWZ(row, colB) ((row) * 256 + ((colB) ^ (((row) & 7) << 4)))
#define SBAR() __builtin_amdgcn_sched_barrier(0)
__device__ __forceinline__ int crow(int r, int hi) { return (r & 3) + 8 * (r >> 2) + 4 * hi; }
__device__ __forceinline__ unsigned cvtpk(float lo, float hi) { unsigned r; asm volatile("v_cvt_pk_bf16_f32 %0, %1, %2" : "=v"(r) : "v"(lo), "v"(hi)); return r; }
__device__ __forceinline__ bf16x8 tobf(f32x8 x) { u32x4 w = {cvtpk(x[0], x[1]), cvtpk(x[2], x[3]), cvtpk(x[4], x[5]), cvtpk(x[6], x[7])}; return *reinterpret_cast<bf16x8*>(&w); }

__device__ __forceinline__ void partialSM(f32x16& p0, f32x16& p1, float& m_reg, float& mn, float& alpha) {
  constexpr float C = SCALE * 1.4426950408889634f;
  float pmax = p0[0];
#pragma unroll
  for (int r = 1; r < 16; ++r) pmax = fmaxf(pmax, p0[r]);
#pragma unroll
  for (int r = 0; r < 16; ++r) pmax = fmaxf(pmax, p1[r]);
  { auto rr = __builtin_amdgcn_permlane32_swap(__float_as_uint(pmax), __float_as_uint(pmax), false, false);
    pmax = fmaxf(__uint_as_float(rr[0]), __uint_as_float(rr[1])); }
  if (__builtin_expect(__all(pmax - m_reg <= THR / SCALE), 1)) { mn = m_reg; alpha = 1.f; }
  else { mn = fmaxf(m_reg, pmax); alpha = __builtin_amdgcn_exp2f((m_reg - mn) * C); m_reg = mn; }
  const float mnC = -mn * C;
#pragma unroll
  for (int r = 0; r < 16; ++r) p0[r] = fmaf(p0[r], C, mnC);
#pragma unroll
  for (int r = 0; r < 16; ++r) p1[r] = fmaf(p1[r], C, mnC);
#pragma unroll
  for (int r = 0; r < 16; ++r) p0[r] = __builtin_amdgcn_exp2f(p0[r]);
}
__device__ __forceinline__ void finishSM(f32x16& p0, f32x16& p1, float alpha, float& l_reg, bf16x8& pa0, bf16x8& pa1, bf16x8& pa2, bf16x8& pa3) {
#pragma unroll
  for (int r = 0; r < 16; ++r) p1[r] = __builtin_amdgcn_exp2f(p1[r]);
  float ps = 0;
#pragma unroll
  for (int r = 0; r < 16; ++r) ps += p0[r];
#pragma unroll
  for (int r = 0; r < 16; ++r) ps += p1[r];
  { auto rr = __builtin_amdgcn_permlane32_swap(__float_as_uint(ps), __float_as_uint(ps), false, false);
    ps = __uint_as_float(rr[0]) + __uint_as_float(rr[1]); }
  l_reg = l_reg * alpha + ps;
#define PK4(P, BASE, OUT) do { unsigned a0 = cvtpk(P[BASE + 0], P[BASE + 1]), a1 = cvtpk(P[BASE + 2], P[BASE + 3]);   \
    unsigned b0 = cvtpk(P[BASE + 4], P[BASE + 5]), b1 = cvtpk(P[BASE + 6], P[BASE + 7]);                              \
    auto r0 = __builtin_amdgcn_permlane32_swap(a0, b0, false, false); auto r1 = __builtin_amdgcn_permlane32_swap(a1, b1, false, false); \
    u32x4 w = {r0[0], r1[0], r0[1], r1[1]}; OUT = *reinterpret_cast<bf16x8*>(&w); } while (0)
  PK4(p0, 0, pa0); PK4(p0, 8, pa1); PK4(p1, 0, pa2); PK4(p1, 8, pa3);
#undef PK4
}
__device__ __forceinline__ void qkt(f32x16& p0, f32x16& p1, const char* Ks, const bf16x8* qr, int r32, int hi) {
  p0 = f32x16{}; p1 = f32x16{};
#pragma unroll
  for (int d0 = 0; d0 < DK / 16; ++d0) { const int cb = (d0 * 16 + hi * 8) * 2;
    const bf16x8 b0 = *reinterpret_cast<const bf16x8*>(Ks + KSWZ(r32, cb));
    const bf16x8 b1 = *reinterpret_cast<const bf16x8*>(Ks + KSWZ(32 + r32, cb));
    p0 = __builtin_amdgcn_mfma_f32_32x32x16_bf16(b0, qr[d0], p0, 0, 0, 0);
    p1 = __builtin_amdgcn_mfma_f32_32x32x16_bf16(b1, qr[d0], p1, 0, 0, 0); }
}
__device__ __forceinline__ int v_st(int k, int c) { const int kk = (k & ~0xC) | ((k & 4) << 1) | ((k & 8) >> 1); return ((kk >> 3) * 2 + (c >> 5)) * 512 + ((kk & 7) * 32 + (c & 31)) * 2; }
__device__ __forceinline__ int v_rd_base(int lane) { return ((lane & 3) << 3) | (((lane >> 2) & 3) << 6) | (((lane >> 4) & 1) << 5) | (((lane >> 5) & 1) << 8); }
constexpr int v_rd_off(int d0, int ks, int half) { return d0 * 512 + ks * 2048 + half * 1024; }
template <int OFF> __device__ __forceinline__ s16x4 tr_read(int vb) {
  s16x4 r; asm volatile("ds_read_b64_tr_b16 %0, %1 offset:%2" : "=&v"(r) : "v"(vb), "i"(OFF) : "memory"); return r;
}
template <int D0> __device__ __forceinline__ void pv_one(f32x16& od, int vb, bf16x8 pa0, bf16x8 pa1, bf16x8 pa2, bf16x8 pa3) {
  const s16x4 l0 = tr_read<v_rd_off(D0, 0, 0)>(vb), h0 = tr_read<v_rd_off(D0, 0, 1)>(vb), l1 = tr_read<v_rd_off(D0, 1, 0)>(vb), h1 = tr_read<v_rd_off(D0, 1, 1)>(vb);
  const s16x4 l2 = tr_read<v_rd_off(D0, 2, 0)>(vb), h2 = tr_read<v_rd_off(D0, 2, 1)>(vb), l3 = tr_read<v_rd_off(D0, 3, 0)>(vb), h3 = tr_read<v_rd_off(D0, 3, 1)>(vb);
  asm volatile("s_waitcnt lgkmcnt(0)" ::: "memory"); SBAR();
#define PK(L, H) (bf16x8){L[0], L[1], L[2], L[3], H[0], H[1], H[2], H[3]}
  od = __builtin_amdgcn_mfma_f32_32x32x16_bf16(pa0, PK(l0, h0), od, 0, 0, 0);
  od = __builtin_amdgcn_mfma_f32_32x32x16_bf16(pa1, PK(l1, h1), od, 0, 0, 0);
  od = __builtin_amdgcn_mfma_f32_32x32x16_bf16(pa2, PK(l2, h2), od, 0, 0, 0);
  od = __builtin_amdgcn_mfma_f32_32x32x16_bf16(pa3, PK(l3, h3), od, 0, 0, 0);
#undef PK
}
__device__ __forceinline__ void pv_d0(f32x16* o, int vb, bf16x8 pa0, bf16x8 pa1, bf16x8 pa2, bf16x8 pa3) {
  pv_one<0>(o[0], vb, pa0, pa1, pa2, pa3); pv_one<1>(o[1], vb, pa0, pa1, pa2, pa3);
}

template <class TQ, class Out>
__device__ __forceinline__ void attn_unit(const TQ* Qb, int ldq, const unsigned short* Kh, const unsigned short* Vh, int seq, char* lds, const Out& OUT) {
  int tid_ = threadIdx.x; asm volatile("" : "+v"(tid_));
  const int tid = tid_, wid = tid >> 6, lane = tid & 63, r32 = lane & 31, hi = lane >> 5;
  char* V_lds = lds; char* K_lds = lds + 2 * SHM_V;
  float* ws = (float*)(lds + 2 * SHM_V + 2 * SHM_K) + wid * 64; float* li_l = ws; float* al_l = ws + 32;
  float m_reg = -1e30f, l_reg = 0; f32x16 o[2] = {}; bf16x8 qr[DK / 16];
  { const TQ* Qw = Qb + (long)(wid * QBLK + r32) * ldq + hi * 8;
#pragma unroll
    for (int d0 = 0; d0 < DK / 16; ++d0) {
      if constexpr (sizeof(TQ) == 4) qr[d0] = tobf(*reinterpret_cast<const f32x8*>(Qw + d0 * 16)); else qr[d0] = *reinterpret_cast<const bf16x8*>(Qw + d0 * 16); } }
  const int kc0 = tid, kc1 = 512 + tid; const bool two = tid < 256;
  const int kst0 = KSWZ(kc0 / 12, (kc0 % 12) * 16), kst1 = KSWZ(kc1 / 12, (kc1 % 12) * 16), vst = v_st(tid >> 3, (tid & 7) * 8);
  const int vb0 = (int)(uintptr_t)V_lds + v_rd_base(lane);
  struct { bf16x8 v, k0, k1; } sr_[2];
#define SLOAD(i, key0) do { sr_[i].v = *reinterpret_cast<const bf16x8*>(Vh + (long)(key0) * DV + tid * 8); sr_[i].k0 = *reinterpret_cast<const bf16x8*>(Kh + (long)(key0) * DK + kc0 * 8); \
    if (two) sr_[i].k1 = *reinterpret_cast<const bf16x8*>(Kh + (long)(key0) * DK + kc1 * 8); } while (0)
#define SWRITE(b, i) do { *(bf16x8*)(V_lds + (b) * SHM_V + vst) = sr_[i].v; *(bf16x8*)(K_lds + (b) * SHM_K + kst0) = sr_[i].k0; if (two) *(bf16x8*)(K_lds + (b) * SHM_K + kst1) = sr_[i].k1; } while (0)
#define RESC(a) do { if (__any((a) < 1.f)) { if (hi == 0) al_l[r32] = (a); asm volatile("s_waitcnt lgkmcnt(0)" ::: "memory"); \
    _Pragma("unroll") for (int d = 0; d < 2; ++d) _Pragma("unroll") for (int r = 0; r < 16; ++r) o[d][r] *= al_l[crow(r, hi)]; } } while (0)
  f32x16 pA0, pA1, pB0, pB1; float mnA, mnB, alA, alB; bf16x8 pa0, pa1, pa2, pa3; const int NT = seq / KVBLK;
  constexpr int SE = 0, SO = 1;
  SLOAD(SE, 0); asm volatile("s_waitcnt vmcnt(0)" ::: "memory"); SWRITE(0, SE); __syncthreads();
  qkt(pA0, pA1, K_lds, qr, r32, hi); partialSM(pA0, pA1, m_reg, mnA, alA);
  SLOAD(SO, KVBLK); if (2 < NT) SLOAD(SE, 2 * KVBLK);
  SWRITE(1, SO); __syncthreads();
  for (int j = 1; j + 1 < NT; j += 2) {
    SBAR(); qkt(pB0, pB1, K_lds + SHM_K, qr, r32, hi);
    finishSM(pA0, pA1, alA, l_reg, pa0, pa1, pa2, pa3); SBAR();
    SLOAD(SO, (j + 2) * KVBLK); SBAR();
    pv_d0(o, vb0, pa0, pa1, pa2, pa3); partialSM(pB0, pB1, m_reg, mnB, alB);
    __syncthreads(); SWRITE(0, SE);
    RESC(alB); __syncthreads();
    SBAR(); qkt(pA0, pA1, K_lds, qr, r32, hi);
    finishSM(pB0, pB1, alB, l_reg, pa0, pa1, pa2, pa3); SBAR();
    if (j + 3 < NT) SLOAD(SE, (j + 3) * KVBLK); SBAR();
    pv_d0(o, vb0 + SHM_V, pa0, pa1, pa2, pa3); partialSM(pA0, pA1, m_reg, mnA, alA);
    __syncthreads(); SWRITE(1, SO);
    RESC(alA); __syncthreads();
  }
  SBAR(); qkt(pB0, pB1, K_lds + SHM_K, qr, r32, hi);
  finishSM(pA0, pA1, alA, l_reg, pa0, pa1, pa2, pa3); SBAR();
  pv_d0(o, vb0, pa0, pa1, pa2, pa3); partialSM(pB0, pB1, m_reg, mnB, alB);
  __syncthreads(); RESC(alB);
  finishSM(pB0, pB1, alB, l_reg, pa0, pa1, pa2, pa3); SBAR();
  pv_d0(o, vb0 + SHM_V, pa0, pa1, pa2, pa3);
  if (hi == 0) li_l[r32] = l_reg; asm volatile("s_waitcnt lgkmcnt(0)" ::: "memory");
  float rli[16];
#pragma unroll
  for (int r = 0; r < 16; ++r) rli[r] = __builtin_amdgcn_rcpf(li_l[crow(r, hi)]);
#pragma unroll
  for (int r = 0; r < 16; ++r) { const int orow = wid * QBLK + crow(r, hi);
#pragma unroll
    for (int d0 = 0; d0 < 2; ++d0) OUT(orow, d0 * 32 + r32, o[d0][r] * rli[r]); }
  __syncthreads();
#undef SLOAD
#undef SWRITE
#undef RESC
}
#undef KSWZ
#undef SBAR
}
struct Q2 {
    bf16* U16;
    bf16 *WtL;
    bf16 *WtM;
    bf16 *WtG;
    float *LSL;
    float *HLOC, *PCUM;
    float *SA, *SB;
    bf16 *QN16, *KVN16;
    bf16 *Q16;
    bf16 *WtKvbP;
    bf16 *XCM16, *QKV16;
    float *GATES;
    float *CLOC, *NLOC, *MLB;
    bf16 *YB16;
};
constexpr int NCH = TPB / 128;
constexpr int NCH_CTX = CTX / 128;

__device__ __forceinline__ float wave_sum(float v) {
#pragma unroll
    for (int o = 1; o < 64; o <<= 1) v += __shfl_xor(v, o);
    return v;
}
__device__ __forceinline__ float fast_sigmoid(float x) { return __builtin_amdgcn_rcpf(1.f + __expf(-x)); }
__device__ __forceinline__ float fast_silu(float x) { return x * fast_sigmoid(x); }
__device__ __forceinline__ float fast_gelu(float x) { const float u = 0.7978845608028654f * (x + 0.044715f * x * x * x); return x * fast_sigmoid(2.f * u); }

struct EpiU16 {
    static constexpr bool PERM = true; bf16* U;
    __device__ __forceinline__ void operator()(const pg8::f32x4 (&acc)[2][2][4][2], const pg8::Unit& u, int wr, int wc, int fr, int fq) const {
#pragma unroll
        for (int ai = 0; ai < 2; ++ai)
#pragma unroll
            for (int m = 0; m < 4; ++m) { const int row = u.pm * 256 + ai * 128 + wr * 64 + m * 16 + fr;
#pragma unroll
                for (int bj = 0; bj < 2; ++bj) { const int c = u.pn * 256 + bj * 128 + wc * 32 + 8 * fq; const pg8::f32x4 v0 = acc[ai][bj][m][0], v1 = acc[ai][bj][m][1];
                    u32x4 w; w.x = pg8::cvt_pk_bf16(v0[0], v0[1]); w.y = pg8::cvt_pk_bf16(v0[2], v0[3]); w.z = pg8::cvt_pk_bf16(v1[0], v1[1]); w.w = pg8::cvt_pk_bf16(v1[2], v1[3]);
                    *(u32x4*)(U + (size_t)row * DINP + c) = w; } }
    }
};
__device__ __forceinline__ void opt_inproj16(const Q& q, const Q2& q2, int l, LAS unsigned char* lds, int G, int bid) {
    pg8::Gemm g{q.H16, q.WtIn + (size_t)l * DINP * D, D}; pg8::StaticOrder S; S.init(NT, DINP, G, bid);
    EpiU16 E{q2.U16}; pg8::gemm_phase<EpiU16, pg8::StaticOrder, true>(lds, g, S, E);
}

__device__ __forceinline__ void opt_convert_small(const P& p, const Q2& q2, long gtid, long nthr) {
    for (long it = gtid; it < (long)DEPTH * 4 * 256 * 64; it += nthr) { const int i = (int)(it & 63), n = (int)((it >> 6) & 255), g = (int)((it >> 14) & 3), l = (int)(it >> 16);
        const int d = n >> 7, gate = (n >> 6) & 1, j = n & 63; const float* w = (gate ? p.in[I_LWX] : p.in[I_LWA]) + ((((size_t)l * 2 + d) * 4 + g) * 64 + i) * 64 + j;
        q2.WtL[it] = (bf16)f2bf(*w); }
    for (long it = gtid; it < (long)DEPTH * 4 * 3 * 64 * 64; it += nthr) { const int i = (int)(it & 63), j = (int)((it >> 6) & 63), m = (int)((it >> 12) % 3), h = (int)((it / (3 * 4096)) & 3), l = (int)(it / (12 * 4096));
        const float* w = (m == 0 ? p.in[I_MWQ] : (m == 1 ? p.in[I_MWK] : p.in[I_MWV])) + (((size_t)l * 4 + h) * 64 + i) * 64 + j;
        q2.WtM[it] = (bf16)f2bf(*w * (m == 1 ? 0.125f : 1.f)); }
    for (long it = gtid; it < (long)DEPTH * 32 * 768; it += nthr) { const int i = (int)(it % 768), n = (int)((it / 768) & 31), l = (int)(it / (32 * 768));
        q2.WtG[it] = n < 16 ? (bf16)f2bf(p.in[I_MWG][((((size_t)l * 2 + (n >> 3)) * 768) + i) * 8 + (n & 7)]) : (bf16)0; }
    for (long it = gtid; it < (long)DEPTH * 2 * 256; it += nthr) q2.LSL[it] = logsigmoid_f(p.in[I_LLAM][it]);
}

__device__ __forceinline__ void opt_init_mod(const P& p, char* lds, int bid, int G) {
    int tid_ = threadIdx.x; asm volatile("" : "+v"(tid_));
    const int tid = tid_; float* SC = (float*)lds; float* RED = (float*)(lds + 12288);
    for (int i = tid; i < 3 * D; i += 512) { const int cv = i / D, k = i % D; const float x = cv < 2 ? p.in[I_C][cv * D + k] : p.in[I_CCTX][k]; SC[i] = x / (1.f + __expf(-x)); }
    __syncthreads();
    for (int it = bid; it < DEPTH * 6 * D / 64; it += G) { const int l = it / (6 * D / 64), j = (it % (6 * D / 64)) * 64 + (tid & 63), kq = tid >> 6;
        const float* w = p.in[I_WMOD] + (size_t)l * D * 6 * D + (size_t)(128 * kq) * 6 * D + j; float a0 = 0.f, a1 = 0.f, a2 = 0.f;
#pragma unroll 8
        for (int k = 0; k < 128; ++k) { const float wv = w[(size_t)k * 6 * D]; a0 += SC[128 * kq + k] * wv; a1 += SC[D + 128 * kq + k] * wv; a2 += SC[2 * D + 128 * kq + k] * wv; }
        RED[(kq * 3 + 0) * 64 + (tid & 63)] = a0; RED[(kq * 3 + 1) * 64 + (tid & 63)] = a1; RED[(kq * 3 + 2) * 64 + (tid & 63)] = a2;
        __syncthreads();
        if (tid < 192) { const int cv = tid >> 6, jj = tid & 63; float sacc = p.in[I_BMOD][(size_t)l * 6 * D + (it % (6 * D / 64)) * 64 + jj];
#pragma unroll
            for (int x = 0; x < 8; ++x) sacc += RED[(x * 3 + cv) * 64 + jj];
            p.MOD[((size_t)l * 3 + cv) * 6 * D + (it % (6 * D / 64)) * 64 + jj] = sacc; }
        __syncthreads(); }
}
__device__ __forceinline__ void opt_init_rope(const P& p, long gtid, long nthr) {
    for (long it = gtid; it < (long)SEQ * 16; it += nthr) { const int s = (int)(it / 16), a = (int)((it / 8) & 1), f = (int)(it & 7); const int pos = a == 0 ? s / GRID_W : s % GRID_W;
        const float frf = (float)pow(10000.0, -(double)f / 8.0); const double ang = (double)((float)pos * frf);
        p.ROPET[it * 2] = (float)cos(ang); p.ROPET[it * 2 + 1] = (float)sin(ang); }
}

template <int KS, class TA, class TB>
__device__ __forceinline__ void wave_mm32(att::f32x16& acc, const TA* A, int lda, const TB* B, int ldb, int r32, int hi) {
#pragma unroll
    for (int ks = 0; ks < KS; ++ks) {
        const att::bf16x8 a = *reinterpret_cast<const att::bf16x8*>(A + (size_t)r32 * lda + ks * 16 + hi * 8);
        const att::bf16x8 b = *reinterpret_cast<const att::bf16x8*>(B + (size_t)r32 * ldb + ks * 16 + hi * 8);
        acc = __builtin_amdgcn_mfma_f32_32x32x16_bf16(a, b, acc, 0, 0, 0);
    }
}

constexpr int LRU1_LDS = 18432 + 65536 + 4096;
template <class UL>
__device__ __forceinline__ void lru1_item(const P& p, const Q2& q2, int l, int b, int ch, int g, char* lds, const UL& U) {
    int tid_ = threadIdx.x; asm volatile("" : "+v"(tid_));
    const int tid = tid_, wave = tid >> 6, lane = tid & 63, r32 = lane & 31, hi = lane >> 5;
    unsigned short* XC16 = (unsigned short*)lds; float* AB = (float*)(lds + 18432); float* CMP = (float*)(lds + 18432 + 65536);
    const int t0 = b * TPB + ch * 128, seg_lo = ch < NCH_CTX ? b * TPB : b * TPB + CTX, seg_hi = ch < NCH_CTX ? b * TPB + CTX : (b + 1) * TPB;
    { const int j = tid & 63, c = g * 64 + j, tb = (tid >> 6) * 16; const float* cw = p.in[I_LCW] + (size_t)l * 4 * 256 + c; const float w0 = cw[0], w1 = cw[256], w2 = cw[512], w3 = cw[768], cb = p.in[I_LCB][(size_t)l * 256 + c];
      float xm2 = (t0 + tb - 2 >= seg_lo) ? U(t0 + tb - 2, OFF_AX + c) : 0.f, xm1 = (t0 + tb - 1 >= seg_lo) ? U(t0 + tb - 1, OFF_AX + c) : 0.f, x0 = U(t0 + tb, OFF_AX + c);
#pragma unroll 4
      for (int i = 0; i < 16; ++i) { const int t = t0 + tb + i; const float xp1 = (t + 1 < seg_hi) ? U(t + 1, OFF_AX + c) : 0.f;
          const float v = cb + w0 * xm2 + w1 * xm1 + w2 * x0 + w3 * xp1; XC16[(tb + i) * 72 + j] = (unsigned short)f2bf(v); xm2 = xm1; xm1 = x0; x0 = xp1; } }
    __syncthreads();
    const bf16* Wt = q2.WtL + ((size_t)l * 4 + g) * 256 * 64;
#pragma unroll 1
    for (int d = 0; d < 2; ++d) {
        const int rt = wave & 3, cj = wave >> 2; att::f32x16 ar = {}, ai = {};
        wave_mm32<4>(ar, XC16 + rt * 32 * 72, 72, Wt + (size_t)(d * 128 + cj * 32) * 64, 64, r32, hi);
        wave_mm32<4>(ai, XC16 + rt * 32 * 72, 72, Wt + (size_t)(d * 128 + 64 + cj * 32) * 64, 64, r32, hi);
        { const int j = cj * 32 + r32, c = g * 64 + j; const float ba = p.in[I_LBA][((size_t)l * 2 + d) * 256 + c], bx = p.in[I_LBX][((size_t)l * 2 + d) * 256 + c], lsl = q2.LSL[((size_t)l * 2 + d) * 256 + c];
#pragma unroll
          for (int r = 0; r < 16; ++r) { const int tt = rt * 32 + att::crow(r, hi); const float rg = fast_sigmoid(ar[r] + ba), ig = fast_sigmoid(ai[r] + bx), la = 8.f * rg * lsl, a = __expf(la);
              const float xc = bf2f(XC16[tt * 72 + j]); const float bb = sqrtf(fmaxf(1.f - a * a, 0.f)) * ig * xc;
              AB[(tt * 64 + j) * 2] = a; AB[(tt * 64 + j) * 2 + 1] = bb; } }
        __syncthreads();
        { const int j = tid & 63, sg = tid >> 6; float av[16], bv[16]; float A = 1.f, B = 0.f;
#pragma unroll
          for (int i = 0; i < 16; ++i) { const int s = sg * 16 + i, tt = d == 0 ? s : 127 - s; av[i] = AB[(tt * 64 + j) * 2]; bv[i] = AB[(tt * 64 + j) * 2 + 1]; B = av[i] * B + bv[i]; A *= av[i]; }
          CMP[(sg * 64 + j) * 2] = A; CMP[(sg * 64 + j) * 2 + 1] = B;
          __syncthreads();
          float cA = 1.f, cB = 0.f;
          for (int x = 0; x < sg; ++x) { const float xa = CMP[(x * 64 + j) * 2], xb = CMP[(x * 64 + j) * 2 + 1]; cB = xa * cB + xb; cA *= xa; }
          const int c = g * 64 + j; float h = cB, pc = cA;
#pragma unroll
          for (int i = 0; i < 16; ++i) { const int s = sg * 16 + i, tt = d == 0 ? s : 127 - s; h = av[i] * h + bv[i]; pc *= av[i];
              q2.HLOC[((size_t)d * NT + t0 + tt) * 256 + c] = h; q2.PCUM[((size_t)d * NT + t0 + tt) * 256 + c] = pc; }
          if (sg == 7) { q2.SA[(((size_t)d * NB + b) * NCH + ch) * 256 + c] = pc; q2.SB[(((size_t)d * NB + b) * NCH + ch) * 256 + c] = h; } }
        __syncthreads();
    }
}
template <class UL, class YS>
__device__ __forceinline__ void lru2_item(const Q2& q2, int b, int ch, char* lds, const UL& U, const YS& Y) {
    int tid_ = threadIdx.x; asm volatile("" : "+v"(tid_));
    const int tid = tid_; float* CAR = (float*)lds;
    { const int d = tid >> 8, c = tid & 255; float h = 0.f;
      if (d == 0) { for (int j = 0; j < ch; ++j) h = q2.SA[(((size_t)0 * NB + b) * NCH + j) * 256 + c] * h + q2.SB[(((size_t)0 * NB + b) * NCH + j) * 256 + c]; }
      else { const bool isctx = ch < NCH_CTX;
          for (int j = NCH_CTX - 1; j >= (isctx ? ch + 1 : 0); --j) h = q2.SA[(((size_t)1 * NB + b) * NCH + j) * 256 + c] * h + q2.SB[(((size_t)1 * NB + b) * NCH + j) * 256 + c];
          if (!isctx) for (int j = NCH - 1; j > ch; --j) h = q2.SA[(((size_t)1 * NB + b) * NCH + j) * 256 + c] * h + q2.SB[(((size_t)1 * NB + b) * NCH + j) * 256 + c]; }
      CAR[tid] = h; }
    __syncthreads();
    const int t0 = b * TPB + ch * 128, c = tid & 255; const float c0 = CAR[c], c1 = CAR[256 + c];
#pragma unroll 4
    for (int i = 0; i < 64; ++i) { const int t = t0 + (tid >> 8) + 2 * i;
        const float hf = q2.HLOC[(size_t)t * 256 + c] + q2.PCUM[(size_t)t * 256 + c] * c0, hb = q2.HLOC[((size_t)NT + t) * 256 + c] + q2.PCUM[((size_t)NT + t) * 256 + c] * c1;
        Y(t, c, (hf + hb) * fast_gelu(U(t, OFF_AG + c))); }
    __syncthreads();
}

template <class UL>
__device__ __forceinline__ void mla_prep_token(const P& p, const Q& q, const Q2& q2, int l, int t, int lane, const UL& U) {
    float xq[4], xk[2]; float sq = 0.f, sk = 0.f;
#pragma unroll
    for (int i = 0; i < 4; ++i) { xq[i] = U(t, OFF_BQ + lane * 4 + i); sq += xq[i] * xq[i]; }
#pragma unroll
    for (int i = 0; i < 2; ++i) { xk[i] = U(t, OFF_BKV + lane * 2 + i); sk += xk[i] * xk[i]; }
    sq = wave_sum(sq); sk = wave_sum(sk);
    const float rq = 1.f / sqrtf(sq * (1.f / QRANK) + EPS), rk = 1.f / sqrtf(sk * (1.f / KVRANK) + EPS);
    const float* gq = p.in[I_QNG] + (size_t)l * QRANK + lane * 4; const float* gk = p.in[I_KVNG] + (size_t)l * KVRANK + lane * 2;
    u32x2 wq; wq.x = pk2(xq[0] * rq * gq[0], xq[1] * rq * gq[1]); wq.y = pk2(xq[2] * rq * gq[2], xq[3] * rq * gq[3]);
    *(u32x2*)(q2.QN16 + (size_t)t * 256 + lane * 4) = wq;
    *(unsigned*)(q2.KVN16 + (size_t)t * 256 + lane * 2) = pk2(xk[0] * rk * gk[0], xk[1] * rk * gk[1]);
    *(unsigned*)(q2.KVN16 + (size_t)t * 256 + 128 + lane * 2) = 0u;
    const int b = t / TPB, key = t % TPB, h = lane >> 3, d0 = (lane & 7) * 4; const bool lat = key >= CTX; const int s = key - CTX;
    float o[4];
#pragma unroll
    for (int i = 0; i < 4; ++i) { const int dd = d0 + i, a = dd >> 4, half = (dd >> 3) & 1, f = dd & 7; const float me = U(t, OFF_BKR + dd), other = U(t, OFF_BKR + (dd ^ 8));
        float cs = 1.f, sn = 0.f; if (lat) { cs = p.ROPET[(((size_t)s * 2 + a) * 8 + f) * 2]; sn = p.ROPET[(((size_t)s * 2 + a) * 8 + f) * 2 + 1]; }
        o[i] = half == 0 ? me * cs - other * sn : me * cs + other * sn; }
    u32x2 wk; wk.x = pk2(o[0], o[1]); wk.y = pk2(o[2], o[3]);
    *(u32x2*)(q.K16 + (((size_t)b * AH + h) * TPB + key) * QKD + NOPE + d0) = wk;
}

struct EpiQproj {
    static constexpr bool PERM = true; bf16* Q16; const float* ROPET;
    __device__ __forceinline__ void operator()(const pg8::f32x4 (&acc)[2][2][4][2], const pg8::Unit& u, int wr, int wc, int fr, int fq) const {
#pragma unroll
        for (int bj = 0; bj < 2; ++bj) { const int blk = u.pn * 8 + bj * 4 + wc; const bool rope = (blk % 3) == 2; const int c = blk * 32 + 8 * fq;
#pragma unroll
            for (int ai = 0; ai < 2; ++ai)
#pragma unroll
                for (int m = 0; m < 4; ++m) { const int row = u.pm * 256 + ai * 128 + wr * 64 + m * 16 + fr; float v[8];
#pragma unroll
                    for (int x = 0; x < 4; ++x) { v[x] = acc[ai][bj][m][0][x]; v[4 + x] = acc[ai][bj][m][1][x]; }
                    if (rope) {
                        const int key = (u.pm % (TPB / 256)) * 256 + ai * 128 + wr * 64 + m * 16 + fr; const bool lat = key >= CTX; const int s = lat ? key - CTX : 0, a = fq >> 1; const float* tb = ROPET + ((size_t)s * 2 + a) * 16;
#pragma unroll
                        for (int x = 0; x < 8; ++x) { const float other = __shfl_xor(v[x], 16); const float cs = lat ? tb[x * 2] : 1.f, sn = lat ? tb[x * 2 + 1] : 0.f;
                            v[x] = (fq & 1) == 0 ? v[x] * cs - other * sn : v[x] * cs + other * sn; } }
                    u32x4 w; w.x = pg8::cvt_pk_bf16(v[0], v[1]); w.y = pg8::cvt_pk_bf16(v[2], v[3]); w.z = pg8::cvt_pk_bf16(v[4], v[5]); w.w = pg8::cvt_pk_bf16(v[6], v[7]);
                    *(u32x4*)(Q16 + (size_t)row * 768 + c) = w; asm volatile("" ::: "memory"); } }
    }
};
struct EpiKVproj {
    static constexpr bool PERM = true; bf16* K16; bf16* V16;
    __device__ __forceinline__ void operator()(const pg8::f32x4 (&acc)[2][2][4][2], const pg8::Unit& u, int wr, int wc, int fr, int fq) const {
#pragma unroll
        for (int bj = 0; bj < 2; ++bj) { const int h = u.pn * 2 + bj, dcol = wc * 32 + 8 * fq; const bool isv = dcol >= 64;
#pragma unroll
            for (int ai = 0; ai < 2; ++ai)
#pragma unroll
                for (int m = 0; m < 4; ++m) { const int b = u.pm / (TPB / 256), key = (u.pm % (TPB / 256)) * 256 + ai * 128 + wr * 64 + m * 16 + fr; const pg8::f32x4 v0 = acc[ai][bj][m][0], v1 = acc[ai][bj][m][1];
                    u32x4 w; w.x = pg8::cvt_pk_bf16(v0[0], v0[1]); w.y = pg8::cvt_pk_bf16(v0[2], v0[3]); w.z = pg8::cvt_pk_bf16(v1[0], v1[1]); w.w = pg8::cvt_pk_bf16(v1[2], v1[3]);
                    bf16* dst = isv ? V16 + (((size_t)b * AH + h) * TPB + key) * VD + (dcol - 64) : K16 + (((size_t)b * AH + h) * TPB + key) * QKD + dcol;
                    *(u32x4*)dst = w; asm volatile("" ::: "memory"); } }
    }
};
__device__ __forceinline__ void opt_mla_proj(const P& p, const Q& q, const Q2& q2, int l, LAS unsigned char* lds, int G, int bid) {
    { pg8::Gemm g{q2.QN16, q.WtQb + (size_t)l * 768 * QRANK, QRANK}; pg8::StaticOrder S; S.init(NT, 768, G, bid);
      EpiQproj E{q2.Q16, p.ROPET}; pg8::gemm_phase<EpiQproj, pg8::StaticOrder, true>(lds, g, S, E); }
    { pg8::Gemm g{q2.KVN16, q2.WtKvbP + (size_t)l * 1024 * 256, 256}; pg8::StaticOrder S; S.init(NT, 1024, G, (bid + 198) % G);
      EpiKVproj E{q.K16, q.V16}; pg8::gemm_phase<EpiKVproj, pg8::StaticOrder, true>(lds, g, S, E); }
}
__device__ __forceinline__ int ord_len(int d, int ch) { return d == 0 ? ch : (ch < NCH_CTX ? NCH_CTX - 1 - ch : NCH_CTX + (NCH - 1 - ch)); }
__device__ __forceinline__ int ord_chunk(int d, int ch, int i) { return d == 0 ? i : (i < (ch < NCH_CTX ? NCH_CTX - 1 - ch : NCH_CTX) ? NCH_CTX - 1 - i : NCH - 1 - (i - NCH_CTX)); }

__device__ __forceinline__ void wave_scan_add128(float& x0, float& x1, int lane) {
#pragma unroll
    for (int off = 1; off < 64; off <<= 1) { const float y0 = __shfl_up(x0, off), y1 = __shfl_up(x1, off); if (lane >= off) { x0 += y0; x1 += y1; } }
    x1 += __shfl(x0, 63);
}
__device__ __forceinline__ void wave_scan_max128(float& x0, float& x1, int lane) {
#pragma unroll
    for (int off = 1; off < 64; off <<= 1) { const float y0 = __shfl_up(x0, off), y1 = __shfl_up(x1, off); if (lane >= off) { x0 = fmaxf(x0, y0); x1 = fmaxf(x1, y1); } }
    x1 = fmaxf(x1, __shfl(x0, 63));
}
__device__ __forceinline__ float wave_max(float v) {
#pragma unroll
    for (int o = 1; o < 64; o <<= 1) v = fmaxf(v, __shfl_xor(v, o));
    return v;
}

constexpr int ML1_LDS = 116736;
template <class UL>
__device__ __forceinline__ void ml1_item(const P& p, const Q2& q2, int l, int b, int ch, char* lds, const UL& U) {
    int tid_ = threadIdx.x; asm volatile("" : "+v"(tid_));
    const int tid = tid_, wave = tid >> 6, lane = tid & 63, r32 = lane & 31, hi = lane >> 5;
    unsigned short* XCh = (unsigned short*)lds; unsigned short* UXh = (unsigned short*)(lds + 18432); unsigned short* QKVh = (unsigned short*)(lds + 36864);
    float* GP = (float*)(lds + 92160); float* GT = (float*)(lds + 108544);
    const int t0 = b * TPB + ch * 128, seg_lo = ch < NCH_CTX ? b * TPB : b * TPB + CTX, seg_hi = ch < NCH_CTX ? b * TPB + CTX : (b + 1) * TPB;
    const int rt = wave & 3, wh = wave >> 2;
    att::f32x16 gacc = {};
#pragma unroll 1
    for (int h = 0; h < 4; ++h) {
        { const int j = tid & 63, c = h * 64 + j, tb = (tid >> 6) * 16; const float* cw = p.in[I_MCW] + (size_t)l * 4 * 256 + c; const float w0 = cw[0], w1 = cw[256], w2 = cw[512], w3 = cw[768], cb = p.in[I_MCB][(size_t)l * 256 + c];
          float xm2 = (t0 + tb - 2 >= seg_lo) ? U(t0 + tb - 2, OFF_MX + c) : 0.f, xm1 = (t0 + tb - 1 >= seg_lo) ? U(t0 + tb - 1, OFF_MX + c) : 0.f, x0 = U(t0 + tb, OFF_MX + c);
#pragma unroll 4
          for (int i = 0; i < 16; ++i) { const int t = t0 + tb + i; const float xp1 = (t + 1 < seg_hi) ? U(t + 1, OFF_MX + c) : 0.f;
              const float v = fast_silu(cb + w0 * xm2 + w1 * xm1 + w2 * x0 + w3 * xp1); const unsigned short vb = (unsigned short)f2bf(v);
              XCh[(tb + i) * 72 + j] = vb; UXh[(tb + i) * 72 + j] = (unsigned short)f2bf(x0); q2.XCM16[(size_t)t * 256 + c] = vb; xm2 = xm1; xm1 = x0; x0 = xp1; } }
        __syncthreads();
        { const bf16* Wm = q2.WtM + ((size_t)l * 4 + h) * 3 * 4096;
#pragma unroll
          for (int m = 0; m < 3; ++m) { att::f32x16 a = {};
              wave_mm32<4>(a, (m == 2 ? UXh : XCh) + rt * 32 * 72, 72, Wm + (size_t)m * 4096 + (size_t)wh * 32 * 64, 64, r32, hi);
#pragma unroll
              for (int r = 0; r < 16; ++r) { const int tt = rt * 32 + att::crow(r, hi); const unsigned short vb = (unsigned short)f2bf(a[r]);
                  QKVh[(m * 128 + tt) * 72 + wh * 32 + r32] = vb; q2.QKV16[(size_t)(t0 + tt) * 768 + m * 256 + h * 64 + wh * 32 + r32] = vb; } } }
        __syncthreads();
        { const bf16* Wg = q2.WtG + (size_t)l * 32 * 768;
#pragma unroll
          for (int x = 0; x < 6; ++x) { const int idx = wh * 6 + x, m = idx >> 2, ks = idx & 3;
              const att::bf16x8 a = *reinterpret_cast<const att::bf16x8*>(QKVh + (m * 128 + rt * 32 + r32) * 72 + ks * 16 + hi * 8);
              const att::bf16x8 bb = *reinterpret_cast<const att::bf16x8*>(Wg + (size_t)r32 * 768 + m * 256 + h * 64 + ks * 16 + hi * 8);
              gacc = __builtin_amdgcn_mfma_f32_32x32x16_bf16(a, bb, gacc, 0, 0, 0); } }
        __syncthreads();
    }
    if (r32 < 16) {
#pragma unroll
        for (int r = 0; r < 16; ++r) GP[(wh * 128 + rt * 32 + att::crow(r, hi)) * 16 + r32] = gacc[r]; }
    __syncthreads();
    for (int i = tid; i < 128 * 16; i += 512) { const int n = i & 15, d = n >> 3, g = n & 7; float v = GP[i] + GP[128 * 16 + i] + p.in[I_MBG][((size_t)l * 2 + d) * 8 + g];
        if (g >= 4) v = fminf(v, 0.f) - __logf(1.f + __expf(-fabsf(v)));
        GT[i] = v; q2.GATES[(size_t)(t0 + (i >> 4)) * 16 + n] = v; }
    __syncthreads();
    unsigned short* KT = (unsigned short*)lds; unsigned short* VT = (unsigned short*)(lds + 17408); float* WR = (float*)(lds + 52224); float* MB = (float*)(lds + 53248); float* WE = (float*)(lds + 53280);
#pragma unroll 1
    for (int h = 0; h < 4; ++h) {
        if (wave < 2) { const int d = wave, ta = d == 0 ? lane : 127 - lane, tb = d == 0 ? lane + 64 : 63 - lane;
            float b0 = GT[ta * 16 + d * 8 + 4 + h], b1 = GT[tb * 16 + d * 8 + 4 + h]; wave_scan_add128(b0, b1, lane);
            const float bL = __shfl(b1, 63), w0 = bL - b0 + GT[ta * 16 + d * 8 + h], w1 = bL - b1 + GT[tb * 16 + d * 8 + h];
            WR[d * 128 + ta] = w0; WR[d * 128 + tb] = w1; const float mx = wave_max(fmaxf(w0, w1));
            if (lane == 0) { MB[d * 2] = mx; MB[d * 2 + 1] = bL; } }
        __syncthreads();
        { const int tt = tid & 127, jg = tid >> 7; const float w0 = __expf(WR[tt] - MB[0]), w1 = __expf(WR[128 + tt] - MB[2]);
          const unsigned short* ksrc = (const unsigned short*)q2.QKV16 + (size_t)(t0 + tt) * 768 + 256 + h * 64 + jg * 16; const unsigned short* vsrc = ksrc + 256;
          const att::bf16x8 k0 = *reinterpret_cast<const att::bf16x8*>(ksrc), k1 = *reinterpret_cast<const att::bf16x8*>(ksrc + 8), v0 = *reinterpret_cast<const att::bf16x8*>(vsrc), v1 = *reinterpret_cast<const att::bf16x8*>(vsrc + 8);
#pragma unroll
          for (int i = 0; i < 8; ++i) { KT[(jg * 16 + i) * 136 + tt] = (unsigned short)k0[i]; KT[(jg * 16 + 8 + i) * 136 + tt] = (unsigned short)k1[i];
              const float va = bf2f((unsigned short)v0[i]), vb = bf2f((unsigned short)v1[i]);
              VT[(jg * 16 + i) * 136 + tt] = (unsigned short)f2bf(va * w0); VT[(jg * 16 + 8 + i) * 136 + tt] = (unsigned short)f2bf(vb * w0);
              VT[(64 + jg * 16 + i) * 136 + tt] = (unsigned short)f2bf(va * w1); VT[(64 + jg * 16 + 8 + i) * 136 + tt] = (unsigned short)f2bf(vb * w1); }
          if (tid < 128) WE[tid] = w0; else if (tid < 256) WE[tid] = w1; }
        __syncthreads();
        { const int d = wave >> 2, vt = (wave >> 1) & 1, kt = wave & 1; att::f32x16 c = {};
          wave_mm32<8>(c, VT + (size_t)(d * 64 + vt * 32) * 136, 136, KT + (size_t)kt * 32 * 136, 136, r32, hi);
          float* dst = q2.CLOC + ((((size_t)d * NB + b) * NCH + ch) * 4 + h) * 4096;
#pragma unroll
          for (int r = 0; r < 16; ++r) dst[(vt * 32 + att::crow(r, hi)) * 64 + kt * 32 + r32] = c[r];
          if (tid < 128) { const int dd = tid >> 6, k = tid & 63; float s = 0.f; for (int tt = 0; tt < 128; ++tt) s += WE[dd * 128 + tt] * bf2f(KT[k * 136 + tt]);
              q2.NLOC[((((size_t)dd * NB + b) * NCH + ch) * 4 + h) * 64 + k] = s; }
          if (tid < 2) { float* mb = q2.MLB + ((((size_t)tid * NB + b) * NCH + ch) * 4 + h) * 2; mb[0] = MB[tid * 2]; mb[1] = MB[tid * 2 + 1]; } }
        __syncthreads();
    }
}

constexpr int ML2_LDS = 145536;
template <class UL, class YS>
__device__ __forceinline__ void ml2_item(const P& p, const Q2& q2, int l, int b, int ch, int h, char* lds, const UL& U, const YS& Y) {
    int tid_ = threadIdx.x; asm volatile("" : "+v"(tid_));
    const int tid = tid_, wave = tid >> 6, lane = tid & 63, r32 = lane & 31, hi = lane >> 5;
    char* Ks = lds; char* Vs = lds + 32768; unsigned short* C0 = (unsigned short*)(lds + 49152); float* N0 = (float*)(lds + 67584); float* ROWV = (float*)(lds + 68096);
    float* COEF = (float*)(lds + 73216); float* M0 = (float*)(lds + 73792); float* WS = (float*)(lds + 73856) + wave * 64; float* HX = (float*)(lds + 75904);
    const int t0 = b * TPB + ch * 128;
    { const unsigned short* base = (const unsigned short*)q2.QKV16 + (size_t)t0 * 768 + h * 64;
#pragma unroll
      for (int x = 0; x < 2; ++x) { const int cidx = tid + x * 512, key = cidx >> 3, c8 = cidx & 7, tile = key >> 6, kk = key & 63;
          const att::bf16x8 kv = *reinterpret_cast<const att::bf16x8*>(base + (size_t)key * 768 + 256 + c8 * 8), vv = *reinterpret_cast<const att::bf16x8*>(base + (size_t)key * 768 + 512 + c8 * 8);
          *(att::bf16x8*)(Ks + tile * 16384 + (kk * 256 + ((c8 * 16) ^ ((kk & 7) << 4)))) = kv;
          *(att::bf16x8*)(Vs + tile * 8192 + att::v_st(kk, c8 * 8)) = vv; } }
    if (wave < 2) { const int d = wave, ta = d == 0 ? lane : 127 - lane, tb = d == 0 ? lane + 64 : 63 - lane;
        float* g = ROWV + (d * 5 + 0) * 128; float* pmv = ROWV + (d * 5 + 1) * 128; float* bv = ROWV + (d * 5 + 2) * 128;
        const float iga = q2.GATES[(size_t)(t0 + ta) * 16 + d * 8 + h], igb = q2.GATES[(size_t)(t0 + tb) * 16 + d * 8 + h];
        float b0 = q2.GATES[(size_t)(t0 + ta) * 16 + d * 8 + 4 + h], b1 = q2.GATES[(size_t)(t0 + tb) * 16 + d * 8 + 4 + h]; wave_scan_add128(b0, b1, lane);
        const float g0 = iga - b0, g1 = igb - b1; float p0 = g0, p1 = g1; wave_scan_max128(p0, p1, lane);
        g[ta] = g0; g[tb] = g1; pmv[ta] = p0; pmv[tb] = p1; bv[ta] = b0; bv[tb] = b1; }
    else if (wave < 4) { const int d = wave - 2, n = ord_len(d, ch);
        float* MLs = HX + d * 160;
        for (int i = lane; i < n; i += 64) { const float* mb = q2.MLB + ((((size_t)d * NB + b) * NCH + ord_chunk(d, ch, i)) * 4 + h) * 2; MLs[i * 2] = mb[0]; MLs[i * 2 + 1] = mb[1]; }
        asm volatile("s_waitcnt vmcnt(0) lgkmcnt(0)" ::: "memory");
        if (lane == 0) { float m = 0.f;
            for (int i = 0; i < n; ++i) m = fmaxf(MLs[i * 2 + 1] + m, MLs[i * 2]);
            float suf = 0.f;
            for (int i = n - 1; i >= 0; --i) { COEF[d * 72 + i] = __expf(MLs[i * 2] + suf - m); suf += MLs[i * 2 + 1]; }
            M0[d] = m; } }
    __syncthreads();
    { const int d = tid >> 8, e0 = (tid & 255) * 16, n = ord_len(d, ch); f32x4 a0 = {0.f, 0.f, 0.f, 0.f}, a1 = a0, a2 = a0, a3 = a0; float nn = 0.f; const int nk = tid & 63, nd = (tid >> 6) & 1;
      int i0 = 0; while (i0 < n && COEF[d * 72 + i0] < 1e-7f) ++i0;
      int i = i0;
      for (; i + 4 <= n; i += 4) { f32x4 v[4][4]; float cf[4];
#pragma unroll
          for (int x = 0; x < 4; ++x) { cf[x] = COEF[d * 72 + i + x]; const f32x4* src = (const f32x4*)(q2.CLOC + ((((size_t)d * NB + b) * NCH + ord_chunk(d, ch, i + x)) * 4 + h) * 4096 + e0);
              v[x][0] = src[0]; v[x][1] = src[1]; v[x][2] = src[2]; v[x][3] = src[3]; }
#pragma unroll
          for (int x = 0; x < 4; ++x) { a0 += v[x][0] * cf[x]; a1 += v[x][1] * cf[x]; a2 += v[x][2] * cf[x]; a3 += v[x][3] * cf[x]; } }
      for (; i < n; ++i) { const float cf = COEF[d * 72 + i]; const f32x4* src = (const f32x4*)(q2.CLOC + ((((size_t)d * NB + b) * NCH + ord_chunk(d, ch, i)) * 4 + h) * 4096 + e0);
          a0 += src[0] * cf; a1 += src[1] * cf; a2 += src[2] * cf; a3 += src[3] * cf; }
      { const int v = e0 >> 6, k = e0 & 63; unsigned short* dst = C0 + (d * 64 + v) * 72 + k;
        u32x4 w0, w1; w0.x = pk2(a0.x, a0.y); w0.y = pk2(a0.z, a0.w); w0.z = pk2(a1.x, a1.y); w0.w = pk2(a1.z, a1.w); w1.x = pk2(a2.x, a2.y); w1.y = pk2(a2.z, a2.w); w1.z = pk2(a3.x, a3.y); w1.w = pk2(a3.z, a3.w);
        *(u32x4*)dst = w0; *(u32x4*)(dst + 8) = w1; }
      if (tid < 128) { const int n2 = ord_len(nd, ch);
          for (int i = 0; i < n2; ++i) { const float cf = COEF[nd * 72 + i]; if (cf < 1e-7f) continue;
              const int j = ord_chunk(nd, ch, i);
              nn += cf * q2.NLOC[((((size_t)nd * NB + b) * NCH + j) * 4 + h) * 64 + nk]; }
          N0[nd * 64 + nk] = nn; }
      if (tid < 256) { const int dd = tid >> 7, tt = tid & 127; const float m0 = M0[dd], M = fmaxf(m0, ROWV[(dd * 5 + 1) * 128 + tt]);
          ROWV[(dd * 5 + 1) * 128 + tt] = M; ROWV[(dd * 5 + 3) * 128 + tt] = __expf(m0 - M); ROWV[(dd * 5 + 4) * 128 + tt] = __expf(-(ROWV[(dd * 5 + 2) * 128 + tt] + M)); } }
    __syncthreads();
    { const int qb = wave & 3, d = wave >> 2; const float* g = ROWV + (d * 5 + 0) * 128; const float* Mv = ROWV + (d * 5 + 1) * 128; const float* wiv = ROWV + (d * 5 + 3) * 128; const float* emtv = ROWV + (d * 5 + 4) * 128;
      att::bf16x8 qr[4]; const int sq = qb * 32 + r32;
      { const unsigned short* qw = (const unsigned short*)q2.QKV16 + (size_t)(t0 + sq) * 768 + h * 64 + hi * 8;
#pragma unroll
        for (int d0 = 0; d0 < 4; ++d0) qr[d0] = *reinterpret_cast<const att::bf16x8*>(qw + d0 * 16); }
      const float Ms = Mv[sq] * 1.4426950408889634f; att::f32x16 o[2] = {}; float rs = 0.f;
      const int vb0 = (int)(uintptr_t)Vs + att::v_rd_base(lane);
#pragma unroll
      for (int kt = 0; kt < 2; ++kt) {
          const bool skip = d == 0 ? (kt == 1 && qb < 2) : (kt == 0 && qb >= 2);
          if (!skip) {
              att::f32x16 p0 = {}, p1 = {}; const char* Kt = Ks + kt * 16384;
#pragma unroll
              for (int d0 = 0; d0 < 4; ++d0) { const int cb = (d0 * 16 + hi * 8) * 2;
                  const att::bf16x8 b0 = *reinterpret_cast<const att::bf16x8*>(Kt + (r32 * 256 + (cb ^ ((r32 & 7) << 4))));
                  const att::bf16x8 b1 = *reinterpret_cast<const att::bf16x8*>(Kt + ((32 + r32) * 256 + (cb ^ ((r32 & 7) << 4))));
                  p0 = __builtin_amdgcn_mfma_f32_32x32x16_bf16(b0, qr[d0], p0, 0, 0, 0); p1 = __builtin_amdgcn_mfma_f32_32x32x16_bf16(b1, qr[d0], p1, 0, 0, 0); }
#pragma unroll
              for (int r = 0; r < 16; ++r) { const int k0 = kt * 64 + att::crow(r, hi), k1 = k0 + 32;
                  const bool ok0 = d == 0 ? k0 <= sq : k0 >= sq, ok1 = d == 0 ? k1 <= sq : k1 >= sq;
                  p0[r] = ok0 ? p0[r] * __builtin_amdgcn_exp2f(g[k0] * 1.4426950408889634f - Ms) : 0.f; p1[r] = ok1 ? p1[r] * __builtin_amdgcn_exp2f(g[k1] * 1.4426950408889634f - Ms) : 0.f;
                  rs += p0[r] + p1[r]; }
              att::bf16x8 pa0, pa1, pa2, pa3;
#define PK4(P, BASE, OUT) do { unsigned a0 = att::cvtpk(P[BASE + 0], P[BASE + 1]), a1 = att::cvtpk(P[BASE + 2], P[BASE + 3]);   \
    unsigned b0 = att::cvtpk(P[BASE + 4], P[BASE + 5]), b1 = att::cvtpk(P[BASE + 6], P[BASE + 7]);                              \
    auto r0 = __builtin_amdgcn_permlane32_swap(a0, b0, false, false); auto r1 = __builtin_amdgcn_permlane32_swap(a1, b1, false, false); \
    att::u32x4 w = {r0[0], r1[0], r0[1], r1[1]}; OUT = *reinterpret_cast<att::bf16x8*>(&w); } while (0)
              PK4(p0, 0, pa0); PK4(p0, 8, pa1); PK4(p1, 0, pa2); PK4(p1, 8, pa3);
#undef PK4
              att::pv_d0(o, vb0 + kt * 8192, pa0, pa1, pa2, pa3);
          }
      }
      att::f32x16 ic[2] = {};
#pragma unroll
      for (int vt = 0; vt < 2; ++vt)
#pragma unroll
          for (int d0 = 0; d0 < 4; ++d0) { const att::bf16x8 cb = *reinterpret_cast<const att::bf16x8*>(C0 + (d * 64 + vt * 32 + r32) * 72 + d0 * 16 + hi * 8);
              ic[vt] = __builtin_amdgcn_mfma_f32_32x32x16_bf16(qr[d0], cb, ic[vt], 0, 0, 0); }
      float nq = 0.f;
#pragma unroll
      for (int d0 = 0; d0 < 4; ++d0)
#pragma unroll
          for (int x = 0; x < 8; ++x) nq += bf2f((unsigned short)qr[d0][x]) * N0[d * 64 + d0 * 16 + hi * 8 + x];
      { auto rr = __builtin_amdgcn_permlane32_swap(__float_as_uint(nq), __float_as_uint(nq), false, false); nq = __uint_as_float(rr[0]) + __uint_as_float(rr[1]); }
      { auto rr = __builtin_amdgcn_permlane32_swap(__float_as_uint(rs), __float_as_uint(rs), false, false); rs = __uint_as_float(rr[0]) + __uint_as_float(rr[1]); }
      const float den = rs + wiv[sq] * nq, dn = fmaxf(fabsf(den), emtv[sq]);
      if (hi == 0) WS[r32] = __builtin_amdgcn_rcpf(dn);
      asm volatile("s_waitcnt lgkmcnt(0)" ::: "memory");
#pragma unroll
      for (int r = 0; r < 16; ++r) { const int row = att::crow(r, hi), tt = qb * 32 + row; const float inv = WS[row], wi = wiv[tt];
#pragma unroll
          for (int vt = 0; vt < 2; ++vt) HX[(d * 128 + tt) * 68 + vt * 32 + r32] = (o[vt][r] + wi * ic[vt][r]) * inv; }
    }
    __syncthreads();
    { const int tt = tid >> 2, v0 = (tid & 3) * 16, t = t0 + tt; float hv[16]; float s = 0.f;
#pragma unroll
      for (int i = 0; i < 16; ++i) { hv[i] = HX[tt * 68 + v0 + i] + HX[(128 + tt) * 68 + v0 + i]; s += hv[i]; }
      s += __shfl_xor(s, 1); s += __shfl_xor(s, 2); const float mu = s * (1.f / 64.f); float vs = 0.f;
#pragma unroll
      for (int i = 0; i < 16; ++i) { hv[i] -= mu; vs += hv[i] * hv[i]; }
      vs += __shfl_xor(vs, 1); vs += __shfl_xor(vs, 2); const float rstd = 1.f / sqrtf(vs * (1.f / 64.f) + EPS);
#pragma unroll
      for (int i = 0; i < 16; ++i) { const int c = h * 64 + v0 + i;
          const float y = hv[i] * rstd * p.in[I_MNG][(size_t)l * 256 + c] + p.in[I_MSK][(size_t)l * 256 + c] * bf2f(q2.XCM16[(size_t)t * 256 + c]);
          Y(t, 768 + c, y * fast_silu(U(t, OFF_MZ + c))); } }
    __syncthreads();
}
typedef float f32x4_t __attribute__((ext_vector_type(4)));

__device__ __forceinline__ void row_norm_mod(f32x4 (&v)[4], const float* g, const float* sc, const float* sh, int lane) {
    float s = 0.f;
#pragma unroll
    for (int j = 0; j < 4; ++j) s += (v[j].x * v[j].x + v[j].y * v[j].y) + (v[j].z * v[j].z + v[j].w * v[j].w);
    const float rstd = 1.f / sqrtf(wave_sum(s) * (1.f / D) + EPS);
#pragma unroll
    for (int j = 0; j < 4; ++j) { const int k = (j * 64 + lane) * 4; const f32x4 gv = *(const f32x4*)(g + k);
        if (sc) { const f32x4 scv = *(const f32x4*)(sc + k), shv = *(const f32x4*)(sh + k); v[j] = v[j] * rstd * gv * (scv + 1.f) + shv; } else v[j] = v[j] * rstd * gv; }
}
__device__ __forceinline__ void row_store_bf16(bf16* dst, const f32x4 (&v)[4], int lane) {
#pragma unroll
    for (int j = 0; j < 4; ++j) { u32x2 w; w.x = pk2(v[j].x, v[j].y); w.y = pk2(v[j].z, v[j].w); *(u32x2*)(dst + (j * 64 + lane) * 4) = w; }
}
__device__ __forceinline__ void rp_first(const P& p, const Q& q, int gw, int ngw, int lane) {
    for (int t = gw; t < NT; t += ngw) { const int b = t / TPB, i = t % TPB; const float* src = i < CTX ? p.in[I_CTX] + ((size_t)b * CTX + i) * D : p.in[I_X] + ((size_t)b * SEQ + (i - CTX)) * D;
        f32x4 v[4];
#pragma unroll
        for (int j = 0; j < 4; ++j) { v[j] = *(const f32x4*)(src + (j * 64 + lane) * 4); *(f32x4*)(p.X + (size_t)t * D + (j * 64 + lane) * 4) = v[j]; }
        const int cv = tok_cv(t); row_norm_mod(v, p.in[I_N1G], modp(p, 0, cv, 1), modp(p, 0, cv, 0), lane); row_store_bf16(q.H16 + (size_t)t * D, v, lane); }
}
__device__ __forceinline__ void rp_end(const P& p, const Q& q, const Q2& q2, int l, int gw, int ngw, int lane, float probe_scale = 1.f) {
    for (int t = gw; t < NT; t += ngw) { const int cv = tok_cv(t); const float* g2 = modp(p, l, cv, 5); f32x4 v[4];
#pragma unroll
        for (int j = 0; j < 4; ++j) { const int k = (j * 64 + lane) * 4; f32x4 s = {0.f, 0.f, 0.f, 0.f};
#pragma unroll
            for (int e = 0; e < 4; ++e) { const u32x2 w = *(const u32x2*)(q2.YB16 + ((size_t)t * 4 + e) * D + k);
                s.x += __builtin_bit_cast(float, w.x << 16); s.y += __builtin_bit_cast(float, w.x & 0xffff0000u); s.z += __builtin_bit_cast(float, w.y << 16); s.w += __builtin_bit_cast(float, w.y & 0xffff0000u); }
            v[j] = *(const f32x4*)(p.X + (size_t)t * D + k) + *(const f32x4*)(g2 + k) * s * probe_scale; }
        if (l + 1 < DEPTH) {
#pragma unroll
            for (int j = 0; j < 4; ++j) *(f32x4*)(p.X + (size_t)t * D + (j * 64 + lane) * 4) = v[j];
            row_norm_mod(v, p.in[I_N1G] + (size_t)(l + 1) * D, modp(p, l + 1, cv, 1), modp(p, l + 1, cv, 0), lane); row_store_bf16(q.H16 + (size_t)t * D, v, lane);
        } else { const int b = t / TPB, i = t % TPB; if (i < CTX) continue;
            row_norm_mod(v, p.in[I_FG], nullptr, nullptr, lane);
#pragma unroll
            for (int j = 0; j < 4; ++j) *(f32x4*)(p.out + ((size_t)b * SEQ + (i - CTX)) * D + (j * 64 + lane) * 4) = v[j]; }
    }
}
constexpr int RPM_LDS = 87488;
__device__ __forceinline__ void rp_mid(const P& p, const Q& q, int l, char* lds, int G, int bid, bool probe_nolist = false) {
    int tid_ = threadIdx.x; asm volatile("" : "+v"(tid_));
    const int tid = tid_, wave = tid >> 6, lane = tid & 63;
    float* HS = (float*)lds; float* PART = (float*)(lds + 65664); float* LG = (float*)(lds + 82048); int* LCNT = (int*)(lds + 84096); int* LBASE = (int*)(lds + 84224); int* PEND = (int*)(lds + 84352); int* NPEND = (int*)(lds + 87424);
    if (tid < 32) LCNT[tid] = 0; if (tid == 32) NPEND[0] = 0;
    float B0[32], B1[32]; const float* Wr = p.in[I_WR] + (size_t)l * D * NE;
#pragma unroll
    for (int ks = 0; ks < 32; ++ks) { const int k = 128 * wave + 4 * ks + (lane >> 4); B0[ks] = Wr[(size_t)k * NE + (lane & 15)]; B1[ks] = Wr[(size_t)k * NE + 16 + (lane & 15)]; }
    __syncthreads();
    const int nitems = NT / 16;
    for (int it = bid; it < nitems; it += G) {
#pragma unroll 1
        for (int rr = 0; rr < 2; ++rr) { const int row = 2 * wave + rr, t = it * 16 + row, cv = tok_cv(t); f32x4 v[4];
#pragma unroll
            for (int j = 0; j < 4; ++j) v[j] = *(const f32x4*)(p.X + (size_t)t * D + (j * 64 + lane) * 4);
            row_norm_mod(v, p.in[I_N2G] + (size_t)l * D, modp(p, l, cv, 4), modp(p, l, cv, 3), lane); row_store_bf16(q.H16 + (size_t)t * D, v, lane);
#pragma unroll
            for (int j = 0; j < 4; ++j) { float* d = HS + row * 1026 + (j * 64 + lane) * 4; *(float2*)d = make_float2(v[j].x, v[j].y); *(float2*)(d + 2) = make_float2(v[j].z, v[j].w); } }
        __syncthreads();
        { f32x4_t a0 = {0.f, 0.f, 0.f, 0.f}, a1 = a0; const float* hrow = HS + (lane & 15) * 1026 + 128 * wave + (lane >> 4);
#pragma unroll
          for (int ks = 0; ks < 32; ++ks) { const float a = hrow[4 * ks]; a0 = __builtin_amdgcn_mfma_f32_16x16x4f32(a, B0[ks], a0, 0, 0, 0); a1 = __builtin_amdgcn_mfma_f32_16x16x4f32(a, B1[ks], a1, 0, 0, 0); }
#pragma unroll
          for (int r = 0; r < 4; ++r) { const int row = (lane >> 4) * 4 + r; PART[(wave * 16 + row) * 32 + (lane & 15)] = a0[r]; PART[(wave * 16 + row) * 32 + 16 + (lane & 15)] = a1[r]; } }
        __syncthreads();
        { float s = p.in[I_BR][(size_t)l * NE + (tid & 31)];
#pragma unroll
          for (int w = 0; w < 8; ++w) s += PART[w * 512 + tid];
          LG[tid] = s; }
        __syncthreads();
        if (tid < 16) { const int t = it * 16 + tid; float lg[NE];
#pragma unroll
            for (int e = 0; e < NE; ++e) lg[e] = LG[tid * 32 + e];
            int te[TOPK]; float tv[TOPK];
#pragma unroll
            for (int r = 0; r < TOPK; ++r) { float best = -3.0e38f; int bi = 0;
#pragma unroll
                for (int e = 0; e < NE; ++e) { const bool c = lg[e] > best; best = c ? lg[e] : best; bi = c ? e : bi; }
                te[r] = bi; tv[r] = best;
#pragma unroll
                for (int e = 0; e < NE; ++e) lg[e] = (e == bi) ? -3.0e38f : lg[e]; }
            float ssum = 0.f, ex[TOPK];
#pragma unroll
            for (int r = 0; r < TOPK; ++r) { ex[r] = __expf(tv[r] - tv[0]); ssum += ex[r]; }
            const float inv = 1.f / ssum;
#pragma unroll
            for (int r = 0; r < TOPK; ++r) { p.TOPG[t * TOPK + r] = ex[r] * inv; const int lp = atomicAdd(&LCNT[te[r]], 1); const int slot = atomicAdd(NPEND, 1);
                PEND[slot * 2] = t * TOPK + r; PEND[slot * 2 + 1] = (te[r] << 16) | lp; } }
        __syncthreads();
    }
    if (probe_nolist) return;
    if (tid < 32) LBASE[tid] = LCNT[tid] > 0 ? atomicAdd(&p.CNT[tid], LCNT[tid]) : 0;
    __syncthreads();
    for (int i = tid; i < NPEND[0]; i += 512) { const int pr = PEND[i * 2], x = PEND[i * 2 + 1], e = x >> 16, lp = x & 0xffff; p.LIST[(size_t)e * NT + LBASE[e] + lp] = pr; }
    __syncthreads();
}
struct EpiDown16 {
    static constexpr bool PERM = true; bf16* YB; const float* bd; const float* TOPG; const int* CNT; const int* LIST; int nN;
    __device__ __forceinline__ void operator()(const pg8::f32x4 (&acc)[2][2][4][2], const pg8::Unit& u, int wr, int wc, int fr, int fq) const {
        const int ntile = u.pn - u.e * nN, cnt = CNT[u.e]; const float* b = bd + (size_t)u.e * D;
#pragma unroll
        for (int ai = 0; ai < 2; ++ai)
#pragma unroll
            for (int m = 0; m < 4; ++m) { const int idx = u.mb * 256 + ai * 128 + wr * 64 + m * 16 + fr;
                if (idx < cnt) { const int pr = LIST[(size_t)u.e * NT + idx]; const float g = TOPG[pr];
#pragma unroll
                    for (int bj = 0; bj < 2; ++bj) { const int c = ntile * 256 + bj * 128 + wc * 32 + 8 * fq; const pg8::f32x4 b0 = *(const pg8::f32x4*)(b + c), b1 = *(const pg8::f32x4*)(b + c + 4);
                        const pg8::f32x4 v0 = (acc[ai][bj][m][0] + b0) * g, v1 = (acc[ai][bj][m][1] + b1) * g;
                        u32x4 w; w.x = pg8::cvt_pk_bf16(v0[0], v0[1]); w.y = pg8::cvt_pk_bf16(v0[2], v0[3]); w.z = pg8::cvt_pk_bf16(v1[0], v1[1]); w.w = pg8::cvt_pk_bf16(v1[2], v1[3]);
                        *(u32x4*)(YB + (size_t)pr * D + c) = w; } } }
    }
};
__device__ __forceinline__ void opt_moe_down16(const P& p, const Q& q, const Q2& q2, int l, LAS unsigned char* lds, int G, int bid) {
    pg8::Gemm g{q.ACT16, q.WtDn + (size_t)l * NE * D * DE, DE}; DnOrder S; S.init(p.CNT, p.LIST, D / 256, G, bid, (LAS int*)(lds + pg8::STAGE_BYTES));
    EpiDown16 E{q2.YB16, p.in[I_BD] + (size_t)l * NE * D, p.TOPG, p.CNT, p.LIST, D / 256}; pg8::gemm_phase<EpiDown16, DnOrder, true>(lds, g, S, E);
}
#define GAS __attribute__((address_space(1)))
typedef GAS unsigned gu32;
#define XB_TMO      128
#define XB_XCNT(j)  (256  + 64 * (j))
#define XB_XSUB(j)  (1280 + 64 * (j))
#define XB_XGEN(j)  (2304 + 64 * (j))
#define XB_TOP      3328
#define XB_TOPGEN   3392
#define XCD_BAR_WORDS 3456
#define XB_SPIN_CAP (1u << 18)

__device__ __forceinline__ unsigned xb_ld(unsigned* p)              { return __hip_atomic_load(p, __ATOMIC_RELAXED, __HIP_MEMORY_SCOPE_AGENT); }
__device__ __forceinline__ unsigned xb_add(unsigned* p, unsigned v) { return __hip_atomic_fetch_add(p, v, __ATOMIC_RELAXED, __HIP_MEMORY_SCOPE_AGENT); }
__device__ __forceinline__ unsigned xb_xcc_id() { return (unsigned)__builtin_amdgcn_s_getreg((3 << 11) | 20) & 0xFu; }
#define XB_SPIN(cond, bar) do { unsigned _sp = 0; while (cond) { __builtin_amdgcn_s_sleep(1); \
    if ((++_sp & 255u) == 0u) { if (xb_ld(&(bar)[XB_TMO])) break; if (_sp > XB_SPIN_CAP) { atomicAdd(&(bar)[XB_TMO], 1u); break; } } } } while (0)

struct XcdBarrier {
    unsigned* bar; unsigned x;
    volatile LAS unsigned* st;
};

__device__ __forceinline__ XcdBarrier xcd_barrier_post(unsigned* bar, volatile LAS unsigned* st) {
    XcdBarrier b; b.bar = bar; b.x = xb_xcc_id(); b.st = st;
    if (threadIdx.x == 0) (void)xb_add(&bar[XB_XCNT(b.x)], 1u);
    return b;
}
__device__ __forceinline__ void xcd_barrier_complete(unsigned* bar, unsigned x, unsigned& nloc, unsigned& nx) {
    const unsigned G = gridDim.x * gridDim.y * gridDim.z;
    unsigned sum, cnt, mine, sp = 0u;
    for (;;) {
        sum = 0u; cnt = 0u; mine = 0u;
#pragma unroll
        for (unsigned j = 0; j < 16; ++j) { const unsigned c = xb_ld(&bar[XB_XCNT(j)]); sum += c; cnt += (c > 0u) ? 1u : 0u; mine = (j == x) ? c : mine; }
        if (sum == G) break;
        __builtin_amdgcn_s_sleep(1);
        if ((++sp & 255u) == 0u) { if (xb_ld(&bar[XB_TMO])) break; if (sp > XB_SPIN_CAP) { atomicAdd(&bar[XB_TMO], 1u); break; } }
    }
    nloc = mine > 0u ? mine : 1u; nx = cnt > 0u ? cnt : 1u;
}

__device__ __forceinline__ void xcd_barrier(const XcdBarrier& b) {
    asm volatile("s_waitcnt vmcnt(0)" ::: "memory");
    __syncthreads();
    if (threadIdx.x == 0) {
        unsigned* bar = b.bar;
        __builtin_amdgcn_s_waitcnt(0);
        unsigned nloc = b.st[0], nx = b.st[1];
        if (nloc == 0u) { xcd_barrier_complete(bar, b.x, nloc, nx); b.st[0] = nloc; b.st[1] = nx; }
        const unsigned old = xb_add(&bar[XB_XSUB(b.x)], 1u);
        const unsigned gen = old / nloc;
        if (old + 1u == (gen + 1u) * nloc) {
            __builtin_amdgcn_fence(__ATOMIC_RELEASE, "agent");
            asm volatile("s_waitcnt vmcnt(0)" ::: "memory");
            const unsigned og = xb_add(&bar[XB_TOP], 1u);
            const unsigned tg = og / nx;
            if (og + 1u == (tg + 1u) * nx) xb_add(&bar[XB_TOPGEN], 1u);
            else XB_SPIN(xb_ld(&bar[XB_TOPGEN]) == tg, bar);
            __builtin_amdgcn_fence(__ATOMIC_ACQUIRE, "agent");
            xb_add(&bar[XB_XGEN(b.x)], 1u);
            asm volatile("s_waitcnt vmcnt(0)" ::: "memory");
        } else {
            XB_SPIN(xb_ld(&bar[XB_XGEN(b.x)]) == gen, bar);
            __builtin_amdgcn_fence(__ATOMIC_ACQUIRE, "agent");
            asm volatile("s_waitcnt vmcnt(0)" ::: "memory");
        }
    }
    __syncthreads();
}
#include <hip/hip_cooperative_groups.h>
#include <cstdio>
namespace cg = cooperative_groups;
#ifndef ONE_LAUNCH
#define ONE_LAUNCH 1
#endif
constexpr int LDS_BYTES = 148480;
static_assert(ML2_LDS <= LDS_BYTES && ML1_LDS <= LDS_BYTES && LRU1_LDS <= LDS_BYTES && RPM_LDS <= LDS_BYTES && att::SHM_ATTN <= LDS_BYTES && pg8::STAGE_BYTES + 1024 <= LDS_BYTES, "LDS map");

struct BMap { size_t off[64]; size_t total; };
static inline BMap b_map() {
    BMap m; size_t o = 0; int i = 0;
    auto add = [&](size_t bytes) { m.off[i++] = o; o += (bytes + 255) & ~(size_t)255; };
    add((size_t)DEPTH * 3 * 6 * D * 4);
    add((size_t)SEQ * 16 * 2 * 4);
    add((size_t)NT * D * 4);
    add((size_t)NT * TOPK * 4);
    add((size_t)256);
    add((size_t)NE * NT * 4);
    add((size_t)DEPTH * DINP * D * 2);
    add((size_t)DEPTH * D * DMIX * 2);
    add((size_t)DEPTH * NE * 2 * DE * D * 2);
    add((size_t)DEPTH * NE * D * DE * 2);
    add((size_t)DEPTH * 768 * QRANK * 2);
    add((size_t)DEPTH * 1024 * KVRANK * 2);
    add((size_t)NT * D * 2);
    add((size_t)NT * DMIX * 2);
    add((size_t)SLOT_MAX * DE * 2);
    add((size_t)NT * AH * QKD * 2);
    add((size_t)NT * AH * VD * 2);
    add((size_t)NT * DINP * 2);
    add((size_t)DEPTH * 4 * 256 * 64 * 2);
    add((size_t)DEPTH * 4 * 3 * 4096 * 2);
    add((size_t)DEPTH * 32 * 768 * 2);
    add((size_t)DEPTH * 2 * 256 * 4);
    add((size_t)2 * NT * 256 * 4);
    add((size_t)2 * NT * 256 * 4);
    add((size_t)2 * NB * NCH * 256 * 4);
    add((size_t)2 * NB * NCH * 256 * 4);
    add((size_t)NT * 256 * 2);
    add((size_t)NT * 256 * 2);
    add((size_t)NT * 768 * 2);
    add((size_t)DEPTH * 1024 * 256 * 2);
    add((size_t)NT * 256 * 2);
    add((size_t)NT * 768 * 2);
    add((size_t)NT * 16 * 4);
    add((size_t)2 * NB * NCH * 4 * 4096 * 4);
    add((size_t)2 * NB * NCH * 4 * 64 * 4);
    add((size_t)2 * NB * NCH * 4 * 2 * 4);
    add((size_t)NT * TOPK * D * 2);
    add((size_t)XCD_BAR_WORDS * 4);
    m.total = o; return m;
}
struct Args { P p; Q q; Q2 q2; unsigned* bar; };
static inline void fill_args(Args& a, void* const* d_in, void* d_out, void* d_ws) {
    for (int i = 0; i < N_IN; ++i) a.p.in[i] = (const float*)d_in[i];
    a.p.out = (float*)d_out; char* w = (char*)d_ws; const BMap m = b_map();
    a.p.MOD = (float*)(w + m.off[0]); a.p.ROPET = (float*)(w + m.off[1]); a.p.X = (float*)(w + m.off[2]); a.p.TOPG = (float*)(w + m.off[3]); a.p.CNT = (int*)(w + m.off[4]); a.p.LIST = (int*)(w + m.off[5]);
    a.q.WtIn = (bf16*)(w + m.off[6]); a.q.WtOut = (bf16*)(w + m.off[7]); a.q.WtGu = (bf16*)(w + m.off[8]); a.q.WtDn = (bf16*)(w + m.off[9]); a.q.WtQb = (bf16*)(w + m.off[10]); a.q.WtKvb = (bf16*)(w + m.off[11]);
    a.q.H16 = (bf16*)(w + m.off[12]); a.q.Y16 = (bf16*)(w + m.off[13]); a.q.ACT16 = (bf16*)(w + m.off[14]); a.q.K16 = (bf16*)(w + m.off[15]); a.q.V16 = (bf16*)(w + m.off[16]);
    a.q2.U16 = (bf16*)(w + m.off[17]); a.q2.WtL = (bf16*)(w + m.off[18]); a.q2.WtM = (bf16*)(w + m.off[19]); a.q2.WtG = (bf16*)(w + m.off[20]); a.q2.LSL = (float*)(w + m.off[21]);
    a.q2.HLOC = (float*)(w + m.off[22]); a.q2.PCUM = (float*)(w + m.off[23]); a.q2.SA = (float*)(w + m.off[24]); a.q2.SB = (float*)(w + m.off[25]);
    a.q2.QN16 = (bf16*)(w + m.off[26]); a.q2.KVN16 = (bf16*)(w + m.off[27]); a.q2.Q16 = (bf16*)(w + m.off[28]); a.q2.WtKvbP = (bf16*)(w + m.off[29]);
    a.q2.XCM16 = (bf16*)(w + m.off[30]); a.q2.QKV16 = (bf16*)(w + m.off[31]); a.q2.GATES = (float*)(w + m.off[32]); a.q2.CLOC = (float*)(w + m.off[33]); a.q2.NLOC = (float*)(w + m.off[34]); a.q2.MLB = (float*)(w + m.off[35]);
    a.q2.YB16 = (bf16*)(w + m.off[36]); a.bar = (unsigned*)(w + m.off[37]);
}

struct ULoad16 { const bf16* U; __device__ __forceinline__ float operator()(int t, int col) const { return bf2f(U[(size_t)t * DINP + col]); } };
struct YStore16 { bf16* Y; __device__ __forceinline__ void operator()(int t, int col, float v) const { Y[(size_t)t * DMIX + col] = (bf16)f2bf(v); } };
struct OutY16 { bf16* y; __device__ __forceinline__ void operator()(int row, int col, float v) const { y[(size_t)row * DMIX + col] = (bf16)f2bf(v); } };

enum { ST_INIT = 0, ST_RPFIRST, ST_INPROJ, ST_PREP, ST_MLAPROJ, ST_MIX, ST_OUTPROJ, ST_RPMID, ST_GU, ST_DOWN, ST_RPEND, N_ST };

typedef const __attribute__((address_space(4))) Args* KArgs;
__device__ __forceinline__ KArgs kargs() { KArgs k = (KArgs)__builtin_amdgcn_kernarg_segment_ptr(); asm volatile("" : "+s"(k)); return k; }
__device__ __forceinline__ void run_step(const Args& a, int step, int l_, unsigned char* lds_raw) {
    const int l = l_ & 0xff, sub = l_ >> 8;
    const P& p = a.p; const Q& q = a.q; const Q2& q2 = a.q2;
    LAS unsigned char* lds = (LAS unsigned char*)lds_raw; char* ldsg = (char*)lds_raw;
    int G_ = gridDim.x, bid_ = blockIdx.x; asm volatile("" : "+s"(G_), "+s"(bid_));
    const int G = G_, bid = bid_;
#define THREAD_IDS int tid_ = threadIdx.x; asm volatile("" : "+v"(tid_)); const int tid = tid_, lane = tid & 63, wave = __builtin_amdgcn_readfirstlane(tid >> 6); \
    const int gw = bid * NWAVES + wave, ngw = G * NWAVES; const long gtid = (long)bid * NTHREADS + tid, nthr = (long)G * NTHREADS; (void)lane; (void)gw; (void)ngw; (void)gtid; (void)nthr;
    switch (step) {
    case ST_INIT: { THREAD_IDS
        opt_init_mod(p, ldsg, bid, G); opt_init_rope(p, gtid, nthr); opt_convert_small(p, q2, gtid, nthr); opt_convert_weights(p, q, q2.WtKvbP, lds, gw, ngw, wave, lane); break; }
    case ST_RPFIRST: { THREAD_IDS rp_first(p, q, gw, ngw, lane); break; }
    case ST_INPROJ: opt_inproj16(q, q2, l, lds, G, bid); break;
    case ST_PREP: { THREAD_IDS
        if (gtid < NE) p.CNT[gtid] = 0;
        const ULoad16 U{q2.U16};
        for (int it = bid; it < NB * NCH * 5; it += G) {
            if (it < NB * NCH) { if (sub == 0 || (sub & 1)) ml1_item(p, q2, l, it / NCH, it % NCH, ldsg, U); }
            else if (sub == 0 || (sub & 2)) { const int x = it - NB * NCH; lru1_item(p, q2, l, (x >> 2) / NCH, (x >> 2) % NCH, x & 3, ldsg, U); } }
        if (sub == 0 || (sub & 4)) for (int t = gw; t < NT; t += ngw) mla_prep_token(p, q, q2, l, t, lane, U);
        break; }
    case ST_MLAPROJ: opt_mla_proj(p, q, q2, l, lds, G, bid); break;
    case ST_MIX: {
        const ULoad16 U{q2.U16}; const YStore16 Y{q.Y16};
        const int c = bid, vcu = (G % 8 == 0) ? (c % 8) * (G / 8) + c / 8 : c;
        constexpr int QB_LAT = SEQ / 256, QB_CTX = CTX / 256, NU_LAT = NB * AH * QB_LAT, NU_CTX = NB * AH * QB_CTX;
        if (sub == 0 || (sub & 1)) for (int u = vcu; u < NU_LAT; u += G) { const int bh = u / QB_LAT, qb = u % QB_LAT, b = bh / AH, h = bh % AH, t0 = b * TPB + CTX + qb * 256;
            OutY16 out{q.Y16 + (size_t)t0 * DMIX + 256 + h * VD};
            att::attn_unit<unsigned short, OutY16>((const unsigned short*)q2.Q16 + (size_t)t0 * 768 + h * QKD, 768, (const unsigned short*)q.K16 + ((size_t)b * AH + h) * TPB * QKD, (const unsigned short*)q.V16 + ((size_t)b * AH + h) * TPB * VD, TPB, ldsg, out); }
        if ((sub == 0 || (sub & 1)) && l + 1 < DEPTH) for (int u = vcu; u < NU_CTX; u += G) { const int bh = u / QB_CTX, qb = u % QB_CTX, b = bh / AH, h = bh % AH, t0 = b * TPB + qb * 256;
            OutY16 out{q.Y16 + (size_t)t0 * DMIX + 256 + h * VD};
            att::attn_unit<unsigned short, OutY16>((const unsigned short*)q2.Q16 + (size_t)t0 * 768 + h * QKD, 768, (const unsigned short*)q.K16 + ((size_t)b * AH + h) * TPB * QKD, (const unsigned short*)q.V16 + ((size_t)b * AH + h) * TPB * VD, CTX, ldsg, out); }
        if (sub == 0 || (sub & 2)) for (int it = G - 1 - c; it < NB * NCH * 4; it += G) { const int x = it; ml2_item(p, q2, l, (x >> 2) / NCH, (x >> 2) % NCH, x & 3, ldsg, U, Y); }
        if (sub == 0 || (sub & 4)) for (int it = c; it < NB * NCH; it += G) lru2_item(q2, it / NCH, it % NCH, ldsg, U, Y);
        break; }
    case ST_OUTPROJ: opt_outproj(p, q, l, lds, G, bid); break;
    case ST_RPMID: rp_mid(p, q, l, ldsg, G, bid, sub != 0); break;
    case ST_GU: opt_moe_gu(p, q, l, lds, G, bid); break;
    case ST_DOWN: opt_moe_down16(p, q, q2, l, lds, G, bid); break;
    case ST_RPEND: { THREAD_IDS rp_end(p, q, q2, l, gw, ngw, lane, sub != 0 ? 0.f : 1.f); break; }
    }
}

#if ONE_LAUNCH
__global__ void __launch_bounds__(512, 2) k_mega(Args a) {
    extern __shared__ __attribute__((aligned(16))) unsigned char lds_raw[];
    cg::grid_group grid = cg::this_grid();
    volatile LAS unsigned* MISC = (volatile LAS unsigned*)((LAS unsigned char*)lds_raw + LDS_BYTES - 64);
    if (threadIdx.x < 16) MISC[threadIdx.x] = 0u;
    __syncthreads();
    { const XcdBarrier b0 = xcd_barrier_post(a.bar, MISC + 8); if (threadIdx.x == 0) MISC[10] = b0.x; }
#define GRID_BAR() do { XcdBarrier b_; b_.bar = a.bar; b_.st = MISC + 8; b_.x = MISC[10]; xcd_barrier(b_); } while (0)
    run_step(a, ST_INIT, 0, lds_raw); grid.sync();
    run_step(a, ST_RPFIRST, 0, lds_raw); GRID_BAR();
#pragma unroll 1
    for (int l = 0; l < DEPTH; ++l) {
#pragma unroll 1
        for (int s = ST_INPROJ; s <= ST_RPEND; ++s) { run_step(a, s, l, lds_raw); if (!(l == DEPTH - 1 && s == ST_RPEND)) GRID_BAR(); }
    }
}
#else
template <int STEP>
__global__ void __launch_bounds__(512, 2) k_step(Args a, int l) {
    extern __shared__ __attribute__((aligned(16))) unsigned char lds_raw[];
    run_step(a, STEP, l, lds_raw);
}
template <int STEP> static void launch_step(const Args& a, int l, hipStream_t stream) {
    static bool attr = false;
    if (!attr) { (void)hipFuncSetAttribute((const void*)k_step<STEP>, hipFuncAttributeMaxDynamicSharedMemorySize, LDS_BYTES); attr = true; }
    hipLaunchKernelGGL(k_step<STEP>, dim3(256), dim3(512), LDS_BYTES, stream, a, l);
}
#endif

extern "C" void kernel_launch(void* const* d_in, const int* in_sizes, int n_in, void* d_out, int out_size, void* d_ws, size_t ws_size, hipStream_t stream) {
    static int grid_blocks = 0;
    if (!grid_blocks) {
        int dev = 0, cus = 0;
        (void)hipGetDevice(&dev); (void)hipDeviceGetAttribute(&cus, hipDeviceAttributeMultiprocessorCount, dev);
        grid_blocks = cus;
#if ONE_LAUNCH
        int per_cu = 0;
        (void)hipFuncSetAttribute((const void*)k_mega, hipFuncAttributeMaxDynamicSharedMemorySize, LDS_BYTES);
        (void)hipOccupancyMaxActiveBlocksPerMultiprocessor(&per_cu, (const void*)k_mega, 512, LDS_BYTES);
        if (per_cu < 1) fprintf(stderr, "kernel_launch: occupancy query reports %d workgroups per CU\n", per_cu);
#endif
        const BMap m = b_map();
        if (n_in != N_IN || m.total > ws_size) fprintf(stderr, "kernel_launch: bad n_in %d or workspace too small (%zu needed, %zu given)\n", n_in, m.total, ws_size);
    }
    Args a{}; fill_args(a, d_in, d_out, d_ws);
#if ONE_LAUNCH
    (void)hipMemsetAsync(a.bar, 0, XCD_BAR_WORDS * 4, stream);
    void* args[] = {&a};
    hipError_t e = hipLaunchCooperativeKernel((const void*)k_mega, dim3(grid_blocks), dim3(512), args, LDS_BYTES, stream);
    if (e != hipSuccess) fprintf(stderr, "cooperative launch failed: %s (grid %d)\n", hipGetErrorString(e), grid_blocks);
#else
#ifndef DUP_STEP
#define DUP_STEP -1
#endif
#ifndef DUP_SUB
#define DUP_SUB 0
#endif
#define LS(ST, l) do { launch_step<ST>(a, l, stream); if (ST == DUP_STEP) launch_step<ST>(a, (l) | (DUP_SUB << 8), stream); } while (0)
    LS(ST_INIT, 0); LS(ST_RPFIRST, 0);
    for (int l = 0; l < DEPTH; ++l) {
        LS(ST_INPROJ, l); LS(ST_PREP, l); LS(ST_MLAPROJ, l); LS(ST_MIX, l); LS(ST_OUTPROJ, l);
        LS(ST_RPMID, l); LS(ST_GU, l); LS(ST_DOWN, l); LS(ST_RPEND, l);
    }
#endif
}
```

```cpp
#include <hip/hip_runtime.h>
#define ONE_LAUNCH 1
#include <math.h>
#include <stdint.h>

#ifndef CFG_D_MODEL
#define CFG_D_MODEL 1024
#endif
#ifndef CFG_SEQ
#define CFG_SEQ 8192
#endif
#ifndef CFG_GRID_W
#define CFG_GRID_W 64
#endif
#ifndef CFG_CTX_LEN
#define CFG_CTX_LEN 256
#endif
#ifndef CFG_N_EXPERTS
#define CFG_N_EXPERTS 32
#endif
#ifndef CFG_D_EXPERT
#define CFG_D_EXPERT 1024
#endif

#ifdef HOST_TEST
#define HD inline
struct float4 { float x, y, z, w; };
static inline int atomic_add_i(int* p, int v) { int o = *p; *p = o + v; return o; }
#else
#define HD __device__ __forceinline__
static __device__ __forceinline__ int atomic_add_i(int* p, int v) { return atomicAdd(p, v); }
#endif

constexpr int D = CFG_D_MODEL, NB = 2, SEQ = CFG_SEQ, DEPTH = 2, GRID_W = CFG_GRID_W, CTX = CFG_CTX_LEN;
constexpr int TPB = CTX + SEQ;
constexpr int NT = NB * TPB;
constexpr int LW = 256, MLH = 4, MHD = 64, MW = 256;
constexpr int AH = 8, NOPE = 64, ROPE = 32, VD = 64, QRANK = 256, KVRANK = 128, QKD = NOPE + ROPE;
constexpr int DIN = 1440, DMIX = 1024;
constexpr int OFF_AX = 0, OFF_AG = 256, OFF_BQ = 512, OFF_BKV = 768, OFF_BKR = 896, OFF_MX = 928, OFF_MZ = 1184;
constexpr int NE = CFG_N_EXPERTS, TOPK = 4, DE = CFG_D_EXPERT;
constexpr float EPS = 1e-6f;

enum { I_X = 0, I_C, I_CTX, I_CCTX, I_N1G, I_N2G, I_WMOD, I_BMOD, I_WIN, I_WOUT, I_LCW, I_LCB, I_LWA, I_LBA, I_LWX, I_LBX, I_LLAM,
       I_QNG, I_WQB, I_KVNG, I_WKVB, I_MCW, I_MCB, I_MWQ, I_MWK, I_MWV, I_MWG, I_MBG, I_MNG, I_MSK, I_WR, I_BR, I_WGU, I_BGU, I_WD, I_BD, I_FG, N_IN };

struct P {
    const float* in[N_IN];
    float* out;
    float *MOD, *ROPET, *X, *H, *U, *XC, *LA, *LB, *HL, *QN, *KVN, *QF, *KVF, *Qr, *Kr, *Vr, *XCM, *QM, *KM, *VM, *IGF, *HM, *Y, *TOPG, *ACT, *YB;
    int *TOPE, *CNT, *LIST;
};

HD float sigmoid_f(float x) { return 1.f / (1.f + expf(-x)); }
HD float silu_f(float x) { return x * sigmoid_f(x); }
HD float logsigmoid_f(float x) { return fminf(x, 0.f) - log1pf(expf(-fabsf(x))); }
HD float gelu_f(float x) { return 0.5f * x * (1.f + tanhf(0.7978845608028654f * (x + 0.044715f * x * x * x))); }

HD int tok_b(int t) { return t / TPB; }
HD int tok_i(int t) { return t % TPB; }
HD bool tok_isctx(int t) { return tok_i(t) < CTX; }
HD int tok_cv(int t) { return tok_isctx(t) ? 2 : tok_b(t); }
HD const float* modp(const P& p, int l, int cv, int which) { return p.MOD + (((size_t)l * 3 + cv) * 6 + which) * D; }

template <int R>
HD void gemm_rx4(const float* (&a)[R], const float* B, int ldb, int K, float4 (&acc)[R]) {
    for (int k = 0; k < K; ++k) {
        const float4 bv = *(const float4*)(B + (size_t)k * ldb);
#pragma unroll
        for (int r = 0; r < R; ++r) { const float av = a[r][k]; acc[r].x += av * bv.x; acc[r].y += av * bv.y; acc[r].z += av * bv.z; acc[r].w += av * bv.w; }
    }
}

HD void nv_init(const P& p, long gtid, long nthr) {
    for (long it = gtid; it < (long)DEPTH * 6 * D; it += nthr) {
        const int l = (int)(it / (6 * D)), j = (int)(it % (6 * D));
        const float* w = p.in[I_WMOD] + (size_t)l * D * 6 * D + j;
        float a0 = 0.f, a1 = 0.f, a2 = 0.f;
        for (int k = 0; k < D; ++k) { const float wv = w[(size_t)k * 6 * D];
            a0 += silu_f(p.in[I_C][k]) * wv; a1 += silu_f(p.in[I_C][D + k]) * wv; a2 += silu_f(p.in[I_CCTX][k]) * wv; }
        const float bb = p.in[I_BMOD][(size_t)l * 6 * D + j];
        p.MOD[((size_t)l * 3 + 0) * 6 * D + j] = a0 + bb; p.MOD[((size_t)l * 3 + 1) * 6 * D + j] = a1 + bb; p.MOD[((size_t)l * 3 + 2) * 6 * D + j] = a2 + bb;
    }
    for (long it = gtid; it < (long)NT * D; it += nthr) {
        const int t = (int)(it / D), k = (int)(it % D), b = tok_b(t), i = tok_i(t);
        p.X[it] = (i < CTX) ? p.in[I_CTX][((size_t)b * CTX + i) * D + k] : p.in[I_X][((size_t)b * SEQ + (i - CTX)) * D + k];
    }
    for (long it = gtid; it < (long)SEQ * 16; it += nthr) {
        const int s = (int)(it / 16), a = (int)((it / 8) & 1), f = (int)(it & 7);
        const int pos = a == 0 ? s / GRID_W : s % GRID_W;
        const double fr = pow(10000.0, -(double)f / 8.0);
        const float frf = (float)fr;
        const double ang = (double)((float)pos * frf);
        p.ROPET[it * 2] = (float)cos(ang); p.ROPET[it * 2 + 1] = (float)sin(ang);
    }
}

HD void nv_norm(const P& p, int l, int which  , long gtid, long nthr) {
    const float* g = p.in[which == 0 ? I_N1G : I_N2G] + (size_t)l * D;
    for (long t = gtid; t < NT; t += nthr) {
        const float* x = p.X + (size_t)t * D; float ss = 0.f;
        for (int k = 0; k < D; ++k) ss += x[k] * x[k];
        const float rstd = 1.f / sqrtf(ss / (float)D + EPS);
        const int cv = tok_cv((int)t); const float* sh = modp(p, l, cv, which == 0 ? 0 : 3); const float* sc = modp(p, l, cv, which == 0 ? 1 : 4);
        float* h = p.H + (size_t)t * D;
        for (int k = 0; k < D; ++k) h[k] = x[k] * rstd * g[k] * (1.f + sc[k]) + sh[k];
    }
}

HD void nv_inproj(const P& p, int l, long gtid, long nthr) {
    constexpr int R = 8, NQ = DIN / 4; const float* W = p.in[I_WIN] + (size_t)l * D * DIN;
    for (long it = gtid; it < (long)(NT / R) * NQ; it += nthr) {
        const int mi = (int)(it / NQ), n = (int)(it % NQ) * 4;
        const float* a[R]; float4 acc[R];
#pragma unroll
        for (int r = 0; r < R; ++r) { a[r] = p.H + (size_t)(mi * R + r) * D; acc[r] = float4{0.f, 0.f, 0.f, 0.f}; }
        gemm_rx4<R>(a, W + n, DIN, D, acc);
#pragma unroll
        for (int r = 0; r < R; ++r) *(float4*)(p.U + (size_t)(mi * R + r) * DIN + n) = acc[r];
    }
}

HD float conv_at(const P& p, int t, int col, int c, const float* w  , const float* bias) {
    const int i = tok_i(t), isc = i < CTX, li = isc ? i : i - CTX, len = isc ? CTX : SEQ;
    float s = bias[c];
#pragma unroll
    for (int k = 0; k < 4; ++k) { const int j = li + k - 2; if (j >= 0 && j < len) s += w[k * 256 + c] * p.U[(size_t)(t + k - 2) * DIN + col + c]; }
    return s;
}

HD void nv_prep1(const P& p, int l, long gtid, long nthr) {
    for (long it = gtid; it < (long)NT * 256; it += nthr) {
        const int t = (int)(it / 256), c = (int)(it % 256);
        p.XC[it] = conv_at(p, t, OFF_AX, c, p.in[I_LCW] + (size_t)l * 4 * 256, p.in[I_LCB] + (size_t)l * 256);
        p.XCM[it] = silu_f(conv_at(p, t, OFF_MX, c, p.in[I_MCW] + (size_t)l * 4 * 256, p.in[I_MCB] + (size_t)l * 256));
    }
    for (long t = gtid; t < NT; t += nthr) {
        const float* u = p.U + (size_t)t * DIN; float sq = 0.f, sk = 0.f;
        for (int k = 0; k < QRANK; ++k) sq += u[OFF_BQ + k] * u[OFF_BQ + k];
        for (int k = 0; k < KVRANK; ++k) sk += u[OFF_BKV + k] * u[OFF_BKV + k];
        const float rq = 1.f / sqrtf(sq / (float)QRANK + EPS), rk = 1.f / sqrtf(sk / (float)KVRANK + EPS);
        for (int k = 0; k < QRANK; ++k) p.QN[(size_t)t * QRANK + k] = u[OFF_BQ + k] * rq * p.in[I_QNG][(size_t)l * QRANK + k];
        for (int k = 0; k < KVRANK; ++k) p.KVN[(size_t)t * KVRANK + k] = u[OFF_BKV + k] * rk * p.in[I_KVNG][(size_t)l * KVRANK + k];
    }
}

HD void nv_prep2(const P& p, int l, long gtid, long nthr) {
    for (long it = gtid; it < (long)2 * NT * 256; it += nthr) {
        const int d = (int)(it / ((long)NT * 256)), t = (int)((it / 256) % NT), c = (int)(it % 256), g = c / 64, j = c % 64;
        const float* xc = p.XC + (size_t)t * 256 + g * 64;
        const float* wa = p.in[I_LWA] + ((((size_t)l * 2 + d) * 4 + g) * 64) * 64 + j;
        const float* wx = p.in[I_LWX] + ((((size_t)l * 2 + d) * 4 + g) * 64) * 64 + j;
        float sa = 0.f, sx = 0.f;
        for (int i = 0; i < 64; ++i) { sa += xc[i] * wa[i * 64]; sx += xc[i] * wx[i * 64]; }
        const float r = sigmoid_f(sa + p.in[I_LBA][((size_t)l * 2 + d) * 256 + c]), ig = sigmoid_f(sx + p.in[I_LBX][((size_t)l * 2 + d) * 256 + c]);
        const float log_a = 8.0f * r * logsigmoid_f(p.in[I_LLAM][((size_t)l * 2 + d) * 256 + c]);
        p.LA[it] = expf(log_a); p.LB[it] = sqrtf(-expm1f(2.f * log_a)) * ig * p.XC[(size_t)t * 256 + c];
    }
    { constexpr int R = 8, NQ = 768 / 4; const float* W = p.in[I_WQB] + (size_t)l * QRANK * 768;
      for (long it = gtid; it < (long)(NT / R) * NQ; it += nthr) { const int mi = (int)(it / NQ), n = (int)(it % NQ) * 4;
        const float* a[R]; float4 acc[R];
#pragma unroll
        for (int r = 0; r < R; ++r) { a[r] = p.QN + (size_t)(mi * R + r) * QRANK; acc[r] = float4{0.f, 0.f, 0.f, 0.f}; }
        gemm_rx4<R>(a, W + n, 768, QRANK, acc);
#pragma unroll
        for (int r = 0; r < R; ++r) *(float4*)(p.QF + (size_t)(mi * R + r) * 768 + n) = acc[r]; } }
    { constexpr int R = 8, NQ = 1024 / 4; const float* W = p.in[I_WKVB] + (size_t)l * KVRANK * 1024;
      for (long it = gtid; it < (long)(NT / R) * NQ; it += nthr) { const int mi = (int)(it / NQ), n = (int)(it % NQ) * 4;
        const float* a[R]; float4 acc[R];
#pragma unroll
        for (int r = 0; r < R; ++r) { a[r] = p.KVN + (size_t)(mi * R + r) * KVRANK; acc[r] = float4{0.f, 0.f, 0.f, 0.f}; }
        gemm_rx4<R>(a, W + n, 1024, KVRANK, acc);
#pragma unroll
        for (int r = 0; r < R; ++r) *(float4*)(p.KVF + (size_t)(mi * R + r) * 1024 + n) = acc[r]; } }
    for (long it = gtid; it < (long)NT * 256; it += nthr) {
        const int t = (int)(it / 256), c = (int)(it % 256), h = c / 64, j = c % 64;
        const float* xc = p.XCM + (size_t)t * 256 + h * 64; const float* ux = p.U + (size_t)t * DIN + OFF_MX + h * 64;
        const float* wq = p.in[I_MWQ] + (((size_t)l * 4 + h) * 64) * 64 + j; const float* wk = p.in[I_MWK] + (((size_t)l * 4 + h) * 64) * 64 + j; const float* wv = p.in[I_MWV] + (((size_t)l * 4 + h) * 64) * 64 + j;
        float sq = 0.f, sk = 0.f, sv = 0.f;
        for (int i = 0; i < 64; ++i) { sq += xc[i] * wq[i * 64]; sk += xc[i] * wk[i * 64]; sv += ux[i] * wv[i * 64]; }
        p.QM[it] = sq; p.KM[it] = sk * 0.125f; p.VM[it] = sv;
    }
}

HD void nv_prep3(const P& p, int l, long gtid, long nthr) {
    for (long it = gtid; it < (long)NB * 2 * 256; it += nthr) {
        const int b = (int)(it / 512), d = (int)((it / 256) & 1), c = (int)(it % 256);
        const float* A = p.LA + (size_t)d * NT * 256; const float* Bc = p.LB + (size_t)d * NT * 256; float* Ho = p.HL + (size_t)d * NT * 256;
        float h = 0.f;
        for (int seg = 0; seg < 2; ++seg) { const int base = b * TPB + (seg == 0 ? 0 : CTX), len = seg == 0 ? CTX : SEQ;
            for (int s = 0; s < len; ++s) { const int t = base + (d == 0 ? s : len - 1 - s);
                h = A[(size_t)t * 256 + c] * h + Bc[(size_t)t * 256 + c]; Ho[(size_t)t * 256 + c] = h; } }
    }
    for (long it = gtid; it < (long)NT * AH; it += nthr) {
        const int t = (int)(it / AH), h = (int)(it % AH), i = tok_i(t); const bool lat = i >= CTX; const int s = i - CTX;
        const float* qf = p.QF + (size_t)t * 768 + h * QKD; const float* kvf = p.KVF + (size_t)t * 1024 + h * (NOPE + VD); const float* kr = p.U + (size_t)t * DIN + OFF_BKR;
        float* qo = p.Qr + ((size_t)t * AH + h) * QKD; float* ko = p.Kr + ((size_t)t * AH + h) * QKD; float* vo = p.Vr + ((size_t)t * AH + h) * VD;
        for (int k = 0; k < NOPE; ++k) { qo[k] = qf[k]; ko[k] = kvf[k]; vo[k] = kvf[NOPE + k]; }
        for (int a = 0; a < 2; ++a) for (int f = 0; f < 8; ++f) {
            float cs = 1.f, sn = 0.f; if (lat) { cs = p.ROPET[(((size_t)s * 2 + a) * 8 + f) * 2]; sn = p.ROPET[(((size_t)s * 2 + a) * 8 + f) * 2 + 1]; }
            const float q1 = qf[NOPE + a * 16 + f], q2 = qf[NOPE + a * 16 + 8 + f], k1 = kr[a * 16 + f], k2 = kr[a * 16 + 8 + f];
            qo[NOPE + a * 16 + f] = q1 * cs - q2 * sn; qo[NOPE + a * 16 + 8 + f] = q2 * cs + q1 * sn;
            ko[NOPE + a * 16 + f] = k1 * cs - k2 * sn; ko[NOPE + a * 16 + 8 + f] = k2 * cs + k1 * sn; }
    }
    for (long it = gtid; it < (long)2 * NT * 8; it += nthr) {
        const int d = (int)(it / ((long)NT * 8)), t = (int)((it / 8) % NT), g = (int)(it % 8);
        const float* w = p.in[I_MWG] + (((size_t)l * 2 + d) * 768) * 8 + g; float s = p.in[I_MBG][((size_t)l * 2 + d) * 8 + g];
        for (int i = 0; i < 256; ++i) s += p.QM[(size_t)t * 256 + i] * w[(size_t)i * 8];
        for (int i = 0; i < 256; ++i) s += p.KM[(size_t)t * 256 + i] * w[(size_t)(256 + i) * 8];
        for (int i = 0; i < 256; ++i) s += p.VM[(size_t)t * 256 + i] * w[(size_t)(512 + i) * 8];
        p.IGF[it] = g < 4 ? s : logsigmoid_f(s);
    }
}

HD void nv_attn(const P& p, long gtid, long nthr) {
    const float scale = 1.0f / sqrtf((float)QKD);
    for (long it = gtid; it < (long)NT * AH; it += nthr) {
        const int h = (int)((it / TPB) % AH), b = (int)(it / ((long)TPB * AH)), i = (int)(it % TPB), t = b * TPB + i;
        const int nk = i < CTX ? CTX : TPB;
        float q[QKD], o[VD];
#pragma unroll
        for (int k = 0; k < QKD; ++k) q[k] = p.Qr[((size_t)t * AH + h) * QKD + k] * scale;
#pragma unroll
        for (int k = 0; k < VD; ++k) o[k] = 0.f;
        float m = -1e30f, lsum = 0.f;
        for (int j = 0; j < nk; ++j) {
            const float* kk = p.Kr + ((size_t)(b * TPB + j) * AH + h) * QKD; const float* vv = p.Vr + ((size_t)(b * TPB + j) * AH + h) * VD;
            float s = 0.f;
#pragma unroll
            for (int k = 0; k < QKD; ++k) s += q[k] * kk[k];
            if (s > m) { const float f = expf(m - s); lsum *= f;
#pragma unroll
                for (int k = 0; k < VD; ++k) o[k] *= f;
                m = s; }
            const float pr = expf(s - m); lsum += pr;
#pragma unroll
            for (int k = 0; k < VD; ++k) o[k] += pr * vv[k];
        }
        const float inv = 1.f / lsum;
#pragma unroll
        for (int k = 0; k < VD; ++k) p.Y[(size_t)t * DMIX + 256 + h * VD + k] = o[k] * inv;
    }
}
HD void nv_mlstm_scan(const P& p, long gtid, long nthr) {
    for (long it = gtid; it < (long)NB * MLH * 2 * 64; it += nthr) {
        const int v = (int)(it % 64), d = (int)((it / 64) & 1), h = (int)((it / 128) % MLH), b = (int)(it / (128 * MLH));
        float C[64], n[64];
#pragma unroll
        for (int k = 0; k < 64; ++k) { C[k] = 0.f; n[k] = 0.f; }
        float m = 0.f;
        for (int seg = 0; seg < 2; ++seg) { const int base = b * TPB + (seg == 0 ? 0 : CTX), len = seg == 0 ? CTX : SEQ;
            for (int s = 0; s < len; ++s) { const int t = base + (d == 0 ? s : len - 1 - s);
                const float ig = p.IGF[((size_t)d * NT + t) * 8 + h], lf = p.IGF[((size_t)d * NT + t) * 8 + 4 + h];
                const float mn = fmaxf(lf + m, ig), fd = expf(lf + m - mn), iw = expf(ig - mn); m = mn;
                const float* qq = p.QM + (size_t)t * 256 + h * 64; const float* kk = p.KM + (size_t)t * 256 + h * 64; const float vv = p.VM[(size_t)t * 256 + h * 64 + v];
                float num = 0.f, den = 0.f;
#pragma unroll
                for (int k = 0; k < 64; ++k) { const float kv = kk[k], qv = qq[k]; C[k] = fd * C[k] + iw * vv * kv; n[k] = fd * n[k] + iw * kv; num += C[k] * qv; den += n[k] * qv; }
                p.HM[((size_t)d * NT + t) * 256 + h * 64 + v] = num / fmaxf(fabsf(den), expf(-mn)); } }
    }
}
HD void nv_lru_out(const P& p, long gtid, long nthr) {
    for (long it = gtid; it < (long)NT * 256; it += nthr) { const int t = (int)(it / 256), c = (int)(it % 256);
        p.Y[(size_t)t * DMIX + c] = (p.HL[it] + p.HL[(size_t)NT * 256 + it]) * gelu_f(p.U[(size_t)t * DIN + OFF_AG + c]); }
}
HD void nv_mlstm_finish(const P& p, int l, long gtid, long nthr) {
    for (long it = gtid; it < (long)NT * MLH; it += nthr) { const int t = (int)(it / MLH), h = (int)(it % MLH);
        const float* h0 = p.HM + (size_t)t * 256 + h * 64; const float* h1 = p.HM + ((size_t)NT + t) * 256 + h * 64;
        float mu = 0.f; for (int j = 0; j < 64; ++j) mu += h0[j] + h1[j]; mu *= (1.f / 64.f);
        float var = 0.f; for (int j = 0; j < 64; ++j) { const float dlt = h0[j] + h1[j] - mu; var += dlt * dlt; } var *= (1.f / 64.f);
        const float rstd = 1.f / sqrtf(var + EPS);
        for (int j = 0; j < 64; ++j) { const int c = h * 64 + j;
            const float y = (h0[j] + h1[j] - mu) * rstd * p.in[I_MNG][(size_t)l * 256 + c] + p.in[I_MSK][(size_t)l * 256 + c] * p.XCM[(size_t)t * 256 + c];
            p.Y[(size_t)t * DMIX + 768 + c] = y * silu_f(p.U[(size_t)t * DIN + OFF_MZ + c]); } }
}
HD void nv_outproj(const P& p, int l, long gtid, long nthr) {
    constexpr int R = 8, NQ = D / 4; const float* W = p.in[I_WOUT] + (size_t)l * DMIX * D;
    for (long it = gtid; it < (long)(NT / R) * NQ; it += nthr) { const int mi = (int)(it / NQ), n = (int)(it % NQ) * 4;
        const float* a[R]; float4 acc[R];
#pragma unroll
        for (int r = 0; r < R; ++r) { a[r] = p.Y + (size_t)(mi * R + r) * DMIX; acc[r] = float4{0.f, 0.f, 0.f, 0.f}; }
        gemm_rx4<R>(a, W + n, D, DMIX, acc);
#pragma unroll
        for (int r = 0; r < R; ++r) { const int t = mi * R + r; const float* g1 = modp(p, l, tok_cv(t), 2) + n; float* x = p.X + (size_t)t * D + n;
            x[0] += g1[0] * acc[r].x; x[1] += g1[1] * acc[r].y; x[2] += g1[2] * acc[r].z; x[3] += g1[3] * acc[r].w; } }
}
HD void nv_zero_cnt(const P& p, long gtid, long nthr) { for (long i = gtid; i < NE; i += nthr) p.CNT[i] = 0; }
HD void nv_router(const P& p, int l, long gtid, long nthr) {
    for (long t = gtid; t < NT; t += nthr) {
        float lg[NE]; const float* h = p.H + (size_t)t * D; const float* W = p.in[I_WR] + (size_t)l * D * NE;
#pragma unroll
        for (int e = 0; e < NE; ++e) lg[e] = p.in[I_BR][(size_t)l * NE + e];
        for (int k = 0; k < D; ++k) { const float hv = h[k];
#pragma unroll
            for (int e = 0; e < NE; ++e) lg[e] += hv * W[(size_t)k * NE + e]; }
        int te[TOPK]; float tv[TOPK];
#pragma unroll
        for (int r = 0; r < TOPK; ++r) { float best = -3.0e38f; int bi = 0;
#pragma unroll
            for (int e = 0; e < NE; ++e) { const bool c = lg[e] > best; best = c ? lg[e] : best; bi = c ? e : bi; }
            te[r] = bi; tv[r] = best;
#pragma unroll
            for (int e = 0; e < NE; ++e) lg[e] = (e == bi) ? -3.0e38f : lg[e]; }
        float s = 0.f, ex[TOPK];
#pragma unroll
        for (int r = 0; r < TOPK; ++r) { ex[r] = expf(tv[r] - tv[0]); s += ex[r]; }
#pragma unroll
        for (int r = 0; r < TOPK; ++r) { p.TOPE[t * TOPK + r] = te[r]; p.TOPG[t * TOPK + r] = ex[r] / s;
            const int pos = atomic_add_i(&p.CNT[te[r]], 1); p.LIST[(size_t)te[r] * NT + pos] = (int)t * TOPK + r; }
    }
}
HD bool moe_item(const P& p, int R, long grp, int& e, int& r0) {
    long acc = 0;
    for (int x = 0; x < NE; ++x) { const int c = p.CNT[x], ng = (c + R - 1) / R; if (grp < acc + ng) { e = x; r0 = (int)(grp - acc) * R; return true; } acc += ng; }
    return false;
}
HD long moe_groups(const P& p, int R) { long acc = 0; for (int x = 0; x < NE; ++x) acc += (p.CNT[x] + R - 1) / R; return acc; }
HD void nv_moe_gu(const P& p, int l, long gtid, long nthr) {
    constexpr int R = 8, NQ = DE / 4; const long ngrp = moe_groups(p, R);
    for (long it = gtid; it < ngrp * NQ; it += nthr) { int e, r0; moe_item(p, R, it / NQ, e, r0); const int n = (int)(it % NQ) * 4, cnt = p.CNT[e];
        const float* Wg = p.in[I_WGU] + ((size_t)l * NE + e) * D * 2 * DE; const float* bg = p.in[I_BGU] + ((size_t)l * NE + e) * 2 * DE;
        const float* a[R]; int pr[R]; float4 ag[R], al[R];
#pragma unroll
        for (int r = 0; r < R; ++r) { const int rr = r0 + r < cnt ? r0 + r : cnt - 1; pr[r] = p.LIST[(size_t)e * NT + rr]; a[r] = p.H + (size_t)(pr[r] / TOPK) * D; ag[r] = float4{0.f, 0.f, 0.f, 0.f}; al[r] = float4{0.f, 0.f, 0.f, 0.f}; }
        gemm_rx4<R>(a, Wg + n, 2 * DE, D, ag);
        gemm_rx4<R>(a, Wg + DE + n, 2 * DE, D, al);
#pragma unroll
        for (int r = 0; r < R; ++r) if (r0 + r < cnt) { float gv[4] = {ag[r].x + bg[n], ag[r].y + bg[n + 1], ag[r].z + bg[n + 2], ag[r].w + bg[n + 3]};
            float lv[4] = {al[r].x + bg[DE + n], al[r].y + bg[DE + n + 1], al[r].z + bg[DE + n + 2], al[r].w + bg[DE + n + 3]};
#pragma unroll
            for (int q = 0; q < 4; ++q) { const float glu = fminf(gv[q], 7.0f), lin = fminf(fmaxf(lv[q], -7.0f), 7.0f);
                p.ACT[(size_t)pr[r] * DE + n + q] = glu * sigmoid_f(1.702f * glu) * (lin + 1.f); } }
    }
}
HD void nv_moe_down(const P& p, int l, long gtid, long nthr) {
    constexpr int R = 8, NQ = D / 4; const long ngrp = moe_groups(p, R);
    for (long it = gtid; it < ngrp * NQ; it += nthr) { int e, r0; moe_item(p, R, it / NQ, e, r0); const int n = (int)(it % NQ) * 4, cnt = p.CNT[e];
        const float* Wd = p.in[I_WD] + ((size_t)l * NE + e) * DE * D; const float* bd = p.in[I_BD] + ((size_t)l * NE + e) * D;
        const float* a[R]; int pr[R]; float4 acc[R];
#pragma unroll
        for (int r = 0; r < R; ++r) { const int rr = r0 + r < cnt ? r0 + r : cnt - 1; pr[r] = p.LIST[(size_t)e * NT + rr]; a[r] = p.ACT + (size_t)pr[r] * DE; acc[r] = float4{0.f, 0.f, 0.f, 0.f}; }
        gemm_rx4<R>(a, Wd + n, D, DE, acc);
#pragma unroll
        for (int r = 0; r < R; ++r) if (r0 + r < cnt) { const float g = p.TOPG[pr[r]]; float* y = p.YB + (size_t)pr[r] * D + n;
            y[0] = g * (acc[r].x + bd[n]); y[1] = g * (acc[r].y + bd[n + 1]); y[2] = g * (acc[r].z + bd[n + 2]); y[3] = g * (acc[r].w + bd[n + 3]); }
    }
}
HD void nv_combine(const P& p, int l, long gtid, long nthr) {
    for (long it = gtid; it < (long)NT * D; it += nthr) { const int t = (int)(it / D), n = (int)(it % D);
        const float s = ((p.YB[((size_t)t * 4 + 0) * D + n] + p.YB[((size_t)t * 4 + 1) * D + n]) + p.YB[((size_t)t * 4 + 2) * D + n]) + p.YB[((size_t)t * 4 + 3) * D + n];
        p.X[it] += modp(p, l, tok_cv(t), 5)[n] * s; }
}
HD void nv_final(const P& p, long gtid, long nthr) {
    for (long r = gtid; r < (long)NB * SEQ; r += nthr) { const int b = (int)(r / SEQ), s = (int)(r % SEQ), t = b * TPB + CTX + s;
        const float* x = p.X + (size_t)t * D; float ss = 0.f;
        for (int k = 0; k < D; ++k) ss += x[k] * x[k];
        const float rstd = 1.f / sqrtf(ss / (float)D + EPS);
        for (int k = 0; k < D; ++k) p.out[(size_t)r * D + k] = x[k] * rstd * p.in[I_FG][k]; }
}

constexpr int PH_PER_LAYER = 13, N_PHASES = 1 + DEPTH * PH_PER_LAYER + 1;
HD void nv_run_phase(const P& p, int ph, long gtid, long nthr) {
    if (ph == 0) { nv_init(p, gtid, nthr); return; }
    if (ph == N_PHASES - 1) { nv_final(p, gtid, nthr); return; }
    const int l = (ph - 1) / PH_PER_LAYER, s = (ph - 1) % PH_PER_LAYER;
    switch (s) {
        case 0: nv_norm(p, l, 0, gtid, nthr); break;
        case 1: nv_inproj(p, l, gtid, nthr); break;
        case 2: nv_prep1(p, l, gtid, nthr); break;
        case 3: nv_prep2(p, l, gtid, nthr); break;
        case 4: nv_prep3(p, l, gtid, nthr); break;
        case 5: nv_mlstm_scan(p, gtid, nthr); nv_attn(p, gtid, nthr); nv_lru_out(p, gtid, nthr); break;
        case 6: nv_mlstm_finish(p, l, gtid, nthr); break;
        case 7: nv_outproj(p, l, gtid, nthr); break;
        case 8: nv_norm(p, l, 1, gtid, nthr); nv_zero_cnt(p, gtid, nthr); break;
        case 9: nv_router(p, l, gtid, nthr); break;
        case 10: nv_moe_gu(p, l, gtid, nthr); break;
        case 11: nv_moe_down(p, l, gtid, nthr); break;
        case 12: nv_combine(p, l, gtid, nthr); break;
    }
}

struct WsMap { size_t off[32]; size_t total; };
static inline WsMap ws_map() {
    WsMap m; size_t o = 0; int i = 0;
    auto add = [&](size_t n) { m.off[i++] = o; o += (n + 63) & ~(size_t)63; };
    add((size_t)DEPTH * 3 * 6 * D);
    add((size_t)SEQ * 16 * 2);
    add((size_t)NT * D);
    add((size_t)NT * D);
    add((size_t)NT * DIN);
    add((size_t)NT * 256);
    add((size_t)2 * NT * 256);
    add((size_t)2 * NT * 256);
    add((size_t)2 * NT * 256);
    add((size_t)NT * QRANK);
    add((size_t)NT * KVRANK);
    add((size_t)NT * 768);
    add((size_t)NT * 1024);
    add((size_t)NT * AH * QKD);
    add((size_t)NT * AH * QKD);
    add((size_t)NT * AH * VD);
    add((size_t)NT * 256);
    add((size_t)NT * 256);
    add((size_t)NT * 256);
    add((size_t)NT * 256);
    add((size_t)2 * NT * 8);
    add((size_t)2 * NT * 256);
    add((size_t)NT * DMIX);
    add((size_t)NT * TOPK);
    add((size_t)NT * TOPK * DE);
    add((size_t)NT * TOPK * D);
    add((size_t)NT * TOPK);
    add((size_t)64);
    add((size_t)NE * NT);
    m.total = o; return m;
}
static inline void fill_params(P& p, void* const* d_in, void* d_out, void* d_ws) {
    for (int i = 0; i < N_IN; ++i) p.in[i] = (const float*)d_in[i];
    p.out = (float*)d_out; float* w = (float*)d_ws; const WsMap m = ws_map();
    p.MOD = w + m.off[0]; p.ROPET = w + m.off[1]; p.X = w + m.off[2]; p.H = w + m.off[3]; p.U = w + m.off[4]; p.XC = w + m.off[5]; p.LA = w + m.off[6]; p.LB = w + m.off[7]; p.HL = w + m.off[8];
    p.QN = w + m.off[9]; p.KVN = w + m.off[10]; p.QF = w + m.off[11]; p.KVF = w + m.off[12]; p.Qr = w + m.off[13]; p.Kr = w + m.off[14]; p.Vr = w + m.off[15];
    p.XCM = w + m.off[16]; p.QM = w + m.off[17]; p.KM = w + m.off[18]; p.VM = w + m.off[19]; p.IGF = w + m.off[20]; p.HM = w + m.off[21]; p.Y = w + m.off[22];
    p.TOPG = w + m.off[23]; p.ACT = w + m.off[24]; p.YB = w + m.off[25]; p.TOPE = (int*)(w + m.off[26]); p.CNT = (int*)(w + m.off[27]); p.LIST = (int*)(w + m.off[28]);
}
extern __shared__ __attribute__((aligned(16))) unsigned char g_lds_base[];
constexpr int WTAB_OFF = 148480 - 64 - 256;
#define HWID() ((int)__builtin_amdgcn_s_getreg((5 << 11) | 4) & 63)
#if ONE_LAUNCH
__device__ __forceinline__ int tidx_() {
    unsigned z = 0u; asm volatile("" : "+v"(z));
    const int lane = (int)__builtin_amdgcn_mbcnt_hi(~0u, __builtin_amdgcn_mbcnt_lo(~0u, z));
    const int wv = __builtin_amdgcn_readfirstlane(((const volatile __attribute__((address_space(3))) int*)((__attribute__((address_space(3))) unsigned char*)g_lds_base + WTAB_OFF))[HWID()]);
    return wv * 64 + lane;
}
#define TIDX tidx_()
#else
#define TIDX ((int)threadIdx.x)
#endif
namespace pg8 {
#define PG8_LAS __attribute__((address_space(3)))
typedef unsigned short bf16_t;
typedef short bf16x8 __attribute__((ext_vector_type(8)));
typedef float f32x4 __attribute__((ext_vector_type(4)));
typedef unsigned u32x4 __attribute__((ext_vector_type(4)));
constexpr int BM = 256, BK = 64, HALF = 128, HTB = HALF * BK * 2  , STAGE_BYTES = 8 * HTB, NXCD = 8, WGM = 8;

__host__ __device__ __forceinline__ int lds_byte(int r, int c) { const int st = (r >> 4) * 2 + (c >> 5), rr = r & 15, cc = c & 31, ob = rr * 64 + cc * 2; return st * 1024 + (ob ^ (((ob >> 9) & 1) << 5)); }
__host__ __device__ __forceinline__ void stage_rc(int b, int& R, int& C) { const int st = b / 1024, sb = b % 1024, swz = sb ^ (((sb >> 9) & 1) << 5); R = (st >> 1) * 16 + swz / 64; C = (st & 1) * 32 + (swz % 64) / 2; }
__host__ __device__ __forceinline__ int perm32(int rho) { const int n = rho >> 4, i = rho & 15; return 8 * (i >> 2) + 4 * n + (i & 3); }

struct Unit { int pm, pn, e, mb; };
struct Gemm { const bf16_t* A; const bf16_t* Bt; int K; };

struct StaticOrder {
    int nM, nN, nwg, G, c;
    __device__ void init(int M, int N, int G_, int c_) { nM = M / BM; nN = N / BM; nwg = nM * nN; G = G_; c = c_; }
    __device__ bool next(int i, Unit& u) const {
        const long L = (long)i * G + c; if (L >= nwg) return false;
        int wgid = (int)L; { const int q = nwg / NXCD, r = nwg % NXCD, xcd = wgid % NXCD, off = wgid / NXCD; wgid = (xcd < r ? xcd * (q + 1) : r * (q + 1) + (xcd - r) * q) + off; }
        const int nig = WGM * nN, gid = wgid / nig, fm = gid * WGM, gsz = (nM - fm) < WGM ? (nM - fm) : WGM;
        u.pm = fm + ((wgid % nig) % gsz); u.pn = (wgid % nig) / gsz; u.e = 0; u.mb = 0; return true;
    }
    __device__ __forceinline__ int arow(const Unit& u, int r) const { return u.pm * BM + r; }
};

__device__ __forceinline__ unsigned cvt_pk_bf16(float lo, float hi) { unsigned r; asm volatile("v_cvt_pk_bf16_f32 %0, %1, %2" : "=v"(r) : "v"(lo), "v"(hi)); return r; }

template <class Epi, class Sched, bool ALIGN_EPI>
__device__ __forceinline__ void gemm_phase(PG8_LAS unsigned char* lds, const Gemm g, const Sched& S, const Epi& E) {
    int tid_ = TIDX; asm volatile("" : "+v"(tid_));
    const int tid = tid_, wid = __builtin_amdgcn_readfirstlane(tid >> 6), lane = tid & 63, wr = wid >> 2, wc = wid & 3, fr = lane & 15, fq = lane >> 4;
    const int K = g.K, nt = K / BK;
    unsigned voffB[2];
#pragma unroll
    for (int i = 0; i < 2; ++i) { int R, C; stage_rc(tid * 16 + i * 8192, R, C); const int Rb = Epi::PERM ? ((R & ~31) + perm32(R & 31)) : R;
        voffB[i] = (unsigned)(Rb * K + C) * 2u; }
    const size_t kstep = (size_t)(BK * 2);
    const size_t hstep = (size_t)HALF * K * 2;
    const size_t tstep = 2 * hstep;
    const unsigned ldsw = (unsigned)wid * 1024u;
    const int aoff = lds_byte(wr * 64 + fr, fq * 8), boff = lds_byte(wc * 32 + fr, fq * 8);
#define PG8_SA(b, h) (((b) * 2 + (h)) * HTB)
#define PG8_SB(b, h) ((4 + (b) * 2 + (h)) * HTB)
#define PG8_STAGE(bufoff, gbase, voff) do { _Pragma("unroll") for (int _i = 0; _i < 2; ++_i) \
        __builtin_amdgcn_global_load_lds((const unsigned*)((const char*)(gbase) + (voff)[_i]), (PG8_LAS unsigned*)(lds + (bufoff) + ldsw + _i * 8192), 16, 0, 0); } while (0)
#define PG8_LDA(dst, b, h) do { _Pragma("unroll") for (int m = 0; m < 4; ++m) _Pragma("unroll") for (int k = 0; k < 2; ++k) dst[m][k] = *(const PG8_LAS bf16x8*)(lds + PG8_SA(b, h) + aoff + m * 2048 + k * 1024); } while (0)
#define PG8_LDB(dst, b, h) do { _Pragma("unroll") for (int n = 0; n < 2; ++n) _Pragma("unroll") for (int k = 0; k < 2; ++k) dst[n][k] = *(const PG8_LAS bf16x8*)(lds + PG8_SB(b, h) + boff + n * 2048 + k * 1024); } while (0)
#define PG8_MMA(ai, bj, At, Bt) do { __builtin_amdgcn_s_setprio(1); _Pragma("unroll") for (int m = 0; m < 4; ++m) _Pragma("unroll") for (int n = 0; n < 2; ++n) _Pragma("unroll") for (int k = 0; k < 2; ++k) \
        acc[ai][bj][m][n] = __builtin_amdgcn_mfma_f32_16x16x32_bf16(Bt[n][k], At[m][k], acc[ai][bj][m][n], 0, 0, 0); __builtin_amdgcn_s_setprio(0); } while (0)
#define PG8_WAIT_V(n) asm volatile("s_waitcnt vmcnt(" #n ")" ::: "memory")
#define PG8_WAIT_L(n) asm volatile("s_waitcnt lgkmcnt(" #n ")" ::: "memory")
#define PG8_BAR __builtin_amdgcn_s_barrier()
#define PG8_SCHED __builtin_amdgcn_sched_barrier(0)
#define PG8_AOFFS(dst, U) do { int _t = tid; asm volatile("" : "+v"(_t)); _Pragma("unroll") for (int _i = 0; _i < 2; ++_i) { int _R, _C; stage_rc(_t * 16 + _i * 8192, _R, _C); \
        _Pragma("unroll") for (int _h = 0; _h < 2; ++_h) dst[_h][_i] = (unsigned)(S.arow(U, _h * HALF + _R) * K + _C) * 2u; } } while (0)
    Unit cur, nxt; int ui = 0;
    if (!S.next(0, cur)) return;
    f32x4 acc[2][2][4][2];
#pragma unroll
    for (int a = 0; a < 2; ++a)
#pragma unroll
        for (int b = 0; b < 2; ++b)
#pragma unroll
            for (int m = 0; m < 4; ++m)
#pragma unroll
                for (int n = 0; n < 2; ++n) acc[a][b][m][n] = (f32x4){0.f, 0.f, 0.f, 0.f};
    bf16x8 At[4][2], B0[2][2], B1[2][2];
    unsigned vA[2][2];
    PG8_AOFFS(vA, cur);
    const char* gA = (const char*)g.A;
    const char* cB = (const char*)g.Bt + (size_t)cur.pn * tstep;
    PG8_STAGE(PG8_SB(0, 0), cB, voffB); PG8_STAGE(PG8_SB(0, 1), cB + hstep, voffB); PG8_STAGE(PG8_SA(0, 0), gA, vA[0]); PG8_STAGE(PG8_SA(0, 1), gA, vA[1]);
    if (wr == 1) PG8_BAR;
    PG8_WAIT_V(2); PG8_BAR;
    PG8_STAGE(PG8_SB(1, 0), cB + kstep, voffB); PG8_STAGE(PG8_SA(1, 0), gA + kstep, vA[0]); PG8_STAGE(PG8_SB(1, 1), cB + hstep + kstep, voffB);
    PG8_WAIT_V(6); PG8_BAR;
    for (;;) {
        const bool has_next = S.next(ui + 1, nxt);
        { unsigned nvA[2][2];
          if (has_next) { PG8_AOFFS(nvA, nxt); } else {
#pragma unroll
            for (int h = 0; h < 2; ++h)
#pragma unroll
                for (int i = 0; i < 2; ++i) nvA[h][i] = vA[h][i]; }
          *(PG8_LAS u32x4*)(lds + STAGE_BYTES + 1024 + tid * 16) = (u32x4){nvA[0][0], nvA[0][1], nvA[1][0], nvA[1][1]}; }
        const char* nB = has_next ? (const char*)g.Bt + (size_t)nxt.pn * tstep : cB;
#pragma unroll 1
        for (int t = 0; t < nt; t += 2) {
            const bool last = (t == nt - 2);
            const char* a1 = gA + (size_t)(t + 1) * kstep;
            const char* a2 = last ? gA : gA + (size_t)(t + 2) * kstep; const char* b2 = last ? nB : cB + (size_t)(t + 2) * kstep;
            const char* a3 = a2 + kstep; const char* b3 = b2 + kstep;
            unsigned o2[2][2];
            if (last) { const u32x4 nv = *(const PG8_LAS u32x4*)(lds + STAGE_BYTES + 1024 + tid * 16); o2[0][0] = nv.x; o2[0][1] = nv.y; o2[1][0] = nv.z; o2[1][1] = nv.w; }
            else {
#pragma unroll
                for (int h = 0; h < 2; ++h)
#pragma unroll
                    for (int i = 0; i < 2; ++i) o2[h][i] = vA[h][i]; }
            PG8_LDB(B0, 0, 0); PG8_LDB(B1, 0, 1); PG8_SCHED; PG8_LDA(At, 0, 0); PG8_STAGE(PG8_SA(1, 1), a1, vA[1]);
            PG8_WAIT_V(8); PG8_WAIT_L(0); PG8_BAR; PG8_MMA(0, 0, At, B0); PG8_MMA(0, 1, At, B1); PG8_BAR; PG8_SCHED;
            PG8_LDA(At, 0, 1); PG8_STAGE(PG8_SB(0, 0), b2, voffB); PG8_STAGE(PG8_SB(0, 1), b2 + hstep, voffB); PG8_STAGE(PG8_SA(0, 0), a2, o2[0]);
            PG8_WAIT_V(8); PG8_WAIT_L(0); PG8_BAR; PG8_MMA(1, 0, At, B0); PG8_MMA(1, 1, At, B1); PG8_BAR; PG8_SCHED;
            PG8_LDB(B0, 1, 0); PG8_LDB(B1, 1, 1); PG8_SCHED; PG8_LDA(At, 1, 0); PG8_STAGE(PG8_SA(0, 1), a2, o2[1]);
            PG8_WAIT_V(8); PG8_WAIT_L(0); PG8_BAR; PG8_MMA(0, 0, At, B0); PG8_MMA(0, 1, At, B1); PG8_BAR; PG8_SCHED;
            PG8_LDA(At, 1, 1); PG8_STAGE(PG8_SB(1, 0), b3, voffB); PG8_STAGE(PG8_SB(1, 1), b3 + hstep, voffB); PG8_STAGE(PG8_SA(1, 0), a3, o2[0]);
            PG8_WAIT_V(8); PG8_WAIT_L(0); PG8_BAR; PG8_MMA(1, 0, At, B0); PG8_MMA(1, 1, At, B1); PG8_BAR; PG8_SCHED;
        }
        if constexpr (ALIGN_EPI) { if (wr == 0) PG8_BAR; }
        E(acc, cur, wr, wc, fr, fq);
        if (!has_next) break;
#pragma unroll
        for (int a = 0; a < 2; ++a)
#pragma unroll
            for (int b = 0; b < 2; ++b)
#pragma unroll
                for (int m = 0; m < 4; ++m)
#pragma unroll
                    for (int n = 0; n < 2; ++n) acc[a][b][m][n] = (f32x4){0.f, 0.f, 0.f, 0.f};
        cur = nxt; cB = nB; ++ui;
        { const u32x4 nv = *(const PG8_LAS u32x4*)(lds + STAGE_BYTES + 1024 + tid * 16); vA[0][0] = nv.x; vA[0][1] = nv.y; vA[1][0] = nv.z; vA[1][1] = nv.w; }
        if constexpr (ALIGN_EPI) { if (wr == 1) PG8_BAR; }
    }
    PG8_WAIT_V(0);
    if constexpr (!ALIGN_EPI) { if (wr == 0) PG8_BAR; }
    PG8_BAR;
#undef PG8_SA
#undef PG8_SB
#undef PG8_STAGE
#undef PG8_LDA
#undef PG8_LDB
#undef PG8_MMA
#undef PG8_WAIT_V
#undef PG8_WAIT_L
#undef PG8_BAR
#undef PG8_SCHED
#undef PG8_AOFFS
}
}
#define LAS __attribute__((address_space(3)))
typedef unsigned short bf16;
typedef float f32x4 __attribute__((ext_vector_type(4)));
typedef unsigned u32x4 __attribute__((ext_vector_type(4)));
typedef unsigned u32x2 __attribute__((ext_vector_type(2)));

constexpr int NWAVES = 8, NTHREADS = 512;
constexpr int DINP = 1536;
constexpr int SLOT_MAX = NT * TOPK + NE * 256;

struct Q {
    bf16 *WtIn, *WtOut, *WtGu, *WtDn, *WtQb, *WtKvb;
    bf16 *H16, *Y16, *ACT16, *K16, *V16;
};

__device__ __forceinline__ unsigned f2bf(float f) { unsigned u = __builtin_bit_cast(unsigned, f); return (u + 0x7fffu + ((u >> 16) & 1u)) >> 16; }
__device__ __forceinline__ unsigned pk2(float lo, float hi) { return f2bf(lo) | (f2bf(hi) << 16); }
__device__ __forceinline__ float bf2f(unsigned short b) { return __builtin_bit_cast(float, (unsigned)b << 16); }

__device__ __forceinline__ void transpose_item(const float* W, int N, bf16* WT, int ldk, int k0, int n0, int drow0, LAS float* scr, int lane) {
#pragma unroll 4
    for (int i = 0; i < 16; ++i) { const int kk = 4 * i + (lane >> 4), c4 = (lane & 15) * 4; const f32x4 v = *(const f32x4*)(W + (size_t)(k0 + kk) * N + n0 + c4);
        LAS float* d = scr + kk * 65 + c4; d[0] = v.x; d[1] = v.y; d[2] = v.z; d[3] = v.w; }
    asm volatile("s_waitcnt lgkmcnt(0)" ::: "memory");
#pragma unroll
    for (int j = 0; j < 8; ++j) { const int n = 8 * j + (lane >> 3), c = lane & 7; const LAS float* sp = scr + (8 * c) * 65 + n;
        u32x4 o; o.x = pk2(sp[0 * 65], sp[1 * 65]); o.y = pk2(sp[2 * 65], sp[3 * 65]); o.z = pk2(sp[4 * 65], sp[5 * 65]); o.w = pk2(sp[6 * 65], sp[7 * 65]);
        *(u32x4*)(WT + (size_t)(drow0 + n) * ldk + k0 + 8 * c) = o; }
    asm volatile("s_waitcnt lgkmcnt(0)" ::: "memory");
}
__device__ __forceinline__ void opt_convert_weights(const P& p, const Q& q, bf16* WtKvbP, LAS unsigned char* lds, int gw, int ngw, int wave, int lane) {
    LAS float* scr = (LAS float*)(lds + wave * 16640);
    constexpr int I_GU = (D / 64) * (2 * DE / 64), I_DN = (DE / 64) * (D / 64);
    constexpr int I_IN = (D / 64) * ((DIN + 63) / 64), I_OUT = (DMIX / 64) * (D / 64), I_QB = (QRANK / 64) * (768 / 64), I_KVB = (KVRANK / 64) * (1024 / 64);
    constexpr int PER_L = NE * (I_GU + I_DN) + I_IN + I_OUT + I_QB + I_KVB;
    for (int it = gw; it < DEPTH * PER_L; it += ngw) {
        const int l = it / PER_L; int r = it % PER_L;
        if (r < NE * I_GU) { const int e = r / I_GU, rr = r % I_GU, nb = 2 * DE / 64, kb = rr / nb, n0 = 64 * (rr % nb);
            const int isl = n0 >= DE, j0 = n0 - isl * DE, drow0 = 256 * (j0 / 128) + 128 * isl + (j0 % 128);
            transpose_item(p.in[I_WGU] + ((size_t)l * NE + e) * D * 2 * DE, 2 * DE, q.WtGu + ((size_t)l * NE + e) * 2 * DE * D, D, 64 * kb, n0, drow0, scr, lane); continue; } r -= NE * I_GU;
        if (r < NE * I_DN) { const int e = r / I_DN, rr = r % I_DN, nb = D / 64, kb = rr / nb, n0 = 64 * (rr % nb);
            transpose_item(p.in[I_WD] + ((size_t)l * NE + e) * DE * D, D, q.WtDn + ((size_t)l * NE + e) * D * DE, DE, 64 * kb, n0, n0, scr, lane); continue; } r -= NE * I_DN;
        if (r < I_IN) { const int nb = (DIN + 63) / 64, kb = r / nb, n0 = 64 * (r % nb);
            const int n0c = n0 + 64 <= DIN ? n0 : DIN - 64; transpose_item(p.in[I_WIN] + (size_t)l * D * DIN, DIN, q.WtIn + (size_t)l * DINP * D, D, 64 * kb, n0c, n0c, scr, lane); continue; } r -= I_IN;
        if (r < I_OUT) { const int nb = D / 64, kb = r / nb, n0 = 64 * (r % nb); transpose_item(p.in[I_WOUT] + (size_t)l * DMIX * D, D, q.WtOut + (size_t)l * D * DMIX, DMIX, 64 * kb, n0, n0, scr, lane); continue; } r -= I_OUT;
        if (r < I_QB) { const int nb = 768 / 64, kb = r / nb, n0 = 64 * (r % nb); transpose_item(p.in[I_WQB] + (size_t)l * QRANK * 768, 768, q.WtQb + (size_t)l * 768 * QRANK, QRANK, 64 * kb, n0, n0, scr, lane); continue; } r -= I_QB;
        { const int nb = 1024 / 64, kb = r / nb, n0 = 64 * (r % nb); transpose_item(p.in[I_WKVB] + (size_t)l * KVRANK * 1024, 1024, WtKvbP + (size_t)l * 1024 * 256, 256, 64 * kb, n0, n0, scr, lane); }
    }
    const long gt = (long)gw * 64 + lane, ngt = (long)ngw * 64;
    for (long i = gt; i < (long)DEPTH * (DINP - DIN) * D / 8; i += ngt) { const int l = (int)(i / ((DINP - DIN) * D / 8)); const long o = i % ((DINP - DIN) * D / 8);
        *(u32x4*)(q.WtIn + ((size_t)l * DINP + DIN) * D + o * 8) = (u32x4){0u, 0u, 0u, 0u}; }
    for (long i = gt; i < (long)DEPTH * 1024 * 16; i += ngt) *(u32x4*)(WtKvbP + (size_t)(i >> 4) * 256 + 128 + (i & 15) * 8) = (u32x4){0u, 0u, 0u, 0u};
}

struct EpiInprojF32 {
    static constexpr bool PERM = false; float* U;
    __device__ __forceinline__ void operator()(const pg8::f32x4 (&acc)[2][2][4][2], const pg8::Unit& u, int wr, int wc, int fr, int fq) const {
#pragma unroll
        for (int ai = 0; ai < 2; ++ai)
#pragma unroll
            for (int m = 0; m < 4; ++m) { const int row = u.pm * 256 + ai * 128 + wr * 64 + m * 16 + fr;
#pragma unroll
                for (int bj = 0; bj < 2; ++bj)
#pragma unroll
                    for (int n = 0; n < 2; ++n) { const int c = u.pn * 256 + bj * 128 + wc * 32 + n * 16 + 4 * fq; if (c < DIN) *(pg8::f32x4*)(U + (size_t)row * DIN + c) = acc[ai][bj][m][n]; } }
    }
};
struct EpiOutproj {
    static constexpr bool PERM = false; float* X; const float* mod;
    __device__ __forceinline__ void operator()(const pg8::f32x4 (&acc)[2][2][4][2], const pg8::Unit& u, int wr, int wc, int fr, int fq) const {
#pragma unroll
        for (int ai = 0; ai < 2; ++ai)
#pragma unroll
            for (int m = 0; m < 4; ++m) { const int row = u.pm * 256 + ai * 128 + wr * 64 + m * 16 + fr; const float* g1 = mod + ((size_t)tok_cv(row) * 6 + 2) * D;
#pragma unroll
                for (int bj = 0; bj < 2; ++bj)
#pragma unroll
                    for (int n = 0; n < 2; ++n) { const int c = u.pn * 256 + bj * 128 + wc * 32 + n * 16 + 4 * fq;
                        pg8::f32x4* xp = (pg8::f32x4*)(X + (size_t)row * D + c); const pg8::f32x4 gv = *(const pg8::f32x4*)(g1 + c); *xp = *xp + gv * acc[ai][bj][m][n]; } }
    }
};
struct GroupedOrder {
    const int* CNT; const int* LIST; const LAS int* ut;
    __device__ void init(const int* cnt, const int* list, int nN, int G, int c, LAS int* tab) { CNT = cnt; LIST = list; ut = tab + 64;
        __syncthreads();
        if (TIDX == 0) { int a = 0; for (int e = 0; e < NE; ++e) { tab[e] = a; a += (cnt[e] + 255) >> 8; } tab[NE] = a; }
        __syncthreads();
        if (TIDX < 16) { const int total = tab[NE] * nN; const long L = (long)TIDX * G + c; int pm = -1, pn = 0, e = 0, mb = 0;
            if (L < total) { int w = (int)L; { const int nx = pg8::NXCD, qq = total / nx, r = total % nx, xcd = w % nx, off = w / nx; w = (xcd < r ? xcd * (qq + 1) : r * (qq + 1) + (xcd - r) * qq) + off; }
                const int blk = w / nN, ntile = w % nN;
                for (int x = 1; x < NE; ++x) if (tab[x] <= blk) e = x;
                mb = blk - tab[e]; pm = blk; pn = e * nN + ntile; }
            tab[64 + TIDX * 4] = pm; tab[64 + TIDX * 4 + 1] = pn; tab[64 + TIDX * 4 + 2] = e; tab[64 + TIDX * 4 + 3] = mb; }
        __syncthreads(); }
    __device__ bool next(int i, pg8::Unit& u) const { if (i >= 16) return false; const int pm = ut[i * 4]; if (pm < 0) return false; u.pm = pm; u.pn = ut[i * 4 + 1]; u.e = ut[i * 4 + 2]; u.mb = ut[i * 4 + 3]; return true; }
};
struct GuOrder : GroupedOrder {
    __device__ __forceinline__ int arow(const pg8::Unit& u, int r) const { const int idx = u.mb * 256 + r; return idx < CNT[u.e] ? (LIST[(size_t)u.e * NT + idx] >> 2) : 0; }
};
struct DnOrder : GroupedOrder {
    __device__ __forceinline__ int arow(const pg8::Unit& u, int r) const { return u.pm * 256 + r; }
};
struct EpiGu {
    static constexpr bool PERM = true; bf16* ACT; const float* bgu;   int nN; int probe_skip;
    __device__ __forceinline__ void operator()(const pg8::f32x4 (&acc)[2][2][4][2], const pg8::Unit& u, int wr, int wc, int fr, int fq) const {
        if (probe_skip) return;
        const int ntile = u.pn - u.e * nN, j0 = ntile * 128 + wc * 32 + 8 * fq; const float* bg = bgu + (size_t)u.e * 2 * DE;
        float bgl[8], bli[8];
#pragma unroll
        for (int x = 0; x < 8; ++x) { bgl[x] = bg[j0 + x]; bli[x] = bg[DE + j0 + x]; }
#pragma unroll
        for (int ai = 0; ai < 2; ++ai)
#pragma unroll
            for (int m = 0; m < 4; ++m) { const int row = u.pm * 256 + ai * 128 + wr * 64 + m * 16 + fr; float a[8];
#pragma unroll
                for (int n = 0; n < 2; ++n)
#pragma unroll
                    for (int x = 0; x < 4; ++x) { const float glu = fminf(acc[ai][0][m][n][x] + bgl[4 * n + x], 7.0f), lin = fminf(fmaxf(acc[ai][1][m][n][x] + bli[4 * n + x], -7.0f), 7.0f);
                        a[4 * n + x] = glu * __builtin_amdgcn_rcpf(1.f + __builtin_amdgcn_exp2f(-2.4554669595930157f * glu)) * (lin + 1.f); }
                u32x4 w; w.x = pg8::cvt_pk_bf16(a[0], a[1]); w.y = pg8::cvt_pk_bf16(a[2], a[3]); w.z = pg8::cvt_pk_bf16(a[4], a[5]); w.w = pg8::cvt_pk_bf16(a[6], a[7]);
                *(u32x4*)(ACT + (size_t)row * DE + j0) = w; }
    }
};
struct EpiDownF32 {
    static constexpr bool PERM = false; float* YB; const float* bd;   const float* TOPG; const int* CNT; const int* LIST; int nN;
    __device__ __forceinline__ void operator()(const pg8::f32x4 (&acc)[2][2][4][2], const pg8::Unit& u, int wr, int wc, int fr, int fq) const {
        const int ntile = u.pn - u.e * nN, cnt = CNT[u.e]; const float* b = bd + (size_t)u.e * D;
#pragma unroll
        for (int ai = 0; ai < 2; ++ai)
#pragma unroll
            for (int m = 0; m < 4; ++m) { const int idx = u.mb * 256 + ai * 128 + wr * 64 + m * 16 + fr;
                if (idx < cnt) { const int pr = LIST[(size_t)u.e * NT + idx]; const float g = TOPG[pr];
#pragma unroll
                    for (int bj = 0; bj < 2; ++bj)
#pragma unroll
                        for (int n = 0; n < 2; ++n) { const int c = ntile * 256 + bj * 128 + wc * 32 + n * 16 + 4 * fq; const pg8::f32x4 bv = *(const pg8::f32x4*)(b + c);
                            *(pg8::f32x4*)(YB + (size_t)pr * D + c) = (acc[ai][bj][m][n] + bv) * g; } } }
    }
};

__device__ __forceinline__ void opt_inproj(const P& p, const Q& q, int l, LAS unsigned char* lds, int G, int bid) {
    pg8::Gemm g{q.H16, q.WtIn + (size_t)l * DINP * D, D}; pg8::StaticOrder S; S.init(NT, DINP, G, bid);
    EpiInprojF32 E{p.U}; pg8::gemm_phase<EpiInprojF32, pg8::StaticOrder, true>(lds, g, S, E);
}
struct LatentOrder : pg8::StaticOrder {
    __device__ bool next(int i, pg8::Unit& u) const { if (!pg8::StaticOrder::next(i, u)) return false; constexpr int TL = SEQ / 256, TC = CTX / 256; u.pm = (u.pm / TL) * (TL + TC) + TC + u.pm % TL; return true; }
};
__device__ __forceinline__ void opt_outproj(const P& p, const Q& q, int l, LAS unsigned char* lds, int G, int bid, bool latent_only) {
    pg8::Gemm g{q.Y16, q.WtOut + (size_t)l * D * DMIX, DMIX}; EpiOutproj E{p.X, p.MOD + (size_t)l * 3 * 6 * D};
    if (latent_only) { LatentOrder S; S.init(NB * SEQ, D, G, bid); pg8::gemm_phase<EpiOutproj, LatentOrder, true>(lds, g, S, E); }
    else { pg8::StaticOrder S; S.init(NT, D, G, bid); pg8::gemm_phase<EpiOutproj, pg8::StaticOrder, true>(lds, g, S, E); }
}
__device__ __forceinline__ void opt_moe_gu(const P& p, const Q& q, int l, LAS unsigned char* lds, int G, int bid, int probe_skip = 0) {
    pg8::Gemm g{q.H16, q.WtGu + (size_t)l * NE * 2 * DE * D, D}; GuOrder S; S.init(p.CNT, p.LIST, 2 * DE / 256, G, bid, (LAS int*)(lds + pg8::STAGE_BYTES));
    EpiGu E{q.ACT16, p.in[I_BGU] + (size_t)l * NE * 2 * DE, 2 * DE / 256, probe_skip}; pg8::gemm_phase<EpiGu, GuOrder, true>(lds, g, S, E);
}
__device__ __forceinline__ void opt_moe_down(const P& p, const Q& q, int l, LAS unsigned char* lds, int G, int bid) {
    pg8::Gemm g{q.ACT16, q.WtDn + (size_t)l * NE * D * DE, DE}; DnOrder S; S.init(p.CNT, p.LIST, D / 256, G, bid, (LAS int*)(lds + pg8::STAGE_BYTES));
    EpiDownF32 E{p.YB, p.in[I_BD] + (size_t)l * NE * D, p.TOPG, p.CNT, p.LIST, D / 256}; pg8::gemm_phase<EpiDownF32, DnOrder, true>(lds, g, S, E);
}
namespace att {
using bf16x8 = __attribute__((ext_vector_type(8))) short;
using s16x4  = __attribute__((ext_vector_type(4))) short;
using f32x16 = __attribute__((ext_vector_type(16))) float;
using f32x8  = __attribute__((ext_vector_type(8))) float;
using u32x4  = __attribute__((ext_vector_type(4))) unsigned;
constexpr int DK = 96, DV = 64, NW = 8, QBLK = 32, KVBLK = 64;
constexpr float SCALE = 0.10206207261596575f;
#ifndef ATTN_THR
#define ATTN_THR 8.f
#endif
constexpr float THR = ATTN_THR;
#ifndef ATTN_SM_SPLIT
#define ATTN_SM_SPLIT 0
#endif
constexpr int KROW = 208;
constexpr int SHM_K = KVBLK * KROW, SHM_V = KVBLK * DV * 2;
constexpr int SHM_ATTN = 2 * SHM_V + 2 * SHM_K + NW * 64 * 4;
#define KSWZ(row, colB) ((row) * KROW + (colB))
#define SBAR() __builtin_amdgcn_sched_barrier(0)
__device__ __forceinline__ int crow(int r, int hi) { return (r & 3) + 8 * (r >> 2) + 4 * hi; }
__device__ __forceinline__ unsigned cvtpk(float lo, float hi) { unsigned r; asm volatile("v_cvt_pk_bf16_f32 %0, %1, %2" : "=v"(r) : "v"(lo), "v"(hi)); return r; }
__device__ __forceinline__ bf16x8 tobf(f32x8 x) { u32x4 w = {cvtpk(x[0], x[1]), cvtpk(x[2], x[3]), cvtpk(x[4], x[5]), cvtpk(x[6], x[7])}; return *reinterpret_cast<bf16x8*>(&w); }

__device__ __forceinline__ void partialSM(f32x16& p0, f32x16& p1, float& m_reg, float& mn, float& alpha) {
  constexpr float C = SCALE * 1.4426950408889634f;
  float pmax = p0[0];
#pragma unroll
  for (int r = 1; r < 16; ++r) pmax = fmaxf(pmax, p0[r]);
#pragma unroll
  for (int r = 0; r < 16; ++r) pmax = fmaxf(pmax, p1[r]);
  { auto rr = __builtin_amdgcn_permlane32_swap(__float_as_uint(pmax), __float_as_uint(pmax), false, false);
    pmax = fmaxf(__uint_as_float(rr[0]), __uint_as_float(rr[1])); }
  if (__builtin_expect(__all(pmax - m_reg <= THR / SCALE), 1)) { mn = m_reg; alpha = 1.f; }
  else { mn = fmaxf(m_reg, pmax); alpha = __builtin_amdgcn_exp2f((m_reg - mn) * C); m_reg = mn; }
#if ATTN_SM_SPLIT
  const float mnC = -mn * C;
#pragma unroll
  for (int r = 0; r < 16; ++r) p0[r] = fmaf(p0[r], C, mnC);
#pragma unroll
  for (int r = 0; r < 16; ++r) p1[r] = fmaf(p1[r], C, mnC);
#pragma unroll
  for (int r = 0; r < 16; ++r) p0[r] = __builtin_amdgcn_exp2f(p0[r]);
#endif
}
__device__ __forceinline__ void finishSM(f32x16& p0, f32x16& p1, float mn, float alpha, float& l_reg, bf16x8& pa0, bf16x8& pa1, bf16x8& pa2, bf16x8& pa3) {
#if ATTN_SM_SPLIT
#pragma unroll
  for (int r = 0; r < 16; ++r) p1[r] = __builtin_amdgcn_exp2f(p1[r]);
#else
  { constexpr float C = SCALE * 1.4426950408889634f; const float mnC = -mn * C;
#pragma unroll
    for (int r = 0; r < 16; ++r) { p0[r] = __builtin_amdgcn_exp2f(fmaf(p0[r], C, mnC)); p1[r] = __builtin_amdgcn_exp2f(fmaf(p1[r], C, mnC)); } }
#endif
  float ps = 0;
#pragma unroll
  for (int r = 0; r < 16; ++r) ps += p0[r];
#pragma unroll
  for (int r = 0; r < 16; ++r) ps += p1[r];
  { auto rr = __builtin_amdgcn_permlane32_swap(__float_as_uint(ps), __float_as_uint(ps), false, false);
    ps = __uint_as_float(rr[0]) + __uint_as_float(rr[1]); }
  l_reg = l_reg * alpha + ps;
#define PK4(P, BASE, OUT) do { unsigned a0 = cvtpk(P[BASE + 0], P[BASE + 1]), a1 = cvtpk(P[BASE + 2], P[BASE + 3]);   \
    unsigned b0 = cvtpk(P[BASE + 4], P[BASE + 5]), b1 = cvtpk(P[BASE + 6], P[BASE + 7]);                              \
    auto r0 = __builtin_amdgcn_permlane32_swap(a0, b0, false, false); auto r1 = __builtin_amdgcn_permlane32_swap(a1, b1, false, false); \
    u32x4 w = {r0[0], r1[0], r0[1], r1[1]}; OUT = *reinterpret_cast<bf16x8*>(&w); } while (0)
  PK4(p0, 0, pa0); PK4(p0, 8, pa1); PK4(p1, 0, pa2); PK4(p1, 8, pa3);
#undef PK4
}
__device__ __forceinline__ void qkt(f32x16& p0, f32x16& p1, const char* Ks, const bf16x8* qr, int r32, int hi) {
  p0 = f32x16{}; p1 = f32x16{};
#pragma unroll
  for (int d0 = 0; d0 < DK / 16; ++d0) { const int cb = (d0 * 16 + hi * 8) * 2;
    const bf16x8 b0 = *reinterpret_cast<const bf16x8*>(Ks + KSWZ(r32, cb));
    const bf16x8 b1 = *reinterpret_cast<const bf16x8*>(Ks + KSWZ(32 + r32, cb));
    p0 = __builtin_amdgcn_mfma_f32_32x32x16_bf16(b0, qr[d0], p0, 0, 0, 0);
    p1 = __builtin_amdgcn_mfma_f32_32x32x16_bf16(b1, qr[d0], p1, 0, 0, 0); }
}
__device__ __forceinline__ int v_st(int k, int c) { const int kk = (k & ~0xC) | ((k & 4) << 1) | ((k & 8) >> 1); return ((kk >> 3) * 2 + (c >> 5)) * 512 + ((kk & 7) * 32 + (c & 31)) * 2; }
__device__ __forceinline__ int v_rd_base(int lane) { return ((lane & 3) << 3) | (((lane >> 2) & 3) << 6) | (((lane >> 4) & 1) << 5) | (((lane >> 5) & 1) << 8); }
constexpr int v_rd_off(int d0, int ks, int half) { return d0 * 512 + ks * 2048 + half * 1024; }
template <int OFF> __device__ __forceinline__ s16x4 tr_read(int vb) {
  s16x4 r; asm volatile("ds_read_b64_tr_b16 %0, %1 offset:%2" : "=&v"(r) : "v"(vb), "i"(OFF) : "memory"); return r;
}
template <int D0> __device__ __forceinline__ void pv_one(f32x16& od, int vb, bf16x8 pa0, bf16x8 pa1, bf16x8 pa2, bf16x8 pa3) {
  const s16x4 l0 = tr_read<v_rd_off(D0, 0, 0)>(vb), h0 = tr_read<v_rd_off(D0, 0, 1)>(vb), l1 = tr_read<v_rd_off(D0, 1, 0)>(vb), h1 = tr_read<v_rd_off(D0, 1, 1)>(vb);
  const s16x4 l2 = tr_read<v_rd_off(D0, 2, 0)>(vb), h2 = tr_read<v_rd_off(D0, 2, 1)>(vb), l3 = tr_read<v_rd_off(D0, 3, 0)>(vb), h3 = tr_read<v_rd_off(D0, 3, 1)>(vb);
  asm volatile("s_waitcnt lgkmcnt(0)" ::: "memory"); SBAR();
#define PK(L, H) (bf16x8){L[0], L[1], L[2], L[3], H[0], H[1], H[2], H[3]}
  od = __builtin_amdgcn_mfma_f32_32x32x16_bf16(pa0, PK(l0, h0), od, 0, 0, 0);
  od = __builtin_amdgcn_mfma_f32_32x32x16_bf16(pa1, PK(l1, h1), od, 0, 0, 0);
  od = __builtin_amdgcn_mfma_f32_32x32x16_bf16(pa2, PK(l2, h2), od, 0, 0, 0);
  od = __builtin_amdgcn_mfma_f32_32x32x16_bf16(pa3, PK(l3, h3), od, 0, 0, 0);
#undef PK
}
__device__ __forceinline__ void pv_d0(f32x16* o, int vb, bf16x8 pa0, bf16x8 pa1, bf16x8 pa2, bf16x8 pa3) {
  pv_one<0>(o[0], vb, pa0, pa1, pa2, pa3); pv_one<1>(o[1], vb, pa0, pa1, pa2, pa3);
}

template <class TQ, class Out, int VAR = 0>
__device__ __forceinline__ void attn_unit(const TQ* Qb, int ldq, const unsigned short* Kh, const unsigned short* Vh, int seq, char* lds, const Out& OUT) {
  int tid_ = TIDX; asm volatile("" : "+v"(tid_));
  const int tid = tid_, wid = tid >> 6, lane = tid & 63, r32 = lane & 31, hi = lane >> 5;
  char* V_lds = lds; char* K_lds = lds + 2 * SHM_V;
  float* ws = (float*)(lds + 2 * SHM_V + 2 * SHM_K) + wid * 64; float* li_l = ws; float* al_l = ws + 32;
  float m_reg = -1e30f, l_reg = 0; f32x16 o[2] = {}; bf16x8 qr[DK / 16];
  { const TQ* Qw = Qb + (long)(wid * QBLK + r32) * ldq + hi * 8;
#pragma unroll
    for (int d0 = 0; d0 < DK / 16; ++d0) {
      if constexpr (sizeof(TQ) == 4) qr[d0] = tobf(*reinterpret_cast<const f32x8*>(Qw + d0 * 16)); else qr[d0] = *reinterpret_cast<const bf16x8*>(Qw + d0 * 16); } }
  const int kc0 = tid, kc1 = 512 + tid; const bool two = tid < 256;
  const int kst0 = KSWZ(kc0 / 12, (kc0 % 12) * 16), kst1 = KSWZ(kc1 / 12, (kc1 % 12) * 16), vst = v_st(tid >> 3, (tid & 7) * 8);
  const int vb0 = (int)(uintptr_t)V_lds + v_rd_base(lane);
  struct { bf16x8 v, k0, k1; } sr_[2];
#define SLOAD(i, key0) do { sr_[i].v = *reinterpret_cast<const bf16x8*>(Vh + (long)(key0) * DV + tid * 8); sr_[i].k0 = *reinterpret_cast<const bf16x8*>(Kh + (long)(key0) * DK + kc0 * 8); \
    if (two) sr_[i].k1 = *reinterpret_cast<const bf16x8*>(Kh + (long)(key0) * DK + kc1 * 8); } while (0)
#define SWRITE(b, i) do { *(bf16x8*)(V_lds + (b) * SHM_V + vst) = sr_[i].v; *(bf16x8*)(K_lds + (b) * SHM_K + kst0) = sr_[i].k0; if (two) *(bf16x8*)(K_lds + (b) * SHM_K + kst1) = sr_[i].k1; } while (0)
#define RESC(a) do { if (__any((a) < 1.f)) { if (hi == 0) al_l[r32] = (a); asm volatile("s_waitcnt lgkmcnt(0)" ::: "memory"); \
    _Pragma("unroll") for (int d = 0; d < 2; ++d) _Pragma("unroll") for (int r = 0; r < 16; ++r) o[d][r] *= al_l[crow(r, hi)]; } } while (0)
  f32x16 pA0 = {}, pA1 = {}, pB0 = {}, pB1 = {}; float mnA, mnB, alA, alB; bf16x8 pa0, pa1, pa2, pa3; const int NT = seq / KVBLK;
  constexpr int SE = 0, SO = 1;
#define PSM(p0_, p1_, m_, mn_, al_) do { if constexpr (VAR == 1) { mn_ = 0.f; al_ = 1.f; } else partialSM(p0_, p1_, m_, mn_, al_); } while (0)
#define FSM(p0_, p1_, mn_, al_, l_, a0_, a1_, a2_, a3_) do { if constexpr (VAR == 1) { u32x4 w0_ = {cvtpk(p0_[0], p0_[1]), cvtpk(p0_[2], p0_[3]), cvtpk(p0_[4], p0_[5]), cvtpk(p0_[6], p0_[7])}; a0_ = *reinterpret_cast<bf16x8*>(&w0_); \
      u32x4 w1_ = {cvtpk(p0_[8], p0_[9]), cvtpk(p0_[10], p0_[11]), cvtpk(p0_[12], p0_[13]), cvtpk(p0_[14], p0_[15])}; a1_ = *reinterpret_cast<bf16x8*>(&w1_); \
      u32x4 w2_ = {cvtpk(p1_[0], p1_[1]), cvtpk(p1_[2], p1_[3]), cvtpk(p1_[4], p1_[5]), cvtpk(p1_[6], p1_[7])}; a2_ = *reinterpret_cast<bf16x8*>(&w2_); \
      u32x4 w3_ = {cvtpk(p1_[8], p1_[9]), cvtpk(p1_[10], p1_[11]), cvtpk(p1_[12], p1_[13]), cvtpk(p1_[14], p1_[15])}; a3_ = *reinterpret_cast<bf16x8*>(&w3_); } else finishSM(p0_, p1_, mn_, al_, l_, a0_, a1_, a2_, a3_); } while (0)
#define PVD(o_, vb_, a0_, a1_, a2_, a3_) do { if constexpr (VAR == 2) { asm volatile("" : "+v"(o_[0]), "+v"(o_[1]) : "v"(a0_), "v"(a1_), "v"(a2_), "v"(a3_)); } else pv_d0(o_, vb_, a0_, a1_, a2_, a3_); } while (0)
#define QKT(p0_, p1_, K_, q_, r_, h_) do { if constexpr (VAR == 5) { asm volatile("" : "+v"(p0_), "+v"(p1_)); } else qkt(p0_, p1_, K_, q_, r_, h_); } while (0)
#define LSLOAD(i_, k_) do { if constexpr (VAR != 3) SLOAD(i_, k_); } while (0)
#define LSWRITE(b_, i_) do { if constexpr (VAR != 3) SWRITE(b_, i_); } while (0)
#define LSYNC() do { if constexpr (VAR != 4) __syncthreads(); } while (0)
  SLOAD(SE, 0); asm volatile("s_waitcnt vmcnt(0)" ::: "memory"); SWRITE(0, SE); __syncthreads();
  QKT(pA0, pA1, K_lds, qr, r32, hi); PSM(pA0, pA1, m_reg, mnA, alA);
  SLOAD(SO, KVBLK); if (2 < NT) SLOAD(SE, 2 * KVBLK);
  SWRITE(1, SO); __syncthreads();
  for (int j = 1; j + 1 < NT; j += 2) {
    SBAR(); QKT(pB0, pB1, K_lds + SHM_K, qr, r32, hi);
    FSM(pA0, pA1, mnA, alA, l_reg, pa0, pa1, pa2, pa3); SBAR();
    LSLOAD(SO, (j + 2) * KVBLK); SBAR();
    PVD(o, vb0, pa0, pa1, pa2, pa3); PSM(pB0, pB1, m_reg, mnB, alB);
    LSYNC(); LSWRITE(0, SE);
    RESC(alB); LSYNC();
    SBAR(); QKT(pA0, pA1, K_lds, qr, r32, hi);
    FSM(pB0, pB1, mnB, alB, l_reg, pa0, pa1, pa2, pa3); SBAR();
    if (j + 3 < NT) LSLOAD(SE, (j + 3) * KVBLK); SBAR();
    PVD(o, vb0 + SHM_V, pa0, pa1, pa2, pa3); PSM(pA0, pA1, m_reg, mnA, alA);
    LSYNC(); LSWRITE(1, SO);
    RESC(alA); LSYNC();
  }
  SBAR(); QKT(pB0, pB1, K_lds + SHM_K, qr, r32, hi);
  FSM(pA0, pA1, mnA, alA, l_reg, pa0, pa1, pa2, pa3); SBAR();
  PVD(o, vb0, pa0, pa1, pa2, pa3); PSM(pB0, pB1, m_reg, mnB, alB);
  __syncthreads(); RESC(alB);
  FSM(pB0, pB1, mnB, alB, l_reg, pa0, pa1, pa2, pa3); SBAR();
  PVD(o, vb0 + SHM_V, pa0, pa1, pa2, pa3);
  if (hi == 0) li_l[r32] = l_reg; asm volatile("s_waitcnt lgkmcnt(0)" ::: "memory");
  float rli[16];
#pragma unroll
  for (int r = 0; r < 16; ++r) rli[r] = __builtin_amdgcn_rcpf(li_l[crow(r, hi)]);
#pragma unroll
  for (int r = 0; r < 16; ++r) { const int orow = wid * QBLK + crow(r, hi);
#pragma unroll
    for (int d0 = 0; d0 < 2; ++d0) OUT(orow, d0 * 32 + r32, o[d0][r] * rli[r]); }
  __syncthreads();
#undef SLOAD
#undef SWRITE
#undef RESC
#undef PSM
#undef FSM
#undef PVD
#undef QKT
#undef LSLOAD
#undef LSWRITE
#undef LSYNC
}
#undef KSWZ
#undef SBAR
}
struct Q2 {
    bf16* U16;
    bf16 *WtL;
    bf16 *WtM;
    bf16 *WtG;
    float *LSL;
    bf16 *HLOC, *PCUM;
    float *SA, *SB;
    bf16 *QN16, *KVN16;
    bf16 *Q16;
    bf16 *WtKvbP;
    bf16 *XCM16, *QKV16;
    float *GATES;
    float *CLOC, *NLOC, *MLB;
    bf16 *CST; float *NST, *MST;
    bf16 *YB16;
    float *GLIST;
};
constexpr int NCH = TPB / 128;
constexpr int NCH_CTX = CTX / 128;

__device__ __forceinline__ float wave_sum(float v) {
#pragma unroll
    for (int o = 1; o < 64; o <<= 1) v += __shfl_xor(v, o);
    return v;
}
__device__ __forceinline__ float fast_sigmoid(float x) { return __builtin_amdgcn_rcpf(1.f + __expf(-x)); }
__device__ __forceinline__ float fast_silu(float x) { return x * fast_sigmoid(x); }
__device__ __forceinline__ float fast_gelu(float x) { const float u = 0.7978845608028654f * (x + 0.044715f * x * x * x); return x * fast_sigmoid(2.f * u); }

struct EpiU16 {
    static constexpr bool PERM = true; bf16* U;
    __device__ __forceinline__ void operator()(const pg8::f32x4 (&acc)[2][2][4][2], const pg8::Unit& u, int wr, int wc, int fr, int fq) const {
#pragma unroll
        for (int ai = 0; ai < 2; ++ai)
#pragma unroll
            for (int m = 0; m < 4; ++m) { const int row = u.pm * 256 + ai * 128 + wr * 64 + m * 16 + fr;
#pragma unroll
                for (int bj = 0; bj < 2; ++bj) { const int c = u.pn * 256 + bj * 128 + wc * 32 + 8 * fq; const pg8::f32x4 v0 = acc[ai][bj][m][0], v1 = acc[ai][bj][m][1];
                    u32x4 w; w.x = pg8::cvt_pk_bf16(v0[0], v0[1]); w.y = pg8::cvt_pk_bf16(v0[2], v0[3]); w.z = pg8::cvt_pk_bf16(v1[0], v1[1]); w.w = pg8::cvt_pk_bf16(v1[2], v1[3]);
                    *(u32x4*)(U + (size_t)row * DINP + c) = w; } }
    }
};
__device__ __forceinline__ void opt_inproj16(const Q& q, const Q2& q2, int l, LAS unsigned char* lds, int G, int bid) {
    pg8::Gemm g{q.H16, q.WtIn + (size_t)l * DINP * D, D}; pg8::StaticOrder S; S.init(NT, DINP, G, bid);
    EpiU16 E{q2.U16}; pg8::gemm_phase<EpiU16, pg8::StaticOrder, true>(lds, g, S, E);
}

__device__ __forceinline__ void opt_convert_small(const P& p, const Q2& q2, long gtid, long nthr) {
    for (long it = gtid; it < (long)DEPTH * 4 * 256 * 64; it += nthr) { const int i = (int)(it & 63), n = (int)((it >> 6) & 255), g = (int)((it >> 14) & 3), l = (int)(it >> 16);
        const int d = n >> 7, gate = (n >> 6) & 1, j = n & 63; const float* w = (gate ? p.in[I_LWX] : p.in[I_LWA]) + ((((size_t)l * 2 + d) * 4 + g) * 64 + i) * 64 + j;
        q2.WtL[it] = (bf16)f2bf(*w); }
    for (long it = gtid; it < (long)DEPTH * 4 * 3 * 64 * 64; it += nthr) { const int i = (int)(it & 63), j = (int)((it >> 6) & 63), m = (int)((it >> 12) % 3), h = (int)((it / (3 * 4096)) & 3), l = (int)(it / (12 * 4096));
        const float* w = (m == 0 ? p.in[I_MWQ] : (m == 1 ? p.in[I_MWK] : p.in[I_MWV])) + (((size_t)l * 4 + h) * 64 + i) * 64 + j;
        q2.WtM[it] = (bf16)f2bf(*w * (m == 1 ? 0.125f : 1.f)); }
    for (long it = gtid; it < (long)DEPTH * 32 * 768; it += nthr) { const int i = (int)(it % 768), n = (int)((it / 768) & 31), l = (int)(it / (32 * 768));
        q2.WtG[it] = n < 16 ? (bf16)f2bf(p.in[I_MWG][((((size_t)l * 2 + (n >> 3)) * 768) + i) * 8 + (n & 7)]) : (bf16)0; }
    for (long it = gtid; it < (long)DEPTH * 2 * 256; it += nthr) q2.LSL[it] = logsigmoid_f(p.in[I_LLAM][it]);
}

__device__ __forceinline__ void opt_init_mod(const P& p, char* lds, int bid, int G) {
    int tid_ = TIDX; asm volatile("" : "+v"(tid_));
    const int tid = tid_; float* SC = (float*)lds; float* RED = (float*)(lds + 12288);
    for (int i = tid; i < 3 * D; i += 512) { const int cv = i / D, k = i % D; const float x = cv < 2 ? p.in[I_C][cv * D + k] : p.in[I_CCTX][k]; SC[i] = x / (1.f + __expf(-x)); }
    __syncthreads();
    for (int it = bid; it < DEPTH * 6 * D / 64; it += G) { const int l = it / (6 * D / 64), j = (it % (6 * D / 64)) * 64 + (tid & 63), kq = tid >> 6;
        const float* w = p.in[I_WMOD] + (size_t)l * D * 6 * D + (size_t)(128 * kq) * 6 * D + j; float a0 = 0.f, a1 = 0.f, a2 = 0.f;
#pragma unroll 8
        for (int k = 0; k < 128; ++k) { const float wv = w[(size_t)k * 6 * D]; a0 += SC[128 * kq + k] * wv; a1 += SC[D + 128 * kq + k] * wv; a2 += SC[2 * D + 128 * kq + k] * wv; }
        RED[(kq * 3 + 0) * 64 + (tid & 63)] = a0; RED[(kq * 3 + 1) * 64 + (tid & 63)] = a1; RED[(kq * 3 + 2) * 64 + (tid & 63)] = a2;
        __syncthreads();
        if (tid < 192) { const int cv = tid >> 6, jj = tid & 63; float sacc = p.in[I_BMOD][(size_t)l * 6 * D + (it % (6 * D / 64)) * 64 + jj];
#pragma unroll
            for (int x = 0; x < 8; ++x) sacc += RED[(x * 3 + cv) * 64 + jj];
            p.MOD[((size_t)l * 3 + cv) * 6 * D + (it % (6 * D / 64)) * 64 + jj] = sacc; }
        __syncthreads(); }
}
__device__ __forceinline__ void opt_init_rope(const P& p, long gtid, long nthr) {
    for (long it = gtid; it < (long)SEQ * 16; it += nthr) { const int s = (int)(it / 16), a = (int)((it / 8) & 1), f = (int)(it & 7); const int pos = a == 0 ? s / GRID_W : s % GRID_W;
        const float frf = (float)pow(10000.0, -(double)f / 8.0); const double ang = (double)((float)pos * frf);
        p.ROPET[it * 2] = (float)cos(ang); p.ROPET[it * 2 + 1] = (float)sin(ang); }
}

template <int KS, class TA, class TB>
__device__ __forceinline__ void wave_mm32(att::f32x16& acc, const TA* A, int lda, const TB* B, int ldb, int r32, int hi) {
#pragma unroll
    for (int ks = 0; ks < KS; ++ks) {
        const att::bf16x8 a = *reinterpret_cast<const att::bf16x8*>(A + (size_t)r32 * lda + ks * 16 + hi * 8);
        const att::bf16x8 b = *reinterpret_cast<const att::bf16x8*>(B + (size_t)r32 * ldb + ks * 16 + hi * 8);
        acc = __builtin_amdgcn_mfma_f32_32x32x16_bf16(a, b, acc, 0, 0, 0);
    }
}

constexpr int LRU1_LDS = 18432 + 65536 + 4096;
template <class UL>
__device__ __forceinline__ void lru1_item(const P& p, const Q2& q2, int l, int b, int ch, int g, char* lds, const UL& U) {
    int tid_ = TIDX; asm volatile("" : "+v"(tid_));
    const int tid = tid_, wave = tid >> 6, lane = tid & 63, r32 = lane & 31, hi = lane >> 5;
    unsigned short* XC16 = (unsigned short*)lds; float* AB = (float*)(lds + 18432); float* CMP = (float*)(lds + 18432 + 65536);
    const int t0 = b * TPB + ch * 128, seg_lo = ch < NCH_CTX ? b * TPB : b * TPB + CTX, seg_hi = ch < NCH_CTX ? b * TPB + CTX : (b + 1) * TPB;
    { const int j = tid & 63, c = g * 64 + j, tb = (tid >> 6) * 16; const float* cw = p.in[I_LCW] + (size_t)l * 4 * 256 + c; const float w0 = cw[0], w1 = cw[256], w2 = cw[512], w3 = cw[768], cb = p.in[I_LCB][(size_t)l * 256 + c];
      float xm2 = (t0 + tb - 2 >= seg_lo) ? U(t0 + tb - 2, OFF_AX + c) : 0.f, xm1 = (t0 + tb - 1 >= seg_lo) ? U(t0 + tb - 1, OFF_AX + c) : 0.f, x0 = U(t0 + tb, OFF_AX + c);
#pragma unroll 4
      for (int i = 0; i < 16; ++i) { const int t = t0 + tb + i; const float xp1 = (t + 1 < seg_hi) ? U(t + 1, OFF_AX + c) : 0.f;
          const float v = cb + w0 * xm2 + w1 * xm1 + w2 * x0 + w3 * xp1; XC16[(tb + i) * 72 + j] = (unsigned short)f2bf(v); xm2 = xm1; xm1 = x0; x0 = xp1; } }
    __syncthreads();
    const bf16* Wt = q2.WtL + ((size_t)l * 4 + g) * 256 * 64;
#pragma unroll 1
    for (int d = 0; d < 2; ++d) {
        const int rt = wave & 3, cj = wave >> 2; att::f32x16 ar = {}, ai = {};
        wave_mm32<4>(ar, XC16 + rt * 32 * 72, 72, Wt + (size_t)(d * 128 + cj * 32) * 64, 64, r32, hi);
        wave_mm32<4>(ai, XC16 + rt * 32 * 72, 72, Wt + (size_t)(d * 128 + 64 + cj * 32) * 64, 64, r32, hi);
        { const int j = cj * 32 + r32, c = g * 64 + j; const float ba = p.in[I_LBA][((size_t)l * 2 + d) * 256 + c], bx = p.in[I_LBX][((size_t)l * 2 + d) * 256 + c], lsl = q2.LSL[((size_t)l * 2 + d) * 256 + c];
#pragma unroll
          for (int r = 0; r < 16; ++r) { const int tt = rt * 32 + att::crow(r, hi); const float rg = fast_sigmoid(ar[r] + ba), ig = fast_sigmoid(ai[r] + bx), la = 8.f * rg * lsl, a = __expf(la);
              const float xc = bf2f(XC16[tt * 72 + j]); const float bb = sqrtf(fmaxf(1.f - a * a, 0.f)) * ig * xc;
              AB[(tt * 64 + j) * 2] = a; AB[(tt * 64 + j) * 2 + 1] = bb; } }
        __syncthreads();
        { const int j = tid & 63, sg = tid >> 6; float av[16], bv[16]; float A = 1.f, B = 0.f;
#pragma unroll
          for (int i = 0; i < 16; ++i) { const int s = sg * 16 + i, tt = d == 0 ? s : 127 - s; av[i] = AB[(tt * 64 + j) * 2]; bv[i] = AB[(tt * 64 + j) * 2 + 1]; B = av[i] * B + bv[i]; A *= av[i]; }
          CMP[(sg * 64 + j) * 2] = A; CMP[(sg * 64 + j) * 2 + 1] = B;
          __syncthreads();
          float cA = 1.f, cB = 0.f;
          for (int x = 0; x < sg; ++x) { const float xa = CMP[(x * 64 + j) * 2], xb = CMP[(x * 64 + j) * 2 + 1]; cB = xa * cB + xb; cA *= xa; }
          const int c = g * 64 + j; float h = cB, pc = cA;
#pragma unroll
          for (int i = 0; i < 16; ++i) { const int s = sg * 16 + i, tt = d == 0 ? s : 127 - s; h = av[i] * h + bv[i]; pc *= av[i];
              q2.HLOC[((size_t)d * NT + t0 + tt) * 256 + c] = (bf16)f2bf(h); q2.PCUM[((size_t)d * NT + t0 + tt) * 256 + c] = (bf16)f2bf(pc); }
          if (sg == 7) { q2.SA[(((size_t)d * NB + b) * NCH + ch) * 256 + c] = pc; q2.SB[(((size_t)d * NB + b) * NCH + ch) * 256 + c] = h; } }
        __syncthreads();
    }
}
template <class UL, class YS>
__device__ __forceinline__ void lru2_item(const Q2& q2, int b, int ch, char* lds, const UL& U, const YS& Y) {
    int tid_ = TIDX; asm volatile("" : "+v"(tid_));
    const int tid = tid_; float* CAR = (float*)lds;
    { const int d = tid >> 8, c = tid & 255; float h = 0.f;
      if (d == 0) { for (int j = 0; j < ch; ++j) h = q2.SA[(((size_t)0 * NB + b) * NCH + j) * 256 + c] * h + q2.SB[(((size_t)0 * NB + b) * NCH + j) * 256 + c]; }
      else { const bool isctx = ch < NCH_CTX;
          for (int j = NCH_CTX - 1; j >= (isctx ? ch + 1 : 0); --j) h = q2.SA[(((size_t)1 * NB + b) * NCH + j) * 256 + c] * h + q2.SB[(((size_t)1 * NB + b) * NCH + j) * 256 + c];
          if (!isctx) for (int j = NCH - 1; j > ch; --j) h = q2.SA[(((size_t)1 * NB + b) * NCH + j) * 256 + c] * h + q2.SB[(((size_t)1 * NB + b) * NCH + j) * 256 + c]; }
      CAR[tid] = h; }
    __syncthreads();
    const int t0 = b * TPB + ch * 128, c = tid & 255; const float c0 = CAR[c], c1 = CAR[256 + c];
#pragma unroll 4
    for (int i = 0; i < 64; ++i) { const int t = t0 + (tid >> 8) + 2 * i;
        const float hf = bf2f(q2.HLOC[(size_t)t * 256 + c]) + bf2f(q2.PCUM[(size_t)t * 256 + c]) * c0, hb = bf2f(q2.HLOC[((size_t)NT + t) * 256 + c]) + bf2f(q2.PCUM[((size_t)NT + t) * 256 + c]) * c1;
        Y(t, c, (hf + hb) * fast_gelu(U(t, OFF_AG + c))); }
    __syncthreads();
}

template <class UL>
__device__ __forceinline__ void mla_prep_token(const P& p, const Q& q, const Q2& q2, int l, int t, int lane, const UL& U) {
    float xq[4], xk[2]; float sq = 0.f, sk = 0.f;
#pragma unroll
    for (int i = 0; i < 4; ++i) { xq[i] = U(t, OFF_BQ + lane * 4 + i); sq += xq[i] * xq[i]; }
#pragma unroll
    for (int i = 0; i < 2; ++i) { xk[i] = U(t, OFF_BKV + lane * 2 + i); sk += xk[i] * xk[i]; }
    sq = wave_sum(sq); sk = wave_sum(sk);
    const float rq = 1.f / sqrtf(sq * (1.f / QRANK) + EPS), rk = 1.f / sqrtf(sk * (1.f / KVRANK) + EPS);
    const float* gq = p.in[I_QNG] + (size_t)l * QRANK + lane * 4; const float* gk = p.in[I_KVNG] + (size_t)l * KVRANK + lane * 2;
    u32x2 wq; wq.x = pk2(xq[0] * rq * gq[0], xq[1] * rq * gq[1]); wq.y = pk2(xq[2] * rq * gq[2], xq[3] * rq * gq[3]);
    *(u32x2*)(q2.QN16 + (size_t)t * 256 + lane * 4) = wq;
    *(unsigned*)(q2.KVN16 + (size_t)t * 256 + lane * 2) = pk2(xk[0] * rk * gk[0], xk[1] * rk * gk[1]);
    *(unsigned*)(q2.KVN16 + (size_t)t * 256 + 128 + lane * 2) = 0u;
    const int b = t / TPB, key = t % TPB, h = lane >> 3, d0 = (lane & 7) * 4; const bool lat = key >= CTX; const int s = key - CTX;
    float o[4];
#pragma unroll
    for (int i = 0; i < 4; ++i) { const int dd = d0 + i, a = dd >> 4, half = (dd >> 3) & 1, f = dd & 7; const float me = U(t, OFF_BKR + dd), other = U(t, OFF_BKR + (dd ^ 8));
        float cs = 1.f, sn = 0.f; if (lat) { cs = p.ROPET[(((size_t)s * 2 + a) * 8 + f) * 2]; sn = p.ROPET[(((size_t)s * 2 + a) * 8 + f) * 2 + 1]; }
        o[i] = half == 0 ? me * cs - other * sn : me * cs + other * sn; }
    u32x2 wk; wk.x = pk2(o[0], o[1]); wk.y = pk2(o[2], o[3]);
    *(u32x2*)(q.K16 + (((size_t)b * AH + h) * TPB + key) * QKD + NOPE + d0) = wk;
}

struct EpiQproj {
    static constexpr bool PERM = true; bf16* Q16; const float* ROPET;
    __device__ __forceinline__ void operator()(const pg8::f32x4 (&acc)[2][2][4][2], const pg8::Unit& u, int wr, int wc, int fr, int fq) const {
#pragma unroll
        for (int bj = 0; bj < 2; ++bj) { const int blk = u.pn * 8 + bj * 4 + wc; const bool rope = (blk % 3) == 2; const int c = blk * 32 + 8 * fq;
#pragma unroll
            for (int ai = 0; ai < 2; ++ai)
#pragma unroll
                for (int m = 0; m < 4; ++m) { const int row = u.pm * 256 + ai * 128 + wr * 64 + m * 16 + fr; float v[8];
#pragma unroll
                    for (int x = 0; x < 4; ++x) { v[x] = acc[ai][bj][m][0][x]; v[4 + x] = acc[ai][bj][m][1][x]; }
                    if (rope) {
                        const int key = (u.pm % (TPB / 256)) * 256 + ai * 128 + wr * 64 + m * 16 + fr; const bool lat = key >= CTX; const int s = lat ? key - CTX : 0, a = fq >> 1; const float* tb = ROPET + ((size_t)s * 2 + a) * 16;
#pragma unroll
                        for (int x = 0; x < 8; ++x) { const float other = __shfl_xor(v[x], 16); const float cs = lat ? tb[x * 2] : 1.f, sn = lat ? tb[x * 2 + 1] : 0.f;
                            v[x] = (fq & 1) == 0 ? v[x] * cs - other * sn : v[x] * cs + other * sn; } }
                    u32x4 w; w.x = pg8::cvt_pk_bf16(v[0], v[1]); w.y = pg8::cvt_pk_bf16(v[2], v[3]); w.z = pg8::cvt_pk_bf16(v[4], v[5]); w.w = pg8::cvt_pk_bf16(v[6], v[7]);
                    *(u32x4*)(Q16 + (size_t)row * 768 + c) = w; asm volatile("" ::: "memory"); } }
    }
};
struct EpiKVproj {
    static constexpr bool PERM = true; bf16* K16; bf16* V16;
    __device__ __forceinline__ void operator()(const pg8::f32x4 (&acc)[2][2][4][2], const pg8::Unit& u, int wr, int wc, int fr, int fq) const {
#pragma unroll
        for (int bj = 0; bj < 2; ++bj) { const int h = u.pn * 2 + bj, dcol = wc * 32 + 8 * fq; const bool isv = dcol >= 64;
#pragma unroll
            for (int ai = 0; ai < 2; ++ai)
#pragma unroll
                for (int m = 0; m < 4; ++m) { const int b = u.pm / (TPB / 256), key = (u.pm % (TPB / 256)) * 256 + ai * 128 + wr * 64 + m * 16 + fr; const pg8::f32x4 v0 = acc[ai][bj][m][0], v1 = acc[ai][bj][m][1];
                    u32x4 w; w.x = pg8::cvt_pk_bf16(v0[0], v0[1]); w.y = pg8::cvt_pk_bf16(v0[2], v0[3]); w.z = pg8::cvt_pk_bf16(v1[0], v1[1]); w.w = pg8::cvt_pk_bf16(v1[2], v1[3]);
                    bf16* dst = isv ? V16 + (((size_t)b * AH + h) * TPB + key) * VD + (dcol - 64) : K16 + (((size_t)b * AH + h) * TPB + key) * QKD + dcol;
                    *(u32x4*)dst = w; asm volatile("" ::: "memory"); } }
    }
};
__device__ __forceinline__ void opt_mla_proj(const P& p, const Q& q, const Q2& q2, int l, LAS unsigned char* lds, int G, int bid) {
    { pg8::Gemm g{q2.QN16, q.WtQb + (size_t)l * 768 * QRANK, QRANK}; pg8::StaticOrder S; S.init(NT, 768, G, bid);
      EpiQproj E{q2.Q16, p.ROPET}; pg8::gemm_phase<EpiQproj, pg8::StaticOrder, true>(lds, g, S, E); }
    { pg8::Gemm g{q2.KVN16, q2.WtKvbP + (size_t)l * 1024 * 256, 256}; pg8::StaticOrder S; S.init(NT, 1024, G, (bid + 198) % G);
      EpiKVproj E{q.K16, q.V16}; pg8::gemm_phase<EpiKVproj, pg8::StaticOrder, true>(lds, g, S, E); }
}
__device__ __forceinline__ int ord_len(int d, int ch) { return d == 0 ? ch : (ch < NCH_CTX ? NCH_CTX - 1 - ch : NCH_CTX + (NCH - 1 - ch)); }
__device__ __forceinline__ int ord_chunk(int d, int ch, int i) { return d == 0 ? i : (i < (ch < NCH_CTX ? NCH_CTX - 1 - ch : NCH_CTX) ? NCH_CTX - 1 - i : NCH - 1 - (i - NCH_CTX)); }

__device__ __forceinline__ void wave_scan_add128(float& x0, float& x1, int lane) {
#pragma unroll
    for (int off = 1; off < 64; off <<= 1) { const float y0 = __shfl_up(x0, off), y1 = __shfl_up(x1, off); if (lane >= off) { x0 += y0; x1 += y1; } }
    x1 += __shfl(x0, 63);
}
__device__ __forceinline__ void wave_scan_max128(float& x0, float& x1, int lane) {
#pragma unroll
    for (int off = 1; off < 64; off <<= 1) { const float y0 = __shfl_up(x0, off), y1 = __shfl_up(x1, off); if (lane >= off) { x0 = fmaxf(x0, y0); x1 = fmaxf(x1, y1); } }
    x1 = fmaxf(x1, __shfl(x0, 63));
}
__device__ __forceinline__ float wave_max(float v) {
#pragma unroll
    for (int o = 1; o < 64; o <<= 1) v = fmaxf(v, __shfl_xor(v, o));
    return v;
}

constexpr int ML1_LDS = 116736;
template <class UL>
__device__ __forceinline__ void ml1_item(const P& p, const Q2& q2, int l, int b, int ch, char* lds, const UL& U) {
    int tid_ = TIDX; asm volatile("" : "+v"(tid_));
    const int tid = tid_, wave = tid >> 6, lane = tid & 63, r32 = lane & 31, hi = lane >> 5;
    unsigned short* XCh = (unsigned short*)lds; unsigned short* UXh = (unsigned short*)(lds + 18432); unsigned short* QKVh = (unsigned short*)(lds + 36864);
    float* GP = (float*)(lds + 92160); float* GT = (float*)(lds + 108544);
    const int t0 = b * TPB + ch * 128, seg_lo = ch < NCH_CTX ? b * TPB : b * TPB + CTX, seg_hi = ch < NCH_CTX ? b * TPB + CTX : (b + 1) * TPB;
    const int rt = wave & 3, wh = wave >> 2;
    att::f32x16 gacc = {};
#pragma unroll 1
    for (int h = 0; h < 4; ++h) {
        { const int j = tid & 63, c = h * 64 + j, tb = (tid >> 6) * 16; const float* cw = p.in[I_MCW] + (size_t)l * 4 * 256 + c; const float w0 = cw[0], w1 = cw[256], w2 = cw[512], w3 = cw[768], cb = p.in[I_MCB][(size_t)l * 256 + c];
          float xm2 = (t0 + tb - 2 >= seg_lo) ? U(t0 + tb - 2, OFF_MX + c) : 0.f, xm1 = (t0 + tb - 1 >= seg_lo) ? U(t0 + tb - 1, OFF_MX + c) : 0.f, x0 = U(t0 + tb, OFF_MX + c);
#pragma unroll 4
          for (int i = 0; i < 16; ++i) { const int t = t0 + tb + i; const float xp1 = (t + 1 < seg_hi) ? U(t + 1, OFF_MX + c) : 0.f;
              const float v = fast_silu(cb + w0 * xm2 + w1 * xm1 + w2 * x0 + w3 * xp1); const unsigned short vb = (unsigned short)f2bf(v);
              XCh[(tb + i) * 72 + j] = vb; UXh[(tb + i) * 72 + j] = (unsigned short)f2bf(x0); q2.XCM16[(size_t)t * 256 + c] = vb; xm2 = xm1; xm1 = x0; x0 = xp1; } }
        __syncthreads();
        { const bf16* Wm = q2.WtM + ((size_t)l * 4 + h) * 3 * 4096;
#pragma unroll
          for (int m = 0; m < 3; ++m) { att::f32x16 a = {};
              wave_mm32<4>(a, (m == 2 ? UXh : XCh) + rt * 32 * 72, 72, Wm + (size_t)m * 4096 + (size_t)wh * 32 * 64, 64, r32, hi);
#pragma unroll
              for (int r = 0; r < 16; ++r) { const int tt = rt * 32 + att::crow(r, hi); const unsigned short vb = (unsigned short)f2bf(a[r]);
                  QKVh[(m * 128 + tt) * 72 + wh * 32 + r32] = vb; q2.QKV16[(size_t)(t0 + tt) * 768 + m * 256 + h * 64 + wh * 32 + r32] = vb; } } }
        __syncthreads();
        { const bf16* Wg = q2.WtG + (size_t)l * 32 * 768;
#pragma unroll
          for (int x = 0; x < 6; ++x) { const int idx = wh * 6 + x, m = idx >> 2, ks = idx & 3;
              const att::bf16x8 a = *reinterpret_cast<const att::bf16x8*>(QKVh + (m * 128 + rt * 32 + r32) * 72 + ks * 16 + hi * 8);
              const att::bf16x8 bb = *reinterpret_cast<const att::bf16x8*>(Wg + (size_t)r32 * 768 + m * 256 + h * 64 + ks * 16 + hi * 8);
              gacc = __builtin_amdgcn_mfma_f32_32x32x16_bf16(a, bb, gacc, 0, 0, 0); } }
        __syncthreads();
    }
    if (r32 < 16) {
#pragma unroll
        for (int r = 0; r < 16; ++r) GP[(wh * 128 + rt * 32 + att::crow(r, hi)) * 16 + r32] = gacc[r]; }
    __syncthreads();
    for (int i = tid; i < 128 * 16; i += 512) { const int n = i & 15, d = n >> 3, g = n & 7; float v = GP[i] + GP[128 * 16 + i] + p.in[I_MBG][((size_t)l * 2 + d) * 8 + g];
        if (g >= 4) v = fminf(v, 0.f) - __logf(1.f + __expf(-fabsf(v)));
        GT[i] = v; q2.GATES[(size_t)(t0 + (i >> 4)) * 16 + n] = v; }
    __syncthreads();
    unsigned short* KT = (unsigned short*)lds; unsigned short* VT = (unsigned short*)(lds + 17408); float* WR = (float*)(lds + 52224); float* MB = (float*)(lds + 53248); float* WE = (float*)(lds + 53280);
#pragma unroll 1
    for (int h = 0; h < 4; ++h) {
        if (wave < 2) { const int d = wave, ta = d == 0 ? lane : 127 - lane, tb = d == 0 ? lane + 64 : 63 - lane;
            float b0 = GT[ta * 16 + d * 8 + 4 + h], b1 = GT[tb * 16 + d * 8 + 4 + h]; wave_scan_add128(b0, b1, lane);
            const float bL = __shfl(b1, 63), w0 = bL - b0 + GT[ta * 16 + d * 8 + h], w1 = bL - b1 + GT[tb * 16 + d * 8 + h];
            WR[d * 128 + ta] = w0; WR[d * 128 + tb] = w1; const float mx = wave_max(fmaxf(w0, w1));
            if (lane == 0) { MB[d * 2] = mx; MB[d * 2 + 1] = bL; } }
        __syncthreads();
        { const int tt = tid & 127, jg = tid >> 7; const float w0 = __expf(WR[tt] - MB[0]), w1 = __expf(WR[128 + tt] - MB[2]);
          const unsigned short* ksrc = (const unsigned short*)q2.QKV16 + (size_t)(t0 + tt) * 768 + 256 + h * 64 + jg * 16; const unsigned short* vsrc = ksrc + 256;
          const att::bf16x8 k0 = *reinterpret_cast<const att::bf16x8*>(ksrc), k1 = *reinterpret_cast<const att::bf16x8*>(ksrc + 8), v0 = *reinterpret_cast<const att::bf16x8*>(vsrc), v1 = *reinterpret_cast<const att::bf16x8*>(vsrc + 8);
#pragma unroll
          for (int i = 0; i < 8; ++i) { KT[(jg * 16 + i) * 136 + tt] = (unsigned short)k0[i]; KT[(jg * 16 + 8 + i) * 136 + tt] = (unsigned short)k1[i];
              const float va = bf2f((unsigned short)v0[i]), vb = bf2f((unsigned short)v1[i]);
              VT[(jg * 16 + i) * 136 + tt] = (unsigned short)f2bf(va * w0); VT[(jg * 16 + 8 + i) * 136 + tt] = (unsigned short)f2bf(vb * w0);
              VT[(64 + jg * 16 + i) * 136 + tt] = (unsigned short)f2bf(va * w1); VT[(64 + jg * 16 + 8 + i) * 136 + tt] = (unsigned short)f2bf(vb * w1); }
          if (tid < 128) WE[tid] = w0; else if (tid < 256) WE[tid] = w1; }
        __syncthreads();
        { const int d = wave >> 2, vt = (wave >> 1) & 1, kt = wave & 1; att::f32x16 c = {};
          wave_mm32<8>(c, VT + (size_t)(d * 64 + vt * 32) * 136, 136, KT + (size_t)kt * 32 * 136, 136, r32, hi);
          float* dst = q2.CLOC + ((((size_t)d * NB + b) * NCH + ch) * 4 + h) * 4096;
#pragma unroll
          for (int r = 0; r < 16; ++r) dst[(vt * 32 + att::crow(r, hi)) * 64 + kt * 32 + r32] = c[r];
          if (tid < 128) { const int dd = tid >> 6, k = tid & 63; float s = 0.f; for (int tt = 0; tt < 128; ++tt) s += WE[dd * 128 + tt] * bf2f(KT[k * 136 + tt]);
              q2.NLOC[((((size_t)dd * NB + b) * NCH + ch) * 4 + h) * 64 + k] = s; }
          if (tid < 2) { float* mb = q2.MLB + ((((size_t)tid * NB + b) * NCH + ch) * 4 + h) * 2; mb[0] = MB[tid * 2]; mb[1] = MB[tid * 2 + 1]; } }
        __syncthreads();
    }
}

__device__ __forceinline__ void ml_scan_item(const Q2& q2, int item, char* lds) {
    int tid_ = TIDX; asm volatile("" : "+v"(tid_));
    const int tid = tid_, vq = item & 3, h = (item >> 2) & 3, b = (item >> 4) & 1, d = item >> 5;
    float* MLs = (float*)lds; float* MSEQ = MLs + 2 * NCH + 16;
    for (int i = tid; i < NCH; i += 512) { const float* mb = q2.MLB + ((((size_t)d * NB + b) * NCH + ord_chunk(d, NCH, i)) * 4 + h) * 2; MLs[2 * i] = mb[0]; MLs[2 * i + 1] = mb[1]; }
    __syncthreads();
    if (tid == 0) { float m = 0.f; for (int i = 0; i < NCH; ++i) { MSEQ[i] = m; m = fmaxf(MLs[2 * i + 1] + m, MLs[2 * i]); } MSEQ[NCH] = m; }
    __syncthreads();
    const int e0 = vq * 1024 + tid * 2; float c0 = 0.f, c1 = 0.f, nn = 0.f; const bool don = (vq == 0 && tid < 64);
#pragma unroll 4
    for (int i = 0; i < NCH; ++i) { const int j = ord_chunk(d, NCH, i); const size_t idx = (((size_t)d * NB + b) * NCH + j) * 4 + h;
        *(unsigned*)(q2.CST + idx * 4096 + e0) = pk2(c0, c1);
        if (don) q2.NST[idx * 64 + tid] = nn;
        if (vq == 0 && tid == 64) q2.MST[idx] = MSEQ[i];
        const float m = MSEQ[i], mn = MSEQ[i + 1], dec = __expf(MLs[2 * i + 1] + m - mn), sc = __expf(MLs[2 * i] - mn);
        const float2 cl = *(const float2*)(q2.CLOC + idx * 4096 + e0); c0 = dec * c0 + sc * cl.x; c1 = dec * c1 + sc * cl.y;
        if (don) nn = dec * nn + sc * q2.NLOC[idx * 64 + tid]; }
    __syncthreads();
}

constexpr int ML2_LDS = 145536;
template <class UL, class YS>
__device__ __forceinline__ void ml2_item(const P& p, const Q2& q2, int l, int b, int ch, int h, char* lds, const UL& U, const YS& Y) {
    int tid_ = TIDX; asm volatile("" : "+v"(tid_));
    const int tid = tid_, wave = tid >> 6, lane = tid & 63, r32 = lane & 31, hi = lane >> 5;
    char* Ks = lds; char* Vs = lds + 32768; unsigned short* C0 = (unsigned short*)(lds + 49152); float* N0 = (float*)(lds + 67584); float* ROWV = (float*)(lds + 68096);
    float* COEF = (float*)(lds + 73216); float* M0 = (float*)(lds + 73792); float* WS = (float*)(lds + 73856) + wave * 64; float* HX = (float*)(lds + 75904);
    const int t0 = b * TPB + ch * 128;
    { const unsigned short* base = (const unsigned short*)q2.QKV16 + (size_t)t0 * 768 + h * 64;
#pragma unroll
      for (int x = 0; x < 2; ++x) { const int cidx = tid + x * 512, key = cidx >> 3, c8 = cidx & 7, tile = key >> 6, kk = key & 63;
          const att::bf16x8 kv = *reinterpret_cast<const att::bf16x8*>(base + (size_t)key * 768 + 256 + c8 * 8), vv = *reinterpret_cast<const att::bf16x8*>(base + (size_t)key * 768 + 512 + c8 * 8);
          *(att::bf16x8*)(Ks + tile * 16384 + (kk * 256 + ((c8 * 16) ^ ((kk & 7) << 4)))) = kv;
          *(att::bf16x8*)(Vs + tile * 8192 + att::v_st(kk, c8 * 8)) = vv; } }
    if (wave < 2) { const int d = wave, ta = d == 0 ? lane : 127 - lane, tb = d == 0 ? lane + 64 : 63 - lane;
        float* g = ROWV + (d * 5 + 0) * 128; float* pmv = ROWV + (d * 5 + 1) * 128; float* bv = ROWV + (d * 5 + 2) * 128;
        const float iga = q2.GATES[(size_t)(t0 + ta) * 16 + d * 8 + h], igb = q2.GATES[(size_t)(t0 + tb) * 16 + d * 8 + h];
        float b0 = q2.GATES[(size_t)(t0 + ta) * 16 + d * 8 + 4 + h], b1 = q2.GATES[(size_t)(t0 + tb) * 16 + d * 8 + 4 + h]; wave_scan_add128(b0, b1, lane);
        const float g0 = iga - b0, g1 = igb - b1; float p0 = g0, p1 = g1; wave_scan_max128(p0, p1, lane);
        g[ta] = g0; g[tb] = g1; pmv[ta] = p0; pmv[tb] = p1; bv[ta] = b0; bv[tb] = b1; }
    __syncthreads();
    { const int d = tid >> 8, e0 = (tid & 255) * 16; const size_t idx = (((size_t)d * NB + b) * NCH + ch) * 4 + h;
      const u32x4* src = (const u32x4*)(q2.CST + idx * 4096 + e0); const u32x4 w0 = src[0], w1 = src[1];
      { const int v = e0 >> 6, k = e0 & 63; unsigned short* dst = C0 + (d * 64 + v) * 72 + k; *(u32x4*)dst = w0; *(u32x4*)(dst + 8) = w1; }
      if (tid < 128) { const int nd = tid >> 6, nk = tid & 63; N0[nd * 64 + nk] = q2.NST[((((size_t)nd * NB + b) * NCH + ch) * 4 + h) * 64 + nk]; }
      if (tid < 2) M0[tid] = q2.MST[(((size_t)tid * NB + b) * NCH + ch) * 4 + h]; }
    __syncthreads();
    {
      if (tid < 256) { const int dd = tid >> 7, tt = tid & 127; const float m0 = M0[dd], M = fmaxf(m0, ROWV[(dd * 5 + 1) * 128 + tt]);
          ROWV[(dd * 5 + 1) * 128 + tt] = M; ROWV[(dd * 5 + 3) * 128 + tt] = __expf(m0 - M); ROWV[(dd * 5 + 4) * 128 + tt] = __expf(-(ROWV[(dd * 5 + 2) * 128 + tt] + M)); } }
    __syncthreads();
    { const int qb = wave & 3, d = wave >> 2; const float* g = ROWV + (d * 5 + 0) * 128; const float* Mv = ROWV + (d * 5 + 1) * 128; const float* wiv = ROWV + (d * 5 + 3) * 128; const float* emtv = ROWV + (d * 5 + 4) * 128;
      att::bf16x8 qr[4]; const int sq = qb * 32 + r32;
      { const unsigned short* qw = (const unsigned short*)q2.QKV16 + (size_t)(t0 + sq) * 768 + h * 64 + hi * 8;
#pragma unroll
        for (int d0 = 0; d0 < 4; ++d0) qr[d0] = *reinterpret_cast<const att::bf16x8*>(qw + d0 * 16); }
      const float Ms = Mv[sq] * 1.4426950408889634f; att::f32x16 o[2] = {}; float rs = 0.f;
      const int vb0 = (int)(uintptr_t)Vs + att::v_rd_base(lane);
#pragma unroll
      for (int kt = 0; kt < 2; ++kt) {
          const bool skip = d == 0 ? (kt == 1 && qb < 2) : (kt == 0 && qb >= 2);
          if (!skip) {
              att::f32x16 p0 = {}, p1 = {}; const char* Kt = Ks + kt * 16384;
#pragma unroll
              for (int d0 = 0; d0 < 4; ++d0) { const int cb = (d0 * 16 + hi * 8) * 2;
                  const att::bf16x8 b0 = *reinterpret_cast<const att::bf16x8*>(Kt + (r32 * 256 + (cb ^ ((r32 & 7) << 4))));
                  const att::bf16x8 b1 = *reinterpret_cast<const att::bf16x8*>(Kt + ((32 + r32) * 256 + (cb ^ ((r32 & 7) << 4))));
                  p0 = __builtin_amdgcn_mfma_f32_32x32x16_bf16(b0, qr[d0], p0, 0, 0, 0); p1 = __builtin_amdgcn_mfma_f32_32x32x16_bf16(b1, qr[d0], p1, 0, 0, 0); }
#pragma unroll
              for (int r = 0; r < 16; ++r) { const int k0 = kt * 64 + att::crow(r, hi), k1 = k0 + 32;
                  const bool ok0 = d == 0 ? k0 <= sq : k0 >= sq, ok1 = d == 0 ? k1 <= sq : k1 >= sq;
                  p0[r] = ok0 ? p0[r] * __builtin_amdgcn_exp2f(g[k0] * 1.4426950408889634f - Ms) : 0.f; p1[r] = ok1 ? p1[r] * __builtin_amdgcn_exp2f(g[k1] * 1.4426950408889634f - Ms) : 0.f;
                  rs += p0[r] + p1[r]; }
              att::bf16x8 pa0, pa1, pa2, pa3;
#define PK4(P, BASE, OUT) do { unsigned a0 = att::cvtpk(P[BASE + 0], P[BASE + 1]), a1 = att::cvtpk(P[BASE + 2], P[BASE + 3]);   \
    unsigned b0 = att::cvtpk(P[BASE + 4], P[BASE + 5]), b1 = att::cvtpk(P[BASE + 6], P[BASE + 7]);                              \
    auto r0 = __builtin_amdgcn_permlane32_swap(a0, b0, false, false); auto r1 = __builtin_amdgcn_permlane32_swap(a1, b1, false, false); \
    att::u32x4 w = {r0[0], r1[0], r0[1], r1[1]}; OUT = *reinterpret_cast<att::bf16x8*>(&w); } while (0)
              PK4(p0, 0, pa0); PK4(p0, 8, pa1); PK4(p1, 0, pa2); PK4(p1, 8, pa3);
#undef PK4
              att::pv_d0(o, vb0 + kt * 8192, pa0, pa1, pa2, pa3);
          }
      }
      att::f32x16 ic[2] = {};
#pragma unroll
      for (int vt = 0; vt < 2; ++vt)
#pragma unroll
          for (int d0 = 0; d0 < 4; ++d0) { const att::bf16x8 cb = *reinterpret_cast<const att::bf16x8*>(C0 + (d * 64 + vt * 32 + r32) * 72 + d0 * 16 + hi * 8);
              ic[vt] = __builtin_amdgcn_mfma_f32_32x32x16_bf16(qr[d0], cb, ic[vt], 0, 0, 0); }
      float nq = 0.f;
#pragma unroll
      for (int d0 = 0; d0 < 4; ++d0)
#pragma unroll
          for (int x = 0; x < 8; ++x) nq += bf2f((unsigned short)qr[d0][x]) * N0[d * 64 + d0 * 16 + hi * 8 + x];
      { auto rr = __builtin_amdgcn_permlane32_swap(__float_as_uint(nq), __float_as_uint(nq), false, false); nq = __uint_as_float(rr[0]) + __uint_as_float(rr[1]); }
      { auto rr = __builtin_amdgcn_permlane32_swap(__float_as_uint(rs), __float_as_uint(rs), false, false); rs = __uint_as_float(rr[0]) + __uint_as_float(rr[1]); }
      const float den = rs + wiv[sq] * nq, dn = fmaxf(fabsf(den), emtv[sq]);
      if (hi == 0) WS[r32] = __builtin_amdgcn_rcpf(dn);
      asm volatile("s_waitcnt lgkmcnt(0)" ::: "memory");
#pragma unroll
      for (int r = 0; r < 16; ++r) { const int row = att::crow(r, hi), tt = qb * 32 + row; const float inv = WS[row], wi = wiv[tt];
#pragma unroll
          for (int vt = 0; vt < 2; ++vt) HX[(d * 128 + tt) * 68 + vt * 32 + r32] = (o[vt][r] + wi * ic[vt][r]) * inv; }
    }
    __syncthreads();
    { const int tt = tid >> 2, v0 = (tid & 3) * 16, t = t0 + tt; float hv[16]; float s = 0.f;
#pragma unroll
      for (int i = 0; i < 16; ++i) { hv[i] = HX[tt * 68 + v0 + i] + HX[(128 + tt) * 68 + v0 + i]; s += hv[i]; }
      s += __shfl_xor(s, 1); s += __shfl_xor(s, 2); const float mu = s * (1.f / 64.f); float vs = 0.f;
#pragma unroll
      for (int i = 0; i < 16; ++i) { hv[i] -= mu; vs += hv[i] * hv[i]; }
      vs += __shfl_xor(vs, 1); vs += __shfl_xor(vs, 2); const float rstd = 1.f / sqrtf(vs * (1.f / 64.f) + EPS);
#pragma unroll
      for (int i = 0; i < 16; ++i) { const int c = h * 64 + v0 + i;
          const float y = hv[i] * rstd * p.in[I_MNG][(size_t)l * 256 + c] + p.in[I_MSK][(size_t)l * 256 + c] * bf2f(q2.XCM16[(size_t)t * 256 + c]);
          Y(t, 768 + c, y * fast_silu(U(t, OFF_MZ + c))); } }
    __syncthreads();
}
typedef float f32x4_t __attribute__((ext_vector_type(4)));

__device__ __forceinline__ void row_norm_mod(f32x4 (&v)[4], const float* g, const float* sc, const float* sh, int lane) {
    float s = 0.f;
#pragma unroll
    for (int j = 0; j < 4; ++j) s += (v[j].x * v[j].x + v[j].y * v[j].y) + (v[j].z * v[j].z + v[j].w * v[j].w);
    const float rstd = 1.f / sqrtf(wave_sum(s) * (1.f / D) + EPS);
#pragma unroll
    for (int j = 0; j < 4; ++j) { const int k = (j * 64 + lane) * 4; const f32x4 gv = *(const f32x4*)(g + k);
        if (sc) { const f32x4 scv = *(const f32x4*)(sc + k), shv = *(const f32x4*)(sh + k); v[j] = v[j] * rstd * gv * (scv + 1.f) + shv; } else v[j] = v[j] * rstd * gv; }
}
__device__ __forceinline__ void row_store_bf16(bf16* dst, const f32x4 (&v)[4], int lane) {
#pragma unroll
    for (int j = 0; j < 4; ++j) { u32x2 w; w.x = pk2(v[j].x, v[j].y); w.y = pk2(v[j].z, v[j].w); *(u32x2*)(dst + (j * 64 + lane) * 4) = w; }
}
__device__ __forceinline__ void rp_first(const P& p, const Q& q, int gw, int ngw, int lane) {
    for (int t = gw; t < NT; t += ngw) { const int b = t / TPB, i = t % TPB; const float* src = i < CTX ? p.in[I_CTX] + ((size_t)b * CTX + i) * D : p.in[I_X] + ((size_t)b * SEQ + (i - CTX)) * D;
        f32x4 v[4];
#pragma unroll
        for (int j = 0; j < 4; ++j) { v[j] = *(const f32x4*)(src + (j * 64 + lane) * 4); *(f32x4*)(p.X + (size_t)t * D + (j * 64 + lane) * 4) = v[j]; }
        const int cv = tok_cv(t); row_norm_mod(v, p.in[I_N1G], modp(p, 0, cv, 1), modp(p, 0, cv, 0), lane); row_store_bf16(q.H16 + (size_t)t * D, v, lane); }
}
__device__ __forceinline__ void rp_end(const P& p, const Q& q, const Q2& q2, int l, int gw, int ngw, int lane, float probe_scale = 1.f) {
    const bool last = l + 1 == DEPTH; const int nrows = last ? NB * SEQ : NT;
    for (int r_ = gw; r_ < nrows; r_ += ngw) { const int t = last ? (r_ / SEQ) * TPB + CTX + r_ % SEQ : r_; const int cv = tok_cv(t); const float* g2 = modp(p, l, cv, 5); f32x4 v[4];
#pragma unroll
        for (int j = 0; j < 4; ++j) { const int k = (j * 64 + lane) * 4; f32x4 s = {0.f, 0.f, 0.f, 0.f};
#pragma unroll
            for (int e = 0; e < 4; ++e) { const u32x2 w = *(const u32x2*)(q2.YB16 + ((size_t)t * 4 + e) * D + k);
                s.x += __builtin_bit_cast(float, w.x << 16); s.y += __builtin_bit_cast(float, w.x & 0xffff0000u); s.z += __builtin_bit_cast(float, w.y << 16); s.w += __builtin_bit_cast(float, w.y & 0xffff0000u); }
            v[j] = *(const f32x4*)(p.X + (size_t)t * D + k) + *(const f32x4*)(g2 + k) * s * probe_scale; }
        if (l + 1 < DEPTH) {
#pragma unroll
            for (int j = 0; j < 4; ++j) *(f32x4*)(p.X + (size_t)t * D + (j * 64 + lane) * 4) = v[j];
            row_norm_mod(v, p.in[I_N1G] + (size_t)(l + 1) * D, modp(p, l + 1, cv, 1), modp(p, l + 1, cv, 0), lane); row_store_bf16(q.H16 + (size_t)t * D, v, lane);
        } else { const int b = t / TPB, i = t % TPB; if (i < CTX) continue;
            row_norm_mod(v, p.in[I_FG], nullptr, nullptr, lane);
#pragma unroll
            for (int j = 0; j < 4; ++j) *(f32x4*)(p.out + ((size_t)b * SEQ + (i - CTX)) * D + (j * 64 + lane) * 4) = v[j]; }
    }
}
constexpr int RPM_LDS = 89024;
__device__ __forceinline__ void rp_mid(const P& p, const Q& q, float* GLIST, int l, char* lds, int G, int bid, bool latent_only, bool probe_nolist = false) {
    int tid_ = TIDX; asm volatile("" : "+v"(tid_));
    const int tid = tid_, wave = tid >> 6, lane = tid & 63;
    float* HS = (float*)lds; float* PART = (float*)(lds + 65664); float* LG = (float*)(lds + 82048); int* LCNT = (int*)(lds + 84096); int* LBASE = (int*)(lds + 84224); int* PEND = (int*)(lds + 84352); int* NPEND = (int*)(lds + 88960);
    if (tid < 32) LCNT[tid] = 0; if (tid == 32) NPEND[0] = 0;
    float B0[32], B1[32]; const float* Wr = p.in[I_WR] + (size_t)l * D * NE;
#pragma unroll
    for (int ks = 0; ks < 32; ++ks) { const int k = 128 * wave + 4 * ks + (lane >> 4); B0[ks] = Wr[(size_t)k * NE + (lane & 15)]; B1[ks] = Wr[(size_t)k * NE + 16 + (lane & 15)]; }
    __syncthreads();
    const int nitems = latent_only ? NB * SEQ / 16 : NT / 16;
    for (int it_ = bid; it_ < nitems; it_ += G) { const int it = latent_only ? (it_ / (SEQ / 16)) * (TPB / 16) + CTX / 16 + it_ % (SEQ / 16) : it_;
#pragma unroll 1
        for (int rr = 0; rr < 2; ++rr) { const int row = 2 * wave + rr, t = it * 16 + row, cv = tok_cv(t); f32x4 v[4];
#pragma unroll
            for (int j = 0; j < 4; ++j) v[j] = *(const f32x4*)(p.X + (size_t)t * D + (j * 64 + lane) * 4);
            row_norm_mod(v, p.in[I_N2G] + (size_t)l * D, modp(p, l, cv, 4), modp(p, l, cv, 3), lane); row_store_bf16(q.H16 + (size_t)t * D, v, lane);
#pragma unroll
            for (int j = 0; j < 4; ++j) { float* d = HS + row * 1026 + (j * 64 + lane) * 4; *(float2*)d = make_float2(v[j].x, v[j].y); *(float2*)(d + 2) = make_float2(v[j].z, v[j].w); } }
        __syncthreads();
        { f32x4_t a0 = {0.f, 0.f, 0.f, 0.f}, a1 = a0; const float* hrow = HS + (lane & 15) * 1026 + 128 * wave + (lane >> 4);
#pragma unroll
          for (int ks = 0; ks < 32; ++ks) { const float a = hrow[4 * ks]; a0 = __builtin_amdgcn_mfma_f32_16x16x4f32(a, B0[ks], a0, 0, 0, 0); a1 = __builtin_amdgcn_mfma_f32_16x16x4f32(a, B1[ks], a1, 0, 0, 0); }
#pragma unroll
          for (int r = 0; r < 4; ++r) { const int row = (lane >> 4) * 4 + r; PART[(wave * 16 + row) * 32 + (lane & 15)] = a0[r]; PART[(wave * 16 + row) * 32 + 16 + (lane & 15)] = a1[r]; } }
        __syncthreads();
        { float s = p.in[I_BR][(size_t)l * NE + (tid & 31)];
#pragma unroll
          for (int w = 0; w < 8; ++w) s += PART[w * 512 + tid];
          LG[tid] = s; }
        __syncthreads();
        if (tid < 16) { const int t = it * 16 + tid; float lg[NE];
#pragma unroll
            for (int e = 0; e < NE; ++e) lg[e] = LG[tid * 32 + e];
            int te[TOPK]; float tv[TOPK];
#pragma unroll
            for (int r = 0; r < TOPK; ++r) { float best = -3.0e38f; int bi = 0;
#pragma unroll
                for (int e = 0; e < NE; ++e) { const bool c = lg[e] > best; best = c ? lg[e] : best; bi = c ? e : bi; }
                te[r] = bi; tv[r] = best;
#pragma unroll
                for (int e = 0; e < NE; ++e) lg[e] = (e == bi) ? -3.0e38f : lg[e]; }
            float ssum = 0.f, ex[TOPK];
#pragma unroll
            for (int r = 0; r < TOPK; ++r) { ex[r] = __expf(tv[r] - tv[0]); ssum += ex[r]; }
            const float inv = 1.f / ssum;
#pragma unroll
            for (int r = 0; r < TOPK; ++r) { p.TOPG[t * TOPK + r] = ex[r] * inv; const int lp = atomicAdd(&LCNT[te[r]], 1); const int slot = atomicAdd(NPEND, 1);
                PEND[slot * 3] = t * TOPK + r; PEND[slot * 3 + 1] = (te[r] << 16) | lp; PEND[slot * 3 + 2] = __float_as_int(ex[r] * inv); } }
        __syncthreads();
    }
    if (probe_nolist) return;
    if (tid < 32) LBASE[tid] = LCNT[tid] > 0 ? atomicAdd(&p.CNT[tid], LCNT[tid]) : 0;
    __syncthreads();
    for (int i = tid; i < NPEND[0]; i += 512) { const int pr = PEND[i * 3], x = PEND[i * 3 + 1], e = x >> 16, lp = x & 0xffff; p.LIST[(size_t)e * NT + LBASE[e] + lp] = pr; GLIST[(size_t)e * NT + LBASE[e] + lp] = __int_as_float(PEND[i * 3 + 2]); }
    __syncthreads();
}
struct EpiDown16 {
    static constexpr bool PERM = true; bf16* YB; const float* bd; const float* GL; const int* CNT; const int* LIST; int nN; int probe_skip;
    __device__ __forceinline__ void operator()(const pg8::f32x4 (&acc)[2][2][4][2], const pg8::Unit& u, int wr, int wc, int fr, int fq) const {
        if (probe_skip) return;
        const int ntile = u.pn - u.e * nN, cnt = CNT[u.e]; const float* b = bd + (size_t)u.e * D;
        int pr[2][4]; float gt[2][4];
#pragma unroll
        for (int ai = 0; ai < 2; ++ai)
#pragma unroll
            for (int m = 0; m < 4; ++m) { const int idx = u.mb * 256 + ai * 128 + wr * 64 + m * 16 + fr, ic = idx < cnt ? idx : 0; pr[ai][m] = LIST[(size_t)u.e * NT + ic]; gt[ai][m] = GL[(size_t)u.e * NT + ic]; }
        pg8::f32x4 bv[2][2];
#pragma unroll
        for (int bj = 0; bj < 2; ++bj) { const int c = ntile * 256 + bj * 128 + wc * 32 + 8 * fq; bv[bj][0] = *(const pg8::f32x4*)(b + c); bv[bj][1] = *(const pg8::f32x4*)(b + c + 4); }
#pragma unroll
        for (int ai = 0; ai < 2; ++ai)
#pragma unroll
            for (int m = 0; m < 4; ++m) { const int idx = u.mb * 256 + ai * 128 + wr * 64 + m * 16 + fr;
                if (idx < cnt) { const float g = gt[ai][m];
#pragma unroll
                    for (int bj = 0; bj < 2; ++bj) { const int c = ntile * 256 + bj * 128 + wc * 32 + 8 * fq;
                        const pg8::f32x4 v0 = (acc[ai][bj][m][0] + bv[bj][0]) * g, v1 = (acc[ai][bj][m][1] + bv[bj][1]) * g;
                        u32x4 w; w.x = pg8::cvt_pk_bf16(v0[0], v0[1]); w.y = pg8::cvt_pk_bf16(v0[2], v0[3]); w.z = pg8::cvt_pk_bf16(v1[0], v1[1]); w.w = pg8::cvt_pk_bf16(v1[2], v1[3]);
                        *(u32x4*)(YB + (size_t)pr[ai][m] * D + c) = w; } } }
    }
};
__device__ __forceinline__ void opt_moe_down16(const P& p, const Q& q, const Q2& q2, int l, LAS unsigned char* lds, int G, int bid, int probe_skip = 0) {
    pg8::Gemm g{q.ACT16, q.WtDn + (size_t)l * NE * D * DE, DE}; DnOrder S; S.init(p.CNT, p.LIST, D / 256, G, bid, (LAS int*)(lds + pg8::STAGE_BYTES));
    EpiDown16 E{q2.YB16, p.in[I_BD] + (size_t)l * NE * D, q2.GLIST, p.CNT, p.LIST, D / 256, probe_skip}; pg8::gemm_phase<EpiDown16, DnOrder, true>(lds, g, S, E);
}
#define GAS __attribute__((address_space(1)))
typedef GAS unsigned gu32;
#define XB_TMO      128
#define XB_XCNT(j)  (256  + 64 * (j))
#define XB_XSUB(j)  (1280 + 64 * (j))
#define XB_XGEN(j)  (2304 + 64 * (j))
#define XB_TOP      3328
#define XB_TOPGEN   3392
#define XCD_BAR_WORDS 3456
#define XB_SPIN_CAP (1u << 18)

__device__ __forceinline__ unsigned xb_ld(unsigned* p)              { return __hip_atomic_load(p, __ATOMIC_RELAXED, __HIP_MEMORY_SCOPE_AGENT); }
__device__ __forceinline__ unsigned xb_add(unsigned* p, unsigned v) { return __hip_atomic_fetch_add(p, v, __ATOMIC_RELAXED, __HIP_MEMORY_SCOPE_AGENT); }
__device__ __forceinline__ unsigned xb_xcc_id() { return (unsigned)__builtin_amdgcn_s_getreg((3 << 11) | 20) & 0xFu; }
#define XB_SPIN(cond, bar) do { unsigned _sp = 0; while (cond) { __builtin_amdgcn_s_sleep(1); \
    if ((++_sp & 255u) == 0u) { if (xb_ld(&(bar)[XB_TMO])) break; if (_sp > XB_SPIN_CAP) { atomicAdd(&(bar)[XB_TMO], 1u); break; } } } } while (0)

struct XcdBarrier {
    unsigned* bar; unsigned x;
    volatile LAS unsigned* st;
};

__device__ __forceinline__ XcdBarrier xcd_barrier_post(unsigned* bar, volatile LAS unsigned* st) {
    XcdBarrier b; b.bar = bar; b.x = xb_xcc_id(); b.st = st;
    if (TIDX == 0) (void)xb_add(&bar[XB_XCNT(b.x)], 1u);
    return b;
}
__device__ __forceinline__ void xcd_barrier_complete(unsigned* bar, unsigned x, unsigned& nloc, unsigned& nx) {
    const unsigned G = gridDim.x * gridDim.y * gridDim.z;
    unsigned sum, cnt, mine, sp = 0u;
    for (;;) {
        sum = 0u; cnt = 0u; mine = 0u;
#pragma unroll
        for (unsigned j = 0; j < 16; ++j) { const unsigned c = xb_ld(&bar[XB_XCNT(j)]); sum += c; cnt += (c > 0u) ? 1u : 0u; mine = (j == x) ? c : mine; }
        if (sum == G) break;
        __builtin_amdgcn_s_sleep(1);
        if ((++sp & 255u) == 0u) { if (xb_ld(&bar[XB_TMO])) break; if (sp > XB_SPIN_CAP) { atomicAdd(&bar[XB_TMO], 1u); break; } }
    }
    nloc = mine > 0u ? mine : 1u; nx = cnt > 0u ? cnt : 1u;
}

__device__ __forceinline__ void xcd_barrier(const XcdBarrier& b) {
    asm volatile("s_waitcnt vmcnt(0)" ::: "memory");
    __syncthreads();
    if (TIDX == 0) {
        unsigned* bar = b.bar;
        __builtin_amdgcn_s_waitcnt(0);
        unsigned nloc = b.st[0], nx = b.st[1];
        if (nloc == 0u) { xcd_barrier_complete(bar, b.x, nloc, nx); b.st[0] = nloc; b.st[1] = nx; }
        const unsigned old = xb_add(&bar[XB_XSUB(b.x)], 1u);
        const unsigned gen = old / nloc;
        if (old + 1u == (gen + 1u) * nloc) {
            __builtin_amdgcn_fence(__ATOMIC_RELEASE, "agent");
            asm volatile("s_waitcnt vmcnt(0)" ::: "memory");
            const unsigned og = xb_add(&bar[XB_TOP], 1u);
            const unsigned tg = og / nx;
            if (og + 1u == (tg + 1u) * nx) xb_add(&bar[XB_TOPGEN], 1u);
            else XB_SPIN(xb_ld(&bar[XB_TOPGEN]) == tg, bar);
            __builtin_amdgcn_fence(__ATOMIC_ACQUIRE, "agent");
            xb_add(&bar[XB_XGEN(b.x)], 1u);
            asm volatile("s_waitcnt vmcnt(0)" ::: "memory");
        } else {
            XB_SPIN(xb_ld(&bar[XB_XGEN(b.x)]) == gen, bar);
            __builtin_amdgcn_fence(__ATOMIC_ACQUIRE, "agent");
            asm volatile("s_waitcnt vmcnt(0)" ::: "memory");
        }
    }
    __syncthreads();
}
#include <hip/hip_cooperative_groups.h>
#include <cstdio>
namespace cg = cooperative_groups;
#ifndef ONE_LAUNCH
#define ONE_LAUNCH 1
#endif
constexpr int LDS_BYTES = 148480;
static_assert(ML2_LDS <= LDS_BYTES && ML1_LDS <= LDS_BYTES && LRU1_LDS <= LDS_BYTES && RPM_LDS <= LDS_BYTES && att::SHM_ATTN <= LDS_BYTES && pg8::STAGE_BYTES + 1024 + 8192 <= LDS_BYTES - 64, "LDS map");

struct BMap { size_t off[64]; size_t total; };
static inline BMap b_map() {
    BMap m; size_t o = 0; int i = 0;
    auto add = [&](size_t bytes) { m.off[i++] = o; o += (bytes + 255) & ~(size_t)255; };
    add((size_t)DEPTH * 3 * 6 * D * 4);
    add((size_t)SEQ * 16 * 2 * 4);
    add((size_t)NT * D * 4);
    add((size_t)NT * TOPK * 4);
    add((size_t)256);
    add((size_t)NE * NT * 4);
    add((size_t)DEPTH * DINP * D * 2);
    add((size_t)DEPTH * D * DMIX * 2);
    add((size_t)DEPTH * NE * 2 * DE * D * 2);
    add((size_t)DEPTH * NE * D * DE * 2);
    add((size_t)DEPTH * 768 * QRANK * 2);
    add((size_t)DEPTH * 1024 * KVRANK * 2);
    add((size_t)NT * D * 2);
    add((size_t)NT * DMIX * 2);
    add((size_t)SLOT_MAX * DE * 2);
    add((size_t)NT * AH * QKD * 2);
    add((size_t)NT * AH * VD * 2);
    add((size_t)NT * DINP * 2);
    add((size_t)DEPTH * 4 * 256 * 64 * 2);
    add((size_t)DEPTH * 4 * 3 * 4096 * 2);
    add((size_t)DEPTH * 32 * 768 * 2);
    add((size_t)DEPTH * 2 * 256 * 4);
    add((size_t)2 * NT * 256 * 4);
    add((size_t)2 * NT * 256 * 4);
    add((size_t)2 * NB * NCH * 256 * 4);
    add((size_t)2 * NB * NCH * 256 * 4);
    add((size_t)NT * 256 * 2);
    add((size_t)NT * 256 * 2);
    add((size_t)NT * 768 * 2);
    add((size_t)DEPTH * 1024 * 256 * 2);
    add((size_t)NT * 256 * 2);
    add((size_t)NT * 768 * 2);
    add((size_t)NT * 16 * 4);
    add((size_t)2 * NB * NCH * 4 * 4096 * 4);
    add((size_t)2 * NB * NCH * 4 * 64 * 4);
    add((size_t)2 * NB * NCH * 4 * 2 * 4);
    add((size_t)NT * TOPK * D * 2);
    add((size_t)XCD_BAR_WORDS * 4);
    add((size_t)2 * NB * NCH * 4 * 4096 * 2);
    add((size_t)2 * NB * NCH * 4 * 64 * 4);
    add((size_t)2 * NB * NCH * 4 * 4);
    add((size_t)NE * NT * 4);
    m.total = o; return m;
}
struct Args { P p; Q q; Q2 q2; unsigned* bar; };
static inline void fill_args(Args& a, void* const* d_in, void* d_out, void* d_ws) {
    for (int i = 0; i < N_IN; ++i) a.p.in[i] = (const float*)d_in[i];
    a.p.out = (float*)d_out; char* w = (char*)d_ws; const BMap m = b_map();
    a.p.MOD = (float*)(w + m.off[0]); a.p.ROPET = (float*)(w + m.off[1]); a.p.X = (float*)(w + m.off[2]); a.p.TOPG = (float*)(w + m.off[3]); a.p.CNT = (int*)(w + m.off[4]); a.p.LIST = (int*)(w + m.off[5]);
    a.q.WtIn = (bf16*)(w + m.off[6]); a.q.WtOut = (bf16*)(w + m.off[7]); a.q.WtGu = (bf16*)(w + m.off[8]); a.q.WtDn = (bf16*)(w + m.off[9]); a.q.WtQb = (bf16*)(w + m.off[10]); a.q.WtKvb = (bf16*)(w + m.off[11]);
    a.q.H16 = (bf16*)(w + m.off[12]); a.q.Y16 = (bf16*)(w + m.off[13]); a.q.ACT16 = (bf16*)(w + m.off[14]); a.q.K16 = (bf16*)(w + m.off[15]); a.q.V16 = (bf16*)(w + m.off[16]);
    a.q2.U16 = (bf16*)(w + m.off[17]); a.q2.WtL = (bf16*)(w + m.off[18]); a.q2.WtM = (bf16*)(w + m.off[19]); a.q2.WtG = (bf16*)(w + m.off[20]); a.q2.LSL = (float*)(w + m.off[21]);
    a.q2.HLOC = (bf16*)(w + m.off[22]); a.q2.PCUM = (bf16*)(w + m.off[23]); a.q2.SA = (float*)(w + m.off[24]); a.q2.SB = (float*)(w + m.off[25]);
    a.q2.QN16 = (bf16*)(w + m.off[26]); a.q2.KVN16 = (bf16*)(w + m.off[27]); a.q2.Q16 = (bf16*)(w + m.off[28]); a.q2.WtKvbP = (bf16*)(w + m.off[29]);
    a.q2.XCM16 = (bf16*)(w + m.off[30]); a.q2.QKV16 = (bf16*)(w + m.off[31]); a.q2.GATES = (float*)(w + m.off[32]); a.q2.CLOC = (float*)(w + m.off[33]); a.q2.NLOC = (float*)(w + m.off[34]); a.q2.MLB = (float*)(w + m.off[35]);
    a.q2.YB16 = (bf16*)(w + m.off[36]); a.bar = (unsigned*)(w + m.off[37]); a.q2.CST = (bf16*)(w + m.off[38]); a.q2.NST = (float*)(w + m.off[39]); a.q2.MST = (float*)(w + m.off[40]); a.q2.GLIST = (float*)(w + m.off[41]);
}

struct ULoad16 { const bf16* U; __device__ __forceinline__ float operator()(int t, int col) const { return bf2f(U[(size_t)t * DINP + col]); } };
struct YStore16 { bf16* Y; __device__ __forceinline__ void operator()(int t, int col, float v) const { Y[(size_t)t * DMIX + col] = (bf16)f2bf(v); } };
struct OutY16 { bf16* y; __device__ __forceinline__ void operator()(int row, int col, float v) const { y[(size_t)row * DMIX + col] = (bf16)f2bf(v); } };

enum { ST_INIT = 0, ST_RPFIRST, ST_INPROJ, ST_PREP, ST_MLAPROJ, ST_MIX, ST_OUTPROJ, ST_RPMID, ST_GU, ST_DOWN, ST_RPEND, N_ST };

typedef const __attribute__((address_space(4))) Args* KArgs;
__device__ __forceinline__ KArgs kargs() { KArgs k = (KArgs)__builtin_amdgcn_kernarg_segment_ptr(); asm volatile("" : "+s"(k)); return k; }
__device__ __forceinline__ void run_step(const Args& a, int step, int l_, unsigned char* lds_raw) {
    const int l = l_ & 0xff, sub = l_ >> 8;
    const P& p = a.p; const Q& q = a.q; const Q2& q2 = a.q2;
    LAS unsigned char* lds = (LAS unsigned char*)lds_raw; char* ldsg = (char*)lds_raw;
    int G_ = gridDim.x, bid_ = blockIdx.x; asm volatile("" : "+s"(G_), "+s"(bid_));
    const int G = G_, bid = bid_;
#define THREAD_IDS int tid_ = TIDX; asm volatile("" : "+v"(tid_)); const int tid = tid_, lane = tid & 63, wave = __builtin_amdgcn_readfirstlane(tid >> 6); \
    const int gw = bid * NWAVES + wave, ngw = G * NWAVES; const long gtid = (long)bid * NTHREADS + tid, nthr = (long)G * NTHREADS; (void)lane; (void)gw; (void)ngw; (void)gtid; (void)nthr;
    switch (step) {
    case ST_INIT: { THREAD_IDS
        opt_init_mod(p, ldsg, bid, G); opt_init_rope(p, gtid, nthr); opt_convert_small(p, q2, gtid, nthr); opt_convert_weights(p, q, q2.WtKvbP, lds, gw, ngw, wave, lane); break; }
    case ST_RPFIRST: { THREAD_IDS rp_first(p, q, gw, ngw, lane); break; }
    case ST_INPROJ: opt_inproj16(q, q2, l, lds, G, bid); break;
    case ST_PREP: { THREAD_IDS
        if (gtid < NE) p.CNT[gtid] = 0;
        const ULoad16 U{q2.U16};
        for (int it = bid; it < NB * NCH * 5; it += G) {
            if (it < NB * NCH) { if (sub == 0 || (sub & 1)) ml1_item(p, q2, l, it / NCH, it % NCH, ldsg, U); }
            else if (sub == 0 || (sub & 2)) { const int x = it - NB * NCH; lru1_item(p, q2, l, (x >> 2) / NCH, (x >> 2) % NCH, x & 3, ldsg, U); } }
        if (sub == 0 || (sub & 4)) for (int t = gw; t < NT; t += ngw) mla_prep_token(p, q, q2, l, t, lane, U);
        break; }
    case ST_MLAPROJ: { for (int it = G - 1 - bid; it < 64; it += G) ml_scan_item(q2, it, ldsg);
        opt_mla_proj(p, q, q2, l, lds, G, bid); break; }
    case ST_MIX: {
        const ULoad16 U{q2.U16}; const YStore16 Y{q.Y16};
        const int c = bid, vcu = (G % 8 == 0) ? (c % 8) * (G / 8) + c / 8 : c;
        constexpr int QB_LAT = SEQ / 256, QB_CTX = CTX / 256, NU_LAT = NB * AH * QB_LAT, NU_CTX = NB * AH * QB_CTX;
#ifdef ATTN_PROBE_VAR
        if (sub & 1) { struct NoOut { __device__ __forceinline__ void operator()(int, int, float) const {} } noout;
            for (int u = vcu; u < NU_LAT; u += G) { const int bh = u / QB_LAT, qb = u % QB_LAT, b = bh / AH, h = bh % AH, t0 = b * TPB + CTX + qb * 256;
                att::attn_unit<unsigned short, NoOut, ATTN_PROBE_VAR>((const unsigned short*)q2.Q16 + (size_t)t0 * 768 + h * QKD, 768, (const unsigned short*)q.K16 + ((size_t)b * AH + h) * TPB * QKD, (const unsigned short*)q.V16 + ((size_t)b * AH + h) * TPB * VD, TPB, ldsg, noout); } }
        else
#endif
        if (sub == 0 || (sub & 1)) for (int u = vcu; u < NU_LAT; u += G) { const int bh = u / QB_LAT, qb = u % QB_LAT, b = bh / AH, h = bh % AH, t0 = b * TPB + CTX + qb * 256;
            OutY16 out{q.Y16 + (size_t)t0 * DMIX + 256 + h * VD};
            att::attn_unit<unsigned short, OutY16>((const unsigned short*)q2.Q16 + (size_t)t0 * 768 + h * QKD, 768, (const unsigned short*)q.K16 + ((size_t)b * AH + h) * TPB * QKD, (const unsigned short*)q.V16 + ((size_t)b * AH + h) * TPB * VD, TPB, ldsg, out); }
        if ((sub == 0 || (sub & 1)) && l + 1 < DEPTH) for (int u = vcu; u < NU_CTX; u += G) { const int bh = u / QB_CTX, qb = u % QB_CTX, b = bh / AH, h = bh % AH, t0 = b * TPB + qb * 256;
            OutY16 out{q.Y16 + (size_t)t0 * DMIX + 256 + h * VD};
            att::attn_unit<unsigned short, OutY16>((const unsigned short*)q2.Q16 + (size_t)t0 * 768 + h * QKD, 768, (const unsigned short*)q.K16 + ((size_t)b * AH + h) * TPB * QKD, (const unsigned short*)q.V16 + ((size_t)b * AH + h) * TPB * VD, CTX, ldsg, out); }
        const int ch0 = (l + 1 < DEPTH) ? 0 : NCH_CTX, nch = NCH - ch0;
        if (sub == 0 || (sub & 2)) for (int it = G - 1 - c; it < NB * nch * 4; it += G) { const int x = it >> 2; ml2_item(p, q2, l, x / nch, ch0 + x % nch, it & 3, ldsg, U, Y); }
        if (sub == 0 || (sub & 4)) for (int it = c; it < NB * nch; it += G) lru2_item(q2, it / nch, ch0 + it % nch, ldsg, U, Y);
        break; }
    case ST_OUTPROJ: opt_outproj(p, q, l, lds, G, bid, l + 1 == DEPTH); break;
    case ST_RPMID: rp_mid(p, q, q2.GLIST, l, ldsg, G, bid, l + 1 == DEPTH, sub != 0); break;
    case ST_GU: opt_moe_gu(p, q, l, lds, G, bid, sub); break;
    case ST_DOWN: opt_moe_down16(p, q, q2, l, lds, G, bid, sub); break;
    case ST_RPEND: { THREAD_IDS rp_end(p, q, q2, l, gw, ngw, lane, sub != 0 ? 0.f : 1.f); break; }
    }
}

#if ONE_LAUNCH
__global__ void __launch_bounds__(512, 2) k_mega(Args a) {
    extern __shared__ __attribute__((aligned(16))) unsigned char lds_raw[];
    volatile LAS unsigned* MISC = (volatile LAS unsigned*)((LAS unsigned char*)lds_raw + LDS_BYTES - 64);
    if (threadIdx.x < 16) MISC[threadIdx.x] = 0u;
    if ((threadIdx.x & 63) == 0) ((LAS int*)((LAS unsigned char*)lds_raw + WTAB_OFF))[HWID()] = threadIdx.x >> 6;
    __syncthreads();
    { const XcdBarrier b0 = xcd_barrier_post(a.bar, MISC + 8); if (TIDX == 0) MISC[10] = b0.x; }
#define GRID_BAR() do { XcdBarrier b_; b_.bar = a.bar; b_.st = MISC + 8; b_.x = MISC[10]; xcd_barrier(b_); } while (0)
    run_step(a, ST_INIT, 0, lds_raw); GRID_BAR();
    run_step(a, ST_RPFIRST, 0, lds_raw); GRID_BAR();
#pragma unroll 1
    for (int l = 0; l < DEPTH; ++l) {
#pragma unroll 1
        for (int s = ST_INPROJ; s <= ST_RPEND; ++s) { run_step(a, s, l, lds_raw); if (!(l == DEPTH - 1 && s == ST_RPEND)) GRID_BAR();
#ifdef MEGA_DUP_STEP
            if (s == MEGA_DUP_STEP) { run_step(a, s, l, lds_raw); GRID_BAR(); }
#endif
        }
    }
}
#else
template <int STEP>
__global__ void __launch_bounds__(512, 2) k_step(Args a, int l) {
    extern __shared__ __attribute__((aligned(16))) unsigned char lds_raw[];
    run_step(a, STEP, l, lds_raw);
}
template <int STEP> static void launch_step(const Args& a, int l, hipStream_t stream) {
    static bool attr = false;
    if (!attr) { (void)hipFuncSetAttribute((const void*)k_step<STEP>, hipFuncAttributeMaxDynamicSharedMemorySize, LDS_BYTES); attr = true; }
    hipLaunchKernelGGL(k_step<STEP>, dim3(256), dim3(512), LDS_BYTES, stream, a, l);
}
#endif

extern "C" void kernel_launch(void* const* d_in, const int* in_sizes, int n_in, void* d_out, int out_size, void* d_ws, size_t ws_size, hipStream_t stream) {
    static int grid_blocks = 0;
    if (!grid_blocks) {
        int dev = 0, cus = 0;
        (void)hipGetDevice(&dev); (void)hipDeviceGetAttribute(&cus, hipDeviceAttributeMultiprocessorCount, dev);
        grid_blocks = cus;
#if ONE_LAUNCH
        int per_cu = 0;
        (void)hipFuncSetAttribute((const void*)k_mega, hipFuncAttributeMaxDynamicSharedMemorySize, LDS_BYTES);
        (void)hipOccupancyMaxActiveBlocksPerMultiprocessor(&per_cu, (const void*)k_mega, 512, LDS_BYTES);
        if (per_cu < 1) fprintf(stderr, "kernel_launch: occupancy query reports %d workgroups per CU\n", per_cu);
#endif
        const BMap m = b_map();
        if (n_in != N_IN || m.total > ws_size) fprintf(stderr, "kernel_launch: bad n_in %d or workspace too small (%zu needed, %zu given)\n", n_in, m.total, ws_size);
    }
    Args a{}; fill_args(a, d_in, d_out, d_ws);
#if ONE_LAUNCH
    (void)hipMemsetAsync(a.bar, 0, XCD_BAR_WORDS * 4, stream);
    void* args[] = {&a};
    hipError_t e = hipLaunchCooperativeKernel((const void*)k_mega, dim3(grid_blocks), dim3(512), args, LDS_BYTES, stream);
    if (e != hipSuccess) fprintf(stderr, "cooperative launch failed: %s (grid %d)\n", hipGetErrorString(e), grid_blocks);
#else
#ifndef DUP_STEP
#define DUP_STEP -1
#endif
#ifndef DUP_SUB
#define DUP_SUB 0
#endif
#define LS(ST, l) do { launch_step<ST>(a, l, stream); if (ST == DUP_STEP) launch_step<ST>(a, (l) | (DUP_SUB << 8), stream); } while (0)
    LS(ST_INIT, 0); LS(ST_RPFIRST, 0);
    for (int l = 0; l < DEPTH; ++l) {
        LS(ST_INPROJ, l); LS(ST_PREP, l); LS(ST_MLAPROJ, l); LS(ST_MIX, l); LS(ST_OUTPROJ, l);
        LS(ST_RPMID, l); LS(ST_GU, l); LS(ST_DOWN, l); LS(ST_RPEND, l);
    }
#endif
}
```

```cpp
#include <hip/hip_runtime.h>
#define ONE_LAUNCH 1
#include <math.h>
#include <stdint.h>

#ifndef CFG_D_MODEL
#define CFG_D_MODEL 1024
#endif
#ifndef CFG_SEQ
#define CFG_SEQ 8192
#endif
#ifndef CFG_GRID_W
#define CFG_GRID_W 64
#endif
#ifndef CFG_CTX_LEN
#define CFG_CTX_LEN 256
#endif
#ifndef CFG_N_EXPERTS
#define CFG_N_EXPERTS 32
#endif
#ifndef CFG_D_EXPERT
#define CFG_D_EXPERT 1024
#endif

#ifdef HOST_TEST
#define HD inline
struct float4 { float x, y, z, w; };
static inline int atomic_add_i(int* p, int v) { int o = *p; *p = o + v; return o; }
#else
#define HD __device__ __forceinline__
static __device__ __forceinline__ int atomic_add_i(int* p, int v) { return atomicAdd(p, v); }
#endif

constexpr int D = CFG_D_MODEL, NB = 2, SEQ = CFG_SEQ, DEPTH = 2, GRID_W = CFG_GRID_W, CTX = CFG_CTX_LEN;
constexpr int TPB = CTX + SEQ;
constexpr int NT = NB * TPB;
constexpr int LW = 256, MLH = 4, MHD = 64, MW = 256;
constexpr int AH = 8, NOPE = 64, ROPE = 32, VD = 64, QRANK = 256, KVRANK = 128, QKD = NOPE + ROPE;
constexpr int DIN = 1440, DMIX = 1024;
constexpr int OFF_AX = 0, OFF_AG = 256, OFF_BQ = 512, OFF_BKV = 768, OFF_BKR = 896, OFF_MX = 928, OFF_MZ = 1184;
constexpr int NE = CFG_N_EXPERTS, TOPK = 4, DE = CFG_D_EXPERT;
constexpr float EPS = 1e-6f;

enum { I_X = 0, I_C, I_CTX, I_CCTX, I_N1G, I_N2G, I_WMOD, I_BMOD, I_WIN, I_WOUT, I_LCW, I_LCB, I_LWA, I_LBA, I_LWX, I_LBX, I_LLAM,
       I_QNG, I_WQB, I_KVNG, I_WKVB, I_MCW, I_MCB, I_MWQ, I_MWK, I_MWV, I_MWG, I_MBG, I_MNG, I_MSK, I_WR, I_BR, I_WGU, I_BGU, I_WD, I_BD, I_FG, N_IN };

struct P {
    const float* in[N_IN];
    float* out;
    float *MOD, *ROPET, *X, *H, *U, *XC, *LA, *LB, *HL, *QN, *KVN, *QF, *KVF, *Qr, *Kr, *Vr, *XCM, *QM, *KM, *VM, *IGF, *HM, *Y, *TOPG, *ACT, *YB;
    int *TOPE, *CNT, *LIST;
};

HD float sigmoid_f(float x) { return 1.f / (1.f + expf(-x)); }
HD float silu_f(float x) { return x * sigmoid_f(x); }
HD float logsigmoid_f(float x) { return fminf(x, 0.f) - log1pf(expf(-fabsf(x))); }
HD float gelu_f(float x) { return 0.5f * x * (1.f + tanhf(0.7978845608028654f * (x + 0.044715f * x * x * x))); }

HD int tok_b(int t) { return t / TPB; }
HD int tok_i(int t) { return t % TPB; }
HD bool tok_isctx(int t) { return tok_i(t) < CTX; }
HD int tok_cv(int t) { return tok_isctx(t) ? 2 : tok_b(t); }
HD const float* modp(const P& p, int l, int cv, int which) { return p.MOD + (((size_t)l * 3 + cv) * 6 + which) * D; }

template <int R>
HD void gemm_rx4(const float* (&a)[R], const float* B, int ldb, int K, float4 (&acc)[R]) {
    for (int k = 0; k < K; ++k) {
        const float4 bv = *(const float4*)(B + (size_t)k * ldb);
#pragma unroll
        for (int r = 0; r < R; ++r) { const float av = a[r][k]; acc[r].x += av * bv.x; acc[r].y += av * bv.y; acc[r].z += av * bv.z; acc[r].w += av * bv.w; }
    }
}

HD void nv_init(const P& p, long gtid, long nthr) {
    for (long it = gtid; it < (long)DEPTH * 6 * D; it += nthr) {
        const int l = (int)(it / (6 * D)), j = (int)(it % (6 * D));
        const float* w = p.in[I_WMOD] + (size_t)l * D * 6 * D + j;
        float a0 = 0.f, a1 = 0.f, a2 = 0.f;
        for (int k = 0; k < D; ++k) { const float wv = w[(size_t)k * 6 * D];
            a0 += silu_f(p.in[I_C][k]) * wv; a1 += silu_f(p.in[I_C][D + k]) * wv; a2 += silu_f(p.in[I_CCTX][k]) * wv; }
        const float bb = p.in[I_BMOD][(size_t)l * 6 * D + j];
        p.MOD[((size_t)l * 3 + 0) * 6 * D + j] = a0 + bb; p.MOD[((size_t)l * 3 + 1) * 6 * D + j] = a1 + bb; p.MOD[((size_t)l * 3 + 2) * 6 * D + j] = a2 + bb;
    }
    for (long it = gtid; it < (long)NT * D; it += nthr) {
        const int t = (int)(it / D), k = (int)(it % D), b = tok_b(t), i = tok_i(t);
        p.X[it] = (i < CTX) ? p.in[I_CTX][((size_t)b * CTX + i) * D + k] : p.in[I_X][((size_t)b * SEQ + (i - CTX)) * D + k];
    }
    for (long it = gtid; it < (long)SEQ * 16; it += nthr) {
        const int s = (int)(it / 16), a = (int)((it / 8) & 1), f = (int)(it & 7);
        const int pos = a == 0 ? s / GRID_W : s % GRID_W;
        const double fr = pow(10000.0, -(double)f / 8.0);
        const float frf = (float)fr;
        const double ang = (double)((float)pos * frf);
        p.ROPET[it * 2] = (float)cos(ang); p.ROPET[it * 2 + 1] = (float)sin(ang);
    }
}

HD void nv_norm(const P& p, int l, int which  , long gtid, long nthr) {
    const float* g = p.in[which == 0 ? I_N1G : I_N2G] + (size_t)l * D;
    for (long t = gtid; t < NT; t += nthr) {
        const float* x = p.X + (size_t)t * D; float ss = 0.f;
        for (int k = 0; k < D; ++k) ss += x[k] * x[k];
        const float rstd = 1.f / sqrtf(ss / (float)D + EPS);
        const int cv = tok_cv((int)t); const float* sh = modp(p, l, cv, which == 0 ? 0 : 3); const float* sc = modp(p, l, cv, which == 0 ? 1 : 4);
        float* h = p.H + (size_t)t * D;
        for (int k = 0; k < D; ++k) h[k] = x[k] * rstd * g[k] * (1.f + sc[k]) + sh[k];
    }
}

HD void nv_inproj(const P& p, int l, long gtid, long nthr) {
    constexpr int R = 8, NQ = DIN / 4; const float* W = p.in[I_WIN] + (size_t)l * D * DIN;
    for (long it = gtid; it < (long)(NT / R) * NQ; it += nthr) {
        const int mi = (int)(it / NQ), n = (int)(it % NQ) * 4;
        const float* a[R]; float4 acc[R];
#pragma unroll
        for (int r = 0; r < R; ++r) { a[r] = p.H + (size_t)(mi * R + r) * D; acc[r] = float4{0.f, 0.f, 0.f, 0.f}; }
        gemm_rx4<R>(a, W + n, DIN, D, acc);
#pragma unroll
        for (int r = 0; r < R; ++r) *(float4*)(p.U + (size_t)(mi * R + r) * DIN + n) = acc[r];
    }
}

HD float conv_at(const P& p, int t, int col, int c, const float* w  , const float* bias) {
    const int i = tok_i(t), isc = i < CTX, li = isc ? i : i - CTX, len = isc ? CTX : SEQ;
    float s = bias[c];
#pragma unroll
    for (int k = 0; k < 4; ++k) { const int j = li + k - 2; if (j >= 0 && j < len) s += w[k * 256 + c] * p.U[(size_t)(t + k - 2) * DIN + col + c]; }
    return s;
}

HD void nv_prep1(const P& p, int l, long gtid, long nthr) {
    for (long it = gtid; it < (long)NT * 256; it += nthr) {
        const int t = (int)(it / 256), c = (int)(it % 256);
        p.XC[it] = conv_at(p, t, OFF_AX, c, p.in[I_LCW] + (size_t)l * 4 * 256, p.in[I_LCB] + (size_t)l * 256);
        p.XCM[it] = silu_f(conv_at(p, t, OFF_MX, c, p.in[I_MCW] + (size_t)l * 4 * 256, p.in[I_MCB] + (size_t)l * 256));
    }
    for (long t = gtid; t < NT; t += nthr) {
        const float* u = p.U + (size_t)t * DIN; float sq = 0.f, sk = 0.f;
        for (int k = 0; k < QRANK; ++k) sq += u[OFF_BQ + k] * u[OFF_BQ + k];
        for (int k = 0; k < KVRANK; ++k) sk += u[OFF_BKV + k] * u[OFF_BKV + k];
        const float rq = 1.f / sqrtf(sq / (float)QRANK + EPS), rk = 1.f / sqrtf(sk / (float)KVRANK + EPS);
        for (int k = 0; k < QRANK; ++k) p.QN[(size_t)t * QRANK + k] = u[OFF_BQ + k] * rq * p.in[I_QNG][(size_t)l * QRANK + k];
        for (int k = 0; k < KVRANK; ++k) p.KVN[(size_t)t * KVRANK + k] = u[OFF_BKV + k] * rk * p.in[I_KVNG][(size_t)l * KVRANK + k];
    }
}

HD void nv_prep2(const P& p, int l, long gtid, long nthr) {
    for (long it = gtid; it < (long)2 * NT * 256; it += nthr) {
        const int d = (int)(it / ((long)NT * 256)), t = (int)((it / 256) % NT), c = (int)(it % 256), g = c / 64, j = c % 64;
        const float* xc = p.XC + (size_t)t * 256 + g * 64;
        const float* wa = p.in[I_LWA] + ((((size_t)l * 2 + d) * 4 + g) * 64) * 64 + j;
        const float* wx = p.in[I_LWX] + ((((size_t)l * 2 + d) * 4 + g) * 64) * 64 + j;
        float sa = 0.f, sx = 0.f;
        for (int i = 0; i < 64; ++i) { sa += xc[i] * wa[i * 64]; sx += xc[i] * wx[i * 64]; }
        const float r = sigmoid_f(sa + p.in[I_LBA][((size_t)l * 2 + d) * 256 + c]), ig = sigmoid_f(sx + p.in[I_LBX][((size_t)l * 2 + d) * 256 + c]);
        const float log_a = 8.0f * r * logsigmoid_f(p.in[I_LLAM][((size_t)l * 2 + d) * 256 + c]);
        p.LA[it] = expf(log_a); p.LB[it] = sqrtf(-expm1f(2.f * log_a)) * ig * p.XC[(size_t)t * 256 + c];
    }
    { constexpr int R = 8, NQ = 768 / 4; const float* W = p.in[I_WQB] + (size_t)l * QRANK * 768;
      for (long it = gtid; it < (long)(NT / R) * NQ; it += nthr) { const int mi = (int)(it / NQ), n = (int)(it % NQ) * 4;
        const float* a[R]; float4 acc[R];
#pragma unroll
        for (int r = 0; r < R; ++r) { a[r] = p.QN + (size_t)(mi * R + r) * QRANK; acc[r] = float4{0.f, 0.f, 0.f, 0.f}; }
        gemm_rx4<R>(a, W + n, 768, QRANK, acc);
#pragma unroll
        for (int r = 0; r < R; ++r) *(float4*)(p.QF + (size_t)(mi * R + r) * 768 + n) = acc[r]; } }
    { constexpr int R = 8, NQ = 1024 / 4; const float* W = p.in[I_WKVB] + (size_t)l * KVRANK * 1024;
      for (long it = gtid; it < (long)(NT / R) * NQ; it += nthr) { const int mi = (int)(it / NQ), n = (int)(it % NQ) * 4;
        const float* a[R]; float4 acc[R];
#pragma unroll
        for (int r = 0; r < R; ++r) { a[r] = p.KVN + (size_t)(mi * R + r) * KVRANK; acc[r] = float4{0.f, 0.f, 0.f, 0.f}; }
        gemm_rx4<R>(a, W + n, 1024, KVRANK, acc);
#pragma unroll
        for (int r = 0; r < R; ++r) *(float4*)(p.KVF + (size_t)(mi * R + r) * 1024 + n) = acc[r]; } }
    for (long it = gtid; it < (long)NT * 256; it += nthr) {
        const int t = (int)(it / 256), c = (int)(it % 256), h = c / 64, j = c % 64;
        const float* xc = p.XCM + (size_t)t * 256 + h * 64; const float* ux = p.U + (size_t)t * DIN + OFF_MX + h * 64;
        const float* wq = p.in[I_MWQ] + (((size_t)l * 4 + h) * 64) * 64 + j; const float* wk = p.in[I_MWK] + (((size_t)l * 4 + h) * 64) * 64 + j; const float* wv = p.in[I_MWV] + (((size_t)l * 4 + h) * 64) * 64 + j;
        float sq = 0.f, sk = 0.f, sv = 0.f;
        for (int i = 0; i < 64; ++i) { sq += xc[i] * wq[i * 64]; sk += xc[i] * wk[i * 64]; sv += ux[i] * wv[i * 64]; }
        p.QM[it] = sq; p.KM[it] = sk * 0.125f; p.VM[it] = sv;
    }
}

HD void nv_prep3(const P& p, int l, long gtid, long nthr) {
    for (long it = gtid; it < (long)NB * 2 * 256; it += nthr) {
        const int b = (int)(it / 512), d = (int)((it / 256) & 1), c = (int)(it % 256);
        const float* A = p.LA + (size_t)d * NT * 256; const float* Bc = p.LB + (size_t)d * NT * 256; float* Ho = p.HL + (size_t)d * NT * 256;
        float h = 0.f;
        for (int seg = 0; seg < 2; ++seg) { const int base = b * TPB + (seg == 0 ? 0 : CTX), len = seg == 0 ? CTX : SEQ;
            for (int s = 0; s < len; ++s) { const int t = base + (d == 0 ? s : len - 1 - s);
                h = A[(size_t)t * 256 + c] * h + Bc[(size_t)t * 256 + c]; Ho[(size_t)t * 256 + c] = h; } }
    }
    for (long it = gtid; it < (long)NT * AH; it += nthr) {
        const int t = (int)(it / AH), h = (int)(it % AH), i = tok_i(t); const bool lat = i >= CTX; const int s = i - CTX;
        const float* qf = p.QF + (size_t)t * 768 + h * QKD; const float* kvf = p.KVF + (size_t)t * 1024 + h * (NOPE + VD); const float* kr = p.U + (size_t)t * DIN + OFF_BKR;
        float* qo = p.Qr + ((size_t)t * AH + h) * QKD; float* ko = p.Kr + ((size_t)t * AH + h) * QKD; float* vo = p.Vr + ((size_t)t * AH + h) * VD;
        for (int k = 0; k < NOPE; ++k) { qo[k] = qf[k]; ko[k] = kvf[k]; vo[k] = kvf[NOPE + k]; }
        for (int a = 0; a < 2; ++a) for (int f = 0; f < 8; ++f) {
            float cs = 1.f, sn = 0.f; if (lat) { cs = p.ROPET[(((size_t)s * 2 + a) * 8 + f) * 2]; sn = p.ROPET[(((size_t)s * 2 + a) * 8 + f) * 2 + 1]; }
            const float q1 = qf[NOPE + a * 16 + f], q2 = qf[NOPE + a * 16 + 8 + f], k1 = kr[a * 16 + f], k2 = kr[a * 16 + 8 + f];
            qo[NOPE + a * 16 + f] = q1 * cs - q2 * sn; qo[NOPE + a * 16 + 8 + f] = q2 * cs + q1 * sn;
            ko[NOPE + a * 16 + f] = k1 * cs - k2 * sn; ko[NOPE + a * 16 + 8 + f] = k2 * cs + k1 * sn; }
    }
    for (long it = gtid; it < (long)2 * NT * 8; it += nthr) {
        const int d = (int)(it / ((long)NT * 8)), t = (int)((it / 8) % NT), g = (int)(it % 8);
        const float* w = p.in[I_MWG] + (((size_t)l * 2 + d) * 768) * 8 + g; float s = p.in[I_MBG][((size_t)l * 2 + d) * 8 + g];
        for (int i = 0; i < 256; ++i) s += p.QM[(size_t)t * 256 + i] * w[(size_t)i * 8];
        for (int i = 0; i < 256; ++i) s += p.KM[(size_t)t * 256 + i] * w[(size_t)(256 + i) * 8];
        for (int i = 0; i < 256; ++i) s += p.VM[(size_t)t * 256 + i] * w[(size_t)(512 + i) * 8];
        p.IGF[it] = g < 4 ? s : logsigmoid_f(s);
    }
}

HD void nv_attn(const P& p, long gtid, long nthr) {
    const float scale = 1.0f / sqrtf((float)QKD);
    for (long it = gtid; it < (long)NT * AH; it += nthr) {
        const int h = (int)((it / TPB) % AH), b = (int)(it / ((long)TPB * AH)), i = (int)(it % TPB), t = b * TPB + i;
        const int nk = i < CTX ? CTX : TPB;
        float q[QKD], o[VD];
#pragma unroll
        for (int k = 0; k < QKD; ++k) q[k] = p.Qr[((size_t)t * AH + h) * QKD + k] * scale;
#pragma unroll
        for (int k = 0; k < VD; ++k) o[k] = 0.f;
        float m = -1e30f, lsum = 0.f;
        for (int j = 0; j < nk; ++j) {
            const float* kk = p.Kr + ((size_t)(b * TPB + j) * AH + h) * QKD; const float* vv = p.Vr + ((size_t)(b * TPB + j) * AH + h) * VD;
            float s = 0.f;
#pragma unroll
            for (int k = 0; k < QKD; ++k) s += q[k] * kk[k];
            if (s > m) { const float f = expf(m - s); lsum *= f;
#pragma unroll
                for (int k = 0; k < VD; ++k) o[k] *= f;
                m = s; }
            const float pr = expf(s - m); lsum += pr;
#pragma unroll
            for (int k = 0; k < VD; ++k) o[k] += pr * vv[k];
        }
        const float inv = 1.f / lsum;
#pragma unroll
        for (int k = 0; k < VD; ++k) p.Y[(size_t)t * DMIX + 256 + h * VD + k] = o[k] * inv;
    }
}
HD void nv_mlstm_scan(const P& p, long gtid, long nthr) {
    for (long it = gtid; it < (long)NB * MLH * 2 * 64; it += nthr) {
        const int v = (int)(it % 64), d = (int)((it / 64) & 1), h = (int)((it / 128) % MLH), b = (int)(it / (128 * MLH));
        float C[64], n[64];
#pragma unroll
        for (int k = 0; k < 64; ++k) { C[k] = 0.f; n[k] = 0.f; }
        float m = 0.f;
        for (int seg = 0; seg < 2; ++seg) { const int base = b * TPB + (seg == 0 ? 0 : CTX), len = seg == 0 ? CTX : SEQ;
            for (int s = 0; s < len; ++s) { const int t = base + (d == 0 ? s : len - 1 - s);
                const float ig = p.IGF[((size_t)d * NT + t) * 8 + h], lf = p.IGF[((size_t)d * NT + t) * 8 + 4 + h];
                const float mn = fmaxf(lf + m, ig), fd = expf(lf + m - mn), iw = expf(ig - mn); m = mn;
                const float* qq = p.QM + (size_t)t * 256 + h * 64; const float* kk = p.KM + (size_t)t * 256 + h * 64; const float vv = p.VM[(size_t)t * 256 + h * 64 + v];
                float num = 0.f, den = 0.f;
#pragma unroll
                for (int k = 0; k < 64; ++k) { const float kv = kk[k], qv = qq[k]; C[k] = fd * C[k] + iw * vv * kv; n[k] = fd * n[k] + iw * kv; num += C[k] * qv; den += n[k] * qv; }
                p.HM[((size_t)d * NT + t) * 256 + h * 64 + v] = num / fmaxf(fabsf(den), expf(-mn)); } }
    }
}
HD void nv_lru_out(const P& p, long gtid, long nthr) {
    for (long it = gtid; it < (long)NT * 256; it += nthr) { const int t = (int)(it / 256), c = (int)(it % 256);
        p.Y[(size_t)t * DMIX + c] = (p.HL[it] + p.HL[(size_t)NT * 256 + it]) * gelu_f(p.U[(size_t)t * DIN + OFF_AG + c]); }
}
HD void nv_mlstm_finish(const P& p, int l, long gtid, long nthr) {
    for (long it = gtid; it < (long)NT * MLH; it += nthr) { const int t = (int)(it / MLH), h = (int)(it % MLH);
        const float* h0 = p.HM + (size_t)t * 256 + h * 64; const float* h1 = p.HM + ((size_t)NT + t) * 256 + h * 64;
        float mu = 0.f; for (int j = 0; j < 64; ++j) mu += h0[j] + h1[j]; mu *= (1.f / 64.f);
        float var = 0.f; for (int j = 0; j < 64; ++j) { const float dlt = h0[j] + h1[j] - mu; var += dlt * dlt; } var *= (1.f / 64.f);
        const float rstd = 1.f / sqrtf(var + EPS);
        for (int j = 0; j < 64; ++j) { const int c = h * 64 + j;
            const float y = (h0[j] + h1[j] - mu) * rstd * p.in[I_MNG][(size_t)l * 256 + c] + p.in[I_MSK][(size_t)l * 256 + c] * p.XCM[(size_t)t * 256 + c];
            p.Y[(size_t)t * DMIX + 768 + c] = y * silu_f(p.U[(size_t)t * DIN + OFF_MZ + c]); } }
}
HD void nv_outproj(const P& p, int l, long gtid, long nthr) {
    constexpr int R = 8, NQ = D / 4; const float* W = p.in[I_WOUT] + (size_t)l * DMIX * D;
    for (long it = gtid; it < (long)(NT / R) * NQ; it += nthr) { const int mi = (int)(it / NQ), n = (int)(it % NQ) * 4;
        const float* a[R]; float4 acc[R];
#pragma unroll
        for (int r = 0; r < R; ++r) { a[r] = p.Y + (size_t)(mi * R + r) * DMIX; acc[r] = float4{0.f, 0.f, 0.f, 0.f}; }
        gemm_rx4<R>(a, W + n, D, DMIX, acc);
#pragma unroll
        for (int r = 0; r < R; ++r) { const int t = mi * R + r; const float* g1 = modp(p, l, tok_cv(t), 2) + n; float* x = p.X + (size_t)t * D + n;
            x[0] += g1[0] * acc[r].x; x[1] += g1[1] * acc[r].y; x[2] += g1[2] * acc[r].z; x[3] += g1[3] * acc[r].w; } }
}
HD void nv_zero_cnt(const P& p, long gtid, long nthr) { for (long i = gtid; i < NE; i += nthr) p.CNT[i] = 0; }
HD void nv_router(const P& p, int l, long gtid, long nthr) {
    for (long t = gtid; t < NT; t += nthr) {
        float lg[NE]; const float* h = p.H + (size_t)t * D; const float* W = p.in[I_WR] + (size_t)l * D * NE;
#pragma unroll
        for (int e = 0; e < NE; ++e) lg[e] = p.in[I_BR][(size_t)l * NE + e];
        for (int k = 0; k < D; ++k) { const float hv = h[k];
#pragma unroll
            for (int e = 0; e < NE; ++e) lg[e] += hv * W[(size_t)k * NE + e]; }
        int te[TOPK]; float tv[TOPK];
#pragma unroll
        for (int r = 0; r < TOPK; ++r) { float best = -3.0e38f; int bi = 0;
#pragma unroll
            for (int e = 0; e < NE; ++e) { const bool c = lg[e] > best; best = c ? lg[e] : best; bi = c ? e : bi; }
            te[r] = bi; tv[r] = best;
#pragma unroll
            for (int e = 0; e < NE; ++e) lg[e] = (e == bi) ? -3.0e38f : lg[e]; }
        float s = 0.f, ex[TOPK];
#pragma unroll
        for (int r = 0; r < TOPK; ++r) { ex[r] = expf(tv[r] - tv[0]); s += ex[r]; }
#pragma unroll
        for (int r = 0; r < TOPK; ++r) { p.TOPE[t * TOPK + r] = te[r]; p.TOPG[t * TOPK + r] = ex[r] / s;
            const int pos = atomic_add_i(&p.CNT[te[r]], 1); p.LIST[(size_t)te[r] * NT + pos] = (int)t * TOPK + r; }
    }
}
HD bool moe_item(const P& p, int R, long grp, int& e, int& r0) {
    long acc = 0;
    for (int x = 0; x < NE; ++x) { const int c = p.CNT[x], ng = (c + R - 1) / R; if (grp < acc + ng) { e = x; r0 = (int)(grp - acc) * R; return true; } acc += ng; }
    return false;
}
HD long moe_groups(const P& p, int R) { long acc = 0; for (int x = 0; x < NE; ++x) acc += (p.CNT[x] + R - 1) / R; return acc; }
HD void nv_moe_gu(const P& p, int l, long gtid, long nthr) {
    constexpr int R = 8, NQ = DE / 4; const long ngrp = moe_groups(p, R);
    for (long it = gtid; it < ngrp * NQ; it += nthr) { int e, r0; moe_item(p, R, it / NQ, e, r0); const int n = (int)(it % NQ) * 4, cnt = p.CNT[e];
        const float* Wg = p.in[I_WGU] + ((size_t)l * NE + e) * D * 2 * DE; const float* bg = p.in[I_BGU] + ((size_t)l * NE + e) * 2 * DE;
        const float* a[R]; int pr[R]; float4 ag[R], al[R];
#pragma unroll
        for (int r = 0; r < R; ++r) { const int rr = r0 + r < cnt ? r0 + r : cnt - 1; pr[r] = p.LIST[(size_t)e * NT + rr]; a[r] = p.H + (size_t)(pr[r] / TOPK) * D; ag[r] = float4{0.f, 0.f, 0.f, 0.f}; al[r] = float4{0.f, 0.f, 0.f, 0.f}; }
        gemm_rx4<R>(a, Wg + n, 2 * DE, D, ag);
        gemm_rx4<R>(a, Wg + DE + n, 2 * DE, D, al);
#pragma unroll
        for (int r = 0; r < R; ++r) if (r0 + r < cnt) { float gv[4] = {ag[r].x + bg[n], ag[r].y + bg[n + 1], ag[r].z + bg[n + 2], ag[r].w + bg[n + 3]};
            float lv[4] = {al[r].x + bg[DE + n], al[r].y + bg[DE + n + 1], al[r].z + bg[DE + n + 2], al[r].w + bg[DE + n + 3]};
#pragma unroll
            for (int q = 0; q < 4; ++q) { const float glu = fminf(gv[q], 7.0f), lin = fminf(fmaxf(lv[q], -7.0f), 7.0f);
                p.ACT[(size_t)pr[r] * DE + n + q] = glu * sigmoid_f(1.702f * glu) * (lin + 1.f); } }
    }
}
HD void nv_moe_down(const P& p, int l, long gtid, long nthr) {
    constexpr int R = 8, NQ = D / 4; const long ngrp = moe_groups(p, R);
    for (long it = gtid; it < ngrp * NQ; it += nthr) { int e, r0; moe_item(p, R, it / NQ, e, r0); const int n = (int)(it % NQ) * 4, cnt = p.CNT[e];
        const float* Wd = p.in[I_WD] + ((size_t)l * NE + e) * DE * D; const float* bd = p.in[I_BD] + ((size_t)l * NE + e) * D;
        const float* a[R]; int pr[R]; float4 acc[R];
#pragma unroll
        for (int r = 0; r < R; ++r) { const int rr = r0 + r < cnt ? r0 + r : cnt - 1; pr[r] = p.LIST[(size_t)e * NT + rr]; a[r] = p.ACT + (size_t)pr[r] * DE; acc[r] = float4{0.f, 0.f, 0.f, 0.f}; }
        gemm_rx4<R>(a, Wd + n, D, DE, acc);
#pragma unroll
        for (int r = 0; r < R; ++r) if (r0 + r < cnt) { const float g = p.TOPG[pr[r]]; float* y = p.YB + (size_t)pr[r] * D + n;
            y[0] = g * (acc[r].x + bd[n]); y[1] = g * (acc[r].y + bd[n + 1]); y[2] = g * (acc[r].z + bd[n + 2]); y[3] = g * (acc[r].w + bd[n + 3]); }
    }
}
HD void nv_combine(const P& p, int l, long gtid, long nthr) {
    for (long it = gtid; it < (long)NT * D; it += nthr) { const int t = (int)(it / D), n = (int)(it % D);
        const float s = ((p.YB[((size_t)t * 4 + 0) * D + n] + p.YB[((size_t)t * 4 + 1) * D + n]) + p.YB[((size_t)t * 4 + 2) * D + n]) + p.YB[((size_t)t * 4 + 3) * D + n];
        p.X[it] += modp(p, l, tok_cv(t), 5)[n] * s; }
}
HD void nv_final(const P& p, long gtid, long nthr) {
    for (long r = gtid; r < (long)NB * SEQ; r += nthr) { const int b = (int)(r / SEQ), s = (int)(r % SEQ), t = b * TPB + CTX + s;
        const float* x = p.X + (size_t)t * D; float ss = 0.f;
        for (int k = 0; k < D; ++k) ss += x[k] * x[k];
        const float rstd = 1.f / sqrtf(ss / (float)D + EPS);
        for (int k = 0; k < D; ++k) p.out[(size_t)r * D + k] = x[k] * rstd * p.in[I_FG][k]; }
}

constexpr int PH_PER_LAYER = 13, N_PHASES = 1 + DEPTH * PH_PER_LAYER + 1;
HD void nv_run_phase(const P& p, int ph, long gtid, long nthr) {
    if (ph == 0) { nv_init(p, gtid, nthr); return; }
    if (ph == N_PHASES - 1) { nv_final(p, gtid, nthr); return; }
    const int l = (ph - 1) / PH_PER_LAYER, s = (ph - 1) % PH_PER_LAYER;
    switch (s) {
        case 0: nv_norm(p, l, 0, gtid, nthr); break;
        case 1: nv_inproj(p, l, gtid, nthr); break;
        case 2: nv_prep1(p, l, gtid, nthr); break;
        case 3: nv_prep2(p, l, gtid, nthr); break;
        case 4: nv_prep3(p, l, gtid, nthr); break;
        case 5: nv_mlstm_scan(p, gtid, nthr); nv_attn(p, gtid, nthr); nv_lru_out(p, gtid, nthr); break;
        case 6: nv_mlstm_finish(p, l, gtid, nthr); break;
        case 7: nv_outproj(p, l, gtid, nthr); break;
        case 8: nv_norm(p, l, 1, gtid, nthr); nv_zero_cnt(p, gtid, nthr); break;
        case 9: nv_router(p, l, gtid, nthr); break;
        case 10: nv_moe_gu(p, l, gtid, nthr); break;
        case 11: nv_moe_down(p, l, gtid, nthr); break;
        case 12: nv_combine(p, l, gtid, nthr); break;
    }
}

struct WsMap { size_t off[32]; size_t total; };
static inline WsMap ws_map() {
    WsMap m; size_t o = 0; int i = 0;
    auto add = [&](size_t n) { m.off[i++] = o; o += (n + 63) & ~(size_t)63; };
    add((size_t)DEPTH * 3 * 6 * D);
    add((size_t)SEQ * 16 * 2);
    add((size_t)NT * D);
    add((size_t)NT * D);
    add((size_t)NT * DIN);
    add((size_t)NT * 256);
    add((size_t)2 * NT * 256);
    add((size_t)2 * NT * 256);
    add((size_t)2 * NT * 256);
    add((size_t)NT * QRANK);
    add((size_t)NT * KVRANK);
    add((size_t)NT * 768);
    add((size_t)NT * 1024);
    add((size_t)NT * AH * QKD);
    add((size_t)NT * AH * QKD);
    add((size_t)NT * AH * VD);
    add((size_t)NT * 256);
    add((size_t)NT * 256);
    add((size_t)NT * 256);
    add((size_t)NT * 256);
    add((size_t)2 * NT * 8);
    add((size_t)2 * NT * 256);
    add((size_t)NT * DMIX);
    add((size_t)NT * TOPK);
    add((size_t)NT * TOPK * DE);
    add((size_t)NT * TOPK * D);
    add((size_t)NT * TOPK);
    add((size_t)64);
    add((size_t)NE * NT);
    m.total = o; return m;
}
static inline void fill_params(P& p, void* const* d_in, void* d_out, void* d_ws) {
    for (int i = 0; i < N_IN; ++i) p.in[i] = (const float*)d_in[i];
    p.out = (float*)d_out; float* w = (float*)d_ws; const WsMap m = ws_map();
    p.MOD = w + m.off[0]; p.ROPET = w + m.off[1]; p.X = w + m.off[2]; p.H = w + m.off[3]; p.U = w + m.off[4]; p.XC = w + m.off[5]; p.LA = w + m.off[6]; p.LB = w + m.off[7]; p.HL = w + m.off[8];
    p.QN = w + m.off[9]; p.KVN = w + m.off[10]; p.QF = w + m.off[11]; p.KVF = w + m.off[12]; p.Qr = w + m.off[13]; p.Kr = w + m.off[14]; p.Vr = w + m.off[15];
    p.XCM = w + m.off[16]; p.QM = w + m.off[17]; p.KM = w + m.off[18]; p.VM = w + m.off[19]; p.IGF = w + m.off[20]; p.HM = w + m.off[21]; p.Y = w + m.off[22];
    p.TOPG = w + m.off[23]; p.ACT = w + m.off[24]; p.YB = w + m.off[25]; p.TOPE = (int*)(w + m.off[26]); p.CNT = (int*)(w + m.off[27]); p.LIST = (int*)(w + m.off[28]);
}
extern __shared__ __attribute__((aligned(16))) unsigned char g_lds_base[];
constexpr int WTAB_OFF = 148480 - 64 - 256;
#define HWID() ((int)__builtin_amdgcn_s_getreg((5 << 11) | 4) & 63)
#if ONE_LAUNCH
__device__ __forceinline__ int tidx_() {
    unsigned z = 0u; asm volatile("" : "+v"(z));
    const int lane = (int)__builtin_amdgcn_mbcnt_hi(~0u, __builtin_amdgcn_mbcnt_lo(~0u, z));
    const int wv = __builtin_amdgcn_readfirstlane(((const volatile __attribute__((address_space(3))) int*)((__attribute__((address_space(3))) unsigned char*)g_lds_base + WTAB_OFF))[HWID()]);
    return wv * 64 + lane;
}
#define TIDX tidx_()
#else
#define TIDX ((int)threadIdx.x)
#endif
namespace pg8 {
#define PG8_LAS __attribute__((address_space(3)))
typedef unsigned short bf16_t;
typedef short bf16x8 __attribute__((ext_vector_type(8)));
typedef float f32x4 __attribute__((ext_vector_type(4)));
typedef unsigned u32x4 __attribute__((ext_vector_type(4)));
constexpr int BM = 256, BK = 64, HALF = 128, HTB = HALF * BK * 2  , STAGE_BYTES = 8 * HTB, NXCD = 8, WGM = 8;

__host__ __device__ __forceinline__ int lds_byte(int r, int c) { const int st = (r >> 4) * 2 + (c >> 5), rr = r & 15, cc = c & 31, ob = rr * 64 + cc * 2; return st * 1024 + (ob ^ (((ob >> 9) & 1) << 5)); }
__host__ __device__ __forceinline__ void stage_rc(int b, int& R, int& C) { const int st = b / 1024, sb = b % 1024, swz = sb ^ (((sb >> 9) & 1) << 5); R = (st >> 1) * 16 + swz / 64; C = (st & 1) * 32 + (swz % 64) / 2; }
__host__ __device__ __forceinline__ int perm32(int rho) { const int n = rho >> 4, i = rho & 15; return 8 * (i >> 2) + 4 * n + (i & 3); }

struct Unit { int pm, pn, e, mb; };
struct Gemm { const bf16_t* A; const bf16_t* Bt; int K; };

struct StaticOrder {
    int nM, nN, nwg, G, c;
    __device__ void init(int M, int N, int G_, int c_) { nM = M / BM; nN = N / BM; nwg = nM * nN; G = G_; c = c_; }
    __device__ bool next(int i, Unit& u) const {
        const long L = (long)i * G + c; if (L >= nwg) return false;
        int wgid = (int)L; { const int q = nwg / NXCD, r = nwg % NXCD, xcd = wgid % NXCD, off = wgid / NXCD; wgid = (xcd < r ? xcd * (q + 1) : r * (q + 1) + (xcd - r) * q) + off; }
        const int nig = WGM * nN, gid = wgid / nig, fm = gid * WGM, gsz = (nM - fm) < WGM ? (nM - fm) : WGM;
        u.pm = fm + ((wgid % nig) % gsz); u.pn = (wgid % nig) / gsz; u.e = 0; u.mb = 0; return true;
    }
    __device__ __forceinline__ int arow(const Unit& u, int r) const { return u.pm * BM + r; }
};

__device__ __forceinline__ unsigned cvt_pk_bf16(float lo, float hi) { unsigned r; asm volatile("v_cvt_pk_bf16_f32 %0, %1, %2" : "=v"(r) : "v"(lo), "v"(hi)); return r; }

template <class Epi, class Sched, bool ALIGN_EPI>
__device__ __forceinline__ void gemm_phase(PG8_LAS unsigned char* lds, const Gemm g, const Sched& S, const Epi& E) {
    int tid_ = TIDX; asm volatile("" : "+v"(tid_));
    const int tid = tid_, wid = __builtin_amdgcn_readfirstlane(tid >> 6), lane = tid & 63, wr = wid >> 2, wc = wid & 3, fr = lane & 15, fq = lane >> 4;
    const int K = g.K, nt = K / BK;
    unsigned voffB[2];
#pragma unroll
    for (int i = 0; i < 2; ++i) { int R, C; stage_rc(tid * 16 + i * 8192, R, C); const int Rb = Epi::PERM ? ((R & ~31) + perm32(R & 31)) : R;
        voffB[i] = (unsigned)(Rb * K + C) * 2u; }
    const size_t kstep = (size_t)(BK * 2);
    const size_t hstep = (size_t)HALF * K * 2;
    const size_t tstep = 2 * hstep;
    const unsigned ldsw = (unsigned)wid * 1024u;
    const int aoff = lds_byte(wr * 64 + fr, fq * 8), boff = lds_byte(wc * 32 + fr, fq * 8);
#define PG8_SA(b, h) (((b) * 2 + (h)) * HTB)
#define PG8_SB(b, h) ((4 + (b) * 2 + (h)) * HTB)
#define PG8_STAGE(bufoff, gbase, voff) do { _Pragma("unroll") for (int _i = 0; _i < 2; ++_i) \
        __builtin_amdgcn_global_load_lds((const unsigned*)((const char*)(gbase) + (voff)[_i]), (PG8_LAS unsigned*)(lds + (bufoff) + ldsw + _i * 8192), 16, 0, 0); } while (0)
#define PG8_LDA(dst, b, h) do { _Pragma("unroll") for (int m = 0; m < 4; ++m) _Pragma("unroll") for (int k = 0; k < 2; ++k) dst[m][k] = *(const PG8_LAS bf16x8*)(lds + PG8_SA(b, h) + aoff + m * 2048 + k * 1024); } while (0)
#define PG8_LDB(dst, b, h) do { _Pragma("unroll") for (int n = 0; n < 2; ++n) _Pragma("unroll") for (int k = 0; k < 2; ++k) dst[n][k] = *(const PG8_LAS bf16x8*)(lds + PG8_SB(b, h) + boff + n * 2048 + k * 1024); } while (0)
#define PG8_MMA(ai, bj, At, Bt) do { __builtin_amdgcn_s_setprio(1); _Pragma("unroll") for (int m = 0; m < 4; ++m) _Pragma("unroll") for (int n = 0; n < 2; ++n) _Pragma("unroll") for (int k = 0; k < 2; ++k) \
        acc[ai][bj][m][n] = __builtin_amdgcn_mfma_f32_16x16x32_bf16(Bt[n][k], At[m][k], acc[ai][bj][m][n], 0, 0, 0); __builtin_amdgcn_s_setprio(0); } while (0)
#define PG8_WAIT_V(n) asm volatile("s_waitcnt vmcnt(" #n ")" ::: "memory")
#define PG8_WAIT_L(n) asm volatile("s_waitcnt lgkmcnt(" #n ")" ::: "memory")
#define PG8_BAR __builtin_amdgcn_s_barrier()
#define PG8_SCHED __builtin_amdgcn_sched_barrier(0)
#define PG8_AOFFS(dst, U) do { int _t = tid; asm volatile("" : "+v"(_t)); _Pragma("unroll") for (int _i = 0; _i < 2; ++_i) { int _R, _C; stage_rc(_t * 16 + _i * 8192, _R, _C); \
        _Pragma("unroll") for (int _h = 0; _h < 2; ++_h) dst[_h][_i] = (unsigned)(S.arow(U, _h * HALF + _R) * K + _C) * 2u; } } while (0)
    Unit cur, nxt; int ui = 0;
    if (!S.next(0, cur)) return;
    f32x4 acc[2][2][4][2];
#pragma unroll
    for (int a = 0; a < 2; ++a)
#pragma unroll
        for (int b = 0; b < 2; ++b)
#pragma unroll
            for (int m = 0; m < 4; ++m)
#pragma unroll
                for (int n = 0; n < 2; ++n) acc[a][b][m][n] = (f32x4){0.f, 0.f, 0.f, 0.f};
    bf16x8 At[4][2], B0[2][2], B1[2][2];
    unsigned vA[2][2];
    PG8_AOFFS(vA, cur);
    const char* gA = (const char*)g.A;
    const char* cB = (const char*)g.Bt + (size_t)cur.pn * tstep;
    PG8_STAGE(PG8_SB(0, 0), cB, voffB); PG8_STAGE(PG8_SB(0, 1), cB + hstep, voffB); PG8_STAGE(PG8_SA(0, 0), gA, vA[0]); PG8_STAGE(PG8_SA(0, 1), gA, vA[1]);
    if (wr == 1) PG8_BAR;
    PG8_WAIT_V(2); PG8_BAR;
    PG8_STAGE(PG8_SB(1, 0), cB + kstep, voffB); PG8_STAGE(PG8_SA(1, 0), gA + kstep, vA[0]); PG8_STAGE(PG8_SB(1, 1), cB + hstep + kstep, voffB);
    PG8_WAIT_V(6); PG8_BAR;
    for (;;) {
        const bool has_next = S.next(ui + 1, nxt);
        { unsigned nvA[2][2];
          if (has_next) { PG8_AOFFS(nvA, nxt); } else {
#pragma unroll
            for (int h = 0; h < 2; ++h)
#pragma unroll
                for (int i = 0; i < 2; ++i) nvA[h][i] = vA[h][i]; }
          *(PG8_LAS u32x4*)(lds + STAGE_BYTES + 1024 + tid * 16) = (u32x4){nvA[0][0], nvA[0][1], nvA[1][0], nvA[1][1]}; }
        const char* nB = has_next ? (const char*)g.Bt + (size_t)nxt.pn * tstep : cB;
#pragma unroll 1
        for (int t = 0; t < nt; t += 2) {
            const bool last = (t == nt - 2);
            const char* a1 = gA + (size_t)(t + 1) * kstep;
            const char* a2 = last ? gA : gA + (size_t)(t + 2) * kstep; const char* b2 = last ? nB : cB + (size_t)(t + 2) * kstep;
            const char* a3 = a2 + kstep; const char* b3 = b2 + kstep;
            unsigned o2[2][2];
            if (last) { const u32x4 nv = *(const PG8_LAS u32x4*)(lds + STAGE_BYTES + 1024 + tid * 16); o2[0][0] = nv.x; o2[0][1] = nv.y; o2[1][0] = nv.z; o2[1][1] = nv.w; }
            else {
#pragma unroll
                for (int h = 0; h < 2; ++h)
#pragma unroll
                    for (int i = 0; i < 2; ++i) o2[h][i] = vA[h][i]; }
            PG8_LDB(B0, 0, 0); PG8_LDB(B1, 0, 1); PG8_SCHED; PG8_LDA(At, 0, 0); PG8_STAGE(PG8_SA(1, 1), a1, vA[1]);
            PG8_WAIT_V(8); PG8_WAIT_L(0); PG8_BAR; PG8_MMA(0, 0, At, B0); PG8_MMA(0, 1, At, B1); PG8_BAR; PG8_SCHED;
            PG8_LDA(At, 0, 1); PG8_STAGE(PG8_SB(0, 0), b2, voffB); PG8_STAGE(PG8_SB(0, 1), b2 + hstep, voffB); PG8_STAGE(PG8_SA(0, 0), a2, o2[0]);
            PG8_WAIT_V(8); PG8_WAIT_L(0); PG8_BAR; PG8_MMA(1, 0, At, B0); PG8_MMA(1, 1, At, B1); PG8_BAR; PG8_SCHED;
            PG8_LDB(B0, 1, 0); PG8_LDB(B1, 1, 1); PG8_SCHED; PG8_LDA(At, 1, 0); PG8_STAGE(PG8_SA(0, 1), a2, o2[1]);
            PG8_WAIT_V(8); PG8_WAIT_L(0); PG8_BAR; PG8_MMA(0, 0, At, B0); PG8_MMA(0, 1, At, B1); PG8_BAR; PG8_SCHED;
            PG8_LDA(At, 1, 1); PG8_STAGE(PG8_SB(1, 0), b3, voffB); PG8_STAGE(PG8_SB(1, 1), b3 + hstep, voffB); PG8_STAGE(PG8_SA(1, 0), a3, o2[0]);
            PG8_WAIT_V(8); PG8_WAIT_L(0); PG8_BAR; PG8_MMA(1, 0, At, B0); PG8_MMA(1, 1, At, B1); PG8_BAR; PG8_SCHED;
        }
        if constexpr (ALIGN_EPI) { if (wr == 0) PG8_BAR; }
        E(acc, cur, wr, wc, fr, fq);
        if (!has_next) break;
#pragma unroll
        for (int a = 0; a < 2; ++a)
#pragma unroll
            for (int b = 0; b < 2; ++b)
#pragma unroll
                for (int m = 0; m < 4; ++m)
#pragma unroll
                    for (int n = 0; n < 2; ++n) acc[a][b][m][n] = (f32x4){0.f, 0.f, 0.f, 0.f};
        cur = nxt; cB = nB; ++ui;
        { const u32x4 nv = *(const PG8_LAS u32x4*)(lds + STAGE_BYTES + 1024 + tid * 16); vA[0][0] = nv.x; vA[0][1] = nv.y; vA[1][0] = nv.z; vA[1][1] = nv.w; }
        if constexpr (ALIGN_EPI) { if (wr == 1) PG8_BAR; }
    }
    PG8_WAIT_V(0);
    if constexpr (!ALIGN_EPI) { if (wr == 0) PG8_BAR; }
    PG8_BAR;
#undef PG8_SA
#undef PG8_SB
#undef PG8_STAGE
#undef PG8_LDA
#undef PG8_LDB
#undef PG8_MMA
#undef PG8_WAIT_V
#undef PG8_WAIT_L
#undef PG8_BAR
#undef PG8_SCHED
#undef PG8_AOFFS
}
}
#define LAS __attribute__((address_space(3)))
typedef unsigned short bf16;
typedef float f32x4 __attribute__((ext_vector_type(4)));
typedef unsigned u32x4 __attribute__((ext_vector_type(4)));
typedef unsigned u32x2 __attribute__((ext_vector_type(2)));

constexpr int NWAVES = 8, NTHREADS = 512;
constexpr int DINP = 1536;
constexpr int SLOT_MAX = NT * TOPK + NE * 256;

struct Q {
    bf16 *WtIn, *WtOut, *WtGu, *WtDn, *WtQb, *WtKvb;
    bf16 *H16, *Y16, *ACT16, *K16, *V16;
};

__device__ __forceinline__ unsigned f2bf(float f) { unsigned u = __builtin_bit_cast(unsigned, f); return (u + 0x7fffu + ((u >> 16) & 1u)) >> 16; }
__device__ __forceinline__ unsigned pk2(float lo, float hi) { return f2bf(lo) | (f2bf(hi) << 16); }
__device__ __forceinline__ float bf2f(unsigned short b) { return __builtin_bit_cast(float, (unsigned)b << 16); }

__device__ __forceinline__ void transpose_item(const float* W, int N, bf16* WT, int ldk, int k0, int n0, int drow0, LAS float* scr, int lane) {
#pragma unroll 4
    for (int i = 0; i < 16; ++i) { const int kk = 4 * i + (lane >> 4), c4 = (lane & 15) * 4; const f32x4 v = *(const f32x4*)(W + (size_t)(k0 + kk) * N + n0 + c4);
        LAS float* d = scr + kk * 65 + c4; d[0] = v.x; d[1] = v.y; d[2] = v.z; d[3] = v.w; }
    asm volatile("s_waitcnt lgkmcnt(0)" ::: "memory");
#pragma unroll
    for (int j = 0; j < 8; ++j) { const int n = 8 * j + (lane >> 3), c = lane & 7; const LAS float* sp = scr + (8 * c) * 65 + n;
        u32x4 o; o.x = pk2(sp[0 * 65], sp[1 * 65]); o.y = pk2(sp[2 * 65], sp[3 * 65]); o.z = pk2(sp[4 * 65], sp[5 * 65]); o.w = pk2(sp[6 * 65], sp[7 * 65]);
        *(u32x4*)(WT + (size_t)(drow0 + n) * ldk + k0 + 8 * c) = o; }
    asm volatile("s_waitcnt lgkmcnt(0)" ::: "memory");
}
__device__ __forceinline__ void opt_convert_weights(const P& p, const Q& q, bf16* WtKvbP, LAS unsigned char* lds, int gw, int ngw, int wave, int lane) {
    LAS float* scr = (LAS float*)(lds + wave * 16640);
    constexpr int I_GU = (D / 64) * (2 * DE / 64), I_DN = (DE / 64) * (D / 64);
    constexpr int I_IN = (D / 64) * ((DIN + 63) / 64), I_OUT = (DMIX / 64) * (D / 64), I_QB = (QRANK / 64) * (768 / 64), I_KVB = (KVRANK / 64) * (1024 / 64);
    constexpr int PER_L = NE * (I_GU + I_DN) + I_IN + I_OUT + I_QB + I_KVB;
    for (int it = gw; it < DEPTH * PER_L; it += ngw) {
        const int l = it / PER_L; int r = it % PER_L;
        if (r < NE * I_GU) { const int e = r / I_GU, rr = r % I_GU, nb = 2 * DE / 64, kb = rr / nb, n0 = 64 * (rr % nb);
            const int isl = n0 >= DE, j0 = n0 - isl * DE, drow0 = 256 * (j0 / 128) + 128 * isl + (j0 % 128);
            transpose_item(p.in[I_WGU] + ((size_t)l * NE + e) * D * 2 * DE, 2 * DE, q.WtGu + ((size_t)l * NE + e) * 2 * DE * D, D, 64 * kb, n0, drow0, scr, lane); continue; } r -= NE * I_GU;
        if (r < NE * I_DN) { const int e = r / I_DN, rr = r % I_DN, nb = D / 64, kb = rr / nb, n0 = 64 * (rr % nb);
            transpose_item(p.in[I_WD] + ((size_t)l * NE + e) * DE * D, D, q.WtDn + ((size_t)l * NE + e) * D * DE, DE, 64 * kb, n0, n0, scr, lane); continue; } r -= NE * I_DN;
        if (r < I_IN) { const int nb = (DIN + 63) / 64, kb = r / nb, n0 = 64 * (r % nb);
            const int n0c = n0 + 64 <= DIN ? n0 : DIN - 64; transpose_item(p.in[I_WIN] + (size_t)l * D * DIN, DIN, q.WtIn + (size_t)l * DINP * D, D, 64 * kb, n0c, n0c, scr, lane); continue; } r -= I_IN;
        if (r < I_OUT) { const int nb = D / 64, kb = r / nb, n0 = 64 * (r % nb); transpose_item(p.in[I_WOUT] + (size_t)l * DMIX * D, D, q.WtOut + (size_t)l * D * DMIX, DMIX, 64 * kb, n0, n0, scr, lane); continue; } r -= I_OUT;
        if (r < I_QB) { const int nb = 768 / 64, kb = r / nb, n0 = 64 * (r % nb); transpose_item(p.in[I_WQB] + (size_t)l * QRANK * 768, 768, q.WtQb + (size_t)l * 768 * QRANK, QRANK, 64 * kb, n0, n0, scr, lane); continue; } r -= I_QB;
        { const int nb = 1024 / 64, kb = r / nb, n0 = 64 * (r % nb); transpose_item(p.in[I_WKVB] + (size_t)l * KVRANK * 1024, 1024, WtKvbP + (size_t)l * 1024 * 256, 256, 64 * kb, n0, n0, scr, lane); }
    }
    const long gt = (long)gw * 64 + lane, ngt = (long)ngw * 64;
    for (long i = gt; i < (long)DEPTH * (DINP - DIN) * D / 8; i += ngt) { const int l = (int)(i / ((DINP - DIN) * D / 8)); const long o = i % ((DINP - DIN) * D / 8);
        *(u32x4*)(q.WtIn + ((size_t)l * DINP + DIN) * D + o * 8) = (u32x4){0u, 0u, 0u, 0u}; }
    for (long i = gt; i < (long)DEPTH * 1024 * 16; i += ngt) *(u32x4*)(WtKvbP + (size_t)(i >> 4) * 256 + 128 + (i & 15) * 8) = (u32x4){0u, 0u, 0u, 0u};
}

struct EpiInprojF32 {
    static constexpr bool PERM = false; float* U;
    __device__ __forceinline__ void operator()(const pg8::f32x4 (&acc)[2][2][4][2], const pg8::Unit& u, int wr, int wc, int fr, int fq) const {
#pragma unroll
        for (int ai = 0; ai < 2; ++ai)
#pragma unroll
            for (int m = 0; m < 4; ++m) { const int row = u.pm * 256 + ai * 128 + wr * 64 + m * 16 + fr;
#pragma unroll
                for (int bj = 0; bj < 2; ++bj)
#pragma unroll
                    for (int n = 0; n < 2; ++n) { const int c = u.pn * 256 + bj * 128 + wc * 32 + n * 16 + 4 * fq; if (c < DIN) *(pg8::f32x4*)(U + (size_t)row * DIN + c) = acc[ai][bj][m][n]; } }
    }
};
struct EpiOutproj {
    static constexpr bool PERM = false; float* X; const float* mod;
    __device__ __forceinline__ void operator()(const pg8::f32x4 (&acc)[2][2][4][2], const pg8::Unit& u, int wr, int wc, int fr, int fq) const {
#pragma unroll
        for (int ai = 0; ai < 2; ++ai)
#pragma unroll
            for (int m = 0; m < 4; ++m) { const int row = u.pm * 256 + ai * 128 + wr * 64 + m * 16 + fr; const float* g1 = mod + ((size_t)tok_cv(row) * 6 + 2) * D;
#pragma unroll
                for (int bj = 0; bj < 2; ++bj)
#pragma unroll
                    for (int n = 0; n < 2; ++n) { const int c = u.pn * 256 + bj * 128 + wc * 32 + n * 16 + 4 * fq;
                        pg8::f32x4* xp = (pg8::f32x4*)(X + (size_t)row * D + c); const pg8::f32x4 gv = *(const pg8::f32x4*)(g1 + c); *xp = *xp + gv * acc[ai][bj][m][n]; } }
    }
};
struct GroupedOrder {
    const int* CNT; const int* LIST; const LAS int* ut;
    __device__ void init(const int* cnt, const int* list, int nN, int G, int c, LAS int* tab) { CNT = cnt; LIST = list; ut = tab + 64;
        __syncthreads();
        if (TIDX == 0) { int a = 0; for (int e = 0; e < NE; ++e) { tab[e] = a; a += (cnt[e] + 255) >> 8; } tab[NE] = a; }
        __syncthreads();
        if (TIDX < 16) { const int total = tab[NE] * nN; const long L = (long)TIDX * G + c; int pm = -1, pn = 0, e = 0, mb = 0;
            if (L < total) { int w = (int)L; { const int nx = pg8::NXCD, qq = total / nx, r = total % nx, xcd = w % nx, off = w / nx; w = (xcd < r ? xcd * (qq + 1) : r * (qq + 1) + (xcd - r) * qq) + off; }
                const int blk = w / nN, ntile = w % nN;
                for (int x = 1; x < NE; ++x) if (tab[x] <= blk) e = x;
                mb = blk - tab[e]; pm = blk; pn = e * nN + ntile; }
            tab[64 + TIDX * 4] = pm; tab[64 + TIDX * 4 + 1] = pn; tab[64 + TIDX * 4 + 2] = e; tab[64 + TIDX * 4 + 3] = mb; }
        __syncthreads(); }
    __device__ bool next(int i, pg8::Unit& u) const { if (i >= 16) return false; const int pm = ut[i * 4]; if (pm < 0) return false; u.pm = pm; u.pn = ut[i * 4 + 1]; u.e = ut[i * 4 + 2]; u.mb = ut[i * 4 + 3]; return true; }
};
struct GuOrder : GroupedOrder {
    __device__ __forceinline__ int arow(const pg8::Unit& u, int r) const { const int idx = u.mb * 256 + r; return idx < CNT[u.e] ? (LIST[(size_t)u.e * NT + idx] >> 2) : 0; }
};
struct DnOrder : GroupedOrder {
    __device__ __forceinline__ int arow(const pg8::Unit& u, int r) const { return u.pm * 256 + r; }
};
struct EpiGu {
    static constexpr bool PERM = true; bf16* ACT; const float* bgu;   int nN; int probe_skip;
    __device__ __forceinline__ void operator()(const pg8::f32x4 (&acc)[2][2][4][2], const pg8::Unit& u, int wr, int wc, int fr, int fq) const {
        if (probe_skip) return;
        const int ntile = u.pn - u.e * nN, j0 = ntile * 128 + wc * 32 + 8 * fq; const float* bg = bgu + (size_t)u.e * 2 * DE;
        float bgl[8], bli[8];
#pragma unroll
        for (int x = 0; x < 8; ++x) { bgl[x] = bg[j0 + x]; bli[x] = bg[DE + j0 + x]; }
#pragma unroll
        for (int ai = 0; ai < 2; ++ai)
#pragma unroll
            for (int m = 0; m < 4; ++m) { const int row = u.pm * 256 + ai * 128 + wr * 64 + m * 16 + fr; float a[8];
#pragma unroll
                for (int n = 0; n < 2; ++n)
#pragma unroll
                    for (int x = 0; x < 4; ++x) { const float glu = fminf(acc[ai][0][m][n][x] + bgl[4 * n + x], 7.0f), lin = fminf(fmaxf(acc[ai][1][m][n][x] + bli[4 * n + x], -7.0f), 7.0f);
                        a[4 * n + x] = glu * __builtin_amdgcn_rcpf(1.f + __builtin_amdgcn_exp2f(-2.4554669595930157f * glu)) * (lin + 1.f); }
                u32x4 w; w.x = pg8::cvt_pk_bf16(a[0], a[1]); w.y = pg8::cvt_pk_bf16(a[2], a[3]); w.z = pg8::cvt_pk_bf16(a[4], a[5]); w.w = pg8::cvt_pk_bf16(a[6], a[7]);
                *(u32x4*)(ACT + (size_t)row * DE + j0) = w; }
    }
};
struct EpiDownF32 {
    static constexpr bool PERM = false; float* YB; const float* bd;   const float* TOPG; const int* CNT; const int* LIST; int nN;
    __device__ __forceinline__ void operator()(const pg8::f32x4 (&acc)[2][2][4][2], const pg8::Unit& u, int wr, int wc, int fr, int fq) const {
        const int ntile = u.pn - u.e * nN, cnt = CNT[u.e]; const float* b = bd + (size_t)u.e * D;
#pragma unroll
        for (int ai = 0; ai < 2; ++ai)
#pragma unroll
            for (int m = 0; m < 4; ++m) { const int idx = u.mb * 256 + ai * 128 + wr * 64 + m * 16 + fr;
                if (idx < cnt) { const int pr = LIST[(size_t)u.e * NT + idx]; const float g = TOPG[pr];
#pragma unroll
                    for (int bj = 0; bj < 2; ++bj)
#pragma unroll
                        for (int n = 0; n < 2; ++n) { const int c = ntile * 256 + bj * 128 + wc * 32 + n * 16 + 4 * fq; const pg8::f32x4 bv = *(const pg8::f32x4*)(b + c);
                            *(pg8::f32x4*)(YB + (size_t)pr * D + c) = (acc[ai][bj][m][n] + bv) * g; } } }
    }
};

__device__ __forceinline__ void opt_inproj(const P& p, const Q& q, int l, LAS unsigned char* lds, int G, int bid) {
    pg8::Gemm g{q.H16, q.WtIn + (size_t)l * DINP * D, D}; pg8::StaticOrder S; S.init(NT, DINP, G, bid);
    EpiInprojF32 E{p.U}; pg8::gemm_phase<EpiInprojF32, pg8::StaticOrder, true>(lds, g, S, E);
}
struct LatentOrder : pg8::StaticOrder {
    __device__ bool next(int i, pg8::Unit& u) const { if (!pg8::StaticOrder::next(i, u)) return false; constexpr int TL = SEQ / 256, TC = CTX / 256; u.pm = (u.pm / TL) * (TL + TC) + TC + u.pm % TL; return true; }
};
__device__ __forceinline__ void opt_outproj(const P& p, const Q& q, int l, LAS unsigned char* lds, int G, int bid, bool latent_only) {
    pg8::Gemm g{q.Y16, q.WtOut + (size_t)l * D * DMIX, DMIX}; EpiOutproj E{p.X, p.MOD + (size_t)l * 3 * 6 * D};
    if (latent_only) { LatentOrder S; S.init(NB * SEQ, D, G, bid); pg8::gemm_phase<EpiOutproj, LatentOrder, true>(lds, g, S, E); }
    else { pg8::StaticOrder S; S.init(NT, D, G, bid); pg8::gemm_phase<EpiOutproj, pg8::StaticOrder, true>(lds, g, S, E); }
}
__device__ __forceinline__ void opt_moe_gu(const P& p, const Q& q, int l, LAS unsigned char* lds, int G, int bid, int probe_skip = 0) {
    pg8::Gemm g{q.H16, q.WtGu + (size_t)l * NE * 2 * DE * D, D}; GuOrder S; S.init(p.CNT, p.LIST, 2 * DE / 256, G, bid, (LAS int*)(lds + pg8::STAGE_BYTES));
    EpiGu E{q.ACT16, p.in[I_BGU] + (size_t)l * NE * 2 * DE, 2 * DE / 256, probe_skip}; pg8::gemm_phase<EpiGu, GuOrder, true>(lds, g, S, E);
}
__device__ __forceinline__ void opt_moe_down(const P& p, const Q& q, int l, LAS unsigned char* lds, int G, int bid) {
    pg8::Gemm g{q.ACT16, q.WtDn + (size_t)l * NE * D * DE, DE}; DnOrder S; S.init(p.CNT, p.LIST, D / 256, G, bid, (LAS int*)(lds + pg8::STAGE_BYTES));
    EpiDownF32 E{p.YB, p.in[I_BD] + (size_t)l * NE * D, p.TOPG, p.CNT, p.LIST, D / 256}; pg8::gemm_phase<EpiDownF32, DnOrder, true>(lds, g, S, E);
}
namespace att {
using bf16x8 = __attribute__((ext_vector_type(8))) short;
using s16x4  = __attribute__((ext_vector_type(4))) short;
using f32x16 = __attribute__((ext_vector_type(16))) float;
using f32x8  = __attribute__((ext_vector_type(8))) float;
using u32x4  = __attribute__((ext_vector_type(4))) unsigned;
constexpr int DK = 96, DV = 64, NW = 8, QBLK = 32, KVBLK = 64;
constexpr float SCALE = 0.10206207261596575f;
#ifndef ATTN_THR
#define ATTN_THR 8.f
#endif
constexpr float THR = ATTN_THR;
#ifndef ATTN_SM_SPLIT
#define ATTN_SM_SPLIT 0
#endif
constexpr int KROW = 208;
constexpr int SHM_K = KVBLK * KROW, SHM_V = KVBLK * DV * 2;
constexpr int SHM_ATTN = 2 * SHM_V + 2 * SHM_K + NW * 64 * 4;
#define KSWZ(row, colB) ((row) * KROW + (colB))
#define SBAR() __builtin_amdgcn_sched_barrier(0)
__device__ __forceinline__ int crow(int r, int hi) { return (r & 3) + 8 * (r >> 2) + 4 * hi; }
__device__ __forceinline__ unsigned cvtpk(float lo, float hi) { unsigned r; asm volatile("v_cvt_pk_bf16_f32 %0, %1, %2" : "=v"(r) : "v"(lo), "v"(hi)); return r; }
__device__ __forceinline__ bf16x8 tobf(f32x8 x) { u32x4 w = {cvtpk(x[0], x[1]), cvtpk(x[2], x[3]), cvtpk(x[4], x[5]), cvtpk(x[6], x[7])}; return *reinterpret_cast<bf16x8*>(&w); }

__device__ __forceinline__ void partialSM(f32x16& p0, f32x16& p1, float& m_reg, float& mn, float& alpha) {
  constexpr float C = SCALE * 1.4426950408889634f;
  float pmax = p0[0];
#pragma unroll
  for (int r = 1; r < 16; ++r) pmax = fmaxf(pmax, p0[r]);
#pragma unroll
  for (int r = 0; r < 16; ++r) pmax = fmaxf(pmax, p1[r]);
  { auto rr = __builtin_amdgcn_permlane32_swap(__float_as_uint(pmax), __float_as_uint(pmax), false, false);
    pmax = fmaxf(__uint_as_float(rr[0]), __uint_as_float(rr[1])); }
#if ATTN_SM_SPLIT == 2
  { const bool keep = __all(pmax - m_reg <= THR / SCALE); mn = keep ? m_reg : fmaxf(m_reg, pmax); alpha = __builtin_amdgcn_exp2f((m_reg - mn) * C); m_reg = mn;
    const float mnC = -mn * C;
#pragma unroll
    for (int r = 0; r < 16; ++r) { p0[r] = __builtin_amdgcn_exp2f(fmaf(p0[r], C, mnC)); p1[r] = __builtin_amdgcn_exp2f(fmaf(p1[r], C, mnC)); } }
  return;
#endif
  if (__builtin_expect(__all(pmax - m_reg <= THR / SCALE), 1)) { mn = m_reg; alpha = 1.f; }
  else { mn = fmaxf(m_reg, pmax); alpha = __builtin_amdgcn_exp2f((m_reg - mn) * C); m_reg = mn; }
#if ATTN_SM_SPLIT == 1
  const float mnC = -mn * C;
#pragma unroll
  for (int r = 0; r < 16; ++r) p0[r] = fmaf(p0[r], C, mnC);
#pragma unroll
  for (int r = 0; r < 16; ++r) p1[r] = fmaf(p1[r], C, mnC);
#pragma unroll
  for (int r = 0; r < 16; ++r) p0[r] = __builtin_amdgcn_exp2f(p0[r]);
#endif
}
__device__ __forceinline__ void finishSM(f32x16& p0, f32x16& p1, float mn, float alpha, float& l_reg, bf16x8& pa0, bf16x8& pa1, bf16x8& pa2, bf16x8& pa3) {
#if ATTN_SM_SPLIT == 1
#pragma unroll
  for (int r = 0; r < 16; ++r) p1[r] = __builtin_amdgcn_exp2f(p1[r]);
#elif ATTN_SM_SPLIT == 2
  (void)mn;
#else
  { constexpr float C = SCALE * 1.4426950408889634f; const float mnC = -mn * C;
#pragma unroll
    for (int r = 0; r < 16; ++r) { p0[r] = __builtin_amdgcn_exp2f(fmaf(p0[r], C, mnC)); p1[r] = __builtin_amdgcn_exp2f(fmaf(p1[r], C, mnC)); } }
#endif
  float ps = 0;
#pragma unroll
  for (int r = 0; r < 16; ++r) ps += p0[r];
#pragma unroll
  for (int r = 0; r < 16; ++r) ps += p1[r];
  { auto rr = __builtin_amdgcn_permlane32_swap(__float_as_uint(ps), __float_as_uint(ps), false, false);
    ps = __uint_as_float(rr[0]) + __uint_as_float(rr[1]); }
  l_reg = l_reg * alpha + ps;
#define PK4(P, BASE, OUT) do { unsigned a0 = cvtpk(P[BASE + 0], P[BASE + 1]), a1 = cvtpk(P[BASE + 2], P[BASE + 3]);   \
    unsigned b0 = cvtpk(P[BASE + 4], P[BASE + 5]), b1 = cvtpk(P[BASE + 6], P[BASE + 7]);                              \
    auto r0 = __builtin_amdgcn_permlane32_swap(a0, b0, false, false); auto r1 = __builtin_amdgcn_permlane32_swap(a1, b1, false, false); \
    u32x4 w = {r0[0], r1[0], r0[1], r1[1]}; OUT = *reinterpret_cast<bf16x8*>(&w); } while (0)
  PK4(p0, 0, pa0); PK4(p0, 8, pa1); PK4(p1, 0, pa2); PK4(p1, 8, pa3);
#undef PK4
}
__device__ __forceinline__ void qkt(f32x16& p0, f32x16& p1, const char* Ks, const bf16x8* qr, int r32, int hi) {
  p0 = f32x16{}; p1 = f32x16{};
#pragma unroll
  for (int d0 = 0; d0 < DK / 16; ++d0) { const int cb = (d0 * 16 + hi * 8) * 2;
    const bf16x8 b0 = *reinterpret_cast<const bf16x8*>(Ks + KSWZ(r32, cb));
    const bf16x8 b1 = *reinterpret_cast<const bf16x8*>(Ks + KSWZ(32 + r32, cb));
    p0 = __builtin_amdgcn_mfma_f32_32x32x16_bf16(b0, qr[d0], p0, 0, 0, 0);
    p1 = __builtin_amdgcn_mfma_f32_32x32x16_bf16(b1, qr[d0], p1, 0, 0, 0); }
}
__device__ __forceinline__ int v_st(int k, int c) { const int kk = (k & ~0xC) | ((k & 4) << 1) | ((k & 8) >> 1); return ((kk >> 3) * 2 + (c >> 5)) * 512 + ((kk & 7) * 32 + (c & 31)) * 2; }
__device__ __forceinline__ int v_rd_base(int lane) { return ((lane & 3) << 3) | (((lane >> 2) & 3) << 6) | (((lane >> 4) & 1) << 5) | (((lane >> 5) & 1) << 8); }
constexpr int v_rd_off(int d0, int ks, int half) { return d0 * 512 + ks * 2048 + half * 1024; }
template <int OFF> __device__ __forceinline__ s16x4 tr_read(int vb) {
  s16x4 r; asm volatile("ds_read_b64_tr_b16 %0, %1 offset:%2" : "=&v"(r) : "v"(vb), "i"(OFF) : "memory"); return r;
}
template <int D0> __device__ __forceinline__ void pv_one(f32x16& od, int vb, bf16x8 pa0, bf16x8 pa1, bf16x8 pa2, bf16x8 pa3) {
  const s16x4 l0 = tr_read<v_rd_off(D0, 0, 0)>(vb), h0 = tr_read<v_rd_off(D0, 0, 1)>(vb), l1 = tr_read<v_rd_off(D0, 1, 0)>(vb), h1 = tr_read<v_rd_off(D0, 1, 1)>(vb);
  const s16x4 l2 = tr_read<v_rd_off(D0, 2, 0)>(vb), h2 = tr_read<v_rd_off(D0, 2, 1)>(vb), l3 = tr_read<v_rd_off(D0, 3, 0)>(vb), h3 = tr_read<v_rd_off(D0, 3, 1)>(vb);
  asm volatile("s_waitcnt lgkmcnt(0)" ::: "memory"); SBAR();
#define PK(L, H) (bf16x8){L[0], L[1], L[2], L[3], H[0], H[1], H[2], H[3]}
  od = __builtin_amdgcn_mfma_f32_32x32x16_bf16(pa0, PK(l0, h0), od, 0, 0, 0);
  od = __builtin_amdgcn_mfma_f32_32x32x16_bf16(pa1, PK(l1, h1), od, 0, 0, 0);
  od = __builtin_amdgcn_mfma_f32_32x32x16_bf16(pa2, PK(l2, h2), od, 0, 0, 0);
  od = __builtin_amdgcn_mfma_f32_32x32x16_bf16(pa3, PK(l3, h3), od, 0, 0, 0);
#undef PK
}
__device__ __forceinline__ void pv_d0(f32x16* o, int vb, bf16x8 pa0, bf16x8 pa1, bf16x8 pa2, bf16x8 pa3) {
  pv_one<0>(o[0], vb, pa0, pa1, pa2, pa3); pv_one<1>(o[1], vb, pa0, pa1, pa2, pa3);
}

__device__ __forceinline__ void pv_sm(f32x16* o, int vb, bf16x8 pa0, bf16x8 pa1, bf16x8 pa2, bf16x8 pa3, f32x16& p0, f32x16& p1, float& m_reg, float& mn, float& alpha) {
  constexpr float C = SCALE * 1.4426950408889634f;
  const s16x4 l00 = tr_read<v_rd_off(0, 0, 0)>(vb), h00 = tr_read<v_rd_off(0, 0, 1)>(vb), l10 = tr_read<v_rd_off(1, 0, 0)>(vb), h10 = tr_read<v_rd_off(1, 0, 1)>(vb);
  const s16x4 l01 = tr_read<v_rd_off(0, 1, 0)>(vb), h01 = tr_read<v_rd_off(0, 1, 1)>(vb), l11 = tr_read<v_rd_off(1, 1, 0)>(vb), h11 = tr_read<v_rd_off(1, 1, 1)>(vb);
  const s16x4 l02 = tr_read<v_rd_off(0, 2, 0)>(vb), h02 = tr_read<v_rd_off(0, 2, 1)>(vb), l12 = tr_read<v_rd_off(1, 2, 0)>(vb), h12 = tr_read<v_rd_off(1, 2, 1)>(vb);
  const s16x4 l03 = tr_read<v_rd_off(0, 3, 0)>(vb), h03 = tr_read<v_rd_off(0, 3, 1)>(vb), l13 = tr_read<v_rd_off(1, 3, 0)>(vb), h13 = tr_read<v_rd_off(1, 3, 1)>(vb);
  float pmax = p0[0];
#pragma unroll
  for (int r = 1; r < 16; ++r) pmax = fmaxf(pmax, p0[r]);
#pragma unroll
  for (int r = 0; r < 16; ++r) pmax = fmaxf(pmax, p1[r]);
  { auto rr = __builtin_amdgcn_permlane32_swap(__float_as_uint(pmax), __float_as_uint(pmax), false, false);
    pmax = fmaxf(__uint_as_float(rr[0]), __uint_as_float(rr[1])); }
  const bool keep = __all(pmax - m_reg <= THR / SCALE); mn = keep ? m_reg : fmaxf(m_reg, pmax); alpha = __builtin_amdgcn_exp2f((m_reg - mn) * C); m_reg = mn;
  const float mnC = -mn * C;
  asm volatile("s_waitcnt lgkmcnt(0)" ::: "memory"); SBAR();
#define PK(L, H) (bf16x8){L[0], L[1], L[2], L[3], H[0], H[1], H[2], H[3]}
#define EX4(P, B) do { P[B] = __builtin_amdgcn_exp2f(fmaf(P[B], C, mnC)); P[B + 1] = __builtin_amdgcn_exp2f(fmaf(P[B + 1], C, mnC)); P[B + 2] = __builtin_amdgcn_exp2f(fmaf(P[B + 2], C, mnC)); P[B + 3] = __builtin_amdgcn_exp2f(fmaf(P[B + 3], C, mnC)); } while (0)
  o[0] = __builtin_amdgcn_mfma_f32_32x32x16_bf16(pa0, PK(l00, h00), o[0], 0, 0, 0); EX4(p0, 0); SBAR();
  o[1] = __builtin_amdgcn_mfma_f32_32x32x16_bf16(pa0, PK(l10, h10), o[1], 0, 0, 0); EX4(p0, 4); SBAR();
  o[0] = __builtin_amdgcn_mfma_f32_32x32x16_bf16(pa1, PK(l01, h01), o[0], 0, 0, 0); EX4(p0, 8); SBAR();
  o[1] = __builtin_amdgcn_mfma_f32_32x32x16_bf16(pa1, PK(l11, h11), o[1], 0, 0, 0); EX4(p0, 12); SBAR();
  o[0] = __builtin_amdgcn_mfma_f32_32x32x16_bf16(pa2, PK(l02, h02), o[0], 0, 0, 0); EX4(p1, 0); SBAR();
  o[1] = __builtin_amdgcn_mfma_f32_32x32x16_bf16(pa2, PK(l12, h12), o[1], 0, 0, 0); EX4(p1, 4); SBAR();
  o[0] = __builtin_amdgcn_mfma_f32_32x32x16_bf16(pa3, PK(l03, h03), o[0], 0, 0, 0); EX4(p1, 8); SBAR();
  o[1] = __builtin_amdgcn_mfma_f32_32x32x16_bf16(pa3, PK(l13, h13), o[1], 0, 0, 0); EX4(p1, 12); SBAR();
#undef PK
#undef EX4
}

template <class TQ, class Out, int VAR = 0>
__device__ __forceinline__ void attn_unit(const TQ* Qb, int ldq, const unsigned short* Kh, const unsigned short* Vh, int seq, char* lds, const Out& OUT) {
  int tid_ = TIDX; asm volatile("" : "+v"(tid_));
  const int tid = tid_, wid = tid >> 6, lane = tid & 63, r32 = lane & 31, hi = lane >> 5;
  char* V_lds = lds; char* K_lds = lds + 2 * SHM_V;
  float* ws = (float*)(lds + 2 * SHM_V + 2 * SHM_K) + wid * 64; float* li_l = ws; float* al_l = ws + 32;
  float m_reg = -1e30f, l_reg = 0; f32x16 o[2] = {}; bf16x8 qr[DK / 16];
  { const TQ* Qw = Qb + (long)(wid * QBLK + r32) * ldq + hi * 8;
#pragma unroll
    for (int d0 = 0; d0 < DK / 16; ++d0) {
      if constexpr (sizeof(TQ) == 4) qr[d0] = tobf(*reinterpret_cast<const f32x8*>(Qw + d0 * 16)); else qr[d0] = *reinterpret_cast<const bf16x8*>(Qw + d0 * 16); } }
  const int kc0 = tid, kc1 = 512 + tid; const bool two = tid < 256;
  const int kst0 = KSWZ(kc0 / 12, (kc0 % 12) * 16), kst1 = KSWZ(kc1 / 12, (kc1 % 12) * 16), vst = v_st(tid >> 3, (tid & 7) * 8);
  const int vb0 = (int)(uintptr_t)V_lds + v_rd_base(lane);
  struct { bf16x8 v, k0, k1; } sr_[2];
#define SLOAD(i, key0) do { sr_[i].v = *reinterpret_cast<const bf16x8*>(Vh + (long)(key0) * DV + tid * 8); sr_[i].k0 = *reinterpret_cast<const bf16x8*>(Kh + (long)(key0) * DK + kc0 * 8); \
    if (two) sr_[i].k1 = *reinterpret_cast<const bf16x8*>(Kh + (long)(key0) * DK + kc1 * 8); } while (0)
#define SWRITE(b, i) do { *(bf16x8*)(V_lds + (b) * SHM_V + vst) = sr_[i].v; *(bf16x8*)(K_lds + (b) * SHM_K + kst0) = sr_[i].k0; if (two) *(bf16x8*)(K_lds + (b) * SHM_K + kst1) = sr_[i].k1; } while (0)
#define RESC(a) do { if (__any((a) < 1.f)) { if (hi == 0) al_l[r32] = (a); asm volatile("s_waitcnt lgkmcnt(0)" ::: "memory"); \
    _Pragma("unroll") for (int d = 0; d < 2; ++d) _Pragma("unroll") for (int r = 0; r < 16; ++r) o[d][r] *= al_l[crow(r, hi)]; } } while (0)
  f32x16 pA0 = {}, pA1 = {}, pB0 = {}, pB1 = {}; float mnA, mnB, alA, alB; bf16x8 pa0, pa1, pa2, pa3; const int NT = seq / KVBLK;
  constexpr int SE = 0, SO = 1;
#define PSM(p0_, p1_, m_, mn_, al_) do { if constexpr (VAR == 1) { mn_ = 0.f; al_ = 1.f; } else partialSM(p0_, p1_, m_, mn_, al_); } while (0)
#define FSM(p0_, p1_, mn_, al_, l_, a0_, a1_, a2_, a3_) do { if constexpr (VAR == 1) { u32x4 w0_ = {cvtpk(p0_[0], p0_[1]), cvtpk(p0_[2], p0_[3]), cvtpk(p0_[4], p0_[5]), cvtpk(p0_[6], p0_[7])}; a0_ = *reinterpret_cast<bf16x8*>(&w0_); \
      u32x4 w1_ = {cvtpk(p0_[8], p0_[9]), cvtpk(p0_[10], p0_[11]), cvtpk(p0_[12], p0_[13]), cvtpk(p0_[14], p0_[15])}; a1_ = *reinterpret_cast<bf16x8*>(&w1_); \
      u32x4 w2_ = {cvtpk(p1_[0], p1_[1]), cvtpk(p1_[2], p1_[3]), cvtpk(p1_[4], p1_[5]), cvtpk(p1_[6], p1_[7])}; a2_ = *reinterpret_cast<bf16x8*>(&w2_); \
      u32x4 w3_ = {cvtpk(p1_[8], p1_[9]), cvtpk(p1_[10], p1_[11]), cvtpk(p1_[12], p1_[13]), cvtpk(p1_[14], p1_[15])}; a3_ = *reinterpret_cast<bf16x8*>(&w3_); } else finishSM(p0_, p1_, mn_, al_, l_, a0_, a1_, a2_, a3_); } while (0)
#define PVSM(o_, vb_, a0_, a1_, a2_, a3_, p0_, p1_, m_, mn_, al_) do { if constexpr (VAR == 0 && ATTN_SM_SPLIT == 2) pv_sm(o_, vb_, a0_, a1_, a2_, a3_, p0_, p1_, m_, mn_, al_); else { PVD(o_, vb_, a0_, a1_, a2_, a3_); PSM(p0_, p1_, m_, mn_, al_); } } while (0)
#define PVD(o_, vb_, a0_, a1_, a2_, a3_) do { if constexpr (VAR == 2) { asm volatile("" : "+v"(o_[0]), "+v"(o_[1]) : "v"(a0_), "v"(a1_), "v"(a2_), "v"(a3_)); } else pv_d0(o_, vb_, a0_, a1_, a2_, a3_); } while (0)
#define QKT(p0_, p1_, K_, q_, r_, h_) do { if constexpr (VAR == 5) { asm volatile("" : "+v"(p0_), "+v"(p1_)); } else qkt(p0_, p1_, K_, q_, r_, h_); } while (0)
#define LSLOAD(i_, k_) do { if constexpr (VAR != 3) SLOAD(i_, k_); } while (0)
#define LSWRITE(b_, i_) do { if constexpr (VAR != 3) SWRITE(b_, i_); } while (0)
#define LSYNC() do { if constexpr (VAR != 4) __syncthreads(); } while (0)
  SLOAD(SE, 0); asm volatile("s_waitcnt vmcnt(0)" ::: "memory"); SWRITE(0, SE); __syncthreads();
  QKT(pA0, pA1, K_lds, qr, r32, hi); PSM(pA0, pA1, m_reg, mnA, alA);
  SLOAD(SO, KVBLK); if (2 < NT) SLOAD(SE, 2 * KVBLK);
  SWRITE(1, SO); __syncthreads();
  for (int j = 1; j + 1 < NT; j += 2) {
    SBAR(); QKT(pB0, pB1, K_lds + SHM_K, qr, r32, hi);
    FSM(pA0, pA1, mnA, alA, l_reg, pa0, pa1, pa2, pa3); SBAR();
    LSLOAD(SO, (j + 2) * KVBLK); SBAR();
    PVSM(o, vb0, pa0, pa1, pa2, pa3, pB0, pB1, m_reg, mnB, alB);
    LSYNC(); LSWRITE(0, SE);
    RESC(alB); LSYNC();
    SBAR(); QKT(pA0, pA1, K_lds, qr, r32, hi);
    FSM(pB0, pB1, mnB, alB, l_reg, pa0, pa1, pa2, pa3); SBAR();
    if (j + 3 < NT) LSLOAD(SE, (j + 3) * KVBLK); SBAR();
    PVSM(o, vb0 + SHM_V, pa0, pa1, pa2, pa3, pA0, pA1, m_reg, mnA, alA);
    LSYNC(); LSWRITE(1, SO);
    RESC(alA); LSYNC();
  }
  SBAR(); QKT(pB0, pB1, K_lds + SHM_K, qr, r32, hi);
  FSM(pA0, pA1, mnA, alA, l_reg, pa0, pa1, pa2, pa3); SBAR();
  PVSM(o, vb0, pa0, pa1, pa2, pa3, pB0, pB1, m_reg, mnB, alB);
  __syncthreads(); RESC(alB);
  FSM(pB0, pB1, mnB, alB, l_reg, pa0, pa1, pa2, pa3); SBAR();
  PVD(o, vb0 + SHM_V, pa0, pa1, pa2, pa3);
  if (hi == 0) li_l[r32] = l_reg; asm volatile("s_waitcnt lgkmcnt(0)" ::: "memory");
  float rli[16];
#pragma unroll
  for (int r = 0; r < 16; ++r) rli[r] = __builtin_amdgcn_rcpf(li_l[crow(r, hi)]);
#pragma unroll
  for (int r = 0; r < 16; ++r) { const int orow = wid * QBLK + crow(r, hi);
#pragma unroll
    for (int d0 = 0; d0 < 2; ++d0) OUT(orow, d0 * 32 + r32, o[d0][r] * rli[r]); }
  __syncthreads();
#undef SLOAD
#undef SWRITE
#undef RESC
#undef PSM
#undef PVSM
#undef FSM
#undef PVD
#undef QKT
#undef LSLOAD
#undef LSWRITE
#undef LSYNC
}
#undef KSWZ
#undef SBAR
}
struct Q2 {
    bf16* U16;
    bf16 *WtL;
    bf16 *WtM;
    bf16 *WtG;
    float *LSL;
    bf16 *HLOC, *PCUM;
    float *SA, *SB;
    bf16 *QN16, *KVN16;
    bf16 *Q16;
    bf16 *WtKvbP;
    bf16 *XCM16, *QKV16;
    float *GATES;
    float *CLOC, *NLOC, *MLB;
    bf16 *CST; float *NST, *MST;
    bf16 *YB16;
    float *GLIST;
};
constexpr int NCH = TPB / 128;
constexpr int NCH_CTX = CTX / 128;

__device__ __forceinline__ float wave_sum(float v) {
#pragma unroll
    for (int o = 1; o < 64; o <<= 1) v += __shfl_xor(v, o);
    return v;
}
__device__ __forceinline__ float fast_sigmoid(float x) { return __builtin_amdgcn_rcpf(1.f + __expf(-x)); }
__device__ __forceinline__ float fast_silu(float x) { return x * fast_sigmoid(x); }
__device__ __forceinline__ float fast_gelu(float x) { const float u = 0.7978845608028654f * (x + 0.044715f * x * x * x); return x * fast_sigmoid(2.f * u); }

struct EpiU16 {
    static constexpr bool PERM = true; bf16* U;
    __device__ __forceinline__ void operator()(const pg8::f32x4 (&acc)[2][2][4][2], const pg8::Unit& u, int wr, int wc, int fr, int fq) const {
#pragma unroll
        for (int ai = 0; ai < 2; ++ai)
#pragma unroll
            for (int m = 0; m < 4; ++m) { const int row = u.pm * 256 + ai * 128 + wr * 64 + m * 16 + fr;
#pragma unroll
                for (int bj = 0; bj < 2; ++bj) { const int c = u.pn * 256 + bj * 128 + wc * 32 + 8 * fq; const pg8::f32x4 v0 = acc[ai][bj][m][0], v1 = acc[ai][bj][m][1];
                    u32x4 w; w.x = pg8::cvt_pk_bf16(v0[0], v0[1]); w.y = pg8::cvt_pk_bf16(v0[2], v0[3]); w.z = pg8::cvt_pk_bf16(v1[0], v1[1]); w.w = pg8::cvt_pk_bf16(v1[2], v1[3]);
                    *(u32x4*)(U + (size_t)row * DINP + c) = w; } }
    }
};
__device__ __forceinline__ void opt_inproj16(const Q& q, const Q2& q2, int l, LAS unsigned char* lds, int G, int bid) {
    pg8::Gemm g{q.H16, q.WtIn + (size_t)l * DINP * D, D}; pg8::StaticOrder S; S.init(NT, DINP, G, bid);
    EpiU16 E{q2.U16}; pg8::gemm_phase<EpiU16, pg8::StaticOrder, true>(lds, g, S, E);
}

__device__ __forceinline__ void opt_convert_small(const P& p, const Q2& q2, long gtid, long nthr) {
    for (long it = gtid; it < (long)DEPTH * 4 * 256 * 64; it += nthr) { const int i = (int)(it & 63), n = (int)((it >> 6) & 255), g = (int)((it >> 14) & 3), l = (int)(it >> 16);
        const int d = n >> 7, gate = (n >> 6) & 1, j = n & 63; const float* w = (gate ? p.in[I_LWX] : p.in[I_LWA]) + ((((size_t)l * 2 + d) * 4 + g) * 64 + i) * 64 + j;
        q2.WtL[it] = (bf16)f2bf(*w); }
    for (long it = gtid; it < (long)DEPTH * 4 * 3 * 64 * 64; it += nthr) { const int i = (int)(it & 63), j = (int)((it >> 6) & 63), m = (int)((it >> 12) % 3), h = (int)((it / (3 * 4096)) & 3), l = (int)(it / (12 * 4096));
        const float* w = (m == 0 ? p.in[I_MWQ] : (m == 1 ? p.in[I_MWK] : p.in[I_MWV])) + (((size_t)l * 4 + h) * 64 + i) * 64 + j;
        q2.WtM[it] = (bf16)f2bf(*w * (m == 1 ? 0.125f : 1.f)); }
    for (long it = gtid; it < (long)DEPTH * 32 * 768; it += nthr) { const int i = (int)(it % 768), n = (int)((it / 768) & 31), l = (int)(it / (32 * 768));
        q2.WtG[it] = n < 16 ? (bf16)f2bf(p.in[I_MWG][((((size_t)l * 2 + (n >> 3)) * 768) + i) * 8 + (n & 7)]) : (bf16)0; }
    for (long it = gtid; it < (long)DEPTH * 2 * 256; it += nthr) q2.LSL[it] = logsigmoid_f(p.in[I_LLAM][it]);
}

__device__ __forceinline__ void opt_init_mod(const P& p, char* lds, int bid, int G) {
    int tid_ = TIDX; asm volatile("" : "+v"(tid_));
    const int tid = tid_; float* SC = (float*)lds; float* RED = (float*)(lds + 12288);
    for (int i = tid; i < 3 * D; i += 512) { const int cv = i / D, k = i % D; const float x = cv < 2 ? p.in[I_C][cv * D + k] : p.in[I_CCTX][k]; SC[i] = x / (1.f + __expf(-x)); }
    __syncthreads();
    for (int it = bid; it < DEPTH * 6 * D / 64; it += G) { const int l = it / (6 * D / 64), j = (it % (6 * D / 64)) * 64 + (tid & 63), kq = tid >> 6;
        const float* w = p.in[I_WMOD] + (size_t)l * D * 6 * D + (size_t)(128 * kq) * 6 * D + j; float a0 = 0.f, a1 = 0.f, a2 = 0.f;
#pragma unroll 8
        for (int k = 0; k < 128; ++k) { const float wv = w[(size_t)k * 6 * D]; a0 += SC[128 * kq + k] * wv; a1 += SC[D + 128 * kq + k] * wv; a2 += SC[2 * D + 128 * kq + k] * wv; }
        RED[(kq * 3 + 0) * 64 + (tid & 63)] = a0; RED[(kq * 3 + 1) * 64 + (tid & 63)] = a1; RED[(kq * 3 + 2) * 64 + (tid & 63)] = a2;
        __syncthreads();
        if (tid < 192) { const int cv = tid >> 6, jj = tid & 63; float sacc = p.in[I_BMOD][(size_t)l * 6 * D + (it % (6 * D / 64)) * 64 + jj];
#pragma unroll
            for (int x = 0; x < 8; ++x) sacc += RED[(x * 3 + cv) * 64 + jj];
            p.MOD[((size_t)l * 3 + cv) * 6 * D + (it % (6 * D / 64)) * 64 + jj] = sacc; }
        __syncthreads(); }
}
__device__ __forceinline__ void opt_init_rope(const P& p, long gtid, long nthr) {
    for (long it = gtid; it < (long)SEQ * 16; it += nthr) { const int s = (int)(it / 16), a = (int)((it / 8) & 1), f = (int)(it & 7); const int pos = a == 0 ? s / GRID_W : s % GRID_W;
        const float frf = (float)pow(10000.0, -(double)f / 8.0); const double ang = (double)((float)pos * frf);
        p.ROPET[it * 2] = (float)cos(ang); p.ROPET[it * 2 + 1] = (float)sin(ang); }
}

template <int KS, class TA, class TB>
__device__ __forceinline__ void wave_mm32(att::f32x16& acc, const TA* A, int lda, const TB* B, int ldb, int r32, int hi) {
#pragma unroll
    for (int ks = 0; ks < KS; ++ks) {
        const att::bf16x8 a = *reinterpret_cast<const att::bf16x8*>(A + (size_t)r32 * lda + ks * 16 + hi * 8);
        const att::bf16x8 b = *reinterpret_cast<const att::bf16x8*>(B + (size_t)r32 * ldb + ks * 16 + hi * 8);
        acc = __builtin_amdgcn_mfma_f32_32x32x16_bf16(a, b, acc, 0, 0, 0);
    }
}

constexpr int LRU1_LDS = 18432 + 65536 + 4096;
template <class UL>
__device__ __forceinline__ void lru1_item(const P& p, const Q2& q2, int l, int b, int ch, int g, char* lds, const UL& U) {
    int tid_ = TIDX; asm volatile("" : "+v"(tid_));
    const int tid = tid_, wave = tid >> 6, lane = tid & 63, r32 = lane & 31, hi = lane >> 5;
    unsigned short* XC16 = (unsigned short*)lds; float* AB = (float*)(lds + 18432); float* CMP = (float*)(lds + 18432 + 65536);
    const int t0 = b * TPB + ch * 128, seg_lo = ch < NCH_CTX ? b * TPB : b * TPB + CTX, seg_hi = ch < NCH_CTX ? b * TPB + CTX : (b + 1) * TPB;
    { const int j = tid & 63, c = g * 64 + j, tb = (tid >> 6) * 16; const float* cw = p.in[I_LCW] + (size_t)l * 4 * 256 + c; const float w0 = cw[0], w1 = cw[256], w2 = cw[512], w3 = cw[768], cb = p.in[I_LCB][(size_t)l * 256 + c];
      float xm2 = (t0 + tb - 2 >= seg_lo) ? U(t0 + tb - 2, OFF_AX + c) : 0.f, xm1 = (t0 + tb - 1 >= seg_lo) ? U(t0 + tb - 1, OFF_AX + c) : 0.f, x0 = U(t0 + tb, OFF_AX + c);
#pragma unroll 4
      for (int i = 0; i < 16; ++i) { const int t = t0 + tb + i; const float xp1 = (t + 1 < seg_hi) ? U(t + 1, OFF_AX + c) : 0.f;
          const float v = cb + w0 * xm2 + w1 * xm1 + w2 * x0 + w3 * xp1; XC16[(tb + i) * 72 + j] = (unsigned short)f2bf(v); xm2 = xm1; xm1 = x0; x0 = xp1; } }
    __syncthreads();
    const bf16* Wt = q2.WtL + ((size_t)l * 4 + g) * 256 * 64;
#pragma unroll 1
    for (int d = 0; d < 2; ++d) {
        const int rt = wave & 3, cj = wave >> 2; att::f32x16 ar = {}, ai = {};
        wave_mm32<4>(ar, XC16 + rt * 32 * 72, 72, Wt + (size_t)(d * 128 + cj * 32) * 64, 64, r32, hi);
        wave_mm32<4>(ai, XC16 + rt * 32 * 72, 72, Wt + (size_t)(d * 128 + 64 + cj * 32) * 64, 64, r32, hi);
        { const int j = cj * 32 + r32, c = g * 64 + j; const float ba = p.in[I_LBA][((size_t)l * 2 + d) * 256 + c], bx = p.in[I_LBX][((size_t)l * 2 + d) * 256 + c], lsl = q2.LSL[((size_t)l * 2 + d) * 256 + c];
#pragma unroll
          for (int r = 0; r < 16; ++r) { const int tt = rt * 32 + att::crow(r, hi); const float rg = fast_sigmoid(ar[r] + ba), ig = fast_sigmoid(ai[r] + bx), la = 8.f * rg * lsl, a = __expf(la);
              const float xc = bf2f(XC16[tt * 72 + j]); const float bb = sqrtf(fmaxf(1.f - a * a, 0.f)) * ig * xc;
              AB[(tt * 64 + j) * 2] = a; AB[(tt * 64 + j) * 2 + 1] = bb; } }
        __syncthreads();
        { const int j = tid & 63, sg = tid >> 6; float av[16], bv[16]; float A = 1.f, B = 0.f;
#pragma unroll
          for (int i = 0; i < 16; ++i) { const int s = sg * 16 + i, tt = d == 0 ? s : 127 - s; av[i] = AB[(tt * 64 + j) * 2]; bv[i] = AB[(tt * 64 + j) * 2 + 1]; B = av[i] * B + bv[i]; A *= av[i]; }
          CMP[(sg * 64 + j) * 2] = A; CMP[(sg * 64 + j) * 2 + 1] = B;
          __syncthreads();
          float cA = 1.f, cB = 0.f;
          for (int x = 0; x < sg; ++x) { const float xa = CMP[(x * 64 + j) * 2], xb = CMP[(x * 64 + j) * 2 + 1]; cB = xa * cB + xb; cA *= xa; }
          const int c = g * 64 + j; float h = cB, pc = cA;
          unsigned short* OUTS = (unsigned short*)AB;
#pragma unroll
          for (int i = 0; i < 16; ++i) { const int s = sg * 16 + i, tt = d == 0 ? s : 127 - s; h = av[i] * h + bv[i]; pc *= av[i];
              OUTS[tt * 64 + j] = (unsigned short)f2bf(h); OUTS[(128 + tt) * 64 + j] = (unsigned short)f2bf(pc); }
          if (sg == 7) { q2.SA[(((size_t)d * NB + b) * NCH + ch) * 256 + c] = pc; q2.SB[(((size_t)d * NB + b) * NCH + ch) * 256 + c] = h; }
          __syncthreads();
#pragma unroll
          for (int k = 0; k < 4; ++k) { const int x = tid + k * 512, arr = x >> 10, tt = (x >> 3) & 127, c8 = x & 7; const u32x4 v = *(const u32x4*)(OUTS + (arr * 128 + tt) * 64 + c8 * 8);
              *(u32x4*)((arr ? q2.PCUM : q2.HLOC) + ((size_t)d * NT + t0 + tt) * 256 + g * 64 + c8 * 8) = v; } }
        __syncthreads();
    }
}
__device__ __forceinline__ void lru2_item(const Q2& q2, bf16* Yp, int b, int ch, char* lds) {
    int tid_ = TIDX; asm volatile("" : "+v"(tid_));
    const int tid = tid_; float* CAR = (float*)lds;
    { const int d = tid >> 8, c = tid & 255; float h = 0.f;
      if (d == 0) { for (int j = 0; j < ch; ++j) h = q2.SA[(((size_t)0 * NB + b) * NCH + j) * 256 + c] * h + q2.SB[(((size_t)0 * NB + b) * NCH + j) * 256 + c]; }
      else { const bool isctx = ch < NCH_CTX;
          for (int j = NCH_CTX - 1; j >= (isctx ? ch + 1 : 0); --j) h = q2.SA[(((size_t)1 * NB + b) * NCH + j) * 256 + c] * h + q2.SB[(((size_t)1 * NB + b) * NCH + j) * 256 + c];
          if (!isctx) for (int j = NCH - 1; j > ch; --j) h = q2.SA[(((size_t)1 * NB + b) * NCH + j) * 256 + c] * h + q2.SB[(((size_t)1 * NB + b) * NCH + j) * 256 + c]; }
      CAR[tid] = h; }
    __syncthreads();
    const int t0 = b * TPB + ch * 128;
#pragma unroll 2
    for (int k = 0; k < 8; ++k) { const int x = tid + k * 512, tt = x >> 5, c0 = (x & 31) * 8, t = t0 + tt;
        const u32x4 hf = *(const u32x4*)(q2.HLOC + (size_t)t * 256 + c0), pf = *(const u32x4*)(q2.PCUM + (size_t)t * 256 + c0), hb = *(const u32x4*)(q2.HLOC + ((size_t)NT + t) * 256 + c0), pb = *(const u32x4*)(q2.PCUM + ((size_t)NT + t) * 256 + c0);
        const u32x4 ag = *(const u32x4*)(q2.U16 + (size_t)t * DINP + OFF_AG + c0); u32x4 o;
#pragma unroll
        for (int w = 0; w < 4; ++w) { float y[2];
#pragma unroll
            for (int e = 0; e < 2; ++e) { const int c = c0 + 2 * w + e; const unsigned sh = e ? 0u : 16u;
                const float h0 = __builtin_bit_cast(float, e ? (hf[w] & 0xffff0000u) : (hf[w] << 16)), p0 = __builtin_bit_cast(float, e ? (pf[w] & 0xffff0000u) : (pf[w] << 16));
                const float h1 = __builtin_bit_cast(float, e ? (hb[w] & 0xffff0000u) : (hb[w] << 16)), p1 = __builtin_bit_cast(float, e ? (pb[w] & 0xffff0000u) : (pb[w] << 16));
                const float a = __builtin_bit_cast(float, e ? (ag[w] & 0xffff0000u) : (ag[w] << 16)); (void)sh;
                y[e] = ((h0 + p0 * CAR[c]) + (h1 + p1 * CAR[256 + c])) * fast_gelu(a); }
            o[w] = pk2(y[0], y[1]); }
        *(u32x4*)(Yp + (size_t)t * DMIX + c0) = o; }
    __syncthreads();
}

template <class UL>
__device__ __forceinline__ void mla_prep_token(const P& p, const Q& q, const Q2& q2, int l, int t, int lane, const UL& U) {
    float xq[4], xk[2]; float sq = 0.f, sk = 0.f;
#pragma unroll
    for (int i = 0; i < 4; ++i) { xq[i] = U(t, OFF_BQ + lane * 4 + i); sq += xq[i] * xq[i]; }
#pragma unroll
    for (int i = 0; i < 2; ++i) { xk[i] = U(t, OFF_BKV + lane * 2 + i); sk += xk[i] * xk[i]; }
    sq = wave_sum(sq); sk = wave_sum(sk);
    const float rq = 1.f / sqrtf(sq * (1.f / QRANK) + EPS), rk = 1.f / sqrtf(sk * (1.f / KVRANK) + EPS);
    const float* gq = p.in[I_QNG] + (size_t)l * QRANK + lane * 4; const float* gk = p.in[I_KVNG] + (size_t)l * KVRANK + lane * 2;
    u32x2 wq; wq.x = pk2(xq[0] * rq * gq[0], xq[1] * rq * gq[1]); wq.y = pk2(xq[2] * rq * gq[2], xq[3] * rq * gq[3]);
    *(u32x2*)(q2.QN16 + (size_t)t * 256 + lane * 4) = wq;
    *(unsigned*)(q2.KVN16 + (size_t)t * 256 + lane * 2) = pk2(xk[0] * rk * gk[0], xk[1] * rk * gk[1]);
    *(unsigned*)(q2.KVN16 + (size_t)t * 256 + 128 + lane * 2) = 0u;
    const int b = t / TPB, key = t % TPB, h = lane >> 3, d0 = (lane & 7) * 4; const bool lat = key >= CTX; const int s = key - CTX;
    float o[4];
#pragma unroll
    for (int i = 0; i < 4; ++i) { const int dd = d0 + i, a = dd >> 4, half = (dd >> 3) & 1, f = dd & 7; const float me = U(t, OFF_BKR + dd), other = U(t, OFF_BKR + (dd ^ 8));
        float cs = 1.f, sn = 0.f; if (lat) { cs = p.ROPET[(((size_t)s * 2 + a) * 8 + f) * 2]; sn = p.ROPET[(((size_t)s * 2 + a) * 8 + f) * 2 + 1]; }
        o[i] = half == 0 ? me * cs - other * sn : me * cs + other * sn; }
    u32x2 wk; wk.x = pk2(o[0], o[1]); wk.y = pk2(o[2], o[3]);
    *(u32x2*)(q.K16 + (((size_t)b * AH + h) * TPB + key) * QKD + NOPE + d0) = wk;
}

struct EpiQproj {
    static constexpr bool PERM = true; bf16* Q16; const float* ROPET;
    __device__ __forceinline__ void operator()(const pg8::f32x4 (&acc)[2][2][4][2], const pg8::Unit& u, int wr, int wc, int fr, int fq) const {
#pragma unroll
        for (int bj = 0; bj < 2; ++bj) { const int blk = u.pn * 8 + bj * 4 + wc; const bool rope = (blk % 3) == 2; const int c = blk * 32 + 8 * fq;
#pragma unroll
            for (int ai = 0; ai < 2; ++ai)
#pragma unroll
                for (int m = 0; m < 4; ++m) { const int row = u.pm * 256 + ai * 128 + wr * 64 + m * 16 + fr; float v[8];
#pragma unroll
                    for (int x = 0; x < 4; ++x) { v[x] = acc[ai][bj][m][0][x]; v[4 + x] = acc[ai][bj][m][1][x]; }
                    if (rope) {
                        const int key = (u.pm % (TPB / 256)) * 256 + ai * 128 + wr * 64 + m * 16 + fr; const bool lat = key >= CTX; const int s = lat ? key - CTX : 0, a = fq >> 1; const float* tb = ROPET + ((size_t)s * 2 + a) * 16;
#pragma unroll
                        for (int x = 0; x < 8; ++x) { const float other = __shfl_xor(v[x], 16); const float cs = lat ? tb[x * 2] : 1.f, sn = lat ? tb[x * 2 + 1] : 0.f;
                            v[x] = (fq & 1) == 0 ? v[x] * cs - other * sn : v[x] * cs + other * sn; } }
                    u32x4 w; w.x = pg8::cvt_pk_bf16(v[0], v[1]); w.y = pg8::cvt_pk_bf16(v[2], v[3]); w.z = pg8::cvt_pk_bf16(v[4], v[5]); w.w = pg8::cvt_pk_bf16(v[6], v[7]);
                    *(u32x4*)(Q16 + (size_t)row * 768 + c) = w; asm volatile("" ::: "memory"); } }
    }
};
struct EpiKVproj {
    static constexpr bool PERM = true; bf16* K16; bf16* V16;
    __device__ __forceinline__ void operator()(const pg8::f32x4 (&acc)[2][2][4][2], const pg8::Unit& u, int wr, int wc, int fr, int fq) const {
#pragma unroll
        for (int bj = 0; bj < 2; ++bj) { const int h = u.pn * 2 + bj, dcol = wc * 32 + 8 * fq; const bool isv = dcol >= 64;
#pragma unroll
            for (int ai = 0; ai < 2; ++ai)
#pragma unroll
                for (int m = 0; m < 4; ++m) { const int b = u.pm / (TPB / 256), key = (u.pm % (TPB / 256)) * 256 + ai * 128 + wr * 64 + m * 16 + fr; const pg8::f32x4 v0 = acc[ai][bj][m][0], v1 = acc[ai][bj][m][1];
                    u32x4 w; w.x = pg8::cvt_pk_bf16(v0[0], v0[1]); w.y = pg8::cvt_pk_bf16(v0[2], v0[3]); w.z = pg8::cvt_pk_bf16(v1[0], v1[1]); w.w = pg8::cvt_pk_bf16(v1[2], v1[3]);
                    bf16* dst = isv ? V16 + (((size_t)b * AH + h) * TPB + key) * VD + (dcol - 64) : K16 + (((size_t)b * AH + h) * TPB + key) * QKD + dcol;
                    *(u32x4*)dst = w; asm volatile("" ::: "memory"); } }
    }
};
__device__ __forceinline__ void opt_mla_proj(const P& p, const Q& q, const Q2& q2, int l, LAS unsigned char* lds, int G, int bid) {
    { pg8::Gemm g{q2.QN16, q.WtQb + (size_t)l * 768 * QRANK, QRANK}; pg8::StaticOrder S; S.init(NT, 768, G, bid);
      EpiQproj E{q2.Q16, p.ROPET}; pg8::gemm_phase<EpiQproj, pg8::StaticOrder, true>(lds, g, S, E); }
    { pg8::Gemm g{q2.KVN16, q2.WtKvbP + (size_t)l * 1024 * 256, 256}; pg8::StaticOrder S; S.init(NT, 1024, G, (bid + 198) % G);
      EpiKVproj E{q.K16, q.V16}; pg8::gemm_phase<EpiKVproj, pg8::StaticOrder, true>(lds, g, S, E); }
}
__device__ __forceinline__ int ord_len(int d, int ch) { return d == 0 ? ch : (ch < NCH_CTX ? NCH_CTX - 1 - ch : NCH_CTX + (NCH - 1 - ch)); }
__device__ __forceinline__ int ord_chunk(int d, int ch, int i) { return d == 0 ? i : (i < (ch < NCH_CTX ? NCH_CTX - 1 - ch : NCH_CTX) ? NCH_CTX - 1 - i : NCH - 1 - (i - NCH_CTX)); }

__device__ __forceinline__ void wave_scan_add128(float& x0, float& x1, int lane) {
#pragma unroll
    for (int off = 1; off < 64; off <<= 1) { const float y0 = __shfl_up(x0, off), y1 = __shfl_up(x1, off); if (lane >= off) { x0 += y0; x1 += y1; } }
    x1 += __shfl(x0, 63);
}
__device__ __forceinline__ void wave_scan_max128(float& x0, float& x1, int lane) {
#pragma unroll
    for (int off = 1; off < 64; off <<= 1) { const float y0 = __shfl_up(x0, off), y1 = __shfl_up(x1, off); if (lane >= off) { x0 = fmaxf(x0, y0); x1 = fmaxf(x1, y1); } }
    x1 = fmaxf(x1, __shfl(x0, 63));
}
__device__ __forceinline__ float wave_max(float v) {
#pragma unroll
    for (int o = 1; o < 64; o <<= 1) v = fmaxf(v, __shfl_xor(v, o));
    return v;
}

constexpr int ML1_LDS = 116736;
template <class UL>
__device__ __forceinline__ void ml1_item(const P& p, const Q2& q2, int l, int b, int ch, char* lds, const UL& U) {
    int tid_ = TIDX; asm volatile("" : "+v"(tid_));
    const int tid = tid_, wave = tid >> 6, lane = tid & 63, r32 = lane & 31, hi = lane >> 5;
    unsigned short* XCh = (unsigned short*)lds; unsigned short* UXh = (unsigned short*)(lds + 18432); unsigned short* QKVh = (unsigned short*)(lds + 36864);
    float* GP = (float*)(lds + 92160); float* GT = (float*)(lds + 108544);
    const int t0 = b * TPB + ch * 128, seg_lo = ch < NCH_CTX ? b * TPB : b * TPB + CTX, seg_hi = ch < NCH_CTX ? b * TPB + CTX : (b + 1) * TPB;
    const int rt = wave & 3, wh = wave >> 2;
    att::f32x16 gacc = {};
#pragma unroll 1
    for (int h = 0; h < 4; ++h) {
        { const int j = tid & 63, c = h * 64 + j, tb = (tid >> 6) * 16; const float* cw = p.in[I_MCW] + (size_t)l * 4 * 256 + c; const float w0 = cw[0], w1 = cw[256], w2 = cw[512], w3 = cw[768], cb = p.in[I_MCB][(size_t)l * 256 + c];
          float xm2 = (t0 + tb - 2 >= seg_lo) ? U(t0 + tb - 2, OFF_MX + c) : 0.f, xm1 = (t0 + tb - 1 >= seg_lo) ? U(t0 + tb - 1, OFF_MX + c) : 0.f, x0 = U(t0 + tb, OFF_MX + c);
#pragma unroll 4
          for (int i = 0; i < 16; ++i) { const int t = t0 + tb + i; const float xp1 = (t + 1 < seg_hi) ? U(t + 1, OFF_MX + c) : 0.f;
              const float v = fast_silu(cb + w0 * xm2 + w1 * xm1 + w2 * x0 + w3 * xp1); const unsigned short vb = (unsigned short)f2bf(v);
              XCh[(tb + i) * 72 + j] = vb; UXh[(tb + i) * 72 + j] = (unsigned short)f2bf(x0); xm2 = xm1; xm1 = x0; x0 = xp1; } }
        __syncthreads();
        { const bf16* Wm = q2.WtM + ((size_t)l * 4 + h) * 3 * 4096;
#pragma unroll
          for (int m = 0; m < 3; ++m) { att::f32x16 a = {};
              wave_mm32<4>(a, (m == 2 ? UXh : XCh) + rt * 32 * 72, 72, Wm + (size_t)m * 4096 + (size_t)wh * 32 * 64, 64, r32, hi);
#pragma unroll
              for (int r = 0; r < 16; ++r) { const int tt = rt * 32 + att::crow(r, hi); const unsigned short vb = (unsigned short)f2bf(a[r]);
                  QKVh[(m * 128 + tt) * 72 + wh * 32 + r32] = vb; } } }
        __syncthreads();
#pragma unroll
        for (int k = 0; k < 2; ++k) { const int x = tid + k * 512, tt = x >> 3, c8 = x & 7; *(u32x4*)(q2.XCM16 + (size_t)(t0 + tt) * 256 + h * 64 + c8 * 8) = *(const u32x4*)(XCh + tt * 72 + c8 * 8); }
#pragma unroll
        for (int k = 0; k < 6; ++k) { const int x = tid + k * 512, m = x >> 10, tt = (x >> 3) & 127, c8 = x & 7;
            *(u32x4*)(q2.QKV16 + (size_t)(t0 + tt) * 768 + m * 256 + h * 64 + c8 * 8) = *(const u32x4*)(QKVh + (m * 128 + tt) * 72 + c8 * 8); }
        { const bf16* Wg = q2.WtG + (size_t)l * 32 * 768;
#pragma unroll
          for (int x = 0; x < 6; ++x) { const int idx = wh * 6 + x, m = idx >> 2, ks = idx & 3;
              const att::bf16x8 a = *reinterpret_cast<const att::bf16x8*>(QKVh + (m * 128 + rt * 32 + r32) * 72 + ks * 16 + hi * 8);
              const att::bf16x8 bb = *reinterpret_cast<const att::bf16x8*>(Wg + (size_t)r32 * 768 + m * 256 + h * 64 + ks * 16 + hi * 8);
              gacc = __builtin_amdgcn_mfma_f32_32x32x16_bf16(a, bb, gacc, 0, 0, 0); } }
        __syncthreads();
    }
    if (r32 < 16) {
#pragma unroll
        for (int r = 0; r < 16; ++r) GP[(wh * 128 + rt * 32 + att::crow(r, hi)) * 16 + r32] = gacc[r]; }
    __syncthreads();
    for (int i = tid; i < 128 * 16; i += 512) { const int n = i & 15, d = n >> 3, g = n & 7; float v = GP[i] + GP[128 * 16 + i] + p.in[I_MBG][((size_t)l * 2 + d) * 8 + g];
        if (g >= 4) v = fminf(v, 0.f) - __logf(1.f + __expf(-fabsf(v)));
        GT[i] = v; q2.GATES[(size_t)(t0 + (i >> 4)) * 16 + n] = v; }
    __syncthreads();
    unsigned short* KT = (unsigned short*)lds; unsigned short* VT = (unsigned short*)(lds + 17408); float* WR = (float*)(lds + 52224); float* MB = (float*)(lds + 53248); float* WE = (float*)(lds + 53280);
#pragma unroll 1
    for (int h = 0; h < 4; ++h) {
        if (wave < 2) { const int d = wave, ta = d == 0 ? lane : 127 - lane, tb = d == 0 ? lane + 64 : 63 - lane;
            float b0 = GT[ta * 16 + d * 8 + 4 + h], b1 = GT[tb * 16 + d * 8 + 4 + h]; wave_scan_add128(b0, b1, lane);
            const float bL = __shfl(b1, 63), w0 = bL - b0 + GT[ta * 16 + d * 8 + h], w1 = bL - b1 + GT[tb * 16 + d * 8 + h];
            WR[d * 128 + ta] = w0; WR[d * 128 + tb] = w1; const float mx = wave_max(fmaxf(w0, w1));
            if (lane == 0) { MB[d * 2] = mx; MB[d * 2 + 1] = bL; } }
        __syncthreads();
        { const int tt = tid & 127, jg = tid >> 7; const float w0 = __expf(WR[tt] - MB[0]), w1 = __expf(WR[128 + tt] - MB[2]);
          const unsigned short* ksrc = (const unsigned short*)q2.QKV16 + (size_t)(t0 + tt) * 768 + 256 + h * 64 + jg * 16; const unsigned short* vsrc = ksrc + 256;
          const att::bf16x8 k0 = *reinterpret_cast<const att::bf16x8*>(ksrc), k1 = *reinterpret_cast<const att::bf16x8*>(ksrc + 8), v0 = *reinterpret_cast<const att::bf16x8*>(vsrc), v1 = *reinterpret_cast<const att::bf16x8*>(vsrc + 8);
#pragma unroll
          for (int i = 0; i < 8; ++i) { KT[(jg * 16 + i) * 136 + tt] = (unsigned short)k0[i]; KT[(jg * 16 + 8 + i) * 136 + tt] = (unsigned short)k1[i];
              const float va = bf2f((unsigned short)v0[i]), vb = bf2f((unsigned short)v1[i]);
              VT[(jg * 16 + i) * 136 + tt] = (unsigned short)f2bf(va * w0); VT[(jg * 16 + 8 + i) * 136 + tt] = (unsigned short)f2bf(vb * w0);
              VT[(64 + jg * 16 + i) * 136 + tt] = (unsigned short)f2bf(va * w1); VT[(64 + jg * 16 + 8 + i) * 136 + tt] = (unsigned short)f2bf(vb * w1); }
          if (tid < 128) WE[tid] = w0; else if (tid < 256) WE[tid] = w1; }
        __syncthreads();
        { const int d = wave >> 2, vt = (wave >> 1) & 1, kt = wave & 1; att::f32x16 c = {};
          wave_mm32<8>(c, VT + (size_t)(d * 64 + vt * 32) * 136, 136, KT + (size_t)kt * 32 * 136, 136, r32, hi);
          float* dst = q2.CLOC + ((((size_t)d * NB + b) * NCH + ch) * 4 + h) * 4096;
#pragma unroll
          for (int r = 0; r < 16; ++r) dst[(vt * 32 + att::crow(r, hi)) * 64 + kt * 32 + r32] = c[r];
          if (tid < 128) { const int dd = tid >> 6, k = tid & 63; float s = 0.f; for (int tt = 0; tt < 128; ++tt) s += WE[dd * 128 + tt] * bf2f(KT[k * 136 + tt]);
              q2.NLOC[((((size_t)dd * NB + b) * NCH + ch) * 4 + h) * 64 + k] = s; }
          if (tid < 2) { float* mb = q2.MLB + ((((size_t)tid * NB + b) * NCH + ch) * 4 + h) * 2; mb[0] = MB[tid * 2]; mb[1] = MB[tid * 2 + 1]; } }
        __syncthreads();
    }
}

__device__ __forceinline__ void ml_scan_item(const Q2& q2, int item, char* lds) {
    int tid_ = TIDX; asm volatile("" : "+v"(tid_));
    const int tid = tid_, vq = item & 3, h = (item >> 2) & 3, b = (item >> 4) & 1, d = item >> 5;
    float* MLs = (float*)lds; float* MSEQ = MLs + 2 * NCH + 16;
    for (int i = tid; i < NCH; i += 512) { const float* mb = q2.MLB + ((((size_t)d * NB + b) * NCH + ord_chunk(d, NCH, i)) * 4 + h) * 2; MLs[2 * i] = mb[0]; MLs[2 * i + 1] = mb[1]; }
    __syncthreads();
    if (tid == 0) { float m = 0.f; for (int i = 0; i < NCH; ++i) { MSEQ[i] = m; m = fmaxf(MLs[2 * i + 1] + m, MLs[2 * i]); } MSEQ[NCH] = m; }
    __syncthreads();
    const int e0 = vq * 1024 + tid * 2; float c0 = 0.f, c1 = 0.f, nn = 0.f; const bool don = (vq == 0 && tid < 64);
    static_assert(NCH % 11 == 0, "the scan streams the chunk contributions 11 at a time");
#pragma unroll 1
    for (int i0 = 0; i0 < NCH; i0 += 11) { float2 cl[11]; float nl[11];
#pragma unroll
        for (int x = 0; x < 11; ++x) { const size_t idx = (((size_t)d * NB + b) * NCH + ord_chunk(d, NCH, i0 + x)) * 4 + h; cl[x] = *(const float2*)(q2.CLOC + idx * 4096 + e0); nl[x] = don ? q2.NLOC[idx * 64 + tid] : 0.f; }
#pragma unroll
        for (int x = 0; x < 11; ++x) { const int i = i0 + x; const size_t idx = (((size_t)d * NB + b) * NCH + ord_chunk(d, NCH, i)) * 4 + h;
            *(unsigned*)(q2.CST + idx * 4096 + e0) = pk2(c0, c1);
            if (don) q2.NST[idx * 64 + tid] = nn;
            if (vq == 0 && tid == 64) q2.MST[idx] = MSEQ[i];
            const float m = MSEQ[i], mn = MSEQ[i + 1], dec = __expf(MLs[2 * i + 1] + m - mn), sc = __expf(MLs[2 * i] - mn);
            c0 = dec * c0 + sc * cl[x].x; c1 = dec * c1 + sc * cl[x].y; nn = dec * nn + sc * nl[x]; } }
    __syncthreads();
}

constexpr int ML2_LDS = 145536;
template <class UL, class YS>
__device__ __forceinline__ void ml2_item(const P& p, const Q2& q2, int l, int b, int ch, int h, char* lds, const UL& U, const YS& Y) {
    int tid_ = TIDX; asm volatile("" : "+v"(tid_));
    const int tid = tid_, wave = tid >> 6, lane = tid & 63, r32 = lane & 31, hi = lane >> 5;
    char* Ks = lds; char* Vs = lds + 32768; unsigned short* C0 = (unsigned short*)(lds + 49152); float* N0 = (float*)(lds + 67584); float* ROWV = (float*)(lds + 68096);
    float* COEF = (float*)(lds + 73216); float* M0 = (float*)(lds + 73792); float* WS = (float*)(lds + 73856) + wave * 64; float* HX = (float*)(lds + 75904);
    const int t0 = b * TPB + ch * 128;
    { const unsigned short* base = (const unsigned short*)q2.QKV16 + (size_t)t0 * 768 + h * 64;
#pragma unroll
      for (int x = 0; x < 2; ++x) { const int cidx = tid + x * 512, key = cidx >> 3, c8 = cidx & 7, tile = key >> 6, kk = key & 63;
          const att::bf16x8 kv = *reinterpret_cast<const att::bf16x8*>(base + (size_t)key * 768 + 256 + c8 * 8), vv = *reinterpret_cast<const att::bf16x8*>(base + (size_t)key * 768 + 512 + c8 * 8);
          *(att::bf16x8*)(Ks + tile * 16384 + (kk * 256 + ((c8 * 16) ^ ((kk & 7) << 4)))) = kv;
          *(att::bf16x8*)(Vs + tile * 8192 + att::v_st(kk, c8 * 8)) = vv; } }
    if (wave < 2) { const int d = wave, ta = d == 0 ? lane : 127 - lane, tb = d == 0 ? lane + 64 : 63 - lane;
        float* g = ROWV + (d * 5 + 0) * 128; float* pmv = ROWV + (d * 5 + 1) * 128; float* bv = ROWV + (d * 5 + 2) * 128;
        const float iga = q2.GATES[(size_t)(t0 + ta) * 16 + d * 8 + h], igb = q2.GATES[(size_t)(t0 + tb) * 16 + d * 8 + h];
        float b0 = q2.GATES[(size_t)(t0 + ta) * 16 + d * 8 + 4 + h], b1 = q2.GATES[(size_t)(t0 + tb) * 16 + d * 8 + 4 + h]; wave_scan_add128(b0, b1, lane);
        const float g0 = iga - b0, g1 = igb - b1; float p0 = g0, p1 = g1; wave_scan_max128(p0, p1, lane);
        g[ta] = g0; g[tb] = g1; pmv[ta] = p0; pmv[tb] = p1; bv[ta] = b0; bv[tb] = b1; }
    __syncthreads();
    { const int d = tid >> 8, e0 = (tid & 255) * 16; const size_t idx = (((size_t)d * NB + b) * NCH + ch) * 4 + h;
      const u32x4* src = (const u32x4*)(q2.CST + idx * 4096 + e0); const u32x4 w0 = src[0], w1 = src[1];
      { const int v = e0 >> 6, k = e0 & 63; unsigned short* dst = C0 + (d * 64 + v) * 72 + k; *(u32x4*)dst = w0; *(u32x4*)(dst + 8) = w1; }
      if (tid < 128) { const int nd = tid >> 6, nk = tid & 63; N0[nd * 64 + nk] = q2.NST[((((size_t)nd * NB + b) * NCH + ch) * 4 + h) * 64 + nk]; }
      if (tid < 2) M0[tid] = q2.MST[(((size_t)tid * NB + b) * NCH + ch) * 4 + h]; }
    __syncthreads();
    {
      if (tid < 256) { const int dd = tid >> 7, tt = tid & 127; const float m0 = M0[dd], M = fmaxf(m0, ROWV[(dd * 5 + 1) * 128 + tt]);
          ROWV[(dd * 5 + 1) * 128 + tt] = M; ROWV[(dd * 5 + 3) * 128 + tt] = __expf(m0 - M); ROWV[(dd * 5 + 4) * 128 + tt] = __expf(-(ROWV[(dd * 5 + 2) * 128 + tt] + M)); } }
    __syncthreads();
    { const int qb = wave & 3, d = wave >> 2; const float* g = ROWV + (d * 5 + 0) * 128; const float* Mv = ROWV + (d * 5 + 1) * 128; const float* wiv = ROWV + (d * 5 + 3) * 128; const float* emtv = ROWV + (d * 5 + 4) * 128;
      att::bf16x8 qr[4]; const int sq = qb * 32 + r32;
      { const unsigned short* qw = (const unsigned short*)q2.QKV16 + (size_t)(t0 + sq) * 768 + h * 64 + hi * 8;
#pragma unroll
        for (int d0 = 0; d0 < 4; ++d0) qr[d0] = *reinterpret_cast<const att::bf16x8*>(qw + d0 * 16); }
      const float Ms = Mv[sq] * 1.4426950408889634f; att::f32x16 o[2] = {}; float rs = 0.f;
      const int vb0 = (int)(uintptr_t)Vs + att::v_rd_base(lane);
#pragma unroll
      for (int kt = 0; kt < 2; ++kt) {
          const bool skip = d == 0 ? (kt == 1 && qb < 2) : (kt == 0 && qb >= 2);
          if (!skip) {
              att::f32x16 p0 = {}, p1 = {}; const char* Kt = Ks + kt * 16384;
#pragma unroll
              for (int d0 = 0; d0 < 4; ++d0) { const int cb = (d0 * 16 + hi * 8) * 2;
                  const att::bf16x8 b0 = *reinterpret_cast<const att::bf16x8*>(Kt + (r32 * 256 + (cb ^ ((r32 & 7) << 4))));
                  const att::bf16x8 b1 = *reinterpret_cast<const att::bf16x8*>(Kt + ((32 + r32) * 256 + (cb ^ ((r32 & 7) << 4))));
                  p0 = __builtin_amdgcn_mfma_f32_32x32x16_bf16(b0, qr[d0], p0, 0, 0, 0); p1 = __builtin_amdgcn_mfma_f32_32x32x16_bf16(b1, qr[d0], p1, 0, 0, 0); }
#pragma unroll
              for (int r = 0; r < 16; ++r) { const int k0 = kt * 64 + att::crow(r, hi), k1 = k0 + 32;
                  const bool ok0 = d == 0 ? k0 <= sq : k0 >= sq, ok1 = d == 0 ? k1 <= sq : k1 >= sq;
                  p0[r] = ok0 ? p0[r] * __builtin_amdgcn_exp2f(g[k0] * 1.4426950408889634f - Ms) : 0.f; p1[r] = ok1 ? p1[r] * __builtin_amdgcn_exp2f(g[k1] * 1.4426950408889634f - Ms) : 0.f;
                  rs += p0[r] + p1[r]; }
              att::bf16x8 pa0, pa1, pa2, pa3;
#define PK4(P, BASE, OUT) do { unsigned a0 = att::cvtpk(P[BASE + 0], P[BASE + 1]), a1 = att::cvtpk(P[BASE + 2], P[BASE + 3]);   \
    unsigned b0 = att::cvtpk(P[BASE + 4], P[BASE + 5]), b1 = att::cvtpk(P[BASE + 6], P[BASE + 7]);                              \
    auto r0 = __builtin_amdgcn_permlane32_swap(a0, b0, false, false); auto r1 = __builtin_amdgcn_permlane32_swap(a1, b1, false, false); \
    att::u32x4 w = {r0[0], r1[0], r0[1], r1[1]}; OUT = *reinterpret_cast<att::bf16x8*>(&w); } while (0)
              PK4(p0, 0, pa0); PK4(p0, 8, pa1); PK4(p1, 0, pa2); PK4(p1, 8, pa3);
#undef PK4
              att::pv_d0(o, vb0 + kt * 8192, pa0, pa1, pa2, pa3);
          }
      }
      att::f32x16 ic[2] = {};
#pragma unroll
      for (int vt = 0; vt < 2; ++vt)
#pragma unroll
          for (int d0 = 0; d0 < 4; ++d0) { const att::bf16x8 cb = *reinterpret_cast<const att::bf16x8*>(C0 + (d * 64 + vt * 32 + r32) * 72 + d0 * 16 + hi * 8);
              ic[vt] = __builtin_amdgcn_mfma_f32_32x32x16_bf16(qr[d0], cb, ic[vt], 0, 0, 0); }
      float nq = 0.f;
#pragma unroll
      for (int d0 = 0; d0 < 4; ++d0)
#pragma unroll
          for (int x = 0; x < 8; ++x) nq += bf2f((unsigned short)qr[d0][x]) * N0[d * 64 + d0 * 16 + hi * 8 + x];
      { auto rr = __builtin_amdgcn_permlane32_swap(__float_as_uint(nq), __float_as_uint(nq), false, false); nq = __uint_as_float(rr[0]) + __uint_as_float(rr[1]); }
      { auto rr = __builtin_amdgcn_permlane32_swap(__float_as_uint(rs), __float_as_uint(rs), false, false); rs = __uint_as_float(rr[0]) + __uint_as_float(rr[1]); }
      const float den = rs + wiv[sq] * nq, dn = fmaxf(fabsf(den), emtv[sq]);
      if (hi == 0) WS[r32] = __builtin_amdgcn_rcpf(dn);
      asm volatile("s_waitcnt lgkmcnt(0)" ::: "memory");
#pragma unroll
      for (int r = 0; r < 16; ++r) { const int row = att::crow(r, hi), tt = qb * 32 + row; const float inv = WS[row], wi = wiv[tt];
#pragma unroll
          for (int vt = 0; vt < 2; ++vt) HX[(d * 128 + tt) * 68 + vt * 32 + r32] = (o[vt][r] + wi * ic[vt][r]) * inv; }
    }
    __syncthreads();
    { const int tt = tid >> 2, v0 = (tid & 3) * 16, t = t0 + tt; float hv[16]; float s = 0.f;
#pragma unroll
      for (int i = 0; i < 16; ++i) { hv[i] = HX[tt * 68 + v0 + i] + HX[(128 + tt) * 68 + v0 + i]; s += hv[i]; }
      s += __shfl_xor(s, 1); s += __shfl_xor(s, 2); const float mu = s * (1.f / 64.f); float vs = 0.f;
#pragma unroll
      for (int i = 0; i < 16; ++i) { hv[i] -= mu; vs += hv[i] * hv[i]; }
      vs += __shfl_xor(vs, 1); vs += __shfl_xor(vs, 2); const float rstd = 1.f / sqrtf(vs * (1.f / 64.f) + EPS);
#pragma unroll
      for (int i = 0; i < 16; ++i) { const int c = h * 64 + v0 + i;
          const float y = hv[i] * rstd * p.in[I_MNG][(size_t)l * 256 + c] + p.in[I_MSK][(size_t)l * 256 + c] * bf2f(q2.XCM16[(size_t)t * 256 + c]);
          Y(t, 768 + c, y * fast_silu(U(t, OFF_MZ + c))); } }
    __syncthreads();
}
typedef float f32x4_t __attribute__((ext_vector_type(4)));

__device__ __forceinline__ void row_norm_mod(f32x4 (&v)[4], const float* g, const float* sc, const float* sh, int lane) {
    float s = 0.f;
#pragma unroll
    for (int j = 0; j < 4; ++j) s += (v[j].x * v[j].x + v[j].y * v[j].y) + (v[j].z * v[j].z + v[j].w * v[j].w);
    const float rstd = 1.f / sqrtf(wave_sum(s) * (1.f / D) + EPS);
#pragma unroll
    for (int j = 0; j < 4; ++j) { const int k = (j * 64 + lane) * 4; const f32x4 gv = *(const f32x4*)(g + k);
        if (sc) { const f32x4 scv = *(const f32x4*)(sc + k), shv = *(const f32x4*)(sh + k); v[j] = v[j] * rstd * gv * (scv + 1.f) + shv; } else v[j] = v[j] * rstd * gv; }
}
__device__ __forceinline__ void row_store_bf16(bf16* dst, const f32x4 (&v)[4], int lane) {
#pragma unroll
    for (int j = 0; j < 4; ++j) { u32x2 w; w.x = pk2(v[j].x, v[j].y); w.y = pk2(v[j].z, v[j].w); *(u32x2*)(dst + (j * 64 + lane) * 4) = w; }
}
__device__ __forceinline__ void rp_first(const P& p, const Q& q, int gw, int ngw, int lane) {
    for (int t = gw; t < NT; t += ngw) { const int b = t / TPB, i = t % TPB; const float* src = i < CTX ? p.in[I_CTX] + ((size_t)b * CTX + i) * D : p.in[I_X] + ((size_t)b * SEQ + (i - CTX)) * D;
        f32x4 v[4];
#pragma unroll
        for (int j = 0; j < 4; ++j) { v[j] = *(const f32x4*)(src + (j * 64 + lane) * 4); *(f32x4*)(p.X + (size_t)t * D + (j * 64 + lane) * 4) = v[j]; }
        const int cv = tok_cv(t); row_norm_mod(v, p.in[I_N1G], modp(p, 0, cv, 1), modp(p, 0, cv, 0), lane); row_store_bf16(q.H16 + (size_t)t * D, v, lane); }
}
__device__ __forceinline__ void rp_end(const P& p, const Q& q, const Q2& q2, int l, int gw, int ngw, int lane, float probe_scale = 1.f) {
    const bool last = l + 1 == DEPTH; const int nrows = last ? NB * SEQ : NT;
    for (int r_ = gw; r_ < nrows; r_ += ngw) { const int t = last ? (r_ / SEQ) * TPB + CTX + r_ % SEQ : r_; const int cv = tok_cv(t); const float* g2 = modp(p, l, cv, 5); f32x4 v[4];
#pragma unroll
        for (int j = 0; j < 4; ++j) { const int k = (j * 64 + lane) * 4; f32x4 s = {0.f, 0.f, 0.f, 0.f};
#pragma unroll
            for (int e = 0; e < 4; ++e) { const u32x2 w = *(const u32x2*)(q2.YB16 + ((size_t)t * 4 + e) * D + k);
                s.x += __builtin_bit_cast(float, w.x << 16); s.y += __builtin_bit_cast(float, w.x & 0xffff0000u); s.z += __builtin_bit_cast(float, w.y << 16); s.w += __builtin_bit_cast(float, w.y & 0xffff0000u); }
            v[j] = *(const f32x4*)(p.X + (size_t)t * D + k) + *(const f32x4*)(g2 + k) * s * probe_scale; }
        if (l + 1 < DEPTH) {
#pragma unroll
            for (int j = 0; j < 4; ++j) *(f32x4*)(p.X + (size_t)t * D + (j * 64 + lane) * 4) = v[j];
            row_norm_mod(v, p.in[I_N1G] + (size_t)(l + 1) * D, modp(p, l + 1, cv, 1), modp(p, l + 1, cv, 0), lane); row_store_bf16(q.H16 + (size_t)t * D, v, lane);
        } else { const int b = t / TPB, i = t % TPB; if (i < CTX) continue;
            row_norm_mod(v, p.in[I_FG], nullptr, nullptr, lane);
#pragma unroll
            for (int j = 0; j < 4; ++j) *(f32x4*)(p.out + ((size_t)b * SEQ + (i - CTX)) * D + (j * 64 + lane) * 4) = v[j]; }
    }
}
constexpr int RPM_LDS = 89024;
__device__ __forceinline__ void rp_mid(const P& p, const Q& q, float* GLIST, int l, char* lds, int G, int bid, bool latent_only, bool probe_nolist = false) {
    int tid_ = TIDX; asm volatile("" : "+v"(tid_));
    const int tid = tid_, wave = tid >> 6, lane = tid & 63;
    float* HS = (float*)lds; float* PART = (float*)(lds + 65664); float* LG = (float*)(lds + 82048); int* LCNT = (int*)(lds + 84096); int* LBASE = (int*)(lds + 84224); int* PEND = (int*)(lds + 84352); int* NPEND = (int*)(lds + 88960);
    if (tid < 32) LCNT[tid] = 0; if (tid == 32) NPEND[0] = 0;
    float B0[32], B1[32]; const float* Wr = p.in[I_WR] + (size_t)l * D * NE;
#pragma unroll
    for (int ks = 0; ks < 32; ++ks) { const int k = 128 * wave + 4 * ks + (lane >> 4); B0[ks] = Wr[(size_t)k * NE + (lane & 15)]; B1[ks] = Wr[(size_t)k * NE + 16 + (lane & 15)]; }
    __syncthreads();
    const int nitems = latent_only ? NB * SEQ / 16 : NT / 16;
    for (int it_ = bid; it_ < nitems; it_ += G) { const int it = latent_only ? (it_ / (SEQ / 16)) * (TPB / 16) + CTX / 16 + it_ % (SEQ / 16) : it_;
#pragma unroll 1
        for (int rr = 0; rr < 2; ++rr) { const int row = 2 * wave + rr, t = it * 16 + row, cv = tok_cv(t); f32x4 v[4];
#pragma unroll
            for (int j = 0; j < 4; ++j) v[j] = *(const f32x4*)(p.X + (size_t)t * D + (j * 64 + lane) * 4);
            row_norm_mod(v, p.in[I_N2G] + (size_t)l * D, modp(p, l, cv, 4), modp(p, l, cv, 3), lane); row_store_bf16(q.H16 + (size_t)t * D, v, lane);
#pragma unroll
            for (int j = 0; j < 4; ++j) { float* d = HS + row * 1026 + (j * 64 + lane) * 4; *(float2*)d = make_float2(v[j].x, v[j].y); *(float2*)(d + 2) = make_float2(v[j].z, v[j].w); } }
        __syncthreads();
        { f32x4_t a0 = {0.f, 0.f, 0.f, 0.f}, a1 = a0; const float* hrow = HS + (lane & 15) * 1026 + 128 * wave + (lane >> 4);
#pragma unroll
          for (int ks = 0; ks < 32; ++ks) { const float a = hrow[4 * ks]; a0 = __builtin_amdgcn_mfma_f32_16x16x4f32(a, B0[ks], a0, 0, 0, 0); a1 = __builtin_amdgcn_mfma_f32_16x16x4f32(a, B1[ks], a1, 0, 0, 0); }
#pragma unroll
          for (int r = 0; r < 4; ++r) { const int row = (lane >> 4) * 4 + r; PART[(wave * 16 + row) * 32 + (lane & 15)] = a0[r]; PART[(wave * 16 + row) * 32 + 16 + (lane & 15)] = a1[r]; } }
        __syncthreads();
        { float s = p.in[I_BR][(size_t)l * NE + (tid & 31)];
#pragma unroll
          for (int w = 0; w < 8; ++w) s += PART[w * 512 + tid];
          LG[tid] = s; }
        __syncthreads();
        if (tid < 16) { const int t = it * 16 + tid; float lg[NE];
#pragma unroll
            for (int e = 0; e < NE; ++e) lg[e] = LG[tid * 32 + e];
            int te[TOPK]; float tv[TOPK];
#pragma unroll
            for (int r = 0; r < TOPK; ++r) { float best = -3.0e38f; int bi = 0;
#pragma unroll
                for (int e = 0; e < NE; ++e) { const bool c = lg[e] > best; best = c ? lg[e] : best; bi = c ? e : bi; }
                te[r] = bi; tv[r] = best;
#pragma unroll
                for (int e = 0; e < NE; ++e) lg[e] = (e == bi) ? -3.0e38f : lg[e]; }
            float ssum = 0.f, ex[TOPK];
#pragma unroll
            for (int r = 0; r < TOPK; ++r) { ex[r] = __expf(tv[r] - tv[0]); ssum += ex[r]; }
            const float inv = 1.f / ssum;
#pragma unroll
            for (int r = 0; r < TOPK; ++r) { p.TOPG[t * TOPK + r] = ex[r] * inv; const int lp = atomicAdd(&LCNT[te[r]], 1); const int slot = atomicAdd(NPEND, 1);
                PEND[slot * 3] = t * TOPK + r; PEND[slot * 3 + 1] = (te[r] << 16) | lp; PEND[slot * 3 + 2] = __float_as_int(ex[r] * inv); } }
        __syncthreads();
    }
    if (probe_nolist) return;
    if (tid < 32) LBASE[tid] = LCNT[tid] > 0 ? atomicAdd(&p.CNT[tid], LCNT[tid]) : 0;
    __syncthreads();
    for (int i = tid; i < NPEND[0]; i += 512) { const int pr = PEND[i * 3], x = PEND[i * 3 + 1], e = x >> 16, lp = x & 0xffff; p.LIST[(size_t)e * NT + LBASE[e] + lp] = pr; GLIST[(size_t)e * NT + LBASE[e] + lp] = __int_as_float(PEND[i * 3 + 2]); }
    __syncthreads();
}
struct EpiDown16 {
    static constexpr bool PERM = true; bf16* YB; const float* bd; const float* GL; const int* CNT; const int* LIST; int nN; int probe_skip;
    __device__ __forceinline__ void operator()(const pg8::f32x4 (&acc)[2][2][4][2], const pg8::Unit& u, int wr, int wc, int fr, int fq) const {
        if (probe_skip) return;
        const int ntile = u.pn - u.e * nN, cnt = CNT[u.e]; const float* b = bd + (size_t)u.e * D;
        int pr[2][4]; float gt[2][4];
#pragma unroll
        for (int ai = 0; ai < 2; ++ai)
#pragma unroll
            for (int m = 0; m < 4; ++m) { const int idx = u.mb * 256 + ai * 128 + wr * 64 + m * 16 + fr, ic = idx < cnt ? idx : 0; pr[ai][m] = LIST[(size_t)u.e * NT + ic]; gt[ai][m] = GL[(size_t)u.e * NT + ic]; }
        pg8::f32x4 bv[2][2];
#pragma unroll
        for (int bj = 0; bj < 2; ++bj) { const int c = ntile * 256 + bj * 128 + wc * 32 + 8 * fq; bv[bj][0] = *(const pg8::f32x4*)(b + c); bv[bj][1] = *(const pg8::f32x4*)(b + c + 4); }
#pragma unroll
        for (int ai = 0; ai < 2; ++ai)
#pragma unroll
            for (int m = 0; m < 4; ++m) { const int idx = u.mb * 256 + ai * 128 + wr * 64 + m * 16 + fr;
                if (idx < cnt) { const float g = gt[ai][m];
#pragma unroll
                    for (int bj = 0; bj < 2; ++bj) { const int c = ntile * 256 + bj * 128 + wc * 32 + 8 * fq;
                        const pg8::f32x4 v0 = (acc[ai][bj][m][0] + bv[bj][0]) * g, v1 = (acc[ai][bj][m][1] + bv[bj][1]) * g;
                        u32x4 w; w.x = pg8::cvt_pk_bf16(v0[0], v0[1]); w.y = pg8::cvt_pk_bf16(v0[2], v0[3]); w.z = pg8::cvt_pk_bf16(v1[0], v1[1]); w.w = pg8::cvt_pk_bf16(v1[2], v1[3]);
                        *(u32x4*)(YB + (size_t)pr[ai][m] * D + c) = w; } } }
    }
};
__device__ __forceinline__ void opt_moe_down16(const P& p, const Q& q, const Q2& q2, int l, LAS unsigned char* lds, int G, int bid, int probe_skip = 0) {
    pg8::Gemm g{q.ACT16, q.WtDn + (size_t)l * NE * D * DE, DE}; DnOrder S; S.init(p.CNT, p.LIST, D / 256, G, bid, (LAS int*)(lds + pg8::STAGE_BYTES));
    EpiDown16 E{q2.YB16, p.in[I_BD] + (size_t)l * NE * D, q2.GLIST, p.CNT, p.LIST, D / 256, probe_skip}; pg8::gemm_phase<EpiDown16, DnOrder, true>(lds, g, S, E);
}
#define GAS __attribute__((address_space(1)))
typedef GAS unsigned gu32;
#define XB_TMO      128
#define XB_XCNT(j)  (256  + 64 * (j))
#define XB_XSUB(j)  (1280 + 64 * (j))
#define XB_XGEN(j)  (2304 + 64 * (j))
#define XB_TOP      3328
#define XB_TOPGEN   3392
#define XCD_BAR_WORDS 3456
#define XB_SPIN_CAP (1u << 18)

__device__ __forceinline__ unsigned xb_ld(unsigned* p)              { return __hip_atomic_load(p, __ATOMIC_RELAXED, __HIP_MEMORY_SCOPE_AGENT); }
__device__ __forceinline__ unsigned xb_add(unsigned* p, unsigned v) { return __hip_atomic_fetch_add(p, v, __ATOMIC_RELAXED, __HIP_MEMORY_SCOPE_AGENT); }
__device__ __forceinline__ unsigned xb_xcc_id() { return (unsigned)__builtin_amdgcn_s_getreg((3 << 11) | 20) & 0xFu; }
#define XB_SPIN(cond, bar) do { unsigned _sp = 0; while (cond) { __builtin_amdgcn_s_sleep(1); \
    if ((++_sp & 255u) == 0u) { if (xb_ld(&(bar)[XB_TMO])) break; if (_sp > XB_SPIN_CAP) { atomicAdd(&(bar)[XB_TMO], 1u); break; } } } } while (0)

struct XcdBarrier {
    unsigned* bar; unsigned x;
    volatile LAS unsigned* st;
};

__device__ __forceinline__ XcdBarrier xcd_barrier_post(unsigned* bar, volatile LAS unsigned* st) {
    XcdBarrier b; b.bar = bar; b.x = xb_xcc_id(); b.st = st;
    if (TIDX == 0) (void)xb_add(&bar[XB_XCNT(b.x)], 1u);
    return b;
}
__device__ __forceinline__ void xcd_barrier_complete(unsigned* bar, unsigned x, unsigned& nloc, unsigned& nx) {
    const unsigned G = gridDim.x * gridDim.y * gridDim.z;
    unsigned sum, cnt, mine, sp = 0u;
    for (;;) {
        sum = 0u; cnt = 0u; mine = 0u;
#pragma unroll
        for (unsigned j = 0; j < 16; ++j) { const unsigned c = xb_ld(&bar[XB_XCNT(j)]); sum += c; cnt += (c > 0u) ? 1u : 0u; mine = (j == x) ? c : mine; }
        if (sum == G) break;
        __builtin_amdgcn_s_sleep(1);
        if ((++sp & 255u) == 0u) { if (xb_ld(&bar[XB_TMO])) break; if (sp > XB_SPIN_CAP) { atomicAdd(&bar[XB_TMO], 1u); break; } }
    }
    nloc = mine > 0u ? mine : 1u; nx = cnt > 0u ? cnt : 1u;
}

__device__ __forceinline__ void xcd_barrier(const XcdBarrier& b) {
    asm volatile("s_waitcnt vmcnt(0)" ::: "memory");
    __syncthreads();
    if (TIDX == 0) {
        unsigned* bar = b.bar;
        __builtin_amdgcn_s_waitcnt(0);
        unsigned nloc = b.st[0], nx = b.st[1];
        if (nloc == 0u) { xcd_barrier_complete(bar, b.x, nloc, nx); b.st[0] = nloc; b.st[1] = nx; }
        const unsigned old = xb_add(&bar[XB_XSUB(b.x)], 1u);
        const unsigned gen = old / nloc;
        if (old + 1u == (gen + 1u) * nloc) {
            __builtin_amdgcn_fence(__ATOMIC_RELEASE, "agent");
            asm volatile("s_waitcnt vmcnt(0)" ::: "memory");
            const unsigned og = xb_add(&bar[XB_TOP], 1u);
            const unsigned tg = og / nx;
            if (og + 1u == (tg + 1u) * nx) xb_add(&bar[XB_TOPGEN], 1u);
            else XB_SPIN(xb_ld(&bar[XB_TOPGEN]) == tg, bar);
            __builtin_amdgcn_fence(__ATOMIC_ACQUIRE, "agent");
            xb_add(&bar[XB_XGEN(b.x)], 1u);
            asm volatile("s_waitcnt vmcnt(0)" ::: "memory");
        } else {
            XB_SPIN(xb_ld(&bar[XB_XGEN(b.x)]) == gen, bar);
            __builtin_amdgcn_fence(__ATOMIC_ACQUIRE, "agent");
            asm volatile("s_waitcnt vmcnt(0)" ::: "memory");
        }
    }
    __syncthreads();
}
#include <hip/hip_cooperative_groups.h>
#include <cstdio>
namespace cg = cooperative_groups;
#ifndef ONE_LAUNCH
#define ONE_LAUNCH 1
#endif
constexpr int LDS_BYTES = 148480;
static_assert(ML2_LDS <= LDS_BYTES && ML1_LDS <= LDS_BYTES && LRU1_LDS <= LDS_BYTES && RPM_LDS <= LDS_BYTES && att::SHM_ATTN <= LDS_BYTES && pg8::STAGE_BYTES + 1024 + 8192 <= LDS_BYTES - 64, "LDS map");

struct BMap { size_t off[64]; size_t total; };
static inline BMap b_map() {
    BMap m; size_t o = 0; int i = 0;
    auto add = [&](size_t bytes) { m.off[i++] = o; o += (bytes + 255) & ~(size_t)255; };
    add((size_t)DEPTH * 3 * 6 * D * 4);
    add((size_t)SEQ * 16 * 2 * 4);
    add((size_t)NT * D * 4);
    add((size_t)NT * TOPK * 4);
    add((size_t)256);
    add((size_t)NE * NT * 4);
    add((size_t)DEPTH * DINP * D * 2);
    add((size_t)DEPTH * D * DMIX * 2);
    add((size_t)DEPTH * NE * 2 * DE * D * 2);
    add((size_t)DEPTH * NE * D * DE * 2);
    add((size_t)DEPTH * 768 * QRANK * 2);
    add((size_t)DEPTH * 1024 * KVRANK * 2);
    add((size_t)NT * D * 2);
    add((size_t)NT * DMIX * 2);
    add((size_t)SLOT_MAX * DE * 2);
    add((size_t)NT * AH * QKD * 2);
    add((size_t)NT * AH * VD * 2);
    add((size_t)NT * DINP * 2);
    add((size_t)DEPTH * 4 * 256 * 64 * 2);
    add((size_t)DEPTH * 4 * 3 * 4096 * 2);
    add((size_t)DEPTH * 32 * 768 * 2);
    add((size_t)DEPTH * 2 * 256 * 4);
    add((size_t)2 * NT * 256 * 4);
    add((size_t)2 * NT * 256 * 4);
    add((size_t)2 * NB * NCH * 256 * 4);
    add((size_t)2 * NB * NCH * 256 * 4);
    add((size_t)NT * 256 * 2);
    add((size_t)NT * 256 * 2);
    add((size_t)NT * 768 * 2);
    add((size_t)DEPTH * 1024 * 256 * 2);
    add((size_t)NT * 256 * 2);
    add((size_t)NT * 768 * 2);
    add((size_t)NT * 16 * 4);
    add((size_t)2 * NB * NCH * 4 * 4096 * 4);
    add((size_t)2 * NB * NCH * 4 * 64 * 4);
    add((size_t)2 * NB * NCH * 4 * 2 * 4);
    add((size_t)NT * TOPK * D * 2);
    add((size_t)XCD_BAR_WORDS * 4);
    add((size_t)2 * NB * NCH * 4 * 4096 * 2);
    add((size_t)2 * NB * NCH * 4 * 64 * 4);
    add((size_t)2 * NB * NCH * 4 * 4);
    add((size_t)NE * NT * 4);
    m.total = o; return m;
}
struct Args { P p; Q q; Q2 q2; unsigned* bar; };
static inline void fill_args(Args& a, void* const* d_in, void* d_out, void* d_ws) {
    for (int i = 0; i < N_IN; ++i) a.p.in[i] = (const float*)d_in[i];
    a.p.out = (float*)d_out; char* w = (char*)d_ws; const BMap m = b_map();
    a.p.MOD = (float*)(w + m.off[0]); a.p.ROPET = (float*)(w + m.off[1]); a.p.X = (float*)(w + m.off[2]); a.p.TOPG = (float*)(w + m.off[3]); a.p.CNT = (int*)(w + m.off[4]); a.p.LIST = (int*)(w + m.off[5]);
    a.q.WtIn = (bf16*)(w + m.off[6]); a.q.WtOut = (bf16*)(w + m.off[7]); a.q.WtGu = (bf16*)(w + m.off[8]); a.q.WtDn = (bf16*)(w + m.off[9]); a.q.WtQb = (bf16*)(w + m.off[10]); a.q.WtKvb = (bf16*)(w + m.off[11]);
    a.q.H16 = (bf16*)(w + m.off[12]); a.q.Y16 = (bf16*)(w + m.off[13]); a.q.ACT16 = (bf16*)(w + m.off[14]); a.q.K16 = (bf16*)(w + m.off[15]); a.q.V16 = (bf16*)(w + m.off[16]);
    a.q2.U16 = (bf16*)(w + m.off[17]); a.q2.WtL = (bf16*)(w + m.off[18]); a.q2.WtM = (bf16*)(w + m.off[19]); a.q2.WtG = (bf16*)(w + m.off[20]); a.q2.LSL = (float*)(w + m.off[21]);
    a.q2.HLOC = (bf16*)(w + m.off[22]); a.q2.PCUM = (bf16*)(w + m.off[23]); a.q2.SA = (float*)(w + m.off[24]); a.q2.SB = (float*)(w + m.off[25]);
    a.q2.QN16 = (bf16*)(w + m.off[26]); a.q2.KVN16 = (bf16*)(w + m.off[27]); a.q2.Q16 = (bf16*)(w + m.off[28]); a.q2.WtKvbP = (bf16*)(w + m.off[29]);
    a.q2.XCM16 = (bf16*)(w + m.off[30]); a.q2.QKV16 = (bf16*)(w + m.off[31]); a.q2.GATES = (float*)(w + m.off[32]); a.q2.CLOC = (float*)(w + m.off[33]); a.q2.NLOC = (float*)(w + m.off[34]); a.q2.MLB = (float*)(w + m.off[35]);
    a.q2.YB16 = (bf16*)(w + m.off[36]); a.bar = (unsigned*)(w + m.off[37]); a.q2.CST = (bf16*)(w + m.off[38]); a.q2.NST = (float*)(w + m.off[39]); a.q2.MST = (float*)(w + m.off[40]); a.q2.GLIST = (float*)(w + m.off[41]);
}

struct ULoad16 { const bf16* U; __device__ __forceinline__ float operator()(int t, int col) const { return bf2f(U[(size_t)t * DINP + col]); } };
struct YStore16 { bf16* Y; __device__ __forceinline__ void operator()(int t, int col, float v) const { Y[(size_t)t * DMIX + col] = (bf16)f2bf(v); } };
struct OutY16 { bf16* y; __device__ __forceinline__ void operator()(int row, int col, float v) const { y[(size_t)row * DMIX + col] = (bf16)f2bf(v); } };

enum { ST_INIT = 0, ST_RPFIRST, ST_INPROJ, ST_PREP, ST_MLAPROJ, ST_MIX, ST_OUTPROJ, ST_RPMID, ST_GU, ST_DOWN, ST_RPEND, N_ST };

typedef const __attribute__((address_space(4))) Args* KArgs;
__device__ __forceinline__ KArgs kargs() { KArgs k = (KArgs)__builtin_amdgcn_kernarg_segment_ptr(); asm volatile("" : "+s"(k)); return k; }
__device__ __forceinline__ void run_step(const Args& a, int step, int l_, unsigned char* lds_raw) {
    const int l = l_ & 0xff, sub = l_ >> 8;
    const P& p = a.p; const Q& q = a.q; const Q2& q2 = a.q2;
    LAS unsigned char* lds = (LAS unsigned char*)lds_raw; char* ldsg = (char*)lds_raw;
    int G_ = gridDim.x, bid_ = blockIdx.x; asm volatile("" : "+s"(G_), "+s"(bid_));
    const int G = G_, bid = bid_;
#define THREAD_IDS int tid_ = TIDX; asm volatile("" : "+v"(tid_)); const int tid = tid_, lane = tid & 63, wave = __builtin_amdgcn_readfirstlane(tid >> 6); \
    const int gw = bid * NWAVES + wave, ngw = G * NWAVES; const long gtid = (long)bid * NTHREADS + tid, nthr = (long)G * NTHREADS; (void)lane; (void)gw; (void)ngw; (void)gtid; (void)nthr;
    switch (step) {
    case ST_INIT: { THREAD_IDS
        opt_init_mod(p, ldsg, bid, G); opt_init_rope(p, gtid, nthr); opt_convert_small(p, q2, gtid, nthr); opt_convert_weights(p, q, q2.WtKvbP, lds, gw, ngw, wave, lane); break; }
    case ST_RPFIRST: { THREAD_IDS rp_first(p, q, gw, ngw, lane); break; }
    case ST_INPROJ: opt_inproj16(q, q2, l, lds, G, bid); break;
    case ST_PREP: { THREAD_IDS
        if (gtid < NE) p.CNT[gtid] = 0;
        const ULoad16 U{q2.U16};
        constexpr int NM = NB * NCH, NL = NB * NCH * 4;
        if (G > NM + 8) {
            if (bid < NM) { if (sub == 0 || (sub & 1)) ml1_item(p, q2, l, bid / NCH, bid % NCH, ldsg, U);
                if (sub == 0 || (sub & 2)) lru1_item(p, q2, l, (bid >> 2) / NCH, (bid >> 2) % NCH, bid & 3, ldsg, U); }
            else if (sub == 0 || (sub & 2)) for (int x = NM + (bid - NM); x < NL; x += G - NM) lru1_item(p, q2, l, (x >> 2) / NCH, (x >> 2) % NCH, x & 3, ldsg, U);
        } else for (int it = bid; it < NM + NL; it += G) {
            if (it < NM) { if (sub == 0 || (sub & 1)) ml1_item(p, q2, l, it / NCH, it % NCH, ldsg, U); }
            else if (sub == 0 || (sub & 2)) { const int x = it - NM; lru1_item(p, q2, l, (x >> 2) / NCH, (x >> 2) % NCH, x & 3, ldsg, U); } }
        if (sub == 0 || (sub & 4)) for (int t = gw; t < NT; t += ngw) mla_prep_token(p, q, q2, l, t, lane, U);
        break; }
    case ST_MLAPROJ: { for (int it = G - 1 - bid; it < 64; it += G) ml_scan_item(q2, it, ldsg);
        opt_mla_proj(p, q, q2, l, lds, G, bid); break; }
    case ST_MIX: {
        const ULoad16 U{q2.U16}; const YStore16 Y{q.Y16};
        const int c = bid, vcu = (G % 8 == 0) ? (c % 8) * (G / 8) + c / 8 : c;
        constexpr int QB_LAT = SEQ / 256, QB_CTX = CTX / 256, NU_LAT = NB * AH * QB_LAT, NU_CTX = NB * AH * QB_CTX;
#ifdef ATTN_PROBE_VAR
        if (sub & 1) { struct NoOut { __device__ __forceinline__ void operator()(int, int, float) const {} } noout;
            for (int u = vcu; u < NU_LAT; u += G) { const int bh = u / QB_LAT, qb = u % QB_LAT, b = bh / AH, h = bh % AH, t0 = b * TPB + CTX + qb * 256;
                att::attn_unit<unsigned short, NoOut, ATTN_PROBE_VAR>((const unsigned short*)q2.Q16 + (size_t)t0 * 768 + h * QKD, 768, (const unsigned short*)q.K16 + ((size_t)b * AH + h) * TPB * QKD, (const unsigned short*)q.V16 + ((size_t)b * AH + h) * TPB * VD, TPB, ldsg, noout); } }
        else
#endif
        if (sub == 0 || (sub & 1)) for (int u = vcu; u < NU_LAT; u += G) { const int bh = u / QB_LAT, qb = u % QB_LAT, b = bh / AH, h = bh % AH, t0 = b * TPB + CTX + qb * 256;
            OutY16 out{q.Y16 + (size_t)t0 * DMIX + 256 + h * VD};
            att::attn_unit<unsigned short, OutY16>((const unsigned short*)q2.Q16 + (size_t)t0 * 768 + h * QKD, 768, (const unsigned short*)q.K16 + ((size_t)b * AH + h) * TPB * QKD, (const unsigned short*)q.V16 + ((size_t)b * AH + h) * TPB * VD, TPB, ldsg, out); }
        if ((sub == 0 || (sub & 1)) && l + 1 < DEPTH) for (int u = vcu; u < NU_CTX; u += G) { const int bh = u / QB_CTX, qb = u % QB_CTX, b = bh / AH, h = bh % AH, t0 = b * TPB + qb * 256;
            OutY16 out{q.Y16 + (size_t)t0 * DMIX + 256 + h * VD};
            att::attn_unit<unsigned short, OutY16>((const unsigned short*)q2.Q16 + (size_t)t0 * 768 + h * QKD, 768, (const unsigned short*)q.K16 + ((size_t)b * AH + h) * TPB * QKD, (const unsigned short*)q.V16 + ((size_t)b * AH + h) * TPB * VD, CTX, ldsg, out); }
        const int ch0 = (l + 1 < DEPTH) ? 0 : NCH_CTX, nch = NCH - ch0;
        if (sub == 0 || (sub & 2)) for (int it = G - 1 - c; it < NB * nch * 4; it += G) { const int x = it >> 2; ml2_item(p, q2, l, x / nch, ch0 + x % nch, it & 3, ldsg, U, Y); }
        if (sub == 0 || (sub & 4)) for (int it = c; it < NB * nch; it += G) lru2_item(q2, q.Y16, it / nch, ch0 + it % nch, ldsg);
        break; }
    case ST_OUTPROJ: opt_outproj(p, q, l, lds, G, bid, l + 1 == DEPTH); break;
    case ST_RPMID: rp_mid(p, q, q2.GLIST, l, ldsg, G, bid, l + 1 == DEPTH, sub != 0); break;
    case ST_GU: opt_moe_gu(p, q, l, lds, G, bid, sub); break;
    case ST_DOWN: opt_moe_down16(p, q, q2, l, lds, G, bid, sub); break;
    case ST_RPEND: { THREAD_IDS rp_end(p, q, q2, l, gw, ngw, lane, sub != 0 ? 0.f : 1.f); break; }
    }
}

#if ONE_LAUNCH
__global__ void __launch_bounds__(512, 2) k_mega(Args a) {
    extern __shared__ __attribute__((aligned(16))) unsigned char lds_raw[];
    volatile LAS unsigned* MISC = (volatile LAS unsigned*)((LAS unsigned char*)lds_raw + LDS_BYTES - 64);
    if (threadIdx.x < 16) MISC[threadIdx.x] = 0u;
    if ((threadIdx.x & 63) == 0) ((LAS int*)((LAS unsigned char*)lds_raw + WTAB_OFF))[HWID()] = threadIdx.x >> 6;
    __syncthreads();
    { const XcdBarrier b0 = xcd_barrier_post(a.bar, MISC + 8); if (TIDX == 0) MISC[10] = b0.x; }
#define GRID_BAR() do { XcdBarrier b_; b_.bar = a.bar; b_.st = MISC + 8; b_.x = MISC[10]; xcd_barrier(b_); } while (0)
    run_step(a, ST_INIT, 0, lds_raw); GRID_BAR();
    run_step(a, ST_RPFIRST, 0, lds_raw); GRID_BAR();
#pragma unroll 1
    for (int l = 0; l < DEPTH; ++l) {
#pragma unroll 1
        for (int s = ST_INPROJ; s <= ST_RPEND; ++s) { run_step(a, s, l, lds_raw); if (!(l == DEPTH - 1 && s == ST_RPEND)) GRID_BAR();
#ifdef MEGA_DUP_STEP
            if (s == MEGA_DUP_STEP) { run_step(a, s, l, lds_raw); GRID_BAR(); }
#endif
        }
    }
}
#else
template <int STEP>
__global__ void __launch_bounds__(512, 2) k_step(Args a, int l) {
    extern __shared__ __attribute__((aligned(16))) unsigned char lds_raw[];
    run_step(a, STEP, l, lds_raw);
}
template <int STEP> static void launch_step(const Args& a, int l, hipStream_t stream) {
    static bool attr = false;
    if (!attr) { (void)hipFuncSetAttribute((const void*)k_step<STEP>, hipFuncAttributeMaxDynamicSharedMemorySize, LDS_BYTES); attr = true; }
    hipLaunchKernelGGL(k_step<STEP>, dim3(256), dim3(512), LDS_BYTES, stream, a, l);
}
#endif

extern "C" void kernel_launch(void* const* d_in, const int* in_sizes, int n_in, void* d_out, int out_size, void* d_ws, size_t ws_size, hipStream_t stream) {
    static int grid_blocks = 0;
    if (!grid_blocks) {
        int dev = 0, cus = 0;
        (void)hipGetDevice(&dev); (void)hipDeviceGetAttribute(&cus, hipDeviceAttributeMultiprocessorCount, dev);
        grid_blocks = cus;
#if ONE_LAUNCH
        int per_cu = 0;
        (void)hipFuncSetAttribute((const void*)k_mega, hipFuncAttributeMaxDynamicSharedMemorySize, LDS_BYTES);
        (void)hipOccupancyMaxActiveBlocksPerMultiprocessor(&per_cu, (const void*)k_mega, 512, LDS_BYTES);
        if (per_cu < 1) fprintf(stderr, "kernel_launch: occupancy query reports %d workgroups per CU\n", per_cu);
#endif
        const BMap m = b_map();
        if (n_in != N_IN || m.total > ws_size) fprintf(stderr, "kernel_launch: bad n_in %d or workspace too small (%zu needed, %zu given)\n", n_in, m.total, ws_size);
    }
    Args a{}; fill_args(a, d_in, d_out, d_ws);
#if ONE_LAUNCH
    (void)hipMemsetAsync(a.bar, 0, XCD_BAR_WORDS * 4, stream);
    void* args[] = {&a};
    hipError_t e = hipLaunchCooperativeKernel((const void*)k_mega, dim3(grid_blocks), dim3(512), args, LDS_BYTES, stream);
    if (e != hipSuccess) fprintf(stderr, "cooperative launch failed: %s (grid %d)\n", hipGetErrorString(e), grid_blocks);
#else
#ifndef DUP_STEP
#define DUP_STEP -1
#endif
#ifndef DUP_SUB
#define DUP_SUB 0
#endif
#define LS(ST, l) do { launch_step<ST>(a, l, stream); if (ST == DUP_STEP) launch_step<ST>(a, (l) | (DUP_SUB << 8), stream); } while (0)
    LS(ST_INIT, 0); LS(ST_RPFIRST, 0);
    for (int l = 0; l < DEPTH; ++l) {
        LS(ST_INPROJ, l); LS(ST_PREP, l); LS(ST_MLAPROJ, l); LS(ST_MIX, l); LS(ST_OUTPROJ, l);
        LS(ST_RPMID, l); LS(ST_GU, l); LS(ST_DOWN, l); LS(ST_RPEND, l);
    }
#endif
}
```

```cpp
#include <hip/hip_runtime.h>
#define ONE_LAUNCH 1
#include <math.h>
#include <stdint.h>

#ifndef CFG_D_MODEL
#define CFG_D_MODEL 1024
#endif
#ifndef CFG_SEQ
#define CFG_SEQ 8192
#endif
#ifndef CFG_GRID_W
#define CFG_GRID_W 64
#endif
#ifndef CFG_CTX_LEN
#define CFG_CTX_LEN 256
#endif
#ifndef CFG_N_EXPERTS
#define CFG_N_EXPERTS 32
#endif
#ifndef CFG_D_EXPERT
#define CFG_D_EXPERT 1024
#endif

#ifdef HOST_TEST
#define HD inline
struct float4 { float x, y, z, w; };
static inline int atomic_add_i(int* p, int v) { int o = *p; *p = o + v; return o; }
#else
#define HD __device__ __forceinline__
static __device__ __forceinline__ int atomic_add_i(int* p, int v) { return atomicAdd(p, v); }
#endif

constexpr int D = CFG_D_MODEL, NB = 2, SEQ = CFG_SEQ, DEPTH = 2, GRID_W = CFG_GRID_W, CTX = CFG_CTX_LEN;
constexpr int TPB = CTX + SEQ;
constexpr int NT = NB * TPB;
constexpr int LW = 256, MLH = 4, MHD = 64, MW = 256;
constexpr int AH = 8, NOPE = 64, ROPE = 32, VD = 64, QRANK = 256, KVRANK = 128, QKD = NOPE + ROPE;
constexpr int DIN = 1440, DMIX = 1024;
constexpr int OFF_AX = 0, OFF_AG = 256, OFF_BQ = 512, OFF_BKV = 768, OFF_BKR = 896, OFF_MX = 928, OFF_MZ = 1184;
constexpr int NE = CFG_N_EXPERTS, TOPK = 4, DE = CFG_D_EXPERT;
constexpr float EPS = 1e-6f;

enum { I_X = 0, I_C, I_CTX, I_CCTX, I_N1G, I_N2G, I_WMOD, I_BMOD, I_WIN, I_WOUT, I_LCW, I_LCB, I_LWA, I_LBA, I_LWX, I_LBX, I_LLAM,
       I_QNG, I_WQB, I_KVNG, I_WKVB, I_MCW, I_MCB, I_MWQ, I_MWK, I_MWV, I_MWG, I_MBG, I_MNG, I_MSK, I_WR, I_BR, I_WGU, I_BGU, I_WD, I_BD, I_FG, N_IN };

struct P {
    const float* in[N_IN];
    float* out;
    float *MOD, *ROPET, *X, *H, *U, *XC, *LA, *LB, *HL, *QN, *KVN, *QF, *KVF, *Qr, *Kr, *Vr, *XCM, *QM, *KM, *VM, *IGF, *HM, *Y, *TOPG, *ACT, *YB;
    int *TOPE, *CNT, *LIST;
};

HD float sigmoid_f(float x) { return 1.f / (1.f + expf(-x)); }
HD float silu_f(float x) { return x * sigmoid_f(x); }
HD float logsigmoid_f(float x) { return fminf(x, 0.f) - log1pf(expf(-fabsf(x))); }
HD float gelu_f(float x) { return 0.5f * x * (1.f + tanhf(0.7978845608028654f * (x + 0.044715f * x * x * x))); }

HD int tok_b(int t) { return t / TPB; }
HD int tok_i(int t) { return t % TPB; }
HD bool tok_isctx(int t) { return tok_i(t) < CTX; }
HD int tok_cv(int t) { return tok_isctx(t) ? 2 : tok_b(t); }
HD const float* modp(const P& p, int l, int cv, int which) { return p.MOD + (((size_t)l * 3 + cv) * 6 + which) * D; }

template <int R>
HD void gemm_rx4(const float* (&a)[R], const float* B, int ldb, int K, float4 (&acc)[R]) {
    for (int k = 0; k < K; ++k) {
        const float4 bv = *(const float4*)(B + (size_t)k * ldb);
#pragma unroll
        for (int r = 0; r < R; ++r) { const float av = a[r][k]; acc[r].x += av * bv.x; acc[r].y += av * bv.y; acc[r].z += av * bv.z; acc[r].w += av * bv.w; }
    }
}

HD void nv_init(const P& p, long gtid, long nthr) {
    for (long it = gtid; it < (long)DEPTH * 6 * D; it += nthr) {
        const int l = (int)(it / (6 * D)), j = (int)(it % (6 * D));
        const float* w = p.in[I_WMOD] + (size_t)l * D * 6 * D + j;
        float a0 = 0.f, a1 = 0.f, a2 = 0.f;
        for (int k = 0; k < D; ++k) { const float wv = w[(size_t)k * 6 * D];
            a0 += silu_f(p.in[I_C][k]) * wv; a1 += silu_f(p.in[I_C][D + k]) * wv; a2 += silu_f(p.in[I_CCTX][k]) * wv; }
        const float bb = p.in[I_BMOD][(size_t)l * 6 * D + j];
        p.MOD[((size_t)l * 3 + 0) * 6 * D + j] = a0 + bb; p.MOD[((size_t)l * 3 + 1) * 6 * D + j] = a1 + bb; p.MOD[((size_t)l * 3 + 2) * 6 * D + j] = a2 + bb;
    }
    for (long it = gtid; it < (long)NT * D; it += nthr) {
        const int t = (int)(it / D), k = (int)(it % D), b = tok_b(t), i = tok_i(t);
        p.X[it] = (i < CTX) ? p.in[I_CTX][((size_t)b * CTX + i) * D + k] : p.in[I_X][((size_t)b * SEQ + (i - CTX)) * D + k];
    }
    for (long it = gtid; it < (long)SEQ * 16; it += nthr) {
        const int s = (int)(it / 16), a = (int)((it / 8) & 1), f = (int)(it & 7);
        const int pos = a == 0 ? s / GRID_W : s % GRID_W;
        const double fr = pow(10000.0, -(double)f / 8.0);
        const float frf = (float)fr;
        const double ang = (double)((float)pos * frf);
        p.ROPET[it * 2] = (float)cos(ang); p.ROPET[it * 2 + 1] = (float)sin(ang);
    }
}

HD void nv_norm(const P& p, int l, int which  , long gtid, long nthr) {
    const float* g = p.in[which == 0 ? I_N1G : I_N2G] + (size_t)l * D;
    for (long t = gtid; t < NT; t += nthr) {
        const float* x = p.X + (size_t)t * D; float ss = 0.f;
        for (int k = 0; k < D; ++k) ss += x[k] * x[k];
        const float rstd = 1.f / sqrtf(ss / (float)D + EPS);
        const int cv = tok_cv((int)t); const float* sh = modp(p, l, cv, which == 0 ? 0 : 3); const float* sc = modp(p, l, cv, which == 0 ? 1 : 4);
        float* h = p.H + (size_t)t * D;
        for (int k = 0; k < D; ++k) h[k] = x[k] * rstd * g[k] * (1.f + sc[k]) + sh[k];
    }
}

HD void nv_inproj(const P& p, int l, long gtid, long nthr) {
    constexpr int R = 8, NQ = DIN / 4; const float* W = p.in[I_WIN] + (size_t)l * D * DIN;
    for (long it = gtid; it < (long)(NT / R) * NQ; it += nthr) {
        const int mi = (int)(it / NQ), n = (int)(it % NQ) * 4;
        const float* a[R]; float4 acc[R];
#pragma unroll
        for (int r = 0; r < R; ++r) { a[r] = p.H + (size_t)(mi * R + r) * D; acc[r] = float4{0.f, 0.f, 0.f, 0.f}; }
        gemm_rx4<R>(a, W + n, DIN, D, acc);
#pragma unroll
        for (int r = 0; r < R; ++r) *(float4*)(p.U + (size_t)(mi * R + r) * DIN + n) = acc[r];
    }
}

HD float conv_at(const P& p, int t, int col, int c, const float* w  , const float* bias) {
    const int i = tok_i(t), isc = i < CTX, li = isc ? i : i - CTX, len = isc ? CTX : SEQ;
    float s = bias[c];
#pragma unroll
    for (int k = 0; k < 4; ++k) { const int j = li + k - 2; if (j >= 0 && j < len) s += w[k * 256 + c] * p.U[(size_t)(t + k - 2) * DIN + col + c]; }
    return s;
}

HD void nv_prep1(const P& p, int l, long gtid, long nthr) {
    for (long it = gtid; it < (long)NT * 256; it += nthr) {
        const int t = (int)(it / 256), c = (int)(it % 256);
        p.XC[it] = conv_at(p, t, OFF_AX, c, p.in[I_LCW] + (size_t)l * 4 * 256, p.in[I_LCB] + (size_t)l * 256);
        p.XCM[it] = silu_f(conv_at(p, t, OFF_MX, c, p.in[I_MCW] + (size_t)l * 4 * 256, p.in[I_MCB] + (size_t)l * 256));
    }
    for (long t = gtid; t < NT; t += nthr) {
        const float* u = p.U + (size_t)t * DIN; float sq = 0.f, sk = 0.f;
        for (int k = 0; k < QRANK; ++k) sq += u[OFF_BQ + k] * u[OFF_BQ + k];
        for (int k = 0; k < KVRANK; ++k) sk += u[OFF_BKV + k] * u[OFF_BKV + k];
        const float rq = 1.f / sqrtf(sq / (float)QRANK + EPS), rk = 1.f / sqrtf(sk / (float)KVRANK + EPS);
        for (int k = 0; k < QRANK; ++k) p.QN[(size_t)t * QRANK + k] = u[OFF_BQ + k] * rq * p.in[I_QNG][(size_t)l * QRANK + k];
        for (int k = 0; k < KVRANK; ++k) p.KVN[(size_t)t * KVRANK + k] = u[OFF_BKV + k] * rk * p.in[I_KVNG][(size_t)l * KVRANK + k];
    }
}

HD void nv_prep2(const P& p, int l, long gtid, long nthr) {
    for (long it = gtid; it < (long)2 * NT * 256; it += nthr) {
        const int d = (int)(it / ((long)NT * 256)), t = (int)((it / 256) % NT), c = (int)(it % 256), g = c / 64, j = c % 64;
        const float* xc = p.XC + (size_t)t * 256 + g * 64;
        const float* wa = p.in[I_LWA] + ((((size_t)l * 2 + d) * 4 + g) * 64) * 64 + j;
        const float* wx = p.in[I_LWX] + ((((size_t)l * 2 + d) * 4 + g) * 64) * 64 + j;
        float sa = 0.f, sx = 0.f;
        for (int i = 0; i < 64; ++i) { sa += xc[i] * wa[i * 64]; sx += xc[i] * wx[i * 64]; }
        const float r = sigmoid_f(sa + p.in[I_LBA][((size_t)l * 2 + d) * 256 + c]), ig = sigmoid_f(sx + p.in[I_LBX][((size_t)l * 2 + d) * 256 + c]);
        const float log_a = 8.0f * r * logsigmoid_f(p.in[I_LLAM][((size_t)l * 2 + d) * 256 + c]);
        p.LA[it] = expf(log_a); p.LB[it] = sqrtf(-expm1f(2.f * log_a)) * ig * p.XC[(size_t)t * 256 + c];
    }
    { constexpr int R = 8, NQ = 768 / 4; const float* W = p.in[I_WQB] + (size_t)l * QRANK * 768;
      for (long it = gtid; it < (long)(NT / R) * NQ; it += nthr) { const int mi = (int)(it / NQ), n = (int)(it % NQ) * 4;
        const float* a[R]; float4 acc[R];
#pragma unroll
        for (int r = 0; r < R; ++r) { a[r] = p.QN + (size_t)(mi * R + r) * QRANK; acc[r] = float4{0.f, 0.f, 0.f, 0.f}; }
        gemm_rx4<R>(a, W + n, 768, QRANK, acc);
#pragma unroll
        for (int r = 0; r < R; ++r) *(float4*)(p.QF + (size_t)(mi * R + r) * 768 + n) = acc[r]; } }
    { constexpr int R = 8, NQ = 1024 / 4; const float* W = p.in[I_WKVB] + (size_t)l * KVRANK * 1024;
      for (long it = gtid; it < (long)(NT / R) * NQ; it += nthr) { const int mi = (int)(it / NQ), n = (int)(it % NQ) * 4;
        const float* a[R]; float4 acc[R];
#pragma unroll
        for (int r = 0; r < R; ++r) { a[r] = p.KVN + (size_t)(mi * R + r) * KVRANK; acc[r] = float4{0.f, 0.f, 0.f, 0.f}; }
        gemm_rx4<R>(a, W + n, 1024, KVRANK, acc);
#pragma unroll
        for (int r = 0; r < R; ++r) *(float4*)(p.KVF + (size_t)(mi * R + r) * 1024 + n) = acc[r]; } }
    for (long it = gtid; it < (long)NT * 256; it += nthr) {
        const int t = (int)(it / 256), c = (int)(it % 256), h = c / 64, j = c % 64;
        const float* xc = p.XCM + (size_t)t * 256 + h * 64; const float* ux = p.U + (size_t)t * DIN + OFF_MX + h * 64;
        const float* wq = p.in[I_MWQ] + (((size_t)l * 4 + h) * 64) * 64 + j; const float* wk = p.in[I_MWK] + (((size_t)l * 4 + h) * 64) * 64 + j; const float* wv = p.in[I_MWV] + (((size_t)l * 4 + h) * 64) * 64 + j;
        float sq = 0.f, sk = 0.f, sv = 0.f;
        for (int i = 0; i < 64; ++i) { sq += xc[i] * wq[i * 64]; sk += xc[i] * wk[i * 64]; sv += ux[i] * wv[i * 64]; }
        p.QM[it] = sq; p.KM[it] = sk * 0.125f; p.VM[it] = sv;
    }
}

HD void nv_prep3(const P& p, int l, long gtid, long nthr) {
    for (long it = gtid; it < (long)NB * 2 * 256; it += nthr) {
        const int b = (int)(it / 512), d = (int)((it / 256) & 1), c = (int)(it % 256);
        const float* A = p.LA + (size_t)d * NT * 256; const float* Bc = p.LB + (size_t)d * NT * 256; float* Ho = p.HL + (size_t)d * NT * 256;
        float h = 0.f;
        for (int seg = 0; seg < 2; ++seg) { const int base = b * TPB + (seg == 0 ? 0 : CTX), len = seg == 0 ? CTX : SEQ;
            for (int s = 0; s < len; ++s) { const int t = base + (d == 0 ? s : len - 1 - s);
                h = A[(size_t)t * 256 + c] * h + Bc[(size_t)t * 256 + c]; Ho[(size_t)t * 256 + c] = h; } }
    }
    for (long it = gtid; it < (long)NT * AH; it += nthr) {
        const int t = (int)(it / AH), h = (int)(it % AH), i = tok_i(t); const bool lat = i >= CTX; const int s = i - CTX;
        const float* qf = p.QF + (size_t)t * 768 + h * QKD; const float* kvf = p.KVF + (size_t)t * 1024 + h * (NOPE + VD); const float* kr = p.U + (size_t)t * DIN + OFF_BKR;
        float* qo = p.Qr + ((size_t)t * AH + h) * QKD; float* ko = p.Kr + ((size_t)t * AH + h) * QKD; float* vo = p.Vr + ((size_t)t * AH + h) * VD;
        for (int k = 0; k < NOPE; ++k) { qo[k] = qf[k]; ko[k] = kvf[k]; vo[k] = kvf[NOPE + k]; }
        for (int a = 0; a < 2; ++a) for (int f = 0; f < 8; ++f) {
            float cs = 1.f, sn = 0.f; if (lat) { cs = p.ROPET[(((size_t)s * 2 + a) * 8 + f) * 2]; sn = p.ROPET[(((size_t)s * 2 + a) * 8 + f) * 2 + 1]; }
            const float q1 = qf[NOPE + a * 16 + f], q2 = qf[NOPE + a * 16 + 8 + f], k1 = kr[a * 16 + f], k2 = kr[a * 16 + 8 + f];
            qo[NOPE + a * 16 + f] = q1 * cs - q2 * sn; qo[NOPE + a * 16 + 8 + f] = q2 * cs + q1 * sn;
            ko[NOPE + a * 16 + f] = k1 * cs - k2 * sn; ko[NOPE + a * 16 + 8 + f] = k2 * cs + k1 * sn; }
    }
    for (long it = gtid; it < (long)2 * NT * 8; it += nthr) {
        const int d = (int)(it / ((long)NT * 8)), t = (int)((it / 8) % NT), g = (int)(it % 8);
        const float* w = p.in[I_MWG] + (((size_t)l * 2 + d) * 768) * 8 + g; float s = p.in[I_MBG][((size_t)l * 2 + d) * 8 + g];
        for (int i = 0; i < 256; ++i) s += p.QM[(size_t)t * 256 + i] * w[(size_t)i * 8];
        for (int i = 0; i < 256; ++i) s += p.KM[(size_t)t * 256 + i] * w[(size_t)(256 + i) * 8];
        for (int i = 0; i < 256; ++i) s += p.VM[(size_t)t * 256 + i] * w[(size_t)(512 + i) * 8];
        p.IGF[it] = g < 4 ? s : logsigmoid_f(s);
    }
}

HD void nv_attn(const P& p, long gtid, long nthr) {
    const float scale = 1.0f / sqrtf((float)QKD);
    for (long it = gtid; it < (long)NT * AH; it += nthr) {
        const int h = (int)((it / TPB) % AH), b = (int)(it / ((long)TPB * AH)), i = (int)(it % TPB), t = b * TPB + i;
        const int nk = i < CTX ? CTX : TPB;
        float q[QKD], o[VD];
#pragma unroll
        for (int k = 0; k < QKD; ++k) q[k] = p.Qr[((size_t)t * AH + h) * QKD + k] * scale;
#pragma unroll
        for (int k = 0; k < VD; ++k) o[k] = 0.f;
        float m = -1e30f, lsum = 0.f;
        for (int j = 0; j < nk; ++j) {
            const float* kk = p.Kr + ((size_t)(b * TPB + j) * AH + h) * QKD; const float* vv = p.Vr + ((size_t)(b * TPB + j) * AH + h) * VD;
            float s = 0.f;
#pragma unroll
            for (int k = 0; k < QKD; ++k) s += q[k] * kk[k];
            if (s > m) { const float f = expf(m - s); lsum *= f;
#pragma unroll
                for (int k = 0; k < VD; ++k) o[k] *= f;
                m = s; }
            const float pr = expf(s - m); lsum += pr;
#pragma unroll
            for (int k = 0; k < VD; ++k) o[k] += pr * vv[k];
        }
        const float inv = 1.f / lsum;
#pragma unroll
        for (int k = 0; k < VD; ++k) p.Y[(size_t)t * DMIX + 256 + h * VD + k] = o[k] * inv;
    }
}
HD void nv_mlstm_scan(const P& p, long gtid, long nthr) {
    for (long it = gtid; it < (long)NB * MLH * 2 * 64; it += nthr) {
        const int v = (int)(it % 64), d = (int)((it / 64) & 1), h = (int)((it / 128) % MLH), b = (int)(it / (128 * MLH));
        float C[64], n[64];
#pragma unroll
        for (int k = 0; k < 64; ++k) { C[k] = 0.f; n[k] = 0.f; }
        float m = 0.f;
        for (int seg = 0; seg < 2; ++seg) { const int base = b * TPB + (seg == 0 ? 0 : CTX), len = seg == 0 ? CTX : SEQ;
            for (int s = 0; s < len; ++s) { const int t = base + (d == 0 ? s : len - 1 - s);
                const float ig = p.IGF[((size_t)d * NT + t) * 8 + h], lf = p.IGF[((size_t)d * NT + t) * 8 + 4 + h];
                const float mn = fmaxf(lf + m, ig), fd = expf(lf + m - mn), iw = expf(ig - mn); m = mn;
                const float* qq = p.QM + (size_t)t * 256 + h * 64; const float* kk = p.KM + (size_t)t * 256 + h * 64; const float vv = p.VM[(size_t)t * 256 + h * 64 + v];
                float num = 0.f, den = 0.f;
#pragma unroll
                for (int k = 0; k < 64; ++k) { const float kv = kk[k], qv = qq[k]; C[k] = fd * C[k] + iw * vv * kv; n[k] = fd * n[k] + iw * kv; num += C[k] * qv; den += n[k] * qv; }
                p.HM[((size_t)d * NT + t) * 256 + h * 64 + v] = num / fmaxf(fabsf(den), expf(-mn)); } }
    }
}
HD void nv_lru_out(const P& p, long gtid, long nthr) {
    for (long it = gtid; it < (long)NT * 256; it += nthr) { const int t = (int)(it / 256), c = (int)(it % 256);
        p.Y[(size_t)t * DMIX + c] = (p.HL[it] + p.HL[(size_t)NT * 256 + it]) * gelu_f(p.U[(size_t)t * DIN + OFF_AG + c]); }
}
HD void nv_mlstm_finish(const P& p, int l, long gtid, long nthr) {
    for (long it = gtid; it < (long)NT * MLH; it += nthr) { const int t = (int)(it / MLH), h = (int)(it % MLH);
        const float* h0 = p.HM + (size_t)t * 256 + h * 64; const float* h1 = p.HM + ((size_t)NT + t) * 256 + h * 64;
        float mu = 0.f; for (int j = 0; j < 64; ++j) mu += h0[j] + h1[j]; mu *= (1.f / 64.f);
        float var = 0.f; for (int j = 0; j < 64; ++j) { const float dlt = h0[j] + h1[j] - mu; var += dlt * dlt; } var *= (1.f / 64.f);
        const float rstd = 1.f / sqrtf(var + EPS);
        for (int j = 0; j < 64; ++j) { const int c = h * 64 + j;
            const float y = (h0[j] + h1[j] - mu) * rstd * p.in[I_MNG][(size_t)l * 256 + c] + p.in[I_MSK][(size_t)l * 256 + c] * p.XCM[(size_t)t * 256 + c];
            p.Y[(size_t)t * DMIX + 768 + c] = y * silu_f(p.U[(size_t)t * DIN + OFF_MZ + c]); } }
}
HD void nv_outproj(const P& p, int l, long gtid, long nthr) {
    constexpr int R = 8, NQ = D / 4; const float* W = p.in[I_WOUT] + (size_t)l * DMIX * D;
    for (long it = gtid; it < (long)(NT / R) * NQ; it += nthr) { const int mi = (int)(it / NQ), n = (int)(it % NQ) * 4;
        const float* a[R]; float4 acc[R];
#pragma unroll
        for (int r = 0; r < R; ++r) { a[r] = p.Y + (size_t)(mi * R + r) * DMIX; acc[r] = float4{0.f, 0.f, 0.f, 0.f}; }
        gemm_rx4<R>(a, W + n, D, DMIX, acc);
#pragma unroll
        for (int r = 0; r < R; ++r) { const int t = mi * R + r; const float* g1 = modp(p, l, tok_cv(t), 2) + n; float* x = p.X + (size_t)t * D + n;
            x[0] += g1[0] * acc[r].x; x[1] += g1[1] * acc[r].y; x[2] += g1[2] * acc[r].z; x[3] += g1[3] * acc[r].w; } }
}
HD void nv_zero_cnt(const P& p, long gtid, long nthr) { for (long i = gtid; i < NE; i += nthr) p.CNT[i] = 0; }
HD void nv_router(const P& p, int l, long gtid, long nthr) {
    for (long t = gtid; t < NT; t += nthr) {
        float lg[NE]; const float* h = p.H + (size_t)t * D; const float* W = p.in[I_WR] + (size_t)l * D * NE;
#pragma unroll
        for (int e = 0; e < NE; ++e) lg[e] = p.in[I_BR][(size_t)l * NE + e];
        for (int k = 0; k < D; ++k) { const float hv = h[k];
#pragma unroll
            for (int e = 0; e < NE; ++e) lg[e] += hv * W[(size_t)k * NE + e]; }
        int te[TOPK]; float tv[TOPK];
#pragma unroll
        for (int r = 0; r < TOPK; ++r) { float best = -3.0e38f; int bi = 0;
#pragma unroll
            for (int e = 0; e < NE; ++e) { const bool c = lg[e] > best; best = c ? lg[e] : best; bi = c ? e : bi; }
            te[r] = bi; tv[r] = best;
#pragma unroll
            for (int e = 0; e < NE; ++e) lg[e] = (e == bi) ? -3.0e38f : lg[e]; }
        float s = 0.f, ex[TOPK];
#pragma unroll
        for (int r = 0; r < TOPK; ++r) { ex[r] = expf(tv[r] - tv[0]); s += ex[r]; }
#pragma unroll
        for (int r = 0; r < TOPK; ++r) { p.TOPE[t * TOPK + r] = te[r]; p.TOPG[t * TOPK + r] = ex[r] / s;
            const int pos = atomic_add_i(&p.CNT[te[r]], 1); p.LIST[(size_t)te[r] * NT + pos] = (int)t * TOPK + r; }
    }
}
HD bool moe_item(const P& p, int R, long grp, int& e, int& r0) {
    long acc = 0;
    for (int x = 0; x < NE; ++x) { const int c = p.CNT[x], ng = (c + R - 1) / R; if (grp < acc + ng) { e = x; r0 = (int)(grp - acc) * R; return true; } acc += ng; }
    return false;
}
HD long moe_groups(const P& p, int R) { long acc = 0; for (int x = 0; x < NE; ++x) acc += (p.CNT[x] + R - 1) / R; return acc; }
HD void nv_moe_gu(const P& p, int l, long gtid, long nthr) {
    constexpr int R = 8, NQ = DE / 4; const long ngrp = moe_groups(p, R);
    for (long it = gtid; it < ngrp * NQ; it += nthr) { int e, r0; moe_item(p, R, it / NQ, e, r0); const int n = (int)(it % NQ) * 4, cnt = p.CNT[e];
        const float* Wg = p.in[I_WGU] + ((size_t)l * NE + e) * D * 2 * DE; const float* bg = p.in[I_BGU] + ((size_t)l * NE + e) * 2 * DE;
        const float* a[R]; int pr[R]; float4 ag[R], al[R];
#pragma unroll
        for (int r = 0; r < R; ++r) { const int rr = r0 + r < cnt ? r0 + r : cnt - 1; pr[r] = p.LIST[(size_t)e * NT + rr]; a[r] = p.H + (size_t)(pr[r] / TOPK) * D; ag[r] = float4{0.f, 0.f, 0.f, 0.f}; al[r] = float4{0.f, 0.f, 0.f, 0.f}; }
        gemm_rx4<R>(a, Wg + n, 2 * DE, D, ag);
        gemm_rx4<R>(a, Wg + DE + n, 2 * DE, D, al);
#pragma unroll
        for (int r = 0; r < R; ++r) if (r0 + r < cnt) { float gv[4] = {ag[r].x + bg[n], ag[r].y + bg[n + 1], ag[r].z + bg[n + 2], ag[r].w + bg[n + 3]};
            float lv[4] = {al[r].x + bg[DE + n], al[r].y + bg[DE + n + 1], al[r].z + bg[DE + n + 2], al[r].w + bg[DE + n + 3]};
#pragma unroll
            for (int q = 0; q < 4; ++q) { const float glu = fminf(gv[q], 7.0f), lin = fminf(fmaxf(lv[q], -7.0f), 7.0f);
                p.ACT[(size_t)pr[r] * DE + n + q] = glu * sigmoid_f(1.702f * glu) * (lin + 1.f); } }
    }
}
HD void nv_moe_down(const P& p, int l, long gtid, long nthr) {
    constexpr int R = 8, NQ = D / 4; const long ngrp = moe_groups(p, R);
    for (long it = gtid; it < ngrp * NQ; it += nthr) { int e, r0; moe_item(p, R, it / NQ, e, r0); const int n = (int)(it % NQ) * 4, cnt = p.CNT[e];
        const float* Wd = p.in[I_WD] + ((size_t)l * NE + e) * DE * D; const float* bd = p.in[I_BD] + ((size_t)l * NE + e) * D;
        const float* a[R]; int pr[R]; float4 acc[R];
#pragma unroll
        for (int r = 0; r < R; ++r) { const int rr = r0 + r < cnt ? r0 + r : cnt - 1; pr[r] = p.LIST[(size_t)e * NT + rr]; a[r] = p.ACT + (size_t)pr[r] * DE; acc[r] = float4{0.f, 0.f, 0.f, 0.f}; }
        gemm_rx4<R>(a, Wd + n, D, DE, acc);
#pragma unroll
        for (int r = 0; r < R; ++r) if (r0 + r < cnt) { const float g = p.TOPG[pr[r]]; float* y = p.YB + (size_t)pr[r] * D + n;
            y[0] = g * (acc[r].x + bd[n]); y[1] = g * (acc[r].y + bd[n + 1]); y[2] = g * (acc[r].z + bd[n + 2]); y[3] = g * (acc[r].w + bd[n + 3]); }
    }
}
HD void nv_combine(const P& p, int l, long gtid, long nthr) {
    for (long it = gtid; it < (long)NT * D; it += nthr) { const int t = (int)(it / D), n = (int)(it % D);
        const float s = ((p.YB[((size_t)t * 4 + 0) * D + n] + p.YB[((size_t)t * 4 + 1) * D + n]) + p.YB[((size_t)t * 4 + 2) * D + n]) + p.YB[((size_t)t * 4 + 3) * D + n];
        p.X[it] += modp(p, l, tok_cv(t), 5)[n] * s; }
}
HD void nv_final(const P& p, long gtid, long nthr) {
    for (long r = gtid; r < (long)NB * SEQ; r += nthr) { const int b = (int)(r / SEQ), s = (int)(r % SEQ), t = b * TPB + CTX + s;
        const float* x = p.X + (size_t)t * D; float ss = 0.f;
        for (int k = 0; k < D; ++k) ss += x[k] * x[k];
        const float rstd = 1.f / sqrtf(ss / (float)D + EPS);
        for (int k = 0; k < D; ++k) p.out[(size_t)r * D + k] = x[k] * rstd * p.in[I_FG][k]; }
}

constexpr int PH_PER_LAYER = 13, N_PHASES = 1 + DEPTH * PH_PER_LAYER + 1;
HD void nv_run_phase(const P& p, int ph, long gtid, long nthr) {
    if (ph == 0) { nv_init(p, gtid, nthr); return; }
    if (ph == N_PHASES - 1) { nv_final(p, gtid, nthr); return; }
    const int l = (ph - 1) / PH_PER_LAYER, s = (ph - 1) % PH_PER_LAYER;
    switch (s) {
        case 0: nv_norm(p, l, 0, gtid, nthr); break;
        case 1: nv_inproj(p, l, gtid, nthr); break;
        case 2: nv_prep1(p, l, gtid, nthr); break;
        case 3: nv_prep2(p, l, gtid, nthr); break;
        case 4: nv_prep3(p, l, gtid, nthr); break;
        case 5: nv_mlstm_scan(p, gtid, nthr); nv_attn(p, gtid, nthr); nv_lru_out(p, gtid, nthr); break;
        case 6: nv_mlstm_finish(p, l, gtid, nthr); break;
        case 7: nv_outproj(p, l, gtid, nthr); break;
        case 8: nv_norm(p, l, 1, gtid, nthr); nv_zero_cnt(p, gtid, nthr); break;
        case 9: nv_router(p, l, gtid, nthr); break;
        case 10: nv_moe_gu(p, l, gtid, nthr); break;
        case 11: nv_moe_down(p, l, gtid, nthr); break;
        case 12: nv_combine(p, l, gtid, nthr); break;
    }
}

struct WsMap { size_t off[32]; size_t total; };
static inline WsMap ws_map() {
    WsMap m; size_t o = 0; int i = 0;
    auto add = [&](size_t n) { m.off[i++] = o; o += (n + 63) & ~(size_t)63; };
    add((size_t)DEPTH * 3 * 6 * D);
    add((size_t)SEQ * 16 * 2);
    add((size_t)NT * D);
    add((size_t)NT * D);
    add((size_t)NT * DIN);
    add((size_t)NT * 256);
    add((size_t)2 * NT * 256);
    add((size_t)2 * NT * 256);
    add((size_t)2 * NT * 256);
    add((size_t)NT * QRANK);
    add((size_t)NT * KVRANK);
    add((size_t)NT * 768);
    add((size_t)NT * 1024);
    add((size_t)NT * AH * QKD);
    add((size_t)NT * AH * QKD);
    add((size_t)NT * AH * VD);
    add((size_t)NT * 256);
    add((size_t)NT * 256);
    add((size_t)NT * 256);
    add((size_t)NT * 256);
    add((size_t)2 * NT * 8);
    add((size_t)2 * NT * 256);
    add((size_t)NT * DMIX);
    add((size_t)NT * TOPK);
    add((size_t)NT * TOPK * DE);
    add((size_t)NT * TOPK * D);
    add((size_t)NT * TOPK);
    add((size_t)64);
    add((size_t)NE * NT);
    m.total = o; return m;
}
static inline void fill_params(P& p, void* const* d_in, void* d_out, void* d_ws) {
    for (int i = 0; i < N_IN; ++i) p.in[i] = (const float*)d_in[i];
    p.out = (float*)d_out; float* w = (float*)d_ws; const WsMap m = ws_map();
    p.MOD = w + m.off[0]; p.ROPET = w + m.off[1]; p.X = w + m.off[2]; p.H = w + m.off[3]; p.U = w + m.off[4]; p.XC = w + m.off[5]; p.LA = w + m.off[6]; p.LB = w + m.off[7]; p.HL = w + m.off[8];
    p.QN = w + m.off[9]; p.KVN = w + m.off[10]; p.QF = w + m.off[11]; p.KVF = w + m.off[12]; p.Qr = w + m.off[13]; p.Kr = w + m.off[14]; p.Vr = w + m.off[15];
    p.XCM = w + m.off[16]; p.QM = w + m.off[17]; p.KM = w + m.off[18]; p.VM = w + m.off[19]; p.IGF = w + m.off[20]; p.HM = w + m.off[21]; p.Y = w + m.off[22];
    p.TOPG = w + m.off[23]; p.ACT = w + m.off[24]; p.YB = w + m.off[25]; p.TOPE = (int*)(w + m.off[26]); p.CNT = (int*)(w + m.off[27]); p.LIST = (int*)(w + m.off[28]);
}
extern __shared__ __attribute__((aligned(16))) unsigned char g_lds_base[];
constexpr int WTAB_OFF = 148480 - 64 - 256;
#define HWID() ((int)__builtin_amdgcn_s_getreg((5 << 11) | 4) & 63)
#if ONE_LAUNCH
__device__ __forceinline__ int tidx_() {
    unsigned z = 0u; asm volatile("" : "+v"(z));
    const int lane = (int)__builtin_amdgcn_mbcnt_hi(~0u, __builtin_amdgcn_mbcnt_lo(~0u, z));
    const int wv = __builtin_amdgcn_readfirstlane(((const volatile __attribute__((address_space(3))) int*)((__attribute__((address_space(3))) unsigned char*)g_lds_base + WTAB_OFF))[HWID()]);
    return wv * 64 + lane;
}
#define TIDX tidx_()
#else
#define TIDX ((int)threadIdx.x)
#endif
namespace pg8 {
#define PG8_LAS __attribute__((address_space(3)))
typedef unsigned short bf16_t;
typedef short bf16x8 __attribute__((ext_vector_type(8)));
typedef float f32x4 __attribute__((ext_vector_type(4)));
typedef unsigned u32x4 __attribute__((ext_vector_type(4)));
constexpr int BM = 256, BK = 64, HALF = 128, HTB = HALF * BK * 2  , STAGE_BYTES = 8 * HTB, NXCD = 8, WGM = 8;

__host__ __device__ __forceinline__ int lds_byte(int r, int c) { const int st = (r >> 4) * 2 + (c >> 5), rr = r & 15, cc = c & 31, ob = rr * 64 + cc * 2; return st * 1024 + (ob ^ (((ob >> 9) & 1) << 5)); }
__host__ __device__ __forceinline__ void stage_rc(int b, int& R, int& C) { const int st = b / 1024, sb = b % 1024, swz = sb ^ (((sb >> 9) & 1) << 5); R = (st >> 1) * 16 + swz / 64; C = (st & 1) * 32 + (swz % 64) / 2; }
__host__ __device__ __forceinline__ int perm32(int rho) { const int n = rho >> 4, i = rho & 15; return 8 * (i >> 2) + 4 * n + (i & 3); }

struct Unit { int pm, pn, e, mb; };
struct Gemm { const bf16_t* A; const bf16_t* Bt; int K; };

struct StaticOrder {
    int nM, nN, nwg, G, c;
    __device__ void init(int M, int N, int G_, int c_) { nM = M / BM; nN = N / BM; nwg = nM * nN; G = G_; c = c_; }
    __device__ bool next(int i, Unit& u) const {
        const long L = (long)i * G + c; if (L >= nwg) return false;
        int wgid = (int)L; { const int q = nwg / NXCD, r = nwg % NXCD, xcd = wgid % NXCD, off = wgid / NXCD; wgid = (xcd < r ? xcd * (q + 1) : r * (q + 1) + (xcd - r) * q) + off; }
        const int nig = WGM * nN, gid = wgid / nig, fm = gid * WGM, gsz = (nM - fm) < WGM ? (nM - fm) : WGM;
        u.pm = fm + ((wgid % nig) % gsz); u.pn = (wgid % nig) / gsz; u.e = 0; u.mb = 0; return true;
    }
    __device__ __forceinline__ int arow(const Unit& u, int r) const { return u.pm * BM + r; }
};

__device__ __forceinline__ unsigned cvt_pk_bf16(float lo, float hi) { unsigned r; asm volatile("v_cvt_pk_bf16_f32 %0, %1, %2" : "=v"(r) : "v"(lo), "v"(hi)); return r; }

template <class Epi, class Sched, bool ALIGN_EPI>
__device__ __forceinline__ void gemm_phase(PG8_LAS unsigned char* lds, const Gemm g, const Sched& S, const Epi& E) {
    int tid_ = TIDX; asm volatile("" : "+v"(tid_));
    const int tid = tid_, wid = __builtin_amdgcn_readfirstlane(tid >> 6), lane = tid & 63, wr = wid >> 2, wc = wid & 3, fr = lane & 15, fq = lane >> 4;
    const int K = g.K, nt = K / BK;
    unsigned voffB[2];
#pragma unroll
    for (int i = 0; i < 2; ++i) { int R, C; stage_rc(tid * 16 + i * 8192, R, C); const int Rb = Epi::PERM ? ((R & ~31) + perm32(R & 31)) : R;
        voffB[i] = (unsigned)(Rb * K + C) * 2u; }
    const size_t kstep = (size_t)(BK * 2);
    const size_t hstep = (size_t)HALF * K * 2;
    const size_t tstep = 2 * hstep;
    const unsigned ldsw = (unsigned)wid * 1024u;
    const int aoff = lds_byte(wr * 64 + fr, fq * 8), boff = lds_byte(wc * 32 + fr, fq * 8);
#define PG8_SA(b, h) (((b) * 2 + (h)) * HTB)
#define PG8_SB(b, h) ((4 + (b) * 2 + (h)) * HTB)
#define PG8_STAGE(bufoff, gbase, voff) do { _Pragma("unroll") for (int _i = 0; _i < 2; ++_i) \
        __builtin_amdgcn_global_load_lds((const unsigned*)((const char*)(gbase) + (voff)[_i]), (PG8_LAS unsigned*)(lds + (bufoff) + ldsw + _i * 8192), 16, 0, 0); } while (0)
#define PG8_LDA(dst, b, h) do { _Pragma("unroll") for (int m = 0; m < 4; ++m) _Pragma("unroll") for (int k = 0; k < 2; ++k) dst[m][k] = *(const PG8_LAS bf16x8*)(lds + PG8_SA(b, h) + aoff + m * 2048 + k * 1024); } while (0)
#define PG8_LDB(dst, b, h) do { _Pragma("unroll") for (int n = 0; n < 2; ++n) _Pragma("unroll") for (int k = 0; k < 2; ++k) dst[n][k] = *(const PG8_LAS bf16x8*)(lds + PG8_SB(b, h) + boff + n * 2048 + k * 1024); } while (0)
#define PG8_MMA(ai, bj, At, Bt) do { __builtin_amdgcn_s_setprio(1); _Pragma("unroll") for (int m = 0; m < 4; ++m) _Pragma("unroll") for (int n = 0; n < 2; ++n) _Pragma("unroll") for (int k = 0; k < 2; ++k) \
        acc[ai][bj][m][n] = __builtin_amdgcn_mfma_f32_16x16x32_bf16(Bt[n][k], At[m][k], acc[ai][bj][m][n], 0, 0, 0); __builtin_amdgcn_s_setprio(0); } while (0)
#define PG8_WAIT_V(n) asm volatile("s_waitcnt vmcnt(" #n ")" ::: "memory")
#define PG8_WAIT_L(n) asm volatile("s_waitcnt lgkmcnt(" #n ")" ::: "memory")
#define PG8_BAR __builtin_amdgcn_s_barrier()
#define PG8_SCHED __builtin_amdgcn_sched_barrier(0)
#define PG8_AOFFS(dst, U) do { int _t = tid; asm volatile("" : "+v"(_t)); _Pragma("unroll") for (int _i = 0; _i < 2; ++_i) { int _R, _C; stage_rc(_t * 16 + _i * 8192, _R, _C); \
        _Pragma("unroll") for (int _h = 0; _h < 2; ++_h) dst[_h][_i] = (unsigned)(S.arow(U, _h * HALF + _R) * K + _C) * 2u; } } while (0)
    Unit cur, nxt; int ui = 0;
    if (!S.next(0, cur)) return;
    f32x4 acc[2][2][4][2];
#pragma unroll
    for (int a = 0; a < 2; ++a)
#pragma unroll
        for (int b = 0; b < 2; ++b)
#pragma unroll
            for (int m = 0; m < 4; ++m)
#pragma unroll
                for (int n = 0; n < 2; ++n) acc[a][b][m][n] = (f32x4){0.f, 0.f, 0.f, 0.f};
    bf16x8 At[4][2], B0[2][2], B1[2][2];
    unsigned vA[2][2];
    PG8_AOFFS(vA, cur);
    const char* gA = (const char*)g.A;
    const char* cB = (const char*)g.Bt + (size_t)cur.pn * tstep;
    PG8_STAGE(PG8_SB(0, 0), cB, voffB); PG8_STAGE(PG8_SB(0, 1), cB + hstep, voffB); PG8_STAGE(PG8_SA(0, 0), gA, vA[0]); PG8_STAGE(PG8_SA(0, 1), gA, vA[1]);
    if (wr == 1) PG8_BAR;
    PG8_WAIT_V(2); PG8_BAR;
    PG8_STAGE(PG8_SB(1, 0), cB + kstep, voffB); PG8_STAGE(PG8_SA(1, 0), gA + kstep, vA[0]); PG8_STAGE(PG8_SB(1, 1), cB + hstep + kstep, voffB);
    PG8_WAIT_V(6); PG8_BAR;
    for (;;) {
        const bool has_next = S.next(ui + 1, nxt);
        { unsigned nvA[2][2];
          if (has_next) { PG8_AOFFS(nvA, nxt); } else {
#pragma unroll
            for (int h = 0; h < 2; ++h)
#pragma unroll
                for (int i = 0; i < 2; ++i) nvA[h][i] = vA[h][i]; }
          *(PG8_LAS u32x4*)(lds + STAGE_BYTES + 1024 + tid * 16) = (u32x4){nvA[0][0], nvA[0][1], nvA[1][0], nvA[1][1]}; }
        const char* nB = has_next ? (const char*)g.Bt + (size_t)nxt.pn * tstep : cB;
#pragma unroll 1
        for (int t = 0; t < nt; t += 2) {
            const bool last = (t == nt - 2);
            const char* a1 = gA + (size_t)(t + 1) * kstep;
            const char* a2 = last ? gA : gA + (size_t)(t + 2) * kstep; const char* b2 = last ? nB : cB + (size_t)(t + 2) * kstep;
            const char* a3 = a2 + kstep; const char* b3 = b2 + kstep;
            unsigned o2[2][2];
            if (last) { const u32x4 nv = *(const PG8_LAS u32x4*)(lds + STAGE_BYTES + 1024 + tid * 16); o2[0][0] = nv.x; o2[0][1] = nv.y; o2[1][0] = nv.z; o2[1][1] = nv.w; }
            else {
#pragma unroll
                for (int h = 0; h < 2; ++h)
#pragma unroll
                    for (int i = 0; i < 2; ++i) o2[h][i] = vA[h][i]; }
            PG8_LDB(B0, 0, 0); PG8_LDB(B1, 0, 1); PG8_SCHED; PG8_LDA(At, 0, 0); PG8_STAGE(PG8_SA(1, 1), a1, vA[1]);
            PG8_WAIT_V(8); PG8_WAIT_L(0); PG8_BAR; PG8_MMA(0, 0, At, B0); PG8_MMA(0, 1, At, B1); PG8_BAR; PG8_SCHED;
            PG8_LDA(At, 0, 1); PG8_STAGE(PG8_SB(0, 0), b2, voffB); PG8_STAGE(PG8_SB(0, 1), b2 + hstep, voffB); PG8_STAGE(PG8_SA(0, 0), a2, o2[0]);
            PG8_WAIT_V(8); PG8_WAIT_L(0); PG8_BAR; PG8_MMA(1, 0, At, B0); PG8_MMA(1, 1, At, B1); PG8_BAR; PG8_SCHED;
            PG8_LDB(B0, 1, 0); PG8_LDB(B1, 1, 1); PG8_SCHED; PG8_LDA(At, 1, 0); PG8_STAGE(PG8_SA(0, 1), a2, o2[1]);
            PG8_WAIT_V(8); PG8_WAIT_L(0); PG8_BAR; PG8_MMA(0, 0, At, B0); PG8_MMA(0, 1, At, B1); PG8_BAR; PG8_SCHED;
            PG8_LDA(At, 1, 1); PG8_STAGE(PG8_SB(1, 0), b3, voffB); PG8_STAGE(PG8_SB(1, 1), b3 + hstep, voffB); PG8_STAGE(PG8_SA(1, 0), a3, o2[0]);
            PG8_WAIT_V(8); PG8_WAIT_L(0); PG8_BAR; PG8_MMA(1, 0, At, B0); PG8_MMA(1, 1, At, B1); PG8_BAR; PG8_SCHED;
        }
        if constexpr (ALIGN_EPI) { if (wr == 0) PG8_BAR; }
        E(acc, cur, wr, wc, fr, fq);
        if (!has_next) break;
#pragma unroll
        for (int a = 0; a < 2; ++a)
#pragma unroll
            for (int b = 0; b < 2; ++b)
#pragma unroll
                for (int m = 0; m < 4; ++m)
#pragma unroll
                    for (int n = 0; n < 2; ++n) acc[a][b][m][n] = (f32x4){0.f, 0.f, 0.f, 0.f};
        cur = nxt; cB = nB; ++ui;
        { const u32x4 nv = *(const PG8_LAS u32x4*)(lds + STAGE_BYTES + 1024 + tid * 16); vA[0][0] = nv.x; vA[0][1] = nv.y; vA[1][0] = nv.z; vA[1][1] = nv.w; }
        if constexpr (ALIGN_EPI) { if (wr == 1) PG8_BAR; }
    }
    PG8_WAIT_V(0);
    if constexpr (!ALIGN_EPI) { if (wr == 0) PG8_BAR; }
    PG8_BAR;
#undef PG8_SA
#undef PG8_SB
#undef PG8_STAGE
#undef PG8_LDA
#undef PG8_LDB
#undef PG8_MMA
#undef PG8_WAIT_V
#undef PG8_WAIT_L
#undef PG8_BAR
#undef PG8_SCHED
#undef PG8_AOFFS
}
}
#define LAS __attribute__((address_space(3)))
typedef unsigned short bf16;
typedef float f32x4 __attribute__((ext_vector_type(4)));
typedef unsigned u32x4 __attribute__((ext_vector_type(4)));
typedef unsigned u32x2 __attribute__((ext_vector_type(2)));

constexpr int NWAVES = 8, NTHREADS = 512;
constexpr int DINP = 1536;
constexpr int SLOT_MAX = NT * TOPK + NE * 256;

struct Q {
    bf16 *WtIn, *WtOut, *WtGu, *WtDn, *WtQb, *WtKvb;
    bf16 *H16, *Y16, *ACT16, *K16, *V16;
};

__device__ __forceinline__ unsigned f2bf(float f) { unsigned u = __builtin_bit_cast(unsigned, f); return (u + 0x7fffu + ((u >> 16) & 1u)) >> 16; }
__device__ __forceinline__ unsigned pk2(float lo, float hi) { return f2bf(lo) | (f2bf(hi) << 16); }
__device__ __forceinline__ float bf2f(unsigned short b) { return __builtin_bit_cast(float, (unsigned)b << 16); }

__device__ __forceinline__ void transpose_item(const float* W, int N, bf16* WT, int ldk, int k0, int n0, int drow0, LAS float* scr, int lane) {
#pragma unroll 4
    for (int i = 0; i < 16; ++i) { const int kk = 4 * i + (lane >> 4), c4 = (lane & 15) * 4; const f32x4 v = *(const f32x4*)(W + (size_t)(k0 + kk) * N + n0 + c4);
        LAS float* d = scr + kk * 65 + c4; d[0] = v.x; d[1] = v.y; d[2] = v.z; d[3] = v.w; }
    asm volatile("s_waitcnt lgkmcnt(0)" ::: "memory");
#pragma unroll
    for (int j = 0; j < 8; ++j) { const int n = 8 * j + (lane >> 3), c = lane & 7; const LAS float* sp = scr + (8 * c) * 65 + n;
        u32x4 o; o.x = pk2(sp[0 * 65], sp[1 * 65]); o.y = pk2(sp[2 * 65], sp[3 * 65]); o.z = pk2(sp[4 * 65], sp[5 * 65]); o.w = pk2(sp[6 * 65], sp[7 * 65]);
        *(u32x4*)(WT + (size_t)(drow0 + n) * ldk + k0 + 8 * c) = o; }
    asm volatile("s_waitcnt lgkmcnt(0)" ::: "memory");
}
__device__ __forceinline__ void opt_convert_weights(const P& p, const Q& q, bf16* WtKvbP, LAS unsigned char* lds, int gw, int ngw, int wave, int lane) {
    LAS float* scr = (LAS float*)(lds + wave * 16640);
    constexpr int I_GU = (D / 64) * (2 * DE / 64), I_DN = (DE / 64) * (D / 64);
    constexpr int I_IN = (D / 64) * ((DIN + 63) / 64), I_OUT = (DMIX / 64) * (D / 64), I_QB = (QRANK / 64) * (768 / 64), I_KVB = (KVRANK / 64) * (1024 / 64);
    constexpr int PER_L = NE * (I_GU + I_DN) + I_IN + I_OUT + I_QB + I_KVB;
    for (int it = gw; it < DEPTH * PER_L; it += ngw) {
        const int l = it / PER_L; int r = it % PER_L;
        if (r < NE * I_GU) { const int e = r / I_GU, rr = r % I_GU, nb = 2 * DE / 64, kb = rr / nb, n0 = 64 * (rr % nb);
            const int isl = n0 >= DE, j0 = n0 - isl * DE, drow0 = 256 * (j0 / 128) + 128 * isl + (j0 % 128);
            transpose_item(p.in[I_WGU] + ((size_t)l * NE + e) * D * 2 * DE, 2 * DE, q.WtGu + ((size_t)l * NE + e) * 2 * DE * D, D, 64 * kb, n0, drow0, scr, lane); continue; } r -= NE * I_GU;
        if (r < NE * I_DN) { const int e = r / I_DN, rr = r % I_DN, nb = D / 64, kb = rr / nb, n0 = 64 * (rr % nb);
            transpose_item(p.in[I_WD] + ((size_t)l * NE + e) * DE * D, D, q.WtDn + ((size_t)l * NE + e) * D * DE, DE, 64 * kb, n0, n0, scr, lane); continue; } r -= NE * I_DN;
        if (r < I_IN) { const int nb = (DIN + 63) / 64, kb = r / nb, n0 = 64 * (r % nb);
            const int n0c = n0 + 64 <= DIN ? n0 : DIN - 64; transpose_item(p.in[I_WIN] + (size_t)l * D * DIN, DIN, q.WtIn + (size_t)l * DINP * D, D, 64 * kb, n0c, n0c, scr, lane); continue; } r -= I_IN;
        if (r < I_OUT) { const int nb = D / 64, kb = r / nb, n0 = 64 * (r % nb); transpose_item(p.in[I_WOUT] + (size_t)l * DMIX * D, D, q.WtOut + (size_t)l * D * DMIX, DMIX, 64 * kb, n0, n0, scr, lane); continue; } r -= I_OUT;
        if (r < I_QB) { const int nb = 768 / 64, kb = r / nb, n0 = 64 * (r % nb); transpose_item(p.in[I_WQB] + (size_t)l * QRANK * 768, 768, WtKvbP + (size_t)l * 1792 * 256, 256, 64 * kb, n0, n0, scr, lane); continue; } r -= I_QB;
        { const int nb = 1024 / 64, kb = r / nb, n0 = 64 * (r % nb); transpose_item(p.in[I_WKVB] + (size_t)l * KVRANK * 1024, 1024, WtKvbP + (size_t)l * 1792 * 256, 256, 64 * kb, n0, 768 + n0, scr, lane); }
    }
    const long gt = (long)gw * 64 + lane, ngt = (long)ngw * 64;
    for (long i = gt; i < (long)DEPTH * (DINP - DIN) * D / 8; i += ngt) { const int l = (int)(i / ((DINP - DIN) * D / 8)); const long o = i % ((DINP - DIN) * D / 8);
        *(u32x4*)(q.WtIn + ((size_t)l * DINP + DIN) * D + o * 8) = (u32x4){0u, 0u, 0u, 0u}; }
    for (long i = gt; i < (long)DEPTH * 1024 * 16; i += ngt) { const long row = i >> 4, l = row >> 10, n = row & 1023; *(u32x4*)(WtKvbP + ((size_t)l * 1792 + 768 + n) * 256 + 128 + (i & 15) * 8) = (u32x4){0u, 0u, 0u, 0u}; }
}

struct EpiInprojF32 {
    static constexpr bool PERM = false; float* U;
    __device__ __forceinline__ void operator()(const pg8::f32x4 (&acc)[2][2][4][2], const pg8::Unit& u, int wr, int wc, int fr, int fq) const {
#pragma unroll
        for (int ai = 0; ai < 2; ++ai)
#pragma unroll
            for (int m = 0; m < 4; ++m) { const int row = u.pm * 256 + ai * 128 + wr * 64 + m * 16 + fr;
#pragma unroll
                for (int bj = 0; bj < 2; ++bj)
#pragma unroll
                    for (int n = 0; n < 2; ++n) { const int c = u.pn * 256 + bj * 128 + wc * 32 + n * 16 + 4 * fq; if (c < DIN) *(pg8::f32x4*)(U + (size_t)row * DIN + c) = acc[ai][bj][m][n]; } }
    }
};
struct EpiOutproj {
    static constexpr bool PERM = false; float* X; const float* mod;   const float* xin; const float* cin;
    __device__ __forceinline__ void operator()(const pg8::f32x4 (&acc)[2][2][4][2], const pg8::Unit& u, int wr, int wc, int fr, int fq) const {
#pragma unroll
        for (int ai = 0; ai < 2; ++ai)
#pragma unroll
            for (int m = 0; m < 4; ++m) { const int row = u.pm * 256 + ai * 128 + wr * 64 + m * 16 + fr, b = row / TPB, i = row % TPB; const float* g1 = mod + ((size_t)(i < CTX ? 2 : b) * 6 + 2) * D;
                const float* base = xin ? (i < CTX ? cin + ((size_t)b * CTX + i) * D : xin + ((size_t)b * SEQ + (i - CTX)) * D) : X + (size_t)row * D;
#pragma unroll
                for (int bj = 0; bj < 2; ++bj)
#pragma unroll
                    for (int n = 0; n < 2; ++n) { const int c = u.pn * 256 + bj * 128 + wc * 32 + n * 16 + 4 * fq;
                        const pg8::f32x4 gv = *(const pg8::f32x4*)(g1 + c); *(pg8::f32x4*)(X + (size_t)row * D + c) = *(const pg8::f32x4*)(base + c) + gv * acc[ai][bj][m][n]; } }
    }
};
struct GroupedOrder {
    const int* CNT; const int* LIST; const LAS int* ut;
    __device__ void init(const int* cnt, const int* list, int nN, int G, int c, LAS int* tab) { CNT = cnt; LIST = list; ut = tab + 64;
        __syncthreads();
        if (TIDX == 0) { int a = 0; for (int e = 0; e < NE; ++e) { tab[e] = a; a += (cnt[e] + 255) >> 8; } tab[NE] = a; }
        __syncthreads();
        if (TIDX < 16) { const int total = tab[NE] * nN; const long L = (long)TIDX * G + c; int pm = -1, pn = 0, e = 0, mb = 0;
            if (L < total) { int w = (int)L; { const int nx = pg8::NXCD, qq = total / nx, r = total % nx, xcd = w % nx, off = w / nx; w = (xcd < r ? xcd * (qq + 1) : r * (qq + 1) + (xcd - r) * qq) + off; }
                const int blk = w / nN, ntile = w % nN;
                for (int x = 1; x < NE; ++x) if (tab[x] <= blk) e = x;
                mb = blk - tab[e]; pm = blk; pn = e * nN + ntile; }
            tab[64 + TIDX * 4] = pm; tab[64 + TIDX * 4 + 1] = pn; tab[64 + TIDX * 4 + 2] = e; tab[64 + TIDX * 4 + 3] = mb; }
        __syncthreads(); }
    __device__ bool next(int i, pg8::Unit& u) const { if (i >= 16) return false; const int pm = ut[i * 4]; if (pm < 0) return false; u.pm = pm; u.pn = ut[i * 4 + 1]; u.e = ut[i * 4 + 2]; u.mb = ut[i * 4 + 3]; return true; }
};
struct GuOrder : GroupedOrder {
    __device__ __forceinline__ int arow(const pg8::Unit& u, int r) const { const int idx = u.mb * 256 + r; return idx < CNT[u.e] ? (LIST[(size_t)u.e * NT + idx] >> 2) : 0; }
};
struct DnOrder : GroupedOrder {
    __device__ __forceinline__ int arow(const pg8::Unit& u, int r) const { return u.pm * 256 + r; }
};
struct EpiGu {
    static constexpr bool PERM = true; bf16* ACT; const float* bgu;   int nN; int probe_skip;
    __device__ __forceinline__ void operator()(const pg8::f32x4 (&acc)[2][2][4][2], const pg8::Unit& u, int wr, int wc, int fr, int fq) const {
        if (probe_skip) return;
        const int ntile = u.pn - u.e * nN, j0 = ntile * 128 + wc * 32 + 8 * fq; const float* bg = bgu + (size_t)u.e * 2 * DE;
        float bgl[8], bli[8];
#pragma unroll
        for (int x = 0; x < 8; ++x) { bgl[x] = bg[j0 + x]; bli[x] = bg[DE + j0 + x]; }
#pragma unroll
        for (int ai = 0; ai < 2; ++ai)
#pragma unroll
            for (int m = 0; m < 4; ++m) { const int row = u.pm * 256 + ai * 128 + wr * 64 + m * 16 + fr; float a[8];
#pragma unroll
                for (int n = 0; n < 2; ++n)
#pragma unroll
                    for (int x = 0; x < 4; ++x) { const float glu = fminf(acc[ai][0][m][n][x] + bgl[4 * n + x], 7.0f), lin = fminf(fmaxf(acc[ai][1][m][n][x] + bli[4 * n + x], -7.0f), 7.0f);
                        a[4 * n + x] = glu * __builtin_amdgcn_rcpf(1.f + __builtin_amdgcn_exp2f(-2.4554669595930157f * glu)) * (lin + 1.f); }
                u32x4 w; w.x = pg8::cvt_pk_bf16(a[0], a[1]); w.y = pg8::cvt_pk_bf16(a[2], a[3]); w.z = pg8::cvt_pk_bf16(a[4], a[5]); w.w = pg8::cvt_pk_bf16(a[6], a[7]);
                *(u32x4*)(ACT + (size_t)row * DE + j0) = w; }
    }
};
struct EpiDownF32 {
    static constexpr bool PERM = false; float* YB; const float* bd;   const float* TOPG; const int* CNT; const int* LIST; int nN;
    __device__ __forceinline__ void operator()(const pg8::f32x4 (&acc)[2][2][4][2], const pg8::Unit& u, int wr, int wc, int fr, int fq) const {
        const int ntile = u.pn - u.e * nN, cnt = CNT[u.e]; const float* b = bd + (size_t)u.e * D;
#pragma unroll
        for (int ai = 0; ai < 2; ++ai)
#pragma unroll
            for (int m = 0; m < 4; ++m) { const int idx = u.mb * 256 + ai * 128 + wr * 64 + m * 16 + fr;
                if (idx < cnt) { const int pr = LIST[(size_t)u.e * NT + idx]; const float g = TOPG[pr];
#pragma unroll
                    for (int bj = 0; bj < 2; ++bj)
#pragma unroll
                        for (int n = 0; n < 2; ++n) { const int c = ntile * 256 + bj * 128 + wc * 32 + n * 16 + 4 * fq; const pg8::f32x4 bv = *(const pg8::f32x4*)(b + c);
                            *(pg8::f32x4*)(YB + (size_t)pr * D + c) = (acc[ai][bj][m][n] + bv) * g; } } }
    }
};

__device__ __forceinline__ void opt_inproj(const P& p, const Q& q, int l, LAS unsigned char* lds, int G, int bid) {
    pg8::Gemm g{q.H16, q.WtIn + (size_t)l * DINP * D, D}; pg8::StaticOrder S; S.init(NT, DINP, G, bid);
    EpiInprojF32 E{p.U}; pg8::gemm_phase<EpiInprojF32, pg8::StaticOrder, true>(lds, g, S, E);
}
struct LatentOrder : pg8::StaticOrder {
    __device__ bool next(int i, pg8::Unit& u) const { if (!pg8::StaticOrder::next(i, u)) return false; constexpr int TL = SEQ / 256, TC = CTX / 256; u.pm = (u.pm / TL) * (TL + TC) + TC + u.pm % TL; return true; }
};
__device__ __forceinline__ void opt_outproj(const P& p, const Q& q, int l, LAS unsigned char* lds, int G, int bid, bool latent_only) {
    pg8::Gemm g{q.Y16, q.WtOut + (size_t)l * D * DMIX, DMIX}; EpiOutproj E{p.X, p.MOD + (size_t)l * 3 * 6 * D, l == 0 ? p.in[I_X] : nullptr, p.in[I_CTX]};
    if (latent_only) { LatentOrder S; S.init(NB * SEQ, D, G, bid); pg8::gemm_phase<EpiOutproj, LatentOrder, true>(lds, g, S, E); }
    else { pg8::StaticOrder S; S.init(NT, D, G, bid); pg8::gemm_phase<EpiOutproj, pg8::StaticOrder, true>(lds, g, S, E); }
}
__device__ __forceinline__ void opt_moe_gu(const P& p, const Q& q, int l, LAS unsigned char* lds, int G, int bid, int probe_skip = 0) {
    pg8::Gemm g{q.H16, q.WtGu + (size_t)l * NE * 2 * DE * D, D}; GuOrder S; S.init(p.CNT, p.LIST, 2 * DE / 256, G, bid, (LAS int*)(lds + pg8::STAGE_BYTES));
    EpiGu E{q.ACT16, p.in[I_BGU] + (size_t)l * NE * 2 * DE, 2 * DE / 256, probe_skip}; pg8::gemm_phase<EpiGu, GuOrder, true>(lds, g, S, E);
}
__device__ __forceinline__ void opt_moe_down(const P& p, const Q& q, int l, LAS unsigned char* lds, int G, int bid) {
    pg8::Gemm g{q.ACT16, q.WtDn + (size_t)l * NE * D * DE, DE}; DnOrder S; S.init(p.CNT, p.LIST, D / 256, G, bid, (LAS int*)(lds + pg8::STAGE_BYTES));
    EpiDownF32 E{p.YB, p.in[I_BD] + (size_t)l * NE * D, p.TOPG, p.CNT, p.LIST, D / 256}; pg8::gemm_phase<EpiDownF32, DnOrder, true>(lds, g, S, E);
}
namespace att {
using bf16x8 = __attribute__((ext_vector_type(8))) short;
using s16x4  = __attribute__((ext_vector_type(4))) short;
using f32x16 = __attribute__((ext_vector_type(16))) float;
using f32x8  = __attribute__((ext_vector_type(8))) float;
using u32x4  = __attribute__((ext_vector_type(4))) unsigned;
constexpr int DK = 96, DV = 64, NW = 8, QBLK = 32, KVBLK = 64;
constexpr float SCALE = 0.10206207261596575f;
#ifndef ATTN_THR
#define ATTN_THR 8.f
#endif
constexpr float THR = ATTN_THR;
#ifndef ATTN_SM_SPLIT
#define ATTN_SM_SPLIT 0
#endif
#ifndef ATTN_NEGM
#define ATTN_NEGM 1
#endif
constexpr float QPRESCALE = ATTN_NEGM ? SCALE * 1.4426950408889634f : 1.f;
constexpr int KROW = 208;
constexpr int SHM_K = KVBLK * KROW, SHM_V = KVBLK * DV * 2;
constexpr int SHM_ATTN = 3 * SHM_V + 3 * SHM_K + NW * 64 * 4;
#define KSWZ(row, colB) ((row) * KROW + (colB))
#define SBAR() __builtin_amdgcn_sched_barrier(0)
__device__ __forceinline__ int crow(int r, int hi) { return (r & 3) + 8 * (r >> 2) + 4 * hi; }
__device__ __forceinline__ unsigned cvtpk(float lo, float hi) { unsigned r; asm volatile("v_cvt_pk_bf16_f32 %0, %1, %2" : "=v"(r) : "v"(lo), "v"(hi)); return r; }
__device__ __forceinline__ bf16x8 tobf(f32x8 x) { u32x4 w = {cvtpk(x[0], x[1]), cvtpk(x[2], x[3]), cvtpk(x[4], x[5]), cvtpk(x[6], x[7])}; return *reinterpret_cast<bf16x8*>(&w); }

#if ATTN_NEGM
template <bool FIRST = false>
__device__ __forceinline__ void partialSM_n(f32x16& p0, f32x16& p1, f32x16& negm, float& alpha) {
  constexpr float THR2 = THR * 1.4426950408889634f;
  float pmax = p0[0];
#pragma unroll
  for (int r = 1; r < 16; ++r) pmax = fmaxf(pmax, p0[r]);
#pragma unroll
  for (int r = 0; r < 16; ++r) pmax = fmaxf(pmax, p1[r]);
  { auto rr = __builtin_amdgcn_permlane32_swap(__float_as_uint(pmax), __float_as_uint(pmax), false, false);
    pmax = fmaxf(__uint_as_float(rr[0]), __uint_as_float(rr[1])); }
  if (!FIRST && __builtin_expect(__all(pmax <= THR2), 1)) { alpha = 1.f; }
  else { const float dl = FIRST ? pmax : fmaxf(pmax, 0.f); alpha = FIRST ? 1.f : __builtin_amdgcn_exp2f(-dl);
#pragma unroll
    for (int r = 0; r < 16; ++r) { p0[r] -= dl; p1[r] -= dl; negm[r] -= dl; } }
}
__device__ __forceinline__ void finishSM_n(f32x16& p0, f32x16& p1, float alpha, float& l_reg, bf16x8& pa0, bf16x8& pa1, bf16x8& pa2, bf16x8& pa3) {
#pragma unroll
  for (int r = 0; r < 16; ++r) { p0[r] = __builtin_amdgcn_exp2f(p0[r]); p1[r] = __builtin_amdgcn_exp2f(p1[r]); }
  float ps = 0;
#pragma unroll
  for (int r = 0; r < 16; ++r) ps += p0[r];
#pragma unroll
  for (int r = 0; r < 16; ++r) ps += p1[r];
  { auto rr = __builtin_amdgcn_permlane32_swap(__float_as_uint(ps), __float_as_uint(ps), false, false);
    ps = __uint_as_float(rr[0]) + __uint_as_float(rr[1]); }
  l_reg = l_reg * alpha + ps;
#define PK4(P, BASE, OUT) do { unsigned a0 = cvtpk(P[BASE + 0], P[BASE + 1]), a1 = cvtpk(P[BASE + 2], P[BASE + 3]);   \
    unsigned b0 = cvtpk(P[BASE + 4], P[BASE + 5]), b1 = cvtpk(P[BASE + 6], P[BASE + 7]);                              \
    auto r0 = __builtin_amdgcn_permlane32_swap(a0, b0, false, false); auto r1 = __builtin_amdgcn_permlane32_swap(a1, b1, false, false); \
    u32x4 w = {r0[0], r1[0], r0[1], r1[1]}; OUT = *reinterpret_cast<bf16x8*>(&w); } while (0)
  PK4(p0, 0, pa0); PK4(p0, 8, pa1); PK4(p1, 0, pa2); PK4(p1, 8, pa3);
#undef PK4
}
__device__ __forceinline__ void qkt_n(f32x16& p0, f32x16& p1, const char* Ks, const bf16x8* qr, const f32x16& negm, int r32, int hi) {
#pragma unroll
  for (int d0 = 0; d0 < DK / 16; ++d0) { const int cb = (d0 * 16 + hi * 8) * 2;
    const bf16x8 b0 = *reinterpret_cast<const bf16x8*>(Ks + ((r32) * KROW + cb));
    const bf16x8 b1 = *reinterpret_cast<const bf16x8*>(Ks + ((32 + r32) * KROW + cb));
    if (d0 == 0) { p0 = __builtin_amdgcn_mfma_f32_32x32x16_bf16(b0, qr[0], negm, 0, 0, 0); p1 = __builtin_amdgcn_mfma_f32_32x32x16_bf16(b1, qr[0], negm, 0, 0, 0); }
    else { p0 = __builtin_amdgcn_mfma_f32_32x32x16_bf16(b0, qr[d0], p0, 0, 0, 0); p1 = __builtin_amdgcn_mfma_f32_32x32x16_bf16(b1, qr[d0], p1, 0, 0, 0); } }
}
#endif
__device__ __forceinline__ void partialSM(f32x16& p0, f32x16& p1, float& m_reg, float& mn, float& alpha) {
  constexpr float C = SCALE * 1.4426950408889634f;
  float pmax = p0[0];
#pragma unroll
  for (int r = 1; r < 16; ++r) pmax = fmaxf(pmax, p0[r]);
#pragma unroll
  for (int r = 0; r < 16; ++r) pmax = fmaxf(pmax, p1[r]);
  { auto rr = __builtin_amdgcn_permlane32_swap(__float_as_uint(pmax), __float_as_uint(pmax), false, false);
    pmax = fmaxf(__uint_as_float(rr[0]), __uint_as_float(rr[1])); }
#if ATTN_SM_SPLIT == 2
  { const bool keep = __all(pmax - m_reg <= THR / SCALE); mn = keep ? m_reg : fmaxf(m_reg, pmax); alpha = __builtin_amdgcn_exp2f((m_reg - mn) * C); m_reg = mn;
    const float mnC = -mn * C;
#pragma unroll
    for (int r = 0; r < 16; ++r) { p0[r] = __builtin_amdgcn_exp2f(fmaf(p0[r], C, mnC)); p1[r] = __builtin_amdgcn_exp2f(fmaf(p1[r], C, mnC)); } }
  return;
#endif
  if (__builtin_expect(__all(pmax - m_reg <= THR / SCALE), 1)) { mn = m_reg; alpha = 1.f; }
  else { mn = fmaxf(m_reg, pmax); alpha = __builtin_amdgcn_exp2f((m_reg - mn) * C); m_reg = mn; }
#if ATTN_SM_SPLIT == 1
  const float mnC = -mn * C;
#pragma unroll
  for (int r = 0; r < 16; ++r) p0[r] = fmaf(p0[r], C, mnC);
#pragma unroll
  for (int r = 0; r < 16; ++r) p1[r] = fmaf(p1[r], C, mnC);
#pragma unroll
  for (int r = 0; r < 16; ++r) p0[r] = __builtin_amdgcn_exp2f(p0[r]);
#endif
}
__device__ __forceinline__ void finishSM(f32x16& p0, f32x16& p1, float mn, float alpha, float& l_reg, bf16x8& pa0, bf16x8& pa1, bf16x8& pa2, bf16x8& pa3) {
#if ATTN_SM_SPLIT == 1
#pragma unroll
  for (int r = 0; r < 16; ++r) p1[r] = __builtin_amdgcn_exp2f(p1[r]);
#elif ATTN_SM_SPLIT == 2
  (void)mn;
#else
  { constexpr float C = SCALE * 1.4426950408889634f; const float mnC = -mn * C;
#pragma unroll
    for (int r = 0; r < 16; ++r) { p0[r] = __builtin_amdgcn_exp2f(fmaf(p0[r], C, mnC)); p1[r] = __builtin_amdgcn_exp2f(fmaf(p1[r], C, mnC)); } }
#endif
  float ps = 0;
#pragma unroll
  for (int r = 0; r < 16; ++r) ps += p0[r];
#pragma unroll
  for (int r = 0; r < 16; ++r) ps += p1[r];
  { auto rr = __builtin_amdgcn_permlane32_swap(__float_as_uint(ps), __float_as_uint(ps), false, false);
    ps = __uint_as_float(rr[0]) + __uint_as_float(rr[1]); }
  l_reg = l_reg * alpha + ps;
#define PK4(P, BASE, OUT) do { unsigned a0 = cvtpk(P[BASE + 0], P[BASE + 1]), a1 = cvtpk(P[BASE + 2], P[BASE + 3]);   \
    unsigned b0 = cvtpk(P[BASE + 4], P[BASE + 5]), b1 = cvtpk(P[BASE + 6], P[BASE + 7]);                              \
    auto r0 = __builtin_amdgcn_permlane32_swap(a0, b0, false, false); auto r1 = __builtin_amdgcn_permlane32_swap(a1, b1, false, false); \
    u32x4 w = {r0[0], r1[0], r0[1], r1[1]}; OUT = *reinterpret_cast<bf16x8*>(&w); } while (0)
  PK4(p0, 0, pa0); PK4(p0, 8, pa1); PK4(p1, 0, pa2); PK4(p1, 8, pa3);
#undef PK4
}
__device__ __forceinline__ void qkt(f32x16& p0, f32x16& p1, const char* Ks, const bf16x8* qr, int r32, int hi) {
  p0 = f32x16{}; p1 = f32x16{};
#pragma unroll
  for (int d0 = 0; d0 < DK / 16; ++d0) { const int cb = (d0 * 16 + hi * 8) * 2;
    const bf16x8 b0 = *reinterpret_cast<const bf16x8*>(Ks + KSWZ(r32, cb));
    const bf16x8 b1 = *reinterpret_cast<const bf16x8*>(Ks + KSWZ(32 + r32, cb));
    p0 = __builtin_amdgcn_mfma_f32_32x32x16_bf16(b0, qr[d0], p0, 0, 0, 0);
    p1 = __builtin_amdgcn_mfma_f32_32x32x16_bf16(b1, qr[d0], p1, 0, 0, 0); }
}
__device__ __forceinline__ int v_st(int k, int c) { const int kk = (k & ~0xC) | ((k & 4) << 1) | ((k & 8) >> 1); return ((kk >> 3) * 2 + (c >> 5)) * 512 + ((kk & 7) * 32 + (c & 31)) * 2; }
__device__ __forceinline__ int v_rd_base(int lane) { return ((lane & 3) << 3) | (((lane >> 2) & 3) << 6) | (((lane >> 4) & 1) << 5) | (((lane >> 5) & 1) << 8); }
constexpr int v_rd_off(int d0, int ks, int half) { return d0 * 512 + ks * 2048 + half * 1024; }
template <int OFF> __device__ __forceinline__ s16x4 tr_read(int vb) {
  s16x4 r; asm volatile("ds_read_b64_tr_b16 %0, %1 offset:%2" : "=&v"(r) : "v"(vb), "i"(OFF) : "memory"); return r;
}
template <int D0> __device__ __forceinline__ void pv_one(f32x16& od, int vb, bf16x8 pa0, bf16x8 pa1, bf16x8 pa2, bf16x8 pa3) {
  const s16x4 l0 = tr_read<v_rd_off(D0, 0, 0)>(vb), h0 = tr_read<v_rd_off(D0, 0, 1)>(vb), l1 = tr_read<v_rd_off(D0, 1, 0)>(vb), h1 = tr_read<v_rd_off(D0, 1, 1)>(vb);
  const s16x4 l2 = tr_read<v_rd_off(D0, 2, 0)>(vb), h2 = tr_read<v_rd_off(D0, 2, 1)>(vb), l3 = tr_read<v_rd_off(D0, 3, 0)>(vb), h3 = tr_read<v_rd_off(D0, 3, 1)>(vb);
  asm volatile("s_waitcnt lgkmcnt(0)" ::: "memory"); SBAR();
#define PK(L, H) (bf16x8){L[0], L[1], L[2], L[3], H[0], H[1], H[2], H[3]}
  od = __builtin_amdgcn_mfma_f32_32x32x16_bf16(pa0, PK(l0, h0), od, 0, 0, 0);
  od = __builtin_amdgcn_mfma_f32_32x32x16_bf16(pa1, PK(l1, h1), od, 0, 0, 0);
  od = __builtin_amdgcn_mfma_f32_32x32x16_bf16(pa2, PK(l2, h2), od, 0, 0, 0);
  od = __builtin_amdgcn_mfma_f32_32x32x16_bf16(pa3, PK(l3, h3), od, 0, 0, 0);
#undef PK
}
__device__ __forceinline__ void pv_d0(f32x16* o, int vb, bf16x8 pa0, bf16x8 pa1, bf16x8 pa2, bf16x8 pa3) {
  pv_one<0>(o[0], vb, pa0, pa1, pa2, pa3); pv_one<1>(o[1], vb, pa0, pa1, pa2, pa3);
}

__device__ __forceinline__ void pv_sm(f32x16* o, int vb, bf16x8 pa0, bf16x8 pa1, bf16x8 pa2, bf16x8 pa3, f32x16& p0, f32x16& p1, float& m_reg, float& mn, float& alpha) {
  constexpr float C = SCALE * 1.4426950408889634f;
  const s16x4 l00 = tr_read<v_rd_off(0, 0, 0)>(vb), h00 = tr_read<v_rd_off(0, 0, 1)>(vb), l10 = tr_read<v_rd_off(1, 0, 0)>(vb), h10 = tr_read<v_rd_off(1, 0, 1)>(vb);
  const s16x4 l01 = tr_read<v_rd_off(0, 1, 0)>(vb), h01 = tr_read<v_rd_off(0, 1, 1)>(vb), l11 = tr_read<v_rd_off(1, 1, 0)>(vb), h11 = tr_read<v_rd_off(1, 1, 1)>(vb);
  const s16x4 l02 = tr_read<v_rd_off(0, 2, 0)>(vb), h02 = tr_read<v_rd_off(0, 2, 1)>(vb), l12 = tr_read<v_rd_off(1, 2, 0)>(vb), h12 = tr_read<v_rd_off(1, 2, 1)>(vb);
  const s16x4 l03 = tr_read<v_rd_off(0, 3, 0)>(vb), h03 = tr_read<v_rd_off(0, 3, 1)>(vb), l13 = tr_read<v_rd_off(1, 3, 0)>(vb), h13 = tr_read<v_rd_off(1, 3, 1)>(vb);
  float pmax = p0[0];
#pragma unroll
  for (int r = 1; r < 16; ++r) pmax = fmaxf(pmax, p0[r]);
#pragma unroll
  for (int r = 0; r < 16; ++r) pmax = fmaxf(pmax, p1[r]);
  { auto rr = __builtin_amdgcn_permlane32_swap(__float_as_uint(pmax), __float_as_uint(pmax), false, false);
    pmax = fmaxf(__uint_as_float(rr[0]), __uint_as_float(rr[1])); }
  const bool keep = __all(pmax - m_reg <= THR / SCALE); mn = keep ? m_reg : fmaxf(m_reg, pmax); alpha = __builtin_amdgcn_exp2f((m_reg - mn) * C); m_reg = mn;
  const float mnC = -mn * C;
  asm volatile("s_waitcnt lgkmcnt(0)" ::: "memory"); SBAR();
#define PK(L, H) (bf16x8){L[0], L[1], L[2], L[3], H[0], H[1], H[2], H[3]}
#define EX4(P, B) do { P[B] = __builtin_amdgcn_exp2f(fmaf(P[B], C, mnC)); P[B + 1] = __builtin_amdgcn_exp2f(fmaf(P[B + 1], C, mnC)); P[B + 2] = __builtin_amdgcn_exp2f(fmaf(P[B + 2], C, mnC)); P[B + 3] = __builtin_amdgcn_exp2f(fmaf(P[B + 3], C, mnC)); } while (0)
  o[0] = __builtin_amdgcn_mfma_f32_32x32x16_bf16(pa0, PK(l00, h00), o[0], 0, 0, 0); EX4(p0, 0); SBAR();
  o[1] = __builtin_amdgcn_mfma_f32_32x32x16_bf16(pa0, PK(l10, h10), o[1], 0, 0, 0); EX4(p0, 4); SBAR();
  o[0] = __builtin_amdgcn_mfma_f32_32x32x16_bf16(pa1, PK(l01, h01), o[0], 0, 0, 0); EX4(p0, 8); SBAR();
  o[1] = __builtin_amdgcn_mfma_f32_32x32x16_bf16(pa1, PK(l11, h11), o[1], 0, 0, 0); EX4(p0, 12); SBAR();
  o[0] = __builtin_amdgcn_mfma_f32_32x32x16_bf16(pa2, PK(l02, h02), o[0], 0, 0, 0); EX4(p1, 0); SBAR();
  o[1] = __builtin_amdgcn_mfma_f32_32x32x16_bf16(pa2, PK(l12, h12), o[1], 0, 0, 0); EX4(p1, 4); SBAR();
  o[0] = __builtin_amdgcn_mfma_f32_32x32x16_bf16(pa3, PK(l03, h03), o[0], 0, 0, 0); EX4(p1, 8); SBAR();
  o[1] = __builtin_amdgcn_mfma_f32_32x32x16_bf16(pa3, PK(l13, h13), o[1], 0, 0, 0); EX4(p1, 12); SBAR();
#undef PK
#undef EX4
}

template <class TQ, class Out, int VAR = 0>
__device__ __forceinline__ void attn_unit(const TQ* Qb, int ldq, const unsigned short* Kh, const unsigned short* Vh, int seq, char* lds, const Out& OUT) {
  int tid_ = TIDX; asm volatile("" : "+v"(tid_));
  const int tid = tid_, wid = tid >> 6, lane = tid & 63, r32 = lane & 31, hi = lane >> 5;
  char* V_lds = lds; char* K_lds = lds + 3 * SHM_V;
  float* ws = (float*)(lds + 3 * SHM_V + 3 * SHM_K) + wid * 64; float* li_l = ws; float* al_l = ws + 32;
  float m_reg = -1e30f, l_reg = 0; f32x16 o[2] = {}; bf16x8 qr[DK / 16]; f32x16 negm = {}; (void)negm;
  { const TQ* Qw = Qb + (long)(wid * QBLK + r32) * ldq + hi * 8;
#pragma unroll
    for (int d0 = 0; d0 < DK / 16; ++d0) {
      if constexpr (sizeof(TQ) == 4) qr[d0] = tobf(*reinterpret_cast<const f32x8*>(Qw + d0 * 16)); else qr[d0] = *reinterpret_cast<const bf16x8*>(Qw + d0 * 16); } }
  const int kc0 = tid, kc1 = 512 + tid; const bool two = tid < 256;
  const int kst0 = KSWZ(kc0 / 12, (kc0 % 12) * 16), kst1 = KSWZ(kc1 / 12, (kc1 % 12) * 16), vst = v_st(tid >> 3, (tid & 7) * 8);
  const int vb0 = (int)(uintptr_t)V_lds + v_rd_base(lane);
  struct { bf16x8 v, k0, k1; } sr_[2];
#define SLOAD(i, key0) do { sr_[i].v = *reinterpret_cast<const bf16x8*>(Vh + (long)(key0) * DV + tid * 8); sr_[i].k0 = *reinterpret_cast<const bf16x8*>(Kh + (long)(key0) * DK + kc0 * 8); \
    if (two) sr_[i].k1 = *reinterpret_cast<const bf16x8*>(Kh + (long)(key0) * DK + kc1 * 8); } while (0)
#define SWRITE(b, i) do { *(bf16x8*)(V_lds + (b) * SHM_V + vst) = sr_[i].v; *(bf16x8*)(K_lds + (b) * SHM_K + kst0) = sr_[i].k0; if (two) *(bf16x8*)(K_lds + (b) * SHM_K + kst1) = sr_[i].k1; } while (0)
#define RESC(a) do { if (__any((a) < 1.f)) { if (hi == 0) al_l[r32] = (a); asm volatile("s_waitcnt lgkmcnt(0)" ::: "memory"); \
    _Pragma("unroll") for (int d = 0; d < 2; ++d) _Pragma("unroll") for (int r = 0; r < 16; ++r) o[d][r] *= al_l[crow(r, hi)]; } } while (0)
  f32x16 pA0 = {}, pA1 = {}, pB0 = {}, pB1 = {}; float mnA, mnB, alA, alB; bf16x8 pa0, pa1, pa2, pa3; const int NT = seq / KVBLK;
  constexpr int SE = 0, SO = 1;
#if ATTN_NEGM
#define PSM(p0_, p1_, m_, mn_, al_) do { (void)mn_; partialSM_n(p0_, p1_, negm, al_); } while (0)
#else
#define PSM(p0_, p1_, m_, mn_, al_) do { if constexpr (VAR == 1) { mn_ = 0.f; al_ = 1.f; } else partialSM(p0_, p1_, m_, mn_, al_); } while (0)
#endif
#define FSM(p0_, p1_, mn_, al_, l_, a0_, a1_, a2_, a3_) do { if constexpr (VAR == 1) { u32x4 w0_ = {cvtpk(p0_[0], p0_[1]), cvtpk(p0_[2], p0_[3]), cvtpk(p0_[4], p0_[5]), cvtpk(p0_[6], p0_[7])}; a0_ = *reinterpret_cast<bf16x8*>(&w0_); \
      u32x4 w1_ = {cvtpk(p0_[8], p0_[9]), cvtpk(p0_[10], p0_[11]), cvtpk(p0_[12], p0_[13]), cvtpk(p0_[14], p0_[15])}; a1_ = *reinterpret_cast<bf16x8*>(&w1_); \
      u32x4 w2_ = {cvtpk(p1_[0], p1_[1]), cvtpk(p1_[2], p1_[3]), cvtpk(p1_[4], p1_[5]), cvtpk(p1_[6], p1_[7])}; a2_ = *reinterpret_cast<bf16x8*>(&w2_); \
      u32x4 w3_ = {cvtpk(p1_[8], p1_[9]), cvtpk(p1_[10], p1_[11]), cvtpk(p1_[12], p1_[13]), cvtpk(p1_[14], p1_[15])}; a3_ = *reinterpret_cast<bf16x8*>(&w3_); } else { if constexpr (ATTN_NEGM != 0) finishSM_n(p0_, p1_, al_, l_, a0_, a1_, a2_, a3_); else finishSM(p0_, p1_, mn_, al_, l_, a0_, a1_, a2_, a3_); } } while (0)
#define PVSM(o_, vb_, a0_, a1_, a2_, a3_, p0_, p1_, m_, mn_, al_) do { if constexpr (VAR == 0 && ATTN_SM_SPLIT == 2) pv_sm(o_, vb_, a0_, a1_, a2_, a3_, p0_, p1_, m_, mn_, al_); else { PVD(o_, vb_, a0_, a1_, a2_, a3_); PSM(p0_, p1_, m_, mn_, al_); } } while (0)
#define PVD(o_, vb_, a0_, a1_, a2_, a3_) do { if constexpr (VAR == 2) { asm volatile("" : "+v"(o_[0]), "+v"(o_[1]) : "v"(a0_), "v"(a1_), "v"(a2_), "v"(a3_)); } else pv_d0(o_, vb_, a0_, a1_, a2_, a3_); } while (0)
#define QKT(p0_, p1_, K_, q_, r_, h_) do { if constexpr (VAR == 5) { asm volatile("" : "+v"(p0_), "+v"(p1_)); } else { if constexpr (ATTN_NEGM != 0) qkt_n(p0_, p1_, K_, q_, negm, r_, h_); else qkt(p0_, p1_, K_, q_, r_, h_); } } while (0)
#define LSLOAD(i_, k_) do { if constexpr (VAR != 3) SLOAD(i_, k_); } while (0)
#define LSWRITE(b_, i_) do { if constexpr (VAR != 3) SWRITE(b_, i_); } while (0)
#define LSYNC() do { if constexpr (VAR != 4) __syncthreads(); } while (0)
  int bp = 0, bc = 1, bn = 2;
#define ROT3() do { const int t_ = bp; bp = bc; bc = bn; bn = t_; } while (0)
  SLOAD(SE, 0); asm volatile("s_waitcnt vmcnt(0)" ::: "memory"); SWRITE(0, SE); __syncthreads();
  QKT(pA0, pA1, K_lds, qr, r32, hi);
#if ATTN_NEGM
  partialSM_n<true>(pA0, pA1, negm, alA);
#else
  PSM(pA0, pA1, m_reg, mnA, alA);
#endif
  SLOAD(SO, KVBLK); if (2 < NT) SLOAD(SE, 2 * KVBLK);
  SWRITE(1, SO); __syncthreads();
  for (int j = 1; j + 1 < NT; j += 2) {
    SBAR(); QKT(pB0, pB1, K_lds + bc * SHM_K, qr, r32, hi);
    FSM(pA0, pA1, mnA, alA, l_reg, pa0, pa1, pa2, pa3); SBAR();
    LSLOAD(SO, (j + 2) * KVBLK); SBAR();
    PVSM(o, vb0 + bp * SHM_V, pa0, pa1, pa2, pa3, pB0, pB1, m_reg, mnB, alB);
    LSWRITE(bn, SE);
    RESC(alB); LSYNC(); ROT3();
    SBAR(); QKT(pA0, pA1, K_lds + bc * SHM_K, qr, r32, hi);
    FSM(pB0, pB1, mnB, alB, l_reg, pa0, pa1, pa2, pa3); SBAR();
    if (j + 3 < NT) LSLOAD(SE, (j + 3) * KVBLK); SBAR();
    PVSM(o, vb0 + bp * SHM_V, pa0, pa1, pa2, pa3, pA0, pA1, m_reg, mnA, alA);
    LSWRITE(bn, SO);
    RESC(alA); LSYNC(); ROT3();
  }
  SBAR(); QKT(pB0, pB1, K_lds + bc * SHM_K, qr, r32, hi);
  FSM(pA0, pA1, mnA, alA, l_reg, pa0, pa1, pa2, pa3); SBAR();
  PVSM(o, vb0 + bp * SHM_V, pa0, pa1, pa2, pa3, pB0, pB1, m_reg, mnB, alB);
  RESC(alB);
  FSM(pB0, pB1, mnB, alB, l_reg, pa0, pa1, pa2, pa3); SBAR();
  PVD(o, vb0 + bc * SHM_V, pa0, pa1, pa2, pa3);
#undef ROT3
  if (hi == 0) li_l[r32] = l_reg; asm volatile("s_waitcnt lgkmcnt(0)" ::: "memory");
  float rli[16];
#pragma unroll
  for (int r = 0; r < 16; ++r) rli[r] = __builtin_amdgcn_rcpf(li_l[crow(r, hi)]);
#pragma unroll
  for (int r = 0; r < 16; ++r) { const int orow = wid * QBLK + crow(r, hi);
#pragma unroll
    for (int d0 = 0; d0 < 2; ++d0) OUT(orow, d0 * 32 + r32, o[d0][r] * rli[r]); }
  __syncthreads();
#undef SLOAD
#undef SWRITE
#undef RESC
#undef PSM
#undef PVSM
#undef FSM
#undef PVD
#undef QKT
#undef LSLOAD
#undef LSWRITE
#undef LSYNC
}
#undef KSWZ
#undef SBAR
}
struct Q2 {
    bf16* U16;
    bf16 *WtL;
    bf16 *WtM;
    bf16 *WtG;
    float *LSL;
    bf16 *HLOC, *PCUM;
    float *SA, *SB;
    bf16 *QN16, *KVN16;
    bf16 *Q16;
    bf16 *WtKvbP;
    bf16 *XCM16, *QKV16;
    float *GATES;
    float *CLOC, *NLOC, *MLB;
    bf16 *CST; float *NST, *MST;
    bf16 *YB16;
    float *GLIST;
};
constexpr int NCH = TPB / 128;
constexpr int NCH_CTX = CTX / 128;

__device__ __forceinline__ float wave_sum(float v) {
#pragma unroll
    for (int o = 1; o < 64; o <<= 1) v += __shfl_xor(v, o);
    return v;
}
__device__ __forceinline__ float fast_sigmoid(float x) { return __builtin_amdgcn_rcpf(1.f + __expf(-x)); }
__device__ __forceinline__ float fast_silu(float x) { return x * fast_sigmoid(x); }
__device__ __forceinline__ float fast_gelu(float x) { const float u = 0.7978845608028654f * (x + 0.044715f * x * x * x); return x * fast_sigmoid(2.f * u); }

struct EpiU16 {
    static constexpr bool PERM = true; bf16* U;
    __device__ __forceinline__ void operator()(const pg8::f32x4 (&acc)[2][2][4][2], const pg8::Unit& u, int wr, int wc, int fr, int fq) const {
#pragma unroll
        for (int ai = 0; ai < 2; ++ai)
#pragma unroll
            for (int m = 0; m < 4; ++m) { const int row = u.pm * 256 + ai * 128 + wr * 64 + m * 16 + fr;
#pragma unroll
                for (int bj = 0; bj < 2; ++bj) { const int c = u.pn * 256 + bj * 128 + wc * 32 + 8 * fq; const pg8::f32x4 v0 = acc[ai][bj][m][0], v1 = acc[ai][bj][m][1];
                    u32x4 w; w.x = pg8::cvt_pk_bf16(v0[0], v0[1]); w.y = pg8::cvt_pk_bf16(v0[2], v0[3]); w.z = pg8::cvt_pk_bf16(v1[0], v1[1]); w.w = pg8::cvt_pk_bf16(v1[2], v1[3]);
                    *(u32x4*)(U + (size_t)row * DINP + c) = w; } }
    }
};
__device__ __forceinline__ void opt_inproj16(const Q& q, const Q2& q2, int l, LAS unsigned char* lds, int G, int bid) {
    pg8::Gemm g{q.H16, q.WtIn + (size_t)l * DINP * D, D}; pg8::StaticOrder S; S.init(NT, DINP, G, bid);
    EpiU16 E{q2.U16}; pg8::gemm_phase<EpiU16, pg8::StaticOrder, true>(lds, g, S, E);
}

__device__ __forceinline__ void opt_convert_small(const P& p, const Q2& q2, long gtid, long nthr) {
    for (long it = gtid; it < (long)DEPTH * 4 * 256 * 64; it += nthr) { const int i = (int)(it & 63), n = (int)((it >> 6) & 255), g = (int)((it >> 14) & 3), l = (int)(it >> 16);
        const int d = n >> 7, gate = (n >> 6) & 1, j = n & 63; const float* w = (gate ? p.in[I_LWX] : p.in[I_LWA]) + ((((size_t)l * 2 + d) * 4 + g) * 64 + i) * 64 + j;
        q2.WtL[it] = (bf16)f2bf(*w); }
    for (long it = gtid; it < (long)DEPTH * 4 * 3 * 64 * 64; it += nthr) { const int i = (int)(it & 63), j = (int)((it >> 6) & 63), m = (int)((it >> 12) % 3), h = (int)((it / (3 * 4096)) & 3), l = (int)(it / (12 * 4096));
        const float* w = (m == 0 ? p.in[I_MWQ] : (m == 1 ? p.in[I_MWK] : p.in[I_MWV])) + (((size_t)l * 4 + h) * 64 + i) * 64 + j;
        q2.WtM[it] = (bf16)f2bf(*w * (m == 1 ? 0.125f : 1.f)); }
    for (long it = gtid; it < (long)DEPTH * 32 * 768; it += nthr) { const int i = (int)(it % 768), n = (int)((it / 768) & 31), l = (int)(it / (32 * 768));
        q2.WtG[it] = n < 16 ? (bf16)f2bf(p.in[I_MWG][((((size_t)l * 2 + (n >> 3)) * 768) + i) * 8 + (n & 7)]) : (bf16)0; }
    for (long it = gtid; it < (long)DEPTH * 2 * 256; it += nthr) q2.LSL[it] = logsigmoid_f(p.in[I_LLAM][it]);
}

__device__ __forceinline__ void opt_init_mod(const P& p, char* lds, int bid, int G) {
    int tid_ = TIDX; asm volatile("" : "+v"(tid_));
    const int tid = tid_; float* SC = (float*)lds; float* RED = (float*)(lds + 12288);
    for (int i = tid; i < 3 * D; i += 512) { const int cv = i / D, k = i % D; const float x = cv < 2 ? p.in[I_C][cv * D + k] : p.in[I_CCTX][k]; SC[i] = x / (1.f + __expf(-x)); }
    __syncthreads();
    for (int it = bid; it < DEPTH * 6 * D / 64; it += G) { const int l = it / (6 * D / 64), j = (it % (6 * D / 64)) * 64 + (tid & 63), kq = tid >> 6;
        const float* w = p.in[I_WMOD] + (size_t)l * D * 6 * D + (size_t)(128 * kq) * 6 * D + j; float a0 = 0.f, a1 = 0.f, a2 = 0.f;
#pragma unroll 8
        for (int k = 0; k < 128; ++k) { const float wv = w[(size_t)k * 6 * D]; a0 += SC[128 * kq + k] * wv; a1 += SC[D + 128 * kq + k] * wv; a2 += SC[2 * D + 128 * kq + k] * wv; }
        RED[(kq * 3 + 0) * 64 + (tid & 63)] = a0; RED[(kq * 3 + 1) * 64 + (tid & 63)] = a1; RED[(kq * 3 + 2) * 64 + (tid & 63)] = a2;
        __syncthreads();
        if (tid < 192) { const int cv = tid >> 6, jj = tid & 63; float sacc = p.in[I_BMOD][(size_t)l * 6 * D + (it % (6 * D / 64)) * 64 + jj];
#pragma unroll
            for (int x = 0; x < 8; ++x) sacc += RED[(x * 3 + cv) * 64 + jj];
            p.MOD[((size_t)l * 3 + cv) * 6 * D + (it % (6 * D / 64)) * 64 + jj] = sacc; }
        __syncthreads(); }
}
__device__ __forceinline__ void opt_init_rope(const P& p, long gtid, long nthr) {
    for (long it = gtid; it < (long)SEQ * 16; it += nthr) { const int s = (int)(it / 16), a = (int)((it / 8) & 1), f = (int)(it & 7); const int pos = a == 0 ? s / GRID_W : s % GRID_W;
        const float frf = (float)pow(10000.0, -(double)f / 8.0); const double ang = (double)((float)pos * frf);
        p.ROPET[it * 2] = (float)cos(ang); p.ROPET[it * 2 + 1] = (float)sin(ang); }
}

template <int KS, class TA, class TB>
__device__ __forceinline__ void wave_mm32(att::f32x16& acc, const TA* A, int lda, const TB* B, int ldb, int r32, int hi) {
#pragma unroll
    for (int ks = 0; ks < KS; ++ks) {
        const att::bf16x8 a = *reinterpret_cast<const att::bf16x8*>(A + (size_t)r32 * lda + ks * 16 + hi * 8);
        const att::bf16x8 b = *reinterpret_cast<const att::bf16x8*>(B + (size_t)r32 * ldb + ks * 16 + hi * 8);
        acc = __builtin_amdgcn_mfma_f32_32x32x16_bf16(a, b, acc, 0, 0, 0);
    }
}

constexpr int LRU1_LDS = 18432 + 65536 + 4096;
template <class UL>
__device__ __forceinline__ void lru1_item(const P& p, const Q2& q2, int l, int b, int ch, int g, char* lds, const UL& U) {
    int tid_ = TIDX; asm volatile("" : "+v"(tid_));
    const int tid = tid_, wave = tid >> 6, lane = tid & 63, r32 = lane & 31, hi = lane >> 5;
    unsigned short* XC16 = (unsigned short*)lds; float* AB = (float*)(lds + 18432); float* CMP = (float*)(lds + 18432 + 65536);
    const int t0 = b * TPB + ch * 128, seg_lo = ch < NCH_CTX ? b * TPB : b * TPB + CTX, seg_hi = ch < NCH_CTX ? b * TPB + CTX : (b + 1) * TPB;
    { const int j = tid & 63, c = g * 64 + j, tb = (tid >> 6) * 16; const float* cw = p.in[I_LCW] + (size_t)l * 4 * 256 + c; const float w0 = cw[0], w1 = cw[256], w2 = cw[512], w3 = cw[768], cb = p.in[I_LCB][(size_t)l * 256 + c];
      float xm2 = (t0 + tb - 2 >= seg_lo) ? U(t0 + tb - 2, OFF_AX + c) : 0.f, xm1 = (t0 + tb - 1 >= seg_lo) ? U(t0 + tb - 1, OFF_AX + c) : 0.f, x0 = U(t0 + tb, OFF_AX + c);
#pragma unroll 4
      for (int i = 0; i < 16; ++i) { const int t = t0 + tb + i; const float xp1 = (t + 1 < seg_hi) ? U(t + 1, OFF_AX + c) : 0.f;
          const float v = cb + w0 * xm2 + w1 * xm1 + w2 * x0 + w3 * xp1; XC16[(tb + i) * 72 + j] = (unsigned short)f2bf(v); xm2 = xm1; xm1 = x0; x0 = xp1; } }
    __syncthreads();
    const bf16* Wt = q2.WtL + ((size_t)l * 4 + g) * 256 * 64;
#pragma unroll 1
    for (int d = 0; d < 2; ++d) {
        const int rt = wave & 3, cj = wave >> 2; att::f32x16 ar = {}, ai = {};
        wave_mm32<4>(ar, XC16 + rt * 32 * 72, 72, Wt + (size_t)(d * 128 + cj * 32) * 64, 64, r32, hi);
        wave_mm32<4>(ai, XC16 + rt * 32 * 72, 72, Wt + (size_t)(d * 128 + 64 + cj * 32) * 64, 64, r32, hi);
        { const int j = cj * 32 + r32, c = g * 64 + j; const float ba = p.in[I_LBA][((size_t)l * 2 + d) * 256 + c], bx = p.in[I_LBX][((size_t)l * 2 + d) * 256 + c], lsl = q2.LSL[((size_t)l * 2 + d) * 256 + c];
#pragma unroll
          for (int r = 0; r < 16; ++r) { const int tt = rt * 32 + att::crow(r, hi); const float rg = fast_sigmoid(ar[r] + ba), ig = fast_sigmoid(ai[r] + bx), la = 8.f * rg * lsl, a = __expf(la);
              const float xc = bf2f(XC16[tt * 72 + j]); const float bb = sqrtf(fmaxf(1.f - a * a, 0.f)) * ig * xc;
              AB[(tt * 64 + j) * 2] = a; AB[(tt * 64 + j) * 2 + 1] = bb; } }
        __syncthreads();
        { const int j = tid & 63, sg = tid >> 6; float av[16], bv[16]; float A = 1.f, B = 0.f;
#pragma unroll
          for (int i = 0; i < 16; ++i) { const int s = sg * 16 + i, tt = d == 0 ? s : 127 - s; av[i] = AB[(tt * 64 + j) * 2]; bv[i] = AB[(tt * 64 + j) * 2 + 1]; B = av[i] * B + bv[i]; A *= av[i]; }
          CMP[(sg * 64 + j) * 2] = A; CMP[(sg * 64 + j) * 2 + 1] = B;
          __syncthreads();
          float cA = 1.f, cB = 0.f;
          for (int x = 0; x < sg; ++x) { const float xa = CMP[(x * 64 + j) * 2], xb = CMP[(x * 64 + j) * 2 + 1]; cB = xa * cB + xb; cA *= xa; }
          const int c = g * 64 + j; float h = cB, pc = cA;
          unsigned short* OUTS = (unsigned short*)AB;
#pragma unroll
          for (int i = 0; i < 16; ++i) { const int s = sg * 16 + i, tt = d == 0 ? s : 127 - s; h = av[i] * h + bv[i]; pc *= av[i];
              OUTS[tt * 64 + j] = (unsigned short)f2bf(h); OUTS[(128 + tt) * 64 + j] = (unsigned short)f2bf(pc); }
          if (sg == 7) { q2.SA[(((size_t)d * NB + b) * NCH + ch) * 256 + c] = pc; q2.SB[(((size_t)d * NB + b) * NCH + ch) * 256 + c] = h; }
          __syncthreads();
#pragma unroll
          for (int k = 0; k < 4; ++k) { const int x = tid + k * 512, arr = x >> 10, tt = (x >> 3) & 127, c8 = x & 7; const u32x4 v = *(const u32x4*)(OUTS + (arr * 128 + tt) * 64 + c8 * 8);
              *(u32x4*)((arr ? q2.PCUM : q2.HLOC) + ((size_t)d * NT + t0 + tt) * 256 + g * 64 + c8 * 8) = v; } }
        __syncthreads();
    }
}
__device__ __forceinline__ void lru2_item(const Q2& q2, bf16* Yp, int b, int ch, char* lds) {
    int tid_ = TIDX; asm volatile("" : "+v"(tid_));
    const int tid = tid_; float* CAR = (float*)lds;
    { const int d = tid >> 8, c = tid & 255; float h = 0.f;
      if (d == 0) { for (int j = 0; j < ch; ++j) h = q2.SA[(((size_t)0 * NB + b) * NCH + j) * 256 + c] * h + q2.SB[(((size_t)0 * NB + b) * NCH + j) * 256 + c]; }
      else { const bool isctx = ch < NCH_CTX;
          for (int j = NCH_CTX - 1; j >= (isctx ? ch + 1 : 0); --j) h = q2.SA[(((size_t)1 * NB + b) * NCH + j) * 256 + c] * h + q2.SB[(((size_t)1 * NB + b) * NCH + j) * 256 + c];
          if (!isctx) for (int j = NCH - 1; j > ch; --j) h = q2.SA[(((size_t)1 * NB + b) * NCH + j) * 256 + c] * h + q2.SB[(((size_t)1 * NB + b) * NCH + j) * 256 + c]; }
      CAR[tid] = h; }
    __syncthreads();
    const int t0 = b * TPB + ch * 128;
#pragma unroll 2
    for (int k = 0; k < 8; ++k) { const int x = tid + k * 512, tt = x >> 5, c0 = (x & 31) * 8, t = t0 + tt;
        const u32x4 hf = *(const u32x4*)(q2.HLOC + (size_t)t * 256 + c0), pf = *(const u32x4*)(q2.PCUM + (size_t)t * 256 + c0), hb = *(const u32x4*)(q2.HLOC + ((size_t)NT + t) * 256 + c0), pb = *(const u32x4*)(q2.PCUM + ((size_t)NT + t) * 256 + c0);
        const u32x4 ag = *(const u32x4*)(q2.U16 + (size_t)t * DINP + OFF_AG + c0); u32x4 o;
#pragma unroll
        for (int w = 0; w < 4; ++w) { float y[2];
#pragma unroll
            for (int e = 0; e < 2; ++e) { const int c = c0 + 2 * w + e; const unsigned sh = e ? 0u : 16u;
                const float h0 = __builtin_bit_cast(float, e ? (hf[w] & 0xffff0000u) : (hf[w] << 16)), p0 = __builtin_bit_cast(float, e ? (pf[w] & 0xffff0000u) : (pf[w] << 16));
                const float h1 = __builtin_bit_cast(float, e ? (hb[w] & 0xffff0000u) : (hb[w] << 16)), p1 = __builtin_bit_cast(float, e ? (pb[w] & 0xffff0000u) : (pb[w] << 16));
                const float a = __builtin_bit_cast(float, e ? (ag[w] & 0xffff0000u) : (ag[w] << 16)); (void)sh;
                y[e] = ((h0 + p0 * CAR[c]) + (h1 + p1 * CAR[256 + c])) * fast_gelu(a); }
            o[w] = pk2(y[0], y[1]); }
        *(u32x4*)(Yp + (size_t)t * DMIX + c0) = o; }
    __syncthreads();
}

template <class UL>
__device__ __forceinline__ void mla_prep_token(const P& p, const Q& q, const Q2& q2, int l, int t, int lane, const UL& U) {
    float xq[4], xk[2]; float sq = 0.f, sk = 0.f;
#pragma unroll
    for (int i = 0; i < 4; ++i) { xq[i] = U(t, OFF_BQ + lane * 4 + i); sq += xq[i] * xq[i]; }
#pragma unroll
    for (int i = 0; i < 2; ++i) { xk[i] = U(t, OFF_BKV + lane * 2 + i); sk += xk[i] * xk[i]; }
    sq = wave_sum(sq); sk = wave_sum(sk);
    const float rq = 1.f / sqrtf(sq * (1.f / QRANK) + EPS), rk = 1.f / sqrtf(sk * (1.f / KVRANK) + EPS);
    const float* gq = p.in[I_QNG] + (size_t)l * QRANK + lane * 4; const float* gk = p.in[I_KVNG] + (size_t)l * KVRANK + lane * 2;
    u32x2 wq; wq.x = pk2(xq[0] * rq * gq[0], xq[1] * rq * gq[1]); wq.y = pk2(xq[2] * rq * gq[2], xq[3] * rq * gq[3]);
    *(u32x2*)(q2.QN16 + (size_t)t * 256 + lane * 4) = wq;
    *(unsigned*)(q2.KVN16 + (size_t)t * 256 + lane * 2) = pk2(xk[0] * rk * gk[0], xk[1] * rk * gk[1]);
    *(unsigned*)(q2.KVN16 + (size_t)t * 256 + 128 + lane * 2) = 0u;
    const int b = t / TPB, key = t % TPB, h = lane >> 3, d0 = (lane & 7) * 4; const bool lat = key >= CTX; const int s = key - CTX;
    float o[4];
#pragma unroll
    for (int i = 0; i < 4; ++i) { const int dd = d0 + i, a = dd >> 4, half = (dd >> 3) & 1, f = dd & 7; const float me = U(t, OFF_BKR + dd), other = U(t, OFF_BKR + (dd ^ 8));
        float cs = 1.f, sn = 0.f; if (lat) { cs = p.ROPET[(((size_t)s * 2 + a) * 8 + f) * 2]; sn = p.ROPET[(((size_t)s * 2 + a) * 8 + f) * 2 + 1]; }
        o[i] = half == 0 ? me * cs - other * sn : me * cs + other * sn; }
    u32x2 wk; wk.x = pk2(o[0], o[1]); wk.y = pk2(o[2], o[3]);
    *(u32x2*)(q.K16 + (((size_t)b * AH + h) * TPB + key) * QKD + NOPE + d0) = wk;
}

struct EpiQproj {
    static constexpr bool PERM = true; bf16* Q16; const float* ROPET;
    __device__ __forceinline__ void operator()(const pg8::f32x4 (&acc)[2][2][4][2], const pg8::Unit& u, int wr, int wc, int fr, int fq) const {
#pragma unroll
        for (int bj = 0; bj < 2; ++bj) { const int blk = u.pn * 8 + bj * 4 + wc; const bool rope = (blk % 3) == 2; const int c = blk * 32 + 8 * fq;
#pragma unroll
            for (int ai = 0; ai < 2; ++ai)
#pragma unroll
                for (int m = 0; m < 4; ++m) { const int row = u.pm * 256 + ai * 128 + wr * 64 + m * 16 + fr; float v[8];
#pragma unroll
                    for (int x = 0; x < 4; ++x) { v[x] = acc[ai][bj][m][0][x]; v[4 + x] = acc[ai][bj][m][1][x]; }
                    if (rope) {
                        const int key = (u.pm % (TPB / 256)) * 256 + ai * 128 + wr * 64 + m * 16 + fr; const bool lat = key >= CTX; const int s = lat ? key - CTX : 0, a = fq >> 1; const float* tb = ROPET + ((size_t)s * 2 + a) * 16;
#pragma unroll
                        for (int x = 0; x < 8; ++x) { const float other = __shfl_xor(v[x], 16); const float cs = lat ? tb[x * 2] : 1.f, sn = lat ? tb[x * 2 + 1] : 0.f;
                            v[x] = (fq & 1) == 0 ? v[x] * cs - other * sn : v[x] * cs + other * sn; } }
#pragma unroll
                    for (int x = 0; x < 8; ++x) v[x] *= att::QPRESCALE;
                    u32x4 w; w.x = pg8::cvt_pk_bf16(v[0], v[1]); w.y = pg8::cvt_pk_bf16(v[2], v[3]); w.z = pg8::cvt_pk_bf16(v[4], v[5]); w.w = pg8::cvt_pk_bf16(v[6], v[7]);
                    *(u32x4*)(Q16 + (size_t)row * 768 + c) = w; asm volatile("" ::: "memory"); } }
    }
};
struct EpiKVproj {
    static constexpr bool PERM = true; bf16* K16; bf16* V16;
    __device__ __forceinline__ void operator()(const pg8::f32x4 (&acc)[2][2][4][2], const pg8::Unit& u, int wr, int wc, int fr, int fq) const {
#pragma unroll
        for (int bj = 0; bj < 2; ++bj) { const int h = u.pn * 2 + bj, dcol = wc * 32 + 8 * fq; const bool isv = dcol >= 64;
#pragma unroll
            for (int ai = 0; ai < 2; ++ai)
#pragma unroll
                for (int m = 0; m < 4; ++m) { const int b = u.pm / (TPB / 256), key = (u.pm % (TPB / 256)) * 256 + ai * 128 + wr * 64 + m * 16 + fr; const pg8::f32x4 v0 = acc[ai][bj][m][0], v1 = acc[ai][bj][m][1];
                    u32x4 w; w.x = pg8::cvt_pk_bf16(v0[0], v0[1]); w.y = pg8::cvt_pk_bf16(v0[2], v0[3]); w.z = pg8::cvt_pk_bf16(v1[0], v1[1]); w.w = pg8::cvt_pk_bf16(v1[2], v1[3]);
                    bf16* dst = isv ? V16 + (((size_t)b * AH + h) * TPB + key) * VD + (dcol - 64) : K16 + (((size_t)b * AH + h) * TPB + key) * QKD + dcol;
                    *(u32x4*)dst = w; asm volatile("" ::: "memory"); } }
    }
};
struct MlaOrder : pg8::StaticOrder { __device__ __forceinline__ int arow(const pg8::Unit& u, int r) const { return (u.pn >= 3 ? NT : 0) + u.pm * pg8::BM + r; } };
struct EpiMla { static constexpr bool PERM = true; EpiQproj eq; EpiKVproj ekv;
    __device__ __forceinline__ void operator()(const pg8::f32x4 (&acc)[2][2][4][2], const pg8::Unit& u, int wr, int wc, int fr, int fq) const {
        if (u.pn < 3) eq(acc, u, wr, wc, fr, fq); else { pg8::Unit v = u; v.pn = u.pn - 3; ekv(acc, v, wr, wc, fr, fq); } } };
__device__ __forceinline__ void opt_mla_proj(const P& p, const Q& q, const Q2& q2, int l, LAS unsigned char* lds, int G, int bid) {
    pg8::Gemm g{q2.QN16, q2.WtKvbP + (size_t)l * 1792 * 256, 256}; MlaOrder S; S.init(NT, 1792, G, bid);
    EpiMla E{EpiQproj{q2.Q16, p.ROPET}, EpiKVproj{q.K16, q.V16}}; pg8::gemm_phase<EpiMla, MlaOrder, true>(lds, g, S, E);
}
__device__ __forceinline__ int ord_len(int d, int ch) { return d == 0 ? ch : (ch < NCH_CTX ? NCH_CTX - 1 - ch : NCH_CTX + (NCH - 1 - ch)); }
__device__ __forceinline__ int ord_chunk(int d, int ch, int i) { return d == 0 ? i : (i < (ch < NCH_CTX ? NCH_CTX - 1 - ch : NCH_CTX) ? NCH_CTX - 1 - i : NCH - 1 - (i - NCH_CTX)); }

__device__ __forceinline__ void wave_scan_add128(float& x0, float& x1, int lane) {
#pragma unroll
    for (int off = 1; off < 64; off <<= 1) { const float y0 = __shfl_up(x0, off), y1 = __shfl_up(x1, off); if (lane >= off) { x0 += y0; x1 += y1; } }
    x1 += __shfl(x0, 63);
}
__device__ __forceinline__ void wave_scan_max128(float& x0, float& x1, int lane) {
#pragma unroll
    for (int off = 1; off < 64; off <<= 1) { const float y0 = __shfl_up(x0, off), y1 = __shfl_up(x1, off); if (lane >= off) { x0 = fmaxf(x0, y0); x1 = fmaxf(x1, y1); } }
    x1 = fmaxf(x1, __shfl(x0, 63));
}
__device__ __forceinline__ float wave_max(float v) {
#pragma unroll
    for (int o = 1; o < 64; o <<= 1) v = fmaxf(v, __shfl_xor(v, o));
    return v;
}

constexpr int ML1_LDS = 116736;
template <class UL>
__device__ __forceinline__ void ml1_item(const P& p, const Q2& q2, int l, int b, int ch, char* lds, const UL& U) {
    int tid_ = TIDX; asm volatile("" : "+v"(tid_));
    const int tid = tid_, wave = tid >> 6, lane = tid & 63, r32 = lane & 31, hi = lane >> 5;
    unsigned short* XCh = (unsigned short*)lds; unsigned short* UXh = (unsigned short*)(lds + 18432); unsigned short* QKVh = (unsigned short*)(lds + 36864);
    float* GP = (float*)(lds + 92160); float* GT = (float*)(lds + 108544);
    const int t0 = b * TPB + ch * 128, seg_lo = ch < NCH_CTX ? b * TPB : b * TPB + CTX, seg_hi = ch < NCH_CTX ? b * TPB + CTX : (b + 1) * TPB;
    const int rt = wave & 3, wh = wave >> 2;
    att::f32x16 gacc = {};
#pragma unroll 1
    for (int h = 0; h < 4; ++h) {
        { const int j = tid & 63, c = h * 64 + j, tb = (tid >> 6) * 16; const float* cw = p.in[I_MCW] + (size_t)l * 4 * 256 + c; const float w0 = cw[0], w1 = cw[256], w2 = cw[512], w3 = cw[768], cb = p.in[I_MCB][(size_t)l * 256 + c];
          float xm2 = (t0 + tb - 2 >= seg_lo) ? U(t0 + tb - 2, OFF_MX + c) : 0.f, xm1 = (t0 + tb - 1 >= seg_lo) ? U(t0 + tb - 1, OFF_MX + c) : 0.f, x0 = U(t0 + tb, OFF_MX + c);
#pragma unroll 4
          for (int i = 0; i < 16; ++i) { const int t = t0 + tb + i; const float xp1 = (t + 1 < seg_hi) ? U(t + 1, OFF_MX + c) : 0.f;
              const float v = fast_silu(cb + w0 * xm2 + w1 * xm1 + w2 * x0 + w3 * xp1); const unsigned short vb = (unsigned short)f2bf(v);
              XCh[(tb + i) * 72 + j] = vb; UXh[(tb + i) * 72 + j] = (unsigned short)f2bf(x0); xm2 = xm1; xm1 = x0; x0 = xp1; } }
        __syncthreads();
        { const bf16* Wm = q2.WtM + ((size_t)l * 4 + h) * 3 * 4096;
#pragma unroll
          for (int m = 0; m < 3; ++m) { att::f32x16 a = {};
              wave_mm32<4>(a, (m == 2 ? UXh : XCh) + rt * 32 * 72, 72, Wm + (size_t)m * 4096 + (size_t)wh * 32 * 64, 64, r32, hi);
#pragma unroll
              for (int r = 0; r < 16; ++r) { const int tt = rt * 32 + att::crow(r, hi); const unsigned short vb = (unsigned short)f2bf(a[r]);
                  QKVh[(m * 128 + tt) * 72 + wh * 32 + r32] = vb; } } }
        __syncthreads();
#pragma unroll
        for (int k = 0; k < 2; ++k) { const int x = tid + k * 512, tt = x >> 3, c8 = x & 7; *(u32x4*)(q2.XCM16 + (size_t)(t0 + tt) * 256 + h * 64 + c8 * 8) = *(const u32x4*)(XCh + tt * 72 + c8 * 8); }
#pragma unroll
        for (int k = 0; k < 6; ++k) { const int x = tid + k * 512, m = x >> 10, tt = (x >> 3) & 127, c8 = x & 7;
            *(u32x4*)(q2.QKV16 + (size_t)(t0 + tt) * 768 + m * 256 + h * 64 + c8 * 8) = *(const u32x4*)(QKVh + (m * 128 + tt) * 72 + c8 * 8); }
        { const bf16* Wg = q2.WtG + (size_t)l * 32 * 768;
#pragma unroll
          for (int x = 0; x < 6; ++x) { const int idx = wh * 6 + x, m = idx >> 2, ks = idx & 3;
              const att::bf16x8 a = *reinterpret_cast<const att::bf16x8*>(QKVh + (m * 128 + rt * 32 + r32) * 72 + ks * 16 + hi * 8);
              const att::bf16x8 bb = *reinterpret_cast<const att::bf16x8*>(Wg + (size_t)r32 * 768 + m * 256 + h * 64 + ks * 16 + hi * 8);
              gacc = __builtin_amdgcn_mfma_f32_32x32x16_bf16(a, bb, gacc, 0, 0, 0); } }
        __syncthreads();
    }
    if (r32 < 16) {
#pragma unroll
        for (int r = 0; r < 16; ++r) GP[(wh * 128 + rt * 32 + att::crow(r, hi)) * 16 + r32] = gacc[r]; }
    __syncthreads();
    for (int i = tid; i < 128 * 16; i += 512) { const int n = i & 15, d = n >> 3, g = n & 7; float v = GP[i] + GP[128 * 16 + i] + p.in[I_MBG][((size_t)l * 2 + d) * 8 + g];
        if (g >= 4) v = fminf(v, 0.f) - __logf(1.f + __expf(-fabsf(v)));
        GT[i] = v; q2.GATES[(size_t)(t0 + (i >> 4)) * 16 + n] = v; }
    __syncthreads();
    unsigned short* KT = (unsigned short*)lds; unsigned short* VT = (unsigned short*)(lds + 17408); float* WR = (float*)(lds + 52224); float* MB = (float*)(lds + 53248); float* WE = (float*)(lds + 53280);
#pragma unroll 1
    for (int h = 0; h < 4; ++h) {
        if (wave < 2) { const int d = wave, ta = d == 0 ? lane : 127 - lane, tb = d == 0 ? lane + 64 : 63 - lane;
            float b0 = GT[ta * 16 + d * 8 + 4 + h], b1 = GT[tb * 16 + d * 8 + 4 + h]; wave_scan_add128(b0, b1, lane);
            const float bL = __shfl(b1, 63), w0 = bL - b0 + GT[ta * 16 + d * 8 + h], w1 = bL - b1 + GT[tb * 16 + d * 8 + h];
            WR[d * 128 + ta] = w0; WR[d * 128 + tb] = w1; const float mx = wave_max(fmaxf(w0, w1));
            if (lane == 0) { MB[d * 2] = mx; MB[d * 2 + 1] = bL; } }
        __syncthreads();
        { const int tt = tid & 127, jg = tid >> 7; const float w0 = __expf(WR[tt] - MB[0]), w1 = __expf(WR[128 + tt] - MB[2]);
          const unsigned short* ksrc = (const unsigned short*)q2.QKV16 + (size_t)(t0 + tt) * 768 + 256 + h * 64 + jg * 16; const unsigned short* vsrc = ksrc + 256;
          const att::bf16x8 k0 = *reinterpret_cast<const att::bf16x8*>(ksrc), k1 = *reinterpret_cast<const att::bf16x8*>(ksrc + 8), v0 = *reinterpret_cast<const att::bf16x8*>(vsrc), v1 = *reinterpret_cast<const att::bf16x8*>(vsrc + 8);
#pragma unroll
          for (int i = 0; i < 8; ++i) { KT[(jg * 16 + i) * 136 + tt] = (unsigned short)k0[i]; KT[(jg * 16 + 8 + i) * 136 + tt] = (unsigned short)k1[i];
              const float va = bf2f((unsigned short)v0[i]), vb = bf2f((unsigned short)v1[i]);
              VT[(jg * 16 + i) * 136 + tt] = (unsigned short)f2bf(va * w0); VT[(jg * 16 + 8 + i) * 136 + tt] = (unsigned short)f2bf(vb * w0);
              VT[(64 + jg * 16 + i) * 136 + tt] = (unsigned short)f2bf(va * w1); VT[(64 + jg * 16 + 8 + i) * 136 + tt] = (unsigned short)f2bf(vb * w1); }
          if (tid < 128) WE[tid] = w0; else if (tid < 256) WE[tid] = w1; }
        __syncthreads();
        { const int d = wave >> 2, vt = (wave >> 1) & 1, kt = wave & 1; att::f32x16 c = {};
          wave_mm32<8>(c, VT + (size_t)(d * 64 + vt * 32) * 136, 136, KT + (size_t)kt * 32 * 136, 136, r32, hi);
          float* dst = q2.CLOC + ((((size_t)d * NB + b) * NCH + ch) * 4 + h) * 4096;
#pragma unroll
          for (int r = 0; r < 16; ++r) dst[(vt * 32 + att::crow(r, hi)) * 64 + kt * 32 + r32] = c[r];
          if (tid < 128) { const int dd = tid >> 6, k = tid & 63; float s = 0.f; for (int tt = 0; tt < 128; ++tt) s += WE[dd * 128 + tt] * bf2f(KT[k * 136 + tt]);
              q2.NLOC[((((size_t)dd * NB + b) * NCH + ch) * 4 + h) * 64 + k] = s; }
          if (tid < 2) { float* mb = q2.MLB + ((((size_t)tid * NB + b) * NCH + ch) * 4 + h) * 2; mb[0] = MB[tid * 2]; mb[1] = MB[tid * 2 + 1]; } }
        __syncthreads();
    }
}

__device__ __forceinline__ void ml_scan_item(const Q2& q2, int item, char* lds) {
    int tid_ = TIDX; asm volatile("" : "+v"(tid_));
    const int tid = tid_, vq = item & 3, h = (item >> 2) & 3, b = (item >> 4) & 1, d = item >> 5;
    float* MLs = (float*)lds; float* MSEQ = MLs + 2 * NCH + 16;
    for (int i = tid; i < NCH; i += 512) { const float* mb = q2.MLB + ((((size_t)d * NB + b) * NCH + ord_chunk(d, NCH, i)) * 4 + h) * 2; MLs[2 * i] = mb[0]; MLs[2 * i + 1] = mb[1]; }
    __syncthreads();
    if (tid == 0) { float m = 0.f; for (int i = 0; i < NCH; ++i) { MSEQ[i] = m; m = fmaxf(MLs[2 * i + 1] + m, MLs[2 * i]); } MSEQ[NCH] = m; }
    __syncthreads();
    const int e0 = vq * 1024 + tid * 2; float c0 = 0.f, c1 = 0.f, nn = 0.f; const bool don = (vq == 0 && tid < 64);
    static_assert(NCH % 11 == 0, "the scan streams the chunk contributions 11 at a time");
#pragma unroll 1
    for (int i0 = 0; i0 < NCH; i0 += 11) { float2 cl[11]; float nl[11];
#pragma unroll
        for (int x = 0; x < 11; ++x) { const size_t idx = (((size_t)d * NB + b) * NCH + ord_chunk(d, NCH, i0 + x)) * 4 + h; cl[x] = *(const float2*)(q2.CLOC + idx * 4096 + e0); nl[x] = don ? q2.NLOC[idx * 64 + tid] : 0.f; }
#pragma unroll
        for (int x = 0; x < 11; ++x) { const int i = i0 + x; const size_t idx = (((size_t)d * NB + b) * NCH + ord_chunk(d, NCH, i)) * 4 + h;
            *(unsigned*)(q2.CST + idx * 4096 + e0) = pk2(c0, c1);
            if (don) q2.NST[idx * 64 + tid] = nn;
            if (vq == 0 && tid == 64) q2.MST[idx] = MSEQ[i];
            const float m = MSEQ[i], mn = MSEQ[i + 1], dec = __expf(MLs[2 * i + 1] + m - mn), sc = __expf(MLs[2 * i] - mn);
            c0 = dec * c0 + sc * cl[x].x; c1 = dec * c1 + sc * cl[x].y; nn = dec * nn + sc * nl[x]; } }
    __syncthreads();
}

constexpr int ML2_LDS = 145536;
template <class UL, class YS>
__device__ __forceinline__ void ml2_item(const P& p, const Q2& q2, int l, int b, int ch, int h, char* lds, const UL& U, const YS& Y) {
    int tid_ = TIDX; asm volatile("" : "+v"(tid_));
    const int tid = tid_, wave = tid >> 6, lane = tid & 63, r32 = lane & 31, hi = lane >> 5;
    char* Ks = lds; char* Vs = lds + 32768; unsigned short* C0 = (unsigned short*)(lds + 49152); float* N0 = (float*)(lds + 67584); float* ROWV = (float*)(lds + 68096);
    float* COEF = (float*)(lds + 73216); float* M0 = (float*)(lds + 73792); float* WS = (float*)(lds + 73856) + wave * 64; float* HX = (float*)(lds + 75904);
    const int t0 = b * TPB + ch * 128;
    { const unsigned short* base = (const unsigned short*)q2.QKV16 + (size_t)t0 * 768 + h * 64;
#pragma unroll
      for (int x = 0; x < 2; ++x) { const int cidx = tid + x * 512, key = cidx >> 3, c8 = cidx & 7, tile = key >> 6, kk = key & 63;
          const att::bf16x8 kv = *reinterpret_cast<const att::bf16x8*>(base + (size_t)key * 768 + 256 + c8 * 8), vv = *reinterpret_cast<const att::bf16x8*>(base + (size_t)key * 768 + 512 + c8 * 8);
          *(att::bf16x8*)(Ks + tile * 16384 + (kk * 256 + ((c8 * 16) ^ ((kk & 7) << 4)))) = kv;
          *(att::bf16x8*)(Vs + tile * 8192 + att::v_st(kk, c8 * 8)) = vv; } }
    if (wave < 2) { const int d = wave, ta = d == 0 ? lane : 127 - lane, tb = d == 0 ? lane + 64 : 63 - lane;
        float* g = ROWV + (d * 5 + 0) * 128; float* pmv = ROWV + (d * 5 + 1) * 128; float* bv = ROWV + (d * 5 + 2) * 128;
        const float iga = q2.GATES[(size_t)(t0 + ta) * 16 + d * 8 + h], igb = q2.GATES[(size_t)(t0 + tb) * 16 + d * 8 + h];
        float b0 = q2.GATES[(size_t)(t0 + ta) * 16 + d * 8 + 4 + h], b1 = q2.GATES[(size_t)(t0 + tb) * 16 + d * 8 + 4 + h]; wave_scan_add128(b0, b1, lane);
        const float g0 = iga - b0, g1 = igb - b1; float p0 = g0, p1 = g1; wave_scan_max128(p0, p1, lane);
        g[ta] = g0; g[tb] = g1; pmv[ta] = p0; pmv[tb] = p1; bv[ta] = b0; bv[tb] = b1; }
    __syncthreads();
    { const int d = tid >> 8, e0 = (tid & 255) * 16; const size_t idx = (((size_t)d * NB + b) * NCH + ch) * 4 + h;
      const u32x4* src = (const u32x4*)(q2.CST + idx * 4096 + e0); const u32x4 w0 = src[0], w1 = src[1];
      { const int v = e0 >> 6, k = e0 & 63; unsigned short* dst = C0 + (d * 64 + v) * 72 + k; *(u32x4*)dst = w0; *(u32x4*)(dst + 8) = w1; }
      if (tid < 128) { const int nd = tid >> 6, nk = tid & 63; N0[nd * 64 + nk] = q2.NST[((((size_t)nd * NB + b) * NCH + ch) * 4 + h) * 64 + nk]; }
      if (tid < 2) M0[tid] = q2.MST[(((size_t)tid * NB + b) * NCH + ch) * 4 + h]; }
    __syncthreads();
    {
      if (tid < 256) { const int dd = tid >> 7, tt = tid & 127; const float m0 = M0[dd], M = fmaxf(m0, ROWV[(dd * 5 + 1) * 128 + tt]);
          ROWV[(dd * 5 + 1) * 128 + tt] = M; ROWV[(dd * 5 + 3) * 128 + tt] = __expf(m0 - M); ROWV[(dd * 5 + 4) * 128 + tt] = __expf(-(ROWV[(dd * 5 + 2) * 128 + tt] + M)); } }
    __syncthreads();
    { const int qb = wave & 3, d = wave >> 2; const float* g = ROWV + (d * 5 + 0) * 128; const float* Mv = ROWV + (d * 5 + 1) * 128; const float* wiv = ROWV + (d * 5 + 3) * 128; const float* emtv = ROWV + (d * 5 + 4) * 128;
      att::bf16x8 qr[4]; const int sq = qb * 32 + r32;
      { const unsigned short* qw = (const unsigned short*)q2.QKV16 + (size_t)(t0 + sq) * 768 + h * 64 + hi * 8;
#pragma unroll
        for (int d0 = 0; d0 < 4; ++d0) qr[d0] = *reinterpret_cast<const att::bf16x8*>(qw + d0 * 16); }
      const float Ms = Mv[sq] * 1.4426950408889634f; att::f32x16 o[2] = {}; float rs = 0.f;
      const int vb0 = (int)(uintptr_t)Vs + att::v_rd_base(lane);
#pragma unroll
      for (int kt = 0; kt < 2; ++kt) {
          const bool skip = d == 0 ? (kt == 1 && qb < 2) : (kt == 0 && qb >= 2);
          if (!skip) {
              att::f32x16 p0 = {}, p1 = {}; const char* Kt = Ks + kt * 16384;
#pragma unroll
              for (int d0 = 0; d0 < 4; ++d0) { const int cb = (d0 * 16 + hi * 8) * 2;
                  const att::bf16x8 b0 = *reinterpret_cast<const att::bf16x8*>(Kt + (r32 * 256 + (cb ^ ((r32 & 7) << 4))));
                  const att::bf16x8 b1 = *reinterpret_cast<const att::bf16x8*>(Kt + ((32 + r32) * 256 + (cb ^ ((r32 & 7) << 4))));
                  p0 = __builtin_amdgcn_mfma_f32_32x32x16_bf16(b0, qr[d0], p0, 0, 0, 0); p1 = __builtin_amdgcn_mfma_f32_32x32x16_bf16(b1, qr[d0], p1, 0, 0, 0); }
#pragma unroll
              for (int r = 0; r < 16; ++r) { const int k0 = kt * 64 + att::crow(r, hi), k1 = k0 + 32;
                  const bool ok0 = d == 0 ? k0 <= sq : k0 >= sq, ok1 = d == 0 ? k1 <= sq : k1 >= sq;
                  p0[r] = ok0 ? p0[r] * __builtin_amdgcn_exp2f(g[k0] * 1.4426950408889634f - Ms) : 0.f; p1[r] = ok1 ? p1[r] * __builtin_amdgcn_exp2f(g[k1] * 1.4426950408889634f - Ms) : 0.f;
                  rs += p0[r] + p1[r]; }
              att::bf16x8 pa0, pa1, pa2, pa3;
#define PK4(P, BASE, OUT) do { unsigned a0 = att::cvtpk(P[BASE + 0], P[BASE + 1]), a1 = att::cvtpk(P[BASE + 2], P[BASE + 3]);   \
    unsigned b0 = att::cvtpk(P[BASE + 4], P[BASE + 5]), b1 = att::cvtpk(P[BASE + 6], P[BASE + 7]);                              \
    auto r0 = __builtin_amdgcn_permlane32_swap(a0, b0, false, false); auto r1 = __builtin_amdgcn_permlane32_swap(a1, b1, false, false); \
    att::u32x4 w = {r0[0], r1[0], r0[1], r1[1]}; OUT = *reinterpret_cast<att::bf16x8*>(&w); } while (0)
              PK4(p0, 0, pa0); PK4(p0, 8, pa1); PK4(p1, 0, pa2); PK4(p1, 8, pa3);
#undef PK4
              att::pv_d0(o, vb0 + kt * 8192, pa0, pa1, pa2, pa3);
          }
      }
      att::f32x16 ic[2] = {};
#pragma unroll
      for (int vt = 0; vt < 2; ++vt)
#pragma unroll
          for (int d0 = 0; d0 < 4; ++d0) { const att::bf16x8 cb = *reinterpret_cast<const att::bf16x8*>(C0 + (d * 64 + vt * 32 + r32) * 72 + d0 * 16 + hi * 8);
              ic[vt] = __builtin_amdgcn_mfma_f32_32x32x16_bf16(qr[d0], cb, ic[vt], 0, 0, 0); }
      float nq = 0.f;
#pragma unroll
      for (int d0 = 0; d0 < 4; ++d0)
#pragma unroll
          for (int x = 0; x < 8; ++x) nq += bf2f((unsigned short)qr[d0][x]) * N0[d * 64 + d0 * 16 + hi * 8 + x];
      { auto rr = __builtin_amdgcn_permlane32_swap(__float_as_uint(nq), __float_as_uint(nq), false, false); nq = __uint_as_float(rr[0]) + __uint_as_float(rr[1]); }
      { auto rr = __builtin_amdgcn_permlane32_swap(__float_as_uint(rs), __float_as_uint(rs), false, false); rs = __uint_as_float(rr[0]) + __uint_as_float(rr[1]); }
      const float den = rs + wiv[sq] * nq, dn = fmaxf(fabsf(den), emtv[sq]);
      if (hi == 0) WS[r32] = __builtin_amdgcn_rcpf(dn);
      asm volatile("s_waitcnt lgkmcnt(0)" ::: "memory");
#pragma unroll
      for (int r = 0; r < 16; ++r) { const int row = att::crow(r, hi), tt = qb * 32 + row; const float inv = WS[row], wi = wiv[tt];
#pragma unroll
          for (int vt = 0; vt < 2; ++vt) HX[(d * 128 + tt) * 68 + vt * 32 + r32] = (o[vt][r] + wi * ic[vt][r]) * inv; }
    }
    __syncthreads();
    { const int tt = tid >> 2, v0 = (tid & 3) * 16, t = t0 + tt; float hv[16]; float s = 0.f;
#pragma unroll
      for (int i = 0; i < 16; ++i) { hv[i] = HX[tt * 68 + v0 + i] + HX[(128 + tt) * 68 + v0 + i]; s += hv[i]; }
      s += __shfl_xor(s, 1); s += __shfl_xor(s, 2); const float mu = s * (1.f / 64.f); float vs = 0.f;
#pragma unroll
      for (int i = 0; i < 16; ++i) { hv[i] -= mu; vs += hv[i] * hv[i]; }
      vs += __shfl_xor(vs, 1); vs += __shfl_xor(vs, 2); const float rstd = 1.f / sqrtf(vs * (1.f / 64.f) + EPS);
#pragma unroll
      for (int i = 0; i < 16; ++i) { const int c = h * 64 + v0 + i;
          const float y = hv[i] * rstd * p.in[I_MNG][(size_t)l * 256 + c] + p.in[I_MSK][(size_t)l * 256 + c] * bf2f(q2.XCM16[(size_t)t * 256 + c]);
          Y(t, 768 + c, y * fast_silu(U(t, OFF_MZ + c))); } }
    __syncthreads();
}
typedef float f32x4_t __attribute__((ext_vector_type(4)));

__device__ __forceinline__ void row_norm_mod(f32x4 (&v)[4], const float* g, const float* sc, const float* sh, int lane) {
    float s = 0.f;
#pragma unroll
    for (int j = 0; j < 4; ++j) s += (v[j].x * v[j].x + v[j].y * v[j].y) + (v[j].z * v[j].z + v[j].w * v[j].w);
    const float rstd = 1.f / sqrtf(wave_sum(s) * (1.f / D) + EPS);
#pragma unroll
    for (int j = 0; j < 4; ++j) { const int k = (j * 64 + lane) * 4; const f32x4 gv = *(const f32x4*)(g + k);
        if (sc) { const f32x4 scv = *(const f32x4*)(sc + k), shv = *(const f32x4*)(sh + k); v[j] = v[j] * rstd * gv * (scv + 1.f) + shv; } else v[j] = v[j] * rstd * gv; }
}
__device__ __forceinline__ void row_store_bf16(bf16* dst, const f32x4 (&v)[4], int lane) {
#pragma unroll
    for (int j = 0; j < 4; ++j) { u32x2 w; w.x = pk2(v[j].x, v[j].y); w.y = pk2(v[j].z, v[j].w); *(u32x2*)(dst + (j * 64 + lane) * 4) = w; }
}
__device__ __forceinline__ void rp_first(const P& p, const Q& q, int gw, int ngw, int lane) {
    for (int t = gw; t < NT; t += ngw) { const int b = t / TPB, i = t % TPB; const float* src = i < CTX ? p.in[I_CTX] + ((size_t)b * CTX + i) * D : p.in[I_X] + ((size_t)b * SEQ + (i - CTX)) * D;
        f32x4 v[4];
#pragma unroll
        for (int j = 0; j < 4; ++j) v[j] = *(const f32x4*)(src + (j * 64 + lane) * 4);
        const int cv = tok_cv(t); row_norm_mod(v, p.in[I_N1G], modp(p, 0, cv, 1), modp(p, 0, cv, 0), lane); row_store_bf16(q.H16 + (size_t)t * D, v, lane); }
}
__device__ __forceinline__ void rp_end(const P& p, const Q& q, const Q2& q2, int l, int gw, int ngw, int lane, float probe_scale = 1.f) {
    const bool last = l + 1 == DEPTH; const int nrows = last ? NB * SEQ : NT;
    for (int r_ = gw; r_ < nrows; r_ += ngw) { const int t = last ? (r_ / SEQ) * TPB + CTX + r_ % SEQ : r_; const int cv = tok_cv(t); const float* g2 = modp(p, l, cv, 5); f32x4 v[4];
#pragma unroll
        for (int j = 0; j < 4; ++j) { const int k = (j * 64 + lane) * 4; f32x4 s = {0.f, 0.f, 0.f, 0.f};
#pragma unroll
            for (int e = 0; e < 4; ++e) { const u32x2 w = *(const u32x2*)(q2.YB16 + ((size_t)t * 4 + e) * D + k);
                s.x += __builtin_bit_cast(float, w.x << 16); s.y += __builtin_bit_cast(float, w.x & 0xffff0000u); s.z += __builtin_bit_cast(float, w.y << 16); s.w += __builtin_bit_cast(float, w.y & 0xffff0000u); }
            v[j] = *(const f32x4*)(p.X + (size_t)t * D + k) + *(const f32x4*)(g2 + k) * s * probe_scale; }
        if (l + 1 < DEPTH) {
#pragma unroll
            for (int j = 0; j < 4; ++j) *(f32x4*)(p.X + (size_t)t * D + (j * 64 + lane) * 4) = v[j];
            row_norm_mod(v, p.in[I_N1G] + (size_t)(l + 1) * D, modp(p, l + 1, cv, 1), modp(p, l + 1, cv, 0), lane); row_store_bf16(q.H16 + (size_t)t * D, v, lane);
        } else { const int b = t / TPB, i = t % TPB; if (i < CTX) continue;
            row_norm_mod(v, p.in[I_FG], nullptr, nullptr, lane);
#pragma unroll
            for (int j = 0; j < 4; ++j) *(f32x4*)(p.out + ((size_t)b * SEQ + (i - CTX)) * D + (j * 64 + lane) * 4) = v[j]; }
    }
}
constexpr int RPM_LDS = 89024;
__device__ __forceinline__ void rp_mid(const P& p, const Q& q, float* GLIST, int l, char* lds, int G, int bid, bool latent_only, bool probe_nolist = false) {
    int tid_ = TIDX; asm volatile("" : "+v"(tid_));
    const int tid = tid_, wave = tid >> 6, lane = tid & 63;
    float* HS = (float*)lds; float* PART = (float*)(lds + 65664); float* LG = (float*)(lds + 82048); int* LCNT = (int*)(lds + 84096); int* LBASE = (int*)(lds + 84224); int* PEND = (int*)(lds + 84352); int* NPEND = (int*)(lds + 88960);
    if (tid < 32) LCNT[tid] = 0; if (tid == 32) NPEND[0] = 0;
    float B0[32], B1[32]; const float* Wr = p.in[I_WR] + (size_t)l * D * NE;
#pragma unroll
    for (int ks = 0; ks < 32; ++ks) { const int k = 128 * wave + 4 * ks + (lane >> 4); B0[ks] = Wr[(size_t)k * NE + (lane & 15)]; B1[ks] = Wr[(size_t)k * NE + 16 + (lane & 15)]; }
    __syncthreads();
    const int nitems = latent_only ? NB * SEQ / 16 : NT / 16;
    for (int it_ = bid; it_ < nitems; it_ += G) { const int it = latent_only ? (it_ / (SEQ / 16)) * (TPB / 16) + CTX / 16 + it_ % (SEQ / 16) : it_;
#pragma unroll 1
        for (int rr = 0; rr < 2; ++rr) { const int row = 2 * wave + rr, t = it * 16 + row, cv = tok_cv(t); f32x4 v[4];
#pragma unroll
            for (int j = 0; j < 4; ++j) v[j] = *(const f32x4*)(p.X + (size_t)t * D + (j * 64 + lane) * 4);
            row_norm_mod(v, p.in[I_N2G] + (size_t)l * D, modp(p, l, cv, 4), modp(p, l, cv, 3), lane); row_store_bf16(q.H16 + (size_t)t * D, v, lane);
#pragma unroll
            for (int j = 0; j < 4; ++j) { float* d = HS + row * 1026 + (j * 64 + lane) * 4; *(float2*)d = make_float2(v[j].x, v[j].y); *(float2*)(d + 2) = make_float2(v[j].z, v[j].w); } }
        __syncthreads();
        { f32x4_t a0 = {0.f, 0.f, 0.f, 0.f}, a1 = a0; const float* hrow = HS + (lane & 15) * 1026 + 128 * wave + (lane >> 4);
#pragma unroll
          for (int ks = 0; ks < 32; ++ks) { const float a = hrow[4 * ks]; a0 = __builtin_amdgcn_mfma_f32_16x16x4f32(a, B0[ks], a0, 0, 0, 0); a1 = __builtin_amdgcn_mfma_f32_16x16x4f32(a, B1[ks], a1, 0, 0, 0); }
#pragma unroll
          for (int r = 0; r < 4; ++r) { const int row = (lane >> 4) * 4 + r; PART[(wave * 16 + row) * 32 + (lane & 15)] = a0[r]; PART[(wave * 16 + row) * 32 + 16 + (lane & 15)] = a1[r]; } }
        __syncthreads();
        { float s = p.in[I_BR][(size_t)l * NE + (tid & 31)];
#pragma unroll
          for (int w = 0; w < 8; ++w) s += PART[w * 512 + tid];
          LG[tid] = s; }
        __syncthreads();
        if (tid < 16) { const int t = it * 16 + tid; float lg[NE];
#pragma unroll
            for (int e = 0; e < NE; ++e) lg[e] = LG[tid * 32 + e];
            int te[TOPK]; float tv[TOPK];
#pragma unroll
            for (int r = 0; r < TOPK; ++r) { float best = -3.0e38f; int bi = 0;
#pragma unroll
                for (int e = 0; e < NE; ++e) { const bool c = lg[e] > best; best = c ? lg[e] : best; bi = c ? e : bi; }
                te[r] = bi; tv[r] = best;
#pragma unroll
                for (int e = 0; e < NE; ++e) lg[e] = (e == bi) ? -3.0e38f : lg[e]; }
            float ssum = 0.f, ex[TOPK];
#pragma unroll
            for (int r = 0; r < TOPK; ++r) { ex[r] = __expf(tv[r] - tv[0]); ssum += ex[r]; }
            const float inv = 1.f / ssum;
#pragma unroll
            for (int r = 0; r < TOPK; ++r) { p.TOPG[t * TOPK + r] = ex[r] * inv; const int lp = atomicAdd(&LCNT[te[r]], 1); const int slot = atomicAdd(NPEND, 1);
                PEND[slot * 3] = t * TOPK + r; PEND[slot * 3 + 1] = (te[r] << 16) | lp; PEND[slot * 3 + 2] = __float_as_int(ex[r] * inv); } }
        __syncthreads();
    }
    if (probe_nolist) return;
    if (tid < 32) LBASE[tid] = LCNT[tid] > 0 ? atomicAdd(&p.CNT[tid], LCNT[tid]) : 0;
    __syncthreads();
    for (int i = tid; i < NPEND[0]; i += 512) { const int pr = PEND[i * 3], x = PEND[i * 3 + 1], e = x >> 16, lp = x & 0xffff; p.LIST[(size_t)e * NT + LBASE[e] + lp] = pr; GLIST[(size_t)e * NT + LBASE[e] + lp] = __int_as_float(PEND[i * 3 + 2]); }
    __syncthreads();
}
struct EpiDown16 {
    static constexpr bool PERM = true; bf16* YB; const float* bd; const float* GL; const int* CNT; const int* LIST; int nN; int probe_skip;
    __device__ __forceinline__ void operator()(const pg8::f32x4 (&acc)[2][2][4][2], const pg8::Unit& u, int wr, int wc, int fr, int fq) const {
        if (probe_skip) return;
        const int ntile = u.pn - u.e * nN, cnt = CNT[u.e]; const float* b = bd + (size_t)u.e * D;
        int pr[2][4]; float gt[2][4];
#pragma unroll
        for (int ai = 0; ai < 2; ++ai)
#pragma unroll
            for (int m = 0; m < 4; ++m) { const int idx = u.mb * 256 + ai * 128 + wr * 64 + m * 16 + fr, ic = idx < cnt ? idx : 0; pr[ai][m] = LIST[(size_t)u.e * NT + ic]; gt[ai][m] = GL[(size_t)u.e * NT + ic]; }
        pg8::f32x4 bv[2][2];
#pragma unroll
        for (int bj = 0; bj < 2; ++bj) { const int c = ntile * 256 + bj * 128 + wc * 32 + 8 * fq; bv[bj][0] = *(const pg8::f32x4*)(b + c); bv[bj][1] = *(const pg8::f32x4*)(b + c + 4); }
#pragma unroll
        for (int ai = 0; ai < 2; ++ai)
#pragma unroll
            for (int m = 0; m < 4; ++m) { const int idx = u.mb * 256 + ai * 128 + wr * 64 + m * 16 + fr;
                if (idx < cnt) { const float g = gt[ai][m];
#pragma unroll
                    for (int bj = 0; bj < 2; ++bj) { const int c = ntile * 256 + bj * 128 + wc * 32 + 8 * fq;
                        const pg8::f32x4 v0 = (acc[ai][bj][m][0] + bv[bj][0]) * g, v1 = (acc[ai][bj][m][1] + bv[bj][1]) * g;
                        u32x4 w; w.x = pg8::cvt_pk_bf16(v0[0], v0[1]); w.y = pg8::cvt_pk_bf16(v0[2], v0[3]); w.z = pg8::cvt_pk_bf16(v1[0], v1[1]); w.w = pg8::cvt_pk_bf16(v1[2], v1[3]);
                        *(u32x4*)(YB + (size_t)pr[ai][m] * D + c) = w; } } }
    }
};
__device__ __forceinline__ void opt_moe_down16(const P& p, const Q& q, const Q2& q2, int l, LAS unsigned char* lds, int G, int bid, int probe_skip = 0) {
    pg8::Gemm g{q.ACT16, q.WtDn + (size_t)l * NE * D * DE, DE}; DnOrder S; S.init(p.CNT, p.LIST, D / 256, G, bid, (LAS int*)(lds + pg8::STAGE_BYTES));
    EpiDown16 E{q2.YB16, p.in[I_BD] + (size_t)l * NE * D, q2.GLIST, p.CNT, p.LIST, D / 256, probe_skip}; pg8::gemm_phase<EpiDown16, DnOrder, true>(lds, g, S, E);
}
#define GAS __attribute__((address_space(1)))
typedef GAS unsigned gu32;
#define XB_TMO      128
#define XB_XCNT(j)  (256  + 64 * (j))
#define XB_XSUB(j)  (1280 + 64 * (j))
#define XB_XGEN(j)  (2304 + 64 * (j))
#define XB_TOP      3328
#define XB_TOPGEN   3392
#define XCD_BAR_WORDS 3456
#define XB_SPIN_CAP (1u << 18)

__device__ __forceinline__ unsigned xb_ld(unsigned* p)              { return __hip_atomic_load(p, __ATOMIC_RELAXED, __HIP_MEMORY_SCOPE_AGENT); }
__device__ __forceinline__ unsigned xb_add(unsigned* p, unsigned v) { return __hip_atomic_fetch_add(p, v, __ATOMIC_RELAXED, __HIP_MEMORY_SCOPE_AGENT); }
__device__ __forceinline__ unsigned xb_xcc_id() { return (unsigned)__builtin_amdgcn_s_getreg((3 << 11) | 20) & 0xFu; }
#define XB_SPIN(cond, bar) do { unsigned _sp = 0; while (cond) { __builtin_amdgcn_s_sleep(1); \
    if ((++_sp & 255u) == 0u) { if (xb_ld(&(bar)[XB_TMO])) break; if (_sp > XB_SPIN_CAP) { atomicAdd(&(bar)[XB_TMO], 1u); break; } } } } while (0)

struct XcdBarrier {
    unsigned* bar; unsigned x;
    volatile LAS unsigned* st;
};

__device__ __forceinline__ XcdBarrier xcd_barrier_post(unsigned* bar, volatile LAS unsigned* st) {
    XcdBarrier b; b.bar = bar; b.x = xb_xcc_id(); b.st = st;
    if (TIDX == 0) (void)xb_add(&bar[XB_XCNT(b.x)], 1u);
    return b;
}
__device__ __forceinline__ void xcd_barrier_complete(unsigned* bar, unsigned x, unsigned& nloc, unsigned& nx) {
    const unsigned G = gridDim.x * gridDim.y * gridDim.z;
    unsigned sum, cnt, mine, sp = 0u;
    for (;;) {
        sum = 0u; cnt = 0u; mine = 0u;
#pragma unroll
        for (unsigned j = 0; j < 16; ++j) { const unsigned c = xb_ld(&bar[XB_XCNT(j)]); sum += c; cnt += (c > 0u) ? 1u : 0u; mine = (j == x) ? c : mine; }
        if (sum == G) break;
        __builtin_amdgcn_s_sleep(1);
        if ((++sp & 255u) == 0u) { if (xb_ld(&bar[XB_TMO])) break; if (sp > XB_SPIN_CAP) { atomicAdd(&bar[XB_TMO], 1u); break; } }
    }
    nloc = mine > 0u ? mine : 1u; nx = cnt > 0u ? cnt : 1u;
}

__device__ __forceinline__ void xcd_barrier(const XcdBarrier& b) {
    asm volatile("s_waitcnt vmcnt(0)" ::: "memory");
    __syncthreads();
    if (TIDX == 0) {
        unsigned* bar = b.bar;
        __builtin_amdgcn_s_waitcnt(0);
        unsigned nloc = b.st[0], nx = b.st[1];
        if (nloc == 0u) { xcd_barrier_complete(bar, b.x, nloc, nx); b.st[0] = nloc; b.st[1] = nx; }
        const unsigned old = xb_add(&bar[XB_XSUB(b.x)], 1u);
        const unsigned gen = old / nloc;
        if (old + 1u == (gen + 1u) * nloc) {
            __builtin_amdgcn_fence(__ATOMIC_RELEASE, "agent");
            asm volatile("s_waitcnt vmcnt(0)" ::: "memory");
            const unsigned og = xb_add(&bar[XB_TOP], 1u);
            const unsigned tg = og / nx;
            if (og + 1u == (tg + 1u) * nx) xb_add(&bar[XB_TOPGEN], 1u);
            else XB_SPIN(xb_ld(&bar[XB_TOPGEN]) == tg, bar);
            __builtin_amdgcn_fence(__ATOMIC_ACQUIRE, "agent");
            xb_add(&bar[XB_XGEN(b.x)], 1u);
            asm volatile("s_waitcnt vmcnt(0)" ::: "memory");
        } else {
            XB_SPIN(xb_ld(&bar[XB_XGEN(b.x)]) == gen, bar);
            __builtin_amdgcn_fence(__ATOMIC_ACQUIRE, "agent");
            asm volatile("s_waitcnt vmcnt(0)" ::: "memory");
        }
    }
    __syncthreads();
}
#include <hip/hip_cooperative_groups.h>
#include <cstdio>
namespace cg = cooperative_groups;
#ifndef ONE_LAUNCH
#define ONE_LAUNCH 1
#endif
constexpr int LDS_BYTES = 148480;
static_assert(ML2_LDS <= LDS_BYTES && ML1_LDS <= LDS_BYTES && LRU1_LDS <= LDS_BYTES && RPM_LDS <= LDS_BYTES && att::SHM_ATTN <= LDS_BYTES && pg8::STAGE_BYTES + 1024 + 8192 <= LDS_BYTES - 64, "LDS map");

struct BMap { size_t off[64]; size_t total; };
static inline BMap b_map() {
    BMap m; size_t o = 0; int i = 0;
    auto add = [&](size_t bytes) { m.off[i++] = o; o += (bytes + 255) & ~(size_t)255; };
    add((size_t)DEPTH * 3 * 6 * D * 4);
    add((size_t)SEQ * 16 * 2 * 4);
    add((size_t)NT * D * 4);
    add((size_t)NT * TOPK * 4);
    add((size_t)256);
    add((size_t)NE * NT * 4);
    add((size_t)DEPTH * DINP * D * 2);
    add((size_t)DEPTH * D * DMIX * 2);
    add((size_t)DEPTH * NE * 2 * DE * D * 2);
    add((size_t)DEPTH * NE * D * DE * 2);
    add((size_t)DEPTH * 768 * QRANK * 2);
    add((size_t)DEPTH * 1024 * KVRANK * 2);
    add((size_t)NT * D * 2);
    add((size_t)NT * DMIX * 2);
    add((size_t)SLOT_MAX * DE * 2);
    add((size_t)NT * AH * QKD * 2);
    add((size_t)NT * AH * VD * 2);
    add((size_t)NT * DINP * 2);
    add((size_t)DEPTH * 4 * 256 * 64 * 2);
    add((size_t)DEPTH * 4 * 3 * 4096 * 2);
    add((size_t)DEPTH * 32 * 768 * 2);
    add((size_t)DEPTH * 2 * 256 * 4);
    add((size_t)2 * NT * 256 * 4);
    add((size_t)2 * NT * 256 * 4);
    add((size_t)2 * NB * NCH * 256 * 4);
    add((size_t)2 * NB * NCH * 256 * 4);
    add((size_t)2 * NT * 256 * 2);
    add((size_t)256);
    add((size_t)NT * 768 * 2);
    add((size_t)DEPTH * 1792 * 256 * 2);
    add((size_t)NT * 256 * 2);
    add((size_t)NT * 768 * 2);
    add((size_t)NT * 16 * 4);
    add((size_t)2 * NB * NCH * 4 * 4096 * 4);
    add((size_t)2 * NB * NCH * 4 * 64 * 4);
    add((size_t)2 * NB * NCH * 4 * 2 * 4);
    add((size_t)NT * TOPK * D * 2);
    add((size_t)XCD_BAR_WORDS * 4);
    add((size_t)2 * NB * NCH * 4 * 4096 * 2);
    add((size_t)2 * NB * NCH * 4 * 64 * 4);
    add((size_t)2 * NB * NCH * 4 * 4);
    add((size_t)NE * NT * 4);
    m.total = o; return m;
}
struct Args { P p; Q q; Q2 q2; unsigned* bar; };
static inline void fill_args(Args& a, void* const* d_in, void* d_out, void* d_ws) {
    for (int i = 0; i < N_IN; ++i) a.p.in[i] = (const float*)d_in[i];
    a.p.out = (float*)d_out; char* w = (char*)d_ws; const BMap m = b_map();
    a.p.MOD = (float*)(w + m.off[0]); a.p.ROPET = (float*)(w + m.off[1]); a.p.X = (float*)(w + m.off[2]); a.p.TOPG = (float*)(w + m.off[3]); a.p.CNT = (int*)(w + m.off[4]); a.p.LIST = (int*)(w + m.off[5]);
    a.q.WtIn = (bf16*)(w + m.off[6]); a.q.WtOut = (bf16*)(w + m.off[7]); a.q.WtGu = (bf16*)(w + m.off[8]); a.q.WtDn = (bf16*)(w + m.off[9]); a.q.WtQb = (bf16*)(w + m.off[10]); a.q.WtKvb = (bf16*)(w + m.off[11]);
    a.q.H16 = (bf16*)(w + m.off[12]); a.q.Y16 = (bf16*)(w + m.off[13]); a.q.ACT16 = (bf16*)(w + m.off[14]); a.q.K16 = (bf16*)(w + m.off[15]); a.q.V16 = (bf16*)(w + m.off[16]);
    a.q2.U16 = (bf16*)(w + m.off[17]); a.q2.WtL = (bf16*)(w + m.off[18]); a.q2.WtM = (bf16*)(w + m.off[19]); a.q2.WtG = (bf16*)(w + m.off[20]); a.q2.LSL = (float*)(w + m.off[21]);
    a.q2.HLOC = (bf16*)(w + m.off[22]); a.q2.PCUM = (bf16*)(w + m.off[23]); a.q2.SA = (float*)(w + m.off[24]); a.q2.SB = (float*)(w + m.off[25]);
    a.q2.QN16 = (bf16*)(w + m.off[26]); a.q2.KVN16 = a.q2.QN16 + (size_t)NT * 256;     a.q2.Q16 = (bf16*)(w + m.off[28]); a.q2.WtKvbP = (bf16*)(w + m.off[29]);
    a.q2.XCM16 = (bf16*)(w + m.off[30]); a.q2.QKV16 = (bf16*)(w + m.off[31]); a.q2.GATES = (float*)(w + m.off[32]); a.q2.CLOC = (float*)(w + m.off[33]); a.q2.NLOC = (float*)(w + m.off[34]); a.q2.MLB = (float*)(w + m.off[35]);
    a.q2.YB16 = (bf16*)(w + m.off[36]); a.bar = (unsigned*)(w + m.off[37]); a.q2.CST = (bf16*)(w + m.off[38]); a.q2.NST = (float*)(w + m.off[39]); a.q2.MST = (float*)(w + m.off[40]); a.q2.GLIST = (float*)(w + m.off[41]);
}

struct ULoad16 { const bf16* U; __device__ __forceinline__ float operator()(int t, int col) const { return bf2f(U[(size_t)t * DINP + col]); } };
struct YStore16 { bf16* Y; __device__ __forceinline__ void operator()(int t, int col, float v) const { Y[(size_t)t * DMIX + col] = (bf16)f2bf(v); } };
struct OutY16 { bf16* y; __device__ __forceinline__ void operator()(int row, int col, float v) const { y[(size_t)row * DMIX + col] = (bf16)f2bf(v); } };

enum { ST_INIT = 0, ST_RPFIRST, ST_INPROJ, ST_PREP, ST_MLAPROJ, ST_MIX, ST_OUTPROJ, ST_RPMID, ST_GU, ST_DOWN, ST_RPEND, N_ST };

typedef const __attribute__((address_space(4))) Args* KArgs;
__device__ __forceinline__ KArgs kargs() { KArgs k = (KArgs)__builtin_amdgcn_kernarg_segment_ptr(); asm volatile("" : "+s"(k)); return k; }
__device__ __forceinline__ void run_step(const Args& a, int step, int l_, unsigned char* lds_raw) {
    const int l = l_ & 0xff, sub = l_ >> 8;
    const P& p = a.p; const Q& q = a.q; const Q2& q2 = a.q2;
    LAS unsigned char* lds = (LAS unsigned char*)lds_raw; char* ldsg = (char*)lds_raw;
    int G_ = gridDim.x, bid_ = blockIdx.x; asm volatile("" : "+s"(G_), "+s"(bid_));
    const int G = G_, bid = bid_;
#define THREAD_IDS int tid_ = TIDX; asm volatile("" : "+v"(tid_)); const int tid = tid_, lane = tid & 63, wave = __builtin_amdgcn_readfirstlane(tid >> 6); \
    const int gw = bid * NWAVES + wave, ngw = G * NWAVES; const long gtid = (long)bid * NTHREADS + tid, nthr = (long)G * NTHREADS; (void)lane; (void)gw; (void)ngw; (void)gtid; (void)nthr;
    switch (step) {
    case ST_INIT: { THREAD_IDS
        opt_init_mod(p, ldsg, bid, G); opt_init_rope(p, gtid, nthr); opt_convert_small(p, q2, gtid, nthr); opt_convert_weights(p, q, q2.WtKvbP, lds, gw, ngw, wave, lane); break; }
    case ST_RPFIRST: { THREAD_IDS rp_first(p, q, gw, ngw, lane); break; }
    case ST_INPROJ: opt_inproj16(q, q2, l, lds, G, bid); break;
    case ST_PREP: { THREAD_IDS
        if (gtid < NE) p.CNT[gtid] = 0;
        const ULoad16 U{q2.U16};
        constexpr int NM = NB * NCH, NL = NB * NCH * 4;
        if (G > NM + 8) {
            if (bid < NM) { if (sub == 0 || (sub & 1)) ml1_item(p, q2, l, bid / NCH, bid % NCH, ldsg, U);
                if (sub == 0 || (sub & 2)) lru1_item(p, q2, l, (bid >> 2) / NCH, (bid >> 2) % NCH, bid & 3, ldsg, U); }
            else if (sub == 0 || (sub & 2)) for (int x = NM + (bid - NM); x < NL; x += G - NM) lru1_item(p, q2, l, (x >> 2) / NCH, (x >> 2) % NCH, x & 3, ldsg, U);
        } else for (int it = bid; it < NM + NL; it += G) {
            if (it < NM) { if (sub == 0 || (sub & 1)) ml1_item(p, q2, l, it / NCH, it % NCH, ldsg, U); }
            else if (sub == 0 || (sub & 2)) { const int x = it - NM; lru1_item(p, q2, l, (x >> 2) / NCH, (x >> 2) % NCH, x & 3, ldsg, U); } }
        if (sub == 0 || (sub & 4)) for (int t = gw; t < NT; t += ngw) mla_prep_token(p, q, q2, l, t, lane, U);
        break; }
    case ST_MLAPROJ: { for (int it = G - 1 - bid; it < 64; it += G) ml_scan_item(q2, it, ldsg);
        opt_mla_proj(p, q, q2, l, lds, G, bid); break; }
    case ST_MIX: {
        const ULoad16 U{q2.U16}; const YStore16 Y{q.Y16};
        const int c = bid, vcu = (G % 8 == 0) ? (c % 8) * (G / 8) + c / 8 : c;
        constexpr int QB_LAT = SEQ / 256, QB_CTX = CTX / 256, NU_LAT = NB * AH * QB_LAT, NU_CTX = NB * AH * QB_CTX;
#ifdef ATTN_PROBE_VAR
        if (sub & 1) { struct NoOut { __device__ __forceinline__ void operator()(int, int, float) const {} } noout;
            for (int u = vcu; u < NU_LAT; u += G) { const int bh = u / QB_LAT, qb = u % QB_LAT, b = bh / AH, h = bh % AH, t0 = b * TPB + CTX + qb * 256;
                att::attn_unit<unsigned short, NoOut, ATTN_PROBE_VAR>((const unsigned short*)q2.Q16 + (size_t)t0 * 768 + h * QKD, 768, (const unsigned short*)q.K16 + ((size_t)b * AH + h) * TPB * QKD, (const unsigned short*)q.V16 + ((size_t)b * AH + h) * TPB * VD, TPB, ldsg, noout); } }
        else
#endif
        if (sub == 0 || (sub & 1)) for (int u = vcu; u < NU_LAT; u += G) { const int bh = u / QB_LAT, qb = u % QB_LAT, b = bh / AH, h = bh % AH, t0 = b * TPB + CTX + qb * 256;
            OutY16 out{q.Y16 + (size_t)t0 * DMIX + 256 + h * VD};
            att::attn_unit<unsigned short, OutY16>((const unsigned short*)q2.Q16 + (size_t)t0 * 768 + h * QKD, 768, (const unsigned short*)q.K16 + ((size_t)b * AH + h) * TPB * QKD, (const unsigned short*)q.V16 + ((size_t)b * AH + h) * TPB * VD, TPB, ldsg, out); }
        if ((sub == 0 || (sub & 1)) && l + 1 < DEPTH) for (int u = vcu; u < NU_CTX; u += G) { const int bh = u / QB_CTX, qb = u % QB_CTX, b = bh / AH, h = bh % AH, t0 = b * TPB + qb * 256;
            OutY16 out{q.Y16 + (size_t)t0 * DMIX + 256 + h * VD};
            att::attn_unit<unsigned short, OutY16>((const unsigned short*)q2.Q16 + (size_t)t0 * 768 + h * QKD, 768, (const unsigned short*)q.K16 + ((size_t)b * AH + h) * TPB * QKD, (const unsigned short*)q.V16 + ((size_t)b * AH + h) * TPB * VD, CTX, ldsg, out); }
        const int ch0 = (l + 1 < DEPTH) ? 0 : NCH_CTX, nch = NCH - ch0;
        if (sub == 0 || (sub & 2)) for (int it = G - 1 - c; it < NB * nch * 4; it += G) { const int x = it >> 2; ml2_item(p, q2, l, x / nch, ch0 + x % nch, it & 3, ldsg, U, Y); }
        if (sub == 0 || (sub & 4)) for (int it = c; it < NB * nch; it += G) lru2_item(q2, q.Y16, it / nch, ch0 + it % nch, ldsg);
        break; }
    case ST_OUTPROJ: opt_outproj(p, q, l, lds, G, bid, l + 1 == DEPTH); break;
    case ST_RPMID: rp_mid(p, q, q2.GLIST, l, ldsg, G, bid, l + 1 == DEPTH, sub != 0); break;
    case ST_GU: opt_moe_gu(p, q, l, lds, G, bid, sub); break;
    case ST_DOWN: opt_moe_down16(p, q, q2, l, lds, G, bid, sub); break;
    case ST_RPEND: { THREAD_IDS rp_end(p, q, q2, l, gw, ngw, lane, sub != 0 ? 0.f : 1.f); break; }
    }
}

#if ONE_LAUNCH
__global__ void __launch_bounds__(512, 2) k_mega(Args a) {
    extern __shared__ __attribute__((aligned(16))) unsigned char lds_raw[];
    volatile LAS unsigned* MISC = (volatile LAS unsigned*)((LAS unsigned char*)lds_raw + LDS_BYTES - 64);
    if (threadIdx.x < 16) MISC[threadIdx.x] = 0u;
    if ((threadIdx.x & 63) == 0) ((LAS int*)((LAS unsigned char*)lds_raw + WTAB_OFF))[HWID()] = threadIdx.x >> 6;
    __syncthreads();
    { const XcdBarrier b0 = xcd_barrier_post(a.bar, MISC + 8); if (TIDX == 0) MISC[10] = b0.x; }
#define GRID_BAR() do { XcdBarrier b_; b_.bar = a.bar; b_.st = MISC + 8; b_.x = MISC[10]; xcd_barrier(b_); } while (0)
    run_step(a, ST_INIT, 0, lds_raw); GRID_BAR();
    run_step(a, ST_RPFIRST, 0, lds_raw); GRID_BAR();
#pragma unroll 1
    for (int l = 0; l < DEPTH; ++l) {
#pragma unroll 1
        for (int s = ST_INPROJ; s <= ST_RPEND; ++s) { run_step(a, s, l, lds_raw); if (!(l == DEPTH - 1 && s == ST_RPEND)) GRID_BAR();
#ifdef MEGA_DUP_STEP
            if (s == MEGA_DUP_STEP) { run_step(a, s, l, lds_raw); GRID_BAR(); }
#endif
        }
    }
}
#else
template <int STEP>
__global__ void __launch_bounds__(512, 2) k_step(Args a, int l) {
    extern __shared__ __attribute__((aligned(16))) unsigned char lds_raw[];
    run_step(a, STEP, l, lds_raw);
}
template <int STEP> static void launch_step(const Args& a, int l, hipStream_t stream) {
    static bool attr = false;
    if (!attr) { (void)hipFuncSetAttribute((const void*)k_step<STEP>, hipFuncAttributeMaxDynamicSharedMemorySize, LDS_BYTES); attr = true; }
    hipLaunchKernelGGL(k_step<STEP>, dim3(256), dim3(512), LDS_BYTES, stream, a, l);
}
#endif

extern "C" void kernel_launch(void* const* d_in, const int* in_sizes, int n_in, void* d_out, int out_size, void* d_ws, size_t ws_size, hipStream_t stream) {
    static int grid_blocks = 0;
    if (!grid_blocks) {
        int dev = 0, cus = 0;
        (void)hipGetDevice(&dev); (void)hipDeviceGetAttribute(&cus, hipDeviceAttributeMultiprocessorCount, dev);
        grid_blocks = cus;
#if ONE_LAUNCH
        int per_cu = 0;
        (void)hipFuncSetAttribute((const void*)k_mega, hipFuncAttributeMaxDynamicSharedMemorySize, LDS_BYTES);
        (void)hipOccupancyMaxActiveBlocksPerMultiprocessor(&per_cu, (const void*)k_mega, 512, LDS_BYTES);
        if (per_cu < 1) fprintf(stderr, "kernel_launch: occupancy query reports %d workgroups per CU\n", per_cu);
#endif
        const BMap m = b_map();
        if (n_in != N_IN || m.total > ws_size) fprintf(stderr, "kernel_launch: bad n_in %d or workspace too small (%zu needed, %zu given)\n", n_in, m.total, ws_size);
    }
    Args a{}; fill_args(a, d_in, d_out, d_ws);
#if ONE_LAUNCH
    (void)hipMemsetAsync(a.bar, 0, XCD_BAR_WORDS * 4, stream);
    void* args[] = {&a};
    hipError_t e = hipLaunchCooperativeKernel((const void*)k_mega, dim3(grid_blocks), dim3(512), args, LDS_BYTES, stream);
    if (e != hipSuccess) fprintf(stderr, "cooperative launch failed: %s (grid %d)\n", hipGetErrorString(e), grid_blocks);
#else
#ifndef DUP_STEP
#define DUP_STEP -1
#endif
#ifndef DUP_SUB
#define DUP_SUB 0
#endif
#define LS(ST, l) do { launch_step<ST>(a, l, stream); if (ST == DUP_STEP) launch_step<ST>(a, (l) | (DUP_SUB << 8), stream); } while (0)
    LS(ST_INIT, 0); LS(ST_RPFIRST, 0);
    for (int l = 0; l < DEPTH; ++l) {
        LS(ST_INPROJ, l); LS(ST_PREP, l); LS(ST_MLAPROJ, l); LS(ST_MIX, l); LS(ST_OUTPROJ, l);
        LS(ST_RPMID, l); LS(ST_GU, l); LS(ST_DOWN, l); LS(ST_RPEND, l);
    }
#endif
}
```

```cpp
#include <hip/hip_runtime.h>
#define ONE_LAUNCH 1
#include <math.h>
#include <stdint.h>

#ifndef CFG_D_MODEL
#define CFG_D_MODEL 1024
#endif
#ifndef CFG_SEQ
#define CFG_SEQ 8192
#endif
#ifndef CFG_GRID_W
#define CFG_GRID_W 64
#endif
#ifndef CFG_CTX_LEN
#define CFG_CTX_LEN 256
#endif
#ifndef CFG_N_EXPERTS
#define CFG_N_EXPERTS 32
#endif
#ifndef CFG_D_EXPERT
#define CFG_D_EXPERT 1024
#endif

#ifdef HOST_TEST
#define HD inline
struct float4 { float x, y, z, w; };
static inline int atomic_add_i(int* p, int v) { int o = *p; *p = o + v; return o; }
#else
#define HD __device__ __forceinline__
static __device__ __forceinline__ int atomic_add_i(int* p, int v) { return atomicAdd(p, v); }
#endif

constexpr int D = CFG_D_MODEL, NB = 2, SEQ = CFG_SEQ, DEPTH = 2, GRID_W = CFG_GRID_W, CTX = CFG_CTX_LEN;
constexpr int TPB = CTX + SEQ;
constexpr int NT = NB * TPB;
constexpr int LW = 256, MLH = 4, MHD = 64, MW = 256;
constexpr int AH = 8, NOPE = 64, ROPE = 32, VD = 64, QRANK = 256, KVRANK = 128, QKD = NOPE + ROPE;
constexpr int DIN = 1440, DMIX = 1024;
constexpr int OFF_AX = 0, OFF_AG = 256, OFF_BQ = 512, OFF_BKV = 768, OFF_BKR = 896, OFF_MX = 928, OFF_MZ = 1184;
constexpr int NE = CFG_N_EXPERTS, TOPK = 4, DE = CFG_D_EXPERT;
constexpr float EPS = 1e-6f;

enum { I_X = 0, I_C, I_CTX, I_CCTX, I_N1G, I_N2G, I_WMOD, I_BMOD, I_WIN, I_WOUT, I_LCW, I_LCB, I_LWA, I_LBA, I_LWX, I_LBX, I_LLAM,
       I_QNG, I_WQB, I_KVNG, I_WKVB, I_MCW, I_MCB, I_MWQ, I_MWK, I_MWV, I_MWG, I_MBG, I_MNG, I_MSK, I_WR, I_BR, I_WGU, I_BGU, I_WD, I_BD, I_FG, N_IN };

struct P {
    const float* in[N_IN];
    float* out;
    float *MOD, *ROPET, *X, *H, *U, *XC, *LA, *LB, *HL, *QN, *KVN, *QF, *KVF, *Qr, *Kr, *Vr, *XCM, *QM, *KM, *VM, *IGF, *HM, *Y, *TOPG, *ACT, *YB;
    int *TOPE, *CNT, *LIST;
};

HD float sigmoid_f(float x) { return 1.f / (1.f + expf(-x)); }
HD float silu_f(float x) { return x * sigmoid_f(x); }
HD float logsigmoid_f(float x) { return fminf(x, 0.f) - log1pf(expf(-fabsf(x))); }
HD float gelu_f(float x) { return 0.5f * x * (1.f + tanhf(0.7978845608028654f * (x + 0.044715f * x * x * x))); }

HD int tok_b(int t) { return t / TPB; }
HD int tok_i(int t) { return t % TPB; }
HD bool tok_isctx(int t) { return tok_i(t) < CTX; }
HD int tok_cv(int t) { return tok_isctx(t) ? 2 : tok_b(t); }
HD const float* modp(const P& p, int l, int cv, int which) { return p.MOD + (((size_t)l * 3 + cv) * 6 + which) * D; }

template <int R>
HD void gemm_rx4(const float* (&a)[R], const float* B, int ldb, int K, float4 (&acc)[R]) {
    for (int k = 0; k < K; ++k) {
        const float4 bv = *(const float4*)(B + (size_t)k * ldb);
#pragma unroll
        for (int r = 0; r < R; ++r) { const float av = a[r][k]; acc[r].x += av * bv.x; acc[r].y += av * bv.y; acc[r].z += av * bv.z; acc[r].w += av * bv.w; }
    }
}

HD void nv_init(const P& p, long gtid, long nthr) {
    for (long it = gtid; it < (long)DEPTH * 6 * D; it += nthr) {
        const int l = (int)(it / (6 * D)), j = (int)(it % (6 * D));
        const float* w = p.in[I_WMOD] + (size_t)l * D * 6 * D + j;
        float a0 = 0.f, a1 = 0.f, a2 = 0.f;
        for (int k = 0; k < D; ++k) { const float wv = w[(size_t)k * 6 * D];
            a0 += silu_f(p.in[I_C][k]) * wv; a1 += silu_f(p.in[I_C][D + k]) * wv; a2 += silu_f(p.in[I_CCTX][k]) * wv; }
        const float bb = p.in[I_BMOD][(size_t)l * 6 * D + j];
        p.MOD[((size_t)l * 3 + 0) * 6 * D + j] = a0 + bb; p.MOD[((size_t)l * 3 + 1) * 6 * D + j] = a1 + bb; p.MOD[((size_t)l * 3 + 2) * 6 * D + j] = a2 + bb;
    }
    for (long it = gtid; it < (long)NT * D; it += nthr) {
        const int t = (int)(it / D), k = (int)(it % D), b = tok_b(t), i = tok_i(t);
        p.X[it] = (i < CTX) ? p.in[I_CTX][((size_t)b * CTX + i) * D + k] : p.in[I_X][((size_t)b * SEQ + (i - CTX)) * D + k];
    }
    for (long it = gtid; it < (long)SEQ * 16; it += nthr) {
        const int s = (int)(it / 16), a = (int)((it / 8) & 1), f = (int)(it & 7);
        const int pos = a == 0 ? s / GRID_W : s % GRID_W;
        const double fr = pow(10000.0, -(double)f / 8.0);
        const float frf = (float)fr;
        const double ang = (double)((float)pos * frf);
        p.ROPET[it * 2] = (float)cos(ang); p.ROPET[it * 2 + 1] = (float)sin(ang);
    }
}

HD void nv_norm(const P& p, int l, int which  , long gtid, long nthr) {
    const float* g = p.in[which == 0 ? I_N1G : I_N2G] + (size_t)l * D;
    for (long t = gtid; t < NT; t += nthr) {
        const float* x = p.X + (size_t)t * D; float ss = 0.f;
        for (int k = 0; k < D; ++k) ss += x[k] * x[k];
        const float rstd = 1.f / sqrtf(ss / (float)D + EPS);
        const int cv = tok_cv((int)t); const float* sh = modp(p, l, cv, which == 0 ? 0 : 3); const float* sc = modp(p, l, cv, which == 0 ? 1 : 4);
        float* h = p.H + (size_t)t * D;
        for (int k = 0; k < D; ++k) h[k] = x[k] * rstd * g[k] * (1.f + sc[k]) + sh[k];
    }
}

HD void nv_inproj(const P& p, int l, long gtid, long nthr) {
    constexpr int R = 8, NQ = DIN / 4; const float* W = p.in[I_WIN] + (size_t)l * D * DIN;
    for (long it = gtid; it < (long)(NT / R) * NQ; it += nthr) {
        const int mi = (int)(it / NQ), n = (int)(it % NQ) * 4;
        const float* a[R]; float4 acc[R];
#pragma unroll
        for (int r = 0; r < R; ++r) { a[r] = p.H + (size_t)(mi * R + r) * D; acc[r] = float4{0.f, 0.f, 0.f, 0.f}; }
        gemm_rx4<R>(a, W + n, DIN, D, acc);
#pragma unroll
        for (int r = 0; r < R; ++r) *(float4*)(p.U + (size_t)(mi * R + r) * DIN + n) = acc[r];
    }
}

HD float conv_at(const P& p, int t, int col, int c, const float* w  , const float* bias) {
    const int i = tok_i(t), isc = i < CTX, li = isc ? i : i - CTX, len = isc ? CTX : SEQ;
    float s = bias[c];
#pragma unroll
    for (int k = 0; k < 4; ++k) { const int j = li + k - 2; if (j >= 0 && j < len) s += w[k * 256 + c] * p.U[(size_t)(t + k - 2) * DIN + col + c]; }
    return s;
}

HD void nv_prep1(const P& p, int l, long gtid, long nthr) {
    for (long it = gtid; it < (long)NT * 256; it += nthr) {
        const int t = (int)(it / 256), c = (int)(it % 256);
        p.XC[it] = conv_at(p, t, OFF_AX, c, p.in[I_LCW] + (size_t)l * 4 * 256, p.in[I_LCB] + (size_t)l * 256);
        p.XCM[it] = silu_f(conv_at(p, t, OFF_MX, c, p.in[I_MCW] + (size_t)l * 4 * 256, p.in[I_MCB] + (size_t)l * 256));
    }
    for (long t = gtid; t < NT; t += nthr) {
        const float* u = p.U + (size_t)t * DIN; float sq = 0.f, sk = 0.f;
        for (int k = 0; k < QRANK; ++k) sq += u[OFF_BQ + k] * u[OFF_BQ + k];
        for (int k = 0; k < KVRANK; ++k) sk += u[OFF_BKV + k] * u[OFF_BKV + k];
        const float rq = 1.f / sqrtf(sq / (float)QRANK + EPS), rk = 1.f / sqrtf(sk / (float)KVRANK + EPS);
        for (int k = 0; k < QRANK; ++k) p.QN[(size_t)t * QRANK + k] = u[OFF_BQ + k] * rq * p.in[I_QNG][(size_t)l * QRANK + k];
        for (int k = 0; k < KVRANK; ++k) p.KVN[(size_t)t * KVRANK + k] = u[OFF_BKV + k] * rk * p.in[I_KVNG][(size_t)l * KVRANK + k];
    }
}

HD void nv_prep2(const P& p, int l, long gtid, long nthr) {
    for (long it = gtid; it < (long)2 * NT * 256; it += nthr) {
        const int d = (int)(it / ((long)NT * 256)), t = (int)((it / 256) % NT), c = (int)(it % 256), g = c / 64, j = c % 64;
        const float* xc = p.XC + (size_t)t * 256 + g * 64;
        const float* wa = p.in[I_LWA] + ((((size_t)l * 2 + d) * 4 + g) * 64) * 64 + j;
        const float* wx = p.in[I_LWX] + ((((size_t)l * 2 + d) * 4 + g) * 64) * 64 + j;
        float sa = 0.f, sx = 0.f;
        for (int i = 0; i < 64; ++i) { sa += xc[i] * wa[i * 64]; sx += xc[i] * wx[i * 64]; }
        const float r = sigmoid_f(sa + p.in[I_LBA][((size_t)l * 2 + d) * 256 + c]), ig = sigmoid_f(sx + p.in[I_LBX][((size_t)l * 2 + d) * 256 + c]);
        const float log_a = 8.0f * r * logsigmoid_f(p.in[I_LLAM][((size_t)l * 2 + d) * 256 + c]);
        p.LA[it] = expf(log_a); p.LB[it] = sqrtf(-expm1f(2.f * log_a)) * ig * p.XC[(size_t)t * 256 + c];
    }
    { constexpr int R = 8, NQ = 768 / 4; const float* W = p.in[I_WQB] + (size_t)l * QRANK * 768;
      for (long it = gtid; it < (long)(NT / R) * NQ; it += nthr) { const int mi = (int)(it / NQ), n = (int)(it % NQ) * 4;
        const float* a[R]; float4 acc[R];
#pragma unroll
        for (int r = 0; r < R; ++r) { a[r] = p.QN + (size_t)(mi * R + r) * QRANK; acc[r] = float4{0.f, 0.f, 0.f, 0.f}; }
        gemm_rx4<R>(a, W + n, 768, QRANK, acc);
#pragma unroll
        for (int r = 0; r < R; ++r) *(float4*)(p.QF + (size_t)(mi * R + r) * 768 + n) = acc[r]; } }
    { constexpr int R = 8, NQ = 1024 / 4; const float* W = p.in[I_WKVB] + (size_t)l * KVRANK * 1024;
      for (long it = gtid; it < (long)(NT / R) * NQ; it += nthr) { const int mi = (int)(it / NQ), n = (int)(it % NQ) * 4;
        const float* a[R]; float4 acc[R];
#pragma unroll
        for (int r = 0; r < R; ++r) { a[r] = p.KVN + (size_t)(mi * R + r) * KVRANK; acc[r] = float4{0.f, 0.f, 0.f, 0.f}; }
        gemm_rx4<R>(a, W + n, 1024, KVRANK, acc);
#pragma unroll
        for (int r = 0; r < R; ++r) *(float4*)(p.KVF + (size_t)(mi * R + r) * 1024 + n) = acc[r]; } }
    for (long it = gtid; it < (long)NT * 256; it += nthr) {
        const int t = (int)(it / 256), c = (int)(it % 256), h = c / 64, j = c % 64;
        const float* xc = p.XCM + (size_t)t * 256 + h * 64; const float* ux = p.U + (size_t)t * DIN + OFF_MX + h * 64;
        const float* wq = p.in[I_MWQ] + (((size_t)l * 4 + h) * 64) * 64 + j; const float* wk = p.in[I_MWK] + (((size_t)l * 4 + h) * 64) * 64 + j; const float* wv = p.in[I_MWV] + (((size_t)l * 4 + h) * 64) * 64 + j;
        float sq = 0.f, sk = 0.f, sv = 0.f;
        for (int i = 0; i < 64; ++i) { sq += xc[i] * wq[i * 64]; sk += xc[i] * wk[i * 64]; sv += ux[i] * wv[i * 64]; }
        p.QM[it] = sq; p.KM[it] = sk * 0.125f; p.VM[it] = sv;
    }
}

HD void nv_prep3(const P& p, int l, long gtid, long nthr) {
    for (long it = gtid; it < (long)NB * 2 * 256; it += nthr) {
        const int b = (int)(it / 512), d = (int)((it / 256) & 1), c = (int)(it % 256);
        const float* A = p.LA + (size_t)d * NT * 256; const float* Bc = p.LB + (size_t)d * NT * 256; float* Ho = p.HL + (size_t)d * NT * 256;
        float h = 0.f;
        for (int seg = 0; seg < 2; ++seg) { const int base = b * TPB + (seg == 0 ? 0 : CTX), len = seg == 0 ? CTX : SEQ;
            for (int s = 0; s < len; ++s) { const int t = base + (d == 0 ? s : len - 1 - s);
                h = A[(size_t)t * 256 + c] * h + Bc[(size_t)t * 256 + c]; Ho[(size_t)t * 256 + c] = h; } }
    }
    for (long it = gtid; it < (long)NT * AH; it += nthr) {
        const int t = (int)(it / AH), h = (int)(it % AH), i = tok_i(t); const bool lat = i >= CTX; const int s = i - CTX;
        const float* qf = p.QF + (size_t)t * 768 + h * QKD; const float* kvf = p.KVF + (size_t)t * 1024 + h * (NOPE + VD); const float* kr = p.U + (size_t)t * DIN + OFF_BKR;
        float* qo = p.Qr + ((size_t)t * AH + h) * QKD; float* ko = p.Kr + ((size_t)t * AH + h) * QKD; float* vo = p.Vr + ((size_t)t * AH + h) * VD;
        for (int k = 0; k < NOPE; ++k) { qo[k] = qf[k]; ko[k] = kvf[k]; vo[k] = kvf[NOPE + k]; }
        for (int a = 0; a < 2; ++a) for (int f = 0; f < 8; ++f) {
            float cs = 1.f, sn = 0.f; if (lat) { cs = p.ROPET[(((size_t)s * 2 + a) * 8 + f) * 2]; sn = p.ROPET[(((size_t)s * 2 + a) * 8 + f) * 2 + 1]; }
            const float q1 = qf[NOPE + a * 16 + f], q2 = qf[NOPE + a * 16 + 8 + f], k1 = kr[a * 16 + f], k2 = kr[a * 16 + 8 + f];
            qo[NOPE + a * 16 + f] = q1 * cs - q2 * sn; qo[NOPE + a * 16 + 8 + f] = q2 * cs + q1 * sn;
            ko[NOPE + a * 16 + f] = k1 * cs - k2 * sn; ko[NOPE + a * 16 + 8 + f] = k2 * cs + k1 * sn; }
    }
    for (long it = gtid; it < (long)2 * NT * 8; it += nthr) {
        const int d = (int)(it / ((long)NT * 8)), t = (int)((it / 8) % NT), g = (int)(it % 8);
        const float* w = p.in[I_MWG] + (((size_t)l * 2 + d) * 768) * 8 + g; float s = p.in[I_MBG][((size_t)l * 2 + d) * 8 + g];
        for (int i = 0; i < 256; ++i) s += p.QM[(size_t)t * 256 + i] * w[(size_t)i * 8];
        for (int i = 0; i < 256; ++i) s += p.KM[(size_t)t * 256 + i] * w[(size_t)(256 + i) * 8];
        for (int i = 0; i < 256; ++i) s += p.VM[(size_t)t * 256 + i] * w[(size_t)(512 + i) * 8];
        p.IGF[it] = g < 4 ? s : logsigmoid_f(s);
    }
}

HD void nv_attn(const P& p, long gtid, long nthr) {
    const float scale = 1.0f / sqrtf((float)QKD);
    for (long it = gtid; it < (long)NT * AH; it += nthr) {
        const int h = (int)((it / TPB) % AH), b = (int)(it / ((long)TPB * AH)), i = (int)(it % TPB), t = b * TPB + i;
        const int nk = i < CTX ? CTX : TPB;
        float q[QKD], o[VD];
#pragma unroll
        for (int k = 0; k < QKD; ++k) q[k] = p.Qr[((size_t)t * AH + h) * QKD + k] * scale;
#pragma unroll
        for (int k = 0; k < VD; ++k) o[k] = 0.f;
        float m = -1e30f, lsum = 0.f;
        for (int j = 0; j < nk; ++j) {
            const float* kk = p.Kr + ((size_t)(b * TPB + j) * AH + h) * QKD; const float* vv = p.Vr + ((size_t)(b * TPB + j) * AH + h) * VD;
            float s = 0.f;
#pragma unroll
            for (int k = 0; k < QKD; ++k) s += q[k] * kk[k];
            if (s > m) { const float f = expf(m - s); lsum *= f;
#pragma unroll
                for (int k = 0; k < VD; ++k) o[k] *= f;
                m = s; }
            const float pr = expf(s - m); lsum += pr;
#pragma unroll
            for (int k = 0; k < VD; ++k) o[k] += pr * vv[k];
        }
        const float inv = 1.f / lsum;
#pragma unroll
        for (int k = 0; k < VD; ++k) p.Y[(size_t)t * DMIX + 256 + h * VD + k] = o[k] * inv;
    }
}
HD void nv_mlstm_scan(const P& p, long gtid, long nthr) {
    for (long it = gtid; it < (long)NB * MLH * 2 * 64; it += nthr) {
        const int v = (int)(it % 64), d = (int)((it / 64) & 1), h = (int)((it / 128) % MLH), b = (int)(it / (128 * MLH));
        float C[64], n[64];
#pragma unroll
        for (int k = 0; k < 64; ++k) { C[k] = 0.f; n[k] = 0.f; }
        float m = 0.f;
        for (int seg = 0; seg < 2; ++seg) { const int base = b * TPB + (seg == 0 ? 0 : CTX), len = seg == 0 ? CTX : SEQ;
            for (int s = 0; s < len; ++s) { const int t = base + (d == 0 ? s : len - 1 - s);
                const float ig = p.IGF[((size_t)d * NT + t) * 8 + h], lf = p.IGF[((size_t)d * NT + t) * 8 + 4 + h];
                const float mn = fmaxf(lf + m, ig), fd = expf(lf + m - mn), iw = expf(ig - mn); m = mn;
                const float* qq = p.QM + (size_t)t * 256 + h * 64; const float* kk = p.KM + (size_t)t * 256 + h * 64; const float vv = p.VM[(size_t)t * 256 + h * 64 + v];
                float num = 0.f, den = 0.f;
#pragma unroll
                for (int k = 0; k < 64; ++k) { const float kv = kk[k], qv = qq[k]; C[k] = fd * C[k] + iw * vv * kv; n[k] = fd * n[k] + iw * kv; num += C[k] * qv; den += n[k] * qv; }
                p.HM[((size_t)d * NT + t) * 256 + h * 64 + v] = num / fmaxf(fabsf(den), expf(-mn)); } }
    }
}
HD void nv_lru_out(const P& p, long gtid, long nthr) {
    for (long it = gtid; it < (long)NT * 256; it += nthr) { const int t = (int)(it / 256), c = (int)(it % 256);
        p.Y[(size_t)t * DMIX + c] = (p.HL[it] + p.HL[(size_t)NT * 256 + it]) * gelu_f(p.U[(size_t)t * DIN + OFF_AG + c]); }
}
HD void nv_mlstm_finish(const P& p, int l, long gtid, long nthr) {
    for (long it = gtid; it < (long)NT * MLH; it += nthr) { const int t = (int)(it / MLH), h = (int)(it % MLH);
        const float* h0 = p.HM + (size_t)t * 256 + h * 64; const float* h1 = p.HM + ((size_t)NT + t) * 256 + h * 64;
        float mu = 0.f; for (int j = 0; j < 64; ++j) mu += h0[j] + h1[j]; mu *= (1.f / 64.f);
        float var = 0.f; for (int j = 0; j < 64; ++j) { const float dlt = h0[j] + h1[j] - mu; var += dlt * dlt; } var *= (1.f / 64.f);
        const float rstd = 1.f / sqrtf(var + EPS);
        for (int j = 0; j < 64; ++j) { const int c = h * 64 + j;
            const float y = (h0[j] + h1[j] - mu) * rstd * p.in[I_MNG][(size_t)l * 256 + c] + p.in[I_MSK][(size_t)l * 256 + c] * p.XCM[(size_t)t * 256 + c];
            p.Y[(size_t)t * DMIX + 768 + c] = y * silu_f(p.U[(size_t)t * DIN + OFF_MZ + c]); } }
}
HD void nv_outproj(const P& p, int l, long gtid, long nthr) {
    constexpr int R = 8, NQ = D / 4; const float* W = p.in[I_WOUT] + (size_t)l * DMIX * D;
    for (long it = gtid; it < (long)(NT / R) * NQ; it += nthr) { const int mi = (int)(it / NQ), n = (int)(it % NQ) * 4;
        const float* a[R]; float4 acc[R];
#pragma unroll
        for (int r = 0; r < R; ++r) { a[r] = p.Y + (size_t)(mi * R + r) * DMIX; acc[r] = float4{0.f, 0.f, 0.f, 0.f}; }
        gemm_rx4<R>(a, W + n, D, DMIX, acc);
#pragma unroll
        for (int r = 0; r < R; ++r) { const int t = mi * R + r; const float* g1 = modp(p, l, tok_cv(t), 2) + n; float* x = p.X + (size_t)t * D + n;
            x[0] += g1[0] * acc[r].x; x[1] += g1[1] * acc[r].y; x[2] += g1[2] * acc[r].z; x[3] += g1[3] * acc[r].w; } }
}
HD void nv_zero_cnt(const P& p, long gtid, long nthr) { for (long i = gtid; i < NE; i += nthr) p.CNT[i] = 0; }
HD void nv_router(const P& p, int l, long gtid, long nthr) {
    for (long t = gtid; t < NT; t += nthr) {
        float lg[NE]; const float* h = p.H + (size_t)t * D; const float* W = p.in[I_WR] + (size_t)l * D * NE;
#pragma unroll
        for (int e = 0; e < NE; ++e) lg[e] = p.in[I_BR][(size_t)l * NE + e];
        for (int k = 0; k < D; ++k) { const float hv = h[k];
#pragma unroll
            for (int e = 0; e < NE; ++e) lg[e] += hv * W[(size_t)k * NE + e]; }
        int te[TOPK]; float tv[TOPK];
#pragma unroll
        for (int r = 0; r < TOPK; ++r) { float best = -3.0e38f; int bi = 0;
#pragma unroll
            for (int e = 0; e < NE; ++e) { const bool c = lg[e] > best; best = c ? lg[e] : best; bi = c ? e : bi; }
            te[r] = bi; tv[r] = best;
#pragma unroll
            for (int e = 0; e < NE; ++e) lg[e] = (e == bi) ? -3.0e38f : lg[e]; }
        float s = 0.f, ex[TOPK];
#pragma unroll
        for (int r = 0; r < TOPK; ++r) { ex[r] = expf(tv[r] - tv[0]); s += ex[r]; }
#pragma unroll
        for (int r = 0; r < TOPK; ++r) { p.TOPE[t * TOPK + r] = te[r]; p.TOPG[t * TOPK + r] = ex[r] / s;
            const int pos = atomic_add_i(&p.CNT[te[r]], 1); p.LIST[(size_t)te[r] * NT + pos] = (int)t * TOPK + r; }
    }
}
HD bool moe_item(const P& p, int R, long grp, int& e, int& r0) {
    long acc = 0;
    for (int x = 0; x < NE; ++x) { const int c = p.CNT[x], ng = (c + R - 1) / R; if (grp < acc + ng) { e = x; r0 = (int)(grp - acc) * R; return true; } acc += ng; }
    return false;
}
HD long moe_groups(const P& p, int R) { long acc = 0; for (int x = 0; x < NE; ++x) acc += (p.CNT[x] + R - 1) / R; return acc; }
HD void nv_moe_gu(const P& p, int l, long gtid, long nthr) {
    constexpr int R = 8, NQ = DE / 4; const long ngrp = moe_groups(p, R);
    for (long it = gtid; it < ngrp * NQ; it += nthr) { int e, r0; moe_item(p, R, it / NQ, e, r0); const int n = (int)(it % NQ) * 4, cnt = p.CNT[e];
        const float* Wg = p.in[I_WGU] + ((size_t)l * NE + e) * D * 2 * DE; const float* bg = p.in[I_BGU] + ((size_t)l * NE + e) * 2 * DE;
        const float* a[R]; int pr[R]; float4 ag[R], al[R];
#pragma unroll
        for (int r = 0; r < R; ++r) { const int rr = r0 + r < cnt ? r0 + r : cnt - 1; pr[r] = p.LIST[(size_t)e * NT + rr]; a[r] = p.H + (size_t)(pr[r] / TOPK) * D; ag[r] = float4{0.f, 0.f, 0.f, 0.f}; al[r] = float4{0.f, 0.f, 0.f, 0.f}; }
        gemm_rx4<R>(a, Wg + n, 2 * DE, D, ag);
        gemm_rx4<R>(a, Wg + DE + n, 2 * DE, D, al);
#pragma unroll
        for (int r = 0; r < R; ++r) if (r0 + r < cnt) { float gv[4] = {ag[r].x + bg[n], ag[r].y + bg[n + 1], ag[r].z + bg[n + 2], ag[r].w + bg[n + 3]};
            float lv[4] = {al[r].x + bg[DE + n], al[r].y + bg[DE + n + 1], al[r].z + bg[DE + n + 2], al[r].w + bg[DE + n + 3]};
#pragma unroll
            for (int q = 0; q < 4; ++q) { const float glu = fminf(gv[q], 7.0f), lin = fminf(fmaxf(lv[q], -7.0f), 7.0f);
                p.ACT[(size_t)pr[r] * DE + n + q] = glu * sigmoid_f(1.702f * glu) * (lin + 1.f); } }
    }
}
HD void nv_moe_down(const P& p, int l, long gtid, long nthr) {
    constexpr int R = 8, NQ = D / 4; const long ngrp = moe_groups(p, R);
    for (long it = gtid; it < ngrp * NQ; it += nthr) { int e, r0; moe_item(p, R, it / NQ, e, r0); const int n = (int)(it % NQ) * 4, cnt = p.CNT[e];
        const float* Wd = p.in[I_WD] + ((size_t)l * NE + e) * DE * D; const float* bd = p.in[I_BD] + ((size_t)l * NE + e) * D;
        const float* a[R]; int pr[R]; float4 acc[R];
#pragma unroll
        for (int r = 0; r < R; ++r) { const int rr = r0 + r < cnt ? r0 + r : cnt - 1; pr[r] = p.LIST[(size_t)e * NT + rr]; a[r] = p.ACT + (size_t)pr[r] * DE; acc[r] = float4{0.f, 0.f, 0.f, 0.f}; }
        gemm_rx4<R>(a, Wd + n, D, DE, acc);
#pragma unroll
        for (int r = 0; r < R; ++r) if (r0 + r < cnt) { const float g = p.TOPG[pr[r]]; float* y = p.YB + (size_t)pr[r] * D + n;
            y[0] = g * (acc[r].x + bd[n]); y[1] = g * (acc[r].y + bd[n + 1]); y[2] = g * (acc[r].z + bd[n + 2]); y[3] = g * (acc[r].w + bd[n + 3]); }
    }
}
HD void nv_combine(const P& p, int l, long gtid, long nthr) {
    for (long it = gtid; it < (long)NT * D; it += nthr) { const int t = (int)(it / D), n = (int)(it % D);
        const float s = ((p.YB[((size_t)t * 4 + 0) * D + n] + p.YB[((size_t)t * 4 + 1) * D + n]) + p.YB[((size_t)t * 4 + 2) * D + n]) + p.YB[((size_t)t * 4 + 3) * D + n];
        p.X[it] += modp(p, l, tok_cv(t), 5)[n] * s; }
}
HD void nv_final(const P& p, long gtid, long nthr) {
    for (long r = gtid; r < (long)NB * SEQ; r += nthr) { const int b = (int)(r / SEQ), s = (int)(r % SEQ), t = b * TPB + CTX + s;
        const float* x = p.X + (size_t)t * D; float ss = 0.f;
        for (int k = 0; k < D; ++k) ss += x[k] * x[k];
        const float rstd = 1.f / sqrtf(ss / (float)D + EPS);
        for (int k = 0; k < D; ++k) p.out[(size_t)r * D + k] = x[k] * rstd * p.in[I_FG][k]; }
}

constexpr int PH_PER_LAYER = 13, N_PHASES = 1 + DEPTH * PH_PER_LAYER + 1;
HD void nv_run_phase(const P& p, int ph, long gtid, long nthr) {
    if (ph == 0) { nv_init(p, gtid, nthr); return; }
    if (ph == N_PHASES - 1) { nv_final(p, gtid, nthr); return; }
    const int l = (ph - 1) / PH_PER_LAYER, s = (ph - 1) % PH_PER_LAYER;
    switch (s) {
        case 0: nv_norm(p, l, 0, gtid, nthr); break;
        case 1: nv_inproj(p, l, gtid, nthr); break;
        case 2: nv_prep1(p, l, gtid, nthr); break;
        case 3: nv_prep2(p, l, gtid, nthr); break;
        case 4: nv_prep3(p, l, gtid, nthr); break;
        case 5: nv_mlstm_scan(p, gtid, nthr); nv_attn(p, gtid, nthr); nv_lru_out(p, gtid, nthr); break;
        case 6: nv_mlstm_finish(p, l, gtid, nthr); break;
        case 7: nv_outproj(p, l, gtid, nthr); break;
        case 8: nv_norm(p, l, 1, gtid, nthr); nv_zero_cnt(p, gtid, nthr); break;
        case 9: nv_router(p, l, gtid, nthr); break;
        case 10: nv_moe_gu(p, l, gtid, nthr); break;
        case 11: nv_moe_down(p, l, gtid, nthr); break;
        case 12: nv_combine(p, l, gtid, nthr); break;
    }
}

struct WsMap { size_t off[32]; size_t total; };
static inline WsMap ws_map() {
    WsMap m; size_t o = 0; int i = 0;
    auto add = [&](size_t n) { m.off[i++] = o; o += (n + 63) & ~(size_t)63; };
    add((size_t)DEPTH * 3 * 6 * D);
    add((size_t)SEQ * 16 * 2);
    add((size_t)NT * D);
    add((size_t)NT * D);
    add((size_t)NT * DIN);
    add((size_t)NT * 256);
    add((size_t)2 * NT * 256);
    add((size_t)2 * NT * 256);
    add((size_t)2 * NT * 256);
    add((size_t)NT * QRANK);
    add((size_t)NT * KVRANK);
    add((size_t)NT * 768);
    add((size_t)NT * 1024);
    add((size_t)NT * AH * QKD);
    add((size_t)NT * AH * QKD);
    add((size_t)NT * AH * VD);
    add((size_t)NT * 256);
    add((size_t)NT * 256);
    add((size_t)NT * 256);
    add((size_t)NT * 256);
    add((size_t)2 * NT * 8);
    add((size_t)2 * NT * 256);
    add((size_t)NT * DMIX);
    add((size_t)NT * TOPK);
    add((size_t)NT * TOPK * DE);
    add((size_t)NT * TOPK * D);
    add((size_t)NT * TOPK);
    add((size_t)64);
    add((size_t)NE * NT);
    m.total = o; return m;
}
static inline void fill_params(P& p, void* const* d_in, void* d_out, void* d_ws) {
    for (int i = 0; i < N_IN; ++i) p.in[i] = (const float*)d_in[i];
    p.out = (float*)d_out; float* w = (float*)d_ws; const WsMap m = ws_map();
    p.MOD = w + m.off[0]; p.ROPET = w + m.off[1]; p.X = w + m.off[2]; p.H = w + m.off[3]; p.U = w + m.off[4]; p.XC = w + m.off[5]; p.LA = w + m.off[6]; p.LB = w + m.off[7]; p.HL = w + m.off[8];
    p.QN = w + m.off[9]; p.KVN = w + m.off[10]; p.QF = w + m.off[11]; p.KVF = w + m.off[12]; p.Qr = w + m.off[13]; p.Kr = w + m.off[14]; p.Vr = w + m.off[15];
    p.XCM = w + m.off[16]; p.QM = w + m.off[17]; p.KM = w + m.off[18]; p.VM = w + m.off[19]; p.IGF = w + m.off[20]; p.HM = w + m.off[21]; p.Y = w + m.off[22];
    p.TOPG = w + m.off[23]; p.ACT = w + m.off[24]; p.YB = w + m.off[25]; p.TOPE = (int*)(w + m.off[26]); p.CNT = (int*)(w + m.off[27]); p.LIST = (int*)(w + m.off[28]);
}
extern __shared__ __attribute__((aligned(16))) unsigned char g_lds_base[];
constexpr int WTAB_OFF = 148480 - 64 - 256;
#define HWID() ((int)__builtin_amdgcn_s_getreg((5 << 11) | 4) & 63)
#if ONE_LAUNCH
__device__ __forceinline__ int tidx_() {
    unsigned z = 0u; asm volatile("" : "+v"(z));
    const int lane = (int)__builtin_amdgcn_mbcnt_hi(~0u, __builtin_amdgcn_mbcnt_lo(~0u, z));
    const int wv = __builtin_amdgcn_readfirstlane(((const volatile __attribute__((address_space(3))) int*)((__attribute__((address_space(3))) unsigned char*)g_lds_base + WTAB_OFF))[HWID()]);
    return wv * 64 + lane;
}
#define TIDX tidx_()
#else
#define TIDX ((int)threadIdx.x)
#endif
namespace pg8 {
#define PG8_LAS __attribute__((address_space(3)))
typedef unsigned short bf16_t;
typedef short bf16x8 __attribute__((ext_vector_type(8)));
typedef float f32x4 __attribute__((ext_vector_type(4)));
typedef unsigned u32x4 __attribute__((ext_vector_type(4)));
constexpr int BM = 256, BK = 64, HALF = 128, HTB = HALF * BK * 2  , STAGE_BYTES = 8 * HTB, NXCD = 8, WGM = 8;

__host__ __device__ __forceinline__ int lds_byte(int r, int c) { const int st = (r >> 4) * 2 + (c >> 5), rr = r & 15, cc = c & 31, ob = rr * 64 + cc * 2; return st * 1024 + (ob ^ (((ob >> 9) & 1) << 5)); }
__host__ __device__ __forceinline__ void stage_rc(int b, int& R, int& C) { const int st = b / 1024, sb = b % 1024, swz = sb ^ (((sb >> 9) & 1) << 5); R = (st >> 1) * 16 + swz / 64; C = (st & 1) * 32 + (swz % 64) / 2; }
__host__ __device__ __forceinline__ int perm32(int rho) { const int n = rho >> 4, i = rho & 15; return 8 * (i >> 2) + 4 * n + (i & 3); }

struct Unit { int pm, pn, e, mb, slot; };
struct Gemm { const bf16_t* A; const bf16_t* Bt; int K; };

struct StaticOrder {
    int nM, nN, nwg, G, c;
    __device__ void init(int M, int N, int G_, int c_) { nM = M / BM; nN = N / BM; nwg = nM * nN; G = G_; c = c_; }
    __device__ bool next(int i, Unit& u) const {
        const long L = (long)i * G + c; if (L >= nwg) return false;
        int wgid = (int)L; { const int q = nwg / NXCD, r = nwg % NXCD, xcd = wgid % NXCD, off = wgid / NXCD; wgid = (xcd < r ? xcd * (q + 1) : r * (q + 1) + (xcd - r) * q) + off; }
        const int nig = WGM * nN, gid = wgid / nig, fm = gid * WGM, gsz = (nM - fm) < WGM ? (nM - fm) : WGM;
        u.pm = fm + ((wgid % nig) % gsz); u.pn = (wgid % nig) / gsz; u.e = 0; u.mb = 0; u.slot = 0; return true;
    }
    __device__ __forceinline__ int arow(const Unit& u, int r) const { return u.pm * BM + r; }
};

typedef float f32x2_c __attribute__((ext_vector_type(2))); typedef __bf16 bf16x2_c __attribute__((ext_vector_type(2)));
__device__ __forceinline__ unsigned cvt_pk_bf16(float lo, float hi) { f32x2_c v = {lo, hi}; bf16x2_c b = __builtin_convertvector(v, bf16x2_c); return __builtin_bit_cast(unsigned, b); }

template <class Epi, class Sched, bool ALIGN_EPI>
__device__ __forceinline__ void gemm_phase(PG8_LAS unsigned char* lds, const Gemm g, const Sched& S, const Epi& E) {
    int tid_ = TIDX; asm volatile("" : "+v"(tid_));
    const int tid = tid_, wid = __builtin_amdgcn_readfirstlane(tid >> 6), lane = tid & 63, wr = wid >> 2, wc = wid & 3, fr = lane & 15, fq = lane >> 4;
    const int K = g.K, nt = K / BK;
    unsigned voffB[2];
#pragma unroll
    for (int i = 0; i < 2; ++i) { int R, C; stage_rc(tid * 16 + i * 8192, R, C); const int Rb = Epi::PERM ? ((R & ~31) + perm32(R & 31)) : R;
        voffB[i] = (unsigned)(Rb * K + C) * 2u; }
    const size_t kstep = (size_t)(BK * 2);
    const size_t hstep = (size_t)HALF * K * 2;
    const size_t tstep = 2 * hstep;
    const unsigned ldsw = (unsigned)wid * 1024u;
    const int aoff = lds_byte(wr * 64 + fr, fq * 8), boff = lds_byte(wc * 32 + fr, fq * 8);
#define PG8_SA(b, h) (((b) * 2 + (h)) * HTB)
#define PG8_SB(b, h) ((4 + (b) * 2 + (h)) * HTB)
#define PG8_STAGE(bufoff, gbase, voff) do { _Pragma("unroll") for (int _i = 0; _i < 2; ++_i) \
        __builtin_amdgcn_global_load_lds((const unsigned*)((const char*)(gbase) + (voff)[_i]), (PG8_LAS unsigned*)(lds + (bufoff) + ldsw + _i * 8192), 16, 0, 0); } while (0)
#define PG8_LDA(dst, b, h) do { _Pragma("unroll") for (int m = 0; m < 4; ++m) _Pragma("unroll") for (int k = 0; k < 2; ++k) dst[m][k] = *(const PG8_LAS bf16x8*)(lds + PG8_SA(b, h) + aoff + m * 2048 + k * 1024); } while (0)
#define PG8_LDB(dst, b, h) do { _Pragma("unroll") for (int n = 0; n < 2; ++n) _Pragma("unroll") for (int k = 0; k < 2; ++k) dst[n][k] = *(const PG8_LAS bf16x8*)(lds + PG8_SB(b, h) + boff + n * 2048 + k * 1024); } while (0)
#define PG8_MMA(ai, bj, At, Bt) do { __builtin_amdgcn_s_setprio(1); _Pragma("unroll") for (int m = 0; m < 4; ++m) _Pragma("unroll") for (int n = 0; n < 2; ++n) _Pragma("unroll") for (int k = 0; k < 2; ++k) \
        acc[ai][bj][m][n] = __builtin_amdgcn_mfma_f32_16x16x32_bf16(Bt[n][k], At[m][k], acc[ai][bj][m][n], 0, 0, 0); __builtin_amdgcn_s_setprio(0); } while (0)
#define PG8_WAIT_V(n) asm volatile("s_waitcnt vmcnt(" #n ")" ::: "memory")
#define PG8_WAIT_L(n) asm volatile("s_waitcnt lgkmcnt(" #n ")" ::: "memory")
#define PG8_BAR __builtin_amdgcn_s_barrier()
#define PG8_SCHED __builtin_amdgcn_sched_barrier(0)
#define PG8_AOFFS(dst, U) do { int _t = tid; asm volatile("" : "+v"(_t)); _Pragma("unroll") for (int _i = 0; _i < 2; ++_i) { int _R, _C; stage_rc(_t * 16 + _i * 8192, _R, _C); \
        _Pragma("unroll") for (int _h = 0; _h < 2; ++_h) dst[_h][_i] = (unsigned)(S.arow(U, _h * HALF + _R) * K + _C) * 2u; } } while (0)
    Unit cur, nxt; int ui = 0;
    if (!S.next(0, cur)) return;
    f32x4 acc[2][2][4][2];
#pragma unroll
    for (int a = 0; a < 2; ++a)
#pragma unroll
        for (int b = 0; b < 2; ++b)
#pragma unroll
            for (int m = 0; m < 4; ++m)
#pragma unroll
                for (int n = 0; n < 2; ++n) acc[a][b][m][n] = (f32x4){0.f, 0.f, 0.f, 0.f};
    bf16x8 At[4][2], B0[2][2], B1[2][2];
    unsigned vA[2][2];
    PG8_AOFFS(vA, cur);
    const char* gA = (const char*)g.A;
    const char* cB = (const char*)g.Bt + (size_t)cur.pn * tstep;
    PG8_STAGE(PG8_SB(0, 0), cB, voffB); PG8_STAGE(PG8_SB(0, 1), cB + hstep, voffB); PG8_STAGE(PG8_SA(0, 0), gA, vA[0]); PG8_STAGE(PG8_SA(0, 1), gA, vA[1]);
    if (wr == 1) PG8_BAR;
    PG8_WAIT_V(2); PG8_BAR;
    PG8_STAGE(PG8_SB(1, 0), cB + kstep, voffB); PG8_STAGE(PG8_SA(1, 0), gA + kstep, vA[0]); PG8_STAGE(PG8_SB(1, 1), cB + hstep + kstep, voffB);
    PG8_WAIT_V(6); PG8_BAR;
    for (;;) {
        const bool has_next = S.next(ui + 1, nxt);
        { unsigned nvA[2][2];
          if (has_next) { PG8_AOFFS(nvA, nxt); } else {
#pragma unroll
            for (int h = 0; h < 2; ++h)
#pragma unroll
                for (int i = 0; i < 2; ++i) nvA[h][i] = vA[h][i]; }
          *(PG8_LAS u32x4*)(lds + STAGE_BYTES + 1024 + tid * 16) = (u32x4){nvA[0][0], nvA[0][1], nvA[1][0], nvA[1][1]}; }
        const char* nB = has_next ? (const char*)g.Bt + (size_t)nxt.pn * tstep : cB;
#pragma unroll 1
        for (int t = 0; t < nt; t += 2) {
            const bool last = (t == nt - 2);
            const char* a1 = gA + (size_t)(t + 1) * kstep;
            const char* a2 = last ? gA : gA + (size_t)(t + 2) * kstep; const char* b2 = last ? nB : cB + (size_t)(t + 2) * kstep;
            const char* a3 = a2 + kstep; const char* b3 = b2 + kstep;
            unsigned o2[2][2];
            if (last) { const u32x4 nv = *(const PG8_LAS u32x4*)(lds + STAGE_BYTES + 1024 + tid * 16); o2[0][0] = nv.x; o2[0][1] = nv.y; o2[1][0] = nv.z; o2[1][1] = nv.w; }
            else {
#pragma unroll
                for (int h = 0; h < 2; ++h)
#pragma unroll
                    for (int i = 0; i < 2; ++i) o2[h][i] = vA[h][i]; }
            PG8_LDB(B0, 0, 0); PG8_LDB(B1, 0, 1); PG8_SCHED; PG8_LDA(At, 0, 0); PG8_STAGE(PG8_SA(1, 1), a1, vA[1]);
            PG8_WAIT_V(8); PG8_WAIT_L(0); PG8_BAR; PG8_MMA(0, 0, At, B0); PG8_MMA(0, 1, At, B1); PG8_BAR; PG8_SCHED;
            PG8_LDA(At, 0, 1); PG8_STAGE(PG8_SB(0, 0), b2, voffB); PG8_STAGE(PG8_SB(0, 1), b2 + hstep, voffB); PG8_STAGE(PG8_SA(0, 0), a2, o2[0]);
            PG8_WAIT_V(8); PG8_WAIT_L(0); PG8_BAR; PG8_MMA(1, 0, At, B0); PG8_MMA(1, 1, At, B1); PG8_BAR; PG8_SCHED;
            PG8_LDB(B0, 1, 0); PG8_LDB(B1, 1, 1); PG8_SCHED; PG8_LDA(At, 1, 0); PG8_STAGE(PG8_SA(0, 1), a2, o2[1]);
            PG8_WAIT_V(8); PG8_WAIT_L(0); PG8_BAR; PG8_MMA(0, 0, At, B0); PG8_MMA(0, 1, At, B1); PG8_BAR; PG8_SCHED;
            PG8_LDA(At, 1, 1); PG8_STAGE(PG8_SB(1, 0), b3, voffB); PG8_STAGE(PG8_SB(1, 1), b3 + hstep, voffB); PG8_STAGE(PG8_SA(1, 0), a3, o2[0]);
            PG8_WAIT_V(8); PG8_WAIT_L(0); PG8_BAR; PG8_MMA(1, 0, At, B0); PG8_MMA(1, 1, At, B1); PG8_BAR; PG8_SCHED;
        }
        if constexpr (ALIGN_EPI) { if (wr == 0) PG8_BAR; }
        E(acc, cur, wr, wc, fr, fq);
        if (!has_next) break;
#pragma unroll
        for (int a = 0; a < 2; ++a)
#pragma unroll
            for (int b = 0; b < 2; ++b)
#pragma unroll
                for (int m = 0; m < 4; ++m)
#pragma unroll
                    for (int n = 0; n < 2; ++n) acc[a][b][m][n] = (f32x4){0.f, 0.f, 0.f, 0.f};
        cur = nxt; cB = nB; ++ui;
        { const u32x4 nv = *(const PG8_LAS u32x4*)(lds + STAGE_BYTES + 1024 + tid * 16); vA[0][0] = nv.x; vA[0][1] = nv.y; vA[1][0] = nv.z; vA[1][1] = nv.w; }
        if constexpr (ALIGN_EPI) { if (wr == 1) PG8_BAR; }
    }
    PG8_WAIT_V(0);
    if constexpr (!ALIGN_EPI) { if (wr == 0) PG8_BAR; }
    PG8_BAR;
#undef PG8_SA
#undef PG8_SB
#undef PG8_STAGE
#undef PG8_LDA
#undef PG8_LDB
#undef PG8_MMA
#undef PG8_WAIT_V
#undef PG8_WAIT_L
#undef PG8_BAR
#undef PG8_SCHED
#undef PG8_AOFFS
}
}
#define LAS __attribute__((address_space(3)))
typedef unsigned short bf16;
typedef float f32x4 __attribute__((ext_vector_type(4)));
typedef unsigned u32x4 __attribute__((ext_vector_type(4)));
typedef unsigned u32x2 __attribute__((ext_vector_type(2)));

constexpr int NWAVES = 8, NTHREADS = 512;
constexpr int DINP = 1536;
constexpr int SLOT_MAX = NT * TOPK + NE * 256;

struct Q {
    bf16 *WtIn, *WtOut, *WtGu, *WtDn, *WtQb, *WtKvb;
    bf16 *H16, *Y16, *ACT16, *K16, *V16;
};

__device__ __forceinline__ unsigned f2bf(float f) { unsigned u = __builtin_bit_cast(unsigned, f); return (u + 0x7fffu + ((u >> 16) & 1u)) >> 16; }
__device__ __forceinline__ unsigned pk2(float lo, float hi) { return f2bf(lo) | (f2bf(hi) << 16); }
__device__ __forceinline__ float bf2f(unsigned short b) { return __builtin_bit_cast(float, (unsigned)b << 16); }

__device__ __forceinline__ void transpose_item(const float* W, int N, bf16* WT, int ldk, int k0, int n0, int drow0, LAS float* scr, int lane) {
#pragma unroll 4
    for (int i = 0; i < 16; ++i) { const int kk = 4 * i + (lane >> 4), c4 = (lane & 15) * 4; const f32x4 v = *(const f32x4*)(W + (size_t)(k0 + kk) * N + n0 + c4);
        LAS float* d = scr + kk * 65 + c4; d[0] = v.x; d[1] = v.y; d[2] = v.z; d[3] = v.w; }
    asm volatile("s_waitcnt lgkmcnt(0)" ::: "memory");
#pragma unroll
    for (int j = 0; j < 8; ++j) { const int n = 8 * j + (lane >> 3), c = lane & 7; const LAS float* sp = scr + (8 * c) * 65 + n;
        u32x4 o; o.x = pk2(sp[0 * 65], sp[1 * 65]); o.y = pk2(sp[2 * 65], sp[3 * 65]); o.z = pk2(sp[4 * 65], sp[5 * 65]); o.w = pk2(sp[6 * 65], sp[7 * 65]);
        *(u32x4*)(WT + (size_t)(drow0 + n) * ldk + k0 + 8 * c) = o; }
    asm volatile("s_waitcnt lgkmcnt(0)" ::: "memory");
}
__device__ __forceinline__ void opt_convert_weights(const P& p, const Q& q, bf16* WtKvbP, LAS unsigned char* lds, int gw, int ngw, int wave, int lane) {
    LAS float* scr = (LAS float*)(lds + wave * 16640);
    constexpr int I_GU = (D / 64) * (2 * DE / 64), I_DN = (DE / 64) * (D / 64);
    constexpr int I_IN = (D / 64) * ((DIN + 63) / 64), I_OUT = (DMIX / 64) * (D / 64), I_QB = (QRANK / 64) * (768 / 64), I_KVB = (KVRANK / 64) * (1024 / 64);
    constexpr int PER_L = NE * (I_GU + I_DN) + I_IN + I_OUT + I_QB + I_KVB;
    for (int it = gw; it < DEPTH * PER_L; it += ngw) {
        const int l = it / PER_L; int r = it % PER_L;
        if (r < NE * I_GU) { const int e = r / I_GU, rr = r % I_GU, nb = 2 * DE / 64, kb = rr / nb, n0 = 64 * (rr % nb);
            const int isl = n0 >= DE, j0 = n0 - isl * DE, drow0 = 256 * (j0 / 128) + 128 * isl + (j0 % 128);
            transpose_item(p.in[I_WGU] + ((size_t)l * NE + e) * D * 2 * DE, 2 * DE, q.WtGu + ((size_t)l * NE + e) * 2 * DE * D, D, 64 * kb, n0, drow0, scr, lane); continue; } r -= NE * I_GU;
        if (r < NE * I_DN) { const int e = r / I_DN, rr = r % I_DN, nb = D / 64, kb = rr / nb, n0 = 64 * (rr % nb);
            transpose_item(p.in[I_WD] + ((size_t)l * NE + e) * DE * D, D, q.WtDn + ((size_t)l * NE + e) * D * DE, DE, 64 * kb, n0, n0, scr, lane); continue; } r -= NE * I_DN;
        if (r < I_IN) { const int nb = (DIN + 63) / 64, kb = r / nb, n0 = 64 * (r % nb);
            const int n0c = n0 + 64 <= DIN ? n0 : DIN - 64; transpose_item(p.in[I_WIN] + (size_t)l * D * DIN, DIN, q.WtIn + (size_t)l * DINP * D, D, 64 * kb, n0c, n0c, scr, lane); continue; } r -= I_IN;
        if (r < I_OUT) { const int nb = D / 64, kb = r / nb, n0 = 64 * (r % nb); transpose_item(p.in[I_WOUT] + (size_t)l * DMIX * D, D, q.WtOut + (size_t)l * D * DMIX, DMIX, 64 * kb, n0, n0, scr, lane); continue; } r -= I_OUT;
        if (r < I_QB) { const int nb = 768 / 64, kb = r / nb, n0 = 64 * (r % nb); transpose_item(p.in[I_WQB] + (size_t)l * QRANK * 768, 768, WtKvbP + (size_t)l * 1792 * 256, 256, 64 * kb, n0, n0, scr, lane); continue; } r -= I_QB;
        { const int nb = 1024 / 64, kb = r / nb, n0 = 64 * (r % nb); transpose_item(p.in[I_WKVB] + (size_t)l * KVRANK * 1024, 1024, WtKvbP + (size_t)l * 1792 * 256, 256, 64 * kb, n0, 768 + n0, scr, lane); }
    }
    const long gt = (long)gw * 64 + lane, ngt = (long)ngw * 64;
    for (long i = gt; i < (long)DEPTH * (DINP - DIN) * D / 8; i += ngt) { const int l = (int)(i / ((DINP - DIN) * D / 8)); const long o = i % ((DINP - DIN) * D / 8);
        *(u32x4*)(q.WtIn + ((size_t)l * DINP + DIN) * D + o * 8) = (u32x4){0u, 0u, 0u, 0u}; }
    for (long i = gt; i < (long)DEPTH * 1024 * 16; i += ngt) { const long row = i >> 4, l = row >> 10, n = row & 1023; *(u32x4*)(WtKvbP + ((size_t)l * 1792 + 768 + n) * 256 + 128 + (i & 15) * 8) = (u32x4){0u, 0u, 0u, 0u}; }
}

struct EpiInprojF32 {
    static constexpr bool PERM = false; float* U;
    __device__ __forceinline__ void operator()(const pg8::f32x4 (&acc)[2][2][4][2], const pg8::Unit& u, int wr, int wc, int fr, int fq) const {
#pragma unroll
        for (int ai = 0; ai < 2; ++ai)
#pragma unroll
            for (int m = 0; m < 4; ++m) { const int row = u.pm * 256 + ai * 128 + wr * 64 + m * 16 + fr;
#pragma unroll
                for (int bj = 0; bj < 2; ++bj)
#pragma unroll
                    for (int n = 0; n < 2; ++n) { const int c = u.pn * 256 + bj * 128 + wc * 32 + n * 16 + 4 * fq; if (c < DIN) *(pg8::f32x4*)(U + (size_t)row * DIN + c) = acc[ai][bj][m][n]; } }
    }
};
struct EpiOutproj {
    static constexpr bool PERM = false; float* X; const float* mod;   const float* xin; const float* cin;
    __device__ __forceinline__ void operator()(const pg8::f32x4 (&acc)[2][2][4][2], const pg8::Unit& u, int wr, int wc, int fr, int fq) const {
#pragma unroll
        for (int ai = 0; ai < 2; ++ai)
#pragma unroll
            for (int m = 0; m < 4; ++m) { const int row = u.pm * 256 + ai * 128 + wr * 64 + m * 16 + fr, b = row / TPB, i = row % TPB; const float* g1 = mod + ((size_t)(i < CTX ? 2 : b) * 6 + 2) * D;
                const float* base = xin ? (i < CTX ? cin + ((size_t)b * CTX + i) * D : xin + ((size_t)b * SEQ + (i - CTX)) * D) : X + (size_t)row * D;
#pragma unroll
                for (int bj = 0; bj < 2; ++bj)
#pragma unroll
                    for (int n = 0; n < 2; ++n) { const int c = u.pn * 256 + bj * 128 + wc * 32 + n * 16 + 4 * fq;
                        const pg8::f32x4 gv = *(const pg8::f32x4*)(g1 + c); *(pg8::f32x4*)(X + (size_t)row * D + c) = *(const pg8::f32x4*)(base + c) + gv * acc[ai][bj][m][n]; } }
    }
};
struct GroupedOrder {
    const int* CNT; const int* LIST; const LAS int* ut;
    __device__ void init(const int* cnt, const int* list, int nN, int G, int c, LAS int* tab) { CNT = cnt; LIST = list; ut = tab + 64;
        __syncthreads();
        if (TIDX == 0) { int a = 0; for (int e = 0; e < NE; ++e) { tab[e] = a; a += (cnt[e] + 255) >> 8; } tab[NE] = a; }
        __syncthreads();
        static_assert(NT < 65536, "row -> token map is 16-bit");
        if (TIDX < 16) { const int total = tab[NE] * nN; const long L = (long)TIDX * G + c; int pm = -1, pn = 0, e = 0, mb = 0;
            if (L < total) { int w = (int)L; { const int nx = pg8::NXCD, qq = total / nx, r = total % nx, xcd = w % nx, off = w / nx; w = (xcd < r ? xcd * (qq + 1) : r * (qq + 1) + (xcd - r) * qq) + off; }
                const int blk = w / nN, ntile = w % nN;
                for (int x = 1; x < NE; ++x) if (tab[x] <= blk) e = x;
                mb = blk - tab[e]; pm = blk; pn = e * nN + ntile; }
            tab[64 + TIDX * 4] = pm; tab[64 + TIDX * 4 + 1] = pn; tab[64 + TIDX * 4 + 2] = e; tab[64 + TIDX * 4 + 3] = mb; }
        __syncthreads(); }
    __device__ bool next(int i, pg8::Unit& u) const { if (i >= 15) return false; const int pm = ut[i * 4]; if (pm < 0) return false; u.pm = pm; u.pn = ut[i * 4 + 1]; u.e = ut[i * 4 + 2]; u.mb = ut[i * 4 + 3]; u.slot = i; return true; }
};
struct GuOrder : GroupedOrder {
    const LAS unsigned short* rowtok;
    __device__ void init_rows(LAS unsigned short* rt) { rowtok = rt;
        for (int x = TIDX; x < 15 * 256; x += 512) { const int i = x >> 8, r = x & 255, pm = ut[i * 4]; unsigned short v = 0;
            if (pm >= 0) { const int e = ut[i * 4 + 2], idx = ut[i * 4 + 3] * 256 + r; if (idx < CNT[e]) v = (unsigned short)(LIST[(size_t)e * NT + idx] >> 2); }
            rt[x] = v; }
        __syncthreads(); }
    __device__ __forceinline__ int arow(const pg8::Unit& u, int r) const { return rowtok[u.slot * 256 + r]; }
};
struct DnOrder : GroupedOrder {
    __device__ __forceinline__ int arow(const pg8::Unit& u, int r) const { return u.pm * 256 + r; }
};
struct EpiGu {
    static constexpr bool PERM = true; bf16* ACT; const float* bgu;   int nN; int probe_skip;
    __device__ __forceinline__ void operator()(const pg8::f32x4 (&acc)[2][2][4][2], const pg8::Unit& u, int wr, int wc, int fr, int fq) const {
        if (probe_skip) return;
        const int ntile = u.pn - u.e * nN, j0 = ntile * 128 + wc * 32 + 8 * fq; const float* bg = bgu + (size_t)u.e * 2 * DE;
        float bgl[8], bli[8];
#pragma unroll
        for (int x = 0; x < 8; ++x) { bgl[x] = bg[j0 + x]; bli[x] = bg[DE + j0 + x]; }
#pragma unroll
        for (int ai = 0; ai < 2; ++ai)
#pragma unroll
            for (int m = 0; m < 4; ++m) { const int row = u.pm * 256 + ai * 128 + wr * 64 + m * 16 + fr; float a[8];
#pragma unroll
                for (int n = 0; n < 2; ++n)
#pragma unroll
                    for (int x = 0; x < 4; ++x) { const float glu = fminf(acc[ai][0][m][n][x] + bgl[4 * n + x], 7.0f), lin = fminf(fmaxf(acc[ai][1][m][n][x] + bli[4 * n + x], -7.0f), 7.0f);
                        a[4 * n + x] = glu * __builtin_amdgcn_rcpf(1.f + __builtin_amdgcn_exp2f(-2.4554669595930157f * glu)) * (lin + 1.f); }
                u32x4 w; w.x = pg8::cvt_pk_bf16(a[0], a[1]); w.y = pg8::cvt_pk_bf16(a[2], a[3]); w.z = pg8::cvt_pk_bf16(a[4], a[5]); w.w = pg8::cvt_pk_bf16(a[6], a[7]);
                *(u32x4*)(ACT + (size_t)row * DE + j0) = w; }
    }
};
struct EpiDownF32 {
    static constexpr bool PERM = false; float* YB; const float* bd;   const float* TOPG; const int* CNT; const int* LIST; int nN;
    __device__ __forceinline__ void operator()(const pg8::f32x4 (&acc)[2][2][4][2], const pg8::Unit& u, int wr, int wc, int fr, int fq) const {
        const int ntile = u.pn - u.e * nN, cnt = CNT[u.e]; const float* b = bd + (size_t)u.e * D;
#pragma unroll
        for (int ai = 0; ai < 2; ++ai)
#pragma unroll
            for (int m = 0; m < 4; ++m) { const int idx = u.mb * 256 + ai * 128 + wr * 64 + m * 16 + fr;
                if (idx < cnt) { const int pr = LIST[(size_t)u.e * NT + idx]; const float g = TOPG[pr];
#pragma unroll
                    for (int bj = 0; bj < 2; ++bj)
#pragma unroll
                        for (int n = 0; n < 2; ++n) { const int c = ntile * 256 + bj * 128 + wc * 32 + n * 16 + 4 * fq; const pg8::f32x4 bv = *(const pg8::f32x4*)(b + c);
                            *(pg8::f32x4*)(YB + (size_t)pr * D + c) = (acc[ai][bj][m][n] + bv) * g; } } }
    }
};

__device__ __forceinline__ void opt_inproj(const P& p, const Q& q, int l, LAS unsigned char* lds, int G, int bid) {
    pg8::Gemm g{q.H16, q.WtIn + (size_t)l * DINP * D, D}; pg8::StaticOrder S; S.init(NT, DINP, G, bid);
    EpiInprojF32 E{p.U}; pg8::gemm_phase<EpiInprojF32, pg8::StaticOrder, true>(lds, g, S, E);
}
struct LatentOrder : pg8::StaticOrder {
    __device__ bool next(int i, pg8::Unit& u) const { if (!pg8::StaticOrder::next(i, u)) return false; constexpr int TL = SEQ / 256, TC = CTX / 256; u.pm = (u.pm / TL) * (TL + TC) + TC + u.pm % TL; return true; }
};
__device__ __forceinline__ void opt_outproj(const P& p, const Q& q, int l, LAS unsigned char* lds, int G, int bid, bool latent_only) {
    pg8::Gemm g{q.Y16, q.WtOut + (size_t)l * D * DMIX, DMIX}; EpiOutproj E{p.X, p.MOD + (size_t)l * 3 * 6 * D, l == 0 ? p.in[I_X] : nullptr, p.in[I_CTX]};
    if (latent_only) { LatentOrder S; S.init(NB * SEQ, D, G, bid); pg8::gemm_phase<EpiOutproj, LatentOrder, true>(lds, g, S, E); }
    else { pg8::StaticOrder S; S.init(NT, D, G, bid); pg8::gemm_phase<EpiOutproj, pg8::StaticOrder, true>(lds, g, S, E); }
}
__device__ __forceinline__ void opt_moe_gu(const P& p, const Q& q, int l, LAS unsigned char* lds, int G, int bid, int probe_skip = 0) {
    pg8::Gemm g{q.H16, q.WtGu + (size_t)l * NE * 2 * DE * D, D}; GuOrder S; S.init(p.CNT, p.LIST, 2 * DE / 256, G, bid, (LAS int*)(lds + pg8::STAGE_BYTES)); S.init_rows((LAS unsigned short*)(lds + pg8::STAGE_BYTES + 1024 + 8192));
    EpiGu E{q.ACT16, p.in[I_BGU] + (size_t)l * NE * 2 * DE, 2 * DE / 256, probe_skip}; pg8::gemm_phase<EpiGu, GuOrder, true>(lds, g, S, E);
}
__device__ __forceinline__ void opt_moe_down(const P& p, const Q& q, int l, LAS unsigned char* lds, int G, int bid) {
    pg8::Gemm g{q.ACT16, q.WtDn + (size_t)l * NE * D * DE, DE}; DnOrder S; S.init(p.CNT, p.LIST, D / 256, G, bid, (LAS int*)(lds + pg8::STAGE_BYTES));
    EpiDownF32 E{p.YB, p.in[I_BD] + (size_t)l * NE * D, p.TOPG, p.CNT, p.LIST, D / 256}; pg8::gemm_phase<EpiDownF32, DnOrder, true>(lds, g, S, E);
}
namespace att {
using bf16x8 = __attribute__((ext_vector_type(8))) short;
using s16x4  = __attribute__((ext_vector_type(4))) short;
using f32x16 = __attribute__((ext_vector_type(16))) float;
using f32x8  = __attribute__((ext_vector_type(8))) float;
using u32x4  = __attribute__((ext_vector_type(4))) unsigned;
constexpr int DK = 96, DV = 64, NW = 8, QBLK = 32, KVBLK = 64;
constexpr float SCALE = 0.10206207261596575f;
#ifndef ATTN_THR
#define ATTN_THR 8.f
#endif
constexpr float THR = ATTN_THR;
#ifndef ATTN_SM_SPLIT
#define ATTN_SM_SPLIT 0
#endif
#ifndef ATTN_NEGM
#define ATTN_NEGM 1
#endif
constexpr float QPRESCALE = ATTN_NEGM ? SCALE * 1.4426950408889634f : 1.f;
constexpr int KROW = 208;
constexpr int SHM_K = KVBLK * KROW, SHM_V = KVBLK * DV * 2;
#ifndef ATTN_STAG
#define ATTN_STAG 0
#endif
#ifndef ATTN_LAG2
#define ATTN_LAG2 0
#endif
constexpr int NRING = (ATTN_LAG2 || ATTN_STAG) ? 4 : 3;
constexpr int SHM_Q = ATTN_STAG ? 256 * KROW : 0;
constexpr int SHM_ATTN = NRING * SHM_V + NRING * SHM_K + NW * 64 * 4 + SHM_Q;
#define KSWZ(row, colB) ((row) * KROW + (colB))
#define SBAR() __builtin_amdgcn_sched_barrier(0)
__device__ __forceinline__ int crow(int r, int hi) { return (r & 3) + 8 * (r >> 2) + 4 * hi; }
typedef float f32x2_t __attribute__((ext_vector_type(2))); typedef __bf16 bf16x2_t __attribute__((ext_vector_type(2)));
__device__ __forceinline__ unsigned cvtpk(float lo, float hi) { f32x2_t v = {lo, hi}; bf16x2_t b = __builtin_convertvector(v, bf16x2_t); return __builtin_bit_cast(unsigned, b); }
__device__ __forceinline__ bf16x8 tobf(f32x8 x) { u32x4 w = {cvtpk(x[0], x[1]), cvtpk(x[2], x[3]), cvtpk(x[4], x[5]), cvtpk(x[6], x[7])}; return *reinterpret_cast<bf16x8*>(&w); }

#if ATTN_NEGM
template <bool FIRST = false>
__device__ __forceinline__ void partialSM_n(f32x16& p0, f32x16& p1, f32x16& negm, float& alpha) {
  constexpr float THR2 = THR * 1.4426950408889634f;
  float pmax = p0[0];
#pragma unroll
  for (int r = 1; r < 16; ++r) pmax = fmaxf(pmax, p0[r]);
#pragma unroll
  for (int r = 0; r < 16; ++r) pmax = fmaxf(pmax, p1[r]);
  { auto rr = __builtin_amdgcn_permlane32_swap(__float_as_uint(pmax), __float_as_uint(pmax), false, false);
    pmax = fmaxf(__uint_as_float(rr[0]), __uint_as_float(rr[1])); }
  if (!FIRST && __builtin_expect(__all(pmax <= THR2), 1)) { alpha = 1.f; }
  else { const float dl = FIRST ? pmax : fmaxf(pmax, 0.f); alpha = FIRST ? 1.f : __builtin_amdgcn_exp2f(-dl);
#pragma unroll
    for (int r = 0; r < 16; ++r) { p0[r] -= dl; p1[r] -= dl; negm[r] -= dl; } }
}
__device__ __forceinline__ void finishSM_n(f32x16& p0, f32x16& p1, float alpha, float& l_reg, bf16x8& pa0, bf16x8& pa1, bf16x8& pa2, bf16x8& pa3) {
#pragma unroll
  for (int r = 0; r < 16; ++r) { p0[r] = __builtin_amdgcn_exp2f(p0[r]); p1[r] = __builtin_amdgcn_exp2f(p1[r]); }
  float ps = 0;
#pragma unroll
  for (int r = 0; r < 16; ++r) ps += p0[r];
#pragma unroll
  for (int r = 0; r < 16; ++r) ps += p1[r];
  { auto rr = __builtin_amdgcn_permlane32_swap(__float_as_uint(ps), __float_as_uint(ps), false, false);
    ps = __uint_as_float(rr[0]) + __uint_as_float(rr[1]); }
  l_reg = l_reg * alpha + ps;
#define PK4(P, BASE, OUT) do { unsigned a0 = cvtpk(P[BASE + 0], P[BASE + 1]), a1 = cvtpk(P[BASE + 2], P[BASE + 3]);   \
    unsigned b0 = cvtpk(P[BASE + 4], P[BASE + 5]), b1 = cvtpk(P[BASE + 6], P[BASE + 7]);                              \
    auto r0 = __builtin_amdgcn_permlane32_swap(a0, b0, false, false); auto r1 = __builtin_amdgcn_permlane32_swap(a1, b1, false, false); \
    u32x4 w = {r0[0], r1[0], r0[1], r1[1]}; OUT = *reinterpret_cast<bf16x8*>(&w); } while (0)
  PK4(p0, 0, pa0); PK4(p0, 8, pa1); PK4(p1, 0, pa2); PK4(p1, 8, pa3);
#undef PK4
}
__device__ __forceinline__ void qkt_n(f32x16& p0, f32x16& p1, const char* Ks, const bf16x8* qr, const f32x16& negm, int r32, int hi) {
#pragma unroll
  for (int d0 = 0; d0 < DK / 16; ++d0) { const int cb = (d0 * 16 + hi * 8) * 2;
    const bf16x8 b0 = *reinterpret_cast<const bf16x8*>(Ks + ((r32) * KROW + cb));
    const bf16x8 b1 = *reinterpret_cast<const bf16x8*>(Ks + ((32 + r32) * KROW + cb));
#if ATTN_STAG
    const bf16x8 qf = *reinterpret_cast<const bf16x8*>((const char*)qr + d0 * 32);
#else
    const bf16x8 qf = qr[d0];
#endif
    if (d0 == 0) { p0 = __builtin_amdgcn_mfma_f32_32x32x16_bf16(b0, qf, negm, 0, 0, 0); p1 = __builtin_amdgcn_mfma_f32_32x32x16_bf16(b1, qf, negm, 0, 0, 0); }
    else { p0 = __builtin_amdgcn_mfma_f32_32x32x16_bf16(b0, qf, p0, 0, 0, 0); p1 = __builtin_amdgcn_mfma_f32_32x32x16_bf16(b1, qf, p1, 0, 0, 0); } }
}
#endif
__device__ __forceinline__ void partialSM(f32x16& p0, f32x16& p1, float& m_reg, float& mn, float& alpha) {
  constexpr float C = SCALE * 1.4426950408889634f;
  float pmax = p0[0];
#pragma unroll
  for (int r = 1; r < 16; ++r) pmax = fmaxf(pmax, p0[r]);
#pragma unroll
  for (int r = 0; r < 16; ++r) pmax = fmaxf(pmax, p1[r]);
  { auto rr = __builtin_amdgcn_permlane32_swap(__float_as_uint(pmax), __float_as_uint(pmax), false, false);
    pmax = fmaxf(__uint_as_float(rr[0]), __uint_as_float(rr[1])); }
#if ATTN_SM_SPLIT == 2
  { const bool keep = __all(pmax - m_reg <= THR / SCALE); mn = keep ? m_reg : fmaxf(m_reg, pmax); alpha = __builtin_amdgcn_exp2f((m_reg - mn) * C); m_reg = mn;
    const float mnC = -mn * C;
#pragma unroll
    for (int r = 0; r < 16; ++r) { p0[r] = __builtin_amdgcn_exp2f(fmaf(p0[r], C, mnC)); p1[r] = __builtin_amdgcn_exp2f(fmaf(p1[r], C, mnC)); } }
  return;
#endif
  if (__builtin_expect(__all(pmax - m_reg <= THR / SCALE), 1)) { mn = m_reg; alpha = 1.f; }
  else { mn = fmaxf(m_reg, pmax); alpha = __builtin_amdgcn_exp2f((m_reg - mn) * C); m_reg = mn; }
#if ATTN_SM_SPLIT == 1
  const float mnC = -mn * C;
#pragma unroll
  for (int r = 0; r < 16; ++r) p0[r] = fmaf(p0[r], C, mnC);
#pragma unroll
  for (int r = 0; r < 16; ++r) p1[r] = fmaf(p1[r], C, mnC);
#pragma unroll
  for (int r = 0; r < 16; ++r) p0[r] = __builtin_amdgcn_exp2f(p0[r]);
#endif
}
__device__ __forceinline__ void finishSM(f32x16& p0, f32x16& p1, float mn, float alpha, float& l_reg, bf16x8& pa0, bf16x8& pa1, bf16x8& pa2, bf16x8& pa3) {
#if ATTN_SM_SPLIT == 1
#pragma unroll
  for (int r = 0; r < 16; ++r) p1[r] = __builtin_amdgcn_exp2f(p1[r]);
#elif ATTN_SM_SPLIT == 2
  (void)mn;
#else
  { constexpr float C = SCALE * 1.4426950408889634f; const float mnC = -mn * C;
#pragma unroll
    for (int r = 0; r < 16; ++r) { p0[r] = __builtin_amdgcn_exp2f(fmaf(p0[r], C, mnC)); p1[r] = __builtin_amdgcn_exp2f(fmaf(p1[r], C, mnC)); } }
#endif
  float ps = 0;
#pragma unroll
  for (int r = 0; r < 16; ++r) ps += p0[r];
#pragma unroll
  for (int r = 0; r < 16; ++r) ps += p1[r];
  { auto rr = __builtin_amdgcn_permlane32_swap(__float_as_uint(ps), __float_as_uint(ps), false, false);
    ps = __uint_as_float(rr[0]) + __uint_as_float(rr[1]); }
  l_reg = l_reg * alpha + ps;
#define PK4(P, BASE, OUT) do { unsigned a0 = cvtpk(P[BASE + 0], P[BASE + 1]), a1 = cvtpk(P[BASE + 2], P[BASE + 3]);   \
    unsigned b0 = cvtpk(P[BASE + 4], P[BASE + 5]), b1 = cvtpk(P[BASE + 6], P[BASE + 7]);                              \
    auto r0 = __builtin_amdgcn_permlane32_swap(a0, b0, false, false); auto r1 = __builtin_amdgcn_permlane32_swap(a1, b1, false, false); \
    u32x4 w = {r0[0], r1[0], r0[1], r1[1]}; OUT = *reinterpret_cast<bf16x8*>(&w); } while (0)
  PK4(p0, 0, pa0); PK4(p0, 8, pa1); PK4(p1, 0, pa2); PK4(p1, 8, pa3);
#undef PK4
}
__device__ __forceinline__ void qkt(f32x16& p0, f32x16& p1, const char* Ks, const bf16x8* qr, int r32, int hi) {
  p0 = f32x16{}; p1 = f32x16{};
#pragma unroll
  for (int d0 = 0; d0 < DK / 16; ++d0) { const int cb = (d0 * 16 + hi * 8) * 2;
    const bf16x8 b0 = *reinterpret_cast<const bf16x8*>(Ks + KSWZ(r32, cb));
    const bf16x8 b1 = *reinterpret_cast<const bf16x8*>(Ks + KSWZ(32 + r32, cb));
    p0 = __builtin_amdgcn_mfma_f32_32x32x16_bf16(b0, qr[d0], p0, 0, 0, 0);
    p1 = __builtin_amdgcn_mfma_f32_32x32x16_bf16(b1, qr[d0], p1, 0, 0, 0); }
}
__device__ __forceinline__ int v_st(int k, int c) { const int kk = (k & ~0xC) | ((k & 4) << 1) | ((k & 8) >> 1); return ((kk >> 3) * 2 + (c >> 5)) * 512 + ((kk & 7) * 32 + (c & 31)) * 2; }
__device__ __forceinline__ int v_rd_base(int lane) { return ((lane & 3) << 3) | (((lane >> 2) & 3) << 6) | (((lane >> 4) & 1) << 5) | (((lane >> 5) & 1) << 8); }
constexpr int v_rd_off(int d0, int ks, int half) { return d0 * 512 + ks * 2048 + half * 1024; }
template <int OFF> __device__ __forceinline__ s16x4 tr_read(int vb) {
  s16x4 r; asm volatile("ds_read_b64_tr_b16 %0, %1 offset:%2" : "=&v"(r) : "v"(vb), "i"(OFF) : "memory"); return r;
}
template <int D0> __device__ __forceinline__ void pv_one(f32x16& od, int vb, bf16x8 pa0, bf16x8 pa1, bf16x8 pa2, bf16x8 pa3) {
  const s16x4 l0 = tr_read<v_rd_off(D0, 0, 0)>(vb), h0 = tr_read<v_rd_off(D0, 0, 1)>(vb), l1 = tr_read<v_rd_off(D0, 1, 0)>(vb), h1 = tr_read<v_rd_off(D0, 1, 1)>(vb);
  const s16x4 l2 = tr_read<v_rd_off(D0, 2, 0)>(vb), h2 = tr_read<v_rd_off(D0, 2, 1)>(vb), l3 = tr_read<v_rd_off(D0, 3, 0)>(vb), h3 = tr_read<v_rd_off(D0, 3, 1)>(vb);
  asm volatile("s_waitcnt lgkmcnt(0)" ::: "memory"); SBAR();
#define PK(L, H) (bf16x8){L[0], L[1], L[2], L[3], H[0], H[1], H[2], H[3]}
  od = __builtin_amdgcn_mfma_f32_32x32x16_bf16(pa0, PK(l0, h0), od, 0, 0, 0);
  od = __builtin_amdgcn_mfma_f32_32x32x16_bf16(pa1, PK(l1, h1), od, 0, 0, 0);
  od = __builtin_amdgcn_mfma_f32_32x32x16_bf16(pa2, PK(l2, h2), od, 0, 0, 0);
  od = __builtin_amdgcn_mfma_f32_32x32x16_bf16(pa3, PK(l3, h3), od, 0, 0, 0);
#undef PK
}
__device__ __forceinline__ void pv_d0(f32x16* o, int vb, bf16x8 pa0, bf16x8 pa1, bf16x8 pa2, bf16x8 pa3) {
  pv_one<0>(o[0], vb, pa0, pa1, pa2, pa3); pv_one<1>(o[1], vb, pa0, pa1, pa2, pa3);
}

__device__ __forceinline__ void pv_sm(f32x16* o, int vb, bf16x8 pa0, bf16x8 pa1, bf16x8 pa2, bf16x8 pa3, f32x16& p0, f32x16& p1, float& m_reg, float& mn, float& alpha) {
  constexpr float C = SCALE * 1.4426950408889634f;
  const s16x4 l00 = tr_read<v_rd_off(0, 0, 0)>(vb), h00 = tr_read<v_rd_off(0, 0, 1)>(vb), l10 = tr_read<v_rd_off(1, 0, 0)>(vb), h10 = tr_read<v_rd_off(1, 0, 1)>(vb);
  const s16x4 l01 = tr_read<v_rd_off(0, 1, 0)>(vb), h01 = tr_read<v_rd_off(0, 1, 1)>(vb), l11 = tr_read<v_rd_off(1, 1, 0)>(vb), h11 = tr_read<v_rd_off(1, 1, 1)>(vb);
  const s16x4 l02 = tr_read<v_rd_off(0, 2, 0)>(vb), h02 = tr_read<v_rd_off(0, 2, 1)>(vb), l12 = tr_read<v_rd_off(1, 2, 0)>(vb), h12 = tr_read<v_rd_off(1, 2, 1)>(vb);
  const s16x4 l03 = tr_read<v_rd_off(0, 3, 0)>(vb), h03 = tr_read<v_rd_off(0, 3, 1)>(vb), l13 = tr_read<v_rd_off(1, 3, 0)>(vb), h13 = tr_read<v_rd_off(1, 3, 1)>(vb);
  float pmax = p0[0];
#pragma unroll
  for (int r = 1; r < 16; ++r) pmax = fmaxf(pmax, p0[r]);
#pragma unroll
  for (int r = 0; r < 16; ++r) pmax = fmaxf(pmax, p1[r]);
  { auto rr = __builtin_amdgcn_permlane32_swap(__float_as_uint(pmax), __float_as_uint(pmax), false, false);
    pmax = fmaxf(__uint_as_float(rr[0]), __uint_as_float(rr[1])); }
  const bool keep = __all(pmax - m_reg <= THR / SCALE); mn = keep ? m_reg : fmaxf(m_reg, pmax); alpha = __builtin_amdgcn_exp2f((m_reg - mn) * C); m_reg = mn;
  const float mnC = -mn * C;
  asm volatile("s_waitcnt lgkmcnt(0)" ::: "memory"); SBAR();
#define PK(L, H) (bf16x8){L[0], L[1], L[2], L[3], H[0], H[1], H[2], H[3]}
#define EX4(P, B) do { P[B] = __builtin_amdgcn_exp2f(fmaf(P[B], C, mnC)); P[B + 1] = __builtin_amdgcn_exp2f(fmaf(P[B + 1], C, mnC)); P[B + 2] = __builtin_amdgcn_exp2f(fmaf(P[B + 2], C, mnC)); P[B + 3] = __builtin_amdgcn_exp2f(fmaf(P[B + 3], C, mnC)); } while (0)
  o[0] = __builtin_amdgcn_mfma_f32_32x32x16_bf16(pa0, PK(l00, h00), o[0], 0, 0, 0); EX4(p0, 0); SBAR();
  o[1] = __builtin_amdgcn_mfma_f32_32x32x16_bf16(pa0, PK(l10, h10), o[1], 0, 0, 0); EX4(p0, 4); SBAR();
  o[0] = __builtin_amdgcn_mfma_f32_32x32x16_bf16(pa1, PK(l01, h01), o[0], 0, 0, 0); EX4(p0, 8); SBAR();
  o[1] = __builtin_amdgcn_mfma_f32_32x32x16_bf16(pa1, PK(l11, h11), o[1], 0, 0, 0); EX4(p0, 12); SBAR();
  o[0] = __builtin_amdgcn_mfma_f32_32x32x16_bf16(pa2, PK(l02, h02), o[0], 0, 0, 0); EX4(p1, 0); SBAR();
  o[1] = __builtin_amdgcn_mfma_f32_32x32x16_bf16(pa2, PK(l12, h12), o[1], 0, 0, 0); EX4(p1, 4); SBAR();
  o[0] = __builtin_amdgcn_mfma_f32_32x32x16_bf16(pa3, PK(l03, h03), o[0], 0, 0, 0); EX4(p1, 8); SBAR();
  o[1] = __builtin_amdgcn_mfma_f32_32x32x16_bf16(pa3, PK(l13, h13), o[1], 0, 0, 0); EX4(p1, 12); SBAR();
#undef PK
#undef EX4
}

template <class TQ, class Out, int VAR = 0>
__device__ __forceinline__ void attn_unit(const TQ* Qb, int ldq, const unsigned short* Kh, const unsigned short* Vh, int seq, char* lds, const Out& OUT) {
  int tid_ = TIDX; asm volatile("" : "+v"(tid_));
  const int tid = tid_, wid = tid >> 6, lane = tid & 63, r32 = lane & 31, hi = lane >> 5;
  char* V_lds = lds; char* K_lds = lds + NRING * SHM_V;
  float* ws = (float*)(lds + NRING * SHM_V + NRING * SHM_K) + wid * 64; float* li_l = ws; float* al_l = ws + 32;
  float m_reg = -1e30f, l_reg = 0; f32x16 o[2] = {}; f32x16 negm = {}; (void)negm;
#if ATTN_STAG
  char* Q_lds = lds + NRING * SHM_V + NRING * SHM_K + NW * 64 * 4;
  { static_assert(sizeof(TQ) == 2, "the stagger variant takes bf16 q rows");
#pragma unroll
    for (int k = 0; k < 6; ++k) { const int x = tid + k * 512, row = x / 12, c16 = x % 12; *(bf16x8*)(Q_lds + row * KROW + c16 * 16) = *reinterpret_cast<const bf16x8*>(Qb + (long)row * ldq + c16 * 8); } }
  const bf16x8* qr = reinterpret_cast<const bf16x8*>(Q_lds + (wid * QBLK + r32) * KROW + hi * 16);
#else
  bf16x8 qr[DK / 16];
  { const TQ* Qw = Qb + (long)(wid * QBLK + r32) * ldq + hi * 8;
#pragma unroll
    for (int d0 = 0; d0 < DK / 16; ++d0) {
      if constexpr (sizeof(TQ) == 4) qr[d0] = tobf(*reinterpret_cast<const f32x8*>(Qw + d0 * 16)); else qr[d0] = *reinterpret_cast<const bf16x8*>(Qw + d0 * 16); } }
#endif
  const int kc0 = tid, kc1 = 512 + tid; const bool two = tid < 256;
  const int kst0 = KSWZ(kc0 / 12, (kc0 % 12) * 16), kst1 = KSWZ(kc1 / 12, (kc1 % 12) * 16), vst = v_st(tid >> 3, (tid & 7) * 8);
  const int vb0 = (int)(uintptr_t)V_lds + v_rd_base(lane);
  struct { bf16x8 v, k0, k1; } sr_[ATTN_STAG ? 1 : 2];
#define SLOAD(i, key0) do { sr_[i].v = *reinterpret_cast<const bf16x8*>(Vh + (long)(key0) * DV + tid * 8); sr_[i].k0 = *reinterpret_cast<const bf16x8*>(Kh + (long)(key0) * DK + kc0 * 8); \
    if (two) sr_[i].k1 = *reinterpret_cast<const bf16x8*>(Kh + (long)(key0) * DK + kc1 * 8); } while (0)
#define SWRITE(b, i) do { *(bf16x8*)(V_lds + (b) * SHM_V + vst) = sr_[i].v; *(bf16x8*)(K_lds + (b) * SHM_K + kst0) = sr_[i].k0; if (two) *(bf16x8*)(K_lds + (b) * SHM_K + kst1) = sr_[i].k1; } while (0)
#define RESC(a) do { if (__any((a) < 1.f)) { if (hi == 0) al_l[r32] = (a); asm volatile("s_waitcnt lgkmcnt(0)" ::: "memory"); \
    _Pragma("unroll") for (int d = 0; d < 2; ++d) _Pragma("unroll") for (int r = 0; r < 16; ++r) o[d][r] *= al_l[crow(r, hi)]; } } while (0)
  f32x16 pA0 = {}, pA1 = {}, pB0 = {}, pB1 = {}; float mnA, mnB, alA, alB; bf16x8 pa0, pa1, pa2, pa3; const int NT = seq / KVBLK;
  constexpr int SE = 0, SO = 1;
#if ATTN_NEGM
#define PSM(p0_, p1_, m_, mn_, al_) do { (void)mn_; partialSM_n(p0_, p1_, negm, al_); } while (0)
#else
#define PSM(p0_, p1_, m_, mn_, al_) do { if constexpr (VAR == 1) { mn_ = 0.f; al_ = 1.f; } else partialSM(p0_, p1_, m_, mn_, al_); } while (0)
#endif
#define FSM(p0_, p1_, mn_, al_, l_, a0_, a1_, a2_, a3_) do { if constexpr (VAR == 1) { u32x4 w0_ = {cvtpk(p0_[0], p0_[1]), cvtpk(p0_[2], p0_[3]), cvtpk(p0_[4], p0_[5]), cvtpk(p0_[6], p0_[7])}; a0_ = *reinterpret_cast<bf16x8*>(&w0_); \
      u32x4 w1_ = {cvtpk(p0_[8], p0_[9]), cvtpk(p0_[10], p0_[11]), cvtpk(p0_[12], p0_[13]), cvtpk(p0_[14], p0_[15])}; a1_ = *reinterpret_cast<bf16x8*>(&w1_); \
      u32x4 w2_ = {cvtpk(p1_[0], p1_[1]), cvtpk(p1_[2], p1_[3]), cvtpk(p1_[4], p1_[5]), cvtpk(p1_[6], p1_[7])}; a2_ = *reinterpret_cast<bf16x8*>(&w2_); \
      u32x4 w3_ = {cvtpk(p1_[8], p1_[9]), cvtpk(p1_[10], p1_[11]), cvtpk(p1_[12], p1_[13]), cvtpk(p1_[14], p1_[15])}; a3_ = *reinterpret_cast<bf16x8*>(&w3_); } else { if constexpr (ATTN_NEGM != 0) finishSM_n(p0_, p1_, al_, l_, a0_, a1_, a2_, a3_); else finishSM(p0_, p1_, mn_, al_, l_, a0_, a1_, a2_, a3_); } } while (0)
#define PVSM(o_, vb_, a0_, a1_, a2_, a3_, p0_, p1_, m_, mn_, al_) do { if constexpr (VAR == 0 && ATTN_SM_SPLIT == 2) pv_sm(o_, vb_, a0_, a1_, a2_, a3_, p0_, p1_, m_, mn_, al_); else { PVD(o_, vb_, a0_, a1_, a2_, a3_); PSM(p0_, p1_, m_, mn_, al_); } } while (0)
#define PVD(o_, vb_, a0_, a1_, a2_, a3_) do { if constexpr (VAR == 2) { asm volatile("" : "+v"(o_[0]), "+v"(o_[1]) : "v"(a0_), "v"(a1_), "v"(a2_), "v"(a3_)); } else pv_d0(o_, vb_, a0_, a1_, a2_, a3_); } while (0)
#define QKT(p0_, p1_, K_, q_, r_, h_) do { if constexpr (VAR == 5) { asm volatile("" : "+v"(p0_), "+v"(p1_)); } else { if constexpr (ATTN_NEGM != 0) qkt_n(p0_, p1_, K_, q_, negm, r_, h_); else qkt(p0_, p1_, K_, q_, r_, h_); } } while (0)
#define LSLOAD(i_, k_) do { if constexpr (VAR != 3) SLOAD(i_, k_); } while (0)
#define LSWRITE(b_, i_) do { if constexpr (VAR != 3) SWRITE(b_, i_); } while (0)
#define LSYNC() do { if constexpr (VAR != 4) __syncthreads(); } while (0)
#if ATTN_STAG
  const bool lead = __builtin_amdgcn_readfirstlane(wid) < 4;
  SLOAD(SE, 0); asm volatile("s_waitcnt vmcnt(0)" ::: "memory"); SWRITE(0, SE); __syncthreads();
  QKT(pA0, pA1, K_lds, qr, r32, hi);
  SLOAD(SE, KVBLK);
  if (lead) partialSM_n<true>(pA0, pA1, negm, alA);
  SWRITE(1, SE); __syncthreads();
  LSLOAD(SE, 2 * KVBLK);
  if (lead) { SBAR(); QKT(pB0, pB1, K_lds + 1 * SHM_K, qr, r32, hi); FSM(pA0, pA1, mnA, alA, l_reg, pa0, pa1, pa2, pa3); SBAR();
      PVD(o, vb0 + 0 * SHM_V, pa0, pa1, pa2, pa3); PSM(pB0, pB1, m_reg, mnB, alB); }
  else { partialSM_n<true>(pA0, pA1, negm, alA);
      SBAR(); QKT(pB0, pB1, K_lds + 1 * SHM_K, qr, r32, hi); FSM(pA0, pA1, mnA, alA, l_reg, pa0, pa1, pa2, pa3); SBAR(); }
  LSWRITE(2, SE); if (lead) RESC(alB); LSYNC();
  for (int j = 2; j < NT; j += 2) {
    if (j + 1 < NT) LSLOAD(SE, (j + 1) * KVBLK);
    if (lead) { SBAR(); QKT(pA0, pA1, K_lds + (j & 3) * SHM_K, qr, r32, hi); FSM(pB0, pB1, mnB, alB, l_reg, pa0, pa1, pa2, pa3); SBAR();
        PVD(o, vb0 + ((j - 1) & 3) * SHM_V, pa0, pa1, pa2, pa3); PSM(pA0, pA1, m_reg, mnA, alA); }
    else { PVD(o, vb0 + ((j - 2) & 3) * SHM_V, pa0, pa1, pa2, pa3); PSM(pB0, pB1, m_reg, mnB, alB); RESC(alB);
        SBAR(); QKT(pA0, pA1, K_lds + (j & 3) * SHM_K, qr, r32, hi); FSM(pB0, pB1, mnB, alB, l_reg, pa0, pa1, pa2, pa3); SBAR(); }
    if (j + 1 < NT) LSWRITE((j + 1) & 3, SE);
    if (lead) RESC(alA);
    LSYNC();
    if (j + 2 < NT) LSLOAD(SE, (j + 2) * KVBLK);
    if (lead) { SBAR(); QKT(pB0, pB1, K_lds + ((j + 1) & 3) * SHM_K, qr, r32, hi); FSM(pA0, pA1, mnA, alA, l_reg, pa0, pa1, pa2, pa3); SBAR();
        PVD(o, vb0 + (j & 3) * SHM_V, pa0, pa1, pa2, pa3); PSM(pB0, pB1, m_reg, mnB, alB); }
    else { PVD(o, vb0 + ((j - 1) & 3) * SHM_V, pa0, pa1, pa2, pa3); PSM(pA0, pA1, m_reg, mnA, alA); RESC(alA);
        SBAR(); QKT(pB0, pB1, K_lds + ((j + 1) & 3) * SHM_K, qr, r32, hi); FSM(pA0, pA1, mnA, alA, l_reg, pa0, pa1, pa2, pa3); SBAR(); }
    if (j + 2 < NT) LSWRITE((j + 2) & 3, SE);
    if (lead) RESC(alB);
    LSYNC();
  }
  if (!lead) { PVD(o, vb0 + ((NT - 2) & 3) * SHM_V, pa0, pa1, pa2, pa3); PSM(pB0, pB1, m_reg, mnB, alB); RESC(alB); }
  FSM(pB0, pB1, mnB, alB, l_reg, pa0, pa1, pa2, pa3); SBAR();
  PVD(o, vb0 + ((NT - 1) & 3) * SHM_V, pa0, pa1, pa2, pa3);
#elif ATTN_LAG2
  bf16x8 pb0, pb1, pb2, pb3;
  SLOAD(SE, 0); asm volatile("s_waitcnt vmcnt(0)" ::: "memory"); SWRITE(0, SE); __syncthreads();
  QKT(pA0, pA1, K_lds, qr, r32, hi);
#if ATTN_NEGM
  partialSM_n<true>(pA0, pA1, negm, alA);
#else
  PSM(pA0, pA1, m_reg, mnA, alA);
#endif
  SLOAD(SO, KVBLK); if (2 < NT) SLOAD(SE, 2 * KVBLK);
  SWRITE(1, SO); __syncthreads();
  SBAR(); QKT(pB0, pB1, K_lds + 1 * SHM_K, qr, r32, hi);
  FSM(pA0, pA1, mnA, alA, l_reg, pb0, pb1, pb2, pb3); SBAR();
  if (3 < NT) LSLOAD(SO, 3 * KVBLK); SBAR();
  PSM(pB0, pB1, m_reg, mnB, alB);
  LSWRITE(2, SE); LSYNC();
  for (int j = 2; j < NT; j += 2) {
    SBAR(); QKT(pA0, pA1, K_lds + (j & 3) * SHM_K, qr, r32, hi);
    FSM(pB0, pB1, mnB, alB, l_reg, pa0, pa1, pa2, pa3);
    PVD(o, vb0 + ((j - 2) & 3) * SHM_V, pb0, pb1, pb2, pb3); SBAR();
    if (j + 2 < NT) LSLOAD(SE, (j + 2) * KVBLK); SBAR();
    RESC(alB); PSM(pA0, pA1, m_reg, mnA, alA);
    if (j + 1 < NT) LSWRITE((j + 1) & 3, SO);
    LSYNC();
    SBAR(); QKT(pB0, pB1, K_lds + ((j + 1) & 3) * SHM_K, qr, r32, hi);
    FSM(pA0, pA1, mnA, alA, l_reg, pb0, pb1, pb2, pb3);
    PVD(o, vb0 + ((j - 1) & 3) * SHM_V, pa0, pa1, pa2, pa3); SBAR();
    if (j + 3 < NT) LSLOAD(SO, (j + 3) * KVBLK); SBAR();
    RESC(alA); PSM(pB0, pB1, m_reg, mnB, alB);
    if (j + 2 < NT) LSWRITE((j + 2) & 3, SE);
    LSYNC();
  }
  PVD(o, vb0 + ((NT - 2) & 3) * SHM_V, pb0, pb1, pb2, pb3);
  RESC(alB);
  FSM(pB0, pB1, mnB, alB, l_reg, pa0, pa1, pa2, pa3); SBAR();
  PVD(o, vb0 + ((NT - 1) & 3) * SHM_V, pa0, pa1, pa2, pa3);
#else
  int bp = 0, bc = 1, bn = 2;
#define ROT3() do { const int t_ = bp; bp = bc; bc = bn; bn = t_; } while (0)
  SLOAD(SE, 0); asm volatile("s_waitcnt vmcnt(0)" ::: "memory"); SWRITE(0, SE); __syncthreads();
  QKT(pA0, pA1, K_lds, qr, r32, hi);
#if ATTN_NEGM
  partialSM_n<true>(pA0, pA1, negm, alA);
#else
  PSM(pA0, pA1, m_reg, mnA, alA);
#endif
  SLOAD(SO, KVBLK); if (2 < NT) SLOAD(SE, 2 * KVBLK);
  SWRITE(1, SO); __syncthreads();
  for (int j = 1; j + 1 < NT; j += 2) {
    SBAR(); QKT(pB0, pB1, K_lds + bc * SHM_K, qr, r32, hi);
    FSM(pA0, pA1, mnA, alA, l_reg, pa0, pa1, pa2, pa3); SBAR();
    LSLOAD(SO, (j + 2) * KVBLK); SBAR();
    PVSM(o, vb0 + bp * SHM_V, pa0, pa1, pa2, pa3, pB0, pB1, m_reg, mnB, alB);
    LSWRITE(bn, SE);
    RESC(alB); LSYNC(); ROT3();
    SBAR(); QKT(pA0, pA1, K_lds + bc * SHM_K, qr, r32, hi);
    FSM(pB0, pB1, mnB, alB, l_reg, pa0, pa1, pa2, pa3); SBAR();
    if (j + 3 < NT) LSLOAD(SE, (j + 3) * KVBLK); SBAR();
    PVSM(o, vb0 + bp * SHM_V, pa0, pa1, pa2, pa3, pA0, pA1, m_reg, mnA, alA);
    LSWRITE(bn, SO);
    RESC(alA); LSYNC(); ROT3();
  }
  SBAR(); QKT(pB0, pB1, K_lds + bc * SHM_K, qr, r32, hi);
  FSM(pA0, pA1, mnA, alA, l_reg, pa0, pa1, pa2, pa3); SBAR();
  PVSM(o, vb0 + bp * SHM_V, pa0, pa1, pa2, pa3, pB0, pB1, m_reg, mnB, alB);
  RESC(alB);
  FSM(pB0, pB1, mnB, alB, l_reg, pa0, pa1, pa2, pa3); SBAR();
  PVD(o, vb0 + bc * SHM_V, pa0, pa1, pa2, pa3);
#undef ROT3
#endif
  if (hi == 0) li_l[r32] = l_reg; asm volatile("s_waitcnt lgkmcnt(0)" ::: "memory");
  float rli[16];
#pragma unroll
  for (int r = 0; r < 16; ++r) rli[r] = __builtin_amdgcn_rcpf(li_l[crow(r, hi)]);
#pragma unroll
  for (int r = 0; r < 16; ++r) { const int orow = wid * QBLK + crow(r, hi);
#pragma unroll
    for (int d0 = 0; d0 < 2; ++d0) OUT(orow, d0 * 32 + r32, o[d0][r] * rli[r]); }
  __syncthreads();
#undef SLOAD
#undef SWRITE
#undef RESC
#undef PSM
#undef PVSM
#undef FSM
#undef PVD
#undef QKT
#undef LSLOAD
#undef LSWRITE
#undef LSYNC
}
#undef KSWZ
#undef SBAR
}
struct Q2 {
    bf16* U16;
    bf16 *WtL;
    bf16 *WtM;
    bf16 *WtG;
    float *LSL;
    bf16 *HLOC, *PCUM;
    float *SA, *SB;
    bf16 *QN16, *KVN16;
    bf16 *Q16;
    bf16 *WtKvbP;
    bf16 *XCM16, *QKV16;
    float *GATES;
    float *CLOC, *NLOC, *MLB;
    bf16 *CST; float *NST, *MST;
    bf16 *YB16;
    float *GLIST;
};
constexpr int NCH = TPB / 128;
constexpr int NCH_CTX = CTX / 128;

__device__ __forceinline__ float wave_sum(float v) {
#pragma unroll
    for (int o = 1; o < 64; o <<= 1) v += __shfl_xor(v, o);
    return v;
}
__device__ __forceinline__ float fast_sigmoid(float x) { return __builtin_amdgcn_rcpf(1.f + __expf(-x)); }
__device__ __forceinline__ float fast_silu(float x) { return x * fast_sigmoid(x); }
__device__ __forceinline__ float fast_gelu(float x) { const float u = 0.7978845608028654f * (x + 0.044715f * x * x * x); return x * fast_sigmoid(2.f * u); }

struct EpiU16 {
    static constexpr bool PERM = true; bf16* U;
    __device__ __forceinline__ void operator()(const pg8::f32x4 (&acc)[2][2][4][2], const pg8::Unit& u, int wr, int wc, int fr, int fq) const {
#pragma unroll
        for (int ai = 0; ai < 2; ++ai)
#pragma unroll
            for (int m = 0; m < 4; ++m) { const int row = u.pm * 256 + ai * 128 + wr * 64 + m * 16 + fr;
#pragma unroll
                for (int bj = 0; bj < 2; ++bj) { const int c = u.pn * 256 + bj * 128 + wc * 32 + 8 * fq; const pg8::f32x4 v0 = acc[ai][bj][m][0], v1 = acc[ai][bj][m][1];
                    u32x4 w; w.x = pg8::cvt_pk_bf16(v0[0], v0[1]); w.y = pg8::cvt_pk_bf16(v0[2], v0[3]); w.z = pg8::cvt_pk_bf16(v1[0], v1[1]); w.w = pg8::cvt_pk_bf16(v1[2], v1[3]);
                    *(u32x4*)(U + (size_t)row * DINP + c) = w; } }
    }
};
__device__ __forceinline__ void opt_inproj16(const Q& q, const Q2& q2, int l, LAS unsigned char* lds, int G, int bid) {
    pg8::Gemm g{q.H16, q.WtIn + (size_t)l * DINP * D, D}; pg8::StaticOrder S; S.init(NT, DINP, G, bid);
    EpiU16 E{q2.U16}; pg8::gemm_phase<EpiU16, pg8::StaticOrder, true>(lds, g, S, E);
}

__device__ __forceinline__ void opt_convert_small(const P& p, const Q2& q2, long gtid, long nthr) {
    for (long it = gtid; it < (long)DEPTH * 4 * 256 * 64; it += nthr) { const int i = (int)(it & 63), n = (int)((it >> 6) & 255), g = (int)((it >> 14) & 3), l = (int)(it >> 16);
        const int d = n >> 7, gate = (n >> 6) & 1, j = n & 63; const float* w = (gate ? p.in[I_LWX] : p.in[I_LWA]) + ((((size_t)l * 2 + d) * 4 + g) * 64 + i) * 64 + j;
        q2.WtL[it] = (bf16)f2bf(*w); }
    for (long it = gtid; it < (long)DEPTH * 4 * 3 * 64 * 64; it += nthr) { const int i = (int)(it & 63), j = (int)((it >> 6) & 63), m = (int)((it >> 12) % 3), h = (int)((it / (3 * 4096)) & 3), l = (int)(it / (12 * 4096));
        const float* w = (m == 0 ? p.in[I_MWQ] : (m == 1 ? p.in[I_MWK] : p.in[I_MWV])) + (((size_t)l * 4 + h) * 64 + i) * 64 + j;
        q2.WtM[it] = (bf16)f2bf(*w * (m == 1 ? 0.125f : 1.f)); }
    for (long it = gtid; it < (long)DEPTH * 32 * 768; it += nthr) { const int i = (int)(it % 768), n = (int)((it / 768) & 31), l = (int)(it / (32 * 768));
        q2.WtG[it] = n < 16 ? (bf16)f2bf(p.in[I_MWG][((((size_t)l * 2 + (n >> 3)) * 768) + i) * 8 + (n & 7)]) : (bf16)0; }
    for (long it = gtid; it < (long)DEPTH * 2 * 256; it += nthr) q2.LSL[it] = logsigmoid_f(p.in[I_LLAM][it]);
}

__device__ __forceinline__ void opt_init_mod(const P& p, char* lds, int bid, int G) {
    int tid_ = TIDX; asm volatile("" : "+v"(tid_));
    const int tid = tid_; float* SC = (float*)lds; float* RED = (float*)(lds + 12288);
    for (int i = tid; i < 3 * D; i += 512) { const int cv = i / D, k = i % D; const float x = cv < 2 ? p.in[I_C][cv * D + k] : p.in[I_CCTX][k]; SC[i] = x / (1.f + __expf(-x)); }
    __syncthreads();
    for (int it = bid; it < DEPTH * 6 * D / 64; it += G) { const int l = it / (6 * D / 64), j = (it % (6 * D / 64)) * 64 + (tid & 63), kq = tid >> 6;
        const float* w = p.in[I_WMOD] + (size_t)l * D * 6 * D + (size_t)(128 * kq) * 6 * D + j; float a0 = 0.f, a1 = 0.f, a2 = 0.f;
#pragma unroll 8
        for (int k = 0; k < 128; ++k) { const float wv = w[(size_t)k * 6 * D]; a0 += SC[128 * kq + k] * wv; a1 += SC[D + 128 * kq + k] * wv; a2 += SC[2 * D + 128 * kq + k] * wv; }
        RED[(kq * 3 + 0) * 64 + (tid & 63)] = a0; RED[(kq * 3 + 1) * 64 + (tid & 63)] = a1; RED[(kq * 3 + 2) * 64 + (tid & 63)] = a2;
        __syncthreads();
        if (tid < 192) { const int cv = tid >> 6, jj = tid & 63; float sacc = p.in[I_BMOD][(size_t)l * 6 * D + (it % (6 * D / 64)) * 64 + jj];
#pragma unroll
            for (int x = 0; x < 8; ++x) sacc += RED[(x * 3 + cv) * 64 + jj];
            p.MOD[((size_t)l * 3 + cv) * 6 * D + (it % (6 * D / 64)) * 64 + jj] = sacc; }
        __syncthreads(); }
}
__device__ __forceinline__ void opt_init_rope(const P& p, long gtid, long nthr) {
    for (long it = gtid; it < (long)SEQ * 16; it += nthr) { const int s = (int)(it / 16), a = (int)((it / 8) & 1), f = (int)(it & 7); const int pos = a == 0 ? s / GRID_W : s % GRID_W;
        const float frf = f == 0 ? 1.f : f == 1 ? 0.31622776601683794f : f == 2 ? 0.1f : f == 3 ? 0.031622776601683791f : f == 4 ? 0.01f : f == 5 ? 0.0031622776601683794f : f == 6 ? 0.001f : 0.00031622776601683794f;
        const float ang = (float)pos * frf; float sn, cs; sincosf(ang, &sn, &cs);
        p.ROPET[it * 2] = cs; p.ROPET[it * 2 + 1] = sn; }
}

template <int KS, class TA, class TB>
__device__ __forceinline__ void wave_mm32(att::f32x16& acc, const TA* A, int lda, const TB* B, int ldb, int r32, int hi) {
#pragma unroll
    for (int ks = 0; ks < KS; ++ks) {
        const att::bf16x8 a = *reinterpret_cast<const att::bf16x8*>(A + (size_t)r32 * lda + ks * 16 + hi * 8);
        const att::bf16x8 b = *reinterpret_cast<const att::bf16x8*>(B + (size_t)r32 * ldb + ks * 16 + hi * 8);
        acc = __builtin_amdgcn_mfma_f32_32x32x16_bf16(a, b, acc, 0, 0, 0);
    }
}

constexpr int LRU1_LDS = 18432 + 65536 + 4096;
template <class UL>
__device__ __forceinline__ void lru1_item(const P& p, const Q2& q2, int l, int b, int ch, int g, char* lds, const UL& U) {
    int tid_ = TIDX; asm volatile("" : "+v"(tid_));
    const int tid = tid_, wave = tid >> 6, lane = tid & 63, r32 = lane & 31, hi = lane >> 5;
    unsigned short* XC16 = (unsigned short*)lds; float* AB = (float*)(lds + 18432); float* CMP = (float*)(lds + 18432 + 65536);
    const int t0 = b * TPB + ch * 128, seg_lo = ch < NCH_CTX ? b * TPB : b * TPB + CTX, seg_hi = ch < NCH_CTX ? b * TPB + CTX : (b + 1) * TPB;
    { const int j = tid & 63, c = g * 64 + j, tb = (tid >> 6) * 16; const float* cw = p.in[I_LCW] + (size_t)l * 4 * 256 + c; const float w0 = cw[0], w1 = cw[256], w2 = cw[512], w3 = cw[768], cb = p.in[I_LCB][(size_t)l * 256 + c];
      float xm2 = (t0 + tb - 2 >= seg_lo) ? U(t0 + tb - 2, OFF_AX + c) : 0.f, xm1 = (t0 + tb - 1 >= seg_lo) ? U(t0 + tb - 1, OFF_AX + c) : 0.f, x0 = U(t0 + tb, OFF_AX + c);
#pragma unroll 4
      for (int i = 0; i < 16; ++i) { const int t = t0 + tb + i; const float xp1 = (t + 1 < seg_hi) ? U(t + 1, OFF_AX + c) : 0.f;
          const float v = cb + w0 * xm2 + w1 * xm1 + w2 * x0 + w3 * xp1; XC16[(tb + i) * 72 + j] = (unsigned short)f2bf(v); xm2 = xm1; xm1 = x0; x0 = xp1; } }
    __syncthreads();
    const bf16* Wt = q2.WtL + ((size_t)l * 4 + g) * 256 * 64;
#pragma unroll 1
    for (int d = 0; d < 2; ++d) {
        const int rt = wave & 3, cj = wave >> 2; att::f32x16 ar = {}, ai = {};
        wave_mm32<4>(ar, XC16 + rt * 32 * 72, 72, Wt + (size_t)(d * 128 + cj * 32) * 64, 64, r32, hi);
        wave_mm32<4>(ai, XC16 + rt * 32 * 72, 72, Wt + (size_t)(d * 128 + 64 + cj * 32) * 64, 64, r32, hi);
        { const int j = cj * 32 + r32, c = g * 64 + j; const float ba = p.in[I_LBA][((size_t)l * 2 + d) * 256 + c], bx = p.in[I_LBX][((size_t)l * 2 + d) * 256 + c], lsl = q2.LSL[((size_t)l * 2 + d) * 256 + c];
#pragma unroll
          for (int r = 0; r < 16; ++r) { const int tt = rt * 32 + att::crow(r, hi); const float rg = fast_sigmoid(ar[r] + ba), ig = fast_sigmoid(ai[r] + bx), la = 8.f * rg * lsl, a = __expf(la);
              const float xc = bf2f(XC16[tt * 72 + j]); const float bb = sqrtf(fmaxf(1.f - a * a, 0.f)) * ig * xc;
              AB[(tt * 64 + j) * 2] = a; AB[(tt * 64 + j) * 2 + 1] = bb; } }
        __syncthreads();
        { const int j = tid & 63, sg = tid >> 6; float av[16], bv[16]; float A = 1.f, B = 0.f;
#pragma unroll
          for (int i = 0; i < 16; ++i) { const int s = sg * 16 + i, tt = d == 0 ? s : 127 - s; av[i] = AB[(tt * 64 + j) * 2]; bv[i] = AB[(tt * 64 + j) * 2 + 1]; B = av[i] * B + bv[i]; A *= av[i]; }
          CMP[(sg * 64 + j) * 2] = A; CMP[(sg * 64 + j) * 2 + 1] = B;
          __syncthreads();
          float cA = 1.f, cB = 0.f;
          for (int x = 0; x < sg; ++x) { const float xa = CMP[(x * 64 + j) * 2], xb = CMP[(x * 64 + j) * 2 + 1]; cB = xa * cB + xb; cA *= xa; }
          const int c = g * 64 + j; float h = cB, pc = cA;
          unsigned short* OUTS = (unsigned short*)AB;
#pragma unroll
          for (int i = 0; i < 16; ++i) { const int s = sg * 16 + i, tt = d == 0 ? s : 127 - s; h = av[i] * h + bv[i]; pc *= av[i];
              OUTS[tt * 64 + j] = (unsigned short)f2bf(h); OUTS[(128 + tt) * 64 + j] = (unsigned short)f2bf(pc); }
          if (sg == 7) { q2.SA[(((size_t)d * NB + b) * NCH + ch) * 256 + c] = pc; q2.SB[(((size_t)d * NB + b) * NCH + ch) * 256 + c] = h; }
          __syncthreads();
#pragma unroll
          for (int k = 0; k < 4; ++k) { const int x = tid + k * 512, arr = x >> 10, tt = (x >> 3) & 127, c8 = x & 7; const u32x4 v = *(const u32x4*)(OUTS + (arr * 128 + tt) * 64 + c8 * 8);
              *(u32x4*)((arr ? q2.PCUM : q2.HLOC) + ((size_t)d * NT + t0 + tt) * 256 + g * 64 + c8 * 8) = v; } }
        __syncthreads();
    }
}
__device__ __forceinline__ void lru2_item(const Q2& q2, bf16* Yp, int b, int ch, char* lds) {
    int tid_ = TIDX; asm volatile("" : "+v"(tid_));
    const int tid = tid_; float* CAR = (float*)lds;
    { const int d = tid >> 8, c = tid & 255; float h = 0.f;
      if (d == 0) { for (int j = 0; j < ch; ++j) h = q2.SA[(((size_t)0 * NB + b) * NCH + j) * 256 + c] * h + q2.SB[(((size_t)0 * NB + b) * NCH + j) * 256 + c]; }
      else { const bool isctx = ch < NCH_CTX;
          for (int j = NCH_CTX - 1; j >= (isctx ? ch + 1 : 0); --j) h = q2.SA[(((size_t)1 * NB + b) * NCH + j) * 256 + c] * h + q2.SB[(((size_t)1 * NB + b) * NCH + j) * 256 + c];
          if (!isctx) for (int j = NCH - 1; j > ch; --j) h = q2.SA[(((size_t)1 * NB + b) * NCH + j) * 256 + c] * h + q2.SB[(((size_t)1 * NB + b) * NCH + j) * 256 + c]; }
      CAR[tid] = h; }
    __syncthreads();
    const int t0 = b * TPB + ch * 128;
#pragma unroll 2
    for (int k = 0; k < 8; ++k) { const int x = tid + k * 512, tt = x >> 5, c0 = (x & 31) * 8, t = t0 + tt;
        const u32x4 hf = *(const u32x4*)(q2.HLOC + (size_t)t * 256 + c0), pf = *(const u32x4*)(q2.PCUM + (size_t)t * 256 + c0), hb = *(const u32x4*)(q2.HLOC + ((size_t)NT + t) * 256 + c0), pb = *(const u32x4*)(q2.PCUM + ((size_t)NT + t) * 256 + c0);
        const u32x4 ag = *(const u32x4*)(q2.U16 + (size_t)t * DINP + OFF_AG + c0); u32x4 o;
#pragma unroll
        for (int w = 0; w < 4; ++w) { float y[2];
#pragma unroll
            for (int e = 0; e < 2; ++e) { const int c = c0 + 2 * w + e; const unsigned sh = e ? 0u : 16u;
                const float h0 = __builtin_bit_cast(float, e ? (hf[w] & 0xffff0000u) : (hf[w] << 16)), p0 = __builtin_bit_cast(float, e ? (pf[w] & 0xffff0000u) : (pf[w] << 16));
                const float h1 = __builtin_bit_cast(float, e ? (hb[w] & 0xffff0000u) : (hb[w] << 16)), p1 = __builtin_bit_cast(float, e ? (pb[w] & 0xffff0000u) : (pb[w] << 16));
                const float a = __builtin_bit_cast(float, e ? (ag[w] & 0xffff0000u) : (ag[w] << 16)); (void)sh;
                y[e] = ((h0 + p0 * CAR[c]) + (h1 + p1 * CAR[256 + c])) * fast_gelu(a); }
            o[w] = pk2(y[0], y[1]); }
        *(u32x4*)(Yp + (size_t)t * DMIX + c0) = o; }
    __syncthreads();
}

template <class UL>
__device__ __forceinline__ void mla_prep_token(const P& p, const Q& q, const Q2& q2, int l, int t, int lane, const UL& U) {
    float xq[4], xk[2]; float sq = 0.f, sk = 0.f;
#pragma unroll
    for (int i = 0; i < 4; ++i) { xq[i] = U(t, OFF_BQ + lane * 4 + i); sq += xq[i] * xq[i]; }
#pragma unroll
    for (int i = 0; i < 2; ++i) { xk[i] = U(t, OFF_BKV + lane * 2 + i); sk += xk[i] * xk[i]; }
    sq = wave_sum(sq); sk = wave_sum(sk);
    const float rq = 1.f / sqrtf(sq * (1.f / QRANK) + EPS), rk = 1.f / sqrtf(sk * (1.f / KVRANK) + EPS);
    const float* gq = p.in[I_QNG] + (size_t)l * QRANK + lane * 4; const float* gk = p.in[I_KVNG] + (size_t)l * KVRANK + lane * 2;
    u32x2 wq; wq.x = pk2(xq[0] * rq * gq[0], xq[1] * rq * gq[1]); wq.y = pk2(xq[2] * rq * gq[2], xq[3] * rq * gq[3]);
    *(u32x2*)(q2.QN16 + (size_t)t * 256 + lane * 4) = wq;
    *(unsigned*)(q2.KVN16 + (size_t)t * 256 + lane * 2) = pk2(xk[0] * rk * gk[0], xk[1] * rk * gk[1]);
    *(unsigned*)(q2.KVN16 + (size_t)t * 256 + 128 + lane * 2) = 0u;
    const int b = t / TPB, key = t % TPB, h = lane >> 3, d0 = (lane & 7) * 4; const bool lat = key >= CTX; const int s = key - CTX;
    float o[4];
#pragma unroll
    for (int i = 0; i < 4; ++i) { const int dd = d0 + i, a = dd >> 4, half = (dd >> 3) & 1, f = dd & 7; const float me = U(t, OFF_BKR + dd), other = U(t, OFF_BKR + (dd ^ 8));
        float cs = 1.f, sn = 0.f; if (lat) { cs = p.ROPET[(((size_t)s * 2 + a) * 8 + f) * 2]; sn = p.ROPET[(((size_t)s * 2 + a) * 8 + f) * 2 + 1]; }
        o[i] = half == 0 ? me * cs - other * sn : me * cs + other * sn; }
    u32x2 wk; wk.x = pk2(o[0], o[1]); wk.y = pk2(o[2], o[3]);
    *(u32x2*)(q.K16 + (((size_t)b * AH + h) * TPB + key) * QKD + NOPE + d0) = wk;
}

struct EpiQproj {
    static constexpr bool PERM = true; bf16* Q16; const float* ROPET;
    __device__ __forceinline__ void operator()(const pg8::f32x4 (&acc)[2][2][4][2], const pg8::Unit& u, int wr, int wc, int fr, int fq) const {
#pragma unroll
        for (int bj = 0; bj < 2; ++bj) { const int blk = u.pn * 8 + bj * 4 + wc; const bool rope = (blk % 3) == 2; const int c = blk * 32 + 8 * fq;
#pragma unroll
            for (int ai = 0; ai < 2; ++ai)
#pragma unroll
                for (int m = 0; m < 4; ++m) { const int row = u.pm * 256 + ai * 128 + wr * 64 + m * 16 + fr; float v[8];
#pragma unroll
                    for (int x = 0; x < 4; ++x) { v[x] = acc[ai][bj][m][0][x]; v[4 + x] = acc[ai][bj][m][1][x]; }
                    if (rope) {
                        const int key = (u.pm % (TPB / 256)) * 256 + ai * 128 + wr * 64 + m * 16 + fr; const bool lat = key >= CTX; const int s = lat ? key - CTX : 0, a = fq >> 1; const float* tb = ROPET + ((size_t)s * 2 + a) * 16;
#pragma unroll
                        for (int x = 0; x < 8; ++x) { const float other = __shfl_xor(v[x], 16); const float cs = lat ? tb[x * 2] : 1.f, sn = lat ? tb[x * 2 + 1] : 0.f;
                            v[x] = (fq & 1) == 0 ? v[x] * cs - other * sn : v[x] * cs + other * sn; } }
#pragma unroll
                    for (int x = 0; x < 8; ++x) v[x] *= att::QPRESCALE;
                    u32x4 w; w.x = pg8::cvt_pk_bf16(v[0], v[1]); w.y = pg8::cvt_pk_bf16(v[2], v[3]); w.z = pg8::cvt_pk_bf16(v[4], v[5]); w.w = pg8::cvt_pk_bf16(v[6], v[7]);
                    *(u32x4*)(Q16 + (size_t)row * 768 + c) = w; asm volatile("" ::: "memory"); } }
    }
};
struct EpiKVproj {
    static constexpr bool PERM = true; bf16* K16; bf16* V16;
    __device__ __forceinline__ void operator()(const pg8::f32x4 (&acc)[2][2][4][2], const pg8::Unit& u, int wr, int wc, int fr, int fq) const {
#pragma unroll
        for (int bj = 0; bj < 2; ++bj) { const int h = u.pn * 2 + bj, dcol = wc * 32 + 8 * fq; const bool isv = dcol >= 64;
#pragma unroll
            for (int ai = 0; ai < 2; ++ai)
#pragma unroll
                for (int m = 0; m < 4; ++m) { const int b = u.pm / (TPB / 256), key = (u.pm % (TPB / 256)) * 256 + ai * 128 + wr * 64 + m * 16 + fr; const pg8::f32x4 v0 = acc[ai][bj][m][0], v1 = acc[ai][bj][m][1];
                    u32x4 w; w.x = pg8::cvt_pk_bf16(v0[0], v0[1]); w.y = pg8::cvt_pk_bf16(v0[2], v0[3]); w.z = pg8::cvt_pk_bf16(v1[0], v1[1]); w.w = pg8::cvt_pk_bf16(v1[2], v1[3]);
                    bf16* dst = isv ? V16 + (((size_t)b * AH + h) * TPB + key) * VD + (dcol - 64) : K16 + (((size_t)b * AH + h) * TPB + key) * QKD + dcol;
                    *(u32x4*)dst = w; asm volatile("" ::: "memory"); } }
    }
};
struct MlaOrder : pg8::StaticOrder { __device__ __forceinline__ int arow(const pg8::Unit& u, int r) const { return (u.pn >= 3 ? NT : 0) + u.pm * pg8::BM + r; } };
struct EpiMla { static constexpr bool PERM = true; EpiQproj eq; EpiKVproj ekv;
    __device__ __forceinline__ void operator()(const pg8::f32x4 (&acc)[2][2][4][2], const pg8::Unit& u, int wr, int wc, int fr, int fq) const {
        if (u.pn < 3) eq(acc, u, wr, wc, fr, fq); else { pg8::Unit v = u; v.pn = u.pn - 3; ekv(acc, v, wr, wc, fr, fq); } } };
__device__ __forceinline__ void opt_mla_proj(const P& p, const Q& q, const Q2& q2, int l, LAS unsigned char* lds, int G, int bid) {
    pg8::Gemm g{q2.QN16, q2.WtKvbP + (size_t)l * 1792 * 256, 256}; MlaOrder S; S.init(NT, 1792, G, bid);
    EpiMla E{EpiQproj{q2.Q16, p.ROPET}, EpiKVproj{q.K16, q.V16}}; pg8::gemm_phase<EpiMla, MlaOrder, true>(lds, g, S, E);
}
__device__ __forceinline__ int ord_len(int d, int ch) { return d == 0 ? ch : (ch < NCH_CTX ? NCH_CTX - 1 - ch : NCH_CTX + (NCH - 1 - ch)); }
__device__ __forceinline__ int ord_chunk(int d, int ch, int i) { return d == 0 ? i : (i < (ch < NCH_CTX ? NCH_CTX - 1 - ch : NCH_CTX) ? NCH_CTX - 1 - i : NCH - 1 - (i - NCH_CTX)); }

__device__ __forceinline__ void wave_scan_add128(float& x0, float& x1, int lane) {
#pragma unroll
    for (int off = 1; off < 64; off <<= 1) { const float y0 = __shfl_up(x0, off), y1 = __shfl_up(x1, off); if (lane >= off) { x0 += y0; x1 += y1; } }
    x1 += __shfl(x0, 63);
}
__device__ __forceinline__ void wave_scan_max128(float& x0, float& x1, int lane) {
#pragma unroll
    for (int off = 1; off < 64; off <<= 1) { const float y0 = __shfl_up(x0, off), y1 = __shfl_up(x1, off); if (lane >= off) { x0 = fmaxf(x0, y0); x1 = fmaxf(x1, y1); } }
    x1 = fmaxf(x1, __shfl(x0, 63));
}
__device__ __forceinline__ float wave_max(float v) {
#pragma unroll
    for (int o = 1; o < 64; o <<= 1) v = fmaxf(v, __shfl_xor(v, o));
    return v;
}

constexpr int ML1_LDS = 116736;
template <class UL>
__device__ __forceinline__ void ml1_item(const P& p, const Q2& q2, int l, int b, int ch, char* lds, const UL& U) {
    int tid_ = TIDX; asm volatile("" : "+v"(tid_));
    const int tid = tid_, wave = tid >> 6, lane = tid & 63, r32 = lane & 31, hi = lane >> 5;
    unsigned short* XCh = (unsigned short*)lds; unsigned short* UXh = (unsigned short*)(lds + 18432); unsigned short* QKVh = (unsigned short*)(lds + 36864);
    float* GP = (float*)(lds + 92160); float* GT = (float*)(lds + 108544);
    const int t0 = b * TPB + ch * 128, seg_lo = ch < NCH_CTX ? b * TPB : b * TPB + CTX, seg_hi = ch < NCH_CTX ? b * TPB + CTX : (b + 1) * TPB;
    const int rt = wave & 3, wh = wave >> 2;
    att::f32x16 gacc = {};
#pragma unroll 1
    for (int h = 0; h < 4; ++h) {
        { const int j = tid & 63, c = h * 64 + j, tb = (tid >> 6) * 16; const float* cw = p.in[I_MCW] + (size_t)l * 4 * 256 + c; const float w0 = cw[0], w1 = cw[256], w2 = cw[512], w3 = cw[768], cb = p.in[I_MCB][(size_t)l * 256 + c];
          float xm2 = (t0 + tb - 2 >= seg_lo) ? U(t0 + tb - 2, OFF_MX + c) : 0.f, xm1 = (t0 + tb - 1 >= seg_lo) ? U(t0 + tb - 1, OFF_MX + c) : 0.f, x0 = U(t0 + tb, OFF_MX + c);
#pragma unroll 4
          for (int i = 0; i < 16; ++i) { const int t = t0 + tb + i; const float xp1 = (t + 1 < seg_hi) ? U(t + 1, OFF_MX + c) : 0.f;
              const float v = fast_silu(cb + w0 * xm2 + w1 * xm1 + w2 * x0 + w3 * xp1); const unsigned short vb = (unsigned short)f2bf(v);
              XCh[(tb + i) * 72 + j] = vb; UXh[(tb + i) * 72 + j] = (unsigned short)f2bf(x0); xm2 = xm1; xm1 = x0; x0 = xp1; } }
        __syncthreads();
        { const bf16* Wm = q2.WtM + ((size_t)l * 4 + h) * 3 * 4096;
#pragma unroll
          for (int m = 0; m < 3; ++m) { att::f32x16 a = {};
              wave_mm32<4>(a, (m == 2 ? UXh : XCh) + rt * 32 * 72, 72, Wm + (size_t)m * 4096 + (size_t)wh * 32 * 64, 64, r32, hi);
#pragma unroll
              for (int r = 0; r < 16; ++r) { const int tt = rt * 32 + att::crow(r, hi); const unsigned short vb = (unsigned short)f2bf(a[r]);
                  QKVh[(m * 128 + tt) * 72 + wh * 32 + r32] = vb; } } }
        __syncthreads();
#pragma unroll
        for (int k = 0; k < 2; ++k) { const int x = tid + k * 512, tt = x >> 3, c8 = x & 7; *(u32x4*)(q2.XCM16 + (size_t)(t0 + tt) * 256 + h * 64 + c8 * 8) = *(const u32x4*)(XCh + tt * 72 + c8 * 8); }
#pragma unroll
        for (int k = 0; k < 6; ++k) { const int x = tid + k * 512, m = x >> 10, tt = (x >> 3) & 127, c8 = x & 7;
            *(u32x4*)(q2.QKV16 + (size_t)(t0 + tt) * 768 + m * 256 + h * 64 + c8 * 8) = *(const u32x4*)(QKVh + (m * 128 + tt) * 72 + c8 * 8); }
        { const bf16* Wg = q2.WtG + (size_t)l * 32 * 768;
#pragma unroll
          for (int x = 0; x < 6; ++x) { const int idx = wh * 6 + x, m = idx >> 2, ks = idx & 3;
              const att::bf16x8 a = *reinterpret_cast<const att::bf16x8*>(QKVh + (m * 128 + rt * 32 + r32) * 72 + ks * 16 + hi * 8);
              const att::bf16x8 bb = *reinterpret_cast<const att::bf16x8*>(Wg + (size_t)r32 * 768 + m * 256 + h * 64 + ks * 16 + hi * 8);
              gacc = __builtin_amdgcn_mfma_f32_32x32x16_bf16(a, bb, gacc, 0, 0, 0); } }
        __syncthreads();
    }
    if (r32 < 16) {
#pragma unroll
        for (int r = 0; r < 16; ++r) GP[(wh * 128 + rt * 32 + att::crow(r, hi)) * 16 + r32] = gacc[r]; }
    __syncthreads();
    for (int i = tid; i < 128 * 16; i += 512) { const int n = i & 15, d = n >> 3, g = n & 7; float v = GP[i] + GP[128 * 16 + i] + p.in[I_MBG][((size_t)l * 2 + d) * 8 + g];
        if (g >= 4) v = fminf(v, 0.f) - __logf(1.f + __expf(-fabsf(v)));
        GT[i] = v; q2.GATES[(size_t)(t0 + (i >> 4)) * 16 + n] = v; }
    __syncthreads();
    unsigned short* KT = (unsigned short*)lds; unsigned short* VT = (unsigned short*)(lds + 17408); float* WR = (float*)(lds + 52224); float* MB = (float*)(lds + 53248); float* WE = (float*)(lds + 53280);
#pragma unroll 1
    for (int h = 0; h < 4; ++h) {
        if (wave < 2) { const int d = wave, ta = d == 0 ? lane : 127 - lane, tb = d == 0 ? lane + 64 : 63 - lane;
            float b0 = GT[ta * 16 + d * 8 + 4 + h], b1 = GT[tb * 16 + d * 8 + 4 + h]; wave_scan_add128(b0, b1, lane);
            const float bL = __shfl(b1, 63), w0 = bL - b0 + GT[ta * 16 + d * 8 + h], w1 = bL - b1 + GT[tb * 16 + d * 8 + h];
            WR[d * 128 + ta] = w0; WR[d * 128 + tb] = w1; const float mx = wave_max(fmaxf(w0, w1));
            if (lane == 0) { MB[d * 2] = mx; MB[d * 2 + 1] = bL; } }
        __syncthreads();
        { const int tt = tid & 127, jg = tid >> 7; const float w0 = __expf(WR[tt] - MB[0]), w1 = __expf(WR[128 + tt] - MB[2]);
          const unsigned short* ksrc = (const unsigned short*)q2.QKV16 + (size_t)(t0 + tt) * 768 + 256 + h * 64 + jg * 16; const unsigned short* vsrc = ksrc + 256;
          const att::bf16x8 k0 = *reinterpret_cast<const att::bf16x8*>(ksrc), k1 = *reinterpret_cast<const att::bf16x8*>(ksrc + 8), v0 = *reinterpret_cast<const att::bf16x8*>(vsrc), v1 = *reinterpret_cast<const att::bf16x8*>(vsrc + 8);
#pragma unroll
          for (int i = 0; i < 8; ++i) { KT[(jg * 16 + i) * 136 + tt] = (unsigned short)k0[i]; KT[(jg * 16 + 8 + i) * 136 + tt] = (unsigned short)k1[i];
              const float va = bf2f((unsigned short)v0[i]), vb = bf2f((unsigned short)v1[i]);
              VT[(jg * 16 + i) * 136 + tt] = (unsigned short)f2bf(va * w0); VT[(jg * 16 + 8 + i) * 136 + tt] = (unsigned short)f2bf(vb * w0);
              VT[(64 + jg * 16 + i) * 136 + tt] = (unsigned short)f2bf(va * w1); VT[(64 + jg * 16 + 8 + i) * 136 + tt] = (unsigned short)f2bf(vb * w1); }
          if (tid < 128) WE[tid] = w0; else if (tid < 256) WE[tid] = w1; }
        __syncthreads();
        { const int d = wave >> 2, vt = (wave >> 1) & 1, kt = wave & 1; att::f32x16 c = {};
          wave_mm32<8>(c, VT + (size_t)(d * 64 + vt * 32) * 136, 136, KT + (size_t)kt * 32 * 136, 136, r32, hi);
          float* dst = q2.CLOC + ((((size_t)d * NB + b) * NCH + ch) * 4 + h) * 4096;
#pragma unroll
          for (int r = 0; r < 16; ++r) dst[(vt * 32 + att::crow(r, hi)) * 64 + kt * 32 + r32] = c[r];
          { const int dd = tid >> 8, k = (tid >> 2) & 63, qt = tid & 3; float s = 0.f;
#pragma unroll 8
            for (int i = 0; i < 32; ++i) { const int tt = qt * 32 + i; s += WE[dd * 128 + tt] * bf2f(KT[k * 136 + tt]); }
            s += __shfl_xor(s, 1); s += __shfl_xor(s, 2);
            if (qt == 0) q2.NLOC[((((size_t)dd * NB + b) * NCH + ch) * 4 + h) * 64 + k] = s; }
          if (tid < 2) { float* mb = q2.MLB + ((((size_t)tid * NB + b) * NCH + ch) * 4 + h) * 2; mb[0] = MB[tid * 2]; mb[1] = MB[tid * 2 + 1]; } }
        __syncthreads();
    }
}

__device__ __forceinline__ void ml_scan_item(const Q2& q2, int item, char* lds) {
    int tid_ = TIDX; asm volatile("" : "+v"(tid_));
    const int tid = tid_, vq = item & 3, h = (item >> 2) & 3, b = (item >> 4) & 1, d = item >> 5;
    float* MLs = (float*)lds; float* MSEQ = MLs + 2 * NCH + 16;
    for (int i = tid; i < NCH; i += 512) { const float* mb = q2.MLB + ((((size_t)d * NB + b) * NCH + ord_chunk(d, NCH, i)) * 4 + h) * 2; MLs[2 * i] = mb[0]; MLs[2 * i + 1] = mb[1]; }
    __syncthreads();
    if (tid == 0) { float m = 0.f; for (int i = 0; i < NCH; ++i) { MSEQ[i] = m; m = fmaxf(MLs[2 * i + 1] + m, MLs[2 * i]); } MSEQ[NCH] = m; }
    __syncthreads();
    const int e0 = vq * 1024 + tid * 2; float c0 = 0.f, c1 = 0.f, nn = 0.f; const bool don = (vq == 0 && tid < 64);
    static_assert(NCH % 11 == 0, "the scan streams the chunk contributions 11 at a time");
#pragma unroll 1
    for (int i0 = 0; i0 < NCH; i0 += 11) { float2 cl[11]; float nl[11];
#pragma unroll
        for (int x = 0; x < 11; ++x) { const size_t idx = (((size_t)d * NB + b) * NCH + ord_chunk(d, NCH, i0 + x)) * 4 + h; cl[x] = *(const float2*)(q2.CLOC + idx * 4096 + e0); nl[x] = don ? q2.NLOC[idx * 64 + tid] : 0.f; }
#pragma unroll
        for (int x = 0; x < 11; ++x) { const int i = i0 + x; const size_t idx = (((size_t)d * NB + b) * NCH + ord_chunk(d, NCH, i)) * 4 + h;
            *(unsigned*)(q2.CST + idx * 4096 + e0) = pk2(c0, c1);
            if (don) q2.NST[idx * 64 + tid] = nn;
            if (vq == 0 && tid == 64) q2.MST[idx] = MSEQ[i];
            const float m = MSEQ[i], mn = MSEQ[i + 1], dec = __expf(MLs[2 * i + 1] + m - mn), sc = __expf(MLs[2 * i] - mn);
            c0 = dec * c0 + sc * cl[x].x; c1 = dec * c1 + sc * cl[x].y; nn = dec * nn + sc * nl[x]; } }
    __syncthreads();
}

constexpr int ML2_LDS = 145536;
template <class UL, class YS>
__device__ __forceinline__ void ml2_item(const P& p, const Q2& q2, int l, int b, int ch, int h, char* lds, const UL& U, const YS& Y) {
    int tid_ = TIDX; asm volatile("" : "+v"(tid_));
    const int tid = tid_, wave = tid >> 6, lane = tid & 63, r32 = lane & 31, hi = lane >> 5;
    char* Ks = lds; char* Vs = lds + 32768; unsigned short* C0 = (unsigned short*)(lds + 49152); float* N0 = (float*)(lds + 67584); float* ROWV = (float*)(lds + 68096);
    float* COEF = (float*)(lds + 73216); float* M0 = (float*)(lds + 73792); float* WS = (float*)(lds + 73856) + wave * 64; float* HX = (float*)(lds + 75904);
    const int t0 = b * TPB + ch * 128;
    { const unsigned short* base = (const unsigned short*)q2.QKV16 + (size_t)t0 * 768 + h * 64;
#pragma unroll
      for (int x = 0; x < 2; ++x) { const int cidx = tid + x * 512, key = cidx >> 3, c8 = cidx & 7, tile = key >> 6, kk = key & 63;
          const att::bf16x8 kv = *reinterpret_cast<const att::bf16x8*>(base + (size_t)key * 768 + 256 + c8 * 8), vv = *reinterpret_cast<const att::bf16x8*>(base + (size_t)key * 768 + 512 + c8 * 8);
          *(att::bf16x8*)(Ks + tile * 16384 + (kk * 256 + ((c8 * 16) ^ ((kk & 7) << 4)))) = kv;
          *(att::bf16x8*)(Vs + tile * 8192 + att::v_st(kk, c8 * 8)) = vv; } }
    if (wave < 2) { const int d = wave, ta = d == 0 ? lane : 127 - lane, tb = d == 0 ? lane + 64 : 63 - lane;
        float* g = ROWV + (d * 5 + 0) * 128; float* pmv = ROWV + (d * 5 + 1) * 128; float* bv = ROWV + (d * 5 + 2) * 128;
        const float iga = q2.GATES[(size_t)(t0 + ta) * 16 + d * 8 + h], igb = q2.GATES[(size_t)(t0 + tb) * 16 + d * 8 + h];
        float b0 = q2.GATES[(size_t)(t0 + ta) * 16 + d * 8 + 4 + h], b1 = q2.GATES[(size_t)(t0 + tb) * 16 + d * 8 + 4 + h]; wave_scan_add128(b0, b1, lane);
        const float g0 = iga - b0, g1 = igb - b1; float p0 = g0, p1 = g1; wave_scan_max128(p0, p1, lane);
        g[ta] = g0; g[tb] = g1; pmv[ta] = p0; pmv[tb] = p1; bv[ta] = b0; bv[tb] = b1; }
    __syncthreads();
    { const int d = tid >> 8, e0 = (tid & 255) * 16; const size_t idx = (((size_t)d * NB + b) * NCH + ch) * 4 + h;
      const u32x4* src = (const u32x4*)(q2.CST + idx * 4096 + e0); const u32x4 w0 = src[0], w1 = src[1];
      { const int v = e0 >> 6, k = e0 & 63; unsigned short* dst = C0 + (d * 64 + v) * 72 + k; *(u32x4*)dst = w0; *(u32x4*)(dst + 8) = w1; }
      if (tid < 128) { const int nd = tid >> 6, nk = tid & 63; N0[nd * 64 + nk] = q2.NST[((((size_t)nd * NB + b) * NCH + ch) * 4 + h) * 64 + nk]; }
      if (tid < 2) M0[tid] = q2.MST[(((size_t)tid * NB + b) * NCH + ch) * 4 + h]; }
    __syncthreads();
    {
      if (tid < 256) { const int dd = tid >> 7, tt = tid & 127; const float m0 = M0[dd], M = fmaxf(m0, ROWV[(dd * 5 + 1) * 128 + tt]);
          ROWV[(dd * 5 + 1) * 128 + tt] = M; ROWV[(dd * 5 + 3) * 128 + tt] = __expf(m0 - M); ROWV[(dd * 5 + 4) * 128 + tt] = __expf(-(ROWV[(dd * 5 + 2) * 128 + tt] + M)); } }
    __syncthreads();
    { const int qb = wave & 3, d = wave >> 2; const float* g = ROWV + (d * 5 + 0) * 128; const float* Mv = ROWV + (d * 5 + 1) * 128; const float* wiv = ROWV + (d * 5 + 3) * 128; const float* emtv = ROWV + (d * 5 + 4) * 128;
      att::bf16x8 qr[4]; const int sq = qb * 32 + r32;
      { const unsigned short* qw = (const unsigned short*)q2.QKV16 + (size_t)(t0 + sq) * 768 + h * 64 + hi * 8;
#pragma unroll
        for (int d0 = 0; d0 < 4; ++d0) qr[d0] = *reinterpret_cast<const att::bf16x8*>(qw + d0 * 16); }
      const float Ms = Mv[sq] * 1.4426950408889634f; att::f32x16 o[2] = {}; float rs = 0.f;
      const int vb0 = (int)(uintptr_t)Vs + att::v_rd_base(lane);
#pragma unroll
      for (int kt = 0; kt < 2; ++kt) {
          const bool skip = d == 0 ? (kt == 1 && qb < 2) : (kt == 0 && qb >= 2);
          if (!skip) {
              att::f32x16 p0 = {}, p1 = {}; const char* Kt = Ks + kt * 16384;
#pragma unroll
              for (int d0 = 0; d0 < 4; ++d0) { const int cb = (d0 * 16 + hi * 8) * 2;
                  const att::bf16x8 b0 = *reinterpret_cast<const att::bf16x8*>(Kt + (r32 * 256 + (cb ^ ((r32 & 7) << 4))));
                  const att::bf16x8 b1 = *reinterpret_cast<const att::bf16x8*>(Kt + ((32 + r32) * 256 + (cb ^ ((r32 & 7) << 4))));
                  p0 = __builtin_amdgcn_mfma_f32_32x32x16_bf16(b0, qr[d0], p0, 0, 0, 0); p1 = __builtin_amdgcn_mfma_f32_32x32x16_bf16(b1, qr[d0], p1, 0, 0, 0); }
#pragma unroll
              for (int r = 0; r < 16; ++r) { const int k0 = kt * 64 + att::crow(r, hi), k1 = k0 + 32;
                  const bool ok0 = d == 0 ? k0 <= sq : k0 >= sq, ok1 = d == 0 ? k1 <= sq : k1 >= sq;
                  p0[r] = ok0 ? p0[r] * __builtin_amdgcn_exp2f(g[k0] * 1.4426950408889634f - Ms) : 0.f; p1[r] = ok1 ? p1[r] * __builtin_amdgcn_exp2f(g[k1] * 1.4426950408889634f - Ms) : 0.f;
                  rs += p0[r] + p1[r]; }
              att::bf16x8 pa0, pa1, pa2, pa3;
#define PK4(P, BASE, OUT) do { unsigned a0 = att::cvtpk(P[BASE + 0], P[BASE + 1]), a1 = att::cvtpk(P[BASE + 2], P[BASE + 3]);   \
    unsigned b0 = att::cvtpk(P[BASE + 4], P[BASE + 5]), b1 = att::cvtpk(P[BASE + 6], P[BASE + 7]);                              \
    auto r0 = __builtin_amdgcn_permlane32_swap(a0, b0, false, false); auto r1 = __builtin_amdgcn_permlane32_swap(a1, b1, false, false); \
    att::u32x4 w = {r0[0], r1[0], r0[1], r1[1]}; OUT = *reinterpret_cast<att::bf16x8*>(&w); } while (0)
              PK4(p0, 0, pa0); PK4(p0, 8, pa1); PK4(p1, 0, pa2); PK4(p1, 8, pa3);
#undef PK4
              att::pv_d0(o, vb0 + kt * 8192, pa0, pa1, pa2, pa3);
          }
      }
      att::f32x16 ic[2] = {};
#pragma unroll
      for (int vt = 0; vt < 2; ++vt)
#pragma unroll
          for (int d0 = 0; d0 < 4; ++d0) { const att::bf16x8 cb = *reinterpret_cast<const att::bf16x8*>(C0 + (d * 64 + vt * 32 + r32) * 72 + d0 * 16 + hi * 8);
              ic[vt] = __builtin_amdgcn_mfma_f32_32x32x16_bf16(qr[d0], cb, ic[vt], 0, 0, 0); }
      float nq = 0.f;
#pragma unroll
      for (int d0 = 0; d0 < 4; ++d0)
#pragma unroll
          for (int x = 0; x < 8; ++x) nq += bf2f((unsigned short)qr[d0][x]) * N0[d * 64 + d0 * 16 + hi * 8 + x];
      { auto rr = __builtin_amdgcn_permlane32_swap(__float_as_uint(nq), __float_as_uint(nq), false, false); nq = __uint_as_float(rr[0]) + __uint_as_float(rr[1]); }
      { auto rr = __builtin_amdgcn_permlane32_swap(__float_as_uint(rs), __float_as_uint(rs), false, false); rs = __uint_as_float(rr[0]) + __uint_as_float(rr[1]); }
      const float den = rs + wiv[sq] * nq, dn = fmaxf(fabsf(den), emtv[sq]);
      if (hi == 0) WS[r32] = __builtin_amdgcn_rcpf(dn);
      asm volatile("s_waitcnt lgkmcnt(0)" ::: "memory");
#pragma unroll
      for (int r = 0; r < 16; ++r) { const int row = att::crow(r, hi), tt = qb * 32 + row; const float inv = WS[row], wi = wiv[tt];
#pragma unroll
          for (int vt = 0; vt < 2; ++vt) HX[(d * 128 + tt) * 68 + vt * 32 + r32] = (o[vt][r] + wi * ic[vt][r]) * inv; }
    }
    __syncthreads();
    { const int tt = tid >> 2, v0 = (tid & 3) * 16, t = t0 + tt; float hv[16]; float s = 0.f;
#pragma unroll
      for (int i = 0; i < 16; ++i) { hv[i] = HX[tt * 68 + v0 + i] + HX[(128 + tt) * 68 + v0 + i]; s += hv[i]; }
      s += __shfl_xor(s, 1); s += __shfl_xor(s, 2); const float mu = s * (1.f / 64.f); float vs = 0.f;
#pragma unroll
      for (int i = 0; i < 16; ++i) { hv[i] -= mu; vs += hv[i] * hv[i]; }
      vs += __shfl_xor(vs, 1); vs += __shfl_xor(vs, 2); const float rstd = 1.f / sqrtf(vs * (1.f / 64.f) + EPS);
#pragma unroll
      for (int i = 0; i < 16; ++i) { const int c = h * 64 + v0 + i;
          const float y = hv[i] * rstd * p.in[I_MNG][(size_t)l * 256 + c] + p.in[I_MSK][(size_t)l * 256 + c] * bf2f(q2.XCM16[(size_t)t * 256 + c]);
          Y(t, 768 + c, y * fast_silu(U(t, OFF_MZ + c))); } }
    __syncthreads();
}
typedef float f32x4_t __attribute__((ext_vector_type(4)));

__device__ __forceinline__ void row_norm_mod(f32x4 (&v)[4], const float* g, const float* sc, const float* sh, int lane) {
    float s = 0.f;
#pragma unroll
    for (int j = 0; j < 4; ++j) s += (v[j].x * v[j].x + v[j].y * v[j].y) + (v[j].z * v[j].z + v[j].w * v[j].w);
    const float rstd = 1.f / sqrtf(wave_sum(s) * (1.f / D) + EPS);
#pragma unroll
    for (int j = 0; j < 4; ++j) { const int k = (j * 64 + lane) * 4; const f32x4 gv = *(const f32x4*)(g + k);
        if (sc) { const f32x4 scv = *(const f32x4*)(sc + k), shv = *(const f32x4*)(sh + k); v[j] = v[j] * rstd * gv * (scv + 1.f) + shv; } else v[j] = v[j] * rstd * gv; }
}
__device__ __forceinline__ void row_store_bf16(bf16* dst, const f32x4 (&v)[4], int lane) {
#pragma unroll
    for (int j = 0; j < 4; ++j) { u32x2 w; w.x = pk2(v[j].x, v[j].y); w.y = pk2(v[j].z, v[j].w); *(u32x2*)(dst + (j * 64 + lane) * 4) = w; }
}
__device__ __forceinline__ void rp_first(const P& p, const Q& q, int gw, int ngw, int lane) {
    for (int t = gw; t < NT; t += ngw) { const int b = t / TPB, i = t % TPB; const float* src = i < CTX ? p.in[I_CTX] + ((size_t)b * CTX + i) * D : p.in[I_X] + ((size_t)b * SEQ + (i - CTX)) * D;
        f32x4 v[4];
#pragma unroll
        for (int j = 0; j < 4; ++j) v[j] = *(const f32x4*)(src + (j * 64 + lane) * 4);
        const int cv = tok_cv(t); row_norm_mod(v, p.in[I_N1G], modp(p, 0, cv, 1), modp(p, 0, cv, 0), lane); row_store_bf16(q.H16 + (size_t)t * D, v, lane); }
}
__device__ __forceinline__ void rp_end(const P& p, const Q& q, const Q2& q2, int l, int gw, int ngw, int lane, float probe_scale = 1.f) {
    const bool last = l + 1 == DEPTH; const int nrows = last ? NB * SEQ : NT;
    for (int r_ = gw; r_ < nrows; r_ += ngw) { const int t = last ? (r_ / SEQ) * TPB + CTX + r_ % SEQ : r_; const int cv = tok_cv(t); const float* g2 = modp(p, l, cv, 5); f32x4 v[4];
#pragma unroll
        for (int j = 0; j < 4; ++j) { const int k = (j * 64 + lane) * 4; f32x4 s = {0.f, 0.f, 0.f, 0.f};
#pragma unroll
            for (int e = 0; e < 4; ++e) { const u32x2 w = *(const u32x2*)(q2.YB16 + ((size_t)t * 4 + e) * D + k);
                s.x += __builtin_bit_cast(float, w.x << 16); s.y += __builtin_bit_cast(float, w.x & 0xffff0000u); s.z += __builtin_bit_cast(float, w.y << 16); s.w += __builtin_bit_cast(float, w.y & 0xffff0000u); }
            v[j] = *(const f32x4*)(p.X + (size_t)t * D + k) + *(const f32x4*)(g2 + k) * s * probe_scale; }
        if (l + 1 < DEPTH) {
#pragma unroll
            for (int j = 0; j < 4; ++j) *(f32x4*)(p.X + (size_t)t * D + (j * 64 + lane) * 4) = v[j];
            row_norm_mod(v, p.in[I_N1G] + (size_t)(l + 1) * D, modp(p, l + 1, cv, 1), modp(p, l + 1, cv, 0), lane); row_store_bf16(q.H16 + (size_t)t * D, v, lane);
        } else { const int b = t / TPB, i = t % TPB; if (i < CTX) continue;
            row_norm_mod(v, p.in[I_FG], nullptr, nullptr, lane);
#pragma unroll
            for (int j = 0; j < 4; ++j) *(f32x4*)(p.out + ((size_t)b * SEQ + (i - CTX)) * D + (j * 64 + lane) * 4) = v[j]; }
    }
}
constexpr int RPM_LDS = 89024;
__device__ __forceinline__ void rp_mid(const P& p, const Q& q, float* GLIST, int l, char* lds, int G, int bid, bool latent_only, bool probe_nolist = false) {
    int tid_ = TIDX; asm volatile("" : "+v"(tid_));
    const int tid = tid_, wave = tid >> 6, lane = tid & 63;
    float* HS = (float*)lds; float* PART = (float*)(lds + 65664); float* LG = (float*)(lds + 82048); int* LCNT = (int*)(lds + 84096); int* LBASE = (int*)(lds + 84224); int* PEND = (int*)(lds + 84352); int* NPEND = (int*)(lds + 88960);
    if (tid < 32) LCNT[tid] = 0; if (tid == 32) NPEND[0] = 0;
    float B0[32], B1[32]; const float* Wr = p.in[I_WR] + (size_t)l * D * NE;
#pragma unroll
    for (int ks = 0; ks < 32; ++ks) { const int k = 128 * wave + 4 * ks + (lane >> 4); B0[ks] = Wr[(size_t)k * NE + (lane & 15)]; B1[ks] = Wr[(size_t)k * NE + 16 + (lane & 15)]; }
    __syncthreads();
    const int nitems = latent_only ? NB * SEQ / 16 : NT / 16;
    for (int it_ = bid; it_ < nitems; it_ += G) { const int it = latent_only ? (it_ / (SEQ / 16)) * (TPB / 16) + CTX / 16 + it_ % (SEQ / 16) : it_;
#pragma unroll 1
        for (int rr = 0; rr < 2; ++rr) { const int row = 2 * wave + rr, t = it * 16 + row, cv = tok_cv(t); f32x4 v[4];
#pragma unroll
            for (int j = 0; j < 4; ++j) v[j] = *(const f32x4*)(p.X + (size_t)t * D + (j * 64 + lane) * 4);
            row_norm_mod(v, p.in[I_N2G] + (size_t)l * D, modp(p, l, cv, 4), modp(p, l, cv, 3), lane); row_store_bf16(q.H16 + (size_t)t * D, v, lane);
#pragma unroll
            for (int j = 0; j < 4; ++j) { float* d = HS + row * 1026 + (j * 64 + lane) * 4; *(float2*)d = make_float2(v[j].x, v[j].y); *(float2*)(d + 2) = make_float2(v[j].z, v[j].w); } }
        __syncthreads();
        { f32x4_t a0 = {0.f, 0.f, 0.f, 0.f}, a1 = a0; const float* hrow = HS + (lane & 15) * 1026 + 128 * wave + (lane >> 4);
#pragma unroll
          for (int ks = 0; ks < 32; ++ks) { const float a = hrow[4 * ks]; a0 = __builtin_amdgcn_mfma_f32_16x16x4f32(a, B0[ks], a0, 0, 0, 0); a1 = __builtin_amdgcn_mfma_f32_16x16x4f32(a, B1[ks], a1, 0, 0, 0); }
#pragma unroll
          for (int r = 0; r < 4; ++r) { const int row = (lane >> 4) * 4 + r; PART[(wave * 16 + row) * 32 + (lane & 15)] = a0[r]; PART[(wave * 16 + row) * 32 + 16 + (lane & 15)] = a1[r]; } }
        __syncthreads();
        { float s = p.in[I_BR][(size_t)l * NE + (tid & 31)];
#pragma unroll
          for (int w = 0; w < 8; ++w) s += PART[w * 512 + tid];
          LG[tid] = s; }
        __syncthreads();
        if (tid < 16) { const int t = it * 16 + tid; float lg[NE];
#pragma unroll
            for (int e = 0; e < NE; ++e) lg[e] = LG[tid * 32 + e];
            int te[TOPK]; float tv[TOPK];
#pragma unroll
            for (int r = 0; r < TOPK; ++r) { float best = -3.0e38f; int bi = 0;
#pragma unroll
                for (int e = 0; e < NE; ++e) { const bool c = lg[e] > best; best = c ? lg[e] : best; bi = c ? e : bi; }
                te[r] = bi; tv[r] = best;
#pragma unroll
                for (int e = 0; e < NE; ++e) lg[e] = (e == bi) ? -3.0e38f : lg[e]; }
            float ssum = 0.f, ex[TOPK];
#pragma unroll
            for (int r = 0; r < TOPK; ++r) { ex[r] = __expf(tv[r] - tv[0]); ssum += ex[r]; }
            const float inv = 1.f / ssum;
#pragma unroll
            for (int r = 0; r < TOPK; ++r) { p.TOPG[t * TOPK + r] = ex[r] * inv; const int lp = atomicAdd(&LCNT[te[r]], 1); const int slot = atomicAdd(NPEND, 1);
                PEND[slot * 3] = t * TOPK + r; PEND[slot * 3 + 1] = (te[r] << 16) | lp; PEND[slot * 3 + 2] = __float_as_int(ex[r] * inv); } }
        __syncthreads();
    }
    if (probe_nolist) return;
    if (tid < 32) LBASE[tid] = LCNT[tid] > 0 ? atomicAdd(&p.CNT[tid], LCNT[tid]) : 0;
    __syncthreads();
    for (int i = tid; i < NPEND[0]; i += 512) { const int pr = PEND[i * 3], x = PEND[i * 3 + 1], e = x >> 16, lp = x & 0xffff; p.LIST[(size_t)e * NT + LBASE[e] + lp] = pr; GLIST[(size_t)e * NT + LBASE[e] + lp] = __int_as_float(PEND[i * 3 + 2]); }
    __syncthreads();
}
struct EpiDown16 {
    static constexpr bool PERM = true; bf16* YB; const float* bd; const float* GL; const int* CNT; const int* LIST; int nN; int probe_skip;
    __device__ __forceinline__ void operator()(const pg8::f32x4 (&acc)[2][2][4][2], const pg8::Unit& u, int wr, int wc, int fr, int fq) const {
        if (probe_skip) return;
        const int ntile = u.pn - u.e * nN, cnt = CNT[u.e]; const float* b = bd + (size_t)u.e * D;
        int pr[2][4]; float gt[2][4];
#pragma unroll
        for (int ai = 0; ai < 2; ++ai)
#pragma unroll
            for (int m = 0; m < 4; ++m) { const int idx = u.mb * 256 + ai * 128 + wr * 64 + m * 16 + fr, ic = idx < cnt ? idx : 0; pr[ai][m] = LIST[(size_t)u.e * NT + ic]; gt[ai][m] = GL[(size_t)u.e * NT + ic]; }
        pg8::f32x4 bv[2][2];
#pragma unroll
        for (int bj = 0; bj < 2; ++bj) { const int c = ntile * 256 + bj * 128 + wc * 32 + 8 * fq; bv[bj][0] = *(const pg8::f32x4*)(b + c); bv[bj][1] = *(const pg8::f32x4*)(b + c + 4); }
#pragma unroll
        for (int ai = 0; ai < 2; ++ai)
#pragma unroll
            for (int m = 0; m < 4; ++m) { const int idx = u.mb * 256 + ai * 128 + wr * 64 + m * 16 + fr;
                if (idx < cnt) { const float g = gt[ai][m];
#pragma unroll
                    for (int bj = 0; bj < 2; ++bj) { const int c = ntile * 256 + bj * 128 + wc * 32 + 8 * fq;
                        const pg8::f32x4 v0 = (acc[ai][bj][m][0] + bv[bj][0]) * g, v1 = (acc[ai][bj][m][1] + bv[bj][1]) * g;
                        u32x4 w; w.x = pg8::cvt_pk_bf16(v0[0], v0[1]); w.y = pg8::cvt_pk_bf16(v0[2], v0[3]); w.z = pg8::cvt_pk_bf16(v1[0], v1[1]); w.w = pg8::cvt_pk_bf16(v1[2], v1[3]);
                        *(u32x4*)(YB + (size_t)pr[ai][m] * D + c) = w; } } }
    }
};
__device__ __forceinline__ void opt_moe_down16(const P& p, const Q& q, const Q2& q2, int l, LAS unsigned char* lds, int G, int bid, int probe_skip = 0) {
    pg8::Gemm g{q.ACT16, q.WtDn + (size_t)l * NE * D * DE, DE}; DnOrder S; S.init(p.CNT, p.LIST, D / 256, G, bid, (LAS int*)(lds + pg8::STAGE_BYTES));
    EpiDown16 E{q2.YB16, p.in[I_BD] + (size_t)l * NE * D, q2.GLIST, p.CNT, p.LIST, D / 256, probe_skip}; pg8::gemm_phase<EpiDown16, DnOrder, true>(lds, g, S, E);
}
#define GAS __attribute__((address_space(1)))
typedef GAS unsigned gu32;
#define XB_TMO      128
#define XB_XCNT(j)  (256  + 64 * (j))
#define XB_XSUB(j)  (1280 + 64 * (j))
#define XB_XGEN(j)  (2304 + 64 * (j))
#define XB_TOP      3328
#define XB_TOPGEN   3392
#define XCD_BAR_WORDS 3456
#define XB_SPIN_CAP (1u << 18)

__device__ __forceinline__ unsigned xb_ld(unsigned* p)              { return __hip_atomic_load(p, __ATOMIC_RELAXED, __HIP_MEMORY_SCOPE_AGENT); }
__device__ __forceinline__ unsigned xb_add(unsigned* p, unsigned v) { return __hip_atomic_fetch_add(p, v, __ATOMIC_RELAXED, __HIP_MEMORY_SCOPE_AGENT); }
__device__ __forceinline__ unsigned xb_xcc_id() { return (unsigned)__builtin_amdgcn_s_getreg((3 << 11) | 20) & 0xFu; }
#define XB_SPIN(cond, bar) do { unsigned _sp = 0; while (cond) { __builtin_amdgcn_s_sleep(1); \
    if ((++_sp & 255u) == 0u) { if (xb_ld(&(bar)[XB_TMO])) break; if (_sp > XB_SPIN_CAP) { atomicAdd(&(bar)[XB_TMO], 1u); break; } } } } while (0)

struct XcdBarrier {
    unsigned* bar; unsigned x;
    volatile LAS unsigned* st;
};

__device__ __forceinline__ XcdBarrier xcd_barrier_post(unsigned* bar, volatile LAS unsigned* st) {
    XcdBarrier b; b.bar = bar; b.x = xb_xcc_id(); b.st = st;
    if (TIDX == 0) (void)xb_add(&bar[XB_XCNT(b.x)], 1u);
    return b;
}
__device__ __forceinline__ void xcd_barrier_complete(unsigned* bar, unsigned x, unsigned& nloc, unsigned& nx) {
    const unsigned G = gridDim.x * gridDim.y * gridDim.z;
    unsigned sum, cnt, mine, sp = 0u;
    for (;;) {
        sum = 0u; cnt = 0u; mine = 0u;
#pragma unroll
        for (unsigned j = 0; j < 16; ++j) { const unsigned c = xb_ld(&bar[XB_XCNT(j)]); sum += c; cnt += (c > 0u) ? 1u : 0u; mine = (j == x) ? c : mine; }
        if (sum == G) break;
        __builtin_amdgcn_s_sleep(1);
        if ((++sp & 255u) == 0u) { if (xb_ld(&bar[XB_TMO])) break; if (sp > XB_SPIN_CAP) { atomicAdd(&bar[XB_TMO], 1u); break; } }
    }
    nloc = mine > 0u ? mine : 1u; nx = cnt > 0u ? cnt : 1u;
}

__device__ __forceinline__ void xcd_barrier(const XcdBarrier& b) {
    asm volatile("s_waitcnt vmcnt(0)" ::: "memory");
    __syncthreads();
    if (TIDX == 0) {
        unsigned* bar = b.bar;
        __builtin_amdgcn_s_waitcnt(0);
        unsigned nloc = b.st[0], nx = b.st[1];
        if (nloc == 0u) { xcd_barrier_complete(bar, b.x, nloc, nx); b.st[0] = nloc; b.st[1] = nx; }
        const unsigned old = xb_add(&bar[XB_XSUB(b.x)], 1u);
        const unsigned gen = old / nloc;
        if (old + 1u == (gen + 1u) * nloc) {
            __builtin_amdgcn_fence(__ATOMIC_RELEASE, "agent");
            asm volatile("s_waitcnt vmcnt(0)" ::: "memory");
            const unsigned og = xb_add(&bar[XB_TOP], 1u);
            const unsigned tg = og / nx;
            if (og + 1u == (tg + 1u) * nx) xb_add(&bar[XB_TOPGEN], 1u);
            else XB_SPIN(xb_ld(&bar[XB_TOPGEN]) == tg, bar);
            __builtin_amdgcn_fence(__ATOMIC_ACQUIRE, "agent");
            xb_add(&bar[XB_XGEN(b.x)], 1u);
            asm volatile("s_waitcnt vmcnt(0)" ::: "memory");
        } else {
            XB_SPIN(xb_ld(&bar[XB_XGEN(b.x)]) == gen, bar);
            __builtin_amdgcn_fence(__ATOMIC_ACQUIRE, "agent");
            asm volatile("s_waitcnt vmcnt(0)" ::: "memory");
        }
    }
    __syncthreads();
}
#include <hip/hip_cooperative_groups.h>
#include <cstdio>
namespace cg = cooperative_groups;
#ifndef ONE_LAUNCH
#define ONE_LAUNCH 1
#endif
constexpr int LDS_BYTES = 148480;
static_assert(ML2_LDS <= LDS_BYTES && ML1_LDS <= LDS_BYTES && LRU1_LDS <= LDS_BYTES && RPM_LDS <= LDS_BYTES && att::SHM_ATTN <= LDS_BYTES && pg8::STAGE_BYTES + 1024 + 8192 + 15 * 512 <= LDS_BYTES - 64 - 256, "LDS map");

struct BMap { size_t off[64]; size_t total; };
static inline BMap b_map() {
    BMap m; size_t o = 0; int i = 0;
    auto add = [&](size_t bytes) { m.off[i++] = o; o += (bytes + 255) & ~(size_t)255; };
    add((size_t)DEPTH * 3 * 6 * D * 4);
    add((size_t)SEQ * 16 * 2 * 4);
    add((size_t)NT * D * 4);
    add((size_t)NT * TOPK * 4);
    add((size_t)256);
    add((size_t)NE * NT * 4);
    add((size_t)DEPTH * DINP * D * 2);
    add((size_t)DEPTH * D * DMIX * 2);
    add((size_t)DEPTH * NE * 2 * DE * D * 2);
    add((size_t)DEPTH * NE * D * DE * 2);
    add((size_t)DEPTH * 768 * QRANK * 2);
    add((size_t)DEPTH * 1024 * KVRANK * 2);
    add((size_t)NT * D * 2);
    add((size_t)NT * DMIX * 2);
    add((size_t)SLOT_MAX * DE * 2);
    add((size_t)NT * AH * QKD * 2);
    add((size_t)NT * AH * VD * 2);
    add((size_t)NT * DINP * 2);
    add((size_t)DEPTH * 4 * 256 * 64 * 2);
    add((size_t)DEPTH * 4 * 3 * 4096 * 2);
    add((size_t)DEPTH * 32 * 768 * 2);
    add((size_t)DEPTH * 2 * 256 * 4);
    add((size_t)2 * NT * 256 * 4);
    add((size_t)2 * NT * 256 * 4);
    add((size_t)2 * NB * NCH * 256 * 4);
    add((size_t)2 * NB * NCH * 256 * 4);
    add((size_t)2 * NT * 256 * 2);
    add((size_t)256);
    add((size_t)NT * 768 * 2);
    add((size_t)DEPTH * 1792 * 256 * 2);
    add((size_t)NT * 256 * 2);
    add((size_t)NT * 768 * 2);
    add((size_t)NT * 16 * 4);
    add((size_t)2 * NB * NCH * 4 * 4096 * 4);
    add((size_t)2 * NB * NCH * 4 * 64 * 4);
    add((size_t)2 * NB * NCH * 4 * 2 * 4);
    add((size_t)NT * TOPK * D * 2);
    add((size_t)XCD_BAR_WORDS * 4);
    add((size_t)2 * NB * NCH * 4 * 4096 * 2);
    add((size_t)2 * NB * NCH * 4 * 64 * 4);
    add((size_t)2 * NB * NCH * 4 * 4);
    add((size_t)NE * NT * 4);
    m.total = o; return m;
}
struct Args { P p; Q q; Q2 q2; unsigned* bar; };
static inline void fill_args(Args& a, void* const* d_in, void* d_out, void* d_ws) {
    for (int i = 0; i < N_IN; ++i) a.p.in[i] = (const float*)d_in[i];
    a.p.out = (float*)d_out; char* w = (char*)d_ws; const BMap m = b_map();
    a.p.MOD = (float*)(w + m.off[0]); a.p.ROPET = (float*)(w + m.off[1]); a.p.X = (float*)(w + m.off[2]); a.p.TOPG = (float*)(w + m.off[3]); a.p.CNT = (int*)(w + m.off[4]); a.p.LIST = (int*)(w + m.off[5]);
    a.q.WtIn = (bf16*)(w + m.off[6]); a.q.WtOut = (bf16*)(w + m.off[7]); a.q.WtGu = (bf16*)(w + m.off[8]); a.q.WtDn = (bf16*)(w + m.off[9]); a.q.WtQb = (bf16*)(w + m.off[10]); a.q.WtKvb = (bf16*)(w + m.off[11]);
    a.q.H16 = (bf16*)(w + m.off[12]); a.q.Y16 = (bf16*)(w + m.off[13]); a.q.ACT16 = (bf16*)(w + m.off[14]); a.q.K16 = (bf16*)(w + m.off[15]); a.q.V16 = (bf16*)(w + m.off[16]);
    a.q2.U16 = (bf16*)(w + m.off[17]); a.q2.WtL = (bf16*)(w + m.off[18]); a.q2.WtM = (bf16*)(w + m.off[19]); a.q2.WtG = (bf16*)(w + m.off[20]); a.q2.LSL = (float*)(w + m.off[21]);
    a.q2.HLOC = (bf16*)(w + m.off[22]); a.q2.PCUM = (bf16*)(w + m.off[23]); a.q2.SA = (float*)(w + m.off[24]); a.q2.SB = (float*)(w + m.off[25]);
    a.q2.QN16 = (bf16*)(w + m.off[26]); a.q2.KVN16 = a.q2.QN16 + (size_t)NT * 256;     a.q2.Q16 = (bf16*)(w + m.off[28]); a.q2.WtKvbP = (bf16*)(w + m.off[29]);
    a.q2.XCM16 = (bf16*)(w + m.off[30]); a.q2.QKV16 = (bf16*)(w + m.off[31]); a.q2.GATES = (float*)(w + m.off[32]); a.q2.CLOC = (float*)(w + m.off[33]); a.q2.NLOC = (float*)(w + m.off[34]); a.q2.MLB = (float*)(w + m.off[35]);
    a.q2.YB16 = (bf16*)(w + m.off[36]); a.bar = (unsigned*)(w + m.off[37]); a.q2.CST = (bf16*)(w + m.off[38]); a.q2.NST = (float*)(w + m.off[39]); a.q2.MST = (float*)(w + m.off[40]); a.q2.GLIST = (float*)(w + m.off[41]);
}

struct ULoad16 { const bf16* U; __device__ __forceinline__ float operator()(int t, int col) const { return bf2f(U[(size_t)t * DINP + col]); } };
struct YStore16 { bf16* Y; __device__ __forceinline__ void operator()(int t, int col, float v) const { Y[(size_t)t * DMIX + col] = (bf16)f2bf(v); } };
struct OutY16 { bf16* y; __device__ __forceinline__ void operator()(int row, int col, float v) const { y[(size_t)row * DMIX + col] = (bf16)f2bf(v); } };

enum { ST_INIT = 0, ST_RPFIRST, ST_INPROJ, ST_PREP, ST_MLAPROJ, ST_MIX, ST_OUTPROJ, ST_RPMID, ST_GU, ST_DOWN, ST_RPEND, N_ST };

typedef const __attribute__((address_space(4))) Args* KArgs;
__device__ __forceinline__ KArgs kargs() { KArgs k = (KArgs)__builtin_amdgcn_kernarg_segment_ptr(); asm volatile("" : "+s"(k)); return k; }
__device__ __forceinline__ void run_step(const Args& a, int step, int l_, unsigned char* lds_raw) {
    const int l = l_ & 0xff, sub = l_ >> 8;
    const P& p = a.p; const Q& q = a.q; const Q2& q2 = a.q2;
    LAS unsigned char* lds = (LAS unsigned char*)lds_raw; char* ldsg = (char*)lds_raw;
    int G_ = gridDim.x, bid_ = blockIdx.x; asm volatile("" : "+s"(G_), "+s"(bid_));
    const int G = G_, bid = bid_;
#define THREAD_IDS int tid_ = TIDX; asm volatile("" : "+v"(tid_)); const int tid = tid_, lane = tid & 63, wave = __builtin_amdgcn_readfirstlane(tid >> 6); \
    const int gw = bid * NWAVES + wave, ngw = G * NWAVES; const long gtid = (long)bid * NTHREADS + tid, nthr = (long)G * NTHREADS; (void)lane; (void)gw; (void)ngw; (void)gtid; (void)nthr;
    switch (step) {
    case ST_INIT: { THREAD_IDS
        opt_init_mod(p, ldsg, bid, G); opt_init_rope(p, gtid, nthr); opt_convert_small(p, q2, gtid, nthr); opt_convert_weights(p, q, q2.WtKvbP, lds, gw, ngw, wave, lane); break; }
    case ST_RPFIRST: { THREAD_IDS rp_first(p, q, gw, ngw, lane); break; }
    case ST_INPROJ: opt_inproj16(q, q2, l, lds, G, bid); break;
    case ST_PREP: { THREAD_IDS
        if (gtid < NE) p.CNT[gtid] = 0;
        const ULoad16 U{q2.U16};
        constexpr int NM = NB * NCH, NL = NB * NCH * 4;
        if (G > NM + 8) {
            if (bid < NM) { if (sub == 0 || (sub & 1)) ml1_item(p, q2, l, bid / NCH, bid % NCH, ldsg, U);
                if (sub == 0 || (sub & 2)) lru1_item(p, q2, l, (bid >> 2) / NCH, (bid >> 2) % NCH, bid & 3, ldsg, U); }
            else if (sub == 0 || (sub & 2)) for (int x = NM + (bid - NM); x < NL; x += G - NM) lru1_item(p, q2, l, (x >> 2) / NCH, (x >> 2) % NCH, x & 3, ldsg, U);
        } else for (int it = bid; it < NM + NL; it += G) {
            if (it < NM) { if (sub == 0 || (sub & 1)) ml1_item(p, q2, l, it / NCH, it % NCH, ldsg, U); }
            else if (sub == 0 || (sub & 2)) { const int x = it - NM; lru1_item(p, q2, l, (x >> 2) / NCH, (x >> 2) % NCH, x & 3, ldsg, U); } }
        if (sub == 0 || (sub & 4)) for (int t = gw; t < NT; t += ngw) mla_prep_token(p, q, q2, l, t, lane, U);
        break; }
    case ST_MLAPROJ: { for (int it = G - 1 - bid; it < 64; it += G) ml_scan_item(q2, it, ldsg);
        opt_mla_proj(p, q, q2, l, lds, G, bid); break; }
    case ST_MIX: {
        const ULoad16 U{q2.U16}; const YStore16 Y{q.Y16};
        const int c = bid, vcu = (G % 8 == 0) ? (c % 8) * (G / 8) + c / 8 : c;
        constexpr int QB_LAT = SEQ / 256, QB_CTX = CTX / 256, NU_LAT = NB * AH * QB_LAT, NU_CTX = NB * AH * QB_CTX;
#ifdef ATTN_PROBE_VAR
        if (sub & 1) { struct NoOut { __device__ __forceinline__ void operator()(int, int, float) const {} } noout;
            for (int u = vcu; u < NU_LAT; u += G) { const int bh = u / QB_LAT, qb = u % QB_LAT, b = bh / AH, h = bh % AH, t0 = b * TPB + CTX + qb * 256;
                att::attn_unit<unsigned short, NoOut, ATTN_PROBE_VAR>((const unsigned short*)q2.Q16 + (size_t)t0 * 768 + h * QKD, 768, (const unsigned short*)q.K16 + ((size_t)b * AH + h) * TPB * QKD, (const unsigned short*)q.V16 + ((size_t)b * AH + h) * TPB * VD, TPB, ldsg, noout); } }
        else
#endif
        if (sub == 0 || (sub & 1)) for (int u = vcu; u < NU_LAT; u += G) { const int bh = u / QB_LAT, qb = u % QB_LAT, b = bh / AH, h = bh % AH, t0 = b * TPB + CTX + qb * 256;
            OutY16 out{q.Y16 + (size_t)t0 * DMIX + 256 + h * VD};
            att::attn_unit<unsigned short, OutY16>((const unsigned short*)q2.Q16 + (size_t)t0 * 768 + h * QKD, 768, (const unsigned short*)q.K16 + ((size_t)b * AH + h) * TPB * QKD, (const unsigned short*)q.V16 + ((size_t)b * AH + h) * TPB * VD, TPB, ldsg, out); }
        if ((sub == 0 || (sub & 1)) && l + 1 < DEPTH) for (int u = vcu; u < NU_CTX; u += G) { const int bh = u / QB_CTX, qb = u % QB_CTX, b = bh / AH, h = bh % AH, t0 = b * TPB + qb * 256;
            OutY16 out{q.Y16 + (size_t)t0 * DMIX + 256 + h * VD};
            att::attn_unit<unsigned short, OutY16>((const unsigned short*)q2.Q16 + (size_t)t0 * 768 + h * QKD, 768, (const unsigned short*)q.K16 + ((size_t)b * AH + h) * TPB * QKD, (const unsigned short*)q.V16 + ((size_t)b * AH + h) * TPB * VD, CTX, ldsg, out); }
        const int ch0 = (l + 1 < DEPTH) ? 0 : NCH_CTX, nch = NCH - ch0;
        if (sub == 0 || (sub & 2)) for (int it = G - 1 - c; it < NB * nch * 4; it += G) { const int x = it >> 2; ml2_item(p, q2, l, x / nch, ch0 + x % nch, it & 3, ldsg, U, Y); }
        if (sub == 0 || (sub & 4)) for (int it = c; it < NB * nch; it += G) lru2_item(q2, q.Y16, it / nch, ch0 + it % nch, ldsg);
        break; }
    case ST_OUTPROJ: opt_outproj(p, q, l, lds, G, bid, l + 1 == DEPTH); break;
    case ST_RPMID: rp_mid(p, q, q2.GLIST, l, ldsg, G, bid, l + 1 == DEPTH, sub != 0); break;
    case ST_GU: opt_moe_gu(p, q, l, lds, G, bid, sub); break;
    case ST_DOWN: opt_moe_down16(p, q, q2, l, lds, G, bid, sub); break;
    case ST_RPEND: { THREAD_IDS rp_end(p, q, q2, l, gw, ngw, lane, sub != 0 ? 0.f : 1.f); break; }
    }
}

#if ONE_LAUNCH
__global__ void __launch_bounds__(512, 2) k_mega(Args a) {
    extern __shared__ __attribute__((aligned(16))) unsigned char lds_raw[];
    volatile LAS unsigned* MISC = (volatile LAS unsigned*)((LAS unsigned char*)lds_raw + LDS_BYTES - 64);
    if (threadIdx.x < 16) MISC[threadIdx.x] = 0u;
    if ((threadIdx.x & 63) == 0) ((LAS int*)((LAS unsigned char*)lds_raw + WTAB_OFF))[HWID()] = threadIdx.x >> 6;
    __syncthreads();
    { const XcdBarrier b0 = xcd_barrier_post(a.bar, MISC + 8); if (TIDX == 0) MISC[10] = b0.x; }
#define GRID_BAR() do { XcdBarrier b_; b_.bar = a.bar; b_.st = MISC + 8; b_.x = MISC[10]; xcd_barrier(b_); } while (0)
    run_step(a, ST_INIT, 0, lds_raw); GRID_BAR();
    run_step(a, ST_RPFIRST, 0, lds_raw); GRID_BAR();
#pragma unroll 1
    for (int l = 0; l < DEPTH; ++l) {
#pragma unroll 1
        for (int s = ST_INPROJ; s <= ST_RPEND; ++s) { run_step(a, s, l, lds_raw); if (!(l == DEPTH - 1 && s == ST_RPEND)) GRID_BAR();
#ifdef MEGA_DUP_STEP
            if (s == MEGA_DUP_STEP) { run_step(a, s, l, lds_raw); GRID_BAR(); }
#endif
        }
    }
}
#else
template <int STEP>
__global__ void __launch_bounds__(512, 2) k_step(Args a, int l) {
    extern __shared__ __attribute__((aligned(16))) unsigned char lds_raw[];
    run_step(a, STEP, l, lds_raw);
}
template <int STEP> static void launch_step(const Args& a, int l, hipStream_t stream) {
    static bool attr = false;
    if (!attr) { (void)hipFuncSetAttribute((const void*)k_step<STEP>, hipFuncAttributeMaxDynamicSharedMemorySize, LDS_BYTES); attr = true; }
    hipLaunchKernelGGL(k_step<STEP>, dim3(256), dim3(512), LDS_BYTES, stream, a, l);
}
#endif

extern "C" void kernel_launch(void* const* d_in, const int* in_sizes, int n_in, void* d_out, int out_size, void* d_ws, size_t ws_size, hipStream_t stream) {
    static int grid_blocks = 0;
    if (!grid_blocks) {
        int dev = 0, cus = 0;
        (void)hipGetDevice(&dev); (void)hipDeviceGetAttribute(&cus, hipDeviceAttributeMultiprocessorCount, dev);
        grid_blocks = cus;
#if ONE_LAUNCH
        int per_cu = 0;
        (void)hipFuncSetAttribute((const void*)k_mega, hipFuncAttributeMaxDynamicSharedMemorySize, LDS_BYTES);
        (void)hipOccupancyMaxActiveBlocksPerMultiprocessor(&per_cu, (const void*)k_mega, 512, LDS_BYTES);
        if (per_cu < 1) fprintf(stderr, "kernel_launch: occupancy query reports %d workgroups per CU\n", per_cu);
#endif
        const BMap m = b_map();
        if (n_in != N_IN || m.total > ws_size) fprintf(stderr, "kernel_launch: bad n_in %d or workspace too small (%zu needed, %zu given)\n", n_in, m.total, ws_size);
    }
    Args a{}; fill_args(a, d_in, d_out, d_ws);
#if ONE_LAUNCH
    (void)hipMemsetAsync(a.bar, 0, XCD_BAR_WORDS * 4, stream);
    void* args[] = {&a};
    hipError_t e = hipLaunchCooperativeKernel((const void*)k_mega, dim3(grid_blocks), dim3(512), args, LDS_BYTES, stream);
    if (e != hipSuccess) fprintf(stderr, "cooperative launch failed: %s (grid %d)\n", hipGetErrorString(e), grid_blocks);
#else
#ifndef DUP_STEP
#define DUP_STEP -1
#endif
#ifndef DUP_SUB
#define DUP_SUB 0
#endif
#define LS(ST, l) do { launch_step<ST>(a, l, stream); if (ST == DUP_STEP) launch_step<ST>(a, (l) | (DUP_SUB << 8), stream); } while (0)
    LS(ST_INIT, 0); LS(ST_RPFIRST, 0);
    for (int l = 0; l < DEPTH; ++l) {
        LS(ST_INPROJ, l); LS(ST_PREP, l); LS(ST_MLAPROJ, l); LS(ST_MIX, l); LS(ST_OUTPROJ, l);
        LS(ST_RPMID, l); LS(ST_GU, l); LS(ST_DOWN, l); LS(ST_RPEND, l);
    }
#endif
}
```

```cpp
#include <hip/hip_runtime.h>
#define ONE_LAUNCH 1
#include <math.h>
#include <stdint.h>

#ifndef CFG_D_MODEL
#define CFG_D_MODEL 1024
#endif
#ifndef CFG_SEQ
#define CFG_SEQ 8192
#endif
#ifndef CFG_GRID_W
#define CFG_GRID_W 64
#endif
#ifndef CFG_CTX_LEN
#define CFG_CTX_LEN 256
#endif
#ifndef CFG_N_EXPERTS
#define CFG_N_EXPERTS 32
#endif
#ifndef CFG_D_EXPERT
#define CFG_D_EXPERT 1024
#endif

#ifdef HOST_TEST
#define HD inline
struct float4 { float x, y, z, w; };
static inline int atomic_add_i(int* p, int v) { int o = *p; *p = o + v; return o; }
#else
#define HD __device__ __forceinline__
static __device__ __forceinline__ int atomic_add_i(int* p, int v) { return atomicAdd(p, v); }
#endif

constexpr int D = CFG_D_MODEL, NB = 2, SEQ = CFG_SEQ, DEPTH = 2, GRID_W = CFG_GRID_W, CTX = CFG_CTX_LEN;
constexpr int TPB = CTX + SEQ;
constexpr int NT = NB * TPB;
constexpr int LW = 256, MLH = 4, MHD = 64, MW = 256;
constexpr int AH = 8, NOPE = 64, ROPE = 32, VD = 64, QRANK = 256, KVRANK = 128, QKD = NOPE + ROPE;
constexpr int DIN = 1440, DMIX = 1024;
constexpr int OFF_AX = 0, OFF_AG = 256, OFF_BQ = 512, OFF_BKV = 768, OFF_BKR = 896, OFF_MX = 928, OFF_MZ = 1184;
constexpr int NE = CFG_N_EXPERTS, TOPK = 4, DE = CFG_D_EXPERT;
constexpr float EPS = 1e-6f;

enum { I_X = 0, I_C, I_CTX, I_CCTX, I_N1G, I_N2G, I_WMOD, I_BMOD, I_WIN, I_WOUT, I_LCW, I_LCB, I_LWA, I_LBA, I_LWX, I_LBX, I_LLAM,
       I_QNG, I_WQB, I_KVNG, I_WKVB, I_MCW, I_MCB, I_MWQ, I_MWK, I_MWV, I_MWG, I_MBG, I_MNG, I_MSK, I_WR, I_BR, I_WGU, I_BGU, I_WD, I_BD, I_FG, N_IN };

struct P {
    const float* in[N_IN];
    float* out;
    float *MOD, *ROPET, *X, *H, *U, *XC, *LA, *LB, *HL, *QN, *KVN, *QF, *KVF, *Qr, *Kr, *Vr, *XCM, *QM, *KM, *VM, *IGF, *HM, *Y, *TOPG, *ACT, *YB;
    int *TOPE, *CNT, *LIST;
};

HD float sigmoid_f(float x) { return 1.f / (1.f + expf(-x)); }
HD float silu_f(float x) { return x * sigmoid_f(x); }
HD float logsigmoid_f(float x) { return fminf(x, 0.f) - log1pf(expf(-fabsf(x))); }
HD float gelu_f(float x) { return 0.5f * x * (1.f + tanhf(0.7978845608028654f * (x + 0.044715f * x * x * x))); }

HD int tok_b(int t) { return t / TPB; }
HD int tok_i(int t) { return t % TPB; }
HD bool tok_isctx(int t) { return tok_i(t) < CTX; }
HD int tok_cv(int t) { return tok_isctx(t) ? 2 : tok_b(t); }
HD const float* modp(const P& p, int l, int cv, int which) { return p.MOD + (((size_t)l * 3 + cv) * 6 + which) * D; }

template <int R>
HD void gemm_rx4(const float* (&a)[R], const float* B, int ldb, int K, float4 (&acc)[R]) {
    for (int k = 0; k < K; ++k) {
        const float4 bv = *(const float4*)(B + (size_t)k * ldb);
#pragma unroll
        for (int r = 0; r < R; ++r) { const float av = a[r][k]; acc[r].x += av * bv.x; acc[r].y += av * bv.y; acc[r].z += av * bv.z; acc[r].w += av * bv.w; }
    }
}

HD void nv_init(const P& p, long gtid, long nthr) {
    for (long it = gtid; it < (long)DEPTH * 6 * D; it += nthr) {
        const int l = (int)(it / (6 * D)), j = (int)(it % (6 * D));
        const float* w = p.in[I_WMOD] + (size_t)l * D * 6 * D + j;
        float a0 = 0.f, a1 = 0.f, a2 = 0.f;
        for (int k = 0; k < D; ++k) { const float wv = w[(size_t)k * 6 * D];
            a0 += silu_f(p.in[I_C][k]) * wv; a1 += silu_f(p.in[I_C][D + k]) * wv; a2 += silu_f(p.in[I_CCTX][k]) * wv; }
        const float bb = p.in[I_BMOD][(size_t)l * 6 * D + j];
        p.MOD[((size_t)l * 3 + 0) * 6 * D + j] = a0 + bb; p.MOD[((size_t)l * 3 + 1) * 6 * D + j] = a1 + bb; p.MOD[((size_t)l * 3 + 2) * 6 * D + j] = a2 + bb;
    }
    for (long it = gtid; it < (long)NT * D; it += nthr) {
        const int t = (int)(it / D), k = (int)(it % D), b = tok_b(t), i = tok_i(t);
        p.X[it] = (i < CTX) ? p.in[I_CTX][((size_t)b * CTX + i) * D + k] : p.in[I_X][((size_t)b * SEQ + (i - CTX)) * D + k];
    }
    for (long it = gtid; it < (long)SEQ * 16; it += nthr) {
        const int s = (int)(it / 16), a = (int)((it / 8) & 1), f = (int)(it & 7);
        const int pos = a == 0 ? s / GRID_W : s % GRID_W;
        const double fr = pow(10000.0, -(double)f / 8.0);
        const float frf = (float)fr;
        const double ang = (double)((float)pos * frf);
        p.ROPET[it * 2] = (float)cos(ang); p.ROPET[it * 2 + 1] = (float)sin(ang);
    }
}

HD void nv_norm(const P& p, int l, int which  , long gtid, long nthr) {
    const float* g = p.in[which == 0 ? I_N1G : I_N2G] + (size_t)l * D;
    for (long t = gtid; t < NT; t += nthr) {
        const float* x = p.X + (size_t)t * D; float ss = 0.f;
        for (int k = 0; k < D; ++k) ss += x[k] * x[k];
        const float rstd = 1.f / sqrtf(ss / (float)D + EPS);
        const int cv = tok_cv((int)t); const float* sh = modp(p, l, cv, which == 0 ? 0 : 3); const float* sc = modp(p, l, cv, which == 0 ? 1 : 4);
        float* h = p.H + (size_t)t * D;
        for (int k = 0; k < D; ++k) h[k] = x[k] * rstd * g[k] * (1.f + sc[k]) + sh[k];
    }
}

HD void nv_inproj(const P& p, int l, long gtid, long nthr) {
    constexpr int R = 8, NQ = DIN / 4; const float* W = p.in[I_WIN] + (size_t)l * D * DIN;
    for (long it = gtid; it < (long)(NT / R) * NQ; it += nthr) {
        const int mi = (int)(it / NQ), n = (int)(it % NQ) * 4;
        const float* a[R]; float4 acc[R];
#pragma unroll
        for (int r = 0; r < R; ++r) { a[r] = p.H + (size_t)(mi * R + r) * D; acc[r] = float4{0.f, 0.f, 0.f, 0.f}; }
        gemm_rx4<R>(a, W + n, DIN, D, acc);
#pragma unroll
        for (int r = 0; r < R; ++r) *(float4*)(p.U + (size_t)(mi * R + r) * DIN + n) = acc[r];
    }
}

HD float conv_at(const P& p, int t, int col, int c, const float* w  , const float* bias) {
    const int i = tok_i(t), isc = i < CTX, li = isc ? i : i - CTX, len = isc ? CTX : SEQ;
    float s = bias[c];
#pragma unroll
    for (int k = 0; k < 4; ++k) { const int j = li + k - 2; if (j >= 0 && j < len) s += w[k * 256 + c] * p.U[(size_t)(t + k - 2) * DIN + col + c]; }
    return s;
}

HD void nv_prep1(const P& p, int l, long gtid, long nthr) {
    for (long it = gtid; it < (long)NT * 256; it += nthr) {
        const int t = (int)(it / 256), c = (int)(it % 256);
        p.XC[it] = conv_at(p, t, OFF_AX, c, p.in[I_LCW] + (size_t)l * 4 * 256, p.in[I_LCB] + (size_t)l * 256);
        p.XCM[it] = silu_f(conv_at(p, t, OFF_MX, c, p.in[I_MCW] + (size_t)l * 4 * 256, p.in[I_MCB] + (size_t)l * 256));
    }
    for (long t = gtid; t < NT; t += nthr) {
        const float* u = p.U + (size_t)t * DIN; float sq = 0.f, sk = 0.f;
        for (int k = 0; k < QRANK; ++k) sq += u[OFF_BQ + k] * u[OFF_BQ + k];
        for (int k = 0; k < KVRANK; ++k) sk += u[OFF_BKV + k] * u[OFF_BKV + k];
        const float rq = 1.f / sqrtf(sq / (float)QRANK + EPS), rk = 1.f / sqrtf(sk / (float)KVRANK + EPS);
        for (int k = 0; k < QRANK; ++k) p.QN[(size_t)t * QRANK + k] = u[OFF_BQ + k] * rq * p.in[I_QNG][(size_t)l * QRANK + k];
        for (int k = 0; k < KVRANK; ++k) p.KVN[(size_t)t * KVRANK + k] = u[OFF_BKV + k] * rk * p.in[I_KVNG][(size_t)l * KVRANK + k];
    }
}

HD void nv_prep2(const P& p, int l, long gtid, long nthr) {
    for (long it = gtid; it < (long)2 * NT * 256; it += nthr) {
        const int d = (int)(it / ((long)NT * 256)), t = (int)((it / 256) % NT), c = (int)(it % 256), g = c / 64, j = c % 64;
        const float* xc = p.XC + (size_t)t * 256 + g * 64;
        const float* wa = p.in[I_LWA] + ((((size_t)l * 2 + d) * 4 + g) * 64) * 64 + j;
        const float* wx = p.in[I_LWX] + ((((size_t)l * 2 + d) * 4 + g) * 64) * 64 + j;
        float sa = 0.f, sx = 0.f;
        for (int i = 0; i < 64; ++i) { sa += xc[i] * wa[i * 64]; sx += xc[i] * wx[i * 64]; }
        const float r = sigmoid_f(sa + p.in[I_LBA][((size_t)l * 2 + d) * 256 + c]), ig = sigmoid_f(sx + p.in[I_LBX][((size_t)l * 2 + d) * 256 + c]);
        const float log_a = 8.0f * r * logsigmoid_f(p.in[I_LLAM][((size_t)l * 2 + d) * 256 + c]);
        p.LA[it] = expf(log_a); p.LB[it] = sqrtf(-expm1f(2.f * log_a)) * ig * p.XC[(size_t)t * 256 + c];
    }
    { constexpr int R = 8, NQ = 768 / 4; const float* W = p.in[I_WQB] + (size_t)l * QRANK * 768;
      for (long it = gtid; it < (long)(NT / R) * NQ; it += nthr) { const int mi = (int)(it / NQ), n = (int)(it % NQ) * 4;
        const float* a[R]; float4 acc[R];
#pragma unroll
        for (int r = 0; r < R; ++r) { a[r] = p.QN + (size_t)(mi * R + r) * QRANK; acc[r] = float4{0.f, 0.f, 0.f, 0.f}; }
        gemm_rx4<R>(a, W + n, 768, QRANK, acc);
#pragma unroll
        for (int r = 0; r < R; ++r) *(float4*)(p.QF + (size_t)(mi * R + r) * 768 + n) = acc[r]; } }
    { constexpr int R = 8, NQ = 1024 / 4; const float* W = p.in[I_WKVB] + (size_t)l * KVRANK * 1024;
      for (long it = gtid; it < (long)(NT / R) * NQ; it += nthr) { const int mi = (int)(it / NQ), n = (int)(it % NQ) * 4;
        const float* a[R]; float4 acc[R];
#pragma unroll
        for (int r = 0; r < R; ++r) { a[r] = p.KVN + (size_t)(mi * R + r) * KVRANK; acc[r] = float4{0.f, 0.f, 0.f, 0.f}; }
        gemm_rx4<R>(a, W + n, 1024, KVRANK, acc);
#pragma unroll
        for (int r = 0; r < R; ++r) *(float4*)(p.KVF + (size_t)(mi * R + r) * 1024 + n) = acc[r]; } }
    for (long it = gtid; it < (long)NT * 256; it += nthr) {
        const int t = (int)(it / 256), c = (int)(it % 256), h = c / 64, j = c % 64;
        const float* xc = p.XCM + (size_t)t * 256 + h * 64; const float* ux = p.U + (size_t)t * DIN + OFF_MX + h * 64;
        const float* wq = p.in[I_MWQ] + (((size_t)l * 4 + h) * 64) * 64 + j; const float* wk = p.in[I_MWK] + (((size_t)l * 4 + h) * 64) * 64 + j; const float* wv = p.in[I_MWV] + (((size_t)l * 4 + h) * 64) * 64 + j;
        float sq = 0.f, sk = 0.f, sv = 0.f;
        for (int i = 0; i < 64; ++i) { sq += xc[i] * wq[i * 64]; sk += xc[i] * wk[i * 64]; sv += ux[i] * wv[i * 64]; }
        p.QM[it] = sq; p.KM[it] = sk * 0.125f; p.VM[it] = sv;
    }
}

HD void nv_prep3(const P& p, int l, long gtid, long nthr) {
    for (long it = gtid; it < (long)NB * 2 * 256; it += nthr) {
        const int b = (int)(it / 512), d = (int)((it / 256) & 1), c = (int)(it % 256);
        const float* A = p.LA + (size_t)d * NT * 256; const float* Bc = p.LB + (size_t)d * NT * 256; float* Ho = p.HL + (size_t)d * NT * 256;
        float h = 0.f;
        for (int seg = 0; seg < 2; ++seg) { const int base = b * TPB + (seg == 0 ? 0 : CTX), len = seg == 0 ? CTX : SEQ;
            for (int s = 0; s < len; ++s) { const int t = base + (d == 0 ? s : len - 1 - s);
                h = A[(size_t)t * 256 + c] * h + Bc[(size_t)t * 256 + c]; Ho[(size_t)t * 256 + c] = h; } }
    }
    for (long it = gtid; it < (long)NT * AH; it += nthr) {
        const int t = (int)(it / AH), h = (int)(it % AH), i = tok_i(t); const bool lat = i >= CTX; const int s = i - CTX;
        const float* qf = p.QF + (size_t)t * 768 + h * QKD; const float* kvf = p.KVF + (size_t)t * 1024 + h * (NOPE + VD); const float* kr = p.U + (size_t)t * DIN + OFF_BKR;
        float* qo = p.Qr + ((size_t)t * AH + h) * QKD; float* ko = p.Kr + ((size_t)t * AH + h) * QKD; float* vo = p.Vr + ((size_t)t * AH + h) * VD;
        for (int k = 0; k < NOPE; ++k) { qo[k] = qf[k]; ko[k] = kvf[k]; vo[k] = kvf[NOPE + k]; }
        for (int a = 0; a < 2; ++a) for (int f = 0; f < 8; ++f) {
            float cs = 1.f, sn = 0.f; if (lat) { cs = p.ROPET[(((size_t)s * 2 + a) * 8 + f) * 2]; sn = p.ROPET[(((size_t)s * 2 + a) * 8 + f) * 2 + 1]; }
            const float q1 = qf[NOPE + a * 16 + f], q2 = qf[NOPE + a * 16 + 8 + f], k1 = kr[a * 16 + f], k2 = kr[a * 16 + 8 + f];
            qo[NOPE + a * 16 + f] = q1 * cs - q2 * sn; qo[NOPE + a * 16 + 8 + f] = q2 * cs + q1 * sn;
            ko[NOPE + a * 16 + f] = k1 * cs - k2 * sn; ko[NOPE + a * 16 + 8 + f] = k2 * cs + k1 * sn; }
    }
    for (long it = gtid; it < (long)2 * NT * 8; it += nthr) {
        const int d = (int)(it / ((long)NT * 8)), t = (int)((it / 8) % NT), g = (int)(it % 8);
        const float* w = p.in[I_MWG] + (((size_t)l * 2 + d) * 768) * 8 + g; float s = p.in[I_MBG][((size_t)l * 2 + d) * 8 + g];
        for (int i = 0; i < 256; ++i) s += p.QM[(size_t)t * 256 + i] * w[(size_t)i * 8];
        for (int i = 0; i < 256; ++i) s += p.KM[(size_t)t * 256 + i] * w[(size_t)(256 + i) * 8];
        for (int i = 0; i < 256; ++i) s += p.VM[(size_t)t * 256 + i] * w[(size_t)(512 + i) * 8];
        p.IGF[it] = g < 4 ? s : logsigmoid_f(s);
    }
}

HD void nv_attn(const P& p, long gtid, long nthr) {
    const float scale = 1.0f / sqrtf((float)QKD);
    for (long it = gtid; it < (long)NT * AH; it += nthr) {
        const int h = (int)((it / TPB) % AH), b = (int)(it / ((long)TPB * AH)), i = (int)(it % TPB), t = b * TPB + i;
        const int nk = i < CTX ? CTX : TPB;
        float q[QKD], o[VD];
#pragma unroll
        for (int k = 0; k < QKD; ++k) q[k] = p.Qr[((size_t)t * AH + h) * QKD + k] * scale;
#pragma unroll
        for (int k = 0; k < VD; ++k) o[k] = 0.f;
        float m = -1e30f, lsum = 0.f;
        for (int j = 0; j < nk; ++j) {
            const float* kk = p.Kr + ((size_t)(b * TPB + j) * AH + h) * QKD; const float* vv = p.Vr + ((size_t)(b * TPB + j) * AH + h) * VD;
            float s = 0.f;
#pragma unroll
            for (int k = 0; k < QKD; ++k) s += q[k] * kk[k];
            if (s > m) { const float f = expf(m - s); lsum *= f;
#pragma unroll
                for (int k = 0; k < VD; ++k) o[k] *= f;
                m = s; }
            const float pr = expf(s - m); lsum += pr;
#pragma unroll
            for (int k = 0; k < VD; ++k) o[k] += pr * vv[k];
        }
        const float inv = 1.f / lsum;
#pragma unroll
        for (int k = 0; k < VD; ++k) p.Y[(size_t)t * DMIX + 256 + h * VD + k] = o[k] * inv;
    }
}
HD void nv_mlstm_scan(const P& p, long gtid, long nthr) {
    for (long it = gtid; it < (long)NB * MLH * 2 * 64; it += nthr) {
        const int v = (int)(it % 64), d = (int)((it / 64) & 1), h = (int)((it / 128) % MLH), b = (int)(it / (128 * MLH));
        float C[64], n[64];
#pragma unroll
        for (int k = 0; k < 64; ++k) { C[k] = 0.f; n[k] = 0.f; }
        float m = 0.f;
        for (int seg = 0; seg < 2; ++seg) { const int base = b * TPB + (seg == 0 ? 0 : CTX), len = seg == 0 ? CTX : SEQ;
            for (int s = 0; s < len; ++s) { const int t = base + (d == 0 ? s : len - 1 - s);
                const float ig = p.IGF[((size_t)d * NT + t) * 8 + h], lf = p.IGF[((size_t)d * NT + t) * 8 + 4 + h];
                const float mn = fmaxf(lf + m, ig), fd = expf(lf + m - mn), iw = expf(ig - mn); m = mn;
                const float* qq = p.QM + (size_t)t * 256 + h * 64; const float* kk = p.KM + (size_t)t * 256 + h * 64; const float vv = p.VM[(size_t)t * 256 + h * 64 + v];
                float num = 0.f, den = 0.f;
#pragma unroll
                for (int k = 0; k < 64; ++k) { const float kv = kk[k], qv = qq[k]; C[k] = fd * C[k] + iw * vv * kv; n[k] = fd * n[k] + iw * kv; num += C[k] * qv; den += n[k] * qv; }
                p.HM[((size_t)d * NT + t) * 256 + h * 64 + v] = num / fmaxf(fabsf(den), expf(-mn)); } }
    }
}
HD void nv_lru_out(const P& p, long gtid, long nthr) {
    for (long it = gtid; it < (long)NT * 256; it += nthr) { const int t = (int)(it / 256), c = (int)(it % 256);
        p.Y[(size_t)t * DMIX + c] = (p.HL[it] + p.HL[(size_t)NT * 256 + it]) * gelu_f(p.U[(size_t)t * DIN + OFF_AG + c]); }
}
HD void nv_mlstm_finish(const P& p, int l, long gtid, long nthr) {
    for (long it = gtid; it < (long)NT * MLH; it += nthr) { const int t = (int)(it / MLH), h = (int)(it % MLH);
        const float* h0 = p.HM + (size_t)t * 256 + h * 64; const float* h1 = p.HM + ((size_t)NT + t) * 256 + h * 64;
        float mu = 0.f; for (int j = 0; j < 64; ++j) mu += h0[j] + h1[j]; mu *= (1.f / 64.f);
        float var = 0.f; for (int j = 0; j < 64; ++j) { const float dlt = h0[j] + h1[j] - mu; var += dlt * dlt; } var *= (1.f / 64.f);
        const float rstd = 1.f / sqrtf(var + EPS);
        for (int j = 0; j < 64; ++j) { const int c = h * 64 + j;
            const float y = (h0[j] + h1[j] - mu) * rstd * p.in[I_MNG][(size_t)l * 256 + c] + p.in[I_MSK][(size_t)l * 256 + c] * p.XCM[(size_t)t * 256 + c];
            p.Y[(size_t)t * DMIX + 768 + c] = y * silu_f(p.U[(size_t)t * DIN + OFF_MZ + c]); } }
}
HD void nv_outproj(const P& p, int l, long gtid, long nthr) {
    constexpr int R = 8, NQ = D / 4; const float* W = p.in[I_WOUT] + (size_t)l * DMIX * D;
    for (long it = gtid; it < (long)(NT / R) * NQ; it += nthr) { const int mi = (int)(it / NQ), n = (int)(it % NQ) * 4;
        const float* a[R]; float4 acc[R];
#pragma unroll
        for (int r = 0; r < R; ++r) { a[r] = p.Y + (size_t)(mi * R + r) * DMIX; acc[r] = float4{0.f, 0.f, 0.f, 0.f}; }
        gemm_rx4<R>(a, W + n, D, DMIX, acc);
#pragma unroll
        for (int r = 0; r < R; ++r) { const int t = mi * R + r; const float* g1 = modp(p, l, tok_cv(t), 2) + n; float* x = p.X + (size_t)t * D + n;
            x[0] += g1[0] * acc[r].x; x[1] += g1[1] * acc[r].y; x[2] += g1[2] * acc[r].z; x[3] += g1[3] * acc[r].w; } }
}
HD void nv_zero_cnt(const P& p, long gtid, long nthr) { for (long i = gtid; i < NE; i += nthr) p.CNT[i] = 0; }
HD void nv_router(const P& p, int l, long gtid, long nthr) {
    for (long t = gtid; t < NT; t += nthr) {
        float lg[NE]; const float* h = p.H + (size_t)t * D; const float* W = p.in[I_WR] + (size_t)l * D * NE;
#pragma unroll
        for (int e = 0; e < NE; ++e) lg[e] = p.in[I_BR][(size_t)l * NE + e];
        for (int k = 0; k < D; ++k) { const float hv = h[k];
#pragma unroll
            for (int e = 0; e < NE; ++e) lg[e] += hv * W[(size_t)k * NE + e]; }
        int te[TOPK]; float tv[TOPK];
#pragma unroll
        for (int r = 0; r < TOPK; ++r) { float best = -3.0e38f; int bi = 0;
#pragma unroll
            for (int e = 0; e < NE; ++e) { const bool c = lg[e] > best; best = c ? lg[e] : best; bi = c ? e : bi; }
            te[r] = bi; tv[r] = best;
#pragma unroll
            for (int e = 0; e < NE; ++e) lg[e] = (e == bi) ? -3.0e38f : lg[e]; }
        float s = 0.f, ex[TOPK];
#pragma unroll
        for (int r = 0; r < TOPK; ++r) { ex[r] = expf(tv[r] - tv[0]); s += ex[r]; }
#pragma unroll
        for (int r = 0; r < TOPK; ++r) { p.TOPE[t * TOPK + r] = te[r]; p.TOPG[t * TOPK + r] = ex[r] / s;
            const int pos = atomic_add_i(&p.CNT[te[r]], 1); p.LIST[(size_t)te[r] * NT + pos] = (int)t * TOPK + r; }
    }
}
HD bool moe_item(const P& p, int R, long grp, int& e, int& r0) {
    long acc = 0;
    for (int x = 0; x < NE; ++x) { const int c = p.CNT[x], ng = (c + R - 1) / R; if (grp < acc + ng) { e = x; r0 = (int)(grp - acc) * R; return true; } acc += ng; }
    return false;
}
HD long moe_groups(const P& p, int R) { long acc = 0; for (int x = 0; x < NE; ++x) acc += (p.CNT[x] + R - 1) / R; return acc; }
HD void nv_moe_gu(const P& p, int l, long gtid, long nthr) {
    constexpr int R = 8, NQ = DE / 4; const long ngrp = moe_groups(p, R);
    for (long it = gtid; it < ngrp * NQ; it += nthr) { int e, r0; moe_item(p, R, it / NQ, e, r0); const int n = (int)(it % NQ) * 4, cnt = p.CNT[e];
        const float* Wg = p.in[I_WGU] + ((size_t)l * NE + e) * D * 2 * DE; const float* bg = p.in[I_BGU] + ((size_t)l * NE + e) * 2 * DE;
        const float* a[R]; int pr[R]; float4 ag[R], al[R];
#pragma unroll
        for (int r = 0; r < R; ++r) { const int rr = r0 + r < cnt ? r0 + r : cnt - 1; pr[r] = p.LIST[(size_t)e * NT + rr]; a[r] = p.H + (size_t)(pr[r] / TOPK) * D; ag[r] = float4{0.f, 0.f, 0.f, 0.f}; al[r] = float4{0.f, 0.f, 0.f, 0.f}; }
        gemm_rx4<R>(a, Wg + n, 2 * DE, D, ag);
        gemm_rx4<R>(a, Wg + DE + n, 2 * DE, D, al);
#pragma unroll
        for (int r = 0; r < R; ++r) if (r0 + r < cnt) { float gv[4] = {ag[r].x + bg[n], ag[r].y + bg[n + 1], ag[r].z + bg[n + 2], ag[r].w + bg[n + 3]};
            float lv[4] = {al[r].x + bg[DE + n], al[r].y + bg[DE + n + 1], al[r].z + bg[DE + n + 2], al[r].w + bg[DE + n + 3]};
#pragma unroll
            for (int q = 0; q < 4; ++q) { const float glu = fminf(gv[q], 7.0f), lin = fminf(fmaxf(lv[q], -7.0f), 7.0f);
                p.ACT[(size_t)pr[r] * DE + n + q] = glu * sigmoid_f(1.702f * glu) * (lin + 1.f); } }
    }
}
HD void nv_moe_down(const P& p, int l, long gtid, long nthr) {
    constexpr int R = 8, NQ = D / 4; const long ngrp = moe_groups(p, R);
    for (long it = gtid; it < ngrp * NQ; it += nthr) { int e, r0; moe_item(p, R, it / NQ, e, r0); const int n = (int)(it % NQ) * 4, cnt = p.CNT[e];
        const float* Wd = p.in[I_WD] + ((size_t)l * NE + e) * DE * D; const float* bd = p.in[I_BD] + ((size_t)l * NE + e) * D;
        const float* a[R]; int pr[R]; float4 acc[R];
#pragma unroll
        for (int r = 0; r < R; ++r) { const int rr = r0 + r < cnt ? r0 + r : cnt - 1; pr[r] = p.LIST[(size_t)e * NT + rr]; a[r] = p.ACT + (size_t)pr[r] * DE; acc[r] = float4{0.f, 0.f, 0.f, 0.f}; }
        gemm_rx4<R>(a, Wd + n, D, DE, acc);
#pragma unroll
        for (int r = 0; r < R; ++r) if (r0 + r < cnt) { const float g = p.TOPG[pr[r]]; float* y = p.YB + (size_t)pr[r] * D + n;
            y[0] = g * (acc[r].x + bd[n]); y[1] = g * (acc[r].y + bd[n + 1]); y[2] = g * (acc[r].z + bd[n + 2]); y[3] = g * (acc[r].w + bd[n + 3]); }
    }
}
HD void nv_combine(const P& p, int l, long gtid, long nthr) {
    for (long it = gtid; it < (long)NT * D; it += nthr) { const int t = (int)(it / D), n = (int)(it % D);
        const float s = ((p.YB[((size_t)t * 4 + 0) * D + n] + p.YB[((size_t)t * 4 + 1) * D + n]) + p.YB[((size_t)t * 4 + 2) * D + n]) + p.YB[((size_t)t * 4 + 3) * D + n];
        p.X[it] += modp(p, l, tok_cv(t), 5)[n] * s; }
}
HD void nv_final(const P& p, long gtid, long nthr) {
    for (long r = gtid; r < (long)NB * SEQ; r += nthr) { const int b = (int)(r / SEQ), s = (int)(r % SEQ), t = b * TPB + CTX + s;
        const float* x = p.X + (size_t)t * D; float ss = 0.f;
        for (int k = 0; k < D; ++k) ss += x[k] * x[k];
        const float rstd = 1.f / sqrtf(ss / (float)D + EPS);
        for (int k = 0; k < D; ++k) p.out[(size_t)r * D + k] = x[k] * rstd * p.in[I_FG][k]; }
}

constexpr int PH_PER_LAYER = 13, N_PHASES = 1 + DEPTH * PH_PER_LAYER + 1;
HD void nv_run_phase(const P& p, int ph, long gtid, long nthr) {
    if (ph == 0) { nv_init(p, gtid, nthr); return; }
    if (ph == N_PHASES - 1) { nv_final(p, gtid, nthr); return; }
    const int l = (ph - 1) / PH_PER_LAYER, s = (ph - 1) % PH_PER_LAYER;
    switch (s) {
        case 0: nv_norm(p, l, 0, gtid, nthr); break;
        case 1: nv_inproj(p, l, gtid, nthr); break;
        case 2: nv_prep1(p, l, gtid, nthr); break;
        case 3: nv_prep2(p, l, gtid, nthr); break;
        case 4: nv_prep3(p, l, gtid, nthr); break;
        case 5: nv_mlstm_scan(p, gtid, nthr); nv_attn(p, gtid, nthr); nv_lru_out(p, gtid, nthr); break;
        case 6: nv_mlstm_finish(p, l, gtid, nthr); break;
        case 7: nv_outproj(p, l, gtid, nthr); break;
        case 8: nv_norm(p, l, 1, gtid, nthr); nv_zero_cnt(p, gtid, nthr); break;
        case 9: nv_router(p, l, gtid, nthr); break;
        case 10: nv_moe_gu(p, l, gtid, nthr); break;
        case 11: nv_moe_down(p, l, gtid, nthr); break;
        case 12: nv_combine(p, l, gtid, nthr); break;
    }
}

struct WsMap { size_t off[32]; size_t total; };
static inline WsMap ws_map() {
    WsMap m; size_t o = 0; int i = 0;
    auto add = [&](size_t n) { m.off[i++] = o; o += (n + 63) & ~(size_t)63; };
    add((size_t)DEPTH * 3 * 6 * D);
    add((size_t)SEQ * 16 * 2);
    add((size_t)NT * D);
    add((size_t)NT * D);
    add((size_t)NT * DIN);
    add((size_t)NT * 256);
    add((size_t)2 * NT * 256);
    add((size_t)2 * NT * 256);
    add((size_t)2 * NT * 256);
    add((size_t)NT * QRANK);
    add((size_t)NT * KVRANK);
    add((size_t)NT * 768);
    add((size_t)NT * 1024);
    add((size_t)NT * AH * QKD);
    add((size_t)NT * AH * QKD);
    add((size_t)NT * AH * VD);
    add((size_t)NT * 256);
    add((size_t)NT * 256);
    add((size_t)NT * 256);
    add((size_t)NT * 256);
    add((size_t)2 * NT * 8);
    add((size_t)2 * NT * 256);
    add((size_t)NT * DMIX);
    add((size_t)NT * TOPK);
    add((size_t)NT * TOPK * DE);
    add((size_t)NT * TOPK * D);
    add((size_t)NT * TOPK);
    add((size_t)64);
    add((size_t)NE * NT);
    m.total = o; return m;
}
static inline void fill_params(P& p, void* const* d_in, void* d_out, void* d_ws) {
    for (int i = 0; i < N_IN; ++i) p.in[i] = (const float*)d_in[i];
    p.out = (float*)d_out; float* w = (float*)d_ws; const WsMap m = ws_map();
    p.MOD = w + m.off[0]; p.ROPET = w + m.off[1]; p.X = w + m.off[2]; p.H = w + m.off[3]; p.U = w + m.off[4]; p.XC = w + m.off[5]; p.LA = w + m.off[6]; p.LB = w + m.off[7]; p.HL = w + m.off[8];
    p.QN = w + m.off[9]; p.KVN = w + m.off[10]; p.QF = w + m.off[11]; p.KVF = w + m.off[12]; p.Qr = w + m.off[13]; p.Kr = w + m.off[14]; p.Vr = w + m.off[15];
    p.XCM = w + m.off[16]; p.QM = w + m.off[17]; p.KM = w + m.off[18]; p.VM = w + m.off[19]; p.IGF = w + m.off[20]; p.HM = w + m.off[21]; p.Y = w + m.off[22];
    p.TOPG = w + m.off[23]; p.ACT = w + m.off[24]; p.YB = w + m.off[25]; p.TOPE = (int*)(w + m.off[26]); p.CNT = (int*)(w + m.off[27]); p.LIST = (int*)(w + m.off[28]);
}
extern __shared__ __attribute__((aligned(16))) unsigned char g_lds_base[];
constexpr int WTAB_OFF = 148480 - 64 - 256;
#define HWID() ((int)__builtin_amdgcn_s_getreg((5 << 11) | 4) & 63)
#if ONE_LAUNCH
__device__ __forceinline__ int tidx_() {
    unsigned z = 0u; asm volatile("" : "+v"(z));
    const int lane = (int)__builtin_amdgcn_mbcnt_hi(~0u, __builtin_amdgcn_mbcnt_lo(~0u, z));
    const int wv = __builtin_amdgcn_readfirstlane(((const volatile __attribute__((address_space(3))) int*)((__attribute__((address_space(3))) unsigned char*)g_lds_base + WTAB_OFF))[HWID()]);
    return wv * 64 + lane;
}
#define TIDX tidx_()
#else
#define TIDX ((int)threadIdx.x)
#endif
namespace pg8 {
#define PG8_LAS __attribute__((address_space(3)))
typedef unsigned short bf16_t;
typedef short bf16x8 __attribute__((ext_vector_type(8)));
typedef float f32x4 __attribute__((ext_vector_type(4)));
typedef unsigned u32x4 __attribute__((ext_vector_type(4)));
constexpr int BM = 256, BK = 64, HALF = 128, HTB = HALF * BK * 2  , STAGE_BYTES = 8 * HTB, NXCD = 8, WGM = 8;

__host__ __device__ __forceinline__ int lds_byte(int r, int c) { const int st = (r >> 4) * 2 + (c >> 5), rr = r & 15, cc = c & 31, ob = rr * 64 + cc * 2; return st * 1024 + (ob ^ (((ob >> 9) & 1) << 5)); }
__host__ __device__ __forceinline__ void stage_rc(int b, int& R, int& C) { const int st = b / 1024, sb = b % 1024, swz = sb ^ (((sb >> 9) & 1) << 5); R = (st >> 1) * 16 + swz / 64; C = (st & 1) * 32 + (swz % 64) / 2; }
__host__ __device__ __forceinline__ int perm32(int rho) { const int n = rho >> 4, i = rho & 15; return 8 * (i >> 2) + 4 * n + (i & 3); }

struct Unit { int pm, pn, e, mb, slot; };
struct Gemm { const bf16_t* A; const bf16_t* Bt; int K; };

struct StaticOrder {
    int nM, nN, nwg, G, c;
    __device__ void init(int M, int N, int G_, int c_) { nM = M / BM; nN = N / BM; nwg = nM * nN; G = G_; c = c_; }
    __device__ bool next(int i, Unit& u) const {
        const long L = (long)i * G + c; if (L >= nwg) return false;
        int wgid = (int)L; { const int q = nwg / NXCD, r = nwg % NXCD, xcd = wgid % NXCD, off = wgid / NXCD; wgid = (xcd < r ? xcd * (q + 1) : r * (q + 1) + (xcd - r) * q) + off; }
        const int nig = WGM * nN, gid = wgid / nig, fm = gid * WGM, gsz = (nM - fm) < WGM ? (nM - fm) : WGM;
        u.pm = fm + ((wgid % nig) % gsz); u.pn = (wgid % nig) / gsz; u.e = 0; u.mb = 0; u.slot = 0; return true;
    }
    __device__ __forceinline__ int arow(const Unit& u, int r) const { return u.pm * BM + r; }
};

typedef float f32x2_c __attribute__((ext_vector_type(2))); typedef __bf16 bf16x2_c __attribute__((ext_vector_type(2)));
__device__ __forceinline__ unsigned cvt_pk_bf16(float lo, float hi) { f32x2_c v = {lo, hi}; bf16x2_c b = __builtin_convertvector(v, bf16x2_c); return __builtin_bit_cast(unsigned, b); }

template <class Epi, class Sched, bool ALIGN_EPI>
__device__ __forceinline__ void gemm_phase(PG8_LAS unsigned char* lds, const Gemm g, const Sched& S, const Epi& E) {
    int tid_ = TIDX; asm volatile("" : "+v"(tid_));
    const int tid = tid_, wid = __builtin_amdgcn_readfirstlane(tid >> 6), lane = tid & 63, wr = wid >> 2, wc = wid & 3, fr = lane & 15, fq = lane >> 4;
    const int K = g.K, nt = K / BK;
    unsigned voffB[2];
#pragma unroll
    for (int i = 0; i < 2; ++i) { int R, C; stage_rc(tid * 16 + i * 8192, R, C); const int Rb = Epi::PERM ? ((R & ~31) + perm32(R & 31)) : R;
        voffB[i] = (unsigned)(Rb * K + C) * 2u; }
    const size_t kstep = (size_t)(BK * 2);
    const size_t hstep = (size_t)HALF * K * 2;
    const size_t tstep = 2 * hstep;
    const unsigned ldsw = (unsigned)wid * 1024u;
    const int aoff = lds_byte(wr * 64 + fr, fq * 8), boff = lds_byte(wc * 32 + fr, fq * 8);
#define PG8_SA(b, h) (((b) * 2 + (h)) * HTB)
#define PG8_SB(b, h) ((4 + (b) * 2 + (h)) * HTB)
#define PG8_STAGE(bufoff, gbase, voff) do { _Pragma("unroll") for (int _i = 0; _i < 2; ++_i) \
        __builtin_amdgcn_global_load_lds((const unsigned*)((const char*)(gbase) + (voff)[_i]), (PG8_LAS unsigned*)(lds + (bufoff) + ldsw + _i * 8192), 16, 0, 0); } while (0)
#define PG8_LDA(dst, b, h) do { _Pragma("unroll") for (int m = 0; m < 4; ++m) _Pragma("unroll") for (int k = 0; k < 2; ++k) dst[m][k] = *(const PG8_LAS bf16x8*)(lds + PG8_SA(b, h) + aoff + m * 2048 + k * 1024); } while (0)
#define PG8_LDB(dst, b, h) do { _Pragma("unroll") for (int n = 0; n < 2; ++n) _Pragma("unroll") for (int k = 0; k < 2; ++k) dst[n][k] = *(const PG8_LAS bf16x8*)(lds + PG8_SB(b, h) + boff + n * 2048 + k * 1024); } while (0)
#define PG8_MMA(ai, bj, At, Bt) do { __builtin_amdgcn_s_setprio(1); _Pragma("unroll") for (int m = 0; m < 4; ++m) _Pragma("unroll") for (int n = 0; n < 2; ++n) _Pragma("unroll") for (int k = 0; k < 2; ++k) \
        acc[ai][bj][m][n] = __builtin_amdgcn_mfma_f32_16x16x32_bf16(Bt[n][k], At[m][k], acc[ai][bj][m][n], 0, 0, 0); __builtin_amdgcn_s_setprio(0); } while (0)
#define PG8_WAIT_V(n) asm volatile("s_waitcnt vmcnt(" #n ")" ::: "memory")
#define PG8_WAIT_L(n) asm volatile("s_waitcnt lgkmcnt(" #n ")" ::: "memory")
#define PG8_BAR __builtin_amdgcn_s_barrier()
#define PG8_SCHED __builtin_amdgcn_sched_barrier(0)
#define PG8_AOFFS(dst, U) do { int _t = tid; asm volatile("" : "+v"(_t)); _Pragma("unroll") for (int _i = 0; _i < 2; ++_i) { int _R, _C; stage_rc(_t * 16 + _i * 8192, _R, _C); \
        _Pragma("unroll") for (int _h = 0; _h < 2; ++_h) dst[_h][_i] = (unsigned)(S.arow(U, _h * HALF + _R) * K + _C) * 2u; } } while (0)
    Unit cur, nxt; int ui = 0;
    if (!S.next(0, cur)) return;
    f32x4 acc[2][2][4][2];
#pragma unroll
    for (int a = 0; a < 2; ++a)
#pragma unroll
        for (int b = 0; b < 2; ++b)
#pragma unroll
            for (int m = 0; m < 4; ++m)
#pragma unroll
                for (int n = 0; n < 2; ++n) acc[a][b][m][n] = (f32x4){0.f, 0.f, 0.f, 0.f};
    bf16x8 At[4][2], B0[2][2], B1[2][2];
    unsigned vA[2][2];
    PG8_AOFFS(vA, cur);
    const char* gA = (const char*)g.A;
    const char* cB = (const char*)g.Bt + (size_t)cur.pn * tstep;
    PG8_STAGE(PG8_SB(0, 0), cB, voffB); PG8_STAGE(PG8_SB(0, 1), cB + hstep, voffB); PG8_STAGE(PG8_SA(0, 0), gA, vA[0]); PG8_STAGE(PG8_SA(0, 1), gA, vA[1]);
    if (wr == 1) PG8_BAR;
    PG8_WAIT_V(2); PG8_BAR;
    PG8_STAGE(PG8_SB(1, 0), cB + kstep, voffB); PG8_STAGE(PG8_SA(1, 0), gA + kstep, vA[0]); PG8_STAGE(PG8_SB(1, 1), cB + hstep + kstep, voffB);
    PG8_WAIT_V(6); PG8_BAR;
    for (;;) {
        const bool has_next = S.next(ui + 1, nxt);
        { unsigned nvA[2][2];
          if (has_next) { PG8_AOFFS(nvA, nxt); } else {
#pragma unroll
            for (int h = 0; h < 2; ++h)
#pragma unroll
                for (int i = 0; i < 2; ++i) nvA[h][i] = vA[h][i]; }
          *(PG8_LAS u32x4*)(lds + STAGE_BYTES + 1024 + tid * 16) = (u32x4){nvA[0][0], nvA[0][1], nvA[1][0], nvA[1][1]}; }
        const char* nB = has_next ? (const char*)g.Bt + (size_t)nxt.pn * tstep : cB;
#pragma unroll 1
        for (int t = 0; t < nt; t += 2) {
            const bool last = (t == nt - 2);
            const char* a1 = gA + (size_t)(t + 1) * kstep;
            const char* a2 = last ? gA : gA + (size_t)(t + 2) * kstep; const char* b2 = last ? nB : cB + (size_t)(t + 2) * kstep;
            const char* a3 = a2 + kstep; const char* b3 = b2 + kstep;
            unsigned o2[2][2];
            if (last) { const u32x4 nv = *(const PG8_LAS u32x4*)(lds + STAGE_BYTES + 1024 + tid * 16); o2[0][0] = nv.x; o2[0][1] = nv.y; o2[1][0] = nv.z; o2[1][1] = nv.w; }
            else {
#pragma unroll
                for (int h = 0; h < 2; ++h)
#pragma unroll
                    for (int i = 0; i < 2; ++i) o2[h][i] = vA[h][i]; }
            PG8_LDB(B0, 0, 0); PG8_LDB(B1, 0, 1); PG8_SCHED; PG8_LDA(At, 0, 0); PG8_STAGE(PG8_SA(1, 1), a1, vA[1]);
            PG8_WAIT_V(8); PG8_WAIT_L(0); PG8_BAR; PG8_MMA(0, 0, At, B0); PG8_MMA(0, 1, At, B1); PG8_BAR; PG8_SCHED;
            PG8_LDA(At, 0, 1); PG8_STAGE(PG8_SB(0, 0), b2, voffB); PG8_STAGE(PG8_SB(0, 1), b2 + hstep, voffB); PG8_STAGE(PG8_SA(0, 0), a2, o2[0]);
            PG8_WAIT_V(8); PG8_WAIT_L(0); PG8_BAR; PG8_MMA(1, 0, At, B0); PG8_MMA(1, 1, At, B1); PG8_BAR; PG8_SCHED;
            PG8_LDB(B0, 1, 0); PG8_LDB(B1, 1, 1); PG8_SCHED; PG8_LDA(At, 1, 0); PG8_STAGE(PG8_SA(0, 1), a2, o2[1]);
            PG8_WAIT_V(8); PG8_WAIT_L(0); PG8_BAR; PG8_MMA(0, 0, At, B0); PG8_MMA(0, 1, At, B1); PG8_BAR; PG8_SCHED;
            PG8_LDA(At, 1, 1); PG8_STAGE(PG8_SB(1, 0), b3, voffB); PG8_STAGE(PG8_SB(1, 1), b3 + hstep, voffB); PG8_STAGE(PG8_SA(1, 0), a3, o2[0]);
            PG8_WAIT_V(8); PG8_WAIT_L(0); PG8_BAR; PG8_MMA(1, 0, At, B0); PG8_MMA(1, 1, At, B1); PG8_BAR; PG8_SCHED;
        }
        if constexpr (ALIGN_EPI) { if (wr == 0) PG8_BAR; }
        E(acc, cur, wr, wc, fr, fq);
        if (!has_next) break;
#pragma unroll
        for (int a = 0; a < 2; ++a)
#pragma unroll
            for (int b = 0; b < 2; ++b)
#pragma unroll
                for (int m = 0; m < 4; ++m)
#pragma unroll
                    for (int n = 0; n < 2; ++n) acc[a][b][m][n] = (f32x4){0.f, 0.f, 0.f, 0.f};
        cur = nxt; cB = nB; ++ui;
        { const u32x4 nv = *(const PG8_LAS u32x4*)(lds + STAGE_BYTES + 1024 + tid * 16); vA[0][0] = nv.x; vA[0][1] = nv.y; vA[1][0] = nv.z; vA[1][1] = nv.w; }
        if constexpr (ALIGN_EPI) { if (wr == 1) PG8_BAR; }
    }
    PG8_WAIT_V(0);
    if constexpr (!ALIGN_EPI) { if (wr == 0) PG8_BAR; }
    PG8_BAR;
#undef PG8_SA
#undef PG8_SB
#undef PG8_STAGE
#undef PG8_LDA
#undef PG8_LDB
#undef PG8_MMA
#undef PG8_WAIT_V
#undef PG8_WAIT_L
#undef PG8_BAR
#undef PG8_SCHED
#undef PG8_AOFFS
}
}
#define LAS __attribute__((address_space(3)))
typedef unsigned short bf16;
typedef float f32x4 __attribute__((ext_vector_type(4)));
typedef unsigned u32x4 __attribute__((ext_vector_type(4)));
typedef unsigned u32x2 __attribute__((ext_vector_type(2)));

constexpr int NWAVES = 8, NTHREADS = 512;
constexpr int DINP = 1536;
constexpr int SLOT_MAX = NT * TOPK + NE * 256;

struct Q {
    bf16 *WtIn, *WtOut, *WtGu, *WtDn, *WtQb, *WtKvb;
    bf16 *H16, *Y16, *ACT16, *K16, *V16;
};

__device__ __forceinline__ unsigned f2bf(float f) { unsigned u = __builtin_bit_cast(unsigned, f); return (u + 0x7fffu + ((u >> 16) & 1u)) >> 16; }
__device__ __forceinline__ unsigned pk2(float lo, float hi) { return f2bf(lo) | (f2bf(hi) << 16); }
__device__ __forceinline__ float bf2f(unsigned short b) { return __builtin_bit_cast(float, (unsigned)b << 16); }

__device__ __forceinline__ void tr_decode(const P& p, const Q& q, bf16* WtKvbP, int it, const float*& src, int& N, bf16*& dst, int& ldk) {
    constexpr int I_GU = (D / 64) * (2 * DE / 64), I_DN = (DE / 64) * (D / 64);
    constexpr int I_IN = (D / 64) * ((DIN + 63) / 64), I_OUT = (DMIX / 64) * (D / 64), I_QB = (QRANK / 64) * (768 / 64), I_KVB = (KVRANK / 64) * (1024 / 64);
    constexpr int PER_L = NE * (I_GU + I_DN) + I_IN + I_OUT + I_QB + I_KVB;
    const int l = it / PER_L; int r = it % PER_L;
    if (r < NE * I_GU) { const int e = r / I_GU, rr = r % I_GU, kbs = D / 64, kb = rr % kbs, n0 = 64 * (rr / kbs);
        const int isl = n0 >= DE, j0 = n0 - isl * DE, drow0 = 256 * (j0 / 128) + 128 * isl + (j0 % 128);
        N = 2 * DE; ldk = D; src = p.in[I_WGU] + ((size_t)l * NE + e) * D * 2 * DE + (size_t)(64 * kb) * N + n0; dst = q.WtGu + ((size_t)l * NE + e) * 2 * DE * D + (size_t)drow0 * ldk + 64 * kb; return; } r -= NE * I_GU;
    if (r < NE * I_DN) { const int e = r / I_DN, rr = r % I_DN, kbs = DE / 64, kb = rr % kbs, n0 = 64 * (rr / kbs);
        N = D; ldk = DE; src = p.in[I_WD] + ((size_t)l * NE + e) * DE * D + (size_t)(64 * kb) * N + n0; dst = q.WtDn + ((size_t)l * NE + e) * D * DE + (size_t)n0 * ldk + 64 * kb; return; } r -= NE * I_DN;
    if (r < I_IN) { const int nb = (DIN + 63) / 64, kb = r / nb, n0 = 64 * (r % nb);
        const int n0c = n0 + 64 <= DIN ? n0 : DIN - 64; N = DIN; ldk = D; src = p.in[I_WIN] + (size_t)l * D * DIN + (size_t)(64 * kb) * N + n0c; dst = q.WtIn + (size_t)l * DINP * D + (size_t)n0c * ldk + 64 * kb; return; } r -= I_IN;
    if (r < I_OUT) { const int nb = D / 64, kb = r / nb, n0 = 64 * (r % nb); N = D; ldk = DMIX; src = p.in[I_WOUT] + (size_t)l * DMIX * D + (size_t)(64 * kb) * N + n0; dst = q.WtOut + (size_t)l * D * DMIX + (size_t)n0 * ldk + 64 * kb; return; } r -= I_OUT;
    if (r < I_QB) { const int nb = 768 / 64, kb = r / nb, n0 = 64 * (r % nb); N = 768; ldk = 256; src = p.in[I_WQB] + (size_t)l * QRANK * 768 + (size_t)(64 * kb) * N + n0; dst = WtKvbP + (size_t)l * 1792 * 256 + (size_t)n0 * ldk + 64 * kb; return; } r -= I_QB;
    { const int nb = 1024 / 64, kb = r / nb, n0 = 64 * (r % nb); N = 1024; ldk = 256; src = p.in[I_WKVB] + (size_t)l * KVRANK * 1024 + (size_t)(64 * kb) * N + n0; dst = WtKvbP + (size_t)l * 1792 * 256 + (size_t)(768 + n0) * ldk + 64 * kb; }
}
__device__ __forceinline__ void opt_convert_weights(const P& p, const Q& q, bf16* WtKvbP, LAS unsigned char* lds, int gw, int ngw, int wave, int lane) {
    LAS float* scr = (LAS float*)(lds + wave * 16640);
    constexpr int I_GU = (D / 64) * (2 * DE / 64), I_DN = (DE / 64) * (D / 64);
    constexpr int I_IN = (D / 64) * ((DIN + 63) / 64), I_OUT = (DMIX / 64) * (D / 64), I_QB = (QRANK / 64) * (768 / 64), I_KVB = (KVRANK / 64) * (1024 / 64);
    constexpr int PER_L = NE * (I_GU + I_DN) + I_IN + I_OUT + I_QB + I_KVB, REST = I_IN + I_OUT + I_QB + I_KVB;
    const int lr = lane >> 4, c4 = (lane & 15) * 4;
    for (int x = gw; x < DEPTH * REST; x += ngw) {
        const float* src; bf16* dst; int N, ldk; tr_decode(p, q, WtKvbP, (x / REST) * PER_L + NE * (I_GU + I_DN) + x % REST, src, N, dst, ldk);
        f32x4 v[16];
#pragma unroll
        for (int i = 0; i < 16; ++i) v[i] = *(const f32x4*)(src + (size_t)(4 * i + lr) * N + c4);
#pragma unroll
        for (int i = 0; i < 16; ++i) { LAS float* d = scr + (4 * i + lr) * 65 + c4; d[0] = v[i].x; d[1] = v[i].y; d[2] = v[i].z; d[3] = v[i].w; }
        asm volatile("s_waitcnt lgkmcnt(0)" ::: "memory");
#pragma unroll
        for (int j = 0; j < 8; ++j) { const int n = 8 * j + (lane >> 3), c = lane & 7; const LAS float* sp = scr + (8 * c) * 65 + n;
            u32x4 o; o.x = pk2(sp[0 * 65], sp[1 * 65]); o.y = pk2(sp[2 * 65], sp[3 * 65]); o.z = pk2(sp[4 * 65], sp[5 * 65]); o.w = pk2(sp[6 * 65], sp[7 * 65]);
            *(u32x4*)(dst + (size_t)n * ldk + 8 * c) = o; }
        asm volatile("s_waitcnt lgkmcnt(0)" ::: "memory");
    }
    const long gt = (long)gw * 64 + lane, ngt = (long)ngw * 64;
    for (long i = gt; i < (long)DEPTH * (DINP - DIN) * D / 8; i += ngt) { const int l = (int)(i / ((DINP - DIN) * D / 8)); const long o = i % ((DINP - DIN) * D / 8);
        *(u32x4*)(q.WtIn + ((size_t)l * DINP + DIN) * D + o * 8) = (u32x4){0u, 0u, 0u, 0u}; }
    for (long i = gt; i < (long)DEPTH * 1024 * 16; i += ngt) { const long row = i >> 4, l = row >> 10, n = row & 1023; *(u32x4*)(WtKvbP + ((size_t)l * 1792 + 768 + n) * 256 + 128 + (i & 15) * 8) = (u32x4){0u, 0u, 0u, 0u}; }
}

struct BgConv {
    const float* wgu; const float* wdn; bf16* tgu; bf16* tdn;
    int it, stride, ph; unsigned ldsb;
    const float* src; bf16* dst; int N;
    static constexpr int I_GU = NE * (2 * DE / 32) * (D / 64), I_DN = NE * (D / 32) * (DE / 64), TOTAL = I_GU + I_DN, LDS_PER_WAVE = 8192;
    static constexpr int BG_GAP = 1;
    static_assert(D == 1024 && DE == 1024 && NE == 32, "BgConv decodes items by shifts");
    __device__ __forceinline__ void decode() {
        if (it < I_GU) { const int e = it >> 10, nblk = (it >> 4) & 63, kb = it & 15, n0 = 32 * nblk, isl = n0 >= DE, j0 = n0 - isl * DE, drow0 = 256 * (j0 / 128) + 128 * isl + (j0 % 128);
            N = 2 * DE; src = wgu + ((size_t)e * D + 64 * kb) * (2 * DE) + n0; dst = tgu + ((size_t)e * 2 * DE + drow0) * D + 64 * kb; }
        else { const int r = it - I_GU, e = r >> 9, nblk = (r >> 4) & 31, kb = r & 15, n0 = 32 * nblk;
            N = D; src = wdn + ((size_t)e * DE + 64 * kb) * D + n0; dst = tdn + ((size_t)e * D + n0) * DE + 64 * kb; }
    }
    __device__ __forceinline__ void init(const P& p, const Q& q, int l, LAS unsigned char* lds, int gw, int ngw, int wave) {
        wgu = p.in[I_WGU] + (size_t)l * NE * D * 2 * DE; wdn = p.in[I_WD] + (size_t)l * NE * DE * D; tgu = q.WtGu + (size_t)l * NE * 2 * DE * D; tdn = q.WtDn + (size_t)l * NE * D * DE;
        it = gw; stride = ngw; ph = 0; ldsb = (unsigned)(uintptr_t)(lds + wave * LDS_PER_WAVE); src = nullptr; dst = nullptr; N = 0;
        if (it < TOTAL) decode();
    }
    __device__ __forceinline__ bool done() const { return it >= TOTAL; }
    __device__ __forceinline__ void collect() {
        if (it >= TOTAL || ph < BG_GAP + 2) return;
        const int lane = (int)__builtin_amdgcn_mbcnt_hi(~0u, __builtin_amdgcn_mbcnt_lo(~0u, 0u));
        if (ph == BG_GAP + 2) asm volatile("s_waitcnt vmcnt(0)" ::: "memory");
#pragma unroll
        for (int rr = 0; rr < 2; ++rr) { const int r = 2 * (ph - (BG_GAP + 2)) + rr, n = 8 * r + (lane >> 3), c = lane & 7;
            const LAS float* sp = (const LAS float*)(ldsb + (unsigned)(c * 1024 + ((((n >> 2) ^ c) & 7) << 4) + (n & 3) * 4));
            u32x4 o; o.x = pg8::cvt_pk_bf16(sp[0 * 32], sp[1 * 32]); o.y = pg8::cvt_pk_bf16(sp[2 * 32], sp[3 * 32]); o.z = pg8::cvt_pk_bf16(sp[4 * 32], sp[5 * 32]); o.w = pg8::cvt_pk_bf16(sp[6 * 32], sp[7 * 32]);
            __builtin_nontemporal_store(o, (u32x4*)(dst + (size_t)n * D + 8 * c)); }
        if (ph == BG_GAP + 3) { asm volatile("s_waitcnt lgkmcnt(0)" ::: "memory"); it += stride; if (it < TOTAL) decode(); ph = -1; }
    }
    __device__ __forceinline__ void issue() {
        if (it >= TOTAL) return;
        if (ph >= 0 && ph < 2) {
            const int lane = (int)__builtin_amdgcn_mbcnt_hi(~0u, __builtin_amdgcn_mbcnt_lo(~0u, 0u));
            const unsigned rowoff = (unsigned)(lane >> 3) * (unsigned)(N * 4);
#pragma unroll
            for (int i = 0; i < 4; ++i) { const int ii = 4 * ph + i; const unsigned voff = rowoff + (unsigned)(((lane & 7) ^ ii) << 4); const float* sb = src + (size_t)(8 * ii) * N; const unsigned m0v = ldsb + 1024u * ii;
                unsigned sv; asm volatile("s_mov_b32 %0, m0\n\ts_mov_b32 m0, %1\n\ts_nop 0\n\tglobal_load_lds_dwordx4 %2, %3 nt\n\ts_mov_b32 m0, %0" : "=&s"(sv) : "s"(m0v), "v"(voff), "s"(sb) : "memory"); }
        }
        ++ph;
    }
    __device__ __forceinline__ void drain() { while (it < TOTAL) { collect(); issue(); } }
};

struct EpiInprojF32 {
    static constexpr bool PERM = false; float* U;
    __device__ __forceinline__ void operator()(const pg8::f32x4 (&acc)[2][2][4][2], const pg8::Unit& u, int wr, int wc, int fr, int fq) const {
#pragma unroll
        for (int ai = 0; ai < 2; ++ai)
#pragma unroll
            for (int m = 0; m < 4; ++m) { const int row = u.pm * 256 + ai * 128 + wr * 64 + m * 16 + fr;
#pragma unroll
                for (int bj = 0; bj < 2; ++bj)
#pragma unroll
                    for (int n = 0; n < 2; ++n) { const int c = u.pn * 256 + bj * 128 + wc * 32 + n * 16 + 4 * fq; if (c < DIN) *(pg8::f32x4*)(U + (size_t)row * DIN + c) = acc[ai][bj][m][n]; } }
    }
};
struct EpiOutproj {
    static constexpr bool PERM = false; float* X; const float* mod;   const float* xin; const float* cin;
    __device__ __forceinline__ void operator()(const pg8::f32x4 (&acc)[2][2][4][2], const pg8::Unit& u, int wr, int wc, int fr, int fq) const {
#pragma unroll
        for (int ai = 0; ai < 2; ++ai)
#pragma unroll
            for (int m = 0; m < 4; ++m) { const int row = u.pm * 256 + ai * 128 + wr * 64 + m * 16 + fr, b = row / TPB, i = row % TPB; const float* g1 = mod + ((size_t)(i < CTX ? 2 : b) * 6 + 2) * D;
                const float* base = xin ? (i < CTX ? cin + ((size_t)b * CTX + i) * D : xin + ((size_t)b * SEQ + (i - CTX)) * D) : X + (size_t)row * D;
#pragma unroll
                for (int bj = 0; bj < 2; ++bj)
#pragma unroll
                    for (int n = 0; n < 2; ++n) { const int c = u.pn * 256 + bj * 128 + wc * 32 + n * 16 + 4 * fq;
                        const pg8::f32x4 gv = *(const pg8::f32x4*)(g1 + c); *(pg8::f32x4*)(X + (size_t)row * D + c) = *(const pg8::f32x4*)(base + c) + gv * acc[ai][bj][m][n]; } }
    }
};
struct GroupedOrder {
    const int* CNT; const int* LIST; const LAS int* ut;
    __device__ void init(const int* cnt, const int* list, int nN, int G, int c, LAS int* tab) { CNT = cnt; LIST = list; ut = tab + 64;
        __syncthreads();
        if (TIDX == 0) { int a = 0; for (int e = 0; e < NE; ++e) { tab[e] = a; a += (cnt[e] + 255) >> 8; } tab[NE] = a; }
        __syncthreads();
        static_assert(NT < 65536, "row -> token map is 16-bit");
        if (TIDX < 16) { const int total = tab[NE] * nN; const long L = (long)TIDX * G + c; int pm = -1, pn = 0, e = 0, mb = 0;
            if (L < total) { int w = (int)L; { const int nx = pg8::NXCD, qq = total / nx, r = total % nx, xcd = w % nx, off = w / nx; w = (xcd < r ? xcd * (qq + 1) : r * (qq + 1) + (xcd - r) * qq) + off; }
                const int blk = w / nN, ntile = w % nN;
                for (int x = 1; x < NE; ++x) if (tab[x] <= blk) e = x;
                mb = blk - tab[e]; pm = blk; pn = e * nN + ntile; }
            tab[64 + TIDX * 4] = pm; tab[64 + TIDX * 4 + 1] = pn; tab[64 + TIDX * 4 + 2] = e; tab[64 + TIDX * 4 + 3] = mb; }
        __syncthreads(); }
    __device__ bool next(int i, pg8::Unit& u) const { if (i >= 15) return false; const int pm = ut[i * 4]; if (pm < 0) return false; u.pm = pm; u.pn = ut[i * 4 + 1]; u.e = ut[i * 4 + 2]; u.mb = ut[i * 4 + 3]; u.slot = i; return true; }
};
struct GuOrder : GroupedOrder {
    const LAS unsigned short* rowtok;
    __device__ void init_rows(LAS unsigned short* rt) { rowtok = rt;
        for (int x = TIDX; x < 15 * 256; x += 512) { const int i = x >> 8, r = x & 255, pm = ut[i * 4]; unsigned short v = 0;
            if (pm >= 0) { const int e = ut[i * 4 + 2], idx = ut[i * 4 + 3] * 256 + r; if (idx < CNT[e]) v = (unsigned short)(LIST[(size_t)e * NT + idx] >> 2); }
            rt[x] = v; }
        __syncthreads(); }
    __device__ __forceinline__ int arow(const pg8::Unit& u, int r) const { return rowtok[u.slot * 256 + r]; }
};
struct DnOrder : GroupedOrder {
    __device__ __forceinline__ int arow(const pg8::Unit& u, int r) const { return u.pm * 256 + r; }
};
struct EpiGu {
    static constexpr bool PERM = true; bf16* ACT; const float* bgu;   int nN; int probe_skip;
    __device__ __forceinline__ void operator()(const pg8::f32x4 (&acc)[2][2][4][2], const pg8::Unit& u, int wr, int wc, int fr, int fq) const {
        if (probe_skip) return;
        const int ntile = u.pn - u.e * nN, j0 = ntile * 128 + wc * 32 + 8 * fq; const float* bg = bgu + (size_t)u.e * 2 * DE;
        float bgl[8], bli[8];
#pragma unroll
        for (int x = 0; x < 8; ++x) { bgl[x] = bg[j0 + x]; bli[x] = bg[DE + j0 + x]; }
#pragma unroll
        for (int ai = 0; ai < 2; ++ai)
#pragma unroll
            for (int m = 0; m < 4; ++m) { const int row = u.pm * 256 + ai * 128 + wr * 64 + m * 16 + fr; float a[8];
#pragma unroll
                for (int n = 0; n < 2; ++n)
#pragma unroll
                    for (int x = 0; x < 4; ++x) { const float glu = fminf(acc[ai][0][m][n][x] + bgl[4 * n + x], 7.0f), lin = fminf(fmaxf(acc[ai][1][m][n][x] + bli[4 * n + x], -7.0f), 7.0f);
                        a[4 * n + x] = glu * __builtin_amdgcn_rcpf(1.f + __builtin_amdgcn_exp2f(-2.4554669595930157f * glu)) * (lin + 1.f); }
                u32x4 w; w.x = pg8::cvt_pk_bf16(a[0], a[1]); w.y = pg8::cvt_pk_bf16(a[2], a[3]); w.z = pg8::cvt_pk_bf16(a[4], a[5]); w.w = pg8::cvt_pk_bf16(a[6], a[7]);
                *(u32x4*)(ACT + (size_t)row * DE + j0) = w; }
    }
};
struct EpiDownF32 {
    static constexpr bool PERM = false; float* YB; const float* bd;   const float* TOPG; const int* CNT; const int* LIST; int nN;
    __device__ __forceinline__ void operator()(const pg8::f32x4 (&acc)[2][2][4][2], const pg8::Unit& u, int wr, int wc, int fr, int fq) const {
        const int ntile = u.pn - u.e * nN, cnt = CNT[u.e]; const float* b = bd + (size_t)u.e * D;
#pragma unroll
        for (int ai = 0; ai < 2; ++ai)
#pragma unroll
            for (int m = 0; m < 4; ++m) { const int idx = u.mb * 256 + ai * 128 + wr * 64 + m * 16 + fr;
                if (idx < cnt) { const int pr = LIST[(size_t)u.e * NT + idx]; const float g = TOPG[pr];
#pragma unroll
                    for (int bj = 0; bj < 2; ++bj)
#pragma unroll
                        for (int n = 0; n < 2; ++n) { const int c = ntile * 256 + bj * 128 + wc * 32 + n * 16 + 4 * fq; const pg8::f32x4 bv = *(const pg8::f32x4*)(b + c);
                            *(pg8::f32x4*)(YB + (size_t)pr * D + c) = (acc[ai][bj][m][n] + bv) * g; } } }
    }
};

__device__ __forceinline__ void opt_inproj(const P& p, const Q& q, int l, LAS unsigned char* lds, int G, int bid) {
    pg8::Gemm g{q.H16, q.WtIn + (size_t)l * DINP * D, D}; pg8::StaticOrder S; S.init(NT, DINP, G, bid);
    EpiInprojF32 E{p.U}; pg8::gemm_phase<EpiInprojF32, pg8::StaticOrder, true>(lds, g, S, E);
}
struct LatentOrder : pg8::StaticOrder {
    __device__ bool next(int i, pg8::Unit& u) const { if (!pg8::StaticOrder::next(i, u)) return false; constexpr int TL = SEQ / 256, TC = CTX / 256; u.pm = (u.pm / TL) * (TL + TC) + TC + u.pm % TL; return true; }
};
__device__ __forceinline__ void opt_outproj(const P& p, const Q& q, int l, LAS unsigned char* lds, int G, int bid, bool latent_only) {
    pg8::Gemm g{q.Y16, q.WtOut + (size_t)l * D * DMIX, DMIX}; EpiOutproj E{p.X, p.MOD + (size_t)l * 3 * 6 * D, l == 0 ? p.in[I_X] : nullptr, p.in[I_CTX]};
    if (latent_only) { LatentOrder S; S.init(NB * SEQ, D, G, bid); pg8::gemm_phase<EpiOutproj, LatentOrder, true>(lds, g, S, E); }
    else { pg8::StaticOrder S; S.init(NT, D, G, bid); pg8::gemm_phase<EpiOutproj, pg8::StaticOrder, true>(lds, g, S, E); }
}
__device__ __forceinline__ void opt_moe_gu(const P& p, const Q& q, int l, LAS unsigned char* lds, int G, int bid, int probe_skip = 0) {
    pg8::Gemm g{q.H16, q.WtGu + (size_t)l * NE * 2 * DE * D, D}; GuOrder S; S.init(p.CNT, p.LIST, 2 * DE / 256, G, bid, (LAS int*)(lds + pg8::STAGE_BYTES)); S.init_rows((LAS unsigned short*)(lds + pg8::STAGE_BYTES + 1024 + 8192));
    EpiGu E{q.ACT16, p.in[I_BGU] + (size_t)l * NE * 2 * DE, 2 * DE / 256, probe_skip}; pg8::gemm_phase<EpiGu, GuOrder, true>(lds, g, S, E);
}
__device__ __forceinline__ void opt_moe_down(const P& p, const Q& q, int l, LAS unsigned char* lds, int G, int bid) {
    pg8::Gemm g{q.ACT16, q.WtDn + (size_t)l * NE * D * DE, DE}; DnOrder S; S.init(p.CNT, p.LIST, D / 256, G, bid, (LAS int*)(lds + pg8::STAGE_BYTES));
    EpiDownF32 E{p.YB, p.in[I_BD] + (size_t)l * NE * D, p.TOPG, p.CNT, p.LIST, D / 256}; pg8::gemm_phase<EpiDownF32, DnOrder, true>(lds, g, S, E);
}
namespace att {
using bf16x8 = __attribute__((ext_vector_type(8))) short;
using s16x4  = __attribute__((ext_vector_type(4))) short;
using f32x16 = __attribute__((ext_vector_type(16))) float;
using f32x8  = __attribute__((ext_vector_type(8))) float;
using u32x4  = __attribute__((ext_vector_type(4))) unsigned;
constexpr int DK = 96, DV = 64, NW = 8, QBLK = 32, KVBLK = 64;
constexpr float SCALE = 0.10206207261596575f;
#ifndef ATTN_THR
#define ATTN_THR 8.f
#endif
constexpr float THR = ATTN_THR;
#ifndef ATTN_SM_SPLIT
#define ATTN_SM_SPLIT 0
#endif
#ifndef ATTN_NEGM
#define ATTN_NEGM 1
#endif
constexpr float QPRESCALE = ATTN_NEGM ? SCALE * 1.4426950408889634f : 1.f;
constexpr int KROW = 208;
constexpr int SHM_K = KVBLK * KROW, SHM_V = KVBLK * DV * 2;
#ifndef ATTN_STAG
#define ATTN_STAG 0
#endif
#ifndef ATTN_LAG2
#define ATTN_LAG2 0
#endif
constexpr int NRING = (ATTN_LAG2 || ATTN_STAG) ? 4 : 3;
constexpr int SHM_Q = ATTN_STAG ? 256 * KROW : 0;
constexpr int SHM_ATTN = NRING * SHM_V + NRING * SHM_K + NW * 64 * 4 + SHM_Q;
#define KSWZ(row, colB) ((row) * KROW + (colB))
#define SBAR() __builtin_amdgcn_sched_barrier(0)
__device__ __forceinline__ int crow(int r, int hi) { return (r & 3) + 8 * (r >> 2) + 4 * hi; }
typedef float f32x2_t __attribute__((ext_vector_type(2))); typedef __bf16 bf16x2_t __attribute__((ext_vector_type(2)));
__device__ __forceinline__ unsigned cvtpk(float lo, float hi) { f32x2_t v = {lo, hi}; bf16x2_t b = __builtin_convertvector(v, bf16x2_t); return __builtin_bit_cast(unsigned, b); }
__device__ __forceinline__ bf16x8 tobf(f32x8 x) { u32x4 w = {cvtpk(x[0], x[1]), cvtpk(x[2], x[3]), cvtpk(x[4], x[5]), cvtpk(x[6], x[7])}; return *reinterpret_cast<bf16x8*>(&w); }

#if ATTN_NEGM
template <bool FIRST = false>
__device__ __forceinline__ void partialSM_n(f32x16& p0, f32x16& p1, f32x16& negm, float& alpha) {
  constexpr float THR2 = THR * 1.4426950408889634f;
  float pmax = p0[0];
#pragma unroll
  for (int r = 1; r < 16; ++r) pmax = fmaxf(pmax, p0[r]);
#pragma unroll
  for (int r = 0; r < 16; ++r) pmax = fmaxf(pmax, p1[r]);
  { auto rr = __builtin_amdgcn_permlane32_swap(__float_as_uint(pmax), __float_as_uint(pmax), false, false);
    pmax = fmaxf(__uint_as_float(rr[0]), __uint_as_float(rr[1])); }
  if (!FIRST && __builtin_expect(__all(pmax <= THR2), 1)) { alpha = 1.f; }
  else { const float dl = FIRST ? pmax : fmaxf(pmax, 0.f); alpha = FIRST ? 1.f : __builtin_amdgcn_exp2f(-dl);
#pragma unroll
    for (int r = 0; r < 16; ++r) { p0[r] -= dl; p1[r] -= dl; negm[r] -= dl; } }
}
__device__ __forceinline__ void finishSM_n(f32x16& p0, f32x16& p1, float alpha, float& l_reg, bf16x8& pa0, bf16x8& pa1, bf16x8& pa2, bf16x8& pa3) {
#pragma unroll
  for (int r = 0; r < 16; ++r) { p0[r] = __builtin_amdgcn_exp2f(p0[r]); p1[r] = __builtin_amdgcn_exp2f(p1[r]); }
  float ps = 0;
#pragma unroll
  for (int r = 0; r < 16; ++r) ps += p0[r];
#pragma unroll
  for (int r = 0; r < 16; ++r) ps += p1[r];
  { auto rr = __builtin_amdgcn_permlane32_swap(__float_as_uint(ps), __float_as_uint(ps), false, false);
    ps = __uint_as_float(rr[0]) + __uint_as_float(rr[1]); }
  l_reg = l_reg * alpha + ps;
#define PK4(P, BASE, OUT) do { unsigned a0 = cvtpk(P[BASE + 0], P[BASE + 1]), a1 = cvtpk(P[BASE + 2], P[BASE + 3]);   \
    unsigned b0 = cvtpk(P[BASE + 4], P[BASE + 5]), b1 = cvtpk(P[BASE + 6], P[BASE + 7]);                              \
    auto r0 = __builtin_amdgcn_permlane32_swap(a0, b0, false, false); auto r1 = __builtin_amdgcn_permlane32_swap(a1, b1, false, false); \
    u32x4 w = {r0[0], r1[0], r0[1], r1[1]}; OUT = *reinterpret_cast<bf16x8*>(&w); } while (0)
  PK4(p0, 0, pa0); PK4(p0, 8, pa1); PK4(p1, 0, pa2); PK4(p1, 8, pa3);
#undef PK4
}
__device__ __forceinline__ void qkt_n(f32x16& p0, f32x16& p1, const char* Ks, const bf16x8* qr, const f32x16& negm, int r32, int hi) {
#pragma unroll
  for (int d0 = 0; d0 < DK / 16; ++d0) { const int cb = (d0 * 16 + hi * 8) * 2;
    const bf16x8 b0 = *reinterpret_cast<const bf16x8*>(Ks + ((r32) * KROW + cb));
    const bf16x8 b1 = *reinterpret_cast<const bf16x8*>(Ks + ((32 + r32) * KROW + cb));
#if ATTN_STAG
    const bf16x8 qf = *reinterpret_cast<const bf16x8*>((const char*)qr + d0 * 32);
#else
    const bf16x8 qf = qr[d0];
#endif
    if (d0 == 0) { p0 = __builtin_amdgcn_mfma_f32_32x32x16_bf16(b0, qf, negm, 0, 0, 0); p1 = __builtin_amdgcn_mfma_f32_32x32x16_bf16(b1, qf, negm, 0, 0, 0); }
    else { p0 = __builtin_amdgcn_mfma_f32_32x32x16_bf16(b0, qf, p0, 0, 0, 0); p1 = __builtin_amdgcn_mfma_f32_32x32x16_bf16(b1, qf, p1, 0, 0, 0); } }
}
#endif
__device__ __forceinline__ void partialSM(f32x16& p0, f32x16& p1, float& m_reg, float& mn, float& alpha) {
  constexpr float C = SCALE * 1.4426950408889634f;
  float pmax = p0[0];
#pragma unroll
  for (int r = 1; r < 16; ++r) pmax = fmaxf(pmax, p0[r]);
#pragma unroll
  for (int r = 0; r < 16; ++r) pmax = fmaxf(pmax, p1[r]);
  { auto rr = __builtin_amdgcn_permlane32_swap(__float_as_uint(pmax), __float_as_uint(pmax), false, false);
    pmax = fmaxf(__uint_as_float(rr[0]), __uint_as_float(rr[1])); }
#if ATTN_SM_SPLIT == 2
  { const bool keep = __all(pmax - m_reg <= THR / SCALE); mn = keep ? m_reg : fmaxf(m_reg, pmax); alpha = __builtin_amdgcn_exp2f((m_reg - mn) * C); m_reg = mn;
    const float mnC = -mn * C;
#pragma unroll
    for (int r = 0; r < 16; ++r) { p0[r] = __builtin_amdgcn_exp2f(fmaf(p0[r], C, mnC)); p1[r] = __builtin_amdgcn_exp2f(fmaf(p1[r], C, mnC)); } }
  return;
#endif
  if (__builtin_expect(__all(pmax - m_reg <= THR / SCALE), 1)) { mn = m_reg; alpha = 1.f; }
  else { mn = fmaxf(m_reg, pmax); alpha = __builtin_amdgcn_exp2f((m_reg - mn) * C); m_reg = mn; }
#if ATTN_SM_SPLIT == 1
  const float mnC = -mn * C;
#pragma unroll
  for (int r = 0; r < 16; ++r) p0[r] = fmaf(p0[r], C, mnC);
#pragma unroll
  for (int r = 0; r < 16; ++r) p1[r] = fmaf(p1[r], C, mnC);
#pragma unroll
  for (int r = 0; r < 16; ++r) p0[r] = __builtin_amdgcn_exp2f(p0[r]);
#endif
}
__device__ __forceinline__ void finishSM(f32x16& p0, f32x16& p1, float mn, float alpha, float& l_reg, bf16x8& pa0, bf16x8& pa1, bf16x8& pa2, bf16x8& pa3) {
#if ATTN_SM_SPLIT == 1
#pragma unroll
  for (int r = 0; r < 16; ++r) p1[r] = __builtin_amdgcn_exp2f(p1[r]);
#elif ATTN_SM_SPLIT == 2
  (void)mn;
#else
  { constexpr float C = SCALE * 1.4426950408889634f; const float mnC = -mn * C;
#pragma unroll
    for (int r = 0; r < 16; ++r) { p0[r] = __builtin_amdgcn_exp2f(fmaf(p0[r], C, mnC)); p1[r] = __builtin_amdgcn_exp2f(fmaf(p1[r], C, mnC)); } }
#endif
  float ps = 0;
#pragma unroll
  for (int r = 0; r < 16; ++r) ps += p0[r];
#pragma unroll
  for (int r = 0; r < 16; ++r) ps += p1[r];
  { auto rr = __builtin_amdgcn_permlane32_swap(__float_as_uint(ps), __float_as_uint(ps), false, false);
    ps = __uint_as_float(rr[0]) + __uint_as_float(rr[1]); }
  l_reg = l_reg * alpha + ps;
#define PK4(P, BASE, OUT) do { unsigned a0 = cvtpk(P[BASE + 0], P[BASE + 1]), a1 = cvtpk(P[BASE + 2], P[BASE + 3]);   \
    unsigned b0 = cvtpk(P[BASE + 4], P[BASE + 5]), b1 = cvtpk(P[BASE + 6], P[BASE + 7]);                              \
    auto r0 = __builtin_amdgcn_permlane32_swap(a0, b0, false, false); auto r1 = __builtin_amdgcn_permlane32_swap(a1, b1, false, false); \
    u32x4 w = {r0[0], r1[0], r0[1], r1[1]}; OUT = *reinterpret_cast<bf16x8*>(&w); } while (0)
  PK4(p0, 0, pa0); PK4(p0, 8, pa1); PK4(p1, 0, pa2); PK4(p1, 8, pa3);
#undef PK4
}
__device__ __forceinline__ void qkt(f32x16& p0, f32x16& p1, const char* Ks, const bf16x8* qr, int r32, int hi) {
  p0 = f32x16{}; p1 = f32x16{};
#pragma unroll
  for (int d0 = 0; d0 < DK / 16; ++d0) { const int cb = (d0 * 16 + hi * 8) * 2;
    const bf16x8 b0 = *reinterpret_cast<const bf16x8*>(Ks + KSWZ(r32, cb));
    const bf16x8 b1 = *reinterpret_cast<const bf16x8*>(Ks + KSWZ(32 + r32, cb));
    p0 = __builtin_amdgcn_mfma_f32_32x32x16_bf16(b0, qr[d0], p0, 0, 0, 0);
    p1 = __builtin_amdgcn_mfma_f32_32x32x16_bf16(b1, qr[d0], p1, 0, 0, 0); }
}
__device__ __forceinline__ int v_st(int k, int c) { const int kk = (k & ~0xC) | ((k & 4) << 1) | ((k & 8) >> 1); return ((kk >> 3) * 2 + (c >> 5)) * 512 + ((kk & 7) * 32 + (c & 31)) * 2; }
__device__ __forceinline__ int v_rd_base(int lane) { return ((lane & 3) << 3) | (((lane >> 2) & 3) << 6) | (((lane >> 4) & 1) << 5) | (((lane >> 5) & 1) << 8); }
constexpr int v_rd_off(int d0, int ks, int half) { return d0 * 512 + ks * 2048 + half * 1024; }
template <int OFF> __device__ __forceinline__ s16x4 tr_read(int vb) {
  s16x4 r; asm volatile("ds_read_b64_tr_b16 %0, %1 offset:%2" : "=&v"(r) : "v"(vb), "i"(OFF) : "memory"); return r;
}
template <int D0> __device__ __forceinline__ void pv_one(f32x16& od, int vb, bf16x8 pa0, bf16x8 pa1, bf16x8 pa2, bf16x8 pa3) {
  const s16x4 l0 = tr_read<v_rd_off(D0, 0, 0)>(vb), h0 = tr_read<v_rd_off(D0, 0, 1)>(vb), l1 = tr_read<v_rd_off(D0, 1, 0)>(vb), h1 = tr_read<v_rd_off(D0, 1, 1)>(vb);
  const s16x4 l2 = tr_read<v_rd_off(D0, 2, 0)>(vb), h2 = tr_read<v_rd_off(D0, 2, 1)>(vb), l3 = tr_read<v_rd_off(D0, 3, 0)>(vb), h3 = tr_read<v_rd_off(D0, 3, 1)>(vb);
  asm volatile("s_waitcnt lgkmcnt(0)" ::: "memory"); SBAR();
#define PK(L, H) (bf16x8){L[0], L[1], L[2], L[3], H[0], H[1], H[2], H[3]}
  od = __builtin_amdgcn_mfma_f32_32x32x16_bf16(pa0, PK(l0, h0), od, 0, 0, 0);
  od = __builtin_amdgcn_mfma_f32_32x32x16_bf16(pa1, PK(l1, h1), od, 0, 0, 0);
  od = __builtin_amdgcn_mfma_f32_32x32x16_bf16(pa2, PK(l2, h2), od, 0, 0, 0);
  od = __builtin_amdgcn_mfma_f32_32x32x16_bf16(pa3, PK(l3, h3), od, 0, 0, 0);
#undef PK
}
__device__ __forceinline__ void pv_d0(f32x16* o, int vb, bf16x8 pa0, bf16x8 pa1, bf16x8 pa2, bf16x8 pa3) {
  pv_one<0>(o[0], vb, pa0, pa1, pa2, pa3); pv_one<1>(o[1], vb, pa0, pa1, pa2, pa3);
}

__device__ __forceinline__ void pv_sm(f32x16* o, int vb, bf16x8 pa0, bf16x8 pa1, bf16x8 pa2, bf16x8 pa3, f32x16& p0, f32x16& p1, float& m_reg, float& mn, float& alpha) {
  constexpr float C = SCALE * 1.4426950408889634f;
  const s16x4 l00 = tr_read<v_rd_off(0, 0, 0)>(vb), h00 = tr_read<v_rd_off(0, 0, 1)>(vb), l10 = tr_read<v_rd_off(1, 0, 0)>(vb), h10 = tr_read<v_rd_off(1, 0, 1)>(vb);
  const s16x4 l01 = tr_read<v_rd_off(0, 1, 0)>(vb), h01 = tr_read<v_rd_off(0, 1, 1)>(vb), l11 = tr_read<v_rd_off(1, 1, 0)>(vb), h11 = tr_read<v_rd_off(1, 1, 1)>(vb);
  const s16x4 l02 = tr_read<v_rd_off(0, 2, 0)>(vb), h02 = tr_read<v_rd_off(0, 2, 1)>(vb), l12 = tr_read<v_rd_off(1, 2, 0)>(vb), h12 = tr_read<v_rd_off(1, 2, 1)>(vb);
  const s16x4 l03 = tr_read<v_rd_off(0, 3, 0)>(vb), h03 = tr_read<v_rd_off(0, 3, 1)>(vb), l13 = tr_read<v_rd_off(1, 3, 0)>(vb), h13 = tr_read<v_rd_off(1, 3, 1)>(vb);
  float pmax = p0[0];
#pragma unroll
  for (int r = 1; r < 16; ++r) pmax = fmaxf(pmax, p0[r]);
#pragma unroll
  for (int r = 0; r < 16; ++r) pmax = fmaxf(pmax, p1[r]);
  { auto rr = __builtin_amdgcn_permlane32_swap(__float_as_uint(pmax), __float_as_uint(pmax), false, false);
    pmax = fmaxf(__uint_as_float(rr[0]), __uint_as_float(rr[1])); }
  const bool keep = __all(pmax - m_reg <= THR / SCALE); mn = keep ? m_reg : fmaxf(m_reg, pmax); alpha = __builtin_amdgcn_exp2f((m_reg - mn) * C); m_reg = mn;
  const float mnC = -mn * C;
  asm volatile("s_waitcnt lgkmcnt(0)" ::: "memory"); SBAR();
#define PK(L, H) (bf16x8){L[0], L[1], L[2], L[3], H[0], H[1], H[2], H[3]}
#define EX4(P, B) do { P[B] = __builtin_amdgcn_exp2f(fmaf(P[B], C, mnC)); P[B + 1] = __builtin_amdgcn_exp2f(fmaf(P[B + 1], C, mnC)); P[B + 2] = __builtin_amdgcn_exp2f(fmaf(P[B + 2], C, mnC)); P[B + 3] = __builtin_amdgcn_exp2f(fmaf(P[B + 3], C, mnC)); } while (0)
  o[0] = __builtin_amdgcn_mfma_f32_32x32x16_bf16(pa0, PK(l00, h00), o[0], 0, 0, 0); EX4(p0, 0); SBAR();
  o[1] = __builtin_amdgcn_mfma_f32_32x32x16_bf16(pa0, PK(l10, h10), o[1], 0, 0, 0); EX4(p0, 4); SBAR();
  o[0] = __builtin_amdgcn_mfma_f32_32x32x16_bf16(pa1, PK(l01, h01), o[0], 0, 0, 0); EX4(p0, 8); SBAR();
  o[1] = __builtin_amdgcn_mfma_f32_32x32x16_bf16(pa1, PK(l11, h11), o[1], 0, 0, 0); EX4(p0, 12); SBAR();
  o[0] = __builtin_amdgcn_mfma_f32_32x32x16_bf16(pa2, PK(l02, h02), o[0], 0, 0, 0); EX4(p1, 0); SBAR();
  o[1] = __builtin_amdgcn_mfma_f32_32x32x16_bf16(pa2, PK(l12, h12), o[1], 0, 0, 0); EX4(p1, 4); SBAR();
  o[0] = __builtin_amdgcn_mfma_f32_32x32x16_bf16(pa3, PK(l03, h03), o[0], 0, 0, 0); EX4(p1, 8); SBAR();
  o[1] = __builtin_amdgcn_mfma_f32_32x32x16_bf16(pa3, PK(l13, h13), o[1], 0, 0, 0); EX4(p1, 12); SBAR();
#undef PK
#undef EX4
}

struct NoBgWork { __device__ __forceinline__ void collect() {} __device__ __forceinline__ void issue() {} };
template <class TQ, class Out, int VAR = 0, class BG = NoBgWork>
__device__ __forceinline__ void attn_unit(const TQ* Qb, int ldq, const unsigned short* Kh, const unsigned short* Vh, int seq, char* lds, const Out& OUT, BG&& bg = BG()) {
  int tid_ = TIDX; asm volatile("" : "+v"(tid_));
  const int tid = tid_, wid = tid >> 6, lane = tid & 63, r32 = lane & 31, hi = lane >> 5;
  char* V_lds = lds; char* K_lds = lds + NRING * SHM_V;
  float* ws = (float*)(lds + NRING * SHM_V + NRING * SHM_K) + wid * 64; float* li_l = ws; float* al_l = ws + 32;
  float m_reg = -1e30f, l_reg = 0; f32x16 o[2] = {}; f32x16 negm = {}; (void)negm;
#if ATTN_STAG
  char* Q_lds = lds + NRING * SHM_V + NRING * SHM_K + NW * 64 * 4;
  { static_assert(sizeof(TQ) == 2, "the stagger variant takes bf16 q rows");
#pragma unroll
    for (int k = 0; k < 6; ++k) { const int x = tid + k * 512, row = x / 12, c16 = x % 12; *(bf16x8*)(Q_lds + row * KROW + c16 * 16) = *reinterpret_cast<const bf16x8*>(Qb + (long)row * ldq + c16 * 8); } }
  const bf16x8* qr = reinterpret_cast<const bf16x8*>(Q_lds + (wid * QBLK + r32) * KROW + hi * 16);
#else
  bf16x8 qr[DK / 16];
  { const TQ* Qw = Qb + (long)(wid * QBLK + r32) * ldq + hi * 8;
#pragma unroll
    for (int d0 = 0; d0 < DK / 16; ++d0) {
      if constexpr (sizeof(TQ) == 4) qr[d0] = tobf(*reinterpret_cast<const f32x8*>(Qw + d0 * 16)); else qr[d0] = *reinterpret_cast<const bf16x8*>(Qw + d0 * 16); } }
#endif
  const int kc0 = tid, kc1 = 512 + tid; const bool two = tid < 256;
  const int kst0 = KSWZ(kc0 / 12, (kc0 % 12) * 16), kst1 = KSWZ(kc1 / 12, (kc1 % 12) * 16), vst = v_st(tid >> 3, (tid & 7) * 8);
  const int vb0 = (int)(uintptr_t)V_lds + v_rd_base(lane);
  struct { bf16x8 v, k0, k1; } sr_[ATTN_STAG ? 1 : 2];
#define SLOAD(i, key0) do { sr_[i].v = *reinterpret_cast<const bf16x8*>(Vh + (long)(key0) * DV + tid * 8); sr_[i].k0 = *reinterpret_cast<const bf16x8*>(Kh + (long)(key0) * DK + kc0 * 8); \
    if (two) sr_[i].k1 = *reinterpret_cast<const bf16x8*>(Kh + (long)(key0) * DK + kc1 * 8); } while (0)
#define SWRITE(b, i) do { *(bf16x8*)(V_lds + (b) * SHM_V + vst) = sr_[i].v; *(bf16x8*)(K_lds + (b) * SHM_K + kst0) = sr_[i].k0; if (two) *(bf16x8*)(K_lds + (b) * SHM_K + kst1) = sr_[i].k1; } while (0)
#define RESC(a) do { if (__any((a) < 1.f)) { if (hi == 0) al_l[r32] = (a); asm volatile("s_waitcnt lgkmcnt(0)" ::: "memory"); \
    _Pragma("unroll") for (int d = 0; d < 2; ++d) _Pragma("unroll") for (int r = 0; r < 16; ++r) o[d][r] *= al_l[crow(r, hi)]; } } while (0)
  f32x16 pA0 = {}, pA1 = {}, pB0 = {}, pB1 = {}; float mnA, mnB, alA, alB; bf16x8 pa0, pa1, pa2, pa3; const int NT = seq / KVBLK;
  constexpr int SE = 0, SO = 1;
#if ATTN_NEGM
#define PSM(p0_, p1_, m_, mn_, al_) do { (void)mn_; partialSM_n(p0_, p1_, negm, al_); } while (0)
#else
#define PSM(p0_, p1_, m_, mn_, al_) do { if constexpr (VAR == 1) { mn_ = 0.f; al_ = 1.f; } else partialSM(p0_, p1_, m_, mn_, al_); } while (0)
#endif
#define FSM(p0_, p1_, mn_, al_, l_, a0_, a1_, a2_, a3_) do { if constexpr (VAR == 1) { u32x4 w0_ = {cvtpk(p0_[0], p0_[1]), cvtpk(p0_[2], p0_[3]), cvtpk(p0_[4], p0_[5]), cvtpk(p0_[6], p0_[7])}; a0_ = *reinterpret_cast<bf16x8*>(&w0_); \
      u32x4 w1_ = {cvtpk(p0_[8], p0_[9]), cvtpk(p0_[10], p0_[11]), cvtpk(p0_[12], p0_[13]), cvtpk(p0_[14], p0_[15])}; a1_ = *reinterpret_cast<bf16x8*>(&w1_); \
      u32x4 w2_ = {cvtpk(p1_[0], p1_[1]), cvtpk(p1_[2], p1_[3]), cvtpk(p1_[4], p1_[5]), cvtpk(p1_[6], p1_[7])}; a2_ = *reinterpret_cast<bf16x8*>(&w2_); \
      u32x4 w3_ = {cvtpk(p1_[8], p1_[9]), cvtpk(p1_[10], p1_[11]), cvtpk(p1_[12], p1_[13]), cvtpk(p1_[14], p1_[15])}; a3_ = *reinterpret_cast<bf16x8*>(&w3_); } else { if constexpr (ATTN_NEGM != 0) finishSM_n(p0_, p1_, al_, l_, a0_, a1_, a2_, a3_); else finishSM(p0_, p1_, mn_, al_, l_, a0_, a1_, a2_, a3_); } } while (0)
#define PVSM(o_, vb_, a0_, a1_, a2_, a3_, p0_, p1_, m_, mn_, al_) do { if constexpr (VAR == 0 && ATTN_SM_SPLIT == 2) pv_sm(o_, vb_, a0_, a1_, a2_, a3_, p0_, p1_, m_, mn_, al_); else { PVD(o_, vb_, a0_, a1_, a2_, a3_); PSM(p0_, p1_, m_, mn_, al_); } } while (0)
#define PVD(o_, vb_, a0_, a1_, a2_, a3_) do { if constexpr (VAR == 2) { asm volatile("" : "+v"(o_[0]), "+v"(o_[1]) : "v"(a0_), "v"(a1_), "v"(a2_), "v"(a3_)); } else pv_d0(o_, vb_, a0_, a1_, a2_, a3_); } while (0)
#define QKT(p0_, p1_, K_, q_, r_, h_) do { if constexpr (VAR == 5) { asm volatile("" : "+v"(p0_), "+v"(p1_)); } else { if constexpr (ATTN_NEGM != 0) qkt_n(p0_, p1_, K_, q_, negm, r_, h_); else qkt(p0_, p1_, K_, q_, r_, h_); } } while (0)
#define LSLOAD(i_, k_) do { if constexpr (VAR != 3) SLOAD(i_, k_); } while (0)
#define LSWRITE(b_, i_) do { if constexpr (VAR != 3) SWRITE(b_, i_); } while (0)
#define LSYNC() do { if constexpr (VAR != 4) __syncthreads(); } while (0)
#if ATTN_STAG
  const bool lead = __builtin_amdgcn_readfirstlane(wid) < 4;
  SLOAD(SE, 0); asm volatile("s_waitcnt vmcnt(0)" ::: "memory"); SWRITE(0, SE); __syncthreads();
  QKT(pA0, pA1, K_lds, qr, r32, hi);
  SLOAD(SE, KVBLK);
  if (lead) partialSM_n<true>(pA0, pA1, negm, alA);
  SWRITE(1, SE); __syncthreads();
  LSLOAD(SE, 2 * KVBLK);
  if (lead) { SBAR(); QKT(pB0, pB1, K_lds + 1 * SHM_K, qr, r32, hi); FSM(pA0, pA1, mnA, alA, l_reg, pa0, pa1, pa2, pa3); SBAR();
      PVD(o, vb0 + 0 * SHM_V, pa0, pa1, pa2, pa3); PSM(pB0, pB1, m_reg, mnB, alB); }
  else { partialSM_n<true>(pA0, pA1, negm, alA);
      SBAR(); QKT(pB0, pB1, K_lds + 1 * SHM_K, qr, r32, hi); FSM(pA0, pA1, mnA, alA, l_reg, pa0, pa1, pa2, pa3); SBAR(); }
  LSWRITE(2, SE); if (lead) RESC(alB); LSYNC();
  for (int j = 2; j < NT; j += 2) {
    if (j + 1 < NT) LSLOAD(SE, (j + 1) * KVBLK);
    if (lead) { SBAR(); QKT(pA0, pA1, K_lds + (j & 3) * SHM_K, qr, r32, hi); FSM(pB0, pB1, mnB, alB, l_reg, pa0, pa1, pa2, pa3); SBAR();
        PVD(o, vb0 + ((j - 1) & 3) * SHM_V, pa0, pa1, pa2, pa3); PSM(pA0, pA1, m_reg, mnA, alA); }
    else { PVD(o, vb0 + ((j - 2) & 3) * SHM_V, pa0, pa1, pa2, pa3); PSM(pB0, pB1, m_reg, mnB, alB); RESC(alB);
        SBAR(); QKT(pA0, pA1, K_lds + (j & 3) * SHM_K, qr, r32, hi); FSM(pB0, pB1, mnB, alB, l_reg, pa0, pa1, pa2, pa3); SBAR(); }
    if (j + 1 < NT) LSWRITE((j + 1) & 3, SE);
    if (lead) RESC(alA);
    LSYNC();
    if (j + 2 < NT) LSLOAD(SE, (j + 2) * KVBLK);
    if (lead) { SBAR(); QKT(pB0, pB1, K_lds + ((j + 1) & 3) * SHM_K, qr, r32, hi); FSM(pA0, pA1, mnA, alA, l_reg, pa0, pa1, pa2, pa3); SBAR();
        PVD(o, vb0 + (j & 3) * SHM_V, pa0, pa1, pa2, pa3); PSM(pB0, pB1, m_reg, mnB, alB); }
    else { PVD(o, vb0 + ((j - 1) & 3) * SHM_V, pa0, pa1, pa2, pa3); PSM(pA0, pA1, m_reg, mnA, alA); RESC(alA);
        SBAR(); QKT(pB0, pB1, K_lds + ((j + 1) & 3) * SHM_K, qr, r32, hi); FSM(pA0, pA1, mnA, alA, l_reg, pa0, pa1, pa2, pa3); SBAR(); }
    if (j + 2 < NT) LSWRITE((j + 2) & 3, SE);
    if (lead) RESC(alB);
    LSYNC();
  }
  if (!lead) { PVD(o, vb0 + ((NT - 2) & 3) * SHM_V, pa0, pa1, pa2, pa3); PSM(pB0, pB1, m_reg, mnB, alB); RESC(alB); }
  FSM(pB0, pB1, mnB, alB, l_reg, pa0, pa1, pa2, pa3); SBAR();
  PVD(o, vb0 + ((NT - 1) & 3) * SHM_V, pa0, pa1, pa2, pa3);
#elif ATTN_LAG2
  bf16x8 pb0, pb1, pb2, pb3;
  SLOAD(SE, 0); asm volatile("s_waitcnt vmcnt(0)" ::: "memory"); SWRITE(0, SE); __syncthreads();
  QKT(pA0, pA1, K_lds, qr, r32, hi);
#if ATTN_NEGM
  partialSM_n<true>(pA0, pA1, negm, alA);
#else
  PSM(pA0, pA1, m_reg, mnA, alA);
#endif
  SLOAD(SO, KVBLK); if (2 < NT) SLOAD(SE, 2 * KVBLK);
  SWRITE(1, SO); __syncthreads();
  SBAR(); QKT(pB0, pB1, K_lds + 1 * SHM_K, qr, r32, hi);
  FSM(pA0, pA1, mnA, alA, l_reg, pb0, pb1, pb2, pb3); SBAR();
  if (3 < NT) LSLOAD(SO, 3 * KVBLK); SBAR();
  PSM(pB0, pB1, m_reg, mnB, alB);
  LSWRITE(2, SE); LSYNC();
  for (int j = 2; j < NT; j += 2) {
    SBAR(); QKT(pA0, pA1, K_lds + (j & 3) * SHM_K, qr, r32, hi);
    FSM(pB0, pB1, mnB, alB, l_reg, pa0, pa1, pa2, pa3);
    PVD(o, vb0 + ((j - 2) & 3) * SHM_V, pb0, pb1, pb2, pb3); SBAR();
    if (j + 2 < NT) LSLOAD(SE, (j + 2) * KVBLK); SBAR();
    RESC(alB); PSM(pA0, pA1, m_reg, mnA, alA);
    if (j + 1 < NT) LSWRITE((j + 1) & 3, SO);
    LSYNC();
    SBAR(); QKT(pB0, pB1, K_lds + ((j + 1) & 3) * SHM_K, qr, r32, hi);
    FSM(pA0, pA1, mnA, alA, l_reg, pb0, pb1, pb2, pb3);
    PVD(o, vb0 + ((j - 1) & 3) * SHM_V, pa0, pa1, pa2, pa3); SBAR();
    if (j + 3 < NT) LSLOAD(SO, (j + 3) * KVBLK); SBAR();
    RESC(alA); PSM(pB0, pB1, m_reg, mnB, alB);
    if (j + 2 < NT) LSWRITE((j + 2) & 3, SE);
    LSYNC();
  }
  PVD(o, vb0 + ((NT - 2) & 3) * SHM_V, pb0, pb1, pb2, pb3);
  RESC(alB);
  FSM(pB0, pB1, mnB, alB, l_reg, pa0, pa1, pa2, pa3); SBAR();
  PVD(o, vb0 + ((NT - 1) & 3) * SHM_V, pa0, pa1, pa2, pa3);
#else
  int bp = 0, bc = 1, bn = 2;
#define ROT3() do { const int t_ = bp; bp = bc; bc = bn; bn = t_; } while (0)
  SLOAD(SE, 0); asm volatile("s_waitcnt vmcnt(0)" ::: "memory"); SWRITE(0, SE); __syncthreads();
  QKT(pA0, pA1, K_lds, qr, r32, hi);
#if ATTN_NEGM
  partialSM_n<true>(pA0, pA1, negm, alA);
#else
  PSM(pA0, pA1, m_reg, mnA, alA);
#endif
  SLOAD(SO, KVBLK); if (2 < NT) SLOAD(SE, 2 * KVBLK);
  SWRITE(1, SO); __syncthreads();
  for (int j = 1; j + 1 < NT; j += 2) {
    SBAR(); QKT(pB0, pB1, K_lds + bc * SHM_K, qr, r32, hi);
    FSM(pA0, pA1, mnA, alA, l_reg, pa0, pa1, pa2, pa3); SBAR();
    bg.collect(); SBAR();
    LSLOAD(SO, (j + 2) * KVBLK); SBAR();
    bg.issue(); SBAR();
    PVSM(o, vb0 + bp * SHM_V, pa0, pa1, pa2, pa3, pB0, pB1, m_reg, mnB, alB);
    LSWRITE(bn, SE);
    RESC(alB); LSYNC(); ROT3();
    SBAR(); QKT(pA0, pA1, K_lds + bc * SHM_K, qr, r32, hi);
    FSM(pB0, pB1, mnB, alB, l_reg, pa0, pa1, pa2, pa3); SBAR();
    bg.collect(); SBAR();
    if (j + 3 < NT) LSLOAD(SE, (j + 3) * KVBLK); SBAR();
    bg.issue(); SBAR();
    PVSM(o, vb0 + bp * SHM_V, pa0, pa1, pa2, pa3, pA0, pA1, m_reg, mnA, alA);
    LSWRITE(bn, SO);
    RESC(alA); LSYNC(); ROT3();
  }
  SBAR(); QKT(pB0, pB1, K_lds + bc * SHM_K, qr, r32, hi);
  FSM(pA0, pA1, mnA, alA, l_reg, pa0, pa1, pa2, pa3); SBAR();
  PVSM(o, vb0 + bp * SHM_V, pa0, pa1, pa2, pa3, pB0, pB1, m_reg, mnB, alB);
  RESC(alB);
  FSM(pB0, pB1, mnB, alB, l_reg, pa0, pa1, pa2, pa3); SBAR();
  PVD(o, vb0 + bc * SHM_V, pa0, pa1, pa2, pa3);
#undef ROT3
#endif
  if (hi == 0) li_l[r32] = l_reg; asm volatile("s_waitcnt lgkmcnt(0)" ::: "memory");
  float rli[16];
#pragma unroll
  for (int r = 0; r < 16; ++r) rli[r] = __builtin_amdgcn_rcpf(li_l[crow(r, hi)]);
#pragma unroll
  for (int r = 0; r < 16; ++r) { const int orow = wid * QBLK + crow(r, hi);
#pragma unroll
    for (int d0 = 0; d0 < 2; ++d0) OUT(orow, d0 * 32 + r32, o[d0][r] * rli[r]); }
  __syncthreads();
#undef SLOAD
#undef SWRITE
#undef RESC
#undef PSM
#undef PVSM
#undef FSM
#undef PVD
#undef QKT
#undef LSLOAD
#undef LSWRITE
#undef LSYNC
}
#undef KSWZ
#undef SBAR
}
struct Q2 {
    bf16* U16;
    bf16 *WtL;
    bf16 *WtM;
    bf16 *WtG;
    float *LSL;
    bf16 *HLOC, *PCUM;
    float *SA, *SB;
    bf16 *QN16, *KVN16;
    bf16 *Q16;
    bf16 *WtKvbP;
    bf16 *XCM16, *QKV16;
    float *GATES;
    float *CLOC, *NLOC, *MLB;
    bf16 *CST; float *NST, *MST;
    bf16 *YB16;
    float *GLIST;
};
constexpr int NCH = TPB / 128;
constexpr int NCH_CTX = CTX / 128;

__device__ __forceinline__ float wave_sum(float v) {
#pragma unroll
    for (int o = 1; o < 64; o <<= 1) v += __shfl_xor(v, o);
    return v;
}
__device__ __forceinline__ float fast_sigmoid(float x) { return __builtin_amdgcn_rcpf(1.f + __expf(-x)); }
__device__ __forceinline__ float fast_silu(float x) { return x * fast_sigmoid(x); }
__device__ __forceinline__ float fast_gelu(float x) { const float u = 0.7978845608028654f * (x + 0.044715f * x * x * x); return x * fast_sigmoid(2.f * u); }

struct EpiU16 {
    static constexpr bool PERM = true; bf16* U;
    __device__ __forceinline__ void operator()(const pg8::f32x4 (&acc)[2][2][4][2], const pg8::Unit& u, int wr, int wc, int fr, int fq) const {
#pragma unroll
        for (int ai = 0; ai < 2; ++ai)
#pragma unroll
            for (int m = 0; m < 4; ++m) { const int row = u.pm * 256 + ai * 128 + wr * 64 + m * 16 + fr;
#pragma unroll
                for (int bj = 0; bj < 2; ++bj) { const int c = u.pn * 256 + bj * 128 + wc * 32 + 8 * fq; const pg8::f32x4 v0 = acc[ai][bj][m][0], v1 = acc[ai][bj][m][1];
                    u32x4 w; w.x = pg8::cvt_pk_bf16(v0[0], v0[1]); w.y = pg8::cvt_pk_bf16(v0[2], v0[3]); w.z = pg8::cvt_pk_bf16(v1[0], v1[1]); w.w = pg8::cvt_pk_bf16(v1[2], v1[3]);
                    *(u32x4*)(U + (size_t)row * DINP + c) = w; } }
    }
};
__device__ __forceinline__ void opt_inproj16(const Q& q, const Q2& q2, int l, LAS unsigned char* lds, int G, int bid) {
    pg8::Gemm g{q.H16, q.WtIn + (size_t)l * DINP * D, D}; pg8::StaticOrder S; S.init(NT, DINP, G, bid);
    EpiU16 E{q2.U16}; pg8::gemm_phase<EpiU16, pg8::StaticOrder, true>(lds, g, S, E);
}

__device__ __forceinline__ void opt_convert_small(const P& p, const Q2& q2, long gtid, long nthr) {
    for (long it = gtid; it < (long)DEPTH * 4 * 256 * 64; it += nthr) { const int i = (int)(it & 63), n = (int)((it >> 6) & 255), g = (int)((it >> 14) & 3), l = (int)(it >> 16);
        const int d = n >> 7, gate = (n >> 6) & 1, j = n & 63; const float* w = (gate ? p.in[I_LWX] : p.in[I_LWA]) + ((((size_t)l * 2 + d) * 4 + g) * 64 + i) * 64 + j;
        q2.WtL[it] = (bf16)f2bf(*w); }
    for (long it = gtid; it < (long)DEPTH * 4 * 3 * 64 * 64; it += nthr) { const int i = (int)(it & 63), j = (int)((it >> 6) & 63), m = (int)((it >> 12) % 3), h = (int)((it / (3 * 4096)) & 3), l = (int)(it / (12 * 4096));
        const float* w = (m == 0 ? p.in[I_MWQ] : (m == 1 ? p.in[I_MWK] : p.in[I_MWV])) + (((size_t)l * 4 + h) * 64 + i) * 64 + j;
        q2.WtM[it] = (bf16)f2bf(*w * (m == 1 ? 0.125f : 1.f)); }
    for (long it = gtid; it < (long)DEPTH * 32 * 768; it += nthr) { const int i = (int)(it % 768), n = (int)((it / 768) & 31), l = (int)(it / (32 * 768));
        q2.WtG[it] = n < 16 ? (bf16)f2bf(p.in[I_MWG][((((size_t)l * 2 + (n >> 3)) * 768) + i) * 8 + (n & 7)]) : (bf16)0; }
    for (long it = gtid; it < (long)DEPTH * 2 * 256; it += nthr) q2.LSL[it] = logsigmoid_f(p.in[I_LLAM][it]);
}

__device__ __forceinline__ void opt_init_mod(const P& p, char* lds, int bid, int G) {
    int tid_ = TIDX; asm volatile("" : "+v"(tid_));
    const int tid = tid_; float* SC = (float*)lds; float* RED = (float*)(lds + 12288);
    for (int i = tid; i < 3 * D; i += 512) { const int cv = i / D, k = i % D; const float x = cv < 2 ? p.in[I_C][cv * D + k] : p.in[I_CCTX][k]; SC[i] = x / (1.f + __expf(-x)); }
    __syncthreads();
    for (int it = bid; it < DEPTH * 6 * D / 64; it += G) { const int l = it / (6 * D / 64), j = (it % (6 * D / 64)) * 64 + (tid & 63), kq = tid >> 6;
        const float* w = p.in[I_WMOD] + (size_t)l * D * 6 * D + (size_t)(128 * kq) * 6 * D + j; float a0 = 0.f, a1 = 0.f, a2 = 0.f;
#pragma unroll 8
        for (int k = 0; k < 128; ++k) { const float wv = w[(size_t)k * 6 * D]; a0 += SC[128 * kq + k] * wv; a1 += SC[D + 128 * kq + k] * wv; a2 += SC[2 * D + 128 * kq + k] * wv; }
        RED[(kq * 3 + 0) * 64 + (tid & 63)] = a0; RED[(kq * 3 + 1) * 64 + (tid & 63)] = a1; RED[(kq * 3 + 2) * 64 + (tid & 63)] = a2;
        __syncthreads();
        if (tid < 192) { const int cv = tid >> 6, jj = tid & 63; float sacc = p.in[I_BMOD][(size_t)l * 6 * D + (it % (6 * D / 64)) * 64 + jj];
#pragma unroll
            for (int x = 0; x < 8; ++x) sacc += RED[(x * 3 + cv) * 64 + jj];
            p.MOD[((size_t)l * 3 + cv) * 6 * D + (it % (6 * D / 64)) * 64 + jj] = sacc; }
        __syncthreads(); }
}
__device__ __forceinline__ void opt_init_rope(const P& p, long gtid, long nthr) {
    for (long it = gtid; it < (long)SEQ * 16; it += nthr) { const int s = (int)(it / 16), a = (int)((it / 8) & 1), f = (int)(it & 7); const int pos = a == 0 ? s / GRID_W : s % GRID_W;
        const float frf = f == 0 ? 1.f : f == 1 ? 0.31622776601683794f : f == 2 ? 0.1f : f == 3 ? 0.031622776601683791f : f == 4 ? 0.01f : f == 5 ? 0.0031622776601683794f : f == 6 ? 0.001f : 0.00031622776601683794f;
        const float ang = (float)pos * frf; float sn, cs; sincosf(ang, &sn, &cs);
        p.ROPET[it * 2] = cs; p.ROPET[it * 2 + 1] = sn; }
}

template <int KS, class TA, class TB>
__device__ __forceinline__ void wave_mm32(att::f32x16& acc, const TA* A, int lda, const TB* B, int ldb, int r32, int hi) {
#pragma unroll
    for (int ks = 0; ks < KS; ++ks) {
        const att::bf16x8 a = *reinterpret_cast<const att::bf16x8*>(A + (size_t)r32 * lda + ks * 16 + hi * 8);
        const att::bf16x8 b = *reinterpret_cast<const att::bf16x8*>(B + (size_t)r32 * ldb + ks * 16 + hi * 8);
        acc = __builtin_amdgcn_mfma_f32_32x32x16_bf16(a, b, acc, 0, 0, 0);
    }
}

constexpr int LRU1_LDS = 18432 + 65536 + 4096;
template <class UL>
__device__ __forceinline__ void lru1_item(const P& p, const Q2& q2, int l, int b, int ch, int g, char* lds, const UL& U) {
    int tid_ = TIDX; asm volatile("" : "+v"(tid_));
    const int tid = tid_, wave = tid >> 6, lane = tid & 63, r32 = lane & 31, hi = lane >> 5;
    unsigned short* XC16 = (unsigned short*)lds; float* AB = (float*)(lds + 18432); float* CMP = (float*)(lds + 18432 + 65536);
    const int t0 = b * TPB + ch * 128, seg_lo = ch < NCH_CTX ? b * TPB : b * TPB + CTX, seg_hi = ch < NCH_CTX ? b * TPB + CTX : (b + 1) * TPB;
    { const int j = tid & 63, c = g * 64 + j, tb = (tid >> 6) * 16; const float* cw = p.in[I_LCW] + (size_t)l * 4 * 256 + c; const float w0 = cw[0], w1 = cw[256], w2 = cw[512], w3 = cw[768], cb = p.in[I_LCB][(size_t)l * 256 + c];
      float xm2 = (t0 + tb - 2 >= seg_lo) ? U(t0 + tb - 2, OFF_AX + c) : 0.f, xm1 = (t0 + tb - 1 >= seg_lo) ? U(t0 + tb - 1, OFF_AX + c) : 0.f, x0 = U(t0 + tb, OFF_AX + c);
#pragma unroll 4
      for (int i = 0; i < 16; ++i) { const int t = t0 + tb + i; const float xp1 = (t + 1 < seg_hi) ? U(t + 1, OFF_AX + c) : 0.f;
          const float v = cb + w0 * xm2 + w1 * xm1 + w2 * x0 + w3 * xp1; XC16[(tb + i) * 72 + j] = (unsigned short)f2bf(v); xm2 = xm1; xm1 = x0; x0 = xp1; } }
    __syncthreads();
    const bf16* Wt = q2.WtL + ((size_t)l * 4 + g) * 256 * 64;
#pragma unroll 1
    for (int d = 0; d < 2; ++d) {
        const int rt = wave & 3, cj = wave >> 2; att::f32x16 ar = {}, ai = {};
        wave_mm32<4>(ar, XC16 + rt * 32 * 72, 72, Wt + (size_t)(d * 128 + cj * 32) * 64, 64, r32, hi);
        wave_mm32<4>(ai, XC16 + rt * 32 * 72, 72, Wt + (size_t)(d * 128 + 64 + cj * 32) * 64, 64, r32, hi);
        { const int j = cj * 32 + r32, c = g * 64 + j; const float ba = p.in[I_LBA][((size_t)l * 2 + d) * 256 + c], bx = p.in[I_LBX][((size_t)l * 2 + d) * 256 + c], lsl = q2.LSL[((size_t)l * 2 + d) * 256 + c];
#pragma unroll
          for (int r = 0; r < 16; ++r) { const int tt = rt * 32 + att::crow(r, hi); const float rg = fast_sigmoid(ar[r] + ba), ig = fast_sigmoid(ai[r] + bx), la = 8.f * rg * lsl, a = __expf(la);
              const float xc = bf2f(XC16[tt * 72 + j]); const float bb = sqrtf(fmaxf(1.f - a * a, 0.f)) * ig * xc;
              AB[(tt * 64 + j) * 2] = a; AB[(tt * 64 + j) * 2 + 1] = bb; } }
        __syncthreads();
        { const int j = tid & 63, sg = tid >> 6; float av[16], bv[16]; float A = 1.f, B = 0.f;
#pragma unroll
          for (int i = 0; i < 16; ++i) { const int s = sg * 16 + i, tt = d == 0 ? s : 127 - s; av[i] = AB[(tt * 64 + j) * 2]; bv[i] = AB[(tt * 64 + j) * 2 + 1]; B = av[i] * B + bv[i]; A *= av[i]; }
          CMP[(sg * 64 + j) * 2] = A; CMP[(sg * 64 + j) * 2 + 1] = B;
          __syncthreads();
          float cA = 1.f, cB = 0.f;
          for (int x = 0; x < sg; ++x) { const float xa = CMP[(x * 64 + j) * 2], xb = CMP[(x * 64 + j) * 2 + 1]; cB = xa * cB + xb; cA *= xa; }
          const int c = g * 64 + j; float h = cB, pc = cA;
          unsigned short* OUTS = (unsigned short*)AB;
#pragma unroll
          for (int i = 0; i < 16; ++i) { const int s = sg * 16 + i, tt = d == 0 ? s : 127 - s; h = av[i] * h + bv[i]; pc *= av[i];
              OUTS[tt * 64 + j] = (unsigned short)f2bf(h); OUTS[(128 + tt) * 64 + j] = (unsigned short)f2bf(pc); }
          if (sg == 7) { q2.SA[(((size_t)d * NB + b) * NCH + ch) * 256 + c] = pc; q2.SB[(((size_t)d * NB + b) * NCH + ch) * 256 + c] = h; }
          __syncthreads();
#pragma unroll
          for (int k = 0; k < 4; ++k) { const int x = tid + k * 512, arr = x >> 10, tt = (x >> 3) & 127, c8 = x & 7; const u32x4 v = *(const u32x4*)(OUTS + (arr * 128 + tt) * 64 + c8 * 8);
              *(u32x4*)((arr ? q2.PCUM : q2.HLOC) + ((size_t)d * NT + t0 + tt) * 256 + g * 64 + c8 * 8) = v; } }
        __syncthreads();
    }
}
__device__ __forceinline__ void lru2_item(const Q2& q2, bf16* Yp, int b, int ch, char* lds) {
    int tid_ = TIDX; asm volatile("" : "+v"(tid_));
    const int tid = tid_; float* CAR = (float*)lds;
    { const int d = tid >> 8, c = tid & 255; float h = 0.f;
      if (d == 0) { for (int j = 0; j < ch; ++j) h = q2.SA[(((size_t)0 * NB + b) * NCH + j) * 256 + c] * h + q2.SB[(((size_t)0 * NB + b) * NCH + j) * 256 + c]; }
      else { const bool isctx = ch < NCH_CTX;
          for (int j = NCH_CTX - 1; j >= (isctx ? ch + 1 : 0); --j) h = q2.SA[(((size_t)1 * NB + b) * NCH + j) * 256 + c] * h + q2.SB[(((size_t)1 * NB + b) * NCH + j) * 256 + c];
          if (!isctx) for (int j = NCH - 1; j > ch; --j) h = q2.SA[(((size_t)1 * NB + b) * NCH + j) * 256 + c] * h + q2.SB[(((size_t)1 * NB + b) * NCH + j) * 256 + c]; }
      CAR[tid] = h; }
    __syncthreads();
    const int t0 = b * TPB + ch * 128;
#pragma unroll 2
    for (int k = 0; k < 8; ++k) { const int x = tid + k * 512, tt = x >> 5, c0 = (x & 31) * 8, t = t0 + tt;
        const u32x4 hf = *(const u32x4*)(q2.HLOC + (size_t)t * 256 + c0), pf = *(const u32x4*)(q2.PCUM + (size_t)t * 256 + c0), hb = *(const u32x4*)(q2.HLOC + ((size_t)NT + t) * 256 + c0), pb = *(const u32x4*)(q2.PCUM + ((size_t)NT + t) * 256 + c0);
        const u32x4 ag = *(const u32x4*)(q2.U16 + (size_t)t * DINP + OFF_AG + c0); u32x4 o;
#pragma unroll
        for (int w = 0; w < 4; ++w) { float y[2];
#pragma unroll
            for (int e = 0; e < 2; ++e) { const int c = c0 + 2 * w + e; const unsigned sh = e ? 0u : 16u;
                const float h0 = __builtin_bit_cast(float, e ? (hf[w] & 0xffff0000u) : (hf[w] << 16)), p0 = __builtin_bit_cast(float, e ? (pf[w] & 0xffff0000u) : (pf[w] << 16));
                const float h1 = __builtin_bit_cast(float, e ? (hb[w] & 0xffff0000u) : (hb[w] << 16)), p1 = __builtin_bit_cast(float, e ? (pb[w] & 0xffff0000u) : (pb[w] << 16));
                const float a = __builtin_bit_cast(float, e ? (ag[w] & 0xffff0000u) : (ag[w] << 16)); (void)sh;
                y[e] = ((h0 + p0 * CAR[c]) + (h1 + p1 * CAR[256 + c])) * fast_gelu(a); }
            o[w] = pk2(y[0], y[1]); }
        *(u32x4*)(Yp + (size_t)t * DMIX + c0) = o; }
    __syncthreads();
}

template <class UL>
__device__ __forceinline__ void mla_prep_token(const P& p, const Q& q, const Q2& q2, int l, int t, int lane, const UL& U) {
    float xq[4], xk[2]; float sq = 0.f, sk = 0.f;
#pragma unroll
    for (int i = 0; i < 4; ++i) { xq[i] = U(t, OFF_BQ + lane * 4 + i); sq += xq[i] * xq[i]; }
#pragma unroll
    for (int i = 0; i < 2; ++i) { xk[i] = U(t, OFF_BKV + lane * 2 + i); sk += xk[i] * xk[i]; }
    sq = wave_sum(sq); sk = wave_sum(sk);
    const float rq = 1.f / sqrtf(sq * (1.f / QRANK) + EPS), rk = 1.f / sqrtf(sk * (1.f / KVRANK) + EPS);
    const float* gq = p.in[I_QNG] + (size_t)l * QRANK + lane * 4; const float* gk = p.in[I_KVNG] + (size_t)l * KVRANK + lane * 2;
    u32x2 wq; wq.x = pk2(xq[0] * rq * gq[0], xq[1] * rq * gq[1]); wq.y = pk2(xq[2] * rq * gq[2], xq[3] * rq * gq[3]);
    *(u32x2*)(q2.QN16 + (size_t)t * 256 + lane * 4) = wq;
    *(unsigned*)(q2.KVN16 + (size_t)t * 256 + lane * 2) = pk2(xk[0] * rk * gk[0], xk[1] * rk * gk[1]);
    *(unsigned*)(q2.KVN16 + (size_t)t * 256 + 128 + lane * 2) = 0u;
    const int b = t / TPB, key = t % TPB, h = lane >> 3, d0 = (lane & 7) * 4; const bool lat = key >= CTX; const int s = key - CTX;
    float o[4];
#pragma unroll
    for (int i = 0; i < 4; ++i) { const int dd = d0 + i, a = dd >> 4, half = (dd >> 3) & 1, f = dd & 7; const float me = U(t, OFF_BKR + dd), other = U(t, OFF_BKR + (dd ^ 8));
        float cs = 1.f, sn = 0.f; if (lat) { cs = p.ROPET[(((size_t)s * 2 + a) * 8 + f) * 2]; sn = p.ROPET[(((size_t)s * 2 + a) * 8 + f) * 2 + 1]; }
        o[i] = half == 0 ? me * cs - other * sn : me * cs + other * sn; }
    u32x2 wk; wk.x = pk2(o[0], o[1]); wk.y = pk2(o[2], o[3]);
    *(u32x2*)(q.K16 + (((size_t)b * AH + h) * TPB + key) * QKD + NOPE + d0) = wk;
}

struct EpiQproj {
    static constexpr bool PERM = true; bf16* Q16; const float* ROPET;
    __device__ __forceinline__ void operator()(const pg8::f32x4 (&acc)[2][2][4][2], const pg8::Unit& u, int wr, int wc, int fr, int fq) const {
#pragma unroll
        for (int bj = 0; bj < 2; ++bj) { const int blk = u.pn * 8 + bj * 4 + wc; const bool rope = (blk % 3) == 2; const int c = blk * 32 + 8 * fq;
#pragma unroll
            for (int ai = 0; ai < 2; ++ai)
#pragma unroll
                for (int m = 0; m < 4; ++m) { const int row = u.pm * 256 + ai * 128 + wr * 64 + m * 16 + fr; float v[8];
#pragma unroll
                    for (int x = 0; x < 4; ++x) { v[x] = acc[ai][bj][m][0][x]; v[4 + x] = acc[ai][bj][m][1][x]; }
                    if (rope) {
                        const int key = (u.pm % (TPB / 256)) * 256 + ai * 128 + wr * 64 + m * 16 + fr; const bool lat = key >= CTX; const int s = lat ? key - CTX : 0, a = fq >> 1; const float* tb = ROPET + ((size_t)s * 2 + a) * 16;
#pragma unroll
                        for (int x = 0; x < 8; ++x) { const float other = __shfl_xor(v[x], 16); const float cs = lat ? tb[x * 2] : 1.f, sn = lat ? tb[x * 2 + 1] : 0.f;
                            v[x] = (fq & 1) == 0 ? v[x] * cs - other * sn : v[x] * cs + other * sn; } }
#pragma unroll
                    for (int x = 0; x < 8; ++x) v[x] *= att::QPRESCALE;
                    u32x4 w; w.x = pg8::cvt_pk_bf16(v[0], v[1]); w.y = pg8::cvt_pk_bf16(v[2], v[3]); w.z = pg8::cvt_pk_bf16(v[4], v[5]); w.w = pg8::cvt_pk_bf16(v[6], v[7]);
                    *(u32x4*)(Q16 + (size_t)row * 768 + c) = w; asm volatile("" ::: "memory"); } }
    }
};
struct EpiKVproj {
    static constexpr bool PERM = true; bf16* K16; bf16* V16;
    __device__ __forceinline__ void operator()(const pg8::f32x4 (&acc)[2][2][4][2], const pg8::Unit& u, int wr, int wc, int fr, int fq) const {
#pragma unroll
        for (int bj = 0; bj < 2; ++bj) { const int h = u.pn * 2 + bj, dcol = wc * 32 + 8 * fq; const bool isv = dcol >= 64;
#pragma unroll
            for (int ai = 0; ai < 2; ++ai)
#pragma unroll
                for (int m = 0; m < 4; ++m) { const int b = u.pm / (TPB / 256), key = (u.pm % (TPB / 256)) * 256 + ai * 128 + wr * 64 + m * 16 + fr; const pg8::f32x4 v0 = acc[ai][bj][m][0], v1 = acc[ai][bj][m][1];
                    u32x4 w; w.x = pg8::cvt_pk_bf16(v0[0], v0[1]); w.y = pg8::cvt_pk_bf16(v0[2], v0[3]); w.z = pg8::cvt_pk_bf16(v1[0], v1[1]); w.w = pg8::cvt_pk_bf16(v1[2], v1[3]);
                    bf16* dst = isv ? V16 + (((size_t)b * AH + h) * TPB + key) * VD + (dcol - 64) : K16 + (((size_t)b * AH + h) * TPB + key) * QKD + dcol;
                    *(u32x4*)dst = w; asm volatile("" ::: "memory"); } }
    }
};
struct MlaOrder : pg8::StaticOrder { __device__ __forceinline__ int arow(const pg8::Unit& u, int r) const { return (u.pn >= 3 ? NT : 0) + u.pm * pg8::BM + r; } };
struct EpiMla { static constexpr bool PERM = true; EpiQproj eq; EpiKVproj ekv;
    __device__ __forceinline__ void operator()(const pg8::f32x4 (&acc)[2][2][4][2], const pg8::Unit& u, int wr, int wc, int fr, int fq) const {
        if (u.pn < 3) eq(acc, u, wr, wc, fr, fq); else { pg8::Unit v = u; v.pn = u.pn - 3; ekv(acc, v, wr, wc, fr, fq); } } };
__device__ __forceinline__ void opt_mla_proj(const P& p, const Q& q, const Q2& q2, int l, LAS unsigned char* lds, int G, int bid) {
    pg8::Gemm g{q2.QN16, q2.WtKvbP + (size_t)l * 1792 * 256, 256}; MlaOrder S; S.init(NT, 1792, G, bid);
    EpiMla E{EpiQproj{q2.Q16, p.ROPET}, EpiKVproj{q.K16, q.V16}}; pg8::gemm_phase<EpiMla, MlaOrder, true>(lds, g, S, E);
}
__device__ __forceinline__ int ord_len(int d, int ch) { return d == 0 ? ch : (ch < NCH_CTX ? NCH_CTX - 1 - ch : NCH_CTX + (NCH - 1 - ch)); }
__device__ __forceinline__ int ord_chunk(int d, int ch, int i) { return d == 0 ? i : (i < (ch < NCH_CTX ? NCH_CTX - 1 - ch : NCH_CTX) ? NCH_CTX - 1 - i : NCH - 1 - (i - NCH_CTX)); }

__device__ __forceinline__ void wave_scan_add128(float& x0, float& x1, int lane) {
#pragma unroll
    for (int off = 1; off < 64; off <<= 1) { const float y0 = __shfl_up(x0, off), y1 = __shfl_up(x1, off); if (lane >= off) { x0 += y0; x1 += y1; } }
    x1 += __shfl(x0, 63);
}
__device__ __forceinline__ void wave_scan_max128(float& x0, float& x1, int lane) {
#pragma unroll
    for (int off = 1; off < 64; off <<= 1) { const float y0 = __shfl_up(x0, off), y1 = __shfl_up(x1, off); if (lane >= off) { x0 = fmaxf(x0, y0); x1 = fmaxf(x1, y1); } }
    x1 = fmaxf(x1, __shfl(x0, 63));
}
__device__ __forceinline__ float wave_max(float v) {
#pragma unroll
    for (int o = 1; o < 64; o <<= 1) v = fmaxf(v, __shfl_xor(v, o));
    return v;
}

constexpr int ML1_LDS = 116736;
template <class UL>
__device__ __forceinline__ void ml1_item(const P& p, const Q2& q2, int l, int b, int ch, char* lds, const UL& U) {
    int tid_ = TIDX; asm volatile("" : "+v"(tid_));
    const int tid = tid_, wave = tid >> 6, lane = tid & 63, r32 = lane & 31, hi = lane >> 5;
    unsigned short* XCh = (unsigned short*)lds; unsigned short* UXh = (unsigned short*)(lds + 18432); unsigned short* QKVh = (unsigned short*)(lds + 36864);
    float* GP = (float*)(lds + 92160); float* GT = (float*)(lds + 108544);
    const int t0 = b * TPB + ch * 128, seg_lo = ch < NCH_CTX ? b * TPB : b * TPB + CTX, seg_hi = ch < NCH_CTX ? b * TPB + CTX : (b + 1) * TPB;
    const int rt = wave & 3, wh = wave >> 2;
    att::f32x16 gacc = {};
#pragma unroll 1
    for (int h = 0; h < 4; ++h) {
        { const int j = tid & 63, c = h * 64 + j, tb = (tid >> 6) * 16; const float* cw = p.in[I_MCW] + (size_t)l * 4 * 256 + c; const float w0 = cw[0], w1 = cw[256], w2 = cw[512], w3 = cw[768], cb = p.in[I_MCB][(size_t)l * 256 + c];
          float xm2 = (t0 + tb - 2 >= seg_lo) ? U(t0 + tb - 2, OFF_MX + c) : 0.f, xm1 = (t0 + tb - 1 >= seg_lo) ? U(t0 + tb - 1, OFF_MX + c) : 0.f, x0 = U(t0 + tb, OFF_MX + c);
#pragma unroll 4
          for (int i = 0; i < 16; ++i) { const int t = t0 + tb + i; const float xp1 = (t + 1 < seg_hi) ? U(t + 1, OFF_MX + c) : 0.f;
              const float v = fast_silu(cb + w0 * xm2 + w1 * xm1 + w2 * x0 + w3 * xp1); const unsigned short vb = (unsigned short)f2bf(v);
              XCh[(tb + i) * 72 + j] = vb; UXh[(tb + i) * 72 + j] = (unsigned short)f2bf(x0); xm2 = xm1; xm1 = x0; x0 = xp1; } }
        __syncthreads();
        { const bf16* Wm = q2.WtM + ((size_t)l * 4 + h) * 3 * 4096;
#pragma unroll
          for (int m = 0; m < 3; ++m) { att::f32x16 a = {};
              wave_mm32<4>(a, (m == 2 ? UXh : XCh) + rt * 32 * 72, 72, Wm + (size_t)m * 4096 + (size_t)wh * 32 * 64, 64, r32, hi);
#pragma unroll
              for (int r = 0; r < 16; ++r) { const int tt = rt * 32 + att::crow(r, hi); const unsigned short vb = (unsigned short)f2bf(a[r]);
                  QKVh[(m * 128 + tt) * 72 + wh * 32 + r32] = vb; } } }
        __syncthreads();
#pragma unroll
        for (int k = 0; k < 2; ++k) { const int x = tid + k * 512, tt = x >> 3, c8 = x & 7; *(u32x4*)(q2.XCM16 + (size_t)(t0 + tt) * 256 + h * 64 + c8 * 8) = *(const u32x4*)(XCh + tt * 72 + c8 * 8); }
#pragma unroll
        for (int k = 0; k < 6; ++k) { const int x = tid + k * 512, m = x >> 10, tt = (x >> 3) & 127, c8 = x & 7;
            *(u32x4*)(q2.QKV16 + (size_t)(t0 + tt) * 768 + m * 256 + h * 64 + c8 * 8) = *(const u32x4*)(QKVh + (m * 128 + tt) * 72 + c8 * 8); }
        { const bf16* Wg = q2.WtG + (size_t)l * 32 * 768;
#pragma unroll
          for (int x = 0; x < 6; ++x) { const int idx = wh * 6 + x, m = idx >> 2, ks = idx & 3;
              const att::bf16x8 a = *reinterpret_cast<const att::bf16x8*>(QKVh + (m * 128 + rt * 32 + r32) * 72 + ks * 16 + hi * 8);
              const att::bf16x8 bb = *reinterpret_cast<const att::bf16x8*>(Wg + (size_t)r32 * 768 + m * 256 + h * 64 + ks * 16 + hi * 8);
              gacc = __builtin_amdgcn_mfma_f32_32x32x16_bf16(a, bb, gacc, 0, 0, 0); } }
        __syncthreads();
    }
    if (r32 < 16) {
#pragma unroll
        for (int r = 0; r < 16; ++r) GP[(wh * 128 + rt * 32 + att::crow(r, hi)) * 16 + r32] = gacc[r]; }
    __syncthreads();
    for (int i = tid; i < 128 * 16; i += 512) { const int n = i & 15, d = n >> 3, g = n & 7; float v = GP[i] + GP[128 * 16 + i] + p.in[I_MBG][((size_t)l * 2 + d) * 8 + g];
        if (g >= 4) v = fminf(v, 0.f) - __logf(1.f + __expf(-fabsf(v)));
        GT[i] = v; q2.GATES[(size_t)(t0 + (i >> 4)) * 16 + n] = v; }
    __syncthreads();
    unsigned short* KT = (unsigned short*)lds; unsigned short* VT = (unsigned short*)(lds + 17408); float* WR = (float*)(lds + 52224); float* MB = (float*)(lds + 53248); float* WE = (float*)(lds + 53280);
#pragma unroll 1
    for (int h = 0; h < 4; ++h) {
        if (wave < 2) { const int d = wave, ta = d == 0 ? lane : 127 - lane, tb = d == 0 ? lane + 64 : 63 - lane;
            float b0 = GT[ta * 16 + d * 8 + 4 + h], b1 = GT[tb * 16 + d * 8 + 4 + h]; wave_scan_add128(b0, b1, lane);
            const float bL = __shfl(b1, 63), w0 = bL - b0 + GT[ta * 16 + d * 8 + h], w1 = bL - b1 + GT[tb * 16 + d * 8 + h];
            WR[d * 128 + ta] = w0; WR[d * 128 + tb] = w1; const float mx = wave_max(fmaxf(w0, w1));
            if (lane == 0) { MB[d * 2] = mx; MB[d * 2 + 1] = bL; } }
        __syncthreads();
        { const int tt = tid & 127, jg = tid >> 7; const float w0 = __expf(WR[tt] - MB[0]), w1 = __expf(WR[128 + tt] - MB[2]);
          const unsigned short* ksrc = (const unsigned short*)q2.QKV16 + (size_t)(t0 + tt) * 768 + 256 + h * 64 + jg * 16; const unsigned short* vsrc = ksrc + 256;
          const att::bf16x8 k0 = *reinterpret_cast<const att::bf16x8*>(ksrc), k1 = *reinterpret_cast<const att::bf16x8*>(ksrc + 8), v0 = *reinterpret_cast<const att::bf16x8*>(vsrc), v1 = *reinterpret_cast<const att::bf16x8*>(vsrc + 8);
#pragma unroll
          for (int i = 0; i < 8; ++i) { KT[(jg * 16 + i) * 136 + tt] = (unsigned short)k0[i]; KT[(jg * 16 + 8 + i) * 136 + tt] = (unsigned short)k1[i];
              const float va = bf2f((unsigned short)v0[i]), vb = bf2f((unsigned short)v1[i]);
              VT[(jg * 16 + i) * 136 + tt] = (unsigned short)f2bf(va * w0); VT[(jg * 16 + 8 + i) * 136 + tt] = (unsigned short)f2bf(vb * w0);
              VT[(64 + jg * 16 + i) * 136 + tt] = (unsigned short)f2bf(va * w1); VT[(64 + jg * 16 + 8 + i) * 136 + tt] = (unsigned short)f2bf(vb * w1); }
          if (tid < 128) WE[tid] = w0; else if (tid < 256) WE[tid] = w1; }
        __syncthreads();
        { const int d = wave >> 2, vt = (wave >> 1) & 1, kt = wave & 1; att::f32x16 c = {};
          wave_mm32<8>(c, VT + (size_t)(d * 64 + vt * 32) * 136, 136, KT + (size_t)kt * 32 * 136, 136, r32, hi);
          float* dst = q2.CLOC + ((((size_t)d * NB + b) * NCH + ch) * 4 + h) * 4096;
#pragma unroll
          for (int r = 0; r < 16; ++r) dst[(vt * 32 + att::crow(r, hi)) * 64 + kt * 32 + r32] = c[r];
          { const int dd = tid >> 8, k = (tid >> 2) & 63, qt = tid & 3; float s = 0.f;
#pragma unroll 8
            for (int i = 0; i < 32; ++i) { const int tt = qt * 32 + i; s += WE[dd * 128 + tt] * bf2f(KT[k * 136 + tt]); }
            s += __shfl_xor(s, 1); s += __shfl_xor(s, 2);
            if (qt == 0) q2.NLOC[((((size_t)dd * NB + b) * NCH + ch) * 4 + h) * 64 + k] = s; }
          if (tid < 2) { float* mb = q2.MLB + ((((size_t)tid * NB + b) * NCH + ch) * 4 + h) * 2; mb[0] = MB[tid * 2]; mb[1] = MB[tid * 2 + 1]; } }
        __syncthreads();
    }
}

__device__ __forceinline__ void ml_scan_item(const Q2& q2, int item, char* lds) {
    int tid_ = TIDX; asm volatile("" : "+v"(tid_));
    const int tid = tid_, vq = item & 3, h = (item >> 2) & 3, b = (item >> 4) & 1, d = item >> 5;
    float* MLs = (float*)lds; float* MSEQ = MLs + 2 * NCH + 16;
    for (int i = tid; i < NCH; i += 512) { const float* mb = q2.MLB + ((((size_t)d * NB + b) * NCH + ord_chunk(d, NCH, i)) * 4 + h) * 2; MLs[2 * i] = mb[0]; MLs[2 * i + 1] = mb[1]; }
    __syncthreads();
    if (tid == 0) { float m = 0.f; for (int i = 0; i < NCH; ++i) { MSEQ[i] = m; m = fmaxf(MLs[2 * i + 1] + m, MLs[2 * i]); } MSEQ[NCH] = m; }
    __syncthreads();
    const int e0 = vq * 1024 + tid * 2; float c0 = 0.f, c1 = 0.f, nn = 0.f; const bool don = (vq == 0 && tid < 64);
    static_assert(NCH % 11 == 0, "the scan streams the chunk contributions 11 at a time");
#pragma unroll 1
    for (int i0 = 0; i0 < NCH; i0 += 11) { float2 cl[11]; float nl[11];
#pragma unroll
        for (int x = 0; x < 11; ++x) { const size_t idx = (((size_t)d * NB + b) * NCH + ord_chunk(d, NCH, i0 + x)) * 4 + h; cl[x] = *(const float2*)(q2.CLOC + idx * 4096 + e0); nl[x] = don ? q2.NLOC[idx * 64 + tid] : 0.f; }
#pragma unroll
        for (int x = 0; x < 11; ++x) { const int i = i0 + x; const size_t idx = (((size_t)d * NB + b) * NCH + ord_chunk(d, NCH, i)) * 4 + h;
            *(unsigned*)(q2.CST + idx * 4096 + e0) = pk2(c0, c1);
            if (don) q2.NST[idx * 64 + tid] = nn;
            if (vq == 0 && tid == 64) q2.MST[idx] = MSEQ[i];
            const float m = MSEQ[i], mn = MSEQ[i + 1], dec = __expf(MLs[2 * i + 1] + m - mn), sc = __expf(MLs[2 * i] - mn);
            c0 = dec * c0 + sc * cl[x].x; c1 = dec * c1 + sc * cl[x].y; nn = dec * nn + sc * nl[x]; } }
    __syncthreads();
}

constexpr int ML2_LDS = 145536;
template <class UL, class YS>
__device__ __forceinline__ void ml2_item(const P& p, const Q2& q2, int l, int b, int ch, int h, char* lds, const UL& U, const YS& Y) {
    int tid_ = TIDX; asm volatile("" : "+v"(tid_));
    const int tid = tid_, wave = tid >> 6, lane = tid & 63, r32 = lane & 31, hi = lane >> 5;
    char* Ks = lds; char* Vs = lds + 32768; unsigned short* C0 = (unsigned short*)(lds + 49152); float* N0 = (float*)(lds + 67584); float* ROWV = (float*)(lds + 68096);
    float* COEF = (float*)(lds + 73216); float* M0 = (float*)(lds + 73792); float* WS = (float*)(lds + 73856) + wave * 64; float* HX = (float*)(lds + 75904);
    const int t0 = b * TPB + ch * 128;
    { const unsigned short* base = (const unsigned short*)q2.QKV16 + (size_t)t0 * 768 + h * 64;
#pragma unroll
      for (int x = 0; x < 2; ++x) { const int cidx = tid + x * 512, key = cidx >> 3, c8 = cidx & 7, tile = key >> 6, kk = key & 63;
          const att::bf16x8 kv = *reinterpret_cast<const att::bf16x8*>(base + (size_t)key * 768 + 256 + c8 * 8), vv = *reinterpret_cast<const att::bf16x8*>(base + (size_t)key * 768 + 512 + c8 * 8);
          *(att::bf16x8*)(Ks + tile * 16384 + (kk * 256 + ((c8 * 16) ^ ((kk & 7) << 4)))) = kv;
          *(att::bf16x8*)(Vs + tile * 8192 + att::v_st(kk, c8 * 8)) = vv; } }
    if (wave < 2) { const int d = wave, ta = d == 0 ? lane : 127 - lane, tb = d == 0 ? lane + 64 : 63 - lane;
        float* g = ROWV + (d * 5 + 0) * 128; float* pmv = ROWV + (d * 5 + 1) * 128; float* bv = ROWV + (d * 5 + 2) * 128;
        const float iga = q2.GATES[(size_t)(t0 + ta) * 16 + d * 8 + h], igb = q2.GATES[(size_t)(t0 + tb) * 16 + d * 8 + h];
        float b0 = q2.GATES[(size_t)(t0 + ta) * 16 + d * 8 + 4 + h], b1 = q2.GATES[(size_t)(t0 + tb) * 16 + d * 8 + 4 + h]; wave_scan_add128(b0, b1, lane);
        const float g0 = iga - b0, g1 = igb - b1; float p0 = g0, p1 = g1; wave_scan_max128(p0, p1, lane);
        g[ta] = g0; g[tb] = g1; pmv[ta] = p0; pmv[tb] = p1; bv[ta] = b0; bv[tb] = b1; }
    __syncthreads();
    { const int d = tid >> 8, e0 = (tid & 255) * 16; const size_t idx = (((size_t)d * NB + b) * NCH + ch) * 4 + h;
      const u32x4* src = (const u32x4*)(q2.CST + idx * 4096 + e0); const u32x4 w0 = src[0], w1 = src[1];
      { const int v = e0 >> 6, k = e0 & 63; unsigned short* dst = C0 + (d * 64 + v) * 72 + k; *(u32x4*)dst = w0; *(u32x4*)(dst + 8) = w1; }
      if (tid < 128) { const int nd = tid >> 6, nk = tid & 63; N0[nd * 64 + nk] = q2.NST[((((size_t)nd * NB + b) * NCH + ch) * 4 + h) * 64 + nk]; }
      if (tid < 2) M0[tid] = q2.MST[(((size_t)tid * NB + b) * NCH + ch) * 4 + h]; }
    __syncthreads();
    {
      if (tid < 256) { const int dd = tid >> 7, tt = tid & 127; const float m0 = M0[dd], M = fmaxf(m0, ROWV[(dd * 5 + 1) * 128 + tt]);
          ROWV[(dd * 5 + 1) * 128 + tt] = M; ROWV[(dd * 5 + 3) * 128 + tt] = __expf(m0 - M); ROWV[(dd * 5 + 4) * 128 + tt] = __expf(-(ROWV[(dd * 5 + 2) * 128 + tt] + M)); } }
    __syncthreads();
    { const int qb = wave & 3, d = wave >> 2; const float* g = ROWV + (d * 5 + 0) * 128; const float* Mv = ROWV + (d * 5 + 1) * 128; const float* wiv = ROWV + (d * 5 + 3) * 128; const float* emtv = ROWV + (d * 5 + 4) * 128;
      att::bf16x8 qr[4]; const int sq = qb * 32 + r32;
      { const unsigned short* qw = (const unsigned short*)q2.QKV16 + (size_t)(t0 + sq) * 768 + h * 64 + hi * 8;
#pragma unroll
        for (int d0 = 0; d0 < 4; ++d0) qr[d0] = *reinterpret_cast<const att::bf16x8*>(qw + d0 * 16); }
      const float Ms = Mv[sq] * 1.4426950408889634f; att::f32x16 o[2] = {}; float rs = 0.f;
      const int vb0 = (int)(uintptr_t)Vs + att::v_rd_base(lane);
#pragma unroll
      for (int kt = 0; kt < 2; ++kt) {
          const bool skip = d == 0 ? (kt == 1 && qb < 2) : (kt == 0 && qb >= 2);
          if (!skip) {
              att::f32x16 p0 = {}, p1 = {}; const char* Kt = Ks + kt * 16384;
#pragma unroll
              for (int d0 = 0; d0 < 4; ++d0) { const int cb = (d0 * 16 + hi * 8) * 2;
                  const att::bf16x8 b0 = *reinterpret_cast<const att::bf16x8*>(Kt + (r32 * 256 + (cb ^ ((r32 & 7) << 4))));
                  const att::bf16x8 b1 = *reinterpret_cast<const att::bf16x8*>(Kt + ((32 + r32) * 256 + (cb ^ ((r32 & 7) << 4))));
                  p0 = __builtin_amdgcn_mfma_f32_32x32x16_bf16(b0, qr[d0], p0, 0, 0, 0); p1 = __builtin_amdgcn_mfma_f32_32x32x16_bf16(b1, qr[d0], p1, 0, 0, 0); }
#pragma unroll
              for (int r = 0; r < 16; ++r) { const int k0 = kt * 64 + att::crow(r, hi), k1 = k0 + 32;
                  const bool ok0 = d == 0 ? k0 <= sq : k0 >= sq, ok1 = d == 0 ? k1 <= sq : k1 >= sq;
                  p0[r] = ok0 ? p0[r] * __builtin_amdgcn_exp2f(g[k0] * 1.4426950408889634f - Ms) : 0.f; p1[r] = ok1 ? p1[r] * __builtin_amdgcn_exp2f(g[k1] * 1.4426950408889634f - Ms) : 0.f;
                  rs += p0[r] + p1[r]; }
              att::bf16x8 pa0, pa1, pa2, pa3;
#define PK4(P, BASE, OUT) do { unsigned a0 = att::cvtpk(P[BASE + 0], P[BASE + 1]), a1 = att::cvtpk(P[BASE + 2], P[BASE + 3]);   \
    unsigned b0 = att::cvtpk(P[BASE + 4], P[BASE + 5]), b1 = att::cvtpk(P[BASE + 6], P[BASE + 7]);                              \
    auto r0 = __builtin_amdgcn_permlane32_swap(a0, b0, false, false); auto r1 = __builtin_amdgcn_permlane32_swap(a1, b1, false, false); \
    att::u32x4 w = {r0[0], r1[0], r0[1], r1[1]}; OUT = *reinterpret_cast<att::bf16x8*>(&w); } while (0)
              PK4(p0, 0, pa0); PK4(p0, 8, pa1); PK4(p1, 0, pa2); PK4(p1, 8, pa3);
#undef PK4
              att::pv_d0(o, vb0 + kt * 8192, pa0, pa1, pa2, pa3);
          }
      }
      att::f32x16 ic[2] = {};
#pragma unroll
      for (int vt = 0; vt < 2; ++vt)
#pragma unroll
          for (int d0 = 0; d0 < 4; ++d0) { const att::bf16x8 cb = *reinterpret_cast<const att::bf16x8*>(C0 + (d * 64 + vt * 32 + r32) * 72 + d0 * 16 + hi * 8);
              ic[vt] = __builtin_amdgcn_mfma_f32_32x32x16_bf16(qr[d0], cb, ic[vt], 0, 0, 0); }
      float nq = 0.f;
#pragma unroll
      for (int d0 = 0; d0 < 4; ++d0)
#pragma unroll
          for (int x = 0; x < 8; ++x) nq += bf2f((unsigned short)qr[d0][x]) * N0[d * 64 + d0 * 16 + hi * 8 + x];
      { auto rr = __builtin_amdgcn_permlane32_swap(__float_as_uint(nq), __float_as_uint(nq), false, false); nq = __uint_as_float(rr[0]) + __uint_as_float(rr[1]); }
      { auto rr = __builtin_amdgcn_permlane32_swap(__float_as_uint(rs), __float_as_uint(rs), false, false); rs = __uint_as_float(rr[0]) + __uint_as_float(rr[1]); }
      const float den = rs + wiv[sq] * nq, dn = fmaxf(fabsf(den), emtv[sq]);
      if (hi == 0) WS[r32] = __builtin_amdgcn_rcpf(dn);
      asm volatile("s_waitcnt lgkmcnt(0)" ::: "memory");
#pragma unroll
      for (int r = 0; r < 16; ++r) { const int row = att::crow(r, hi), tt = qb * 32 + row; const float inv = WS[row], wi = wiv[tt];
#pragma unroll
          for (int vt = 0; vt < 2; ++vt) HX[(d * 128 + tt) * 68 + vt * 32 + r32] = (o[vt][r] + wi * ic[vt][r]) * inv; }
    }
    __syncthreads();
    { const int tt = tid >> 2, v0 = (tid & 3) * 16, t = t0 + tt; float hv[16]; float s = 0.f;
#pragma unroll
      for (int i = 0; i < 16; ++i) { hv[i] = HX[tt * 68 + v0 + i] + HX[(128 + tt) * 68 + v0 + i]; s += hv[i]; }
      s += __shfl_xor(s, 1); s += __shfl_xor(s, 2); const float mu = s * (1.f / 64.f); float vs = 0.f;
#pragma unroll
      for (int i = 0; i < 16; ++i) { hv[i] -= mu; vs += hv[i] * hv[i]; }
      vs += __shfl_xor(vs, 1); vs += __shfl_xor(vs, 2); const float rstd = 1.f / sqrtf(vs * (1.f / 64.f) + EPS);
#pragma unroll
      for (int i = 0; i < 16; ++i) { const int c = h * 64 + v0 + i;
          const float y = hv[i] * rstd * p.in[I_MNG][(size_t)l * 256 + c] + p.in[I_MSK][(size_t)l * 256 + c] * bf2f(q2.XCM16[(size_t)t * 256 + c]);
          Y(t, 768 + c, y * fast_silu(U(t, OFF_MZ + c))); } }
    __syncthreads();
}
typedef float f32x4_t __attribute__((ext_vector_type(4)));

__device__ __forceinline__ void row_norm_mod(f32x4 (&v)[4], const float* g, const float* sc, const float* sh, int lane) {
    float s = 0.f;
#pragma unroll
    for (int j = 0; j < 4; ++j) s += (v[j].x * v[j].x + v[j].y * v[j].y) + (v[j].z * v[j].z + v[j].w * v[j].w);
    const float rstd = 1.f / sqrtf(wave_sum(s) * (1.f / D) + EPS);
#pragma unroll
    for (int j = 0; j < 4; ++j) { const int k = (j * 64 + lane) * 4; const f32x4 gv = *(const f32x4*)(g + k);
        if (sc) { const f32x4 scv = *(const f32x4*)(sc + k), shv = *(const f32x4*)(sh + k); v[j] = v[j] * rstd * gv * (scv + 1.f) + shv; } else v[j] = v[j] * rstd * gv; }
}
__device__ __forceinline__ void row_store_bf16(bf16* dst, const f32x4 (&v)[4], int lane) {
#pragma unroll
    for (int j = 0; j < 4; ++j) { u32x2 w; w.x = pk2(v[j].x, v[j].y); w.y = pk2(v[j].z, v[j].w); *(u32x2*)(dst + (j * 64 + lane) * 4) = w; }
}
__device__ __forceinline__ void rp_first(const P& p, const Q& q, int gw, int ngw, int lane) {
    for (int t = gw; t < NT; t += ngw) { const int b = t / TPB, i = t % TPB; const float* src = i < CTX ? p.in[I_CTX] + ((size_t)b * CTX + i) * D : p.in[I_X] + ((size_t)b * SEQ + (i - CTX)) * D;
        f32x4 v[4];
#pragma unroll
        for (int j = 0; j < 4; ++j) v[j] = *(const f32x4*)(src + (j * 64 + lane) * 4);
        const int cv = tok_cv(t); row_norm_mod(v, p.in[I_N1G], modp(p, 0, cv, 1), modp(p, 0, cv, 0), lane); row_store_bf16(q.H16 + (size_t)t * D, v, lane); }
}
__device__ __forceinline__ void rp_end(const P& p, const Q& q, const Q2& q2, int l, int gw, int ngw, int lane, float probe_scale = 1.f) {
    const bool last = l + 1 == DEPTH; const int nrows = last ? NB * SEQ : NT;
    for (int r_ = gw; r_ < nrows; r_ += ngw) { const int t = last ? (r_ / SEQ) * TPB + CTX + r_ % SEQ : r_; const int cv = tok_cv(t); const float* g2 = modp(p, l, cv, 5); f32x4 v[4];
#pragma unroll
        for (int j = 0; j < 4; ++j) { const int k = (j * 64 + lane) * 4; f32x4 s = {0.f, 0.f, 0.f, 0.f};
#pragma unroll
            for (int e = 0; e < 4; ++e) { const u32x2 w = *(const u32x2*)(q2.YB16 + ((size_t)t * 4 + e) * D + k);
                s.x += __builtin_bit_cast(float, w.x << 16); s.y += __builtin_bit_cast(float, w.x & 0xffff0000u); s.z += __builtin_bit_cast(float, w.y << 16); s.w += __builtin_bit_cast(float, w.y & 0xffff0000u); }
            v[j] = *(const f32x4*)(p.X + (size_t)t * D + k) + *(const f32x4*)(g2 + k) * s * probe_scale; }
        if (l + 1 < DEPTH) {
#pragma unroll
            for (int j = 0; j < 4; ++j) *(f32x4*)(p.X + (size_t)t * D + (j * 64 + lane) * 4) = v[j];
            row_norm_mod(v, p.in[I_N1G] + (size_t)(l + 1) * D, modp(p, l + 1, cv, 1), modp(p, l + 1, cv, 0), lane); row_store_bf16(q.H16 + (size_t)t * D, v, lane);
        } else { const int b = t / TPB, i = t % TPB; if (i < CTX) continue;
            row_norm_mod(v, p.in[I_FG], nullptr, nullptr, lane);
#pragma unroll
            for (int j = 0; j < 4; ++j) *(f32x4*)(p.out + ((size_t)b * SEQ + (i - CTX)) * D + (j * 64 + lane) * 4) = v[j]; }
    }
}
constexpr int RPM_LDS = 89024;
__device__ __forceinline__ void rp_mid(const P& p, const Q& q, float* GLIST, int l, char* lds, int G, int bid, bool latent_only, bool probe_nolist = false) {
    int tid_ = TIDX; asm volatile("" : "+v"(tid_));
    const int tid = tid_, wave = tid >> 6, lane = tid & 63;
    float* HS = (float*)lds; float* PART = (float*)(lds + 65664); float* LG = (float*)(lds + 82048); int* LCNT = (int*)(lds + 84096); int* LBASE = (int*)(lds + 84224); int* PEND = (int*)(lds + 84352); int* NPEND = (int*)(lds + 88960);
    if (tid < 32) LCNT[tid] = 0; if (tid == 32) NPEND[0] = 0;
    float B0[32], B1[32]; const float* Wr = p.in[I_WR] + (size_t)l * D * NE;
#pragma unroll
    for (int ks = 0; ks < 32; ++ks) { const int k = 128 * wave + 4 * ks + (lane >> 4); B0[ks] = Wr[(size_t)k * NE + (lane & 15)]; B1[ks] = Wr[(size_t)k * NE + 16 + (lane & 15)]; }
    __syncthreads();
    const int nitems = latent_only ? NB * SEQ / 16 : NT / 16;
    for (int it_ = bid; it_ < nitems; it_ += G) { const int it = latent_only ? (it_ / (SEQ / 16)) * (TPB / 16) + CTX / 16 + it_ % (SEQ / 16) : it_;
#pragma unroll 1
        for (int rr = 0; rr < 2; ++rr) { const int row = 2 * wave + rr, t = it * 16 + row, cv = tok_cv(t); f32x4 v[4];
#pragma unroll
            for (int j = 0; j < 4; ++j) v[j] = *(const f32x4*)(p.X + (size_t)t * D + (j * 64 + lane) * 4);
            row_norm_mod(v, p.in[I_N2G] + (size_t)l * D, modp(p, l, cv, 4), modp(p, l, cv, 3), lane); row_store_bf16(q.H16 + (size_t)t * D, v, lane);
#pragma unroll
            for (int j = 0; j < 4; ++j) { float* d = HS + row * 1026 + (j * 64 + lane) * 4; *(float2*)d = make_float2(v[j].x, v[j].y); *(float2*)(d + 2) = make_float2(v[j].z, v[j].w); } }
        __syncthreads();
        { f32x4_t a0 = {0.f, 0.f, 0.f, 0.f}, a1 = a0; const float* hrow = HS + (lane & 15) * 1026 + 128 * wave + (lane >> 4);
#pragma unroll
          for (int ks = 0; ks < 32; ++ks) { const float a = hrow[4 * ks]; a0 = __builtin_amdgcn_mfma_f32_16x16x4f32(a, B0[ks], a0, 0, 0, 0); a1 = __builtin_amdgcn_mfma_f32_16x16x4f32(a, B1[ks], a1, 0, 0, 0); }
#pragma unroll
          for (int r = 0; r < 4; ++r) { const int row = (lane >> 4) * 4 + r; PART[(wave * 16 + row) * 32 + (lane & 15)] = a0[r]; PART[(wave * 16 + row) * 32 + 16 + (lane & 15)] = a1[r]; } }
        __syncthreads();
        { float s = p.in[I_BR][(size_t)l * NE + (tid & 31)];
#pragma unroll
          for (int w = 0; w < 8; ++w) s += PART[w * 512 + tid];
          LG[tid] = s; }
        __syncthreads();
        if (tid < 16) { const int t = it * 16 + tid; float lg[NE];
#pragma unroll
            for (int e = 0; e < NE; ++e) lg[e] = LG[tid * 32 + e];
            int te[TOPK]; float tv[TOPK];
#pragma unroll
            for (int r = 0; r < TOPK; ++r) { float best = -3.0e38f; int bi = 0;
#pragma unroll
                for (int e = 0; e < NE; ++e) { const bool c = lg[e] > best; best = c ? lg[e] : best; bi = c ? e : bi; }
                te[r] = bi; tv[r] = best;
#pragma unroll
                for (int e = 0; e < NE; ++e) lg[e] = (e == bi) ? -3.0e38f : lg[e]; }
            float ssum = 0.f, ex[TOPK];
#pragma unroll
            for (int r = 0; r < TOPK; ++r) { ex[r] = __expf(tv[r] - tv[0]); ssum += ex[r]; }
            const float inv = 1.f / ssum;
#pragma unroll
            for (int r = 0; r < TOPK; ++r) { p.TOPG[t * TOPK + r] = ex[r] * inv; const int lp = atomicAdd(&LCNT[te[r]], 1); const int slot = atomicAdd(NPEND, 1);
                PEND[slot * 3] = t * TOPK + r; PEND[slot * 3 + 1] = (te[r] << 16) | lp; PEND[slot * 3 + 2] = __float_as_int(ex[r] * inv); } }
        __syncthreads();
    }
    if (probe_nolist) return;
    if (tid < 32) LBASE[tid] = LCNT[tid] > 0 ? atomicAdd(&p.CNT[tid], LCNT[tid]) : 0;
    __syncthreads();
    for (int i = tid; i < NPEND[0]; i += 512) { const int pr = PEND[i * 3], x = PEND[i * 3 + 1], e = x >> 16, lp = x & 0xffff; p.LIST[(size_t)e * NT + LBASE[e] + lp] = pr; GLIST[(size_t)e * NT + LBASE[e] + lp] = __int_as_float(PEND[i * 3 + 2]); }
    __syncthreads();
}
struct EpiDown16 {
    static constexpr bool PERM = true; bf16* YB; const float* bd; const float* GL; const int* CNT; const int* LIST; int nN; int probe_skip;
    __device__ __forceinline__ void operator()(const pg8::f32x4 (&acc)[2][2][4][2], const pg8::Unit& u, int wr, int wc, int fr, int fq) const {
        if (probe_skip) return;
        const int ntile = u.pn - u.e * nN, cnt = CNT[u.e]; const float* b = bd + (size_t)u.e * D;
        int pr[2][4]; float gt[2][4];
#pragma unroll
        for (int ai = 0; ai < 2; ++ai)
#pragma unroll
            for (int m = 0; m < 4; ++m) { const int idx = u.mb * 256 + ai * 128 + wr * 64 + m * 16 + fr, ic = idx < cnt ? idx : 0; pr[ai][m] = LIST[(size_t)u.e * NT + ic]; gt[ai][m] = GL[(size_t)u.e * NT + ic]; }
        pg8::f32x4 bv[2][2];
#pragma unroll
        for (int bj = 0; bj < 2; ++bj) { const int c = ntile * 256 + bj * 128 + wc * 32 + 8 * fq; bv[bj][0] = *(const pg8::f32x4*)(b + c); bv[bj][1] = *(const pg8::f32x4*)(b + c + 4); }
#pragma unroll
        for (int ai = 0; ai < 2; ++ai)
#pragma unroll
            for (int m = 0; m < 4; ++m) { const int idx = u.mb * 256 + ai * 128 + wr * 64 + m * 16 + fr;
                if (idx < cnt) { const float g = gt[ai][m];
#pragma unroll
                    for (int bj = 0; bj < 2; ++bj) { const int c = ntile * 256 + bj * 128 + wc * 32 + 8 * fq;
                        const pg8::f32x4 v0 = (acc[ai][bj][m][0] + bv[bj][0]) * g, v1 = (acc[ai][bj][m][1] + bv[bj][1]) * g;
                        u32x4 w; w.x = pg8::cvt_pk_bf16(v0[0], v0[1]); w.y = pg8::cvt_pk_bf16(v0[2], v0[3]); w.z = pg8::cvt_pk_bf16(v1[0], v1[1]); w.w = pg8::cvt_pk_bf16(v1[2], v1[3]);
                        *(u32x4*)(YB + (size_t)pr[ai][m] * D + c) = w; } } }
    }
};
__device__ __forceinline__ void opt_moe_down16(const P& p, const Q& q, const Q2& q2, int l, LAS unsigned char* lds, int G, int bid, int probe_skip = 0) {
    pg8::Gemm g{q.ACT16, q.WtDn + (size_t)l * NE * D * DE, DE}; DnOrder S; S.init(p.CNT, p.LIST, D / 256, G, bid, (LAS int*)(lds + pg8::STAGE_BYTES));
    EpiDown16 E{q2.YB16, p.in[I_BD] + (size_t)l * NE * D, q2.GLIST, p.CNT, p.LIST, D / 256, probe_skip}; pg8::gemm_phase<EpiDown16, DnOrder, true>(lds, g, S, E);
}
#define GAS __attribute__((address_space(1)))
typedef GAS unsigned gu32;
#define XB_TMO      128
#define XB_XCNT(j)  (256  + 64 * (j))
#define XB_XSUB(j)  (1280 + 64 * (j))
#define XB_XGEN(j)  (2304 + 64 * (j))
#define XB_TOP      3328
#define XB_TOPGEN   3392
#define XCD_BAR_WORDS 3456
#define XB_SPIN_CAP (1u << 18)

__device__ __forceinline__ unsigned xb_ld(unsigned* p)              { return __hip_atomic_load(p, __ATOMIC_RELAXED, __HIP_MEMORY_SCOPE_AGENT); }
__device__ __forceinline__ unsigned xb_add(unsigned* p, unsigned v) { return __hip_atomic_fetch_add(p, v, __ATOMIC_RELAXED, __HIP_MEMORY_SCOPE_AGENT); }
__device__ __forceinline__ unsigned xb_xcc_id() { return (unsigned)__builtin_amdgcn_s_getreg((3 << 11) | 20) & 0xFu; }
#define XB_SPIN(cond, bar) do { unsigned _sp = 0; while (cond) { __builtin_amdgcn_s_sleep(1); \
    if ((++_sp & 255u) == 0u) { if (xb_ld(&(bar)[XB_TMO])) break; if (_sp > XB_SPIN_CAP) { atomicAdd(&(bar)[XB_TMO], 1u); break; } } } } while (0)

struct XcdBarrier {
    unsigned* bar; unsigned x;
    volatile LAS unsigned* st;
};

__device__ __forceinline__ XcdBarrier xcd_barrier_post(unsigned* bar, volatile LAS unsigned* st) {
    XcdBarrier b; b.bar = bar; b.x = xb_xcc_id(); b.st = st;
    if (TIDX == 0) (void)xb_add(&bar[XB_XCNT(b.x)], 1u);
    return b;
}
__device__ __forceinline__ void xcd_barrier_complete(unsigned* bar, unsigned x, unsigned& nloc, unsigned& nx) {
    const unsigned G = gridDim.x * gridDim.y * gridDim.z;
    unsigned sum, cnt, mine, sp = 0u;
    for (;;) {
        sum = 0u; cnt = 0u; mine = 0u;
#pragma unroll
        for (unsigned j = 0; j < 16; ++j) { const unsigned c = xb_ld(&bar[XB_XCNT(j)]); sum += c; cnt += (c > 0u) ? 1u : 0u; mine = (j == x) ? c : mine; }
        if (sum == G) break;
        __builtin_amdgcn_s_sleep(1);
        if ((++sp & 255u) == 0u) { if (xb_ld(&bar[XB_TMO])) break; if (sp > XB_SPIN_CAP) { atomicAdd(&bar[XB_TMO], 1u); break; } }
    }
    nloc = mine > 0u ? mine : 1u; nx = cnt > 0u ? cnt : 1u;
}

__device__ __forceinline__ void xcd_barrier(const XcdBarrier& b) {
    asm volatile("s_waitcnt vmcnt(0)" ::: "memory");
    __syncthreads();
    if (TIDX == 0) {
        unsigned* bar = b.bar;
        __builtin_amdgcn_s_waitcnt(0);
        unsigned nloc = b.st[0], nx = b.st[1];
        if (nloc == 0u) { xcd_barrier_complete(bar, b.x, nloc, nx); b.st[0] = nloc; b.st[1] = nx; }
        const unsigned old = xb_add(&bar[XB_XSUB(b.x)], 1u);
        const unsigned gen = old / nloc;
        if (old + 1u == (gen + 1u) * nloc) {
            __builtin_amdgcn_fence(__ATOMIC_RELEASE, "agent");
            asm volatile("s_waitcnt vmcnt(0)" ::: "memory");
            const unsigned og = xb_add(&bar[XB_TOP], 1u);
            const unsigned tg = og / nx;
            if (og + 1u == (tg + 1u) * nx) xb_add(&bar[XB_TOPGEN], 1u);
            else XB_SPIN(xb_ld(&bar[XB_TOPGEN]) == tg, bar);
            __builtin_amdgcn_fence(__ATOMIC_ACQUIRE, "agent");
            xb_add(&bar[XB_XGEN(b.x)], 1u);
            asm volatile("s_waitcnt vmcnt(0)" ::: "memory");
        } else {
            XB_SPIN(xb_ld(&bar[XB_XGEN(b.x)]) == gen, bar);
            __builtin_amdgcn_fence(__ATOMIC_ACQUIRE, "agent");
            asm volatile("s_waitcnt vmcnt(0)" ::: "memory");
        }
    }
    __syncthreads();
}
#include <hip/hip_cooperative_groups.h>
#include <cstdio>
namespace cg = cooperative_groups;
#ifndef ONE_LAUNCH
#define ONE_LAUNCH 1
#endif
constexpr int LDS_BYTES = 148480;
static_assert(ML2_LDS <= LDS_BYTES && ML1_LDS <= LDS_BYTES && LRU1_LDS <= LDS_BYTES && RPM_LDS <= LDS_BYTES && att::SHM_ATTN <= LDS_BYTES && pg8::STAGE_BYTES + 1024 + 8192 + 15 * 512 <= LDS_BYTES - 64 - 256, "LDS map");

struct BMap { size_t off[64]; size_t total; };
static inline BMap b_map() {
    BMap m; size_t o = 0; int i = 0;
    auto add = [&](size_t bytes) { m.off[i++] = o; o += (bytes + 255) & ~(size_t)255; };
    add((size_t)DEPTH * 3 * 6 * D * 4);
    add((size_t)SEQ * 16 * 2 * 4);
    add((size_t)NT * D * 4);
    add((size_t)NT * TOPK * 4);
    add((size_t)256);
    add((size_t)NE * NT * 4);
    add((size_t)DEPTH * DINP * D * 2);
    add((size_t)DEPTH * D * DMIX * 2);
    add((size_t)DEPTH * NE * 2 * DE * D * 2);
    add((size_t)DEPTH * NE * D * DE * 2);
    add((size_t)DEPTH * 768 * QRANK * 2);
    add((size_t)DEPTH * 1024 * KVRANK * 2);
    add((size_t)NT * D * 2);
    add((size_t)NT * DMIX * 2);
    add((size_t)SLOT_MAX * DE * 2);
    add((size_t)NT * AH * QKD * 2);
    add((size_t)NT * AH * VD * 2);
    add((size_t)NT * DINP * 2);
    add((size_t)DEPTH * 4 * 256 * 64 * 2);
    add((size_t)DEPTH * 4 * 3 * 4096 * 2);
    add((size_t)DEPTH * 32 * 768 * 2);
    add((size_t)DEPTH * 2 * 256 * 4);
    add((size_t)2 * NT * 256 * 4);
    add((size_t)2 * NT * 256 * 4);
    add((size_t)2 * NB * NCH * 256 * 4);
    add((size_t)2 * NB * NCH * 256 * 4);
    add((size_t)2 * NT * 256 * 2);
    add((size_t)256);
    add((size_t)NT * 768 * 2);
    add((size_t)DEPTH * 1792 * 256 * 2);
    add((size_t)NT * 256 * 2);
    add((size_t)NT * 768 * 2);
    add((size_t)NT * 16 * 4);
    add((size_t)2 * NB * NCH * 4 * 4096 * 4);
    add((size_t)2 * NB * NCH * 4 * 64 * 4);
    add((size_t)2 * NB * NCH * 4 * 2 * 4);
    add((size_t)NT * TOPK * D * 2);
    add((size_t)XCD_BAR_WORDS * 4);
    add((size_t)2 * NB * NCH * 4 * 4096 * 2);
    add((size_t)2 * NB * NCH * 4 * 64 * 4);
    add((size_t)2 * NB * NCH * 4 * 4);
    add((size_t)NE * NT * 4);
    m.total = o; return m;
}
struct Args { P p; Q q; Q2 q2; unsigned* bar; };
static inline void fill_args(Args& a, void* const* d_in, void* d_out, void* d_ws) {
    for (int i = 0; i < N_IN; ++i) a.p.in[i] = (const float*)d_in[i];
    a.p.out = (float*)d_out; char* w = (char*)d_ws; const BMap m = b_map();
    a.p.MOD = (float*)(w + m.off[0]); a.p.ROPET = (float*)(w + m.off[1]); a.p.X = (float*)(w + m.off[2]); a.p.TOPG = (float*)(w + m.off[3]); a.p.CNT = (int*)(w + m.off[4]); a.p.LIST = (int*)(w + m.off[5]);
    a.q.WtIn = (bf16*)(w + m.off[6]); a.q.WtOut = (bf16*)(w + m.off[7]); a.q.WtGu = (bf16*)(w + m.off[8]); a.q.WtDn = (bf16*)(w + m.off[9]); a.q.WtQb = (bf16*)(w + m.off[10]); a.q.WtKvb = (bf16*)(w + m.off[11]);
    a.q.H16 = (bf16*)(w + m.off[12]); a.q.Y16 = (bf16*)(w + m.off[13]); a.q.ACT16 = (bf16*)(w + m.off[14]); a.q.K16 = (bf16*)(w + m.off[15]); a.q.V16 = (bf16*)(w + m.off[16]);
    a.q2.U16 = (bf16*)(w + m.off[17]); a.q2.WtL = (bf16*)(w + m.off[18]); a.q2.WtM = (bf16*)(w + m.off[19]); a.q2.WtG = (bf16*)(w + m.off[20]); a.q2.LSL = (float*)(w + m.off[21]);
    a.q2.HLOC = (bf16*)(w + m.off[22]); a.q2.PCUM = (bf16*)(w + m.off[23]); a.q2.SA = (float*)(w + m.off[24]); a.q2.SB = (float*)(w + m.off[25]);
    a.q2.QN16 = (bf16*)(w + m.off[26]); a.q2.KVN16 = a.q2.QN16 + (size_t)NT * 256;     a.q2.Q16 = (bf16*)(w + m.off[28]); a.q2.WtKvbP = (bf16*)(w + m.off[29]);
    a.q2.XCM16 = (bf16*)(w + m.off[30]); a.q2.QKV16 = (bf16*)(w + m.off[31]); a.q2.GATES = (float*)(w + m.off[32]); a.q2.CLOC = (float*)(w + m.off[33]); a.q2.NLOC = (float*)(w + m.off[34]); a.q2.MLB = (float*)(w + m.off[35]);
    a.q2.YB16 = (bf16*)(w + m.off[36]); a.bar = (unsigned*)(w + m.off[37]); a.q2.CST = (bf16*)(w + m.off[38]); a.q2.NST = (float*)(w + m.off[39]); a.q2.MST = (float*)(w + m.off[40]); a.q2.GLIST = (float*)(w + m.off[41]);
}

struct ULoad16 { const bf16* U; __device__ __forceinline__ float operator()(int t, int col) const { return bf2f(U[(size_t)t * DINP + col]); } };
struct YStore16 { bf16* Y; __device__ __forceinline__ void operator()(int t, int col, float v) const { Y[(size_t)t * DMIX + col] = (bf16)f2bf(v); } };
struct OutY16 { bf16* y; __device__ __forceinline__ void operator()(int row, int col, float v) const { y[(size_t)row * DMIX + col] = (bf16)f2bf(v); } };

enum { ST_INIT = 0, ST_RPFIRST, ST_INPROJ, ST_PREP, ST_MLAPROJ, ST_MIX, ST_OUTPROJ, ST_RPMID, ST_GU, ST_DOWN, ST_RPEND, N_ST };

typedef const __attribute__((address_space(4))) Args* KArgs;
__device__ __forceinline__ KArgs kargs() { KArgs k = (KArgs)__builtin_amdgcn_kernarg_segment_ptr(); asm volatile("" : "+s"(k)); return k; }
__device__ __forceinline__ void run_step(const Args& a, int step, int l_, unsigned char* lds_raw) {
    const int l = l_ & 0xff, sub = l_ >> 8;
    const P& p = a.p; const Q& q = a.q; const Q2& q2 = a.q2;
    LAS unsigned char* lds = (LAS unsigned char*)lds_raw; char* ldsg = (char*)lds_raw;
    int G_ = gridDim.x, bid_ = blockIdx.x; asm volatile("" : "+s"(G_), "+s"(bid_));
    const int G = G_, bid = bid_;
#define THREAD_IDS int tid_ = TIDX; asm volatile("" : "+v"(tid_)); const int tid = tid_, lane = tid & 63, wave = __builtin_amdgcn_readfirstlane(tid >> 6); \
    const int gw = bid * NWAVES + wave, ngw = G * NWAVES; const long gtid = (long)bid * NTHREADS + tid, nthr = (long)G * NTHREADS; (void)lane; (void)gw; (void)ngw; (void)gtid; (void)nthr;
    switch (step) {
    case ST_INIT: { THREAD_IDS
        if (sub == 0 || (sub & 1)) opt_init_mod(p, ldsg, bid, G);
        if (sub == 0 || (sub & 2)) { opt_init_rope(p, gtid, nthr); opt_convert_small(p, q2, gtid, nthr); }
        if (sub == 0 || (sub & 4)) opt_convert_weights(p, q, q2.WtKvbP, lds, gw, ngw, wave, lane);
        break; }
    case ST_RPFIRST: { THREAD_IDS rp_first(p, q, gw, ngw, lane); break; }
    case ST_INPROJ: opt_inproj16(q, q2, l, lds, G, bid); break;
    case ST_PREP: { THREAD_IDS
        if (gtid < NE) p.CNT[gtid] = 0;
        const ULoad16 U{q2.U16};
        constexpr int NM = NB * NCH, NL = NB * NCH * 4;
        if (G > NM + 8) {
            if (bid < NM) { if (sub == 0 || (sub & 1)) ml1_item(p, q2, l, bid / NCH, bid % NCH, ldsg, U);
                if (sub == 0 || (sub & 2)) lru1_item(p, q2, l, (bid >> 2) / NCH, (bid >> 2) % NCH, bid & 3, ldsg, U); }
            else if (sub == 0 || (sub & 2)) for (int x = NM + (bid - NM); x < NL; x += G - NM) lru1_item(p, q2, l, (x >> 2) / NCH, (x >> 2) % NCH, x & 3, ldsg, U);
        } else for (int it = bid; it < NM + NL; it += G) {
            if (it < NM) { if (sub == 0 || (sub & 1)) ml1_item(p, q2, l, it / NCH, it % NCH, ldsg, U); }
            else if (sub == 0 || (sub & 2)) { const int x = it - NM; lru1_item(p, q2, l, (x >> 2) / NCH, (x >> 2) % NCH, x & 3, ldsg, U); } }
        if (sub == 0 || (sub & 4)) for (int t = gw; t < NT; t += ngw) mla_prep_token(p, q, q2, l, t, lane, U);
        break; }
    case ST_MLAPROJ: { for (int it = G - 1 - bid; it < 64; it += G) ml_scan_item(q2, it, ldsg);
        opt_mla_proj(p, q, q2, l, lds, G, bid); break; }
    case ST_MIX: {
        const ULoad16 U{q2.U16}; const YStore16 Y{q.Y16};
        const int c = bid, vcu = (G % 8 == 0) ? (c % 8) * (G / 8) + c / 8 : c;
        constexpr int QB_LAT = SEQ / 256, QB_CTX = CTX / 256, NU_LAT = NB * AH * QB_LAT, NU_CTX = NB * AH * QB_CTX;
#ifdef ATTN_PROBE_VAR
        if (sub & 1) { struct NoOut { __device__ __forceinline__ void operator()(int, int, float) const {} } noout;
            for (int u = vcu; u < NU_LAT; u += G) { const int bh = u / QB_LAT, qb = u % QB_LAT, b = bh / AH, h = bh % AH, t0 = b * TPB + CTX + qb * 256;
                att::attn_unit<unsigned short, NoOut, ATTN_PROBE_VAR>((const unsigned short*)q2.Q16 + (size_t)t0 * 768 + h * QKD, 768, (const unsigned short*)q.K16 + ((size_t)b * AH + h) * TPB * QKD, (const unsigned short*)q.V16 + ((size_t)b * AH + h) * TPB * VD, TPB, ldsg, noout); } }
        else
#endif
        BgConv bg; { const int wv = __builtin_amdgcn_readfirstlane(TIDX >> 6); bg.init(p, q, l, lds + att::SHM_ATTN, bid * NWAVES + wv, G * NWAVES, wv); }
        if (sub == 0 || (sub & 1)) for (int u = vcu; u < NU_LAT; u += G) { const int bh = u / QB_LAT, qb = u % QB_LAT, b = bh / AH, h = bh % AH, t0 = b * TPB + CTX + qb * 256;
            OutY16 out{q.Y16 + (size_t)t0 * DMIX + 256 + h * VD};
            att::attn_unit<unsigned short, OutY16, 0, BgConv&>((const unsigned short*)q2.Q16 + (size_t)t0 * 768 + h * QKD, 768, (const unsigned short*)q.K16 + ((size_t)b * AH + h) * TPB * QKD, (const unsigned short*)q.V16 + ((size_t)b * AH + h) * TPB * VD, TPB, ldsg, out, bg); }
        if ((sub == 0 || (sub & 1)) && l + 1 < DEPTH) for (int u = vcu; u < NU_CTX; u += G) { const int bh = u / QB_CTX, qb = u % QB_CTX, b = bh / AH, h = bh % AH, t0 = b * TPB + qb * 256;
            OutY16 out{q.Y16 + (size_t)t0 * DMIX + 256 + h * VD};
            att::attn_unit<unsigned short, OutY16>((const unsigned short*)q2.Q16 + (size_t)t0 * 768 + h * QKD, 768, (const unsigned short*)q.K16 + ((size_t)b * AH + h) * TPB * QKD, (const unsigned short*)q.V16 + ((size_t)b * AH + h) * TPB * VD, CTX, ldsg, out); }
        bg.drain(); __syncthreads();
        const int ch0 = (l + 1 < DEPTH) ? 0 : NCH_CTX, nch = NCH - ch0;
        if (sub == 0 || (sub & 2)) for (int it = G - 1 - c; it < NB * nch * 4; it += G) { const int x = it >> 2; ml2_item(p, q2, l, x / nch, ch0 + x % nch, it & 3, ldsg, U, Y); }
        if (sub == 0 || (sub & 4)) for (int it = c; it < NB * nch; it += G) lru2_item(q2, q.Y16, it / nch, ch0 + it % nch, ldsg);
        break; }
    case ST_OUTPROJ: opt_outproj(p, q, l, lds, G, bid, l + 1 == DEPTH); break;
    case ST_RPMID: rp_mid(p, q, q2.GLIST, l, ldsg, G, bid, l + 1 == DEPTH, sub != 0); break;
    case ST_GU: opt_moe_gu(p, q, l, lds, G, bid, sub); break;
    case ST_DOWN: opt_moe_down16(p, q, q2, l, lds, G, bid, sub); break;
    case ST_RPEND: { THREAD_IDS rp_end(p, q, q2, l, gw, ngw, lane, sub != 0 ? 0.f : 1.f); break; }
    }
}

#if ONE_LAUNCH
__global__ void __launch_bounds__(512, 2) k_mega(Args a) {
    extern __shared__ __attribute__((aligned(16))) unsigned char lds_raw[];
    volatile LAS unsigned* MISC = (volatile LAS unsigned*)((LAS unsigned char*)lds_raw + LDS_BYTES - 64);
    if (threadIdx.x < 16) MISC[threadIdx.x] = 0u;
    if ((threadIdx.x & 63) == 0) ((LAS int*)((LAS unsigned char*)lds_raw + WTAB_OFF))[HWID()] = threadIdx.x >> 6;
    __syncthreads();
    { const XcdBarrier b0 = xcd_barrier_post(a.bar, MISC + 8); if (TIDX == 0) MISC[10] = b0.x; }
#define GRID_BAR() do { XcdBarrier b_; b_.bar = a.bar; b_.st = MISC + 8; b_.x = MISC[10]; xcd_barrier(b_); } while (0)
    run_step(a, ST_INIT, 0, lds_raw); GRID_BAR();
    run_step(a, ST_RPFIRST, 0, lds_raw); GRID_BAR();
#pragma unroll 1
    for (int l = 0; l < DEPTH; ++l) {
#pragma unroll 1
        for (int s = ST_INPROJ; s <= ST_RPEND; ++s) { run_step(a, s, l, lds_raw); if (!(l == DEPTH - 1 && s == ST_RPEND)) GRID_BAR();
#ifdef MEGA_DUP_STEP
            if (s == MEGA_DUP_STEP) { run_step(a, s, l, lds_raw); GRID_BAR(); }
#endif
        }
    }
}
#else
template <int STEP>
__global__ void __launch_bounds__(512, 2) k_step(Args a, int l) {
    extern __shared__ __attribute__((aligned(16))) unsigned char lds_raw[];
    run_step(a, STEP, l, lds_raw);
}
template <int STEP> static void launch_step(const Args& a, int l, hipStream_t stream) {
    static bool attr = false;
    if (!attr) { (void)hipFuncSetAttribute((const void*)k_step<STEP>, hipFuncAttributeMaxDynamicSharedMemorySize, LDS_BYTES); attr = true; }
    hipLaunchKernelGGL(k_step<STEP>, dim3(256), dim3(512), LDS_BYTES, stream, a, l);
}
#endif

extern "C" void kernel_launch(void* const* d_in, const int* in_sizes, int n_in, void* d_out, int out_size, void* d_ws, size_t ws_size, hipStream_t stream) {
    static int grid_blocks = 0;
    if (!grid_blocks) {
        int dev = 0, cus = 0;
        (void)hipGetDevice(&dev); (void)hipDeviceGetAttribute(&cus, hipDeviceAttributeMultiprocessorCount, dev);
        grid_blocks = cus;
#if ONE_LAUNCH
        int per_cu = 0;
        (void)hipFuncSetAttribute((const void*)k_mega, hipFuncAttributeMaxDynamicSharedMemorySize, LDS_BYTES);
        (void)hipOccupancyMaxActiveBlocksPerMultiprocessor(&per_cu, (const void*)k_mega, 512, LDS_BYTES);
        if (per_cu < 1) fprintf(stderr, "kernel_launch: occupancy query reports %d workgroups per CU\n", per_cu);
#endif
        const BMap m = b_map();
        if (n_in != N_IN || m.total > ws_size) fprintf(stderr, "kernel_launch: bad n_in %d or workspace too small (%zu needed, %zu given)\n", n_in, m.total, ws_size);
    }
    Args a{}; fill_args(a, d_in, d_out, d_ws);
#if ONE_LAUNCH
    (void)hipMemsetAsync(a.bar, 0, XCD_BAR_WORDS * 4, stream);
    void* args[] = {&a};
    hipError_t e = hipLaunchCooperativeKernel((const void*)k_mega, dim3(grid_blocks), dim3(512), args, LDS_BYTES, stream);
    if (e != hipSuccess) fprintf(stderr, "cooperative launch failed: %s (grid %d)\n", hipGetErrorString(e), grid_blocks);
#else
#ifndef DUP_STEP
#define DUP_STEP -1
#endif
#ifndef DUP_SUB
#define DUP_SUB 0
#endif
#define LS(ST, l) do { launch_step<ST>(a, l, stream); if (ST == DUP_STEP) launch_step<ST>(a, (l) | (DUP_SUB << 8), stream); } while (0)
    LS(ST_INIT, 0); LS(ST_RPFIRST, 0);
    for (int l = 0; l < DEPTH; ++l) {
        LS(ST_INPROJ, l); LS(ST_PREP, l); LS(ST_MLAPROJ, l); LS(ST_MIX, l); LS(ST_OUTPROJ, l);
        LS(ST_RPMID, l); LS(ST_GU, l); LS(ST_DOWN, l); LS(ST_RPEND, l);
    }
#endif
}
```

```cpp
#include <hip/hip_runtime.h>
#define ONE_LAUNCH 1
#include <math.h>
#include <stdint.h>

#ifndef CFG_D_MODEL
#define CFG_D_MODEL 1024
#endif
#ifndef CFG_SEQ
#define CFG_SEQ 8192
#endif
#ifndef CFG_GRID_W
#define CFG_GRID_W 64
#endif
#ifndef CFG_CTX_LEN
#define CFG_CTX_LEN 256
#endif
#ifndef CFG_N_EXPERTS
#define CFG_N_EXPERTS 32
#endif
#ifndef CFG_D_EXPERT
#define CFG_D_EXPERT 1024
#endif

#ifdef HOST_TEST
#define HD inline
struct float4 { float x, y, z, w; };
static inline int atomic_add_i(int* p, int v) { int o = *p; *p = o + v; return o; }
#else
#define HD __device__ __forceinline__
static __device__ __forceinline__ int atomic_add_i(int* p, int v) { return atomicAdd(p, v); }
#endif

constexpr int D = CFG_D_MODEL, NB = 2, SEQ = CFG_SEQ, DEPTH = 2, GRID_W = CFG_GRID_W, CTX = CFG_CTX_LEN;
constexpr int TPB = CTX + SEQ;
constexpr int NT = NB * TPB;
constexpr int LW = 256, MLH = 4, MHD = 64, MW = 256;
constexpr int AH = 8, NOPE = 64, ROPE = 32, VD = 64, QRANK = 256, KVRANK = 128, QKD = NOPE + ROPE;
constexpr int DIN = 1440, DMIX = 1024;
constexpr int OFF_AX = 0, OFF_AG = 256, OFF_BQ = 512, OFF_BKV = 768, OFF_BKR = 896, OFF_MX = 928, OFF_MZ = 1184;
constexpr int NE = CFG_N_EXPERTS, TOPK = 4, DE = CFG_D_EXPERT;
constexpr float EPS = 1e-6f;

enum { I_X = 0, I_C, I_CTX, I_CCTX, I_N1G, I_N2G, I_WMOD, I_BMOD, I_WIN, I_WOUT, I_LCW, I_LCB, I_LWA, I_LBA, I_LWX, I_LBX, I_LLAM,
       I_QNG, I_WQB, I_KVNG, I_WKVB, I_MCW, I_MCB, I_MWQ, I_MWK, I_MWV, I_MWG, I_MBG, I_MNG, I_MSK, I_WR, I_BR, I_WGU, I_BGU, I_WD, I_BD, I_FG, N_IN };

struct P {
    const float* in[N_IN];
    float* out;
    float *MOD, *ROPET, *X, *H, *U, *XC, *LA, *LB, *HL, *QN, *KVN, *QF, *KVF, *Qr, *Kr, *Vr, *XCM, *QM, *KM, *VM, *IGF, *HM, *Y, *TOPG, *ACT, *YB;
    int *TOPE, *CNT, *LIST;
};

HD float sigmoid_f(float x) { return 1.f / (1.f + expf(-x)); }
HD float silu_f(float x) { return x * sigmoid_f(x); }
HD float logsigmoid_f(float x) { return fminf(x, 0.f) - log1pf(expf(-fabsf(x))); }
HD float gelu_f(float x) { return 0.5f * x * (1.f + tanhf(0.7978845608028654f * (x + 0.044715f * x * x * x))); }

HD int tok_b(int t) { return t / TPB; }
HD int tok_i(int t) { return t % TPB; }
HD bool tok_isctx(int t) { return tok_i(t) < CTX; }
HD int tok_cv(int t) { return tok_isctx(t) ? 2 : tok_b(t); }
HD const float* modp(const P& p, int l, int cv, int which) { return p.MOD + (((size_t)l * 3 + cv) * 6 + which) * D; }

template <int R>
HD void gemm_rx4(const float* (&a)[R], const float* B, int ldb, int K, float4 (&acc)[R]) {
    for (int k = 0; k < K; ++k) {
        const float4 bv = *(const float4*)(B + (size_t)k * ldb);
#pragma unroll
        for (int r = 0; r < R; ++r) { const float av = a[r][k]; acc[r].x += av * bv.x; acc[r].y += av * bv.y; acc[r].z += av * bv.z; acc[r].w += av * bv.w; }
    }
}

HD void nv_init(const P& p, long gtid, long nthr) {
    for (long it = gtid; it < (long)DEPTH * 6 * D; it += nthr) {
        const int l = (int)(it / (6 * D)), j = (int)(it % (6 * D));
        const float* w = p.in[I_WMOD] + (size_t)l * D * 6 * D + j;
        float a0 = 0.f, a1 = 0.f, a2 = 0.f;
        for (int k = 0; k < D; ++k) { const float wv = w[(size_t)k * 6 * D];
            a0 += silu_f(p.in[I_C][k]) * wv; a1 += silu_f(p.in[I_C][D + k]) * wv; a2 += silu_f(p.in[I_CCTX][k]) * wv; }
        const float bb = p.in[I_BMOD][(size_t)l * 6 * D + j];
        p.MOD[((size_t)l * 3 + 0) * 6 * D + j] = a0 + bb; p.MOD[((size_t)l * 3 + 1) * 6 * D + j] = a1 + bb; p.MOD[((size_t)l * 3 + 2) * 6 * D + j] = a2 + bb;
    }
    for (long it = gtid; it < (long)NT * D; it += nthr) {
        const int t = (int)(it / D), k = (int)(it % D), b = tok_b(t), i = tok_i(t);
        p.X[it] = (i < CTX) ? p.in[I_CTX][((size_t)b * CTX + i) * D + k] : p.in[I_X][((size_t)b * SEQ + (i - CTX)) * D + k];
    }
    for (long it = gtid; it < (long)SEQ * 16; it += nthr) {
        const int s = (int)(it / 16), a = (int)((it / 8) & 1), f = (int)(it & 7);
        const int pos = a == 0 ? s / GRID_W : s % GRID_W;
        const double fr = pow(10000.0, -(double)f / 8.0);
        const float frf = (float)fr;
        const double ang = (double)((float)pos * frf);
        p.ROPET[it * 2] = (float)cos(ang); p.ROPET[it * 2 + 1] = (float)sin(ang);
    }
}

HD void nv_norm(const P& p, int l, int which  , long gtid, long nthr) {
    const float* g = p.in[which == 0 ? I_N1G : I_N2G] + (size_t)l * D;
    for (long t = gtid; t < NT; t += nthr) {
        const float* x = p.X + (size_t)t * D; float ss = 0.f;
        for (int k = 0; k < D; ++k) ss += x[k] * x[k];
        const float rstd = 1.f / sqrtf(ss / (float)D + EPS);
        const int cv = tok_cv((int)t); const float* sh = modp(p, l, cv, which == 0 ? 0 : 3); const float* sc = modp(p, l, cv, which == 0 ? 1 : 4);
        float* h = p.H + (size_t)t * D;
        for (int k = 0; k < D; ++k) h[k] = x[k] * rstd * g[k] * (1.f + sc[k]) + sh[k];
    }
}

HD void nv_inproj(const P& p, int l, long gtid, long nthr) {
    constexpr int R = 8, NQ = DIN / 4; const float* W = p.in[I_WIN] + (size_t)l * D * DIN;
    for (long it = gtid; it < (long)(NT / R) * NQ; it += nthr) {
        const int mi = (int)(it / NQ), n = (int)(it % NQ) * 4;
        const float* a[R]; float4 acc[R];
#pragma unroll
        for (int r = 0; r < R; ++r) { a[r] = p.H + (size_t)(mi * R + r) * D; acc[r] = float4{0.f, 0.f, 0.f, 0.f}; }
        gemm_rx4<R>(a, W + n, DIN, D, acc);
#pragma unroll
        for (int r = 0; r < R; ++r) *(float4*)(p.U + (size_t)(mi * R + r) * DIN + n) = acc[r];
    }
}

HD float conv_at(const P& p, int t, int col, int c, const float* w  , const float* bias) {
    const int i = tok_i(t), isc = i < CTX, li = isc ? i : i - CTX, len = isc ? CTX : SEQ;
    float s = bias[c];
#pragma unroll
    for (int k = 0; k < 4; ++k) { const int j = li + k - 2; if (j >= 0 && j < len) s += w[k * 256 + c] * p.U[(size_t)(t + k - 2) * DIN + col + c]; }
    return s;
}

HD void nv_prep1(const P& p, int l, long gtid, long nthr) {
    for (long it = gtid; it < (long)NT * 256; it += nthr) {
        const int t = (int)(it / 256), c = (int)(it % 256);
        p.XC[it] = conv_at(p, t, OFF_AX, c, p.in[I_LCW] + (size_t)l * 4 * 256, p.in[I_LCB] + (size_t)l * 256);
        p.XCM[it] = silu_f(conv_at(p, t, OFF_MX, c, p.in[I_MCW] + (size_t)l * 4 * 256, p.in[I_MCB] + (size_t)l * 256));
    }
    for (long t = gtid; t < NT; t += nthr) {
        const float* u = p.U + (size_t)t * DIN; float sq = 0.f, sk = 0.f;
        for (int k = 0; k < QRANK; ++k) sq += u[OFF_BQ + k] * u[OFF_BQ + k];
        for (int k = 0; k < KVRANK; ++k) sk += u[OFF_BKV + k] * u[OFF_BKV + k];
        const float rq = 1.f / sqrtf(sq / (float)QRANK + EPS), rk = 1.f / sqrtf(sk / (float)KVRANK + EPS);
        for (int k = 0; k < QRANK; ++k) p.QN[(size_t)t * QRANK + k] = u[OFF_BQ + k] * rq * p.in[I_QNG][(size_t)l * QRANK + k];
        for (int k = 0; k < KVRANK; ++k) p.KVN[(size_t)t * KVRANK + k] = u[OFF_BKV + k] * rk * p.in[I_KVNG][(size_t)l * KVRANK + k];
    }
}

HD void nv_prep2(const P& p, int l, long gtid, long nthr) {
    for (long it = gtid; it < (long)2 * NT * 256; it += nthr) {
        const int d = (int)(it / ((long)NT * 256)), t = (int)((it / 256) % NT), c = (int)(it % 256), g = c / 64, j = c % 64;
        const float* xc = p.XC + (size_t)t * 256 + g * 64;
        const float* wa = p.in[I_LWA] + ((((size_t)l * 2 + d) * 4 + g) * 64) * 64 + j;
        const float* wx = p.in[I_LWX] + ((((size_t)l * 2 + d) * 4 + g) * 64) * 64 + j;
        float sa = 0.f, sx = 0.f;
        for (int i = 0; i < 64; ++i) { sa += xc[i] * wa[i * 64]; sx += xc[i] * wx[i * 64]; }
        const float r = sigmoid_f(sa + p.in[I_LBA][((size_t)l * 2 + d) * 256 + c]), ig = sigmoid_f(sx + p.in[I_LBX][((size_t)l * 2 + d) * 256 + c]);
        const float log_a = 8.0f * r * logsigmoid_f(p.in[I_LLAM][((size_t)l * 2 + d) * 256 + c]);
        p.LA[it] = expf(log_a); p.LB[it] = sqrtf(-expm1f(2.f * log_a)) * ig * p.XC[(size_t)t * 256 + c];
    }
    { constexpr int R = 8, NQ = 768 / 4; const float* W = p.in[I_WQB] + (size_t)l * QRANK * 768;
      for (long it = gtid; it < (long)(NT / R) * NQ; it += nthr) { const int mi = (int)(it / NQ), n = (int)(it % NQ) * 4;
        const float* a[R]; float4 acc[R];
#pragma unroll
        for (int r = 0; r < R; ++r) { a[r] = p.QN + (size_t)(mi * R + r) * QRANK; acc[r] = float4{0.f, 0.f, 0.f, 0.f}; }
        gemm_rx4<R>(a, W + n, 768, QRANK, acc);
#pragma unroll
        for (int r = 0; r < R; ++r) *(float4*)(p.QF + (size_t)(mi * R + r) * 768 + n) = acc[r]; } }
    { constexpr int R = 8, NQ = 1024 / 4; const float* W = p.in[I_WKVB] + (size_t)l * KVRANK * 1024;
      for (long it = gtid; it < (long)(NT / R) * NQ; it += nthr) { const int mi = (int)(it / NQ), n = (int)(it % NQ) * 4;
        const float* a[R]; float4 acc[R];
#pragma unroll
        for (int r = 0; r < R; ++r) { a[r] = p.KVN + (size_t)(mi * R + r) * KVRANK; acc[r] = float4{0.f, 0.f, 0.f, 0.f}; }
        gemm_rx4<R>(a, W + n, 1024, KVRANK, acc);
#pragma unroll
        for (int r = 0; r < R; ++r) *(float4*)(p.KVF + (size_t)(mi * R + r) * 1024 + n) = acc[r]; } }
    for (long it = gtid; it < (long)NT * 256; it += nthr) {
        const int t = (int)(it / 256), c = (int)(it % 256), h = c / 64, j = c % 64;
        const float* xc = p.XCM + (size_t)t * 256 + h * 64; const float* ux = p.U + (size_t)t * DIN + OFF_MX + h * 64;
        const float* wq = p.in[I_MWQ] + (((size_t)l * 4 + h) * 64) * 64 + j; const float* wk = p.in[I_MWK] + (((size_t)l * 4 + h) * 64) * 64 + j; const float* wv = p.in[I_MWV] + (((size_t)l * 4 + h) * 64) * 64 + j;
        float sq = 0.f, sk = 0.f, sv = 0.f;
        for (int i = 0; i < 64; ++i) { sq += xc[i] * wq[i * 64]; sk += xc[i] * wk[i * 64]; sv += ux[i] * wv[i * 64]; }
        p.QM[it] = sq; p.KM[it] = sk * 0.125f; p.VM[it] = sv;
    }
}

HD void nv_prep3(const P& p, int l, long gtid, long nthr) {
    for (long it = gtid; it < (long)NB * 2 * 256; it += nthr) {
        const int b = (int)(it / 512), d = (int)((it / 256) & 1), c = (int)(it % 256);
        const float* A = p.LA + (size_t)d * NT * 256; const float* Bc = p.LB + (size_t)d * NT * 256; float* Ho = p.HL + (size_t)d * NT * 256;
        float h = 0.f;
        for (int seg = 0; seg < 2; ++seg) { const int base = b * TPB + (seg == 0 ? 0 : CTX), len = seg == 0 ? CTX : SEQ;
            for (int s = 0; s < len; ++s) { const int t = base + (d == 0 ? s : len - 1 - s);
                h = A[(size_t)t * 256 + c] * h + Bc[(size_t)t * 256 + c]; Ho[(size_t)t * 256 + c] = h; } }
    }
    for (long it = gtid; it < (long)NT * AH; it += nthr) {
        const int t = (int)(it / AH), h = (int)(it % AH), i = tok_i(t); const bool lat = i >= CTX; const int s = i - CTX;
        const float* qf = p.QF + (size_t)t * 768 + h * QKD; const float* kvf = p.KVF + (size_t)t * 1024 + h * (NOPE + VD); const float* kr = p.U + (size_t)t * DIN + OFF_BKR;
        float* qo = p.Qr + ((size_t)t * AH + h) * QKD; float* ko = p.Kr + ((size_t)t * AH + h) * QKD; float* vo = p.Vr + ((size_t)t * AH + h) * VD;
        for (int k = 0; k < NOPE; ++k) { qo[k] = qf[k]; ko[k] = kvf[k]; vo[k] = kvf[NOPE + k]; }
        for (int a = 0; a < 2; ++a) for (int f = 0; f < 8; ++f) {
            float cs = 1.f, sn = 0.f; if (lat) { cs = p.ROPET[(((size_t)s * 2 + a) * 8 + f) * 2]; sn = p.ROPET[(((size_t)s * 2 + a) * 8 + f) * 2 + 1]; }
            const float q1 = qf[NOPE + a * 16 + f], q2 = qf[NOPE + a * 16 + 8 + f], k1 = kr[a * 16 + f], k2 = kr[a * 16 + 8 + f];
            qo[NOPE + a * 16 + f] = q1 * cs - q2 * sn; qo[NOPE + a * 16 + 8 + f] = q2 * cs + q1 * sn;
            ko[NOPE + a * 16 + f] = k1 * cs - k2 * sn; ko[NOPE + a * 16 + 8 + f] = k2 * cs + k1 * sn; }
    }
    for (long it = gtid; it < (long)2 * NT * 8; it += nthr) {
        const int d = (int)(it / ((long)NT * 8)), t = (int)((it / 8) % NT), g = (int)(it % 8);
        const float* w = p.in[I_MWG] + (((size_t)l * 2 + d) * 768) * 8 + g; float s = p.in[I_MBG][((size_t)l * 2 + d) * 8 + g];
        for (int i = 0; i < 256; ++i) s += p.QM[(size_t)t * 256 + i] * w[(size_t)i * 8];
        for (int i = 0; i < 256; ++i) s += p.KM[(size_t)t * 256 + i] * w[(size_t)(256 + i) * 8];
        for (int i = 0; i < 256; ++i) s += p.VM[(size_t)t * 256 + i] * w[(size_t)(512 + i) * 8];
        p.IGF[it] = g < 4 ? s : logsigmoid_f(s);
    }
}

HD void nv_attn(const P& p, long gtid, long nthr) {
    const float scale = 1.0f / sqrtf((float)QKD);
    for (long it = gtid; it < (long)NT * AH; it += nthr) {
        const int h = (int)((it / TPB) % AH), b = (int)(it / ((long)TPB * AH)), i = (int)(it % TPB), t = b * TPB + i;
        const int nk = i < CTX ? CTX : TPB;
        float q[QKD], o[VD];
#pragma unroll
        for (int k = 0; k < QKD; ++k) q[k] = p.Qr[((size_t)t * AH + h) * QKD + k] * scale;
#pragma unroll
        for (int k = 0; k < VD; ++k) o[k] = 0.f;
        float m = -1e30f, lsum = 0.f;
        for (int j = 0; j < nk; ++j) {
            const float* kk = p.Kr + ((size_t)(b * TPB + j) * AH + h) * QKD; const float* vv = p.Vr + ((size_t)(b * TPB + j) * AH + h) * VD;
            float s = 0.f;
#pragma unroll
            for (int k = 0; k < QKD; ++k) s += q[k] * kk[k];
            if (s > m) { const float f = expf(m - s); lsum *= f;
#pragma unroll
                for (int k = 0; k < VD; ++k) o[k] *= f;
                m = s; }
            const float pr = expf(s - m); lsum += pr;
#pragma unroll
            for (int k = 0; k < VD; ++k) o[k] += pr * vv[k];
        }
        const float inv = 1.f / lsum;
#pragma unroll
        for (int k = 0; k < VD; ++k) p.Y[(size_t)t * DMIX + 256 + h * VD + k] = o[k] * inv;
    }
}
HD void nv_mlstm_scan(const P& p, long gtid, long nthr) {
    for (long it = gtid; it < (long)NB * MLH * 2 * 64; it += nthr) {
        const int v = (int)(it % 64), d = (int)((it / 64) & 1), h = (int)((it / 128) % MLH), b = (int)(it / (128 * MLH));
        float C[64], n[64];
#pragma unroll
        for (int k = 0; k < 64; ++k) { C[k] = 0.f; n[k] = 0.f; }
        float m = 0.f;
        for (int seg = 0; seg < 2; ++seg) { const int base = b * TPB + (seg == 0 ? 0 : CTX), len = seg == 0 ? CTX : SEQ;
            for (int s = 0; s < len; ++s) { const int t = base + (d == 0 ? s : len - 1 - s);
                const float ig = p.IGF[((size_t)d * NT + t) * 8 + h], lf = p.IGF[((size_t)d * NT + t) * 8 + 4 + h];
                const float mn = fmaxf(lf + m, ig), fd = expf(lf + m - mn), iw = expf(ig - mn); m = mn;
                const float* qq = p.QM + (size_t)t * 256 + h * 64; const float* kk = p.KM + (size_t)t * 256 + h * 64; const float vv = p.VM[(size_t)t * 256 + h * 64 + v];
                float num = 0.f, den = 0.f;
#pragma unroll
                for (int k = 0; k < 64; ++k) { const float kv = kk[k], qv = qq[k]; C[k] = fd * C[k] + iw * vv * kv; n[k] = fd * n[k] + iw * kv; num += C[k] * qv; den += n[k] * qv; }
                p.HM[((size_t)d * NT + t) * 256 + h * 64 + v] = num / fmaxf(fabsf(den), expf(-mn)); } }
    }
}
HD void nv_lru_out(const P& p, long gtid, long nthr) {
    for (long it = gtid; it < (long)NT * 256; it += nthr) { const int t = (int)(it / 256), c = (int)(it % 256);
        p.Y[(size_t)t * DMIX + c] = (p.HL[it] + p.HL[(size_t)NT * 256 + it]) * gelu_f(p.U[(size_t)t * DIN + OFF_AG + c]); }
}
HD void nv_mlstm_finish(const P& p, int l, long gtid, long nthr) {
    for (long it = gtid; it < (long)NT * MLH; it += nthr) { const int t = (int)(it / MLH), h = (int)(it % MLH);
        const float* h0 = p.HM + (size_t)t * 256 + h * 64; const float* h1 = p.HM + ((size_t)NT + t) * 256 + h * 64;
        float mu = 0.f; for (int j = 0; j < 64; ++j) mu += h0[j] + h1[j]; mu *= (1.f / 64.f);
        float var = 0.f; for (int j = 0; j < 64; ++j) { const float dlt = h0[j] + h1[j] - mu; var += dlt * dlt; } var *= (1.f / 64.f);
        const float rstd = 1.f / sqrtf(var + EPS);
        for (int j = 0; j < 64; ++j) { const int c = h * 64 + j;
            const float y = (h0[j] + h1[j] - mu) * rstd * p.in[I_MNG][(size_t)l * 256 + c] + p.in[I_MSK][(size_t)l * 256 + c] * p.XCM[(size_t)t * 256 + c];
            p.Y[(size_t)t * DMIX + 768 + c] = y * silu_f(p.U[(size_t)t * DIN + OFF_MZ + c]); } }
}
HD void nv_outproj(const P& p, int l, long gtid, long nthr) {
    constexpr int R = 8, NQ = D / 4; const float* W = p.in[I_WOUT] + (size_t)l * DMIX * D;
    for (long it = gtid; it < (long)(NT / R) * NQ; it += nthr) { const int mi = (int)(it / NQ), n = (int)(it % NQ) * 4;
        const float* a[R]; float4 acc[R];
#pragma unroll
        for (int r = 0; r < R; ++r) { a[r] = p.Y + (size_t)(mi * R + r) * DMIX; acc[r] = float4{0.f, 0.f, 0.f, 0.f}; }
        gemm_rx4<R>(a, W + n, D, DMIX, acc);
#pragma unroll
        for (int r = 0; r < R; ++r) { const int t = mi * R + r; const float* g1 = modp(p, l, tok_cv(t), 2) + n; float* x = p.X + (size_t)t * D + n;
            x[0] += g1[0] * acc[r].x; x[1] += g1[1] * acc[r].y; x[2] += g1[2] * acc[r].z; x[3] += g1[3] * acc[r].w; } }
}
HD void nv_zero_cnt(const P& p, long gtid, long nthr) { for (long i = gtid; i < NE; i += nthr) p.CNT[i] = 0; }
HD void nv_router(const P& p, int l, long gtid, long nthr) {
    for (long t = gtid; t < NT; t += nthr) {
        float lg[NE]; const float* h = p.H + (size_t)t * D; const float* W = p.in[I_WR] + (size_t)l * D * NE;
#pragma unroll
        for (int e = 0; e < NE; ++e) lg[e] = p.in[I_BR][(size_t)l * NE + e];
        for (int k = 0; k < D; ++k) { const float hv = h[k];
#pragma unroll
            for (int e = 0; e < NE; ++e) lg[e] += hv * W[(size_t)k * NE + e]; }
        int te[TOPK]; float tv[TOPK];
#pragma unroll
        for (int r = 0; r < TOPK; ++r) { float best = -3.0e38f; int bi = 0;
#pragma unroll
            for (int e = 0; e < NE; ++e) { const bool c = lg[e] > best; best = c ? lg[e] : best; bi = c ? e : bi; }
            te[r] = bi; tv[r] = best;
#pragma unroll
            for (int e = 0; e < NE; ++e) lg[e] = (e == bi) ? -3.0e38f : lg[e]; }
        float s = 0.f, ex[TOPK];
#pragma unroll
        for (int r = 0; r < TOPK; ++r) { ex[r] = expf(tv[r] - tv[0]); s += ex[r]; }
#pragma unroll
        for (int r = 0; r < TOPK; ++r) { p.TOPE[t * TOPK + r] = te[r]; p.TOPG[t * TOPK + r] = ex[r] / s;
            const int pos = atomic_add_i(&p.CNT[te[r]], 1); p.LIST[(size_t)te[r] * NT + pos] = (int)t * TOPK + r; }
    }
}
HD bool moe_item(const P& p, int R, long grp, int& e, int& r0) {
    long acc = 0;
    for (int x = 0; x < NE; ++x) { const int c = p.CNT[x], ng = (c + R - 1) / R; if (grp < acc + ng) { e = x; r0 = (int)(grp - acc) * R; return true; } acc += ng; }
    return false;
}
HD long moe_groups(const P& p, int R) { long acc = 0; for (int x = 0; x < NE; ++x) acc += (p.CNT[x] + R - 1) / R; return acc; }
HD void nv_moe_gu(const P& p, int l, long gtid, long nthr) {
    constexpr int R = 8, NQ = DE / 4; const long ngrp = moe_groups(p, R);
    for (long it = gtid; it < ngrp * NQ; it += nthr) { int e, r0; moe_item(p, R, it / NQ, e, r0); const int n = (int)(it % NQ) * 4, cnt = p.CNT[e];
        const float* Wg = p.in[I_WGU] + ((size_t)l * NE + e) * D * 2 * DE; const float* bg = p.in[I_BGU] + ((size_t)l * NE + e) * 2 * DE;
        const float* a[R]; int pr[R]; float4 ag[R], al[R];
#pragma unroll
        for (int r = 0; r < R; ++r) { const int rr = r0 + r < cnt ? r0 + r : cnt - 1; pr[r] = p.LIST[(size_t)e * NT + rr]; a[r] = p.H + (size_t)(pr[r] / TOPK) * D; ag[r] = float4{0.f, 0.f, 0.f, 0.f}; al[r] = float4{0.f, 0.f, 0.f, 0.f}; }
        gemm_rx4<R>(a, Wg + n, 2 * DE, D, ag);
        gemm_rx4<R>(a, Wg + DE + n, 2 * DE, D, al);
#pragma unroll
        for (int r = 0; r < R; ++r) if (r0 + r < cnt) { float gv[4] = {ag[r].x + bg[n], ag[r].y + bg[n + 1], ag[r].z + bg[n + 2], ag[r].w + bg[n + 3]};
            float lv[4] = {al[r].x + bg[DE + n], al[r].y + bg[DE + n + 1], al[r].z + bg[DE + n + 2], al[r].w + bg[DE + n + 3]};
#pragma unroll
            for (int q = 0; q < 4; ++q) { const float glu = fminf(gv[q], 7.0f), lin = fminf(fmaxf(lv[q], -7.0f), 7.0f);
                p.ACT[(size_t)pr[r] * DE + n + q] = glu * sigmoid_f(1.702f * glu) * (lin + 1.f); } }
    }
}
HD void nv_moe_down(const P& p, int l, long gtid, long nthr) {
    constexpr int R = 8, NQ = D / 4; const long ngrp = moe_groups(p, R);
    for (long it = gtid; it < ngrp * NQ; it += nthr) { int e, r0; moe_item(p, R, it / NQ, e, r0); const int n = (int)(it % NQ) * 4, cnt = p.CNT[e];
        const float* Wd = p.in[I_WD] + ((size_t)l * NE + e) * DE * D; const float* bd = p.in[I_BD] + ((size_t)l * NE + e) * D;
        const float* a[R]; int pr[R]; float4 acc[R];
#pragma unroll
        for (int r = 0; r < R; ++r) { const int rr = r0 + r < cnt ? r0 + r : cnt - 1; pr[r] = p.LIST[(size_t)e * NT + rr]; a[r] = p.ACT + (size_t)pr[r] * DE; acc[r] = float4{0.f, 0.f, 0.f, 0.f}; }
        gemm_rx4<R>(a, Wd + n, D, DE, acc);
#pragma unroll
        for (int r = 0; r < R; ++r) if (r0 + r < cnt) { const float g = p.TOPG[pr[r]]; float* y = p.YB + (size_t)pr[r] * D + n;
            y[0] = g * (acc[r].x + bd[n]); y[1] = g * (acc[r].y + bd[n + 1]); y[2] = g * (acc[r].z + bd[n + 2]); y[3] = g * (acc[r].w + bd[n + 3]); }
    }
}
HD void nv_combine(const P& p, int l, long gtid, long nthr) {
    for (long it = gtid; it < (long)NT * D; it += nthr) { const int t = (int)(it / D), n = (int)(it % D);
        const float s = ((p.YB[((size_t)t * 4 + 0) * D + n] + p.YB[((size_t)t * 4 + 1) * D + n]) + p.YB[((size_t)t * 4 + 2) * D + n]) + p.YB[((size_t)t * 4 + 3) * D + n];
        p.X[it] += modp(p, l, tok_cv(t), 5)[n] * s; }
}
HD void nv_final(const P& p, long gtid, long nthr) {
    for (long r = gtid; r < (long)NB * SEQ; r += nthr) { const int b = (int)(r / SEQ), s = (int)(r % SEQ), t = b * TPB + CTX + s;
        const float* x = p.X + (size_t)t * D; float ss = 0.f;
        for (int k = 0; k < D; ++k) ss += x[k] * x[k];
        const float rstd = 1.f / sqrtf(ss / (float)D + EPS);
        for (int k = 0; k < D; ++k) p.out[(size_t)r * D + k] = x[k] * rstd * p.in[I_FG][k]; }
}

constexpr int PH_PER_LAYER = 13, N_PHASES = 1 + DEPTH * PH_PER_LAYER + 1;
HD void nv_run_phase(const P& p, int ph, long gtid, long nthr) {
    if (ph == 0) { nv_init(p, gtid, nthr); return; }
    if (ph == N_PHASES - 1) { nv_final(p, gtid, nthr); return; }
    const int l = (ph - 1) / PH_PER_LAYER, s = (ph - 1) % PH_PER_LAYER;
    switch (s) {
        case 0: nv_norm(p, l, 0, gtid, nthr); break;
        case 1: nv_inproj(p, l, gtid, nthr); break;
        case 2: nv_prep1(p, l, gtid, nthr); break;
        case 3: nv_prep2(p, l, gtid, nthr); break;
        case 4: nv_prep3(p, l, gtid, nthr); break;
        case 5: nv_mlstm_scan(p, gtid, nthr); nv_attn(p, gtid, nthr); nv_lru_out(p, gtid, nthr); break;
        case 6: nv_mlstm_finish(p, l, gtid, nthr); break;
        case 7: nv_outproj(p, l, gtid, nthr); break;
        case 8: nv_norm(p, l, 1, gtid, nthr); nv_zero_cnt(p, gtid, nthr); break;
        case 9: nv_router(p, l, gtid, nthr); break;
        case 10: nv_moe_gu(p, l, gtid, nthr); break;
        case 11: nv_moe_down(p, l, gtid, nthr); break;
        case 12: nv_combine(p, l, gtid, nthr); break;
    }
}

struct WsMap { size_t off[32]; size_t total; };
static inline WsMap ws_map() {
    WsMap m; size_t o = 0; int i = 0;
    auto add = [&](size_t n) { m.off[i++] = o; o += (n + 63) & ~(size_t)63; };
    add((size_t)DEPTH * 3 * 6 * D);
    add((size_t)SEQ * 16 * 2);
    add((size_t)NT * D);
    add((size_t)NT * D);
    add((size_t)NT * DIN);
    add((size_t)NT * 256);
    add((size_t)2 * NT * 256);
    add((size_t)2 * NT * 256);
    add((size_t)2 * NT * 256);
    add((size_t)NT * QRANK);
    add((size_t)NT * KVRANK);
    add((size_t)NT * 768);
    add((size_t)NT * 1024);
    add((size_t)NT * AH * QKD);
    add((size_t)NT * AH * QKD);
    add((size_t)NT * AH * VD);
    add((size_t)NT * 256);
    add((size_t)NT * 256);
    add((size_t)NT * 256);
    add((size_t)NT * 256);
    add((size_t)2 * NT * 8);
    add((size_t)2 * NT * 256);
    add((size_t)NT * DMIX);
    add((size_t)NT * TOPK);
    add((size_t)NT * TOPK * DE);
    add((size_t)NT * TOPK * D);
    add((size_t)NT * TOPK);
    add((size_t)64);
    add((size_t)NE * NT);
    m.total = o; return m;
}
static inline void fill_params(P& p, void* const* d_in, void* d_out, void* d_ws) {
    for (int i = 0; i < N_IN; ++i) p.in[i] = (const float*)d_in[i];
    p.out = (float*)d_out; float* w = (float*)d_ws; const WsMap m = ws_map();
    p.MOD = w + m.off[0]; p.ROPET = w + m.off[1]; p.X = w + m.off[2]; p.H = w + m.off[3]; p.U = w + m.off[4]; p.XC = w + m.off[5]; p.LA = w + m.off[6]; p.LB = w + m.off[7]; p.HL = w + m.off[8];
    p.QN = w + m.off[9]; p.KVN = w + m.off[10]; p.QF = w + m.off[11]; p.KVF = w + m.off[12]; p.Qr = w + m.off[13]; p.Kr = w + m.off[14]; p.Vr = w + m.off[15];
    p.XCM = w + m.off[16]; p.QM = w + m.off[17]; p.KM = w + m.off[18]; p.VM = w + m.off[19]; p.IGF = w + m.off[20]; p.HM = w + m.off[21]; p.Y = w + m.off[22];
    p.TOPG = w + m.off[23]; p.ACT = w + m.off[24]; p.YB = w + m.off[25]; p.TOPE = (int*)(w + m.off[26]); p.CNT = (int*)(w + m.off[27]); p.LIST = (int*)(w + m.off[28]);
}
extern __shared__ __attribute__((aligned(16))) unsigned char g_lds_base[];
constexpr int WTAB_OFF = 148480 - 64 - 256;
#define HWID() ((int)__builtin_amdgcn_s_getreg((5 << 11) | 4) & 63)
#if ONE_LAUNCH
__device__ __forceinline__ int tidx_() {
    unsigned z = 0u; asm volatile("" : "+v"(z));
    const int lane = (int)__builtin_amdgcn_mbcnt_hi(~0u, __builtin_amdgcn_mbcnt_lo(~0u, z));
    const int wv = __builtin_amdgcn_readfirstlane(((const volatile __attribute__((address_space(3))) int*)((__attribute__((address_space(3))) unsigned char*)g_lds_base + WTAB_OFF))[HWID()]);
    return wv * 64 + lane;
}
#define TIDX tidx_()
#else
#define TIDX ((int)threadIdx.x)
#endif
namespace pg8 {
#define PG8_LAS __attribute__((address_space(3)))
typedef unsigned short bf16_t;
typedef short bf16x8 __attribute__((ext_vector_type(8)));
typedef float f32x4 __attribute__((ext_vector_type(4)));
typedef unsigned u32x4 __attribute__((ext_vector_type(4)));
constexpr int BM = 256, BK = 64, HALF = 128, HTB = HALF * BK * 2  , STAGE_BYTES = 8 * HTB, NXCD = 8, WGM = 8;

__host__ __device__ __forceinline__ int lds_byte(int r, int c) { const int st = (r >> 4) * 2 + (c >> 5), rr = r & 15, cc = c & 31, ob = rr * 64 + cc * 2; return st * 1024 + (ob ^ (((ob >> 9) & 1) << 5)); }
__host__ __device__ __forceinline__ void stage_rc(int b, int& R, int& C) { const int st = b / 1024, sb = b % 1024, swz = sb ^ (((sb >> 9) & 1) << 5); R = (st >> 1) * 16 + swz / 64; C = (st & 1) * 32 + (swz % 64) / 2; }
__host__ __device__ __forceinline__ int perm32(int rho) { const int n = rho >> 4, i = rho & 15; return 8 * (i >> 2) + 4 * n + (i & 3); }

struct Unit { int pm, pn, e, mb, slot; };
struct Gemm { const bf16_t* A; const bf16_t* Bt; int K; };

struct StaticOrder {
    int nM, nN, nwg, G, c;
    __device__ void init(int M, int N, int G_, int c_) { nM = M / BM; nN = N / BM; nwg = nM * nN; G = G_; c = c_; }
    __device__ bool next(int i, Unit& u) const {
        const long L = (long)i * G + c; if (L >= nwg) return false;
        int wgid = (int)L; { const int q = nwg / NXCD, r = nwg % NXCD, xcd = wgid % NXCD, off = wgid / NXCD; wgid = (xcd < r ? xcd * (q + 1) : r * (q + 1) + (xcd - r) * q) + off; }
        const int nig = WGM * nN, gid = wgid / nig, fm = gid * WGM, gsz = (nM - fm) < WGM ? (nM - fm) : WGM;
        u.pm = fm + ((wgid % nig) % gsz); u.pn = (wgid % nig) / gsz; u.e = 0; u.mb = 0; u.slot = 0; return true;
    }
    __device__ __forceinline__ int arow(const Unit& u, int r) const { return u.pm * BM + r; }
};

typedef float f32x2_c __attribute__((ext_vector_type(2))); typedef __bf16 bf16x2_c __attribute__((ext_vector_type(2)));
__device__ __forceinline__ unsigned cvt_pk_bf16(float lo, float hi) { f32x2_c v = {lo, hi}; bf16x2_c b = __builtin_convertvector(v, bf16x2_c); return __builtin_bit_cast(unsigned, b); }

template <class Epi, class Sched, bool ALIGN_EPI>
__device__ __forceinline__ void gemm_phase(PG8_LAS unsigned char* lds, const Gemm g, const Sched& S, const Epi& E) {
    int tid_ = TIDX; asm volatile("" : "+v"(tid_));
    const int tid = tid_, wid = __builtin_amdgcn_readfirstlane(tid >> 6), lane = tid & 63, wr = wid >> 2, wc = wid & 3, fr = lane & 15, fq = lane >> 4;
    const int K = g.K, nt = K / BK;
    unsigned voffB[2];
#pragma unroll
    for (int i = 0; i < 2; ++i) { int R, C; stage_rc(tid * 16 + i * 8192, R, C); const int Rb = Epi::PERM ? ((R & ~31) + perm32(R & 31)) : R;
        voffB[i] = (unsigned)(Rb * K + C) * 2u; }
    const size_t kstep = (size_t)(BK * 2);
    const size_t hstep = (size_t)HALF * K * 2;
    const size_t tstep = 2 * hstep;
    const unsigned ldsw = (unsigned)wid * 1024u;
    const int aoff = lds_byte(wr * 64 + fr, fq * 8), boff = lds_byte(wc * 32 + fr, fq * 8);
#define PG8_SA(b, h) (((b) * 2 + (h)) * HTB)
#define PG8_SB(b, h) ((4 + (b) * 2 + (h)) * HTB)
#define PG8_STAGE(bufoff, gbase, voff) do { _Pragma("unroll") for (int _i = 0; _i < 2; ++_i) \
        __builtin_amdgcn_global_load_lds((const unsigned*)((const char*)(gbase) + (voff)[_i]), (PG8_LAS unsigned*)(lds + (bufoff) + ldsw + _i * 8192), 16, 0, 0); } while (0)
#define PG8_LDA(dst, b, h) do { _Pragma("unroll") for (int m = 0; m < 4; ++m) _Pragma("unroll") for (int k = 0; k < 2; ++k) dst[m][k] = *(const PG8_LAS bf16x8*)(lds + PG8_SA(b, h) + aoff + m * 2048 + k * 1024); } while (0)
#define PG8_LDB(dst, b, h) do { _Pragma("unroll") for (int n = 0; n < 2; ++n) _Pragma("unroll") for (int k = 0; k < 2; ++k) dst[n][k] = *(const PG8_LAS bf16x8*)(lds + PG8_SB(b, h) + boff + n * 2048 + k * 1024); } while (0)
#define PG8_MMA(ai, bj, At, Bt) do { __builtin_amdgcn_s_setprio(1); _Pragma("unroll") for (int m = 0; m < 4; ++m) _Pragma("unroll") for (int n = 0; n < 2; ++n) _Pragma("unroll") for (int k = 0; k < 2; ++k) \
        acc[ai][bj][m][n] = __builtin_amdgcn_mfma_f32_16x16x32_bf16(Bt[n][k], At[m][k], acc[ai][bj][m][n], 0, 0, 0); __builtin_amdgcn_s_setprio(0); } while (0)
#define PG8_WAIT_V(n) asm volatile("s_waitcnt vmcnt(" #n ")" ::: "memory")
#define PG8_WAIT_L(n) asm volatile("s_waitcnt lgkmcnt(" #n ")" ::: "memory")
#define PG8_BAR __builtin_amdgcn_s_barrier()
#define PG8_SCHED __builtin_amdgcn_sched_barrier(0)
#define PG8_AOFFS(dst, U) do { int _t = tid; asm volatile("" : "+v"(_t)); _Pragma("unroll") for (int _i = 0; _i < 2; ++_i) { int _R, _C; stage_rc(_t * 16 + _i * 8192, _R, _C); \
        _Pragma("unroll") for (int _h = 0; _h < 2; ++_h) dst[_h][_i] = (unsigned)(S.arow(U, _h * HALF + _R) * K + _C) * 2u; } } while (0)
    Unit cur, nxt; int ui = 0;
    if (!S.next(0, cur)) return;
    f32x4 acc[2][2][4][2];
#pragma unroll
    for (int a = 0; a < 2; ++a)
#pragma unroll
        for (int b = 0; b < 2; ++b)
#pragma unroll
            for (int m = 0; m < 4; ++m)
#pragma unroll
                for (int n = 0; n < 2; ++n) acc[a][b][m][n] = (f32x4){0.f, 0.f, 0.f, 0.f};
    bf16x8 At[4][2], B0[2][2], B1[2][2];
    unsigned vA[2][2];
    PG8_AOFFS(vA, cur);
    const char* gA = (const char*)g.A;
    const char* cB = (const char*)g.Bt + (size_t)cur.pn * tstep;
    PG8_STAGE(PG8_SB(0, 0), cB, voffB); PG8_STAGE(PG8_SB(0, 1), cB + hstep, voffB); PG8_STAGE(PG8_SA(0, 0), gA, vA[0]); PG8_STAGE(PG8_SA(0, 1), gA, vA[1]);
    if (wr == 1) PG8_BAR;
    PG8_WAIT_V(2); PG8_BAR;
    PG8_STAGE(PG8_SB(1, 0), cB + kstep, voffB); PG8_STAGE(PG8_SA(1, 0), gA + kstep, vA[0]); PG8_STAGE(PG8_SB(1, 1), cB + hstep + kstep, voffB);
    PG8_WAIT_V(6); PG8_BAR;
    for (;;) {
        const bool has_next = S.next(ui + 1, nxt);
        { unsigned nvA[2][2];
          if (has_next) { PG8_AOFFS(nvA, nxt); } else {
#pragma unroll
            for (int h = 0; h < 2; ++h)
#pragma unroll
                for (int i = 0; i < 2; ++i) nvA[h][i] = vA[h][i]; }
          *(PG8_LAS u32x4*)(lds + STAGE_BYTES + 1024 + tid * 16) = (u32x4){nvA[0][0], nvA[0][1], nvA[1][0], nvA[1][1]}; }
        const char* nB = has_next ? (const char*)g.Bt + (size_t)nxt.pn * tstep : cB;
#pragma unroll 1
        for (int t = 0; t < nt; t += 2) {
            const bool last = (t == nt - 2);
            const char* a1 = gA + (size_t)(t + 1) * kstep;
            const char* a2 = last ? gA : gA + (size_t)(t + 2) * kstep; const char* b2 = last ? nB : cB + (size_t)(t + 2) * kstep;
            const char* a3 = a2 + kstep; const char* b3 = b2 + kstep;
            unsigned o2[2][2];
            if (last) { const u32x4 nv = *(const PG8_LAS u32x4*)(lds + STAGE_BYTES + 1024 + tid * 16); o2[0][0] = nv.x; o2[0][1] = nv.y; o2[1][0] = nv.z; o2[1][1] = nv.w; }
            else {
#pragma unroll
                for (int h = 0; h < 2; ++h)
#pragma unroll
                    for (int i = 0; i < 2; ++i) o2[h][i] = vA[h][i]; }
            PG8_LDB(B0, 0, 0); PG8_LDB(B1, 0, 1); PG8_SCHED; PG8_LDA(At, 0, 0); PG8_STAGE(PG8_SA(1, 1), a1, vA[1]);
            PG8_WAIT_V(8); PG8_WAIT_L(0); PG8_BAR; PG8_MMA(0, 0, At, B0); PG8_MMA(0, 1, At, B1); PG8_BAR; PG8_SCHED;
            PG8_LDA(At, 0, 1); PG8_STAGE(PG8_SB(0, 0), b2, voffB); PG8_STAGE(PG8_SB(0, 1), b2 + hstep, voffB); PG8_STAGE(PG8_SA(0, 0), a2, o2[0]);
            PG8_WAIT_V(8); PG8_WAIT_L(0); PG8_BAR; PG8_MMA(1, 0, At, B0); PG8_MMA(1, 1, At, B1); PG8_BAR; PG8_SCHED;
            PG8_LDB(B0, 1, 0); PG8_LDB(B1, 1, 1); PG8_SCHED; PG8_LDA(At, 1, 0); PG8_STAGE(PG8_SA(0, 1), a2, o2[1]);
            PG8_WAIT_V(8); PG8_WAIT_L(0); PG8_BAR; PG8_MMA(0, 0, At, B0); PG8_MMA(0, 1, At, B1); PG8_BAR; PG8_SCHED;
            PG8_LDA(At, 1, 1); PG8_STAGE(PG8_SB(1, 0), b3, voffB); PG8_STAGE(PG8_SB(1, 1), b3 + hstep, voffB); PG8_STAGE(PG8_SA(1, 0), a3, o2[0]);
            PG8_WAIT_V(8); PG8_WAIT_L(0); PG8_BAR; PG8_MMA(1, 0, At, B0); PG8_MMA(1, 1, At, B1); PG8_BAR; PG8_SCHED;
        }
        if constexpr (ALIGN_EPI) { if (wr == 0) PG8_BAR; }
        E(acc, cur, wr, wc, fr, fq);
        if (!has_next) break;
#pragma unroll
        for (int a = 0; a < 2; ++a)
#pragma unroll
            for (int b = 0; b < 2; ++b)
#pragma unroll
                for (int m = 0; m < 4; ++m)
#pragma unroll
                    for (int n = 0; n < 2; ++n) acc[a][b][m][n] = (f32x4){0.f, 0.f, 0.f, 0.f};
        cur = nxt; cB = nB; ++ui;
        { const u32x4 nv = *(const PG8_LAS u32x4*)(lds + STAGE_BYTES + 1024 + tid * 16); vA[0][0] = nv.x; vA[0][1] = nv.y; vA[1][0] = nv.z; vA[1][1] = nv.w; }
        if constexpr (ALIGN_EPI) { if (wr == 1) PG8_BAR; }
    }
    PG8_WAIT_V(0);
    if constexpr (!ALIGN_EPI) { if (wr == 0) PG8_BAR; }
    PG8_BAR;
#undef PG8_SA
#undef PG8_SB
#undef PG8_STAGE
#undef PG8_LDA
#undef PG8_LDB
#undef PG8_MMA
#undef PG8_WAIT_V
#undef PG8_WAIT_L
#undef PG8_BAR
#undef PG8_SCHED
#undef PG8_AOFFS
}
}
#define LAS __attribute__((address_space(3)))
typedef unsigned short bf16;
typedef float f32x4 __attribute__((ext_vector_type(4)));
typedef unsigned u32x4 __attribute__((ext_vector_type(4)));
typedef unsigned u32x2 __attribute__((ext_vector_type(2)));

constexpr int NWAVES = 8, NTHREADS = 512;
constexpr int DINP = 1536;
constexpr int SLOT_MAX = NT * TOPK + NE * 256;

struct Q {
    bf16 *WtIn, *WtOut, *WtGu, *WtDn, *WtQb, *WtKvb;
    bf16 *H16, *Y16, *ACT16, *K16, *V16;
};

__device__ __forceinline__ unsigned f2bf(float f) { unsigned u = __builtin_bit_cast(unsigned, f); return (u + 0x7fffu + ((u >> 16) & 1u)) >> 16; }
__device__ __forceinline__ unsigned pk2(float lo, float hi) { return f2bf(lo) | (f2bf(hi) << 16); }
__device__ __forceinline__ float bf2f(unsigned short b) { return __builtin_bit_cast(float, (unsigned)b << 16); }

__device__ __forceinline__ void tr_decode(const P& p, const Q& q, bf16* WtKvbP, int it, const float*& src, int& N, bf16*& dst, int& ldk) {
    constexpr int I_GU = (D / 64) * (2 * DE / 64), I_DN = (DE / 64) * (D / 64);
    constexpr int I_IN = (D / 64) * ((DIN + 63) / 64), I_OUT = (DMIX / 64) * (D / 64), I_QB = (QRANK / 64) * (768 / 64), I_KVB = (KVRANK / 64) * (1024 / 64);
    constexpr int PER_L = NE * (I_GU + I_DN) + I_IN + I_OUT + I_QB + I_KVB;
    const int l = it / PER_L; int r = it % PER_L;
    if (r < NE * I_GU) { const int e = r / I_GU, rr = r % I_GU, kbs = D / 64, kb = rr % kbs, n0 = 64 * (rr / kbs);
        const int isl = n0 >= DE, j0 = n0 - isl * DE, drow0 = 256 * (j0 / 128) + 128 * isl + (j0 % 128);
        N = 2 * DE; ldk = D; src = p.in[I_WGU] + ((size_t)l * NE + e) * D * 2 * DE + (size_t)(64 * kb) * N + n0; dst = q.WtGu + ((size_t)l * NE + e) * 2 * DE * D + (size_t)drow0 * ldk + 64 * kb; return; } r -= NE * I_GU;
    if (r < NE * I_DN) { const int e = r / I_DN, rr = r % I_DN, kbs = DE / 64, kb = rr % kbs, n0 = 64 * (rr / kbs);
        N = D; ldk = DE; src = p.in[I_WD] + ((size_t)l * NE + e) * DE * D + (size_t)(64 * kb) * N + n0; dst = q.WtDn + ((size_t)l * NE + e) * D * DE + (size_t)n0 * ldk + 64 * kb; return; } r -= NE * I_DN;
    if (r < I_IN) { const int nb = (DIN + 63) / 64, kb = r / nb, n0 = 64 * (r % nb);
        const int n0c = n0 + 64 <= DIN ? n0 : DIN - 64; N = DIN; ldk = D; src = p.in[I_WIN] + (size_t)l * D * DIN + (size_t)(64 * kb) * N + n0c; dst = q.WtIn + (size_t)l * DINP * D + (size_t)n0c * ldk + 64 * kb; return; } r -= I_IN;
    if (r < I_OUT) { const int nb = D / 64, kb = r / nb, n0 = 64 * (r % nb); N = D; ldk = DMIX; src = p.in[I_WOUT] + (size_t)l * DMIX * D + (size_t)(64 * kb) * N + n0; dst = q.WtOut + (size_t)l * D * DMIX + (size_t)n0 * ldk + 64 * kb; return; } r -= I_OUT;
    if (r < I_QB) { const int nb = 768 / 64, kb = r / nb, n0 = 64 * (r % nb); N = 768; ldk = 256; src = p.in[I_WQB] + (size_t)l * QRANK * 768 + (size_t)(64 * kb) * N + n0; dst = WtKvbP + (size_t)l * 1792 * 256 + (size_t)n0 * ldk + 64 * kb; return; } r -= I_QB;
    { const int nb = 1024 / 64, kb = r / nb, n0 = 64 * (r % nb); N = 1024; ldk = 256; src = p.in[I_WKVB] + (size_t)l * KVRANK * 1024 + (size_t)(64 * kb) * N + n0; dst = WtKvbP + (size_t)l * 1792 * 256 + (size_t)(768 + n0) * ldk + 64 * kb; }
}
__device__ __forceinline__ void opt_convert_weights(const P& p, const Q& q, bf16* WtKvbP, LAS unsigned char* lds, int gw, int ngw, int wave, int lane) {
    LAS float* scr = (LAS float*)(lds + wave * 16640);
    constexpr int I_GU = (D / 64) * (2 * DE / 64), I_DN = (DE / 64) * (D / 64);
    constexpr int I_IN = (D / 64) * ((DIN + 63) / 64), I_OUT = (DMIX / 64) * (D / 64), I_QB = (QRANK / 64) * (768 / 64), I_KVB = (KVRANK / 64) * (1024 / 64);
    constexpr int PER_L = NE * (I_GU + I_DN) + I_IN + I_OUT + I_QB + I_KVB, REST = I_IN + I_OUT + I_QB + I_KVB;
    const int lr = lane >> 4, c4 = (lane & 15) * 4;
#ifdef BG_PROBE
    for (int x = gw; x < DEPTH * PER_L; x += ngw) {
        const float* src; bf16* dst; int N, ldk; tr_decode(p, q, WtKvbP, x, src, N, dst, ldk);
#else
    for (int x = gw; x < DEPTH * REST; x += ngw) {
        const float* src; bf16* dst; int N, ldk; tr_decode(p, q, WtKvbP, (x / REST) * PER_L + NE * (I_GU + I_DN) + x % REST, src, N, dst, ldk);
#endif
        f32x4 v[16];
#pragma unroll
        for (int i = 0; i < 16; ++i) v[i] = *(const f32x4*)(src + (size_t)(4 * i + lr) * N + c4);
#pragma unroll
        for (int i = 0; i < 16; ++i) { LAS float* d = scr + (4 * i + lr) * 65 + c4; d[0] = v[i].x; d[1] = v[i].y; d[2] = v[i].z; d[3] = v[i].w; }
        asm volatile("s_waitcnt lgkmcnt(0)" ::: "memory");
#pragma unroll
        for (int j = 0; j < 8; ++j) { const int n = 8 * j + (lane >> 3), c = lane & 7; const LAS float* sp = scr + (8 * c) * 65 + n;
            u32x4 o; o.x = pk2(sp[0 * 65], sp[1 * 65]); o.y = pk2(sp[2 * 65], sp[3 * 65]); o.z = pk2(sp[4 * 65], sp[5 * 65]); o.w = pk2(sp[6 * 65], sp[7 * 65]);
            *(u32x4*)(dst + (size_t)n * ldk + 8 * c) = o; }
        asm volatile("s_waitcnt lgkmcnt(0)" ::: "memory");
    }
    const long gt = (long)gw * 64 + lane, ngt = (long)ngw * 64;
    for (long i = gt; i < (long)DEPTH * (DINP - DIN) * D / 8; i += ngt) { const int l = (int)(i / ((DINP - DIN) * D / 8)); const long o = i % ((DINP - DIN) * D / 8);
        *(u32x4*)(q.WtIn + ((size_t)l * DINP + DIN) * D + o * 8) = (u32x4){0u, 0u, 0u, 0u}; }
    for (long i = gt; i < (long)DEPTH * 1024 * 16; i += ngt) { const long row = i >> 4, l = row >> 10, n = row & 1023; *(u32x4*)(WtKvbP + ((size_t)l * 1792 + 768 + n) * 256 + 128 + (i & 15) * 8) = (u32x4){0u, 0u, 0u, 0u}; }
}

struct BgConv {
    const float* wgu; const float* wdn; bf16* tgu; bf16* tdn;
    int it, stride, ph; unsigned ldsb;
    const float* src; bf16* dst; int N;
    static constexpr int I_GU = NE * (2 * DE / 32) * (D / 64), I_DN = NE * (D / 32) * (DE / 64), TOTAL = I_GU + I_DN, LDS_PER_WAVE = 8192;
    static_assert(D == 1024 && DE == 1024 && NE == 32, "BgConv decodes items by shifts");
    __device__ __forceinline__ void decode() {
#ifdef BG_PROBE
        const int it = this->it & 2047;
#endif
        if (it < I_GU) { const int e = it >> 10, nblk = (it >> 4) & 63, kb = it & 15, n0 = 32 * nblk, isl = n0 >= DE, j0 = n0 - isl * DE, drow0 = 256 * (j0 / 128) + 128 * isl + (j0 % 128);
            N = 2 * DE; src = wgu + ((size_t)e * D + 64 * kb) * (2 * DE) + n0; dst = tgu + ((size_t)e * 2 * DE + drow0) * D + 64 * kb; }
        else { const int r = it - I_GU, e = r >> 9, nblk = (r >> 4) & 31, kb = r & 15, n0 = 32 * nblk;
            N = D; src = wdn + ((size_t)e * DE + 64 * kb) * D + n0; dst = tdn + ((size_t)e * D + n0) * DE + 64 * kb; }
    }
    __device__ __forceinline__ void init(const P& p, const Q& q, int l, LAS unsigned char* lds, int gw, int ngw, int wave) {
        wgu = p.in[I_WGU] + (size_t)l * NE * D * 2 * DE; wdn = p.in[I_WD] + (size_t)l * NE * DE * D; tgu = q.WtGu + (size_t)l * NE * 2 * DE * D; tdn = q.WtDn + (size_t)l * NE * D * DE;
        it = gw; stride = ngw; ph = 0; ldsb = (unsigned)(uintptr_t)(lds + wave * LDS_PER_WAVE); src = nullptr; dst = nullptr; N = 0;
        if (it < TOTAL) decode();
    }
    __device__ __forceinline__ bool done() const { return it >= TOTAL; }
    __device__ __forceinline__ void collect(bool covered) {
        if (it >= TOTAL || ph != 4) return;
        const int lane = (int)__builtin_amdgcn_mbcnt_hi(~0u, __builtin_amdgcn_mbcnt_lo(~0u, 0u));
        if (!covered) asm volatile("s_waitcnt vmcnt(0)" ::: "memory"); else asm volatile("" ::: "memory");
        const LAS f32x4* sp = (const LAS f32x4*)(ldsb + (unsigned)lane * 16u);
        f32x4 v[8];
#pragma unroll
        for (int i = 0; i < 8; ++i) v[i] = sp[i * 64];
        char* db = (char*)dst + (unsigned)((lane & 7) * (4 * D * 2) + (lane >> 3) * 16);
#pragma unroll
        for (int x = 0; x < 4; ++x) { u32x4 o; o.x = pg8::cvt_pk_bf16(v[0][x], v[1][x]); o.y = pg8::cvt_pk_bf16(v[2][x], v[3][x]); o.z = pg8::cvt_pk_bf16(v[4][x], v[5][x]); o.w = pg8::cvt_pk_bf16(v[6][x], v[7][x]);
            __builtin_nontemporal_store(o, (u32x4*)(db + x * (D * 2))); }
        asm volatile("" ::: "memory");
        it += stride; if (it < TOTAL) decode(); ph = 0;
    }
    __device__ __forceinline__ void issue() {
        if (it >= TOTAL) return;
        if (ph < 2) {
            const int lane = (int)__builtin_amdgcn_mbcnt_hi(~0u, __builtin_amdgcn_mbcnt_lo(~0u, 0u));
            unsigned voff = (unsigned)(lane >> 3) * (unsigned)(N * 32) + (unsigned)(lane & 7) * 16u; const unsigned rstride = (unsigned)(N * 4), m0v = ldsb + 4096u * ph; const float* sb = src + (size_t)(4 * ph) * N; unsigned sv;
            asm volatile("s_mov_b32 %0, m0\n\ts_mov_b32 m0, %2\n\ts_nop 0\n\tglobal_load_lds_dwordx4 %1, %4 nt\n\t"
                         "s_add_u32 m0, m0, 0x400\n\tv_add_u32 %1, %3, %1\n\tglobal_load_lds_dwordx4 %1, %4 nt\n\t"
                         "s_add_u32 m0, m0, 0x400\n\tv_add_u32 %1, %3, %1\n\tglobal_load_lds_dwordx4 %1, %4 nt\n\t"
                         "s_add_u32 m0, m0, 0x400\n\tv_add_u32 %1, %3, %1\n\tglobal_load_lds_dwordx4 %1, %4 nt\n\t"
                         "s_mov_b32 m0, %0" : "=&s"(sv), "+v"(voff) : "s"(m0v), "s"(rstride), "s"(sb) : "memory", "scc");
        }
        ++ph;
    }
    __device__ __forceinline__ void drain() { while (it < TOTAL) { collect(false); issue(); } }
};

struct EpiInprojF32 {
    static constexpr bool PERM = false; float* U;
    __device__ __forceinline__ void operator()(const pg8::f32x4 (&acc)[2][2][4][2], const pg8::Unit& u, int wr, int wc, int fr, int fq) const {
#pragma unroll
        for (int ai = 0; ai < 2; ++ai)
#pragma unroll
            for (int m = 0; m < 4; ++m) { const int row = u.pm * 256 + ai * 128 + wr * 64 + m * 16 + fr;
#pragma unroll
                for (int bj = 0; bj < 2; ++bj)
#pragma unroll
                    for (int n = 0; n < 2; ++n) { const int c = u.pn * 256 + bj * 128 + wc * 32 + n * 16 + 4 * fq; if (c < DIN) *(pg8::f32x4*)(U + (size_t)row * DIN + c) = acc[ai][bj][m][n]; } }
    }
};
struct EpiOutproj {
    static constexpr bool PERM = false; float* X; const float* mod;   const float* xin; const float* cin;
    __device__ __forceinline__ void operator()(const pg8::f32x4 (&acc)[2][2][4][2], const pg8::Unit& u, int wr, int wc, int fr, int fq) const {
#pragma unroll
        for (int ai = 0; ai < 2; ++ai)
#pragma unroll
            for (int m = 0; m < 4; ++m) { const int row = u.pm * 256 + ai * 128 + wr * 64 + m * 16 + fr, b = row / TPB, i = row % TPB; const float* g1 = mod + ((size_t)(i < CTX ? 2 : b) * 6 + 2) * D;
                const float* base = xin ? (i < CTX ? cin + ((size_t)b * CTX + i) * D : xin + ((size_t)b * SEQ + (i - CTX)) * D) : X + (size_t)row * D;
#pragma unroll
                for (int bj = 0; bj < 2; ++bj)
#pragma unroll
                    for (int n = 0; n < 2; ++n) { const int c = u.pn * 256 + bj * 128 + wc * 32 + n * 16 + 4 * fq;
                        const pg8::f32x4 gv = *(const pg8::f32x4*)(g1 + c); *(pg8::f32x4*)(X + (size_t)row * D + c) = *(const pg8::f32x4*)(base + c) + gv * acc[ai][bj][m][n]; } }
    }
};
struct GroupedOrder {
    const int* CNT; const int* LIST; const LAS int* ut;
    __device__ void init(const int* cnt, const int* list, int nN, int G, int c, LAS int* tab) { CNT = cnt; LIST = list; ut = tab + 64;
        __syncthreads();
        if (TIDX == 0) { int a = 0; for (int e = 0; e < NE; ++e) { tab[e] = a; a += (cnt[e] + 255) >> 8; } tab[NE] = a; }
        __syncthreads();
        static_assert(NT < 65536, "row -> token map is 16-bit");
        if (TIDX < 16) { const int total = tab[NE] * nN; const long L = (long)TIDX * G + c; int pm = -1, pn = 0, e = 0, mb = 0;
            if (L < total) { int w = (int)L; { const int nx = pg8::NXCD, qq = total / nx, r = total % nx, xcd = w % nx, off = w / nx; w = (xcd < r ? xcd * (qq + 1) : r * (qq + 1) + (xcd - r) * qq) + off; }
                const int blk = w / nN, ntile = w % nN;
                for (int x = 1; x < NE; ++x) if (tab[x] <= blk) e = x;
                mb = blk - tab[e]; pm = blk; pn = e * nN + ntile; }
            tab[64 + TIDX * 4] = pm; tab[64 + TIDX * 4 + 1] = pn; tab[64 + TIDX * 4 + 2] = e; tab[64 + TIDX * 4 + 3] = mb; }
        __syncthreads(); }
    __device__ bool next(int i, pg8::Unit& u) const { if (i >= 15) return false; const int pm = ut[i * 4]; if (pm < 0) return false; u.pm = pm; u.pn = ut[i * 4 + 1]; u.e = ut[i * 4 + 2]; u.mb = ut[i * 4 + 3]; u.slot = i; return true; }
};
struct GuOrder : GroupedOrder {
    const LAS unsigned short* rowtok;
    __device__ void init_rows(LAS unsigned short* rt) { rowtok = rt;
        for (int x = TIDX; x < 15 * 256; x += 512) { const int i = x >> 8, r = x & 255, pm = ut[i * 4]; unsigned short v = 0;
            if (pm >= 0) { const int e = ut[i * 4 + 2], idx = ut[i * 4 + 3] * 256 + r; if (idx < CNT[e]) v = (unsigned short)(LIST[(size_t)e * NT + idx] >> 2); }
            rt[x] = v; }
        __syncthreads(); }
    __device__ __forceinline__ int arow(const pg8::Unit& u, int r) const { return rowtok[u.slot * 256 + r]; }
};
struct DnOrder : GroupedOrder {
    __device__ __forceinline__ int arow(const pg8::Unit& u, int r) const { return u.pm * 256 + r; }
};
struct EpiGu {
    static constexpr bool PERM = true; bf16* ACT; const float* bgu;   int nN; int probe_skip;
    __device__ __forceinline__ void operator()(const pg8::f32x4 (&acc)[2][2][4][2], const pg8::Unit& u, int wr, int wc, int fr, int fq) const {
        if (probe_skip) return;
        const int ntile = u.pn - u.e * nN, j0 = ntile * 128 + wc * 32 + 8 * fq; const float* bg = bgu + (size_t)u.e * 2 * DE;
        float bgl[8], bli[8];
#pragma unroll
        for (int x = 0; x < 8; ++x) { bgl[x] = bg[j0 + x]; bli[x] = bg[DE + j0 + x]; }
#pragma unroll
        for (int ai = 0; ai < 2; ++ai)
#pragma unroll
            for (int m = 0; m < 4; ++m) { const int row = u.pm * 256 + ai * 128 + wr * 64 + m * 16 + fr; float a[8];
#pragma unroll
                for (int n = 0; n < 2; ++n)
#pragma unroll
                    for (int x = 0; x < 4; ++x) { const float glu = fminf(acc[ai][0][m][n][x] + bgl[4 * n + x], 7.0f), lin = fminf(fmaxf(acc[ai][1][m][n][x] + bli[4 * n + x], -7.0f), 7.0f);
                        a[4 * n + x] = glu * __builtin_amdgcn_rcpf(1.f + __builtin_amdgcn_exp2f(-2.4554669595930157f * glu)) * (lin + 1.f); }
                u32x4 w; w.x = pg8::cvt_pk_bf16(a[0], a[1]); w.y = pg8::cvt_pk_bf16(a[2], a[3]); w.z = pg8::cvt_pk_bf16(a[4], a[5]); w.w = pg8::cvt_pk_bf16(a[6], a[7]);
                *(u32x4*)(ACT + (size_t)row * DE + j0) = w; }
    }
};
struct EpiDownF32 {
    static constexpr bool PERM = false; float* YB; const float* bd;   const float* TOPG; const int* CNT; const int* LIST; int nN;
    __device__ __forceinline__ void operator()(const pg8::f32x4 (&acc)[2][2][4][2], const pg8::Unit& u, int wr, int wc, int fr, int fq) const {
        const int ntile = u.pn - u.e * nN, cnt = CNT[u.e]; const float* b = bd + (size_t)u.e * D;
#pragma unroll
        for (int ai = 0; ai < 2; ++ai)
#pragma unroll
            for (int m = 0; m < 4; ++m) { const int idx = u.mb * 256 + ai * 128 + wr * 64 + m * 16 + fr;
                if (idx < cnt) { const int pr = LIST[(size_t)u.e * NT + idx]; const float g = TOPG[pr];
#pragma unroll
                    for (int bj = 0; bj < 2; ++bj)
#pragma unroll
                        for (int n = 0; n < 2; ++n) { const int c = ntile * 256 + bj * 128 + wc * 32 + n * 16 + 4 * fq; const pg8::f32x4 bv = *(const pg8::f32x4*)(b + c);
                            *(pg8::f32x4*)(YB + (size_t)pr * D + c) = (acc[ai][bj][m][n] + bv) * g; } } }
    }
};

__device__ __forceinline__ void opt_inproj(const P& p, const Q& q, int l, LAS unsigned char* lds, int G, int bid) {
    pg8::Gemm g{q.H16, q.WtIn + (size_t)l * DINP * D, D}; pg8::StaticOrder S; S.init(NT, DINP, G, bid);
    EpiInprojF32 E{p.U}; pg8::gemm_phase<EpiInprojF32, pg8::StaticOrder, true>(lds, g, S, E);
}
struct LatentOrder : pg8::StaticOrder {
    __device__ bool next(int i, pg8::Unit& u) const { if (!pg8::StaticOrder::next(i, u)) return false; constexpr int TL = SEQ / 256, TC = CTX / 256; u.pm = (u.pm / TL) * (TL + TC) + TC + u.pm % TL; return true; }
};
__device__ __forceinline__ void opt_outproj(const P& p, const Q& q, int l, LAS unsigned char* lds, int G, int bid, bool latent_only) {
    pg8::Gemm g{q.Y16, q.WtOut + (size_t)l * D * DMIX, DMIX}; EpiOutproj E{p.X, p.MOD + (size_t)l * 3 * 6 * D, l == 0 ? p.in[I_X] : nullptr, p.in[I_CTX]};
    if (latent_only) { LatentOrder S; S.init(NB * SEQ, D, G, bid); pg8::gemm_phase<EpiOutproj, LatentOrder, true>(lds, g, S, E); }
    else { pg8::StaticOrder S; S.init(NT, D, G, bid); pg8::gemm_phase<EpiOutproj, pg8::StaticOrder, true>(lds, g, S, E); }
}
__device__ __forceinline__ void opt_moe_gu(const P& p, const Q& q, int l, LAS unsigned char* lds, int G, int bid, int probe_skip = 0) {
    pg8::Gemm g{q.H16, q.WtGu + (size_t)l * NE * 2 * DE * D, D}; GuOrder S; S.init(p.CNT, p.LIST, 2 * DE / 256, G, bid, (LAS int*)(lds + pg8::STAGE_BYTES)); S.init_rows((LAS unsigned short*)(lds + pg8::STAGE_BYTES + 1024 + 8192));
    EpiGu E{q.ACT16, p.in[I_BGU] + (size_t)l * NE * 2 * DE, 2 * DE / 256, probe_skip}; pg8::gemm_phase<EpiGu, GuOrder, true>(lds, g, S, E);
}
__device__ __forceinline__ void opt_moe_down(const P& p, const Q& q, int l, LAS unsigned char* lds, int G, int bid) {
    pg8::Gemm g{q.ACT16, q.WtDn + (size_t)l * NE * D * DE, DE}; DnOrder S; S.init(p.CNT, p.LIST, D / 256, G, bid, (LAS int*)(lds + pg8::STAGE_BYTES));
    EpiDownF32 E{p.YB, p.in[I_BD] + (size_t)l * NE * D, p.TOPG, p.CNT, p.LIST, D / 256}; pg8::gemm_phase<EpiDownF32, DnOrder, true>(lds, g, S, E);
}
namespace att {
using bf16x8 = __attribute__((ext_vector_type(8))) short;
using s16x4  = __attribute__((ext_vector_type(4))) short;
using f32x16 = __attribute__((ext_vector_type(16))) float;
using f32x8  = __attribute__((ext_vector_type(8))) float;
using u32x4  = __attribute__((ext_vector_type(4))) unsigned;
constexpr int DK = 96, DV = 64, NW = 8, QBLK = 32, KVBLK = 64;
constexpr float SCALE = 0.10206207261596575f;
#ifndef ATTN_THR
#define ATTN_THR 8.f
#endif
constexpr float THR = ATTN_THR;
#ifndef ATTN_SM_SPLIT
#define ATTN_SM_SPLIT 0
#endif
#ifndef ATTN_NEGM
#define ATTN_NEGM 1
#endif
constexpr float QPRESCALE = ATTN_NEGM ? SCALE * 1.4426950408889634f : 1.f;
constexpr int KROW = 208;
constexpr int SHM_K = KVBLK * KROW, SHM_V = KVBLK * DV * 2;
#ifndef ATTN_STAG
#define ATTN_STAG 0
#endif
#ifndef ATTN_LAG2
#define ATTN_LAG2 0
#endif
constexpr int NRING = (ATTN_LAG2 || ATTN_STAG) ? 4 : 3;
constexpr int SHM_Q = ATTN_STAG ? 256 * KROW : 0;
constexpr int SHM_ATTN = NRING * SHM_V + NRING * SHM_K + NW * 64 * 4 + SHM_Q;
#define KSWZ(row, colB) ((row) * KROW + (colB))
#define SBAR() __builtin_amdgcn_sched_barrier(0)
__device__ __forceinline__ int crow(int r, int hi) { return (r & 3) + 8 * (r >> 2) + 4 * hi; }
typedef float f32x2_t __attribute__((ext_vector_type(2))); typedef __bf16 bf16x2_t __attribute__((ext_vector_type(2)));
__device__ __forceinline__ unsigned cvtpk(float lo, float hi) { f32x2_t v = {lo, hi}; bf16x2_t b = __builtin_convertvector(v, bf16x2_t); return __builtin_bit_cast(unsigned, b); }
__device__ __forceinline__ bf16x8 tobf(f32x8 x) { u32x4 w = {cvtpk(x[0], x[1]), cvtpk(x[2], x[3]), cvtpk(x[4], x[5]), cvtpk(x[6], x[7])}; return *reinterpret_cast<bf16x8*>(&w); }

#if ATTN_NEGM
template <bool FIRST = false>
__device__ __forceinline__ void partialSM_n(f32x16& p0, f32x16& p1, f32x16& negm, float& alpha) {
  constexpr float THR2 = THR * 1.4426950408889634f;
  float pmax = p0[0];
#pragma unroll
  for (int r = 1; r < 16; ++r) pmax = fmaxf(pmax, p0[r]);
#pragma unroll
  for (int r = 0; r < 16; ++r) pmax = fmaxf(pmax, p1[r]);
  { auto rr = __builtin_amdgcn_permlane32_swap(__float_as_uint(pmax), __float_as_uint(pmax), false, false);
    pmax = fmaxf(__uint_as_float(rr[0]), __uint_as_float(rr[1])); }
  if (!FIRST && __builtin_expect(__all(pmax <= THR2), 1)) { alpha = 1.f; }
  else { const float dl = FIRST ? pmax : fmaxf(pmax, 0.f); alpha = FIRST ? 1.f : __builtin_amdgcn_exp2f(-dl);
#pragma unroll
    for (int r = 0; r < 16; ++r) { p0[r] -= dl; p1[r] -= dl; negm[r] -= dl; } }
}
__device__ __forceinline__ void finishSM_n(f32x16& p0, f32x16& p1, float alpha, float& l_reg, bf16x8& pa0, bf16x8& pa1, bf16x8& pa2, bf16x8& pa3) {
#pragma unroll
  for (int r = 0; r < 16; ++r) { p0[r] = __builtin_amdgcn_exp2f(p0[r]); p1[r] = __builtin_amdgcn_exp2f(p1[r]); }
  float ps = 0;
#pragma unroll
  for (int r = 0; r < 16; ++r) ps += p0[r];
#pragma unroll
  for (int r = 0; r < 16; ++r) ps += p1[r];
  { auto rr = __builtin_amdgcn_permlane32_swap(__float_as_uint(ps), __float_as_uint(ps), false, false);
    ps = __uint_as_float(rr[0]) + __uint_as_float(rr[1]); }
  l_reg = l_reg * alpha + ps;
#define PK4(P, BASE, OUT) do { unsigned a0 = cvtpk(P[BASE + 0], P[BASE + 1]), a1 = cvtpk(P[BASE + 2], P[BASE + 3]);   \
    unsigned b0 = cvtpk(P[BASE + 4], P[BASE + 5]), b1 = cvtpk(P[BASE + 6], P[BASE + 7]);                              \
    auto r0 = __builtin_amdgcn_permlane32_swap(a0, b0, false, false); auto r1 = __builtin_amdgcn_permlane32_swap(a1, b1, false, false); \
    u32x4 w = {r0[0], r1[0], r0[1], r1[1]}; OUT = *reinterpret_cast<bf16x8*>(&w); } while (0)
  PK4(p0, 0, pa0); PK4(p0, 8, pa1); PK4(p1, 0, pa2); PK4(p1, 8, pa3);
#undef PK4
}
__device__ __forceinline__ void qkt_n(f32x16& p0, f32x16& p1, const char* Ks, const bf16x8* qr, const f32x16& negm, int r32, int hi) {
#pragma unroll
  for (int d0 = 0; d0 < DK / 16; ++d0) { const int cb = (d0 * 16 + hi * 8) * 2;
    const bf16x8 b0 = *reinterpret_cast<const bf16x8*>(Ks + ((r32) * KROW + cb));
    const bf16x8 b1 = *reinterpret_cast<const bf16x8*>(Ks + ((32 + r32) * KROW + cb));
#if ATTN_STAG
    const bf16x8 qf = *reinterpret_cast<const bf16x8*>((const char*)qr + d0 * 32);
#else
    const bf16x8 qf = qr[d0];
#endif
    if (d0 == 0) { p0 = __builtin_amdgcn_mfma_f32_32x32x16_bf16(b0, qf, negm, 0, 0, 0); p1 = __builtin_amdgcn_mfma_f32_32x32x16_bf16(b1, qf, negm, 0, 0, 0); }
    else { p0 = __builtin_amdgcn_mfma_f32_32x32x16_bf16(b0, qf, p0, 0, 0, 0); p1 = __builtin_amdgcn_mfma_f32_32x32x16_bf16(b1, qf, p1, 0, 0, 0); } }
}
#endif
__device__ __forceinline__ void partialSM(f32x16& p0, f32x16& p1, float& m_reg, float& mn, float& alpha) {
  constexpr float C = SCALE * 1.4426950408889634f;
  float pmax = p0[0];
#pragma unroll
  for (int r = 1; r < 16; ++r) pmax = fmaxf(pmax, p0[r]);
#pragma unroll
  for (int r = 0; r < 16; ++r) pmax = fmaxf(pmax, p1[r]);
  { auto rr = __builtin_amdgcn_permlane32_swap(__float_as_uint(pmax), __float_as_uint(pmax), false, false);
    pmax = fmaxf(__uint_as_float(rr[0]), __uint_as_float(rr[1])); }
#if ATTN_SM_SPLIT == 2
  { const bool keep = __all(pmax - m_reg <= THR / SCALE); mn = keep ? m_reg : fmaxf(m_reg, pmax); alpha = __builtin_amdgcn_exp2f((m_reg - mn) * C); m_reg = mn;
    const float mnC = -mn * C;
#pragma unroll
    for (int r = 0; r < 16; ++r) { p0[r] = __builtin_amdgcn_exp2f(fmaf(p0[r], C, mnC)); p1[r] = __builtin_amdgcn_exp2f(fmaf(p1[r], C, mnC)); } }
  return;
#endif
  if (__builtin_expect(__all(pmax - m_reg <= THR / SCALE), 1)) { mn = m_reg; alpha = 1.f; }
  else { mn = fmaxf(m_reg, pmax); alpha = __builtin_amdgcn_exp2f((m_reg - mn) * C); m_reg = mn; }
#if ATTN_SM_SPLIT == 1
  const float mnC = -mn * C;
#pragma unroll
  for (int r = 0; r < 16; ++r) p0[r] = fmaf(p0[r], C, mnC);
#pragma unroll
  for (int r = 0; r < 16; ++r) p1[r] = fmaf(p1[r], C, mnC);
#pragma unroll
  for (int r = 0; r < 16; ++r) p0[r] = __builtin_amdgcn_exp2f(p0[r]);
#endif
}
__device__ __forceinline__ void finishSM(f32x16& p0, f32x16& p1, float mn, float alpha, float& l_reg, bf16x8& pa0, bf16x8& pa1, bf16x8& pa2, bf16x8& pa3) {
#if ATTN_SM_SPLIT == 1
#pragma unroll
  for (int r = 0; r < 16; ++r) p1[r] = __builtin_amdgcn_exp2f(p1[r]);
#elif ATTN_SM_SPLIT == 2
  (void)mn;
#else
  { constexpr float C = SCALE * 1.4426950408889634f; const float mnC = -mn * C;
#pragma unroll
    for (int r = 0; r < 16; ++r) { p0[r] = __builtin_amdgcn_exp2f(fmaf(p0[r], C, mnC)); p1[r] = __builtin_amdgcn_exp2f(fmaf(p1[r], C, mnC)); } }
#endif
  float ps = 0;
#pragma unroll
  for (int r = 0; r < 16; ++r) ps += p0[r];
#pragma unroll
  for (int r = 0; r < 16; ++r) ps += p1[r];
  { auto rr = __builtin_amdgcn_permlane32_swap(__float_as_uint(ps), __float_as_uint(ps), false, false);
    ps = __uint_as_float(rr[0]) + __uint_as_float(rr[1]); }
  l_reg = l_reg * alpha + ps;
#define PK4(P, BASE, OUT) do { unsigned a0 = cvtpk(P[BASE + 0], P[BASE + 1]), a1 = cvtpk(P[BASE + 2], P[BASE + 3]);   \
    unsigned b0 = cvtpk(P[BASE + 4], P[BASE + 5]), b1 = cvtpk(P[BASE + 6], P[BASE + 7]);                              \
    auto r0 = __builtin_amdgcn_permlane32_swap(a0, b0, false, false); auto r1 = __builtin_amdgcn_permlane32_swap(a1, b1, false, false); \
    u32x4 w = {r0[0], r1[0], r0[1], r1[1]}; OUT = *reinterpret_cast<bf16x8*>(&w); } while (0)
  PK4(p0, 0, pa0); PK4(p0, 8, pa1); PK4(p1, 0, pa2); PK4(p1, 8, pa3);
#undef PK4
}
__device__ __forceinline__ void qkt(f32x16& p0, f32x16& p1, const char* Ks, const bf16x8* qr, int r32, int hi) {
  p0 = f32x16{}; p1 = f32x16{};
#pragma unroll
  for (int d0 = 0; d0 < DK / 16; ++d0) { const int cb = (d0 * 16 + hi * 8) * 2;
    const bf16x8 b0 = *reinterpret_cast<const bf16x8*>(Ks + KSWZ(r32, cb));
    const bf16x8 b1 = *reinterpret_cast<const bf16x8*>(Ks + KSWZ(32 + r32, cb));
    p0 = __builtin_amdgcn_mfma_f32_32x32x16_bf16(b0, qr[d0], p0, 0, 0, 0);
    p1 = __builtin_amdgcn_mfma_f32_32x32x16_bf16(b1, qr[d0], p1, 0, 0, 0); }
}
__device__ __forceinline__ int v_st(int k, int c) { const int kk = (k & ~0xC) | ((k & 4) << 1) | ((k & 8) >> 1); return ((kk >> 3) * 2 + (c >> 5)) * 512 + ((kk & 7) * 32 + (c & 31)) * 2; }
__device__ __forceinline__ int v_rd_base(int lane) { return ((lane & 3) << 3) | (((lane >> 2) & 3) << 6) | (((lane >> 4) & 1) << 5) | (((lane >> 5) & 1) << 8); }
constexpr int v_rd_off(int d0, int ks, int half) { return d0 * 512 + ks * 2048 + half * 1024; }
template <int OFF> __device__ __forceinline__ s16x4 tr_read(int vb) {
  s16x4 r; asm volatile("ds_read_b64_tr_b16 %0, %1 offset:%2" : "=&v"(r) : "v"(vb), "i"(OFF) : "memory"); return r;
}
template <int D0> __device__ __forceinline__ void pv_one(f32x16& od, int vb, bf16x8 pa0, bf16x8 pa1, bf16x8 pa2, bf16x8 pa3) {
  const s16x4 l0 = tr_read<v_rd_off(D0, 0, 0)>(vb), h0 = tr_read<v_rd_off(D0, 0, 1)>(vb), l1 = tr_read<v_rd_off(D0, 1, 0)>(vb), h1 = tr_read<v_rd_off(D0, 1, 1)>(vb);
  const s16x4 l2 = tr_read<v_rd_off(D0, 2, 0)>(vb), h2 = tr_read<v_rd_off(D0, 2, 1)>(vb), l3 = tr_read<v_rd_off(D0, 3, 0)>(vb), h3 = tr_read<v_rd_off(D0, 3, 1)>(vb);
  asm volatile("s_waitcnt lgkmcnt(0)" ::: "memory"); SBAR();
#define PK(L, H) (bf16x8){L[0], L[1], L[2], L[3], H[0], H[1], H[2], H[3]}
  od = __builtin_amdgcn_mfma_f32_32x32x16_bf16(pa0, PK(l0, h0), od, 0, 0, 0);
  od = __builtin_amdgcn_mfma_f32_32x32x16_bf16(pa1, PK(l1, h1), od, 0, 0, 0);
  od = __builtin_amdgcn_mfma_f32_32x32x16_bf16(pa2, PK(l2, h2), od, 0, 0, 0);
  od = __builtin_amdgcn_mfma_f32_32x32x16_bf16(pa3, PK(l3, h3), od, 0, 0, 0);
#undef PK
}
__device__ __forceinline__ void pv_d0(f32x16* o, int vb, bf16x8 pa0, bf16x8 pa1, bf16x8 pa2, bf16x8 pa3) {
  pv_one<0>(o[0], vb, pa0, pa1, pa2, pa3); pv_one<1>(o[1], vb, pa0, pa1, pa2, pa3);
}

__device__ __forceinline__ void pv_sm(f32x16* o, int vb, bf16x8 pa0, bf16x8 pa1, bf16x8 pa2, bf16x8 pa3, f32x16& p0, f32x16& p1, float& m_reg, float& mn, float& alpha) {
  constexpr float C = SCALE * 1.4426950408889634f;
  const s16x4 l00 = tr_read<v_rd_off(0, 0, 0)>(vb), h00 = tr_read<v_rd_off(0, 0, 1)>(vb), l10 = tr_read<v_rd_off(1, 0, 0)>(vb), h10 = tr_read<v_rd_off(1, 0, 1)>(vb);
  const s16x4 l01 = tr_read<v_rd_off(0, 1, 0)>(vb), h01 = tr_read<v_rd_off(0, 1, 1)>(vb), l11 = tr_read<v_rd_off(1, 1, 0)>(vb), h11 = tr_read<v_rd_off(1, 1, 1)>(vb);
  const s16x4 l02 = tr_read<v_rd_off(0, 2, 0)>(vb), h02 = tr_read<v_rd_off(0, 2, 1)>(vb), l12 = tr_read<v_rd_off(1, 2, 0)>(vb), h12 = tr_read<v_rd_off(1, 2, 1)>(vb);
  const s16x4 l03 = tr_read<v_rd_off(0, 3, 0)>(vb), h03 = tr_read<v_rd_off(0, 3, 1)>(vb), l13 = tr_read<v_rd_off(1, 3, 0)>(vb), h13 = tr_read<v_rd_off(1, 3, 1)>(vb);
  float pmax = p0[0];
#pragma unroll
  for (int r = 1; r < 16; ++r) pmax = fmaxf(pmax, p0[r]);
#pragma unroll
  for (int r = 0; r < 16; ++r) pmax = fmaxf(pmax, p1[r]);
  { auto rr = __builtin_amdgcn_permlane32_swap(__float_as_uint(pmax), __float_as_uint(pmax), false, false);
    pmax = fmaxf(__uint_as_float(rr[0]), __uint_as_float(rr[1])); }
  const bool keep = __all(pmax - m_reg <= THR / SCALE); mn = keep ? m_reg : fmaxf(m_reg, pmax); alpha = __builtin_amdgcn_exp2f((m_reg - mn) * C); m_reg = mn;
  const float mnC = -mn * C;
  asm volatile("s_waitcnt lgkmcnt(0)" ::: "memory"); SBAR();
#define PK(L, H) (bf16x8){L[0], L[1], L[2], L[3], H[0], H[1], H[2], H[3]}
#define EX4(P, B) do { P[B] = __builtin_amdgcn_exp2f(fmaf(P[B], C, mnC)); P[B + 1] = __builtin_amdgcn_exp2f(fmaf(P[B + 1], C, mnC)); P[B + 2] = __builtin_amdgcn_exp2f(fmaf(P[B + 2], C, mnC)); P[B + 3] = __builtin_amdgcn_exp2f(fmaf(P[B + 3], C, mnC)); } while (0)
  o[0] = __builtin_amdgcn_mfma_f32_32x32x16_bf16(pa0, PK(l00, h00), o[0], 0, 0, 0); EX4(p0, 0); SBAR();
  o[1] = __builtin_amdgcn_mfma_f32_32x32x16_bf16(pa0, PK(l10, h10), o[1], 0, 0, 0); EX4(p0, 4); SBAR();
  o[0] = __builtin_amdgcn_mfma_f32_32x32x16_bf16(pa1, PK(l01, h01), o[0], 0, 0, 0); EX4(p0, 8); SBAR();
  o[1] = __builtin_amdgcn_mfma_f32_32x32x16_bf16(pa1, PK(l11, h11), o[1], 0, 0, 0); EX4(p0, 12); SBAR();
  o[0] = __builtin_amdgcn_mfma_f32_32x32x16_bf16(pa2, PK(l02, h02), o[0], 0, 0, 0); EX4(p1, 0); SBAR();
  o[1] = __builtin_amdgcn_mfma_f32_32x32x16_bf16(pa2, PK(l12, h12), o[1], 0, 0, 0); EX4(p1, 4); SBAR();
  o[0] = __builtin_amdgcn_mfma_f32_32x32x16_bf16(pa3, PK(l03, h03), o[0], 0, 0, 0); EX4(p1, 8); SBAR();
  o[1] = __builtin_amdgcn_mfma_f32_32x32x16_bf16(pa3, PK(l13, h13), o[1], 0, 0, 0); EX4(p1, 12); SBAR();
#undef PK
#undef EX4
}

struct NoBgWork { __device__ __forceinline__ void collect(bool) {} __device__ __forceinline__ void issue() {} };
template <class TQ, class Out, int VAR = 0, class BG = NoBgWork>
__device__ __forceinline__ void attn_unit(const TQ* Qb, int ldq, const unsigned short* Kh, const unsigned short* Vh, int seq, char* lds, const Out& OUT, BG&& bg = BG()) {
  int tid_ = TIDX; asm volatile("" : "+v"(tid_));
  const int tid = tid_, wid = tid >> 6, lane = tid & 63, r32 = lane & 31, hi = lane >> 5;
  char* V_lds = lds; char* K_lds = lds + NRING * SHM_V;
  float* ws = (float*)(lds + NRING * SHM_V + NRING * SHM_K) + wid * 64; float* li_l = ws; float* al_l = ws + 32;
  float m_reg = -1e30f, l_reg = 0; f32x16 o[2] = {}; f32x16 negm = {}; (void)negm;
#if ATTN_STAG
  char* Q_lds = lds + NRING * SHM_V + NRING * SHM_K + NW * 64 * 4;
  { static_assert(sizeof(TQ) == 2, "the stagger variant takes bf16 q rows");
#pragma unroll
    for (int k = 0; k < 6; ++k) { const int x = tid + k * 512, row = x / 12, c16 = x % 12; *(bf16x8*)(Q_lds + row * KROW + c16 * 16) = *reinterpret_cast<const bf16x8*>(Qb + (long)row * ldq + c16 * 8); } }
  const bf16x8* qr = reinterpret_cast<const bf16x8*>(Q_lds + (wid * QBLK + r32) * KROW + hi * 16);
#else
  bf16x8 qr[DK / 16];
  { const TQ* Qw = Qb + (long)(wid * QBLK + r32) * ldq + hi * 8;
#pragma unroll
    for (int d0 = 0; d0 < DK / 16; ++d0) {
      if constexpr (sizeof(TQ) == 4) qr[d0] = tobf(*reinterpret_cast<const f32x8*>(Qw + d0 * 16)); else qr[d0] = *reinterpret_cast<const bf16x8*>(Qw + d0 * 16); } }
#endif
  const int kc0 = tid, kc1 = 512 + tid; const bool two = tid < 256;
  const int kst0 = KSWZ(kc0 / 12, (kc0 % 12) * 16), kst1 = KSWZ(kc1 / 12, (kc1 % 12) * 16), vst = v_st(tid >> 3, (tid & 7) * 8);
  const int vb0 = (int)(uintptr_t)V_lds + v_rd_base(lane);
  struct { bf16x8 v, k0, k1; } sr_[ATTN_STAG ? 1 : 2];
#define SLOAD(i, key0) do { sr_[i].v = *reinterpret_cast<const bf16x8*>(Vh + (long)(key0) * DV + tid * 8); sr_[i].k0 = *reinterpret_cast<const bf16x8*>(Kh + (long)(key0) * DK + kc0 * 8); \
    if (two) sr_[i].k1 = *reinterpret_cast<const bf16x8*>(Kh + (long)(key0) * DK + kc1 * 8); } while (0)
#define SWRITE(b, i) do { *(bf16x8*)(V_lds + (b) * SHM_V + vst) = sr_[i].v; *(bf16x8*)(K_lds + (b) * SHM_K + kst0) = sr_[i].k0; if (two) *(bf16x8*)(K_lds + (b) * SHM_K + kst1) = sr_[i].k1; } while (0)
#define RESC(a) do { if (__any((a) < 1.f)) { if (hi == 0) al_l[r32] = (a); asm volatile("s_waitcnt lgkmcnt(0)" ::: "memory"); \
    _Pragma("unroll") for (int d = 0; d < 2; ++d) _Pragma("unroll") for (int r = 0; r < 16; ++r) o[d][r] *= al_l[crow(r, hi)]; } } while (0)
  f32x16 pA0 = {}, pA1 = {}, pB0 = {}, pB1 = {}; float mnA, mnB, alA, alB; bf16x8 pa0, pa1, pa2, pa3; const int NT = seq / KVBLK;
  constexpr int SE = 0, SO = 1;
#if ATTN_NEGM
#define PSM(p0_, p1_, m_, mn_, al_) do { (void)mn_; partialSM_n(p0_, p1_, negm, al_); } while (0)
#else
#define PSM(p0_, p1_, m_, mn_, al_) do { if constexpr (VAR == 1) { mn_ = 0.f; al_ = 1.f; } else partialSM(p0_, p1_, m_, mn_, al_); } while (0)
#endif
#define FSM(p0_, p1_, mn_, al_, l_, a0_, a1_, a2_, a3_) do { if constexpr (VAR == 1) { u32x4 w0_ = {cvtpk(p0_[0], p0_[1]), cvtpk(p0_[2], p0_[3]), cvtpk(p0_[4], p0_[5]), cvtpk(p0_[6], p0_[7])}; a0_ = *reinterpret_cast<bf16x8*>(&w0_); \
      u32x4 w1_ = {cvtpk(p0_[8], p0_[9]), cvtpk(p0_[10], p0_[11]), cvtpk(p0_[12], p0_[13]), cvtpk(p0_[14], p0_[15])}; a1_ = *reinterpret_cast<bf16x8*>(&w1_); \
      u32x4 w2_ = {cvtpk(p1_[0], p1_[1]), cvtpk(p1_[2], p1_[3]), cvtpk(p1_[4], p1_[5]), cvtpk(p1_[6], p1_[7])}; a2_ = *reinterpret_cast<bf16x8*>(&w2_); \
      u32x4 w3_ = {cvtpk(p1_[8], p1_[9]), cvtpk(p1_[10], p1_[11]), cvtpk(p1_[12], p1_[13]), cvtpk(p1_[14], p1_[15])}; a3_ = *reinterpret_cast<bf16x8*>(&w3_); } else { if constexpr (ATTN_NEGM != 0) finishSM_n(p0_, p1_, al_, l_, a0_, a1_, a2_, a3_); else finishSM(p0_, p1_, mn_, al_, l_, a0_, a1_, a2_, a3_); } } while (0)
#define PVSM(o_, vb_, a0_, a1_, a2_, a3_, p0_, p1_, m_, mn_, al_) do { if constexpr (VAR == 0 && ATTN_SM_SPLIT == 2) pv_sm(o_, vb_, a0_, a1_, a2_, a3_, p0_, p1_, m_, mn_, al_); else { PVD(o_, vb_, a0_, a1_, a2_, a3_); PSM(p0_, p1_, m_, mn_, al_); } } while (0)
#define PVD(o_, vb_, a0_, a1_, a2_, a3_) do { if constexpr (VAR == 2) { asm volatile("" : "+v"(o_[0]), "+v"(o_[1]) : "v"(a0_), "v"(a1_), "v"(a2_), "v"(a3_)); } else pv_d0(o_, vb_, a0_, a1_, a2_, a3_); } while (0)
#define QKT(p0_, p1_, K_, q_, r_, h_) do { if constexpr (VAR == 5) { asm volatile("" : "+v"(p0_), "+v"(p1_)); } else { if constexpr (ATTN_NEGM != 0) qkt_n(p0_, p1_, K_, q_, negm, r_, h_); else qkt(p0_, p1_, K_, q_, r_, h_); } } while (0)
#define LSLOAD(i_, k_) do { if constexpr (VAR != 3) SLOAD(i_, k_); } while (0)
#define LSWRITE(b_, i_) do { if constexpr (VAR != 3) SWRITE(b_, i_); } while (0)
#define LSYNC() do { if constexpr (VAR != 4) __syncthreads(); } while (0)
#if ATTN_STAG
  const bool lead = __builtin_amdgcn_readfirstlane(wid) < 4;
  SLOAD(SE, 0); asm volatile("s_waitcnt vmcnt(0)" ::: "memory"); SWRITE(0, SE); __syncthreads();
  QKT(pA0, pA1, K_lds, qr, r32, hi);
  SLOAD(SE, KVBLK);
  if (lead) partialSM_n<true>(pA0, pA1, negm, alA);
  SWRITE(1, SE); __syncthreads();
  LSLOAD(SE, 2 * KVBLK);
  if (lead) { SBAR(); QKT(pB0, pB1, K_lds + 1 * SHM_K, qr, r32, hi); FSM(pA0, pA1, mnA, alA, l_reg, pa0, pa1, pa2, pa3); SBAR();
      PVD(o, vb0 + 0 * SHM_V, pa0, pa1, pa2, pa3); PSM(pB0, pB1, m_reg, mnB, alB); }
  else { partialSM_n<true>(pA0, pA1, negm, alA);
      SBAR(); QKT(pB0, pB1, K_lds + 1 * SHM_K, qr, r32, hi); FSM(pA0, pA1, mnA, alA, l_reg, pa0, pa1, pa2, pa3); SBAR(); }
  LSWRITE(2, SE); if (lead) RESC(alB); LSYNC();
  for (int j = 2; j < NT; j += 2) {
    if (j + 1 < NT) LSLOAD(SE, (j + 1) * KVBLK);
    if (lead) { SBAR(); QKT(pA0, pA1, K_lds + (j & 3) * SHM_K, qr, r32, hi); FSM(pB0, pB1, mnB, alB, l_reg, pa0, pa1, pa2, pa3); SBAR();
        PVD(o, vb0 + ((j - 1) & 3) * SHM_V, pa0, pa1, pa2, pa3); PSM(pA0, pA1, m_reg, mnA, alA); }
    else { PVD(o, vb0 + ((j - 2) & 3) * SHM_V, pa0, pa1, pa2, pa3); PSM(pB0, pB1, m_reg, mnB, alB); RESC(alB);
        SBAR(); QKT(pA0, pA1, K_lds + (j & 3) * SHM_K, qr, r32, hi); FSM(pB0, pB1, mnB, alB, l_reg, pa0, pa1, pa2, pa3); SBAR(); }
    if (j + 1 < NT) LSWRITE((j + 1) & 3, SE);
    if (lead) RESC(alA);
    LSYNC();
    if (j + 2 < NT) LSLOAD(SE, (j + 2) * KVBLK);
    if (lead) { SBAR(); QKT(pB0, pB1, K_lds + ((j + 1) & 3) * SHM_K, qr, r32, hi); FSM(pA0, pA1, mnA, alA, l_reg, pa0, pa1, pa2, pa3); SBAR();
        PVD(o, vb0 + (j & 3) * SHM_V, pa0, pa1, pa2, pa3); PSM(pB0, pB1, m_reg, mnB, alB); }
    else { PVD(o, vb0 + ((j - 1) & 3) * SHM_V, pa0, pa1, pa2, pa3); PSM(pA0, pA1, m_reg, mnA, alA); RESC(alA);
        SBAR(); QKT(pB0, pB1, K_lds + ((j + 1) & 3) * SHM_K, qr, r32, hi); FSM(pA0, pA1, mnA, alA, l_reg, pa0, pa1, pa2, pa3); SBAR(); }
    if (j + 2 < NT) LSWRITE((j + 2) & 3, SE);
    if (lead) RESC(alB);
    LSYNC();
  }
  if (!lead) { PVD(o, vb0 + ((NT - 2) & 3) * SHM_V, pa0, pa1, pa2, pa3); PSM(pB0, pB1, m_reg, mnB, alB); RESC(alB); }
  FSM(pB0, pB1, mnB, alB, l_reg, pa0, pa1, pa2, pa3); SBAR();
  PVD(o, vb0 + ((NT - 1) & 3) * SHM_V, pa0, pa1, pa2, pa3);
#elif ATTN_LAG2
  bf16x8 pb0, pb1, pb2, pb3;
  SLOAD(SE, 0); asm volatile("s_waitcnt vmcnt(0)" ::: "memory"); SWRITE(0, SE); __syncthreads();
  QKT(pA0, pA1, K_lds, qr, r32, hi);
#if ATTN_NEGM
  partialSM_n<true>(pA0, pA1, negm, alA);
#else
  PSM(pA0, pA1, m_reg, mnA, alA);
#endif
  SLOAD(SO, KVBLK); if (2 < NT) SLOAD(SE, 2 * KVBLK);
  SWRITE(1, SO); __syncthreads();
  SBAR(); QKT(pB0, pB1, K_lds + 1 * SHM_K, qr, r32, hi);
  FSM(pA0, pA1, mnA, alA, l_reg, pb0, pb1, pb2, pb3); SBAR();
  if (3 < NT) LSLOAD(SO, 3 * KVBLK); SBAR();
  PSM(pB0, pB1, m_reg, mnB, alB);
  LSWRITE(2, SE); LSYNC();
  for (int j = 2; j < NT; j += 2) {
    SBAR(); QKT(pA0, pA1, K_lds + (j & 3) * SHM_K, qr, r32, hi);
    FSM(pB0, pB1, mnB, alB, l_reg, pa0, pa1, pa2, pa3);
    PVD(o, vb0 + ((j - 2) & 3) * SHM_V, pb0, pb1, pb2, pb3); SBAR();
    if (j + 2 < NT) LSLOAD(SE, (j + 2) * KVBLK); SBAR();
    RESC(alB); PSM(pA0, pA1, m_reg, mnA, alA);
    if (j + 1 < NT) LSWRITE((j + 1) & 3, SO);
    LSYNC();
    SBAR(); QKT(pB0, pB1, K_lds + ((j + 1) & 3) * SHM_K, qr, r32, hi);
    FSM(pA0, pA1, mnA, alA, l_reg, pb0, pb1, pb2, pb3);
    PVD(o, vb0 + ((j - 1) & 3) * SHM_V, pa0, pa1, pa2, pa3); SBAR();
    if (j + 3 < NT) LSLOAD(SO, (j + 3) * KVBLK); SBAR();
    RESC(alA); PSM(pB0, pB1, m_reg, mnB, alB);
    if (j + 2 < NT) LSWRITE((j + 2) & 3, SE);
    LSYNC();
  }
  PVD(o, vb0 + ((NT - 2) & 3) * SHM_V, pb0, pb1, pb2, pb3);
  RESC(alB);
  FSM(pB0, pB1, mnB, alB, l_reg, pa0, pa1, pa2, pa3); SBAR();
  PVD(o, vb0 + ((NT - 1) & 3) * SHM_V, pa0, pa1, pa2, pa3);
#else
  int bp = 0, bc = 1, bn = 2;
#define ROT3() do { const int t_ = bp; bp = bc; bc = bn; bn = t_; } while (0)
  SLOAD(SE, 0); asm volatile("s_waitcnt vmcnt(0)" ::: "memory"); SWRITE(0, SE); __syncthreads();
  QKT(pA0, pA1, K_lds, qr, r32, hi);
#if ATTN_NEGM
  partialSM_n<true>(pA0, pA1, negm, alA);
#else
  PSM(pA0, pA1, m_reg, mnA, alA);
#endif
  SLOAD(SO, KVBLK); if (2 < NT) SLOAD(SE, 2 * KVBLK);
  SWRITE(1, SO); __syncthreads();
  for (int j = 1; j + 1 < NT; j += 2) {
    SBAR(); QKT(pB0, pB1, K_lds + bc * SHM_K, qr, r32, hi);
    FSM(pA0, pA1, mnA, alA, l_reg, pa0, pa1, pa2, pa3); SBAR();
    LSLOAD(SO, (j + 2) * KVBLK); SBAR();
    bg.issue(); SBAR();
    PVSM(o, vb0 + bp * SHM_V, pa0, pa1, pa2, pa3, pB0, pB1, m_reg, mnB, alB);
    LSWRITE(bn, SE); SBAR();
    bg.collect(true); SBAR();
    RESC(alB); LSYNC(); ROT3();
    SBAR(); QKT(pA0, pA1, K_lds + bc * SHM_K, qr, r32, hi);
    FSM(pB0, pB1, mnB, alB, l_reg, pa0, pa1, pa2, pa3); SBAR();
    if (j + 3 < NT) LSLOAD(SE, (j + 3) * KVBLK); SBAR();
    bg.issue(); SBAR();
    PVSM(o, vb0 + bp * SHM_V, pa0, pa1, pa2, pa3, pA0, pA1, m_reg, mnA, alA);
    LSWRITE(bn, SO); SBAR();
    bg.collect(true); SBAR();
    RESC(alA); LSYNC(); ROT3();
  }
  SBAR(); QKT(pB0, pB1, K_lds + bc * SHM_K, qr, r32, hi);
  FSM(pA0, pA1, mnA, alA, l_reg, pa0, pa1, pa2, pa3); SBAR();
  PVSM(o, vb0 + bp * SHM_V, pa0, pa1, pa2, pa3, pB0, pB1, m_reg, mnB, alB);
  RESC(alB);
  FSM(pB0, pB1, mnB, alB, l_reg, pa0, pa1, pa2, pa3); SBAR();
  PVD(o, vb0 + bc * SHM_V, pa0, pa1, pa2, pa3);
#undef ROT3
#endif
  if (hi == 0) li_l[r32] = l_reg; asm volatile("s_waitcnt lgkmcnt(0)" ::: "memory");
  float rli[16];
#pragma unroll
  for (int r = 0; r < 16; ++r) rli[r] = __builtin_amdgcn_rcpf(li_l[crow(r, hi)]);
#pragma unroll
  for (int r = 0; r < 16; ++r) { const int orow = wid * QBLK + crow(r, hi);
#pragma unroll
    for (int d0 = 0; d0 < 2; ++d0) OUT(orow, d0 * 32 + r32, o[d0][r] * rli[r]); }
  __syncthreads();
#undef SLOAD
#undef SWRITE
#undef RESC
#undef PSM
#undef PVSM
#undef FSM
#undef PVD
#undef QKT
#undef LSLOAD
#undef LSWRITE
#undef LSYNC
}
#undef KSWZ
#undef SBAR
}
struct Q2 {
    bf16* U16;
    bf16 *WtL;
    bf16 *WtM;
    bf16 *WtG;
    float *LSL;
    bf16 *HLOC, *PCUM;
    float *SA, *SB;
    bf16 *QN16, *KVN16;
    bf16 *Q16;
    bf16 *WtKvbP;
    bf16 *XCM16, *QKV16;
    float *GATES;
    float *CLOC, *NLOC, *MLB;
    bf16 *CST; float *NST, *MST;
    bf16 *YB16;
    float *GLIST;
};
constexpr int NCH = TPB / 128;
constexpr int NCH_CTX = CTX / 128;

__device__ __forceinline__ float wave_sum(float v) {
#pragma unroll
    for (int o = 1; o < 64; o <<= 1) v += __shfl_xor(v, o);
    return v;
}
__device__ __forceinline__ float fast_sigmoid(float x) { return __builtin_amdgcn_rcpf(1.f + __expf(-x)); }
__device__ __forceinline__ float fast_silu(float x) { return x * fast_sigmoid(x); }
__device__ __forceinline__ float fast_gelu(float x) { const float u = 0.7978845608028654f * (x + 0.044715f * x * x * x); return x * fast_sigmoid(2.f * u); }

struct EpiU16 {
    static constexpr bool PERM = true; bf16* U;
    __device__ __forceinline__ void operator()(const pg8::f32x4 (&acc)[2][2][4][2], const pg8::Unit& u, int wr, int wc, int fr, int fq) const {
#pragma unroll
        for (int ai = 0; ai < 2; ++ai)
#pragma unroll
            for (int m = 0; m < 4; ++m) { const int row = u.pm * 256 + ai * 128 + wr * 64 + m * 16 + fr;
#pragma unroll
                for (int bj = 0; bj < 2; ++bj) { const int c = u.pn * 256 + bj * 128 + wc * 32 + 8 * fq; const pg8::f32x4 v0 = acc[ai][bj][m][0], v1 = acc[ai][bj][m][1];
                    u32x4 w; w.x = pg8::cvt_pk_bf16(v0[0], v0[1]); w.y = pg8::cvt_pk_bf16(v0[2], v0[3]); w.z = pg8::cvt_pk_bf16(v1[0], v1[1]); w.w = pg8::cvt_pk_bf16(v1[2], v1[3]);
                    *(u32x4*)(U + (size_t)row * DINP + c) = w; } }
    }
};
__device__ __forceinline__ void opt_inproj16(const Q& q, const Q2& q2, int l, LAS unsigned char* lds, int G, int bid) {
    pg8::Gemm g{q.H16, q.WtIn + (size_t)l * DINP * D, D}; pg8::StaticOrder S; S.init(NT, DINP, G, bid);
    EpiU16 E{q2.U16}; pg8::gemm_phase<EpiU16, pg8::StaticOrder, true>(lds, g, S, E);
}

__device__ __forceinline__ void opt_convert_small(const P& p, const Q2& q2, long gtid, long nthr) {
    for (long it = gtid; it < (long)DEPTH * 4 * 256 * 64; it += nthr) { const int i = (int)(it & 63), n = (int)((it >> 6) & 255), g = (int)((it >> 14) & 3), l = (int)(it >> 16);
        const int d = n >> 7, gate = (n >> 6) & 1, j = n & 63; const float* w = (gate ? p.in[I_LWX] : p.in[I_LWA]) + ((((size_t)l * 2 + d) * 4 + g) * 64 + i) * 64 + j;
        q2.WtL[it] = (bf16)f2bf(*w); }
    for (long it = gtid; it < (long)DEPTH * 4 * 3 * 64 * 64; it += nthr) { const int i = (int)(it & 63), j = (int)((it >> 6) & 63), m = (int)((it >> 12) % 3), h = (int)((it / (3 * 4096)) & 3), l = (int)(it / (12 * 4096));
        const float* w = (m == 0 ? p.in[I_MWQ] : (m == 1 ? p.in[I_MWK] : p.in[I_MWV])) + (((size_t)l * 4 + h) * 64 + i) * 64 + j;
        q2.WtM[it] = (bf16)f2bf(*w * (m == 1 ? 0.125f : 1.f)); }
    for (long it = gtid; it < (long)DEPTH * 32 * 768; it += nthr) { const int i = (int)(it % 768), n = (int)((it / 768) & 31), l = (int)(it / (32 * 768));
        q2.WtG[it] = n < 16 ? (bf16)f2bf(p.in[I_MWG][((((size_t)l * 2 + (n >> 3)) * 768) + i) * 8 + (n & 7)]) : (bf16)0; }
    for (long it = gtid; it < (long)DEPTH * 2 * 256; it += nthr) q2.LSL[it] = logsigmoid_f(p.in[I_LLAM][it]);
}

__device__ __forceinline__ void opt_init_mod(const P& p, char* lds, int bid, int G) {
    int tid_ = TIDX; asm volatile("" : "+v"(tid_));
    const int tid = tid_; float* SC = (float*)lds; float* RED = (float*)(lds + 12288);
    for (int i = tid; i < 3 * D; i += 512) { const int cv = i / D, k = i % D; const float x = cv < 2 ? p.in[I_C][cv * D + k] : p.in[I_CCTX][k]; SC[i] = x / (1.f + __expf(-x)); }
    __syncthreads();
    for (int it = bid; it < DEPTH * 6 * D / 64; it += G) { const int l = it / (6 * D / 64), j = (it % (6 * D / 64)) * 64 + (tid & 63), kq = tid >> 6;
        const float* w = p.in[I_WMOD] + (size_t)l * D * 6 * D + (size_t)(128 * kq) * 6 * D + j; float a0 = 0.f, a1 = 0.f, a2 = 0.f;
#pragma unroll 8
        for (int k = 0; k < 128; ++k) { const float wv = w[(size_t)k * 6 * D]; a0 += SC[128 * kq + k] * wv; a1 += SC[D + 128 * kq + k] * wv; a2 += SC[2 * D + 128 * kq + k] * wv; }
        RED[(kq * 3 + 0) * 64 + (tid & 63)] = a0; RED[(kq * 3 + 1) * 64 + (tid & 63)] = a1; RED[(kq * 3 + 2) * 64 + (tid & 63)] = a2;
        __syncthreads();
        if (tid < 192) { const int cv = tid >> 6, jj = tid & 63; float sacc = p.in[I_BMOD][(size_t)l * 6 * D + (it % (6 * D / 64)) * 64 + jj];
#pragma unroll
            for (int x = 0; x < 8; ++x) sacc += RED[(x * 3 + cv) * 64 + jj];
            p.MOD[((size_t)l * 3 + cv) * 6 * D + (it % (6 * D / 64)) * 64 + jj] = sacc; }
        __syncthreads(); }
}
__device__ __forceinline__ void opt_init_rope(const P& p, long gtid, long nthr) {
    for (long it = gtid; it < (long)SEQ * 16; it += nthr) { const int s = (int)(it / 16), a = (int)((it / 8) & 1), f = (int)(it & 7); const int pos = a == 0 ? s / GRID_W : s % GRID_W;
        const float frf = f == 0 ? 1.f : f == 1 ? 0.31622776601683794f : f == 2 ? 0.1f : f == 3 ? 0.031622776601683791f : f == 4 ? 0.01f : f == 5 ? 0.0031622776601683794f : f == 6 ? 0.001f : 0.00031622776601683794f;
        const float ang = (float)pos * frf; float sn, cs; sincosf(ang, &sn, &cs);
        p.ROPET[it * 2] = cs; p.ROPET[it * 2 + 1] = sn; }
}

template <int KS, class TA, class TB>
__device__ __forceinline__ void wave_mm32(att::f32x16& acc, const TA* A, int lda, const TB* B, int ldb, int r32, int hi) {
#pragma unroll
    for (int ks = 0; ks < KS; ++ks) {
        const att::bf16x8 a = *reinterpret_cast<const att::bf16x8*>(A + (size_t)r32 * lda + ks * 16 + hi * 8);
        const att::bf16x8 b = *reinterpret_cast<const att::bf16x8*>(B + (size_t)r32 * ldb + ks * 16 + hi * 8);
        acc = __builtin_amdgcn_mfma_f32_32x32x16_bf16(a, b, acc, 0, 0, 0);
    }
}

constexpr int LRU1_LDS = 18432 + 65536 + 4096;
template <class UL>
__device__ __forceinline__ void lru1_item(const P& p, const Q2& q2, int l, int b, int ch, int g, char* lds, const UL& U) {
    int tid_ = TIDX; asm volatile("" : "+v"(tid_));
    const int tid = tid_, wave = tid >> 6, lane = tid & 63, r32 = lane & 31, hi = lane >> 5;
    unsigned short* XC16 = (unsigned short*)lds; float* AB = (float*)(lds + 18432); float* CMP = (float*)(lds + 18432 + 65536);
    const int t0 = b * TPB + ch * 128, seg_lo = ch < NCH_CTX ? b * TPB : b * TPB + CTX, seg_hi = ch < NCH_CTX ? b * TPB + CTX : (b + 1) * TPB;
    { const int j = tid & 63, c = g * 64 + j, tb = (tid >> 6) * 16; const float* cw = p.in[I_LCW] + (size_t)l * 4 * 256 + c; const float w0 = cw[0], w1 = cw[256], w2 = cw[512], w3 = cw[768], cb = p.in[I_LCB][(size_t)l * 256 + c];
      float xm2 = (t0 + tb - 2 >= seg_lo) ? U(t0 + tb - 2, OFF_AX + c) : 0.f, xm1 = (t0 + tb - 1 >= seg_lo) ? U(t0 + tb - 1, OFF_AX + c) : 0.f, x0 = U(t0 + tb, OFF_AX + c);
#pragma unroll 4
      for (int i = 0; i < 16; ++i) { const int t = t0 + tb + i; const float xp1 = (t + 1 < seg_hi) ? U(t + 1, OFF_AX + c) : 0.f;
          const float v = cb + w0 * xm2 + w1 * xm1 + w2 * x0 + w3 * xp1; XC16[(tb + i) * 72 + j] = (unsigned short)f2bf(v); xm2 = xm1; xm1 = x0; x0 = xp1; } }
    __syncthreads();
    const bf16* Wt = q2.WtL + ((size_t)l * 4 + g) * 256 * 64;
#pragma unroll 1
    for (int d = 0; d < 2; ++d) {
        const int rt = wave & 3, cj = wave >> 2; att::f32x16 ar = {}, ai = {};
        wave_mm32<4>(ar, XC16 + rt * 32 * 72, 72, Wt + (size_t)(d * 128 + cj * 32) * 64, 64, r32, hi);
        wave_mm32<4>(ai, XC16 + rt * 32 * 72, 72, Wt + (size_t)(d * 128 + 64 + cj * 32) * 64, 64, r32, hi);
        { const int j = cj * 32 + r32, c = g * 64 + j; const float ba = p.in[I_LBA][((size_t)l * 2 + d) * 256 + c], bx = p.in[I_LBX][((size_t)l * 2 + d) * 256 + c], lsl = q2.LSL[((size_t)l * 2 + d) * 256 + c];
#pragma unroll
          for (int r = 0; r < 16; ++r) { const int tt = rt * 32 + att::crow(r, hi); const float rg = fast_sigmoid(ar[r] + ba), ig = fast_sigmoid(ai[r] + bx), la = 8.f * rg * lsl, a = __expf(la);
              const float xc = bf2f(XC16[tt * 72 + j]); const float bb = sqrtf(fmaxf(1.f - a * a, 0.f)) * ig * xc;
              AB[(tt * 64 + j) * 2] = a; AB[(tt * 64 + j) * 2 + 1] = bb; } }
        __syncthreads();
        { const int j = tid & 63, sg = tid >> 6; float av[16], bv[16]; float A = 1.f, B = 0.f;
#pragma unroll
          for (int i = 0; i < 16; ++i) { const int s = sg * 16 + i, tt = d == 0 ? s : 127 - s; av[i] = AB[(tt * 64 + j) * 2]; bv[i] = AB[(tt * 64 + j) * 2 + 1]; B = av[i] * B + bv[i]; A *= av[i]; }
          CMP[(sg * 64 + j) * 2] = A; CMP[(sg * 64 + j) * 2 + 1] = B;
          __syncthreads();
          float cA = 1.f, cB = 0.f;
          for (int x = 0; x < sg; ++x) { const float xa = CMP[(x * 64 + j) * 2], xb = CMP[(x * 64 + j) * 2 + 1]; cB = xa * cB + xb; cA *= xa; }
          const int c = g * 64 + j; float h = cB, pc = cA;
          unsigned short* OUTS = (unsigned short*)AB;
#pragma unroll
          for (int i = 0; i < 16; ++i) { const int s = sg * 16 + i, tt = d == 0 ? s : 127 - s; h = av[i] * h + bv[i]; pc *= av[i];
              OUTS[tt * 64 + j] = (unsigned short)f2bf(h); OUTS[(128 + tt) * 64 + j] = (unsigned short)f2bf(pc); }
          if (sg == 7) { q2.SA[(((size_t)d * NB + b) * NCH + ch) * 256 + c] = pc; q2.SB[(((size_t)d * NB + b) * NCH + ch) * 256 + c] = h; }
          __syncthreads();
#pragma unroll
          for (int k = 0; k < 4; ++k) { const int x = tid + k * 512, arr = x >> 10, tt = (x >> 3) & 127, c8 = x & 7; const u32x4 v = *(const u32x4*)(OUTS + (arr * 128 + tt) * 64 + c8 * 8);
              *(u32x4*)((arr ? q2.PCUM : q2.HLOC) + ((size_t)d * NT + t0 + tt) * 256 + g * 64 + c8 * 8) = v; } }
        __syncthreads();
    }
}
__device__ __forceinline__ void lru2_item(const Q2& q2, bf16* Yp, int b, int ch, char* lds) {
    int tid_ = TIDX; asm volatile("" : "+v"(tid_));
    const int tid = tid_; float* CAR = (float*)lds;
    { const int d = tid >> 8, c = tid & 255; float h = 0.f;
      if (d == 0) { for (int j = 0; j < ch; ++j) h = q2.SA[(((size_t)0 * NB + b) * NCH + j) * 256 + c] * h + q2.SB[(((size_t)0 * NB + b) * NCH + j) * 256 + c]; }
      else { const bool isctx = ch < NCH_CTX;
          for (int j = NCH_CTX - 1; j >= (isctx ? ch + 1 : 0); --j) h = q2.SA[(((size_t)1 * NB + b) * NCH + j) * 256 + c] * h + q2.SB[(((size_t)1 * NB + b) * NCH + j) * 256 + c];
          if (!isctx) for (int j = NCH - 1; j > ch; --j) h = q2.SA[(((size_t)1 * NB + b) * NCH + j) * 256 + c] * h + q2.SB[(((size_t)1 * NB + b) * NCH + j) * 256 + c]; }
      CAR[tid] = h; }
    __syncthreads();
    const int t0 = b * TPB + ch * 128;
#pragma unroll 2
    for (int k = 0; k < 8; ++k) { const int x = tid + k * 512, tt = x >> 5, c0 = (x & 31) * 8, t = t0 + tt;
        const u32x4 hf = *(const u32x4*)(q2.HLOC + (size_t)t * 256 + c0), pf = *(const u32x4*)(q2.PCUM + (size_t)t * 256 + c0), hb = *(const u32x4*)(q2.HLOC + ((size_t)NT + t) * 256 + c0), pb = *(const u32x4*)(q2.PCUM + ((size_t)NT + t) * 256 + c0);
        const u32x4 ag = *(const u32x4*)(q2.U16 + (size_t)t * DINP + OFF_AG + c0); u32x4 o;
#pragma unroll
        for (int w = 0; w < 4; ++w) { float y[2];
#pragma unroll
            for (int e = 0; e < 2; ++e) { const int c = c0 + 2 * w + e; const unsigned sh = e ? 0u : 16u;
                const float h0 = __builtin_bit_cast(float, e ? (hf[w] & 0xffff0000u) : (hf[w] << 16)), p0 = __builtin_bit_cast(float, e ? (pf[w] & 0xffff0000u) : (pf[w] << 16));
                const float h1 = __builtin_bit_cast(float, e ? (hb[w] & 0xffff0000u) : (hb[w] << 16)), p1 = __builtin_bit_cast(float, e ? (pb[w] & 0xffff0000u) : (pb[w] << 16));
                const float a = __builtin_bit_cast(float, e ? (ag[w] & 0xffff0000u) : (ag[w] << 16)); (void)sh;
                y[e] = ((h0 + p0 * CAR[c]) + (h1 + p1 * CAR[256 + c])) * fast_gelu(a); }
            o[w] = pk2(y[0], y[1]); }
        *(u32x4*)(Yp + (size_t)t * DMIX + c0) = o; }
    __syncthreads();
}

template <class UL>
__device__ __forceinline__ void mla_prep_token(const P& p, const Q& q, const Q2& q2, int l, int t, int lane, const UL& U) {
    float xq[4], xk[2]; float sq = 0.f, sk = 0.f;
#pragma unroll
    for (int i = 0; i < 4; ++i) { xq[i] = U(t, OFF_BQ + lane * 4 + i); sq += xq[i] * xq[i]; }
#pragma unroll
    for (int i = 0; i < 2; ++i) { xk[i] = U(t, OFF_BKV + lane * 2 + i); sk += xk[i] * xk[i]; }
    sq = wave_sum(sq); sk = wave_sum(sk);
    const float rq = 1.f / sqrtf(sq * (1.f / QRANK) + EPS), rk = 1.f / sqrtf(sk * (1.f / KVRANK) + EPS);
    const float* gq = p.in[I_QNG] + (size_t)l * QRANK + lane * 4; const float* gk = p.in[I_KVNG] + (size_t)l * KVRANK + lane * 2;
    u32x2 wq; wq.x = pk2(xq[0] * rq * gq[0], xq[1] * rq * gq[1]); wq.y = pk2(xq[2] * rq * gq[2], xq[3] * rq * gq[3]);
    *(u32x2*)(q2.QN16 + (size_t)t * 256 + lane * 4) = wq;
    *(unsigned*)(q2.KVN16 + (size_t)t * 256 + lane * 2) = pk2(xk[0] * rk * gk[0], xk[1] * rk * gk[1]);
    *(unsigned*)(q2.KVN16 + (size_t)t * 256 + 128 + lane * 2) = 0u;
    const int b = t / TPB, key = t % TPB, h = lane >> 3, d0 = (lane & 7) * 4; const bool lat = key >= CTX; const int s = key - CTX;
    float o[4];
#pragma unroll
    for (int i = 0; i < 4; ++i) { const int dd = d0 + i, a = dd >> 4, half = (dd >> 3) & 1, f = dd & 7; const float me = U(t, OFF_BKR + dd), other = U(t, OFF_BKR + (dd ^ 8));
        float cs = 1.f, sn = 0.f; if (lat) { cs = p.ROPET[(((size_t)s * 2 + a) * 8 + f) * 2]; sn = p.ROPET[(((size_t)s * 2 + a) * 8 + f) * 2 + 1]; }
        o[i] = half == 0 ? me * cs - other * sn : me * cs + other * sn; }
    u32x2 wk; wk.x = pk2(o[0], o[1]); wk.y = pk2(o[2], o[3]);
    *(u32x2*)(q.K16 + (((size_t)b * AH + h) * TPB + key) * QKD + NOPE + d0) = wk;
}

struct EpiQproj {
    static constexpr bool PERM = true; bf16* Q16; const float* ROPET;
    __device__ __forceinline__ void operator()(const pg8::f32x4 (&acc)[2][2][4][2], const pg8::Unit& u, int wr, int wc, int fr, int fq) const {
#pragma unroll
        for (int bj = 0; bj < 2; ++bj) { const int blk = u.pn * 8 + bj * 4 + wc; const bool rope = (blk % 3) == 2; const int c = blk * 32 + 8 * fq;
#pragma unroll
            for (int ai = 0; ai < 2; ++ai)
#pragma unroll
                for (int m = 0; m < 4; ++m) { const int row = u.pm * 256 + ai * 128 + wr * 64 + m * 16 + fr; float v[8];
#pragma unroll
                    for (int x = 0; x < 4; ++x) { v[x] = acc[ai][bj][m][0][x]; v[4 + x] = acc[ai][bj][m][1][x]; }
                    if (rope) {
                        const int key = (u.pm % (TPB / 256)) * 256 + ai * 128 + wr * 64 + m * 16 + fr; const bool lat = key >= CTX; const int s = lat ? key - CTX : 0, a = fq >> 1; const float* tb = ROPET + ((size_t)s * 2 + a) * 16;
#pragma unroll
                        for (int x = 0; x < 8; ++x) { const float other = __shfl_xor(v[x], 16); const float cs = lat ? tb[x * 2] : 1.f, sn = lat ? tb[x * 2 + 1] : 0.f;
                            v[x] = (fq & 1) == 0 ? v[x] * cs - other * sn : v[x] * cs + other * sn; } }
#pragma unroll
                    for (int x = 0; x < 8; ++x) v[x] *= att::QPRESCALE;
                    u32x4 w; w.x = pg8::cvt_pk_bf16(v[0], v[1]); w.y = pg8::cvt_pk_bf16(v[2], v[3]); w.z = pg8::cvt_pk_bf16(v[4], v[5]); w.w = pg8::cvt_pk_bf16(v[6], v[7]);
                    *(u32x4*)(Q16 + (size_t)row * 768 + c) = w; asm volatile("" ::: "memory"); } }
    }
};
struct EpiKVproj {
    static constexpr bool PERM = true; bf16* K16; bf16* V16;
    __device__ __forceinline__ void operator()(const pg8::f32x4 (&acc)[2][2][4][2], const pg8::Unit& u, int wr, int wc, int fr, int fq) const {
#pragma unroll
        for (int bj = 0; bj < 2; ++bj) { const int h = u.pn * 2 + bj, dcol = wc * 32 + 8 * fq; const bool isv = dcol >= 64;
#pragma unroll
            for (int ai = 0; ai < 2; ++ai)
#pragma unroll
                for (int m = 0; m < 4; ++m) { const int b = u.pm / (TPB / 256), key = (u.pm % (TPB / 256)) * 256 + ai * 128 + wr * 64 + m * 16 + fr; const pg8::f32x4 v0 = acc[ai][bj][m][0], v1 = acc[ai][bj][m][1];
                    u32x4 w; w.x = pg8::cvt_pk_bf16(v0[0], v0[1]); w.y = pg8::cvt_pk_bf16(v0[2], v0[3]); w.z = pg8::cvt_pk_bf16(v1[0], v1[1]); w.w = pg8::cvt_pk_bf16(v1[2], v1[3]);
                    bf16* dst = isv ? V16 + (((size_t)b * AH + h) * TPB + key) * VD + (dcol - 64) : K16 + (((size_t)b * AH + h) * TPB + key) * QKD + dcol;
                    *(u32x4*)dst = w; asm volatile("" ::: "memory"); } }
    }
};
struct MlaOrder : pg8::StaticOrder { __device__ __forceinline__ int arow(const pg8::Unit& u, int r) const { return (u.pn >= 3 ? NT : 0) + u.pm * pg8::BM + r; } };
struct EpiMla { static constexpr bool PERM = true; EpiQproj eq; EpiKVproj ekv;
    __device__ __forceinline__ void operator()(const pg8::f32x4 (&acc)[2][2][4][2], const pg8::Unit& u, int wr, int wc, int fr, int fq) const {
        if (u.pn < 3) eq(acc, u, wr, wc, fr, fq); else { pg8::Unit v = u; v.pn = u.pn - 3; ekv(acc, v, wr, wc, fr, fq); } } };
__device__ __forceinline__ void opt_mla_proj(const P& p, const Q& q, const Q2& q2, int l, LAS unsigned char* lds, int G, int bid) {
    pg8::Gemm g{q2.QN16, q2.WtKvbP + (size_t)l * 1792 * 256, 256}; MlaOrder S; S.init(NT, 1792, G, bid);
    EpiMla E{EpiQproj{q2.Q16, p.ROPET}, EpiKVproj{q.K16, q.V16}}; pg8::gemm_phase<EpiMla, MlaOrder, true>(lds, g, S, E);
}
__device__ __forceinline__ int ord_len(int d, int ch) { return d == 0 ? ch : (ch < NCH_CTX ? NCH_CTX - 1 - ch : NCH_CTX + (NCH - 1 - ch)); }
__device__ __forceinline__ int ord_chunk(int d, int ch, int i) { return d == 0 ? i : (i < (ch < NCH_CTX ? NCH_CTX - 1 - ch : NCH_CTX) ? NCH_CTX - 1 - i : NCH - 1 - (i - NCH_CTX)); }

__device__ __forceinline__ void wave_scan_add128(float& x0, float& x1, int lane) {
#pragma unroll
    for (int off = 1; off < 64; off <<= 1) { const float y0 = __shfl_up(x0, off), y1 = __shfl_up(x1, off); if (lane >= off) { x0 += y0; x1 += y1; } }
    x1 += __shfl(x0, 63);
}
__device__ __forceinline__ void wave_scan_max128(float& x0, float& x1, int lane) {
#pragma unroll
    for (int off = 1; off < 64; off <<= 1) { const float y0 = __shfl_up(x0, off), y1 = __shfl_up(x1, off); if (lane >= off) { x0 = fmaxf(x0, y0); x1 = fmaxf(x1, y1); } }
    x1 = fmaxf(x1, __shfl(x0, 63));
}
__device__ __forceinline__ float wave_max(float v) {
#pragma unroll
    for (int o = 1; o < 64; o <<= 1) v = fmaxf(v, __shfl_xor(v, o));
    return v;
}

constexpr int ML1_LDS = 116736;
template <class UL>
__device__ __forceinline__ void ml1_item(const P& p, const Q2& q2, int l, int b, int ch, char* lds, const UL& U) {
    int tid_ = TIDX; asm volatile("" : "+v"(tid_));
    const int tid = tid_, wave = tid >> 6, lane = tid & 63, r32 = lane & 31, hi = lane >> 5;
    unsigned short* XCh = (unsigned short*)lds; unsigned short* UXh = (unsigned short*)(lds + 18432); unsigned short* QKVh = (unsigned short*)(lds + 36864);
    float* GP = (float*)(lds + 92160); float* GT = (float*)(lds + 108544);
    const int t0 = b * TPB + ch * 128, seg_lo = ch < NCH_CTX ? b * TPB : b * TPB + CTX, seg_hi = ch < NCH_CTX ? b * TPB + CTX : (b + 1) * TPB;
    const int rt = wave & 3, wh = wave >> 2;
    att::f32x16 gacc = {};
#pragma unroll 1
    for (int h = 0; h < 4; ++h) {
        { const int j = tid & 63, c = h * 64 + j, tb = (tid >> 6) * 16; const float* cw = p.in[I_MCW] + (size_t)l * 4 * 256 + c; const float w0 = cw[0], w1 = cw[256], w2 = cw[512], w3 = cw[768], cb = p.in[I_MCB][(size_t)l * 256 + c];
          float xm2 = (t0 + tb - 2 >= seg_lo) ? U(t0 + tb - 2, OFF_MX + c) : 0.f, xm1 = (t0 + tb - 1 >= seg_lo) ? U(t0 + tb - 1, OFF_MX + c) : 0.f, x0 = U(t0 + tb, OFF_MX + c);
#pragma unroll 4
          for (int i = 0; i < 16; ++i) { const int t = t0 + tb + i; const float xp1 = (t + 1 < seg_hi) ? U(t + 1, OFF_MX + c) : 0.f;
              const float v = fast_silu(cb + w0 * xm2 + w1 * xm1 + w2 * x0 + w3 * xp1); const unsigned short vb = (unsigned short)f2bf(v);
              XCh[(tb + i) * 72 + j] = vb; UXh[(tb + i) * 72 + j] = (unsigned short)f2bf(x0); xm2 = xm1; xm1 = x0; x0 = xp1; } }
        __syncthreads();
        { const bf16* Wm = q2.WtM + ((size_t)l * 4 + h) * 3 * 4096;
#pragma unroll
          for (int m = 0; m < 3; ++m) { att::f32x16 a = {};
              wave_mm32<4>(a, (m == 2 ? UXh : XCh) + rt * 32 * 72, 72, Wm + (size_t)m * 4096 + (size_t)wh * 32 * 64, 64, r32, hi);
#pragma unroll
              for (int r = 0; r < 16; ++r) { const int tt = rt * 32 + att::crow(r, hi); const unsigned short vb = (unsigned short)f2bf(a[r]);
                  QKVh[(m * 128 + tt) * 72 + wh * 32 + r32] = vb; } } }
        __syncthreads();
#pragma unroll
        for (int k = 0; k < 2; ++k) { const int x = tid + k * 512, tt = x >> 3, c8 = x & 7; *(u32x4*)(q2.XCM16 + (size_t)(t0 + tt) * 256 + h * 64 + c8 * 8) = *(const u32x4*)(XCh + tt * 72 + c8 * 8); }
#pragma unroll
        for (int k = 0; k < 6; ++k) { const int x = tid + k * 512, m = x >> 10, tt = (x >> 3) & 127, c8 = x & 7;
            *(u32x4*)(q2.QKV16 + (size_t)(t0 + tt) * 768 + m * 256 + h * 64 + c8 * 8) = *(const u32x4*)(QKVh + (m * 128 + tt) * 72 + c8 * 8); }
        { const bf16* Wg = q2.WtG + (size_t)l * 32 * 768;
#pragma unroll
          for (int x = 0; x < 6; ++x) { const int idx = wh * 6 + x, m = idx >> 2, ks = idx & 3;
              const att::bf16x8 a = *reinterpret_cast<const att::bf16x8*>(QKVh + (m * 128 + rt * 32 + r32) * 72 + ks * 16 + hi * 8);
              const att::bf16x8 bb = *reinterpret_cast<const att::bf16x8*>(Wg + (size_t)r32 * 768 + m * 256 + h * 64 + ks * 16 + hi * 8);
              gacc = __builtin_amdgcn_mfma_f32_32x32x16_bf16(a, bb, gacc, 0, 0, 0); } }
        __syncthreads();
    }
    if (r32 < 16) {
#pragma unroll
        for (int r = 0; r < 16; ++r) GP[(wh * 128 + rt * 32 + att::crow(r, hi)) * 16 + r32] = gacc[r]; }
    __syncthreads();
    for (int i = tid; i < 128 * 16; i += 512) { const int n = i & 15, d = n >> 3, g = n & 7; float v = GP[i] + GP[128 * 16 + i] + p.in[I_MBG][((size_t)l * 2 + d) * 8 + g];
        if (g >= 4) v = fminf(v, 0.f) - __logf(1.f + __expf(-fabsf(v)));
        GT[i] = v; q2.GATES[(size_t)(t0 + (i >> 4)) * 16 + n] = v; }
    __syncthreads();
    unsigned short* KT = (unsigned short*)lds; unsigned short* VT = (unsigned short*)(lds + 17408); float* WR = (float*)(lds + 52224); float* MB = (float*)(lds + 53248); float* WE = (float*)(lds + 53280);
#pragma unroll 1
    for (int h = 0; h < 4; ++h) {
        if (wave < 2) { const int d = wave, ta = d == 0 ? lane : 127 - lane, tb = d == 0 ? lane + 64 : 63 - lane;
            float b0 = GT[ta * 16 + d * 8 + 4 + h], b1 = GT[tb * 16 + d * 8 + 4 + h]; wave_scan_add128(b0, b1, lane);
            const float bL = __shfl(b1, 63), w0 = bL - b0 + GT[ta * 16 + d * 8 + h], w1 = bL - b1 + GT[tb * 16 + d * 8 + h];
            WR[d * 128 + ta] = w0; WR[d * 128 + tb] = w1; const float mx = wave_max(fmaxf(w0, w1));
            if (lane == 0) { MB[d * 2] = mx; MB[d * 2 + 1] = bL; } }
        __syncthreads();
        { const int tt = tid & 127, jg = tid >> 7; const float w0 = __expf(WR[tt] - MB[0]), w1 = __expf(WR[128 + tt] - MB[2]);
          const unsigned short* ksrc = (const unsigned short*)q2.QKV16 + (size_t)(t0 + tt) * 768 + 256 + h * 64 + jg * 16; const unsigned short* vsrc = ksrc + 256;
          const att::bf16x8 k0 = *reinterpret_cast<const att::bf16x8*>(ksrc), k1 = *reinterpret_cast<const att::bf16x8*>(ksrc + 8), v0 = *reinterpret_cast<const att::bf16x8*>(vsrc), v1 = *reinterpret_cast<const att::bf16x8*>(vsrc + 8);
#pragma unroll
          for (int i = 0; i < 8; ++i) { KT[(jg * 16 + i) * 136 + tt] = (unsigned short)k0[i]; KT[(jg * 16 + 8 + i) * 136 + tt] = (unsigned short)k1[i];
              const float va = bf2f((unsigned short)v0[i]), vb = bf2f((unsigned short)v1[i]);
              VT[(jg * 16 + i) * 136 + tt] = (unsigned short)f2bf(va * w0); VT[(jg * 16 + 8 + i) * 136 + tt] = (unsigned short)f2bf(vb * w0);
              VT[(64 + jg * 16 + i) * 136 + tt] = (unsigned short)f2bf(va * w1); VT[(64 + jg * 16 + 8 + i) * 136 + tt] = (unsigned short)f2bf(vb * w1); }
          if (tid < 128) WE[tid] = w0; else if (tid < 256) WE[tid] = w1; }
        __syncthreads();
        { const int d = wave >> 2, vt = (wave >> 1) & 1, kt = wave & 1; att::f32x16 c = {};
          wave_mm32<8>(c, VT + (size_t)(d * 64 + vt * 32) * 136, 136, KT + (size_t)kt * 32 * 136, 136, r32, hi);
          float* dst = q2.CLOC + ((((size_t)d * NB + b) * NCH + ch) * 4 + h) * 4096;
#pragma unroll
          for (int r = 0; r < 16; ++r) dst[(vt * 32 + att::crow(r, hi)) * 64 + kt * 32 + r32] = c[r];
          { const int dd = tid >> 8, k = (tid >> 2) & 63, qt = tid & 3; float s = 0.f;
#pragma unroll 8
            for (int i = 0; i < 32; ++i) { const int tt = qt * 32 + i; s += WE[dd * 128 + tt] * bf2f(KT[k * 136 + tt]); }
            s += __shfl_xor(s, 1); s += __shfl_xor(s, 2);
            if (qt == 0) q2.NLOC[((((size_t)dd * NB + b) * NCH + ch) * 4 + h) * 64 + k] = s; }
          if (tid < 2) { float* mb = q2.MLB + ((((size_t)tid * NB + b) * NCH + ch) * 4 + h) * 2; mb[0] = MB[tid * 2]; mb[1] = MB[tid * 2 + 1]; } }
        __syncthreads();
    }
}

__device__ __forceinline__ void ml_scan_item(const Q2& q2, int item, char* lds) {
    int tid_ = TIDX; asm volatile("" : "+v"(tid_));
    const int tid = tid_, vq = item & 3, h = (item >> 2) & 3, b = (item >> 4) & 1, d = item >> 5;
    float* MLs = (float*)lds; float* MSEQ = MLs + 2 * NCH + 16;
    for (int i = tid; i < NCH; i += 512) { const float* mb = q2.MLB + ((((size_t)d * NB + b) * NCH + ord_chunk(d, NCH, i)) * 4 + h) * 2; MLs[2 * i] = mb[0]; MLs[2 * i + 1] = mb[1]; }
    __syncthreads();
    if (tid == 0) { float m = 0.f; for (int i = 0; i < NCH; ++i) { MSEQ[i] = m; m = fmaxf(MLs[2 * i + 1] + m, MLs[2 * i]); } MSEQ[NCH] = m; }
    __syncthreads();
    const int e0 = vq * 1024 + tid * 2; float c0 = 0.f, c1 = 0.f, nn = 0.f; const bool don = (vq == 0 && tid < 64);
    static_assert(NCH % 11 == 0, "the scan streams the chunk contributions 11 at a time");
#pragma unroll 1
    for (int i0 = 0; i0 < NCH; i0 += 11) { float2 cl[11]; float nl[11];
#pragma unroll
        for (int x = 0; x < 11; ++x) { const size_t idx = (((size_t)d * NB + b) * NCH + ord_chunk(d, NCH, i0 + x)) * 4 + h; cl[x] = *(const float2*)(q2.CLOC + idx * 4096 + e0); nl[x] = don ? q2.NLOC[idx * 64 + tid] : 0.f; }
#pragma unroll
        for (int x = 0; x < 11; ++x) { const int i = i0 + x; const size_t idx = (((size_t)d * NB + b) * NCH + ord_chunk(d, NCH, i)) * 4 + h;
            *(unsigned*)(q2.CST + idx * 4096 + e0) = pk2(c0, c1);
            if (don) q2.NST[idx * 64 + tid] = nn;
            if (vq == 0 && tid == 64) q2.MST[idx] = MSEQ[i];
            const float m = MSEQ[i], mn = MSEQ[i + 1], dec = __expf(MLs[2 * i + 1] + m - mn), sc = __expf(MLs[2 * i] - mn);
            c0 = dec * c0 + sc * cl[x].x; c1 = dec * c1 + sc * cl[x].y; nn = dec * nn + sc * nl[x]; } }
    __syncthreads();
}

constexpr int ML2_LDS = 145536;
template <class UL, class YS>
__device__ __forceinline__ void ml2_item(const P& p, const Q2& q2, int l, int b, int ch, int h, char* lds, const UL& U, const YS& Y) {
    int tid_ = TIDX; asm volatile("" : "+v"(tid_));
    const int tid = tid_, wave = tid >> 6, lane = tid & 63, r32 = lane & 31, hi = lane >> 5;
    char* Ks = lds; char* Vs = lds + 32768; unsigned short* C0 = (unsigned short*)(lds + 49152); float* N0 = (float*)(lds + 67584); float* ROWV = (float*)(lds + 68096);
    float* COEF = (float*)(lds + 73216); float* M0 = (float*)(lds + 73792); float* WS = (float*)(lds + 73856) + wave * 64; float* HX = (float*)(lds + 75904);
    const int t0 = b * TPB + ch * 128;
    { const unsigned short* base = (const unsigned short*)q2.QKV16 + (size_t)t0 * 768 + h * 64;
#pragma unroll
      for (int x = 0; x < 2; ++x) { const int cidx = tid + x * 512, key = cidx >> 3, c8 = cidx & 7, tile = key >> 6, kk = key & 63;
          const att::bf16x8 kv = *reinterpret_cast<const att::bf16x8*>(base + (size_t)key * 768 + 256 + c8 * 8), vv = *reinterpret_cast<const att::bf16x8*>(base + (size_t)key * 768 + 512 + c8 * 8);
          *(att::bf16x8*)(Ks + tile * 16384 + (kk * 256 + ((c8 * 16) ^ ((kk & 7) << 4)))) = kv;
          *(att::bf16x8*)(Vs + tile * 8192 + att::v_st(kk, c8 * 8)) = vv; } }
    if (wave < 2) { const int d = wave, ta = d == 0 ? lane : 127 - lane, tb = d == 0 ? lane + 64 : 63 - lane;
        float* g = ROWV + (d * 5 + 0) * 128; float* pmv = ROWV + (d * 5 + 1) * 128; float* bv = ROWV + (d * 5 + 2) * 128;
        const float iga = q2.GATES[(size_t)(t0 + ta) * 16 + d * 8 + h], igb = q2.GATES[(size_t)(t0 + tb) * 16 + d * 8 + h];
        float b0 = q2.GATES[(size_t)(t0 + ta) * 16 + d * 8 + 4 + h], b1 = q2.GATES[(size_t)(t0 + tb) * 16 + d * 8 + 4 + h]; wave_scan_add128(b0, b1, lane);
        const float g0 = iga - b0, g1 = igb - b1; float p0 = g0, p1 = g1; wave_scan_max128(p0, p1, lane);
        g[ta] = g0; g[tb] = g1; pmv[ta] = p0; pmv[tb] = p1; bv[ta] = b0; bv[tb] = b1; }
    __syncthreads();
    { const int d = tid >> 8, e0 = (tid & 255) * 16; const size_t idx = (((size_t)d * NB + b) * NCH + ch) * 4 + h;
      const u32x4* src = (const u32x4*)(q2.CST + idx * 4096 + e0); const u32x4 w0 = src[0], w1 = src[1];
      { const int v = e0 >> 6, k = e0 & 63; unsigned short* dst = C0 + (d * 64 + v) * 72 + k; *(u32x4*)dst = w0; *(u32x4*)(dst + 8) = w1; }
      if (tid < 128) { const int nd = tid >> 6, nk = tid & 63; N0[nd * 64 + nk] = q2.NST[((((size_t)nd * NB + b) * NCH + ch) * 4 + h) * 64 + nk]; }
      if (tid < 2) M0[tid] = q2.MST[(((size_t)tid * NB + b) * NCH + ch) * 4 + h]; }
    __syncthreads();
    {
      if (tid < 256) { const int dd = tid >> 7, tt = tid & 127; const float m0 = M0[dd], M = fmaxf(m0, ROWV[(dd * 5 + 1) * 128 + tt]);
          ROWV[(dd * 5 + 1) * 128 + tt] = M; ROWV[(dd * 5 + 3) * 128 + tt] = __expf(m0 - M); ROWV[(dd * 5 + 4) * 128 + tt] = __expf(-(ROWV[(dd * 5 + 2) * 128 + tt] + M)); } }
    __syncthreads();
    { const int qb = wave & 3, d = wave >> 2; const float* g = ROWV + (d * 5 + 0) * 128; const float* Mv = ROWV + (d * 5 + 1) * 128; const float* wiv = ROWV + (d * 5 + 3) * 128; const float* emtv = ROWV + (d * 5 + 4) * 128;
      att::bf16x8 qr[4]; const int sq = qb * 32 + r32;
      { const unsigned short* qw = (const unsigned short*)q2.QKV16 + (size_t)(t0 + sq) * 768 + h * 64 + hi * 8;
#pragma unroll
        for (int d0 = 0; d0 < 4; ++d0) qr[d0] = *reinterpret_cast<const att::bf16x8*>(qw + d0 * 16); }
      const float Ms = Mv[sq] * 1.4426950408889634f; att::f32x16 o[2] = {}; float rs = 0.f;
      const int vb0 = (int)(uintptr_t)Vs + att::v_rd_base(lane);
#pragma unroll
      for (int kt = 0; kt < 2; ++kt) {
          const bool skip = d == 0 ? (kt == 1 && qb < 2) : (kt == 0 && qb >= 2);
          if (!skip) {
              att::f32x16 p0 = {}, p1 = {}; const char* Kt = Ks + kt * 16384;
#pragma unroll
              for (int d0 = 0; d0 < 4; ++d0) { const int cb = (d0 * 16 + hi * 8) * 2;
                  const att::bf16x8 b0 = *reinterpret_cast<const att::bf16x8*>(Kt + (r32 * 256 + (cb ^ ((r32 & 7) << 4))));
                  const att::bf16x8 b1 = *reinterpret_cast<const att::bf16x8*>(Kt + ((32 + r32) * 256 + (cb ^ ((r32 & 7) << 4))));
                  p0 = __builtin_amdgcn_mfma_f32_32x32x16_bf16(b0, qr[d0], p0, 0, 0, 0); p1 = __builtin_amdgcn_mfma_f32_32x32x16_bf16(b1, qr[d0], p1, 0, 0, 0); }
#pragma unroll
              for (int r = 0; r < 16; ++r) { const int k0 = kt * 64 + att::crow(r, hi), k1 = k0 + 32;
                  const bool ok0 = d == 0 ? k0 <= sq : k0 >= sq, ok1 = d == 0 ? k1 <= sq : k1 >= sq;
                  p0[r] = ok0 ? p0[r] * __builtin_amdgcn_exp2f(g[k0] * 1.4426950408889634f - Ms) : 0.f; p1[r] = ok1 ? p1[r] * __builtin_amdgcn_exp2f(g[k1] * 1.4426950408889634f - Ms) : 0.f;
                  rs += p0[r] + p1[r]; }
              att::bf16x8 pa0, pa1, pa2, pa3;
#define PK4(P, BASE, OUT) do { unsigned a0 = att::cvtpk(P[BASE + 0], P[BASE + 1]), a1 = att::cvtpk(P[BASE + 2], P[BASE + 3]);   \
    unsigned b0 = att::cvtpk(P[BASE + 4], P[BASE + 5]), b1 = att::cvtpk(P[BASE + 6], P[BASE + 7]);                              \
    auto r0 = __builtin_amdgcn_permlane32_swap(a0, b0, false, false); auto r1 = __builtin_amdgcn_permlane32_swap(a1, b1, false, false); \
    att::u32x4 w = {r0[0], r1[0], r0[1], r1[1]}; OUT = *reinterpret_cast<att::bf16x8*>(&w); } while (0)
              PK4(p0, 0, pa0); PK4(p0, 8, pa1); PK4(p1, 0, pa2); PK4(p1, 8, pa3);
#undef PK4
              att::pv_d0(o, vb0 + kt * 8192, pa0, pa1, pa2, pa3);
          }
      }
      att::f32x16 ic[2] = {};
#pragma unroll
      for (int vt = 0; vt < 2; ++vt)
#pragma unroll
          for (int d0 = 0; d0 < 4; ++d0) { const att::bf16x8 cb = *reinterpret_cast<const att::bf16x8*>(C0 + (d * 64 + vt * 32 + r32) * 72 + d0 * 16 + hi * 8);
              ic[vt] = __builtin_amdgcn_mfma_f32_32x32x16_bf16(qr[d0], cb, ic[vt], 0, 0, 0); }
      float nq = 0.f;
#pragma unroll
      for (int d0 = 0; d0 < 4; ++d0)
#pragma unroll
          for (int x = 0; x < 8; ++x) nq += bf2f((unsigned short)qr[d0][x]) * N0[d * 64 + d0 * 16 + hi * 8 + x];
      { auto rr = __builtin_amdgcn_permlane32_swap(__float_as_uint(nq), __float_as_uint(nq), false, false); nq = __uint_as_float(rr[0]) + __uint_as_float(rr[1]); }
      { auto rr = __builtin_amdgcn_permlane32_swap(__float_as_uint(rs), __float_as_uint(rs), false, false); rs = __uint_as_float(rr[0]) + __uint_as_float(rr[1]); }
      const float den = rs + wiv[sq] * nq, dn = fmaxf(fabsf(den), emtv[sq]);
      if (hi == 0) WS[r32] = __builtin_amdgcn_rcpf(dn);
      asm volatile("s_waitcnt lgkmcnt(0)" ::: "memory");
#pragma unroll
      for (int r = 0; r < 16; ++r) { const int row = att::crow(r, hi), tt = qb * 32 + row; const float inv = WS[row], wi = wiv[tt];
#pragma unroll
          for (int vt = 0; vt < 2; ++vt) HX[(d * 128 + tt) * 68 + vt * 32 + r32] = (o[vt][r] + wi * ic[vt][r]) * inv; }
    }
    __syncthreads();
    { const int tt = tid >> 2, v0 = (tid & 3) * 16, t = t0 + tt; float hv[16]; float s = 0.f;
#pragma unroll
      for (int i = 0; i < 16; ++i) { hv[i] = HX[tt * 68 + v0 + i] + HX[(128 + tt) * 68 + v0 + i]; s += hv[i]; }
      s += __shfl_xor(s, 1); s += __shfl_xor(s, 2); const float mu = s * (1.f / 64.f); float vs = 0.f;
#pragma unroll
      for (int i = 0; i < 16; ++i) { hv[i] -= mu; vs += hv[i] * hv[i]; }
      vs += __shfl_xor(vs, 1); vs += __shfl_xor(vs, 2); const float rstd = 1.f / sqrtf(vs * (1.f / 64.f) + EPS);
#pragma unroll
      for (int i = 0; i < 16; ++i) { const int c = h * 64 + v0 + i;
          const float y = hv[i] * rstd * p.in[I_MNG][(size_t)l * 256 + c] + p.in[I_MSK][(size_t)l * 256 + c] * bf2f(q2.XCM16[(size_t)t * 256 + c]);
          Y(t, 768 + c, y * fast_silu(U(t, OFF_MZ + c))); } }
    __syncthreads();
}
typedef float f32x4_t __attribute__((ext_vector_type(4)));

__device__ __forceinline__ void row_norm_mod(f32x4 (&v)[4], const float* g, const float* sc, const float* sh, int lane) {
    float s = 0.f;
#pragma unroll
    for (int j = 0; j < 4; ++j) s += (v[j].x * v[j].x + v[j].y * v[j].y) + (v[j].z * v[j].z + v[j].w * v[j].w);
    const float rstd = 1.f / sqrtf(wave_sum(s) * (1.f / D) + EPS);
#pragma unroll
    for (int j = 0; j < 4; ++j) { const int k = (j * 64 + lane) * 4; const f32x4 gv = *(const f32x4*)(g + k);
        if (sc) { const f32x4 scv = *(const f32x4*)(sc + k), shv = *(const f32x4*)(sh + k); v[j] = v[j] * rstd * gv * (scv + 1.f) + shv; } else v[j] = v[j] * rstd * gv; }
}
__device__ __forceinline__ void row_store_bf16(bf16* dst, const f32x4 (&v)[4], int lane) {
#pragma unroll
    for (int j = 0; j < 4; ++j) { u32x2 w; w.x = pk2(v[j].x, v[j].y); w.y = pk2(v[j].z, v[j].w); *(u32x2*)(dst + (j * 64 + lane) * 4) = w; }
}
__device__ __forceinline__ void rp_first(const P& p, const Q& q, int gw, int ngw, int lane) {
    for (int t = gw; t < NT; t += ngw) { const int b = t / TPB, i = t % TPB; const float* src = i < CTX ? p.in[I_CTX] + ((size_t)b * CTX + i) * D : p.in[I_X] + ((size_t)b * SEQ + (i - CTX)) * D;
        f32x4 v[4];
#pragma unroll
        for (int j = 0; j < 4; ++j) v[j] = *(const f32x4*)(src + (j * 64 + lane) * 4);
        const int cv = tok_cv(t); row_norm_mod(v, p.in[I_N1G], modp(p, 0, cv, 1), modp(p, 0, cv, 0), lane); row_store_bf16(q.H16 + (size_t)t * D, v, lane); }
}
__device__ __forceinline__ void rp_end(const P& p, const Q& q, const Q2& q2, int l, int gw, int ngw, int lane, float probe_scale = 1.f) {
    const bool last = l + 1 == DEPTH; const int nrows = last ? NB * SEQ : NT;
    for (int r_ = gw; r_ < nrows; r_ += ngw) { const int t = last ? (r_ / SEQ) * TPB + CTX + r_ % SEQ : r_; const int cv = tok_cv(t); const float* g2 = modp(p, l, cv, 5); f32x4 v[4];
#pragma unroll
        for (int j = 0; j < 4; ++j) { const int k = (j * 64 + lane) * 4; f32x4 s = {0.f, 0.f, 0.f, 0.f};
#pragma unroll
            for (int e = 0; e < 4; ++e) { const u32x2 w = *(const u32x2*)(q2.YB16 + ((size_t)t * 4 + e) * D + k);
                s.x += __builtin_bit_cast(float, w.x << 16); s.y += __builtin_bit_cast(float, w.x & 0xffff0000u); s.z += __builtin_bit_cast(float, w.y << 16); s.w += __builtin_bit_cast(float, w.y & 0xffff0000u); }
            v[j] = *(const f32x4*)(p.X + (size_t)t * D + k) + *(const f32x4*)(g2 + k) * s * probe_scale; }
        if (l + 1 < DEPTH) {
#pragma unroll
            for (int j = 0; j < 4; ++j) *(f32x4*)(p.X + (size_t)t * D + (j * 64 + lane) * 4) = v[j];
            row_norm_mod(v, p.in[I_N1G] + (size_t)(l + 1) * D, modp(p, l + 1, cv, 1), modp(p, l + 1, cv, 0), lane); row_store_bf16(q.H16 + (size_t)t * D, v, lane);
        } else { const int b = t / TPB, i = t % TPB; if (i < CTX) continue;
            row_norm_mod(v, p.in[I_FG], nullptr, nullptr, lane);
#pragma unroll
            for (int j = 0; j < 4; ++j) *(f32x4*)(p.out + ((size_t)b * SEQ + (i - CTX)) * D + (j * 64 + lane) * 4) = v[j]; }
    }
}
constexpr int RPM_LDS = 89024;
__device__ __forceinline__ void rp_mid(const P& p, const Q& q, float* GLIST, int l, char* lds, int G, int bid, bool latent_only, bool probe_nolist = false) {
    int tid_ = TIDX; asm volatile("" : "+v"(tid_));
    const int tid = tid_, wave = tid >> 6, lane = tid & 63;
    float* HS = (float*)lds; float* PART = (float*)(lds + 65664); float* LG = (float*)(lds + 82048); int* LCNT = (int*)(lds + 84096); int* LBASE = (int*)(lds + 84224); int* PEND = (int*)(lds + 84352); int* NPEND = (int*)(lds + 88960);
    if (tid < 32) LCNT[tid] = 0; if (tid == 32) NPEND[0] = 0;
    float B0[32], B1[32]; const float* Wr = p.in[I_WR] + (size_t)l * D * NE;
#pragma unroll
    for (int ks = 0; ks < 32; ++ks) { const int k = 128 * wave + 4 * ks + (lane >> 4); B0[ks] = Wr[(size_t)k * NE + (lane & 15)]; B1[ks] = Wr[(size_t)k * NE + 16 + (lane & 15)]; }
    __syncthreads();
    const int nitems = latent_only ? NB * SEQ / 16 : NT / 16;
    for (int it_ = bid; it_ < nitems; it_ += G) { const int it = latent_only ? (it_ / (SEQ / 16)) * (TPB / 16) + CTX / 16 + it_ % (SEQ / 16) : it_;
#pragma unroll 1
        for (int rr = 0; rr < 2; ++rr) { const int row = 2 * wave + rr, t = it * 16 + row, cv = tok_cv(t); f32x4 v[4];
#pragma unroll
            for (int j = 0; j < 4; ++j) v[j] = *(const f32x4*)(p.X + (size_t)t * D + (j * 64 + lane) * 4);
            row_norm_mod(v, p.in[I_N2G] + (size_t)l * D, modp(p, l, cv, 4), modp(p, l, cv, 3), lane); row_store_bf16(q.H16 + (size_t)t * D, v, lane);
#pragma unroll
            for (int j = 0; j < 4; ++j) { float* d = HS + row * 1026 + (j * 64 + lane) * 4; *(float2*)d = make_float2(v[j].x, v[j].y); *(float2*)(d + 2) = make_float2(v[j].z, v[j].w); } }
        __syncthreads();
        { f32x4_t a0 = {0.f, 0.f, 0.f, 0.f}, a1 = a0; const float* hrow = HS + (lane & 15) * 1026 + 128 * wave + (lane >> 4);
#pragma unroll
          for (int ks = 0; ks < 32; ++ks) { const float a = hrow[4 * ks]; a0 = __builtin_amdgcn_mfma_f32_16x16x4f32(a, B0[ks], a0, 0, 0, 0); a1 = __builtin_amdgcn_mfma_f32_16x16x4f32(a, B1[ks], a1, 0, 0, 0); }
#pragma unroll
          for (int r = 0; r < 4; ++r) { const int row = (lane >> 4) * 4 + r; PART[(wave * 16 + row) * 32 + (lane & 15)] = a0[r]; PART[(wave * 16 + row) * 32 + 16 + (lane & 15)] = a1[r]; } }
        __syncthreads();
        { float s = p.in[I_BR][(size_t)l * NE + (tid & 31)];
#pragma unroll
          for (int w = 0; w < 8; ++w) s += PART[w * 512 + tid];
          LG[tid] = s; }
        __syncthreads();
        if (tid < 16) { const int t = it * 16 + tid; float lg[NE];
#pragma unroll
            for (int e = 0; e < NE; ++e) lg[e] = LG[tid * 32 + e];
            int te[TOPK]; float tv[TOPK];
#pragma unroll
            for (int r = 0; r < TOPK; ++r) { float best = -3.0e38f; int bi = 0;
#pragma unroll
                for (int e = 0; e < NE; ++e) { const bool c = lg[e] > best; best = c ? lg[e] : best; bi = c ? e : bi; }
                te[r] = bi; tv[r] = best;
#pragma unroll
                for (int e = 0; e < NE; ++e) lg[e] = (e == bi) ? -3.0e38f : lg[e]; }
            float ssum = 0.f, ex[TOPK];
#pragma unroll
            for (int r = 0; r < TOPK; ++r) { ex[r] = __expf(tv[r] - tv[0]); ssum += ex[r]; }
            const float inv = 1.f / ssum;
#pragma unroll
            for (int r = 0; r < TOPK; ++r) { p.TOPG[t * TOPK + r] = ex[r] * inv; const int lp = atomicAdd(&LCNT[te[r]], 1); const int slot = atomicAdd(NPEND, 1);
                PEND[slot * 3] = t * TOPK + r; PEND[slot * 3 + 1] = (te[r] << 16) | lp; PEND[slot * 3 + 2] = __float_as_int(ex[r] * inv); } }
        __syncthreads();
    }
    if (probe_nolist) return;
    if (tid < 32) LBASE[tid] = LCNT[tid] > 0 ? atomicAdd(&p.CNT[tid], LCNT[tid]) : 0;
    __syncthreads();
    for (int i = tid; i < NPEND[0]; i += 512) { const int pr = PEND[i * 3], x = PEND[i * 3 + 1], e = x >> 16, lp = x & 0xffff; p.LIST[(size_t)e * NT + LBASE[e] + lp] = pr; GLIST[(size_t)e * NT + LBASE[e] + lp] = __int_as_float(PEND[i * 3 + 2]); }
    __syncthreads();
}
struct EpiDown16 {
    static constexpr bool PERM = true; bf16* YB; const float* bd; const float* GL; const int* CNT; const int* LIST; int nN; int probe_skip;
    __device__ __forceinline__ void operator()(const pg8::f32x4 (&acc)[2][2][4][2], const pg8::Unit& u, int wr, int wc, int fr, int fq) const {
        if (probe_skip) return;
        const int ntile = u.pn - u.e * nN, cnt = CNT[u.e]; const float* b = bd + (size_t)u.e * D;
        int pr[2][4]; float gt[2][4];
#pragma unroll
        for (int ai = 0; ai < 2; ++ai)
#pragma unroll
            for (int m = 0; m < 4; ++m) { const int idx = u.mb * 256 + ai * 128 + wr * 64 + m * 16 + fr, ic = idx < cnt ? idx : 0; pr[ai][m] = LIST[(size_t)u.e * NT + ic]; gt[ai][m] = GL[(size_t)u.e * NT + ic]; }
        pg8::f32x4 bv[2][2];
#pragma unroll
        for (int bj = 0; bj < 2; ++bj) { const int c = ntile * 256 + bj * 128 + wc * 32 + 8 * fq; bv[bj][0] = *(const pg8::f32x4*)(b + c); bv[bj][1] = *(const pg8::f32x4*)(b + c + 4); }
#pragma unroll
        for (int ai = 0; ai < 2; ++ai)
#pragma unroll
            for (int m = 0; m < 4; ++m) { const int idx = u.mb * 256 + ai * 128 + wr * 64 + m * 16 + fr;
                if (idx < cnt) { const float g = gt[ai][m];
#pragma unroll
                    for (int bj = 0; bj < 2; ++bj) { const int c = ntile * 256 + bj * 128 + wc * 32 + 8 * fq;
                        const pg8::f32x4 v0 = (acc[ai][bj][m][0] + bv[bj][0]) * g, v1 = (acc[ai][bj][m][1] + bv[bj][1]) * g;
                        u32x4 w; w.x = pg8::cvt_pk_bf16(v0[0], v0[1]); w.y = pg8::cvt_pk_bf16(v0[2], v0[3]); w.z = pg8::cvt_pk_bf16(v1[0], v1[1]); w.w = pg8::cvt_pk_bf16(v1[2], v1[3]);
                        *(u32x4*)(YB + (size_t)pr[ai][m] * D + c) = w; } } }
    }
};
__device__ __forceinline__ void opt_moe_down16(const P& p, const Q& q, const Q2& q2, int l, LAS unsigned char* lds, int G, int bid, int probe_skip = 0) {
    pg8::Gemm g{q.ACT16, q.WtDn + (size_t)l * NE * D * DE, DE}; DnOrder S; S.init(p.CNT, p.LIST, D / 256, G, bid, (LAS int*)(lds + pg8::STAGE_BYTES));
    EpiDown16 E{q2.YB16, p.in[I_BD] + (size_t)l * NE * D, q2.GLIST, p.CNT, p.LIST, D / 256, probe_skip}; pg8::gemm_phase<EpiDown16, DnOrder, true>(lds, g, S, E);
}
#define GAS __attribute__((address_space(1)))
typedef GAS unsigned gu32;
#define XB_TMO      128
#define XB_XCNT(j)  (256  + 64 * (j))
#define XB_XSUB(j)  (1280 + 64 * (j))
#define XB_XGEN(j)  (2304 + 64 * (j))
#define XB_TOP      3328
#define XB_TOPGEN   3392
#define XCD_BAR_WORDS 3456
#define XB_SPIN_CAP (1u << 18)

__device__ __forceinline__ unsigned xb_ld(unsigned* p)              { return __hip_atomic_load(p, __ATOMIC_RELAXED, __HIP_MEMORY_SCOPE_AGENT); }
__device__ __forceinline__ unsigned xb_add(unsigned* p, unsigned v) { return __hip_atomic_fetch_add(p, v, __ATOMIC_RELAXED, __HIP_MEMORY_SCOPE_AGENT); }
__device__ __forceinline__ unsigned xb_xcc_id() { return (unsigned)__builtin_amdgcn_s_getreg((3 << 11) | 20) & 0xFu; }
#define XB_SPIN(cond, bar) do { unsigned _sp = 0; while (cond) { __builtin_amdgcn_s_sleep(1); \
    if ((++_sp & 255u) == 0u) { if (xb_ld(&(bar)[XB_TMO])) break; if (_sp > XB_SPIN_CAP) { atomicAdd(&(bar)[XB_TMO], 1u); break; } } } } while (0)

struct XcdBarrier {
    unsigned* bar; unsigned x;
    volatile LAS unsigned* st;
};

__device__ __forceinline__ XcdBarrier xcd_barrier_post(unsigned* bar, volatile LAS unsigned* st) {
    XcdBarrier b; b.bar = bar; b.x = xb_xcc_id(); b.st = st;
    if (TIDX == 0) (void)xb_add(&bar[XB_XCNT(b.x)], 1u);
    return b;
}
__device__ __forceinline__ void xcd_barrier_complete(unsigned* bar, unsigned x, unsigned& nloc, unsigned& nx) {
    const unsigned G = gridDim.x * gridDim.y * gridDim.z;
    unsigned sum, cnt, mine, sp = 0u;
    for (;;) {
        sum = 0u; cnt = 0u; mine = 0u;
#pragma unroll
        for (unsigned j = 0; j < 16; ++j) { const unsigned c = xb_ld(&bar[XB_XCNT(j)]); sum += c; cnt += (c > 0u) ? 1u : 0u; mine = (j == x) ? c : mine; }
        if (sum == G) break;
        __builtin_amdgcn_s_sleep(1);
        if ((++sp & 255u) == 0u) { if (xb_ld(&bar[XB_TMO])) break; if (sp > XB_SPIN_CAP) { atomicAdd(&bar[XB_TMO], 1u); break; } }
    }
    nloc = mine > 0u ? mine : 1u; nx = cnt > 0u ? cnt : 1u;
}

__device__ __forceinline__ void xcd_barrier(const XcdBarrier& b) {
    asm volatile("s_waitcnt vmcnt(0)" ::: "memory");
    __syncthreads();
    if (TIDX == 0) {
        unsigned* bar = b.bar;
        __builtin_amdgcn_s_waitcnt(0);
        unsigned nloc = b.st[0], nx = b.st[1];
        if (nloc == 0u) { xcd_barrier_complete(bar, b.x, nloc, nx); b.st[0] = nloc; b.st[1] = nx; }
        const unsigned old = xb_add(&bar[XB_XSUB(b.x)], 1u);
        const unsigned gen = old / nloc;
        if (old + 1u == (gen + 1u) * nloc) {
            __builtin_amdgcn_fence(__ATOMIC_RELEASE, "agent");
            asm volatile("s_waitcnt vmcnt(0)" ::: "memory");
            const unsigned og = xb_add(&bar[XB_TOP], 1u);
            const unsigned tg = og / nx;
            if (og + 1u == (tg + 1u) * nx) xb_add(&bar[XB_TOPGEN], 1u);
            else XB_SPIN(xb_ld(&bar[XB_TOPGEN]) == tg, bar);
            __builtin_amdgcn_fence(__ATOMIC_ACQUIRE, "agent");
            xb_add(&bar[XB_XGEN(b.x)], 1u);
            asm volatile("s_waitcnt vmcnt(0)" ::: "memory");
        } else {
            XB_SPIN(xb_ld(&bar[XB_XGEN(b.x)]) == gen, bar);
            __builtin_amdgcn_fence(__ATOMIC_ACQUIRE, "agent");
            asm volatile("s_waitcnt vmcnt(0)" ::: "memory");
        }
    }
    __syncthreads();
}
#include <hip/hip_cooperative_groups.h>
#include <cstdio>
namespace cg = cooperative_groups;
#ifndef ONE_LAUNCH
#define ONE_LAUNCH 1
#endif
constexpr int LDS_BYTES = 148480;
static_assert(ML2_LDS <= LDS_BYTES && ML1_LDS <= LDS_BYTES && LRU1_LDS <= LDS_BYTES && RPM_LDS <= LDS_BYTES && att::SHM_ATTN <= LDS_BYTES && pg8::STAGE_BYTES + 1024 + 8192 + 15 * 512 <= LDS_BYTES - 64 - 256, "LDS map");

struct BMap { size_t off[64]; size_t total; };
static inline BMap b_map() {
    BMap m; size_t o = 0; int i = 0;
    auto add = [&](size_t bytes) { m.off[i++] = o; o += (bytes + 255) & ~(size_t)255; };
    add((size_t)DEPTH * 3 * 6 * D * 4);
    add((size_t)SEQ * 16 * 2 * 4);
    add((size_t)NT * D * 4);
    add((size_t)NT * TOPK * 4);
    add((size_t)256);
    add((size_t)NE * NT * 4);
    add((size_t)DEPTH * DINP * D * 2);
    add((size_t)DEPTH * D * DMIX * 2);
    add((size_t)DEPTH * NE * 2 * DE * D * 2);
    add((size_t)DEPTH * NE * D * DE * 2);
    add((size_t)DEPTH * 768 * QRANK * 2);
    add((size_t)DEPTH * 1024 * KVRANK * 2);
    add((size_t)NT * D * 2);
    add((size_t)NT * DMIX * 2);
    add((size_t)SLOT_MAX * DE * 2);
    add((size_t)NT * AH * QKD * 2);
    add((size_t)NT * AH * VD * 2);
    add((size_t)NT * DINP * 2);
    add((size_t)DEPTH * 4 * 256 * 64 * 2);
    add((size_t)DEPTH * 4 * 3 * 4096 * 2);
    add((size_t)DEPTH * 32 * 768 * 2);
    add((size_t)DEPTH * 2 * 256 * 4);
    add((size_t)2 * NT * 256 * 4);
    add((size_t)2 * NT * 256 * 4);
    add((size_t)2 * NB * NCH * 256 * 4);
    add((size_t)2 * NB * NCH * 256 * 4);
    add((size_t)2 * NT * 256 * 2);
    add((size_t)256);
    add((size_t)NT * 768 * 2);
    add((size_t)DEPTH * 1792 * 256 * 2);
    add((size_t)NT * 256 * 2);
    add((size_t)NT * 768 * 2);
    add((size_t)NT * 16 * 4);
    add((size_t)2 * NB * NCH * 4 * 4096 * 4);
    add((size_t)2 * NB * NCH * 4 * 64 * 4);
    add((size_t)2 * NB * NCH * 4 * 2 * 4);
    add((size_t)NT * TOPK * D * 2);
    add((size_t)XCD_BAR_WORDS * 4);
    add((size_t)2 * NB * NCH * 4 * 4096 * 2);
    add((size_t)2 * NB * NCH * 4 * 64 * 4);
    add((size_t)2 * NB * NCH * 4 * 4);
    add((size_t)NE * NT * 4);
    m.total = o; return m;
}
struct Args { P p; Q q; Q2 q2; unsigned* bar; };
static inline void fill_args(Args& a, void* const* d_in, void* d_out, void* d_ws) {
    for (int i = 0; i < N_IN; ++i) a.p.in[i] = (const float*)d_in[i];
    a.p.out = (float*)d_out; char* w = (char*)d_ws; const BMap m = b_map();
    a.p.MOD = (float*)(w + m.off[0]); a.p.ROPET = (float*)(w + m.off[1]); a.p.X = (float*)(w + m.off[2]); a.p.TOPG = (float*)(w + m.off[3]); a.p.CNT = (int*)(w + m.off[4]); a.p.LIST = (int*)(w + m.off[5]);
    a.q.WtIn = (bf16*)(w + m.off[6]); a.q.WtOut = (bf16*)(w + m.off[7]); a.q.WtGu = (bf16*)(w + m.off[8]); a.q.WtDn = (bf16*)(w + m.off[9]); a.q.WtQb = (bf16*)(w + m.off[10]); a.q.WtKvb = (bf16*)(w + m.off[11]);
    a.q.H16 = (bf16*)(w + m.off[12]); a.q.Y16 = (bf16*)(w + m.off[13]); a.q.ACT16 = (bf16*)(w + m.off[14]); a.q.K16 = (bf16*)(w + m.off[15]); a.q.V16 = (bf16*)(w + m.off[16]);
    a.q2.U16 = (bf16*)(w + m.off[17]); a.q2.WtL = (bf16*)(w + m.off[18]); a.q2.WtM = (bf16*)(w + m.off[19]); a.q2.WtG = (bf16*)(w + m.off[20]); a.q2.LSL = (float*)(w + m.off[21]);
    a.q2.HLOC = (bf16*)(w + m.off[22]); a.q2.PCUM = (bf16*)(w + m.off[23]); a.q2.SA = (float*)(w + m.off[24]); a.q2.SB = (float*)(w + m.off[25]);
    a.q2.QN16 = (bf16*)(w + m.off[26]); a.q2.KVN16 = a.q2.QN16 + (size_t)NT * 256;     a.q2.Q16 = (bf16*)(w + m.off[28]); a.q2.WtKvbP = (bf16*)(w + m.off[29]);
    a.q2.XCM16 = (bf16*)(w + m.off[30]); a.q2.QKV16 = (bf16*)(w + m.off[31]); a.q2.GATES = (float*)(w + m.off[32]); a.q2.CLOC = (float*)(w + m.off[33]); a.q2.NLOC = (float*)(w + m.off[34]); a.q2.MLB = (float*)(w + m.off[35]);
    a.q2.YB16 = (bf16*)(w + m.off[36]); a.bar = (unsigned*)(w + m.off[37]); a.q2.CST = (bf16*)(w + m.off[38]); a.q2.NST = (float*)(w + m.off[39]); a.q2.MST = (float*)(w + m.off[40]); a.q2.GLIST = (float*)(w + m.off[41]);
}

struct ULoad16 { const bf16* U; __device__ __forceinline__ float operator()(int t, int col) const { return bf2f(U[(size_t)t * DINP + col]); } };
struct YStore16 { bf16* Y; __device__ __forceinline__ void operator()(int t, int col, float v) const { Y[(size_t)t * DMIX + col] = (bf16)f2bf(v); } };
struct OutY16 { bf16* y; __device__ __forceinline__ void operator()(int row, int col, float v) const { y[(size_t)row * DMIX + col] = (bf16)f2bf(v); } };

enum { ST_INIT = 0, ST_RPFIRST, ST_INPROJ, ST_PREP, ST_MLAPROJ, ST_MIX, ST_OUTPROJ, ST_RPMID, ST_GU, ST_DOWN, ST_RPEND, N_ST };

typedef const __attribute__((address_space(4))) Args* KArgs;
__device__ __forceinline__ KArgs kargs() { KArgs k = (KArgs)__builtin_amdgcn_kernarg_segment_ptr(); asm volatile("" : "+s"(k)); return k; }
__device__ __forceinline__ void run_step(const Args& a_, int step, int l_, unsigned char* lds_raw) {
#if ONE_LAUNCH
    const Args& a = *(const Args*)kargs(); (void)a_;
#else
    const Args& a = a_;
#endif
    const int l = l_ & 0xff, sub = l_ >> 8;
    const P& p = a.p; const Q& q = a.q; const Q2& q2 = a.q2;
    LAS unsigned char* lds = (LAS unsigned char*)lds_raw; char* ldsg = (char*)lds_raw;
    int G_ = gridDim.x, bid_ = blockIdx.x; asm volatile("" : "+s"(G_), "+s"(bid_));
    const int G = G_, bid = bid_;
#define THREAD_IDS int tid_ = TIDX; asm volatile("" : "+v"(tid_)); const int tid = tid_, lane = tid & 63, wave = __builtin_amdgcn_readfirstlane(tid >> 6); \
    const int gw = bid * NWAVES + wave, ngw = G * NWAVES; const long gtid = (long)bid * NTHREADS + tid, nthr = (long)G * NTHREADS; (void)lane; (void)gw; (void)ngw; (void)gtid; (void)nthr;
    switch (step) {
    case ST_INIT: { THREAD_IDS
        if (sub == 0 || (sub & 1)) opt_init_mod(p, ldsg, bid, G);
        if (sub == 0 || (sub & 2)) { opt_init_rope(p, gtid, nthr); opt_convert_small(p, q2, gtid, nthr); }
        if (sub == 0 || (sub & 4)) opt_convert_weights(p, q, q2.WtKvbP, lds, gw, ngw, wave, lane);
        break; }
    case ST_RPFIRST: { THREAD_IDS rp_first(p, q, gw, ngw, lane); break; }
    case ST_INPROJ: opt_inproj16(q, q2, l, lds, G, bid); break;
    case ST_PREP: { THREAD_IDS
        if (gtid < NE) p.CNT[gtid] = 0;
        const ULoad16 U{q2.U16};
        constexpr int NM = NB * NCH, NL = NB * NCH * 4;
        if (G > NM + 8) {
            if (bid < NM) { if (sub == 0 || (sub & 1)) ml1_item(p, q2, l, bid / NCH, bid % NCH, ldsg, U);
                if (sub == 0 || (sub & 2)) lru1_item(p, q2, l, (bid >> 2) / NCH, (bid >> 2) % NCH, bid & 3, ldsg, U); }
            else if (sub == 0 || (sub & 2)) for (int x = NM + (bid - NM); x < NL; x += G - NM) lru1_item(p, q2, l, (x >> 2) / NCH, (x >> 2) % NCH, x & 3, ldsg, U);
        } else for (int it = bid; it < NM + NL; it += G) {
            if (it < NM) { if (sub == 0 || (sub & 1)) ml1_item(p, q2, l, it / NCH, it % NCH, ldsg, U); }
            else if (sub == 0 || (sub & 2)) { const int x = it - NM; lru1_item(p, q2, l, (x >> 2) / NCH, (x >> 2) % NCH, x & 3, ldsg, U); } }
        if (sub == 0 || (sub & 4)) for (int t = gw; t < NT; t += ngw) mla_prep_token(p, q, q2, l, t, lane, U);
        break; }
    case ST_MLAPROJ: { for (int it = G - 1 - bid; it < 64; it += G) ml_scan_item(q2, it, ldsg);
        opt_mla_proj(p, q, q2, l, lds, G, bid); break; }
    case ST_MIX: {
        const ULoad16 U{q2.U16}; const YStore16 Y{q.Y16};
        const int c = bid, vcu = (G % 8 == 0) ? (c % 8) * (G / 8) + c / 8 : c;
        constexpr int QB_LAT = SEQ / 256, QB_CTX = CTX / 256, NU_LAT = NB * AH * QB_LAT, NU_CTX = NB * AH * QB_CTX;
#ifdef ATTN_PROBE_VAR
        if (sub & 1) { struct NoOut { __device__ __forceinline__ void operator()(int, int, float) const {} } noout;
            for (int u = vcu; u < NU_LAT; u += G) { const int bh = u / QB_LAT, qb = u % QB_LAT, b = bh / AH, h = bh % AH, t0 = b * TPB + CTX + qb * 256;
                att::attn_unit<unsigned short, NoOut, ATTN_PROBE_VAR>((const unsigned short*)q2.Q16 + (size_t)t0 * 768 + h * QKD, 768, (const unsigned short*)q.K16 + ((size_t)b * AH + h) * TPB * QKD, (const unsigned short*)q.V16 + ((size_t)b * AH + h) * TPB * VD, TPB, ldsg, noout); } }
        else
#endif
        BgConv bg; { const int wv = __builtin_amdgcn_readfirstlane(TIDX >> 6); bg.init(p, q, l, lds + att::SHM_ATTN, bid * NWAVES + wv, G * NWAVES, wv); }
        if (sub == 0 || (sub & 1)) for (int u = vcu; u < NU_LAT; u += G) { const int bh = u / QB_LAT, qb = u % QB_LAT, b = bh / AH, h = bh % AH, t0 = b * TPB + CTX + qb * 256;
            OutY16 out{q.Y16 + (size_t)t0 * DMIX + 256 + h * VD};
            att::attn_unit<unsigned short, OutY16, 0, BgConv&>((const unsigned short*)q2.Q16 + (size_t)t0 * 768 + h * QKD, 768, (const unsigned short*)q.K16 + ((size_t)b * AH + h) * TPB * QKD, (const unsigned short*)q.V16 + ((size_t)b * AH + h) * TPB * VD, TPB, ldsg, out, bg); }
        if ((sub == 0 || (sub & 1)) && l + 1 < DEPTH) for (int u = vcu; u < NU_CTX; u += G) { const int bh = u / QB_CTX, qb = u % QB_CTX, b = bh / AH, h = bh % AH, t0 = b * TPB + qb * 256;
            OutY16 out{q.Y16 + (size_t)t0 * DMIX + 256 + h * VD};
            att::attn_unit<unsigned short, OutY16>((const unsigned short*)q2.Q16 + (size_t)t0 * 768 + h * QKD, 768, (const unsigned short*)q.K16 + ((size_t)b * AH + h) * TPB * QKD, (const unsigned short*)q.V16 + ((size_t)b * AH + h) * TPB * VD, CTX, ldsg, out); }
        bg.drain(); __syncthreads();
        const int ch0 = (l + 1 < DEPTH) ? 0 : NCH_CTX, nch = NCH - ch0;
        if (sub == 0 || (sub & 2)) for (int it = G - 1 - c; it < NB * nch * 4; it += G) { const int x = it >> 2; ml2_item(p, q2, l, x / nch, ch0 + x % nch, it & 3, ldsg, U, Y); }
        if (sub == 0 || (sub & 4)) for (int it = c; it < NB * nch; it += G) lru2_item(q2, q.Y16, it / nch, ch0 + it % nch, ldsg);
        break; }
    case ST_OUTPROJ: opt_outproj(p, q, l, lds, G, bid, l + 1 == DEPTH); break;
    case ST_RPMID: rp_mid(p, q, q2.GLIST, l, ldsg, G, bid, l + 1 == DEPTH, sub != 0); break;
    case ST_GU: opt_moe_gu(p, q, l, lds, G, bid, sub); break;
    case ST_DOWN: opt_moe_down16(p, q, q2, l, lds, G, bid, sub); break;
    case ST_RPEND: { THREAD_IDS rp_end(p, q, q2, l, gw, ngw, lane, sub != 0 ? 0.f : 1.f); break; }
    }
}

#if ONE_LAUNCH
__global__ void __launch_bounds__(512, 2) k_mega(Args a) {
    extern __shared__ __attribute__((aligned(16))) unsigned char lds_raw[];
    volatile LAS unsigned* MISC = (volatile LAS unsigned*)((LAS unsigned char*)lds_raw + LDS_BYTES - 64);
    if (threadIdx.x < 16) MISC[threadIdx.x] = 0u;
    if ((threadIdx.x & 63) == 0) ((LAS int*)((LAS unsigned char*)lds_raw + WTAB_OFF))[HWID()] = threadIdx.x >> 6;
    __syncthreads();
    { const XcdBarrier b0 = xcd_barrier_post(kargs()->bar, MISC + 8); if (TIDX == 0) MISC[10] = b0.x; }
#define GRID_BAR() do { XcdBarrier b_; b_.bar = kargs()->bar; b_.st = MISC + 8; b_.x = MISC[10]; xcd_barrier(b_); } while (0)
    run_step(a, ST_INIT, 0, lds_raw); GRID_BAR();
    run_step(a, ST_RPFIRST, 0, lds_raw); GRID_BAR();
#pragma unroll 1
    for (int l = 0; l < DEPTH; ++l) {
#pragma unroll 1
        for (int s = ST_INPROJ; s <= ST_RPEND; ++s) { run_step(a, s, l, lds_raw); if (!(l == DEPTH - 1 && s == ST_RPEND)) GRID_BAR();
#ifdef MEGA_DUP_STEP
            if (s == MEGA_DUP_STEP) { run_step(a, s, l, lds_raw); GRID_BAR(); }
#endif
        }
    }
}
#else
template <int STEP>
__global__ void __launch_bounds__(512, 2) k_step(Args a, int l) {
    extern __shared__ __attribute__((aligned(16))) unsigned char lds_raw[];
    run_step(a, STEP, l, lds_raw);
}
template <int STEP> static void launch_step(const Args& a, int l, hipStream_t stream) {
    static bool attr = false;
    if (!attr) { (void)hipFuncSetAttribute((const void*)k_step<STEP>, hipFuncAttributeMaxDynamicSharedMemorySize, LDS_BYTES); attr = true; }
    hipLaunchKernelGGL(k_step<STEP>, dim3(256), dim3(512), LDS_BYTES, stream, a, l);
}
#endif

extern "C" void kernel_launch(void* const* d_in, const int* in_sizes, int n_in, void* d_out, int out_size, void* d_ws, size_t ws_size, hipStream_t stream) {
    static int grid_blocks = 0;
    if (!grid_blocks) {
        int dev = 0, cus = 0;
        (void)hipGetDevice(&dev); (void)hipDeviceGetAttribute(&cus, hipDeviceAttributeMultiprocessorCount, dev);
        grid_blocks = cus;
#if ONE_LAUNCH
        int per_cu = 0;
        (void)hipFuncSetAttribute((const void*)k_mega, hipFuncAttributeMaxDynamicSharedMemorySize, LDS_BYTES);
        (void)hipOccupancyMaxActiveBlocksPerMultiprocessor(&per_cu, (const void*)k_mega, 512, LDS_BYTES);
        if (per_cu < 1) fprintf(stderr, "kernel_launch: occupancy query reports %d workgroups per CU\n", per_cu);
#endif
        const BMap m = b_map();
        if (n_in != N_IN || m.total > ws_size) fprintf(stderr, "kernel_launch: bad n_in %d or workspace too small (%zu needed, %zu given)\n", n_in, m.total, ws_size);
    }
    Args a{}; fill_args(a, d_in, d_out, d_ws);
#if ONE_LAUNCH
    (void)hipMemsetAsync(a.bar, 0, XCD_BAR_WORDS * 4, stream);
    void* args[] = {&a};
    hipError_t e = hipLaunchCooperativeKernel((const void*)k_mega, dim3(grid_blocks), dim3(512), args, LDS_BYTES, stream);
    if (e != hipSuccess) fprintf(stderr, "cooperative launch failed: %s (grid %d)\n", hipGetErrorString(e), grid_blocks);
#else
#ifndef DUP_STEP
#define DUP_STEP -1
#endif
#ifndef DUP_SUB
#define DUP_SUB 0
#endif
#define LS(ST, l) do { launch_step<ST>(a, l, stream); if (ST == DUP_STEP) launch_step<ST>(a, (l) | (DUP_SUB << 8), stream); } while (0)
    LS(ST_INIT, 0); LS(ST_RPFIRST, 0);
    for (int l = 0; l < DEPTH; ++l) {
        LS(ST_INPROJ, l); LS(ST_PREP, l); LS(ST_MLAPROJ, l); LS(ST_MIX, l); LS(ST_OUTPROJ, l);
        LS(ST_RPMID, l); LS(ST_GU, l); LS(ST_DOWN, l); LS(ST_RPEND, l);
    }
#endif
}
```

```cpp
#include <hip/hip_runtime.h>
#define ONE_LAUNCH 1
#include <math.h>
#include <stdint.h>

#ifndef CFG_D_MODEL
#define CFG_D_MODEL 1024
#endif
#ifndef CFG_SEQ
#define CFG_SEQ 8192
#endif
#ifndef CFG_GRID_W
#define CFG_GRID_W 64
#endif
#ifndef CFG_CTX_LEN
#define CFG_CTX_LEN 256
#endif
#ifndef CFG_N_EXPERTS
#define CFG_N_EXPERTS 32
#endif
#ifndef CFG_D_EXPERT
#define CFG_D_EXPERT 1024
#endif

#ifdef HOST_TEST
#define HD inline
struct float4 { float x, y, z, w; };
static inline int atomic_add_i(int* p, int v) { int o = *p; *p = o + v; return o; }
#else
#define HD __device__ __forceinline__
static __device__ __forceinline__ int atomic_add_i(int* p, int v) { return atomicAdd(p, v); }
#endif

constexpr int D = CFG_D_MODEL, NB = 2, SEQ = CFG_SEQ, DEPTH = 2, GRID_W = CFG_GRID_W, CTX = CFG_CTX_LEN;
constexpr int TPB = CTX + SEQ;
constexpr int NT = NB * TPB;
constexpr int LW = 256, MLH = 4, MHD = 64, MW = 256;
constexpr int AH = 8, NOPE = 64, ROPE = 32, VD = 64, QRANK = 256, KVRANK = 128, QKD = NOPE + ROPE;
constexpr int DIN = 1440, DMIX = 1024;
constexpr int OFF_AX = 0, OFF_AG = 256, OFF_BQ = 512, OFF_BKV = 768, OFF_BKR = 896, OFF_MX = 928, OFF_MZ = 1184;
constexpr int NE = CFG_N_EXPERTS, TOPK = 4, DE = CFG_D_EXPERT;
constexpr float EPS = 1e-6f;

enum { I_X = 0, I_C, I_CTX, I_CCTX, I_N1G, I_N2G, I_WMOD, I_BMOD, I_WIN, I_WOUT, I_LCW, I_LCB, I_LWA, I_LBA, I_LWX, I_LBX, I_LLAM,
       I_QNG, I_WQB, I_KVNG, I_WKVB, I_MCW, I_MCB, I_MWQ, I_MWK, I_MWV, I_MWG, I_MBG, I_MNG, I_MSK, I_WR, I_BR, I_WGU, I_BGU, I_WD, I_BD, I_FG, N_IN };

struct P {
    const float* in[N_IN];
    float* out;
    float *MOD, *ROPET, *X, *H, *U, *XC, *LA, *LB, *HL, *QN, *KVN, *QF, *KVF, *Qr, *Kr, *Vr, *XCM, *QM, *KM, *VM, *IGF, *HM, *Y, *TOPG, *ACT, *YB;
    int *TOPE, *CNT, *LIST;
};

HD float sigmoid_f(float x) { return 1.f / (1.f + expf(-x)); }
HD float silu_f(float x) { return x * sigmoid_f(x); }
HD float logsigmoid_f(float x) { return fminf(x, 0.f) - log1pf(expf(-fabsf(x))); }
HD float gelu_f(float x) { return 0.5f * x * (1.f + tanhf(0.7978845608028654f * (x + 0.044715f * x * x * x))); }

HD int tok_b(int t) { return t / TPB; }
HD int tok_i(int t) { return t % TPB; }
HD bool tok_isctx(int t) { return tok_i(t) < CTX; }
HD int tok_cv(int t) { return tok_isctx(t) ? 2 : tok_b(t); }
HD const float* modp(const P& p, int l, int cv, int which) { return p.MOD + (((size_t)l * 3 + cv) * 6 + which) * D; }

template <int R>
HD void gemm_rx4(const float* (&a)[R], const float* B, int ldb, int K, float4 (&acc)[R]) {
    for (int k = 0; k < K; ++k) {
        const float4 bv = *(const float4*)(B + (size_t)k * ldb);
#pragma unroll
        for (int r = 0; r < R; ++r) { const float av = a[r][k]; acc[r].x += av * bv.x; acc[r].y += av * bv.y; acc[r].z += av * bv.z; acc[r].w += av * bv.w; }
    }
}

HD void nv_init(const P& p, long gtid, long nthr) {
    for (long it = gtid; it < (long)DEPTH * 6 * D; it += nthr) {
        const int l = (int)(it / (6 * D)), j = (int)(it % (6 * D));
        const float* w = p.in[I_WMOD] + (size_t)l * D * 6 * D + j;
        float a0 = 0.f, a1 = 0.f, a2 = 0.f;
        for (int k = 0; k < D; ++k) { const float wv = w[(size_t)k * 6 * D];
            a0 += silu_f(p.in[I_C][k]) * wv; a1 += silu_f(p.in[I_C][D + k]) * wv; a2 += silu_f(p.in[I_CCTX][k]) * wv; }
        const float bb = p.in[I_BMOD][(size_t)l * 6 * D + j];
        p.MOD[((size_t)l * 3 + 0) * 6 * D + j] = a0 + bb; p.MOD[((size_t)l * 3 + 1) * 6 * D + j] = a1 + bb; p.MOD[((size_t)l * 3 + 2) * 6 * D + j] = a2 + bb;
    }
    for (long it = gtid; it < (long)NT * D; it += nthr) {
        const int t = (int)(it / D), k = (int)(it % D), b = tok_b(t), i = tok_i(t);
        p.X[it] = (i < CTX) ? p.in[I_CTX][((size_t)b * CTX + i) * D + k] : p.in[I_X][((size_t)b * SEQ + (i - CTX)) * D + k];
    }
    for (long it = gtid; it < (long)SEQ * 16; it += nthr) {
        const int s = (int)(it / 16), a = (int)((it / 8) & 1), f = (int)(it & 7);
        const int pos = a == 0 ? s / GRID_W : s % GRID_W;
        const double fr = pow(10000.0, -(double)f / 8.0);
        const float frf = (float)fr;
        const double ang = (double)((float)pos * frf);
        p.ROPET[it * 2] = (float)cos(ang); p.ROPET[it * 2 + 1] = (float)sin(ang);
    }
}

HD void nv_norm(const P& p, int l, int which  , long gtid, long nthr) {
    const float* g = p.in[which == 0 ? I_N1G : I_N2G] + (size_t)l * D;
    for (long t = gtid; t < NT; t += nthr) {
        const float* x = p.X + (size_t)t * D; float ss = 0.f;
        for (int k = 0; k < D; ++k) ss += x[k] * x[k];
        const float rstd = 1.f / sqrtf(ss / (float)D + EPS);
        const int cv = tok_cv((int)t); const float* sh = modp(p, l, cv, which == 0 ? 0 : 3); const float* sc = modp(p, l, cv, which == 0 ? 1 : 4);
        float* h = p.H + (size_t)t * D;
        for (int k = 0; k < D; ++k) h[k] = x[k] * rstd * g[k] * (1.f + sc[k]) + sh[k];
    }
}

HD void nv_inproj(const P& p, int l, long gtid, long nthr) {
    constexpr int R = 8, NQ = DIN / 4; const float* W = p.in[I_WIN] + (size_t)l * D * DIN;
    for (long it = gtid; it < (long)(NT / R) * NQ; it += nthr) {
        const int mi = (int)(it / NQ), n = (int)(it % NQ) * 4;
        const float* a[R]; float4 acc[R];
#pragma unroll
        for (int r = 0; r < R; ++r) { a[r] = p.H + (size_t)(mi * R + r) * D; acc[r] = float4{0.f, 0.f, 0.f, 0.f}; }
        gemm_rx4<R>(a, W + n, DIN, D, acc);
#pragma unroll
        for (int r = 0; r < R; ++r) *(float4*)(p.U + (size_t)(mi * R + r) * DIN + n) = acc[r];
    }
}

HD float conv_at(const P& p, int t, int col, int c, const float* w  , const float* bias) {
    const int i = tok_i(t), isc = i < CTX, li = isc ? i : i - CTX, len = isc ? CTX : SEQ;
    float s = bias[c];
#pragma unroll
    for (int k = 0; k < 4; ++k) { const int j = li + k - 2; if (j >= 0 && j < len) s += w[k * 256 + c] * p.U[(size_t)(t + k - 2) * DIN + col + c]; }
    return s;
}

HD void nv_prep1(const P& p, int l, long gtid, long nthr) {
    for (long it = gtid; it < (long)NT * 256; it += nthr) {
        const int t = (int)(it / 256), c = (int)(it % 256);
        p.XC[it] = conv_at(p, t, OFF_AX, c, p.in[I_LCW] + (size_t)l * 4 * 256, p.in[I_LCB] + (size_t)l * 256);
        p.XCM[it] = silu_f(conv_at(p, t, OFF_MX, c, p.in[I_MCW] + (size_t)l * 4 * 256, p.in[I_MCB] + (size_t)l * 256));
    }
    for (long t = gtid; t < NT; t += nthr) {
        const float* u = p.U + (size_t)t * DIN; float sq = 0.f, sk = 0.f;
        for (int k = 0; k < QRANK; ++k) sq += u[OFF_BQ + k] * u[OFF_BQ + k];
        for (int k = 0; k < KVRANK; ++k) sk += u[OFF_BKV + k] * u[OFF_BKV + k];
        const float rq = 1.f / sqrtf(sq / (float)QRANK + EPS), rk = 1.f / sqrtf(sk / (float)KVRANK + EPS);
        for (int k = 0; k < QRANK; ++k) p.QN[(size_t)t * QRANK + k] = u[OFF_BQ + k] * rq * p.in[I_QNG][(size_t)l * QRANK + k];
        for (int k = 0; k < KVRANK; ++k) p.KVN[(size_t)t * KVRANK + k] = u[OFF_BKV + k] * rk * p.in[I_KVNG][(size_t)l * KVRANK + k];
    }
}

HD void nv_prep2(const P& p, int l, long gtid, long nthr) {
    for (long it = gtid; it < (long)2 * NT * 256; it += nthr) {
        const int d = (int)(it / ((long)NT * 256)), t = (int)((it / 256) % NT), c = (int)(it % 256), g = c / 64, j = c % 64;
        const float* xc = p.XC + (size_t)t * 256 + g * 64;
        const float* wa = p.in[I_LWA] + ((((size_t)l * 2 + d) * 4 + g) * 64) * 64 + j;
        const float* wx = p.in[I_LWX] + ((((size_t)l * 2 + d) * 4 + g) * 64) * 64 + j;
        float sa = 0.f, sx = 0.f;
        for (int i = 0; i < 64; ++i) { sa += xc[i] * wa[i * 64]; sx += xc[i] * wx[i * 64]; }
        const float r = sigmoid_f(sa + p.in[I_LBA][((size_t)l * 2 + d) * 256 + c]), ig = sigmoid_f(sx + p.in[I_LBX][((size_t)l * 2 + d) * 256 + c]);
        const float log_a = 8.0f * r * logsigmoid_f(p.in[I_LLAM][((size_t)l * 2 + d) * 256 + c]);
        p.LA[it] = expf(log_a); p.LB[it] = sqrtf(-expm1f(2.f * log_a)) * ig * p.XC[(size_t)t * 256 + c];
    }
    { constexpr int R = 8, NQ = 768 / 4; const float* W = p.in[I_WQB] + (size_t)l * QRANK * 768;
      for (long it = gtid; it < (long)(NT / R) * NQ; it += nthr) { const int mi = (int)(it / NQ), n = (int)(it % NQ) * 4;
        const float* a[R]; float4 acc[R];
#pragma unroll
        for (int r = 0; r < R; ++r) { a[r] = p.QN + (size_t)(mi * R + r) * QRANK; acc[r] = float4{0.f, 0.f, 0.f, 0.f}; }
        gemm_rx4<R>(a, W + n, 768, QRANK, acc);
#pragma unroll
        for (int r = 0; r < R; ++r) *(float4*)(p.QF + (size_t)(mi * R + r) * 768 + n) = acc[r]; } }
    { constexpr int R = 8, NQ = 1024 / 4; const float* W = p.in[I_WKVB] + (size_t)l * KVRANK * 1024;
      for (long it = gtid; it < (long)(NT / R) * NQ; it += nthr) { const int mi = (int)(it / NQ), n = (int)(it % NQ) * 4;
        const float* a[R]; float4 acc[R];
#pragma unroll
        for (int r = 0; r < R; ++r) { a[r] = p.KVN + (size_t)(mi * R + r) * KVRANK; acc[r] = float4{0.f, 0.f, 0.f, 0.f}; }
        gemm_rx4<R>(a, W + n, 1024, KVRANK, acc);
#pragma unroll
        for (int r = 0; r < R; ++r) *(float4*)(p.KVF + (size_t)(mi * R + r) * 1024 + n) = acc[r]; } }
    for (long it = gtid; it < (long)NT * 256; it += nthr) {
        const int t = (int)(it / 256), c = (int)(it % 256), h = c / 64, j = c % 64;
        const float* xc = p.XCM + (size_t)t * 256 + h * 64; const float* ux = p.U + (size_t)t * DIN + OFF_MX + h * 64;
        const float* wq = p.in[I_MWQ] + (((size_t)l * 4 + h) * 64) * 64 + j; const float* wk = p.in[I_MWK] + (((size_t)l * 4 + h) * 64) * 64 + j; const float* wv = p.in[I_MWV] + (((size_t)l * 4 + h) * 64) * 64 + j;
        float sq = 0.f, sk = 0.f, sv = 0.f;
        for (int i = 0; i < 64; ++i) { sq += xc[i] * wq[i * 64]; sk += xc[i] * wk[i * 64]; sv += ux[i] * wv[i * 64]; }
        p.QM[it] = sq; p.KM[it] = sk * 0.125f; p.VM[it] = sv;
    }
}

HD void nv_prep3(const P& p, int l, long gtid, long nthr) {
    for (long it = gtid; it < (long)NB * 2 * 256; it += nthr) {
        const int b = (int)(it / 512), d = (int)((it / 256) & 1), c = (int)(it % 256);
        const float* A = p.LA + (size_t)d * NT * 256; const float* Bc = p.LB + (size_t)d * NT * 256; float* Ho = p.HL + (size_t)d * NT * 256;
        float h = 0.f;
        for (int seg = 0; seg < 2; ++seg) { const int base = b * TPB + (seg == 0 ? 0 : CTX), len = seg == 0 ? CTX : SEQ;
            for (int s = 0; s < len; ++s) { const int t = base + (d == 0 ? s : len - 1 - s);
                h = A[(size_t)t * 256 + c] * h + Bc[(size_t)t * 256 + c]; Ho[(size_t)t * 256 + c] = h; } }
    }
    for (long it = gtid; it < (long)NT * AH; it += nthr) {
        const int t = (int)(it / AH), h = (int)(it % AH), i = tok_i(t); const bool lat = i >= CTX; const int s = i - CTX;
        const float* qf = p.QF + (size_t)t * 768 + h * QKD; const float* kvf = p.KVF + (size_t)t * 1024 + h * (NOPE + VD); const float* kr = p.U + (size_t)t * DIN + OFF_BKR;
        float* qo = p.Qr + ((size_t)t * AH + h) * QKD; float* ko = p.Kr + ((size_t)t * AH + h) * QKD; float* vo = p.Vr + ((size_t)t * AH + h) * VD;
        for (int k = 0; k < NOPE; ++k) { qo[k] = qf[k]; ko[k] = kvf[k]; vo[k] = kvf[NOPE + k]; }
        for (int a = 0; a < 2; ++a) for (int f = 0; f < 8; ++f) {
            float cs = 1.f, sn = 0.f; if (lat) { cs = p.ROPET[(((size_t)s * 2 + a) * 8 + f) * 2]; sn = p.ROPET[(((size_t)s * 2 + a) * 8 + f) * 2 + 1]; }
            const float q1 = qf[NOPE + a * 16 + f], q2 = qf[NOPE + a * 16 + 8 + f], k1 = kr[a * 16 + f], k2 = kr[a * 16 + 8 + f];
            qo[NOPE + a * 16 + f] = q1 * cs - q2 * sn; qo[NOPE + a * 16 + 8 + f] = q2 * cs + q1 * sn;
            ko[NOPE + a * 16 + f] = k1 * cs - k2 * sn; ko[NOPE + a * 16 + 8 + f] = k2 * cs + k1 * sn; }
    }
    for (long it = gtid; it < (long)2 * NT * 8; it += nthr) {
        const int d = (int)(it / ((long)NT * 8)), t = (int)((it / 8) % NT), g = (int)(it % 8);
        const float* w = p.in[I_MWG] + (((size_t)l * 2 + d) * 768) * 8 + g; float s = p.in[I_MBG][((size_t)l * 2 + d) * 8 + g];
        for (int i = 0; i < 256; ++i) s += p.QM[(size_t)t * 256 + i] * w[(size_t)i * 8];
        for (int i = 0; i < 256; ++i) s += p.KM[(size_t)t * 256 + i] * w[(size_t)(256 + i) * 8];
        for (int i = 0; i < 256; ++i) s += p.VM[(size_t)t * 256 + i] * w[(size_t)(512 + i) * 8];
        p.IGF[it] = g < 4 ? s : logsigmoid_f(s);
    }
}

HD void nv_attn(const P& p, long gtid, long nthr) {
    const float scale = 1.0f / sqrtf((float)QKD);
    for (long it = gtid; it < (long)NT * AH; it += nthr) {
        const int h = (int)((it / TPB) % AH), b = (int)(it / ((long)TPB * AH)), i = (int)(it % TPB), t = b * TPB + i;
        const int nk = i < CTX ? CTX : TPB;
        float q[QKD], o[VD];
#pragma unroll
        for (int k = 0; k < QKD; ++k) q[k] = p.Qr[((size_t)t * AH + h) * QKD + k] * scale;
#pragma unroll
        for (int k = 0; k < VD; ++k) o[k] = 0.f;
        float m = -1e30f, lsum = 0.f;
        for (int j = 0; j < nk; ++j) {
            const float* kk = p.Kr + ((size_t)(b * TPB + j) * AH + h) * QKD; const float* vv = p.Vr + ((size_t)(b * TPB + j) * AH + h) * VD;
            float s = 0.f;
#pragma unroll
            for (int k = 0; k < QKD; ++k) s += q[k] * kk[k];
            if (s > m) { const float f = expf(m - s); lsum *= f;
#pragma unroll
                for (int k = 0; k < VD; ++k) o[k] *= f;
                m = s; }
            const float pr = expf(s - m); lsum += pr;
#pragma unroll
            for (int k = 0; k < VD; ++k) o[k] += pr * vv[k];
        }
        const float inv = 1.f / lsum;
#pragma unroll
        for (int k = 0; k < VD; ++k) p.Y[(size_t)t * DMIX + 256 + h * VD + k] = o[k] * inv;
    }
}
HD void nv_mlstm_scan(const P& p, long gtid, long nthr) {
    for (long it = gtid; it < (long)NB * MLH * 2 * 64; it += nthr) {
        const int v = (int)(it % 64), d = (int)((it / 64) & 1), h = (int)((it / 128) % MLH), b = (int)(it / (128 * MLH));
        float C[64], n[64];
#pragma unroll
        for (int k = 0; k < 64; ++k) { C[k] = 0.f; n[k] = 0.f; }
        float m = 0.f;
        for (int seg = 0; seg < 2; ++seg) { const int base = b * TPB + (seg == 0 ? 0 : CTX), len = seg == 0 ? CTX : SEQ;
            for (int s = 0; s < len; ++s) { const int t = base + (d == 0 ? s : len - 1 - s);
                const float ig = p.IGF[((size_t)d * NT + t) * 8 + h], lf = p.IGF[((size_t)d * NT + t) * 8 + 4 + h];
                const float mn = fmaxf(lf + m, ig), fd = expf(lf + m - mn), iw = expf(ig - mn); m = mn;
                const float* qq = p.QM + (size_t)t * 256 + h * 64; const float* kk = p.KM + (size_t)t * 256 + h * 64; const float vv = p.VM[(size_t)t * 256 + h * 64 + v];
                float num = 0.f, den = 0.f;
#pragma unroll
                for (int k = 0; k < 64; ++k) { const float kv = kk[k], qv = qq[k]; C[k] = fd * C[k] + iw * vv * kv; n[k] = fd * n[k] + iw * kv; num += C[k] * qv; den += n[k] * qv; }
                p.HM[((size_t)d * NT + t) * 256 + h * 64 + v] = num / fmaxf(fabsf(den), expf(-mn)); } }
    }
}
HD void nv_lru_out(const P& p, long gtid, long nthr) {
    for (long it = gtid; it < (long)NT * 256; it += nthr) { const int t = (int)(it / 256), c = (int)(it % 256);
        p.Y[(size_t)t * DMIX + c] = (p.HL[it] + p.HL[(size_t)NT * 256 + it]) * gelu_f(p.U[(size_t)t * DIN + OFF_AG + c]); }
}
HD void nv_mlstm_finish(const P& p, int l, long gtid, long nthr) {
    for (long it = gtid; it < (long)NT * MLH; it += nthr) { const int t = (int)(it / MLH), h = (int)(it % MLH);
        const float* h0 = p.HM + (size_t)t * 256 + h * 64; const float* h1 = p.HM + ((size_t)NT + t) * 256 + h * 64;
        float mu = 0.f; for (int j = 0; j < 64; ++j) mu += h0[j] + h1[j]; mu *= (1.f / 64.f);
        float var = 0.f; for (int j = 0; j < 64; ++j) { const float dlt = h0[j] + h1[j] - mu; var += dlt * dlt; } var *= (1.f / 64.f);
        const float rstd = 1.f / sqrtf(var + EPS);
        for (int j = 0; j < 64; ++j) { const int c = h * 64 + j;
            const float y = (h0[j] + h1[j] - mu) * rstd * p.in[I_MNG][(size_t)l * 256 + c] + p.in[I_MSK][(size_t)l * 256 + c] * p.XCM[(size_t)t * 256 + c];
            p.Y[(size_t)t * DMIX + 768 + c] = y * silu_f(p.U[(size_t)t * DIN + OFF_MZ + c]); } }
}
HD void nv_outproj(const P& p, int l, long gtid, long nthr) {
    constexpr int R = 8, NQ = D / 4; const float* W = p.in[I_WOUT] + (size_t)l * DMIX * D;
    for (long it = gtid; it < (long)(NT / R) * NQ; it += nthr) { const int mi = (int)(it / NQ), n = (int)(it % NQ) * 4;
        const float* a[R]; float4 acc[R];
#pragma unroll
        for (int r = 0; r < R; ++r) { a[r] = p.Y + (size_t)(mi * R + r) * DMIX; acc[r] = float4{0.f, 0.f, 0.f, 0.f}; }
        gemm_rx4<R>(a, W + n, D, DMIX, acc);
#pragma unroll
        for (int r = 0; r < R; ++r) { const int t = mi * R + r; const float* g1 = modp(p, l, tok_cv(t), 2) + n; float* x = p.X + (size_t)t * D + n;
            x[0] += g1[0] * acc[r].x; x[1] += g1[1] * acc[r].y; x[2] += g1[2] * acc[r].z; x[3] += g1[3] * acc[r].w; } }
}
HD void nv_zero_cnt(const P& p, long gtid, long nthr) { for (long i = gtid; i < NE; i += nthr) p.CNT[i] = 0; }
HD void nv_router(const P& p, int l, long gtid, long nthr) {
    for (long t = gtid; t < NT; t += nthr) {
        float lg[NE]; const float* h = p.H + (size_t)t * D; const float* W = p.in[I_WR] + (size_t)l * D * NE;
#pragma unroll
        for (int e = 0; e < NE; ++e) lg[e] = p.in[I_BR][(size_t)l * NE + e];
        for (int k = 0; k < D; ++k) { const float hv = h[k];
#pragma unroll
            for (int e = 0; e < NE; ++e) lg[e] += hv * W[(size_t)k * NE + e]; }
        int te[TOPK]; float tv[TOPK];
#pragma unroll
        for (int r = 0; r < TOPK; ++r) { float best = -3.0e38f; int bi = 0;
#pragma unroll
            for (int e = 0; e < NE; ++e) { const bool c = lg[e] > best; best = c ? lg[e] : best; bi = c ? e : bi; }
            te[r] = bi; tv[r] = best;
#pragma unroll
            for (int e = 0; e < NE; ++e) lg[e] = (e == bi) ? -3.0e38f : lg[e]; }
        float s = 0.f, ex[TOPK];
#pragma unroll
        for (int r = 0; r < TOPK; ++r) { ex[r] = expf(tv[r] - tv[0]); s += ex[r]; }
#pragma unroll
        for (int r = 0; r < TOPK; ++r) { p.TOPE[t * TOPK + r] = te[r]; p.TOPG[t * TOPK + r] = ex[r] / s;
            const int pos = atomic_add_i(&p.CNT[te[r]], 1); p.LIST[(size_t)te[r] * NT + pos] = (int)t * TOPK + r; }
    }
}
HD bool moe_item(const P& p, int R, long grp, int& e, int& r0) {
    long acc = 0;
    for (int x = 0; x < NE; ++x) { const int c = p.CNT[x], ng = (c + R - 1) / R; if (grp < acc + ng) { e = x; r0 = (int)(grp - acc) * R; return true; } acc += ng; }
    return false;
}
HD long moe_groups(const P& p, int R) { long acc = 0; for (int x = 0; x < NE; ++x) acc += (p.CNT[x] + R - 1) / R; return acc; }
HD void nv_moe_gu(const P& p, int l, long gtid, long nthr) {
    constexpr int R = 8, NQ = DE / 4; const long ngrp = moe_groups(p, R);
    for (long it = gtid; it < ngrp * NQ; it += nthr) { int e, r0; moe_item(p, R, it / NQ, e, r0); const int n = (int)(it % NQ) * 4, cnt = p.CNT[e];
        const float* Wg = p.in[I_WGU] + ((size_t)l * NE + e) * D * 2 * DE; const float* bg = p.in[I_BGU] + ((size_t)l * NE + e) * 2 * DE;
        const float* a[R]; int pr[R]; float4 ag[R], al[R];
#pragma unroll
        for (int r = 0; r < R; ++r) { const int rr = r0 + r < cnt ? r0 + r : cnt - 1; pr[r] = p.LIST[(size_t)e * NT + rr]; a[r] = p.H + (size_t)(pr[r] / TOPK) * D; ag[r] = float4{0.f, 0.f, 0.f, 0.f}; al[r] = float4{0.f, 0.f, 0.f, 0.f}; }
        gemm_rx4<R>(a, Wg + n, 2 * DE, D, ag);
        gemm_rx4<R>(a, Wg + DE + n, 2 * DE, D, al);
#pragma unroll
        for (int r = 0; r < R; ++r) if (r0 + r < cnt) { float gv[4] = {ag[r].x + bg[n], ag[r].y + bg[n + 1], ag[r].z + bg[n + 2], ag[r].w + bg[n + 3]};
            float lv[4] = {al[r].x + bg[DE + n], al[r].y + bg[DE + n + 1], al[r].z + bg[DE + n + 2], al[r].w + bg[DE + n + 3]};
#pragma unroll
            for (int q = 0; q < 4; ++q) { const float glu = fminf(gv[q], 7.0f), lin = fminf(fmaxf(lv[q], -7.0f), 7.0f);
                p.ACT[(size_t)pr[r] * DE + n + q] = glu * sigmoid_f(1.702f * glu) * (lin + 1.f); } }
    }
}
HD void nv_moe_down(const P& p, int l, long gtid, long nthr) {
    constexpr int R = 8, NQ = D / 4; const long ngrp = moe_groups(p, R);
    for (long it = gtid; it < ngrp * NQ; it += nthr) { int e, r0; moe_item(p, R, it / NQ, e, r0); const int n = (int)(it % NQ) * 4, cnt = p.CNT[e];
        const float* Wd = p.in[I_WD] + ((size_t)l * NE + e) * DE * D; const float* bd = p.in[I_BD] + ((size_t)l * NE + e) * D;
        const float* a[R]; int pr[R]; float4 acc[R];
#pragma unroll
        for (int r = 0; r < R; ++r) { const int rr = r0 + r < cnt ? r0 + r : cnt - 1; pr[r] = p.LIST[(size_t)e * NT + rr]; a[r] = p.ACT + (size_t)pr[r] * DE; acc[r] = float4{0.f, 0.f, 0.f, 0.f}; }
        gemm_rx4<R>(a, Wd + n, D, DE, acc);
#pragma unroll
        for (int r = 0; r < R; ++r) if (r0 + r < cnt) { const float g = p.TOPG[pr[r]]; float* y = p.YB + (size_t)pr[r] * D + n;
            y[0] = g * (acc[r].x + bd[n]); y[1] = g * (acc[r].y + bd[n + 1]); y[2] = g * (acc[r].z + bd[n + 2]); y[3] = g * (acc[r].w + bd[n + 3]); }
    }
}
HD void nv_combine(const P& p, int l, long gtid, long nthr) {
    for (long it = gtid; it < (long)NT * D; it += nthr) { const int t = (int)(it / D), n = (int)(it % D);
        const float s = ((p.YB[((size_t)t * 4 + 0) * D + n] + p.YB[((size_t)t * 4 + 1) * D + n]) + p.YB[((size_t)t * 4 + 2) * D + n]) + p.YB[((size_t)t * 4 + 3) * D + n];
        p.X[it] += modp(p, l, tok_cv(t), 5)[n] * s; }
}
HD void nv_final(const P& p, long gtid, long nthr) {
    for (long r = gtid; r < (long)NB * SEQ; r += nthr) { const int b = (int)(r / SEQ), s = (int)(r % SEQ), t = b * TPB + CTX + s;
        const float* x = p.X + (size_t)t * D; float ss = 0.f;
        for (int k = 0; k < D; ++k) ss += x[k] * x[k];
        const float rstd = 1.f / sqrtf(ss / (float)D + EPS);
        for (int k = 0; k < D; ++k) p.out[(size_t)r * D + k] = x[k] * rstd * p.in[I_FG][k]; }
}

constexpr int PH_PER_LAYER = 13, N_PHASES = 1 + DEPTH * PH_PER_LAYER + 1;
HD void nv_run_phase(const P& p, int ph, long gtid, long nthr) {
    if (ph == 0) { nv_init(p, gtid, nthr); return; }
    if (ph == N_PHASES - 1) { nv_final(p, gtid, nthr); return; }
    const int l = (ph - 1) / PH_PER_LAYER, s = (ph - 1) % PH_PER_LAYER;
    switch (s) {
        case 0: nv_norm(p, l, 0, gtid, nthr); break;
        case 1: nv_inproj(p, l, gtid, nthr); break;
        case 2: nv_prep1(p, l, gtid, nthr); break;
        case 3: nv_prep2(p, l, gtid, nthr); break;
        case 4: nv_prep3(p, l, gtid, nthr); break;
        case 5: nv_mlstm_scan(p, gtid, nthr); nv_attn(p, gtid, nthr); nv_lru_out(p, gtid, nthr); break;
        case 6: nv_mlstm_finish(p, l, gtid, nthr); break;
        case 7: nv_outproj(p, l, gtid, nthr); break;
        case 8: nv_norm(p, l, 1, gtid, nthr); nv_zero_cnt(p, gtid, nthr); break;
        case 9: nv_router(p, l, gtid, nthr); break;
        case 10: nv_moe_gu(p, l, gtid, nthr); break;
        case 11: nv_moe_down(p, l, gtid, nthr); break;
        case 12: nv_combine(p, l, gtid, nthr); break;
    }
}

struct WsMap { size_t off[32]; size_t total; };
static inline WsMap ws_map() {
    WsMap m; size_t o = 0; int i = 0;
    auto add = [&](size_t n) { m.off[i++] = o; o += (n + 63) & ~(size_t)63; };
    add((size_t)DEPTH * 3 * 6 * D);
    add((size_t)SEQ * 16 * 2);
    add((size_t)NT * D);
    add((size_t)NT * D);
    add((size_t)NT * DIN);
    add((size_t)NT * 256);
    add((size_t)2 * NT * 256);
    add((size_t)2 * NT * 256);
    add((size_t)2 * NT * 256);
    add((size_t)NT * QRANK);
    add((size_t)NT * KVRANK);
    add((size_t)NT * 768);
    add((size_t)NT * 1024);
    add((size_t)NT * AH * QKD);
    add((size_t)NT * AH * QKD);
    add((size_t)NT * AH * VD);
    add((size_t)NT * 256);
    add((size_t)NT * 256);
    add((size_t)NT * 256);
    add((size_t)NT * 256);
    add((size_t)2 * NT * 8);
    add((size_t)2 * NT * 256);
    add((size_t)NT * DMIX);
    add((size_t)NT * TOPK);
    add((size_t)NT * TOPK * DE);
    add((size_t)NT * TOPK * D);
    add((size_t)NT * TOPK);
    add((size_t)64);
    add((size_t)NE * NT);
    m.total = o; return m;
}
static inline void fill_params(P& p, void* const* d_in, void* d_out, void* d_ws) {
    for (int i = 0; i < N_IN; ++i) p.in[i] = (const float*)d_in[i];
    p.out = (float*)d_out; float* w = (float*)d_ws; const WsMap m = ws_map();
    p.MOD = w + m.off[0]; p.ROPET = w + m.off[1]; p.X = w + m.off[2]; p.H = w + m.off[3]; p.U = w + m.off[4]; p.XC = w + m.off[5]; p.LA = w + m.off[6]; p.LB = w + m.off[7]; p.HL = w + m.off[8];
    p.QN = w + m.off[9]; p.KVN = w + m.off[10]; p.QF = w + m.off[11]; p.KVF = w + m.off[12]; p.Qr = w + m.off[13]; p.Kr = w + m.off[14]; p.Vr = w + m.off[15];
    p.XCM = w + m.off[16]; p.QM = w + m.off[17]; p.KM = w + m.off[18]; p.VM = w + m.off[19]; p.IGF = w + m.off[20]; p.HM = w + m.off[21]; p.Y = w + m.off[22];
    p.TOPG = w + m.off[23]; p.ACT = w + m.off[24]; p.YB = w + m.off[25]; p.TOPE = (int*)(w + m.off[26]); p.CNT = (int*)(w + m.off[27]); p.LIST = (int*)(w + m.off[28]);
}
extern __shared__ __attribute__((aligned(16))) unsigned char g_lds_base[];
constexpr int WTAB_OFF = 148480 - 64 - 256;
#define HWID() ((int)__builtin_amdgcn_s_getreg((5 << 11) | 4) & 63)
#if ONE_LAUNCH
__device__ __forceinline__ int tidx_() {
    unsigned z = 0u; asm volatile("" : "+v"(z));
    const int lane = (int)__builtin_amdgcn_mbcnt_hi(~0u, __builtin_amdgcn_mbcnt_lo(~0u, z));
    const int wv = __builtin_amdgcn_readfirstlane(((const volatile __attribute__((address_space(3))) int*)((__attribute__((address_space(3))) unsigned char*)g_lds_base + WTAB_OFF))[HWID()]);
    return wv * 64 + lane;
}
#define TIDX tidx_()
#else
#define TIDX ((int)threadIdx.x)
#endif
namespace pg8 {
#define PG8_LAS __attribute__((address_space(3)))
typedef unsigned short bf16_t;
typedef short bf16x8 __attribute__((ext_vector_type(8)));
typedef float f32x4 __attribute__((ext_vector_type(4)));
typedef unsigned u32x4 __attribute__((ext_vector_type(4)));
constexpr int BM = 256, BK = 64, HALF = 128, HTB = HALF * BK * 2  , STAGE_BYTES = 8 * HTB, NXCD = 8, WGM = 8;

__host__ __device__ __forceinline__ int lds_byte(int r, int c) { const int st = (r >> 4) * 2 + (c >> 5), rr = r & 15, cc = c & 31, ob = rr * 64 + cc * 2; return st * 1024 + (ob ^ (((ob >> 9) & 1) << 5)); }
__host__ __device__ __forceinline__ void stage_rc(int b, int& R, int& C) { const int st = b / 1024, sb = b % 1024, swz = sb ^ (((sb >> 9) & 1) << 5); R = (st >> 1) * 16 + swz / 64; C = (st & 1) * 32 + (swz % 64) / 2; }
__host__ __device__ __forceinline__ int perm32(int rho) { const int n = rho >> 4, i = rho & 15; return 8 * (i >> 2) + 4 * n + (i & 3); }

struct Unit { int pm, pn, e, mb, slot; };
struct Gemm { const bf16_t* A; const bf16_t* Bt; int K; };

struct StaticOrder {
    int nM, nN, nwg, G, c;
    __device__ void init(int M, int N, int G_, int c_) { nM = M / BM; nN = N / BM; nwg = nM * nN; G = G_; c = c_; }
    __device__ bool next(int i, Unit& u) const {
        const long L = (long)i * G + c; if (L >= nwg) return false;
        int wgid = (int)L; { const int q = nwg / NXCD, r = nwg % NXCD, xcd = wgid % NXCD, off = wgid / NXCD; wgid = (xcd < r ? xcd * (q + 1) : r * (q + 1) + (xcd - r) * q) + off; }
        const int nig = WGM * nN, gid = wgid / nig, fm = gid * WGM, gsz = (nM - fm) < WGM ? (nM - fm) : WGM;
        u.pm = fm + ((wgid % nig) % gsz); u.pn = (wgid % nig) / gsz; u.e = 0; u.mb = 0; u.slot = 0; return true;
    }
    __device__ __forceinline__ int arow(const Unit& u, int r) const { return u.pm * BM + r; }
};

typedef float f32x2_c __attribute__((ext_vector_type(2))); typedef __bf16 bf16x2_c __attribute__((ext_vector_type(2)));
__device__ __forceinline__ unsigned cvt_pk_bf16(float lo, float hi) { f32x2_c v = {lo, hi}; bf16x2_c b = __builtin_convertvector(v, bf16x2_c); return __builtin_bit_cast(unsigned, b); }

template <class Epi, class Sched, bool ALIGN_EPI>
__device__ __forceinline__ void gemm_phase(PG8_LAS unsigned char* lds, const Gemm g, const Sched& S, const Epi& E) {
    int tid_ = TIDX; asm volatile("" : "+v"(tid_));
    const int tid = tid_, wid = __builtin_amdgcn_readfirstlane(tid >> 6), lane = tid & 63, wr = wid >> 2, wc = wid & 3, fr = lane & 15, fq = lane >> 4;
    const int K = g.K, nt = K / BK;
    unsigned voffB[2];
#pragma unroll
    for (int i = 0; i < 2; ++i) { int R, C; stage_rc(tid * 16 + i * 8192, R, C); const int Rb = Epi::PERM ? ((R & ~31) + perm32(R & 31)) : R;
        voffB[i] = (unsigned)(Rb * K + C) * 2u; }
    const size_t kstep = (size_t)(BK * 2);
    const size_t hstep = (size_t)HALF * K * 2;
    const size_t tstep = 2 * hstep;
    const unsigned ldsw = (unsigned)wid * 1024u;
    const int aoff = lds_byte(wr * 64 + fr, fq * 8), boff = lds_byte(wc * 32 + fr, fq * 8);
#define PG8_SA(b, h) (((b) * 2 + (h)) * HTB)
#define PG8_SB(b, h) ((4 + (b) * 2 + (h)) * HTB)
#define PG8_STAGE(bufoff, gbase, voff) do { _Pragma("unroll") for (int _i = 0; _i < 2; ++_i) \
        __builtin_amdgcn_global_load_lds((const unsigned*)((const char*)(gbase) + (voff)[_i]), (PG8_LAS unsigned*)(lds + (bufoff) + ldsw + _i * 8192), 16, 0, 0); } while (0)
#define PG8_LDA(dst, b, h) do { _Pragma("unroll") for (int m = 0; m < 4; ++m) _Pragma("unroll") for (int k = 0; k < 2; ++k) dst[m][k] = *(const PG8_LAS bf16x8*)(lds + PG8_SA(b, h) + aoff + m * 2048 + k * 1024); } while (0)
#define PG8_LDB(dst, b, h) do { _Pragma("unroll") for (int n = 0; n < 2; ++n) _Pragma("unroll") for (int k = 0; k < 2; ++k) dst[n][k] = *(const PG8_LAS bf16x8*)(lds + PG8_SB(b, h) + boff + n * 2048 + k * 1024); } while (0)
#define PG8_MMA(ai, bj, At, Bt) do { __builtin_amdgcn_s_setprio(1); _Pragma("unroll") for (int m = 0; m < 4; ++m) _Pragma("unroll") for (int n = 0; n < 2; ++n) _Pragma("unroll") for (int k = 0; k < 2; ++k) \
        acc[ai][bj][m][n] = __builtin_amdgcn_mfma_f32_16x16x32_bf16(Bt[n][k], At[m][k], acc[ai][bj][m][n], 0, 0, 0); __builtin_amdgcn_s_setprio(0); } while (0)
#define PG8_WAIT_V(n) asm volatile("s_waitcnt vmcnt(" #n ")" ::: "memory")
#define PG8_WAIT_L(n) asm volatile("s_waitcnt lgkmcnt(" #n ")" ::: "memory")
#define PG8_BAR __builtin_amdgcn_s_barrier()
#define PG8_SCHED __builtin_amdgcn_sched_barrier(0)
#define PG8_AOFFS(dst, U) do { int _t = tid; asm volatile("" : "+v"(_t)); _Pragma("unroll") for (int _i = 0; _i < 2; ++_i) { int _R, _C; stage_rc(_t * 16 + _i * 8192, _R, _C); \
        _Pragma("unroll") for (int _h = 0; _h < 2; ++_h) dst[_h][_i] = (unsigned)(S.arow(U, _h * HALF + _R) * K + _C) * 2u; } } while (0)
    Unit cur, nxt; int ui = 0;
    if (!S.next(0, cur)) return;
    f32x4 acc[2][2][4][2];
#pragma unroll
    for (int a = 0; a < 2; ++a)
#pragma unroll
        for (int b = 0; b < 2; ++b)
#pragma unroll
            for (int m = 0; m < 4; ++m)
#pragma unroll
                for (int n = 0; n < 2; ++n) acc[a][b][m][n] = (f32x4){0.f, 0.f, 0.f, 0.f};
    bf16x8 At[4][2], B0[2][2], B1[2][2];
    unsigned vA[2][2];
    PG8_AOFFS(vA, cur);
    const char* gA = (const char*)g.A;
    const char* cB = (const char*)g.Bt + (size_t)cur.pn * tstep;
    PG8_STAGE(PG8_SB(0, 0), cB, voffB); PG8_STAGE(PG8_SB(0, 1), cB + hstep, voffB); PG8_STAGE(PG8_SA(0, 0), gA, vA[0]); PG8_STAGE(PG8_SA(0, 1), gA, vA[1]);
    if (wr == 1) PG8_BAR;
    PG8_WAIT_V(2); PG8_BAR;
    PG8_STAGE(PG8_SB(1, 0), cB + kstep, voffB); PG8_STAGE(PG8_SA(1, 0), gA + kstep, vA[0]); PG8_STAGE(PG8_SB(1, 1), cB + hstep + kstep, voffB);
    PG8_WAIT_V(6); PG8_BAR;
    for (;;) {
        const bool has_next = S.next(ui + 1, nxt);
        { unsigned nvA[2][2];
          if (has_next) { PG8_AOFFS(nvA, nxt); } else {
#pragma unroll
            for (int h = 0; h < 2; ++h)
#pragma unroll
                for (int i = 0; i < 2; ++i) nvA[h][i] = vA[h][i]; }
          *(PG8_LAS u32x4*)(lds + STAGE_BYTES + 1024 + tid * 16) = (u32x4){nvA[0][0], nvA[0][1], nvA[1][0], nvA[1][1]}; }
        const char* nB = has_next ? (const char*)g.Bt + (size_t)nxt.pn * tstep : cB;
#pragma unroll 1
        for (int t = 0; t < nt; t += 2) {
            const bool last = (t == nt - 2);
            const char* a1 = gA + (size_t)(t + 1) * kstep;
            const char* a2 = last ? gA : gA + (size_t)(t + 2) * kstep; const char* b2 = last ? nB : cB + (size_t)(t + 2) * kstep;
            const char* a3 = a2 + kstep; const char* b3 = b2 + kstep;
            unsigned o2[2][2];
            if (last) { const u32x4 nv = *(const PG8_LAS u32x4*)(lds + STAGE_BYTES + 1024 + tid * 16); o2[0][0] = nv.x; o2[0][1] = nv.y; o2[1][0] = nv.z; o2[1][1] = nv.w; }
            else {
#pragma unroll
                for (int h = 0; h < 2; ++h)
#pragma unroll
                    for (int i = 0; i < 2; ++i) o2[h][i] = vA[h][i]; }
            PG8_LDB(B0, 0, 0); PG8_LDB(B1, 0, 1); PG8_SCHED; PG8_LDA(At, 0, 0); PG8_STAGE(PG8_SA(1, 1), a1, vA[1]);
            PG8_WAIT_V(8); PG8_WAIT_L(0); PG8_BAR; PG8_MMA(0, 0, At, B0); PG8_MMA(0, 1, At, B1); PG8_BAR; PG8_SCHED;
            PG8_LDA(At, 0, 1); PG8_STAGE(PG8_SB(0, 0), b2, voffB); PG8_STAGE(PG8_SB(0, 1), b2 + hstep, voffB); PG8_STAGE(PG8_SA(0, 0), a2, o2[0]);
            PG8_WAIT_V(8); PG8_WAIT_L(0); PG8_BAR; PG8_MMA(1, 0, At, B0); PG8_MMA(1, 1, At, B1); PG8_BAR; PG8_SCHED;
            PG8_LDB(B0, 1, 0); PG8_LDB(B1, 1, 1); PG8_SCHED; PG8_LDA(At, 1, 0); PG8_STAGE(PG8_SA(0, 1), a2, o2[1]);
            PG8_WAIT_V(8); PG8_WAIT_L(0); PG8_BAR; PG8_MMA(0, 0, At, B0); PG8_MMA(0, 1, At, B1); PG8_BAR; PG8_SCHED;
            PG8_LDA(At, 1, 1); PG8_STAGE(PG8_SB(1, 0), b3, voffB); PG8_STAGE(PG8_SB(1, 1), b3 + hstep, voffB); PG8_STAGE(PG8_SA(1, 0), a3, o2[0]);
            PG8_WAIT_V(8); PG8_WAIT_L(0); PG8_BAR; PG8_MMA(1, 0, At, B0); PG8_MMA(1, 1, At, B1); PG8_BAR; PG8_SCHED;
        }
        if constexpr (ALIGN_EPI) { if (wr == 0) PG8_BAR; }
        E(acc, cur, wr, wc, fr, fq);
        if (!has_next) break;
#pragma unroll
        for (int a = 0; a < 2; ++a)
#pragma unroll
            for (int b = 0; b < 2; ++b)
#pragma unroll
                for (int m = 0; m < 4; ++m)
#pragma unroll
                    for (int n = 0; n < 2; ++n) acc[a][b][m][n] = (f32x4){0.f, 0.f, 0.f, 0.f};
        cur = nxt; cB = nB; ++ui;
        { const u32x4 nv = *(const PG8_LAS u32x4*)(lds + STAGE_BYTES + 1024 + tid * 16); vA[0][0] = nv.x; vA[0][1] = nv.y; vA[1][0] = nv.z; vA[1][1] = nv.w; }
        if constexpr (ALIGN_EPI) { if (wr == 1) PG8_BAR; }
    }
    PG8_WAIT_V(0);
    if constexpr (!ALIGN_EPI) { if (wr == 0) PG8_BAR; }
    PG8_BAR;
#undef PG8_SA
#undef PG8_SB
#undef PG8_STAGE
#undef PG8_LDA
#undef PG8_LDB
#undef PG8_MMA
#undef PG8_WAIT_V
#undef PG8_WAIT_L
#undef PG8_BAR
#undef PG8_SCHED
#undef PG8_AOFFS
}
}
#define LAS __attribute__((address_space(3)))
typedef unsigned short bf16;
typedef float f32x4 __attribute__((ext_vector_type(4)));
typedef unsigned u32x4 __attribute__((ext_vector_type(4)));
typedef unsigned u32x2 __attribute__((ext_vector_type(2)));

constexpr int NWAVES = 8, NTHREADS = 512;
constexpr int DINP = 1536;
constexpr int SLOT_MAX = NT * TOPK + NE * 256;

struct Q {
    bf16 *WtIn, *WtOut, *WtGu, *WtDn, *WtQb, *WtKvb;
    bf16 *H16, *Y16, *ACT16, *K16, *V16;
};

__device__ __forceinline__ unsigned f2bf(float f) { unsigned u = __builtin_bit_cast(unsigned, f); return (u + 0x7fffu + ((u >> 16) & 1u)) >> 16; }
__device__ __forceinline__ unsigned pk2(float lo, float hi) { return f2bf(lo) | (f2bf(hi) << 16); }
__device__ __forceinline__ float bf2f(unsigned short b) { return __builtin_bit_cast(float, (unsigned)b << 16); }

__device__ __forceinline__ void tr_decode(const P& p, const Q& q, bf16* WtKvbP, int it, const float*& src, int& N, bf16*& dst, int& ldk) {
    constexpr int I_GU = (D / 64) * (2 * DE / 64), I_DN = (DE / 64) * (D / 64);
    constexpr int I_IN = (D / 64) * ((DIN + 63) / 64), I_OUT = (DMIX / 64) * (D / 64), I_QB = (QRANK / 64) * (768 / 64), I_KVB = (KVRANK / 64) * (1024 / 64);
    constexpr int PER_L = NE * (I_GU + I_DN) + I_IN + I_OUT + I_QB + I_KVB;
    const int l = it / PER_L; int r = it % PER_L;
    if (r < NE * I_GU) { const int e = r / I_GU, rr = r % I_GU, kbs = D / 64, kb = rr % kbs, n0 = 64 * (rr / kbs);
        const int isl = n0 >= DE, j0 = n0 - isl * DE, drow0 = 256 * (j0 / 128) + 128 * isl + (j0 % 128);
        N = 2 * DE; ldk = D; src = p.in[I_WGU] + ((size_t)l * NE + e) * D * 2 * DE + (size_t)(64 * kb) * N + n0; dst = q.WtGu + ((size_t)l * NE + e) * 2 * DE * D + (size_t)drow0 * ldk + 64 * kb; return; } r -= NE * I_GU;
    if (r < NE * I_DN) { const int e = r / I_DN, rr = r % I_DN, kbs = DE / 64, kb = rr % kbs, n0 = 64 * (rr / kbs);
        N = D; ldk = DE; src = p.in[I_WD] + ((size_t)l * NE + e) * DE * D + (size_t)(64 * kb) * N + n0; dst = q.WtDn + ((size_t)l * NE + e) * D * DE + (size_t)n0 * ldk + 64 * kb; return; } r -= NE * I_DN;
    if (r < I_IN) { const int nb = (DIN + 63) / 64, kb = r / nb, n0 = 64 * (r % nb);
        const int n0c = n0 + 64 <= DIN ? n0 : DIN - 64; N = DIN; ldk = D; src = p.in[I_WIN] + (size_t)l * D * DIN + (size_t)(64 * kb) * N + n0c; dst = q.WtIn + (size_t)l * DINP * D + (size_t)n0c * ldk + 64 * kb; return; } r -= I_IN;
    if (r < I_OUT) { const int nb = D / 64, kb = r / nb, n0 = 64 * (r % nb); N = D; ldk = DMIX; src = p.in[I_WOUT] + (size_t)l * DMIX * D + (size_t)(64 * kb) * N + n0; dst = q.WtOut + (size_t)l * D * DMIX + (size_t)n0 * ldk + 64 * kb; return; } r -= I_OUT;
    if (r < I_QB) { const int nb = 768 / 64, kb = r / nb, n0 = 64 * (r % nb); N = 768; ldk = 256; src = p.in[I_WQB] + (size_t)l * QRANK * 768 + (size_t)(64 * kb) * N + n0; dst = WtKvbP + (size_t)l * 1792 * 256 + (size_t)n0 * ldk + 64 * kb; return; } r -= I_QB;
    { const int nb = 1024 / 64, kb = r / nb, n0 = 64 * (r % nb); N = 1024; ldk = 256; src = p.in[I_WKVB] + (size_t)l * KVRANK * 1024 + (size_t)(64 * kb) * N + n0; dst = WtKvbP + (size_t)l * 1792 * 256 + (size_t)(768 + n0) * ldk + 64 * kb; }
}
__device__ __forceinline__ void opt_convert_weights(const P& p, const Q& q, bf16* WtKvbP, LAS unsigned char* lds, int gw, int ngw, int wave, int lane) {
    LAS float* scr = (LAS float*)(lds + wave * 16640);
    constexpr int I_GU = (D / 64) * (2 * DE / 64), I_DN = (DE / 64) * (D / 64);
    constexpr int I_IN = (D / 64) * ((DIN + 63) / 64), I_OUT = (DMIX / 64) * (D / 64), I_QB = (QRANK / 64) * (768 / 64), I_KVB = (KVRANK / 64) * (1024 / 64);
    constexpr int PER_L = NE * (I_GU + I_DN) + I_IN + I_OUT + I_QB + I_KVB, REST = I_IN + I_OUT + I_QB + I_KVB;
    const int lr = lane >> 4, c4 = (lane & 15) * 4;
#ifdef BG_PROBE
    for (int x = gw; x < DEPTH * PER_L; x += ngw) {
        const float* src; bf16* dst; int N, ldk; tr_decode(p, q, WtKvbP, x, src, N, dst, ldk);
#else
    for (int x = gw; x < DEPTH * REST; x += ngw) {
        const float* src; bf16* dst; int N, ldk; tr_decode(p, q, WtKvbP, (x / REST) * PER_L + NE * (I_GU + I_DN) + x % REST, src, N, dst, ldk);
#endif
        f32x4 v[16];
#pragma unroll
        for (int i = 0; i < 16; ++i) v[i] = *(const f32x4*)(src + (size_t)(4 * i + lr) * N + c4);
#pragma unroll
        for (int i = 0; i < 16; ++i) { LAS float* d = scr + (4 * i + lr) * 65 + c4; d[0] = v[i].x; d[1] = v[i].y; d[2] = v[i].z; d[3] = v[i].w; }
        asm volatile("s_waitcnt lgkmcnt(0)" ::: "memory");
#pragma unroll
        for (int j = 0; j < 8; ++j) { const int n = 8 * j + (lane >> 3), c = lane & 7; const LAS float* sp = scr + (8 * c) * 65 + n;
            u32x4 o; o.x = pk2(sp[0 * 65], sp[1 * 65]); o.y = pk2(sp[2 * 65], sp[3 * 65]); o.z = pk2(sp[4 * 65], sp[5 * 65]); o.w = pk2(sp[6 * 65], sp[7 * 65]);
            *(u32x4*)(dst + (size_t)n * ldk + 8 * c) = o; }
        asm volatile("s_waitcnt lgkmcnt(0)" ::: "memory");
    }
    const long gt = (long)gw * 64 + lane, ngt = (long)ngw * 64;
    for (long i = gt; i < (long)DEPTH * (DINP - DIN) * D / 8; i += ngt) { const int l = (int)(i / ((DINP - DIN) * D / 8)); const long o = i % ((DINP - DIN) * D / 8);
        *(u32x4*)(q.WtIn + ((size_t)l * DINP + DIN) * D + o * 8) = (u32x4){0u, 0u, 0u, 0u}; }
    for (long i = gt; i < (long)DEPTH * 1024 * 16; i += ngt) { const long row = i >> 4, l = row >> 10, n = row & 1023; *(u32x4*)(WtKvbP + ((size_t)l * 1792 + 768 + n) * 256 + 128 + (i & 15) * 8) = (u32x4){0u, 0u, 0u, 0u}; }
}

struct BgConv {
    const float* wgu; const float* wdn; bf16* tgu; bf16* tdn;
    int it, stride, ph; unsigned ldsb;
    const float* src; bf16* dst; int N;
    static constexpr int I_GU = NE * (2 * DE / 32) * (D / 64), I_DN = NE * (D / 32) * (DE / 64), TOTAL = I_GU + I_DN, LDS_PER_WAVE = 8192;
    static_assert(D == 1024 && DE == 1024 && NE == 32, "BgConv decodes items by shifts");
    __device__ __forceinline__ void decode() {
#ifdef BG_PROBE
        const int it = this->it & 2047;
#endif
        if (it < I_GU) { const int e = it >> 10, nblk = (it >> 4) & 63, kb = it & 15, n0 = 32 * nblk, isl = n0 >= DE, j0 = n0 - isl * DE, drow0 = 256 * (j0 / 128) + 128 * isl + (j0 % 128);
            N = 2 * DE; src = wgu + ((size_t)e * D + 64 * kb) * (2 * DE) + n0; dst = tgu + ((size_t)e * 2 * DE + drow0) * D + 64 * kb; }
        else { const int r = it - I_GU, e = r >> 9, nblk = (r >> 4) & 31, kb = r & 15, n0 = 32 * nblk;
            N = D; src = wdn + ((size_t)e * DE + 64 * kb) * D + n0; dst = tdn + ((size_t)e * D + n0) * DE + 64 * kb; }
    }
    __device__ __forceinline__ void init(const P& p, const Q& q, int l, LAS unsigned char* lds, int gw, int ngw, int wave) {
        wgu = p.in[I_WGU] + (size_t)l * NE * D * 2 * DE; wdn = p.in[I_WD] + (size_t)l * NE * DE * D; tgu = q.WtGu + (size_t)l * NE * 2 * DE * D; tdn = q.WtDn + (size_t)l * NE * D * DE;
        it = gw; stride = ngw; ph = 0; ldsb = (unsigned)(uintptr_t)(lds + wave * LDS_PER_WAVE); src = nullptr; dst = nullptr; N = 0;
        if (it < TOTAL) decode();
    }
    __device__ __forceinline__ bool done() const { return it >= TOTAL; }
    __device__ __forceinline__ void collect(bool covered) {
        if (it >= TOTAL || ph != 3) return;
#ifdef BG_NO_RD
        it += stride; if (it < TOTAL) decode(); ph = 0; return;
#endif
        const int lane = (int)__builtin_amdgcn_mbcnt_hi(~0u, __builtin_amdgcn_mbcnt_lo(~0u, 0u));
        if (!covered) asm volatile("s_waitcnt vmcnt(0)" ::: "memory"); else asm volatile("" ::: "memory");
        const LAS f32x4* sp = (const LAS f32x4*)(ldsb + (unsigned)lane * 16u);
        f32x4 v[8];
#pragma unroll
        for (int i = 0; i < 8; ++i) v[i] = sp[i * 64];
        char* db = (char*)dst + (unsigned)((lane & 7) * (4 * D * 2) + (lane >> 3) * 16);
#pragma unroll
        for (int x = 0; x < 4; ++x) { u32x4 o; o.x = pg8::cvt_pk_bf16(v[0][x], v[1][x]); o.y = pg8::cvt_pk_bf16(v[2][x], v[3][x]); o.z = pg8::cvt_pk_bf16(v[4][x], v[5][x]); o.w = pg8::cvt_pk_bf16(v[6][x], v[7][x]);
            __builtin_nontemporal_store(o, (u32x4*)(db + x * (D * 2))); }
        asm volatile("" ::: "memory");
        it += stride; if (it < TOTAL) decode(); ph = 0;
    }
    __device__ __forceinline__ void issue() {
        if (it >= TOTAL) return;
#ifdef BG_NO_DMA
        if (false) {
#else
        if (ph < 2) {
#endif
            const int lane = (int)__builtin_amdgcn_mbcnt_hi(~0u, __builtin_amdgcn_mbcnt_lo(~0u, 0u));
            unsigned voff = (unsigned)(lane >> 3) * (unsigned)(N * 32) + (unsigned)(lane & 7) * 16u; const unsigned rstride = (unsigned)(N * 4), m0v = ldsb + 4096u * ph; const float* sb = src + (size_t)(4 * ph) * N; unsigned sv;
            asm volatile("s_mov_b32 %0, m0\n\ts_mov_b32 m0, %2\n\ts_nop 0\n\tglobal_load_lds_dwordx4 %1, %4 nt\n\t"
                         "s_add_u32 m0, m0, 0x400\n\tv_add_u32 %1, %3, %1\n\tglobal_load_lds_dwordx4 %1, %4 nt\n\t"
                         "s_add_u32 m0, m0, 0x400\n\tv_add_u32 %1, %3, %1\n\tglobal_load_lds_dwordx4 %1, %4 nt\n\t"
                         "s_add_u32 m0, m0, 0x400\n\tv_add_u32 %1, %3, %1\n\tglobal_load_lds_dwordx4 %1, %4 nt\n\t"
                         "s_mov_b32 m0, %0" : "=&s"(sv), "+v"(voff) : "s"(m0v), "s"(rstride), "s"(sb) : "memory", "scc");
        }
        ++ph;
    }
    __device__ __forceinline__ void drain() { while (it < TOTAL) { collect(false); issue(); } }
};

struct EpiInprojF32 {
    static constexpr bool PERM = false; float* U;
    __device__ __forceinline__ void operator()(const pg8::f32x4 (&acc)[2][2][4][2], const pg8::Unit& u, int wr, int wc, int fr, int fq) const {
#pragma unroll
        for (int ai = 0; ai < 2; ++ai)
#pragma unroll
            for (int m = 0; m < 4; ++m) { const int row = u.pm * 256 + ai * 128 + wr * 64 + m * 16 + fr;
#pragma unroll
                for (int bj = 0; bj < 2; ++bj)
#pragma unroll
                    for (int n = 0; n < 2; ++n) { const int c = u.pn * 256 + bj * 128 + wc * 32 + n * 16 + 4 * fq; if (c < DIN) *(pg8::f32x4*)(U + (size_t)row * DIN + c) = acc[ai][bj][m][n]; } }
    }
};
struct EpiOutproj {
    static constexpr bool PERM = false; float* X; const float* mod;   const float* xin; const float* cin;
    __device__ __forceinline__ void operator()(const pg8::f32x4 (&acc)[2][2][4][2], const pg8::Unit& u, int wr, int wc, int fr, int fq) const {
#pragma unroll
        for (int ai = 0; ai < 2; ++ai)
#pragma unroll
            for (int m = 0; m < 4; ++m) { const int row = u.pm * 256 + ai * 128 + wr * 64 + m * 16 + fr, b = row / TPB, i = row % TPB; const float* g1 = mod + ((size_t)(i < CTX ? 2 : b) * 6 + 2) * D;
                const float* base = xin ? (i < CTX ? cin + ((size_t)b * CTX + i) * D : xin + ((size_t)b * SEQ + (i - CTX)) * D) : X + (size_t)row * D;
#pragma unroll
                for (int bj = 0; bj < 2; ++bj)
#pragma unroll
                    for (int n = 0; n < 2; ++n) { const int c = u.pn * 256 + bj * 128 + wc * 32 + n * 16 + 4 * fq;
                        const pg8::f32x4 gv = *(const pg8::f32x4*)(g1 + c); *(pg8::f32x4*)(X + (size_t)row * D + c) = *(const pg8::f32x4*)(base + c) + gv * acc[ai][bj][m][n]; } }
    }
};
struct GroupedOrder {
    const int* CNT; const int* LIST; const LAS int* ut;
    __device__ void init(const int* cnt, const int* list, int nN, int G, int c, LAS int* tab) { CNT = cnt; LIST = list; ut = tab + 64;
        __syncthreads();
        if (TIDX == 0) { int a = 0; for (int e = 0; e < NE; ++e) { tab[e] = a; a += (cnt[e] + 255) >> 8; } tab[NE] = a; }
        __syncthreads();
        static_assert(NT < 65536, "row -> token map is 16-bit");
        if (TIDX < 16) { const int total = tab[NE] * nN; const long L = (long)TIDX * G + c; int pm = -1, pn = 0, e = 0, mb = 0;
            if (L < total) { int w = (int)L; { const int nx = pg8::NXCD, qq = total / nx, r = total % nx, xcd = w % nx, off = w / nx; w = (xcd < r ? xcd * (qq + 1) : r * (qq + 1) + (xcd - r) * qq) + off; }
                const int blk = w / nN, ntile = w % nN;
                for (int x = 1; x < NE; ++x) if (tab[x] <= blk) e = x;
                mb = blk - tab[e]; pm = blk; pn = e * nN + ntile; }
            tab[64 + TIDX * 4] = pm; tab[64 + TIDX * 4 + 1] = pn; tab[64 + TIDX * 4 + 2] = e; tab[64 + TIDX * 4 + 3] = mb; }
        __syncthreads(); }
    __device__ bool next(int i, pg8::Unit& u) const { if (i >= 15) return false; const int pm = ut[i * 4]; if (pm < 0) return false; u.pm = pm; u.pn = ut[i * 4 + 1]; u.e = ut[i * 4 + 2]; u.mb = ut[i * 4 + 3]; u.slot = i; return true; }
};
struct GuOrder : GroupedOrder {
    const LAS unsigned short* rowtok;
    __device__ void init_rows(LAS unsigned short* rt) { rowtok = rt;
        for (int x = TIDX; x < 15 * 256; x += 512) { const int i = x >> 8, r = x & 255, pm = ut[i * 4]; unsigned short v = 0;
            if (pm >= 0) { const int e = ut[i * 4 + 2], idx = ut[i * 4 + 3] * 256 + r; if (idx < CNT[e]) v = (unsigned short)(LIST[(size_t)e * NT + idx] >> 2); }
            rt[x] = v; }
        __syncthreads(); }
    __device__ __forceinline__ int arow(const pg8::Unit& u, int r) const { return rowtok[u.slot * 256 + r]; }
};
struct DnOrder : GroupedOrder {
    __device__ __forceinline__ int arow(const pg8::Unit& u, int r) const { return u.pm * 256 + r; }
};
struct EpiGu {
    static constexpr bool PERM = true; bf16* ACT; const float* bgu;   int nN; int probe_skip;
    __device__ __forceinline__ void operator()(const pg8::f32x4 (&acc)[2][2][4][2], const pg8::Unit& u, int wr, int wc, int fr, int fq) const {
        if (probe_skip) return;
        const int ntile = u.pn - u.e * nN, j0 = ntile * 128 + wc * 32 + 8 * fq; const float* bg = bgu + (size_t)u.e * 2 * DE;
        float bgl[8], bli[8];
#pragma unroll
        for (int x = 0; x < 8; ++x) { bgl[x] = bg[j0 + x]; bli[x] = bg[DE + j0 + x]; }
#pragma unroll
        for (int ai = 0; ai < 2; ++ai)
#pragma unroll
            for (int m = 0; m < 4; ++m) { const int row = u.pm * 256 + ai * 128 + wr * 64 + m * 16 + fr; float a[8];
#pragma unroll
                for (int n = 0; n < 2; ++n)
#pragma unroll
                    for (int x = 0; x < 4; ++x) { const float glu = fminf(acc[ai][0][m][n][x] + bgl[4 * n + x], 7.0f), lin = fminf(fmaxf(acc[ai][1][m][n][x] + bli[4 * n + x], -7.0f), 7.0f);
                        a[4 * n + x] = glu * __builtin_amdgcn_rcpf(1.f + __builtin_amdgcn_exp2f(-2.4554669595930157f * glu)) * (lin + 1.f); }
                u32x4 w; w.x = pg8::cvt_pk_bf16(a[0], a[1]); w.y = pg8::cvt_pk_bf16(a[2], a[3]); w.z = pg8::cvt_pk_bf16(a[4], a[5]); w.w = pg8::cvt_pk_bf16(a[6], a[7]);
                *(u32x4*)(ACT + (size_t)row * DE + j0) = w; }
    }
};
struct EpiDownF32 {
    static constexpr bool PERM = false; float* YB; const float* bd;   const float* TOPG; const int* CNT; const int* LIST; int nN;
    __device__ __forceinline__ void operator()(const pg8::f32x4 (&acc)[2][2][4][2], const pg8::Unit& u, int wr, int wc, int fr, int fq) const {
        const int ntile = u.pn - u.e * nN, cnt = CNT[u.e]; const float* b = bd + (size_t)u.e * D;
#pragma unroll
        for (int ai = 0; ai < 2; ++ai)
#pragma unroll
            for (int m = 0; m < 4; ++m) { const int idx = u.mb * 256 + ai * 128 + wr * 64 + m * 16 + fr;
                if (idx < cnt) { const int pr = LIST[(size_t)u.e * NT + idx]; const float g = TOPG[pr];
#pragma unroll
                    for (int bj = 0; bj < 2; ++bj)
#pragma unroll
                        for (int n = 0; n < 2; ++n) { const int c = ntile * 256 + bj * 128 + wc * 32 + n * 16 + 4 * fq; const pg8::f32x4 bv = *(const pg8::f32x4*)(b + c);
                            *(pg8::f32x4*)(YB + (size_t)pr * D + c) = (acc[ai][bj][m][n] + bv) * g; } } }
    }
};

__device__ __forceinline__ void opt_inproj(const P& p, const Q& q, int l, LAS unsigned char* lds, int G, int bid) {
    pg8::Gemm g{q.H16, q.WtIn + (size_t)l * DINP * D, D}; pg8::StaticOrder S; S.init(NT, DINP, G, bid);
    EpiInprojF32 E{p.U}; pg8::gemm_phase<EpiInprojF32, pg8::StaticOrder, true>(lds, g, S, E);
}
struct LatentOrder : pg8::StaticOrder {
    __device__ bool next(int i, pg8::Unit& u) const { if (!pg8::StaticOrder::next(i, u)) return false; constexpr int TL = SEQ / 256, TC = CTX / 256; u.pm = (u.pm / TL) * (TL + TC) + TC + u.pm % TL; return true; }
};
__device__ __forceinline__ void opt_outproj(const P& p, const Q& q, int l, LAS unsigned char* lds, int G, int bid, bool latent_only) {
    pg8::Gemm g{q.Y16, q.WtOut + (size_t)l * D * DMIX, DMIX}; EpiOutproj E{p.X, p.MOD + (size_t)l * 3 * 6 * D, l == 0 ? p.in[I_X] : nullptr, p.in[I_CTX]};
    if (latent_only) { LatentOrder S; S.init(NB * SEQ, D, G, bid); pg8::gemm_phase<EpiOutproj, LatentOrder, true>(lds, g, S, E); }
    else { pg8::StaticOrder S; S.init(NT, D, G, bid); pg8::gemm_phase<EpiOutproj, pg8::StaticOrder, true>(lds, g, S, E); }
}
__device__ __forceinline__ void opt_moe_gu(const P& p, const Q& q, int l, LAS unsigned char* lds, int G, int bid, int probe_skip = 0) {
    pg8::Gemm g{q.H16, q.WtGu + (size_t)l * NE * 2 * DE * D, D}; GuOrder S; S.init(p.CNT, p.LIST, 2 * DE / 256, G, bid, (LAS int*)(lds + pg8::STAGE_BYTES)); S.init_rows((LAS unsigned short*)(lds + pg8::STAGE_BYTES + 1024 + 8192));
    EpiGu E{q.ACT16, p.in[I_BGU] + (size_t)l * NE * 2 * DE, 2 * DE / 256, probe_skip}; pg8::gemm_phase<EpiGu, GuOrder, true>(lds, g, S, E);
}
__device__ __forceinline__ void opt_moe_down(const P& p, const Q& q, int l, LAS unsigned char* lds, int G, int bid) {
    pg8::Gemm g{q.ACT16, q.WtDn + (size_t)l * NE * D * DE, DE}; DnOrder S; S.init(p.CNT, p.LIST, D / 256, G, bid, (LAS int*)(lds + pg8::STAGE_BYTES));
    EpiDownF32 E{p.YB, p.in[I_BD] + (size_t)l * NE * D, p.TOPG, p.CNT, p.LIST, D / 256}; pg8::gemm_phase<EpiDownF32, DnOrder, true>(lds, g, S, E);
}
namespace att {
using bf16x8 = __attribute__((ext_vector_type(8))) short;
using s16x4  = __attribute__((ext_vector_type(4))) short;
using f32x16 = __attribute__((ext_vector_type(16))) float;
using f32x8  = __attribute__((ext_vector_type(8))) float;
using u32x4  = __attribute__((ext_vector_type(4))) unsigned;
constexpr int DK = 96, DV = 64, NW = 8, QBLK = 32, KVBLK = 64;
constexpr float SCALE = 0.10206207261596575f;
#ifndef ATTN_THR
#define ATTN_THR 8.f
#endif
constexpr float THR = ATTN_THR;
#ifndef ATTN_SM_SPLIT
#define ATTN_SM_SPLIT 0
#endif
#ifndef ATTN_NEGM
#define ATTN_NEGM 1
#endif
constexpr float QPRESCALE = ATTN_NEGM ? SCALE * 1.4426950408889634f : 1.f;
constexpr int KROW = 208;
constexpr int SHM_K = KVBLK * KROW, SHM_V = KVBLK * DV * 2;
#ifndef ATTN_STAG
#define ATTN_STAG 0
#endif
#ifndef ATTN_LAG2
#define ATTN_LAG2 0
#endif
constexpr int NRING = (ATTN_LAG2 || ATTN_STAG) ? 4 : 3;
constexpr int SHM_Q = ATTN_STAG ? 256 * KROW : 0;
constexpr int SHM_ATTN = NRING * SHM_V + NRING * SHM_K + NW * 64 * 4 + SHM_Q;
#define KSWZ(row, colB) ((row) * KROW + (colB))
#define SBAR() __builtin_amdgcn_sched_barrier(0)
__device__ __forceinline__ int crow(int r, int hi) { return (r & 3) + 8 * (r >> 2) + 4 * hi; }
typedef float f32x2_t __attribute__((ext_vector_type(2))); typedef __bf16 bf16x2_t __attribute__((ext_vector_type(2)));
__device__ __forceinline__ unsigned cvtpk(float lo, float hi) { f32x2_t v = {lo, hi}; bf16x2_t b = __builtin_convertvector(v, bf16x2_t); return __builtin_bit_cast(unsigned, b); }
__device__ __forceinline__ bf16x8 tobf(f32x8 x) { u32x4 w = {cvtpk(x[0], x[1]), cvtpk(x[2], x[3]), cvtpk(x[4], x[5]), cvtpk(x[6], x[7])}; return *reinterpret_cast<bf16x8*>(&w); }

#if ATTN_NEGM
template <bool FIRST = false>
__device__ __forceinline__ void partialSM_n(f32x16& p0, f32x16& p1, f32x16& negm, float& alpha) {
  constexpr float THR2 = THR * 1.4426950408889634f;
  float pmax = p0[0];
#pragma unroll
  for (int r = 1; r < 16; ++r) pmax = fmaxf(pmax, p0[r]);
#pragma unroll
  for (int r = 0; r < 16; ++r) pmax = fmaxf(pmax, p1[r]);
  { auto rr = __builtin_amdgcn_permlane32_swap(__float_as_uint(pmax), __float_as_uint(pmax), false, false);
    pmax = fmaxf(__uint_as_float(rr[0]), __uint_as_float(rr[1])); }
  if (!FIRST && __builtin_expect(__all(pmax <= THR2), 1)) { alpha = 1.f; }
  else { const float dl = FIRST ? pmax : fmaxf(pmax, 0.f); alpha = FIRST ? 1.f : __builtin_amdgcn_exp2f(-dl);
#pragma unroll
    for (int r = 0; r < 16; ++r) { p0[r] -= dl; p1[r] -= dl; negm[r] -= dl; } }
}
__device__ __forceinline__ void finishSM_n(f32x16& p0, f32x16& p1, float alpha, float& l_reg, bf16x8& pa0, bf16x8& pa1, bf16x8& pa2, bf16x8& pa3) {
#pragma unroll
  for (int r = 0; r < 16; ++r) { p0[r] = __builtin_amdgcn_exp2f(p0[r]); p1[r] = __builtin_amdgcn_exp2f(p1[r]); }
  float ps = 0;
#pragma unroll
  for (int r = 0; r < 16; ++r) ps += p0[r];
#pragma unroll
  for (int r = 0; r < 16; ++r) ps += p1[r];
  { auto rr = __builtin_amdgcn_permlane32_swap(__float_as_uint(ps), __float_as_uint(ps), false, false);
    ps = __uint_as_float(rr[0]) + __uint_as_float(rr[1]); }
  l_reg = l_reg * alpha + ps;
#define PK4(P, BASE, OUT) do { unsigned a0 = cvtpk(P[BASE + 0], P[BASE + 1]), a1 = cvtpk(P[BASE + 2], P[BASE + 3]);   \
    unsigned b0 = cvtpk(P[BASE + 4], P[BASE + 5]), b1 = cvtpk(P[BASE + 6], P[BASE + 7]);                              \
    auto r0 = __builtin_amdgcn_permlane32_swap(a0, b0, false, false); auto r1 = __builtin_amdgcn_permlane32_swap(a1, b1, false, false); \
    u32x4 w = {r0[0], r1[0], r0[1], r1[1]}; OUT = *reinterpret_cast<bf16x8*>(&w); } while (0)
  PK4(p0, 0, pa0); PK4(p0, 8, pa1); PK4(p1, 0, pa2); PK4(p1, 8, pa3);
#undef PK4
}
__device__ __forceinline__ void qkt_n(f32x16& p0, f32x16& p1, const char* Ks, const bf16x8* qr, const f32x16& negm, int r32, int hi) {
#pragma unroll
  for (int d0 = 0; d0 < DK / 16; ++d0) { const int cb = (d0 * 16 + hi * 8) * 2;
    const bf16x8 b0 = *reinterpret_cast<const bf16x8*>(Ks + ((r32) * KROW + cb));
    const bf16x8 b1 = *reinterpret_cast<const bf16x8*>(Ks + ((32 + r32) * KROW + cb));
#if ATTN_STAG
    const bf16x8 qf = *reinterpret_cast<const bf16x8*>((const char*)qr + d0 * 32);
#else
    const bf16x8 qf = qr[d0];
#endif
    if (d0 == 0) { p0 = __builtin_amdgcn_mfma_f32_32x32x16_bf16(b0, qf, negm, 0, 0, 0); p1 = __builtin_amdgcn_mfma_f32_32x32x16_bf16(b1, qf, negm, 0, 0, 0); }
    else { p0 = __builtin_amdgcn_mfma_f32_32x32x16_bf16(b0, qf, p0, 0, 0, 0); p1 = __builtin_amdgcn_mfma_f32_32x32x16_bf16(b1, qf, p1, 0, 0, 0); } }
}
#endif
__device__ __forceinline__ void partialSM(f32x16& p0, f32x16& p1, float& m_reg, float& mn, float& alpha) {
  constexpr float C = SCALE * 1.4426950408889634f;
  float pmax = p0[0];
#pragma unroll
  for (int r = 1; r < 16; ++r) pmax = fmaxf(pmax, p0[r]);
#pragma unroll
  for (int r = 0; r < 16; ++r) pmax = fmaxf(pmax, p1[r]);
  { auto rr = __builtin_amdgcn_permlane32_swap(__float_as_uint(pmax), __float_as_uint(pmax), false, false);
    pmax = fmaxf(__uint_as_float(rr[0]), __uint_as_float(rr[1])); }
#if ATTN_SM_SPLIT == 2
  { const bool keep = __all(pmax - m_reg <= THR / SCALE); mn = keep ? m_reg : fmaxf(m_reg, pmax); alpha = __builtin_amdgcn_exp2f((m_reg - mn) * C); m_reg = mn;
    const float mnC = -mn * C;
#pragma unroll
    for (int r = 0; r < 16; ++r) { p0[r] = __builtin_amdgcn_exp2f(fmaf(p0[r], C, mnC)); p1[r] = __builtin_amdgcn_exp2f(fmaf(p1[r], C, mnC)); } }
  return;
#endif
  if (__builtin_expect(__all(pmax - m_reg <= THR / SCALE), 1)) { mn = m_reg; alpha = 1.f; }
  else { mn = fmaxf(m_reg, pmax); alpha = __builtin_amdgcn_exp2f((m_reg - mn) * C); m_reg = mn; }
#if ATTN_SM_SPLIT == 1
  const float mnC = -mn * C;
#pragma unroll
  for (int r = 0; r < 16; ++r) p0[r] = fmaf(p0[r], C, mnC);
#pragma unroll
  for (int r = 0; r < 16; ++r) p1[r] = fmaf(p1[r], C, mnC);
#pragma unroll
  for (int r = 0; r < 16; ++r) p0[r] = __builtin_amdgcn_exp2f(p0[r]);
#endif
}
__device__ __forceinline__ void finishSM(f32x16& p0, f32x16& p1, float mn, float alpha, float& l_reg, bf16x8& pa0, bf16x8& pa1, bf16x8& pa2, bf16x8& pa3) {
#if ATTN_SM_SPLIT == 1
#pragma unroll
  for (int r = 0; r < 16; ++r) p1[r] = __builtin_amdgcn_exp2f(p1[r]);
#elif ATTN_SM_SPLIT == 2
  (void)mn;
#else
  { constexpr float C = SCALE * 1.4426950408889634f; const float mnC = -mn * C;
#pragma unroll
    for (int r = 0; r < 16; ++r) { p0[r] = __builtin_amdgcn_exp2f(fmaf(p0[r], C, mnC)); p1[r] = __builtin_amdgcn_exp2f(fmaf(p1[r], C, mnC)); } }
#endif
  float ps = 0;
#pragma unroll
  for (int r = 0; r < 16; ++r) ps += p0[r];
#pragma unroll
  for (int r = 0; r < 16; ++r) ps += p1[r];
  { auto rr = __builtin_amdgcn_permlane32_swap(__float_as_uint(ps), __float_as_uint(ps), false, false);
    ps = __uint_as_float(rr[0]) + __uint_as_float(rr[1]); }
  l_reg = l_reg * alpha + ps;
#define PK4(P, BASE, OUT) do { unsigned a0 = cvtpk(P[BASE + 0], P[BASE + 1]), a1 = cvtpk(P[BASE + 2], P[BASE + 3]);   \
    unsigned b0 = cvtpk(P[BASE + 4], P[BASE + 5]), b1 = cvtpk(P[BASE + 6], P[BASE + 7]);                              \
    auto r0 = __builtin_amdgcn_permlane32_swap(a0, b0, false, false); auto r1 = __builtin_amdgcn_permlane32_swap(a1, b1, false, false); \
    u32x4 w = {r0[0], r1[0], r0[1], r1[1]}; OUT = *reinterpret_cast<bf16x8*>(&w); } while (0)
  PK4(p0, 0, pa0); PK4(p0, 8, pa1); PK4(p1, 0, pa2); PK4(p1, 8, pa3);
#undef PK4
}
__device__ __forceinline__ void qkt(f32x16& p0, f32x16& p1, const char* Ks, const bf16x8* qr, int r32, int hi) {
  p0 = f32x16{}; p1 = f32x16{};
#pragma unroll
  for (int d0 = 0; d0 < DK / 16; ++d0) { const int cb = (d0 * 16 + hi * 8) * 2;
    const bf16x8 b0 = *reinterpret_cast<const bf16x8*>(Ks + KSWZ(r32, cb));
    const bf16x8 b1 = *reinterpret_cast<const bf16x8*>(Ks + KSWZ(32 + r32, cb));
    p0 = __builtin_amdgcn_mfma_f32_32x32x16_bf16(b0, qr[d0], p0, 0, 0, 0);
    p1 = __builtin_amdgcn_mfma_f32_32x32x16_bf16(b1, qr[d0], p1, 0, 0, 0); }
}
__device__ __forceinline__ int v_st(int k, int c) { const int kk = (k & ~0xC) | ((k & 4) << 1) | ((k & 8) >> 1); return ((kk >> 3) * 2 + (c >> 5)) * 512 + ((kk & 7) * 32 + (c & 31)) * 2; }
__device__ __forceinline__ int v_rd_base(int lane) { return ((lane & 3) << 3) | (((lane >> 2) & 3) << 6) | (((lane >> 4) & 1) << 5) | (((lane >> 5) & 1) << 8); }
constexpr int v_rd_off(int d0, int ks, int half) { return d0 * 512 + ks * 2048 + half * 1024; }
template <int OFF> __device__ __forceinline__ s16x4 tr_read(int vb) {
  s16x4 r; asm volatile("ds_read_b64_tr_b16 %0, %1 offset:%2" : "=&v"(r) : "v"(vb), "i"(OFF) : "memory"); return r;
}
template <int D0> __device__ __forceinline__ void pv_one(f32x16& od, int vb, bf16x8 pa0, bf16x8 pa1, bf16x8 pa2, bf16x8 pa3) {
  const s16x4 l0 = tr_read<v_rd_off(D0, 0, 0)>(vb), h0 = tr_read<v_rd_off(D0, 0, 1)>(vb), l1 = tr_read<v_rd_off(D0, 1, 0)>(vb), h1 = tr_read<v_rd_off(D0, 1, 1)>(vb);
  const s16x4 l2 = tr_read<v_rd_off(D0, 2, 0)>(vb), h2 = tr_read<v_rd_off(D0, 2, 1)>(vb), l3 = tr_read<v_rd_off(D0, 3, 0)>(vb), h3 = tr_read<v_rd_off(D0, 3, 1)>(vb);
  asm volatile("s_waitcnt lgkmcnt(0)" ::: "memory"); SBAR();
#define PK(L, H) (bf16x8){L[0], L[1], L[2], L[3], H[0], H[1], H[2], H[3]}
  od = __builtin_amdgcn_mfma_f32_32x32x16_bf16(pa0, PK(l0, h0), od, 0, 0, 0);
  od = __builtin_amdgcn_mfma_f32_32x32x16_bf16(pa1, PK(l1, h1), od, 0, 0, 0);
  od = __builtin_amdgcn_mfma_f32_32x32x16_bf16(pa2, PK(l2, h2), od, 0, 0, 0);
  od = __builtin_amdgcn_mfma_f32_32x32x16_bf16(pa3, PK(l3, h3), od, 0, 0, 0);
#undef PK
}
__device__ __forceinline__ void pv_d0(f32x16* o, int vb, bf16x8 pa0, bf16x8 pa1, bf16x8 pa2, bf16x8 pa3) {
  pv_one<0>(o[0], vb, pa0, pa1, pa2, pa3); pv_one<1>(o[1], vb, pa0, pa1, pa2, pa3);
}

__device__ __forceinline__ void pv_sm(f32x16* o, int vb, bf16x8 pa0, bf16x8 pa1, bf16x8 pa2, bf16x8 pa3, f32x16& p0, f32x16& p1, float& m_reg, float& mn, float& alpha) {
  constexpr float C = SCALE * 1.4426950408889634f;
  const s16x4 l00 = tr_read<v_rd_off(0, 0, 0)>(vb), h00 = tr_read<v_rd_off(0, 0, 1)>(vb), l10 = tr_read<v_rd_off(1, 0, 0)>(vb), h10 = tr_read<v_rd_off(1, 0, 1)>(vb);
  const s16x4 l01 = tr_read<v_rd_off(0, 1, 0)>(vb), h01 = tr_read<v_rd_off(0, 1, 1)>(vb), l11 = tr_read<v_rd_off(1, 1, 0)>(vb), h11 = tr_read<v_rd_off(1, 1, 1)>(vb);
  const s16x4 l02 = tr_read<v_rd_off(0, 2, 0)>(vb), h02 = tr_read<v_rd_off(0, 2, 1)>(vb), l12 = tr_read<v_rd_off(1, 2, 0)>(vb), h12 = tr_read<v_rd_off(1, 2, 1)>(vb);
  const s16x4 l03 = tr_read<v_rd_off(0, 3, 0)>(vb), h03 = tr_read<v_rd_off(0, 3, 1)>(vb), l13 = tr_read<v_rd_off(1, 3, 0)>(vb), h13 = tr_read<v_rd_off(1, 3, 1)>(vb);
  float pmax = p0[0];
#pragma unroll
  for (int r = 1; r < 16; ++r) pmax = fmaxf(pmax, p0[r]);
#pragma unroll
  for (int r = 0; r < 16; ++r) pmax = fmaxf(pmax, p1[r]);
  { auto rr = __builtin_amdgcn_permlane32_swap(__float_as_uint(pmax), __float_as_uint(pmax), false, false);
    pmax = fmaxf(__uint_as_float(rr[0]), __uint_as_float(rr[1])); }
  const bool keep = __all(pmax - m_reg <= THR / SCALE); mn = keep ? m_reg : fmaxf(m_reg, pmax); alpha = __builtin_amdgcn_exp2f((m_reg - mn) * C); m_reg = mn;
  const float mnC = -mn * C;
  asm volatile("s_waitcnt lgkmcnt(0)" ::: "memory"); SBAR();
#define PK(L, H) (bf16x8){L[0], L[1], L[2], L[3], H[0], H[1], H[2], H[3]}
#define EX4(P, B) do { P[B] = __builtin_amdgcn_exp2f(fmaf(P[B], C, mnC)); P[B + 1] = __builtin_amdgcn_exp2f(fmaf(P[B + 1], C, mnC)); P[B + 2] = __builtin_amdgcn_exp2f(fmaf(P[B + 2], C, mnC)); P[B + 3] = __builtin_amdgcn_exp2f(fmaf(P[B + 3], C, mnC)); } while (0)
  o[0] = __builtin_amdgcn_mfma_f32_32x32x16_bf16(pa0, PK(l00, h00), o[0], 0, 0, 0); EX4(p0, 0); SBAR();
  o[1] = __builtin_amdgcn_mfma_f32_32x32x16_bf16(pa0, PK(l10, h10), o[1], 0, 0, 0); EX4(p0, 4); SBAR();
  o[0] = __builtin_amdgcn_mfma_f32_32x32x16_bf16(pa1, PK(l01, h01), o[0], 0, 0, 0); EX4(p0, 8); SBAR();
  o[1] = __builtin_amdgcn_mfma_f32_32x32x16_bf16(pa1, PK(l11, h11), o[1], 0, 0, 0); EX4(p0, 12); SBAR();
  o[0] = __builtin_amdgcn_mfma_f32_32x32x16_bf16(pa2, PK(l02, h02), o[0], 0, 0, 0); EX4(p1, 0); SBAR();
  o[1] = __builtin_amdgcn_mfma_f32_32x32x16_bf16(pa2, PK(l12, h12), o[1], 0, 0, 0); EX4(p1, 4); SBAR();
  o[0] = __builtin_amdgcn_mfma_f32_32x32x16_bf16(pa3, PK(l03, h03), o[0], 0, 0, 0); EX4(p1, 8); SBAR();
  o[1] = __builtin_amdgcn_mfma_f32_32x32x16_bf16(pa3, PK(l13, h13), o[1], 0, 0, 0); EX4(p1, 12); SBAR();
#undef PK
#undef EX4
}

struct NoBgWork { __device__ __forceinline__ void collect(bool) {} __device__ __forceinline__ void issue() {} };
template <class TQ, class Out, int VAR = 0, class BG = NoBgWork>
__device__ __forceinline__ void attn_unit(const TQ* Qb, int ldq, const unsigned short* Kh, const unsigned short* Vh, int seq, char* lds, const Out& OUT, BG&& bg = BG()) {
  int tid_ = TIDX; asm volatile("" : "+v"(tid_));
  const int tid = tid_, wid = tid >> 6, lane = tid & 63, r32 = lane & 31, hi = lane >> 5;
  char* V_lds = lds; char* K_lds = lds + NRING * SHM_V;
  float* ws = (float*)(lds + NRING * SHM_V + NRING * SHM_K) + wid * 64; float* li_l = ws; float* al_l = ws + 32;
  float m_reg = -1e30f, l_reg = 0; f32x16 o[2] = {}; f32x16 negm = {}; (void)negm;
#if ATTN_STAG
  char* Q_lds = lds + NRING * SHM_V + NRING * SHM_K + NW * 64 * 4;
  { static_assert(sizeof(TQ) == 2, "the stagger variant takes bf16 q rows");
#pragma unroll
    for (int k = 0; k < 6; ++k) { const int x = tid + k * 512, row = x / 12, c16 = x % 12; *(bf16x8*)(Q_lds + row * KROW + c16 * 16) = *reinterpret_cast<const bf16x8*>(Qb + (long)row * ldq + c16 * 8); } }
  const bf16x8* qr = reinterpret_cast<const bf16x8*>(Q_lds + (wid * QBLK + r32) * KROW + hi * 16);
#else
  bf16x8 qr[DK / 16];
  { const TQ* Qw = Qb + (long)(wid * QBLK + r32) * ldq + hi * 8;
#pragma unroll
    for (int d0 = 0; d0 < DK / 16; ++d0) {
      if constexpr (sizeof(TQ) == 4) qr[d0] = tobf(*reinterpret_cast<const f32x8*>(Qw + d0 * 16)); else qr[d0] = *reinterpret_cast<const bf16x8*>(Qw + d0 * 16); } }
#endif
  const int kc0 = tid, kc1 = 512 + tid; const bool two = tid < 256;
  const int kst0 = KSWZ(kc0 / 12, (kc0 % 12) * 16), kst1 = KSWZ(kc1 / 12, (kc1 % 12) * 16), vst = v_st(tid >> 3, (tid & 7) * 8);
  const int vb0 = (int)(uintptr_t)V_lds + v_rd_base(lane);
  struct { bf16x8 v, k0, k1; } sr_[ATTN_STAG ? 1 : 2];
#define SLOAD(i, key0) do { sr_[i].v = *reinterpret_cast<const bf16x8*>(Vh + (long)(key0) * DV + tid * 8); sr_[i].k0 = *reinterpret_cast<const bf16x8*>(Kh + (long)(key0) * DK + kc0 * 8); \
    if (two) sr_[i].k1 = *reinterpret_cast<const bf16x8*>(Kh + (long)(key0) * DK + kc1 * 8); } while (0)
#define SWRITE(b, i) do { *(bf16x8*)(V_lds + (b) * SHM_V + vst) = sr_[i].v; *(bf16x8*)(K_lds + (b) * SHM_K + kst0) = sr_[i].k0; if (two) *(bf16x8*)(K_lds + (b) * SHM_K + kst1) = sr_[i].k1; } while (0)
#define RESC(a) do { if (__any((a) < 1.f)) { if (hi == 0) al_l[r32] = (a); asm volatile("s_waitcnt lgkmcnt(0)" ::: "memory"); \
    _Pragma("unroll") for (int d = 0; d < 2; ++d) _Pragma("unroll") for (int r = 0; r < 16; ++r) o[d][r] *= al_l[crow(r, hi)]; } } while (0)
  f32x16 pA0 = {}, pA1 = {}, pB0 = {}, pB1 = {}; float mnA, mnB, alA, alB; bf16x8 pa0, pa1, pa2, pa3; const int NT = seq / KVBLK;
  constexpr int SE = 0, SO = 1;
#if ATTN_NEGM
#define PSM(p0_, p1_, m_, mn_, al_) do { (void)mn_; partialSM_n(p0_, p1_, negm, al_); } while (0)
#else
#define PSM(p0_, p1_, m_, mn_, al_) do { if constexpr (VAR == 1) { mn_ = 0.f; al_ = 1.f; } else partialSM(p0_, p1_, m_, mn_, al_); } while (0)
#endif
#define FSM(p0_, p1_, mn_, al_, l_, a0_, a1_, a2_, a3_) do { if constexpr (VAR == 1) { u32x4 w0_ = {cvtpk(p0_[0], p0_[1]), cvtpk(p0_[2], p0_[3]), cvtpk(p0_[4], p0_[5]), cvtpk(p0_[6], p0_[7])}; a0_ = *reinterpret_cast<bf16x8*>(&w0_); \
      u32x4 w1_ = {cvtpk(p0_[8], p0_[9]), cvtpk(p0_[10], p0_[11]), cvtpk(p0_[12], p0_[13]), cvtpk(p0_[14], p0_[15])}; a1_ = *reinterpret_cast<bf16x8*>(&w1_); \
      u32x4 w2_ = {cvtpk(p1_[0], p1_[1]), cvtpk(p1_[2], p1_[3]), cvtpk(p1_[4], p1_[5]), cvtpk(p1_[6], p1_[7])}; a2_ = *reinterpret_cast<bf16x8*>(&w2_); \
      u32x4 w3_ = {cvtpk(p1_[8], p1_[9]), cvtpk(p1_[10], p1_[11]), cvtpk(p1_[12], p1_[13]), cvtpk(p1_[14], p1_[15])}; a3_ = *reinterpret_cast<bf16x8*>(&w3_); } else { if constexpr (ATTN_NEGM != 0) finishSM_n(p0_, p1_, al_, l_, a0_, a1_, a2_, a3_); else finishSM(p0_, p1_, mn_, al_, l_, a0_, a1_, a2_, a3_); } } while (0)
#define PVSM(o_, vb_, a0_, a1_, a2_, a3_, p0_, p1_, m_, mn_, al_) do { if constexpr (VAR == 0 && ATTN_SM_SPLIT == 2) pv_sm(o_, vb_, a0_, a1_, a2_, a3_, p0_, p1_, m_, mn_, al_); else { PVD(o_, vb_, a0_, a1_, a2_, a3_); PSM(p0_, p1_, m_, mn_, al_); } } while (0)
#define PVD(o_, vb_, a0_, a1_, a2_, a3_) do { if constexpr (VAR == 2) { asm volatile("" : "+v"(o_[0]), "+v"(o_[1]) : "v"(a0_), "v"(a1_), "v"(a2_), "v"(a3_)); } else pv_d0(o_, vb_, a0_, a1_, a2_, a3_); } while (0)
#define QKT(p0_, p1_, K_, q_, r_, h_) do { if constexpr (VAR == 5) { asm volatile("" : "+v"(p0_), "+v"(p1_)); } else { if constexpr (ATTN_NEGM != 0) qkt_n(p0_, p1_, K_, q_, negm, r_, h_); else qkt(p0_, p1_, K_, q_, r_, h_); } } while (0)
#define LSLOAD(i_, k_) do { if constexpr (VAR != 3) SLOAD(i_, k_); } while (0)
#define LSWRITE(b_, i_) do { if constexpr (VAR != 3) SWRITE(b_, i_); } while (0)
#define LSYNC() do { if constexpr (VAR != 4) __syncthreads(); } while (0)
#if ATTN_STAG
  const bool lead = __builtin_amdgcn_readfirstlane(wid) < 4;
  SLOAD(SE, 0); asm volatile("s_waitcnt vmcnt(0)" ::: "memory"); SWRITE(0, SE); __syncthreads();
  QKT(pA0, pA1, K_lds, qr, r32, hi);
  SLOAD(SE, KVBLK);
  if (lead) partialSM_n<true>(pA0, pA1, negm, alA);
  SWRITE(1, SE); __syncthreads();
  LSLOAD(SE, 2 * KVBLK);
  if (lead) { SBAR(); QKT(pB0, pB1, K_lds + 1 * SHM_K, qr, r32, hi); FSM(pA0, pA1, mnA, alA, l_reg, pa0, pa1, pa2, pa3); SBAR();
      PVD(o, vb0 + 0 * SHM_V, pa0, pa1, pa2, pa3); PSM(pB0, pB1, m_reg, mnB, alB); }
  else { partialSM_n<true>(pA0, pA1, negm, alA);
      SBAR(); QKT(pB0, pB1, K_lds + 1 * SHM_K, qr, r32, hi); FSM(pA0, pA1, mnA, alA, l_reg, pa0, pa1, pa2, pa3); SBAR(); }
  LSWRITE(2, SE); if (lead) RESC(alB); LSYNC();
  for (int j = 2; j < NT; j += 2) {
    if (j + 1 < NT) LSLOAD(SE, (j + 1) * KVBLK);
    if (lead) { SBAR(); QKT(pA0, pA1, K_lds + (j & 3) * SHM_K, qr, r32, hi); FSM(pB0, pB1, mnB, alB, l_reg, pa0, pa1, pa2, pa3); SBAR();
        PVD(o, vb0 + ((j - 1) & 3) * SHM_V, pa0, pa1, pa2, pa3); PSM(pA0, pA1, m_reg, mnA, alA); }
    else { PVD(o, vb0 + ((j - 2) & 3) * SHM_V, pa0, pa1, pa2, pa3); PSM(pB0, pB1, m_reg, mnB, alB); RESC(alB);
        SBAR(); QKT(pA0, pA1, K_lds + (j & 3) * SHM_K, qr, r32, hi); FSM(pB0, pB1, mnB, alB, l_reg, pa0, pa1, pa2, pa3); SBAR(); }
    if (j + 1 < NT) LSWRITE((j + 1) & 3, SE);
    if (lead) RESC(alA);
    LSYNC();
    if (j + 2 < NT) LSLOAD(SE, (j + 2) * KVBLK);
    if (lead) { SBAR(); QKT(pB0, pB1, K_lds + ((j + 1) & 3) * SHM_K, qr, r32, hi); FSM(pA0, pA1, mnA, alA, l_reg, pa0, pa1, pa2, pa3); SBAR();
        PVD(o, vb0 + (j & 3) * SHM_V, pa0, pa1, pa2, pa3); PSM(pB0, pB1, m_reg, mnB, alB); }
    else { PVD(o, vb0 + ((j - 1) & 3) * SHM_V, pa0, pa1, pa2, pa3); PSM(pA0, pA1, m_reg, mnA, alA); RESC(alA);
        SBAR(); QKT(pB0, pB1, K_lds + ((j + 1) & 3) * SHM_K, qr, r32, hi); FSM(pA0, pA1, mnA, alA, l_reg, pa0, pa1, pa2, pa3); SBAR(); }
    if (j + 2 < NT) LSWRITE((j + 2) & 3, SE);
    if (lead) RESC(alB);
    LSYNC();
  }
  if (!lead) { PVD(o, vb0 + ((NT - 2) & 3) * SHM_V, pa0, pa1, pa2, pa3); PSM(pB0, pB1, m_reg, mnB, alB); RESC(alB); }
  FSM(pB0, pB1, mnB, alB, l_reg, pa0, pa1, pa2, pa3); SBAR();
  PVD(o, vb0 + ((NT - 1) & 3) * SHM_V, pa0, pa1, pa2, pa3);
#elif ATTN_LAG2
  bf16x8 pb0, pb1, pb2, pb3;
  SLOAD(SE, 0); asm volatile("s_waitcnt vmcnt(0)" ::: "memory"); SWRITE(0, SE); __syncthreads();
  QKT(pA0, pA1, K_lds, qr, r32, hi);
#if ATTN_NEGM
  partialSM_n<true>(pA0, pA1, negm, alA);
#else
  PSM(pA0, pA1, m_reg, mnA, alA);
#endif
  SLOAD(SO, KVBLK); if (2 < NT) SLOAD(SE, 2 * KVBLK);
  SWRITE(1, SO); __syncthreads();
  SBAR(); QKT(pB0, pB1, K_lds + 1 * SHM_K, qr, r32, hi);
  FSM(pA0, pA1, mnA, alA, l_reg, pb0, pb1, pb2, pb3); SBAR();
  if (3 < NT) LSLOAD(SO, 3 * KVBLK); SBAR();
  PSM(pB0, pB1, m_reg, mnB, alB);
  LSWRITE(2, SE); LSYNC();
  for (int j = 2; j < NT; j += 2) {
    SBAR(); QKT(pA0, pA1, K_lds + (j & 3) * SHM_K, qr, r32, hi);
    FSM(pB0, pB1, mnB, alB, l_reg, pa0, pa1, pa2, pa3);
    PVD(o, vb0 + ((j - 2) & 3) * SHM_V, pb0, pb1, pb2, pb3); SBAR();
    if (j + 2 < NT) LSLOAD(SE, (j + 2) * KVBLK); SBAR();
    RESC(alB); PSM(pA0, pA1, m_reg, mnA, alA);
    if (j + 1 < NT) LSWRITE((j + 1) & 3, SO);
    LSYNC();
    SBAR(); QKT(pB0, pB1, K_lds + ((j + 1) & 3) * SHM_K, qr, r32, hi);
    FSM(pA0, pA1, mnA, alA, l_reg, pb0, pb1, pb2, pb3);
    PVD(o, vb0 + ((j - 1) & 3) * SHM_V, pa0, pa1, pa2, pa3); SBAR();
    if (j + 3 < NT) LSLOAD(SO, (j + 3) * KVBLK); SBAR();
    RESC(alA); PSM(pB0, pB1, m_reg, mnB, alB);
    if (j + 2 < NT) LSWRITE((j + 2) & 3, SE);
    LSYNC();
  }
  PVD(o, vb0 + ((NT - 2) & 3) * SHM_V, pb0, pb1, pb2, pb3);
  RESC(alB);
  FSM(pB0, pB1, mnB, alB, l_reg, pa0, pa1, pa2, pa3); SBAR();
  PVD(o, vb0 + ((NT - 1) & 3) * SHM_V, pa0, pa1, pa2, pa3);
#else
  int bp = 0, bc = 1, bn = 2;
#define ROT3() do { const int t_ = bp; bp = bc; bc = bn; bn = t_; } while (0)
  SLOAD(SE, 0); asm volatile("s_waitcnt vmcnt(0)" ::: "memory"); SWRITE(0, SE); __syncthreads();
  QKT(pA0, pA1, K_lds, qr, r32, hi);
#if ATTN_NEGM
  partialSM_n<true>(pA0, pA1, negm, alA);
#else
  PSM(pA0, pA1, m_reg, mnA, alA);
#endif
  SLOAD(SO, KVBLK); if (2 < NT) SLOAD(SE, 2 * KVBLK);
  SWRITE(1, SO); __syncthreads();
  for (int j = 1; j + 1 < NT; j += 2) {
    SBAR(); QKT(pB0, pB1, K_lds + bc * SHM_K, qr, r32, hi);
    FSM(pA0, pA1, mnA, alA, l_reg, pa0, pa1, pa2, pa3); SBAR();
    LSLOAD(SO, (j + 2) * KVBLK); SBAR();
    PVSM(o, vb0 + bp * SHM_V, pa0, pa1, pa2, pa3, pB0, pB1, m_reg, mnB, alB);
    LSWRITE(bn, SE); SBAR();
    bg.collect(true); bg.issue(); SBAR();
    RESC(alB); LSYNC(); ROT3();
    SBAR(); QKT(pA0, pA1, K_lds + bc * SHM_K, qr, r32, hi);
    FSM(pB0, pB1, mnB, alB, l_reg, pa0, pa1, pa2, pa3); SBAR();
    if (j + 3 < NT) LSLOAD(SE, (j + 3) * KVBLK); SBAR();
    PVSM(o, vb0 + bp * SHM_V, pa0, pa1, pa2, pa3, pA0, pA1, m_reg, mnA, alA);
    LSWRITE(bn, SO); SBAR();
    bg.collect(true); bg.issue(); SBAR();
    RESC(alA); LSYNC(); ROT3();
  }
  SBAR(); QKT(pB0, pB1, K_lds + bc * SHM_K, qr, r32, hi);
  FSM(pA0, pA1, mnA, alA, l_reg, pa0, pa1, pa2, pa3); SBAR();
  PVSM(o, vb0 + bp * SHM_V, pa0, pa1, pa2, pa3, pB0, pB1, m_reg, mnB, alB);
  RESC(alB);
  FSM(pB0, pB1, mnB, alB, l_reg, pa0, pa1, pa2, pa3); SBAR();
  PVD(o, vb0 + bc * SHM_V, pa0, pa1, pa2, pa3);
#undef ROT3
#endif
  if (hi == 0) li_l[r32] = l_reg; asm volatile("s_waitcnt lgkmcnt(0)" ::: "memory");
  float rli[16];
#pragma unroll
  for (int r = 0; r < 16; ++r) rli[r] = __builtin_amdgcn_rcpf(li_l[crow(r, hi)]);
#pragma unroll
  for (int r = 0; r < 16; ++r) { const int orow = wid * QBLK + crow(r, hi);
#pragma unroll
    for (int d0 = 0; d0 < 2; ++d0) OUT(orow, d0 * 32 + r32, o[d0][r] * rli[r]); }
  __syncthreads();
#undef SLOAD
#undef SWRITE
#undef RESC
#undef PSM
#undef PVSM
#undef FSM
#undef PVD
#undef QKT
#undef LSLOAD
#undef LSWRITE
#undef LSYNC
}
#undef KSWZ
#undef SBAR
}
struct Q2 {
    bf16* U16;
    bf16 *WtL;
    bf16 *WtM;
    bf16 *WtG;
    float *LSL;
    bf16 *HLOC, *PCUM;
    float *SA, *SB;
    bf16 *QN16, *KVN16;
    bf16 *Q16;
    bf16 *WtKvbP;
    bf16 *XCM16, *QKV16;
    float *GATES;
    float *CLOC, *NLOC, *MLB;
    bf16 *CST; float *NST, *MST;
    bf16 *YB16;
    float *GLIST;
};
constexpr int NCH = TPB / 128;
constexpr int NCH_CTX = CTX / 128;

__device__ __forceinline__ float wave_sum(float v) {
#pragma unroll
    for (int o = 1; o < 64; o <<= 1) v += __shfl_xor(v, o);
    return v;
}
__device__ __forceinline__ float fast_sigmoid(float x) { return __builtin_amdgcn_rcpf(1.f + __expf(-x)); }
__device__ __forceinline__ float fast_silu(float x) { return x * fast_sigmoid(x); }
__device__ __forceinline__ float fast_gelu(float x) { const float u = 0.7978845608028654f * (x + 0.044715f * x * x * x); return x * fast_sigmoid(2.f * u); }

struct EpiU16 {
    static constexpr bool PERM = true; bf16* U;
    __device__ __forceinline__ void operator()(const pg8::f32x4 (&acc)[2][2][4][2], const pg8::Unit& u, int wr, int wc, int fr, int fq) const {
#pragma unroll
        for (int ai = 0; ai < 2; ++ai)
#pragma unroll
            for (int m = 0; m < 4; ++m) { const int row = u.pm * 256 + ai * 128 + wr * 64 + m * 16 + fr;
#pragma unroll
                for (int bj = 0; bj < 2; ++bj) { const int c = u.pn * 256 + bj * 128 + wc * 32 + 8 * fq; const pg8::f32x4 v0 = acc[ai][bj][m][0], v1 = acc[ai][bj][m][1];
                    u32x4 w; w.x = pg8::cvt_pk_bf16(v0[0], v0[1]); w.y = pg8::cvt_pk_bf16(v0[2], v0[3]); w.z = pg8::cvt_pk_bf16(v1[0], v1[1]); w.w = pg8::cvt_pk_bf16(v1[2], v1[3]);
                    *(u32x4*)(U + (size_t)row * DINP + c) = w; } }
    }
};
__device__ __forceinline__ void opt_inproj16(const Q& q, const Q2& q2, int l, LAS unsigned char* lds, int G, int bid) {
    pg8::Gemm g{q.H16, q.WtIn + (size_t)l * DINP * D, D}; pg8::StaticOrder S; S.init(NT, DINP, G, bid);
    EpiU16 E{q2.U16}; pg8::gemm_phase<EpiU16, pg8::StaticOrder, true>(lds, g, S, E);
}

__device__ __forceinline__ void opt_convert_small(const P& p, const Q2& q2, long gtid, long nthr) {
    for (long it = gtid; it < (long)DEPTH * 4 * 256 * 64; it += nthr) { const int i = (int)(it & 63), n = (int)((it >> 6) & 255), g = (int)((it >> 14) & 3), l = (int)(it >> 16);
        const int d = n >> 7, gate = (n >> 6) & 1, j = n & 63; const float* w = (gate ? p.in[I_LWX] : p.in[I_LWA]) + ((((size_t)l * 2 + d) * 4 + g) * 64 + i) * 64 + j;
        q2.WtL[it] = (bf16)f2bf(*w); }
    for (long it = gtid; it < (long)DEPTH * 4 * 3 * 64 * 64; it += nthr) { const int i = (int)(it & 63), j = (int)((it >> 6) & 63), m = (int)((it >> 12) % 3), h = (int)((it / (3 * 4096)) & 3), l = (int)(it / (12 * 4096));
        const float* w = (m == 0 ? p.in[I_MWQ] : (m == 1 ? p.in[I_MWK] : p.in[I_MWV])) + (((size_t)l * 4 + h) * 64 + i) * 64 + j;
        q2.WtM[it] = (bf16)f2bf(*w * (m == 1 ? 0.125f : 1.f)); }
    for (long it = gtid; it < (long)DEPTH * 32 * 768; it += nthr) { const int i = (int)(it % 768), n = (int)((it / 768) & 31), l = (int)(it / (32 * 768));
        q2.WtG[it] = n < 16 ? (bf16)f2bf(p.in[I_MWG][((((size_t)l * 2 + (n >> 3)) * 768) + i) * 8 + (n & 7)]) : (bf16)0; }
    for (long it = gtid; it < (long)DEPTH * 2 * 256; it += nthr) q2.LSL[it] = logsigmoid_f(p.in[I_LLAM][it]);
}

__device__ __forceinline__ void opt_init_mod(const P& p, char* lds, int bid, int G) {
    int tid_ = TIDX; asm volatile("" : "+v"(tid_));
    const int tid = tid_; float* SC = (float*)lds; float* RED = (float*)(lds + 12288);
    for (int i = tid; i < 3 * D; i += 512) { const int cv = i / D, k = i % D; const float x = cv < 2 ? p.in[I_C][cv * D + k] : p.in[I_CCTX][k]; SC[i] = x / (1.f + __expf(-x)); }
    __syncthreads();
    for (int it = bid; it < DEPTH * 6 * D / 64; it += G) { const int l = it / (6 * D / 64), j = (it % (6 * D / 64)) * 64 + (tid & 63), kq = tid >> 6;
        const float* w = p.in[I_WMOD] + (size_t)l * D * 6 * D + (size_t)(128 * kq) * 6 * D + j; float a0 = 0.f, a1 = 0.f, a2 = 0.f;
#pragma unroll 8
        for (int k = 0; k < 128; ++k) { const float wv = w[(size_t)k * 6 * D]; a0 += SC[128 * kq + k] * wv; a1 += SC[D + 128 * kq + k] * wv; a2 += SC[2 * D + 128 * kq + k] * wv; }
        RED[(kq * 3 + 0) * 64 + (tid & 63)] = a0; RED[(kq * 3 + 1) * 64 + (tid & 63)] = a1; RED[(kq * 3 + 2) * 64 + (tid & 63)] = a2;
        __syncthreads();
        if (tid < 192) { const int cv = tid >> 6, jj = tid & 63; float sacc = p.in[I_BMOD][(size_t)l * 6 * D + (it % (6 * D / 64)) * 64 + jj];
#pragma unroll
            for (int x = 0; x < 8; ++x) sacc += RED[(x * 3 + cv) * 64 + jj];
            p.MOD[((size_t)l * 3 + cv) * 6 * D + (it % (6 * D / 64)) * 64 + jj] = sacc; }
        __syncthreads(); }
}
__device__ __forceinline__ void opt_init_rope(const P& p, long gtid, long nthr) {
    for (long it = gtid; it < (long)SEQ * 16; it += nthr) { const int s = (int)(it / 16), a = (int)((it / 8) & 1), f = (int)(it & 7); const int pos = a == 0 ? s / GRID_W : s % GRID_W;
        const float frf = f == 0 ? 1.f : f == 1 ? 0.31622776601683794f : f == 2 ? 0.1f : f == 3 ? 0.031622776601683791f : f == 4 ? 0.01f : f == 5 ? 0.0031622776601683794f : f == 6 ? 0.001f : 0.00031622776601683794f;
        const float ang = (float)pos * frf; float sn, cs; sincosf(ang, &sn, &cs);
        p.ROPET[it * 2] = cs; p.ROPET[it * 2 + 1] = sn; }
}

template <int KS, class TA, class TB>
__device__ __forceinline__ void wave_mm32(att::f32x16& acc, const TA* A, int lda, const TB* B, int ldb, int r32, int hi) {
#pragma unroll
    for (int ks = 0; ks < KS; ++ks) {
        const att::bf16x8 a = *reinterpret_cast<const att::bf16x8*>(A + (size_t)r32 * lda + ks * 16 + hi * 8);
        const att::bf16x8 b = *reinterpret_cast<const att::bf16x8*>(B + (size_t)r32 * ldb + ks * 16 + hi * 8);
        acc = __builtin_amdgcn_mfma_f32_32x32x16_bf16(a, b, acc, 0, 0, 0);
    }
}

constexpr int LRU1_LDS = 18432 + 65536 + 4096;
template <class UL>
__device__ __forceinline__ void lru1_item(const P& p, const Q2& q2, int l, int b, int ch, int g, char* lds, const UL& U) {
    int tid_ = TIDX; asm volatile("" : "+v"(tid_));
    const int tid = tid_, wave = tid >> 6, lane = tid & 63, r32 = lane & 31, hi = lane >> 5;
    unsigned short* XC16 = (unsigned short*)lds; float* AB = (float*)(lds + 18432); float* CMP = (float*)(lds + 18432 + 65536);
    const int t0 = b * TPB + ch * 128, seg_lo = ch < NCH_CTX ? b * TPB : b * TPB + CTX, seg_hi = ch < NCH_CTX ? b * TPB + CTX : (b + 1) * TPB;
    { const int j = tid & 63, c = g * 64 + j, tb = (tid >> 6) * 16; const float* cw = p.in[I_LCW] + (size_t)l * 4 * 256 + c; const float w0 = cw[0], w1 = cw[256], w2 = cw[512], w3 = cw[768], cb = p.in[I_LCB][(size_t)l * 256 + c];
      float xm2 = (t0 + tb - 2 >= seg_lo) ? U(t0 + tb - 2, OFF_AX + c) : 0.f, xm1 = (t0 + tb - 1 >= seg_lo) ? U(t0 + tb - 1, OFF_AX + c) : 0.f, x0 = U(t0 + tb, OFF_AX + c);
#pragma unroll 4
      for (int i = 0; i < 16; ++i) { const int t = t0 + tb + i; const float xp1 = (t + 1 < seg_hi) ? U(t + 1, OFF_AX + c) : 0.f;
          const float v = cb + w0 * xm2 + w1 * xm1 + w2 * x0 + w3 * xp1; XC16[(tb + i) * 72 + j] = (unsigned short)f2bf(v); xm2 = xm1; xm1 = x0; x0 = xp1; } }
    __syncthreads();
    const bf16* Wt = q2.WtL + ((size_t)l * 4 + g) * 256 * 64;
#pragma unroll 1
    for (int d = 0; d < 2; ++d) {
        const int rt = wave & 3, cj = wave >> 2; att::f32x16 ar = {}, ai = {};
        wave_mm32<4>(ar, XC16 + rt * 32 * 72, 72, Wt + (size_t)(d * 128 + cj * 32) * 64, 64, r32, hi);
        wave_mm32<4>(ai, XC16 + rt * 32 * 72, 72, Wt + (size_t)(d * 128 + 64 + cj * 32) * 64, 64, r32, hi);
        { const int j = cj * 32 + r32, c = g * 64 + j; const float ba = p.in[I_LBA][((size_t)l * 2 + d) * 256 + c], bx = p.in[I_LBX][((size_t)l * 2 + d) * 256 + c], lsl = q2.LSL[((size_t)l * 2 + d) * 256 + c];
#pragma unroll
          for (int r = 0; r < 16; ++r) { const int tt = rt * 32 + att::crow(r, hi); const float rg = fast_sigmoid(ar[r] + ba), ig = fast_sigmoid(ai[r] + bx), la = 8.f * rg * lsl, a = __expf(la);
              const float xc = bf2f(XC16[tt * 72 + j]); const float bb = sqrtf(fmaxf(1.f - a * a, 0.f)) * ig * xc;
              AB[(tt * 64 + j) * 2] = a; AB[(tt * 64 + j) * 2 + 1] = bb; } }
        __syncthreads();
        { const int j = tid & 63, sg = tid >> 6; float av[16], bv[16]; float A = 1.f, B = 0.f;
#pragma unroll
          for (int i = 0; i < 16; ++i) { const int s = sg * 16 + i, tt = d == 0 ? s : 127 - s; av[i] = AB[(tt * 64 + j) * 2]; bv[i] = AB[(tt * 64 + j) * 2 + 1]; B = av[i] * B + bv[i]; A *= av[i]; }
          CMP[(sg * 64 + j) * 2] = A; CMP[(sg * 64 + j) * 2 + 1] = B;
          __syncthreads();
          float cA = 1.f, cB = 0.f;
          for (int x = 0; x < sg; ++x) { const float xa = CMP[(x * 64 + j) * 2], xb = CMP[(x * 64 + j) * 2 + 1]; cB = xa * cB + xb; cA *= xa; }
          const int c = g * 64 + j; float h = cB, pc = cA;
          unsigned short* OUTS = (unsigned short*)AB;
#pragma unroll
          for (int i = 0; i < 16; ++i) { const int s = sg * 16 + i, tt = d == 0 ? s : 127 - s; h = av[i] * h + bv[i]; pc *= av[i];
              OUTS[tt * 64 + j] = (unsigned short)f2bf(h); OUTS[(128 + tt) * 64 + j] = (unsigned short)f2bf(pc); }
          if (sg == 7) { q2.SA[(((size_t)d * NB + b) * NCH + ch) * 256 + c] = pc; q2.SB[(((size_t)d * NB + b) * NCH + ch) * 256 + c] = h; }
          __syncthreads();
#pragma unroll
          for (int k = 0; k < 4; ++k) { const int x = tid + k * 512, arr = x >> 10, tt = (x >> 3) & 127, c8 = x & 7; const u32x4 v = *(const u32x4*)(OUTS + (arr * 128 + tt) * 64 + c8 * 8);
              *(u32x4*)((arr ? q2.PCUM : q2.HLOC) + ((size_t)d * NT + t0 + tt) * 256 + g * 64 + c8 * 8) = v; } }
        __syncthreads();
    }
}
__device__ __forceinline__ void lru2_item(const Q2& q2, bf16* Yp, int b, int ch, char* lds) {
    int tid_ = TIDX; asm volatile("" : "+v"(tid_));
    const int tid = tid_; float* CAR = (float*)lds;
    { const int d = tid >> 8, c = tid & 255; float h = 0.f;
      if (d == 0) { for (int j = 0; j < ch; ++j) h = q2.SA[(((size_t)0 * NB + b) * NCH + j) * 256 + c] * h + q2.SB[(((size_t)0 * NB + b) * NCH + j) * 256 + c]; }
      else { const bool isctx = ch < NCH_CTX;
          for (int j = NCH_CTX - 1; j >= (isctx ? ch + 1 : 0); --j) h = q2.SA[(((size_t)1 * NB + b) * NCH + j) * 256 + c] * h + q2.SB[(((size_t)1 * NB + b) * NCH + j) * 256 + c];
          if (!isctx) for (int j = NCH - 1; j > ch; --j) h = q2.SA[(((size_t)1 * NB + b) * NCH + j) * 256 + c] * h + q2.SB[(((size_t)1 * NB + b) * NCH + j) * 256 + c]; }
      CAR[tid] = h; }
    __syncthreads();
    const int t0 = b * TPB + ch * 128;
#pragma unroll 2
    for (int k = 0; k < 8; ++k) { const int x = tid + k * 512, tt = x >> 5, c0 = (x & 31) * 8, t = t0 + tt;
        const u32x4 hf = *(const u32x4*)(q2.HLOC + (size_t)t * 256 + c0), pf = *(const u32x4*)(q2.PCUM + (size_t)t * 256 + c0), hb = *(const u32x4*)(q2.HLOC + ((size_t)NT + t) * 256 + c0), pb = *(const u32x4*)(q2.PCUM + ((size_t)NT + t) * 256 + c0);
        const u32x4 ag = *(const u32x4*)(q2.U16 + (size_t)t * DINP + OFF_AG + c0); u32x4 o;
#pragma unroll
        for (int w = 0; w < 4; ++w) { float y[2];
#pragma unroll
            for (int e = 0; e < 2; ++e) { const int c = c0 + 2 * w + e; const unsigned sh = e ? 0u : 16u;
                const float h0 = __builtin_bit_cast(float, e ? (hf[w] & 0xffff0000u) : (hf[w] << 16)), p0 = __builtin_bit_cast(float, e ? (pf[w] & 0xffff0000u) : (pf[w] << 16));
                const float h1 = __builtin_bit_cast(float, e ? (hb[w] & 0xffff0000u) : (hb[w] << 16)), p1 = __builtin_bit_cast(float, e ? (pb[w] & 0xffff0000u) : (pb[w] << 16));
                const float a = __builtin_bit_cast(float, e ? (ag[w] & 0xffff0000u) : (ag[w] << 16)); (void)sh;
                y[e] = ((h0 + p0 * CAR[c]) + (h1 + p1 * CAR[256 + c])) * fast_gelu(a); }
            o[w] = pk2(y[0], y[1]); }
        *(u32x4*)(Yp + (size_t)t * DMIX + c0) = o; }
    __syncthreads();
}

template <class UL>
__device__ __forceinline__ void mla_prep_token(const P& p, const Q& q, const Q2& q2, int l, int t, int lane, const UL& U) {
    float xq[4], xk[2]; float sq = 0.f, sk = 0.f;
#pragma unroll
    for (int i = 0; i < 4; ++i) { xq[i] = U(t, OFF_BQ + lane * 4 + i); sq += xq[i] * xq[i]; }
#pragma unroll
    for (int i = 0; i < 2; ++i) { xk[i] = U(t, OFF_BKV + lane * 2 + i); sk += xk[i] * xk[i]; }
    sq = wave_sum(sq); sk = wave_sum(sk);
    const float rq = 1.f / sqrtf(sq * (1.f / QRANK) + EPS), rk = 1.f / sqrtf(sk * (1.f / KVRANK) + EPS);
    const float* gq = p.in[I_QNG] + (size_t)l * QRANK + lane * 4; const float* gk = p.in[I_KVNG] + (size_t)l * KVRANK + lane * 2;
    u32x2 wq; wq.x = pk2(xq[0] * rq * gq[0], xq[1] * rq * gq[1]); wq.y = pk2(xq[2] * rq * gq[2], xq[3] * rq * gq[3]);
    *(u32x2*)(q2.QN16 + (size_t)t * 256 + lane * 4) = wq;
    *(unsigned*)(q2.KVN16 + (size_t)t * 256 + lane * 2) = pk2(xk[0] * rk * gk[0], xk[1] * rk * gk[1]);
    *(unsigned*)(q2.KVN16 + (size_t)t * 256 + 128 + lane * 2) = 0u;
    const int b = t / TPB, key = t % TPB, h = lane >> 3, d0 = (lane & 7) * 4; const bool lat = key >= CTX; const int s = key - CTX;
    float o[4];
#pragma unroll
    for (int i = 0; i < 4; ++i) { const int dd = d0 + i, a = dd >> 4, half = (dd >> 3) & 1, f = dd & 7; const float me = U(t, OFF_BKR + dd), other = U(t, OFF_BKR + (dd ^ 8));
        float cs = 1.f, sn = 0.f; if (lat) { cs = p.ROPET[(((size_t)s * 2 + a) * 8 + f) * 2]; sn = p.ROPET[(((size_t)s * 2 + a) * 8 + f) * 2 + 1]; }
        o[i] = half == 0 ? me * cs - other * sn : me * cs + other * sn; }
    u32x2 wk; wk.x = pk2(o[0], o[1]); wk.y = pk2(o[2], o[3]);
    *(u32x2*)(q.K16 + (((size_t)b * AH + h) * TPB + key) * QKD + NOPE + d0) = wk;
}

struct EpiQproj {
    static constexpr bool PERM = true; bf16* Q16; const float* ROPET;
    __device__ __forceinline__ void operator()(const pg8::f32x4 (&acc)[2][2][4][2], const pg8::Unit& u, int wr, int wc, int fr, int fq) const {
#pragma unroll
        for (int bj = 0; bj < 2; ++bj) { const int blk = u.pn * 8 + bj * 4 + wc; const bool rope = (blk % 3) == 2; const int c = blk * 32 + 8 * fq;
#pragma unroll
            for (int ai = 0; ai < 2; ++ai)
#pragma unroll
                for (int m = 0; m < 4; ++m) { const int row = u.pm * 256 + ai * 128 + wr * 64 + m * 16 + fr; float v[8];
#pragma unroll
                    for (int x = 0; x < 4; ++x) { v[x] = acc[ai][bj][m][0][x]; v[4 + x] = acc[ai][bj][m][1][x]; }
                    if (rope) {
                        const int key = (u.pm % (TPB / 256)) * 256 + ai * 128 + wr * 64 + m * 16 + fr; const bool lat = key >= CTX; const int s = lat ? key - CTX : 0, a = fq >> 1; const float* tb = ROPET + ((size_t)s * 2 + a) * 16;
#pragma unroll
                        for (int x = 0; x < 8; ++x) { const float other = __shfl_xor(v[x], 16); const float cs = lat ? tb[x * 2] : 1.f, sn = lat ? tb[x * 2 + 1] : 0.f;
                            v[x] = (fq & 1) == 0 ? v[x] * cs - other * sn : v[x] * cs + other * sn; } }
#pragma unroll
                    for (int x = 0; x < 8; ++x) v[x] *= att::QPRESCALE;
                    u32x4 w; w.x = pg8::cvt_pk_bf16(v[0], v[1]); w.y = pg8::cvt_pk_bf16(v[2], v[3]); w.z = pg8::cvt_pk_bf16(v[4], v[5]); w.w = pg8::cvt_pk_bf16(v[6], v[7]);
                    *(u32x4*)(Q16 + (size_t)row * 768 + c) = w; asm volatile("" ::: "memory"); } }
    }
};
struct EpiKVproj {
    static constexpr bool PERM = true; bf16* K16; bf16* V16;
    __device__ __forceinline__ void operator()(const pg8::f32x4 (&acc)[2][2][4][2], const pg8::Unit& u, int wr, int wc, int fr, int fq) const {
#pragma unroll
        for (int bj = 0; bj < 2; ++bj) { const int h = u.pn * 2 + bj, dcol = wc * 32 + 8 * fq; const bool isv = dcol >= 64;
#pragma unroll
            for (int ai = 0; ai < 2; ++ai)
#pragma unroll
                for (int m = 0; m < 4; ++m) { const int b = u.pm / (TPB / 256), key = (u.pm % (TPB / 256)) * 256 + ai * 128 + wr * 64 + m * 16 + fr; const pg8::f32x4 v0 = acc[ai][bj][m][0], v1 = acc[ai][bj][m][1];
                    u32x4 w; w.x = pg8::cvt_pk_bf16(v0[0], v0[1]); w.y = pg8::cvt_pk_bf16(v0[2], v0[3]); w.z = pg8::cvt_pk_bf16(v1[0], v1[1]); w.w = pg8::cvt_pk_bf16(v1[2], v1[3]);
                    bf16* dst = isv ? V16 + (((size_t)b * AH + h) * TPB + key) * VD + (dcol - 64) : K16 + (((size_t)b * AH + h) * TPB + key) * QKD + dcol;
                    *(u32x4*)dst = w; asm volatile("" ::: "memory"); } }
    }
};
struct MlaOrder : pg8::StaticOrder { __device__ __forceinline__ int arow(const pg8::Unit& u, int r) const { return (u.pn >= 3 ? NT : 0) + u.pm * pg8::BM + r; } };
struct EpiMla { static constexpr bool PERM = true; EpiQproj eq; EpiKVproj ekv;
    __device__ __forceinline__ void operator()(const pg8::f32x4 (&acc)[2][2][4][2], const pg8::Unit& u, int wr, int wc, int fr, int fq) const {
        if (u.pn < 3) eq(acc, u, wr, wc, fr, fq); else { pg8::Unit v = u; v.pn = u.pn - 3; ekv(acc, v, wr, wc, fr, fq); } } };
__device__ __forceinline__ void opt_mla_proj(const P& p, const Q& q, const Q2& q2, int l, LAS unsigned char* lds, int G, int bid) {
    pg8::Gemm g{q2.QN16, q2.WtKvbP + (size_t)l * 1792 * 256, 256}; MlaOrder S; S.init(NT, 1792, G, bid);
    EpiMla E{EpiQproj{q2.Q16, p.ROPET}, EpiKVproj{q.K16, q.V16}}; pg8::gemm_phase<EpiMla, MlaOrder, true>(lds, g, S, E);
}
__device__ __forceinline__ int ord_len(int d, int ch) { return d == 0 ? ch : (ch < NCH_CTX ? NCH_CTX - 1 - ch : NCH_CTX + (NCH - 1 - ch)); }
__device__ __forceinline__ int ord_chunk(int d, int ch, int i) { return d == 0 ? i : (i < (ch < NCH_CTX ? NCH_CTX - 1 - ch : NCH_CTX) ? NCH_CTX - 1 - i : NCH - 1 - (i - NCH_CTX)); }

__device__ __forceinline__ void wave_scan_add128(float& x0, float& x1, int lane) {
#pragma unroll
    for (int off = 1; off < 64; off <<= 1) { const float y0 = __shfl_up(x0, off), y1 = __shfl_up(x1, off); if (lane >= off) { x0 += y0; x1 += y1; } }
    x1 += __shfl(x0, 63);
}
__device__ __forceinline__ void wave_scan_max128(float& x0, float& x1, int lane) {
#pragma unroll
    for (int off = 1; off < 64; off <<= 1) { const float y0 = __shfl_up(x0, off), y1 = __shfl_up(x1, off); if (lane >= off) { x0 = fmaxf(x0, y0); x1 = fmaxf(x1, y1); } }
    x1 = fmaxf(x1, __shfl(x0, 63));
}
__device__ __forceinline__ float wave_max(float v) {
#pragma unroll
    for (int o = 1; o < 64; o <<= 1) v = fmaxf(v, __shfl_xor(v, o));
    return v;
}

constexpr int ML1_LDS = 116736;
template <class UL>
__device__ __forceinline__ void ml1_item(const P& p, const Q2& q2, int l, int b, int ch, char* lds, const UL& U) {
    int tid_ = TIDX; asm volatile("" : "+v"(tid_));
    const int tid = tid_, wave = tid >> 6, lane = tid & 63, r32 = lane & 31, hi = lane >> 5;
    unsigned short* XCh = (unsigned short*)lds; unsigned short* UXh = (unsigned short*)(lds + 18432); unsigned short* QKVh = (unsigned short*)(lds + 36864);
    float* GP = (float*)(lds + 92160); float* GT = (float*)(lds + 108544);
    const int t0 = b * TPB + ch * 128, seg_lo = ch < NCH_CTX ? b * TPB : b * TPB + CTX, seg_hi = ch < NCH_CTX ? b * TPB + CTX : (b + 1) * TPB;
    const int rt = wave & 3, wh = wave >> 2;
    att::f32x16 gacc = {};
#pragma unroll 1
    for (int h = 0; h < 4; ++h) {
        { const int j = tid & 63, c = h * 64 + j, tb = (tid >> 6) * 16; const float* cw = p.in[I_MCW] + (size_t)l * 4 * 256 + c; const float w0 = cw[0], w1 = cw[256], w2 = cw[512], w3 = cw[768], cb = p.in[I_MCB][(size_t)l * 256 + c];
          float xm2 = (t0 + tb - 2 >= seg_lo) ? U(t0 + tb - 2, OFF_MX + c) : 0.f, xm1 = (t0 + tb - 1 >= seg_lo) ? U(t0 + tb - 1, OFF_MX + c) : 0.f, x0 = U(t0 + tb, OFF_MX + c);
#pragma unroll 4
          for (int i = 0; i < 16; ++i) { const int t = t0 + tb + i; const float xp1 = (t + 1 < seg_hi) ? U(t + 1, OFF_MX + c) : 0.f;
              const float v = fast_silu(cb + w0 * xm2 + w1 * xm1 + w2 * x0 + w3 * xp1); const unsigned short vb = (unsigned short)f2bf(v);
              XCh[(tb + i) * 72 + j] = vb; UXh[(tb + i) * 72 + j] = (unsigned short)f2bf(x0); xm2 = xm1; xm1 = x0; x0 = xp1; } }
        __syncthreads();
        { const bf16* Wm = q2.WtM + ((size_t)l * 4 + h) * 3 * 4096;
#pragma unroll
          for (int m = 0; m < 3; ++m) { att::f32x16 a = {};
              wave_mm32<4>(a, (m == 2 ? UXh : XCh) + rt * 32 * 72, 72, Wm + (size_t)m * 4096 + (size_t)wh * 32 * 64, 64, r32, hi);
#pragma unroll
              for (int r = 0; r < 16; ++r) { const int tt = rt * 32 + att::crow(r, hi); const unsigned short vb = (unsigned short)f2bf(a[r]);
                  QKVh[(m * 128 + tt) * 72 + wh * 32 + r32] = vb; } } }
        __syncthreads();
#pragma unroll
        for (int k = 0; k < 2; ++k) { const int x = tid + k * 512, tt = x >> 3, c8 = x & 7; *(u32x4*)(q2.XCM16 + (size_t)(t0 + tt) * 256 + h * 64 + c8 * 8) = *(const u32x4*)(XCh + tt * 72 + c8 * 8); }
#pragma unroll
        for (int k = 0; k < 6; ++k) { const int x = tid + k * 512, m = x >> 10, tt = (x >> 3) & 127, c8 = x & 7;
            *(u32x4*)(q2.QKV16 + (size_t)(t0 + tt) * 768 + m * 256 + h * 64 + c8 * 8) = *(const u32x4*)(QKVh + (m * 128 + tt) * 72 + c8 * 8); }
        { const bf16* Wg = q2.WtG + (size_t)l * 32 * 768;
#pragma unroll
          for (int x = 0; x < 6; ++x) { const int idx = wh * 6 + x, m = idx >> 2, ks = idx & 3;
              const att::bf16x8 a = *reinterpret_cast<const att::bf16x8*>(QKVh + (m * 128 + rt * 32 + r32) * 72 + ks * 16 + hi * 8);
              const att::bf16x8 bb = *reinterpret_cast<const att::bf16x8*>(Wg + (size_t)r32 * 768 + m * 256 + h * 64 + ks * 16 + hi * 8);
              gacc = __builtin_amdgcn_mfma_f32_32x32x16_bf16(a, bb, gacc, 0, 0, 0); } }
        __syncthreads();
    }
    if (r32 < 16) {
#pragma unroll
        for (int r = 0; r < 16; ++r) GP[(wh * 128 + rt * 32 + att::crow(r, hi)) * 16 + r32] = gacc[r]; }
    __syncthreads();
    for (int i = tid; i < 128 * 16; i += 512) { const int n = i & 15, d = n >> 3, g = n & 7; float v = GP[i] + GP[128 * 16 + i] + p.in[I_MBG][((size_t)l * 2 + d) * 8 + g];
        if (g >= 4) v = fminf(v, 0.f) - __logf(1.f + __expf(-fabsf(v)));
        GT[i] = v; q2.GATES[(size_t)(t0 + (i >> 4)) * 16 + n] = v; }
    __syncthreads();
    unsigned short* KT = (unsigned short*)lds; unsigned short* VT = (unsigned short*)(lds + 17408); float* WR = (float*)(lds + 52224); float* MB = (float*)(lds + 53248); float* WE = (float*)(lds + 53280);
#pragma unroll 1
    for (int h = 0; h < 4; ++h) {
        if (wave < 2) { const int d = wave, ta = d == 0 ? lane : 127 - lane, tb = d == 0 ? lane + 64 : 63 - lane;
            float b0 = GT[ta * 16 + d * 8 + 4 + h], b1 = GT[tb * 16 + d * 8 + 4 + h]; wave_scan_add128(b0, b1, lane);
            const float bL = __shfl(b1, 63), w0 = bL - b0 + GT[ta * 16 + d * 8 + h], w1 = bL - b1 + GT[tb * 16 + d * 8 + h];
            WR[d * 128 + ta] = w0; WR[d * 128 + tb] = w1; const float mx = wave_max(fmaxf(w0, w1));
            if (lane == 0) { MB[d * 2] = mx; MB[d * 2 + 1] = bL; } }
        __syncthreads();
        { const int tt = tid & 127, jg = tid >> 7; const float w0 = __expf(WR[tt] - MB[0]), w1 = __expf(WR[128 + tt] - MB[2]);
          const unsigned short* ksrc = (const unsigned short*)q2.QKV16 + (size_t)(t0 + tt) * 768 + 256 + h * 64 + jg * 16; const unsigned short* vsrc = ksrc + 256;
          const att::bf16x8 k0 = *reinterpret_cast<const att::bf16x8*>(ksrc), k1 = *reinterpret_cast<const att::bf16x8*>(ksrc + 8), v0 = *reinterpret_cast<const att::bf16x8*>(vsrc), v1 = *reinterpret_cast<const att::bf16x8*>(vsrc + 8);
#pragma unroll
          for (int i = 0; i < 8; ++i) { KT[(jg * 16 + i) * 136 + tt] = (unsigned short)k0[i]; KT[(jg * 16 + 8 + i) * 136 + tt] = (unsigned short)k1[i];
              const float va = bf2f((unsigned short)v0[i]), vb = bf2f((unsigned short)v1[i]);
              VT[(jg * 16 + i) * 136 + tt] = (unsigned short)f2bf(va * w0); VT[(jg * 16 + 8 + i) * 136 + tt] = (unsigned short)f2bf(vb * w0);
              VT[(64 + jg * 16 + i) * 136 + tt] = (unsigned short)f2bf(va * w1); VT[(64 + jg * 16 + 8 + i) * 136 + tt] = (unsigned short)f2bf(vb * w1); }
          if (tid < 128) WE[tid] = w0; else if (tid < 256) WE[tid] = w1; }
        __syncthreads();
        { const int d = wave >> 2, vt = (wave >> 1) & 1, kt = wave & 1; att::f32x16 c = {};
          wave_mm32<8>(c, VT + (size_t)(d * 64 + vt * 32) * 136, 136, KT + (size_t)kt * 32 * 136, 136, r32, hi);
          float* dst = q2.CLOC + ((((size_t)d * NB + b) * NCH + ch) * 4 + h) * 4096;
#pragma unroll
          for (int r = 0; r < 16; ++r) dst[(vt * 32 + att::crow(r, hi)) * 64 + kt * 32 + r32] = c[r];
          { const int dd = tid >> 8, k = (tid >> 2) & 63, qt = tid & 3; float s = 0.f;
#pragma unroll 8
            for (int i = 0; i < 32; ++i) { const int tt = qt * 32 + i; s += WE[dd * 128 + tt] * bf2f(KT[k * 136 + tt]); }
            s += __shfl_xor(s, 1); s += __shfl_xor(s, 2);
            if (qt == 0) q2.NLOC[((((size_t)dd * NB + b) * NCH + ch) * 4 + h) * 64 + k] = s; }
          if (tid < 2) { float* mb = q2.MLB + ((((size_t)tid * NB + b) * NCH + ch) * 4 + h) * 2; mb[0] = MB[tid * 2]; mb[1] = MB[tid * 2 + 1]; } }
        __syncthreads();
    }
}

__device__ __forceinline__ void ml_scan_item(const Q2& q2, int item, char* lds) {
    int tid_ = TIDX; asm volatile("" : "+v"(tid_));
    const int tid = tid_, vq = item & 3, h = (item >> 2) & 3, b = (item >> 4) & 1, d = item >> 5;
    float* MLs = (float*)lds; float* MSEQ = MLs + 2 * NCH + 16;
    for (int i = tid; i < NCH; i += 512) { const float* mb = q2.MLB + ((((size_t)d * NB + b) * NCH + ord_chunk(d, NCH, i)) * 4 + h) * 2; MLs[2 * i] = mb[0]; MLs[2 * i + 1] = mb[1]; }
    __syncthreads();
    if (tid == 0) { float m = 0.f; for (int i = 0; i < NCH; ++i) { MSEQ[i] = m; m = fmaxf(MLs[2 * i + 1] + m, MLs[2 * i]); } MSEQ[NCH] = m; }
    __syncthreads();
    const int e0 = vq * 1024 + tid * 2; float c0 = 0.f, c1 = 0.f, nn = 0.f; const bool don = (vq == 0 && tid < 64);
    static_assert(NCH % 11 == 0, "the scan streams the chunk contributions 11 at a time");
#pragma unroll 1
    for (int i0 = 0; i0 < NCH; i0 += 11) { float2 cl[11]; float nl[11];
#pragma unroll
        for (int x = 0; x < 11; ++x) { const size_t idx = (((size_t)d * NB + b) * NCH + ord_chunk(d, NCH, i0 + x)) * 4 + h; cl[x] = *(const float2*)(q2.CLOC + idx * 4096 + e0); nl[x] = don ? q2.NLOC[idx * 64 + tid] : 0.f; }
#pragma unroll
        for (int x = 0; x < 11; ++x) { const int i = i0 + x; const size_t idx = (((size_t)d * NB + b) * NCH + ord_chunk(d, NCH, i)) * 4 + h;
            *(unsigned*)(q2.CST + idx * 4096 + e0) = pk2(c0, c1);
            if (don) q2.NST[idx * 64 + tid] = nn;
            if (vq == 0 && tid == 64) q2.MST[idx] = MSEQ[i];
            const float m = MSEQ[i], mn = MSEQ[i + 1], dec = __expf(MLs[2 * i + 1] + m - mn), sc = __expf(MLs[2 * i] - mn);
            c0 = dec * c0 + sc * cl[x].x; c1 = dec * c1 + sc * cl[x].y; nn = dec * nn + sc * nl[x]; } }
    __syncthreads();
}

constexpr int ML2_LDS = 145536;
template <class UL, class YS>
__device__ __forceinline__ void ml2_item(const P& p, const Q2& q2, int l, int b, int ch, int h, char* lds, const UL& U, const YS& Y) {
    int tid_ = TIDX; asm volatile("" : "+v"(tid_));
    const int tid = tid_, wave = tid >> 6, lane = tid & 63, r32 = lane & 31, hi = lane >> 5;
    char* Ks = lds; char* Vs = lds + 32768; unsigned short* C0 = (unsigned short*)(lds + 49152); float* N0 = (float*)(lds + 67584); float* ROWV = (float*)(lds + 68096);
    float* COEF = (float*)(lds + 73216); float* M0 = (float*)(lds + 73792); float* WS = (float*)(lds + 73856) + wave * 64; float* HX = (float*)(lds + 75904);
    const int t0 = b * TPB + ch * 128;
    { const unsigned short* base = (const unsigned short*)q2.QKV16 + (size_t)t0 * 768 + h * 64;
#pragma unroll
      for (int x = 0; x < 2; ++x) { const int cidx = tid + x * 512, key = cidx >> 3, c8 = cidx & 7, tile = key >> 6, kk = key & 63;
          const att::bf16x8 kv = *reinterpret_cast<const att::bf16x8*>(base + (size_t)key * 768 + 256 + c8 * 8), vv = *reinterpret_cast<const att::bf16x8*>(base + (size_t)key * 768 + 512 + c8 * 8);
          *(att::bf16x8*)(Ks + tile * 16384 + (kk * 256 + ((c8 * 16) ^ ((kk & 7) << 4)))) = kv;
          *(att::bf16x8*)(Vs + tile * 8192 + att::v_st(kk, c8 * 8)) = vv; } }
    if (wave < 2) { const int d = wave, ta = d == 0 ? lane : 127 - lane, tb = d == 0 ? lane + 64 : 63 - lane;
        float* g = ROWV + (d * 5 + 0) * 128; float* pmv = ROWV + (d * 5 + 1) * 128; float* bv = ROWV + (d * 5 + 2) * 128;
        const float iga = q2.GATES[(size_t)(t0 + ta) * 16 + d * 8 + h], igb = q2.GATES[(size_t)(t0 + tb) * 16 + d * 8 + h];
        float b0 = q2.GATES[(size_t)(t0 + ta) * 16 + d * 8 + 4 + h], b1 = q2.GATES[(size_t)(t0 + tb) * 16 + d * 8 + 4 + h]; wave_scan_add128(b0, b1, lane);
        const float g0 = iga - b0, g1 = igb - b1; float p0 = g0, p1 = g1; wave_scan_max128(p0, p1, lane);
        g[ta] = g0; g[tb] = g1; pmv[ta] = p0; pmv[tb] = p1; bv[ta] = b0; bv[tb] = b1; }
    __syncthreads();
    { const int d = tid >> 8, e0 = (tid & 255) * 16; const size_t idx = (((size_t)d * NB + b) * NCH + ch) * 4 + h;
      const u32x4* src = (const u32x4*)(q2.CST + idx * 4096 + e0); const u32x4 w0 = src[0], w1 = src[1];
      { const int v = e0 >> 6, k = e0 & 63; unsigned short* dst = C0 + (d * 64 + v) * 72 + k; *(u32x4*)dst = w0; *(u32x4*)(dst + 8) = w1; }
      if (tid < 128) { const int nd = tid >> 6, nk = tid & 63; N0[nd * 64 + nk] = q2.NST[((((size_t)nd * NB + b) * NCH + ch) * 4 + h) * 64 + nk]; }
      if (tid < 2) M0[tid] = q2.MST[(((size_t)tid * NB + b) * NCH + ch) * 4 + h]; }
    __syncthreads();
    {
      if (tid < 256) { const int dd = tid >> 7, tt = tid & 127; const float m0 = M0[dd], M = fmaxf(m0, ROWV[(dd * 5 + 1) * 128 + tt]);
          ROWV[(dd * 5 + 1) * 128 + tt] = M; ROWV[(dd * 5 + 3) * 128 + tt] = __expf(m0 - M); ROWV[(dd * 5 + 4) * 128 + tt] = __expf(-(ROWV[(dd * 5 + 2) * 128 + tt] + M)); } }
    __syncthreads();
    { const int qb = wave & 3, d = wave >> 2; const float* g = ROWV + (d * 5 + 0) * 128; const float* Mv = ROWV + (d * 5 + 1) * 128; const float* wiv = ROWV + (d * 5 + 3) * 128; const float* emtv = ROWV + (d * 5 + 4) * 128;
      att::bf16x8 qr[4]; const int sq = qb * 32 + r32;
      { const unsigned short* qw = (const unsigned short*)q2.QKV16 + (size_t)(t0 + sq) * 768 + h * 64 + hi * 8;
#pragma unroll
        for (int d0 = 0; d0 < 4; ++d0) qr[d0] = *reinterpret_cast<const att::bf16x8*>(qw + d0 * 16); }
      const float Ms = Mv[sq] * 1.4426950408889634f; att::f32x16 o[2] = {}; float rs = 0.f;
      const int vb0 = (int)(uintptr_t)Vs + att::v_rd_base(lane);
#pragma unroll
      for (int kt = 0; kt < 2; ++kt) {
          const bool skip = d == 0 ? (kt == 1 && qb < 2) : (kt == 0 && qb >= 2);
          if (!skip) {
              att::f32x16 p0 = {}, p1 = {}; const char* Kt = Ks + kt * 16384;
#pragma unroll
              for (int d0 = 0; d0 < 4; ++d0) { const int cb = (d0 * 16 + hi * 8) * 2;
                  const att::bf16x8 b0 = *reinterpret_cast<const att::bf16x8*>(Kt + (r32 * 256 + (cb ^ ((r32 & 7) << 4))));
                  const att::bf16x8 b1 = *reinterpret_cast<const att::bf16x8*>(Kt + ((32 + r32) * 256 + (cb ^ ((r32 & 7) << 4))));
                  p0 = __builtin_amdgcn_mfma_f32_32x32x16_bf16(b0, qr[d0], p0, 0, 0, 0); p1 = __builtin_amdgcn_mfma_f32_32x32x16_bf16(b1, qr[d0], p1, 0, 0, 0); }
#pragma unroll
              for (int r = 0; r < 16; ++r) { const int k0 = kt * 64 + att::crow(r, hi), k1 = k0 + 32;
                  const bool ok0 = d == 0 ? k0 <= sq : k0 >= sq, ok1 = d == 0 ? k1 <= sq : k1 >= sq;
                  p0[r] = ok0 ? p0[r] * __builtin_amdgcn_exp2f(g[k0] * 1.4426950408889634f - Ms) : 0.f; p1[r] = ok1 ? p1[r] * __builtin_amdgcn_exp2f(g[k1] * 1.4426950408889634f - Ms) : 0.f;
                  rs += p0[r] + p1[r]; }
              att::bf16x8 pa0, pa1, pa2, pa3;
#define PK4(P, BASE, OUT) do { unsigned a0 = att::cvtpk(P[BASE + 0], P[BASE + 1]), a1 = att::cvtpk(P[BASE + 2], P[BASE + 3]);   \
    unsigned b0 = att::cvtpk(P[BASE + 4], P[BASE + 5]), b1 = att::cvtpk(P[BASE + 6], P[BASE + 7]);                              \
    auto r0 = __builtin_amdgcn_permlane32_swap(a0, b0, false, false); auto r1 = __builtin_amdgcn_permlane32_swap(a1, b1, false, false); \
    att::u32x4 w = {r0[0], r1[0], r0[1], r1[1]}; OUT = *reinterpret_cast<att::bf16x8*>(&w); } while (0)
              PK4(p0, 0, pa0); PK4(p0, 8, pa1); PK4(p1, 0, pa2); PK4(p1, 8, pa3);
#undef PK4
              att::pv_d0(o, vb0 + kt * 8192, pa0, pa1, pa2, pa3);
          }
      }
      att::f32x16 ic[2] = {};
#pragma unroll
      for (int vt = 0; vt < 2; ++vt)
#pragma unroll
          for (int d0 = 0; d0 < 4; ++d0) { const att::bf16x8 cb = *reinterpret_cast<const att::bf16x8*>(C0 + (d * 64 + vt * 32 + r32) * 72 + d0 * 16 + hi * 8);
              ic[vt] = __builtin_amdgcn_mfma_f32_32x32x16_bf16(qr[d0], cb, ic[vt], 0, 0, 0); }
      float nq = 0.f;
#pragma unroll
      for (int d0 = 0; d0 < 4; ++d0)
#pragma unroll
          for (int x = 0; x < 8; ++x) nq += bf2f((unsigned short)qr[d0][x]) * N0[d * 64 + d0 * 16 + hi * 8 + x];
      { auto rr = __builtin_amdgcn_permlane32_swap(__float_as_uint(nq), __float_as_uint(nq), false, false); nq = __uint_as_float(rr[0]) + __uint_as_float(rr[1]); }
      { auto rr = __builtin_amdgcn_permlane32_swap(__float_as_uint(rs), __float_as_uint(rs), false, false); rs = __uint_as_float(rr[0]) + __uint_as_float(rr[1]); }
      const float den = rs + wiv[sq] * nq, dn = fmaxf(fabsf(den), emtv[sq]);
      if (hi == 0) WS[r32] = __builtin_amdgcn_rcpf(dn);
      asm volatile("s_waitcnt lgkmcnt(0)" ::: "memory");
#pragma unroll
      for (int r = 0; r < 16; ++r) { const int row = att::crow(r, hi), tt = qb * 32 + row; const float inv = WS[row], wi = wiv[tt];
#pragma unroll
          for (int vt = 0; vt < 2; ++vt) HX[(d * 128 + tt) * 68 + vt * 32 + r32] = (o[vt][r] + wi * ic[vt][r]) * inv; }
    }
    __syncthreads();
    { const int tt = tid >> 2, v0 = (tid & 3) * 16, t = t0 + tt; float hv[16]; float s = 0.f;
#pragma unroll
      for (int i = 0; i < 16; ++i) { hv[i] = HX[tt * 68 + v0 + i] + HX[(128 + tt) * 68 + v0 + i]; s += hv[i]; }
      s += __shfl_xor(s, 1); s += __shfl_xor(s, 2); const float mu = s * (1.f / 64.f); float vs = 0.f;
#pragma unroll
      for (int i = 0; i < 16; ++i) { hv[i] -= mu; vs += hv[i] * hv[i]; }
      vs += __shfl_xor(vs, 1); vs += __shfl_xor(vs, 2); const float rstd = 1.f / sqrtf(vs * (1.f / 64.f) + EPS);
#pragma unroll
      for (int i = 0; i < 16; ++i) { const int c = h * 64 + v0 + i;
          const float y = hv[i] * rstd * p.in[I_MNG][(size_t)l * 256 + c] + p.in[I_MSK][(size_t)l * 256 + c] * bf2f(q2.XCM16[(size_t)t * 256 + c]);
          Y(t, 768 + c, y * fast_silu(U(t, OFF_MZ + c))); } }
    __syncthreads();
}
typedef float f32x4_t __attribute__((ext_vector_type(4)));

__device__ __forceinline__ void row_norm_mod(f32x4 (&v)[4], const float* g, const float* sc, const float* sh, int lane) {
    float s = 0.f;
#pragma unroll
    for (int j = 0; j < 4; ++j) s += (v[j].x * v[j].x + v[j].y * v[j].y) + (v[j].z * v[j].z + v[j].w * v[j].w);
    const float rstd = 1.f / sqrtf(wave_sum(s) * (1.f / D) + EPS);
#pragma unroll
    for (int j = 0; j < 4; ++j) { const int k = (j * 64 + lane) * 4; const f32x4 gv = *(const f32x4*)(g + k);
        if (sc) { const f32x4 scv = *(const f32x4*)(sc + k), shv = *(const f32x4*)(sh + k); v[j] = v[j] * rstd * gv * (scv + 1.f) + shv; } else v[j] = v[j] * rstd * gv; }
}
__device__ __forceinline__ void row_store_bf16(bf16* dst, const f32x4 (&v)[4], int lane) {
#pragma unroll
    for (int j = 0; j < 4; ++j) { u32x2 w; w.x = pk2(v[j].x, v[j].y); w.y = pk2(v[j].z, v[j].w); *(u32x2*)(dst + (j * 64 + lane) * 4) = w; }
}
__device__ __forceinline__ void rp_first(const P& p, const Q& q, int gw, int ngw, int lane) {
    for (int t = gw; t < NT; t += ngw) { const int b = t / TPB, i = t % TPB; const float* src = i < CTX ? p.in[I_CTX] + ((size_t)b * CTX + i) * D : p.in[I_X] + ((size_t)b * SEQ + (i - CTX)) * D;
        f32x4 v[4];
#pragma unroll
        for (int j = 0; j < 4; ++j) v[j] = *(const f32x4*)(src + (j * 64 + lane) * 4);
        const int cv = tok_cv(t); row_norm_mod(v, p.in[I_N1G], modp(p, 0, cv, 1), modp(p, 0, cv, 0), lane); row_store_bf16(q.H16 + (size_t)t * D, v, lane); }
}
__device__ __forceinline__ void rp_end(const P& p, const Q& q, const Q2& q2, int l, int gw, int ngw, int lane, float probe_scale = 1.f) {
    const bool last = l + 1 == DEPTH; const int nrows = last ? NB * SEQ : NT;
    for (int r_ = gw; r_ < nrows; r_ += ngw) { const int t = last ? (r_ / SEQ) * TPB + CTX + r_ % SEQ : r_; const int cv = tok_cv(t); const float* g2 = modp(p, l, cv, 5); f32x4 v[4];
#pragma unroll
        for (int j = 0; j < 4; ++j) { const int k = (j * 64 + lane) * 4; f32x4 s = {0.f, 0.f, 0.f, 0.f};
#pragma unroll
            for (int e = 0; e < 4; ++e) { const u32x2 w = *(const u32x2*)(q2.YB16 + ((size_t)t * 4 + e) * D + k);
                s.x += __builtin_bit_cast(float, w.x << 16); s.y += __builtin_bit_cast(float, w.x & 0xffff0000u); s.z += __builtin_bit_cast(float, w.y << 16); s.w += __builtin_bit_cast(float, w.y & 0xffff0000u); }
            v[j] = *(const f32x4*)(p.X + (size_t)t * D + k) + *(const f32x4*)(g2 + k) * s * probe_scale; }
        if (l + 1 < DEPTH) {
#pragma unroll
            for (int j = 0; j < 4; ++j) *(f32x4*)(p.X + (size_t)t * D + (j * 64 + lane) * 4) = v[j];
            row_norm_mod(v, p.in[I_N1G] + (size_t)(l + 1) * D, modp(p, l + 1, cv, 1), modp(p, l + 1, cv, 0), lane); row_store_bf16(q.H16 + (size_t)t * D, v, lane);
        } else { const int b = t / TPB, i = t % TPB; if (i < CTX) continue;
            row_norm_mod(v, p.in[I_FG], nullptr, nullptr, lane);
#pragma unroll
            for (int j = 0; j < 4; ++j) *(f32x4*)(p.out + ((size_t)b * SEQ + (i - CTX)) * D + (j * 64 + lane) * 4) = v[j]; }
    }
}
constexpr int RPM_LDS = 89024;
__device__ __forceinline__ void rp_mid(const P& p, const Q& q, float* GLIST, int l, char* lds, int G, int bid, bool latent_only, bool probe_nolist = false) {
    int tid_ = TIDX; asm volatile("" : "+v"(tid_));
    const int tid = tid_, wave = tid >> 6, lane = tid & 63;
    float* HS = (float*)lds; float* PART = (float*)(lds + 65664); float* LG = (float*)(lds + 82048); int* LCNT = (int*)(lds + 84096); int* LBASE = (int*)(lds + 84224); int* PEND = (int*)(lds + 84352); int* NPEND = (int*)(lds + 88960);
    if (tid < 32) LCNT[tid] = 0; if (tid == 32) NPEND[0] = 0;
    float B0[32], B1[32]; const float* Wr = p.in[I_WR] + (size_t)l * D * NE;
#pragma unroll
    for (int ks = 0; ks < 32; ++ks) { const int k = 128 * wave + 4 * ks + (lane >> 4); B0[ks] = Wr[(size_t)k * NE + (lane & 15)]; B1[ks] = Wr[(size_t)k * NE + 16 + (lane & 15)]; }
    __syncthreads();
    const int nitems = latent_only ? NB * SEQ / 16 : NT / 16;
    for (int it_ = bid; it_ < nitems; it_ += G) { const int it = latent_only ? (it_ / (SEQ / 16)) * (TPB / 16) + CTX / 16 + it_ % (SEQ / 16) : it_;
#pragma unroll 1
        for (int rr = 0; rr < 2; ++rr) { const int row = 2 * wave + rr, t = it * 16 + row, cv = tok_cv(t); f32x4 v[4];
#pragma unroll
            for (int j = 0; j < 4; ++j) v[j] = *(const f32x4*)(p.X + (size_t)t * D + (j * 64 + lane) * 4);
            row_norm_mod(v, p.in[I_N2G] + (size_t)l * D, modp(p, l, cv, 4), modp(p, l, cv, 3), lane); row_store_bf16(q.H16 + (size_t)t * D, v, lane);
#pragma unroll
            for (int j = 0; j < 4; ++j) { float* d = HS + row * 1026 + (j * 64 + lane) * 4; *(float2*)d = make_float2(v[j].x, v[j].y); *(float2*)(d + 2) = make_float2(v[j].z, v[j].w); } }
        __syncthreads();
        { f32x4_t a0 = {0.f, 0.f, 0.f, 0.f}, a1 = a0; const float* hrow = HS + (lane & 15) * 1026 + 128 * wave + (lane >> 4);
#pragma unroll
          for (int ks = 0; ks < 32; ++ks) { const float a = hrow[4 * ks]; a0 = __builtin_amdgcn_mfma_f32_16x16x4f32(a, B0[ks], a0, 0, 0, 0); a1 = __builtin_amdgcn_mfma_f32_16x16x4f32(a, B1[ks], a1, 0, 0, 0); }
#pragma unroll
          for (int r = 0; r < 4; ++r) { const int row = (lane >> 4) * 4 + r; PART[(wave * 16 + row) * 32 + (lane & 15)] = a0[r]; PART[(wave * 16 + row) * 32 + 16 + (lane & 15)] = a1[r]; } }
        __syncthreads();
        { float s = p.in[I_BR][(size_t)l * NE + (tid & 31)];
#pragma unroll
          for (int w = 0; w < 8; ++w) s += PART[w * 512 + tid];
          LG[tid] = s; }
        __syncthreads();
        if (tid < 16) { const int t = it * 16 + tid; float lg[NE];
#pragma unroll
            for (int e = 0; e < NE; ++e) lg[e] = LG[tid * 32 + e];
            int te[TOPK]; float tv[TOPK];
#pragma unroll
            for (int r = 0; r < TOPK; ++r) { float best = -3.0e38f; int bi = 0;
#pragma unroll
                for (int e = 0; e < NE; ++e) { const bool c = lg[e] > best; best = c ? lg[e] : best; bi = c ? e : bi; }
                te[r] = bi; tv[r] = best;
#pragma unroll
                for (int e = 0; e < NE; ++e) lg[e] = (e == bi) ? -3.0e38f : lg[e]; }
            float ssum = 0.f, ex[TOPK];
#pragma unroll
            for (int r = 0; r < TOPK; ++r) { ex[r] = __expf(tv[r] - tv[0]); ssum += ex[r]; }
            const float inv = 1.f / ssum;
#pragma unroll
            for (int r = 0; r < TOPK; ++r) { p.TOPG[t * TOPK + r] = ex[r] * inv; const int lp = atomicAdd(&LCNT[te[r]], 1); const int slot = atomicAdd(NPEND, 1);
                PEND[slot * 3] = t * TOPK + r; PEND[slot * 3 + 1] = (te[r] << 16) | lp; PEND[slot * 3 + 2] = __float_as_int(ex[r] * inv); } }
        __syncthreads();
    }
    if (probe_nolist) return;
    if (tid < 32) LBASE[tid] = LCNT[tid] > 0 ? atomicAdd(&p.CNT[tid], LCNT[tid]) : 0;
    __syncthreads();
    for (int i = tid; i < NPEND[0]; i += 512) { const int pr = PEND[i * 3], x = PEND[i * 3 + 1], e = x >> 16, lp = x & 0xffff; p.LIST[(size_t)e * NT + LBASE[e] + lp] = pr; GLIST[(size_t)e * NT + LBASE[e] + lp] = __int_as_float(PEND[i * 3 + 2]); }
    __syncthreads();
}
struct EpiDown16 {
    static constexpr bool PERM = true; bf16* YB; const float* bd; const float* GL; const int* CNT; const int* LIST; int nN; int probe_skip;
    __device__ __forceinline__ void operator()(const pg8::f32x4 (&acc)[2][2][4][2], const pg8::Unit& u, int wr, int wc, int fr, int fq) const {
        if (probe_skip) return;
        const int ntile = u.pn - u.e * nN, cnt = CNT[u.e]; const float* b = bd + (size_t)u.e * D;
        int pr[2][4]; float gt[2][4];
#pragma unroll
        for (int ai = 0; ai < 2; ++ai)
#pragma unroll
            for (int m = 0; m < 4; ++m) { const int idx = u.mb * 256 + ai * 128 + wr * 64 + m * 16 + fr, ic = idx < cnt ? idx : 0; pr[ai][m] = LIST[(size_t)u.e * NT + ic]; gt[ai][m] = GL[(size_t)u.e * NT + ic]; }
        pg8::f32x4 bv[2][2];
#pragma unroll
        for (int bj = 0; bj < 2; ++bj) { const int c = ntile * 256 + bj * 128 + wc * 32 + 8 * fq; bv[bj][0] = *(const pg8::f32x4*)(b + c); bv[bj][1] = *(const pg8::f32x4*)(b + c + 4); }
#pragma unroll
        for (int ai = 0; ai < 2; ++ai)
#pragma unroll
            for (int m = 0; m < 4; ++m) { const int idx = u.mb * 256 + ai * 128 + wr * 64 + m * 16 + fr;
                if (idx < cnt) { const float g = gt[ai][m];
#pragma unroll
                    for (int bj = 0; bj < 2; ++bj) { const int c = ntile * 256 + bj * 128 + wc * 32 + 8 * fq;
                        const pg8::f32x4 v0 = (acc[ai][bj][m][0] + bv[bj][0]) * g, v1 = (acc[ai][bj][m][1] + bv[bj][1]) * g;
                        u32x4 w; w.x = pg8::cvt_pk_bf16(v0[0], v0[1]); w.y = pg8::cvt_pk_bf16(v0[2], v0[3]); w.z = pg8::cvt_pk_bf16(v1[0], v1[1]); w.w = pg8::cvt_pk_bf16(v1[2], v1[3]);
                        *(u32x4*)(YB + (size_t)pr[ai][m] * D + c) = w; } } }
    }
};
__device__ __forceinline__ void opt_moe_down16(const P& p, const Q& q, const Q2& q2, int l, LAS unsigned char* lds, int G, int bid, int probe_skip = 0) {
    pg8::Gemm g{q.ACT16, q.WtDn + (size_t)l * NE * D * DE, DE}; DnOrder S; S.init(p.CNT, p.LIST, D / 256, G, bid, (LAS int*)(lds + pg8::STAGE_BYTES));
    EpiDown16 E{q2.YB16, p.in[I_BD] + (size_t)l * NE * D, q2.GLIST, p.CNT, p.LIST, D / 256, probe_skip}; pg8::gemm_phase<EpiDown16, DnOrder, true>(lds, g, S, E);
}
#define GAS __attribute__((address_space(1)))
typedef GAS unsigned gu32;
#define XB_TMO      128
#define XB_XCNT(j)  (256  + 64 * (j))
#define XB_XSUB(j)  (1280 + 64 * (j))
#define XB_XGEN(j)  (2304 + 64 * (j))
#define XB_TOP      3328
#define XB_TOPGEN   3392
#define XCD_BAR_WORDS 3456
#define XB_SPIN_CAP (1u << 18)

__device__ __forceinline__ unsigned xb_ld(unsigned* p)              { return __hip_atomic_load(p, __ATOMIC_RELAXED, __HIP_MEMORY_SCOPE_AGENT); }
__device__ __forceinline__ unsigned xb_add(unsigned* p, unsigned v) { return __hip_atomic_fetch_add(p, v, __ATOMIC_RELAXED, __HIP_MEMORY_SCOPE_AGENT); }
__device__ __forceinline__ unsigned xb_xcc_id() { return (unsigned)__builtin_amdgcn_s_getreg((3 << 11) | 20) & 0xFu; }
#define XB_SPIN(cond, bar) do { unsigned _sp = 0; while (cond) { __builtin_amdgcn_s_sleep(1); \
    if ((++_sp & 255u) == 0u) { if (xb_ld(&(bar)[XB_TMO])) break; if (_sp > XB_SPIN_CAP) { atomicAdd(&(bar)[XB_TMO], 1u); break; } } } } while (0)

struct XcdBarrier {
    unsigned* bar; unsigned x;
    volatile LAS unsigned* st;
};

__device__ __forceinline__ XcdBarrier xcd_barrier_post(unsigned* bar, volatile LAS unsigned* st) {
    XcdBarrier b; b.bar = bar; b.x = xb_xcc_id(); b.st = st;
    if (TIDX == 0) (void)xb_add(&bar[XB_XCNT(b.x)], 1u);
    return b;
}
__device__ __forceinline__ void xcd_barrier_complete(unsigned* bar, unsigned x, unsigned& nloc, unsigned& nx) {
    const unsigned G = gridDim.x * gridDim.y * gridDim.z;
    unsigned sum, cnt, mine, sp = 0u;
    for (;;) {
        sum = 0u; cnt = 0u; mine = 0u;
#pragma unroll
        for (unsigned j = 0; j < 16; ++j) { const unsigned c = xb_ld(&bar[XB_XCNT(j)]); sum += c; cnt += (c > 0u) ? 1u : 0u; mine = (j == x) ? c : mine; }
        if (sum == G) break;
        __builtin_amdgcn_s_sleep(1);
        if ((++sp & 255u) == 0u) { if (xb_ld(&bar[XB_TMO])) break; if (sp > XB_SPIN_CAP) { atomicAdd(&bar[XB_TMO], 1u); break; } }
    }
    nloc = mine > 0u ? mine : 1u; nx = cnt > 0u ? cnt : 1u;
}

__device__ __forceinline__ void xcd_barrier(const XcdBarrier& b) {
    asm volatile("s_waitcnt vmcnt(0)" ::: "memory");
    __syncthreads();
    if (TIDX == 0) {
        unsigned* bar = b.bar;
        __builtin_amdgcn_s_waitcnt(0);
        unsigned nloc = b.st[0], nx = b.st[1];
        if (nloc == 0u) { xcd_barrier_complete(bar, b.x, nloc, nx); b.st[0] = nloc; b.st[1] = nx; }
#ifdef XB_EARLY_WB
        __builtin_amdgcn_fence(__ATOMIC_RELEASE, "agent"); asm volatile("s_waitcnt vmcnt(0)" ::: "memory");
#endif
        const unsigned old = xb_add(&bar[XB_XSUB(b.x)], 1u);
        const unsigned gen = old / nloc;
        if (old + 1u == (gen + 1u) * nloc) {
            __builtin_amdgcn_fence(__ATOMIC_RELEASE, "agent");
            asm volatile("s_waitcnt vmcnt(0)" ::: "memory");
            const unsigned og = xb_add(&bar[XB_TOP], 1u);
            const unsigned tg = og / nx;
            if (og + 1u == (tg + 1u) * nx) xb_add(&bar[XB_TOPGEN], 1u);
            else XB_SPIN(xb_ld(&bar[XB_TOPGEN]) == tg, bar);
            __builtin_amdgcn_fence(__ATOMIC_ACQUIRE, "agent");
            xb_add(&bar[XB_XGEN(b.x)], 1u);
            asm volatile("s_waitcnt vmcnt(0)" ::: "memory");
        } else {
            XB_SPIN(xb_ld(&bar[XB_XGEN(b.x)]) == gen, bar);
            __builtin_amdgcn_fence(__ATOMIC_ACQUIRE, "agent");
            asm volatile("s_waitcnt vmcnt(0)" ::: "memory");
        }
    }
    __syncthreads();
}
#include <hip/hip_cooperative_groups.h>
#include <cstdio>
namespace cg = cooperative_groups;
#ifndef ONE_LAUNCH
#define ONE_LAUNCH 1
#endif
constexpr int LDS_BYTES = 148480;
static_assert(ML2_LDS <= LDS_BYTES && ML1_LDS <= LDS_BYTES && LRU1_LDS <= LDS_BYTES && RPM_LDS <= LDS_BYTES && att::SHM_ATTN <= LDS_BYTES && pg8::STAGE_BYTES + 1024 + 8192 + 15 * 512 <= LDS_BYTES - 64 - 256, "LDS map");

struct BMap { size_t off[64]; size_t total; };
static inline BMap b_map() {
    BMap m; size_t o = 0; int i = 0;
    auto add = [&](size_t bytes) { m.off[i++] = o; o += (bytes + 255) & ~(size_t)255; };
    add((size_t)DEPTH * 3 * 6 * D * 4);
    add((size_t)SEQ * 16 * 2 * 4);
    add((size_t)NT * D * 4);
    add((size_t)NT * TOPK * 4);
    add((size_t)256);
    add((size_t)NE * NT * 4);
    add((size_t)DEPTH * DINP * D * 2);
    add((size_t)DEPTH * D * DMIX * 2);
    add((size_t)DEPTH * NE * 2 * DE * D * 2);
    add((size_t)DEPTH * NE * D * DE * 2);
    add((size_t)DEPTH * 768 * QRANK * 2);
    add((size_t)DEPTH * 1024 * KVRANK * 2);
    add((size_t)NT * D * 2);
    add((size_t)NT * DMIX * 2);
    add((size_t)SLOT_MAX * DE * 2);
    add((size_t)NT * AH * QKD * 2);
    add((size_t)NT * AH * VD * 2);
    add((size_t)NT * DINP * 2);
    add((size_t)DEPTH * 4 * 256 * 64 * 2);
    add((size_t)DEPTH * 4 * 3 * 4096 * 2);
    add((size_t)DEPTH * 32 * 768 * 2);
    add((size_t)DEPTH * 2 * 256 * 4);
    add((size_t)2 * NT * 256 * 4);
    add((size_t)2 * NT * 256 * 4);
    add((size_t)2 * NB * NCH * 256 * 4);
    add((size_t)2 * NB * NCH * 256 * 4);
    add((size_t)2 * NT * 256 * 2);
    add((size_t)256);
    add((size_t)NT * 768 * 2);
    add((size_t)DEPTH * 1792 * 256 * 2);
    add((size_t)NT * 256 * 2);
    add((size_t)NT * 768 * 2);
    add((size_t)NT * 16 * 4);
    add((size_t)2 * NB * NCH * 4 * 4096 * 4);
    add((size_t)2 * NB * NCH * 4 * 64 * 4);
    add((size_t)2 * NB * NCH * 4 * 2 * 4);
    add((size_t)NT * TOPK * D * 2);
    add((size_t)XCD_BAR_WORDS * 4);
    add((size_t)2 * NB * NCH * 4 * 4096 * 2);
    add((size_t)2 * NB * NCH * 4 * 64 * 4);
    add((size_t)2 * NB * NCH * 4 * 4);
    add((size_t)NE * NT * 4);
    m.total = o; return m;
}
struct Args { P p; Q q; Q2 q2; unsigned* bar; };
static inline void fill_args(Args& a, void* const* d_in, void* d_out, void* d_ws) {
    for (int i = 0; i < N_IN; ++i) a.p.in[i] = (const float*)d_in[i];
    a.p.out = (float*)d_out; char* w = (char*)d_ws; const BMap m = b_map();
    a.p.MOD = (float*)(w + m.off[0]); a.p.ROPET = (float*)(w + m.off[1]); a.p.X = (float*)(w + m.off[2]); a.p.TOPG = (float*)(w + m.off[3]); a.p.CNT = (int*)(w + m.off[4]); a.p.LIST = (int*)(w + m.off[5]);
    a.q.WtIn = (bf16*)(w + m.off[6]); a.q.WtOut = (bf16*)(w + m.off[7]); a.q.WtGu = (bf16*)(w + m.off[8]); a.q.WtDn = (bf16*)(w + m.off[9]); a.q.WtQb = (bf16*)(w + m.off[10]); a.q.WtKvb = (bf16*)(w + m.off[11]);
    a.q.H16 = (bf16*)(w + m.off[12]); a.q.Y16 = (bf16*)(w + m.off[13]); a.q.ACT16 = (bf16*)(w + m.off[14]); a.q.K16 = (bf16*)(w + m.off[15]); a.q.V16 = (bf16*)(w + m.off[16]);
    a.q2.U16 = (bf16*)(w + m.off[17]); a.q2.WtL = (bf16*)(w + m.off[18]); a.q2.WtM = (bf16*)(w + m.off[19]); a.q2.WtG = (bf16*)(w + m.off[20]); a.q2.LSL = (float*)(w + m.off[21]);
    a.q2.HLOC = (bf16*)(w + m.off[22]); a.q2.PCUM = (bf16*)(w + m.off[23]); a.q2.SA = (float*)(w + m.off[24]); a.q2.SB = (float*)(w + m.off[25]);
    a.q2.QN16 = (bf16*)(w + m.off[26]); a.q2.KVN16 = a.q2.QN16 + (size_t)NT * 256;     a.q2.Q16 = (bf16*)(w + m.off[28]); a.q2.WtKvbP = (bf16*)(w + m.off[29]);
    a.q2.XCM16 = (bf16*)(w + m.off[30]); a.q2.QKV16 = (bf16*)(w + m.off[31]); a.q2.GATES = (float*)(w + m.off[32]); a.q2.CLOC = (float*)(w + m.off[33]); a.q2.NLOC = (float*)(w + m.off[34]); a.q2.MLB = (float*)(w + m.off[35]);
    a.q2.YB16 = (bf16*)(w + m.off[36]); a.bar = (unsigned*)(w + m.off[37]); a.q2.CST = (bf16*)(w + m.off[38]); a.q2.NST = (float*)(w + m.off[39]); a.q2.MST = (float*)(w + m.off[40]); a.q2.GLIST = (float*)(w + m.off[41]);
}

struct ULoad16 { const bf16* U; __device__ __forceinline__ float operator()(int t, int col) const { return bf2f(U[(size_t)t * DINP + col]); } };
struct YStore16 { bf16* Y; __device__ __forceinline__ void operator()(int t, int col, float v) const { Y[(size_t)t * DMIX + col] = (bf16)f2bf(v); } };
struct OutY16 { bf16* y; __device__ __forceinline__ void operator()(int row, int col, float v) const { y[(size_t)row * DMIX + col] = (bf16)f2bf(v); } };

enum { ST_INIT = 0, ST_RPFIRST, ST_INPROJ, ST_PREP, ST_MLAPROJ, ST_MIX, ST_OUTPROJ, ST_RPMID, ST_GU, ST_DOWN, ST_RPEND, N_ST };

typedef const __attribute__((address_space(4))) Args* KArgs;
__device__ __forceinline__ KArgs kargs() { KArgs k = (KArgs)__builtin_amdgcn_kernarg_segment_ptr(); asm volatile("" : "+s"(k)); return k; }
__device__ __forceinline__ void run_step(const Args& a_, int step, int l_, unsigned char* lds_raw) {
#if ONE_LAUNCH
    const Args& a = *(const Args*)kargs(); (void)a_;
#else
    const Args& a = a_;
#endif
    const int l = l_ & 0xff, sub = l_ >> 8;
    const P& p = a.p; const Q& q = a.q; const Q2& q2 = a.q2;
    LAS unsigned char* lds = (LAS unsigned char*)lds_raw; char* ldsg = (char*)lds_raw;
    int G_ = gridDim.x, bid_ = blockIdx.x; asm volatile("" : "+s"(G_), "+s"(bid_));
    const int G = G_, bid = bid_;
#define THREAD_IDS int tid_ = TIDX; asm volatile("" : "+v"(tid_)); const int tid = tid_, lane = tid & 63, wave = __builtin_amdgcn_readfirstlane(tid >> 6); \
    const int gw = bid * NWAVES + wave, ngw = G * NWAVES; const long gtid = (long)bid * NTHREADS + tid, nthr = (long)G * NTHREADS; (void)lane; (void)gw; (void)ngw; (void)gtid; (void)nthr;
    switch (step) {
    case ST_INIT: { THREAD_IDS
        if (sub == 0 || (sub & 1)) opt_init_mod(p, ldsg, bid, G);
        if (sub == 0 || (sub & 2)) { opt_init_rope(p, gtid, nthr); opt_convert_small(p, q2, gtid, nthr); }
        if (sub == 0 || (sub & 4)) opt_convert_weights(p, q, q2.WtKvbP, lds, gw, ngw, wave, lane);
        break; }
    case ST_RPFIRST: { THREAD_IDS rp_first(p, q, gw, ngw, lane); break; }
    case ST_INPROJ: opt_inproj16(q, q2, l, lds, G, bid); break;
    case ST_PREP: { THREAD_IDS
        if (gtid < NE) p.CNT[gtid] = 0;
        const ULoad16 U{q2.U16};
        constexpr int NM = NB * NCH, NL = NB * NCH * 4;
        if (G > NM + 8) {
            if (bid < NM) { if (sub == 0 || (sub & 1)) ml1_item(p, q2, l, bid / NCH, bid % NCH, ldsg, U);
                if (sub == 0 || (sub & 2)) lru1_item(p, q2, l, (bid >> 2) / NCH, (bid >> 2) % NCH, bid & 3, ldsg, U); }
            else if (sub == 0 || (sub & 2)) for (int x = NM + (bid - NM); x < NL; x += G - NM) lru1_item(p, q2, l, (x >> 2) / NCH, (x >> 2) % NCH, x & 3, ldsg, U);
        } else for (int it = bid; it < NM + NL; it += G) {
            if (it < NM) { if (sub == 0 || (sub & 1)) ml1_item(p, q2, l, it / NCH, it % NCH, ldsg, U); }
            else if (sub == 0 || (sub & 2)) { const int x = it - NM; lru1_item(p, q2, l, (x >> 2) / NCH, (x >> 2) % NCH, x & 3, ldsg, U); } }
        if (sub == 0 || (sub & 4)) for (int t = gw; t < NT; t += ngw) mla_prep_token(p, q, q2, l, t, lane, U);
        break; }
    case ST_MLAPROJ: { for (int it = G - 1 - bid; it < 64; it += G) ml_scan_item(q2, it, ldsg);
        opt_mla_proj(p, q, q2, l, lds, G, bid); break; }
    case ST_MIX: {
        const ULoad16 U{q2.U16}; const YStore16 Y{q.Y16};
        const int c = bid, vcu = (G % 8 == 0) ? (c % 8) * (G / 8) + c / 8 : c;
        constexpr int QB_LAT = SEQ / 256, QB_CTX = CTX / 256, NU_LAT = NB * AH * QB_LAT, NU_CTX = NB * AH * QB_CTX;
#ifdef ATTN_PROBE_VAR
        if (sub & 1) { struct NoOut { __device__ __forceinline__ void operator()(int, int, float) const {} } noout;
            for (int u = vcu; u < NU_LAT; u += G) { const int bh = u / QB_LAT, qb = u % QB_LAT, b = bh / AH, h = bh % AH, t0 = b * TPB + CTX + qb * 256;
                att::attn_unit<unsigned short, NoOut, ATTN_PROBE_VAR>((const unsigned short*)q2.Q16 + (size_t)t0 * 768 + h * QKD, 768, (const unsigned short*)q.K16 + ((size_t)b * AH + h) * TPB * QKD, (const unsigned short*)q.V16 + ((size_t)b * AH + h) * TPB * VD, TPB, ldsg, noout); } }
        else
#endif
        BgConv bg; { const int wv = __builtin_amdgcn_readfirstlane(TIDX >> 6); bg.init(p, q, l, lds + att::SHM_ATTN, bid * NWAVES + wv, G * NWAVES, wv); }
        if (sub == 0 || (sub & 1)) for (int u = vcu; u < NU_LAT; u += G) { const int bh = u / QB_LAT, qb = u % QB_LAT, b = bh / AH, h = bh % AH, t0 = b * TPB + CTX + qb * 256;
            OutY16 out{q.Y16 + (size_t)t0 * DMIX + 256 + h * VD};
#ifdef BG_OFF
            att::attn_unit<unsigned short, OutY16>((const unsigned short*)q2.Q16 + (size_t)t0 * 768 + h * QKD, 768, (const unsigned short*)q.K16 + ((size_t)b * AH + h) * TPB * QKD, (const unsigned short*)q.V16 + ((size_t)b * AH + h) * TPB * VD, TPB, ldsg, out); }
#else
            att::attn_unit<unsigned short, OutY16, 0, BgConv&>((const unsigned short*)q2.Q16 + (size_t)t0 * 768 + h * QKD, 768, (const unsigned short*)q.K16 + ((size_t)b * AH + h) * TPB * QKD, (const unsigned short*)q.V16 + ((size_t)b * AH + h) * TPB * VD, TPB, ldsg, out, bg); }
#endif
        if ((sub == 0 || (sub & 1)) && l + 1 < DEPTH) for (int u = vcu; u < NU_CTX; u += G) { const int bh = u / QB_CTX, qb = u % QB_CTX, b = bh / AH, h = bh % AH, t0 = b * TPB + qb * 256;
            OutY16 out{q.Y16 + (size_t)t0 * DMIX + 256 + h * VD};
            att::attn_unit<unsigned short, OutY16>((const unsigned short*)q2.Q16 + (size_t)t0 * 768 + h * QKD, 768, (const unsigned short*)q.K16 + ((size_t)b * AH + h) * TPB * QKD, (const unsigned short*)q.V16 + ((size_t)b * AH + h) * TPB * VD, CTX, ldsg, out); }
        bg.drain(); __syncthreads();
        const int ch0 = (l + 1 < DEPTH) ? 0 : NCH_CTX, nch = NCH - ch0;
        if (sub == 0 || (sub & 2)) for (int it = G - 1 - c; it < NB * nch * 4; it += G) { const int x = it >> 2; ml2_item(p, q2, l, x / nch, ch0 + x % nch, it & 3, ldsg, U, Y); }
        if (sub == 0 || (sub & 4)) for (int it = c; it < NB * nch; it += G) lru2_item(q2, q.Y16, it / nch, ch0 + it % nch, ldsg);
        break; }
    case ST_OUTPROJ: opt_outproj(p, q, l, lds, G, bid, l + 1 == DEPTH); break;
    case ST_RPMID: rp_mid(p, q, q2.GLIST, l, ldsg, G, bid, l + 1 == DEPTH, sub != 0); break;
    case ST_GU: opt_moe_gu(p, q, l, lds, G, bid, sub); break;
    case ST_DOWN: opt_moe_down16(p, q, q2, l, lds, G, bid, sub); break;
    case ST_RPEND: { THREAD_IDS rp_end(p, q, q2, l, gw, ngw, lane, sub != 0 ? 0.f : 1.f); break; }
    }
}

#if ONE_LAUNCH
__global__ void __launch_bounds__(512, 2) k_mega(Args a) {
    extern __shared__ __attribute__((aligned(16))) unsigned char lds_raw[];
    volatile LAS unsigned* MISC = (volatile LAS unsigned*)((LAS unsigned char*)lds_raw + LDS_BYTES - 64);
    if (threadIdx.x < 16) MISC[threadIdx.x] = 0u;
    if ((threadIdx.x & 63) == 0) ((LAS int*)((LAS unsigned char*)lds_raw + WTAB_OFF))[HWID()] = threadIdx.x >> 6;
    __syncthreads();
    { const XcdBarrier b0 = xcd_barrier_post(kargs()->bar, MISC + 8); if (TIDX == 0) MISC[10] = b0.x; }
#define GRID_BAR() do { XcdBarrier b_; b_.bar = kargs()->bar; b_.st = MISC + 8; b_.x = MISC[10]; xcd_barrier(b_); } while (0)
    run_step(a, ST_INIT, 0, lds_raw); GRID_BAR();
    run_step(a, ST_RPFIRST, 0, lds_raw); GRID_BAR();
#pragma unroll 1
    for (int l = 0; l < DEPTH; ++l) {
#pragma unroll 1
        for (int s = ST_INPROJ; s <= ST_RPEND; ++s) { run_step(a, s, l, lds_raw); if (!(l == DEPTH - 1 && s == ST_RPEND)) GRID_BAR();
#ifdef MEGA_DUP_STEP
            if (s == MEGA_DUP_STEP) { run_step(a, s, l, lds_raw); GRID_BAR(); }
#endif
        }
    }
}
#else
template <int STEP>
__global__ void __launch_bounds__(512, 2) k_step(Args a, int l) {
    extern __shared__ __attribute__((aligned(16))) unsigned char lds_raw[];
    run_step(a, STEP, l, lds_raw);
}
template <int STEP> static void launch_step(const Args& a, int l, hipStream_t stream) {
    static bool attr = false;
    if (!attr) { (void)hipFuncSetAttribute((const void*)k_step<STEP>, hipFuncAttributeMaxDynamicSharedMemorySize, LDS_BYTES); attr = true; }
    hipLaunchKernelGGL(k_step<STEP>, dim3(256), dim3(512), LDS_BYTES, stream, a, l);
}
#endif

extern "C" void kernel_launch(void* const* d_in, const int* in_sizes, int n_in, void* d_out, int out_size, void* d_ws, size_t ws_size, hipStream_t stream) {
    static int grid_blocks = 0;
    if (!grid_blocks) {
        int dev = 0, cus = 0;
        (void)hipGetDevice(&dev); (void)hipDeviceGetAttribute(&cus, hipDeviceAttributeMultiprocessorCount, dev);
        grid_blocks = cus;
#if ONE_LAUNCH
        int per_cu = 0;
        (void)hipFuncSetAttribute((const void*)k_mega, hipFuncAttributeMaxDynamicSharedMemorySize, LDS_BYTES);
        (void)hipOccupancyMaxActiveBlocksPerMultiprocessor(&per_cu, (const void*)k_mega, 512, LDS_BYTES);
        if (per_cu < 1) fprintf(stderr, "kernel_launch: occupancy query reports %d workgroups per CU\n", per_cu);
#endif
        const BMap m = b_map();
        if (n_in != N_IN || m.total > ws_size) fprintf(stderr, "kernel_launch: bad n_in %d or workspace too small (%zu needed, %zu given)\n", n_in, m.total, ws_size);
    }
    Args a{}; fill_args(a, d_in, d_out, d_ws);
#if ONE_LAUNCH
    (void)hipMemsetAsync(a.bar, 0, XCD_BAR_WORDS * 4, stream);
    void* args[] = {&a};
    hipError_t e = hipLaunchCooperativeKernel((const void*)k_mega, dim3(grid_blocks), dim3(512), args, LDS_BYTES, stream);
    if (e != hipSuccess) fprintf(stderr, "cooperative launch failed: %s (grid %d)\n", hipGetErrorString(e), grid_blocks);
#else
#ifndef DUP_STEP
#define DUP_STEP -1
#endif
#ifndef DUP_SUB
#define DUP_SUB 0
#endif
#define LS(ST, l) do { launch_step<ST>(a, l, stream); if (ST == DUP_STEP) launch_step<ST>(a, (l) | (DUP_SUB << 8), stream); } while (0)
    LS(ST_INIT, 0); LS(ST_RPFIRST, 0);
    for (int l = 0; l < DEPTH; ++l) {
        LS(ST_INPROJ, l); LS(ST_PREP, l); LS(ST_MLAPROJ, l); LS(ST_MIX, l); LS(ST_OUTPROJ, l);
        LS(ST_RPMID, l); LS(ST_GU, l); LS(ST_DOWN, l); LS(ST_RPEND, l);
    }
#endif
}
```

```cpp
#include <hip/hip_runtime.h>
#define ONE_LAUNCH 1
#include <math.h>
#include <stdint.h>

#ifndef CFG_D_MODEL
#define CFG_D_MODEL 1024
#endif
#ifndef CFG_SEQ
#define CFG_SEQ 8192
#endif
#ifndef CFG_GRID_W
#define CFG_GRID_W 64
#endif
#ifndef CFG_CTX_LEN
#define CFG_CTX_LEN 256
#endif
#ifndef CFG_N_EXPERTS
#define CFG_N_EXPERTS 32
#endif
#ifndef CFG_D_EXPERT
#define CFG_D_EXPERT 1024
#endif

#ifdef HOST_TEST
#define HD inline
struct float4 { float x, y, z, w; };
static inline int atomic_add_i(int* p, int v) { int o = *p; *p = o + v; return o; }
#else
#define HD __device__ __forceinline__
static __device__ __forceinline__ int atomic_add_i(int* p, int v) { return atomicAdd(p, v); }
#endif

constexpr int D = CFG_D_MODEL, NB = 2, SEQ = CFG_SEQ, DEPTH = 2, GRID_W = CFG_GRID_W, CTX = CFG_CTX_LEN;
constexpr int TPB = CTX + SEQ;
constexpr int NT = NB * TPB;
constexpr int LW = 256, MLH = 4, MHD = 64, MW = 256;
constexpr int AH = 8, NOPE = 64, ROPE = 32, VD = 64, QRANK = 256, KVRANK = 128, QKD = NOPE + ROPE;
constexpr int DIN = 1440, DMIX = 1024;
constexpr int OFF_AX = 0, OFF_AG = 256, OFF_BQ = 512, OFF_BKV = 768, OFF_BKR = 896, OFF_MX = 928, OFF_MZ = 1184;
constexpr int NE = CFG_N_EXPERTS, TOPK = 4, DE = CFG_D_EXPERT;
constexpr float EPS = 1e-6f;

enum { I_X = 0, I_C, I_CTX, I_CCTX, I_N1G, I_N2G, I_WMOD, I_BMOD, I_WIN, I_WOUT, I_LCW, I_LCB, I_LWA, I_LBA, I_LWX, I_LBX, I_LLAM,
       I_QNG, I_WQB, I_KVNG, I_WKVB, I_MCW, I_MCB, I_MWQ, I_MWK, I_MWV, I_MWG, I_MBG, I_MNG, I_MSK, I_WR, I_BR, I_WGU, I_BGU, I_WD, I_BD, I_FG, N_IN };

struct P {
    const float* in[N_IN];
    float* out;
    float *MOD, *ROPET, *X, *H, *U, *XC, *LA, *LB, *HL, *QN, *KVN, *QF, *KVF, *Qr, *Kr, *Vr, *XCM, *QM, *KM, *VM, *IGF, *HM, *Y, *TOPG, *ACT, *YB;
    int *TOPE, *CNT, *LIST;
};

HD float sigmoid_f(float x) { return 1.f / (1.f + expf(-x)); }
HD float silu_f(float x) { return x * sigmoid_f(x); }
HD float logsigmoid_f(float x) { return fminf(x, 0.f) - log1pf(expf(-fabsf(x))); }
HD float gelu_f(float x) { return 0.5f * x * (1.f + tanhf(0.7978845608028654f * (x + 0.044715f * x * x * x))); }

HD int tok_b(int t) { return t / TPB; }
HD int tok_i(int t) { return t % TPB; }
HD bool tok_isctx(int t) { return tok_i(t) < CTX; }
HD int tok_cv(int t) { return tok_isctx(t) ? 2 : tok_b(t); }
HD const float* modp(const P& p, int l, int cv, int which) { return p.MOD + (((size_t)l * 3 + cv) * 6 + which) * D; }

template <int R>
HD void gemm_rx4(const float* (&a)[R], const float* B, int ldb, int K, float4 (&acc)[R]) {
    for (int k = 0; k < K; ++k) {
        const float4 bv = *(const float4*)(B + (size_t)k * ldb);
#pragma unroll
        for (int r = 0; r < R; ++r) { const float av = a[r][k]; acc[r].x += av * bv.x; acc[r].y += av * bv.y; acc[r].z += av * bv.z; acc[r].w += av * bv.w; }
    }
}

HD void nv_init(const P& p, long gtid, long nthr) {
    for (long it = gtid; it < (long)DEPTH * 6 * D; it += nthr) {
        const int l = (int)(it / (6 * D)), j = (int)(it % (6 * D));
        const float* w = p.in[I_WMOD] + (size_t)l * D * 6 * D + j;
        float a0 = 0.f, a1 = 0.f, a2 = 0.f;
        for (int k = 0; k < D; ++k) { const float wv = w[(size_t)k * 6 * D];
            a0 += silu_f(p.in[I_C][k]) * wv; a1 += silu_f(p.in[I_C][D + k]) * wv; a2 += silu_f(p.in[I_CCTX][k]) * wv; }
        const float bb = p.in[I_BMOD][(size_t)l * 6 * D + j];
        p.MOD[((size_t)l * 3 + 0) * 6 * D + j] = a0 + bb; p.MOD[((size_t)l * 3 + 1) * 6 * D + j] = a1 + bb; p.MOD[((size_t)l * 3 + 2) * 6 * D + j] = a2 + bb;
    }
    for (long it = gtid; it < (long)NT * D; it += nthr) {
        const int t = (int)(it / D), k = (int)(it % D), b = tok_b(t), i = tok_i(t);
        p.X[it] = (i < CTX) ? p.in[I_CTX][((size_t)b * CTX + i) * D + k] : p.in[I_X][((size_t)b * SEQ + (i - CTX)) * D + k];
    }
    for (long it = gtid; it < (long)SEQ * 16; it += nthr) {
        const int s = (int)(it / 16), a = (int)((it / 8) & 1), f = (int)(it & 7);
        const int pos = a == 0 ? s / GRID_W : s % GRID_W;
        const double fr = pow(10000.0, -(double)f / 8.0);
        const float frf = (float)fr;
        const double ang = (double)((float)pos * frf);
        p.ROPET[it * 2] = (float)cos(ang); p.ROPET[it * 2 + 1] = (float)sin(ang);
    }
}

HD void nv_norm(const P& p, int l, int which  , long gtid, long nthr) {
    const float* g = p.in[which == 0 ? I_N1G : I_N2G] + (size_t)l * D;
    for (long t = gtid; t < NT; t += nthr) {
        const float* x = p.X + (size_t)t * D; float ss = 0.f;
        for (int k = 0; k < D; ++k) ss += x[k] * x[k];
        const float rstd = 1.f / sqrtf(ss / (float)D + EPS);
        const int cv = tok_cv((int)t); const float* sh = modp(p, l, cv, which == 0 ? 0 : 3); const float* sc = modp(p, l, cv, which == 0 ? 1 : 4);
        float* h = p.H + (size_t)t * D;
        for (int k = 0; k < D; ++k) h[k] = x[k] * rstd * g[k] * (1.f + sc[k]) + sh[k];
    }
}

HD void nv_inproj(const P& p, int l, long gtid, long nthr) {
    constexpr int R = 8, NQ = DIN / 4; const float* W = p.in[I_WIN] + (size_t)l * D * DIN;
    for (long it = gtid; it < (long)(NT / R) * NQ; it += nthr) {
        const int mi = (int)(it / NQ), n = (int)(it % NQ) * 4;
        const float* a[R]; float4 acc[R];
#pragma unroll
        for (int r = 0; r < R; ++r) { a[r] = p.H + (size_t)(mi * R + r) * D; acc[r] = float4{0.f, 0.f, 0.f, 0.f}; }
        gemm_rx4<R>(a, W + n, DIN, D, acc);
#pragma unroll
        for (int r = 0; r < R; ++r) *(float4*)(p.U + (size_t)(mi * R + r) * DIN + n) = acc[r];
    }
}

HD float conv_at(const P& p, int t, int col, int c, const float* w  , const float* bias) {
    const int i = tok_i(t), isc = i < CTX, li = isc ? i : i - CTX, len = isc ? CTX : SEQ;
    float s = bias[c];
#pragma unroll
    for (int k = 0; k < 4; ++k) { const int j = li + k - 2; if (j >= 0 && j < len) s += w[k * 256 + c] * p.U[(size_t)(t + k - 2) * DIN + col + c]; }
    return s;
}

HD void nv_prep1(const P& p, int l, long gtid, long nthr) {
    for (long it = gtid; it < (long)NT * 256; it += nthr) {
        const int t = (int)(it / 256), c = (int)(it % 256);
        p.XC[it] = conv_at(p, t, OFF_AX, c, p.in[I_LCW] + (size_t)l * 4 * 256, p.in[I_LCB] + (size_t)l * 256);
        p.XCM[it] = silu_f(conv_at(p, t, OFF_MX, c, p.in[I_MCW] + (size_t)l * 4 * 256, p.in[I_MCB] + (size_t)l * 256));
    }
    for (long t = gtid; t < NT; t += nthr) {
        const float* u = p.U + (size_t)t * DIN; float sq = 0.f, sk = 0.f;
        for (int k = 0; k < QRANK; ++k) sq += u[OFF_BQ + k] * u[OFF_BQ + k];
        for (int k = 0; k < KVRANK; ++k) sk += u[OFF_BKV + k] * u[OFF_BKV + k];
        const float rq = 1.f / sqrtf(sq / (float)QRANK + EPS), rk = 1.f / sqrtf(sk / (float)KVRANK + EPS);
        for (int k = 0; k < QRANK; ++k) p.QN[(size_t)t * QRANK + k] = u[OFF_BQ + k] * rq * p.in[I_QNG][(size_t)l * QRANK + k];
        for (int k = 0; k < KVRANK; ++k) p.KVN[(size_t)t * KVRANK + k] = u[OFF_BKV + k] * rk * p.in[I_KVNG][(size_t)l * KVRANK + k];
    }
}

HD void nv_prep2(const P& p, int l, long gtid, long nthr) {
    for (long it = gtid; it < (long)2 * NT * 256; it += nthr) {
        const int d = (int)(it / ((long)NT * 256)), t = (int)((it / 256) % NT), c = (int)(it % 256), g = c / 64, j = c % 64;
        const float* xc = p.XC + (size_t)t * 256 + g * 64;
        const float* wa = p.in[I_LWA] + ((((size_t)l * 2 + d) * 4 + g) * 64) * 64 + j;
        const float* wx = p.in[I_LWX] + ((((size_t)l * 2 + d) * 4 + g) * 64) * 64 + j;
        float sa = 0.f, sx = 0.f;
        for (int i = 0; i < 64; ++i) { sa += xc[i] * wa[i * 64]; sx += xc[i] * wx[i * 64]; }
        const float r = sigmoid_f(sa + p.in[I_LBA][((size_t)l * 2 + d) * 256 + c]), ig = sigmoid_f(sx + p.in[I_LBX][((size_t)l * 2 + d) * 256 + c]);
        const float log_a = 8.0f * r * logsigmoid_f(p.in[I_LLAM][((size_t)l * 2 + d) * 256 + c]);
        p.LA[it] = expf(log_a); p.LB[it] = sqrtf(-expm1f(2.f * log_a)) * ig * p.XC[(size_t)t * 256 + c];
    }
    { constexpr int R = 8, NQ = 768 / 4; const float* W = p.in[I_WQB] + (size_t)l * QRANK * 768;
      for (long it = gtid; it < (long)(NT / R) * NQ; it += nthr) { const int mi = (int)(it / NQ), n = (int)(it % NQ) * 4;
        const float* a[R]; float4 acc[R];
#pragma unroll
        for (int r = 0; r < R; ++r) { a[r] = p.QN + (size_t)(mi * R + r) * QRANK; acc[r] = float4{0.f, 0.f, 0.f, 0.f}; }
        gemm_rx4<R>(a, W + n, 768, QRANK, acc);
#pragma unroll
        for (int r = 0; r < R; ++r) *(float4*)(p.QF + (size_t)(mi * R + r) * 768 + n) = acc[r]; } }
    { constexpr int R = 8, NQ = 1024 / 4; const float* W = p.in[I_WKVB] + (size_t)l * KVRANK * 1024;
      for (long it = gtid; it < (long)(NT / R) * NQ; it += nthr) { const int mi = (int)(it / NQ), n = (int)(it % NQ) * 4;
        const float* a[R]; float4 acc[R];
#pragma unroll
        for (int r = 0; r < R; ++r) { a[r] = p.KVN + (size_t)(mi * R + r) * KVRANK; acc[r] = float4{0.f, 0.f, 0.f, 0.f}; }
        gemm_rx4<R>(a, W + n, 1024, KVRANK, acc);
#pragma unroll
        for (int r = 0; r < R; ++r) *(float4*)(p.KVF + (size_t)(mi * R + r) * 1024 + n) = acc[r]; } }
    for (long it = gtid; it < (long)NT * 256; it += nthr) {
        const int t = (int)(it / 256), c = (int)(it % 256), h = c / 64, j = c % 64;
        const float* xc = p.XCM + (size_t)t * 256 + h * 64; const float* ux = p.U + (size_t)t * DIN + OFF_MX + h * 64;
        const float* wq = p.in[I_MWQ] + (((size_t)l * 4 + h) * 64) * 64 + j; const float* wk = p.in[I_MWK] + (((size_t)l * 4 + h) * 64) * 64 + j; const float* wv = p.in[I_MWV] + (((size_t)l * 4 + h) * 64) * 64 + j;
        float sq = 0.f, sk = 0.f, sv = 0.f;
        for (int i = 0; i < 64; ++i) { sq += xc[i] * wq[i * 64]; sk += xc[i] * wk[i * 64]; sv += ux[i] * wv[i * 64]; }
        p.QM[it] = sq; p.KM[it] = sk * 0.125f; p.VM[it] = sv;
    }
}

HD void nv_prep3(const P& p, int l, long gtid, long nthr) {
    for (long it = gtid; it < (long)NB * 2 * 256; it += nthr) {
        const int b = (int)(it / 512), d = (int)((it / 256) & 1), c = (int)(it % 256);
        const float* A = p.LA + (size_t)d * NT * 256; const float* Bc = p.LB + (size_t)d * NT * 256; float* Ho = p.HL + (size_t)d * NT * 256;
        float h = 0.f;
        for (int seg = 0; seg < 2; ++seg) { const int base = b * TPB + (seg == 0 ? 0 : CTX), len = seg == 0 ? CTX : SEQ;
            for (int s = 0; s < len; ++s) { const int t = base + (d == 0 ? s : len - 1 - s);
                h = A[(size_t)t * 256 + c] * h + Bc[(size_t)t * 256 + c]; Ho[(size_t)t * 256 + c] = h; } }
    }
    for (long it = gtid; it < (long)NT * AH; it += nthr) {
        const int t = (int)(it / AH), h = (int)(it % AH), i = tok_i(t); const bool lat = i >= CTX; const int s = i - CTX;
        const float* qf = p.QF + (size_t)t * 768 + h * QKD; const float* kvf = p.KVF + (size_t)t * 1024 + h * (NOPE + VD); const float* kr = p.U + (size_t)t * DIN + OFF_BKR;
        float* qo = p.Qr + ((size_t)t * AH + h) * QKD; float* ko = p.Kr + ((size_t)t * AH + h) * QKD; float* vo = p.Vr + ((size_t)t * AH + h) * VD;
        for (int k = 0; k < NOPE; ++k) { qo[k] = qf[k]; ko[k] = kvf[k]; vo[k] = kvf[NOPE + k]; }
        for (int a = 0; a < 2; ++a) for (int f = 0; f < 8; ++f) {
            float cs = 1.f, sn = 0.f; if (lat) { cs = p.ROPET[(((size_t)s * 2 + a) * 8 + f) * 2]; sn = p.ROPET[(((size_t)s * 2 + a) * 8 + f) * 2 + 1]; }
            const float q1 = qf[NOPE + a * 16 + f], q2 = qf[NOPE + a * 16 + 8 + f], k1 = kr[a * 16 + f], k2 = kr[a * 16 + 8 + f];
            qo[NOPE + a * 16 + f] = q1 * cs - q2 * sn; qo[NOPE + a * 16 + 8 + f] = q2 * cs + q1 * sn;
            ko[NOPE + a * 16 + f] = k1 * cs - k2 * sn; ko[NOPE + a * 16 + 8 + f] = k2 * cs + k1 * sn; }
    }
    for (long it = gtid; it < (long)2 * NT * 8; it += nthr) {
        const int d = (int)(it / ((long)NT * 8)), t = (int)((it / 8) % NT), g = (int)(it % 8);
        const float* w = p.in[I_MWG] + (((size_t)l * 2 + d) * 768) * 8 + g; float s = p.in[I_MBG][((size_t)l * 2 + d) * 8 + g];
        for (int i = 0; i < 256; ++i) s += p.QM[(size_t)t * 256 + i] * w[(size_t)i * 8];
        for (int i = 0; i < 256; ++i) s += p.KM[(size_t)t * 256 + i] * w[(size_t)(256 + i) * 8];
        for (int i = 0; i < 256; ++i) s += p.VM[(size_t)t * 256 + i] * w[(size_t)(512 + i) * 8];
        p.IGF[it] = g < 4 ? s : logsigmoid_f(s);
    }
}

HD void nv_attn(const P& p, long gtid, long nthr) {
    const float scale = 1.0f / sqrtf((float)QKD);
    for (long it = gtid; it < (long)NT * AH; it += nthr) {
        const int h = (int)((it / TPB) % AH), b = (int)(it / ((long)TPB * AH)), i = (int)(it % TPB), t = b * TPB + i;
        const int nk = i < CTX ? CTX : TPB;
        float q[QKD], o[VD];
#pragma unroll
        for (int k = 0; k < QKD; ++k) q[k] = p.Qr[((size_t)t * AH + h) * QKD + k] * scale;
#pragma unroll
        for (int k = 0; k < VD; ++k) o[k] = 0.f;
        float m = -1e30f, lsum = 0.f;
        for (int j = 0; j < nk; ++j) {
            const float* kk = p.Kr + ((size_t)(b * TPB + j) * AH + h) * QKD; const float* vv = p.Vr + ((size_t)(b * TPB + j) * AH + h) * VD;
            float s = 0.f;
#pragma unroll
            for (int k = 0; k < QKD; ++k) s += q[k] * kk[k];
            if (s > m) { const float f = expf(m - s); lsum *= f;
#pragma unroll
                for (int k = 0; k < VD; ++k) o[k] *= f;
                m = s; }
            const float pr = expf(s - m); lsum += pr;
#pragma unroll
            for (int k = 0; k < VD; ++k) o[k] += pr * vv[k];
        }
        const float inv = 1.f / lsum;
#pragma unroll
        for (int k = 0; k < VD; ++k) p.Y[(size_t)t * DMIX + 256 + h * VD + k] = o[k] * inv;
    }
}
HD void nv_mlstm_scan(const P& p, long gtid, long nthr) {
    for (long it = gtid; it < (long)NB * MLH * 2 * 64; it += nthr) {
        const int v = (int)(it % 64), d = (int)((it / 64) & 1), h = (int)((it / 128) % MLH), b = (int)(it / (128 * MLH));
        float C[64], n[64];
#pragma unroll
        for (int k = 0; k < 64; ++k) { C[k] = 0.f; n[k] = 0.f; }
        float m = 0.f;
        for (int seg = 0; seg < 2; ++seg) { const int base = b * TPB + (seg == 0 ? 0 : CTX), len = seg == 0 ? CTX : SEQ;
            for (int s = 0; s < len; ++s) { const int t = base + (d == 0 ? s : len - 1 - s);
                const float ig = p.IGF[((size_t)d * NT + t) * 8 + h], lf = p.IGF[((size_t)d * NT + t) * 8 + 4 + h];
                const float mn = fmaxf(lf + m, ig), fd = expf(lf + m - mn), iw = expf(ig - mn); m = mn;
                const float* qq = p.QM + (size_t)t * 256 + h * 64; const float* kk = p.KM + (size_t)t * 256 + h * 64; const float vv = p.VM[(size_t)t * 256 + h * 64 + v];
                float num = 0.f, den = 0.f;
#pragma unroll
                for (int k = 0; k < 64; ++k) { const float kv = kk[k], qv = qq[k]; C[k] = fd * C[k] + iw * vv * kv; n[k] = fd * n[k] + iw * kv; num += C[k] * qv; den += n[k] * qv; }
                p.HM[((size_t)d * NT + t) * 256 + h * 64 + v] = num / fmaxf(fabsf(den), expf(-mn)); } }
    }
}
HD void nv_lru_out(const P& p, long gtid, long nthr) {
    for (long it = gtid; it < (long)NT * 256; it += nthr) { const int t = (int)(it / 256), c = (int)(it % 256);
        p.Y[(size_t)t * DMIX + c] = (p.HL[it] + p.HL[(size_t)NT * 256 + it]) * gelu_f(p.U[(size_t)t * DIN + OFF_AG + c]); }
}
HD void nv_mlstm_finish(const P& p, int l, long gtid, long nthr) {
    for (long it = gtid; it < (long)NT * MLH; it += nthr) { const int t = (int)(it / MLH), h = (int)(it % MLH);
        const float* h0 = p.HM + (size_t)t * 256 + h * 64; const float* h1 = p.HM + ((size_t)NT + t) * 256 + h * 64;
        float mu = 0.f; for (int j = 0; j < 64; ++j) mu += h0[j] + h1[j]; mu *= (1.f / 64.f);
        float var = 0.f; for (int j = 0; j < 64; ++j) { const float dlt = h0[j] + h1[j] - mu; var += dlt * dlt; } var *= (1.f / 64.f);
        const float rstd = 1.f / sqrtf(var + EPS);
        for (int j = 0; j < 64; ++j) { const int c = h * 64 + j;
            const float y = (h0[j] + h1[j] - mu) * rstd * p.in[I_MNG][(size_t)l * 256 + c] + p.in[I_MSK][(size_t)l * 256 + c] * p.XCM[(size_t)t * 256 + c];
            p.Y[(size_t)t * DMIX + 768 + c] = y * silu_f(p.U[(size_t)t * DIN + OFF_MZ + c]); } }
}
HD void nv_outproj(const P& p, int l, long gtid, long nthr) {
    constexpr int R = 8, NQ = D / 4; const float* W = p.in[I_WOUT] + (size_t)l * DMIX * D;
    for (long it = gtid; it < (long)(NT / R) * NQ; it += nthr) { const int mi = (int)(it / NQ), n = (int)(it % NQ) * 4;
        const float* a[R]; float4 acc[R];
#pragma unroll
        for (int r = 0; r < R; ++r) { a[r] = p.Y + (size_t)(mi * R + r) * DMIX; acc[r] = float4{0.f, 0.f, 0.f, 0.f}; }
        gemm_rx4<R>(a, W + n, D, DMIX, acc);
#pragma unroll
        for (int r = 0; r < R; ++r) { const int t = mi * R + r; const float* g1 = modp(p, l, tok_cv(t), 2) + n; float* x = p.X + (size_t)t * D + n;
            x[0] += g1[0] * acc[r].x; x[1] += g1[1] * acc[r].y; x[2] += g1[2] * acc[r].z; x[3] += g1[3] * acc[r].w; } }
}
HD void nv_zero_cnt(const P& p, long gtid, long nthr) { for (long i = gtid; i < NE; i += nthr) p.CNT[i] = 0; }
HD void nv_router(const P& p, int l, long gtid, long nthr) {
    for (long t = gtid; t < NT; t += nthr) {
        float lg[NE]; const float* h = p.H + (size_t)t * D; const float* W = p.in[I_WR] + (size_t)l * D * NE;
#pragma unroll
        for (int e = 0; e < NE; ++e) lg[e] = p.in[I_BR][(size_t)l * NE + e];
        for (int k = 0; k < D; ++k) { const float hv = h[k];
#pragma unroll
            for (int e = 0; e < NE; ++e) lg[e] += hv * W[(size_t)k * NE + e]; }
        int te[TOPK]; float tv[TOPK];
#pragma unroll
        for (int r = 0; r < TOPK; ++r) { float best = -3.0e38f; int bi = 0;
#pragma unroll
            for (int e = 0; e < NE; ++e) { const bool c = lg[e] > best; best = c ? lg[e] : best; bi = c ? e : bi; }
            te[r] = bi; tv[r] = best;
#pragma unroll
            for (int e = 0; e < NE; ++e) lg[e] = (e == bi) ? -3.0e38f : lg[e]; }
        float s = 0.f, ex[TOPK];
#pragma unroll
        for (int r = 0; r < TOPK; ++r) { ex[r] = expf(tv[r] - tv[0]); s += ex[r]; }
#pragma unroll
        for (int r = 0; r < TOPK; ++r) { p.TOPE[t * TOPK + r] = te[r]; p.TOPG[t * TOPK + r] = ex[r] / s;
            const int pos = atomic_add_i(&p.CNT[te[r]], 1); p.LIST[(size_t)te[r] * NT + pos] = (int)t * TOPK + r; }
    }
}
HD bool moe_item(const P& p, int R, long grp, int& e, int& r0) {
    long acc = 0;
    for (int x = 0; x < NE; ++x) { const int c = p.CNT[x], ng = (c + R - 1) / R; if (grp < acc + ng) { e = x; r0 = (int)(grp - acc) * R; return true; } acc += ng; }
    return false;
}
HD long moe_groups(const P& p, int R) { long acc = 0; for (int x = 0; x < NE; ++x) acc += (p.CNT[x] + R - 1) / R; return acc; }
HD void nv_moe_gu(const P& p, int l, long gtid, long nthr) {
    constexpr int R = 8, NQ = DE / 4; const long ngrp = moe_groups(p, R);
    for (long it = gtid; it < ngrp * NQ; it += nthr) { int e, r0; moe_item(p, R, it / NQ, e, r0); const int n = (int)(it % NQ) * 4, cnt = p.CNT[e];
        const float* Wg = p.in[I_WGU] + ((size_t)l * NE + e) * D * 2 * DE; const float* bg = p.in[I_BGU] + ((size_t)l * NE + e) * 2 * DE;
        const float* a[R]; int pr[R]; float4 ag[R], al[R];
#pragma unroll
        for (int r = 0; r < R; ++r) { const int rr = r0 + r < cnt ? r0 + r : cnt - 1; pr[r] = p.LIST[(size_t)e * NT + rr]; a[r] = p.H + (size_t)(pr[r] / TOPK) * D; ag[r] = float4{0.f, 0.f, 0.f, 0.f}; al[r] = float4{0.f, 0.f, 0.f, 0.f}; }
        gemm_rx4<R>(a, Wg + n, 2 * DE, D, ag);
        gemm_rx4<R>(a, Wg + DE + n, 2 * DE, D, al);
#pragma unroll
        for (int r = 0; r < R; ++r) if (r0 + r < cnt) { float gv[4] = {ag[r].x + bg[n], ag[r].y + bg[n + 1], ag[r].z + bg[n + 2], ag[r].w + bg[n + 3]};
            float lv[4] = {al[r].x + bg[DE + n], al[r].y + bg[DE + n + 1], al[r].z + bg[DE + n + 2], al[r].w + bg[DE + n + 3]};
#pragma unroll
            for (int q = 0; q < 4; ++q) { const float glu = fminf(gv[q], 7.0f), lin = fminf(fmaxf(lv[q], -7.0f), 7.0f);
                p.ACT[(size_t)pr[r] * DE + n + q] = glu * sigmoid_f(1.702f * glu) * (lin + 1.f); } }
    }
}
HD void nv_moe_down(const P& p, int l, long gtid, long nthr) {
    constexpr int R = 8, NQ = D / 4; const long ngrp = moe_groups(p, R);
    for (long it = gtid; it < ngrp * NQ; it += nthr) { int e, r0; moe_item(p, R, it / NQ, e, r0); const int n = (int)(it % NQ) * 4, cnt = p.CNT[e];
        const float* Wd = p.in[I_WD] + ((size_t)l * NE + e) * DE * D; const float* bd = p.in[I_BD] + ((size_t)l * NE + e) * D;
        const float* a[R]; int pr[R]; float4 acc[R];
#pragma unroll
        for (int r = 0; r < R; ++r) { const int rr = r0 + r < cnt ? r0 + r : cnt - 1; pr[r] = p.LIST[(size_t)e * NT + rr]; a[r] = p.ACT + (size_t)pr[r] * DE; acc[r] = float4{0.f, 0.f, 0.f, 0.f}; }
        gemm_rx4<R>(a, Wd + n, D, DE, acc);
#pragma unroll
        for (int r = 0; r < R; ++r) if (r0 + r < cnt) { const float g = p.TOPG[pr[r]]; float* y = p.YB + (size_t)pr[r] * D + n;
            y[0] = g * (acc[r].x + bd[n]); y[1] = g * (acc[r].y + bd[n + 1]); y[2] = g * (acc[r].z + bd[n + 2]); y[3] = g * (acc[r].w + bd[n + 3]); }
    }
}
HD void nv_combine(const P& p, int l, long gtid, long nthr) {
    for (long it = gtid; it < (long)NT * D; it += nthr) { const int t = (int)(it / D), n = (int)(it % D);
        const float s = ((p.YB[((size_t)t * 4 + 0) * D + n] + p.YB[((size_t)t * 4 + 1) * D + n]) + p.YB[((size_t)t * 4 + 2) * D + n]) + p.YB[((size_t)t * 4 + 3) * D + n];
        p.X[it] += modp(p, l, tok_cv(t), 5)[n] * s; }
}
HD void nv_final(const P& p, long gtid, long nthr) {
    for (long r = gtid; r < (long)NB * SEQ; r += nthr) { const int b = (int)(r / SEQ), s = (int)(r % SEQ), t = b * TPB + CTX + s;
        const float* x = p.X + (size_t)t * D; float ss = 0.f;
        for (int k = 0; k < D; ++k) ss += x[k] * x[k];
        const float rstd = 1.f / sqrtf(ss / (float)D + EPS);
        for (int k = 0; k < D; ++k) p.out[(size_t)r * D + k] = x[k] * rstd * p.in[I_FG][k]; }
}

constexpr int PH_PER_LAYER = 13, N_PHASES = 1 + DEPTH * PH_PER_LAYER + 1;
HD void nv_run_phase(const P& p, int ph, long gtid, long nthr) {
    if (ph == 0) { nv_init(p, gtid, nthr); return; }
    if (ph == N_PHASES - 1) { nv_final(p, gtid, nthr); return; }
    const int l = (ph - 1) / PH_PER_LAYER, s = (ph - 1) % PH_PER_LAYER;
    switch (s) {
        case 0: nv_norm(p, l, 0, gtid, nthr); break;
        case 1: nv_inproj(p, l, gtid, nthr); break;
        case 2: nv_prep1(p, l, gtid, nthr); break;
        case 3: nv_prep2(p, l, gtid, nthr); break;
        case 4: nv_prep3(p, l, gtid, nthr); break;
        case 5: nv_mlstm_scan(p, gtid, nthr); nv_attn(p, gtid, nthr); nv_lru_out(p, gtid, nthr); break;
        case 6: nv_mlstm_finish(p, l, gtid, nthr); break;
        case 7: nv_outproj(p, l, gtid, nthr); break;
        case 8: nv_norm(p, l, 1, gtid, nthr); nv_zero_cnt(p, gtid, nthr); break;
        case 9: nv_router(p, l, gtid, nthr); break;
        case 10: nv_moe_gu(p, l, gtid, nthr); break;
        case 11: nv_moe_down(p, l, gtid, nthr); break;
        case 12: nv_combine(p, l, gtid, nthr); break;
    }
}

struct WsMap { size_t off[32]; size_t total; };
static inline WsMap ws_map() {
    WsMap m; size_t o = 0; int i = 0;
    auto add = [&](size_t n) { m.off[i++] = o; o += (n + 63) & ~(size_t)63; };
    add((size_t)DEPTH * 3 * 6 * D);
    add((size_t)SEQ * 16 * 2);
    add((size_t)NT * D);
    add((size_t)NT * D);
    add((size_t)NT * DIN);
    add((size_t)NT * 256);
    add((size_t)2 * NT * 256);
    add((size_t)2 * NT * 256);
    add((size_t)2 * NT * 256);
    add((size_t)NT * QRANK);
    add((size_t)NT * KVRANK);
    add((size_t)NT * 768);
    add((size_t)NT * 1024);
    add((size_t)NT * AH * QKD);
    add((size_t)NT * AH * QKD);
    add((size_t)NT * AH * VD);
    add((size_t)NT * 256);
    add((size_t)NT * 256);
    add((size_t)NT * 256);
    add((size_t)NT * 256);
    add((size_t)2 * NT * 8);
    add((size_t)2 * NT * 256);
    add((size_t)NT * DMIX);
    add((size_t)NT * TOPK);
    add((size_t)NT * TOPK * DE);
    add((size_t)NT * TOPK * D);
    add((size_t)NT * TOPK);
    add((size_t)64);
    add((size_t)NE * NT);
    m.total = o; return m;
}
static inline void fill_params(P& p, void* const* d_in, void* d_out, void* d_ws) {
    for (int i = 0; i < N_IN; ++i) p.in[i] = (const float*)d_in[i];
    p.out = (float*)d_out; float* w = (float*)d_ws; const WsMap m = ws_map();
    p.MOD = w + m.off[0]; p.ROPET = w + m.off[1]; p.X = w + m.off[2]; p.H = w + m.off[3]; p.U = w + m.off[4]; p.XC = w + m.off[5]; p.LA = w + m.off[6]; p.LB = w + m.off[7]; p.HL = w + m.off[8];
    p.QN = w + m.off[9]; p.KVN = w + m.off[10]; p.QF = w + m.off[11]; p.KVF = w + m.off[12]; p.Qr = w + m.off[13]; p.Kr = w + m.off[14]; p.Vr = w + m.off[15];
    p.XCM = w + m.off[16]; p.QM = w + m.off[17]; p.KM = w + m.off[18]; p.VM = w + m.off[19]; p.IGF = w + m.off[20]; p.HM = w + m.off[21]; p.Y = w + m.off[22];
    p.TOPG = w + m.off[23]; p.ACT = w + m.off[24]; p.YB = w + m.off[25]; p.TOPE = (int*)(w + m.off[26]); p.CNT = (int*)(w + m.off[27]); p.LIST = (int*)(w + m.off[28]);
}
extern __shared__ __attribute__((aligned(16))) unsigned char g_lds_base[];
constexpr int WTAB_OFF = 148480 - 64 - 256;
#define HWID() ((int)__builtin_amdgcn_s_getreg((5 << 11) | 4) & 63)
#if ONE_LAUNCH
__device__ __forceinline__ int tidx_() {
    unsigned z = 0u; asm volatile("" : "+v"(z));
    const int lane = (int)__builtin_amdgcn_mbcnt_hi(~0u, __builtin_amdgcn_mbcnt_lo(~0u, z));
    const int wv = __builtin_amdgcn_readfirstlane(((const volatile __attribute__((address_space(3))) int*)((__attribute__((address_space(3))) unsigned char*)g_lds_base + WTAB_OFF))[HWID()]);
    return wv * 64 + lane;
}
#define TIDX tidx_()
#else
#define TIDX ((int)threadIdx.x)
#endif
namespace pg8 {
#define PG8_LAS __attribute__((address_space(3)))
typedef unsigned short bf16_t;
typedef short bf16x8 __attribute__((ext_vector_type(8)));
typedef float f32x4 __attribute__((ext_vector_type(4)));
typedef unsigned u32x4 __attribute__((ext_vector_type(4)));
typedef int i32x4 __attribute__((ext_vector_type(4)));
typedef int i32x8 __attribute__((ext_vector_type(8)));
constexpr int BM = 256, BK = 64, HALF = 128, HTB = HALF * BK * 2  , STAGE_BYTES = 8 * HTB, NXCD = 8, WGM = 8;

__host__ __device__ __forceinline__ int lds_byte(int r, int c) { const int st = (r >> 4) * 2 + (c >> 5), rr = r & 15, cc = c & 31, ob = rr * 64 + cc * 2; return st * 1024 + (ob ^ (((ob >> 9) & 1) << 5)); }
__host__ __device__ __forceinline__ void stage_rc(int b, int& R, int& C) { const int st = b / 1024, sb = b % 1024, swz = sb ^ (((sb >> 9) & 1) << 5); R = (st >> 1) * 16 + swz / 64; C = (st & 1) * 32 + (swz % 64) / 2; }
__host__ __device__ __forceinline__ int perm32(int rho) { const int n = rho >> 4, i = rho & 15; return 8 * (i >> 2) + 4 * n + (i & 3); }

struct Unit { int pm, pn, e, mb, slot; };
struct Gemm { const bf16_t* A; const bf16_t* Bt; int K; };

struct StaticOrder {
    int nM, nN, nwg, G, c;
    __device__ void init(int M, int N, int G_, int c_) { nM = M / BM; nN = N / BM; nwg = nM * nN; G = G_; c = c_; }
    __device__ bool next(int i, Unit& u) const {
        const long L = (long)i * G + c; if (L >= nwg) return false;
        int wgid = (int)L; { const int q = nwg / NXCD, r = nwg % NXCD, xcd = wgid % NXCD, off = wgid / NXCD; wgid = (xcd < r ? xcd * (q + 1) : r * (q + 1) + (xcd - r) * q) + off; }
        const int nig = WGM * nN, gid = wgid / nig, fm = gid * WGM, gsz = (nM - fm) < WGM ? (nM - fm) : WGM;
        u.pm = fm + ((wgid % nig) % gsz); u.pn = (wgid % nig) / gsz; u.e = 0; u.mb = 0; u.slot = 0; return true;
    }
    __device__ __forceinline__ int arow(const Unit& u, int r) const { return u.pm * BM + r; }
};

typedef float f32x2_c __attribute__((ext_vector_type(2))); typedef __bf16 bf16x2_c __attribute__((ext_vector_type(2)));
__device__ __forceinline__ unsigned cvt_pk_bf16(float lo, float hi) { f32x2_c v = {lo, hi}; bf16x2_c b = __builtin_convertvector(v, bf16x2_c); return __builtin_bit_cast(unsigned, b); }

template <class Epi, class Sched, bool ALIGN_EPI, bool F8 = false>
__device__ __forceinline__ void gemm_phase(PG8_LAS unsigned char* lds, const Gemm g, const Sched& S, const Epi& E) {
    int tid_ = TIDX; asm volatile("" : "+v"(tid_));
    const int tid = tid_, wid = __builtin_amdgcn_readfirstlane(tid >> 6), lane = tid & 63, wr = wid >> 2, wc = wid & 3, fr = lane & 15, fq = lane >> 4;
    constexpr int ES = F8 ? 1 : 2;
    const int K = g.K, nt = K * ES / (BK * 2);
    unsigned voffB[2];
#pragma unroll
    for (int i = 0; i < 2; ++i) { int R, C; stage_rc(tid * 16 + i * 8192, R, C); const int Rb = Epi::PERM ? ((R & ~31) + perm32(R & 31)) : R;
        voffB[i] = (unsigned)(Rb * K * ES + C * 2); }
    const size_t kstep = (size_t)(BK * 2);
    const size_t hstep = (size_t)HALF * K * ES;
    const size_t tstep = 2 * hstep;
    const unsigned ldsw = (unsigned)wid * 1024u;
    const int aoff = lds_byte(wr * 64 + fr, fq * 8), boff = lds_byte(wc * 32 + fr, fq * 8);
#define PG8_SA(b, h) (((b) * 2 + (h)) * HTB)
#define PG8_SB(b, h) ((4 + (b) * 2 + (h)) * HTB)
#define PG8_STAGE(bufoff, gbase, voff) do { _Pragma("unroll") for (int _i = 0; _i < 2; ++_i) \
        __builtin_amdgcn_global_load_lds((const unsigned*)((const char*)(gbase) + (voff)[_i]), (PG8_LAS unsigned*)(lds + (bufoff) + ldsw + _i * 8192), 16, 0, 0); } while (0)
#define PG8_LD8(addr) __builtin_shufflevector(*(const PG8_LAS i32x4*)(addr), *(const PG8_LAS i32x4*)((addr) + 1024), 0, 1, 2, 3, 4, 5, 6, 7)
#define PG8_LDA(dst, b, h) do { _Pragma("unroll") for (int m = 0; m < 4; ++m) { if constexpr (F8) dst##8[m] = PG8_LD8(lds + PG8_SA(b, h) + aoff + m * 2048); else { _Pragma("unroll") for (int k = 0; k < 2; ++k) dst[m][k] = *(const PG8_LAS bf16x8*)(lds + PG8_SA(b, h) + aoff + m * 2048 + k * 1024); } } } while (0)
#define PG8_LDB(dst, b, h) do { _Pragma("unroll") for (int n = 0; n < 2; ++n) { if constexpr (F8) dst##8[n] = PG8_LD8(lds + PG8_SB(b, h) + boff + n * 2048); else { _Pragma("unroll") for (int k = 0; k < 2; ++k) dst[n][k] = *(const PG8_LAS bf16x8*)(lds + PG8_SB(b, h) + boff + n * 2048 + k * 1024); } } } while (0)
#define PG8_MMA(ai, bj, At, Bt) do { __builtin_amdgcn_s_setprio(1); _Pragma("unroll") for (int m = 0; m < 4; ++m) _Pragma("unroll") for (int n = 0; n < 2; ++n) { \
        if constexpr (F8) asm volatile("v_mfma_f32_16x16x128_f8f6f4 %0, %1, %2, %0" : "+v"(acc[ai][bj][m][n]) : "v"(Bt##8[n]), "v"(At##8[m]));   \
        else { _Pragma("unroll") for (int k = 0; k < 2; ++k) acc[ai][bj][m][n] = __builtin_amdgcn_mfma_f32_16x16x32_bf16(Bt[n][k], At[m][k], acc[ai][bj][m][n], 0, 0, 0); } } __builtin_amdgcn_s_setprio(0); } while (0)
#define PG8_WAIT_V(n) asm volatile("s_waitcnt vmcnt(" #n ")" ::: "memory")
#define PG8_WAIT_L(n) asm volatile("s_waitcnt lgkmcnt(" #n ")" ::: "memory")
#define PG8_BAR __builtin_amdgcn_s_barrier()
#define PG8_SCHED __builtin_amdgcn_sched_barrier(0)
#define PG8_AOFFS(dst, U) do { int _t = tid; asm volatile("" : "+v"(_t)); _Pragma("unroll") for (int _i = 0; _i < 2; ++_i) { int _R, _C; stage_rc(_t * 16 + _i * 8192, _R, _C); \
        _Pragma("unroll") for (int _h = 0; _h < 2; ++_h) dst[_h][_i] = (unsigned)(S.arow(U, _h * HALF + _R) * K * ES + _C * 2); } } while (0)
    Unit cur, nxt; int ui = 0;
    if (!S.next(0, cur)) return;
    f32x4 acc[2][2][4][2];
#pragma unroll
    for (int a = 0; a < 2; ++a)
#pragma unroll
        for (int b = 0; b < 2; ++b)
#pragma unroll
            for (int m = 0; m < 4; ++m)
#pragma unroll
                for (int n = 0; n < 2; ++n) acc[a][b][m][n] = (f32x4){0.f, 0.f, 0.f, 0.f};
    bf16x8 At[4][2], B0[2][2], B1[2][2]; i32x8 At8[4], B08[2], B18[2]; (void)At; (void)B0; (void)B1; (void)At8; (void)B08; (void)B18;
    unsigned vA[2][2];
    PG8_AOFFS(vA, cur);
    const char* gA = (const char*)g.A;
    const char* cB = (const char*)g.Bt + (size_t)cur.pn * tstep;
    PG8_STAGE(PG8_SB(0, 0), cB, voffB); PG8_STAGE(PG8_SB(0, 1), cB + hstep, voffB); PG8_STAGE(PG8_SA(0, 0), gA, vA[0]); PG8_STAGE(PG8_SA(0, 1), gA, vA[1]);
    if (wr == 1) PG8_BAR;
    PG8_WAIT_V(2); PG8_BAR;
    PG8_STAGE(PG8_SB(1, 0), cB + kstep, voffB); PG8_STAGE(PG8_SA(1, 0), gA + kstep, vA[0]); PG8_STAGE(PG8_SB(1, 1), cB + hstep + kstep, voffB);
    PG8_WAIT_V(6); PG8_BAR;
    for (;;) {
        const bool has_next = S.next(ui + 1, nxt);
        { unsigned nvA[2][2];
          if (has_next) { PG8_AOFFS(nvA, nxt); } else {
#pragma unroll
            for (int h = 0; h < 2; ++h)
#pragma unroll
                for (int i = 0; i < 2; ++i) nvA[h][i] = vA[h][i]; }
          *(PG8_LAS u32x4*)(lds + STAGE_BYTES + 1024 + tid * 16) = (u32x4){nvA[0][0], nvA[0][1], nvA[1][0], nvA[1][1]}; }
        const char* nB = has_next ? (const char*)g.Bt + (size_t)nxt.pn * tstep : cB;
#pragma unroll 1
        for (int t = 0; t < nt; t += 2) {
            const bool last = (t == nt - 2);
            const char* a1 = gA + (size_t)(t + 1) * kstep;
            const char* a2 = last ? gA : gA + (size_t)(t + 2) * kstep; const char* b2 = last ? nB : cB + (size_t)(t + 2) * kstep;
            const char* a3 = a2 + kstep; const char* b3 = b2 + kstep;
            unsigned o2[2][2];
            if (last) { const u32x4 nv = *(const PG8_LAS u32x4*)(lds + STAGE_BYTES + 1024 + tid * 16); o2[0][0] = nv.x; o2[0][1] = nv.y; o2[1][0] = nv.z; o2[1][1] = nv.w; }
            else {
#pragma unroll
                for (int h = 0; h < 2; ++h)
#pragma unroll
                    for (int i = 0; i < 2; ++i) o2[h][i] = vA[h][i]; }
            PG8_LDB(B0, 0, 0); PG8_LDB(B1, 0, 1); PG8_SCHED; PG8_LDA(At, 0, 0); PG8_STAGE(PG8_SA(1, 1), a1, vA[1]);
            PG8_WAIT_V(8); PG8_WAIT_L(0); PG8_BAR; PG8_MMA(0, 0, At, B0); PG8_MMA(0, 1, At, B1); PG8_BAR; PG8_SCHED;
            PG8_LDA(At, 0, 1); PG8_STAGE(PG8_SB(0, 0), b2, voffB); PG8_STAGE(PG8_SB(0, 1), b2 + hstep, voffB); PG8_STAGE(PG8_SA(0, 0), a2, o2[0]);
            PG8_WAIT_V(8); PG8_WAIT_L(0); PG8_BAR; PG8_MMA(1, 0, At, B0); PG8_MMA(1, 1, At, B1); PG8_BAR; PG8_SCHED;
            PG8_LDB(B0, 1, 0); PG8_LDB(B1, 1, 1); PG8_SCHED; PG8_LDA(At, 1, 0); PG8_STAGE(PG8_SA(0, 1), a2, o2[1]);
            PG8_WAIT_V(8); PG8_WAIT_L(0); PG8_BAR; PG8_MMA(0, 0, At, B0); PG8_MMA(0, 1, At, B1); PG8_BAR; PG8_SCHED;
            PG8_LDA(At, 1, 1); PG8_STAGE(PG8_SB(1, 0), b3, voffB); PG8_STAGE(PG8_SB(1, 1), b3 + hstep, voffB); PG8_STAGE(PG8_SA(1, 0), a3, o2[0]);
            PG8_WAIT_V(8); PG8_WAIT_L(0); PG8_BAR; PG8_MMA(1, 0, At, B0); PG8_MMA(1, 1, At, B1); PG8_BAR; PG8_SCHED;
        }
        if constexpr (ALIGN_EPI) { if (wr == 0) PG8_BAR; }
        if constexpr (F8) asm volatile("s_nop 7\n\ts_nop 7\n\ts_nop 7" ::: "memory");
        E(acc, cur, wr, wc, fr, fq);
        if (!has_next) break;
#pragma unroll
        for (int a = 0; a < 2; ++a)
#pragma unroll
            for (int b = 0; b < 2; ++b)
#pragma unroll
                for (int m = 0; m < 4; ++m)
#pragma unroll
                    for (int n = 0; n < 2; ++n) acc[a][b][m][n] = (f32x4){0.f, 0.f, 0.f, 0.f};
        cur = nxt; cB = nB; ++ui;
        { const u32x4 nv = *(const PG8_LAS u32x4*)(lds + STAGE_BYTES + 1024 + tid * 16); vA[0][0] = nv.x; vA[0][1] = nv.y; vA[1][0] = nv.z; vA[1][1] = nv.w; }
        if constexpr (ALIGN_EPI) { if (wr == 1) PG8_BAR; }
    }
    PG8_WAIT_V(0);
    if constexpr (!ALIGN_EPI) { if (wr == 0) PG8_BAR; }
    PG8_BAR;
#undef PG8_SA
#undef PG8_SB
#undef PG8_STAGE
#undef PG8_LDA
#undef PG8_LDB
#undef PG8_MMA
#undef PG8_LD8
#undef PG8_WAIT_V
#undef PG8_WAIT_L
#undef PG8_BAR
#undef PG8_SCHED
#undef PG8_AOFFS
}
}
#define LAS __attribute__((address_space(3)))
typedef unsigned short bf16;
typedef float f32x4 __attribute__((ext_vector_type(4)));
typedef unsigned u32x4 __attribute__((ext_vector_type(4)));
typedef unsigned u32x2 __attribute__((ext_vector_type(2)));

constexpr int NWAVES = 8, NTHREADS = 512;
constexpr int DINP = 1536;
constexpr int SLOT_MAX = NT * TOPK + NE * 256;

struct Q {
    bf16 *WtIn, *WtOut, *WtGu, *WtDn, *WtQb, *WtKvb;
    bf16 *H16, *Y16, *ACT16, *K16, *V16;
};

__device__ __forceinline__ unsigned f2bf(float f) { unsigned u = __builtin_bit_cast(unsigned, f); return (u + 0x7fffu + ((u >> 16) & 1u)) >> 16; }
__device__ __forceinline__ unsigned pk2(float lo, float hi) { return f2bf(lo) | (f2bf(hi) << 16); }
__device__ __forceinline__ float bf2f(unsigned short b) { return __builtin_bit_cast(float, (unsigned)b << 16); }
typedef unsigned char fp8;
constexpr int FP8_GU = 1;
#ifndef FP8_DN_N
#define FP8_DN_N 1
#endif
constexpr int FP8_DN = FP8_DN_N;
__device__ __forceinline__ float fp8_clamp(float v) { return __builtin_fminf(__builtin_fmaxf(v, -448.f), 448.f); }
__device__ __forceinline__ unsigned fp8_pack4(float a, float b, float c, float d) {
    int w = __builtin_amdgcn_cvt_pk_fp8_f32(fp8_clamp(a), fp8_clamp(b), 0, false); w = __builtin_amdgcn_cvt_pk_fp8_f32(fp8_clamp(c), fp8_clamp(d), w, true); return (unsigned)w; }
__device__ __forceinline__ void pow2_scale(float amax, int TOP, float& qs, float& inv) {
    const int e = (int)((__builtin_bit_cast(unsigned, amax) >> 23) & 255u);
    if (e < 32 || e > 220) { qs = 1.f; inv = 1.f; return; }
    qs = __builtin_bit_cast(float, (unsigned)(254 + TOP - e) << 23); inv = __builtin_bit_cast(float, (unsigned)(e - TOP) << 23); }
__device__ __forceinline__ float* wscale_tab(const Q& q) { return (float*)q.WtKvb + NT; }
__device__ __forceinline__ float* rowscale_tab(const Q& q) { return (float*)q.WtKvb; }


__device__ __forceinline__ void tr_decode(const P& p, const Q& q, bf16* WtKvbP, int it, const float*& src, int& N, bf16*& dst, int& ldk) {
    constexpr int I_GU = (D / 64) * (2 * DE / 64), I_DN = (DE / 64) * (D / 64);
    constexpr int I_IN = (D / 64) * ((DIN + 63) / 64), I_OUT = (DMIX / 64) * (D / 64), I_QB = (QRANK / 64) * (768 / 64), I_KVB = (KVRANK / 64) * (1024 / 64);
    constexpr int PER_L = NE * (I_GU + I_DN) + I_IN + I_OUT + I_QB + I_KVB;
    const int l = it / PER_L; int r = it % PER_L;
    if (r < NE * I_GU) { const int e = r / I_GU, rr = r % I_GU, kbs = D / 64, kb = rr % kbs, n0 = 64 * (rr / kbs);
        const int isl = n0 >= DE, j0 = n0 - isl * DE, drow0 = 256 * (j0 / 128) + 128 * isl + (j0 % 128);
        N = 2 * DE; ldk = D; src = p.in[I_WGU] + ((size_t)l * NE + e) * D * 2 * DE + (size_t)(64 * kb) * N + n0; dst = q.WtGu + ((size_t)l * NE + e) * 2 * DE * D + (size_t)drow0 * ldk + 64 * kb; return; } r -= NE * I_GU;
    if (r < NE * I_DN) { const int e = r / I_DN, rr = r % I_DN, kbs = DE / 64, kb = rr % kbs, n0 = 64 * (rr / kbs);
        N = D; ldk = DE; src = p.in[I_WD] + ((size_t)l * NE + e) * DE * D + (size_t)(64 * kb) * N + n0; dst = q.WtDn + ((size_t)l * NE + e) * D * DE + (size_t)n0 * ldk + 64 * kb; return; } r -= NE * I_DN;
    if (r < I_IN) { const int nb = (DIN + 63) / 64, kb = r / nb, n0 = 64 * (r % nb);
        const int n0c = n0 + 64 <= DIN ? n0 : DIN - 64; N = DIN; ldk = D; src = p.in[I_WIN] + (size_t)l * D * DIN + (size_t)(64 * kb) * N + n0c; dst = q.WtIn + (size_t)l * DINP * D + (size_t)n0c * ldk + 64 * kb; return; } r -= I_IN;
    if (r < I_OUT) { const int nb = D / 64, kb = r / nb, n0 = 64 * (r % nb); N = D; ldk = DMIX; src = p.in[I_WOUT] + (size_t)l * DMIX * D + (size_t)(64 * kb) * N + n0; dst = q.WtOut + (size_t)l * D * DMIX + (size_t)n0 * ldk + 64 * kb; return; } r -= I_OUT;
    if (r < I_QB) { const int nb = 768 / 64, kb = r / nb, n0 = 64 * (r % nb); N = 768; ldk = 256; src = p.in[I_WQB] + (size_t)l * QRANK * 768 + (size_t)(64 * kb) * N + n0; dst = WtKvbP + (size_t)l * 1792 * 256 + (size_t)n0 * ldk + 64 * kb; return; } r -= I_QB;
    { const int nb = 1024 / 64, kb = r / nb, n0 = 64 * (r % nb); N = 1024; ldk = 256; src = p.in[I_WKVB] + (size_t)l * KVRANK * 1024 + (size_t)(64 * kb) * N + n0; dst = WtKvbP + (size_t)l * 1792 * 256 + (size_t)(768 + n0) * ldk + 64 * kb; }
}
__device__ __forceinline__ void opt_convert_weights(const P& p, const Q& q, bf16* WtKvbP, LAS unsigned char* lds, int gw, int ngw, int wave, int lane) {
    LAS float* scr = (LAS float*)(lds + wave * 16640);
    constexpr int I_GU = (D / 64) * (2 * DE / 64), I_DN = (DE / 64) * (D / 64);
    constexpr int I_IN = (D / 64) * ((DIN + 63) / 64), I_OUT = (DMIX / 64) * (D / 64), I_QB = (QRANK / 64) * (768 / 64), I_KVB = (KVRANK / 64) * (1024 / 64);
    constexpr int PER_L = NE * (I_GU + I_DN) + I_IN + I_OUT + I_QB + I_KVB, REST = I_IN + I_OUT + I_QB + I_KVB;
    const int lr = lane >> 4, c4 = (lane & 15) * 4;
#ifdef BG_PROBE
    for (int x = gw; x < DEPTH * PER_L; x += ngw) {
        const float* src; bf16* dst; int N, ldk; tr_decode(p, q, WtKvbP, x, src, N, dst, ldk);
#else
    for (int x = gw; x < DEPTH * REST; x += ngw) {
        const float* src; bf16* dst; int N, ldk; tr_decode(p, q, WtKvbP, (x / REST) * PER_L + NE * (I_GU + I_DN) + x % REST, src, N, dst, ldk);
#endif
        f32x4 v[16];
#pragma unroll
        for (int i = 0; i < 16; ++i) v[i] = *(const f32x4*)(src + (size_t)(4 * i + lr) * N + c4);
#pragma unroll
        for (int i = 0; i < 16; ++i) { LAS float* d = scr + (4 * i + lr) * 65 + c4; d[0] = v[i].x; d[1] = v[i].y; d[2] = v[i].z; d[3] = v[i].w; }
        asm volatile("s_waitcnt lgkmcnt(0)" ::: "memory");
#pragma unroll
        for (int j = 0; j < 8; ++j) { const int n = 8 * j + (lane >> 3), c = lane & 7; const LAS float* sp = scr + (8 * c) * 65 + n;
            u32x4 o; o.x = pk2(sp[0 * 65], sp[1 * 65]); o.y = pk2(sp[2 * 65], sp[3 * 65]); o.z = pk2(sp[4 * 65], sp[5 * 65]); o.w = pk2(sp[6 * 65], sp[7 * 65]);
            *(u32x4*)(dst + (size_t)n * ldk + 8 * c) = o; }
        asm volatile("s_waitcnt lgkmcnt(0)" ::: "memory");
    }
    const long gt = (long)gw * 64 + lane, ngt = (long)ngw * 64;
    for (long i = gt; i < (long)DEPTH * (DINP - DIN) * D / 8; i += ngt) { const int l = (int)(i / ((DINP - DIN) * D / 8)); const long o = i % ((DINP - DIN) * D / 8);
        *(u32x4*)(q.WtIn + ((size_t)l * DINP + DIN) * D + o * 8) = (u32x4){0u, 0u, 0u, 0u}; }
    for (long i = gt; i < (long)DEPTH * 1024 * 16; i += ngt) { const long row = i >> 4, l = row >> 10, n = row & 1023; *(u32x4*)(WtKvbP + ((size_t)l * 1792 + 768 + n) * 256 + 128 + (i & 15) * 8) = (u32x4){0u, 0u, 0u, 0u}; }
}

struct BgConv {
    const float* wgu; const float* wdn; bf16* tgu; bf16* tdn;
    int it, stride, end, ph; unsigned ldsb;
    const float* src; bf16* dst; int N;
    const float* wsc; float qs; int is8;
    static constexpr int I_GU = NE * (2 * DE / 32) * (D / 64), I_DN = NE * (D / 32) * (DE / 64), TOTAL = I_GU + I_DN, LDS_PER_WAVE = 8192;
    static_assert(D == 1024 && DE == 1024 && NE == 32, "BgConv decodes items by shifts");
#ifndef BG_IDLE_N
#define BG_IDLE_N 0
#endif
    static constexpr int BG_IDLE = BG_IDLE_N;
    __device__ __forceinline__ void decode() {
#ifdef BG_PROBE
        const int it = this->it & 2047;
#endif
        if (it < I_GU) { const int e = it >> 10, nblk = (it >> 4) & 63, kb = it & 15, n0 = 32 * nblk, isl = n0 >= DE, j0 = n0 - isl * DE, drow0 = 256 * (j0 / 128) + 128 * isl + (j0 % 128);
            N = 2 * DE; src = wgu + ((size_t)e * D + 64 * kb) * (2 * DE) + n0;
            if (FP8_GU) { is8 = 1; qs = wsc[e * 2]; dst = (bf16*)((fp8*)tgu + ((size_t)e * 2 * DE + drow0) * D + 64 * kb); } else { is8 = 0; dst = tgu + ((size_t)e * 2 * DE + drow0) * D + 64 * kb; } }
        else { const int r = it - I_GU, e = r >> 9, nblk = (r >> 4) & 31, kb = r & 15, n0 = 32 * nblk;
            N = D; src = wdn + ((size_t)e * DE + 64 * kb) * D + n0;
            if (FP8_DN) { is8 = 1; qs = wsc[(NE + e) * 2]; dst = (bf16*)((fp8*)tdn + ((size_t)e * D + n0) * DE + 64 * kb); } else { is8 = 0; dst = tdn + ((size_t)e * D + n0) * DE + 64 * kb; } }
    }
    __device__ __forceinline__ void init(const P& p, const Q& q, int l, LAS unsigned char* lds, int first, int stride_, int end_, int wave) {
        wgu = p.in[I_WGU] + (size_t)l * NE * D * 2 * DE; wdn = p.in[I_WD] + (size_t)l * NE * DE * D; tgu = q.WtGu + (size_t)l * NE * 2 * DE * D; tdn = q.WtDn + (size_t)l * NE * D * DE;
        it = first; stride = stride_; end = end_; ph = 0; ldsb = (unsigned)(uintptr_t)(lds + wave * LDS_PER_WAVE); src = nullptr; dst = nullptr; N = 0; wsc = wscale_tab(q) + (size_t)l * 2 * NE * 2; qs = 1.f; is8 = 0;
        if (it < end) decode();
    }
    __device__ __forceinline__ bool done() const { return it >= end; }
    __device__ __forceinline__ void collect(bool covered) {
        if (it >= end || ph != 3) return;
#ifdef BG_NO_RD
        it += stride; if (it < end) decode(); ph = -BG_IDLE; return;
#endif
        const int lane = (int)__builtin_amdgcn_mbcnt_hi(~0u, __builtin_amdgcn_mbcnt_lo(~0u, 0u));
        if (!covered) asm volatile("s_waitcnt vmcnt(0)" ::: "memory"); else asm volatile("" ::: "memory");
        const LAS f32x4* sp = (const LAS f32x4*)(ldsb + (unsigned)lane * 16u);
        f32x4 v[8];
#pragma unroll
        for (int i = 0; i < 8; ++i) v[i] = sp[i * 64];
        if (is8) { char* db8 = (char*)dst + (unsigned)((lane & 7) * (4 * D) + (lane >> 3) * 8); const float s_ = qs;
#pragma unroll
            for (int x = 0; x < 4; ++x) { u32x2 o; o.x = fp8_pack4(v[0][x] * s_, v[1][x] * s_, v[2][x] * s_, v[3][x] * s_); o.y = fp8_pack4(v[4][x] * s_, v[5][x] * s_, v[6][x] * s_, v[7][x] * s_);
                __builtin_nontemporal_store(o, (u32x2*)(db8 + x * D)); }
        } else {
        char* db = (char*)dst + (unsigned)((lane & 7) * (4 * D * 2) + (lane >> 3) * 16);
#pragma unroll
        for (int x = 0; x < 4; ++x) { u32x4 o; o.x = pg8::cvt_pk_bf16(v[0][x], v[1][x]); o.y = pg8::cvt_pk_bf16(v[2][x], v[3][x]); o.z = pg8::cvt_pk_bf16(v[4][x], v[5][x]); o.w = pg8::cvt_pk_bf16(v[6][x], v[7][x]);
            __builtin_nontemporal_store(o, (u32x4*)(db + x * (D * 2))); }
        }
        asm volatile("" ::: "memory");
        it += stride; if (it < end) decode(); ph = -BG_IDLE;
    }
    __device__ __forceinline__ void issue() {
        if (it >= end) return;
#ifdef BG_NO_DMA
        if (false) {
#else
        if (ph >= 0 && ph < 2) {
#endif
            const int lane = (int)__builtin_amdgcn_mbcnt_hi(~0u, __builtin_amdgcn_mbcnt_lo(~0u, 0u));
            unsigned voff = (unsigned)(lane >> 3) * (unsigned)(N * 32) + (unsigned)(lane & 7) * 16u; const unsigned rstride = (unsigned)(N * 4), m0v = ldsb + 4096u * ph; const float* sb = src + (size_t)(4 * ph) * N; unsigned sv;
            asm volatile("s_mov_b32 %0, m0\n\ts_mov_b32 m0, %2\n\ts_nop 0\n\tglobal_load_lds_dwordx4 %1, %4 nt\n\t"
                         "s_add_u32 m0, m0, 0x400\n\tv_add_u32 %1, %3, %1\n\tglobal_load_lds_dwordx4 %1, %4 nt\n\t"
                         "s_add_u32 m0, m0, 0x400\n\tv_add_u32 %1, %3, %1\n\tglobal_load_lds_dwordx4 %1, %4 nt\n\t"
                         "s_add_u32 m0, m0, 0x400\n\tv_add_u32 %1, %3, %1\n\tglobal_load_lds_dwordx4 %1, %4 nt\n\t"
                         "s_mov_b32 m0, %0" : "=&s"(sv), "+v"(voff) : "s"(m0v), "s"(rstride), "s"(sb) : "memory", "scc");
        }
        ++ph;
    }
    __device__ __forceinline__ void drain() { while (it < end) { collect(false); issue(); } }
};

__device__ __forceinline__ void opt_init_wscale(const P& p, const Q& q, int gw, int ngw, int lane) {
    for (int it = gw; it < DEPTH * 2 * NE; it += ngw) { const int e = it % NE, m = (it / NE) & 1, l = it / (2 * NE);
        const float* w = m == 0 ? p.in[I_WGU] + ((size_t)l * NE + e) * D * 2 * DE : p.in[I_WD] + ((size_t)l * NE + e) * DE * D; const int n4 = (m == 0 ? 8 * 2 * DE : 8 * D) / 4;
        float am = 0.f;
        for (int i = lane; i < n4; i += 64) { const f32x4 v = *(const f32x4*)(w + (size_t)i * 4); am = fmaxf(fmaxf(am, fmaxf(fabsf(v.x), fabsf(v.y))), fmaxf(fabsf(v.z), fabsf(v.w))); }
#pragma unroll
        for (int o = 32; o >= 1; o >>= 1) am = fmaxf(am, __shfl_xor(am, o, 64));
        float qs, inv; pow2_scale(am, 5, qs, inv);
        if (lane == 0) { float* t = wscale_tab(q) + ((size_t)(l * 2 + m) * NE + e) * 2; t[0] = qs; t[1] = inv; } }
}

struct EpiInprojF32 {
    static constexpr bool PERM = false; float* U;
    __device__ __forceinline__ void operator()(const pg8::f32x4 (&acc)[2][2][4][2], const pg8::Unit& u, int wr, int wc, int fr, int fq) const {
#pragma unroll
        for (int ai = 0; ai < 2; ++ai)
#pragma unroll
            for (int m = 0; m < 4; ++m) { const int row = u.pm * 256 + ai * 128 + wr * 64 + m * 16 + fr;
#pragma unroll
                for (int bj = 0; bj < 2; ++bj)
#pragma unroll
                    for (int n = 0; n < 2; ++n) { const int c = u.pn * 256 + bj * 128 + wc * 32 + n * 16 + 4 * fq; if (c < DIN) *(pg8::f32x4*)(U + (size_t)row * DIN + c) = acc[ai][bj][m][n]; } }
    }
};
struct EpiOutproj {
    static constexpr bool PERM = false; bf16* X; const float* mod;   const float* xin; const float* cin;
    __device__ __forceinline__ void operator()(const pg8::f32x4 (&acc)[2][2][4][2], const pg8::Unit& u, int wr, int wc, int fr, int fq) const {
        const int r0 = u.pm * 256, b = r0 / TPB, i0 = r0 % TPB; const bool isctx = i0 < CTX; const float* g1 = mod + ((size_t)(isctx ? 2 : b) * 6 + 2) * D;
        static_assert(TPB % 256 == 0 && CTX % 256 == 0, "row tiles do not straddle segments");
        pg8::f32x4 gv[2][2];
#pragma unroll
        for (int bj = 0; bj < 2; ++bj)
#pragma unroll
            for (int n = 0; n < 2; ++n) gv[bj][n] = *(const pg8::f32x4*)(g1 + u.pn * 256 + bj * 128 + wc * 32 + n * 16 + 4 * fq);
        pg8::f32x4 cur[2][2], nxt[2][2];
        auto bload = [&](pg8::f32x4 (&bs)[2][2], int idx) { const int row = r0 + (idx >> 2) * 128 + wr * 64 + (idx & 3) * 16 + fr, i = row % TPB;
            const float* base = xin ? (isctx ? cin + ((size_t)b * CTX + i) * D : xin + ((size_t)b * SEQ + (i - CTX)) * D) : nullptr;
#pragma unroll
            for (int bj = 0; bj < 2; ++bj)
#pragma unroll
                for (int n = 0; n < 2; ++n) { const int c = u.pn * 256 + bj * 128 + wc * 32 + n * 16 + 4 * fq;
                    if (xin) bs[bj][n] = *(const pg8::f32x4*)(base + c);
                    else { const u32x2 w = *(const u32x2*)(X + (size_t)row * D + c); bs[bj][n][0] = __builtin_bit_cast(float, w.x << 16); bs[bj][n][1] = __builtin_bit_cast(float, w.x & 0xffff0000u); bs[bj][n][2] = __builtin_bit_cast(float, w.y << 16); bs[bj][n][3] = __builtin_bit_cast(float, w.y & 0xffff0000u); } } };
        bload(cur, 0);
#pragma unroll
        for (int idx = 0; idx < 8; ++idx) { const int ai = idx >> 2, m = idx & 3, row = r0 + ai * 128 + wr * 64 + m * 16 + fr;
            if (idx + 1 < 8) bload(nxt, idx + 1);
#pragma unroll
            for (int bj = 0; bj < 2; ++bj)
#pragma unroll
                for (int n = 0; n < 2; ++n) { const int c = u.pn * 256 + bj * 128 + wc * 32 + n * 16 + 4 * fq;
                    const pg8::f32x4 r = cur[bj][n] + gv[bj][n] * acc[ai][bj][m][n]; u32x2 o; o.x = pg8::cvt_pk_bf16(r[0], r[1]); o.y = pg8::cvt_pk_bf16(r[2], r[3]);
                    *(u32x2*)(X + (size_t)row * D + c) = o; }
            if (idx + 1 < 8) {
#pragma unroll
                for (int bj = 0; bj < 2; ++bj)
#pragma unroll
                    for (int n = 0; n < 2; ++n) cur[bj][n] = nxt[bj][n]; } }
    }
};
struct GroupedOrder {
    const int* CNT; const int* LIST; const LAS int* ut;
    __device__ void init(const int* cnt, const int* list, int nN, int G, int c, LAS int* tab) { CNT = cnt; LIST = list; ut = tab + 64;
        __syncthreads();
        if (TIDX == 0) { int a = 0; for (int e = 0; e < NE; ++e) { tab[e] = a; a += (cnt[e] + 255) >> 8; } tab[NE] = a; }
        __syncthreads();
        static_assert(NT < 65536, "row -> token map is 16-bit");
        if (TIDX < 16) { const int total = tab[NE] * nN; const long L = (long)TIDX * G + c; int pm = -1, pn = 0, e = 0, mb = 0;
            if (L < total) { int w = (int)L; { const int nx = pg8::NXCD, qq = total / nx, r = total % nx, xcd = w % nx, off = w / nx; w = (xcd < r ? xcd * (qq + 1) : r * (qq + 1) + (xcd - r) * qq) + off; }
                const int blk = w / nN, ntile = w % nN;
                for (int x = 1; x < NE; ++x) if (tab[x] <= blk) e = x;
                mb = blk - tab[e]; pm = blk; pn = e * nN + ntile; }
            tab[64 + TIDX * 4] = pm; tab[64 + TIDX * 4 + 1] = pn; tab[64 + TIDX * 4 + 2] = e; tab[64 + TIDX * 4 + 3] = mb; }
        __syncthreads(); }
    __device__ bool next(int i, pg8::Unit& u) const { if (i >= 15) return false; const int pm = ut[i * 4]; if (pm < 0) return false; u.pm = pm; u.pn = ut[i * 4 + 1]; u.e = ut[i * 4 + 2]; u.mb = ut[i * 4 + 3]; u.slot = i; return true; }
};
struct GuOrder : GroupedOrder {
    const LAS unsigned short* rowtok;
    __device__ void init_rows(LAS unsigned short* rt) { rowtok = rt;
        for (int x = TIDX; x < 15 * 256; x += 512) { const int i = x >> 8, r = x & 255, pm = ut[i * 4]; unsigned short v = 0;
            if (pm >= 0) { const int e = ut[i * 4 + 2], idx = ut[i * 4 + 3] * 256 + r; if (idx < CNT[e]) v = (unsigned short)(LIST[(size_t)e * NT + idx] >> 2); }
            rt[x] = v; }
        __syncthreads(); }
    __device__ __forceinline__ int arow(const pg8::Unit& u, int r) const { return rowtok[u.slot * 256 + r]; }
};
struct DnOrder : GroupedOrder {
    __device__ __forceinline__ int arow(const pg8::Unit& u, int r) const { return u.pm * 256 + r; }
};
struct EpiGu {
    static constexpr bool PERM = true; bf16* ACT; const float* bgu;   int nN; int probe_skip;
    const LAS unsigned short* rowtok; const float* SH; const float* wsc;
    __device__ __forceinline__ void operator()(const pg8::f32x4 (&acc)[2][2][4][2], const pg8::Unit& u, int wr, int wc, int fr, int fq) const {
        if (probe_skip) return;
        const int ntile = u.pn - u.e * nN, j0 = ntile * 128 + wc * 32 + 8 * fq; const float* bg = bgu + (size_t)u.e * 2 * DE;
        constexpr float GS = FP8_DN ? 8.f : 1.f;
        float bgl[8], bli[8];
#pragma unroll
        for (int x = 0; x < 8; ++x) { bgl[x] = bg[j0 + x] * GS; bli[x] = bg[DE + j0 + x]; }
        float dqv[2][4];
        { const float wq = FP8_GU ? wsc[u.e * 2 + 1] : 1.f;
#pragma unroll
          for (int ai = 0; ai < 2; ++ai)
#pragma unroll
            for (int m = 0; m < 4; ++m) dqv[ai][m] = FP8_GU ? SH[rowtok[u.slot * 256 + ai * 128 + wr * 64 + m * 16 + fr]] * wq : 1.f; }
#pragma unroll
        for (int ai = 0; ai < 2; ++ai)
#pragma unroll
            for (int m = 0; m < 4; ++m) { const int row = u.pm * 256 + ai * 128 + wr * 64 + m * 16 + fr; float a[8]; const float dq = dqv[ai][m];
#pragma unroll
                for (int n = 0; n < 2; ++n)
#pragma unroll
                    for (int x = 0; x < 4; ++x) { const float glu = fminf(acc[ai][0][m][n][x] * (dq * GS) + bgl[4 * n + x], 7.0f * GS), lin = fminf(fmaxf(acc[ai][1][m][n][x] * dq + bli[4 * n + x], -7.0f), 7.0f);
                        a[4 * n + x] = glu * __builtin_amdgcn_rcpf(1.f + __builtin_amdgcn_exp2f((-2.4554669595930157f / GS) * glu)) * (lin + 1.f); }
                if (FP8_DN) { u32x2 w8; int t0_ = __builtin_amdgcn_cvt_pk_fp8_f32(a[0], a[1], 0, false); t0_ = __builtin_amdgcn_cvt_pk_fp8_f32(a[2], a[3], t0_, true); int t1_ = __builtin_amdgcn_cvt_pk_fp8_f32(a[4], a[5], 0, false); t1_ = __builtin_amdgcn_cvt_pk_fp8_f32(a[6], a[7], t1_, true);
                    w8.x = (unsigned)t0_; w8.y = (unsigned)t1_;
                    *(u32x2*)((fp8*)ACT + (size_t)row * DE + j0) = w8; }
                else { u32x4 w; w.x = pg8::cvt_pk_bf16(a[0], a[1]); w.y = pg8::cvt_pk_bf16(a[2], a[3]); w.z = pg8::cvt_pk_bf16(a[4], a[5]); w.w = pg8::cvt_pk_bf16(a[6], a[7]);
                    *(u32x4*)(ACT + (size_t)row * DE + j0) = w; } }
    }
};
struct EpiDownF32 {
    static constexpr bool PERM = false; float* YB; const float* bd;   const float* TOPG; const int* CNT; const int* LIST; int nN;
    __device__ __forceinline__ void operator()(const pg8::f32x4 (&acc)[2][2][4][2], const pg8::Unit& u, int wr, int wc, int fr, int fq) const {
        const int ntile = u.pn - u.e * nN, cnt = CNT[u.e]; const float* b = bd + (size_t)u.e * D;
#pragma unroll
        for (int ai = 0; ai < 2; ++ai)
#pragma unroll
            for (int m = 0; m < 4; ++m) { const int idx = u.mb * 256 + ai * 128 + wr * 64 + m * 16 + fr;
                if (idx < cnt) { const int pr = LIST[(size_t)u.e * NT + idx]; const float g = TOPG[pr];
#pragma unroll
                    for (int bj = 0; bj < 2; ++bj)
#pragma unroll
                        for (int n = 0; n < 2; ++n) { const int c = ntile * 256 + bj * 128 + wc * 32 + n * 16 + 4 * fq; const pg8::f32x4 bv = *(const pg8::f32x4*)(b + c);
                            *(pg8::f32x4*)(YB + (size_t)pr * D + c) = (acc[ai][bj][m][n] + bv) * g; } } }
    }
};

__device__ __forceinline__ void opt_inproj(const P& p, const Q& q, int l, LAS unsigned char* lds, int G, int bid) {
    pg8::Gemm g{q.H16, q.WtIn + (size_t)l * DINP * D, D}; pg8::StaticOrder S; S.init(NT, DINP, G, bid);
    EpiInprojF32 E{p.U}; pg8::gemm_phase<EpiInprojF32, pg8::StaticOrder, true>(lds, g, S, E);
}
struct LatentOrder : pg8::StaticOrder {
    __device__ bool next(int i, pg8::Unit& u) const { if (!pg8::StaticOrder::next(i, u)) return false; constexpr int TL = SEQ / 256, TC = CTX / 256; u.pm = (u.pm / TL) * (TL + TC) + TC + u.pm % TL; return true; }
};
__device__ __forceinline__ void outproj_ctx_rows(const EpiOutproj& E, const bf16* Y, const bf16* Wt, int G, int bid) {
    int tid_ = TIDX; asm volatile("" : "+v"(tid_));
    const int tid = tid_, lane = tid & 63, wv = tid >> 6, fr = lane & 15, fq = lane >> 4, rt = wv >> 2, ct = wv & 3;
    constexpr int RB = NB * CTX / 32, CB = D / 64;
    static_assert(CTX % 32 == 0 && D % 64 == 0 && DMIX % 32 == 0, "context out-projection blocks");
    for (int blk = bid; blk < RB * CB; blk += G) {
        const int rb = blk / CB, cb = blk % CB, cr = rb * 32 + rt * 16 + fr, b = cr / CTX, i = cr % CTX, row = b * TPB + i, col = cb * 64 + ct * 16 + fr;
        const bf16* ap = Y + (size_t)row * DMIX + 8 * fq; const bf16* bp = Wt + (size_t)col * DMIX + 8 * fq;
        pg8::f32x4 acc = {0.f, 0.f, 0.f, 0.f};
#pragma unroll 10
        for (int k0 = 0; k0 < DMIX; k0 += 32) acc = __builtin_amdgcn_mfma_f32_16x16x32_bf16(*(const pg8::bf16x8*)(bp + k0), *(const pg8::bf16x8*)(ap + k0), acc, 0, 0, 0);
        const int c = cb * 64 + ct * 16 + 4 * fq;
        const pg8::f32x4 gv = *(const pg8::f32x4*)(E.mod + ((size_t)2 * 6 + 2) * D + c);
        pg8::f32x4 bs;
        if (E.xin) bs = *(const pg8::f32x4*)(E.cin + ((size_t)b * CTX + i) * D + c);
        else { const u32x2 w = *(const u32x2*)(E.X + (size_t)row * D + c); bs[0] = __builtin_bit_cast(float, w.x << 16); bs[1] = __builtin_bit_cast(float, w.x & 0xffff0000u); bs[2] = __builtin_bit_cast(float, w.y << 16); bs[3] = __builtin_bit_cast(float, w.y & 0xffff0000u); }
        const pg8::f32x4 r = bs + gv * acc; u32x2 o; o.x = pg8::cvt_pk_bf16(r[0], r[1]); o.y = pg8::cvt_pk_bf16(r[2], r[3]);
        *(u32x2*)(E.X + (size_t)row * D + c) = o;
    }
}
__device__ __forceinline__ void opt_outproj(const P& p, const Q& q, int l, LAS unsigned char* lds, int G, int bid, bool latent_only) {
    pg8::Gemm g{q.Y16, q.WtOut + (size_t)l * D * DMIX, DMIX}; EpiOutproj E{(bf16*)p.X, p.MOD + (size_t)l * 3 * 6 * D, l == 0 ? p.in[I_X] : nullptr, p.in[I_CTX]};
    { LatentOrder S; S.init(NB * SEQ, D, G, bid); pg8::gemm_phase<EpiOutproj, LatentOrder, true>(lds, g, S, E); }
    if (!latent_only) outproj_ctx_rows(E, q.Y16, q.WtOut + (size_t)l * D * DMIX, G, bid);
}
__device__ __forceinline__ void opt_moe_gu(const P& p, const Q& q, int l, LAS unsigned char* lds, int G, int bid, int probe_skip = 0) {
    pg8::Gemm g{q.H16, q.WtGu + (size_t)l * NE * 2 * DE * D, D}; GuOrder S;
    S.init(p.CNT, p.LIST, 2 * DE / 256, G, bid, (LAS int*)(lds + pg8::STAGE_BYTES)); S.init_rows((LAS unsigned short*)(lds + pg8::STAGE_BYTES + 1024 + 8192));
    EpiGu E{q.ACT16, p.in[I_BGU] + (size_t)l * NE * 2 * DE, 2 * DE / 256, probe_skip, S.rowtok, rowscale_tab(q), wscale_tab(q) + (size_t)l * 2 * NE * 2};
    pg8::gemm_phase<EpiGu, GuOrder, true, FP8_GU != 0>(lds, g, S, E);
}
__device__ __forceinline__ void opt_moe_down(const P& p, const Q& q, int l, LAS unsigned char* lds, int G, int bid) {
    pg8::Gemm g{q.ACT16, q.WtDn + (size_t)l * NE * D * DE, DE}; DnOrder S; S.init(p.CNT, p.LIST, D / 256, G, bid, (LAS int*)(lds + pg8::STAGE_BYTES));
    EpiDownF32 E{p.YB, p.in[I_BD] + (size_t)l * NE * D, p.TOPG, p.CNT, p.LIST, D / 256}; pg8::gemm_phase<EpiDownF32, DnOrder, true>(lds, g, S, E);
}
namespace att {
using bf16x8 = __attribute__((ext_vector_type(8))) short;
using s16x4  = __attribute__((ext_vector_type(4))) short;
using f32x16 = __attribute__((ext_vector_type(16))) float;
using f32x8  = __attribute__((ext_vector_type(8))) float;
using u32x4  = __attribute__((ext_vector_type(4))) unsigned;
constexpr int DK = 96, DV = 64, NW = 8, QBLK = 32, KVBLK = 64;
constexpr float SCALE = 0.10206207261596575f;
#ifndef ATTN_THR
#define ATTN_THR 8.f
#endif
constexpr float THR = ATTN_THR;
#ifndef ATTN_SM_SPLIT
#define ATTN_SM_SPLIT 0
#endif
#ifndef ATTN_NEGM
#define ATTN_NEGM 1
#endif
constexpr float QPRESCALE = ATTN_NEGM ? SCALE * 1.4426950408889634f : 1.f;
constexpr int KROW = 208;
constexpr int SHM_K = KVBLK * KROW, SHM_V = KVBLK * DV * 2;
#ifndef ATTN_STAG
#define ATTN_STAG 0
#endif
#ifndef ATTN_LAG2
#define ATTN_LAG2 0
#endif
#ifndef ATTN_KPERM
#define ATTN_KPERM 0
#endif
#ifndef ATTN_LMFMA
#define ATTN_LMFMA 1
#endif
constexpr int NRING = (ATTN_LAG2 || ATTN_STAG) ? 4 : 3;
constexpr int SHM_Q = ATTN_STAG ? 256 * KROW : 0;
constexpr int SHM_ATTN = NRING * SHM_V + NRING * SHM_K + NW * 64 * 4 + SHM_Q;
#define KSWZ(row, colB) ((row) * KROW + (colB))
#define SBAR() __builtin_amdgcn_sched_barrier(0)
__device__ __forceinline__ int crow(int r, int hi) { return (r & 3) + 8 * (r >> 2) + 4 * hi; }
typedef float f32x2_t __attribute__((ext_vector_type(2))); typedef __bf16 bf16x2_t __attribute__((ext_vector_type(2)));
__device__ __forceinline__ unsigned cvtpk(float lo, float hi) { f32x2_t v = {lo, hi}; bf16x2_t b = __builtin_convertvector(v, bf16x2_t); return __builtin_bit_cast(unsigned, b); }
__device__ __forceinline__ bf16x8 tobf(f32x8 x) { u32x4 w = {cvtpk(x[0], x[1]), cvtpk(x[2], x[3]), cvtpk(x[4], x[5]), cvtpk(x[6], x[7])}; return *reinterpret_cast<bf16x8*>(&w); }

#if ATTN_NEGM
template <bool FIRST = false>
__device__ __forceinline__ void partialSM_n(f32x16& p0, f32x16& p1, f32x16& negm, float& alpha) {
  constexpr float THR2 = THR * 1.4426950408889634f;
  float pmax = p0[0];
#pragma unroll
  for (int r = 1; r < 16; ++r) pmax = fmaxf(pmax, p0[r]);
#pragma unroll
  for (int r = 0; r < 16; ++r) pmax = fmaxf(pmax, p1[r]);
  { auto rr = __builtin_amdgcn_permlane32_swap(__float_as_uint(pmax), __float_as_uint(pmax), false, false);
    pmax = fmaxf(__uint_as_float(rr[0]), __uint_as_float(rr[1])); }
  if (!FIRST && __builtin_expect(__all(pmax <= THR2), 1)) { alpha = 1.f; }
  else { const float dl = FIRST ? pmax : fmaxf(pmax, 0.f); alpha = FIRST ? 1.f : __builtin_amdgcn_exp2f(-dl);
#pragma unroll
    for (int r = 0; r < 16; ++r) { p0[r] -= dl; p1[r] -= dl; negm[r] -= dl; } }
#if ATTN_SM_SPLIT == 1
#pragma unroll
  for (int r = 0; r < 16; ++r) p0[r] = __builtin_amdgcn_exp2f(p0[r]);
#endif
}
__device__ __forceinline__ void finishSM_n(f32x16& p0, f32x16& p1, float alpha, float& l_reg, bf16x8& pa0, bf16x8& pa1, bf16x8& pa2, bf16x8& pa3) {
#if ATTN_SM_SPLIT == 1
#pragma unroll
  for (int r = 0; r < 16; ++r) p1[r] = __builtin_amdgcn_exp2f(p1[r]);
#else
#pragma unroll
  for (int r = 0; r < 16; ++r) { p0[r] = __builtin_amdgcn_exp2f(p0[r]); p1[r] = __builtin_amdgcn_exp2f(p1[r]); }
#endif
#if !ATTN_LMFMA
  float ps = 0;
#pragma unroll
  for (int r = 0; r < 16; ++r) ps += p0[r];
#pragma unroll
  for (int r = 0; r < 16; ++r) ps += p1[r];
  { auto rr = __builtin_amdgcn_permlane32_swap(__float_as_uint(ps), __float_as_uint(ps), false, false);
    ps = __uint_as_float(rr[0]) + __uint_as_float(rr[1]); }
  l_reg = l_reg * alpha + ps;
#else
  (void)alpha; (void)l_reg;
#endif
#if ATTN_KPERM
#define PK4(P, BASE, OUT) do { u32x4 w = {cvtpk(P[BASE + 0], P[BASE + 1]), cvtpk(P[BASE + 2], P[BASE + 3]), cvtpk(P[BASE + 4], P[BASE + 5]), cvtpk(P[BASE + 6], P[BASE + 7])}; OUT = *reinterpret_cast<bf16x8*>(&w); } while (0)
#else
#define PK4(P, BASE, OUT) do { unsigned a0 = cvtpk(P[BASE + 0], P[BASE + 1]), a1 = cvtpk(P[BASE + 2], P[BASE + 3]);   \
    unsigned b0 = cvtpk(P[BASE + 4], P[BASE + 5]), b1 = cvtpk(P[BASE + 6], P[BASE + 7]);                              \
    auto r0 = __builtin_amdgcn_permlane32_swap(a0, b0, false, false); auto r1 = __builtin_amdgcn_permlane32_swap(a1, b1, false, false); \
    u32x4 w = {r0[0], r1[0], r0[1], r1[1]}; OUT = *reinterpret_cast<bf16x8*>(&w); } while (0)
#endif
  PK4(p0, 0, pa0); PK4(p0, 8, pa1); PK4(p1, 0, pa2); PK4(p1, 8, pa3);
#undef PK4
}
__device__ __forceinline__ void qkt_n(f32x16& p0, f32x16& p1, const char* Ks, const bf16x8* qr, const f32x16& negm, int r32, int hi) {
#pragma unroll
  for (int d0 = 0; d0 < DK / 16; ++d0) { const int cb = (d0 * 16 + hi * 8) * 2;
#if ATTN_KPERM
    const int rk = (r32 & ~0xC) | ((r32 & 4) << 1) | ((r32 & 8) >> 1);
#else
    const int rk = r32;
#endif
    const bf16x8 b0 = *reinterpret_cast<const bf16x8*>(Ks + ((rk) * KROW + cb));
    const bf16x8 b1 = *reinterpret_cast<const bf16x8*>(Ks + ((32 + rk) * KROW + cb));
#if ATTN_STAG
    const bf16x8 qf = *reinterpret_cast<const bf16x8*>((const char*)qr + d0 * 32);
#else
    const bf16x8 qf = qr[d0];
#endif
    if (d0 == 0) { p0 = __builtin_amdgcn_mfma_f32_32x32x16_bf16(b0, qf, negm, 0, 0, 0); p1 = __builtin_amdgcn_mfma_f32_32x32x16_bf16(b1, qf, negm, 0, 0, 0); }
    else { p0 = __builtin_amdgcn_mfma_f32_32x32x16_bf16(b0, qf, p0, 0, 0, 0); p1 = __builtin_amdgcn_mfma_f32_32x32x16_bf16(b1, qf, p1, 0, 0, 0); } }
}
#endif
__device__ __forceinline__ void partialSM(f32x16& p0, f32x16& p1, float& m_reg, float& mn, float& alpha) {
  constexpr float C = SCALE * 1.4426950408889634f;
  float pmax = p0[0];
#pragma unroll
  for (int r = 1; r < 16; ++r) pmax = fmaxf(pmax, p0[r]);
#pragma unroll
  for (int r = 0; r < 16; ++r) pmax = fmaxf(pmax, p1[r]);
  { auto rr = __builtin_amdgcn_permlane32_swap(__float_as_uint(pmax), __float_as_uint(pmax), false, false);
    pmax = fmaxf(__uint_as_float(rr[0]), __uint_as_float(rr[1])); }
#if ATTN_SM_SPLIT == 2
  { const bool keep = __all(pmax - m_reg <= THR / SCALE); mn = keep ? m_reg : fmaxf(m_reg, pmax); alpha = __builtin_amdgcn_exp2f((m_reg - mn) * C); m_reg = mn;
    const float mnC = -mn * C;
#pragma unroll
    for (int r = 0; r < 16; ++r) { p0[r] = __builtin_amdgcn_exp2f(fmaf(p0[r], C, mnC)); p1[r] = __builtin_amdgcn_exp2f(fmaf(p1[r], C, mnC)); } }
  return;
#endif
  if (__builtin_expect(__all(pmax - m_reg <= THR / SCALE), 1)) { mn = m_reg; alpha = 1.f; }
  else { mn = fmaxf(m_reg, pmax); alpha = __builtin_amdgcn_exp2f((m_reg - mn) * C); m_reg = mn; }
#if ATTN_SM_SPLIT == 1
  const float mnC = -mn * C;
#pragma unroll
  for (int r = 0; r < 16; ++r) p0[r] = fmaf(p0[r], C, mnC);
#pragma unroll
  for (int r = 0; r < 16; ++r) p1[r] = fmaf(p1[r], C, mnC);
#pragma unroll
  for (int r = 0; r < 16; ++r) p0[r] = __builtin_amdgcn_exp2f(p0[r]);
#endif
}
__device__ __forceinline__ void finishSM(f32x16& p0, f32x16& p1, float mn, float alpha, float& l_reg, bf16x8& pa0, bf16x8& pa1, bf16x8& pa2, bf16x8& pa3) {
#if ATTN_SM_SPLIT == 1
#pragma unroll
  for (int r = 0; r < 16; ++r) p1[r] = __builtin_amdgcn_exp2f(p1[r]);
#elif ATTN_SM_SPLIT == 2
  (void)mn;
#else
  { constexpr float C = SCALE * 1.4426950408889634f; const float mnC = -mn * C;
#pragma unroll
    for (int r = 0; r < 16; ++r) { p0[r] = __builtin_amdgcn_exp2f(fmaf(p0[r], C, mnC)); p1[r] = __builtin_amdgcn_exp2f(fmaf(p1[r], C, mnC)); } }
#endif
  float ps = 0;
#pragma unroll
  for (int r = 0; r < 16; ++r) ps += p0[r];
#pragma unroll
  for (int r = 0; r < 16; ++r) ps += p1[r];
  { auto rr = __builtin_amdgcn_permlane32_swap(__float_as_uint(ps), __float_as_uint(ps), false, false);
    ps = __uint_as_float(rr[0]) + __uint_as_float(rr[1]); }
  l_reg = l_reg * alpha + ps;
#define PK4(P, BASE, OUT) do { unsigned a0 = cvtpk(P[BASE + 0], P[BASE + 1]), a1 = cvtpk(P[BASE + 2], P[BASE + 3]);   \
    unsigned b0 = cvtpk(P[BASE + 4], P[BASE + 5]), b1 = cvtpk(P[BASE + 6], P[BASE + 7]);                              \
    auto r0 = __builtin_amdgcn_permlane32_swap(a0, b0, false, false); auto r1 = __builtin_amdgcn_permlane32_swap(a1, b1, false, false); \
    u32x4 w = {r0[0], r1[0], r0[1], r1[1]}; OUT = *reinterpret_cast<bf16x8*>(&w); } while (0)
  PK4(p0, 0, pa0); PK4(p0, 8, pa1); PK4(p1, 0, pa2); PK4(p1, 8, pa3);
#undef PK4
}
__device__ __forceinline__ void qkt(f32x16& p0, f32x16& p1, const char* Ks, const bf16x8* qr, int r32, int hi) {
  p0 = f32x16{}; p1 = f32x16{};
#pragma unroll
  for (int d0 = 0; d0 < DK / 16; ++d0) { const int cb = (d0 * 16 + hi * 8) * 2;
    const bf16x8 b0 = *reinterpret_cast<const bf16x8*>(Ks + KSWZ(r32, cb));
    const bf16x8 b1 = *reinterpret_cast<const bf16x8*>(Ks + KSWZ(32 + r32, cb));
    p0 = __builtin_amdgcn_mfma_f32_32x32x16_bf16(b0, qr[d0], p0, 0, 0, 0);
    p1 = __builtin_amdgcn_mfma_f32_32x32x16_bf16(b1, qr[d0], p1, 0, 0, 0); }
}
__device__ __forceinline__ int v_st(int k, int c) { const int kk = (k & ~0xC) | ((k & 4) << 1) | ((k & 8) >> 1); return ((kk >> 3) * 2 + (c >> 5)) * 512 + ((kk & 7) * 32 + (c & 31)) * 2; }
__device__ __forceinline__ int v_rd_base(int lane) { return ((lane & 3) << 3) | (((lane >> 2) & 3) << 6) | (((lane >> 4) & 1) << 5) | (((lane >> 5) & 1) << 8); }
constexpr int v_rd_off(int d0, int ks, int half) { return d0 * 512 + ks * 2048 + half * 1024; }
template <int OFF> __device__ __forceinline__ s16x4 tr_read(int vb) {
  s16x4 r; asm volatile("ds_read_b64_tr_b16 %0, %1 offset:%2" : "=&v"(r) : "v"(vb), "i"(OFF) : "memory"); return r;
}
template <int D0> __device__ __forceinline__ void pv_one(f32x16& od, int vb, bf16x8 pa0, bf16x8 pa1, bf16x8 pa2, bf16x8 pa3) {
  const s16x4 l0 = tr_read<v_rd_off(D0, 0, 0)>(vb), h0 = tr_read<v_rd_off(D0, 0, 1)>(vb), l1 = tr_read<v_rd_off(D0, 1, 0)>(vb), h1 = tr_read<v_rd_off(D0, 1, 1)>(vb);
  const s16x4 l2 = tr_read<v_rd_off(D0, 2, 0)>(vb), h2 = tr_read<v_rd_off(D0, 2, 1)>(vb), l3 = tr_read<v_rd_off(D0, 3, 0)>(vb), h3 = tr_read<v_rd_off(D0, 3, 1)>(vb);
  asm volatile("s_waitcnt lgkmcnt(0)" ::: "memory"); SBAR();
#define PK(L, H) (bf16x8){L[0], L[1], L[2], L[3], H[0], H[1], H[2], H[3]}
  od = __builtin_amdgcn_mfma_f32_32x32x16_bf16(pa0, PK(l0, h0), od, 0, 0, 0);
  od = __builtin_amdgcn_mfma_f32_32x32x16_bf16(pa1, PK(l1, h1), od, 0, 0, 0);
  od = __builtin_amdgcn_mfma_f32_32x32x16_bf16(pa2, PK(l2, h2), od, 0, 0, 0);
  od = __builtin_amdgcn_mfma_f32_32x32x16_bf16(pa3, PK(l3, h3), od, 0, 0, 0);
#undef PK
}
__device__ __forceinline__ void pv_d0(f32x16* o, int vb, bf16x8 pa0, bf16x8 pa1, bf16x8 pa2, bf16x8 pa3) {
  pv_one<0>(o[0], vb, pa0, pa1, pa2, pa3); pv_one<1>(o[1], vb, pa0, pa1, pa2, pa3);
}

__device__ __forceinline__ void pv_sm(f32x16* o, int vb, bf16x8 pa0, bf16x8 pa1, bf16x8 pa2, bf16x8 pa3, f32x16& p0, f32x16& p1, float& m_reg, float& mn, float& alpha) {
  constexpr float C = SCALE * 1.4426950408889634f;
  const s16x4 l00 = tr_read<v_rd_off(0, 0, 0)>(vb), h00 = tr_read<v_rd_off(0, 0, 1)>(vb), l10 = tr_read<v_rd_off(1, 0, 0)>(vb), h10 = tr_read<v_rd_off(1, 0, 1)>(vb);
  const s16x4 l01 = tr_read<v_rd_off(0, 1, 0)>(vb), h01 = tr_read<v_rd_off(0, 1, 1)>(vb), l11 = tr_read<v_rd_off(1, 1, 0)>(vb), h11 = tr_read<v_rd_off(1, 1, 1)>(vb);
  const s16x4 l02 = tr_read<v_rd_off(0, 2, 0)>(vb), h02 = tr_read<v_rd_off(0, 2, 1)>(vb), l12 = tr_read<v_rd_off(1, 2, 0)>(vb), h12 = tr_read<v_rd_off(1, 2, 1)>(vb);
  const s16x4 l03 = tr_read<v_rd_off(0, 3, 0)>(vb), h03 = tr_read<v_rd_off(0, 3, 1)>(vb), l13 = tr_read<v_rd_off(1, 3, 0)>(vb), h13 = tr_read<v_rd_off(1, 3, 1)>(vb);
  float pmax = p0[0];
#pragma unroll
  for (int r = 1; r < 16; ++r) pmax = fmaxf(pmax, p0[r]);
#pragma unroll
  for (int r = 0; r < 16; ++r) pmax = fmaxf(pmax, p1[r]);
  { auto rr = __builtin_amdgcn_permlane32_swap(__float_as_uint(pmax), __float_as_uint(pmax), false, false);
    pmax = fmaxf(__uint_as_float(rr[0]), __uint_as_float(rr[1])); }
  const bool keep = __all(pmax - m_reg <= THR / SCALE); mn = keep ? m_reg : fmaxf(m_reg, pmax); alpha = __builtin_amdgcn_exp2f((m_reg - mn) * C); m_reg = mn;
  const float mnC = -mn * C;
  asm volatile("s_waitcnt lgkmcnt(0)" ::: "memory"); SBAR();
#define PK(L, H) (bf16x8){L[0], L[1], L[2], L[3], H[0], H[1], H[2], H[3]}
#define EX4(P, B) do { P[B] = __builtin_amdgcn_exp2f(fmaf(P[B], C, mnC)); P[B + 1] = __builtin_amdgcn_exp2f(fmaf(P[B + 1], C, mnC)); P[B + 2] = __builtin_amdgcn_exp2f(fmaf(P[B + 2], C, mnC)); P[B + 3] = __builtin_amdgcn_exp2f(fmaf(P[B + 3], C, mnC)); } while (0)
  o[0] = __builtin_amdgcn_mfma_f32_32x32x16_bf16(pa0, PK(l00, h00), o[0], 0, 0, 0); EX4(p0, 0); SBAR();
  o[1] = __builtin_amdgcn_mfma_f32_32x32x16_bf16(pa0, PK(l10, h10), o[1], 0, 0, 0); EX4(p0, 4); SBAR();
  o[0] = __builtin_amdgcn_mfma_f32_32x32x16_bf16(pa1, PK(l01, h01), o[0], 0, 0, 0); EX4(p0, 8); SBAR();
  o[1] = __builtin_amdgcn_mfma_f32_32x32x16_bf16(pa1, PK(l11, h11), o[1], 0, 0, 0); EX4(p0, 12); SBAR();
  o[0] = __builtin_amdgcn_mfma_f32_32x32x16_bf16(pa2, PK(l02, h02), o[0], 0, 0, 0); EX4(p1, 0); SBAR();
  o[1] = __builtin_amdgcn_mfma_f32_32x32x16_bf16(pa2, PK(l12, h12), o[1], 0, 0, 0); EX4(p1, 4); SBAR();
  o[0] = __builtin_amdgcn_mfma_f32_32x32x16_bf16(pa3, PK(l03, h03), o[0], 0, 0, 0); EX4(p1, 8); SBAR();
  o[1] = __builtin_amdgcn_mfma_f32_32x32x16_bf16(pa3, PK(l13, h13), o[1], 0, 0, 0); EX4(p1, 12); SBAR();
#undef PK
#undef EX4
}

struct NoBgWork { __device__ __forceinline__ void collect(bool) {} __device__ __forceinline__ void issue() {} };
template <class TQ, class Out, int VAR = 0, class BG = NoBgWork>
__device__ __forceinline__ void attn_unit(const TQ* Qb, int ldq, const unsigned short* Kh, const unsigned short* Vh, int seq, char* lds, const Out& OUT, BG&& bg = BG()) {
  int tid_ = TIDX; asm volatile("" : "+v"(tid_));
  const int tid = tid_, wid = tid >> 6, lane = tid & 63, r32 = lane & 31, hi = lane >> 5;
  char* V_lds = lds; char* K_lds = lds + NRING * SHM_V;
  float* ws = (float*)(lds + NRING * SHM_V + NRING * SHM_K) + wid * 64; float* li_l = ws; float* al_l = ws + 32;
  float m_reg = -1e30f, l_reg = 0; f32x16 o[2] = {}; f32x16 negm = {}; (void)negm;
  f32x16 lacc = {}; (void)lacc;
  const bf16x8 ones8 = {0x3F80, 0x3F80, 0x3F80, 0x3F80, 0x3F80, 0x3F80, 0x3F80, 0x3F80}; (void)ones8;
#if ATTN_STAG
  char* Q_lds = lds + NRING * SHM_V + NRING * SHM_K + NW * 64 * 4;
  { static_assert(sizeof(TQ) == 2, "the stagger variant takes bf16 q rows");
#pragma unroll
    for (int k = 0; k < 6; ++k) { const int x = tid + k * 512, row = x / 12, c16 = x % 12; *(bf16x8*)(Q_lds + row * KROW + c16 * 16) = *reinterpret_cast<const bf16x8*>(Qb + (long)row * ldq + c16 * 8); } }
  const bf16x8* qr = reinterpret_cast<const bf16x8*>(Q_lds + (wid * QBLK + r32) * KROW + hi * 16);
#else
  bf16x8 qr[DK / 16];
  { const TQ* Qw = Qb + (long)(wid * QBLK + r32) * ldq + hi * 8;
#pragma unroll
    for (int d0 = 0; d0 < DK / 16; ++d0) {
      if constexpr (sizeof(TQ) == 4) qr[d0] = tobf(*reinterpret_cast<const f32x8*>(Qw + d0 * 16)); else qr[d0] = *reinterpret_cast<const bf16x8*>(Qw + d0 * 16); } }
#endif
  const int kc0 = tid, kc1 = 512 + tid; const bool two = tid < 256;
  const int kst0 = KSWZ(kc0 / 12, (kc0 % 12) * 16), kst1 = KSWZ(kc1 / 12, (kc1 % 12) * 16), vst = v_st(tid >> 3, (tid & 7) * 8);
  const int vb0 = (int)(uintptr_t)V_lds + v_rd_base(lane);
  struct { bf16x8 v, k0, k1; } sr_[ATTN_STAG ? 1 : 2];
#define SLOAD(i, key0) do { sr_[i].v = *reinterpret_cast<const bf16x8*>(Vh + (long)(key0) * DV + tid * 8); sr_[i].k0 = *reinterpret_cast<const bf16x8*>(Kh + (long)(key0) * DK + kc0 * 8); \
    if (two) sr_[i].k1 = *reinterpret_cast<const bf16x8*>(Kh + (long)(key0) * DK + kc1 * 8); } while (0)
#define SWRITE(b, i) do { *(bf16x8*)(V_lds + (b) * SHM_V + vst) = sr_[i].v; *(bf16x8*)(K_lds + (b) * SHM_K + kst0) = sr_[i].k0; if (two) *(bf16x8*)(K_lds + (b) * SHM_K + kst1) = sr_[i].k1; } while (0)
#define RESC(a) do { if (__any((a) < 1.f)) { if (hi == 0) al_l[r32] = (a); asm volatile("s_waitcnt lgkmcnt(0)" ::: "memory"); \
    _Pragma("unroll") for (int d = 0; d < 2; ++d) _Pragma("unroll") for (int r = 0; r < 16; ++r) o[d][r] *= al_l[crow(r, hi)]; \
    if constexpr (ATTN_LMFMA != 0 && ATTN_NEGM != 0) { _Pragma("unroll") for (int r = 0; r < 16; ++r) lacc[r] *= al_l[crow(r, hi)]; } } } while (0)
  f32x16 pA0 = {}, pA1 = {}, pB0 = {}, pB1 = {}; float mnA, mnB, alA, alB; bf16x8 pa0, pa1, pa2, pa3; const int NT = seq / KVBLK;
  constexpr int SE = 0, SO = 1;
#if ATTN_NEGM
#define PSM(p0_, p1_, m_, mn_, al_) do { (void)mn_; partialSM_n(p0_, p1_, negm, al_); } while (0)
#else
#define PSM(p0_, p1_, m_, mn_, al_) do { if constexpr (VAR == 1) { mn_ = 0.f; al_ = 1.f; } else partialSM(p0_, p1_, m_, mn_, al_); } while (0)
#endif
#define FSM(p0_, p1_, mn_, al_, l_, a0_, a1_, a2_, a3_) do { if constexpr (VAR == 1) { u32x4 w0_ = {cvtpk(p0_[0], p0_[1]), cvtpk(p0_[2], p0_[3]), cvtpk(p0_[4], p0_[5]), cvtpk(p0_[6], p0_[7])}; a0_ = *reinterpret_cast<bf16x8*>(&w0_); \
      u32x4 w1_ = {cvtpk(p0_[8], p0_[9]), cvtpk(p0_[10], p0_[11]), cvtpk(p0_[12], p0_[13]), cvtpk(p0_[14], p0_[15])}; a1_ = *reinterpret_cast<bf16x8*>(&w1_); \
      u32x4 w2_ = {cvtpk(p1_[0], p1_[1]), cvtpk(p1_[2], p1_[3]), cvtpk(p1_[4], p1_[5]), cvtpk(p1_[6], p1_[7])}; a2_ = *reinterpret_cast<bf16x8*>(&w2_); \
      u32x4 w3_ = {cvtpk(p1_[8], p1_[9]), cvtpk(p1_[10], p1_[11]), cvtpk(p1_[12], p1_[13]), cvtpk(p1_[14], p1_[15])}; a3_ = *reinterpret_cast<bf16x8*>(&w3_); } else { if constexpr (ATTN_NEGM != 0) finishSM_n(p0_, p1_, al_, l_, a0_, a1_, a2_, a3_); else finishSM(p0_, p1_, mn_, al_, l_, a0_, a1_, a2_, a3_); } } while (0)
#define PVSM(o_, vb_, a0_, a1_, a2_, a3_, p0_, p1_, m_, mn_, al_) do { if constexpr (VAR == 0 && ATTN_SM_SPLIT == 2) pv_sm(o_, vb_, a0_, a1_, a2_, a3_, p0_, p1_, m_, mn_, al_); else { PVD(o_, vb_, a0_, a1_, a2_, a3_); PSM(p0_, p1_, m_, mn_, al_); } } while (0)
#define PVD(o_, vb_, a0_, a1_, a2_, a3_) do { if constexpr (VAR == 2) { asm volatile("" : "+v"(o_[0]), "+v"(o_[1]) : "v"(a0_), "v"(a1_), "v"(a2_), "v"(a3_)); } else { pv_d0(o_, vb_, a0_, a1_, a2_, a3_); \
    if constexpr (ATTN_LMFMA != 0 && ATTN_NEGM != 0) { lacc = __builtin_amdgcn_mfma_f32_32x32x16_bf16(a0_, ones8, lacc, 0, 0, 0); lacc = __builtin_amdgcn_mfma_f32_32x32x16_bf16(a1_, ones8, lacc, 0, 0, 0); \
      lacc = __builtin_amdgcn_mfma_f32_32x32x16_bf16(a2_, ones8, lacc, 0, 0, 0); lacc = __builtin_amdgcn_mfma_f32_32x32x16_bf16(a3_, ones8, lacc, 0, 0, 0); } } } while (0)
#define QKT(p0_, p1_, K_, q_, r_, h_) do { if constexpr (VAR == 5) { asm volatile("" : "+v"(p0_), "+v"(p1_)); } else { if constexpr (ATTN_NEGM != 0) qkt_n(p0_, p1_, K_, q_, negm, r_, h_); else qkt(p0_, p1_, K_, q_, r_, h_); } } while (0)
#define LSLOAD(i_, k_) do { if constexpr (VAR != 3) SLOAD(i_, k_); } while (0)
#define LSWRITE(b_, i_) do { if constexpr (VAR != 3) SWRITE(b_, i_); } while (0)
#define LSYNC() do { if constexpr (VAR != 4) __syncthreads(); } while (0)
#if ATTN_STAG
  const bool lead = __builtin_amdgcn_readfirstlane(wid) < 4;
  SLOAD(SE, 0); asm volatile("s_waitcnt vmcnt(0)" ::: "memory"); SWRITE(0, SE); __syncthreads();
  QKT(pA0, pA1, K_lds, qr, r32, hi);
  SLOAD(SE, KVBLK);
  if (lead) partialSM_n<true>(pA0, pA1, negm, alA);
  SWRITE(1, SE); __syncthreads();
  LSLOAD(SE, 2 * KVBLK);
  if (lead) { SBAR(); QKT(pB0, pB1, K_lds + 1 * SHM_K, qr, r32, hi); FSM(pA0, pA1, mnA, alA, l_reg, pa0, pa1, pa2, pa3); SBAR();
      PVD(o, vb0 + 0 * SHM_V, pa0, pa1, pa2, pa3); PSM(pB0, pB1, m_reg, mnB, alB); }
  else { partialSM_n<true>(pA0, pA1, negm, alA);
      SBAR(); QKT(pB0, pB1, K_lds + 1 * SHM_K, qr, r32, hi); FSM(pA0, pA1, mnA, alA, l_reg, pa0, pa1, pa2, pa3); SBAR(); }
  LSWRITE(2, SE); if (lead) RESC(alB); LSYNC();
  for (int j = 2; j < NT; j += 2) {
    if (j + 1 < NT) LSLOAD(SE, (j + 1) * KVBLK);
    if (lead) { SBAR(); QKT(pA0, pA1, K_lds + (j & 3) * SHM_K, qr, r32, hi); FSM(pB0, pB1, mnB, alB, l_reg, pa0, pa1, pa2, pa3); SBAR();
        PVD(o, vb0 + ((j - 1) & 3) * SHM_V, pa0, pa1, pa2, pa3); PSM(pA0, pA1, m_reg, mnA, alA); }
    else { PVD(o, vb0 + ((j - 2) & 3) * SHM_V, pa0, pa1, pa2, pa3); PSM(pB0, pB1, m_reg, mnB, alB); RESC(alB);
        SBAR(); QKT(pA0, pA1, K_lds + (j & 3) * SHM_K, qr, r32, hi); FSM(pB0, pB1, mnB, alB, l_reg, pa0, pa1, pa2, pa3); SBAR(); }
    if (j + 1 < NT) LSWRITE((j + 1) & 3, SE);
    if (lead) RESC(alA);
    LSYNC();
    if (j + 2 < NT) LSLOAD(SE, (j + 2) * KVBLK);
    if (lead) { SBAR(); QKT(pB0, pB1, K_lds + ((j + 1) & 3) * SHM_K, qr, r32, hi); FSM(pA0, pA1, mnA, alA, l_reg, pa0, pa1, pa2, pa3); SBAR();
        PVD(o, vb0 + (j & 3) * SHM_V, pa0, pa1, pa2, pa3); PSM(pB0, pB1, m_reg, mnB, alB); }
    else { PVD(o, vb0 + ((j - 1) & 3) * SHM_V, pa0, pa1, pa2, pa3); PSM(pA0, pA1, m_reg, mnA, alA); RESC(alA);
        SBAR(); QKT(pB0, pB1, K_lds + ((j + 1) & 3) * SHM_K, qr, r32, hi); FSM(pA0, pA1, mnA, alA, l_reg, pa0, pa1, pa2, pa3); SBAR(); }
    if (j + 2 < NT) LSWRITE((j + 2) & 3, SE);
    if (lead) RESC(alB);
    LSYNC();
  }
  if (!lead) { PVD(o, vb0 + ((NT - 2) & 3) * SHM_V, pa0, pa1, pa2, pa3); PSM(pB0, pB1, m_reg, mnB, alB); RESC(alB); }
  FSM(pB0, pB1, mnB, alB, l_reg, pa0, pa1, pa2, pa3); SBAR();
  PVD(o, vb0 + ((NT - 1) & 3) * SHM_V, pa0, pa1, pa2, pa3);
#elif ATTN_LAG2
  bf16x8 pb0, pb1, pb2, pb3;
  SLOAD(SE, 0); asm volatile("s_waitcnt vmcnt(0)" ::: "memory"); SWRITE(0, SE); __syncthreads();
  QKT(pA0, pA1, K_lds, qr, r32, hi);
#if ATTN_NEGM
  partialSM_n<true>(pA0, pA1, negm, alA);
#else
  PSM(pA0, pA1, m_reg, mnA, alA);
#endif
  SLOAD(SO, KVBLK); if (2 < NT) SLOAD(SE, 2 * KVBLK);
  SWRITE(1, SO); __syncthreads();
  SBAR(); QKT(pB0, pB1, K_lds + 1 * SHM_K, qr, r32, hi);
  FSM(pA0, pA1, mnA, alA, l_reg, pb0, pb1, pb2, pb3); SBAR();
  if (3 < NT) LSLOAD(SO, 3 * KVBLK); SBAR();
  PSM(pB0, pB1, m_reg, mnB, alB);
  LSWRITE(2, SE); LSYNC();
  for (int j = 2; j < NT; j += 2) {
    SBAR(); QKT(pA0, pA1, K_lds + (j & 3) * SHM_K, qr, r32, hi);
    FSM(pB0, pB1, mnB, alB, l_reg, pa0, pa1, pa2, pa3);
    PVD(o, vb0 + ((j - 2) & 3) * SHM_V, pb0, pb1, pb2, pb3); SBAR();
    if (j + 2 < NT) LSLOAD(SE, (j + 2) * KVBLK); SBAR();
    RESC(alB); PSM(pA0, pA1, m_reg, mnA, alA);
    if (j + 1 < NT) LSWRITE((j + 1) & 3, SO);
    LSYNC();
    SBAR(); QKT(pB0, pB1, K_lds + ((j + 1) & 3) * SHM_K, qr, r32, hi);
    FSM(pA0, pA1, mnA, alA, l_reg, pb0, pb1, pb2, pb3);
    PVD(o, vb0 + ((j - 1) & 3) * SHM_V, pa0, pa1, pa2, pa3); SBAR();
    if (j + 3 < NT) LSLOAD(SO, (j + 3) * KVBLK); SBAR();
    RESC(alA); PSM(pB0, pB1, m_reg, mnB, alB);
    if (j + 2 < NT) LSWRITE((j + 2) & 3, SE);
    LSYNC();
  }
  PVD(o, vb0 + ((NT - 2) & 3) * SHM_V, pb0, pb1, pb2, pb3);
  RESC(alB);
  FSM(pB0, pB1, mnB, alB, l_reg, pa0, pa1, pa2, pa3); SBAR();
  PVD(o, vb0 + ((NT - 1) & 3) * SHM_V, pa0, pa1, pa2, pa3);
#else
  int bp = 0, bc = 1, bn = 2;
#define ROT3() do { const int t_ = bp; bp = bc; bc = bn; bn = t_; } while (0)
  SLOAD(SE, 0); asm volatile("s_waitcnt vmcnt(0)" ::: "memory"); SWRITE(0, SE); __syncthreads();
  QKT(pA0, pA1, K_lds, qr, r32, hi);
#if ATTN_NEGM
  partialSM_n<true>(pA0, pA1, negm, alA);
#else
  PSM(pA0, pA1, m_reg, mnA, alA);
#endif
  SLOAD(SO, KVBLK); if (2 < NT) SLOAD(SE, 2 * KVBLK);
  SWRITE(1, SO); __syncthreads();
  for (int j = 1; j + 1 < NT; j += 2) {
    SBAR(); QKT(pB0, pB1, K_lds + bc * SHM_K, qr, r32, hi);
    FSM(pA0, pA1, mnA, alA, l_reg, pa0, pa1, pa2, pa3); SBAR();
    LSLOAD(SO, (j + 2) * KVBLK); SBAR();
    PVSM(o, vb0 + bp * SHM_V, pa0, pa1, pa2, pa3, pB0, pB1, m_reg, mnB, alB);
    LSWRITE(bn, SE); SBAR();
    bg.collect(true); bg.issue(); SBAR();
    RESC(alB); LSYNC(); ROT3();
    SBAR(); QKT(pA0, pA1, K_lds + bc * SHM_K, qr, r32, hi);
    FSM(pB0, pB1, mnB, alB, l_reg, pa0, pa1, pa2, pa3); SBAR();
    if (j + 3 < NT) LSLOAD(SE, (j + 3) * KVBLK); SBAR();
    PVSM(o, vb0 + bp * SHM_V, pa0, pa1, pa2, pa3, pA0, pA1, m_reg, mnA, alA);
    LSWRITE(bn, SO); SBAR();
    bg.collect(true); bg.issue(); SBAR();
    RESC(alA); LSYNC(); ROT3();
  }
  SBAR(); QKT(pB0, pB1, K_lds + bc * SHM_K, qr, r32, hi);
  FSM(pA0, pA1, mnA, alA, l_reg, pa0, pa1, pa2, pa3); SBAR();
  PVSM(o, vb0 + bp * SHM_V, pa0, pa1, pa2, pa3, pB0, pB1, m_reg, mnB, alB);
  RESC(alB);
  FSM(pB0, pB1, mnB, alB, l_reg, pa0, pa1, pa2, pa3); SBAR();
  PVD(o, vb0 + bc * SHM_V, pa0, pa1, pa2, pa3);
#undef ROT3
#endif
  float rli[16];
  if constexpr (ATTN_LMFMA != 0 && ATTN_NEGM != 0 && !ATTN_STAG && !ATTN_LAG2) {
#pragma unroll
    for (int r = 0; r < 16; ++r) rli[r] = __builtin_amdgcn_rcpf(lacc[r]);
  } else {
    if (hi == 0) li_l[r32] = l_reg; asm volatile("s_waitcnt lgkmcnt(0)" ::: "memory");
#pragma unroll
    for (int r = 0; r < 16; ++r) rli[r] = __builtin_amdgcn_rcpf(li_l[crow(r, hi)]); }
#pragma unroll
  for (int r = 0; r < 16; ++r) { const int orow = wid * QBLK + crow(r, hi);
#pragma unroll
    for (int d0 = 0; d0 < 2; ++d0) OUT(orow, d0 * 32 + r32, o[d0][r] * rli[r]); }
  __syncthreads();
#undef SLOAD
#undef SWRITE
#undef RESC
#undef PSM
#undef PVSM
#undef FSM
#undef PVD
#undef QKT
#undef LSLOAD
#undef LSWRITE
#undef LSYNC
}
#undef KSWZ
#undef SBAR
}
struct Q2 {
    bf16* U16;
    bf16 *WtL;
    bf16 *WtM;
    bf16 *WtG;
    float *LSL;
    bf16 *HLOC, *PCUM;
    float *SA, *SB;
    bf16 *QN16, *KVN16;
    bf16 *Q16;
    bf16 *WtKvbP;
    bf16 *XCM16, *QKV16;
    float *GATES;
    float *CLOC, *NLOC, *MLB;
    bf16 *CST; float *NST, *MST;
    bf16 *YB16;
    float *GLIST;
};
constexpr int NCH = TPB / 128;
constexpr int NCH_CTX = CTX / 128;

__device__ __forceinline__ float wave_sum(float v) {
#pragma unroll
    for (int o = 1; o < 64; o <<= 1) v += __shfl_xor(v, o);
    return v;
}
__device__ __forceinline__ float fast_sigmoid(float x) { return __builtin_amdgcn_rcpf(1.f + __expf(-x)); }
__device__ __forceinline__ float fast_silu(float x) { return x * fast_sigmoid(x); }
__device__ __forceinline__ float fast_gelu(float x) { const float u = 0.7978845608028654f * (x + 0.044715f * x * x * x); return x * fast_sigmoid(2.f * u); }

struct EpiU16 {
    static constexpr bool PERM = true; bf16* U;
    __device__ __forceinline__ void operator()(const pg8::f32x4 (&acc)[2][2][4][2], const pg8::Unit& u, int wr, int wc, int fr, int fq) const {
#pragma unroll
        for (int ai = 0; ai < 2; ++ai)
#pragma unroll
            for (int m = 0; m < 4; ++m) { const int row = u.pm * 256 + ai * 128 + wr * 64 + m * 16 + fr;
#pragma unroll
                for (int bj = 0; bj < 2; ++bj) { const int c = u.pn * 256 + bj * 128 + wc * 32 + 8 * fq; const pg8::f32x4 v0 = acc[ai][bj][m][0], v1 = acc[ai][bj][m][1];
                    u32x4 w; w.x = pg8::cvt_pk_bf16(v0[0], v0[1]); w.y = pg8::cvt_pk_bf16(v0[2], v0[3]); w.z = pg8::cvt_pk_bf16(v1[0], v1[1]); w.w = pg8::cvt_pk_bf16(v1[2], v1[3]);
                    *(u32x4*)(U + (size_t)row * DINP + c) = w; } }
    }
};
__device__ __forceinline__ void opt_inproj16(const Q& q, const Q2& q2, int l, LAS unsigned char* lds, int G, int bid) {
    pg8::Gemm g{q.H16, q.WtIn + (size_t)l * DINP * D, D}; pg8::StaticOrder S; S.init(NT, DINP, G, bid);
    EpiU16 E{q2.U16}; pg8::gemm_phase<EpiU16, pg8::StaticOrder, true>(lds, g, S, E);
}

__device__ __forceinline__ void opt_convert_small(const P& p, const Q2& q2, long gtid, long nthr) {
    for (long it = gtid; it < (long)DEPTH * 4 * 256 * 64; it += nthr) { const int i = (int)(it & 63), n = (int)((it >> 6) & 255), g = (int)((it >> 14) & 3), l = (int)(it >> 16);
        const int d = n >> 7, gate = (n >> 6) & 1, j = n & 63; const float* w = (gate ? p.in[I_LWX] : p.in[I_LWA]) + ((((size_t)l * 2 + d) * 4 + g) * 64 + i) * 64 + j;
        q2.WtL[it] = (bf16)f2bf(*w); }
    for (long it = gtid; it < (long)DEPTH * 4 * 3 * 64 * 64; it += nthr) { const int i = (int)(it & 63), j = (int)((it >> 6) & 63), m = (int)((it >> 12) % 3), h = (int)((it / (3 * 4096)) & 3), l = (int)(it / (12 * 4096));
        const float* w = (m == 0 ? p.in[I_MWQ] : (m == 1 ? p.in[I_MWK] : p.in[I_MWV])) + (((size_t)l * 4 + h) * 64 + i) * 64 + j;
        q2.WtM[it] = (bf16)f2bf(*w * (m == 1 ? 0.125f : 1.f)); }
    for (long it = gtid; it < (long)DEPTH * 32 * 768; it += nthr) { const int i = (int)(it % 768), n = (int)((it / 768) & 31), l = (int)(it / (32 * 768));
        q2.WtG[it] = n < 16 ? (bf16)f2bf(p.in[I_MWG][((((size_t)l * 2 + (n >> 3)) * 768) + i) * 8 + (n & 7)]) : (bf16)0; }
    for (long it = gtid; it < (long)DEPTH * 2 * 256; it += nthr) q2.LSL[it] = logsigmoid_f(p.in[I_LLAM][it]);
}

constexpr int MOD_FIRST_ITEMS = 2 * D / 64;
__device__ __forceinline__ void opt_init_mod(const P& p, char* lds, int bid, int G, unsigned* rdy = nullptr) {
    int tid_ = TIDX; asm volatile("" : "+v"(tid_));
    const int tid = tid_; float* SC = (float*)lds; float* RED = (float*)(lds + 12288);
    for (int i = tid; i < 3 * D; i += 512) { const int cv = i / D, k = i % D; const float x = cv < 2 ? p.in[I_C][cv * D + k] : p.in[I_CCTX][k]; SC[i] = x / (1.f + __expf(-x)); }
    __syncthreads();
    for (int it = bid; it < DEPTH * 6 * D / 64; it += G) { const int l = it / (6 * D / 64), j = (it % (6 * D / 64)) * 64 + (tid & 63), kq = tid >> 6;
        const float* w = p.in[I_WMOD] + (size_t)l * D * 6 * D + (size_t)(128 * kq) * 6 * D + j; float a0 = 0.f, a1 = 0.f, a2 = 0.f;
#pragma unroll 1
        for (int k0 = 0; k0 < 128; k0 += 32) { float wv[32];
#pragma unroll
            for (int k = 0; k < 32; ++k) wv[k] = __builtin_nontemporal_load(w + (size_t)(k0 + k) * 6 * D);
#pragma unroll
            for (int k = 0; k < 32; ++k) { a0 += SC[128 * kq + k0 + k] * wv[k]; a1 += SC[D + 128 * kq + k0 + k] * wv[k]; a2 += SC[2 * D + 128 * kq + k0 + k] * wv[k]; } }
        RED[(kq * 3 + 0) * 64 + (tid & 63)] = a0; RED[(kq * 3 + 1) * 64 + (tid & 63)] = a1; RED[(kq * 3 + 2) * 64 + (tid & 63)] = a2;
        __syncthreads();
        if (tid < 192) { const int cv = tid >> 6, jj = tid & 63; float sacc = p.in[I_BMOD][(size_t)l * 6 * D + (it % (6 * D / 64)) * 64 + jj];
#pragma unroll
            for (int x = 0; x < 8; ++x) sacc += RED[(x * 3 + cv) * 64 + jj];
            p.MOD[((size_t)l * 3 + cv) * 6 * D + (it % (6 * D / 64)) * 64 + jj] = sacc; }
        if (rdy != nullptr && it < MOD_FIRST_ITEMS) asm volatile("s_waitcnt vmcnt(0)" ::: "memory");
        __syncthreads();
        if (rdy != nullptr && it < MOD_FIRST_ITEMS && tid == 0) { __builtin_amdgcn_fence(__ATOMIC_RELEASE, "agent"); asm volatile("s_waitcnt vmcnt(0)" ::: "memory");
            __hip_atomic_fetch_add(rdy, 1u, __ATOMIC_RELAXED, __HIP_MEMORY_SCOPE_AGENT); } }
}
__device__ __forceinline__ void opt_init_rope(const P& p, long gtid, long nthr) {
    for (long it = gtid; it < (long)SEQ * 16; it += nthr) { const int s = (int)(it / 16), a = (int)((it / 8) & 1), f = (int)(it & 7); const int pos = a == 0 ? s / GRID_W : s % GRID_W;
        const float frf = f == 0 ? 1.f : f == 1 ? 0.31622776601683794f : f == 2 ? 0.1f : f == 3 ? 0.031622776601683791f : f == 4 ? 0.01f : f == 5 ? 0.0031622776601683794f : f == 6 ? 0.001f : 0.00031622776601683794f;
        const float ang = (float)pos * frf; float sn, cs; sincosf(ang, &sn, &cs);
        p.ROPET[it * 2] = cs; p.ROPET[it * 2 + 1] = sn; }
}

template <int KS, class TA, class TB>
__device__ __forceinline__ void wave_mm32(att::f32x16& acc, const TA* A, int lda, const TB* B, int ldb, int r32, int hi) {
#pragma unroll
    for (int ks = 0; ks < KS; ++ks) {
        const att::bf16x8 a = *reinterpret_cast<const att::bf16x8*>(A + (size_t)r32 * lda + ks * 16 + hi * 8);
        const att::bf16x8 b = *reinterpret_cast<const att::bf16x8*>(B + (size_t)r32 * ldb + ks * 16 + hi * 8);
        acc = __builtin_amdgcn_mfma_f32_32x32x16_bf16(a, b, acc, 0, 0, 0);
    }
}

__device__ __forceinline__ void conv4_2x8(const bf16* Ucol  , const float* cw  , const float* cbp, int ta, int seg_lo, int seg_hi,
                                          float (&xin)[5][8], float (&out)[2][8]) {
    u32x4 raw[5];
#pragma unroll
    for (int r = 0; r < 5; ++r) { const int t = ta - 2 + r; raw[r] = (t >= seg_lo && t < seg_hi) ? *(const u32x4*)(Ucol + (size_t)t * DINP) : (u32x4){0u, 0u, 0u, 0u}; }
    float w[4][8], cb[8];
#pragma unroll
    for (int k = 0; k < 4; ++k) { const f32x4 a = *(const f32x4*)(cw + k * 256), b = *(const f32x4*)(cw + k * 256 + 4); w[k][0] = a.x; w[k][1] = a.y; w[k][2] = a.z; w[k][3] = a.w; w[k][4] = b.x; w[k][5] = b.y; w[k][6] = b.z; w[k][7] = b.w; }
    { const f32x4 a = *(const f32x4*)cbp, b = *(const f32x4*)(cbp + 4); cb[0] = a.x; cb[1] = a.y; cb[2] = a.z; cb[3] = a.w; cb[4] = b.x; cb[5] = b.y; cb[6] = b.z; cb[7] = b.w; }
#pragma unroll
    for (int r = 0; r < 5; ++r)
#pragma unroll
        for (int e = 0; e < 8; ++e) { const unsigned wd = raw[r][e >> 1]; xin[r][e] = __builtin_bit_cast(float, (e & 1) ? (wd & 0xffff0000u) : (wd << 16)); }
#pragma unroll
    for (int q = 0; q < 2; ++q)
#pragma unroll
        for (int e = 0; e < 8; ++e) out[q][e] = cb[e] + w[0][e] * xin[q][e] + w[1][e] * xin[q + 1][e] + w[2][e] * xin[q + 2][e] + w[3][e] * xin[q + 3][e];
}
constexpr int LRU1_LDS = 18432 + 65536 + 4096;
template <class UL>
__device__ __forceinline__ void lru1_item(const P& p, const Q2& q2, int l, int b, int ch, int g, char* lds, const UL& U) {
    int tid_ = TIDX; asm volatile("" : "+v"(tid_));
    const int tid = tid_, wave = tid >> 6, lane = tid & 63, r32 = lane & 31, hi = lane >> 5;
    unsigned short* XC16 = (unsigned short*)lds; float* AB = (float*)(lds + 18432); float* CMP = (float*)(lds + 18432 + 65536);
    const int t0 = b * TPB + ch * 128, seg_lo = ch < NCH_CTX ? b * TPB : b * TPB + CTX, seg_hi = ch < NCH_CTX ? b * TPB + CTX : (b + 1) * TPB;
    { const int c8 = tid & 7, tg = tid >> 3, c = g * 64 + c8 * 8; float xin[5][8], out[2][8];
      conv4_2x8(U.U + OFF_AX + c, p.in[I_LCW] + (size_t)l * 4 * 256 + c, p.in[I_LCB] + (size_t)l * 256 + c, t0 + 2 * tg, seg_lo, seg_hi, xin, out);
#pragma unroll
      for (int q = 0; q < 2; ++q) { u32x4 w; w.x = pk2(out[q][0], out[q][1]); w.y = pk2(out[q][2], out[q][3]); w.z = pk2(out[q][4], out[q][5]); w.w = pk2(out[q][6], out[q][7]);
          *(u32x4*)(XC16 + (2 * tg + q) * 72 + c8 * 8) = w; } }
    __syncthreads();
    const bf16* Wt = q2.WtL + ((size_t)l * 4 + g) * 256 * 64;
#pragma unroll 1
    for (int d = 0; d < 2; ++d) {
        const int rt = wave & 3, cj = wave >> 2; att::f32x16 ar = {}, ai = {};
        wave_mm32<4>(ar, XC16 + rt * 32 * 72, 72, Wt + (size_t)(d * 128 + cj * 32) * 64, 64, r32, hi);
        wave_mm32<4>(ai, XC16 + rt * 32 * 72, 72, Wt + (size_t)(d * 128 + 64 + cj * 32) * 64, 64, r32, hi);
        { const int j = cj * 32 + r32, c = g * 64 + j; const float ba = p.in[I_LBA][((size_t)l * 2 + d) * 256 + c], bx = p.in[I_LBX][((size_t)l * 2 + d) * 256 + c], lsl = q2.LSL[((size_t)l * 2 + d) * 256 + c];
#pragma unroll
          for (int r = 0; r < 16; ++r) { const int tt = rt * 32 + att::crow(r, hi); const float rg = fast_sigmoid(ar[r] + ba), ig = fast_sigmoid(ai[r] + bx), la = 8.f * rg * lsl, a = __expf(la);
              const float xc = bf2f(XC16[tt * 72 + j]); const float bb = sqrtf(fmaxf(1.f - a * a, 0.f)) * ig * xc;
              AB[(tt * 64 + j) * 2] = a; AB[(tt * 64 + j) * 2 + 1] = bb; } }
        __syncthreads();
        { const int j = tid & 63, sg = tid >> 6; float av[16], bv[16]; float A = 1.f, B = 0.f;
#pragma unroll
          for (int i = 0; i < 16; ++i) { const int s = sg * 16 + i, tt = d == 0 ? s : 127 - s; av[i] = AB[(tt * 64 + j) * 2]; bv[i] = AB[(tt * 64 + j) * 2 + 1]; B = av[i] * B + bv[i]; A *= av[i]; }
          CMP[(sg * 64 + j) * 2] = A; CMP[(sg * 64 + j) * 2 + 1] = B;
          __syncthreads();
          float cA = 1.f, cB = 0.f;
          for (int x = 0; x < sg; ++x) { const float xa = CMP[(x * 64 + j) * 2], xb = CMP[(x * 64 + j) * 2 + 1]; cB = xa * cB + xb; cA *= xa; }
          const int c = g * 64 + j; float h = cB, pc = cA;
          unsigned short* OUTS = (unsigned short*)AB;
#pragma unroll
          for (int i = 0; i < 16; ++i) { const int s = sg * 16 + i, tt = d == 0 ? s : 127 - s; h = av[i] * h + bv[i]; pc *= av[i];
              OUTS[tt * 64 + j] = (unsigned short)f2bf(h); OUTS[(128 + tt) * 64 + j] = (unsigned short)f2bf(pc); }
          if (sg == 7) { q2.SA[(((size_t)d * NB + b) * NCH + ch) * 256 + c] = pc; q2.SB[(((size_t)d * NB + b) * NCH + ch) * 256 + c] = h; }
          __syncthreads();
#pragma unroll
          for (int k = 0; k < 4; ++k) { const int x = tid + k * 512, arr = x >> 10, tt = (x >> 3) & 127, c8 = x & 7; const u32x4 v = *(const u32x4*)(OUTS + (arr * 128 + tt) * 64 + c8 * 8);
              *(u32x4*)((arr ? q2.PCUM : q2.HLOC) + ((size_t)d * NT + t0 + tt) * 256 + g * 64 + c8 * 8) = v; } }
        __syncthreads();
    }
}
__device__ __forceinline__ void lru2_item(const Q2& q2, bf16* Yp, int b, int ch, char* lds) {
    int tid_ = TIDX; asm volatile("" : "+v"(tid_));
    const int tid = tid_; float* CAR = (float*)lds;
    { const int d = tid >> 8, c = tid & 255; float h = 0.f;
      const bool isctx = ch < NCH_CTX; const int n = d == 0 ? ch : (isctx ? NCH_CTX - 1 - ch : NCH_CTX + (NCH - 1 - ch));
      const float* SAp = q2.SA + (((size_t)d * NB + b) * NCH) * 256 + c; const float* SBp = q2.SB + (((size_t)d * NB + b) * NCH) * 256 + c;
#pragma unroll 1
      for (int i0 = 0; i0 < n; i0 += 16) { float sa[16], sb[16];
#pragma unroll
          for (int x = 0; x < 16; ++x) { const int i = i0 + x; const int j = d == 0 ? i : (i < (isctx ? n : NCH_CTX) ? NCH_CTX - 1 - i : NCH - 1 - (i - NCH_CTX));
              const bool ok = i < n; sa[x] = ok ? SAp[(size_t)j * 256] : 1.f; sb[x] = ok ? SBp[(size_t)j * 256] : 0.f; }
#pragma unroll
          for (int x = 0; x < 16; ++x) h = sa[x] * h + sb[x]; }
      CAR[tid] = h; }
    __syncthreads();
    const int t0 = b * TPB + ch * 128;
#pragma unroll 1
    for (int k0 = 0; k0 < 8; k0 += 4) { u32x4 hf[4], pf[4], hb[4], pb[4], ag[4];
#pragma unroll
        for (int kk = 0; kk < 4; ++kk) { const int x = tid + (k0 + kk) * 512, tt = x >> 5, c0 = (x & 31) * 8, t = t0 + tt;
            hf[kk] = *(const u32x4*)(q2.HLOC + (size_t)t * 256 + c0); pf[kk] = *(const u32x4*)(q2.PCUM + (size_t)t * 256 + c0); hb[kk] = *(const u32x4*)(q2.HLOC + ((size_t)NT + t) * 256 + c0); pb[kk] = *(const u32x4*)(q2.PCUM + ((size_t)NT + t) * 256 + c0);
            ag[kk] = *(const u32x4*)(q2.U16 + (size_t)t * DINP + OFF_AG + c0); }
#pragma unroll
        for (int kk = 0; kk < 4; ++kk) { const int x = tid + (k0 + kk) * 512, tt = x >> 5, c0 = (x & 31) * 8, t = t0 + tt; u32x4 o;
#pragma unroll
            for (int w = 0; w < 4; ++w) { float y[2];
#pragma unroll
                for (int e = 0; e < 2; ++e) { const int c = c0 + 2 * w + e;
                    const float h0 = __builtin_bit_cast(float, e ? (hf[kk][w] & 0xffff0000u) : (hf[kk][w] << 16)), p0 = __builtin_bit_cast(float, e ? (pf[kk][w] & 0xffff0000u) : (pf[kk][w] << 16));
                    const float h1 = __builtin_bit_cast(float, e ? (hb[kk][w] & 0xffff0000u) : (hb[kk][w] << 16)), p1 = __builtin_bit_cast(float, e ? (pb[kk][w] & 0xffff0000u) : (pb[kk][w] << 16));
                    const float a_ = __builtin_bit_cast(float, e ? (ag[kk][w] & 0xffff0000u) : (ag[kk][w] << 16));
                    y[e] = ((h0 + p0 * CAR[c]) + (h1 + p1 * CAR[256 + c])) * fast_gelu(a_); }
                o[w] = pk2(y[0], y[1]); }
            *(u32x4*)(Yp + (size_t)t * DMIX + c0) = o; } }
    __syncthreads();
}

template <int NTOK, class UL>
__device__ __forceinline__ void mla_prep_tokens(const P& p, const Q& q, const Q2& q2, int l, const int (&tt)[NTOK], int lane, const UL& U) {
    float xq[NTOK][4], xk[NTOK][2], me[NTOK][4], ot[NTOK][4], cs[NTOK][4], sn[NTOK][4];
    const int d0 = (lane & 7) * 4, h = lane >> 3;
#pragma unroll
    for (int k = 0; k < NTOK; ++k) { const int t = tt[k]; const int key = t % TPB; const bool lat = key >= CTX; const int s = key - CTX;
        { const bf16* Ur = U.U + (size_t)t * DINP; const u32x2 wq = *(const u32x2*)(Ur + OFF_BQ + lane * 4); const unsigned wk = *(const unsigned*)(Ur + OFF_BKV + lane * 2);
          const u32x2 wm = *(const u32x2*)(Ur + OFF_BKR + d0), wo = *(const u32x2*)(Ur + OFF_BKR + (d0 ^ 8));
          xq[k][0] = __builtin_bit_cast(float, wq.x << 16); xq[k][1] = __builtin_bit_cast(float, wq.x & 0xffff0000u); xq[k][2] = __builtin_bit_cast(float, wq.y << 16); xq[k][3] = __builtin_bit_cast(float, wq.y & 0xffff0000u);
          xk[k][0] = __builtin_bit_cast(float, wk << 16); xk[k][1] = __builtin_bit_cast(float, wk & 0xffff0000u);
          me[k][0] = __builtin_bit_cast(float, wm.x << 16); me[k][1] = __builtin_bit_cast(float, wm.x & 0xffff0000u); me[k][2] = __builtin_bit_cast(float, wm.y << 16); me[k][3] = __builtin_bit_cast(float, wm.y & 0xffff0000u);
          ot[k][0] = __builtin_bit_cast(float, wo.x << 16); ot[k][1] = __builtin_bit_cast(float, wo.x & 0xffff0000u); ot[k][2] = __builtin_bit_cast(float, wo.y << 16); ot[k][3] = __builtin_bit_cast(float, wo.y & 0xffff0000u);
#pragma unroll
          for (int i = 0; i < 4; ++i) { cs[k][i] = 1.f; sn[k][i] = 0.f; }
          if (lat) { const int a = d0 >> 4, f = d0 & 7; const float* rp = p.ROPET + (((size_t)s * 2 + a) * 8 + f) * 2; const f32x4 r0 = *(const f32x4*)rp, r1 = *(const f32x4*)(rp + 4);
              cs[k][0] = r0.x; sn[k][0] = r0.y; cs[k][1] = r0.z; sn[k][1] = r0.w; cs[k][2] = r1.x; sn[k][2] = r1.y; cs[k][3] = r1.z; sn[k][3] = r1.w; } } }
    const float* gq = p.in[I_QNG] + (size_t)l * QRANK + lane * 4; const float* gk = p.in[I_KVNG] + (size_t)l * KVRANK + lane * 2;
    const float gq0 = gq[0], gq1 = gq[1], gq2 = gq[2], gq3 = gq[3], gk0 = gk[0], gk1 = gk[1];
#pragma unroll
    for (int k = 0; k < NTOK; ++k) { const int t = tt[k]; float sq = 0.f, sk = 0.f;
#pragma unroll
        for (int i = 0; i < 4; ++i) sq += xq[k][i] * xq[k][i];
#pragma unroll
        for (int i = 0; i < 2; ++i) sk += xk[k][i] * xk[k][i];
        sq = wave_sum(sq); sk = wave_sum(sk);
        const float rq = 1.f / sqrtf(sq * (1.f / QRANK) + EPS), rk = 1.f / sqrtf(sk * (1.f / KVRANK) + EPS);
        u32x2 wq; wq.x = pk2(xq[k][0] * rq * gq0, xq[k][1] * rq * gq1); wq.y = pk2(xq[k][2] * rq * gq2, xq[k][3] * rq * gq3);
        *(u32x2*)(q2.QN16 + (size_t)t * 256 + lane * 4) = wq;
        *(unsigned*)(q2.KVN16 + (size_t)t * 256 + lane * 2) = pk2(xk[k][0] * rk * gk0, xk[k][1] * rk * gk1);
        *(unsigned*)(q2.KVN16 + (size_t)t * 256 + 128 + lane * 2) = 0u;
        const int b = t / TPB, key = t % TPB; float o[4];
#pragma unroll
        for (int i = 0; i < 4; ++i) { const int half = ((d0 + i) >> 3) & 1; o[i] = half == 0 ? me[k][i] * cs[k][i] - ot[k][i] * sn[k][i] : me[k][i] * cs[k][i] + ot[k][i] * sn[k][i]; }
        u32x2 wk; wk.x = pk2(o[0], o[1]); wk.y = pk2(o[2], o[3]);
        *(u32x2*)(q.K16 + (((size_t)b * AH + h) * TPB + key) * QKD + NOPE + d0) = wk; }
}
template <class UL>
__device__ __forceinline__ void mla_prep_token(const P& p, const Q& q, const Q2& q2, int l, int t, int lane, const UL& U) { const int tt[1] = {t}; mla_prep_tokens<1>(p, q, q2, l, tt, lane, U); }

struct EpiQproj {
    static constexpr bool PERM = true; bf16* Q16; const float* ROPET;
    __device__ __forceinline__ void operator()(const pg8::f32x4 (&acc)[2][2][4][2], const pg8::Unit& u, int wr, int wc, int fr, int fq) const {
#pragma unroll
        for (int bj = 0; bj < 2; ++bj) { const int blk = u.pn * 8 + bj * 4 + wc; const bool rope = (blk % 3) == 2; const int c = blk * 32 + 8 * fq;
            const int key0 = (u.pm % (TPB / 256)) * 256 + wr * 64 + fr, a = fq >> 1; f32x4 tcur[4], tnxt[4];
            auto tload = [&](f32x4 (&tv)[4], int idx) { const int key = key0 + (idx >> 2) * 128 + (idx & 3) * 16; const int s = key >= CTX ? key - CTX : 0; const f32x4* tb = (const f32x4*)(ROPET + ((size_t)s * 2 + a) * 16);
#pragma unroll
                for (int k = 0; k < 4; ++k) tv[k] = tb[k]; };
            if (rope) tload(tcur, 0);
#pragma unroll
            for (int idx = 0; idx < 8; ++idx) { const int ai = idx >> 2, m = idx & 3; const int row = u.pm * 256 + ai * 128 + wr * 64 + m * 16 + fr; float v[8];
#pragma unroll
                for (int x = 0; x < 4; ++x) { v[x] = acc[ai][bj][m][0][x]; v[4 + x] = acc[ai][bj][m][1][x]; }
                if (rope) {
                    if (idx + 1 < 8) tload(tnxt, idx + 1);
                    const int key = key0 + ai * 128 + m * 16; const bool lat = key >= CTX;
#pragma unroll
                    for (int x = 0; x < 8; ++x) { const float other = __shfl_xor(v[x], 16); const float cs = lat ? tcur[x >> 1][(x & 1) * 2] : 1.f, sn = lat ? tcur[x >> 1][(x & 1) * 2 + 1] : 0.f;
                        v[x] = (fq & 1) == 0 ? v[x] * cs - other * sn : v[x] * cs + other * sn; }
                    if (idx + 1 < 8) {
#pragma unroll
                        for (int k = 0; k < 4; ++k) tcur[k] = tnxt[k]; } }
#pragma unroll
                for (int x = 0; x < 8; ++x) v[x] *= att::QPRESCALE;
                u32x4 w; w.x = pg8::cvt_pk_bf16(v[0], v[1]); w.y = pg8::cvt_pk_bf16(v[2], v[3]); w.z = pg8::cvt_pk_bf16(v[4], v[5]); w.w = pg8::cvt_pk_bf16(v[6], v[7]);
                *(u32x4*)(Q16 + (size_t)row * 768 + c) = w; asm volatile("" ::: "memory"); } }
    }
};
struct EpiKVproj {
    static constexpr bool PERM = true; bf16* K16; bf16* V16;
    __device__ __forceinline__ void operator()(const pg8::f32x4 (&acc)[2][2][4][2], const pg8::Unit& u, int wr, int wc, int fr, int fq) const {
#pragma unroll
        for (int bj = 0; bj < 2; ++bj) { const int h = u.pn * 2 + bj, dcol = wc * 32 + 8 * fq; const bool isv = dcol >= 64;
#pragma unroll
            for (int ai = 0; ai < 2; ++ai)
#pragma unroll
                for (int m = 0; m < 4; ++m) { const int b = u.pm / (TPB / 256), key = (u.pm % (TPB / 256)) * 256 + ai * 128 + wr * 64 + m * 16 + fr; const pg8::f32x4 v0 = acc[ai][bj][m][0], v1 = acc[ai][bj][m][1];
                    u32x4 w; w.x = pg8::cvt_pk_bf16(v0[0], v0[1]); w.y = pg8::cvt_pk_bf16(v0[2], v0[3]); w.z = pg8::cvt_pk_bf16(v1[0], v1[1]); w.w = pg8::cvt_pk_bf16(v1[2], v1[3]);
                    bf16* dst = isv ? V16 + (((size_t)b * AH + h) * TPB + key) * VD + (dcol - 64) : K16 + (((size_t)b * AH + h) * TPB + key) * QKD + dcol;
                    *(u32x4*)dst = w; asm volatile("" ::: "memory"); } }
    }
};
struct MlaOrder : pg8::StaticOrder { __device__ __forceinline__ int arow(const pg8::Unit& u, int r) const { return (u.pn >= 3 ? NT : 0) + u.pm * pg8::BM + r; } };
struct EpiMla { static constexpr bool PERM = true; EpiQproj eq; EpiKVproj ekv;
    __device__ __forceinline__ void operator()(const pg8::f32x4 (&acc)[2][2][4][2], const pg8::Unit& u, int wr, int wc, int fr, int fq) const {
        if (u.pn < 3) eq(acc, u, wr, wc, fr, fq); else { pg8::Unit v = u; v.pn = u.pn - 3; ekv(acc, v, wr, wc, fr, fq); } } };
__device__ __forceinline__ void opt_mla_proj(const P& p, const Q& q, const Q2& q2, int l, LAS unsigned char* lds, int G, int bid) {
    pg8::Gemm g{q2.QN16, q2.WtKvbP + (size_t)l * 1792 * 256, 256}; MlaOrder S; S.init(NT, 1792, G, bid);
    EpiMla E{EpiQproj{q2.Q16, p.ROPET}, EpiKVproj{q.K16, q.V16}}; pg8::gemm_phase<EpiMla, MlaOrder, true>(lds, g, S, E);
}
__device__ __forceinline__ int ord_len(int d, int ch) { return d == 0 ? ch : (ch < NCH_CTX ? NCH_CTX - 1 - ch : NCH_CTX + (NCH - 1 - ch)); }
__device__ __forceinline__ int ord_chunk(int d, int ch, int i) { return d == 0 ? i : (i < (ch < NCH_CTX ? NCH_CTX - 1 - ch : NCH_CTX) ? NCH_CTX - 1 - i : NCH - 1 - (i - NCH_CTX)); }

__device__ __forceinline__ void wave_scan_add128(float& x0, float& x1, int lane) {
#pragma unroll
    for (int off = 1; off < 64; off <<= 1) { const float y0 = __shfl_up(x0, off), y1 = __shfl_up(x1, off); if (lane >= off) { x0 += y0; x1 += y1; } }
    x1 += __shfl(x0, 63);
}
__device__ __forceinline__ void wave_scan_max128(float& x0, float& x1, int lane) {
#pragma unroll
    for (int off = 1; off < 64; off <<= 1) { const float y0 = __shfl_up(x0, off), y1 = __shfl_up(x1, off); if (lane >= off) { x0 = fmaxf(x0, y0); x1 = fmaxf(x1, y1); } }
    x1 = fmaxf(x1, __shfl(x0, 63));
}
__device__ __forceinline__ float wave_max(float v) {
#pragma unroll
    for (int o = 1; o < 64; o <<= 1) v = fmaxf(v, __shfl_xor(v, o));
    return v;
}

constexpr int ML1_LDS = 116736;
template <class UL>
__device__ __forceinline__ void ml1_item(const P& p, const Q2& q2, int l, int b, int ch, char* lds, const UL& U) {
    int tid_ = TIDX; asm volatile("" : "+v"(tid_));
    const int tid = tid_, wave = tid >> 6, lane = tid & 63, r32 = lane & 31, hi = lane >> 5;
    unsigned short* XCh = (unsigned short*)lds; unsigned short* UXh = (unsigned short*)(lds + 18432); unsigned short* QKVh = (unsigned short*)(lds + 36864);
    float* GP = (float*)(lds + 92160); float* GT = (float*)(lds + 108544);
    const int t0 = b * TPB + ch * 128, seg_lo = ch < NCH_CTX ? b * TPB : b * TPB + CTX, seg_hi = ch < NCH_CTX ? b * TPB + CTX : (b + 1) * TPB;
    const int rt = wave & 3, wh = wave >> 2;
    att::f32x16 gacc = {};
#pragma unroll 1
    for (int h = 0; h < 4; ++h) {
        { const int c8 = tid & 7, tg = tid >> 3, c = h * 64 + c8 * 8; float xin[5][8], out[2][8];
          conv4_2x8(U.U + OFF_MX + c, p.in[I_MCW] + (size_t)l * 4 * 256 + c, p.in[I_MCB] + (size_t)l * 256 + c, t0 + 2 * tg, seg_lo, seg_hi, xin, out);
#pragma unroll
          for (int q = 0; q < 2; ++q) { u32x4 w, ux;
              w.x = pk2(fast_silu(out[q][0]), fast_silu(out[q][1])); w.y = pk2(fast_silu(out[q][2]), fast_silu(out[q][3])); w.z = pk2(fast_silu(out[q][4]), fast_silu(out[q][5])); w.w = pk2(fast_silu(out[q][6]), fast_silu(out[q][7]));
              ux.x = pk2(xin[q + 2][0], xin[q + 2][1]); ux.y = pk2(xin[q + 2][2], xin[q + 2][3]); ux.z = pk2(xin[q + 2][4], xin[q + 2][5]); ux.w = pk2(xin[q + 2][6], xin[q + 2][7]);
              *(u32x4*)(XCh + (2 * tg + q) * 72 + c8 * 8) = w; *(u32x4*)(UXh + (2 * tg + q) * 72 + c8 * 8) = ux; } }
        __syncthreads();
        { const bf16* Wm = q2.WtM + ((size_t)l * 4 + h) * 3 * 4096;
#pragma unroll
          for (int m = 0; m < 3; ++m) { att::f32x16 a = {};
              wave_mm32<4>(a, (m == 2 ? UXh : XCh) + rt * 32 * 72, 72, Wm + (size_t)m * 4096 + (size_t)wh * 32 * 64, 64, r32, hi);
#pragma unroll
              for (int r = 0; r < 16; ++r) { const int tt = rt * 32 + att::crow(r, hi); const unsigned short vb = (unsigned short)f2bf(a[r]);
                  QKVh[(m * 128 + tt) * 72 + wh * 32 + r32] = vb; } } }
        __syncthreads();
#pragma unroll
        for (int k = 0; k < 2; ++k) { const int x = tid + k * 512, tt = x >> 3, c8 = x & 7; *(u32x4*)(q2.XCM16 + (size_t)(t0 + tt) * 256 + h * 64 + c8 * 8) = *(const u32x4*)(XCh + tt * 72 + c8 * 8); }
#pragma unroll
        for (int k = 0; k < 6; ++k) { const int x = tid + k * 512, m = x >> 10, tt = (x >> 3) & 127, c8 = x & 7;
            *(u32x4*)(q2.QKV16 + (size_t)(t0 + tt) * 768 + m * 256 + h * 64 + c8 * 8) = *(const u32x4*)(QKVh + (m * 128 + tt) * 72 + c8 * 8); }
        { const bf16* Wg = q2.WtG + (size_t)l * 32 * 768;
#pragma unroll
          for (int x = 0; x < 6; ++x) { const int idx = wh * 6 + x, m = idx >> 2, ks = idx & 3;
              const att::bf16x8 a = *reinterpret_cast<const att::bf16x8*>(QKVh + (m * 128 + rt * 32 + r32) * 72 + ks * 16 + hi * 8);
              const att::bf16x8 bb = *reinterpret_cast<const att::bf16x8*>(Wg + (size_t)r32 * 768 + m * 256 + h * 64 + ks * 16 + hi * 8);
              gacc = __builtin_amdgcn_mfma_f32_32x32x16_bf16(a, bb, gacc, 0, 0, 0); } }
        __syncthreads();
    }
    if (r32 < 16) {
#pragma unroll
        for (int r = 0; r < 16; ++r) GP[(wh * 128 + rt * 32 + att::crow(r, hi)) * 16 + r32] = gacc[r]; }
    __syncthreads();
    for (int i = tid; i < 128 * 16; i += 512) { const int n = i & 15, d = n >> 3, g = n & 7; float v = GP[i] + GP[128 * 16 + i] + p.in[I_MBG][((size_t)l * 2 + d) * 8 + g];
        if (g >= 4) v = fminf(v, 0.f) - __logf(1.f + __expf(-fabsf(v)));
        GT[i] = v; q2.GATES[(size_t)(t0 + (i >> 4)) * 16 + n] = v; }
    __syncthreads();
    unsigned short* KT = (unsigned short*)lds; unsigned short* VT = (unsigned short*)(lds + 17408); float* WR = (float*)(lds + 52224); float* MB = (float*)(lds + 53248); float* WE = (float*)(lds + 53280);
#pragma unroll 1
    for (int h = 0; h < 4; ++h) {
        if (wave < 2) { const int d = wave, ta = d == 0 ? lane : 127 - lane, tb = d == 0 ? lane + 64 : 63 - lane;
            float b0 = GT[ta * 16 + d * 8 + 4 + h], b1 = GT[tb * 16 + d * 8 + 4 + h]; wave_scan_add128(b0, b1, lane);
            const float bL = __shfl(b1, 63), w0 = bL - b0 + GT[ta * 16 + d * 8 + h], w1 = bL - b1 + GT[tb * 16 + d * 8 + h];
            WR[d * 128 + ta] = w0; WR[d * 128 + tb] = w1; const float mx = wave_max(fmaxf(w0, w1));
            if (lane == 0) { MB[d * 2] = mx; MB[d * 2 + 1] = bL; } }
        __syncthreads();
        { const int tt = tid & 127, jg = tid >> 7; const float w0 = __expf(WR[tt] - MB[0]), w1 = __expf(WR[128 + tt] - MB[2]);
          const unsigned short* ksrc = (const unsigned short*)q2.QKV16 + (size_t)(t0 + tt) * 768 + 256 + h * 64 + jg * 16; const unsigned short* vsrc = ksrc + 256;
          const att::bf16x8 k0 = *reinterpret_cast<const att::bf16x8*>(ksrc), k1 = *reinterpret_cast<const att::bf16x8*>(ksrc + 8), v0 = *reinterpret_cast<const att::bf16x8*>(vsrc), v1 = *reinterpret_cast<const att::bf16x8*>(vsrc + 8);
#pragma unroll
          for (int i = 0; i < 8; ++i) { KT[(jg * 16 + i) * 136 + tt] = (unsigned short)k0[i]; KT[(jg * 16 + 8 + i) * 136 + tt] = (unsigned short)k1[i];
              const float va = bf2f((unsigned short)v0[i]), vb = bf2f((unsigned short)v1[i]);
              VT[(jg * 16 + i) * 136 + tt] = (unsigned short)f2bf(va * w0); VT[(jg * 16 + 8 + i) * 136 + tt] = (unsigned short)f2bf(vb * w0);
              VT[(64 + jg * 16 + i) * 136 + tt] = (unsigned short)f2bf(va * w1); VT[(64 + jg * 16 + 8 + i) * 136 + tt] = (unsigned short)f2bf(vb * w1); }
          if (tid < 128) WE[tid] = w0; else if (tid < 256) WE[tid] = w1; }
        __syncthreads();
        { const int d = wave >> 2, vt = (wave >> 1) & 1, kt = wave & 1; att::f32x16 c = {};
          wave_mm32<8>(c, VT + (size_t)(d * 64 + vt * 32) * 136, 136, KT + (size_t)kt * 32 * 136, 136, r32, hi);
          float* dst = q2.CLOC + ((((size_t)d * NB + b) * NCH + ch) * 4 + h) * 4096;
#pragma unroll
          for (int r = 0; r < 16; ++r) dst[(vt * 32 + att::crow(r, hi)) * 64 + kt * 32 + r32] = c[r];
          { const int dd = tid >> 8, k = (tid >> 2) & 63, qt = tid & 3; float s = 0.f;
#pragma unroll 8
            for (int i = 0; i < 32; ++i) { const int tt = qt * 32 + i; s += WE[dd * 128 + tt] * bf2f(KT[k * 136 + tt]); }
            s += __shfl_xor(s, 1); s += __shfl_xor(s, 2);
            if (qt == 0) q2.NLOC[((((size_t)dd * NB + b) * NCH + ch) * 4 + h) * 64 + k] = s; }
          if (tid < 2) { float* mb = q2.MLB + ((((size_t)tid * NB + b) * NCH + ch) * 4 + h) * 2; mb[0] = MB[tid * 2]; mb[1] = MB[tid * 2 + 1]; } }
        __syncthreads();
    }
}

#ifndef ML_SCAN_ITEMS_N
#define ML_SCAN_ITEMS_N 32
#endif
constexpr int ML_SCAN_ITEMS = ML_SCAN_ITEMS_N;
__device__ __forceinline__ void ml_scan_item(const Q2& q2, int item, char* lds) {
    int tid_ = TIDX; asm volatile("" : "+v"(tid_));
    constexpr int EPT = ML_SCAN_ITEMS == 32 ? 4 : 2, NVQ = 4096 / (512 * EPT);
    static_assert(ML_SCAN_ITEMS == 32 || ML_SCAN_ITEMS == 64, "items = 2 x NB x 4 heads x (2 or 4) parts");
    const int tid = tid_, vq = item % NVQ, h = (item / NVQ) & 3, b = (item / (NVQ * 4)) & 1, d = item / (NVQ * 8);
    float* MLs = (float*)lds; float* MSEQ = MLs + 2 * NCH + 16;
    for (int i = tid; i < NCH; i += 512) { const float* mb = q2.MLB + ((((size_t)d * NB + b) * NCH + ord_chunk(d, NCH, i)) * 4 + h) * 2; MLs[2 * i] = mb[0]; MLs[2 * i + 1] = mb[1]; }
    __syncthreads();
    if (tid == 0) { float m = 0.f; for (int i = 0; i < NCH; ++i) { MSEQ[i] = m; m = fmaxf(MLs[2 * i + 1] + m, MLs[2 * i]); } MSEQ[NCH] = m; }
    __syncthreads();
    const int e0 = vq * (512 * EPT) + tid * EPT; float c[EPT]; float nn = 0.f; const bool don = (vq == 0 && tid < 64);
#pragma unroll
    for (int k = 0; k < EPT; ++k) c[k] = 0.f;
    constexpr int DEPTH_PF = EPT == 4 ? 22 : 33;
    static_assert(NCH % DEPTH_PF == 0, "the scan streams the chunk contributions DEPTH_PF at a time");
#pragma unroll 1
    for (int i0 = 0; i0 < NCH; i0 += DEPTH_PF) { float cl[DEPTH_PF][EPT]; float nl[DEPTH_PF];
#pragma unroll
        for (int x = 0; x < DEPTH_PF; ++x) { const size_t idx = (((size_t)d * NB + b) * NCH + ord_chunk(d, NCH, i0 + x)) * 4 + h;
            if constexpr (EPT == 4) { const f32x4 v = *(const f32x4*)(q2.CLOC + idx * 4096 + e0); cl[x][0] = v.x; cl[x][1] = v.y; cl[x][2] = v.z; cl[x][3] = v.w; }
            else { const float2 v = *(const float2*)(q2.CLOC + idx * 4096 + e0); cl[x][0] = v.x; cl[x][1] = v.y; }
            nl[x] = don ? q2.NLOC[idx * 64 + tid] : 0.f; }
#pragma unroll
        for (int x = 0; x < DEPTH_PF; ++x) { const int i = i0 + x; const size_t idx = (((size_t)d * NB + b) * NCH + ord_chunk(d, NCH, i)) * 4 + h;
            if constexpr (EPT == 4) { u32x2 w; w.x = pk2(c[0], c[1]); w.y = pk2(c[2], c[3]); *(u32x2*)(q2.CST + idx * 4096 + e0) = w; }
            else *(unsigned*)(q2.CST + idx * 4096 + e0) = pk2(c[0], c[1]);
            if (don) q2.NST[idx * 64 + tid] = nn;
            if (vq == 0 && tid == 64) q2.MST[idx] = MSEQ[i];
            const float m = MSEQ[i], mn = MSEQ[i + 1], dec = __expf(MLs[2 * i + 1] + m - mn), sc = __expf(MLs[2 * i] - mn);
#pragma unroll
            for (int k = 0; k < EPT; ++k) c[k] = dec * c[k] + sc * cl[x][k];
            nn = dec * nn + sc * nl[x]; } }
    __syncthreads();
}

constexpr int ML2_LDS = 145536;
template <class UL, class YS>
__device__ __forceinline__ void ml2_item(const P& p, const Q2& q2, int l, int b, int ch, int h, char* lds, const UL& U, const YS& Y) {
    int tid_ = TIDX; asm volatile("" : "+v"(tid_));
    const int tid = tid_, wave = tid >> 6, lane = tid & 63, r32 = lane & 31, hi = lane >> 5;
    char* Ks = lds; char* Vs = lds + 32768; unsigned short* C0 = (unsigned short*)(lds + 49152); float* N0 = (float*)(lds + 67584); float* ROWV = (float*)(lds + 68096);
    float* COEF = (float*)(lds + 73216); float* M0 = (float*)(lds + 73792); float* WS = (float*)(lds + 73856) + wave * 64; float* HX = (float*)(lds + 75904);
    const int t0 = b * TPB + ch * 128;
    const int d3 = tid >> 8, e03 = (tid & 255) * 16; const size_t idx3 = (((size_t)d3 * NB + b) * NCH + ch) * 4 + h;
    const u32x4 st_w0 = ((const u32x4*)(q2.CST + idx3 * 4096 + e03))[0], st_w1 = ((const u32x4*)(q2.CST + idx3 * 4096 + e03))[1];
    float st_n0 = 0.f, st_m0 = 0.f;
    if (tid < 128) st_n0 = q2.NST[((((size_t)(tid >> 6) * NB + b) * NCH + ch) * 4 + h) * 64 + (tid & 63)];
    if (tid < 2) st_m0 = q2.MST[(((size_t)tid * NB + b) * NCH + ch) * 4 + h];
    att::bf16x8 qr[4];
    { const unsigned short* qw = (const unsigned short*)q2.QKV16 + (size_t)(t0 + (wave & 3) * 32 + r32) * 768 + h * 64 + hi * 8;
#pragma unroll
      for (int d0 = 0; d0 < 4; ++d0) qr[d0] = *reinterpret_cast<const att::bf16x8*>(qw + d0 * 16); }
    { const unsigned short* base = (const unsigned short*)q2.QKV16 + (size_t)t0 * 768 + h * 64;
#pragma unroll
      for (int x = 0; x < 2; ++x) { const int cidx = tid + x * 512, key = cidx >> 3, c8 = cidx & 7, tile = key >> 6, kk = key & 63;
          const att::bf16x8 kv = *reinterpret_cast<const att::bf16x8*>(base + (size_t)key * 768 + 256 + c8 * 8), vv = *reinterpret_cast<const att::bf16x8*>(base + (size_t)key * 768 + 512 + c8 * 8);
          *(att::bf16x8*)(Ks + tile * 16384 + (kk * 256 + ((c8 * 16) ^ ((kk & 7) << 4)))) = kv;
          *(att::bf16x8*)(Vs + tile * 8192 + att::v_st(kk, c8 * 8)) = vv; } }
    if (wave < 2) { const int d = wave, ta = d == 0 ? lane : 127 - lane, tb = d == 0 ? lane + 64 : 63 - lane;
        float* g = ROWV + (d * 5 + 0) * 128; float* pmv = ROWV + (d * 5 + 1) * 128; float* bv = ROWV + (d * 5 + 2) * 128;
        const float iga = q2.GATES[(size_t)(t0 + ta) * 16 + d * 8 + h], igb = q2.GATES[(size_t)(t0 + tb) * 16 + d * 8 + h];
        float b0 = q2.GATES[(size_t)(t0 + ta) * 16 + d * 8 + 4 + h], b1 = q2.GATES[(size_t)(t0 + tb) * 16 + d * 8 + 4 + h]; wave_scan_add128(b0, b1, lane);
        const float g0 = iga - b0, g1 = igb - b1; float p0 = g0, p1 = g1; wave_scan_max128(p0, p1, lane);
        g[ta] = g0; g[tb] = g1; pmv[ta] = p0; pmv[tb] = p1; bv[ta] = b0; bv[tb] = b1; }
    __syncthreads();
    { const int d = d3, e0 = e03;
      { const int v = e0 >> 6, k = e0 & 63; unsigned short* dst = C0 + (d * 64 + v) * 72 + k; *(u32x4*)dst = st_w0; *(u32x4*)(dst + 8) = st_w1; }
      if (tid < 128) { const int nd = tid >> 6, nk = tid & 63; N0[nd * 64 + nk] = st_n0; }
      if (tid < 2) M0[tid] = st_m0; }
    __syncthreads();
    {
      if (tid < 256) { const int dd = tid >> 7, tt = tid & 127; const float m0 = M0[dd], M = fmaxf(m0, ROWV[(dd * 5 + 1) * 128 + tt]);
          ROWV[(dd * 5 + 1) * 128 + tt] = M; ROWV[(dd * 5 + 3) * 128 + tt] = __expf(m0 - M); ROWV[(dd * 5 + 4) * 128 + tt] = __expf(-(ROWV[(dd * 5 + 2) * 128 + tt] + M)); } }
    __syncthreads();
    { const int qb = wave & 3, d = wave >> 2; const float* g = ROWV + (d * 5 + 0) * 128; const float* Mv = ROWV + (d * 5 + 1) * 128; const float* wiv = ROWV + (d * 5 + 3) * 128; const float* emtv = ROWV + (d * 5 + 4) * 128;
      const int sq = qb * 32 + r32;
      const float Ms = Mv[sq] * 1.4426950408889634f; att::f32x16 o[2] = {}; float rs = 0.f;
      const int vb0 = (int)(uintptr_t)Vs + att::v_rd_base(lane);
#pragma unroll
      for (int kt = 0; kt < 2; ++kt) {
          const bool skip = d == 0 ? (kt == 1 && qb < 2) : (kt == 0 && qb >= 2);
          if (!skip) {
              att::f32x16 p0 = {}, p1 = {}; const char* Kt = Ks + kt * 16384;
#pragma unroll
              for (int d0 = 0; d0 < 4; ++d0) { const int cb = (d0 * 16 + hi * 8) * 2;
                  const att::bf16x8 b0 = *reinterpret_cast<const att::bf16x8*>(Kt + (r32 * 256 + (cb ^ ((r32 & 7) << 4))));
                  const att::bf16x8 b1 = *reinterpret_cast<const att::bf16x8*>(Kt + ((32 + r32) * 256 + (cb ^ ((r32 & 7) << 4))));
                  p0 = __builtin_amdgcn_mfma_f32_32x32x16_bf16(b0, qr[d0], p0, 0, 0, 0); p1 = __builtin_amdgcn_mfma_f32_32x32x16_bf16(b1, qr[d0], p1, 0, 0, 0); }
#pragma unroll
              for (int r = 0; r < 16; ++r) { const int k0 = kt * 64 + att::crow(r, hi), k1 = k0 + 32;
                  const bool ok0 = d == 0 ? k0 <= sq : k0 >= sq, ok1 = d == 0 ? k1 <= sq : k1 >= sq;
                  p0[r] = ok0 ? p0[r] * __builtin_amdgcn_exp2f(g[k0] * 1.4426950408889634f - Ms) : 0.f; p1[r] = ok1 ? p1[r] * __builtin_amdgcn_exp2f(g[k1] * 1.4426950408889634f - Ms) : 0.f;
                  rs += p0[r] + p1[r]; }
              att::bf16x8 pa0, pa1, pa2, pa3;
#define PK4(P, BASE, OUT) do { unsigned a0 = att::cvtpk(P[BASE + 0], P[BASE + 1]), a1 = att::cvtpk(P[BASE + 2], P[BASE + 3]);   \
    unsigned b0 = att::cvtpk(P[BASE + 4], P[BASE + 5]), b1 = att::cvtpk(P[BASE + 6], P[BASE + 7]);                              \
    auto r0 = __builtin_amdgcn_permlane32_swap(a0, b0, false, false); auto r1 = __builtin_amdgcn_permlane32_swap(a1, b1, false, false); \
    att::u32x4 w = {r0[0], r1[0], r0[1], r1[1]}; OUT = *reinterpret_cast<att::bf16x8*>(&w); } while (0)
              PK4(p0, 0, pa0); PK4(p0, 8, pa1); PK4(p1, 0, pa2); PK4(p1, 8, pa3);
#undef PK4
              att::pv_d0(o, vb0 + kt * 8192, pa0, pa1, pa2, pa3);
          }
      }
      att::f32x16 ic[2] = {};
#pragma unroll
      for (int vt = 0; vt < 2; ++vt)
#pragma unroll
          for (int d0 = 0; d0 < 4; ++d0) { const att::bf16x8 cb = *reinterpret_cast<const att::bf16x8*>(C0 + (d * 64 + vt * 32 + r32) * 72 + d0 * 16 + hi * 8);
              ic[vt] = __builtin_amdgcn_mfma_f32_32x32x16_bf16(qr[d0], cb, ic[vt], 0, 0, 0); }
      float nq = 0.f;
#pragma unroll
      for (int d0 = 0; d0 < 4; ++d0)
#pragma unroll
          for (int x = 0; x < 8; ++x) nq += bf2f((unsigned short)qr[d0][x]) * N0[d * 64 + d0 * 16 + hi * 8 + x];
      { auto rr = __builtin_amdgcn_permlane32_swap(__float_as_uint(nq), __float_as_uint(nq), false, false); nq = __uint_as_float(rr[0]) + __uint_as_float(rr[1]); }
      { auto rr = __builtin_amdgcn_permlane32_swap(__float_as_uint(rs), __float_as_uint(rs), false, false); rs = __uint_as_float(rr[0]) + __uint_as_float(rr[1]); }
      const float den = rs + wiv[sq] * nq, dn = fmaxf(fabsf(den), emtv[sq]);
      if (hi == 0) WS[r32] = __builtin_amdgcn_rcpf(dn);
      asm volatile("s_waitcnt lgkmcnt(0)" ::: "memory");
#pragma unroll
      for (int r = 0; r < 16; ++r) { const int row = att::crow(r, hi), tt = qb * 32 + row; const float inv = WS[row], wi = wiv[tt];
#pragma unroll
          for (int vt = 0; vt < 2; ++vt) HX[(d * 128 + tt) * 68 + vt * 32 + r32] = (o[vt][r] + wi * ic[vt][r]) * inv; }
    }
    __syncthreads();
    { const int tt = tid >> 2, v0 = (tid & 3) * 16, t = t0 + tt; float hv[16]; float s = 0.f;
#pragma unroll
      for (int i = 0; i < 16; ++i) { hv[i] = HX[tt * 68 + v0 + i] + HX[(128 + tt) * 68 + v0 + i]; s += hv[i]; }
      s += __shfl_xor(s, 1); s += __shfl_xor(s, 2); const float mu = s * (1.f / 64.f); float vs = 0.f;
#pragma unroll
      for (int i = 0; i < 16; ++i) { hv[i] -= mu; vs += hv[i] * hv[i]; }
      vs += __shfl_xor(vs, 1); vs += __shfl_xor(vs, 2); const float rstd = 1.f / sqrtf(vs * (1.f / 64.f) + EPS);
      const int cb = h * 64 + v0; u32x4 xc[2], uz[2], yo[2];
      xc[0] = *(const u32x4*)(q2.XCM16 + (size_t)t * 256 + cb); xc[1] = *(const u32x4*)(q2.XCM16 + (size_t)t * 256 + cb + 8);
      uz[0] = *(const u32x4*)(U.U + (size_t)t * DINP + OFF_MZ + cb); uz[1] = *(const u32x4*)(U.U + (size_t)t * DINP + OFF_MZ + cb + 8);
#pragma unroll
      for (int i = 0; i < 16; i += 2) { const int c = cb + i; const unsigned xw = xc[i >> 3][(i >> 1) & 3], zw = uz[i >> 3][(i >> 1) & 3];
          const float y0 = hv[i] * rstd * p.in[I_MNG][(size_t)l * 256 + c] + p.in[I_MSK][(size_t)l * 256 + c] * __builtin_bit_cast(float, xw << 16);
          const float y1 = hv[i + 1] * rstd * p.in[I_MNG][(size_t)l * 256 + c + 1] + p.in[I_MSK][(size_t)l * 256 + c + 1] * __builtin_bit_cast(float, xw & 0xffff0000u);
          yo[i >> 3][(i >> 1) & 3] = pk2(y0 * fast_silu(__builtin_bit_cast(float, zw << 16)), y1 * fast_silu(__builtin_bit_cast(float, zw & 0xffff0000u))); }
      *(u32x4*)(Y.Y + (size_t)t * DMIX + 768 + cb) = yo[0]; *(u32x4*)(Y.Y + (size_t)t * DMIX + 768 + cb + 8) = yo[1]; }
    __syncthreads();
}
typedef float f32x4_t __attribute__((ext_vector_type(4)));

__device__ __forceinline__ void row_norm_mod(f32x4 (&v)[4], const float* g, const float* sc, const float* sh, int lane) {
    float s = 0.f;
#pragma unroll
    for (int j = 0; j < 4; ++j) s += (v[j].x * v[j].x + v[j].y * v[j].y) + (v[j].z * v[j].z + v[j].w * v[j].w);
    const float rstd = 1.f / sqrtf(wave_sum(s) * (1.f / D) + EPS);
#pragma unroll
    for (int j = 0; j < 4; ++j) { const int k = (j * 64 + lane) * 4; const f32x4 gv = *(const f32x4*)(g + k);
        if (sc) { const f32x4 scv = *(const f32x4*)(sc + k), shv = *(const f32x4*)(sh + k); v[j] = v[j] * rstd * gv * (scv + 1.f) + shv; } else v[j] = v[j] * rstd * gv; }
}
__device__ __forceinline__ void row_store_bf16(bf16* dst, const f32x4 (&v)[4], int lane) {
#pragma unroll
    for (int j = 0; j < 4; ++j) { u32x2 w; w.x = pk2(v[j].x, v[j].y); w.y = pk2(v[j].z, v[j].w); *(u32x2*)(dst + (j * 64 + lane) * 4) = w; }
}
__device__ __forceinline__ void rp_first(const P& p, const Q& q, int gw, int ngw, int lane) {
    for (int t = gw; t < NT; t += ngw) { const int b = t / TPB, i = t % TPB; const float* src = i < CTX ? p.in[I_CTX] + ((size_t)b * CTX + i) * D : p.in[I_X] + ((size_t)b * SEQ + (i - CTX)) * D;
        f32x4 v[4];
#pragma unroll
        for (int j = 0; j < 4; ++j) v[j] = *(const f32x4*)(src + (j * 64 + lane) * 4);
        const int cv = tok_cv(t); row_norm_mod(v, p.in[I_N1G], modp(p, 0, cv, 1), modp(p, 0, cv, 0), lane); row_store_bf16(q.H16 + (size_t)t * D, v, lane); }
}
__device__ __forceinline__ void rp_end(const P& p, const Q& q, const Q2& q2, int l, int gw, int ngw, int lane, float probe_scale = 1.f) {
    const bool last = l + 1 == DEPTH; const int nrows = last ? NB * SEQ : NT;
    for (int r_ = gw; r_ < nrows; r_ += ngw) { const int t = last ? (r_ / SEQ) * TPB + CTX + r_ % SEQ : r_; const int cv = tok_cv(t); const float* g2 = modp(p, l, cv, 5); f32x4 v[4];
#pragma unroll
        for (int j = 0; j < 4; ++j) { const int k = (j * 64 + lane) * 4; f32x4 s = {0.f, 0.f, 0.f, 0.f};
#pragma unroll
            for (int e = 0; e < 4; ++e) { const u32x2 w = *(const u32x2*)(q2.YB16 + ((size_t)t * 4 + e) * D + k);
                s.x += __builtin_bit_cast(float, w.x << 16); s.y += __builtin_bit_cast(float, w.x & 0xffff0000u); s.z += __builtin_bit_cast(float, w.y << 16); s.w += __builtin_bit_cast(float, w.y & 0xffff0000u); }
            const u32x2 xw = *(const u32x2*)((const bf16*)p.X + (size_t)t * D + k); f32x4 xv; xv.x = __builtin_bit_cast(float, xw.x << 16); xv.y = __builtin_bit_cast(float, xw.x & 0xffff0000u); xv.z = __builtin_bit_cast(float, xw.y << 16); xv.w = __builtin_bit_cast(float, xw.y & 0xffff0000u);
            v[j] = xv + *(const f32x4*)(g2 + k) * s * probe_scale; }
        if (l + 1 < DEPTH) {
            row_store_bf16((bf16*)p.X + (size_t)t * D, v, lane);
            row_norm_mod(v, p.in[I_N1G] + (size_t)(l + 1) * D, modp(p, l + 1, cv, 1), modp(p, l + 1, cv, 0), lane); row_store_bf16(q.H16 + (size_t)t * D, v, lane);
        } else { const int b = t / TPB, i = t % TPB; if (i < CTX) continue;
            row_norm_mod(v, p.in[I_FG], nullptr, nullptr, lane);
#pragma unroll
            for (int j = 0; j < 4; ++j) *(f32x4*)(p.out + ((size_t)b * SEQ + (i - CTX)) * D + (j * 64 + lane) * 4) = v[j]; }
    }
}
constexpr int RPM_LDS = 89024;
__device__ __forceinline__ void rp_mid(const P& p, const Q& q, float* GLIST, int l, char* lds, int G, int bid, bool latent_only, bool probe_nolist = false) {
    int tid_ = TIDX; asm volatile("" : "+v"(tid_));
    const int tid = tid_, wave = tid >> 6, lane = tid & 63;
    float* HS = (float*)lds; float* PART = (float*)(lds + 65664); float* LG = (float*)(lds + 82048); int* LCNT = (int*)(lds + 84096); int* LBASE = (int*)(lds + 84224); int* PEND = (int*)(lds + 84352); int* NPEND = (int*)(lds + 88960);
    if (tid < 32) LCNT[tid] = 0; if (tid == 32) NPEND[0] = 0;
    float B0[32], B1[32]; const float* Wr = p.in[I_WR] + (size_t)l * D * NE;
#pragma unroll
    for (int ks = 0; ks < 32; ++ks) { const int k = 128 * wave + 4 * ks + (lane >> 4); B0[ks] = Wr[(size_t)k * NE + (lane & 15)]; B1[ks] = Wr[(size_t)k * NE + 16 + (lane & 15)]; }
    __syncthreads();
    const int nitems = latent_only ? NB * SEQ / 16 : NT / 16;
    for (int it_ = bid; it_ < nitems; it_ += G) { const int it = latent_only ? (it_ / (SEQ / 16)) * (TPB / 16) + CTX / 16 + it_ % (SEQ / 16) : it_;
        u32x2 xrow[2][4];
#pragma unroll
        for (int rr = 0; rr < 2; ++rr)
#pragma unroll
            for (int j = 0; j < 4; ++j) xrow[rr][j] = *(const u32x2*)((const bf16*)p.X + (size_t)(it * 16 + 2 * wave + rr) * D + (j * 64 + lane) * 4);
#pragma unroll
        for (int rr = 0; rr < 2; ++rr) { const int row = 2 * wave + rr, t = it * 16 + row, cv = tok_cv(t); f32x4 v[4];
#pragma unroll
            for (int j = 0; j < 4; ++j) { const u32x2 xw = xrow[rr][j]; v[j].x = __builtin_bit_cast(float, xw.x << 16); v[j].y = __builtin_bit_cast(float, xw.x & 0xffff0000u); v[j].z = __builtin_bit_cast(float, xw.y << 16); v[j].w = __builtin_bit_cast(float, xw.y & 0xffff0000u); }
            row_norm_mod(v, p.in[I_N2G] + (size_t)l * D, modp(p, l, cv, 4), modp(p, l, cv, 3), lane);
            if (FP8_GU) {
                float am = 0.f;
#pragma unroll
                for (int j = 0; j < 4; ++j) am = fmaxf(fmaxf(am, fmaxf(fabsf(v[j].x), fabsf(v[j].y))), fmaxf(fabsf(v[j].z), fabsf(v[j].w)));
                am = wave_max(am); float qs, inv; pow2_scale(am, 7, qs, inv);
#pragma unroll
                for (int j = 0; j < 4; ++j) *(unsigned*)((fp8*)q.H16 + (size_t)t * D + (j * 64 + lane) * 4) = fp8_pack4(v[j].x * qs, v[j].y * qs, v[j].z * qs, v[j].w * qs);
                if (lane == 0) rowscale_tab(q)[t] = inv;
            } else row_store_bf16(q.H16 + (size_t)t * D, v, lane);
#pragma unroll
            for (int j = 0; j < 4; ++j) { float* d = HS + row * 1026 + (j * 64 + lane) * 4; *(float2*)d = make_float2(v[j].x, v[j].y); *(float2*)(d + 2) = make_float2(v[j].z, v[j].w); } }
        __syncthreads();
        { f32x4_t a0 = {0.f, 0.f, 0.f, 0.f}, a1 = a0; const float* hrow = HS + (lane & 15) * 1026 + 128 * wave + (lane >> 4);
#pragma unroll
          for (int ks = 0; ks < 32; ++ks) { const float a = hrow[4 * ks]; a0 = __builtin_amdgcn_mfma_f32_16x16x4f32(a, B0[ks], a0, 0, 0, 0); a1 = __builtin_amdgcn_mfma_f32_16x16x4f32(a, B1[ks], a1, 0, 0, 0); }
#pragma unroll
          for (int r = 0; r < 4; ++r) { const int row = (lane >> 4) * 4 + r; PART[(wave * 16 + row) * 32 + (lane & 15)] = a0[r]; PART[(wave * 16 + row) * 32 + 16 + (lane & 15)] = a1[r]; } }
        __syncthreads();
        { float s = p.in[I_BR][(size_t)l * NE + (tid & 31)];
#pragma unroll
          for (int w = 0; w < 8; ++w) s += PART[w * 512 + tid];
          LG[tid] = s; }
        __syncthreads();
        if (tid < 16) { const int t = it * 16 + tid; float lg[NE];
#pragma unroll
            for (int e = 0; e < NE; ++e) lg[e] = LG[tid * 32 + e];
            int te[TOPK]; float tv[TOPK];
#pragma unroll
            for (int r = 0; r < TOPK; ++r) { float best = -3.0e38f; int bi = 0;
#pragma unroll
                for (int e = 0; e < NE; ++e) { const bool c = lg[e] > best; best = c ? lg[e] : best; bi = c ? e : bi; }
                te[r] = bi; tv[r] = best;
#pragma unroll
                for (int e = 0; e < NE; ++e) lg[e] = (e == bi) ? -3.0e38f : lg[e]; }
            float ssum = 0.f, ex[TOPK];
#pragma unroll
            for (int r = 0; r < TOPK; ++r) { ex[r] = __expf(tv[r] - tv[0]); ssum += ex[r]; }
            const float inv = 1.f / ssum;
#pragma unroll
            for (int r = 0; r < TOPK; ++r) { p.TOPG[t * TOPK + r] = ex[r] * inv; const int lp = atomicAdd(&LCNT[te[r]], 1); const int slot = atomicAdd(NPEND, 1);
                PEND[slot * 3] = t * TOPK + r; PEND[slot * 3 + 1] = (te[r] << 16) | lp; PEND[slot * 3 + 2] = __float_as_int(ex[r] * inv); } }
        __syncthreads();
    }
    if (probe_nolist) return;
    if (tid < 32) LBASE[tid] = LCNT[tid] > 0 ? atomicAdd(&p.CNT[tid], LCNT[tid]) : 0;
    __syncthreads();
    for (int i = tid; i < NPEND[0]; i += 512) { const int pr = PEND[i * 3], x = PEND[i * 3 + 1], e = x >> 16, lp = x & 0xffff; p.LIST[(size_t)e * NT + LBASE[e] + lp] = pr; GLIST[(size_t)e * NT + LBASE[e] + lp] = __int_as_float(PEND[i * 3 + 2]); }
    __syncthreads();
}
struct EpiDown16 {
    static constexpr bool PERM = true; bf16* YB; const float* bd; const float* GL; const int* CNT; const int* LIST; int nN; int probe_skip;
    const float* wsc;
    __device__ __forceinline__ void operator()(const pg8::f32x4 (&acc)[2][2][4][2], const pg8::Unit& u, int wr, int wc, int fr, int fq) const {
        if (probe_skip) return;
        const int ntile = u.pn - u.e * nN, cnt = CNT[u.e]; const float* b = bd + (size_t)u.e * D;
        const float dq = FP8_DN ? 0.125f * wsc[(NE + u.e) * 2 + 1] : 1.f;
        int pr[2][4]; float gt[2][4];
#pragma unroll
        for (int ai = 0; ai < 2; ++ai)
#pragma unroll
            for (int m = 0; m < 4; ++m) { const int idx = u.mb * 256 + ai * 128 + wr * 64 + m * 16 + fr, ic = idx < cnt ? idx : 0; pr[ai][m] = LIST[(size_t)u.e * NT + ic]; gt[ai][m] = GL[(size_t)u.e * NT + ic]; }
        pg8::f32x4 bv[2][2];
#pragma unroll
        for (int bj = 0; bj < 2; ++bj) { const int c = ntile * 256 + bj * 128 + wc * 32 + 8 * fq; bv[bj][0] = *(const pg8::f32x4*)(b + c); bv[bj][1] = *(const pg8::f32x4*)(b + c + 4); }
#pragma unroll
        for (int ai = 0; ai < 2; ++ai)
#pragma unroll
            for (int m = 0; m < 4; ++m) { const int idx = u.mb * 256 + ai * 128 + wr * 64 + m * 16 + fr;
                if (idx < cnt) { const float g = gt[ai][m];
#pragma unroll
                    for (int bj = 0; bj < 2; ++bj) { const int c = ntile * 256 + bj * 128 + wc * 32 + 8 * fq;
                        const pg8::f32x4 v0 = (acc[ai][bj][m][0] * dq + bv[bj][0]) * g, v1 = (acc[ai][bj][m][1] * dq + bv[bj][1]) * g;
                        u32x4 w; w.x = pg8::cvt_pk_bf16(v0[0], v0[1]); w.y = pg8::cvt_pk_bf16(v0[2], v0[3]); w.z = pg8::cvt_pk_bf16(v1[0], v1[1]); w.w = pg8::cvt_pk_bf16(v1[2], v1[3]);
                        *(u32x4*)(YB + (size_t)pr[ai][m] * D + c) = w; } } }
    }
};
__device__ __forceinline__ void opt_moe_down16(const P& p, const Q& q, const Q2& q2, int l, LAS unsigned char* lds, int G, int bid, int probe_skip = 0) {
    pg8::Gemm g{q.ACT16, q.WtDn + (size_t)l * NE * D * DE, DE}; DnOrder S; S.init(p.CNT, p.LIST, D / 256, G, bid, (LAS int*)(lds + pg8::STAGE_BYTES));
    EpiDown16 E{q2.YB16, p.in[I_BD] + (size_t)l * NE * D, q2.GLIST, p.CNT, p.LIST, D / 256, probe_skip, wscale_tab(q) + (size_t)l * 2 * NE * 2}; pg8::gemm_phase<EpiDown16, DnOrder, true, FP8_DN != 0>(lds, g, S, E);
}
#define GAS __attribute__((address_space(1)))
typedef GAS unsigned gu32;
#define XB_TMO      128
#define XB_XCNT(j)  (256  + 64 * (j))
#define XB_XSUB(j)  (1280 + 64 * (j))
#define XB_XGEN(j)  (2304 + 64 * (j))
#define XB_TOP      3328
#define XB_TOPGEN   3392
#define XB_MODRDY   192
#define XCD_BAR_WORDS 3456
#define XB_SPIN_CAP (1u << 18)

__device__ __forceinline__ unsigned xb_ld(unsigned* p)              { return __hip_atomic_load(p, __ATOMIC_RELAXED, __HIP_MEMORY_SCOPE_AGENT); }
__device__ __forceinline__ unsigned xb_add(unsigned* p, unsigned v) { return __hip_atomic_fetch_add(p, v, __ATOMIC_RELAXED, __HIP_MEMORY_SCOPE_AGENT); }
__device__ __forceinline__ unsigned xb_xcc_id() { return (unsigned)__builtin_amdgcn_s_getreg((3 << 11) | 20) & 0xFu; }
#define XB_SPIN(cond, bar) do { unsigned _sp = 0; while (cond) { __builtin_amdgcn_s_sleep(1); \
    if ((++_sp & 255u) == 0u) { if (xb_ld(&(bar)[XB_TMO])) break; if (_sp > XB_SPIN_CAP) { atomicAdd(&(bar)[XB_TMO], 1u); break; } } } } while (0)

struct XcdBarrier {
    unsigned* bar; unsigned x;
    volatile LAS unsigned* st;
};

__device__ __forceinline__ XcdBarrier xcd_barrier_post(unsigned* bar, volatile LAS unsigned* st) {
    XcdBarrier b; b.bar = bar; b.x = xb_xcc_id(); b.st = st;
    if (TIDX == 0) (void)xb_add(&bar[XB_XCNT(b.x)], 1u);
    return b;
}
__device__ __forceinline__ void xcd_barrier_complete(unsigned* bar, unsigned x, unsigned& nloc, unsigned& nx) {
    const unsigned G = gridDim.x * gridDim.y * gridDim.z;
    unsigned sum, cnt, mine, sp = 0u;
    for (;;) {
        sum = 0u; cnt = 0u; mine = 0u;
#pragma unroll
        for (unsigned j = 0; j < 16; ++j) { const unsigned c = xb_ld(&bar[XB_XCNT(j)]); sum += c; cnt += (c > 0u) ? 1u : 0u; mine = (j == x) ? c : mine; }
        if (sum == G) break;
        __builtin_amdgcn_s_sleep(1);
        if ((++sp & 255u) == 0u) { if (xb_ld(&bar[XB_TMO])) break; if (sp > XB_SPIN_CAP) { atomicAdd(&bar[XB_TMO], 1u); break; } }
    }
    nloc = mine > 0u ? mine : 1u; nx = cnt > 0u ? cnt : 1u;
}

__device__ __forceinline__ void xcd_barrier(const XcdBarrier& b) {
    asm volatile("s_waitcnt vmcnt(0)" ::: "memory");
    __syncthreads();
    if (TIDX == 0) {
        unsigned* bar = b.bar;
        __builtin_amdgcn_s_waitcnt(0);
        unsigned nloc = b.st[0], nx = b.st[1];
        if (nloc == 0u) { xcd_barrier_complete(bar, b.x, nloc, nx); b.st[0] = nloc; b.st[1] = nx; }
#ifdef XB_EARLY_WB
        __builtin_amdgcn_fence(__ATOMIC_RELEASE, "agent"); asm volatile("s_waitcnt vmcnt(0)" ::: "memory");
#endif
        const unsigned old = xb_add(&bar[XB_XSUB(b.x)], 1u);
        const unsigned gen = old / nloc;
        if (old + 1u == (gen + 1u) * nloc) {
            __builtin_amdgcn_fence(__ATOMIC_RELEASE, "agent");
            asm volatile("s_waitcnt vmcnt(0)" ::: "memory");
            const unsigned og = xb_add(&bar[XB_TOP], 1u);
            const unsigned tg = og / nx;
#ifdef XB_DIRECT_RELEASE
            if (og + 1u == (tg + 1u) * nx) {
#pragma unroll
                for (unsigned j = 0; j < 16; ++j) xb_add(&bar[XB_XGEN(j)], 1u); }
            else XB_SPIN(xb_ld(&bar[XB_XGEN(b.x)]) == gen, bar);
#else
            if (og + 1u == (tg + 1u) * nx) xb_add(&bar[XB_TOPGEN], 1u);
            else XB_SPIN(xb_ld(&bar[XB_TOPGEN]) == tg, bar);
#endif
#ifdef XB_REL_FIRST
            xb_add(&bar[XB_XGEN(b.x)], 1u);
            __builtin_amdgcn_fence(__ATOMIC_ACQUIRE, "agent");
#else
            __builtin_amdgcn_fence(__ATOMIC_ACQUIRE, "agent");
#ifndef XB_DIRECT_RELEASE
            xb_add(&bar[XB_XGEN(b.x)], 1u);
#endif
#endif
            asm volatile("s_waitcnt vmcnt(0)" ::: "memory");
        } else {
            XB_SPIN(xb_ld(&bar[XB_XGEN(b.x)]) == gen, bar);
            __builtin_amdgcn_fence(__ATOMIC_ACQUIRE, "agent");
            asm volatile("s_waitcnt vmcnt(0)" ::: "memory");
        }
    }
    __syncthreads();
}
#include <hip/hip_cooperative_groups.h>
#include <cstdio>
namespace cg = cooperative_groups;
#ifndef ONE_LAUNCH
#define ONE_LAUNCH 1
#endif
constexpr int LDS_BYTES = 148480;
static_assert(ML2_LDS <= LDS_BYTES && ML1_LDS <= LDS_BYTES && LRU1_LDS <= LDS_BYTES && RPM_LDS <= LDS_BYTES && att::SHM_ATTN <= LDS_BYTES && pg8::STAGE_BYTES + 1024 + 8192 + 15 * 512 <= LDS_BYTES - 64 - 256, "LDS map");

struct BMap { size_t off[64]; size_t total; };
static inline BMap b_map() {
    BMap m; size_t o = 0; int i = 0;
    auto add = [&](size_t bytes) { m.off[i++] = o; o += (bytes + 255) & ~(size_t)255; };
    add((size_t)DEPTH * 3 * 6 * D * 4);
    add((size_t)SEQ * 16 * 2 * 4);
    add((size_t)NT * D * 4);
    add((size_t)NT * TOPK * 4);
    add((size_t)256);
    add((size_t)NE * NT * 4);
    add((size_t)DEPTH * DINP * D * 2);
    add((size_t)DEPTH * D * DMIX * 2);
    add((size_t)DEPTH * NE * 2 * DE * D * 2);
    add((size_t)DEPTH * NE * D * DE * 2);
    add((size_t)DEPTH * 768 * QRANK * 2);
    add((size_t)DEPTH * 1024 * KVRANK * 2);
    add((size_t)NT * D * 2);
    add((size_t)NT * DMIX * 2);
    add((size_t)SLOT_MAX * DE * 2);
    add((size_t)NT * AH * QKD * 2);
    add((size_t)NT * AH * VD * 2);
    add((size_t)NT * DINP * 2);
    add((size_t)DEPTH * 4 * 256 * 64 * 2);
    add((size_t)DEPTH * 4 * 3 * 4096 * 2);
    add((size_t)DEPTH * 32 * 768 * 2);
    add((size_t)DEPTH * 2 * 256 * 4);
    add((size_t)2 * NT * 256 * 4);
    add((size_t)2 * NT * 256 * 4);
    add((size_t)2 * NB * NCH * 256 * 4);
    add((size_t)2 * NB * NCH * 256 * 4);
    add((size_t)2 * NT * 256 * 2);
    add((size_t)256);
    add((size_t)NT * 768 * 2);
    add((size_t)DEPTH * 1792 * 256 * 2);
    add((size_t)NT * 256 * 2);
    add((size_t)NT * 768 * 2);
    add((size_t)NT * 16 * 4);
    add((size_t)2 * NB * NCH * 4 * 4096 * 4);
    add((size_t)2 * NB * NCH * 4 * 64 * 4);
    add((size_t)2 * NB * NCH * 4 * 2 * 4);
    add((size_t)NT * TOPK * D * 2);
    add((size_t)XCD_BAR_WORDS * 4);
    add((size_t)2 * NB * NCH * 4 * 4096 * 2);
    add((size_t)2 * NB * NCH * 4 * 64 * 4);
    add((size_t)2 * NB * NCH * 4 * 4);
    add((size_t)NE * NT * 4);
    m.total = o; return m;
}
struct Args { P p; Q q; Q2 q2; unsigned* bar; };
static inline void fill_args(Args& a, void* const* d_in, void* d_out, void* d_ws) {
    for (int i = 0; i < N_IN; ++i) a.p.in[i] = (const float*)d_in[i];
    a.p.out = (float*)d_out; char* w = (char*)d_ws; const BMap m = b_map();
    a.p.MOD = (float*)(w + m.off[0]); a.p.ROPET = (float*)(w + m.off[1]); a.p.X = (float*)(w + m.off[2]); a.p.TOPG = (float*)(w + m.off[3]); a.p.CNT = (int*)(w + m.off[4]); a.p.LIST = (int*)(w + m.off[5]);
    a.q.WtIn = (bf16*)(w + m.off[6]); a.q.WtOut = (bf16*)(w + m.off[7]); a.q.WtGu = (bf16*)(w + m.off[8]); a.q.WtDn = (bf16*)(w + m.off[9]); a.q.WtQb = (bf16*)(w + m.off[10]); a.q.WtKvb = (bf16*)(w + m.off[11]);
    a.q.H16 = (bf16*)(w + m.off[12]); a.q.Y16 = (bf16*)(w + m.off[13]); a.q.ACT16 = (bf16*)(w + m.off[14]); a.q.K16 = (bf16*)(w + m.off[15]); a.q.V16 = (bf16*)(w + m.off[16]);
    a.q2.U16 = (bf16*)(w + m.off[17]); a.q2.WtL = (bf16*)(w + m.off[18]); a.q2.WtM = (bf16*)(w + m.off[19]); a.q2.WtG = (bf16*)(w + m.off[20]); a.q2.LSL = (float*)(w + m.off[21]);
    a.q2.HLOC = (bf16*)(w + m.off[22]); a.q2.PCUM = (bf16*)(w + m.off[23]); a.q2.SA = (float*)(w + m.off[24]); a.q2.SB = (float*)(w + m.off[25]);
    a.q2.QN16 = (bf16*)(w + m.off[26]); a.q2.KVN16 = a.q2.QN16 + (size_t)NT * 256;     a.q2.Q16 = (bf16*)(w + m.off[28]); a.q2.WtKvbP = (bf16*)(w + m.off[29]);
    a.q2.XCM16 = (bf16*)(w + m.off[30]); a.q2.QKV16 = (bf16*)(w + m.off[31]); a.q2.GATES = (float*)(w + m.off[32]); a.q2.CLOC = (float*)(w + m.off[33]); a.q2.NLOC = (float*)(w + m.off[34]); a.q2.MLB = (float*)(w + m.off[35]);
    a.q2.YB16 = (bf16*)(w + m.off[36]); a.bar = (unsigned*)(w + m.off[37]); a.q2.CST = (bf16*)(w + m.off[38]); a.q2.NST = (float*)(w + m.off[39]); a.q2.MST = (float*)(w + m.off[40]); a.q2.GLIST = (float*)(w + m.off[41]);
}

struct ULoad16 { const bf16* U; __device__ __forceinline__ float operator()(int t, int col) const { return bf2f(U[(size_t)t * DINP + col]); } };
struct YStore16 { bf16* Y; __device__ __forceinline__ void operator()(int t, int col, float v) const { Y[(size_t)t * DMIX + col] = (bf16)f2bf(v); } };
struct OutY16 { bf16* y; __device__ __forceinline__ void operator()(int row, int col, float v) const { y[(size_t)row * DMIX + col] = (bf16)f2bf(v); } };

enum { ST_INIT = 0, ST_RPFIRST, ST_INPROJ, ST_PREP, ST_MLAPROJ, ST_MIX, ST_OUTPROJ, ST_RPMID, ST_GU, ST_DOWN, ST_RPEND, N_ST };

typedef const __attribute__((address_space(4))) Args* KArgs;
__device__ __forceinline__ KArgs kargs() { KArgs k = (KArgs)__builtin_amdgcn_kernarg_segment_ptr(); asm volatile("" : "+s"(k)); return k; }
__device__ __forceinline__ void run_step(const Args& a_, int step, int l_, unsigned char* lds_raw) {
#if ONE_LAUNCH
    const Args& a = *(const Args*)kargs(); (void)a_;
#else
    const Args& a = a_;
#endif
    const int l = l_ & 0xff, sub = l_ >> 8;
    const P& p = a.p; const Q& q = a.q; const Q2& q2 = a.q2;
    LAS unsigned char* lds = (LAS unsigned char*)lds_raw; char* ldsg = (char*)lds_raw;
    int G_ = gridDim.x, bid_ = blockIdx.x; asm volatile("" : "+s"(G_), "+s"(bid_));
    const int G = G_, bid = bid_;
#define THREAD_IDS int tid_ = TIDX; asm volatile("" : "+v"(tid_)); const int tid = tid_, lane = tid & 63, wave = __builtin_amdgcn_readfirstlane(tid >> 6); \
    const int gw = bid * NWAVES + wave, ngw = G * NWAVES; const long gtid = (long)bid * NTHREADS + tid, nthr = (long)G * NTHREADS; (void)lane; (void)gw; (void)ngw; (void)gtid; (void)nthr;
    switch (step) {
    case ST_INIT: { THREAD_IDS
        if (sub == 0 || (sub & 1)) opt_init_mod(p, ldsg, bid, G, ONE_LAUNCH ? a.bar + XB_MODRDY : nullptr);
        if (sub == 0 || (sub & 2)) { opt_init_rope(p, gtid, nthr); opt_convert_small(p, q2, gtid, nthr); opt_init_wscale(p, q, (G - 1 - bid) * NWAVES + wave, ngw, lane); }
        if (sub == 0 || (sub & 4)) opt_convert_weights(p, q, q2.WtKvbP, lds, (G - 1 - bid) * NWAVES + wave, ngw, wave, lane);
#if ONE_LAUNCH
        __syncthreads();
        if (tid == 0) { unsigned* bar = a.bar; XB_SPIN(xb_ld(&bar[XB_MODRDY]) < (unsigned)MOD_FIRST_ITEMS, bar); __builtin_amdgcn_fence(__ATOMIC_ACQUIRE, "agent"); asm volatile("s_waitcnt vmcnt(0)" ::: "memory"); }
        __syncthreads();
        rp_first(p, q, gw, ngw, lane);
#endif
        break; }
    case ST_RPFIRST: { THREAD_IDS rp_first(p, q, gw, ngw, lane); break; }
    case ST_INPROJ: opt_inproj16(q, q2, l, lds, G, bid); break;
    case ST_PREP: { THREAD_IDS
        if (gtid < NE) p.CNT[gtid] = 0;
        const ULoad16 U{q2.U16};
        constexpr int NM = NB * NCH, NL = NB * NCH * 4;
        if (G > NM + 8) {
            if (bid < NM) { if (sub == 0 || (sub & 1)) ml1_item(p, q2, l, bid / NCH, bid % NCH, ldsg, U);
                if (sub == 0 || (sub & 2)) lru1_item(p, q2, l, (bid >> 2) / NCH, (bid >> 2) % NCH, bid & 3, ldsg, U); }
            else if (sub == 0 || (sub & 2)) for (int x = NM + (bid - NM); x < NL; x += G - NM) lru1_item(p, q2, l, (x >> 2) / NCH, (x >> 2) % NCH, x & 3, ldsg, U);
        } else for (int it = bid; it < NM + NL; it += G) {
            if (it < NM) { if (sub == 0 || (sub & 1)) ml1_item(p, q2, l, it / NCH, it % NCH, ldsg, U); }
            else if (sub == 0 || (sub & 2)) { const int x = it - NM; lru1_item(p, q2, l, (x >> 2) / NCH, (x >> 2) % NCH, x & 3, ldsg, U); } }
        if (sub == 0 || (sub & 4)) {
            constexpr int N4 = NL - NM - 3 * (256 - NM), NA = 256 - NM - N4, TA = 160, TB = 64;
            static_assert(N4 >= 0 && NA > 0 && NA * TA + N4 * TB >= NT && NT % 4 == 0, "MLA prep token deal");
            if (G == 256) { int base = NT, cnt = 0;
                if (bid >= NM + N4) { base = (bid - NM - N4) * TA; cnt = TA; } else if (bid >= NM) { base = NA * TA + (bid - NM) * TB; cnt = TB; }
                for (int off = wave * 4; off < cnt; off += NWAVES * 4) { const int t = base + off; if (t < NT) { const int tt[4] = {t, t + 1, t + 2, t + 3}; mla_prep_tokens<4>(p, q, q2, l, tt, lane, U); } }
            } else { int t = gw;
                for (; t + 3 * ngw < NT; t += 4 * ngw) { const int tt[4] = {t, t + ngw, t + 2 * ngw, t + 3 * ngw}; mla_prep_tokens<4>(p, q, q2, l, tt, lane, U); }
                for (; t < NT; t += ngw) mla_prep_token(p, q, q2, l, t, lane, U); } }
        break; }
    case ST_MLAPROJ: { if (sub == 0 || (sub & 1)) for (int it = G - 1 - bid; it < ML_SCAN_ITEMS; it += G) ml_scan_item(q2, it, ldsg);
        if (sub == 0 || (sub & 2)) opt_mla_proj(p, q, q2, l, lds, G, bid); break; }
    case ST_MIX: {
        const ULoad16 U{q2.U16}; const YStore16 Y{q.Y16};
        const int c = bid, vcu = (G % 8 == 0) ? (c % 8) * (G / 8) + c / 8 : c;
        constexpr int QB_LAT = SEQ / 256, QB_CTX = CTX / 256, NU_LAT = NB * AH * QB_LAT, NU_CTX = NB * AH * QB_CTX;
#ifdef ATTN_PROBE_VAR
        if (sub & 1) { struct NoOut { __device__ __forceinline__ void operator()(int, int, float) const {} } noout;
            for (int u = vcu; u < NU_LAT; u += G) { const int bh = u / QB_LAT, qb = u % QB_LAT, b = bh / AH, h = bh % AH, t0 = b * TPB + CTX + qb * 256;
                att::attn_unit<unsigned short, NoOut, ATTN_PROBE_VAR>((const unsigned short*)q2.Q16 + (size_t)t0 * 768 + h * QKD, 768, (const unsigned short*)q.K16 + ((size_t)b * AH + h) * TPB * QKD, (const unsigned short*)q.V16 + ((size_t)b * AH + h) * TPB * VD, TPB, ldsg, noout); } }
        else
#endif
        BgConv bg; { const int wv = __builtin_amdgcn_readfirstlane(TIDX >> 6);
            int first = bid * NWAVES + wv, strd = G * NWAVES, endi = BgConv::TOTAL;
            if (G == 256 && NB * NCH * 4 - 2 * 256 == 16 && NB * NCH == 132) {
                if (l + 1 < DEPTH) { constexpr int QP = 29, QR = 23, QC = 15, QL = 12, SP = 8 * QP * 108, SR = 8 * QR * 116, SC = 8 * QC * 16; static_assert(SP + SR + SC + 8 * QL * 16 >= BgConv::TOTAL, "tile quotas");
                    int st, qn; const int nctx = bid < 128 ? bid / 8 + 1 : 16;
                    if (bid >= 240) { st = SP + SR + SC + 8 * QL * (bid - 240); qn = QL; } else if (bid >= 132) { st = 8 * QP * (bid - 132); qn = QP; }
                    else if (bid < 128 && bid % 8 == 0) { st = SP + SR + 8 * QC * (bid / 8); qn = QC; } else { st = SP + 8 * QR * (bid - nctx); qn = QR; }
                    first = st + wv; strd = NWAVES; endi = st + 8 * qn < BgConv::TOTAL ? st + 8 * qn : BgConv::TOTAL;
                } else { constexpr int QR = 22, QP = 26; static_assert(8 * QR * 128 + 8 * QP * 128 >= BgConv::TOTAL, "tile quotas");
                    const int st = bid < 128 ? 8 * QR * bid : 8 * QR * 128 + 8 * QP * (bid - 128), qn = bid < 128 ? QR : QP;
                    first = st + wv; strd = NWAVES; endi = st + 8 * qn < BgConv::TOTAL ? st + 8 * qn : BgConv::TOTAL; } }
            bg.init(p, q, l, lds + att::SHM_ATTN, first, strd, endi, wv); }
        if (sub == 0 || (sub & 1)) for (int u = vcu; u < NU_LAT; u += G) { const int bh = u / QB_LAT, qb = u % QB_LAT, b = bh / AH, h = bh % AH, t0 = b * TPB + CTX + qb * 256;
            OutY16 out{q.Y16 + (size_t)t0 * DMIX + 256 + h * VD};
#ifdef BG_OFF
            att::attn_unit<unsigned short, OutY16>((const unsigned short*)q2.Q16 + (size_t)t0 * 768 + h * QKD, 768, (const unsigned short*)q.K16 + ((size_t)b * AH + h) * TPB * QKD, (const unsigned short*)q.V16 + ((size_t)b * AH + h) * TPB * VD, TPB, ldsg, out); }
#else
            att::attn_unit<unsigned short, OutY16, 0, BgConv&>((const unsigned short*)q2.Q16 + (size_t)t0 * 768 + h * QKD, 768, (const unsigned short*)q.K16 + ((size_t)b * AH + h) * TPB * QKD, (const unsigned short*)q.V16 + ((size_t)b * AH + h) * TPB * VD, TPB, ldsg, out, bg); }
#endif
        if ((sub == 0 || (sub & 1)) && l + 1 < DEPTH) for (int u = vcu; u < NU_CTX; u += G) { const int bh = u / QB_CTX, qb = u % QB_CTX, b = bh / AH, h = bh % AH, t0 = b * TPB + qb * 256;
            OutY16 out{q.Y16 + (size_t)t0 * DMIX + 256 + h * VD};
            att::attn_unit<unsigned short, OutY16>((const unsigned short*)q2.Q16 + (size_t)t0 * 768 + h * QKD, 768, (const unsigned short*)q.K16 + ((size_t)b * AH + h) * TPB * QKD, (const unsigned short*)q.V16 + ((size_t)b * AH + h) * TPB * VD, CTX, ldsg, out); }
        bg.drain(); __syncthreads();
        const int ch0 = (l + 1 < DEPTH) ? 0 : NCH_CTX, nch = NCH - ch0;
        if (sub == 0 || (sub & 2)) for (int it = G - 1 - c; it < NB * nch * 4; it += G) { const int x = it >> 2; ml2_item(p, q2, l, x / nch, ch0 + x % nch, it & 3, ldsg, U, Y); }
        if (sub == 0 || (sub & 4)) for (int it = c; it < NB * nch; it += G) lru2_item(q2, q.Y16, it / nch, ch0 + it % nch, ldsg);
        break; }
    case ST_OUTPROJ: opt_outproj(p, q, l, lds, G, bid, l + 1 == DEPTH); break;
    case ST_RPMID: rp_mid(p, q, q2.GLIST, l, ldsg, G, bid, l + 1 == DEPTH, sub != 0); break;
    case ST_GU: opt_moe_gu(p, q, l, lds, G, bid, sub); break;
    case ST_DOWN: opt_moe_down16(p, q, q2, l, lds, G, bid, sub); break;
    case ST_RPEND: { THREAD_IDS rp_end(p, q, q2, l, gw, ngw, lane, sub != 0 ? 0.f : 1.f); break; }
    }
}

#if ONE_LAUNCH
__global__ void __launch_bounds__(512, 2) k_mega(Args a) {
    extern __shared__ __attribute__((aligned(16))) unsigned char lds_raw[];
    volatile LAS unsigned* MISC = (volatile LAS unsigned*)((LAS unsigned char*)lds_raw + LDS_BYTES - 64);
    if (threadIdx.x < 16) MISC[threadIdx.x] = 0u;
    if ((threadIdx.x & 63) == 0) ((LAS int*)((LAS unsigned char*)lds_raw + WTAB_OFF))[HWID()] = threadIdx.x >> 6;
    __syncthreads();
    { const XcdBarrier b0 = xcd_barrier_post(kargs()->bar, MISC + 8); if (TIDX == 0) MISC[10] = b0.x; }
#define GRID_BAR() do { XcdBarrier b_; b_.bar = kargs()->bar; b_.st = MISC + 8; b_.x = MISC[10]; xcd_barrier(b_); } while (0)
    run_step(a, ST_INIT, 0, lds_raw); GRID_BAR();
#pragma unroll 1
    for (int l = 0; l < DEPTH; ++l) {
#pragma unroll 1
        for (int s = ST_INPROJ; s <= ST_RPEND; ++s) { run_step(a, s, l, lds_raw); if (!(l == DEPTH - 1 && s == ST_RPEND)) GRID_BAR();
#ifdef MEGA_DUP_STEP
            if (s == MEGA_DUP_STEP) { run_step(a, s, l, lds_raw); GRID_BAR(); }
#endif
        }
    }
}
#else
template <int STEP>
__global__ void __launch_bounds__(512, 2) k_step(Args a, int l) {
    extern __shared__ __attribute__((aligned(16))) unsigned char lds_raw[];
    run_step(a, STEP, l, lds_raw);
}
template <int STEP> static void launch_step(const Args& a, int l, hipStream_t stream) {
    static bool attr = false;
    if (!attr) { (void)hipFuncSetAttribute((const void*)k_step<STEP>, hipFuncAttributeMaxDynamicSharedMemorySize, LDS_BYTES); attr = true; }
    hipLaunchKernelGGL(k_step<STEP>, dim3(256), dim3(512), LDS_BYTES, stream, a, l);
}
#endif

extern "C" void kernel_launch(void* const* d_in, const int* in_sizes, int n_in, void* d_out, int out_size, void* d_ws, size_t ws_size, hipStream_t stream) {
    static int grid_blocks = 0;
    if (!grid_blocks) {
        int dev = 0, cus = 0;
        (void)hipGetDevice(&dev); (void)hipDeviceGetAttribute(&cus, hipDeviceAttributeMultiprocessorCount, dev);
        grid_blocks = cus;
#if ONE_LAUNCH
        int per_cu = 0;
        (void)hipFuncSetAttribute((const void*)k_mega, hipFuncAttributeMaxDynamicSharedMemorySize, LDS_BYTES);
        (void)hipOccupancyMaxActiveBlocksPerMultiprocessor(&per_cu, (const void*)k_mega, 512, LDS_BYTES);
        if (per_cu < 1) fprintf(stderr, "kernel_launch: occupancy query reports %d workgroups per CU\n", per_cu);
#endif
        const BMap m = b_map();
        if (n_in != N_IN || m.total > ws_size) fprintf(stderr, "kernel_launch: bad n_in %d or workspace too small (%zu needed, %zu given)\n", n_in, m.total, ws_size);
    }
    Args a{}; fill_args(a, d_in, d_out, d_ws);
#if ONE_LAUNCH
    (void)hipMemsetAsync(a.bar, 0, XCD_BAR_WORDS * 4, stream);
    void* args[] = {&a};
    hipError_t e = hipLaunchCooperativeKernel((const void*)k_mega, dim3(grid_blocks), dim3(512), args, LDS_BYTES, stream);
    if (e != hipSuccess) fprintf(stderr, "cooperative launch failed: %s (grid %d)\n", hipGetErrorString(e), grid_blocks);
#else
#ifndef DUP_STEP
#define DUP_STEP -1
#endif
#ifndef DUP_SUB
#define DUP_SUB 0
#endif
#define LS(ST, l) do { launch_step<ST>(a, l, stream); if (ST == DUP_STEP) launch_step<ST>(a, (l) | (DUP_SUB << 8), stream); } while (0)
    LS(ST_INIT, 0); LS(ST_RPFIRST, 0);
    for (int l = 0; l < DEPTH; ++l) {
        LS(ST_INPROJ, l); LS(ST_PREP, l); LS(ST_MLAPROJ, l); LS(ST_MIX, l); LS(ST_OUTPROJ, l);
        LS(ST_RPMID, l); LS(ST_GU, l); LS(ST_DOWN, l); LS(ST_RPEND, l);
    }
#endif
}
```
